# Optimizing an MI355X kernel written in HIP

```python
import math
import jax
import jax.numpy as jnp
from jax import lax
import numpy as np

D_MODEL = 1024
BATCH = 2
SEQ = 8192
DEPTH = 4

A_HEAD_DIM = 64
A_HEADS = D_MODEL // A_HEAD_DIM
A_KV_HEADS = 2
A_GROUP = A_HEADS // A_KV_HEADS
WINDOW = 128
ATTN_BLOCK = 128
ROPE_THETA = 10000.0
R_HEADS = 4
R_KEY_DIM = D_MODEL // 8
R_VAL_DIM = 2 * R_KEY_DIM
RET_CHUNK = 128
A_Q = A_HEADS * A_HEAD_DIM
A_KV = A_KV_HEADS * A_HEAD_DIM
R_QK = R_HEADS * R_KEY_DIM
R_V = R_HEADS * R_VAL_DIM
AB_SPLITS = (A_Q, A_Q + A_KV, A_Q + 2 * A_KV, A_Q + 2 * A_KV + R_QK,
             A_Q + 2 * A_KV + 2 * R_QK, A_Q + 2 * A_KV + 2 * R_QK + R_V)
AB_IN = A_Q + 2 * A_KV + 2 * R_QK + 2 * R_V
AB_OUT = A_Q + R_V
SGU_CHUNK = 128
SGU_GROUPS = 4
SGU_GROUP_DIM = D_MODEL // 4
SGU_WIDTH = SGU_GROUPS * SGU_GROUP_DIM
LRU_HEADS = 5
LRU_BLOCK = 256
LRU_WIDTH = LRU_HEADS * LRU_BLOCK
CONV_WIDTH = 4
LRU_C = 8.0
CD_SPLITS = (SGU_WIDTH, 2 * SGU_WIDTH, 2 * SGU_WIDTH + LRU_WIDTH)
CD_IN = 2 * SGU_WIDTH + 2 * LRU_WIDTH
CD_OUT = SGU_WIDTH + LRU_WIDTH
N_EXPERTS = 128
TOP_K = 8
EXPERT_DIM = 256
SHARED_DIM = 256
ROUTE_SCALE = 2.5
EXPERT_BLOCK = 128
DEEPNORM_ALPHA = (2 * DEPTH) ** 0.25
DEEPNORM_BETA = (8 * DEPTH) ** -0.25
N_AB = (DEPTH + 1) // 2
N_CD = DEPTH // 2
LN_EPS = 1e-5
NEG_INF = -1e30

kernel_name = "hybrid_swa_retention_sgu_rglru_moe_deepnorm"

F32 = jnp.float32


def _standardize(x):
    xf = x.astype(F32)
    xc = xf - jnp.mean(xf, axis=-1, keepdims=True)
    return xc * lax.rsqrt(jnp.mean(xc * xc, axis=-1, keepdims=True) + LN_EPS)


def layer_norm(x, g, b):
    return (_standardize(x) * g.astype(F32) + b.astype(F32)).astype(x.dtype)


def rope(x, inv_freq):
    S = x.shape[1]
    ang = jnp.arange(S, dtype=F32)[:, None] * inv_freq[None, :]
    cos = jnp.cos(ang)[:, None, :]
    sin = jnp.sin(ang)[:, None, :]
    xf = x.astype(F32)
    x1, x2 = jnp.split(xf, 2, axis=-1)
    return jnp.concatenate([x1 * cos - x2 * sin, x2 * cos + x1 * sin], axis=-1).astype(x.dtype)


def sliding_window_attention(q, k, v, sinks):
    Bsz, S, _, d = q.shape
    C = ATTN_BLOCK
    N = S // C
    qb = q.reshape(Bsz, N, C, A_KV_HEADS, A_GROUP, d)
    kb = k.reshape(Bsz, N, C, A_KV_HEADS, d)
    vb = v.reshape(Bsz, N, C, A_KV_HEADS, d)

    def with_prev(t):
        prev = jnp.pad(t[:, :-1], ((0, 0), (1, 0), (0, 0), (0, 0), (0, 0)))
        return jnp.concatenate([prev, t], axis=2)

    kw, vw = with_prev(kb), with_prev(vb)
    s = jnp.einsum('bnqhgd,bnkhd->bnhgqk', qb, kw, preferred_element_type=F32) * (d ** -0.5)
    n_idx = jnp.arange(N)[:, None, None]
    q_idx = jnp.arange(C)[None, :, None]
    k_idx = jnp.arange(2 * C)[None, None, :]
    rel = C + q_idx - k_idx
    valid = (rel >= 0) & (rel < WINDOW) & ((n_idx > 0) | (k_idx >= C))
    s = jnp.where(valid[None, :, None, None], s, NEG_INF)
    sink = jnp.broadcast_to(sinks.astype(F32).reshape(1, 1, A_KV_HEADS, A_GROUP, 1, 1), s.shape[:-1] + (1,))
    p = jax.nn.softmax(jnp.concatenate([s, sink], axis=-1), axis=-1)[..., :-1]
    o = jnp.einsum('bnhgqk,bnkhd->bnqhgd', p.astype(v.dtype), vw)
    return o.reshape(Bsz, S, A_HEADS * d)


def retention(q, k, v):
    Bsz, S, H, dk = q.shape
    dv = v.shape[-1]
    C = RET_CHUNK
    N = S // C
    log_g = jnp.log1p(-jnp.exp2(-5.0 - jnp.arange(H, dtype=F32)))
    qf = q.astype(F32).reshape(Bsz, N, C, H, dk)
    kf = k.astype(F32).reshape(Bsz, N, C, H, dk) * (dk ** -0.5)
    vf = v.astype(F32).reshape(Bsz, N, C, H, dv)
    idx = jnp.arange(C, dtype=F32)
    diff = idx[:, None] - idx[None, :]
    decay = jnp.where(diff >= 0, jnp.exp(log_g[:, None, None] * jnp.maximum(diff, 0.0)), 0.0)
    s = jnp.einsum('bnihd,bnjhd->bnhij', qf, kf) * decay[None, None]
    o_intra = jnp.einsum('bnhij,bnjhe->bnihe', s, vf)
    k_dec = kf * jnp.exp(log_g[None, :] * (C - 1.0 - idx)[:, None])[None, None, :, :, None]
    kv = jnp.einsum('bnjhd,bnjhe->nbhde', k_dec, vf)
    g_chunk = jnp.exp(log_g * C)[None, :, None, None]

    def step(state, kv_n):
        return g_chunk * state + kv_n, state

    _, s_prev = lax.scan(step, jnp.zeros_like(kv[0]), kv)
    q_dec = qf * jnp.exp(log_g[None, :] * (idx + 1.0)[:, None])[None, None, :, :, None]
    o_cross = jnp.einsum('bnihd,nbhde->bnihe', q_dec, s_prev)
    return (o_intra + o_cross).reshape(Bsz, S, H, dv)


def ab_mixer(x, w_in, b_in, sinks, w_out, b_out):
    Bsz, S, _ = x.shape
    z = x @ w_in + b_in
    q, k, v, rq, rk, rv, rg = jnp.split(z, AB_SPLITS, axis=-1)
    attn_freq = ROPE_THETA ** (-jnp.arange(0, A_HEAD_DIM, 2, dtype=F32) / A_HEAD_DIM)
    q = rope(q.reshape(Bsz, S, A_HEADS, A_HEAD_DIM), attn_freq)
    k = rope(k.reshape(Bsz, S, A_KV_HEADS, A_HEAD_DIM), attn_freq)
    v = v.reshape(Bsz, S, A_KV_HEADS, A_HEAD_DIM)
    y_a = sliding_window_attention(q, k, v, sinks)
    ret_freq = ROPE_THETA ** (-jnp.linspace(0.0, 1.0, R_KEY_DIM // 2, dtype=F32))
    rq = rope(rq.reshape(Bsz, S, R_HEADS, R_KEY_DIM), ret_freq)
    rk = rope(rk.reshape(Bsz, S, R_HEADS, R_KEY_DIM), ret_freq)
    ro = retention(rq, rk, rv.reshape(Bsz, S, R_HEADS, R_VAL_DIM))
    ro = _standardize(ro).reshape(Bsz, S, R_V)
    y_b = (jax.nn.silu(rg.astype(F32)) * ro).astype(x.dtype)
    return jnp.concatenate([y_a, y_b], axis=-1) @ w_out + b_out


def spatial_gating(u, v, w_s, b_s):
    Bsz, S, W = v.shape
    N = S // SGU_CHUNK
    vn = _standardize(v).reshape(Bsz, N, SGU_CHUNK, SGU_GROUPS, SGU_GROUP_DIM)
    w = jnp.tril(w_s.astype(F32))
    mixed = jnp.einsum('gij,bnjgd->bnigd', w, vn) + b_s.astype(F32).T[None, None, :, :, None]
    return u * mixed.reshape(Bsz, S, W).astype(u.dtype)


def rg_lru(xr, conv_w, conv_b, wa, ba, wx, bx, lam):
    Bsz, S, W = xr.shape
    xc = lax.conv_general_dilated(xr, conv_w[:, None, :], window_strides=(1,),
                                  padding=[(CONV_WIDTH - 1, 0)],
                                  dimension_numbers=('NWC', 'WIO', 'NWC'),
                                  feature_group_count=W) + conv_b
    xb = xc.reshape(Bsz, S, LRU_HEADS, LRU_BLOCK)
    gate_r = jax.nn.sigmoid((jnp.einsum('bshi,hij->bshj', xb, wa).reshape(Bsz, S, W) + ba).astype(F32))
    gate_i = jax.nn.sigmoid((jnp.einsum('bshi,hij->bshj', xb, wx).reshape(Bsz, S, W) + bx).astype(F32))
    log_a = -LRU_C * gate_r * jax.nn.softplus(-lam.astype(F32))
    a = jnp.exp(log_a)
    b = jnp.sqrt(-jnp.expm1(2.0 * log_a)) * (gate_i * xc.astype(F32))

    def combine(left, right):
        a1, b1 = left
        a2, b2 = right
        return a1 * a2, a2 * b1 + b2

    _, h = lax.associative_scan(combine, (a, b), axis=1)
    return h.astype(xr.dtype)


def cd_mixer(x, w_in, b_in, sgu_w, sgu_b, conv_w, conv_b, wa, ba, wx, bx, lam, w_out, b_out):
    z = x @ w_in + b_in
    u, v, gate, xr = jnp.split(z, CD_SPLITS, axis=-1)
    y_c = spatial_gating(jax.nn.gelu(u), jax.nn.gelu(v), sgu_w, sgu_b)
    y_d = jax.nn.gelu(gate) * rg_lru(xr, conv_w, conv_b, wa, ba, wx, bx, lam)
    return jnp.concatenate([y_c, y_d], axis=-1) @ w_out + b_out


def moe_ffn(x, w_router, b_router, w_gate, w_up, w_down, ws_gate, ws_up, ws_down):
    Bsz, S, D = x.shape
    T = Bsz * S
    TK = T * TOP_K
    xt = x.reshape(T, D)
    scores = jax.nn.sigmoid(jnp.matmul(xt.astype(F32), w_router.astype(F32)))
    _, top_idx = lax.top_k(scores + b_router.astype(F32), TOP_K)
    top_s = jnp.take_along_axis(scores, top_idx, axis=-1)
    gates = top_s / jnp.sum(top_s, axis=-1, keepdims=True) * ROUTE_SCALE
    flat_e = top_idx.reshape(-1)
    flat_t = jnp.repeat(jnp.arange(T, dtype=jnp.int32), TOP_K)
    flat_g = gates.reshape(-1)
    order = jnp.argsort(flat_e)
    se, st, sg = flat_e[order], flat_t[order], flat_g[order]
    counts = jnp.bincount(flat_e, length=N_EXPERTS)
    padded = (counts + EXPERT_BLOCK - 1) // EXPERT_BLOCK * EXPERT_BLOCK
    start = jnp.cumsum(counts) - counts
    padded_end = jnp.cumsum(padded)
    padded_start = padded_end - padded
    dest = padded_start[se] + jnp.arange(TK, dtype=jnp.int32) - start[se]
    n_rows = -(-TK // EXPERT_BLOCK) * EXPERT_BLOCK + N_EXPERTS * EXPERT_BLOCK
    n_blocks = n_rows // EXPERT_BLOCK
    row_tok = jnp.zeros((n_rows,), jnp.int32).at[dest].set(st)
    row_gate = jnp.zeros((n_rows,), F32).at[dest].set(sg)
    block_e = jnp.minimum(jnp.searchsorted(padded_end, jnp.arange(n_blocks) * EXPERT_BLOCK, side='right'),
                          N_EXPERTS - 1)

    def expert_block(acc, blk):
        tok, g, e = blk
        xb = xt[tok]
        h = jax.nn.silu(xb @ w_gate[e]) * (xb @ w_up[e])
        y = (h @ w_down[e]).astype(F32) * g[:, None]
        return acc.at[tok].add(y), None

    routed, _ = lax.scan(expert_block, jnp.zeros((T, D), F32),
                         (row_tok.reshape(n_blocks, EXPERT_BLOCK), row_gate.reshape(n_blocks, EXPERT_BLOCK), block_e))
    shared = (jax.nn.silu(xt @ ws_gate) * (xt @ ws_up)) @ ws_down
    return (routed.astype(x.dtype) + shared).reshape(Bsz, S, D)


def setup_inputs(seed: int = 0) -> dict:
    key = jax.random.key(seed)
    ks = iter(jax.random.split(key, 40))

    def nrm(shape, scale):
        return jax.random.normal(next(ks), shape, F32) * scale

    D = D_MODEL
    u = jax.random.uniform(next(ks), (N_CD, LRU_WIDTH), F32, minval=0.9, maxval=0.999)
    a0 = u ** (1.0 / LRU_C)
    lru_lambda = jnp.log(a0) - jnp.log1p(-a0)
    return {
        "x": nrm((BATCH, SEQ, D), 1.0),
        "ab_w_in": nrm((N_AB, D, AB_IN), D ** -0.5),
        "ab_b_in": nrm((N_AB, AB_IN), 0.02),
        "ab_sinks": nrm((N_AB, A_HEADS), 1.0),
        "ab_w_out": nrm((N_AB, AB_OUT, D), AB_OUT ** -0.5 * DEEPNORM_BETA),
        "ab_b_out": nrm((N_AB, D), 0.02),
        "cd_w_in": nrm((N_CD, D, CD_IN), D ** -0.5),
        "cd_b_in": nrm((N_CD, CD_IN), 0.02),
        "sgu_w": nrm((N_CD, SGU_GROUPS, SGU_CHUNK, SGU_CHUNK), SGU_CHUNK ** -0.5),
        "sgu_b": 1.0 + nrm((N_CD, SGU_GROUPS, SGU_CHUNK), 0.1),
        "conv_w": nrm((N_CD, CONV_WIDTH, LRU_WIDTH), CONV_WIDTH ** -0.5),
        "conv_b": nrm((N_CD, LRU_WIDTH), 0.02),
        "lru_wa": nrm((N_CD, LRU_HEADS, LRU_BLOCK, LRU_BLOCK), LRU_BLOCK ** -0.5),
        "lru_ba": nrm((N_CD, LRU_WIDTH), 0.02),
        "lru_wx": nrm((N_CD, LRU_HEADS, LRU_BLOCK, LRU_BLOCK), LRU_BLOCK ** -0.5),
        "lru_bx": nrm((N_CD, LRU_WIDTH), 0.02),
        "lru_lambda": lru_lambda,
        "cd_w_out": nrm((N_CD, CD_OUT, D), CD_OUT ** -0.5 * DEEPNORM_BETA),
        "cd_b_out": nrm((N_CD, D), 0.02),
        "ln_mix_g": 1.0 + nrm((DEPTH, D), 0.02),
        "ln_mix_b": nrm((DEPTH, D), 0.02),
        "router_w": nrm((DEPTH, D, N_EXPERTS), D ** -0.5),
        "router_b": nrm((DEPTH, N_EXPERTS), 0.01),
        "exp_w_gate": nrm((DEPTH, N_EXPERTS, D, EXPERT_DIM), D ** -0.5),
        "exp_w_up": nrm((DEPTH, N_EXPERTS, D, EXPERT_DIM), D ** -0.5),
        "exp_w_down": nrm((DEPTH, N_EXPERTS, EXPERT_DIM, D), EXPERT_DIM ** -0.5 * DEEPNORM_BETA),
        "shared_w_gate": nrm((DEPTH, D, SHARED_DIM), D ** -0.5),
        "shared_w_up": nrm((DEPTH, D, SHARED_DIM), D ** -0.5),
        "shared_w_down": nrm((DEPTH, SHARED_DIM, D), SHARED_DIM ** -0.5 * DEEPNORM_BETA),
        "ln_ffn_g": 1.0 + nrm((DEPTH, D), 0.02),
        "ln_ffn_b": nrm((DEPTH, D), 0.02),
    }


def reference(x, ab_w_in, ab_b_in, ab_sinks, ab_w_out, ab_b_out,
              cd_w_in, cd_b_in, sgu_w, sgu_b, conv_w, conv_b,
              lru_wa, lru_ba, lru_wx, lru_bx, lru_lambda, cd_w_out, cd_b_out,
              ln_mix_g, ln_mix_b, router_w, router_b, exp_w_gate, exp_w_up, exp_w_down,
              shared_w_gate, shared_w_up, shared_w_down, ln_ffn_g, ln_ffn_b):
    for layer in range(DEPTH):
        j = layer // 2
        if layer % 2 == 0:
            h = ab_mixer(x, ab_w_in[j], ab_b_in[j], ab_sinks[j], ab_w_out[j], ab_b_out[j])
        else:
            h = cd_mixer(x, cd_w_in[j], cd_b_in[j], sgu_w[j], sgu_b[j], conv_w[j], conv_b[j],
                         lru_wa[j], lru_ba[j], lru_wx[j], lru_bx[j], lru_lambda[j],
                         cd_w_out[j], cd_b_out[j])
        x = layer_norm(DEEPNORM_ALPHA * x + h, ln_mix_g[layer], ln_mix_b[layer])
        f = moe_ffn(x, router_w[layer], router_b[layer], exp_w_gate[layer], exp_w_up[layer],
                    exp_w_down[layer], shared_w_gate[layer], shared_w_up[layer], shared_w_down[layer])
        x = layer_norm(DEEPNORM_ALPHA * x + f, ln_ffn_g[layer], ln_ffn_b[layer])
    return x
```

```cpp
#include <hip/hip_runtime.h>
#include <cstdio>
#include <cstdint>

#define LAS __attribute__((address_space(3)))
typedef unsigned short bf16_t;
typedef short bf16x8 __attribute__((ext_vector_type(8)));
typedef float f32x4 __attribute__((ext_vector_type(4)));
typedef float f32x2 __attribute__((ext_vector_type(2)));
typedef unsigned u32x4 __attribute__((ext_vector_type(4)));
typedef unsigned u32x2 __attribute__((ext_vector_type(2)));

constexpr int T = 16384, D = 1024, SEQ = 8192;
constexpr int AB_IN = 4352, AB_OUT = 2048, CD_IN = 4608, CD_OUT = 2304;
constexpr int NE = 128, NE1 = 129, TOPK = 8, ED = 256;
constexpr int TK = T * TOPK;
constexpr int NSLOT = TK + T;
constexpr int LISTCAP = 16384;
constexpr float ALPHA = 1.681792830507429f;
constexpr float LN_EPS = 1e-5f;

#ifndef N_LAUNCH_MODE
#define N_LAUNCH_MODE 0
#endif

constexpr size_t al256(size_t x) { return (x + 255) & ~(size_t)255; }
constexpr size_t WS_CTL    = 0;
constexpr size_t CTL_BYTES = 65536;
constexpr size_t CTL_CNT   = 32768;
constexpr size_t WS_WABIN  = CTL_BYTES;
constexpr size_t WS_WABOUT = WS_WABIN  + al256((size_t)2 * AB_IN * D * 2);
constexpr size_t WS_WCDIN  = WS_WABOUT + al256((size_t)2 * D * AB_OUT * 2);
constexpr size_t WS_WCDOUT = WS_WCDIN  + al256((size_t)2 * CD_IN * D * 2);
constexpr size_t WS_WRT    = WS_WCDOUT + al256((size_t)2 * D * CD_OUT * 2);
constexpr size_t WS_WGU    = WS_WRT    + al256((size_t)4 * 256 * D * 2);
constexpr size_t WS_WDN    = WS_WGU    + al256((size_t)4 * NE1 * 512 * D * 2);
constexpr size_t WS_X      = WS_WDN    + al256((size_t)4 * NE1 * D * ED * 2);
constexpr size_t WS_XB     = WS_X      + al256((size_t)T * D * 4);
constexpr size_t WS_U1     = WS_XB     + al256((size_t)T * D * 2);
constexpr size_t U1_BYTES  = al256((size_t)NSLOT * D * 2) > al256((size_t)T * CD_IN * 4) ? al256((size_t)NSLOT * D * 2) : al256((size_t)T * CD_IN * 4);
constexpr size_t WS_U2     = WS_U1     + U1_BYTES;
constexpr size_t U2_BYTES  = al256((size_t)T * 1280 * 4 * 3);
constexpr size_t WS_YCAT   = WS_U2     + U2_BYTES;
constexpr size_t WS_H      = WS_YCAT   + al256((size_t)T * CD_OUT * 2);
constexpr size_t WS_ZR     = WS_H      + al256((size_t)T * D * 4);
constexpr size_t WS_HID    = WS_ZR     + al256((size_t)T * 256 * 4);
constexpr size_t WS_LIST   = WS_HID    + al256((size_t)NSLOT * ED * 2);
constexpr size_t WS_GATE   = WS_LIST   + al256((size_t)NE * LISTCAP * 4);
constexpr size_t WS_END    = WS_GATE   + al256((size_t)NSLOT * 4);

__device__ __forceinline__ float bf2f(bf16_t b) { return __uint_as_float(((unsigned)b) << 16); }
__device__ __forceinline__ bf16_t f2bf(float f) { unsigned u = __float_as_uint(f); u += 0x7FFFu + ((u >> 16) & 1u); return (bf16_t)(u >> 16); }
__device__ __forceinline__ unsigned pk2(float lo, float hi) { return (unsigned)f2bf(lo) | ((unsigned)f2bf(hi) << 16); }
__device__ __forceinline__ float wave_sum(float v) {
#pragma unroll
    for (int o = 32; o; o >>= 1) v += __shfl_xor(v, o);
    return v; }
__device__ __forceinline__ float wave_max(float v) {
#pragma unroll
    for (int o = 32; o; o >>= 1) v = fmaxf(v, __shfl_xor(v, o));
    return v; }
__device__ __forceinline__ float gelu_tanh(float x) { const float u = 0.7978845608028654f * (x + 0.044715f * x * x * x); return 0.5f * x * (1.f + tanhf(u)); }
__device__ __forceinline__ float sigmoidf_(float x) { return 1.f / (1.f + __expf(-x)); }
__device__ __forceinline__ float siluf_(float x) { return x / (1.f + __expf(-x)); }

#define XB_TMO      128
#define XB_XCNT(j)  (256  + 64 * (j))
#define XB_XSUB(j)  (1280 + 64 * (j))
#define XB_XGEN(j)  (2304 + 64 * (j))
#define XB_TOP      3328
#define XB_TOPGEN   3392
#define XCD_BAR_WORDS 3456
#define XB_SPIN_CAP (1u << 22)

__device__ __forceinline__ unsigned xb_ld(unsigned* p)              { return __hip_atomic_load(p, __ATOMIC_RELAXED, __HIP_MEMORY_SCOPE_AGENT); }
__device__ __forceinline__ unsigned xb_add(unsigned* p, unsigned v) { return __hip_atomic_fetch_add(p, v, __ATOMIC_RELAXED, __HIP_MEMORY_SCOPE_AGENT); }
__device__ __forceinline__ unsigned xb_xcc_id() { return (unsigned)__builtin_amdgcn_s_getreg((3 << 11) | 20) & 0xFu; }
#define XB_SPIN(cond, bar) do { unsigned _sp = 0; while (cond) { __builtin_amdgcn_s_sleep(1); \
    if ((++_sp & 255u) == 0u) { if (xb_ld(&(bar)[XB_TMO])) break; if (_sp > XB_SPIN_CAP) { atomicAdd(&(bar)[XB_TMO], 1u); break; } } } } while (0)

struct XcdBarrier { unsigned* bar; unsigned x; volatile LAS unsigned* st; };

__device__ __forceinline__ XcdBarrier xcd_barrier_post(unsigned* bar, volatile LAS unsigned* st) {
    XcdBarrier b; b.bar = bar; b.x = xb_xcc_id(); b.st = st;
    if (threadIdx.x == 0) (void)xb_add(&bar[XB_XCNT(b.x)], 1u);
    return b;
}
__device__ __forceinline__ void xcd_barrier_complete(unsigned* bar, unsigned x, unsigned& nloc, unsigned& nx) {
    const unsigned G = gridDim.x * gridDim.y * gridDim.z;
    unsigned sum, cnt, mine, sp = 0u;
    for (;;) {
        sum = 0u; cnt = 0u; mine = 0u;
#pragma unroll
        for (unsigned j = 0; j < 16; ++j) { const unsigned c = xb_ld(&bar[XB_XCNT(j)]); sum += c; cnt += (c > 0u) ? 1u : 0u; mine = (j == x) ? c : mine; }
        if (sum == G) break;
        __builtin_amdgcn_s_sleep(1);
        if ((++sp & 255u) == 0u) { if (xb_ld(&bar[XB_TMO])) break; if (sp > XB_SPIN_CAP) { atomicAdd(&bar[XB_TMO], 1u); break; } }
    }
    nloc = mine > 0u ? mine : 1u; nx = cnt > 0u ? cnt : 1u;
}
__device__ __forceinline__ void xcd_barrier(const XcdBarrier& b) {
    asm volatile("s_waitcnt vmcnt(0)" ::: "memory");
    __syncthreads();
    if (threadIdx.x == 0) {
        unsigned* bar = b.bar;
        __builtin_amdgcn_s_waitcnt(0);
        unsigned nloc = b.st[0], nx = b.st[1];
        if (nloc == 0u) { xcd_barrier_complete(bar, b.x, nloc, nx); b.st[0] = nloc; b.st[1] = nx; }
        const unsigned old = xb_add(&bar[XB_XSUB(b.x)], 1u);
        const unsigned gen = old / nloc;
        if (old + 1u == (gen + 1u) * nloc) {
            __builtin_amdgcn_fence(__ATOMIC_RELEASE, "agent");
            asm volatile("s_waitcnt vmcnt(0)" ::: "memory");
            const unsigned og = xb_add(&bar[XB_TOP], 1u);
            const unsigned tg = og / nx;
            if (og + 1u == (tg + 1u) * nx) xb_add(&bar[XB_TOPGEN], 1u);
            else XB_SPIN(xb_ld(&bar[XB_TOPGEN]) == tg, bar);
            __builtin_amdgcn_fence(__ATOMIC_ACQUIRE, "agent");
            xb_add(&bar[XB_XGEN(b.x)], 1u);
            asm volatile("s_waitcnt vmcnt(0)" ::: "memory");
        } else {
            XB_SPIN(xb_ld(&bar[XB_XGEN(b.x)]) == gen, bar);
            __builtin_amdgcn_fence(__ATOMIC_ACQUIRE, "agent");
            asm volatile("s_waitcnt vmcnt(0)" ::: "memory");
        }
    }
    __syncthreads();
}

namespace g8 {
constexpr int BM = 256, BK = 64, HALF = 128, HTB = HALF * BK * 2, STAGE_BYTES = 8 * HTB, NXCD = 8, WGM = 8;
__device__ __forceinline__ int lds_byte(int r, int c) { const int st = (r >> 4) * 2 + (c >> 5), rr = r & 15, cc = c & 31, ob = rr * 64 + cc * 2; return st * 1024 + (ob ^ (((ob >> 9) & 1) << 5)); }
__device__ __forceinline__ void stage_rc(int b, int& R, int& C) { const int st = b / 1024, sb = b % 1024, swz = sb ^ (((sb >> 9) & 1) << 5); R = (st >> 1) * 16 + swz / 64; C = (st & 1) * 32 + (swz % 64) / 2; }
__device__ __forceinline__ int perm32(int rho) { const int n = rho >> 4, i = rho & 15; return 8 * (i >> 2) + 4 * n + (i & 3); }

struct Unit { const char* A; const char* B; int pm, pn, aux; };

struct DenseOrder {
    const char* A; const char* Bt; int nM, nN, nwg, G, c, K;
    __device__ void init(const void* A_, const void* Bt_, int M, int N, int K_, int G_, int c_) { A = (const char*)A_; Bt = (const char*)Bt_; nM = M / BM; nN = N / BM; nwg = nM * nN; G = G_; c = c_; K = K_; }
    __device__ __forceinline__ bool next(int i, Unit& u) const {
        const long L = (long)i * G + c; if (L >= nwg) return false;
        int wgid = (int)L; { const int q = nwg / NXCD, r = nwg % NXCD, xcd = wgid % NXCD, off = wgid / NXCD; wgid = (xcd < r ? xcd * (q + 1) : r * (q + 1) + (xcd - r) * q) + off; }
        const int nig = WGM * nN, gid = wgid / nig, fm = gid * WGM, gsz = (nM - fm) < WGM ? (nM - fm) : WGM;
        u.pm = fm + ((wgid % nig) % gsz); u.pn = (wgid % nig) / gsz; u.aux = 0;
        u.A = A + (size_t)u.pm * BM * K * 2; u.B = Bt + (size_t)u.pn * BM * K * 2; return true;
    }
    __device__ __forceinline__ void aoff(const Unit&, int tid, unsigned (&o)[2][2]) const {
#pragma unroll
        for (int i = 0; i < 2; ++i) { int R, C; stage_rc(tid * 16 + i * 8192, R, C);
            o[0][i] = (unsigned)(R * K + C) * 2u; o[1][i] = (unsigned)((R + HALF) * K + C) * 2u; }
    }
};

__device__ __forceinline__ unsigned cvt_pk_bf16(float lo, float hi) { unsigned r; asm volatile("v_cvt_pk_bf16_f32 %0, %1, %2" : "=v"(r) : "v"(lo), "v"(hi)); return r; }

struct EpiF32 {
    static constexpr bool PERM = false;
    float* C; int ldc; const float* bias;
    __device__ __forceinline__ void operator()(const f32x4 (&acc)[2][2][4][2], const Unit& u, int wr, int wc, int fr, int fq) const {
        const int row0 = u.pm * BM + wr * 64 + fr, col0 = u.pn * BM + wc * 32 + 4 * fq;
        f32x4 bv[2][2];
#pragma unroll
        for (int bj = 0; bj < 2; ++bj)
#pragma unroll
            for (int n = 0; n < 2; ++n) bv[bj][n] = bias ? *(const f32x4*)(bias + col0 + bj * HALF + n * 16) : (f32x4){0.f, 0.f, 0.f, 0.f};
#pragma unroll
        for (int ai = 0; ai < 2; ++ai)
#pragma unroll
            for (int m = 0; m < 4; ++m) { float* rowp = C + (size_t)(row0 + ai * HALF + m * 16) * ldc + col0;
#pragma unroll
                for (int bj = 0; bj < 2; ++bj)
#pragma unroll
                    for (int n = 0; n < 2; ++n) *(f32x4*)(rowp + bj * HALF + n * 16) = acc[ai][bj][m][n] + bv[bj][n]; }
    }
};

template <class Epi, class Sched>
__device__ __forceinline__ void gemm_phase(LAS unsigned char* lds, const int K, const Sched& S, const Epi& E) {
    int tid_ = threadIdx.x; asm volatile("" : "+v"(tid_));
    const int tid = tid_, wid = __builtin_amdgcn_readfirstlane(tid >> 6), lane = tid & 63, wr = wid >> 2, wc = wid & 3, fr = lane & 15, fq = lane >> 4;
    const int nt = K / BK;
    unsigned voffB[2];
#pragma unroll
    for (int i = 0; i < 2; ++i) { int R, C; stage_rc(tid * 16 + i * 8192, R, C); const int Rb = Epi::PERM ? ((R & ~31) + perm32(R & 31)) : R;
        voffB[i] = (unsigned)(Rb * K + C) * 2u; }
    const size_t kstep = (size_t)(BK * 2);
    const size_t hstep = (size_t)HALF * K * 2;
    const unsigned ldsw = (unsigned)wid * 1024u;
    const int aoff = lds_byte(wr * 64 + fr, fq * 8), boff = lds_byte(wc * 32 + fr, fq * 8);
#define G8_SA(b, h) (((b) * 2 + (h)) * HTB)
#define G8_SB(b, h) ((4 + (b) * 2 + (h)) * HTB)
#define G8_STAGE(bufoff, gbase, voff) do { _Pragma("unroll") for (int _i = 0; _i < 2; ++_i) \
        __builtin_amdgcn_global_load_lds((const unsigned*)((const char*)(gbase) + (voff)[_i]), (LAS unsigned*)(lds + (bufoff) + ldsw + _i * 8192), 16, 0, 0); } while (0)
#define G8_LDA(dst, b, h) do { _Pragma("unroll") for (int m = 0; m < 4; ++m) _Pragma("unroll") for (int k = 0; k < 2; ++k) dst[m][k] = *(const LAS bf16x8*)(lds + G8_SA(b, h) + aoff + m * 2048 + k * 1024); } while (0)
#define G8_LDB(dst, b, h) do { _Pragma("unroll") for (int n = 0; n < 2; ++n) _Pragma("unroll") for (int k = 0; k < 2; ++k) dst[n][k] = *(const LAS bf16x8*)(lds + G8_SB(b, h) + boff + n * 2048 + k * 1024); } while (0)
#define G8_MMA(ai, bj, At, Bt) do { __builtin_amdgcn_s_setprio(1); _Pragma("unroll") for (int m = 0; m < 4; ++m) _Pragma("unroll") for (int n = 0; n < 2; ++n) _Pragma("unroll") for (int k = 0; k < 2; ++k) \
        acc[ai][bj][m][n] = __builtin_amdgcn_mfma_f32_16x16x32_bf16(Bt[n][k], At[m][k], acc[ai][bj][m][n], 0, 0, 0); __builtin_amdgcn_s_setprio(0); } while (0)
#define G8_WAIT_V(n) asm volatile("s_waitcnt vmcnt(" #n ")" ::: "memory")
#define G8_WAIT_L(n) asm volatile("s_waitcnt lgkmcnt(" #n ")" ::: "memory")
#define G8_BAR __builtin_amdgcn_s_barrier()
#define G8_SCHED __builtin_amdgcn_sched_barrier(0)
    Unit cur, nxt; int ui = 0;
    if (!S.next(0, cur)) return;
    f32x4 acc[2][2][4][2];
#pragma unroll
    for (int a = 0; a < 2; ++a)
#pragma unroll
        for (int b = 0; b < 2; ++b)
#pragma unroll
            for (int m = 0; m < 4; ++m)
#pragma unroll
                for (int n = 0; n < 2; ++n) acc[a][b][m][n] = (f32x4){0.f, 0.f, 0.f, 0.f};
    bf16x8 At[4][2], B0[2][2], B1[2][2];
    unsigned oc[2][2];
    S.aoff(cur, tid, oc);
    const char* cA = cur.A; const char* cB = cur.B;
    G8_STAGE(G8_SB(0, 0), cB, voffB); G8_STAGE(G8_SA(0, 0), cA, oc[0]); G8_STAGE(G8_SB(0, 1), cB + hstep, voffB); G8_STAGE(G8_SA(0, 1), cA, oc[1]);
    if (wr == 1) G8_BAR;
    G8_WAIT_V(4); G8_BAR;
    G8_STAGE(G8_SB(1, 0), cB + kstep, voffB); G8_STAGE(G8_SA(1, 0), cA + kstep, oc[0]); G8_STAGE(G8_SB(1, 1), cB + hstep + kstep, voffB);
    G8_WAIT_V(6); G8_BAR;
    for (;;) {
        const bool has_next = S.next(ui + 1, nxt);
        const char* nA = has_next ? nxt.A : cA; const char* nB = has_next ? nxt.B : cB;
#pragma unroll 1
        for (int t = 0; t < nt; t += 2) {
            const bool last = (t == nt - 2);
            const char* a1 = cA + (size_t)(t + 1) * kstep;
            const char* a2 = last ? nA : cA + (size_t)(t + 2) * kstep; const char* b2 = last ? nB : cB + (size_t)(t + 2) * kstep;
            const char* a3 = a2 + kstep; const char* b3 = b2 + kstep;
            G8_LDB(B0, 0, 0); G8_SCHED; G8_LDA(At, 0, 0); G8_STAGE(G8_SA(1, 1), a1, oc[1]);
            if (last && has_next) S.aoff(nxt, tid, oc);
            G8_WAIT_L(8); G8_BAR; G8_WAIT_L(0); G8_MMA(0, 0, At, B0); G8_BAR; G8_SCHED;
            G8_LDB(B1, 0, 1); G8_STAGE(G8_SB(0, 0), b2, voffB);
            G8_BAR; G8_WAIT_L(0); G8_MMA(0, 1, At, B1); G8_BAR;
            G8_LDA(At, 0, 1); G8_STAGE(G8_SA(0, 0), a2, oc[0]);
            G8_BAR; G8_WAIT_L(0); G8_MMA(1, 0, At, B0); G8_BAR; G8_SCHED;
            G8_STAGE(G8_SB(0, 1), b2 + hstep, voffB);
            G8_WAIT_V(6); G8_BAR; G8_MMA(1, 1, At, B1); G8_BAR;
            G8_LDB(B0, 1, 0); G8_SCHED; G8_LDA(At, 1, 0); G8_STAGE(G8_SA(0, 1), a2, oc[1]);
            G8_WAIT_L(8); G8_BAR; G8_WAIT_L(0); G8_MMA(0, 0, At, B0); G8_BAR; G8_SCHED;
            G8_LDB(B1, 1, 1); G8_STAGE(G8_SB(1, 0), b3, voffB);
            G8_BAR; G8_WAIT_L(0); G8_MMA(0, 1, At, B1); G8_BAR;
            G8_LDA(At, 1, 1); G8_STAGE(G8_SA(1, 0), a3, oc[0]);
            G8_BAR; G8_WAIT_L(0); G8_MMA(1, 0, At, B0); G8_BAR; G8_SCHED;
            G8_STAGE(G8_SB(1, 1), b3 + hstep, voffB);
            G8_WAIT_V(6); G8_BAR; G8_MMA(1, 1, At, B1); G8_BAR;
        }
        E(acc, cur, wr, wc, fr, fq);
        if (!has_next) break;
#pragma unroll
        for (int a = 0; a < 2; ++a)
#pragma unroll
            for (int b = 0; b < 2; ++b)
#pragma unroll
                for (int m = 0; m < 4; ++m)
#pragma unroll
                    for (int n = 0; n < 2; ++n) acc[a][b][m][n] = (f32x4){0.f, 0.f, 0.f, 0.f};
        cur = nxt; cA = nA; cB = nB; ++ui;
    }
    G8_WAIT_V(0);
    if (wr == 0) G8_BAR;
    G8_BAR;
#undef G8_SA
#undef G8_SB
#undef G8_STAGE
#undef G8_LDA
#undef G8_LDB
#undef G8_MMA
#undef G8_WAIT_V
#undef G8_WAIT_L
#undef G8_BAR
#undef G8_SCHED
}
}

constexpr int NTHREADS = 512;
constexpr int LDS_STAGE = 0;
constexpr int LDS_TAB   = g8::STAGE_BYTES;
constexpr int TAB_SLOTS = 12;
constexpr int LDS_DESC  = LDS_TAB + TAB_SLOTS * 256 * 4;
constexpr int LDS_PREF  = LDS_DESC + 64;
constexpr int LDS_MISC  = LDS_PREF + 132 * 4 + 48;
constexpr int LDS_BYTES = 147456;
static_assert(LDS_MISC % 16 == 0 && LDS_MISC + 64 <= LDS_BYTES, "LDS map");

struct Params { const float* in[31]; float* out; unsigned char* ws; int ph_lo, ph_hi; };

struct Ctx {
    const float* const* in; float* out; unsigned char* ws; LAS unsigned char* lds;
    int tid, lane, wid, bid, G, gtid, gthreads, gw, nwaves;
};

template <class DstFn>
__device__ __forceinline__ void convert_T(const Ctx& c, const float* src, int nmat, int K, int N, DstFn dstfn) {
    LAS float* tile = (LAS float*)(c.lds);
    const int tk = K / 64, tn = N / 64; const long ntiles = (long)nmat * tk * tn;
    for (long tix = c.bid; tix < ntiles; tix += c.G) {
        const int m = (int)(tix / (tk * tn)); const int rem = (int)(tix % (tk * tn)); const int kt = rem / tn, nt = rem % tn;
        const float* s = src + (size_t)m * K * N + (size_t)(kt * 64) * N + nt * 64;
#pragma unroll
        for (int i = 0; i < 2; ++i) { const int k = (c.tid >> 4) + 32 * i, n4 = (c.tid & 15) * 4; const f32x4 v = *(const f32x4*)(s + (size_t)k * N + n4);
            tile[k * 65 + n4 + 0] = v[0]; tile[k * 65 + n4 + 1] = v[1]; tile[k * 65 + n4 + 2] = v[2]; tile[k * 65 + n4 + 3] = v[3]; }
        __syncthreads();
        { const int n = c.tid >> 3, k8 = (c.tid & 7) * 8; u32x4 w;
          w[0] = pk2(tile[(k8 + 0) * 65 + n], tile[(k8 + 1) * 65 + n]); w[1] = pk2(tile[(k8 + 2) * 65 + n], tile[(k8 + 3) * 65 + n]);
          w[2] = pk2(tile[(k8 + 4) * 65 + n], tile[(k8 + 5) * 65 + n]); w[3] = pk2(tile[(k8 + 6) * 65 + n], tile[(k8 + 7) * 65 + n]);
          bf16_t* d = dstfn(m, nt * 64 + n) + kt * 64 + k8; *(u32x4*)d = w; }
        __syncthreads();
    }
}

__device__ __forceinline__ void phase_convert(const Ctx& c) {
    unsigned char* ws = c.ws;
    { const float* x = c.in[0]; float* xo = (float*)(ws + WS_X); bf16_t* xb = (bf16_t*)(ws + WS_XB);
      for (long i = c.gtid; i < (long)T * D / 4; i += c.gthreads) { const f32x4 v = *(const f32x4*)(x + i * 4); *(f32x4*)(xo + i * 4) = v; u32x2 w; w[0] = pk2(v[0], v[1]); w[1] = pk2(v[2], v[3]); *(u32x2*)(xb + i * 4) = w; } }
    { bf16_t* wrt = (bf16_t*)(ws + WS_WRT); for (long i = c.gtid; i < (long)4 * 128 * D / 8; i += c.gthreads) { const long l = i / (128 * D / 8), r = i % (128 * D / 8); *(u32x4*)(wrt + (size_t)l * 256 * D + (size_t)128 * D + r * 8) = (u32x4){0u, 0u, 0u, 0u}; }
      float* gate = (float*)(ws + WS_GATE); for (int i = c.gtid; i < T; i += c.gthreads) gate[TK + i] = 1.f; }
    { bf16_t* d = (bf16_t*)(ws + WS_WABIN);  convert_T(c, c.in[1], 2, D, AB_IN, [=](int m, int n) { return d + (size_t)m * AB_IN * D + (size_t)n * D; }); }
    { bf16_t* d = (bf16_t*)(ws + WS_WABOUT); convert_T(c, c.in[4], 2, AB_OUT, D, [=](int m, int n) { return d + (size_t)m * D * AB_OUT + (size_t)n * AB_OUT; }); }
    { bf16_t* d = (bf16_t*)(ws + WS_WCDIN);  convert_T(c, c.in[6], 2, D, CD_IN, [=](int m, int n) { return d + (size_t)m * CD_IN * D + (size_t)n * D; }); }
    { bf16_t* d = (bf16_t*)(ws + WS_WCDOUT); convert_T(c, c.in[17], 2, CD_OUT, D, [=](int m, int n) { return d + (size_t)m * D * CD_OUT + (size_t)n * CD_OUT; }); }
    { bf16_t* d = (bf16_t*)(ws + WS_WRT);    convert_T(c, c.in[21], 4, D, NE, [=](int m, int n) { return d + (size_t)m * 256 * D + (size_t)n * D; }); }
    { bf16_t* d = (bf16_t*)(ws + WS_WGU);
      convert_T(c, c.in[23], 4 * NE, D, ED, [=](int m, int n) { return d + (size_t)((m >> 7) * NE1 + (m & 127)) * 512 * D + (size_t)((n >> 7) * 256 + (n & 127)) * D; });
      convert_T(c, c.in[24], 4 * NE, D, ED, [=](int m, int n) { return d + (size_t)((m >> 7) * NE1 + (m & 127)) * 512 * D + (size_t)((n >> 7) * 256 + 128 + (n & 127)) * D; });
      convert_T(c, c.in[26], 4, D, ED, [=](int m, int n) { return d + (size_t)(m * NE1 + NE) * 512 * D + (size_t)((n >> 7) * 256 + (n & 127)) * D; });
      convert_T(c, c.in[27], 4, D, ED, [=](int m, int n) { return d + (size_t)(m * NE1 + NE) * 512 * D + (size_t)((n >> 7) * 256 + 128 + (n & 127)) * D; }); }
    { bf16_t* d = (bf16_t*)(ws + WS_WDN);
      convert_T(c, c.in[25], 4 * NE, ED, D, [=](int m, int n) { return d + (size_t)((m >> 7) * NE1 + (m & 127)) * D * ED + (size_t)n * ED; });
      convert_T(c, c.in[28], 4, ED, D, [=](int m, int n) { return d + (size_t)(m * NE1 + NE) * D * ED + (size_t)n * ED; }); }
}

__device__ __forceinline__ void phase_dense(const Ctx& c, const bf16_t* A, const bf16_t* Bt, int M, int N, int K, float* C, int ldc, const float* bias) {
    g8::DenseOrder S; S.init(A, Bt, M, N, K, c.G, c.bid);
    g8::EpiF32 E{C, ldc, bias};
    g8::gemm_phase<g8::EpiF32, g8::DenseOrder>(c.lds + LDS_STAGE, K, S, E);
}

__device__ __forceinline__ void phase_ab_rope(const Ctx& c) {
    float* z = (float*)(c.ws + WS_U1);
    for (long idx = c.gtid; idx < (long)T * 1088; idx += c.gthreads) {
        const int t = (int)(idx / 1088), p = (int)(idx % 1088), s = t & (SEQ - 1);
        int c1, c2; float e, scale;
        if (p < 512)      { const int h = p >> 5, j = p & 31; c1 = h * 64 + j; c2 = c1 + 32; e = (float)j * (1.f / 32.f); scale = 0.125f; }
        else if (p < 576) { const int pp = p - 512, h = pp >> 5, j = pp & 31; c1 = 1024 + h * 64 + j; c2 = c1 + 32; e = (float)j * (1.f / 32.f); scale = 1.f; }
        else if (p < 832) { const int pp = p - 576, h = pp >> 6, j = pp & 63; c1 = 1280 + h * 128 + j; c2 = c1 + 64; e = (float)j * (1.f / 63.f); scale = 1.f; }
        else              { const int pp = p - 832, h = pp >> 6, j = pp & 63; c1 = 1792 + h * 128 + j; c2 = c1 + 64; e = (float)j * (1.f / 63.f); scale = 0.08838834764831845f; }
        const float invf = exp2f(-e * 13.287712379549449f);
        const float ang = (float)s * invf; float sn, cs; sincosf(ang, &sn, &cs);
        float* zr = z + (size_t)t * AB_IN; const float x1 = zr[c1], x2 = zr[c2];
        zr[c1] = (x1 * cs - x2 * sn) * scale; zr[c2] = (x2 * cs + x1 * sn) * scale;
    }
}

__device__ __forceinline__ void phase_ab_mix(const Ctx& c, int j) {
    const float* z = (const float*)(c.ws + WS_U1); bf16_t* ycat = (bf16_t*)(c.ws + WS_YCAT); float* ro = (float*)(c.ws + WS_U2);
    const float* sinks = c.in[3] + j * 16;
    const int lane = c.lane;
    if (c.bid < 64) {
        const int it = c.bid * 8 + c.wid; const int b = it >> 8, h = (it >> 6) & 3, e0 = (it & 63) * 4;
        const float gam = 1.f - exp2f(-5.f - (float)h);
        float S0[4] = {0.f, 0.f, 0.f, 0.f}, S1[4] = {0.f, 0.f, 0.f, 0.f};
        for (int s = 0; s < SEQ; ++s) {
            const float* zr = z + (size_t)(b * SEQ + s) * AB_IN;
            const float q0 = zr[1280 + h * 128 + lane], q1 = zr[1280 + h * 128 + 64 + lane];
            const float k0 = zr[1792 + h * 128 + lane], k1 = zr[1792 + h * 128 + 64 + lane];
            const f32x4 v = *(const f32x4*)(zr + 2304 + h * 256 + e0);
            f32x4 o;
#pragma unroll
            for (int e = 0; e < 4; ++e) { S0[e] = gam * S0[e] + k0 * v[e]; S1[e] = gam * S1[e] + k1 * v[e]; o[e] = wave_sum(q0 * S0[e] + q1 * S1[e]); }
            if (lane == 0) *(f32x4*)(ro + (size_t)(b * SEQ + s) * D + h * 256 + e0) = o;
        }
    } else {
        const int nw = (c.G - 64) * 8;
        for (long it = (long)(c.bid - 64) * 8 + c.wid; it < (long)T * 16; it += nw) {
            const int t = (int)(it >> 4), hd = (int)(it & 15), kvh = hd >> 3, s = t & (SEQ - 1), tb = t - s;
            const float* qrow = z + (size_t)t * AB_IN + hd * 64;
            float sc[2];
#pragma unroll
            for (int u2 = 0; u2 < 2; ++u2) { const int jk = s - lane - 64 * u2; float a = -1e30f;
                if (jk >= 0) { const float* kr = z + (size_t)(tb + jk) * AB_IN + 1024 + kvh * 64; float d = 0.f;
                    for (int dd = 0; dd < 64; dd += 4) { const f32x4 qv = *(const f32x4*)(qrow + dd), kv = *(const f32x4*)(kr + dd); d += qv[0] * kv[0] + qv[1] * kv[1] + qv[2] * kv[2] + qv[3] * kv[3]; }
                    a = d; }
                sc[u2] = a; }
            const float sink = sinks[hd];
            const float m = fmaxf(wave_max(fmaxf(sc[0], sc[1])), sink);
            const float p0 = (s - lane >= 0) ? __expf(sc[0] - m) : 0.f, p1 = (s - lane - 64 >= 0) ? __expf(sc[1] - m) : 0.f;
            const float den = wave_sum(p0 + p1) + __expf(sink - m);
            float o = 0.f;
            for (int jj = 0; jj < 128; ++jj) { const float pj = __shfl(jj < 64 ? p0 : p1, jj & 63); const int jk = s - jj;
                if (jk >= 0) o += pj * z[(size_t)(tb + jk) * AB_IN + 1152 + kvh * 64 + lane]; }
            ycat[(size_t)t * AB_OUT + hd * 64 + lane] = f2bf(o / den);
        }
    }
}

__device__ __forceinline__ void phase_ab_norm(const Ctx& c) {
    const float* z = (const float*)(c.ws + WS_U1); bf16_t* ycat = (bf16_t*)(c.ws + WS_YCAT); const float* ro = (const float*)(c.ws + WS_U2);
    for (long it = c.gw; it < (long)T * 4; it += c.nwaves) {
        const int t = (int)(it >> 2), h = (int)(it & 3);
        const f32x4 v = *(const f32x4*)(ro + (size_t)t * D + h * 256 + c.lane * 4);
        const float mean = wave_sum(v[0] + v[1] + v[2] + v[3]) * (1.f / 256.f);
        const f32x4 d = v - mean;
        const float var = wave_sum(d[0] * d[0] + d[1] * d[1] + d[2] * d[2] + d[3] * d[3]) * (1.f / 256.f);
        const float rstd = rsqrtf(var + LN_EPS);
        const f32x4 g = *(const f32x4*)(z + (size_t)t * AB_IN + 3328 + h * 256 + c.lane * 4);
        u32x2 w; w[0] = pk2(siluf_(g[0]) * d[0] * rstd, siluf_(g[1]) * d[1] * rstd); w[1] = pk2(siluf_(g[2]) * d[2] * rstd, siluf_(g[3]) * d[3] * rstd);
        *(u32x2*)(ycat + (size_t)t * AB_OUT + 1024 + h * 256 + c.lane * 4) = w;
    }
}

__device__ __forceinline__ void phase_cd_act(const Ctx& c, int j) {
    float* z = (float*)(c.ws + WS_U1); float* xc = (float*)(c.ws + WS_U2);
    const float* conv_w = c.in[10] + (size_t)j * 4 * 1280; const float* conv_b = c.in[11] + (size_t)j * 1280;
    for (long idx = c.gtid; idx < (long)T * 1280; idx += c.gthreads) {
        const int t = (int)(idx / 1280), ch = (int)(idx % 1280), s = t & (SEQ - 1);
        float a = conv_b[ch];
#pragma unroll
        for (int k = 0; k < 4; ++k) { const int sp = s - 3 + k; if (sp >= 0) a += conv_w[k * 1280 + ch] * z[(size_t)(t - 3 + k) * CD_IN + 3328 + ch]; }
        xc[(size_t)t * 1280 + ch] = a;
    }
    for (long t = c.gw; t < T; t += c.nwaves) {
        float* zr = z + (size_t)t * CD_IN;
        for (int i = c.lane; i < 1024; i += 64) zr[i] = gelu_tanh(zr[i]);
        for (int i = c.lane; i < 1280; i += 64) zr[2048 + i] = gelu_tanh(zr[2048 + i]);
        float gv[16]; float sm = 0.f;
#pragma unroll
        for (int i = 0; i < 16; ++i) { gv[i] = gelu_tanh(zr[1024 + c.lane + 64 * i]); sm += gv[i]; }
        const float mean = wave_sum(sm) * (1.f / 1024.f); float sq = 0.f;
#pragma unroll
        for (int i = 0; i < 16; ++i) { gv[i] -= mean; sq += gv[i] * gv[i]; }
        const float rstd = rsqrtf(wave_sum(sq) * (1.f / 1024.f) + LN_EPS);
#pragma unroll
        for (int i = 0; i < 16; ++i) zr[1024 + c.lane + 64 * i] = gv[i] * rstd;
    }
}

__device__ __forceinline__ void phase_cd_mix(const Ctx& c, int j) {
    const float* z = (const float*)(c.ws + WS_U1); bf16_t* ycat = (bf16_t*)(c.ws + WS_YCAT);
    const float* xc = (const float*)(c.ws + WS_U2); float* av = (float*)(c.ws + WS_U2) + (size_t)T * 1280; float* bv = av + (size_t)T * 1280;
    const float* sgu_w = c.in[8] + (size_t)j * 4 * 128 * 128; const float* sgu_b = c.in[9] + (size_t)j * 4 * 128;
    const float* wa = c.in[12] + (size_t)j * 5 * 65536; const float* ba = c.in[13] + (size_t)j * 1280;
    const float* wx = c.in[14] + (size_t)j * 5 * 65536; const float* bx = c.in[15] + (size_t)j * 1280; const float* lam = c.in[16] + (size_t)j * 1280;
    for (long idx = c.gtid; idx < (long)T * 1024; idx += c.gthreads) {
        const int t = (int)(idx >> 10), col = (int)(idx & 1023), i = t & 127, t0 = t - i, g = col >> 8;
        const float* w = sgu_w + (size_t)g * 16384 + (size_t)i * 128; float a = 0.f;
        for (int jj = 0; jj <= i; ++jj) a += w[jj] * z[(size_t)(t0 + jj) * CD_IN + 1024 + col];
        const float mixed = a + sgu_b[g * 128 + i];
        ycat[(size_t)t * CD_OUT + col] = f2bf(z[(size_t)t * CD_IN + col] * mixed);
    }
    for (long idx = c.gtid; idx < (long)T * 1280; idx += c.gthreads) {
        const int t = (int)(idx / 1280), ch = (int)(idx % 1280), h = ch >> 8, cc = ch & 255;
        const float* xr = xc + (size_t)t * 1280 + h * 256; const float* wah = wa + (size_t)h * 65536 + cc; const float* wxh = wx + (size_t)h * 65536 + cc;
        float r = ba[ch], ig = bx[ch];
        for (int i = 0; i < 256; ++i) { const float xv = xr[i]; r += xv * wah[(size_t)i * 256]; ig += xv * wxh[(size_t)i * 256]; }
        r = sigmoidf_(r); ig = sigmoidf_(ig);
        const float sp = log1pf(expf(-lam[ch]));
        const float log_a = -8.f * r * sp; const float a = expf(log_a);
        const float b = sqrtf(-expm1f(2.f * log_a)) * (ig * xc[(size_t)t * 1280 + ch]);
        av[(size_t)t * 1280 + ch] = a; bv[(size_t)t * 1280 + ch] = b;
    }
}

__device__ __forceinline__ void phase_cd_scan(const Ctx& c) {
    const float* z = (const float*)(c.ws + WS_U1); bf16_t* ycat = (bf16_t*)(c.ws + WS_YCAT);
    const float* av = (const float*)(c.ws + WS_U2) + (size_t)T * 1280; const float* bv = av + (size_t)T * 1280;
    for (int idx = c.gtid; idx < 2 * 1280; idx += c.gthreads) {
        const int b = idx / 1280, ch = idx % 1280; float h = 0.f;
        for (int s = 0; s < SEQ; ++s) { const size_t t = (size_t)b * SEQ + s; h = av[t * 1280 + ch] * h + bv[t * 1280 + ch];
            ycat[t * CD_OUT + 1024 + ch] = f2bf(z[t * CD_IN + 2048 + ch] * h); }
    }
}

template <bool MOE>
__device__ __forceinline__ void phase_ln(const Ctx& c, const float* g, const float* bta, float* xout) {
    float* x = (float*)(c.ws + WS_X); bf16_t* xb = (bf16_t*)(c.ws + WS_XB);
    const float* hbuf = (const float*)(c.ws + WS_H); const bf16_t* Y = (const bf16_t*)(c.ws + WS_U1);
    for (long t = c.gw; t < T; t += c.nwaves) {
        f32x4 v[4];
#pragma unroll
        for (int q = 0; q < 4; ++q) { const int col = q * 256 + c.lane * 4;
            f32x4 f;
            if (!MOE) f = *(const f32x4*)(hbuf + (size_t)t * D + col);
            else { f = (f32x4){0.f, 0.f, 0.f, 0.f};
#pragma unroll
                for (int k = 0; k < 9; ++k) { const size_t srow = (k < 8) ? (size_t)t * 8 + k : (size_t)TK + t; const u32x2 w = *(const u32x2*)(Y + srow * D + col);
                    f[0] += __uint_as_float(w[0] << 16); f[1] += __uint_as_float(w[0] & 0xffff0000u); f[2] += __uint_as_float(w[1] << 16); f[3] += __uint_as_float(w[1] & 0xffff0000u); } }
            const f32x4 xv = *(const f32x4*)(x + (size_t)t * D + col);
            v[q] = xv * ALPHA + f; }
        float sm = 0.f;
#pragma unroll
        for (int q = 0; q < 4; ++q) sm += v[q][0] + v[q][1] + v[q][2] + v[q][3];
        const float mean = wave_sum(sm) * (1.f / 1024.f); float sq = 0.f;
#pragma unroll
        for (int q = 0; q < 4; ++q) { v[q] = v[q] - mean; sq += v[q][0] * v[q][0] + v[q][1] * v[q][1] + v[q][2] * v[q][2] + v[q][3] * v[q][3]; }
        const float rstd = rsqrtf(wave_sum(sq) * (1.f / 1024.f) + LN_EPS);
#pragma unroll
        for (int q = 0; q < 4; ++q) { const int col = q * 256 + c.lane * 4; const f32x4 gg = *(const f32x4*)(g + col), bb = *(const f32x4*)(bta + col);
            const f32x4 o = v[q] * rstd * gg + bb;
            *(f32x4*)(xout + (size_t)t * D + col) = o; if (xout != x) *(f32x4*)(x + (size_t)t * D + col) = o;
            u32x2 w; w[0] = pk2(o[0], o[1]); w[1] = pk2(o[2], o[3]); *(u32x2*)(xb + (size_t)t * D + col) = w; }
    }
}

__device__ __forceinline__ void phase_route(const Ctx& c, int L) {
    const float* zr = (const float*)(c.ws + WS_ZR); const float* rb = c.in[22] + L * NE;
    int* cnt = (int*)(c.ws + CTL_CNT) + L * NE; int* list = (int*)(c.ws + WS_LIST); float* gate = (float*)(c.ws + WS_GATE);
    for (long t = c.gw; t < T; t += c.nwaves) {
        const float s0 = sigmoidf_(zr[(size_t)t * 256 + c.lane]), s1 = sigmoidf_(zr[(size_t)t * 256 + 64 + c.lane]);
        float v0 = s0 + rb[c.lane], v1 = s1 + rb[64 + c.lane];
        float mysc = 0.f; int myexp = -1; float tot = 0.f;
        for (int k = 0; k < 8; ++k) {
            float bv = v0; int bi = c.lane; if (v1 > bv) { bv = v1; bi = c.lane + 64; }
#pragma unroll
            for (int o = 32; o; o >>= 1) { const float ov = __shfl_xor(bv, o); const int oi = __shfl_xor(bi, o); if (ov > bv || (ov == bv && oi < bi)) { bv = ov; bi = oi; } }
            const float sc = __shfl((bi & 64) ? s1 : s0, bi & 63);
            tot += sc;
            if (c.lane == k) { mysc = sc; myexp = bi; }
            if (c.lane == (bi & 63)) { if (bi & 64) v1 = -1e30f; else v0 = -1e30f; }
        }
        if (c.lane < 8) { const int pos = atomicAdd(&cnt[myexp], 1); list[(size_t)myexp * LISTCAP + pos] = (int)t * 8 + c.lane; gate[(size_t)t * 8 + c.lane] = mysc / tot * 2.5f; }
    }
}

struct MoeOrder {
    const char* Abase; const char* Bbase; size_t Bstride; int K, NT, total, G, c, mode;
    LAS int* tab; LAS int* desc;
    __device__ __forceinline__ bool next(int i, g8::Unit& u) const {
        const long L = (long)i * G + c; if (L >= total || i >= TAB_SLOTS) return false;
        const int d = desc[i]; const int e = d >> 12, pn = d & 15;
        u.pm = (d >> 4) & 255; u.pn = pn; u.aux = i; u.A = Abase; u.B = Bbase + (size_t)e * Bstride + (size_t)pn * 256 * K * 2; return true;
    }
    __device__ __forceinline__ void aoff(const g8::Unit& u, int tid, unsigned (&o)[2][2]) const {
#pragma unroll
        for (int i = 0; i < 2; ++i) { int R, C; g8::stage_rc(tid * 16 + i * 8192, R, C);
#pragma unroll
            for (int h = 0; h < 2; ++h) { int s = tab[u.aux * 256 + h * 128 + R]; s = s < 0 ? 0 : s; const int row = mode ? s : (s < TK ? (s >> 3) : s - TK);
                o[h][i] = (unsigned)(row * K + C) * 2u; } }
    }
};
__device__ __forceinline__ void moe_setup(const Ctx& c, MoeOrder& S, const int* cnt, int NT) {
    LAS int* pref = (LAS int*)(c.lds + LDS_PREF); LAS int* desc = (LAS int*)(c.lds + LDS_DESC); LAS int* tab = (LAS int*)(c.lds + LDS_TAB);
    const int* list = (const int*)(c.ws + WS_LIST);
    if (c.tid == 0) { int acc = 0; for (int e = 0; e < NE1; ++e) { pref[e] = acc; const int n = e < NE ? cnt[e] : T; acc += (n + 255) >> 8; } pref[NE1] = acc; }
    __syncthreads();
    const int total = pref[NE1] * NT;
    S.NT = NT; S.total = total; S.G = c.G; S.c = c.bid; S.tab = tab; S.desc = desc;
    for (int i = 0; i < TAB_SLOTS; ++i) {
        const long L = (long)i * c.G + c.bid; if (L >= total) break;
        int wgid = (int)L; { const int q = total / 8, r = total % 8, xcd = wgid % 8, off = wgid / 8; wgid = (xcd < r ? xcd * (q + 1) : r * (q + 1) + (xcd - r) * q) + off; }
        const int rbg = wgid / NT, pn = wgid % NT;
        int lo = 0, hi = NE1;
        while (hi - lo > 1) { const int mid = (lo + hi) >> 1; if (pref[mid] <= rbg) lo = mid; else hi = mid; }
        const int e = lo, rb = rbg - pref[e], n = e < NE ? cnt[e] : T;
        if (c.tid == 0) desc[i] = (e << 12) | (rb << 4) | pn;
        if (c.tid < 256) { const int r = rb * 256 + c.tid; int s = -1; if (r < n) s = (e < NE) ? list[(size_t)e * LISTCAP + r] : TK + r; tab[i * 256 + c.tid] = s; }
    }
    __syncthreads();
}
struct EpiMoeGU {
    static constexpr bool PERM = true;
    bf16_t* H; LAS int* tab;
    __device__ __forceinline__ void operator()(const f32x4 (&acc)[2][2][4][2], const g8::Unit& u, int wr, int wc, int fr, int fq) const {
#pragma unroll
        for (int ai = 0; ai < 2; ++ai)
#pragma unroll
            for (int m = 0; m < 4; ++m) { const int r = ai * 128 + wr * 64 + m * 16 + fr; const int s = tab[u.aux * 256 + r];
                if (s >= 0) { u32x4 w;
#pragma unroll
                    for (int n = 0; n < 2; ++n) { const f32x4 g = acc[ai][0][m][n], up = acc[ai][1][m][n];
                        w[2 * n] = pk2(siluf_(g[0]) * up[0], siluf_(g[1]) * up[1]); w[2 * n + 1] = pk2(siluf_(g[2]) * up[2], siluf_(g[3]) * up[3]); }
                    *(u32x4*)(H + (size_t)s * ED + u.pn * 128 + wc * 32 + fq * 8) = w; } }
    }
};
struct EpiMoeDN {
    static constexpr bool PERM = true;
    bf16_t* Y; const float* gate; LAS int* tab;
    __device__ __forceinline__ void operator()(const f32x4 (&acc)[2][2][4][2], const g8::Unit& u, int wr, int wc, int fr, int fq) const {
#pragma unroll
        for (int ai = 0; ai < 2; ++ai)
#pragma unroll
            for (int m = 0; m < 4; ++m) { const int r = ai * 128 + wr * 64 + m * 16 + fr; const int s = tab[u.aux * 256 + r];
                if (s >= 0) { const float gt = gate[s];
#pragma unroll
                    for (int bj = 0; bj < 2; ++bj) { u32x4 w;
#pragma unroll
                        for (int n = 0; n < 2; ++n) { const f32x4 a = acc[ai][bj][m][n] * gt; w[2 * n] = pk2(a[0], a[1]); w[2 * n + 1] = pk2(a[2], a[3]); }
                        *(u32x4*)(Y + (size_t)s * D + u.pn * 256 + bj * 128 + wc * 32 + fq * 8) = w; } } }
    }
};
__device__ __forceinline__ void phase_moe_gu(const Ctx& c, int L) {
    MoeOrder S; S.Abase = (const char*)(c.ws + WS_XB); S.Bbase = (const char*)(c.ws + WS_WGU) + (size_t)L * NE1 * 512 * D * 2; S.Bstride = (size_t)512 * D * 2; S.K = D; S.mode = 0;
    moe_setup(c, S, (const int*)(c.ws + CTL_CNT) + L * NE, 2);
    EpiMoeGU E{(bf16_t*)(c.ws + WS_HID), S.tab};
    g8::gemm_phase<EpiMoeGU, MoeOrder>(c.lds + LDS_STAGE, D, S, E);
}
__device__ __forceinline__ void phase_moe_dn(const Ctx& c, int L) {
    MoeOrder S; S.Abase = (const char*)(c.ws + WS_HID); S.Bbase = (const char*)(c.ws + WS_WDN) + (size_t)L * NE1 * D * ED * 2; S.Bstride = (size_t)D * ED * 2; S.K = ED; S.mode = 1;
    moe_setup(c, S, (const int*)(c.ws + CTL_CNT) + L * NE, 4);
    EpiMoeDN E{(bf16_t*)(c.ws + WS_U1), (const float*)(c.ws + WS_GATE), S.tab};
    g8::gemm_phase<EpiMoeDN, MoeOrder>(c.lds + LDS_STAGE, ED, S, E);
}

constexpr int PH_PER_LAYER = 11;
constexpr int N_PHASES = 1 + 4 * PH_PER_LAYER;

__global__ void __launch_bounds__(NTHREADS, 2) fwd_kernel(Params p) {
    extern __shared__ __attribute__((aligned(16))) unsigned char lds_raw[];
    LAS unsigned char* const lds0 = (LAS unsigned char*)lds_raw;
    volatile LAS unsigned* misc = (volatile LAS unsigned*)(lds0 + LDS_MISC);
    if (threadIdx.x < 4) misc[threadIdx.x] = 0u;
    __syncthreads();
    const int lo = p.ph_lo, hi = p.ph_hi;
    XcdBarrier bar; bar.bar = (unsigned*)(p.ws + WS_CTL); bar.x = 0; bar.st = misc;
    if (hi - lo > 1) bar = xcd_barrier_post((unsigned*)(p.ws + WS_CTL), misc);
#define MKCTX() Ctx c; { int tid_ = threadIdx.x; asm volatile("" : "+v"(tid_)); int bid_ = blockIdx.x; asm volatile("" : "+s"(bid_)); unsigned long long ws_ = (unsigned long long)p.ws; asm volatile("" : "+s"(ws_)); \
        c.in = p.in; c.out = p.out; c.ws = (unsigned char*)ws_; c.lds = lds0; c.tid = tid_; c.lane = tid_ & 63; c.wid = __builtin_amdgcn_readfirstlane(tid_ >> 6); c.bid = bid_; c.G = gridDim.x; \
        c.gtid = c.bid * NTHREADS + c.tid; c.gthreads = c.G * NTHREADS; c.gw = c.bid * 8 + c.wid; c.nwaves = c.G * 8; } unsigned char* const ws = c.ws; (void)ws
    int id = 0;
#ifndef PMASK
#define PMASK 0xffffffffu
#endif
#define PHASE(k, body) do { if (((PMASK >> (k)) & 1u) && lo <= id && id < hi) { MKCTX(); body; if (id + 1 < hi) xcd_barrier(bar); } ++id; } while (0)
    PHASE(0, phase_convert(c));
#pragma unroll 1
    for (int L = 0; L < 4; ++L) {
        const int j = L >> 1; const bool cd = (L & 1);
        {
            const size_t Woff = cd ? WS_WCDIN + (size_t)j * CD_IN * D * 2 : WS_WABIN + (size_t)j * AB_IN * D * 2;
            const int N = cd ? CD_IN : AB_IN; const float* bias = cd ? p.in[7] + (size_t)j * CD_IN : p.in[2] + (size_t)j * AB_IN;
            PHASE(1, phase_dense(c, (const bf16_t*)(ws + WS_XB), (const bf16_t*)(ws + Woff), T, N, D, (float*)(ws + WS_U1), N, bias));
        }
        if (!cd) { PHASE(2, phase_ab_rope(c)); PHASE(3, phase_ab_mix(c, j)); PHASE(4, phase_ab_norm(c)); }
        else     { PHASE(5, phase_cd_act(c, j)); PHASE(6, phase_cd_mix(c, j)); PHASE(7, phase_cd_scan(c)); }
        {
            const size_t Woff = cd ? WS_WCDOUT + (size_t)j * D * CD_OUT * 2 : WS_WABOUT + (size_t)j * D * AB_OUT * 2;
            const int K = cd ? CD_OUT : AB_OUT; const float* bias = cd ? p.in[18] + (size_t)j * D : p.in[5] + (size_t)j * D;
            PHASE(8, phase_dense(c, (const bf16_t*)(ws + WS_YCAT), (const bf16_t*)(ws + Woff), T, D, K, (float*)(ws + WS_H), D, bias));
        }
        PHASE(9, phase_ln<false>(c, p.in[19] + (size_t)L * D, p.in[20] + (size_t)L * D, (float*)(ws + WS_X)));
        PHASE(10, phase_dense(c, (const bf16_t*)(ws + WS_XB), (const bf16_t*)(ws + WS_WRT) + (size_t)L * 256 * D, T, 256, D, (float*)(ws + WS_ZR), 256, nullptr));
        PHASE(11, phase_route(c, L));
        PHASE(12, phase_moe_gu(c, L));
        PHASE(13, phase_moe_dn(c, L));
        PHASE(14, phase_ln<true>(c, p.in[29] + (size_t)L * D, p.in[30] + (size_t)L * D, L == 3 ? p.out : (float*)(ws + WS_X)));
    }
#undef PHASE
}

extern "C" void kernel_launch(void* const* d_in, const int* in_sizes, int n_in, void* d_out, int out_size, void* d_ws, size_t ws_size, hipStream_t stream) {
    static int grid = 0;
    if (grid == 0) {
        if (n_in != 31 || out_size != T * D || ws_size < WS_END) { fprintf(stderr, "kernel_launch: unexpected shapes (n_in %d out %d ws %zu need %zu)\n", n_in, out_size, ws_size, (size_t)WS_END); grid = -1; return; }
        int dev = 0, cus = 0, per_cu = 0;
        if (hipGetDevice(&dev) != hipSuccess || hipDeviceGetAttribute(&cus, hipDeviceAttributeMultiprocessorCount, dev) != hipSuccess) { grid = -1; return; }
        if (hipFuncSetAttribute((const void*)fwd_kernel, hipFuncAttributeMaxDynamicSharedMemorySize, LDS_BYTES) != hipSuccess) { fprintf(stderr, "kernel_launch: hipFuncSetAttribute failed\n"); grid = -1; return; }
        if (hipOccupancyMaxActiveBlocksPerMultiprocessor(&per_cu, (const void*)fwd_kernel, NTHREADS, LDS_BYTES) != hipSuccess || per_cu < 1) fprintf(stderr, "kernel_launch: occupancy query says %d\n", per_cu);
        (void)hipGetLastError();
        grid = cus;
    }
    if (grid < 0) return;
    (void)hipMemsetAsync((char*)d_ws + WS_CTL, 0, CTL_BYTES, stream);
    Params p{};
    for (int i = 0; i < 31; ++i) p.in[i] = (const float*)d_in[i];
    p.out = (float*)d_out; p.ws = (unsigned char*)d_ws;
#if N_LAUNCH_MODE == 1
    p.ph_lo = 0; p.ph_hi = N_PHASES;
    hipLaunchKernelGGL(fwd_kernel, dim3(grid), dim3(NTHREADS), LDS_BYTES, stream, p);
#else
    for (int i = 0; i < N_PHASES; ++i) { p.ph_lo = i; p.ph_hi = i + 1; hipLaunchKernelGGL(fwd_kernel, dim3(grid), dim3(NTHREADS), LDS_BYTES, stream, p); }
#endif
}
```

```cpp
#include <hip/hip_runtime.h>
#include <cstdio>
#include <cstdint>

#define LAS __attribute__((address_space(3)))
typedef unsigned short bf16_t;
typedef short bf16x8 __attribute__((ext_vector_type(8)));
typedef float f32x4 __attribute__((ext_vector_type(4)));
typedef float f32x2 __attribute__((ext_vector_type(2)));
typedef unsigned u32x4 __attribute__((ext_vector_type(4)));
typedef unsigned u32x2 __attribute__((ext_vector_type(2)));

constexpr int T = 16384, D = 1024, SEQ = 8192;
constexpr int AB_IN = 4352, AB_OUT = 2048, CD_IN = 4608, CD_OUT = 2304;
constexpr int NE = 128, NE1 = 129, TOPK = 8, ED = 256;
constexpr int TK = T * TOPK;
constexpr int NSLOT = TK + T;
constexpr int LISTCAP = 16384;
constexpr float ALPHA = 1.681792830507429f;
constexpr float LN_EPS = 1e-5f;

#ifndef N_LAUNCH_MODE
#define N_LAUNCH_MODE 1
#endif

constexpr size_t al256(size_t x) { return (x + 255) & ~(size_t)255; }
constexpr size_t WS_CTL    = 0;
constexpr size_t CTL_BYTES = 65536;
constexpr size_t CTL_CNT   = 32768;
constexpr size_t WS_WABIN  = CTL_BYTES;
constexpr size_t WS_WABOUT = WS_WABIN  + al256((size_t)2 * AB_IN * D * 2);
constexpr size_t WS_WCDIN  = WS_WABOUT + al256((size_t)2 * D * AB_OUT * 2);
constexpr size_t WS_WCDOUT = WS_WCDIN  + al256((size_t)2 * CD_IN * D * 2);
constexpr size_t WS_WRT    = WS_WCDOUT + al256((size_t)2 * D * CD_OUT * 2);
constexpr size_t WS_WGU    = WS_WRT    + al256((size_t)4 * 256 * D * 2);
constexpr size_t WS_WDN    = WS_WGU    + al256((size_t)4 * NE1 * 512 * D * 2);
constexpr size_t WS_X      = WS_WDN    + al256((size_t)4 * NE1 * D * ED * 2);
constexpr size_t WS_XB     = WS_X      + al256((size_t)T * D * 4);
constexpr size_t WS_U1     = WS_XB     + al256((size_t)T * D * 2);
constexpr size_t U1_BYTES  = al256((size_t)NSLOT * D * 2) > al256((size_t)T * CD_IN * 4) ? al256((size_t)NSLOT * D * 2) : al256((size_t)T * CD_IN * 4);
constexpr size_t WS_U2     = WS_U1     + U1_BYTES;
constexpr size_t U2_BYTES  = al256((size_t)T * 1280 * 4 * 3);
constexpr size_t WS_YCAT   = WS_U2     + U2_BYTES;
constexpr size_t WS_H      = WS_YCAT   + al256((size_t)T * CD_OUT * 2);
constexpr size_t WS_ZR     = WS_H      + al256((size_t)T * D * 4);
constexpr size_t WS_HID    = WS_ZR     + al256((size_t)T * 256 * 4);
constexpr size_t WS_LIST   = WS_HID    + al256((size_t)NSLOT * ED * 2);
constexpr size_t WS_GATE   = WS_LIST   + al256((size_t)NE * LISTCAP * 4);
constexpr size_t WS_END    = WS_GATE   + al256((size_t)NSLOT * 4);

__device__ __forceinline__ float bf2f(bf16_t b) { return __uint_as_float(((unsigned)b) << 16); }
__device__ __forceinline__ bf16_t f2bf(float f) { unsigned u = __float_as_uint(f); u += 0x7FFFu + ((u >> 16) & 1u); return (bf16_t)(u >> 16); }
__device__ __forceinline__ unsigned pk2(float lo, float hi) { return (unsigned)f2bf(lo) | ((unsigned)f2bf(hi) << 16); }
__device__ __forceinline__ float wave_sum(float v) {
#pragma unroll
    for (int o = 32; o; o >>= 1) v += __shfl_xor(v, o);
    return v; }
__device__ __forceinline__ float wave_max(float v) {
#pragma unroll
    for (int o = 32; o; o >>= 1) v = fmaxf(v, __shfl_xor(v, o));
    return v; }
__device__ __forceinline__ float gelu_tanh(float x) { const float u = 0.7978845608028654f * (x + 0.044715f * x * x * x); return 0.5f * x * (1.f + tanhf(u)); }
__device__ __forceinline__ float sigmoidf_(float x) { return 1.f / (1.f + __expf(-x)); }
__device__ __forceinline__ float siluf_(float x) { return x / (1.f + __expf(-x)); }

#define XB_TMO      128
#define XB_XCNT(j)  (256  + 64 * (j))
#define XB_XSUB(j)  (1280 + 64 * (j))
#define XB_XGEN(j)  (2304 + 64 * (j))
#define XB_TOP      3328
#define XB_TOPGEN   3392
#define XCD_BAR_WORDS 3456
#define XB_SPIN_CAP (1u << 22)

__device__ __forceinline__ unsigned xb_ld(unsigned* p)              { return __hip_atomic_load(p, __ATOMIC_RELAXED, __HIP_MEMORY_SCOPE_AGENT); }
__device__ __forceinline__ unsigned xb_add(unsigned* p, unsigned v) { return __hip_atomic_fetch_add(p, v, __ATOMIC_RELAXED, __HIP_MEMORY_SCOPE_AGENT); }
__device__ __forceinline__ unsigned xb_xcc_id() { return (unsigned)__builtin_amdgcn_s_getreg((3 << 11) | 20) & 0xFu; }
#define XB_SPIN(cond, bar) do { unsigned _sp = 0; while (cond) { __builtin_amdgcn_s_sleep(1); \
    if ((++_sp & 255u) == 0u) { if (xb_ld(&(bar)[XB_TMO])) break; if (_sp > XB_SPIN_CAP) { atomicAdd(&(bar)[XB_TMO], 1u); break; } } } } while (0)

struct XcdBarrier { unsigned* bar; unsigned x; volatile LAS unsigned* st; };

__device__ __forceinline__ XcdBarrier xcd_barrier_post(unsigned* bar, volatile LAS unsigned* st) {
    XcdBarrier b; b.bar = bar; b.x = xb_xcc_id(); b.st = st;
    if (threadIdx.x == 0) (void)xb_add(&bar[XB_XCNT(b.x)], 1u);
    return b;
}
__device__ __forceinline__ void xcd_barrier_complete(unsigned* bar, unsigned x, unsigned& nloc, unsigned& nx) {
    const unsigned G = gridDim.x * gridDim.y * gridDim.z;
    unsigned sum, cnt, mine, sp = 0u;
    for (;;) {
        sum = 0u; cnt = 0u; mine = 0u;
#pragma unroll
        for (unsigned j = 0; j < 16; ++j) { const unsigned c = xb_ld(&bar[XB_XCNT(j)]); sum += c; cnt += (c > 0u) ? 1u : 0u; mine = (j == x) ? c : mine; }
        if (sum == G) break;
        __builtin_amdgcn_s_sleep(1);
        if ((++sp & 255u) == 0u) { if (xb_ld(&bar[XB_TMO])) break; if (sp > XB_SPIN_CAP) { atomicAdd(&bar[XB_TMO], 1u); break; } }
    }
    nloc = mine > 0u ? mine : 1u; nx = cnt > 0u ? cnt : 1u;
}
__device__ __forceinline__ void xcd_barrier(const XcdBarrier& b) {
    asm volatile("s_waitcnt vmcnt(0)" ::: "memory");
    __syncthreads();
    if (threadIdx.x == 0) {
        unsigned* bar = b.bar;
        __builtin_amdgcn_s_waitcnt(0);
        unsigned nloc = b.st[0], nx = b.st[1];
        if (nloc == 0u) { xcd_barrier_complete(bar, b.x, nloc, nx); b.st[0] = nloc; b.st[1] = nx; }
        const unsigned old = xb_add(&bar[XB_XSUB(b.x)], 1u);
        const unsigned gen = old / nloc;
        if (old + 1u == (gen + 1u) * nloc) {
            __builtin_amdgcn_fence(__ATOMIC_RELEASE, "agent");
            asm volatile("s_waitcnt vmcnt(0)" ::: "memory");
            const unsigned og = xb_add(&bar[XB_TOP], 1u);
            const unsigned tg = og / nx;
            if (og + 1u == (tg + 1u) * nx) xb_add(&bar[XB_TOPGEN], 1u);
            else XB_SPIN(xb_ld(&bar[XB_TOPGEN]) == tg, bar);
            __builtin_amdgcn_fence(__ATOMIC_ACQUIRE, "agent");
            xb_add(&bar[XB_XGEN(b.x)], 1u);
            asm volatile("s_waitcnt vmcnt(0)" ::: "memory");
        } else {
            XB_SPIN(xb_ld(&bar[XB_XGEN(b.x)]) == gen, bar);
            __builtin_amdgcn_fence(__ATOMIC_ACQUIRE, "agent");
            asm volatile("s_waitcnt vmcnt(0)" ::: "memory");
        }
    }
    __syncthreads();
}

namespace g8 {
constexpr int BM = 256, BK = 64, HALF = 128, HTB = HALF * BK * 2, STAGE_BYTES = 8 * HTB, NXCD = 8, WGM = 8;
__device__ __forceinline__ int lds_byte(int r, int c) { const int st = (r >> 4) * 2 + (c >> 5), rr = r & 15, cc = c & 31, ob = rr * 64 + cc * 2; return st * 1024 + (ob ^ (((ob >> 9) & 1) << 5)); }
__device__ __forceinline__ void stage_rc(int b, int& R, int& C) { const int st = b / 1024, sb = b % 1024, swz = sb ^ (((sb >> 9) & 1) << 5); R = (st >> 1) * 16 + swz / 64; C = (st & 1) * 32 + (swz % 64) / 2; }
__device__ __forceinline__ int perm32(int rho) { const int n = rho >> 4, i = rho & 15; return 8 * (i >> 2) + 4 * n + (i & 3); }

struct Unit { const char* A; const char* B; int pm, pn, aux; };

struct DenseOrder {
    const char* A; const char* Bt; int nM, nN, nwg, G, c, K;
    __device__ void init(const void* A_, const void* Bt_, int M, int N, int K_, int G_, int c_) { A = (const char*)A_; Bt = (const char*)Bt_; nM = M / BM; nN = N / BM; nwg = nM * nN; G = G_; c = c_; K = K_; }
    __device__ __forceinline__ bool next(int i, Unit& u) const {
        const long L = (long)i * G + c; if (L >= nwg) return false;
        int wgid = (int)L; { const int q = nwg / NXCD, r = nwg % NXCD, xcd = wgid % NXCD, off = wgid / NXCD; wgid = (xcd < r ? xcd * (q + 1) : r * (q + 1) + (xcd - r) * q) + off; }
        const int nig = WGM * nN, gid = wgid / nig, fm = gid * WGM, gsz = (nM - fm) < WGM ? (nM - fm) : WGM;
        u.pm = fm + ((wgid % nig) % gsz); u.pn = (wgid % nig) / gsz; u.aux = 0;
        u.A = A + (size_t)u.pm * BM * K * 2; u.B = Bt + (size_t)u.pn * BM * K * 2; return true;
    }
    __device__ __forceinline__ void aoff(const Unit&, int tid, unsigned (&o)[2][2]) const {
#pragma unroll
        for (int i = 0; i < 2; ++i) { int R, C; stage_rc(tid * 16 + i * 8192, R, C);
            o[0][i] = (unsigned)(R * K + C) * 2u; o[1][i] = (unsigned)((R + HALF) * K + C) * 2u; }
    }
};

__device__ __forceinline__ unsigned cvt_pk_bf16(float lo, float hi) { unsigned r; asm volatile("v_cvt_pk_bf16_f32 %0, %1, %2" : "=v"(r) : "v"(lo), "v"(hi)); return r; }

struct EpiF32 {
    static constexpr bool PERM = false;
    float* C; int ldc; const float* bias;
    __device__ __forceinline__ void operator()(const f32x4 (&acc)[2][2][4][2], const Unit& u, int wr, int wc, int fr, int fq) const {
        const int row0 = u.pm * BM + wr * 64 + fr, col0 = u.pn * BM + wc * 32 + 4 * fq;
        f32x4 bv[2][2];
#pragma unroll
        for (int bj = 0; bj < 2; ++bj)
#pragma unroll
            for (int n = 0; n < 2; ++n) bv[bj][n] = bias ? *(const f32x4*)(bias + col0 + bj * HALF + n * 16) : (f32x4){0.f, 0.f, 0.f, 0.f};
#pragma unroll
        for (int ai = 0; ai < 2; ++ai)
#pragma unroll
            for (int m = 0; m < 4; ++m) { float* rowp = C + (size_t)(row0 + ai * HALF + m * 16) * ldc + col0;
#pragma unroll
                for (int bj = 0; bj < 2; ++bj)
#pragma unroll
                    for (int n = 0; n < 2; ++n) *(f32x4*)(rowp + bj * HALF + n * 16) = acc[ai][bj][m][n] + bv[bj][n]; }
    }
};

template <class Epi, class Sched>
__device__ __forceinline__ void gemm_phase(LAS unsigned char* lds, const int K, const Sched& S, const Epi& E) {
    int tid_ = threadIdx.x; asm volatile("" : "+v"(tid_));
    const int tid = tid_, wid = __builtin_amdgcn_readfirstlane(tid >> 6), lane = tid & 63, wr = wid >> 2, wc = wid & 3, fr = lane & 15, fq = lane >> 4;
    const int nt = K / BK;
    unsigned voffB[2];
#pragma unroll
    for (int i = 0; i < 2; ++i) { int R, C; stage_rc(tid * 16 + i * 8192, R, C); const int Rb = Epi::PERM ? ((R & ~31) + perm32(R & 31)) : R;
        voffB[i] = (unsigned)(Rb * K + C) * 2u; }
    const size_t kstep = (size_t)(BK * 2);
    const size_t hstep = (size_t)HALF * K * 2;
    const unsigned ldsw = (unsigned)wid * 1024u;
    const int aoff = lds_byte(wr * 64 + fr, fq * 8), boff = lds_byte(wc * 32 + fr, fq * 8);
#define G8_SA(b, h) (((b) * 2 + (h)) * HTB)
#define G8_SB(b, h) ((4 + (b) * 2 + (h)) * HTB)
#define G8_STAGE(bufoff, gbase, voff) do { _Pragma("unroll") for (int _i = 0; _i < 2; ++_i) \
        __builtin_amdgcn_global_load_lds((const unsigned*)((const char*)(gbase) + (voff)[_i]), (LAS unsigned*)(lds + (bufoff) + ldsw + _i * 8192), 16, 0, 0); } while (0)
#define G8_LDA(dst, b, h) do { _Pragma("unroll") for (int m = 0; m < 4; ++m) _Pragma("unroll") for (int k = 0; k < 2; ++k) dst[m][k] = *(const LAS bf16x8*)(lds + G8_SA(b, h) + aoff + m * 2048 + k * 1024); } while (0)
#define G8_LDB(dst, b, h) do { _Pragma("unroll") for (int n = 0; n < 2; ++n) _Pragma("unroll") for (int k = 0; k < 2; ++k) dst[n][k] = *(const LAS bf16x8*)(lds + G8_SB(b, h) + boff + n * 2048 + k * 1024); } while (0)
#define G8_MMA(ai, bj, At, Bt) do { __builtin_amdgcn_s_setprio(1); _Pragma("unroll") for (int m = 0; m < 4; ++m) _Pragma("unroll") for (int n = 0; n < 2; ++n) _Pragma("unroll") for (int k = 0; k < 2; ++k) \
        acc[ai][bj][m][n] = __builtin_amdgcn_mfma_f32_16x16x32_bf16(Bt[n][k], At[m][k], acc[ai][bj][m][n], 0, 0, 0); __builtin_amdgcn_s_setprio(0); } while (0)
#define G8_WAIT_V(n) asm volatile("s_waitcnt vmcnt(" #n ")" ::: "memory")
#define G8_WAIT_L(n) asm volatile("s_waitcnt lgkmcnt(" #n ")" ::: "memory")
#define G8_BAR __builtin_amdgcn_s_barrier()
#define G8_SCHED __builtin_amdgcn_sched_barrier(0)
    Unit cur, nxt; int ui = 0;
    if (!S.next(0, cur)) return;
    f32x4 acc[2][2][4][2];
#pragma unroll
    for (int a = 0; a < 2; ++a)
#pragma unroll
        for (int b = 0; b < 2; ++b)
#pragma unroll
            for (int m = 0; m < 4; ++m)
#pragma unroll
                for (int n = 0; n < 2; ++n) acc[a][b][m][n] = (f32x4){0.f, 0.f, 0.f, 0.f};
    bf16x8 At[4][2], B0[2][2], B1[2][2];
    unsigned oc[2][2];
    S.aoff(cur, tid, oc);
    const char* cA = cur.A; const char* cB = cur.B;
    G8_STAGE(G8_SB(0, 0), cB, voffB); G8_STAGE(G8_SA(0, 0), cA, oc[0]); G8_STAGE(G8_SB(0, 1), cB + hstep, voffB); G8_STAGE(G8_SA(0, 1), cA, oc[1]);
    if (wr == 1) G8_BAR;
    G8_WAIT_V(4); G8_BAR;
    G8_STAGE(G8_SB(1, 0), cB + kstep, voffB); G8_STAGE(G8_SA(1, 0), cA + kstep, oc[0]); G8_STAGE(G8_SB(1, 1), cB + hstep + kstep, voffB);
    G8_WAIT_V(6); G8_BAR;
    for (;;) {
        const bool has_next = S.next(ui + 1, nxt);
        const char* nA = has_next ? nxt.A : cA; const char* nB = has_next ? nxt.B : cB;
#pragma unroll 1
        for (int t = 0; t < nt; t += 2) {
            const bool last = (t == nt - 2);
            const char* a1 = cA + (size_t)(t + 1) * kstep;
            const char* a2 = last ? nA : cA + (size_t)(t + 2) * kstep; const char* b2 = last ? nB : cB + (size_t)(t + 2) * kstep;
            const char* a3 = a2 + kstep; const char* b3 = b2 + kstep;
            G8_LDB(B0, 0, 0); G8_SCHED; G8_LDA(At, 0, 0); G8_STAGE(G8_SA(1, 1), a1, oc[1]);
            if (last && has_next) S.aoff(nxt, tid, oc);
            G8_WAIT_L(8); G8_BAR; G8_WAIT_L(0); G8_MMA(0, 0, At, B0); G8_BAR; G8_SCHED;
            G8_LDB(B1, 0, 1); G8_STAGE(G8_SB(0, 0), b2, voffB);
            G8_BAR; G8_WAIT_L(0); G8_MMA(0, 1, At, B1); G8_BAR;
            G8_LDA(At, 0, 1); G8_STAGE(G8_SA(0, 0), a2, oc[0]);
            G8_BAR; G8_WAIT_L(0); G8_MMA(1, 0, At, B0); G8_BAR; G8_SCHED;
            G8_STAGE(G8_SB(0, 1), b2 + hstep, voffB);
            G8_WAIT_V(6); G8_BAR; G8_MMA(1, 1, At, B1); G8_BAR;
            G8_LDB(B0, 1, 0); G8_SCHED; G8_LDA(At, 1, 0); G8_STAGE(G8_SA(0, 1), a2, oc[1]);
            G8_WAIT_L(8); G8_BAR; G8_WAIT_L(0); G8_MMA(0, 0, At, B0); G8_BAR; G8_SCHED;
            G8_LDB(B1, 1, 1); G8_STAGE(G8_SB(1, 0), b3, voffB);
            G8_BAR; G8_WAIT_L(0); G8_MMA(0, 1, At, B1); G8_BAR;
            G8_LDA(At, 1, 1); G8_STAGE(G8_SA(1, 0), a3, oc[0]);
            G8_BAR; G8_WAIT_L(0); G8_MMA(1, 0, At, B0); G8_BAR; G8_SCHED;
            G8_STAGE(G8_SB(1, 1), b3 + hstep, voffB);
            G8_WAIT_V(6); G8_BAR; G8_MMA(1, 1, At, B1); G8_BAR;
        }
        E(acc, cur, wr, wc, fr, fq);
        if (!has_next) break;
#pragma unroll
        for (int a = 0; a < 2; ++a)
#pragma unroll
            for (int b = 0; b < 2; ++b)
#pragma unroll
                for (int m = 0; m < 4; ++m)
#pragma unroll
                    for (int n = 0; n < 2; ++n) acc[a][b][m][n] = (f32x4){0.f, 0.f, 0.f, 0.f};
        cur = nxt; cA = nA; cB = nB; ++ui;
    }
    G8_WAIT_V(0);
    if (wr == 0) G8_BAR;
    G8_BAR;
#undef G8_SA
#undef G8_SB
#undef G8_STAGE
#undef G8_LDA
#undef G8_LDB
#undef G8_MMA
#undef G8_WAIT_V
#undef G8_WAIT_L
#undef G8_BAR
#undef G8_SCHED
}
}

constexpr int NTHREADS = 512;
constexpr int LDS_STAGE = 0;
constexpr int LDS_TAB   = g8::STAGE_BYTES;
constexpr int TAB_SLOTS = 12;
constexpr int LDS_DESC  = LDS_TAB + TAB_SLOTS * 256 * 4;
constexpr int LDS_PREF  = LDS_DESC + 64;
constexpr int LDS_MISC  = LDS_PREF + 132 * 4 + 48;
constexpr int LDS_BYTES = 147456;
static_assert(LDS_MISC % 16 == 0 && LDS_MISC + 64 <= LDS_BYTES, "LDS map");

struct Params { const float* in[31]; float* out; unsigned char* ws; int ph_lo, ph_hi; };

struct Ctx {
    const float* const* in; float* out; unsigned char* ws; LAS unsigned char* lds;
    int tid, lane, wid, bid, G, gtid, gthreads, gw, nwaves;
};

template <class DstFn>
__device__ __forceinline__ void convert_T(const Ctx& c, const float* src, int nmat, int K, int N, DstFn dstfn) {
    LAS float* tile = (LAS float*)(c.lds);
    const int tk = K / 64, tn = N / 64; const long ntiles = (long)nmat * tk * tn;
    for (long tix = c.bid; tix < ntiles; tix += c.G) {
        const int m = (int)(tix / (tk * tn)); const int rem = (int)(tix % (tk * tn)); const int kt = rem / tn, nt = rem % tn;
        const float* s = src + (size_t)m * K * N + (size_t)(kt * 64) * N + nt * 64;
#pragma unroll
        for (int i = 0; i < 2; ++i) { const int k = (c.tid >> 4) + 32 * i, n4 = (c.tid & 15) * 4; const f32x4 v = *(const f32x4*)(s + (size_t)k * N + n4);
            tile[k * 65 + n4 + 0] = v[0]; tile[k * 65 + n4 + 1] = v[1]; tile[k * 65 + n4 + 2] = v[2]; tile[k * 65 + n4 + 3] = v[3]; }
        __syncthreads();
        { const int n = c.tid >> 3, k8 = (c.tid & 7) * 8; u32x4 w;
          w[0] = pk2(tile[(k8 + 0) * 65 + n], tile[(k8 + 1) * 65 + n]); w[1] = pk2(tile[(k8 + 2) * 65 + n], tile[(k8 + 3) * 65 + n]);
          w[2] = pk2(tile[(k8 + 4) * 65 + n], tile[(k8 + 5) * 65 + n]); w[3] = pk2(tile[(k8 + 6) * 65 + n], tile[(k8 + 7) * 65 + n]);
          bf16_t* d = dstfn(m, nt * 64 + n) + kt * 64 + k8; *(u32x4*)d = w; }
        __syncthreads();
    }
}

__device__ __forceinline__ void phase_convert(const Ctx& c) {
    unsigned char* ws = c.ws;
    { const float* x = c.in[0]; float* xo = (float*)(ws + WS_X); bf16_t* xb = (bf16_t*)(ws + WS_XB);
      for (long i = c.gtid; i < (long)T * D / 4; i += c.gthreads) { const f32x4 v = *(const f32x4*)(x + i * 4); *(f32x4*)(xo + i * 4) = v; u32x2 w; w[0] = pk2(v[0], v[1]); w[1] = pk2(v[2], v[3]); *(u32x2*)(xb + i * 4) = w; } }
    { bf16_t* wrt = (bf16_t*)(ws + WS_WRT); for (long i = c.gtid; i < (long)4 * 128 * D / 8; i += c.gthreads) { const long l = i / (128 * D / 8), r = i % (128 * D / 8); *(u32x4*)(wrt + (size_t)l * 256 * D + (size_t)128 * D + r * 8) = (u32x4){0u, 0u, 0u, 0u}; }
      float* gate = (float*)(ws + WS_GATE); for (int i = c.gtid; i < T; i += c.gthreads) gate[TK + i] = 1.f; }
    { bf16_t* d = (bf16_t*)(ws + WS_WABIN);  convert_T(c, c.in[1], 2, D, AB_IN, [=](int m, int n) { return d + (size_t)m * AB_IN * D + (size_t)n * D; }); }
    { bf16_t* d = (bf16_t*)(ws + WS_WABOUT); convert_T(c, c.in[4], 2, AB_OUT, D, [=](int m, int n) { return d + (size_t)m * D * AB_OUT + (size_t)n * AB_OUT; }); }
    { bf16_t* d = (bf16_t*)(ws + WS_WCDIN);  convert_T(c, c.in[6], 2, D, CD_IN, [=](int m, int n) { return d + (size_t)m * CD_IN * D + (size_t)n * D; }); }
    { bf16_t* d = (bf16_t*)(ws + WS_WCDOUT); convert_T(c, c.in[17], 2, CD_OUT, D, [=](int m, int n) { return d + (size_t)m * D * CD_OUT + (size_t)n * CD_OUT; }); }
    { bf16_t* d = (bf16_t*)(ws + WS_WRT);    convert_T(c, c.in[21], 4, D, NE, [=](int m, int n) { return d + (size_t)m * 256 * D + (size_t)n * D; }); }
    { bf16_t* d = (bf16_t*)(ws + WS_WGU);
      convert_T(c, c.in[23], 4 * NE, D, ED, [=](int m, int n) { return d + (size_t)((m >> 7) * NE1 + (m & 127)) * 512 * D + (size_t)((n >> 7) * 256 + (n & 127)) * D; });
      convert_T(c, c.in[24], 4 * NE, D, ED, [=](int m, int n) { return d + (size_t)((m >> 7) * NE1 + (m & 127)) * 512 * D + (size_t)((n >> 7) * 256 + 128 + (n & 127)) * D; });
      convert_T(c, c.in[26], 4, D, ED, [=](int m, int n) { return d + (size_t)(m * NE1 + NE) * 512 * D + (size_t)((n >> 7) * 256 + (n & 127)) * D; });
      convert_T(c, c.in[27], 4, D, ED, [=](int m, int n) { return d + (size_t)(m * NE1 + NE) * 512 * D + (size_t)((n >> 7) * 256 + 128 + (n & 127)) * D; }); }
    { bf16_t* d = (bf16_t*)(ws + WS_WDN);
      convert_T(c, c.in[25], 4 * NE, ED, D, [=](int m, int n) { return d + (size_t)((m >> 7) * NE1 + (m & 127)) * D * ED + (size_t)n * ED; });
      convert_T(c, c.in[28], 4, ED, D, [=](int m, int n) { return d + (size_t)(m * NE1 + NE) * D * ED + (size_t)n * ED; }); }
}

__device__ __forceinline__ void phase_dense(const Ctx& c, const bf16_t* A, const bf16_t* Bt, int M, int N, int K, float* C, int ldc, const float* bias) {
    g8::DenseOrder S; S.init(A, Bt, M, N, K, c.G, c.bid);
    g8::EpiF32 E{C, ldc, bias};
    g8::gemm_phase<g8::EpiF32, g8::DenseOrder>(c.lds + LDS_STAGE, K, S, E);
}

__device__ __forceinline__ void phase_ab_rope(const Ctx& c) {
    float* z = (float*)(c.ws + WS_U1);
    for (long idx = c.gtid; idx < (long)T * 1088; idx += c.gthreads) {
        const int t = (int)(idx / 1088), p = (int)(idx % 1088), s = t & (SEQ - 1);
        int c1, c2; float e, scale;
        if (p < 512)      { const int h = p >> 5, j = p & 31; c1 = h * 64 + j; c2 = c1 + 32; e = (float)j * (1.f / 32.f); scale = 0.125f; }
        else if (p < 576) { const int pp = p - 512, h = pp >> 5, j = pp & 31; c1 = 1024 + h * 64 + j; c2 = c1 + 32; e = (float)j * (1.f / 32.f); scale = 1.f; }
        else if (p < 832) { const int pp = p - 576, h = pp >> 6, j = pp & 63; c1 = 1280 + h * 128 + j; c2 = c1 + 64; e = (float)j * (1.f / 63.f); scale = 1.f; }
        else              { const int pp = p - 832, h = pp >> 6, j = pp & 63; c1 = 1792 + h * 128 + j; c2 = c1 + 64; e = (float)j * (1.f / 63.f); scale = 0.08838834764831845f; }
        const float invf = exp2f(-e * 13.287712379549449f);
        const float ang = (float)s * invf; float sn, cs; sincosf(ang, &sn, &cs);
        float* zr = z + (size_t)t * AB_IN; const float x1 = zr[c1], x2 = zr[c2];
        zr[c1] = (x1 * cs - x2 * sn) * scale; zr[c2] = (x2 * cs + x1 * sn) * scale;
    }
}

__device__ __forceinline__ void phase_ab_mix(const Ctx& c, int j) {
    const float* z = (const float*)(c.ws + WS_U1); bf16_t* ycat = (bf16_t*)(c.ws + WS_YCAT); float* ro = (float*)(c.ws + WS_U2);
    const float* sinks = c.in[3] + j * 16;
    const int lane = c.lane;
    if (c.bid < 64) {
        const int it = c.bid * 8 + c.wid; const int b = it >> 8, h = (it >> 6) & 3, e0 = (it & 63) * 4;
        const float gam = 1.f - exp2f(-5.f - (float)h);
        float S0[4] = {0.f, 0.f, 0.f, 0.f}, S1[4] = {0.f, 0.f, 0.f, 0.f};
        for (int s = 0; s < SEQ; ++s) {
            const float* zr = z + (size_t)(b * SEQ + s) * AB_IN;
            const float q0 = zr[1280 + h * 128 + lane], q1 = zr[1280 + h * 128 + 64 + lane];
            const float k0 = zr[1792 + h * 128 + lane], k1 = zr[1792 + h * 128 + 64 + lane];
            const f32x4 v = *(const f32x4*)(zr + 2304 + h * 256 + e0);
            f32x4 o;
#pragma unroll
            for (int e = 0; e < 4; ++e) { S0[e] = gam * S0[e] + k0 * v[e]; S1[e] = gam * S1[e] + k1 * v[e]; o[e] = wave_sum(q0 * S0[e] + q1 * S1[e]); }
            if (lane == 0) *(f32x4*)(ro + (size_t)(b * SEQ + s) * D + h * 256 + e0) = o;
        }
    } else {
        const int nw = (c.G - 64) * 8;
        for (long it = (long)(c.bid - 64) * 8 + c.wid; it < (long)T * 16; it += nw) {
            const int t = (int)(it >> 4), hd = (int)(it & 15), kvh = hd >> 3, s = t & (SEQ - 1), tb = t - s;
            const float* qrow = z + (size_t)t * AB_IN + hd * 64;
            float sc[2];
#pragma unroll
            for (int u2 = 0; u2 < 2; ++u2) { const int jk = s - lane - 64 * u2; float a = -1e30f;
                if (jk >= 0) { const float* kr = z + (size_t)(tb + jk) * AB_IN + 1024 + kvh * 64; float d = 0.f;
                    for (int dd = 0; dd < 64; dd += 4) { const f32x4 qv = *(const f32x4*)(qrow + dd), kv = *(const f32x4*)(kr + dd); d += qv[0] * kv[0] + qv[1] * kv[1] + qv[2] * kv[2] + qv[3] * kv[3]; }
                    a = d; }
                sc[u2] = a; }
            const float sink = sinks[hd];
            const float m = fmaxf(wave_max(fmaxf(sc[0], sc[1])), sink);
            const float p0 = (s - lane >= 0) ? __expf(sc[0] - m) : 0.f, p1 = (s - lane - 64 >= 0) ? __expf(sc[1] - m) : 0.f;
            const float den = wave_sum(p0 + p1) + __expf(sink - m);
            float o = 0.f;
            for (int jj = 0; jj < 128; ++jj) { const float pj = __shfl(jj < 64 ? p0 : p1, jj & 63); const int jk = s - jj;
                if (jk >= 0) o += pj * z[(size_t)(tb + jk) * AB_IN + 1152 + kvh * 64 + lane]; }
            ycat[(size_t)t * AB_OUT + hd * 64 + lane] = f2bf(o / den);
        }
    }
}

__device__ __forceinline__ void phase_ab_norm(const Ctx& c) {
    const float* z = (const float*)(c.ws + WS_U1); bf16_t* ycat = (bf16_t*)(c.ws + WS_YCAT); const float* ro = (const float*)(c.ws + WS_U2);
    for (long it = c.gw; it < (long)T * 4; it += c.nwaves) {
        const int t = (int)(it >> 2), h = (int)(it & 3);
        const f32x4 v = *(const f32x4*)(ro + (size_t)t * D + h * 256 + c.lane * 4);
        const float mean = wave_sum(v[0] + v[1] + v[2] + v[3]) * (1.f / 256.f);
        const f32x4 d = v - mean;
        const float var = wave_sum(d[0] * d[0] + d[1] * d[1] + d[2] * d[2] + d[3] * d[3]) * (1.f / 256.f);
        const float rstd = rsqrtf(var + LN_EPS);
        const f32x4 g = *(const f32x4*)(z + (size_t)t * AB_IN + 3328 + h * 256 + c.lane * 4);
        u32x2 w; w[0] = pk2(siluf_(g[0]) * d[0] * rstd, siluf_(g[1]) * d[1] * rstd); w[1] = pk2(siluf_(g[2]) * d[2] * rstd, siluf_(g[3]) * d[3] * rstd);
        *(u32x2*)(ycat + (size_t)t * AB_OUT + 1024 + h * 256 + c.lane * 4) = w;
    }
}

__device__ __forceinline__ void phase_cd_act(const Ctx& c, int j) {
    float* z = (float*)(c.ws + WS_U1); float* xc = (float*)(c.ws + WS_U2);
    const float* conv_w = c.in[10] + (size_t)j * 4 * 1280; const float* conv_b = c.in[11] + (size_t)j * 1280;
    for (long idx = c.gtid; idx < (long)T * 1280; idx += c.gthreads) {
        const int t = (int)(idx / 1280), ch = (int)(idx % 1280), s = t & (SEQ - 1);
        float a = conv_b[ch];
#pragma unroll
        for (int k = 0; k < 4; ++k) { const int sp = s - 3 + k; if (sp >= 0) a += conv_w[k * 1280 + ch] * z[(size_t)(t - 3 + k) * CD_IN + 3328 + ch]; }
        xc[(size_t)t * 1280 + ch] = a;
    }
    for (long t = c.gw; t < T; t += c.nwaves) {
        float* zr = z + (size_t)t * CD_IN;
        for (int i = c.lane; i < 1024; i += 64) zr[i] = gelu_tanh(zr[i]);
        for (int i = c.lane; i < 1280; i += 64) zr[2048 + i] = gelu_tanh(zr[2048 + i]);
        float gv[16]; float sm = 0.f;
#pragma unroll
        for (int i = 0; i < 16; ++i) { gv[i] = gelu_tanh(zr[1024 + c.lane + 64 * i]); sm += gv[i]; }
        const float mean = wave_sum(sm) * (1.f / 1024.f); float sq = 0.f;
#pragma unroll
        for (int i = 0; i < 16; ++i) { gv[i] -= mean; sq += gv[i] * gv[i]; }
        const float rstd = rsqrtf(wave_sum(sq) * (1.f / 1024.f) + LN_EPS);
#pragma unroll
        for (int i = 0; i < 16; ++i) zr[1024 + c.lane + 64 * i] = gv[i] * rstd;
    }
}

__device__ __forceinline__ void phase_cd_mix(const Ctx& c, int j) {
    const float* z = (const float*)(c.ws + WS_U1); bf16_t* ycat = (bf16_t*)(c.ws + WS_YCAT);
    const float* xc = (const float*)(c.ws + WS_U2); float* av = (float*)(c.ws + WS_U2) + (size_t)T * 1280; float* bv = av + (size_t)T * 1280;
    const float* sgu_w = c.in[8] + (size_t)j * 4 * 128 * 128; const float* sgu_b = c.in[9] + (size_t)j * 4 * 128;
    const float* wa = c.in[12] + (size_t)j * 5 * 65536; const float* ba = c.in[13] + (size_t)j * 1280;
    const float* wx = c.in[14] + (size_t)j * 5 * 65536; const float* bx = c.in[15] + (size_t)j * 1280; const float* lam = c.in[16] + (size_t)j * 1280;
    for (long idx = c.gtid; idx < (long)T * 1024; idx += c.gthreads) {
        const int t = (int)(idx >> 10), col = (int)(idx & 1023), i = t & 127, t0 = t - i, g = col >> 8;
        const float* w = sgu_w + (size_t)g * 16384 + (size_t)i * 128; float a = 0.f;
        for (int jj = 0; jj <= i; ++jj) a += w[jj] * z[(size_t)(t0 + jj) * CD_IN + 1024 + col];
        const float mixed = a + sgu_b[g * 128 + i];
        ycat[(size_t)t * CD_OUT + col] = f2bf(z[(size_t)t * CD_IN + col] * mixed);
    }
    for (long idx = c.gtid; idx < (long)T * 1280; idx += c.gthreads) {
        const int t = (int)(idx / 1280), ch = (int)(idx % 1280), h = ch >> 8, cc = ch & 255;
        const float* xr = xc + (size_t)t * 1280 + h * 256; const float* wah = wa + (size_t)h * 65536 + cc; const float* wxh = wx + (size_t)h * 65536 + cc;
        float r = ba[ch], ig = bx[ch];
        for (int i = 0; i < 256; ++i) { const float xv = xr[i]; r += xv * wah[(size_t)i * 256]; ig += xv * wxh[(size_t)i * 256]; }
        r = sigmoidf_(r); ig = sigmoidf_(ig);
        const float sp = log1pf(expf(-lam[ch]));
        const float log_a = -8.f * r * sp; const float a = expf(log_a);
        const float b = sqrtf(-expm1f(2.f * log_a)) * (ig * xc[(size_t)t * 1280 + ch]);
        av[(size_t)t * 1280 + ch] = a; bv[(size_t)t * 1280 + ch] = b;
    }
}

__device__ __forceinline__ void phase_cd_scan(const Ctx& c) {
    const float* z = (const float*)(c.ws + WS_U1); bf16_t* ycat = (bf16_t*)(c.ws + WS_YCAT);
    const float* av = (const float*)(c.ws + WS_U2) + (size_t)T * 1280; const float* bv = av + (size_t)T * 1280;
    for (int idx = c.gtid; idx < 2 * 1280; idx += c.gthreads) {
        const int b = idx / 1280, ch = idx % 1280; float h = 0.f;
        for (int s = 0; s < SEQ; ++s) { const size_t t = (size_t)b * SEQ + s; h = av[t * 1280 + ch] * h + bv[t * 1280 + ch];
            ycat[t * CD_OUT + 1024 + ch] = f2bf(z[t * CD_IN + 2048 + ch] * h); }
    }
}

template <bool MOE>
__device__ __forceinline__ void phase_ln(const Ctx& c, const float* g, const float* bta, float* xout) {
    float* x = (float*)(c.ws + WS_X); bf16_t* xb = (bf16_t*)(c.ws + WS_XB);
    const float* hbuf = (const float*)(c.ws + WS_H); const bf16_t* Y = (const bf16_t*)(c.ws + WS_U1);
    for (long t = c.gw; t < T; t += c.nwaves) {
        f32x4 v[4];
#pragma unroll
        for (int q = 0; q < 4; ++q) { const int col = q * 256 + c.lane * 4;
            f32x4 f;
            if (!MOE) f = *(const f32x4*)(hbuf + (size_t)t * D + col);
            else { f = (f32x4){0.f, 0.f, 0.f, 0.f};
#pragma unroll
                for (int k = 0; k < 9; ++k) { const size_t srow = (k < 8) ? (size_t)t * 8 + k : (size_t)TK + t; const u32x2 w = *(const u32x2*)(Y + srow * D + col);
                    f[0] += __uint_as_float(w[0] << 16); f[1] += __uint_as_float(w[0] & 0xffff0000u); f[2] += __uint_as_float(w[1] << 16); f[3] += __uint_as_float(w[1] & 0xffff0000u); } }
            const f32x4 xv = *(const f32x4*)(x + (size_t)t * D + col);
            v[q] = xv * ALPHA + f; }
        float sm = 0.f;
#pragma unroll
        for (int q = 0; q < 4; ++q) sm += v[q][0] + v[q][1] + v[q][2] + v[q][3];
        const float mean = wave_sum(sm) * (1.f / 1024.f); float sq = 0.f;
#pragma unroll
        for (int q = 0; q < 4; ++q) { v[q] = v[q] - mean; sq += v[q][0] * v[q][0] + v[q][1] * v[q][1] + v[q][2] * v[q][2] + v[q][3] * v[q][3]; }
        const float rstd = rsqrtf(wave_sum(sq) * (1.f / 1024.f) + LN_EPS);
#pragma unroll
        for (int q = 0; q < 4; ++q) { const int col = q * 256 + c.lane * 4; const f32x4 gg = *(const f32x4*)(g + col), bb = *(const f32x4*)(bta + col);
            const f32x4 o = v[q] * rstd * gg + bb;
            *(f32x4*)(xout + (size_t)t * D + col) = o; if (xout != x) *(f32x4*)(x + (size_t)t * D + col) = o;
            u32x2 w; w[0] = pk2(o[0], o[1]); w[1] = pk2(o[2], o[3]); *(u32x2*)(xb + (size_t)t * D + col) = w; }
    }
}

__device__ __forceinline__ void phase_route(const Ctx& c, int L) {
    const float* zr = (const float*)(c.ws + WS_ZR); const float* rb = c.in[22] + L * NE;
    int* cnt = (int*)(c.ws + CTL_CNT) + L * NE; int* list = (int*)(c.ws + WS_LIST); float* gate = (float*)(c.ws + WS_GATE);
    for (long t = c.gw; t < T; t += c.nwaves) {
        const float s0 = sigmoidf_(zr[(size_t)t * 256 + c.lane]), s1 = sigmoidf_(zr[(size_t)t * 256 + 64 + c.lane]);
        float v0 = s0 + rb[c.lane], v1 = s1 + rb[64 + c.lane];
        float mysc = 0.f; int myexp = -1; float tot = 0.f;
        for (int k = 0; k < 8; ++k) {
            float bv = v0; int bi = c.lane; if (v1 > bv) { bv = v1; bi = c.lane + 64; }
#pragma unroll
            for (int o = 32; o; o >>= 1) { const float ov = __shfl_xor(bv, o); const int oi = __shfl_xor(bi, o); if (ov > bv || (ov == bv && oi < bi)) { bv = ov; bi = oi; } }
            const float sc = __shfl((bi & 64) ? s1 : s0, bi & 63);
            tot += sc;
            if (c.lane == k) { mysc = sc; myexp = bi; }
            if (c.lane == (bi & 63)) { if (bi & 64) v1 = -1e30f; else v0 = -1e30f; }
        }
        if (c.lane < 8) { const int pos = atomicAdd(&cnt[myexp], 1); list[(size_t)myexp * LISTCAP + pos] = (int)t * 8 + c.lane; gate[(size_t)t * 8 + c.lane] = mysc / tot * 2.5f; }
    }
}

struct MoeOrder {
    const char* Abase; const char* Bbase; size_t Bstride; int K, NT, total, G, c, mode;
    LAS int* tab; LAS int* desc;
    __device__ __forceinline__ bool next(int i, g8::Unit& u) const {
        const long L = (long)i * G + c; if (L >= total || i >= TAB_SLOTS) return false;
        const int d = desc[i]; const int e = d >> 12, pn = d & 15;
        u.pm = (d >> 4) & 255; u.pn = pn; u.aux = i; u.A = Abase; u.B = Bbase + (size_t)e * Bstride + (size_t)pn * 256 * K * 2; return true;
    }
    __device__ __forceinline__ void aoff(const g8::Unit& u, int tid, unsigned (&o)[2][2]) const {
#pragma unroll
        for (int i = 0; i < 2; ++i) { int R, C; g8::stage_rc(tid * 16 + i * 8192, R, C);
#pragma unroll
            for (int h = 0; h < 2; ++h) { int s = tab[u.aux * 256 + h * 128 + R]; s = s < 0 ? 0 : s; const int row = mode ? s : (s < TK ? (s >> 3) : s - TK);
                o[h][i] = (unsigned)(row * K + C) * 2u; } }
    }
};
__device__ __forceinline__ void moe_setup(const Ctx& c, MoeOrder& S, const int* cnt, int NT) {
    LAS int* pref = (LAS int*)(c.lds + LDS_PREF); LAS int* desc = (LAS int*)(c.lds + LDS_DESC); LAS int* tab = (LAS int*)(c.lds + LDS_TAB);
    const int* list = (const int*)(c.ws + WS_LIST);
    if (c.tid == 0) { int acc = 0; for (int e = 0; e < NE1; ++e) { pref[e] = acc; const int n = e < NE ? cnt[e] : T; acc += (n + 255) >> 8; } pref[NE1] = acc; }
    __syncthreads();
    const int total = pref[NE1] * NT;
    S.NT = NT; S.total = total; S.G = c.G; S.c = c.bid; S.tab = tab; S.desc = desc;
    for (int i = 0; i < TAB_SLOTS; ++i) {
        const long L = (long)i * c.G + c.bid; if (L >= total) break;
        int wgid = (int)L; { const int q = total / 8, r = total % 8, xcd = wgid % 8, off = wgid / 8; wgid = (xcd < r ? xcd * (q + 1) : r * (q + 1) + (xcd - r) * q) + off; }
        const int rbg = wgid / NT, pn = wgid % NT;
        int lo = 0, hi = NE1;
        while (hi - lo > 1) { const int mid = (lo + hi) >> 1; if (pref[mid] <= rbg) lo = mid; else hi = mid; }
        const int e = lo, rb = rbg - pref[e], n = e < NE ? cnt[e] : T;
        if (c.tid == 0) desc[i] = (e << 12) | (rb << 4) | pn;
        if (c.tid < 256) { const int r = rb * 256 + c.tid; int s = -1; if (r < n) s = (e < NE) ? list[(size_t)e * LISTCAP + r] : TK + r; tab[i * 256 + c.tid] = s; }
    }
    __syncthreads();
}
struct EpiMoeGU {
    static constexpr bool PERM = true;
    bf16_t* H; LAS int* tab;
    __device__ __forceinline__ void operator()(const f32x4 (&acc)[2][2][4][2], const g8::Unit& u, int wr, int wc, int fr, int fq) const {
#pragma unroll
        for (int ai = 0; ai < 2; ++ai)
#pragma unroll
            for (int m = 0; m < 4; ++m) { const int r = ai * 128 + wr * 64 + m * 16 + fr; const int s = tab[u.aux * 256 + r];
                if (s >= 0) { u32x4 w;
#pragma unroll
                    for (int n = 0; n < 2; ++n) { const f32x4 g = acc[ai][0][m][n], up = acc[ai][1][m][n];
                        w[2 * n] = pk2(siluf_(g[0]) * up[0], siluf_(g[1]) * up[1]); w[2 * n + 1] = pk2(siluf_(g[2]) * up[2], siluf_(g[3]) * up[3]); }
                    *(u32x4*)(H + (size_t)s * ED + u.pn * 128 + wc * 32 + fq * 8) = w; } }
    }
};
struct EpiMoeDN {
    static constexpr bool PERM = true;
    bf16_t* Y; const float* gate; LAS int* tab;
    __device__ __forceinline__ void operator()(const f32x4 (&acc)[2][2][4][2], const g8::Unit& u, int wr, int wc, int fr, int fq) const {
#pragma unroll
        for (int ai = 0; ai < 2; ++ai)
#pragma unroll
            for (int m = 0; m < 4; ++m) { const int r = ai * 128 + wr * 64 + m * 16 + fr; const int s = tab[u.aux * 256 + r];
                if (s >= 0) { const float gt = gate[s];
#pragma unroll
                    for (int bj = 0; bj < 2; ++bj) { u32x4 w;
#pragma unroll
                        for (int n = 0; n < 2; ++n) { const f32x4 a = acc[ai][bj][m][n] * gt; w[2 * n] = pk2(a[0], a[1]); w[2 * n + 1] = pk2(a[2], a[3]); }
                        *(u32x4*)(Y + (size_t)s * D + u.pn * 256 + bj * 128 + wc * 32 + fq * 8) = w; } } }
    }
};
__device__ __forceinline__ void phase_moe_gu(const Ctx& c, int L) {
    MoeOrder S; S.Abase = (const char*)(c.ws + WS_XB); S.Bbase = (const char*)(c.ws + WS_WGU) + (size_t)L * NE1 * 512 * D * 2; S.Bstride = (size_t)512 * D * 2; S.K = D; S.mode = 0;
    moe_setup(c, S, (const int*)(c.ws + CTL_CNT) + L * NE, 2);
    EpiMoeGU E{(bf16_t*)(c.ws + WS_HID), S.tab};
    g8::gemm_phase<EpiMoeGU, MoeOrder>(c.lds + LDS_STAGE, D, S, E);
}
__device__ __forceinline__ void phase_moe_dn(const Ctx& c, int L) {
    MoeOrder S; S.Abase = (const char*)(c.ws + WS_HID); S.Bbase = (const char*)(c.ws + WS_WDN) + (size_t)L * NE1 * D * ED * 2; S.Bstride = (size_t)D * ED * 2; S.K = ED; S.mode = 1;
    moe_setup(c, S, (const int*)(c.ws + CTL_CNT) + L * NE, 4);
    EpiMoeDN E{(bf16_t*)(c.ws + WS_U1), (const float*)(c.ws + WS_GATE), S.tab};
    g8::gemm_phase<EpiMoeDN, MoeOrder>(c.lds + LDS_STAGE, ED, S, E);
}

constexpr int PH_PER_LAYER = 11;
constexpr int N_PHASES = 1 + 4 * PH_PER_LAYER;

__global__ void __launch_bounds__(NTHREADS, 2) fwd_kernel(Params p) {
    extern __shared__ __attribute__((aligned(16))) unsigned char lds_raw[];
    LAS unsigned char* const lds0 = (LAS unsigned char*)lds_raw;
    volatile LAS unsigned* misc = (volatile LAS unsigned*)(lds0 + LDS_MISC);
    if (threadIdx.x < 4) misc[threadIdx.x] = 0u;
    __syncthreads();
    const int lo = p.ph_lo, hi = p.ph_hi;
    XcdBarrier bar; bar.bar = (unsigned*)(p.ws + WS_CTL); bar.x = 0; bar.st = misc;
    if (hi - lo > 1) bar = xcd_barrier_post((unsigned*)(p.ws + WS_CTL), misc);
#define MKCTX() Ctx c; { int tid_ = threadIdx.x; asm volatile("" : "+v"(tid_)); int bid_ = blockIdx.x; asm volatile("" : "+s"(bid_)); unsigned long long ws_ = (unsigned long long)p.ws; asm volatile("" : "+s"(ws_)); \
        c.in = p.in; c.out = p.out; c.ws = (unsigned char*)ws_; c.lds = lds0; c.tid = tid_; c.lane = tid_ & 63; c.wid = __builtin_amdgcn_readfirstlane(tid_ >> 6); c.bid = bid_; c.G = gridDim.x; \
        c.gtid = c.bid * NTHREADS + c.tid; c.gthreads = c.G * NTHREADS; c.gw = c.bid * 8 + c.wid; c.nwaves = c.G * 8; } unsigned char* const ws = c.ws; (void)ws
    int id = 0;
#ifndef PMASK
#define PMASK 0xffffffffu
#endif
#define PHASE(k, body) do { if (((PMASK >> (k)) & 1u) && lo <= id && id < hi) { MKCTX(); body; if (id + 1 < hi) xcd_barrier(bar); } ++id; } while (0)
    PHASE(0, phase_convert(c));
#pragma unroll 1
    for (int L = 0; L < 4; ++L) {
        const int j = L >> 1; const bool cd = (L & 1);
        {
            const size_t Woff = cd ? WS_WCDIN + (size_t)j * CD_IN * D * 2 : WS_WABIN + (size_t)j * AB_IN * D * 2;
            const int N = cd ? CD_IN : AB_IN; const float* bias = cd ? p.in[7] + (size_t)j * CD_IN : p.in[2] + (size_t)j * AB_IN;
            PHASE(1, phase_dense(c, (const bf16_t*)(ws + WS_XB), (const bf16_t*)(ws + Woff), T, N, D, (float*)(ws + WS_U1), N, bias));
        }
        if (!cd) { PHASE(2, phase_ab_rope(c)); PHASE(3, phase_ab_mix(c, j)); PHASE(4, phase_ab_norm(c)); }
        else     { PHASE(5, phase_cd_act(c, j)); PHASE(6, phase_cd_mix(c, j)); PHASE(7, phase_cd_scan(c)); }
        {
            const size_t Woff = cd ? WS_WCDOUT + (size_t)j * D * CD_OUT * 2 : WS_WABOUT + (size_t)j * D * AB_OUT * 2;
            const int K = cd ? CD_OUT : AB_OUT; const float* bias = cd ? p.in[18] + (size_t)j * D : p.in[5] + (size_t)j * D;
            PHASE(8, phase_dense(c, (const bf16_t*)(ws + WS_YCAT), (const bf16_t*)(ws + Woff), T, D, K, (float*)(ws + WS_H), D, bias));
        }
        PHASE(9, phase_ln<false>(c, p.in[19] + (size_t)L * D, p.in[20] + (size_t)L * D, (float*)(ws + WS_X)));
        PHASE(10, phase_dense(c, (const bf16_t*)(ws + WS_XB), (const bf16_t*)(ws + WS_WRT) + (size_t)L * 256 * D, T, 256, D, (float*)(ws + WS_ZR), 256, nullptr));
        PHASE(11, phase_route(c, L));
        PHASE(12, phase_moe_gu(c, L));
        PHASE(13, phase_moe_dn(c, L));
        PHASE(14, phase_ln<true>(c, p.in[29] + (size_t)L * D, p.in[30] + (size_t)L * D, L == 3 ? p.out : (float*)(ws + WS_X)));
    }
#undef PHASE
}

extern "C" void kernel_launch(void* const* d_in, const int* in_sizes, int n_in, void* d_out, int out_size, void* d_ws, size_t ws_size, hipStream_t stream) {
    static int grid = 0;
    if (grid == 0) {
        if (n_in != 31 || out_size != T * D || ws_size < WS_END) { fprintf(stderr, "kernel_launch: unexpected shapes (n_in %d out %d ws %zu need %zu)\n", n_in, out_size, ws_size, (size_t)WS_END); grid = -1; return; }
        int dev = 0, cus = 0, per_cu = 0;
        if (hipGetDevice(&dev) != hipSuccess || hipDeviceGetAttribute(&cus, hipDeviceAttributeMultiprocessorCount, dev) != hipSuccess) { grid = -1; return; }
        if (hipFuncSetAttribute((const void*)fwd_kernel, hipFuncAttributeMaxDynamicSharedMemorySize, LDS_BYTES) != hipSuccess) { fprintf(stderr, "kernel_launch: hipFuncSetAttribute failed\n"); grid = -1; return; }
        if (hipOccupancyMaxActiveBlocksPerMultiprocessor(&per_cu, (const void*)fwd_kernel, NTHREADS, LDS_BYTES) != hipSuccess || per_cu < 1) fprintf(stderr, "kernel_launch: occupancy query says %d\n", per_cu);
        (void)hipGetLastError();
        grid = cus;
    }
    if (grid < 0) return;
    (void)hipMemsetAsync((char*)d_ws + WS_CTL, 0, CTL_BYTES, stream);
    Params p{};
    for (int i = 0; i < 31; ++i) p.in[i] = (const float*)d_in[i];
    p.out = (float*)d_out; p.ws = (unsigned char*)d_ws;
#if N_LAUNCH_MODE == 1
    p.ph_lo = 0; p.ph_hi = N_PHASES;
    hipLaunchKernelGGL(fwd_kernel, dim3(grid), dim3(NTHREADS), LDS_BYTES, stream, p);
#else
    for (int i = 0; i < N_PHASES; ++i) { p.ph_lo = i; p.ph_hi = i + 1; hipLaunchKernelGGL(fwd_kernel, dim3(grid), dim3(NTHREADS), LDS_BYTES, stream, p); }
#endif
}
```

```cpp
#include <hip/hip_runtime.h>
#include <cstdio>
#include <cstdint>

#define LAS __attribute__((address_space(3)))
typedef unsigned short bf16_t;
typedef short bf16x8 __attribute__((ext_vector_type(8)));
typedef float f32x4 __attribute__((ext_vector_type(4)));
typedef float f32x2 __attribute__((ext_vector_type(2)));
typedef unsigned u32x4 __attribute__((ext_vector_type(4)));
typedef unsigned u32x2 __attribute__((ext_vector_type(2)));

constexpr int T = 16384, D = 1024, SEQ = 8192;
constexpr int AB_IN = 4352, AB_OUT = 2048, CD_IN = 4608, CD_OUT = 2304;
constexpr int NE = 128, NE1 = 129, TOPK = 8, ED = 256;
constexpr int TK = T * TOPK;
constexpr int NSLOT = TK + T;
constexpr int LISTCAP = 16384;
constexpr float ALPHA = 1.681792830507429f;
constexpr float LN_EPS = 1e-5f;

#ifndef N_LAUNCH_MODE
#define N_LAUNCH_MODE 1
#endif

constexpr size_t al256(size_t x) { return (x + 255) & ~(size_t)255; }
constexpr size_t WS_CTL    = 0;
constexpr size_t CTL_BYTES = 65536;
constexpr size_t CTL_CNT   = 32768;
constexpr size_t WS_WABIN  = CTL_BYTES;
constexpr size_t WS_WABOUT = WS_WABIN  + al256((size_t)2 * AB_IN * D * 2);
constexpr size_t WS_WCDIN  = WS_WABOUT + al256((size_t)2 * D * AB_OUT * 2);
constexpr size_t WS_WCDOUT = WS_WCDIN  + al256((size_t)2 * CD_IN * D * 2);
constexpr size_t WS_WRT    = WS_WCDOUT + al256((size_t)2 * D * CD_OUT * 2);
constexpr size_t WS_WGU    = WS_WRT    + al256((size_t)4 * 256 * D * 2);
constexpr size_t WS_WDN    = WS_WGU    + al256((size_t)4 * NE1 * 512 * D * 2);
constexpr size_t WS_X      = WS_WDN    + al256((size_t)4 * NE1 * D * ED * 2);
constexpr size_t WS_XB     = WS_X      + al256((size_t)T * D * 4);
constexpr size_t WS_U1     = WS_XB     + al256((size_t)T * D * 2);
constexpr size_t U1_BYTES  = al256((size_t)NSLOT * D * 2) > al256((size_t)T * CD_IN * 4) ? al256((size_t)NSLOT * D * 2) : al256((size_t)T * CD_IN * 4);
constexpr size_t WS_U2     = WS_U1     + U1_BYTES;
constexpr size_t U2_BYTES  = al256((size_t)T * 1280 * 4 * 3);
constexpr size_t WS_YCAT   = WS_U2     + U2_BYTES;
constexpr size_t WS_H      = WS_YCAT   + al256((size_t)T * CD_OUT * 2);
constexpr size_t WS_ZR     = WS_H      + al256((size_t)T * D * 4);
constexpr size_t WS_HID    = WS_ZR     + al256((size_t)T * 256 * 4);
constexpr size_t WS_LIST   = WS_HID    + al256((size_t)NSLOT * ED * 2);
constexpr size_t WS_GATE   = WS_LIST   + al256((size_t)NE * LISTCAP * 4);
constexpr size_t WS_END    = WS_GATE   + al256((size_t)NSLOT * 4);

__device__ __forceinline__ float bf2f(bf16_t b) { return __uint_as_float(((unsigned)b) << 16); }
__device__ __forceinline__ bf16_t f2bf(float f) { unsigned u = __float_as_uint(f); u += 0x7FFFu + ((u >> 16) & 1u); return (bf16_t)(u >> 16); }
__device__ __forceinline__ unsigned pk2(float lo, float hi) { return (unsigned)f2bf(lo) | ((unsigned)f2bf(hi) << 16); }
__device__ __forceinline__ float wave_sum(float v) {
#pragma unroll
    for (int o = 32; o; o >>= 1) v += __shfl_xor(v, o);
    return v; }
__device__ __forceinline__ float wave_max(float v) {
#pragma unroll
    for (int o = 32; o; o >>= 1) v = fmaxf(v, __shfl_xor(v, o));
    return v; }
__device__ __forceinline__ float gelu_tanh(float x) { const float u = 0.7978845608028654f * (x + 0.044715f * x * x * x); return 0.5f * x * (1.f + tanhf(u)); }
__device__ __forceinline__ float sigmoidf_(float x) { return 1.f / (1.f + __expf(-x)); }
__device__ __forceinline__ float siluf_(float x) { return x / (1.f + __expf(-x)); }

#define XB_TMO      128
#define XB_XCNT(j)  (256  + 64 * (j))
#define XB_XSUB(j)  (1280 + 64 * (j))
#define XB_XGEN(j)  (2304 + 64 * (j))
#define XB_TOP      3328
#define XB_TOPGEN   3392
#define XCD_BAR_WORDS 3456
#define XB_SPIN_CAP (1u << 22)

__device__ __forceinline__ unsigned xb_ld(unsigned* p)              { return __hip_atomic_load(p, __ATOMIC_RELAXED, __HIP_MEMORY_SCOPE_AGENT); }
__device__ __forceinline__ unsigned xb_add(unsigned* p, unsigned v) { return __hip_atomic_fetch_add(p, v, __ATOMIC_RELAXED, __HIP_MEMORY_SCOPE_AGENT); }
__device__ __forceinline__ unsigned xb_xcc_id() { return (unsigned)__builtin_amdgcn_s_getreg((3 << 11) | 20) & 0xFu; }
#define XB_SPIN(cond, bar) do { unsigned _sp = 0; while (cond) { __builtin_amdgcn_s_sleep(1); \
    if ((++_sp & 255u) == 0u) { if (xb_ld(&(bar)[XB_TMO])) break; if (_sp > XB_SPIN_CAP) { atomicAdd(&(bar)[XB_TMO], 1u); break; } } } } while (0)

struct XcdBarrier { unsigned* bar; unsigned x; volatile LAS unsigned* st; };

__device__ __forceinline__ XcdBarrier xcd_barrier_post(unsigned* bar, volatile LAS unsigned* st) {
    XcdBarrier b; b.bar = bar; b.x = xb_xcc_id(); b.st = st;
    if (threadIdx.x == 0) (void)xb_add(&bar[XB_XCNT(b.x)], 1u);
    return b;
}
__device__ __forceinline__ void xcd_barrier_complete(unsigned* bar, unsigned x, unsigned& nloc, unsigned& nx) {
    const unsigned G = gridDim.x * gridDim.y * gridDim.z;
    unsigned sum, cnt, mine, sp = 0u;
    for (;;) {
        sum = 0u; cnt = 0u; mine = 0u;
#pragma unroll
        for (unsigned j = 0; j < 16; ++j) { const unsigned c = xb_ld(&bar[XB_XCNT(j)]); sum += c; cnt += (c > 0u) ? 1u : 0u; mine = (j == x) ? c : mine; }
        if (sum == G) break;
        __builtin_amdgcn_s_sleep(1);
        if ((++sp & 255u) == 0u) { if (xb_ld(&bar[XB_TMO])) break; if (sp > XB_SPIN_CAP) { atomicAdd(&bar[XB_TMO], 1u); break; } }
    }
    nloc = mine > 0u ? mine : 1u; nx = cnt > 0u ? cnt : 1u;
}
__device__ __forceinline__ void xcd_barrier(const XcdBarrier& b) {
    asm volatile("s_waitcnt vmcnt(0)" ::: "memory");
    __syncthreads();
    if (threadIdx.x == 0) {
        unsigned* bar = b.bar;
        __builtin_amdgcn_s_waitcnt(0);
        unsigned nloc = b.st[0], nx = b.st[1];
        if (nloc == 0u) { xcd_barrier_complete(bar, b.x, nloc, nx); b.st[0] = nloc; b.st[1] = nx; }
        const unsigned old = xb_add(&bar[XB_XSUB(b.x)], 1u);
        const unsigned gen = old / nloc;
        if (old + 1u == (gen + 1u) * nloc) {
            __builtin_amdgcn_fence(__ATOMIC_RELEASE, "agent");
            asm volatile("s_waitcnt vmcnt(0)" ::: "memory");
            const unsigned og = xb_add(&bar[XB_TOP], 1u);
            const unsigned tg = og / nx;
            if (og + 1u == (tg + 1u) * nx) xb_add(&bar[XB_TOPGEN], 1u);
            else XB_SPIN(xb_ld(&bar[XB_TOPGEN]) == tg, bar);
            __builtin_amdgcn_fence(__ATOMIC_ACQUIRE, "agent");
            xb_add(&bar[XB_XGEN(b.x)], 1u);
            asm volatile("s_waitcnt vmcnt(0)" ::: "memory");
        } else {
            XB_SPIN(xb_ld(&bar[XB_XGEN(b.x)]) == gen, bar);
            __builtin_amdgcn_fence(__ATOMIC_ACQUIRE, "agent");
            asm volatile("s_waitcnt vmcnt(0)" ::: "memory");
        }
    }
    __syncthreads();
}

namespace g8 {
constexpr int BM = 256, BK = 64, HALF = 128, HTB = HALF * BK * 2, STAGE_BYTES = 8 * HTB, NXCD = 8, WGM = 8;
__device__ __forceinline__ int lds_byte(int r, int c) { const int st = (r >> 4) * 2 + (c >> 5), rr = r & 15, cc = c & 31, ob = rr * 64 + cc * 2; return st * 1024 + (ob ^ (((ob >> 9) & 1) << 5)); }
__device__ __forceinline__ void stage_rc(int b, int& R, int& C) { const int st = b / 1024, sb = b % 1024, swz = sb ^ (((sb >> 9) & 1) << 5); R = (st >> 1) * 16 + swz / 64; C = (st & 1) * 32 + (swz % 64) / 2; }
__device__ __forceinline__ int perm32(int rho) { const int n = rho >> 4, i = rho & 15; return 8 * (i >> 2) + 4 * n + (i & 3); }

struct Unit { const char* A; const char* B; int pm, pn, aux; };

struct DenseOrder {
    const char* A; const char* Bt; int nM, nN, nwg, G, c, K;
    __device__ void init(const void* A_, const void* Bt_, int M, int N, int K_, int G_, int c_) { A = (const char*)A_; Bt = (const char*)Bt_; nM = M / BM; nN = N / BM; nwg = nM * nN; G = G_; c = c_; K = K_; }
    __device__ __forceinline__ bool next(int i, Unit& u) const {
        const long L = (long)i * G + c; if (L >= nwg) return false;
        int wgid = (int)L; { const int q = nwg / NXCD, r = nwg % NXCD, xcd = wgid % NXCD, off = wgid / NXCD; wgid = (xcd < r ? xcd * (q + 1) : r * (q + 1) + (xcd - r) * q) + off; }
        const int nig = WGM * nN, gid = wgid / nig, fm = gid * WGM, gsz = (nM - fm) < WGM ? (nM - fm) : WGM;
        u.pm = fm + ((wgid % nig) % gsz); u.pn = (wgid % nig) / gsz; u.aux = 0;
        u.A = A + (size_t)u.pm * BM * K * 2; u.B = Bt + (size_t)u.pn * BM * K * 2; return true;
    }
    __device__ __forceinline__ void aoff(const Unit&, int tid, unsigned (&o)[2][2]) const {
#pragma unroll
        for (int i = 0; i < 2; ++i) { int R, C; stage_rc(tid * 16 + i * 8192, R, C);
            o[0][i] = (unsigned)(R * K + C) * 2u; o[1][i] = (unsigned)((R + HALF) * K + C) * 2u; }
    }
};

__device__ __forceinline__ unsigned cvt_pk_bf16(float lo, float hi) { unsigned r; asm volatile("v_cvt_pk_bf16_f32 %0, %1, %2" : "=v"(r) : "v"(lo), "v"(hi)); return r; }

struct EpiF32 {
    static constexpr bool PERM = false;
    float* C; int ldc; const float* bias;
    __device__ __forceinline__ void operator()(const f32x4 (&acc)[2][2][4][2], const Unit& u, int wr, int wc, int fr, int fq) const {
        const int row0 = u.pm * BM + wr * 64 + fr, col0 = u.pn * BM + wc * 32 + 4 * fq;
        f32x4 bv[2][2];
#pragma unroll
        for (int bj = 0; bj < 2; ++bj)
#pragma unroll
            for (int n = 0; n < 2; ++n) bv[bj][n] = bias ? *(const f32x4*)(bias + col0 + bj * HALF + n * 16) : (f32x4){0.f, 0.f, 0.f, 0.f};
#pragma unroll
        for (int ai = 0; ai < 2; ++ai)
#pragma unroll
            for (int m = 0; m < 4; ++m) { float* rowp = C + (size_t)(row0 + ai * HALF + m * 16) * ldc + col0;
#pragma unroll
                for (int bj = 0; bj < 2; ++bj)
#pragma unroll
                    for (int n = 0; n < 2; ++n) *(f32x4*)(rowp + bj * HALF + n * 16) = acc[ai][bj][m][n] + bv[bj][n]; }
    }
};

template <class Epi, class Sched>
__device__ __forceinline__ void gemm_phase(LAS unsigned char* lds, const int K, const Sched& S, const Epi& E) {
    int tid_ = threadIdx.x; asm volatile("" : "+v"(tid_));
    const int tid = tid_, wid = __builtin_amdgcn_readfirstlane(tid >> 6), lane = tid & 63, wr = wid >> 2, wc = wid & 3, fr = lane & 15, fq = lane >> 4;
    const int nt = K / BK;
    unsigned voffB[2];
#pragma unroll
    for (int i = 0; i < 2; ++i) { int R, C; stage_rc(tid * 16 + i * 8192, R, C); const int Rb = Epi::PERM ? ((R & ~31) + perm32(R & 31)) : R;
        voffB[i] = (unsigned)(Rb * K + C) * 2u; }
    const size_t kstep = (size_t)(BK * 2);
    const size_t hstep = (size_t)HALF * K * 2;
    const unsigned ldsw = (unsigned)wid * 1024u;
    const int aoff = lds_byte(wr * 64 + fr, fq * 8), boff = lds_byte(wc * 32 + fr, fq * 8);
#define G8_SA(b, h) (((b) * 2 + (h)) * HTB)
#define G8_SB(b, h) ((4 + (b) * 2 + (h)) * HTB)
#define G8_STAGE(bufoff, gbase, voff) do { _Pragma("unroll") for (int _i = 0; _i < 2; ++_i) \
        __builtin_amdgcn_global_load_lds((const unsigned*)((const char*)(gbase) + (voff)[_i]), (LAS unsigned*)(lds + (bufoff) + ldsw + _i * 8192), 16, 0, 0); } while (0)
#define G8_LDA(dst, b, h) do { _Pragma("unroll") for (int m = 0; m < 4; ++m) _Pragma("unroll") for (int k = 0; k < 2; ++k) dst[m][k] = *(const LAS bf16x8*)(lds + G8_SA(b, h) + aoff + m * 2048 + k * 1024); } while (0)
#define G8_LDB(dst, b, h) do { _Pragma("unroll") for (int n = 0; n < 2; ++n) _Pragma("unroll") for (int k = 0; k < 2; ++k) dst[n][k] = *(const LAS bf16x8*)(lds + G8_SB(b, h) + boff + n * 2048 + k * 1024); } while (0)
#define G8_MMA(ai, bj, At, Bt) do { __builtin_amdgcn_s_setprio(1); _Pragma("unroll") for (int m = 0; m < 4; ++m) _Pragma("unroll") for (int n = 0; n < 2; ++n) _Pragma("unroll") for (int k = 0; k < 2; ++k) \
        acc[ai][bj][m][n] = __builtin_amdgcn_mfma_f32_16x16x32_bf16(Bt[n][k], At[m][k], acc[ai][bj][m][n], 0, 0, 0); __builtin_amdgcn_s_setprio(0); } while (0)
#define G8_WAIT_V(n) asm volatile("s_waitcnt vmcnt(" #n ")" ::: "memory")
#define G8_WAIT_L(n) asm volatile("s_waitcnt lgkmcnt(" #n ")" ::: "memory")
#define G8_BAR __builtin_amdgcn_s_barrier()
#define G8_SCHED __builtin_amdgcn_sched_barrier(0)
    Unit cur, nxt; int ui = 0;
    if (!S.next(0, cur)) return;
    f32x4 acc[2][2][4][2];
#pragma unroll
    for (int a = 0; a < 2; ++a)
#pragma unroll
        for (int b = 0; b < 2; ++b)
#pragma unroll
            for (int m = 0; m < 4; ++m)
#pragma unroll
                for (int n = 0; n < 2; ++n) acc[a][b][m][n] = (f32x4){0.f, 0.f, 0.f, 0.f};
    bf16x8 At[4][2], B0[2][2], B1[2][2];
    unsigned oc[2][2];
    S.aoff(cur, tid, oc);
    const char* cA = cur.A; const char* cB = cur.B;
    G8_STAGE(G8_SB(0, 0), cB, voffB); G8_STAGE(G8_SA(0, 0), cA, oc[0]); G8_STAGE(G8_SB(0, 1), cB + hstep, voffB); G8_STAGE(G8_SA(0, 1), cA, oc[1]);
    if (wr == 1) G8_BAR;
    G8_WAIT_V(4); G8_BAR;
    G8_STAGE(G8_SB(1, 0), cB + kstep, voffB); G8_STAGE(G8_SA(1, 0), cA + kstep, oc[0]); G8_STAGE(G8_SB(1, 1), cB + hstep + kstep, voffB);
    G8_WAIT_V(6); G8_BAR;
    for (;;) {
        const bool has_next = S.next(ui + 1, nxt);
        const char* nA = has_next ? nxt.A : cA; const char* nB = has_next ? nxt.B : cB;
#pragma unroll 1
        for (int t = 0; t < nt; t += 2) {
            const bool last = (t == nt - 2);
            const char* a1 = cA + (size_t)(t + 1) * kstep;
            const char* a2 = last ? nA : cA + (size_t)(t + 2) * kstep; const char* b2 = last ? nB : cB + (size_t)(t + 2) * kstep;
            const char* a3 = a2 + kstep; const char* b3 = b2 + kstep;
            G8_LDB(B0, 0, 0); G8_SCHED; G8_LDA(At, 0, 0); G8_STAGE(G8_SA(1, 1), a1, oc[1]);
            if (last && has_next) S.aoff(nxt, tid, oc);
            G8_WAIT_L(8); G8_BAR; G8_WAIT_L(0); G8_MMA(0, 0, At, B0); G8_BAR; G8_SCHED;
            G8_LDB(B1, 0, 1); G8_STAGE(G8_SB(0, 0), b2, voffB);
            G8_BAR; G8_WAIT_L(0); G8_MMA(0, 1, At, B1); G8_BAR;
            G8_LDA(At, 0, 1); G8_STAGE(G8_SA(0, 0), a2, oc[0]);
            G8_BAR; G8_WAIT_L(0); G8_MMA(1, 0, At, B0); G8_BAR; G8_SCHED;
            G8_STAGE(G8_SB(0, 1), b2 + hstep, voffB);
            G8_WAIT_V(6); G8_BAR; G8_MMA(1, 1, At, B1); G8_BAR;
            G8_LDB(B0, 1, 0); G8_SCHED; G8_LDA(At, 1, 0); G8_STAGE(G8_SA(0, 1), a2, oc[1]);
            G8_WAIT_L(8); G8_BAR; G8_WAIT_L(0); G8_MMA(0, 0, At, B0); G8_BAR; G8_SCHED;
            G8_LDB(B1, 1, 1); G8_STAGE(G8_SB(1, 0), b3, voffB);
            G8_BAR; G8_WAIT_L(0); G8_MMA(0, 1, At, B1); G8_BAR;
            G8_LDA(At, 1, 1); G8_STAGE(G8_SA(1, 0), a3, oc[0]);
            G8_BAR; G8_WAIT_L(0); G8_MMA(1, 0, At, B0); G8_BAR; G8_SCHED;
            G8_STAGE(G8_SB(1, 1), b3 + hstep, voffB);
            G8_WAIT_V(6); G8_BAR; G8_MMA(1, 1, At, B1); G8_BAR;
        }
        E(acc, cur, wr, wc, fr, fq);
        if (!has_next) break;
#pragma unroll
        for (int a = 0; a < 2; ++a)
#pragma unroll
            for (int b = 0; b < 2; ++b)
#pragma unroll
                for (int m = 0; m < 4; ++m)
#pragma unroll
                    for (int n = 0; n < 2; ++n) acc[a][b][m][n] = (f32x4){0.f, 0.f, 0.f, 0.f};
        cur = nxt; cA = nA; cB = nB; ++ui;
    }
    G8_WAIT_V(0);
    if (wr == 0) G8_BAR;
    G8_BAR;
#undef G8_SA
#undef G8_SB
#undef G8_STAGE
#undef G8_LDA
#undef G8_LDB
#undef G8_MMA
#undef G8_WAIT_V
#undef G8_WAIT_L
#undef G8_BAR
#undef G8_SCHED
}
}

constexpr int NTHREADS = 512;
constexpr int LDS_STAGE = 0;
constexpr int LDS_TAB   = g8::STAGE_BYTES;
constexpr int TAB_SLOTS = 12;
constexpr int LDS_DESC  = LDS_TAB + TAB_SLOTS * 256 * 4;
constexpr int LDS_PREF  = LDS_DESC + 64;
constexpr int LDS_MISC  = LDS_PREF + 132 * 4 + 48;
constexpr int LDS_BYTES = 147456;
static_assert(LDS_MISC % 16 == 0 && LDS_MISC + 64 <= LDS_BYTES, "LDS map");

struct Params { const float* in[31]; float* out; unsigned char* ws; int ph_lo, ph_hi; };

struct Ctx {
    const float* const* in; float* out; unsigned char* ws; LAS unsigned char* lds;
    int tid, lane, wid, bid, G, gtid, gthreads, gw, nwaves;
};

template <class DstFn>
__device__ __forceinline__ void convert_T(const Ctx& c, const float* src, int nmat, int K, int N, DstFn dstfn) {
    LAS float* tile = (LAS float*)(c.lds);
    const int tk = K / 64, tn = N / 64; const long ntiles = (long)nmat * tk * tn;
    for (long tix = c.bid; tix < ntiles; tix += c.G) {
        const int m = (int)(tix / (tk * tn)); const int rem = (int)(tix % (tk * tn)); const int kt = rem / tn, nt = rem % tn;
        const float* s = src + (size_t)m * K * N + (size_t)(kt * 64) * N + nt * 64;
#pragma unroll
        for (int i = 0; i < 2; ++i) { const int k = (c.tid >> 4) + 32 * i, n4 = (c.tid & 15) * 4; const f32x4 v = *(const f32x4*)(s + (size_t)k * N + n4);
            tile[k * 65 + n4 + 0] = v[0]; tile[k * 65 + n4 + 1] = v[1]; tile[k * 65 + n4 + 2] = v[2]; tile[k * 65 + n4 + 3] = v[3]; }
        __syncthreads();
        { const int n = c.tid >> 3, k8 = (c.tid & 7) * 8; u32x4 w;
          w[0] = pk2(tile[(k8 + 0) * 65 + n], tile[(k8 + 1) * 65 + n]); w[1] = pk2(tile[(k8 + 2) * 65 + n], tile[(k8 + 3) * 65 + n]);
          w[2] = pk2(tile[(k8 + 4) * 65 + n], tile[(k8 + 5) * 65 + n]); w[3] = pk2(tile[(k8 + 6) * 65 + n], tile[(k8 + 7) * 65 + n]);
          bf16_t* d = dstfn(m, nt * 64 + n) + kt * 64 + k8; *(u32x4*)d = w; }
        __syncthreads();
    }
}

__device__ __forceinline__ void phase_convert(const Ctx& c) {
    unsigned char* ws = c.ws;
    { const float* x = c.in[0]; float* xo = (float*)(ws + WS_X); bf16_t* xb = (bf16_t*)(ws + WS_XB);
      for (long i = c.gtid; i < (long)T * D / 4; i += c.gthreads) { const f32x4 v = *(const f32x4*)(x + i * 4); *(f32x4*)(xo + i * 4) = v; u32x2 w; w[0] = pk2(v[0], v[1]); w[1] = pk2(v[2], v[3]); *(u32x2*)(xb + i * 4) = w; } }
    { bf16_t* wrt = (bf16_t*)(ws + WS_WRT); for (long i = c.gtid; i < (long)4 * 128 * D / 8; i += c.gthreads) { const long l = i / (128 * D / 8), r = i % (128 * D / 8); *(u32x4*)(wrt + (size_t)l * 256 * D + (size_t)128 * D + r * 8) = (u32x4){0u, 0u, 0u, 0u}; }
      float* gate = (float*)(ws + WS_GATE); for (int i = c.gtid; i < T; i += c.gthreads) gate[TK + i] = 1.f; }
    { bf16_t* d = (bf16_t*)(ws + WS_WABIN);  convert_T(c, c.in[1], 2, D, AB_IN, [=](int m, int n) { return d + (size_t)m * AB_IN * D + (size_t)n * D; }); }
    { bf16_t* d = (bf16_t*)(ws + WS_WABOUT); convert_T(c, c.in[4], 2, AB_OUT, D, [=](int m, int n) { return d + (size_t)m * D * AB_OUT + (size_t)n * AB_OUT; }); }
    { bf16_t* d = (bf16_t*)(ws + WS_WCDIN);  convert_T(c, c.in[6], 2, D, CD_IN, [=](int m, int n) { return d + (size_t)m * CD_IN * D + (size_t)n * D; }); }
    { bf16_t* d = (bf16_t*)(ws + WS_WCDOUT); convert_T(c, c.in[17], 2, CD_OUT, D, [=](int m, int n) { return d + (size_t)m * D * CD_OUT + (size_t)n * CD_OUT; }); }
    { bf16_t* d = (bf16_t*)(ws + WS_WRT);    convert_T(c, c.in[21], 4, D, NE, [=](int m, int n) { return d + (size_t)m * 256 * D + (size_t)n * D; }); }
    { bf16_t* d = (bf16_t*)(ws + WS_WGU);
      convert_T(c, c.in[23], 4 * NE, D, ED, [=](int m, int n) { return d + (size_t)((m >> 7) * NE1 + (m & 127)) * 512 * D + (size_t)((n >> 7) * 256 + (n & 127)) * D; });
      convert_T(c, c.in[24], 4 * NE, D, ED, [=](int m, int n) { return d + (size_t)((m >> 7) * NE1 + (m & 127)) * 512 * D + (size_t)((n >> 7) * 256 + 128 + (n & 127)) * D; });
      convert_T(c, c.in[26], 4, D, ED, [=](int m, int n) { return d + (size_t)(m * NE1 + NE) * 512 * D + (size_t)((n >> 7) * 256 + (n & 127)) * D; });
      convert_T(c, c.in[27], 4, D, ED, [=](int m, int n) { return d + (size_t)(m * NE1 + NE) * 512 * D + (size_t)((n >> 7) * 256 + 128 + (n & 127)) * D; }); }
    { bf16_t* d = (bf16_t*)(ws + WS_WDN);
      convert_T(c, c.in[25], 4 * NE, ED, D, [=](int m, int n) { return d + (size_t)((m >> 7) * NE1 + (m & 127)) * D * ED + (size_t)n * ED; });
      convert_T(c, c.in[28], 4, ED, D, [=](int m, int n) { return d + (size_t)(m * NE1 + NE) * D * ED + (size_t)n * ED; }); }
}

__device__ __forceinline__ void phase_dense(const Ctx& c, const bf16_t* A, const bf16_t* Bt, int M, int N, int K, float* C, int ldc, const float* bias) {
    g8::DenseOrder S; S.init(A, Bt, M, N, K, c.G, c.bid);
    g8::EpiF32 E{C, ldc, bias};
    g8::gemm_phase<g8::EpiF32, g8::DenseOrder>(c.lds + LDS_STAGE, K, S, E);
}

__device__ __forceinline__ void phase_ab_rope(const Ctx& c) {
    float* z = (float*)(c.ws + WS_U1);
    for (long idx = c.gtid; idx < (long)T * 1088; idx += c.gthreads) {
        const int t = (int)(idx / 1088), p = (int)(idx % 1088), s = t & (SEQ - 1);
        int c1, c2; float e, scale;
        if (p < 512)      { const int h = p >> 5, j = p & 31; c1 = h * 64 + j; c2 = c1 + 32; e = (float)j * (1.f / 32.f); scale = 0.125f; }
        else if (p < 576) { const int pp = p - 512, h = pp >> 5, j = pp & 31; c1 = 1024 + h * 64 + j; c2 = c1 + 32; e = (float)j * (1.f / 32.f); scale = 1.f; }
        else if (p < 832) { const int pp = p - 576, h = pp >> 6, j = pp & 63; c1 = 1280 + h * 128 + j; c2 = c1 + 64; e = (float)j * (1.f / 63.f); scale = 1.f; }
        else              { const int pp = p - 832, h = pp >> 6, j = pp & 63; c1 = 1792 + h * 128 + j; c2 = c1 + 64; e = (float)j * (1.f / 63.f); scale = 0.08838834764831845f; }
        const float invf = exp2f(-e * 13.287712379549449f);
        const float ang = (float)s * invf; float sn, cs; sincosf(ang, &sn, &cs);
        float* zr = z + (size_t)t * AB_IN; const float x1 = zr[c1], x2 = zr[c2];
        zr[c1] = (x1 * cs - x2 * sn) * scale; zr[c2] = (x2 * cs + x1 * sn) * scale;
    }
}

__device__ __forceinline__ void phase_ab_mix(const Ctx& c, int j) {
    const float* z = (const float*)(c.ws + WS_U1); bf16_t* ycat = (bf16_t*)(c.ws + WS_YCAT); float* ro = (float*)(c.ws + WS_U2);
    const float* sinks = c.in[3] + j * 16;
    const int lane = c.lane;
    if (c.bid < 64) {
        const int it = c.bid * 8 + c.wid; const int b = it >> 8, h = (it >> 6) & 3, e0 = (it & 63) * 4;
        const float gam = 1.f - exp2f(-5.f - (float)h);
        float S0[4] = {0.f, 0.f, 0.f, 0.f}, S1[4] = {0.f, 0.f, 0.f, 0.f};
        for (int s = 0; s < SEQ; ++s) {
            const float* zr = z + (size_t)(b * SEQ + s) * AB_IN;
            const float q0 = zr[1280 + h * 128 + lane], q1 = zr[1280 + h * 128 + 64 + lane];
            const float k0 = zr[1792 + h * 128 + lane], k1 = zr[1792 + h * 128 + 64 + lane];
            const f32x4 v = *(const f32x4*)(zr + 2304 + h * 256 + e0);
            f32x4 o;
#pragma unroll
            for (int e = 0; e < 4; ++e) { S0[e] = gam * S0[e] + k0 * v[e]; S1[e] = gam * S1[e] + k1 * v[e]; o[e] = wave_sum(q0 * S0[e] + q1 * S1[e]); }
            if (lane == 0) *(f32x4*)(ro + (size_t)(b * SEQ + s) * D + h * 256 + e0) = o;
        }
    } else {
        const int nw = (c.G - 64) * 8;
        for (long it = (long)(c.bid - 64) * 8 + c.wid; it < (long)T * 16; it += nw) {
            const int t = (int)(it >> 4), hd = (int)(it & 15), kvh = hd >> 3, s = t & (SEQ - 1), tb = t - s;
            const float* qrow = z + (size_t)t * AB_IN + hd * 64;
            float sc[2];
#pragma unroll
            for (int u2 = 0; u2 < 2; ++u2) { const int jk = s - lane - 64 * u2; float a = -1e30f;
                if (jk >= 0) { const float* kr = z + (size_t)(tb + jk) * AB_IN + 1024 + kvh * 64; float d = 0.f;
                    for (int dd = 0; dd < 64; dd += 4) { const f32x4 qv = *(const f32x4*)(qrow + dd), kv = *(const f32x4*)(kr + dd); d += qv[0] * kv[0] + qv[1] * kv[1] + qv[2] * kv[2] + qv[3] * kv[3]; }
                    a = d; }
                sc[u2] = a; }
            const float sink = sinks[hd];
            const float m = fmaxf(wave_max(fmaxf(sc[0], sc[1])), sink);
            const float p0 = (s - lane >= 0) ? __expf(sc[0] - m) : 0.f, p1 = (s - lane - 64 >= 0) ? __expf(sc[1] - m) : 0.f;
            const float den = wave_sum(p0 + p1) + __expf(sink - m);
            float o = 0.f;
            for (int jj = 0; jj < 128; ++jj) { const float pj = __shfl(jj < 64 ? p0 : p1, jj & 63); const int jk = s - jj;
                if (jk >= 0) o += pj * z[(size_t)(tb + jk) * AB_IN + 1152 + kvh * 64 + lane]; }
            ycat[(size_t)t * AB_OUT + hd * 64 + lane] = f2bf(o / den);
        }
    }
}

__device__ __forceinline__ void phase_ab_norm(const Ctx& c) {
    const float* z = (const float*)(c.ws + WS_U1); bf16_t* ycat = (bf16_t*)(c.ws + WS_YCAT); const float* ro = (const float*)(c.ws + WS_U2);
    for (long it = c.gw; it < (long)T * 4; it += c.nwaves) {
        const int t = (int)(it >> 2), h = (int)(it & 3);
        const f32x4 v = *(const f32x4*)(ro + (size_t)t * D + h * 256 + c.lane * 4);
        const float mean = wave_sum(v[0] + v[1] + v[2] + v[3]) * (1.f / 256.f);
        const f32x4 d = v - mean;
        const float var = wave_sum(d[0] * d[0] + d[1] * d[1] + d[2] * d[2] + d[3] * d[3]) * (1.f / 256.f);
        const float rstd = rsqrtf(var + LN_EPS);
        const f32x4 g = *(const f32x4*)(z + (size_t)t * AB_IN + 3328 + h * 256 + c.lane * 4);
        u32x2 w; w[0] = pk2(siluf_(g[0]) * d[0] * rstd, siluf_(g[1]) * d[1] * rstd); w[1] = pk2(siluf_(g[2]) * d[2] * rstd, siluf_(g[3]) * d[3] * rstd);
        *(u32x2*)(ycat + (size_t)t * AB_OUT + 1024 + h * 256 + c.lane * 4) = w;
    }
}

__device__ __forceinline__ void phase_cd_act(const Ctx& c, int j) {
    float* z = (float*)(c.ws + WS_U1); float* xc = (float*)(c.ws + WS_U2);
    const float* conv_w = c.in[10] + (size_t)j * 4 * 1280; const float* conv_b = c.in[11] + (size_t)j * 1280;
    for (long idx = c.gtid; idx < (long)T * 1280; idx += c.gthreads) {
        const int t = (int)(idx / 1280), ch = (int)(idx % 1280), s = t & (SEQ - 1);
        float a = conv_b[ch];
#pragma unroll
        for (int k = 0; k < 4; ++k) { const int sp = s - 3 + k; if (sp >= 0) a += conv_w[k * 1280 + ch] * z[(size_t)(t - 3 + k) * CD_IN + 3328 + ch]; }
        xc[(size_t)t * 1280 + ch] = a;
    }
    for (long t = c.gw; t < T; t += c.nwaves) {
        float* zr = z + (size_t)t * CD_IN;
        for (int i = c.lane; i < 1024; i += 64) zr[i] = gelu_tanh(zr[i]);
        for (int i = c.lane; i < 1280; i += 64) zr[2048 + i] = gelu_tanh(zr[2048 + i]);
        float gv[16]; float sm = 0.f;
#pragma unroll
        for (int i = 0; i < 16; ++i) { gv[i] = gelu_tanh(zr[1024 + c.lane + 64 * i]); sm += gv[i]; }
        const float mean = wave_sum(sm) * (1.f / 1024.f); float sq = 0.f;
#pragma unroll
        for (int i = 0; i < 16; ++i) { gv[i] -= mean; sq += gv[i] * gv[i]; }
        const float rstd = rsqrtf(wave_sum(sq) * (1.f / 1024.f) + LN_EPS);
#pragma unroll
        for (int i = 0; i < 16; ++i) zr[1024 + c.lane + 64 * i] = gv[i] * rstd;
    }
}

__device__ __forceinline__ void phase_cd_mix(const Ctx& c, int j) {
    const float* z = (const float*)(c.ws + WS_U1); bf16_t* ycat = (bf16_t*)(c.ws + WS_YCAT);
    const float* xc = (const float*)(c.ws + WS_U2); float* av = (float*)(c.ws + WS_U2) + (size_t)T * 1280; float* bv = av + (size_t)T * 1280;
    const float* sgu_w = c.in[8] + (size_t)j * 4 * 128 * 128; const float* sgu_b = c.in[9] + (size_t)j * 4 * 128;
    const float* wa = c.in[12] + (size_t)j * 5 * 65536; const float* ba = c.in[13] + (size_t)j * 1280;
    const float* wx = c.in[14] + (size_t)j * 5 * 65536; const float* bx = c.in[15] + (size_t)j * 1280; const float* lam = c.in[16] + (size_t)j * 1280;
    for (long idx = c.gtid; idx < (long)T * 1024; idx += c.gthreads) {
        const int t = (int)(idx >> 10), col = (int)(idx & 1023), i = t & 127, t0 = t - i, g = col >> 8;
        const float* w = sgu_w + (size_t)g * 16384 + (size_t)i * 128; float a = 0.f;
        for (int jj = 0; jj <= i; ++jj) a += w[jj] * z[(size_t)(t0 + jj) * CD_IN + 1024 + col];
        const float mixed = a + sgu_b[g * 128 + i];
        ycat[(size_t)t * CD_OUT + col] = f2bf(z[(size_t)t * CD_IN + col] * mixed);
    }
    for (long idx = c.gtid; idx < (long)T * 1280; idx += c.gthreads) {
        const int t = (int)(idx / 1280), ch = (int)(idx % 1280), h = ch >> 8, cc = ch & 255;
        const float* xr = xc + (size_t)t * 1280 + h * 256; const float* wah = wa + (size_t)h * 65536 + cc; const float* wxh = wx + (size_t)h * 65536 + cc;
        float r = ba[ch], ig = bx[ch];
        for (int i = 0; i < 256; ++i) { const float xv = xr[i]; r += xv * wah[(size_t)i * 256]; ig += xv * wxh[(size_t)i * 256]; }
        r = sigmoidf_(r); ig = sigmoidf_(ig);
        const float sp = log1pf(expf(-lam[ch]));
        const float log_a = -8.f * r * sp; const float a = expf(log_a);
        const float b = sqrtf(-expm1f(2.f * log_a)) * (ig * xc[(size_t)t * 1280 + ch]);
        av[(size_t)t * 1280 + ch] = a; bv[(size_t)t * 1280 + ch] = b;
    }
}

__device__ __forceinline__ void phase_cd_scan1(const Ctx& c) {
    float* av = (float*)(c.ws + WS_U2) + (size_t)T * 1280; float* bv = av + (size_t)T * 1280;
    float* sum = (float*)(c.ws + WS_H);
    for (int idx = c.gtid; idx < 2 * 64 * 1280; idx += c.gthreads) {
        const int ch = idx % 1280, bn = idx / 1280; const size_t t0 = (size_t)bn * 128;
        float P = 1.f, h = 0.f;
        for (int i = 0; i < 128; ++i) { const size_t o = (t0 + i) * 1280 + ch; const float a = av[o], b = bv[o]; h = a * h + b; P *= a; av[o] = P; bv[o] = h; }
        sum[(size_t)idx * 2] = P; sum[(size_t)idx * 2 + 1] = h;
    }
}
__device__ __forceinline__ void phase_cd_scan2(const Ctx& c) {
    const float* z = (const float*)(c.ws + WS_U1); bf16_t* ycat = (bf16_t*)(c.ws + WS_YCAT);
    const float* av = (const float*)(c.ws + WS_U2) + (size_t)T * 1280; const float* bv = av + (size_t)T * 1280;
    const float* sum = (const float*)(c.ws + WS_H);
    for (int idx = c.gtid; idx < 2 * 64 * 1280; idx += c.gthreads) {
        const int ch = idx % 1280, bn = idx / 1280, b = bn >> 6, n = bn & 63; const size_t t0 = (size_t)bn * 128;
        float carry = 0.f;
        for (int m = 0; m < n; ++m) { const size_t o = ((size_t)(b * 64 + m) * 1280 + ch) * 2; carry = sum[o] * carry + sum[o + 1]; }
        for (int i = 0; i < 128; ++i) { const size_t t = t0 + i; const float h = bv[t * 1280 + ch] + av[t * 1280 + ch] * carry;
            ycat[t * CD_OUT + 1024 + ch] = f2bf(z[t * CD_IN + 2048 + ch] * h); }
    }
}

template <bool MOE>
__device__ __forceinline__ void phase_ln(const Ctx& c, const float* g, const float* bta, float* xout) {
    float* x = (float*)(c.ws + WS_X); bf16_t* xb = (bf16_t*)(c.ws + WS_XB);
    const float* hbuf = (const float*)(c.ws + WS_H); const bf16_t* Y = (const bf16_t*)(c.ws + WS_U1);
    for (long t = c.gw; t < T; t += c.nwaves) {
        f32x4 v[4];
#pragma unroll
        for (int q = 0; q < 4; ++q) { const int col = q * 256 + c.lane * 4;
            f32x4 f;
            if (!MOE) f = *(const f32x4*)(hbuf + (size_t)t * D + col);
            else { f = (f32x4){0.f, 0.f, 0.f, 0.f};
#pragma unroll
                for (int k = 0; k < 9; ++k) { const size_t srow = (k < 8) ? (size_t)t * 8 + k : (size_t)TK + t; const u32x2 w = *(const u32x2*)(Y + srow * D + col);
                    f[0] += __uint_as_float(w[0] << 16); f[1] += __uint_as_float(w[0] & 0xffff0000u); f[2] += __uint_as_float(w[1] << 16); f[3] += __uint_as_float(w[1] & 0xffff0000u); } }
            const f32x4 xv = *(const f32x4*)(x + (size_t)t * D + col);
            v[q] = xv * ALPHA + f; }
        float sm = 0.f;
#pragma unroll
        for (int q = 0; q < 4; ++q) sm += v[q][0] + v[q][1] + v[q][2] + v[q][3];
        const float mean = wave_sum(sm) * (1.f / 1024.f); float sq = 0.f;
#pragma unroll
        for (int q = 0; q < 4; ++q) { v[q] = v[q] - mean; sq += v[q][0] * v[q][0] + v[q][1] * v[q][1] + v[q][2] * v[q][2] + v[q][3] * v[q][3]; }
        const float rstd = rsqrtf(wave_sum(sq) * (1.f / 1024.f) + LN_EPS);
#pragma unroll
        for (int q = 0; q < 4; ++q) { const int col = q * 256 + c.lane * 4; const f32x4 gg = *(const f32x4*)(g + col), bb = *(const f32x4*)(bta + col);
            const f32x4 o = v[q] * rstd * gg + bb;
            *(f32x4*)(xout + (size_t)t * D + col) = o; if (xout != x) *(f32x4*)(x + (size_t)t * D + col) = o;
            u32x2 w; w[0] = pk2(o[0], o[1]); w[1] = pk2(o[2], o[3]); *(u32x2*)(xb + (size_t)t * D + col) = w; }
    }
}

__device__ __forceinline__ void phase_route(const Ctx& c, int L) {
    const float* zr = (const float*)(c.ws + WS_ZR); const float* rb = c.in[22] + L * NE;
    int* cnt = (int*)(c.ws + CTL_CNT) + L * NE; int* list = (int*)(c.ws + WS_LIST); float* gate = (float*)(c.ws + WS_GATE);
    for (long t = c.gw; t < T; t += c.nwaves) {
        const float s0 = sigmoidf_(zr[(size_t)t * 256 + c.lane]), s1 = sigmoidf_(zr[(size_t)t * 256 + 64 + c.lane]);
        float v0 = s0 + rb[c.lane], v1 = s1 + rb[64 + c.lane];
        float mysc = 0.f; int myexp = -1; float tot = 0.f;
        for (int k = 0; k < 8; ++k) {
            float bv = v0; int bi = c.lane; if (v1 > bv) { bv = v1; bi = c.lane + 64; }
#pragma unroll
            for (int o = 32; o; o >>= 1) { const float ov = __shfl_xor(bv, o); const int oi = __shfl_xor(bi, o); if (ov > bv || (ov == bv && oi < bi)) { bv = ov; bi = oi; } }
            const float sc = __shfl((bi & 64) ? s1 : s0, bi & 63);
            tot += sc;
            if (c.lane == k) { mysc = sc; myexp = bi; }
            if (c.lane == (bi & 63)) { if (bi & 64) v1 = -1e30f; else v0 = -1e30f; }
        }
        if (c.lane < 8) { const int pos = atomicAdd(&cnt[myexp], 1); list[(size_t)myexp * LISTCAP + pos] = (int)t * 8 + c.lane; gate[(size_t)t * 8 + c.lane] = mysc / tot * 2.5f; }
    }
}

struct MoeOrder {
    const char* Abase; const char* Bbase; size_t Bstride; int K, NT, total, G, c, mode;
    LAS int* tab; LAS int* desc;
    __device__ __forceinline__ bool next(int i, g8::Unit& u) const {
        const long L = (long)i * G + c; if (L >= total || i >= TAB_SLOTS) return false;
        const int d = desc[i]; const int e = d >> 12, pn = d & 15;
        u.pm = (d >> 4) & 255; u.pn = pn; u.aux = i; u.A = Abase; u.B = Bbase + (size_t)e * Bstride + (size_t)pn * 256 * K * 2; return true;
    }
    __device__ __forceinline__ void aoff(const g8::Unit& u, int tid, unsigned (&o)[2][2]) const {
#pragma unroll
        for (int i = 0; i < 2; ++i) { int R, C; g8::stage_rc(tid * 16 + i * 8192, R, C);
#pragma unroll
            for (int h = 0; h < 2; ++h) { int s = tab[u.aux * 256 + h * 128 + R]; s = s < 0 ? 0 : s; const int row = mode ? s : (s < TK ? (s >> 3) : s - TK);
                o[h][i] = (unsigned)(row * K + C) * 2u; } }
    }
};
__device__ __forceinline__ void moe_setup(const Ctx& c, MoeOrder& S, const int* cnt, int NT) {
    LAS int* pref = (LAS int*)(c.lds + LDS_PREF); LAS int* desc = (LAS int*)(c.lds + LDS_DESC); LAS int* tab = (LAS int*)(c.lds + LDS_TAB);
    const int* list = (const int*)(c.ws + WS_LIST);
    if (c.tid == 0) { int acc = 0; for (int e = 0; e < NE1; ++e) { pref[e] = acc; const int n = e < NE ? cnt[e] : T; acc += (n + 255) >> 8; } pref[NE1] = acc; }
    __syncthreads();
    const int total = pref[NE1] * NT;
    S.NT = NT; S.total = total; S.G = c.G; S.c = c.bid; S.tab = tab; S.desc = desc;
    for (int i = 0; i < TAB_SLOTS; ++i) {
        const long L = (long)i * c.G + c.bid; if (L >= total) break;
        int wgid = (int)L; { const int q = total / 8, r = total % 8, xcd = wgid % 8, off = wgid / 8; wgid = (xcd < r ? xcd * (q + 1) : r * (q + 1) + (xcd - r) * q) + off; }
        const int rbg = wgid / NT, pn = wgid % NT;
        int lo = 0, hi = NE1;
        while (hi - lo > 1) { const int mid = (lo + hi) >> 1; if (pref[mid] <= rbg) lo = mid; else hi = mid; }
        const int e = lo, rb = rbg - pref[e], n = e < NE ? cnt[e] : T;
        if (c.tid == 0) desc[i] = (e << 12) | (rb << 4) | pn;
        if (c.tid < 256) { const int r = rb * 256 + c.tid; int s = -1; if (r < n) s = (e < NE) ? list[(size_t)e * LISTCAP + r] : TK + r; tab[i * 256 + c.tid] = s; }
    }
    __syncthreads();
}
struct EpiMoeGU {
    static constexpr bool PERM = true;
    bf16_t* H; LAS int* tab;
    __device__ __forceinline__ void operator()(const f32x4 (&acc)[2][2][4][2], const g8::Unit& u, int wr, int wc, int fr, int fq) const {
#pragma unroll
        for (int ai = 0; ai < 2; ++ai)
#pragma unroll
            for (int m = 0; m < 4; ++m) { const int r = ai * 128 + wr * 64 + m * 16 + fr; const int s = tab[u.aux * 256 + r];
                if (s >= 0) { u32x4 w;
#pragma unroll
                    for (int n = 0; n < 2; ++n) { const f32x4 g = acc[ai][0][m][n], up = acc[ai][1][m][n];
                        w[2 * n] = pk2(siluf_(g[0]) * up[0], siluf_(g[1]) * up[1]); w[2 * n + 1] = pk2(siluf_(g[2]) * up[2], siluf_(g[3]) * up[3]); }
                    *(u32x4*)(H + (size_t)s * ED + u.pn * 128 + wc * 32 + fq * 8) = w; } }
    }
};
struct EpiMoeDN {
    static constexpr bool PERM = true;
    bf16_t* Y; const float* gate; LAS int* tab;
    __device__ __forceinline__ void operator()(const f32x4 (&acc)[2][2][4][2], const g8::Unit& u, int wr, int wc, int fr, int fq) const {
#pragma unroll
        for (int ai = 0; ai < 2; ++ai)
#pragma unroll
            for (int m = 0; m < 4; ++m) { const int r = ai * 128 + wr * 64 + m * 16 + fr; const int s = tab[u.aux * 256 + r];
                if (s >= 0) { const float gt = gate[s];
#pragma unroll
                    for (int bj = 0; bj < 2; ++bj) { u32x4 w;
#pragma unroll
                        for (int n = 0; n < 2; ++n) { const f32x4 a = acc[ai][bj][m][n] * gt; w[2 * n] = pk2(a[0], a[1]); w[2 * n + 1] = pk2(a[2], a[3]); }
                        *(u32x4*)(Y + (size_t)s * D + u.pn * 256 + bj * 128 + wc * 32 + fq * 8) = w; } } }
    }
};
__device__ __forceinline__ void phase_moe_gu(const Ctx& c, int L) {
    MoeOrder S; S.Abase = (const char*)(c.ws + WS_XB); S.Bbase = (const char*)(c.ws + WS_WGU) + (size_t)L * NE1 * 512 * D * 2; S.Bstride = (size_t)512 * D * 2; S.K = D; S.mode = 0;
    moe_setup(c, S, (const int*)(c.ws + CTL_CNT) + L * NE, 2);
    EpiMoeGU E{(bf16_t*)(c.ws + WS_HID), S.tab};
    g8::gemm_phase<EpiMoeGU, MoeOrder>(c.lds + LDS_STAGE, D, S, E);
}
__device__ __forceinline__ void phase_moe_dn(const Ctx& c, int L) {
    MoeOrder S; S.Abase = (const char*)(c.ws + WS_HID); S.Bbase = (const char*)(c.ws + WS_WDN) + (size_t)L * NE1 * D * ED * 2; S.Bstride = (size_t)D * ED * 2; S.K = ED; S.mode = 1;
    moe_setup(c, S, (const int*)(c.ws + CTL_CNT) + L * NE, 4);
    EpiMoeDN E{(bf16_t*)(c.ws + WS_U1), (const float*)(c.ws + WS_GATE), S.tab};
    g8::gemm_phase<EpiMoeDN, MoeOrder>(c.lds + LDS_STAGE, ED, S, E);
}

constexpr int PH_PER_LAYER = 12;
constexpr int N_PHASES = 1 + 4 * PH_PER_LAYER;

__global__ void __launch_bounds__(NTHREADS, 2) fwd_kernel(Params p) {
    extern __shared__ __attribute__((aligned(16))) unsigned char lds_raw[];
    LAS unsigned char* const lds0 = (LAS unsigned char*)lds_raw;
    volatile LAS unsigned* misc = (volatile LAS unsigned*)(lds0 + LDS_MISC);
    if (threadIdx.x < 4) misc[threadIdx.x] = 0u;
    __syncthreads();
    const int lo = p.ph_lo, hi = p.ph_hi;
    XcdBarrier bar; bar.bar = (unsigned*)(p.ws + WS_CTL); bar.x = 0; bar.st = misc;
    if (hi - lo > 1) bar = xcd_barrier_post((unsigned*)(p.ws + WS_CTL), misc);
#define MKCTX() Ctx c; { int tid_ = threadIdx.x; asm volatile("" : "+v"(tid_)); int bid_ = blockIdx.x; asm volatile("" : "+s"(bid_)); unsigned long long ws_ = (unsigned long long)p.ws; asm volatile("" : "+s"(ws_)); \
        c.in = p.in; c.out = p.out; c.ws = (unsigned char*)ws_; c.lds = lds0; c.tid = tid_; c.lane = tid_ & 63; c.wid = __builtin_amdgcn_readfirstlane(tid_ >> 6); c.bid = bid_; c.G = gridDim.x; \
        c.gtid = c.bid * NTHREADS + c.tid; c.gthreads = c.G * NTHREADS; c.gw = c.bid * 8 + c.wid; c.nwaves = c.G * 8; } unsigned char* const ws = c.ws; (void)ws
    int id = 0;
#ifndef PMASK
#define PMASK 0xffffffffu
#endif
#define PHASE(k, body) do { if (((PMASK >> (k)) & 1u) && lo <= id && id < hi) { MKCTX(); body; if (id + 1 < hi) xcd_barrier(bar); } ++id; } while (0)
    PHASE(0, phase_convert(c));
#pragma unroll 1
    for (int L = 0; L < 4; ++L) {
        const int j = L >> 1; const bool cd = (L & 1);
        {
            const size_t Woff = cd ? WS_WCDIN + (size_t)j * CD_IN * D * 2 : WS_WABIN + (size_t)j * AB_IN * D * 2;
            const int N = cd ? CD_IN : AB_IN; const float* bias = cd ? p.in[7] + (size_t)j * CD_IN : p.in[2] + (size_t)j * AB_IN;
            PHASE(1, phase_dense(c, (const bf16_t*)(ws + WS_XB), (const bf16_t*)(ws + Woff), T, N, D, (float*)(ws + WS_U1), N, bias));
        }
        if (!cd) { PHASE(2, phase_ab_rope(c)); PHASE(3, phase_ab_mix(c, j)); PHASE(4, phase_ab_norm(c)); ++id; }
        else     { PHASE(5, phase_cd_act(c, j)); PHASE(6, phase_cd_mix(c, j)); PHASE(7, phase_cd_scan1(c)); PHASE(15, phase_cd_scan2(c)); }
        {
            const size_t Woff = cd ? WS_WCDOUT + (size_t)j * D * CD_OUT * 2 : WS_WABOUT + (size_t)j * D * AB_OUT * 2;
            const int K = cd ? CD_OUT : AB_OUT; const float* bias = cd ? p.in[18] + (size_t)j * D : p.in[5] + (size_t)j * D;
            PHASE(8, phase_dense(c, (const bf16_t*)(ws + WS_YCAT), (const bf16_t*)(ws + Woff), T, D, K, (float*)(ws + WS_H), D, bias));
        }
        PHASE(9, phase_ln<false>(c, p.in[19] + (size_t)L * D, p.in[20] + (size_t)L * D, (float*)(ws + WS_X)));
        PHASE(10, phase_dense(c, (const bf16_t*)(ws + WS_XB), (const bf16_t*)(ws + WS_WRT) + (size_t)L * 256 * D, T, 256, D, (float*)(ws + WS_ZR), 256, nullptr));
        PHASE(11, phase_route(c, L));
        PHASE(12, phase_moe_gu(c, L));
        PHASE(13, phase_moe_dn(c, L));
        PHASE(14, phase_ln<true>(c, p.in[29] + (size_t)L * D, p.in[30] + (size_t)L * D, L == 3 ? p.out : (float*)(ws + WS_X)));
    }
#undef PHASE
}

extern "C" void kernel_launch(void* const* d_in, const int* in_sizes, int n_in, void* d_out, int out_size, void* d_ws, size_t ws_size, hipStream_t stream) {
    static int grid = 0;
    if (grid == 0) {
        if (n_in != 31 || out_size != T * D || ws_size < WS_END) { fprintf(stderr, "kernel_launch: unexpected shapes (n_in %d out %d ws %zu need %zu)\n", n_in, out_size, ws_size, (size_t)WS_END); grid = -1; return; }
        int dev = 0, cus = 0, per_cu = 0;
        if (hipGetDevice(&dev) != hipSuccess || hipDeviceGetAttribute(&cus, hipDeviceAttributeMultiprocessorCount, dev) != hipSuccess) { grid = -1; return; }
        if (hipFuncSetAttribute((const void*)fwd_kernel, hipFuncAttributeMaxDynamicSharedMemorySize, LDS_BYTES) != hipSuccess) { fprintf(stderr, "kernel_launch: hipFuncSetAttribute failed\n"); grid = -1; return; }
        if (hipOccupancyMaxActiveBlocksPerMultiprocessor(&per_cu, (const void*)fwd_kernel, NTHREADS, LDS_BYTES) != hipSuccess || per_cu < 1) fprintf(stderr, "kernel_launch: occupancy query says %d\n", per_cu);
        (void)hipGetLastError();
        grid = cus;
    }
    if (grid < 0) return;
    (void)hipMemsetAsync((char*)d_ws + WS_CTL, 0, CTL_BYTES, stream);
    Params p{};
    for (int i = 0; i < 31; ++i) p.in[i] = (const float*)d_in[i];
    p.out = (float*)d_out; p.ws = (unsigned char*)d_ws;
#if N_LAUNCH_MODE == 1
    p.ph_lo = 0; p.ph_hi = N_PHASES;
    hipLaunchKernelGGL(fwd_kernel, dim3(grid), dim3(NTHREADS), LDS_BYTES, stream, p);
#else
    for (int i = 0; i < N_PHASES; ++i) { p.ph_lo = i; p.ph_hi = i + 1; hipLaunchKernelGGL(fwd_kernel, dim3(grid), dim3(NTHREADS), LDS_BYTES, stream, p); }
#endif
}
```

```cpp
#include <hip/hip_runtime.h>
#include <cstdio>
#include <cstdint>

#define LAS __attribute__((address_space(3)))
typedef unsigned short bf16_t;
typedef short bf16x8 __attribute__((ext_vector_type(8)));
typedef float f32x4 __attribute__((ext_vector_type(4)));
typedef float f32x2 __attribute__((ext_vector_type(2)));
typedef unsigned u32x4 __attribute__((ext_vector_type(4)));
typedef unsigned u32x2 __attribute__((ext_vector_type(2)));

constexpr int T = 16384, D = 1024, SEQ = 8192;
constexpr int AB_IN = 4352, AB_OUT = 2048, CD_IN = 4608, CD_OUT = 2304;
constexpr int NE = 128, NE1 = 129, TOPK = 8, ED = 256;
constexpr int TK = T * TOPK;
constexpr int NSLOT = TK + T;
constexpr int LISTCAP = 16384;
constexpr float ALPHA = 1.681792830507429f;
constexpr float LN_EPS = 1e-5f;

#ifndef N_LAUNCH_MODE
#define N_LAUNCH_MODE 1
#endif

constexpr size_t al256(size_t x) { return (x + 255) & ~(size_t)255; }
constexpr size_t WS_CTL    = 0;
constexpr size_t CTL_BYTES = 65536;
constexpr size_t CTL_CNT   = 32768;
constexpr size_t WS_WABIN  = CTL_BYTES;
constexpr size_t WS_WABOUT = WS_WABIN  + al256((size_t)2 * AB_IN * D * 2);
constexpr size_t WS_WCDIN  = WS_WABOUT + al256((size_t)2 * D * AB_OUT * 2);
constexpr size_t WS_WCDOUT = WS_WCDIN  + al256((size_t)2 * CD_IN * D * 2);
constexpr size_t WS_WRT    = WS_WCDOUT + al256((size_t)2 * D * CD_OUT * 2);
constexpr size_t WS_WGU    = WS_WRT    + al256((size_t)4 * 256 * D * 2);
constexpr size_t WS_WDN    = WS_WGU    + al256((size_t)4 * NE1 * 512 * D * 2);
constexpr size_t WS_X      = WS_WDN    + al256((size_t)4 * NE1 * D * ED * 2);
constexpr size_t WS_XB     = WS_X      + al256((size_t)T * D * 4);
constexpr size_t WS_U1     = WS_XB     + al256((size_t)T * D * 2);
constexpr size_t U1_BYTES  = al256((size_t)NSLOT * D * 2) > al256((size_t)T * CD_IN * 4) ? al256((size_t)NSLOT * D * 2) : al256((size_t)T * CD_IN * 4);
constexpr size_t WS_U2     = WS_U1     + U1_BYTES;
constexpr size_t U2_BYTES  = al256((size_t)T * 1280 * 4 * 3);
constexpr size_t WS_YCAT   = WS_U2     + U2_BYTES;
constexpr size_t WS_H      = WS_YCAT   + al256((size_t)T * CD_OUT * 2);
constexpr size_t WS_ZR     = WS_H      + al256((size_t)T * D * 4);
constexpr size_t WS_HID    = WS_ZR     + al256((size_t)T * 256 * 4);
constexpr size_t WS_LIST   = WS_HID    + al256((size_t)NSLOT * ED * 2);
constexpr size_t WS_GATE   = WS_LIST   + al256((size_t)NE * LISTCAP * 4);
constexpr size_t WS_ROPEA  = WS_GATE   + al256((size_t)NSLOT * 4);
constexpr size_t WS_ROPER  = WS_ROPEA  + al256((size_t)SEQ * 32 * 8);
constexpr size_t WS_BIASP  = WS_ROPER  + al256((size_t)SEQ * 64 * 8);
constexpr size_t WS_END    = WS_BIASP  + al256((size_t)2 * AB_IN * 4);
constexpr size_t MB = 1024 * 1024;
constexpr size_t AB_QB = WS_U1, AB_KB = WS_U1 + 32 * MB, AB_VT = WS_U1 + 36 * MB, AB_RQB = WS_U1 + 40 * MB, AB_RKB = WS_U1 + 56 * MB, AB_RKDT = WS_U1 + 72 * MB,
                 AB_RVT = WS_U1 + 88 * MB, AB_RGB = WS_U1 + 120 * MB, AB_KV = WS_U1 + 152 * MB  , AB_SPREV = WS_U1 + 216 * MB  ;
static_assert(AB_SPREV + 32 * MB <= WS_U1 + U1_BYTES, "U1 map");

__device__ __forceinline__ float bf2f(bf16_t b) { return __uint_as_float(((unsigned)b) << 16); }
__device__ __forceinline__ bf16_t f2bf(float f) { unsigned u = __float_as_uint(f); u += 0x7FFFu + ((u >> 16) & 1u); return (bf16_t)(u >> 16); }
__device__ __forceinline__ unsigned pk2(float lo, float hi) { return (unsigned)f2bf(lo) | ((unsigned)f2bf(hi) << 16); }
__device__ __forceinline__ float wave_sum(float v) {
#pragma unroll
    for (int o = 32; o; o >>= 1) v += __shfl_xor(v, o);
    return v; }
__device__ __forceinline__ float wave_max(float v) {
#pragma unroll
    for (int o = 32; o; o >>= 1) v = fmaxf(v, __shfl_xor(v, o));
    return v; }
__device__ __forceinline__ float gelu_tanh(float x) { const float u = 0.7978845608028654f * (x + 0.044715f * x * x * x); return 0.5f * x * (1.f + tanhf(u)); }
__device__ __forceinline__ float sigmoidf_(float x) { return 1.f / (1.f + __expf(-x)); }
__device__ __forceinline__ float siluf_(float x) { return x / (1.f + __expf(-x)); }

#define XB_TMO      128
#define XB_XCNT(j)  (256  + 64 * (j))
#define XB_XSUB(j)  (1280 + 64 * (j))
#define XB_XGEN(j)  (2304 + 64 * (j))
#define XB_TOP      3328
#define XB_TOPGEN   3392
#define XCD_BAR_WORDS 3456
#define XB_SPIN_CAP (1u << 22)

__device__ __forceinline__ unsigned xb_ld(unsigned* p)              { return __hip_atomic_load(p, __ATOMIC_RELAXED, __HIP_MEMORY_SCOPE_AGENT); }
__device__ __forceinline__ unsigned xb_add(unsigned* p, unsigned v) { return __hip_atomic_fetch_add(p, v, __ATOMIC_RELAXED, __HIP_MEMORY_SCOPE_AGENT); }
__device__ __forceinline__ unsigned xb_xcc_id() { return (unsigned)__builtin_amdgcn_s_getreg((3 << 11) | 20) & 0xFu; }
#define XB_SPIN(cond, bar) do { unsigned _sp = 0; while (cond) { __builtin_amdgcn_s_sleep(1); \
    if ((++_sp & 255u) == 0u) { if (xb_ld(&(bar)[XB_TMO])) break; if (_sp > XB_SPIN_CAP) { atomicAdd(&(bar)[XB_TMO], 1u); break; } } } } while (0)

struct XcdBarrier { unsigned* bar; unsigned x; volatile LAS unsigned* st; };

__device__ __forceinline__ XcdBarrier xcd_barrier_post(unsigned* bar, volatile LAS unsigned* st) {
    XcdBarrier b; b.bar = bar; b.x = xb_xcc_id(); b.st = st;
    if (threadIdx.x == 0) (void)xb_add(&bar[XB_XCNT(b.x)], 1u);
    return b;
}
__device__ __forceinline__ void xcd_barrier_complete(unsigned* bar, unsigned x, unsigned& nloc, unsigned& nx) {
    const unsigned G = gridDim.x * gridDim.y * gridDim.z;
    unsigned sum, cnt, mine, sp = 0u;
    for (;;) {
        sum = 0u; cnt = 0u; mine = 0u;
#pragma unroll
        for (unsigned j = 0; j < 16; ++j) { const unsigned c = xb_ld(&bar[XB_XCNT(j)]); sum += c; cnt += (c > 0u) ? 1u : 0u; mine = (j == x) ? c : mine; }
        if (sum == G) break;
        __builtin_amdgcn_s_sleep(1);
        if ((++sp & 255u) == 0u) { if (xb_ld(&bar[XB_TMO])) break; if (sp > XB_SPIN_CAP) { atomicAdd(&bar[XB_TMO], 1u); break; } }
    }
    nloc = mine > 0u ? mine : 1u; nx = cnt > 0u ? cnt : 1u;
}
__device__ __forceinline__ void xcd_barrier(const XcdBarrier& b) {
    asm volatile("s_waitcnt vmcnt(0)" ::: "memory");
    __syncthreads();
    if (threadIdx.x == 0) {
        unsigned* bar = b.bar;
        __builtin_amdgcn_s_waitcnt(0);
        unsigned nloc = b.st[0], nx = b.st[1];
        if (nloc == 0u) { xcd_barrier_complete(bar, b.x, nloc, nx); b.st[0] = nloc; b.st[1] = nx; }
        const unsigned old = xb_add(&bar[XB_XSUB(b.x)], 1u);
        const unsigned gen = old / nloc;
        if (old + 1u == (gen + 1u) * nloc) {
            __builtin_amdgcn_fence(__ATOMIC_RELEASE, "agent");
            asm volatile("s_waitcnt vmcnt(0)" ::: "memory");
            const unsigned og = xb_add(&bar[XB_TOP], 1u);
            const unsigned tg = og / nx;
            if (og + 1u == (tg + 1u) * nx) xb_add(&bar[XB_TOPGEN], 1u);
            else XB_SPIN(xb_ld(&bar[XB_TOPGEN]) == tg, bar);
            __builtin_amdgcn_fence(__ATOMIC_ACQUIRE, "agent");
            xb_add(&bar[XB_XGEN(b.x)], 1u);
            asm volatile("s_waitcnt vmcnt(0)" ::: "memory");
        } else {
            XB_SPIN(xb_ld(&bar[XB_XGEN(b.x)]) == gen, bar);
            __builtin_amdgcn_fence(__ATOMIC_ACQUIRE, "agent");
            asm volatile("s_waitcnt vmcnt(0)" ::: "memory");
        }
    }
    __syncthreads();
}

namespace g8 {
constexpr int BM = 256, BK = 64, HALF = 128, HTB = HALF * BK * 2, STAGE_BYTES = 8 * HTB, NXCD = 8, WGM = 8;
__device__ __forceinline__ int lds_byte(int r, int c) { const int st = (r >> 4) * 2 + (c >> 5), rr = r & 15, cc = c & 31, ob = rr * 64 + cc * 2; return st * 1024 + (ob ^ (((ob >> 9) & 1) << 5)); }
__device__ __forceinline__ void stage_rc(int b, int& R, int& C) { const int st = b / 1024, sb = b % 1024, swz = sb ^ (((sb >> 9) & 1) << 5); R = (st >> 1) * 16 + swz / 64; C = (st & 1) * 32 + (swz % 64) / 2; }
__device__ __forceinline__ int perm32(int rho) { const int n = rho >> 4, i = rho & 15; return 8 * (i >> 2) + 4 * n + (i & 3); }

struct Unit { const char* A; const char* B; int pm, pn, aux; };

struct DenseOrder {
    const char* A; const char* Bt; int nM, nN, nwg, G, c, K;
    __device__ void init(const void* A_, const void* Bt_, int M, int N, int K_, int G_, int c_) { A = (const char*)A_; Bt = (const char*)Bt_; nM = M / BM; nN = N / BM; nwg = nM * nN; G = G_; c = c_; K = K_; }
    __device__ __forceinline__ bool next(int i, Unit& u) const {
        const long L = (long)i * G + c; if (L >= nwg) return false;
        int wgid = (int)L; { const int q = nwg / NXCD, r = nwg % NXCD, xcd = wgid % NXCD, off = wgid / NXCD; wgid = (xcd < r ? xcd * (q + 1) : r * (q + 1) + (xcd - r) * q) + off; }
        const int nig = WGM * nN, gid = wgid / nig, fm = gid * WGM, gsz = (nM - fm) < WGM ? (nM - fm) : WGM;
        u.pm = fm + ((wgid % nig) % gsz); u.pn = (wgid % nig) / gsz; u.aux = 0;
        u.A = A + (size_t)u.pm * BM * K * 2; u.B = Bt + (size_t)u.pn * BM * K * 2; return true;
    }
    __device__ __forceinline__ void aoff(const Unit&, int tid, unsigned (&o)[2][2]) const {
#pragma unroll
        for (int i = 0; i < 2; ++i) { int R, C; stage_rc(tid * 16 + i * 8192, R, C);
            o[0][i] = (unsigned)(R * K + C) * 2u; o[1][i] = (unsigned)((R + HALF) * K + C) * 2u; }
    }
};

__device__ __forceinline__ unsigned cvt_pk_bf16(float lo, float hi) { unsigned r; asm volatile("v_cvt_pk_bf16_f32 %0, %1, %2" : "=v"(r) : "v"(lo), "v"(hi)); return r; }

struct EpiF32 {
    static constexpr bool PERM = false;
    float* C; int ldc; const float* bias;
    __device__ __forceinline__ void operator()(const f32x4 (&acc)[2][2][4][2], const Unit& u, int wr, int wc, int fr, int fq) const {
        const int row0 = u.pm * BM + wr * 64 + fr, col0 = u.pn * BM + wc * 32 + 4 * fq;
        f32x4 bv[2][2];
#pragma unroll
        for (int bj = 0; bj < 2; ++bj)
#pragma unroll
            for (int n = 0; n < 2; ++n) bv[bj][n] = bias ? *(const f32x4*)(bias + col0 + bj * HALF + n * 16) : (f32x4){0.f, 0.f, 0.f, 0.f};
#pragma unroll
        for (int ai = 0; ai < 2; ++ai)
#pragma unroll
            for (int m = 0; m < 4; ++m) { float* rowp = C + (size_t)(row0 + ai * HALF + m * 16) * ldc + col0;
#pragma unroll
                for (int bj = 0; bj < 2; ++bj)
#pragma unroll
                    for (int n = 0; n < 2; ++n) *(f32x4*)(rowp + bj * HALF + n * 16) = acc[ai][bj][m][n] + bv[bj][n]; }
    }
};

template <class Epi, class Sched>
__device__ __forceinline__ void gemm_phase(LAS unsigned char* lds, const int K, const Sched& S, const Epi& E) {
    int tid_ = threadIdx.x; asm volatile("" : "+v"(tid_));
    const int tid = tid_, wid = __builtin_amdgcn_readfirstlane(tid >> 6), lane = tid & 63, wr = wid >> 2, wc = wid & 3, fr = lane & 15, fq = lane >> 4;
    const int nt = K / BK;
    unsigned voffB[2];
#pragma unroll
    for (int i = 0; i < 2; ++i) { int R, C; stage_rc(tid * 16 + i * 8192, R, C); const int Rb = Epi::PERM ? ((R & ~31) + perm32(R & 31)) : R;
        voffB[i] = (unsigned)(Rb * K + C) * 2u; }
    const size_t kstep = (size_t)(BK * 2);
    const size_t hstep = (size_t)HALF * K * 2;
    const unsigned ldsw = (unsigned)wid * 1024u;
    const int aoff = lds_byte(wr * 64 + fr, fq * 8), boff = lds_byte(wc * 32 + fr, fq * 8);
#define G8_SA(b, h) (((b) * 2 + (h)) * HTB)
#define G8_SB(b, h) ((4 + (b) * 2 + (h)) * HTB)
#define G8_STAGE(bufoff, gbase, voff) do { _Pragma("unroll") for (int _i = 0; _i < 2; ++_i) \
        __builtin_amdgcn_global_load_lds((const unsigned*)((const char*)(gbase) + (voff)[_i]), (LAS unsigned*)(lds + (bufoff) + ldsw + _i * 8192), 16, 0, 0); } while (0)
#define G8_LDA(dst, b, h) do { _Pragma("unroll") for (int m = 0; m < 4; ++m) _Pragma("unroll") for (int k = 0; k < 2; ++k) dst[m][k] = *(const LAS bf16x8*)(lds + G8_SA(b, h) + aoff + m * 2048 + k * 1024); } while (0)
#define G8_LDB(dst, b, h) do { _Pragma("unroll") for (int n = 0; n < 2; ++n) _Pragma("unroll") for (int k = 0; k < 2; ++k) dst[n][k] = *(const LAS bf16x8*)(lds + G8_SB(b, h) + boff + n * 2048 + k * 1024); } while (0)
#define G8_MMA(ai, bj, At, Bt) do { __builtin_amdgcn_s_setprio(1); _Pragma("unroll") for (int m = 0; m < 4; ++m) _Pragma("unroll") for (int n = 0; n < 2; ++n) _Pragma("unroll") for (int k = 0; k < 2; ++k) \
        acc[ai][bj][m][n] = __builtin_amdgcn_mfma_f32_16x16x32_bf16(Bt[n][k], At[m][k], acc[ai][bj][m][n], 0, 0, 0); __builtin_amdgcn_s_setprio(0); } while (0)
#define G8_WAIT_V(n) asm volatile("s_waitcnt vmcnt(" #n ")" ::: "memory")
#define G8_WAIT_L(n) asm volatile("s_waitcnt lgkmcnt(" #n ")" ::: "memory")
#define G8_BAR __builtin_amdgcn_s_barrier()
#define G8_SCHED __builtin_amdgcn_sched_barrier(0)
    Unit cur, nxt; int ui = 0;
    if (!S.next(0, cur)) return;
    f32x4 acc[2][2][4][2];
#pragma unroll
    for (int a = 0; a < 2; ++a)
#pragma unroll
        for (int b = 0; b < 2; ++b)
#pragma unroll
            for (int m = 0; m < 4; ++m)
#pragma unroll
                for (int n = 0; n < 2; ++n) acc[a][b][m][n] = (f32x4){0.f, 0.f, 0.f, 0.f};
    bf16x8 At[4][2], B0[2][2], B1[2][2];
    unsigned oc[2][2];
    S.aoff(cur, tid, oc);
    const char* cA = cur.A; const char* cB = cur.B;
    G8_STAGE(G8_SB(0, 0), cB, voffB); G8_STAGE(G8_SA(0, 0), cA, oc[0]); G8_STAGE(G8_SB(0, 1), cB + hstep, voffB); G8_STAGE(G8_SA(0, 1), cA, oc[1]);
    if (wr == 1) G8_BAR;
    G8_WAIT_V(4); G8_BAR;
    G8_STAGE(G8_SB(1, 0), cB + kstep, voffB); G8_STAGE(G8_SA(1, 0), cA + kstep, oc[0]); G8_STAGE(G8_SB(1, 1), cB + hstep + kstep, voffB);
    G8_WAIT_V(6); G8_BAR;
    for (;;) {
        const bool has_next = S.next(ui + 1, nxt);
        const char* nA = has_next ? nxt.A : cA; const char* nB = has_next ? nxt.B : cB;
#pragma unroll 1
        for (int t = 0; t < nt; t += 2) {
            const bool last = (t == nt - 2);
            const char* a1 = cA + (size_t)(t + 1) * kstep;
            const char* a2 = last ? nA : cA + (size_t)(t + 2) * kstep; const char* b2 = last ? nB : cB + (size_t)(t + 2) * kstep;
            const char* a3 = a2 + kstep; const char* b3 = b2 + kstep;
            G8_LDB(B0, 0, 0); G8_SCHED; G8_LDA(At, 0, 0); G8_STAGE(G8_SA(1, 1), a1, oc[1]);
            if (last && has_next) S.aoff(nxt, tid, oc);
            G8_WAIT_L(8); G8_BAR; G8_WAIT_L(0); G8_MMA(0, 0, At, B0); G8_BAR; G8_SCHED;
            G8_LDB(B1, 0, 1); G8_STAGE(G8_SB(0, 0), b2, voffB);
            G8_BAR; G8_WAIT_L(0); G8_MMA(0, 1, At, B1); G8_BAR;
            G8_LDA(At, 0, 1); G8_STAGE(G8_SA(0, 0), a2, oc[0]);
            G8_BAR; G8_WAIT_L(0); G8_MMA(1, 0, At, B0); G8_BAR; G8_SCHED;
            G8_STAGE(G8_SB(0, 1), b2 + hstep, voffB);
            G8_WAIT_V(6); G8_BAR; G8_MMA(1, 1, At, B1); G8_BAR;
            G8_LDB(B0, 1, 0); G8_SCHED; G8_LDA(At, 1, 0); G8_STAGE(G8_SA(0, 1), a2, oc[1]);
            G8_WAIT_L(8); G8_BAR; G8_WAIT_L(0); G8_MMA(0, 0, At, B0); G8_BAR; G8_SCHED;
            G8_LDB(B1, 1, 1); G8_STAGE(G8_SB(1, 0), b3, voffB);
            G8_BAR; G8_WAIT_L(0); G8_MMA(0, 1, At, B1); G8_BAR;
            G8_LDA(At, 1, 1); G8_STAGE(G8_SA(1, 0), a3, oc[0]);
            G8_BAR; G8_WAIT_L(0); G8_MMA(1, 0, At, B0); G8_BAR; G8_SCHED;
            G8_STAGE(G8_SB(1, 1), b3 + hstep, voffB);
            G8_WAIT_V(6); G8_BAR; G8_MMA(1, 1, At, B1); G8_BAR;
        }
        E(acc, cur, wr, wc, fr, fq);
        if (!has_next) break;
#pragma unroll
        for (int a = 0; a < 2; ++a)
#pragma unroll
            for (int b = 0; b < 2; ++b)
#pragma unroll
                for (int m = 0; m < 4; ++m)
#pragma unroll
                    for (int n = 0; n < 2; ++n) acc[a][b][m][n] = (f32x4){0.f, 0.f, 0.f, 0.f};
        cur = nxt; cA = nA; cB = nB; ++ui;
    }
    G8_WAIT_V(0);
    if (wr == 0) G8_BAR;
    G8_BAR;
#undef G8_SA
#undef G8_SB
#undef G8_STAGE
#undef G8_LDA
#undef G8_LDB
#undef G8_MMA
#undef G8_WAIT_V
#undef G8_WAIT_L
#undef G8_BAR
#undef G8_SCHED
}
}

constexpr int NTHREADS = 512;
constexpr int LDS_STAGE = 0;
constexpr int LDS_TAB   = g8::STAGE_BYTES;
constexpr int TAB_SLOTS = 12;
constexpr int LDS_DESC  = LDS_TAB + TAB_SLOTS * 256 * 4;
constexpr int LDS_PREF  = LDS_DESC + 64;
constexpr int LDS_MISC  = LDS_PREF + 132 * 4 + 48;
constexpr int LDS_BYTES = 147456;
static_assert(LDS_MISC % 16 == 0 && LDS_MISC + 64 <= LDS_BYTES, "LDS map");

struct Params { const float* in[31]; float* out; unsigned char* ws; int ph_lo, ph_hi; };

struct Ctx {
    const float* const* in; float* out; unsigned char* ws; LAS unsigned char* lds;
    int tid, lane, wid, bid, G, gtid, gthreads, gw, nwaves;
};

__device__ __forceinline__ int ab_phys(int n) {
    if (n < 1024) { const int hd = n >> 6, jj = n & 63; return (hd >> 2) * 256 + (jj >> 5) * 128 + (hd & 3) * 32 + (jj & 31); }
    if (n < 1152) { const int nn = n - 1024, hh = nn >> 6, jj = nn & 63; return 1024 + (jj >> 5) * 128 + hh * 32 + (jj & 31); }
    if (n < 1280) { const int vv = n - 1152; return 1024 + (vv >> 6) * 128 + 64 + (vv & 63); }
    if (n < 2304) { const int base = n < 1792 ? 1280 : 1792, nn = n - base, h = nn >> 7, jj = nn & 127; return base + (h >> 1) * 256 + (jj >> 6) * 128 + (h & 1) * 64 + (jj & 63); }
    return n;
}
template <class DstFn>
__device__ __forceinline__ void convert_T(const Ctx& c, const float* src, int nmat, int K, int N, DstFn dstfn) {
    LAS float* tile = (LAS float*)(c.lds);
    const int tk = K / 64, tn = N / 64; const long ntiles = (long)nmat * tk * tn;
    for (long tix = c.bid; tix < ntiles; tix += c.G) {
        const int m = (int)(tix / (tk * tn)); const int rem = (int)(tix % (tk * tn)); const int kt = rem / tn, nt = rem % tn;
        const float* s = src + (size_t)m * K * N + (size_t)(kt * 64) * N + nt * 64;
#pragma unroll
        for (int i = 0; i < 2; ++i) { const int k = (c.tid >> 4) + 32 * i, n4 = (c.tid & 15) * 4; const f32x4 v = *(const f32x4*)(s + (size_t)k * N + n4);
            tile[k * 65 + n4 + 0] = v[0]; tile[k * 65 + n4 + 1] = v[1]; tile[k * 65 + n4 + 2] = v[2]; tile[k * 65 + n4 + 3] = v[3]; }
        __syncthreads();
        { const int n = c.tid >> 3, k8 = (c.tid & 7) * 8; u32x4 w;
          w[0] = pk2(tile[(k8 + 0) * 65 + n], tile[(k8 + 1) * 65 + n]); w[1] = pk2(tile[(k8 + 2) * 65 + n], tile[(k8 + 3) * 65 + n]);
          w[2] = pk2(tile[(k8 + 4) * 65 + n], tile[(k8 + 5) * 65 + n]); w[3] = pk2(tile[(k8 + 6) * 65 + n], tile[(k8 + 7) * 65 + n]);
          bf16_t* d = dstfn(m, nt * 64 + n) + kt * 64 + k8; *(u32x4*)d = w; }
        __syncthreads();
    }
}

__device__ __forceinline__ void phase_convert(const Ctx& c) {
    unsigned char* ws = c.ws;
    { const float* x = c.in[0]; float* xo = (float*)(ws + WS_X); bf16_t* xb = (bf16_t*)(ws + WS_XB);
      for (long i = c.gtid; i < (long)T * D / 4; i += c.gthreads) { const f32x4 v = *(const f32x4*)(x + i * 4); *(f32x4*)(xo + i * 4) = v; u32x2 w; w[0] = pk2(v[0], v[1]); w[1] = pk2(v[2], v[3]); *(u32x2*)(xb + i * 4) = w; } }
    { bf16_t* wrt = (bf16_t*)(ws + WS_WRT); for (long i = c.gtid; i < (long)4 * 128 * D / 8; i += c.gthreads) { const long l = i / (128 * D / 8), r = i % (128 * D / 8); *(u32x4*)(wrt + (size_t)l * 256 * D + (size_t)128 * D + r * 8) = (u32x4){0u, 0u, 0u, 0u}; }
      float* gate = (float*)(ws + WS_GATE); for (int i = c.gtid; i < T; i += c.gthreads) gate[TK + i] = 1.f;
      f32x2* ra = (f32x2*)(ws + WS_ROPEA); f32x2* rr = (f32x2*)(ws + WS_ROPER);
      for (int i = c.gtid; i < SEQ * 96; i += c.gthreads) { const int sidx = i / 96, q = i % 96; const bool isA = q < 32; const int jx = isA ? q : q - 32;
          const float e = isA ? (float)jx * (1.f / 32.f) : (float)jx * (1.f / 63.f); const float ang = (float)sidx * exp2f(-e * 13.287712379549449f); float sn, cs; sincosf(ang, &sn, &cs);
          if (isA) ra[sidx * 32 + jx] = (f32x2){cs, sn}; else rr[sidx * 64 + jx] = (f32x2){cs, sn}; }
      float* bp = (float*)(ws + WS_BIASP); for (int i = c.gtid; i < 2 * AB_IN; i += c.gthreads) { const int m = i / AB_IN, n = i % AB_IN; bp[m * AB_IN + ab_phys(n)] = c.in[2][i]; } }
    { bf16_t* d = (bf16_t*)(ws + WS_WABIN);  convert_T(c, c.in[1], 2, D, AB_IN, [=](int m, int n) { return d + (size_t)m * AB_IN * D + (size_t)ab_phys(n) * D; }); }
    { bf16_t* d = (bf16_t*)(ws + WS_WABOUT); convert_T(c, c.in[4], 2, AB_OUT, D, [=](int m, int n) { return d + (size_t)m * D * AB_OUT + (size_t)n * AB_OUT; }); }
    { bf16_t* d = (bf16_t*)(ws + WS_WCDIN);  convert_T(c, c.in[6], 2, D, CD_IN, [=](int m, int n) { return d + (size_t)m * CD_IN * D + (size_t)n * D; }); }
    { bf16_t* d = (bf16_t*)(ws + WS_WCDOUT); convert_T(c, c.in[17], 2, CD_OUT, D, [=](int m, int n) { return d + (size_t)m * D * CD_OUT + (size_t)n * CD_OUT; }); }
    { bf16_t* d = (bf16_t*)(ws + WS_WRT);    convert_T(c, c.in[21], 4, D, NE, [=](int m, int n) { return d + (size_t)m * 256 * D + (size_t)n * D; }); }
    { bf16_t* d = (bf16_t*)(ws + WS_WGU);
      convert_T(c, c.in[23], 4 * NE, D, ED, [=](int m, int n) { return d + (size_t)((m >> 7) * NE1 + (m & 127)) * 512 * D + (size_t)((n >> 7) * 256 + (n & 127)) * D; });
      convert_T(c, c.in[24], 4 * NE, D, ED, [=](int m, int n) { return d + (size_t)((m >> 7) * NE1 + (m & 127)) * 512 * D + (size_t)((n >> 7) * 256 + 128 + (n & 127)) * D; });
      convert_T(c, c.in[26], 4, D, ED, [=](int m, int n) { return d + (size_t)(m * NE1 + NE) * 512 * D + (size_t)((n >> 7) * 256 + (n & 127)) * D; });
      convert_T(c, c.in[27], 4, D, ED, [=](int m, int n) { return d + (size_t)(m * NE1 + NE) * 512 * D + (size_t)((n >> 7) * 256 + 128 + (n & 127)) * D; }); }
    { bf16_t* d = (bf16_t*)(ws + WS_WDN);
      convert_T(c, c.in[25], 4 * NE, ED, D, [=](int m, int n) { return d + (size_t)((m >> 7) * NE1 + (m & 127)) * D * ED + (size_t)n * ED; });
      convert_T(c, c.in[28], 4, ED, D, [=](int m, int n) { return d + (size_t)(m * NE1 + NE) * D * ED + (size_t)n * ED; }); }
}

__device__ __forceinline__ void phase_dense(const Ctx& c, const bf16_t* A, const bf16_t* Bt, int M, int N, int K, float* C, int ldc, const float* bias) {
    g8::DenseOrder S; S.init(A, Bt, M, N, K, c.G, c.bid);
    g8::EpiF32 E{C, ldc, bias};
    g8::gemm_phase<g8::EpiF32, g8::DenseOrder>(c.lds + LDS_STAGE, K, S, E);
}

struct EpiABIn {
    static constexpr bool PERM = true;
    const float* biasP; unsigned char* ws;
    __device__ __forceinline__ void operator()(const f32x4 (&acc)[2][2][4][2], const g8::Unit& u, int wr, int wc, int fr, int fq) const {
        const int pn = u.pn; const int colp = pn * 256 + wc * 32 + fq * 8;
        f32x4 bv[2][2];
#pragma unroll
        for (int bj = 0; bj < 2; ++bj)
#pragma unroll
            for (int n = 0; n < 2; ++n) bv[bj][n] = *(const f32x4*)(biasP + colp + bj * 128 + 4 * n);
        bf16_t* qb = (bf16_t*)(ws + AB_QB); bf16_t* kb = (bf16_t*)(ws + AB_KB); bf16_t* vT = (bf16_t*)(ws + AB_VT); bf16_t* rqb = (bf16_t*)(ws + AB_RQB); bf16_t* rkb = (bf16_t*)(ws + AB_RKB);
        bf16_t* rkdT = (bf16_t*)(ws + AB_RKDT); bf16_t* rvT = (bf16_t*)(ws + AB_RVT); bf16_t* rgb = (bf16_t*)(ws + AB_RGB);
        const f32x4* ropeA = (const f32x4*)(ws + WS_ROPEA); const f32x4* ropeR = (const f32x4*)(ws + WS_ROPER);
#pragma unroll
        for (int ai = 0; ai < 2; ++ai)
#pragma unroll
            for (int m = 0; m < 4; ++m) {
                const int t = u.pm * 256 + ai * 128 + wr * 64 + m * 16 + fr, sq = t & (SEQ - 1), b = t >> 13;
                f32x4 x[2][2];
#pragma unroll
                for (int bj = 0; bj < 2; ++bj)
#pragma unroll
                    for (int n = 0; n < 2; ++n) x[bj][n] = acc[ai][bj][m][n] + bv[bj][n];
                if (pn < 4 || (pn == 4 && wc < 2)) {
                    const int j0 = fq * 8; f32x4 o1[2], o2[2];
#pragma unroll
                    for (int n = 0; n < 2; ++n) { const f32x4 cs01 = ropeA[(sq * 32 + j0 + 4 * n) / 2], cs23 = ropeA[(sq * 32 + j0 + 4 * n) / 2 + 1];
                        const float cc[4] = {cs01[0], cs01[2], cs23[0], cs23[2]}, ss[4] = {cs01[1], cs01[3], cs23[1], cs23[3]};
#pragma unroll
                        for (int e = 0; e < 4; ++e) { o1[n][e] = x[0][n][e] * cc[e] - x[1][n][e] * ss[e]; o2[n][e] = x[1][n][e] * cc[e] + x[0][n][e] * ss[e]; } }
                    const float sc = pn < 4 ? 0.125f : 1.f;
                    u32x4 w1, w2;
#pragma unroll
                    for (int n = 0; n < 2; ++n) { w1[2 * n] = pk2(o1[n][0] * sc, o1[n][1] * sc); w1[2 * n + 1] = pk2(o1[n][2] * sc, o1[n][3] * sc); w2[2 * n] = pk2(o2[n][0] * sc, o2[n][1] * sc); w2[2 * n + 1] = pk2(o2[n][2] * sc, o2[n][3] * sc); }
                    bf16_t* dst = pn < 4 ? qb + (size_t)t * 1024 + (pn * 4 + wc) * 64 + j0 : kb + (size_t)t * 128 + wc * 64 + j0;
                    *(u32x4*)dst = w1; *(u32x4*)(dst + 32) = w2;
                } else if (pn == 4) {
                    const int d0 = (wc - 2) * 32 + fq * 8;
#pragma unroll
                    for (int bj = 0; bj < 2; ++bj)
#pragma unroll
                        for (int n = 0; n < 2; ++n)
#pragma unroll
                            for (int e = 0; e < 4; ++e) vT[((size_t)(b * 2 + bj) * 64 + d0 + 4 * n + e) * SEQ + sq] = f2bf(x[bj][n][e]);
                } else if (pn < 9) {
                    const bool isk = pn >= 7; const int h = ((pn - 5) & 1) * 2 + (wc >> 1), j0 = (wc & 1) * 32 + fq * 8; f32x4 o1[2], o2[2];
                    const float sc = isk ? 0.08838834764831845f : 1.f;
#pragma unroll
                    for (int n = 0; n < 2; ++n) { const f32x4 cs01 = ropeR[(sq * 64 + j0 + 4 * n) / 2], cs23 = ropeR[(sq * 64 + j0 + 4 * n) / 2 + 1];
                        const float cc[4] = {cs01[0], cs01[2], cs23[0], cs23[2]}, ss[4] = {cs01[1], cs01[3], cs23[1], cs23[3]};
#pragma unroll
                        for (int e = 0; e < 4; ++e) { o1[n][e] = (x[0][n][e] * cc[e] - x[1][n][e] * ss[e]) * sc; o2[n][e] = (x[1][n][e] * cc[e] + x[0][n][e] * ss[e]) * sc; } }
                    u32x4 w1, w2;
#pragma unroll
                    for (int n = 0; n < 2; ++n) { w1[2 * n] = pk2(o1[n][0], o1[n][1]); w1[2 * n + 1] = pk2(o1[n][2], o1[n][3]); w2[2 * n] = pk2(o2[n][0], o2[n][1]); w2[2 * n + 1] = pk2(o2[n][2], o2[n][3]); }
                    bf16_t* dst = (isk ? rkb : rqb) + (size_t)t * 512 + h * 128 + j0;
                    *(u32x4*)dst = w1; *(u32x4*)(dst + 64) = w2;
                    if (isk) {
                        const float lg = log2f(1.f - exp2f(-5.f - (float)h)); const float dec = exp2f((float)(127 - (sq & 127)) * lg);
                        bf16_t* dT = rkdT + ((size_t)(b * 4 + h) * 128 + j0) * SEQ + sq;
#pragma unroll
                        for (int n = 0; n < 2; ++n)
#pragma unroll
                            for (int e = 0; e < 4; ++e) { dT[(size_t)(4 * n + e) * SEQ] = f2bf(o1[n][e] * dec); dT[(size_t)(64 + 4 * n + e) * SEQ] = f2bf(o2[n][e] * dec); }
                    }
                } else if (pn < 13) {
                    const int h = pn - 9;
#pragma unroll
                    for (int bj = 0; bj < 2; ++bj)
#pragma unroll
                        for (int n = 0; n < 2; ++n)
#pragma unroll
                            for (int e = 0; e < 4; ++e) rvT[((size_t)(b * 4 + h) * 256 + bj * 128 + wc * 32 + fq * 8 + 4 * n + e) * SEQ + sq] = f2bf(x[bj][n][e]);
                } else {
#pragma unroll
                    for (int bj = 0; bj < 2; ++bj) { u32x4 w;
#pragma unroll
                        for (int n = 0; n < 2; ++n) { w[2 * n] = pk2(siluf_(x[bj][n][0]), siluf_(x[bj][n][1])); w[2 * n + 1] = pk2(siluf_(x[bj][n][2]), siluf_(x[bj][n][3])); }
                        *(u32x4*)(rgb + (size_t)t * 1024 + (pn - 13) * 256 + bj * 128 + wc * 32 + fq * 8) = w; }
                }
            }
    }
};
__device__ __forceinline__ void phase_ab_inproj(const Ctx& c, int j) {
    g8::DenseOrder S; S.init(c.ws + WS_XB, c.ws + WS_WABIN + (size_t)j * AB_IN * D * 2, T, AB_IN, D, c.G, c.bid);
    EpiABIn E{(const float*)(c.ws + WS_BIASP) + (size_t)j * AB_IN, c.ws};
    g8::gemm_phase<EpiABIn, g8::DenseOrder>(c.lds + LDS_STAGE, D, S, E);
}

#define MFMA16(a, b, c) __builtin_amdgcn_mfma_f32_16x16x32_bf16((a), (b), (c), 0, 0, 0)
__device__ __forceinline__ bf16x8 pack8(const f32x4& lo, const f32x4& hi) { u32x4 w; w[0] = g8::cvt_pk_bf16(lo[0], lo[1]); w[1] = g8::cvt_pk_bf16(lo[2], lo[3]); w[2] = g8::cvt_pk_bf16(hi[0], hi[1]); w[3] = g8::cvt_pk_bf16(hi[2], hi[3]); return __builtin_bit_cast(bf16x8, w); }
__device__ __forceinline__ bf16x8 cat8(const u32x2& lo, const u32x2& hi) { u32x4 w; w[0] = lo[0]; w[1] = lo[1]; w[2] = hi[0]; w[3] = hi[1]; return __builtin_bit_cast(bf16x8, w); }
template <int ROWS, int RB>
__device__ __forceinline__ void tile_g2l(LAS unsigned char* dst, const unsigned char* src, size_t gs, int tid, int zrows = 0) {
    constexpr int CPR = RB / 16, TOTAL = ROWS * CPR;
#pragma unroll 4
    for (int i = tid; i < TOTAL; i += NTHREADS) { const int r = i / CPR, cc = i % CPR; u32x4 v = (u32x4){0u, 0u, 0u, 0u}; if (r >= zrows) v = *(const u32x4*)(src + (size_t)r * gs + cc * 16);
        *(LAS u32x4*)(dst + r * (RB + 16) + cc * 16) = v; }
}

__device__ __forceinline__ void attn_unit(const Ctx& c, int unit, const float* sinks) {
    const int b = unit >> 7, n = (unit >> 1) & 63, kvh = unit & 1, hd = kvh * 8 + c.wid, lane = c.lane, fr = lane & 15, fq = lane >> 4;
    const bf16_t* qb = (const bf16_t*)(c.ws + AB_QB); const bf16_t* kb = (const bf16_t*)(c.ws + AB_KB); const bf16_t* vT = (const bf16_t*)(c.ws + AB_VT); bf16_t* ycat = (bf16_t*)(c.ws + WS_YCAT);
    LAS unsigned char* Ks = c.lds; LAS unsigned char* Vs = c.lds + 256 * 144;
    const int t0 = b * SEQ + n * 128;
    __syncthreads();
    {
        const unsigned char* src = (const unsigned char*)(kb + (size_t)(t0 - 128) * 128 + kvh * 64);
        constexpr int TOTAL = 256 * 8;
#pragma unroll 4
        for (int i = c.tid; i < TOTAL; i += NTHREADS) { const int r = i >> 3, cc = i & 7; u32x4 v = (u32x4){0u, 0u, 0u, 0u}; if (n > 0 || r >= 128) v = *(const u32x4*)(src + (ptrdiff_t)r * 256 + cc * 16);
            *(LAS u32x4*)(Ks + r * 144 + cc * 16) = v; }
        const unsigned char* vsrc = (const unsigned char*)(vT + (size_t)(b * 2 + kvh) * 64 * SEQ + (n * 128 - 128));
        constexpr int TV = 64 * 32;
#pragma unroll 4
        for (int i = c.tid; i < TV; i += NTHREADS) { const int r = i >> 5, cc = i & 31; u32x4 v = (u32x4){0u, 0u, 0u, 0u}; if (n > 0 || cc >= 16) v = *(const u32x4*)(vsrc + (ptrdiff_t)r * SEQ * 2 + cc * 16);
            *(LAS u32x4*)(Vs + r * 528 + cc * 16) = v; }
    }
    __syncthreads();
    const float sink = sinks[hd];
    for (int si = 0; si < 8; ++si) {
        const int t = t0 + si * 16 + fr;
        bf16x8 qf[2];
#pragma unroll
        for (int ks = 0; ks < 2; ++ks) qf[ks] = *(const bf16x8*)(qb + (size_t)t * 1024 + hd * 64 + ks * 32 + fq * 8);
        f32x4 S[10];
#pragma unroll
        for (int nk = 0; nk < 9; ++nk) { S[nk] = (f32x4){0.f, 0.f, 0.f, 0.f};
#pragma unroll
            for (int ks = 0; ks < 2; ++ks) { const bf16x8 a = *(const LAS bf16x8*)(Ks + (16 * (si + nk) + fr) * 144 + ks * 64 + fq * 16); S[nk] = MFMA16(a, qf[ks], S[nk]); } }
        S[9] = (f32x4){0.f, 0.f, 0.f, 0.f};
        const int i = si * 16 + fr;
        float mx = sink;
#pragma unroll
        for (int nk = 0; nk < 9; ++nk)
#pragma unroll
            for (int r = 0; r < 4; ++r) { const int p = 16 * (si + nk) + 4 * fq + r; const bool ok = (p >= i + 1) && (p <= i + 128) && (n > 0 || p >= 128);
                S[nk][r] = ok ? S[nk][r] : -1e30f; mx = fmaxf(mx, S[nk][r]); }
        mx = fmaxf(mx, __shfl_xor(mx, 16)); mx = fmaxf(mx, __shfl_xor(mx, 32));
        float sum = 0.f;
#pragma unroll
        for (int nk = 0; nk < 9; ++nk)
#pragma unroll
            for (int r = 0; r < 4; ++r) { const float pv = S[nk][r] > -1e29f ? exp2f((S[nk][r] - mx) * 1.4426950408889634f) : 0.f; S[nk][r] = pv; sum += pv; }
        sum += __shfl_xor(sum, 16); sum += __shfl_xor(sum, 32);
        const float inv = 1.f / (sum + exp2f((sink - mx) * 1.4426950408889634f));
        f32x4 O[4];
#pragma unroll
        for (int nd = 0; nd < 4; ++nd) O[nd] = (f32x4){0.f, 0.f, 0.f, 0.f};
#pragma unroll
        for (int kk = 0; kk < 5; ++kk) { const bf16x8 pf = pack8(S[2 * kk], S[2 * kk + 1]);
            const int p0 = 16 * (si + 2 * kk) + 4 * fq, p1 = (kk == 4 && si == 7) ? p0 : p0 + 16;
#pragma unroll
            for (int nd = 0; nd < 4; ++nd) { const u32x2 lo = *(const LAS u32x2*)(Vs + (16 * nd + fr) * 528 + p0 * 2), hi = *(const LAS u32x2*)(Vs + (16 * nd + fr) * 528 + p1 * 2);
                O[nd] = MFMA16(cat8(lo, hi), pf, O[nd]); } }
#pragma unroll
        for (int nd = 0; nd < 4; ++nd) { u32x2 w; w[0] = pk2(O[nd][0] * inv, O[nd][1] * inv); w[1] = pk2(O[nd][2] * inv, O[nd][3] * inv);
            *(u32x2*)(ycat + (size_t)t * AB_OUT + hd * 64 + 16 * nd + 4 * fq) = w; }
    }
}

__device__ __forceinline__ void ret_kv_unit(const Ctx& c, int unit) {
    const int b = unit >> 8, n = (unit >> 2) & 63, h = unit & 3, lane = c.lane, fr = lane & 15, fq = lane >> 4, w = c.wid;
    const bf16_t* rkdT = (const bf16_t*)(c.ws + AB_RKDT); const bf16_t* rvT = (const bf16_t*)(c.ws + AB_RVT); float* kv = (float*)(c.ws + AB_KV);
    LAS unsigned char* Kd = c.lds;
    __syncthreads();
    tile_g2l<128, 256>(Kd, (const unsigned char*)(rkdT + (size_t)(b * 4 + h) * 128 * SEQ + n * 128), (size_t)SEQ * 2, c.tid);
    bf16x8 vf[2][4];
#pragma unroll
    for (int ne = 0; ne < 2; ++ne)
#pragma unroll
        for (int ks = 0; ks < 4; ++ks) vf[ne][ks] = *(const bf16x8*)(rvT + ((size_t)(b * 4 + h) * 256 + 32 * w + 16 * ne + fr) * SEQ + n * 128 + ks * 32 + fq * 8);
    __syncthreads();
    float* out = kv + ((size_t)((b * 64 + n) * 4 + h)) * 256 * 128;
#pragma unroll
    for (int nd = 0; nd < 8; ++nd) { f32x4 a0 = (f32x4){0.f, 0.f, 0.f, 0.f}, a1 = a0;
#pragma unroll
        for (int ks = 0; ks < 4; ++ks) { const bf16x8 kf = *(const LAS bf16x8*)(Kd + (16 * nd + fr) * 272 + ks * 64 + fq * 16); a0 = MFMA16(kf, vf[0][ks], a0); a1 = MFMA16(kf, vf[1][ks], a1); }
        *(f32x4*)(out + (size_t)(32 * w + fr) * 128 + 16 * nd + 4 * fq) = a0; *(f32x4*)(out + (size_t)(32 * w + 16 + fr) * 128 + 16 * nd + 4 * fq) = a1; }
}
__device__ __forceinline__ void ret_scan(const Ctx& c, int first_block, int nblocks) {
    const float* kv = (const float*)(c.ws + AB_KV); bf16_t* sp = (bf16_t*)(c.ws + AB_SPREV);
    const int nthr = nblocks * NTHREADS;
    for (int idx = (c.bid - first_block) * NTHREADS + c.tid; idx < 2 * 4 * 256 * 128 / 4; idx += nthr) {
        const int b = idx >> 15, rem = idx & 32767, h = rem >> 13;
        const float g = exp2f(128.f * log2f(1.f - exp2f(-5.f - (float)h)));
        const size_t base = (size_t)b * 64 * 131072 + (size_t)rem * 4;
        f32x4 st = (f32x4){0.f, 0.f, 0.f, 0.f};
        for (int n0 = 0; n0 < 64; n0 += 8) { f32x4 v[8];
#pragma unroll
            for (int q = 0; q < 8; ++q) v[q] = *(const f32x4*)(kv + base + (size_t)(n0 + q) * 131072);
#pragma unroll
            for (int q = 0; q < 8; ++q) { u32x2 wv; wv[0] = pk2(st[0], st[1]); wv[1] = pk2(st[2], st[3]); *(u32x2*)(sp + base + (size_t)(n0 + q) * 131072) = wv; st = st * g + v[q]; } }
    }
}
__device__ __forceinline__ void ret_out_unit(const Ctx& c, int unit) {
    const int b = unit >> 8, n = (unit >> 2) & 63, h = unit & 3, lane = c.lane, fr = lane & 15, fq = lane >> 4, w = c.wid;
    const bf16_t* rqb = (const bf16_t*)(c.ws + AB_RQB); const bf16_t* rkb = (const bf16_t*)(c.ws + AB_RKB); const bf16_t* rvT = (const bf16_t*)(c.ws + AB_RVT);
    const bf16_t* sp = (const bf16_t*)(c.ws + AB_SPREV); const bf16_t* rgb = (const bf16_t*)(c.ws + AB_RGB); bf16_t* ycat = (bf16_t*)(c.ws + WS_YCAT);
    LAS unsigned char* Kl = c.lds; LAS unsigned char* Bl = c.lds + 128 * 272;
    const int t0 = b * SEQ + n * 128; const float lg = log2f(1.f - exp2f(-5.f - (float)h));
    __syncthreads();
    tile_g2l<128, 256>(Kl, (const unsigned char*)(rkb + (size_t)t0 * 512 + h * 128), (size_t)512 * 2, c.tid);
    tile_g2l<256, 256>(Bl, (const unsigned char*)(sp + ((size_t)((b * 64 + n) * 4 + h)) * 256 * 128), (size_t)128 * 2, c.tid);
    const int t = t0 + 16 * w + fr, i = 16 * w + fr;
    bf16x8 qf[4];
#pragma unroll
    for (int ks = 0; ks < 4; ++ks) qf[ks] = *(const bf16x8*)(rqb + (size_t)t * 512 + h * 128 + ks * 32 + fq * 8);
    __syncthreads();
    bf16x8 pf[4];
#pragma unroll
    for (int kk = 0; kk < 4; ++kk) { f32x4 s2[2];
#pragma unroll
        for (int q = 0; q < 2; ++q) { const int nj = 2 * kk + q; s2[q] = (f32x4){0.f, 0.f, 0.f, 0.f};
            if (nj <= w) {
#pragma unroll
                for (int ks = 0; ks < 4; ++ks) { const bf16x8 kf = *(const LAS bf16x8*)(Kl + (16 * nj + fr) * 272 + ks * 64 + fq * 16); s2[q] = MFMA16(kf, qf[ks], s2[q]); }
#pragma unroll
                for (int r = 0; r < 4; ++r) { const int jj = 16 * nj + 4 * fq + r; s2[q][r] = (i >= jj) ? s2[q][r] * exp2f((float)(i - jj) * lg) : 0.f; } } }
        pf[kk] = pack8(s2[0], s2[1]); }
    f32x4 acc[16];
#pragma unroll
    for (int ne = 0; ne < 16; ++ne) { acc[ne] = (f32x4){0.f, 0.f, 0.f, 0.f};
#pragma unroll
        for (int ks = 0; ks < 4; ++ks) { const bf16x8 sf = *(const LAS bf16x8*)(Bl + (16 * ne + fr) * 272 + ks * 64 + fq * 16); acc[ne] = MFMA16(sf, qf[ks], acc[ne]); } }
    const float rs = exp2f((float)(i + 1) * lg);
#pragma unroll
    for (int ne = 0; ne < 16; ++ne) acc[ne] = acc[ne] * rs;
    __syncthreads();
    tile_g2l<256, 256>(Bl, (const unsigned char*)(rvT + (size_t)(b * 4 + h) * 256 * SEQ + n * 128), (size_t)SEQ * 2, c.tid);
    __syncthreads();
    const int nkk = (w >> 1) + 1;
#pragma unroll
    for (int kk = 0; kk < 4; ++kk) if (kk < nkk) {
#pragma unroll
        for (int ne = 0; ne < 16; ++ne) { const u32x2 lo = *(const LAS u32x2*)(Bl + (16 * ne + fr) * 272 + (32 * kk + 4 * fq) * 2), hi = *(const LAS u32x2*)(Bl + (16 * ne + fr) * 272 + (32 * kk + 16 + 4 * fq) * 2);
            acc[ne] = MFMA16(cat8(lo, hi), pf[kk], acc[ne]); } }
    float sm = 0.f;
#pragma unroll
    for (int ne = 0; ne < 16; ++ne) sm += acc[ne][0] + acc[ne][1] + acc[ne][2] + acc[ne][3];
    sm += __shfl_xor(sm, 16); sm += __shfl_xor(sm, 32);
    const float mean = sm * (1.f / 256.f); float sq = 0.f;
#pragma unroll
    for (int ne = 0; ne < 16; ++ne) { acc[ne] = acc[ne] - mean; sq += acc[ne][0] * acc[ne][0] + acc[ne][1] * acc[ne][1] + acc[ne][2] * acc[ne][2] + acc[ne][3] * acc[ne][3]; }
    sq += __shfl_xor(sq, 16); sq += __shfl_xor(sq, 32);
    const float rstd = rsqrtf(sq * (1.f / 256.f) + LN_EPS);
#pragma unroll
    for (int ne = 0; ne < 16; ++ne) { const u32x2 gw = *(const u32x2*)(rgb + (size_t)t * 1024 + h * 256 + 16 * ne + 4 * fq);
        const float g0 = __uint_as_float(gw[0] << 16), g1 = __uint_as_float(gw[0] & 0xffff0000u), g2 = __uint_as_float(gw[1] << 16), g3 = __uint_as_float(gw[1] & 0xffff0000u);
        u32x2 o; o[0] = pk2(acc[ne][0] * rstd * g0, acc[ne][1] * rstd * g1); o[1] = pk2(acc[ne][2] * rstd * g2, acc[ne][3] * rstd * g3);
        *(u32x2*)(ycat + (size_t)t * AB_OUT + 1024 + h * 256 + 16 * ne + 4 * fq) = o; }
}

__device__ __forceinline__ void phase_ab_p1(const Ctx& c) {
    for (int u = c.bid; u < 512; u += c.G) ret_kv_unit(c, u);
}
__device__ __forceinline__ void phase_ab_p2(const Ctx& c, int j) {
    if (c.bid < 64) ret_scan(c, 0, 64);
    else { const float* sinks = c.in[3] + j * 16; for (int u = c.bid - 64; u < 256; u += c.G - 64) attn_unit(c, u, sinks); }
}
__device__ __forceinline__ void phase_ab_p3(const Ctx& c) {
    for (int u = c.bid; u < 512; u += c.G) ret_out_unit(c, u);
}

__device__ __forceinline__ void phase_cd_act(const Ctx& c, int j) {
    float* z = (float*)(c.ws + WS_U1); float* xc = (float*)(c.ws + WS_U2);
    const float* conv_w = c.in[10] + (size_t)j * 4 * 1280; const float* conv_b = c.in[11] + (size_t)j * 1280;
    for (long idx = c.gtid; idx < (long)T * 1280; idx += c.gthreads) {
        const int t = (int)(idx / 1280), ch = (int)(idx % 1280), s = t & (SEQ - 1);
        float a = conv_b[ch];
#pragma unroll
        for (int k = 0; k < 4; ++k) { const int sp = s - 3 + k; if (sp >= 0) a += conv_w[k * 1280 + ch] * z[(size_t)(t - 3 + k) * CD_IN + 3328 + ch]; }
        xc[(size_t)t * 1280 + ch] = a;
    }
    for (long t = c.gw; t < T; t += c.nwaves) {
        float* zr = z + (size_t)t * CD_IN;
        for (int i = c.lane; i < 1024; i += 64) zr[i] = gelu_tanh(zr[i]);
        for (int i = c.lane; i < 1280; i += 64) zr[2048 + i] = gelu_tanh(zr[2048 + i]);
        float gv[16]; float sm = 0.f;
#pragma unroll
        for (int i = 0; i < 16; ++i) { gv[i] = gelu_tanh(zr[1024 + c.lane + 64 * i]); sm += gv[i]; }
        const float mean = wave_sum(sm) * (1.f / 1024.f); float sq = 0.f;
#pragma unroll
        for (int i = 0; i < 16; ++i) { gv[i] -= mean; sq += gv[i] * gv[i]; }
        const float rstd = rsqrtf(wave_sum(sq) * (1.f / 1024.f) + LN_EPS);
#pragma unroll
        for (int i = 0; i < 16; ++i) zr[1024 + c.lane + 64 * i] = gv[i] * rstd;
    }
}

__device__ __forceinline__ void phase_cd_mix(const Ctx& c, int j) {
    const float* z = (const float*)(c.ws + WS_U1); bf16_t* ycat = (bf16_t*)(c.ws + WS_YCAT);
    const float* xc = (const float*)(c.ws + WS_U2); float* av = (float*)(c.ws + WS_U2) + (size_t)T * 1280; float* bv = av + (size_t)T * 1280;
    const float* sgu_w = c.in[8] + (size_t)j * 4 * 128 * 128; const float* sgu_b = c.in[9] + (size_t)j * 4 * 128;
    const float* wa = c.in[12] + (size_t)j * 5 * 65536; const float* ba = c.in[13] + (size_t)j * 1280;
    const float* wx = c.in[14] + (size_t)j * 5 * 65536; const float* bx = c.in[15] + (size_t)j * 1280; const float* lam = c.in[16] + (size_t)j * 1280;
    for (long idx = c.gtid; idx < (long)T * 1024; idx += c.gthreads) {
        const int t = (int)(idx >> 10), col = (int)(idx & 1023), i = t & 127, t0 = t - i, g = col >> 8;
        const float* w = sgu_w + (size_t)g * 16384 + (size_t)i * 128; float a = 0.f;
        for (int jj = 0; jj <= i; ++jj) a += w[jj] * z[(size_t)(t0 + jj) * CD_IN + 1024 + col];
        const float mixed = a + sgu_b[g * 128 + i];
        ycat[(size_t)t * CD_OUT + col] = f2bf(z[(size_t)t * CD_IN + col] * mixed);
    }
    for (long idx = c.gtid; idx < (long)T * 1280; idx += c.gthreads) {
        const int t = (int)(idx / 1280), ch = (int)(idx % 1280), h = ch >> 8, cc = ch & 255;
        const float* xr = xc + (size_t)t * 1280 + h * 256; const float* wah = wa + (size_t)h * 65536 + cc; const float* wxh = wx + (size_t)h * 65536 + cc;
        float r = ba[ch], ig = bx[ch];
        for (int i = 0; i < 256; ++i) { const float xv = xr[i]; r += xv * wah[(size_t)i * 256]; ig += xv * wxh[(size_t)i * 256]; }
        r = sigmoidf_(r); ig = sigmoidf_(ig);
        const float sp = log1pf(expf(-lam[ch]));
        const float log_a = -8.f * r * sp; const float a = expf(log_a);
        const float b = sqrtf(-expm1f(2.f * log_a)) * (ig * xc[(size_t)t * 1280 + ch]);
        av[(size_t)t * 1280 + ch] = a; bv[(size_t)t * 1280 + ch] = b;
    }
}

__device__ __forceinline__ void phase_cd_scan1(const Ctx& c) {
    float* av = (float*)(c.ws + WS_U2) + (size_t)T * 1280; float* bv = av + (size_t)T * 1280;
    float* sum = (float*)(c.ws + WS_H);
    for (int idx = c.gtid; idx < 2 * 64 * 1280; idx += c.gthreads) {
        const int ch = idx % 1280, bn = idx / 1280; const size_t t0 = (size_t)bn * 128;
        float P = 1.f, h = 0.f;
        for (int i = 0; i < 128; ++i) { const size_t o = (t0 + i) * 1280 + ch; const float a = av[o], b = bv[o]; h = a * h + b; P *= a; av[o] = P; bv[o] = h; }
        sum[(size_t)idx * 2] = P; sum[(size_t)idx * 2 + 1] = h;
    }
}
__device__ __forceinline__ void phase_cd_scan2(const Ctx& c) {
    const float* z = (const float*)(c.ws + WS_U1); bf16_t* ycat = (bf16_t*)(c.ws + WS_YCAT);
    const float* av = (const float*)(c.ws + WS_U2) + (size_t)T * 1280; const float* bv = av + (size_t)T * 1280;
    const float* sum = (const float*)(c.ws + WS_H);
    for (int idx = c.gtid; idx < 2 * 64 * 1280; idx += c.gthreads) {
        const int ch = idx % 1280, bn = idx / 1280, b = bn >> 6, n = bn & 63; const size_t t0 = (size_t)bn * 128;
        float carry = 0.f;
        for (int m = 0; m < n; ++m) { const size_t o = ((size_t)(b * 64 + m) * 1280 + ch) * 2; carry = sum[o] * carry + sum[o + 1]; }
        for (int i = 0; i < 128; ++i) { const size_t t = t0 + i; const float h = bv[t * 1280 + ch] + av[t * 1280 + ch] * carry;
            ycat[t * CD_OUT + 1024 + ch] = f2bf(z[t * CD_IN + 2048 + ch] * h); }
    }
}

template <bool MOE>
__device__ __forceinline__ void phase_ln(const Ctx& c, const float* g, const float* bta, float* xout) {
    float* x = (float*)(c.ws + WS_X); bf16_t* xb = (bf16_t*)(c.ws + WS_XB);
    const float* hbuf = (const float*)(c.ws + WS_H); const bf16_t* Y = (const bf16_t*)(c.ws + WS_U1);
    for (long t = c.gw; t < T; t += c.nwaves) {
        f32x4 v[4];
#pragma unroll
        for (int q = 0; q < 4; ++q) { const int col = q * 256 + c.lane * 4;
            f32x4 f;
            if (!MOE) f = *(const f32x4*)(hbuf + (size_t)t * D + col);
            else { f = (f32x4){0.f, 0.f, 0.f, 0.f};
#pragma unroll
                for (int k = 0; k < 9; ++k) { const size_t srow = (k < 8) ? (size_t)t * 8 + k : (size_t)TK + t; const u32x2 w = *(const u32x2*)(Y + srow * D + col);
                    f[0] += __uint_as_float(w[0] << 16); f[1] += __uint_as_float(w[0] & 0xffff0000u); f[2] += __uint_as_float(w[1] << 16); f[3] += __uint_as_float(w[1] & 0xffff0000u); } }
            const f32x4 xv = *(const f32x4*)(x + (size_t)t * D + col);
            v[q] = xv * ALPHA + f; }
        float sm = 0.f;
#pragma unroll
        for (int q = 0; q < 4; ++q) sm += v[q][0] + v[q][1] + v[q][2] + v[q][3];
        const float mean = wave_sum(sm) * (1.f / 1024.f); float sq = 0.f;
#pragma unroll
        for (int q = 0; q < 4; ++q) { v[q] = v[q] - mean; sq += v[q][0] * v[q][0] + v[q][1] * v[q][1] + v[q][2] * v[q][2] + v[q][3] * v[q][3]; }
        const float rstd = rsqrtf(wave_sum(sq) * (1.f / 1024.f) + LN_EPS);
#pragma unroll
        for (int q = 0; q < 4; ++q) { const int col = q * 256 + c.lane * 4; const f32x4 gg = *(const f32x4*)(g + col), bb = *(const f32x4*)(bta + col);
            const f32x4 o = v[q] * rstd * gg + bb;
            *(f32x4*)(xout + (size_t)t * D + col) = o; if (xout != x) *(f32x4*)(x + (size_t)t * D + col) = o;
            u32x2 w; w[0] = pk2(o[0], o[1]); w[1] = pk2(o[2], o[3]); *(u32x2*)(xb + (size_t)t * D + col) = w; }
    }
}

__device__ __forceinline__ void phase_route(const Ctx& c, int L) {
    const float* zr = (const float*)(c.ws + WS_ZR); const float* rb = c.in[22] + L * NE;
    int* cnt = (int*)(c.ws + CTL_CNT) + L * NE; int* list = (int*)(c.ws + WS_LIST); float* gate = (float*)(c.ws + WS_GATE);
    for (long t = c.gw; t < T; t += c.nwaves) {
        const float s0 = sigmoidf_(zr[(size_t)t * 256 + c.lane]), s1 = sigmoidf_(zr[(size_t)t * 256 + 64 + c.lane]);
        float v0 = s0 + rb[c.lane], v1 = s1 + rb[64 + c.lane];
        float mysc = 0.f; int myexp = -1; float tot = 0.f;
        for (int k = 0; k < 8; ++k) {
            float bv = v0; int bi = c.lane; if (v1 > bv) { bv = v1; bi = c.lane + 64; }
#pragma unroll
            for (int o = 32; o; o >>= 1) { const float ov = __shfl_xor(bv, o); const int oi = __shfl_xor(bi, o); if (ov > bv || (ov == bv && oi < bi)) { bv = ov; bi = oi; } }
            const float sc = __shfl((bi & 64) ? s1 : s0, bi & 63);
            tot += sc;
            if (c.lane == k) { mysc = sc; myexp = bi; }
            if (c.lane == (bi & 63)) { if (bi & 64) v1 = -1e30f; else v0 = -1e30f; }
        }
        if (c.lane < 8) { const int pos = atomicAdd(&cnt[myexp], 1); list[(size_t)myexp * LISTCAP + pos] = (int)t * 8 + c.lane; gate[(size_t)t * 8 + c.lane] = mysc / tot * 2.5f; }
    }
}

struct MoeOrder {
    const char* Abase; const char* Bbase; size_t Bstride; int K, NT, total, G, c, mode;
    LAS int* tab; LAS int* desc;
    __device__ __forceinline__ bool next(int i, g8::Unit& u) const {
        const long L = (long)i * G + c; if (L >= total || i >= TAB_SLOTS) return false;
        const int d = desc[i]; const int e = d >> 12, pn = d & 15;
        u.pm = (d >> 4) & 255; u.pn = pn; u.aux = i; u.A = Abase; u.B = Bbase + (size_t)e * Bstride + (size_t)pn * 256 * K * 2; return true;
    }
    __device__ __forceinline__ void aoff(const g8::Unit& u, int tid, unsigned (&o)[2][2]) const {
#pragma unroll
        for (int i = 0; i < 2; ++i) { int R, C; g8::stage_rc(tid * 16 + i * 8192, R, C);
#pragma unroll
            for (int h = 0; h < 2; ++h) { int s = tab[u.aux * 256 + h * 128 + R]; s = s < 0 ? 0 : s; const int row = mode ? s : (s < TK ? (s >> 3) : s - TK);
                o[h][i] = (unsigned)(row * K + C) * 2u; } }
    }
};
__device__ __forceinline__ void moe_setup(const Ctx& c, MoeOrder& S, const int* cnt, int NT) {
    LAS int* pref = (LAS int*)(c.lds + LDS_PREF); LAS int* desc = (LAS int*)(c.lds + LDS_DESC); LAS int* tab = (LAS int*)(c.lds + LDS_TAB);
    const int* list = (const int*)(c.ws + WS_LIST);
    if (c.tid == 0) { int acc = 0; for (int e = 0; e < NE1; ++e) { pref[e] = acc; const int n = e < NE ? cnt[e] : T; acc += (n + 255) >> 8; } pref[NE1] = acc; }
    __syncthreads();
    const int total = pref[NE1] * NT;
    S.NT = NT; S.total = total; S.G = c.G; S.c = c.bid; S.tab = tab; S.desc = desc;
    for (int i = 0; i < TAB_SLOTS; ++i) {
        const long L = (long)i * c.G + c.bid; if (L >= total) break;
        int wgid = (int)L; { const int q = total / 8, r = total % 8, xcd = wgid % 8, off = wgid / 8; wgid = (xcd < r ? xcd * (q + 1) : r * (q + 1) + (xcd - r) * q) + off; }
        const int rbg = wgid / NT, pn = wgid % NT;
        int lo = 0, hi = NE1;
        while (hi - lo > 1) { const int mid = (lo + hi) >> 1; if (pref[mid] <= rbg) lo = mid; else hi = mid; }
        const int e = lo, rb = rbg - pref[e], n = e < NE ? cnt[e] : T;
        if (c.tid == 0) desc[i] = (e << 12) | (rb << 4) | pn;
        if (c.tid < 256) { const int r = rb * 256 + c.tid; int s = -1; if (r < n) s = (e < NE) ? list[(size_t)e * LISTCAP + r] : TK + r; tab[i * 256 + c.tid] = s; }
    }
    __syncthreads();
}
struct EpiMoeGU {
    static constexpr bool PERM = true;
    bf16_t* H; LAS int* tab;
    __device__ __forceinline__ void operator()(const f32x4 (&acc)[2][2][4][2], const g8::Unit& u, int wr, int wc, int fr, int fq) const {
#pragma unroll
        for (int ai = 0; ai < 2; ++ai)
#pragma unroll
            for (int m = 0; m < 4; ++m) { const int r = ai * 128 + wr * 64 + m * 16 + fr; const int s = tab[u.aux * 256 + r];
                if (s >= 0) { u32x4 w;
#pragma unroll
                    for (int n = 0; n < 2; ++n) { const f32x4 g = acc[ai][0][m][n], up = acc[ai][1][m][n];
                        w[2 * n] = pk2(siluf_(g[0]) * up[0], siluf_(g[1]) * up[1]); w[2 * n + 1] = pk2(siluf_(g[2]) * up[2], siluf_(g[3]) * up[3]); }
                    *(u32x4*)(H + (size_t)s * ED + u.pn * 128 + wc * 32 + fq * 8) = w; } }
    }
};
struct EpiMoeDN {
    static constexpr bool PERM = true;
    bf16_t* Y; const float* gate; LAS int* tab;
    __device__ __forceinline__ void operator()(const f32x4 (&acc)[2][2][4][2], const g8::Unit& u, int wr, int wc, int fr, int fq) const {
#pragma unroll
        for (int ai = 0; ai < 2; ++ai)
#pragma unroll
            for (int m = 0; m < 4; ++m) { const int r = ai * 128 + wr * 64 + m * 16 + fr; const int s = tab[u.aux * 256 + r];
                if (s >= 0) { const float gt = gate[s];
#pragma unroll
                    for (int bj = 0; bj < 2; ++bj) { u32x4 w;
#pragma unroll
                        for (int n = 0; n < 2; ++n) { const f32x4 a = acc[ai][bj][m][n] * gt; w[2 * n] = pk2(a[0], a[1]); w[2 * n + 1] = pk2(a[2], a[3]); }
                        *(u32x4*)(Y + (size_t)s * D + u.pn * 256 + bj * 128 + wc * 32 + fq * 8) = w; } } }
    }
};
__device__ __forceinline__ void phase_moe_gu(const Ctx& c, int L) {
    MoeOrder S; S.Abase = (const char*)(c.ws + WS_XB); S.Bbase = (const char*)(c.ws + WS_WGU) + (size_t)L * NE1 * 512 * D * 2; S.Bstride = (size_t)512 * D * 2; S.K = D; S.mode = 0;
    moe_setup(c, S, (const int*)(c.ws + CTL_CNT) + L * NE, 2);
    EpiMoeGU E{(bf16_t*)(c.ws + WS_HID), S.tab};
    g8::gemm_phase<EpiMoeGU, MoeOrder>(c.lds + LDS_STAGE, D, S, E);
}
__device__ __forceinline__ void phase_moe_dn(const Ctx& c, int L) {
    MoeOrder S; S.Abase = (const char*)(c.ws + WS_HID); S.Bbase = (const char*)(c.ws + WS_WDN) + (size_t)L * NE1 * D * ED * 2; S.Bstride = (size_t)D * ED * 2; S.K = ED; S.mode = 1;
    moe_setup(c, S, (const int*)(c.ws + CTL_CNT) + L * NE, 4);
    EpiMoeDN E{(bf16_t*)(c.ws + WS_U1), (const float*)(c.ws + WS_GATE), S.tab};
    g8::gemm_phase<EpiMoeDN, MoeOrder>(c.lds + LDS_STAGE, ED, S, E);
}

constexpr int PH_PER_LAYER = 12;
constexpr int N_PHASES = 1 + 4 * PH_PER_LAYER;

__global__ void __launch_bounds__(NTHREADS, 2) fwd_kernel(Params p) {
    extern __shared__ __attribute__((aligned(16))) unsigned char lds_raw[];
    LAS unsigned char* const lds0 = (LAS unsigned char*)lds_raw;
    volatile LAS unsigned* misc = (volatile LAS unsigned*)(lds0 + LDS_MISC);
    if (threadIdx.x < 4) misc[threadIdx.x] = 0u;
    __syncthreads();
    const int lo = p.ph_lo, hi = p.ph_hi;
    XcdBarrier bar; bar.bar = (unsigned*)(p.ws + WS_CTL); bar.x = 0; bar.st = misc;
    if (hi - lo > 1) bar = xcd_barrier_post((unsigned*)(p.ws + WS_CTL), misc);
#define MKCTX() Ctx c; { int tid_ = threadIdx.x; asm volatile("" : "+v"(tid_)); int bid_ = blockIdx.x; asm volatile("" : "+s"(bid_)); unsigned long long ws_ = (unsigned long long)p.ws; asm volatile("" : "+s"(ws_)); \
        c.in = p.in; c.out = p.out; c.ws = (unsigned char*)ws_; c.lds = lds0; c.tid = tid_; c.lane = tid_ & 63; c.wid = __builtin_amdgcn_readfirstlane(tid_ >> 6); c.bid = bid_; c.G = gridDim.x; \
        c.gtid = c.bid * NTHREADS + c.tid; c.gthreads = c.G * NTHREADS; c.gw = c.bid * 8 + c.wid; c.nwaves = c.G * 8; } unsigned char* const ws = c.ws; (void)ws
    int id = 0;
#ifndef PMASK
#define PMASK 0xffffffffu
#endif
#define PHASE(k, body) do { if (((PMASK >> (k)) & 1u) && lo <= id && id < hi) { MKCTX(); body; if (id + 1 < hi) xcd_barrier(bar); } ++id; } while (0)
    PHASE(0, phase_convert(c));
#pragma unroll 1
    for (int L = 0; L < 4; ++L) {
        const int j = L >> 1; const bool cd = (L & 1);
        if (cd) {
            PHASE(1, phase_dense(c, (const bf16_t*)(ws + WS_XB), (const bf16_t*)(ws + WS_WCDIN + (size_t)j * CD_IN * D * 2), T, CD_IN, D, (float*)(ws + WS_U1), CD_IN, c.in[7] + (size_t)j * CD_IN));
        } else {
            PHASE(2, phase_ab_inproj(c, j));
        }
        if (!cd) { PHASE(3, phase_ab_p1(c)); PHASE(4, phase_ab_p2(c, j)); PHASE(16, phase_ab_p3(c)); id += 1; }
        else     { PHASE(5, phase_cd_act(c, j)); PHASE(6, phase_cd_mix(c, j)); PHASE(7, phase_cd_scan1(c)); PHASE(15, phase_cd_scan2(c)); }
        {
            const size_t Woff = cd ? WS_WCDOUT + (size_t)j * D * CD_OUT * 2 : WS_WABOUT + (size_t)j * D * AB_OUT * 2;
            const int K = cd ? CD_OUT : AB_OUT; const float* bias = cd ? p.in[18] + (size_t)j * D : p.in[5] + (size_t)j * D;
            PHASE(8, phase_dense(c, (const bf16_t*)(ws + WS_YCAT), (const bf16_t*)(ws + Woff), T, D, K, (float*)(ws + WS_H), D, bias));
        }
        PHASE(9, phase_ln<false>(c, p.in[19] + (size_t)L * D, p.in[20] + (size_t)L * D, (float*)(ws + WS_X)));
        PHASE(10, phase_dense(c, (const bf16_t*)(ws + WS_XB), (const bf16_t*)(ws + WS_WRT) + (size_t)L * 256 * D, T, 256, D, (float*)(ws + WS_ZR), 256, nullptr));
        PHASE(11, phase_route(c, L));
        PHASE(12, phase_moe_gu(c, L));
        PHASE(13, phase_moe_dn(c, L));
        PHASE(14, phase_ln<true>(c, p.in[29] + (size_t)L * D, p.in[30] + (size_t)L * D, L == 3 ? p.out : (float*)(ws + WS_X)));
    }
#undef PHASE
}

extern "C" void kernel_launch(void* const* d_in, const int* in_sizes, int n_in, void* d_out, int out_size, void* d_ws, size_t ws_size, hipStream_t stream) {
    static int grid = 0;
    if (grid == 0) {
        if (n_in != 31 || out_size != T * D || ws_size < WS_END) { fprintf(stderr, "kernel_launch: unexpected shapes (n_in %d out %d ws %zu need %zu)\n", n_in, out_size, ws_size, (size_t)WS_END); grid = -1; return; }
        int dev = 0, cus = 0, per_cu = 0;
        if (hipGetDevice(&dev) != hipSuccess || hipDeviceGetAttribute(&cus, hipDeviceAttributeMultiprocessorCount, dev) != hipSuccess) { grid = -1; return; }
        if (hipFuncSetAttribute((const void*)fwd_kernel, hipFuncAttributeMaxDynamicSharedMemorySize, LDS_BYTES) != hipSuccess) { fprintf(stderr, "kernel_launch: hipFuncSetAttribute failed\n"); grid = -1; return; }
        if (hipOccupancyMaxActiveBlocksPerMultiprocessor(&per_cu, (const void*)fwd_kernel, NTHREADS, LDS_BYTES) != hipSuccess || per_cu < 1) fprintf(stderr, "kernel_launch: occupancy query says %d\n", per_cu);
        (void)hipGetLastError();
        grid = cus;
    }
    if (grid < 0) return;
    (void)hipMemsetAsync((char*)d_ws + WS_CTL, 0, CTL_BYTES, stream);
    Params p{};
    for (int i = 0; i < 31; ++i) p.in[i] = (const float*)d_in[i];
    p.out = (float*)d_out; p.ws = (unsigned char*)d_ws;
#if N_LAUNCH_MODE == 1
    p.ph_lo = 0; p.ph_hi = N_PHASES;
    hipLaunchKernelGGL(fwd_kernel, dim3(grid), dim3(NTHREADS), LDS_BYTES, stream, p);
#else
    for (int i = 0; i < N_PHASES; ++i) { p.ph_lo = i; p.ph_hi = i + 1; hipLaunchKernelGGL(fwd_kernel, dim3(grid), dim3(NTHREADS), LDS_BYTES, stream, p); }
#endif
}
```

```cpp
#include <hip/hip_runtime.h>
#include <cstdio>
#include <cstdint>

#define LAS __attribute__((address_space(3)))
typedef unsigned short bf16_t;
typedef short bf16x8 __attribute__((ext_vector_type(8)));
typedef float f32x4 __attribute__((ext_vector_type(4)));
typedef float f32x2 __attribute__((ext_vector_type(2)));
typedef unsigned u32x4 __attribute__((ext_vector_type(4)));
typedef unsigned u32x2 __attribute__((ext_vector_type(2)));

constexpr int T = 16384, D = 1024, SEQ = 8192;
constexpr int AB_IN = 4352, AB_OUT = 2048, CD_IN = 4608, CD_OUT = 2304;
constexpr int NE = 128, NE1 = 129, TOPK = 8, ED = 256;
constexpr int TK = T * TOPK;
constexpr int NSLOT = TK + T;
constexpr int LISTCAP = 16384;
constexpr float ALPHA = 1.681792830507429f;
constexpr float LN_EPS = 1e-5f;

#ifndef N_LAUNCH_MODE
#define N_LAUNCH_MODE 1
#endif

constexpr size_t al256(size_t x) { return (x + 255) & ~(size_t)255; }
constexpr size_t WS_CTL    = 0;
constexpr size_t CTL_BYTES = 65536;
constexpr size_t CTL_CNT   = 32768;
constexpr size_t WS_WABIN  = CTL_BYTES;
constexpr size_t WS_WABOUT = WS_WABIN  + al256((size_t)2 * AB_IN * D * 2);
constexpr size_t WS_WCDIN  = WS_WABOUT + al256((size_t)2 * D * AB_OUT * 2);
constexpr size_t WS_WCDOUT = WS_WCDIN  + al256((size_t)2 * CD_IN * D * 2);
constexpr size_t WS_WRT    = WS_WCDOUT + al256((size_t)2 * D * CD_OUT * 2);
constexpr size_t WS_WGU    = WS_WRT    + al256((size_t)4 * 256 * D * 2);
constexpr size_t WS_WDN    = WS_WGU    + al256((size_t)4 * NE1 * 512 * D * 2);
constexpr size_t WS_X      = WS_WDN    + al256((size_t)4 * NE1 * D * ED * 2);
constexpr size_t WS_XB     = WS_X      + al256((size_t)T * D * 4);
constexpr size_t WS_U1     = WS_XB     + al256((size_t)T * D * 2);
constexpr size_t U1_BYTES  = al256((size_t)NSLOT * D * 2) > al256((size_t)T * CD_IN * 4) ? al256((size_t)NSLOT * D * 2) : al256((size_t)T * CD_IN * 4);
constexpr size_t WS_U2     = WS_U1     + U1_BYTES;
constexpr size_t U2_BYTES  = al256((size_t)T * 1280 * 4 * 3);
constexpr size_t WS_YCAT   = WS_U2     + U2_BYTES;
constexpr size_t WS_H      = WS_YCAT   + al256((size_t)T * CD_OUT * 2);
constexpr size_t WS_ZR     = WS_H      + al256((size_t)T * D * 4);
constexpr size_t WS_HID    = WS_ZR     + al256((size_t)T * 256 * 4);
constexpr size_t WS_LIST   = WS_HID    + al256((size_t)NSLOT * ED * 2);
constexpr size_t WS_GATE   = WS_LIST   + al256((size_t)NE * LISTCAP * 4);
constexpr size_t WS_ROPEA  = WS_GATE   + al256((size_t)NSLOT * 4);
constexpr size_t WS_ROPER  = WS_ROPEA  + al256((size_t)SEQ * 32 * 8);
constexpr size_t WS_BIASP  = WS_ROPER  + al256((size_t)SEQ * 64 * 8);
constexpr size_t WS_WLRU   = WS_BIASP  + al256((size_t)2 * AB_IN * 4);
constexpr size_t WS_SPL    = WS_WLRU   + al256((size_t)2 * 5 * 2 * 65536 * 2);
constexpr size_t WS_END    = WS_SPL    + al256((size_t)2 * 1280 * 4);
constexpr size_t CD_GU = WS_U1, CD_GVT = WS_U1 + 32 * (1024 * 1024), CD_GG = WS_U1 + 64 * (1024 * 1024), CD_XR = WS_U1 + 104 * (1024 * 1024), CD_STATS = WS_U1 + 144 * (1024 * 1024);
constexpr size_t MB = 1024 * 1024;
constexpr size_t AB_QB = WS_U1, AB_KB = WS_U1 + 32 * MB, AB_VT = WS_U1 + 36 * MB, AB_RQB = WS_U1 + 40 * MB, AB_RKB = WS_U1 + 56 * MB, AB_RKDT = WS_U1 + 72 * MB,
                 AB_RVT = WS_U1 + 88 * MB, AB_RGB = WS_U1 + 120 * MB, AB_KV = WS_U1 + 152 * MB  , AB_SPREV = WS_U1 + 216 * MB  ;
static_assert(AB_SPREV + 32 * MB <= WS_U1 + U1_BYTES, "U1 map");

__device__ __forceinline__ float bf2f(bf16_t b) { return __uint_as_float(((unsigned)b) << 16); }
__device__ __forceinline__ bf16_t f2bf(float f) { unsigned u = __float_as_uint(f); u += 0x7FFFu + ((u >> 16) & 1u); return (bf16_t)(u >> 16); }
__device__ __forceinline__ unsigned pk2(float lo, float hi) { return (unsigned)f2bf(lo) | ((unsigned)f2bf(hi) << 16); }
__device__ __forceinline__ float wave_sum(float v) {
#pragma unroll
    for (int o = 32; o; o >>= 1) v += __shfl_xor(v, o);
    return v; }
__device__ __forceinline__ float wave_max(float v) {
#pragma unroll
    for (int o = 32; o; o >>= 1) v = fmaxf(v, __shfl_xor(v, o));
    return v; }
__device__ __forceinline__ float gelu_tanh(float x) { const float u = 0.7978845608028654f * (x + 0.044715f * x * x * x); return 0.5f * x * (1.f + tanhf(u)); }
__device__ __forceinline__ float sigmoidf_(float x) { return 1.f / (1.f + __expf(-x)); }
__device__ __forceinline__ float siluf_(float x) { return x / (1.f + __expf(-x)); }

#define XB_TMO      128
#define XB_XCNT(j)  (256  + 64 * (j))
#define XB_XSUB(j)  (1280 + 64 * (j))
#define XB_XGEN(j)  (2304 + 64 * (j))
#define XB_TOP      3328
#define XB_TOPGEN   3392
#define XCD_BAR_WORDS 3456
#define XB_SPIN_CAP (1u << 22)

__device__ __forceinline__ unsigned xb_ld(unsigned* p)              { return __hip_atomic_load(p, __ATOMIC_RELAXED, __HIP_MEMORY_SCOPE_AGENT); }
__device__ __forceinline__ unsigned xb_add(unsigned* p, unsigned v) { return __hip_atomic_fetch_add(p, v, __ATOMIC_RELAXED, __HIP_MEMORY_SCOPE_AGENT); }
__device__ __forceinline__ unsigned xb_xcc_id() { return (unsigned)__builtin_amdgcn_s_getreg((3 << 11) | 20) & 0xFu; }
#define XB_SPIN(cond, bar) do { unsigned _sp = 0; while (cond) { __builtin_amdgcn_s_sleep(1); \
    if ((++_sp & 255u) == 0u) { if (xb_ld(&(bar)[XB_TMO])) break; if (_sp > XB_SPIN_CAP) { atomicAdd(&(bar)[XB_TMO], 1u); break; } } } } while (0)

struct XcdBarrier { unsigned* bar; unsigned x; volatile LAS unsigned* st; };

__device__ __forceinline__ XcdBarrier xcd_barrier_post(unsigned* bar, volatile LAS unsigned* st) {
    XcdBarrier b; b.bar = bar; b.x = xb_xcc_id(); b.st = st;
    if (threadIdx.x == 0) (void)xb_add(&bar[XB_XCNT(b.x)], 1u);
    return b;
}
__device__ __forceinline__ void xcd_barrier_complete(unsigned* bar, unsigned x, unsigned& nloc, unsigned& nx) {
    const unsigned G = gridDim.x * gridDim.y * gridDim.z;
    unsigned sum, cnt, mine, sp = 0u;
    for (;;) {
        sum = 0u; cnt = 0u; mine = 0u;
#pragma unroll
        for (unsigned j = 0; j < 16; ++j) { const unsigned c = xb_ld(&bar[XB_XCNT(j)]); sum += c; cnt += (c > 0u) ? 1u : 0u; mine = (j == x) ? c : mine; }
        if (sum == G) break;
        __builtin_amdgcn_s_sleep(1);
        if ((++sp & 255u) == 0u) { if (xb_ld(&bar[XB_TMO])) break; if (sp > XB_SPIN_CAP) { atomicAdd(&bar[XB_TMO], 1u); break; } }
    }
    nloc = mine > 0u ? mine : 1u; nx = cnt > 0u ? cnt : 1u;
}
__device__ __forceinline__ void xcd_barrier(const XcdBarrier& b) {
    asm volatile("s_waitcnt vmcnt(0)" ::: "memory");
    __syncthreads();
    if (threadIdx.x == 0) {
        unsigned* bar = b.bar;
        __builtin_amdgcn_s_waitcnt(0);
        unsigned nloc = b.st[0], nx = b.st[1];
        if (nloc == 0u) { xcd_barrier_complete(bar, b.x, nloc, nx); b.st[0] = nloc; b.st[1] = nx; }
        const unsigned old = xb_add(&bar[XB_XSUB(b.x)], 1u);
        const unsigned gen = old / nloc;
        if (old + 1u == (gen + 1u) * nloc) {
            __builtin_amdgcn_fence(__ATOMIC_RELEASE, "agent");
            asm volatile("s_waitcnt vmcnt(0)" ::: "memory");
            const unsigned og = xb_add(&bar[XB_TOP], 1u);
            const unsigned tg = og / nx;
            if (og + 1u == (tg + 1u) * nx) xb_add(&bar[XB_TOPGEN], 1u);
            else XB_SPIN(xb_ld(&bar[XB_TOPGEN]) == tg, bar);
            __builtin_amdgcn_fence(__ATOMIC_ACQUIRE, "agent");
            xb_add(&bar[XB_XGEN(b.x)], 1u);
            asm volatile("s_waitcnt vmcnt(0)" ::: "memory");
        } else {
            XB_SPIN(xb_ld(&bar[XB_XGEN(b.x)]) == gen, bar);
            __builtin_amdgcn_fence(__ATOMIC_ACQUIRE, "agent");
            asm volatile("s_waitcnt vmcnt(0)" ::: "memory");
        }
    }
    __syncthreads();
}

namespace g8 {
constexpr int BM = 256, BK = 64, HALF = 128, HTB = HALF * BK * 2, STAGE_BYTES = 8 * HTB, NXCD = 8, WGM = 8;
__device__ __forceinline__ int lds_byte(int r, int c) { const int st = (r >> 4) * 2 + (c >> 5), rr = r & 15, cc = c & 31, ob = rr * 64 + cc * 2; return st * 1024 + (ob ^ (((ob >> 9) & 1) << 5)); }
__device__ __forceinline__ void stage_rc(int b, int& R, int& C) { const int st = b / 1024, sb = b % 1024, swz = sb ^ (((sb >> 9) & 1) << 5); R = (st >> 1) * 16 + swz / 64; C = (st & 1) * 32 + (swz % 64) / 2; }
__device__ __forceinline__ int perm32(int rho) { const int n = rho >> 4, i = rho & 15; return 8 * (i >> 2) + 4 * n + (i & 3); }

struct Unit { const char* A; const char* B; int pm, pn, aux; };

struct DenseOrder {
    const char* A; const char* Bt; int nM, nN, nwg, G, c, K;
    __device__ void init(const void* A_, const void* Bt_, int M, int N, int K_, int G_, int c_) { A = (const char*)A_; Bt = (const char*)Bt_; nM = M / BM; nN = N / BM; nwg = nM * nN; G = G_; c = c_; K = K_; }
    __device__ __forceinline__ bool next(int i, Unit& u) const {
        const long L = (long)i * G + c; if (L >= nwg) return false;
        int wgid = (int)L; { const int q = nwg / NXCD, r = nwg % NXCD, xcd = wgid % NXCD, off = wgid / NXCD; wgid = (xcd < r ? xcd * (q + 1) : r * (q + 1) + (xcd - r) * q) + off; }
        const int nig = WGM * nN, gid = wgid / nig, fm = gid * WGM, gsz = (nM - fm) < WGM ? (nM - fm) : WGM;
        u.pm = fm + ((wgid % nig) % gsz); u.pn = (wgid % nig) / gsz; u.aux = 0;
        u.A = A + (size_t)u.pm * BM * K * 2; u.B = Bt + (size_t)u.pn * BM * K * 2; return true;
    }
    __device__ __forceinline__ void aoff(const Unit&, int tid, unsigned (&o)[2][2]) const {
#pragma unroll
        for (int i = 0; i < 2; ++i) { int R, C; stage_rc(tid * 16 + i * 8192, R, C);
            o[0][i] = (unsigned)(R * K + C) * 2u; o[1][i] = (unsigned)((R + HALF) * K + C) * 2u; }
    }
};

__device__ __forceinline__ unsigned cvt_pk_bf16(float lo, float hi) { unsigned r; asm volatile("v_cvt_pk_bf16_f32 %0, %1, %2" : "=v"(r) : "v"(lo), "v"(hi)); return r; }

struct EpiF32 {
    static constexpr bool PERM = false;
    float* C; int ldc; const float* bias;
    __device__ __forceinline__ void operator()(const f32x4 (&acc)[2][2][4][2], const Unit& u, int wr, int wc, int fr, int fq) const {
        const int row0 = u.pm * BM + wr * 64 + fr, col0 = u.pn * BM + wc * 32 + 4 * fq;
        f32x4 bv[2][2];
#pragma unroll
        for (int bj = 0; bj < 2; ++bj)
#pragma unroll
            for (int n = 0; n < 2; ++n) bv[bj][n] = bias ? *(const f32x4*)(bias + col0 + bj * HALF + n * 16) : (f32x4){0.f, 0.f, 0.f, 0.f};
#pragma unroll
        for (int ai = 0; ai < 2; ++ai)
#pragma unroll
            for (int m = 0; m < 4; ++m) { float* rowp = C + (size_t)(row0 + ai * HALF + m * 16) * ldc + col0;
#pragma unroll
                for (int bj = 0; bj < 2; ++bj)
#pragma unroll
                    for (int n = 0; n < 2; ++n) *(f32x4*)(rowp + bj * HALF + n * 16) = acc[ai][bj][m][n] + bv[bj][n]; }
    }
};

template <class Epi, class Sched>
__device__ __forceinline__ void gemm_phase(LAS unsigned char* lds, const int K, const Sched& S, const Epi& E) {
    int tid_ = threadIdx.x; asm volatile("" : "+v"(tid_));
    const int tid = tid_, wid = __builtin_amdgcn_readfirstlane(tid >> 6), lane = tid & 63, wr = wid >> 2, wc = wid & 3, fr = lane & 15, fq = lane >> 4;
    const int nt = K / BK;
    unsigned voffB[2];
#pragma unroll
    for (int i = 0; i < 2; ++i) { int R, C; stage_rc(tid * 16 + i * 8192, R, C); const int Rb = Epi::PERM ? ((R & ~31) + perm32(R & 31)) : R;
        voffB[i] = (unsigned)(Rb * K + C) * 2u; }
    const size_t kstep = (size_t)(BK * 2);
    const size_t hstep = (size_t)HALF * K * 2;
    const unsigned ldsw = (unsigned)wid * 1024u;
    const int aoff = lds_byte(wr * 64 + fr, fq * 8), boff = lds_byte(wc * 32 + fr, fq * 8);
#define G8_SA(b, h) (((b) * 2 + (h)) * HTB)
#define G8_SB(b, h) ((4 + (b) * 2 + (h)) * HTB)
#define G8_STAGE(bufoff, gbase, voff) do { _Pragma("unroll") for (int _i = 0; _i < 2; ++_i) \
        __builtin_amdgcn_global_load_lds((const unsigned*)((const char*)(gbase) + (voff)[_i]), (LAS unsigned*)(lds + (bufoff) + ldsw + _i * 8192), 16, 0, 0); } while (0)
#define G8_LDA(dst, b, h) do { _Pragma("unroll") for (int m = 0; m < 4; ++m) _Pragma("unroll") for (int k = 0; k < 2; ++k) dst[m][k] = *(const LAS bf16x8*)(lds + G8_SA(b, h) + aoff + m * 2048 + k * 1024); } while (0)
#define G8_LDB(dst, b, h) do { _Pragma("unroll") for (int n = 0; n < 2; ++n) _Pragma("unroll") for (int k = 0; k < 2; ++k) dst[n][k] = *(const LAS bf16x8*)(lds + G8_SB(b, h) + boff + n * 2048 + k * 1024); } while (0)
#define G8_MMA(ai, bj, At, Bt) do { __builtin_amdgcn_s_setprio(1); _Pragma("unroll") for (int m = 0; m < 4; ++m) _Pragma("unroll") for (int n = 0; n < 2; ++n) _Pragma("unroll") for (int k = 0; k < 2; ++k) \
        acc[ai][bj][m][n] = __builtin_amdgcn_mfma_f32_16x16x32_bf16(Bt[n][k], At[m][k], acc[ai][bj][m][n], 0, 0, 0); __builtin_amdgcn_s_setprio(0); } while (0)
#define G8_WAIT_V(n) asm volatile("s_waitcnt vmcnt(" #n ")" ::: "memory")
#define G8_WAIT_L(n) asm volatile("s_waitcnt lgkmcnt(" #n ")" ::: "memory")
#define G8_BAR __builtin_amdgcn_s_barrier()
#define G8_SCHED __builtin_amdgcn_sched_barrier(0)
    Unit cur, nxt; int ui = 0;
    if (!S.next(0, cur)) return;
    f32x4 acc[2][2][4][2];
#pragma unroll
    for (int a = 0; a < 2; ++a)
#pragma unroll
        for (int b = 0; b < 2; ++b)
#pragma unroll
            for (int m = 0; m < 4; ++m)
#pragma unroll
                for (int n = 0; n < 2; ++n) acc[a][b][m][n] = (f32x4){0.f, 0.f, 0.f, 0.f};
    bf16x8 At[4][2], B0[2][2], B1[2][2];
    unsigned oc[2][2];
    S.aoff(cur, tid, oc);
    const char* cA = cur.A; const char* cB = cur.B;
    G8_STAGE(G8_SB(0, 0), cB, voffB); G8_STAGE(G8_SA(0, 0), cA, oc[0]); G8_STAGE(G8_SB(0, 1), cB + hstep, voffB); G8_STAGE(G8_SA(0, 1), cA, oc[1]);
    if (wr == 1) G8_BAR;
    G8_WAIT_V(4); G8_BAR;
    G8_STAGE(G8_SB(1, 0), cB + kstep, voffB); G8_STAGE(G8_SA(1, 0), cA + kstep, oc[0]); G8_STAGE(G8_SB(1, 1), cB + hstep + kstep, voffB);
    G8_WAIT_V(6); G8_BAR;
    for (;;) {
        const bool has_next = S.next(ui + 1, nxt);
        const char* nA = has_next ? nxt.A : cA; const char* nB = has_next ? nxt.B : cB;
#pragma unroll 1
        for (int t = 0; t < nt; t += 2) {
            const bool last = (t == nt - 2);
            const char* a1 = cA + (size_t)(t + 1) * kstep;
            const char* a2 = last ? nA : cA + (size_t)(t + 2) * kstep; const char* b2 = last ? nB : cB + (size_t)(t + 2) * kstep;
            const char* a3 = a2 + kstep; const char* b3 = b2 + kstep;
            G8_LDB(B0, 0, 0); G8_SCHED; G8_LDA(At, 0, 0); G8_STAGE(G8_SA(1, 1), a1, oc[1]);
            if (last && has_next) S.aoff(nxt, tid, oc);
            G8_WAIT_L(8); G8_BAR; G8_WAIT_L(0); G8_MMA(0, 0, At, B0); G8_BAR; G8_SCHED;
            G8_LDB(B1, 0, 1); G8_STAGE(G8_SB(0, 0), b2, voffB);
            G8_BAR; G8_WAIT_L(0); G8_MMA(0, 1, At, B1); G8_BAR;
            G8_LDA(At, 0, 1); G8_STAGE(G8_SA(0, 0), a2, oc[0]);
            G8_BAR; G8_WAIT_L(0); G8_MMA(1, 0, At, B0); G8_BAR; G8_SCHED;
            G8_STAGE(G8_SB(0, 1), b2 + hstep, voffB);
            G8_WAIT_V(6); G8_BAR; G8_MMA(1, 1, At, B1); G8_BAR;
            G8_LDB(B0, 1, 0); G8_SCHED; G8_LDA(At, 1, 0); G8_STAGE(G8_SA(0, 1), a2, oc[1]);
            G8_WAIT_L(8); G8_BAR; G8_WAIT_L(0); G8_MMA(0, 0, At, B0); G8_BAR; G8_SCHED;
            G8_LDB(B1, 1, 1); G8_STAGE(G8_SB(1, 0), b3, voffB);
            G8_BAR; G8_WAIT_L(0); G8_MMA(0, 1, At, B1); G8_BAR;
            G8_LDA(At, 1, 1); G8_STAGE(G8_SA(1, 0), a3, oc[0]);
            G8_BAR; G8_WAIT_L(0); G8_MMA(1, 0, At, B0); G8_BAR; G8_SCHED;
            G8_STAGE(G8_SB(1, 1), b3 + hstep, voffB);
            G8_WAIT_V(6); G8_BAR; G8_MMA(1, 1, At, B1); G8_BAR;
        }
        E(acc, cur, wr, wc, fr, fq);
        if (!has_next) break;
#pragma unroll
        for (int a = 0; a < 2; ++a)
#pragma unroll
            for (int b = 0; b < 2; ++b)
#pragma unroll
                for (int m = 0; m < 4; ++m)
#pragma unroll
                    for (int n = 0; n < 2; ++n) acc[a][b][m][n] = (f32x4){0.f, 0.f, 0.f, 0.f};
        cur = nxt; cA = nA; cB = nB; ++ui;
    }
    G8_WAIT_V(0);
    if (wr == 0) G8_BAR;
    G8_BAR;
#undef G8_SA
#undef G8_SB
#undef G8_STAGE
#undef G8_LDA
#undef G8_LDB
#undef G8_MMA
#undef G8_WAIT_V
#undef G8_WAIT_L
#undef G8_BAR
#undef G8_SCHED
}
}

constexpr int NTHREADS = 512;
constexpr int LDS_STAGE = 0;
constexpr int LDS_TAB   = g8::STAGE_BYTES;
constexpr int TAB_SLOTS = 12;
constexpr int LDS_DESC  = LDS_TAB + TAB_SLOTS * 256 * 4;
constexpr int LDS_PREF  = LDS_DESC + 64;
constexpr int LDS_MISC  = LDS_PREF + 132 * 4 + 48;
constexpr int LDS_BYTES = 147456;
static_assert(LDS_MISC % 16 == 0 && LDS_MISC + 64 <= LDS_BYTES, "LDS map");

struct Params { const float* in[31]; float* out; unsigned char* ws; int ph_lo, ph_hi; };

struct Ctx {
    const float* const* in; float* out; unsigned char* ws; LAS unsigned char* lds;
    int tid, lane, wid, bid, G, gtid, gthreads, gw, nwaves;
};

__device__ __forceinline__ int ab_phys(int n) {
    if (n < 1024) { const int hd = n >> 6, jj = n & 63; return (hd >> 2) * 256 + (jj >> 5) * 128 + (hd & 3) * 32 + (jj & 31); }
    if (n < 1152) { const int nn = n - 1024, hh = nn >> 6, jj = nn & 63; return 1024 + (jj >> 5) * 128 + hh * 32 + (jj & 31); }
    if (n < 1280) { const int vv = n - 1152; return 1024 + (vv >> 6) * 128 + 64 + (vv & 63); }
    if (n < 2304) { const int base = n < 1792 ? 1280 : 1792, nn = n - base, h = nn >> 7, jj = nn & 127; return base + (h >> 1) * 256 + (jj >> 6) * 128 + (h & 1) * 64 + (jj & 63); }
    return n;
}
template <class DstFn>
__device__ __forceinline__ void convert_T(const Ctx& c, const float* src, int nmat, int K, int N, DstFn dstfn) {
    LAS float* tile = (LAS float*)(c.lds);
    const int tk = K / 64, tn = N / 64; const long ntiles = (long)nmat * tk * tn;
    for (long tix = c.bid; tix < ntiles; tix += c.G) {
        const int m = (int)(tix / (tk * tn)); const int rem = (int)(tix % (tk * tn)); const int kt = rem / tn, nt = rem % tn;
        const float* s = src + (size_t)m * K * N + (size_t)(kt * 64) * N + nt * 64;
#pragma unroll
        for (int i = 0; i < 2; ++i) { const int k = (c.tid >> 4) + 32 * i, n4 = (c.tid & 15) * 4; const f32x4 v = *(const f32x4*)(s + (size_t)k * N + n4);
            tile[k * 65 + n4 + 0] = v[0]; tile[k * 65 + n4 + 1] = v[1]; tile[k * 65 + n4 + 2] = v[2]; tile[k * 65 + n4 + 3] = v[3]; }
        __syncthreads();
        { const int n = c.tid >> 3, k8 = (c.tid & 7) * 8; u32x4 w;
          w[0] = pk2(tile[(k8 + 0) * 65 + n], tile[(k8 + 1) * 65 + n]); w[1] = pk2(tile[(k8 + 2) * 65 + n], tile[(k8 + 3) * 65 + n]);
          w[2] = pk2(tile[(k8 + 4) * 65 + n], tile[(k8 + 5) * 65 + n]); w[3] = pk2(tile[(k8 + 6) * 65 + n], tile[(k8 + 7) * 65 + n]);
          bf16_t* d = dstfn(m, nt * 64 + n) + kt * 64 + k8; *(u32x4*)d = w; }
        __syncthreads();
    }
}

__device__ __forceinline__ void phase_convert(const Ctx& c) {
    unsigned char* ws = c.ws;
    { const float* x = c.in[0]; float* xo = (float*)(ws + WS_X); bf16_t* xb = (bf16_t*)(ws + WS_XB);
      for (long i = c.gtid; i < (long)T * D / 4; i += c.gthreads) { const f32x4 v = *(const f32x4*)(x + i * 4); *(f32x4*)(xo + i * 4) = v; u32x2 w; w[0] = pk2(v[0], v[1]); w[1] = pk2(v[2], v[3]); *(u32x2*)(xb + i * 4) = w; } }
    { bf16_t* wrt = (bf16_t*)(ws + WS_WRT); for (long i = c.gtid; i < (long)4 * 128 * D / 8; i += c.gthreads) { const long l = i / (128 * D / 8), r = i % (128 * D / 8); *(u32x4*)(wrt + (size_t)l * 256 * D + (size_t)128 * D + r * 8) = (u32x4){0u, 0u, 0u, 0u}; }
      float* gate = (float*)(ws + WS_GATE); for (int i = c.gtid; i < T; i += c.gthreads) gate[TK + i] = 1.f;
      f32x2* ra = (f32x2*)(ws + WS_ROPEA); f32x2* rr = (f32x2*)(ws + WS_ROPER);
      for (int i = c.gtid; i < SEQ * 96; i += c.gthreads) { const int sidx = i / 96, q = i % 96; const bool isA = q < 32; const int jx = isA ? q : q - 32;
          const float e = isA ? (float)jx * (1.f / 32.f) : (float)jx * (1.f / 63.f); const float ang = (float)sidx * exp2f(-e * 13.287712379549449f); float sn, cs; sincosf(ang, &sn, &cs);
          if (isA) ra[sidx * 32 + jx] = (f32x2){cs, sn}; else rr[sidx * 64 + jx] = (f32x2){cs, sn}; }
      float* bp = (float*)(ws + WS_BIASP); for (int i = c.gtid; i < 2 * AB_IN; i += c.gthreads) { const int m = i / AB_IN, n = i % AB_IN; bp[m * AB_IN + ab_phys(n)] = c.in[2][i]; } }
    { bf16_t* d = (bf16_t*)(ws + WS_WABIN);  convert_T(c, c.in[1], 2, D, AB_IN, [=](int m, int n) { return d + (size_t)m * AB_IN * D + (size_t)ab_phys(n) * D; }); }
    { bf16_t* d = (bf16_t*)(ws + WS_WABOUT); convert_T(c, c.in[4], 2, AB_OUT, D, [=](int m, int n) { return d + (size_t)m * D * AB_OUT + (size_t)n * AB_OUT; }); }
    { bf16_t* d = (bf16_t*)(ws + WS_WCDIN);  convert_T(c, c.in[6], 2, D, CD_IN, [=](int m, int n) { return d + (size_t)m * CD_IN * D + (size_t)n * D; }); }
    { bf16_t* d = (bf16_t*)(ws + WS_WCDOUT); convert_T(c, c.in[17], 2, CD_OUT, D, [=](int m, int n) { return d + (size_t)m * D * CD_OUT + (size_t)n * CD_OUT; }); }
    { bf16_t* d = (bf16_t*)(ws + WS_WRT);    convert_T(c, c.in[21], 4, D, NE, [=](int m, int n) { return d + (size_t)m * 256 * D + (size_t)n * D; }); }
    { bf16_t* d = (bf16_t*)(ws + WS_WGU);
      convert_T(c, c.in[23], 4 * NE, D, ED, [=](int m, int n) { return d + (size_t)((m >> 7) * NE1 + (m & 127)) * 512 * D + (size_t)((n >> 7) * 256 + (n & 127)) * D; });
      convert_T(c, c.in[24], 4 * NE, D, ED, [=](int m, int n) { return d + (size_t)((m >> 7) * NE1 + (m & 127)) * 512 * D + (size_t)((n >> 7) * 256 + 128 + (n & 127)) * D; });
      convert_T(c, c.in[26], 4, D, ED, [=](int m, int n) { return d + (size_t)(m * NE1 + NE) * 512 * D + (size_t)((n >> 7) * 256 + (n & 127)) * D; });
      convert_T(c, c.in[27], 4, D, ED, [=](int m, int n) { return d + (size_t)(m * NE1 + NE) * 512 * D + (size_t)((n >> 7) * 256 + 128 + (n & 127)) * D; }); }
    { bf16_t* d = (bf16_t*)(ws + WS_WLRU);
      convert_T(c, c.in[12], 10, 256, 256, [=](int m, int n) { return d + (size_t)(m * 2 + 0) * 65536 + (size_t)n * 256; });
      convert_T(c, c.in[14], 10, 256, 256, [=](int m, int n) { return d + (size_t)(m * 2 + 1) * 65536 + (size_t)n * 256; });
      float* spl = (float*)(ws + WS_SPL); for (int i = c.gtid; i < 2 * 1280; i += c.gthreads) spl[i] = log1pf(expf(-c.in[16][i])); }
    { bf16_t* d = (bf16_t*)(ws + WS_WDN);
      convert_T(c, c.in[25], 4 * NE, ED, D, [=](int m, int n) { return d + (size_t)((m >> 7) * NE1 + (m & 127)) * D * ED + (size_t)n * ED; });
      convert_T(c, c.in[28], 4, ED, D, [=](int m, int n) { return d + (size_t)(m * NE1 + NE) * D * ED + (size_t)n * ED; }); }
}

__device__ __forceinline__ void phase_dense(const Ctx& c, const bf16_t* A, const bf16_t* Bt, int M, int N, int K, float* C, int ldc, const float* bias) {
    g8::DenseOrder S; S.init(A, Bt, M, N, K, c.G, c.bid);
    g8::EpiF32 E{C, ldc, bias};
    g8::gemm_phase<g8::EpiF32, g8::DenseOrder>(c.lds + LDS_STAGE, K, S, E);
}

struct EpiABIn {
    static constexpr bool PERM = true;
    const float* biasP; unsigned char* ws;
    __device__ __forceinline__ void operator()(const f32x4 (&acc)[2][2][4][2], const g8::Unit& u, int wr, int wc, int fr, int fq) const {
        const int pn = u.pn; const int colp = pn * 256 + wc * 32 + fq * 8;
        f32x4 bv[2][2];
#pragma unroll
        for (int bj = 0; bj < 2; ++bj)
#pragma unroll
            for (int n = 0; n < 2; ++n) bv[bj][n] = *(const f32x4*)(biasP + colp + bj * 128 + 4 * n);
        bf16_t* qb = (bf16_t*)(ws + AB_QB); bf16_t* kb = (bf16_t*)(ws + AB_KB); bf16_t* vT = (bf16_t*)(ws + AB_VT); bf16_t* rqb = (bf16_t*)(ws + AB_RQB); bf16_t* rkb = (bf16_t*)(ws + AB_RKB);
        bf16_t* rkdT = (bf16_t*)(ws + AB_RKDT); bf16_t* rvT = (bf16_t*)(ws + AB_RVT); bf16_t* rgb = (bf16_t*)(ws + AB_RGB);
        const f32x4* ropeA = (const f32x4*)(ws + WS_ROPEA); const f32x4* ropeR = (const f32x4*)(ws + WS_ROPER);
#pragma unroll
        for (int ai = 0; ai < 2; ++ai)
#pragma unroll
            for (int m = 0; m < 4; ++m) {
                const int t = u.pm * 256 + ai * 128 + wr * 64 + m * 16 + fr, sq = t & (SEQ - 1), b = t >> 13;
                f32x4 x[2][2];
#pragma unroll
                for (int bj = 0; bj < 2; ++bj)
#pragma unroll
                    for (int n = 0; n < 2; ++n) x[bj][n] = acc[ai][bj][m][n] + bv[bj][n];
                if (pn < 4 || (pn == 4 && wc < 2)) {
                    const int j0 = fq * 8; f32x4 o1[2], o2[2];
#pragma unroll
                    for (int n = 0; n < 2; ++n) { const f32x4 cs01 = ropeA[(sq * 32 + j0 + 4 * n) / 2], cs23 = ropeA[(sq * 32 + j0 + 4 * n) / 2 + 1];
                        const float cc[4] = {cs01[0], cs01[2], cs23[0], cs23[2]}, ss[4] = {cs01[1], cs01[3], cs23[1], cs23[3]};
#pragma unroll
                        for (int e = 0; e < 4; ++e) { o1[n][e] = x[0][n][e] * cc[e] - x[1][n][e] * ss[e]; o2[n][e] = x[1][n][e] * cc[e] + x[0][n][e] * ss[e]; } }
                    const float sc = pn < 4 ? 0.125f : 1.f;
                    u32x4 w1, w2;
#pragma unroll
                    for (int n = 0; n < 2; ++n) { w1[2 * n] = pk2(o1[n][0] * sc, o1[n][1] * sc); w1[2 * n + 1] = pk2(o1[n][2] * sc, o1[n][3] * sc); w2[2 * n] = pk2(o2[n][0] * sc, o2[n][1] * sc); w2[2 * n + 1] = pk2(o2[n][2] * sc, o2[n][3] * sc); }
                    bf16_t* dst = pn < 4 ? qb + (size_t)t * 1024 + (pn * 4 + wc) * 64 + j0 : kb + (size_t)t * 128 + wc * 64 + j0;
                    *(u32x4*)dst = w1; *(u32x4*)(dst + 32) = w2;
                } else if (pn == 4) {
                    const int d0 = (wc - 2) * 32 + fq * 8;
#pragma unroll
                    for (int bj = 0; bj < 2; ++bj)
#pragma unroll
                        for (int n = 0; n < 2; ++n)
#pragma unroll
                            for (int e = 0; e < 4; ++e) vT[((size_t)(b * 2 + bj) * 64 + d0 + 4 * n + e) * SEQ + sq] = f2bf(x[bj][n][e]);
                } else if (pn < 9) {
                    const bool isk = pn >= 7; const int h = ((pn - 5) & 1) * 2 + (wc >> 1), j0 = (wc & 1) * 32 + fq * 8; f32x4 o1[2], o2[2];
                    const float sc = isk ? 0.08838834764831845f : 1.f;
#pragma unroll
                    for (int n = 0; n < 2; ++n) { const f32x4 cs01 = ropeR[(sq * 64 + j0 + 4 * n) / 2], cs23 = ropeR[(sq * 64 + j0 + 4 * n) / 2 + 1];
                        const float cc[4] = {cs01[0], cs01[2], cs23[0], cs23[2]}, ss[4] = {cs01[1], cs01[3], cs23[1], cs23[3]};
#pragma unroll
                        for (int e = 0; e < 4; ++e) { o1[n][e] = (x[0][n][e] * cc[e] - x[1][n][e] * ss[e]) * sc; o2[n][e] = (x[1][n][e] * cc[e] + x[0][n][e] * ss[e]) * sc; } }
                    u32x4 w1, w2;
#pragma unroll
                    for (int n = 0; n < 2; ++n) { w1[2 * n] = pk2(o1[n][0], o1[n][1]); w1[2 * n + 1] = pk2(o1[n][2], o1[n][3]); w2[2 * n] = pk2(o2[n][0], o2[n][1]); w2[2 * n + 1] = pk2(o2[n][2], o2[n][3]); }
                    bf16_t* dst = (isk ? rkb : rqb) + (size_t)t * 512 + h * 128 + j0;
                    *(u32x4*)dst = w1; *(u32x4*)(dst + 64) = w2;
                    if (isk) {
                        const float lg = log2f(1.f - exp2f(-5.f - (float)h)); const float dec = exp2f((float)(127 - (sq & 127)) * lg);
                        bf16_t* dT = rkdT + ((size_t)(b * 4 + h) * 128 + j0) * SEQ + sq;
#pragma unroll
                        for (int n = 0; n < 2; ++n)
#pragma unroll
                            for (int e = 0; e < 4; ++e) { dT[(size_t)(4 * n + e) * SEQ] = f2bf(o1[n][e] * dec); dT[(size_t)(64 + 4 * n + e) * SEQ] = f2bf(o2[n][e] * dec); }
                    }
                } else if (pn < 13) {
                    const int h = pn - 9;
#pragma unroll
                    for (int bj = 0; bj < 2; ++bj)
#pragma unroll
                        for (int n = 0; n < 2; ++n)
#pragma unroll
                            for (int e = 0; e < 4; ++e) rvT[((size_t)(b * 4 + h) * 256 + bj * 128 + wc * 32 + fq * 8 + 4 * n + e) * SEQ + sq] = f2bf(x[bj][n][e]);
                } else {
#pragma unroll
                    for (int bj = 0; bj < 2; ++bj) { u32x4 w;
#pragma unroll
                        for (int n = 0; n < 2; ++n) { w[2 * n] = pk2(siluf_(x[bj][n][0]), siluf_(x[bj][n][1])); w[2 * n + 1] = pk2(siluf_(x[bj][n][2]), siluf_(x[bj][n][3])); }
                        *(u32x4*)(rgb + (size_t)t * 1024 + (pn - 13) * 256 + bj * 128 + wc * 32 + fq * 8) = w; }
                }
            }
    }
};
__device__ __forceinline__ void phase_ab_inproj(const Ctx& c, int j) {
    g8::DenseOrder S; S.init(c.ws + WS_XB, c.ws + WS_WABIN + (size_t)j * AB_IN * D * 2, T, AB_IN, D, c.G, c.bid);
    EpiABIn E{(const float*)(c.ws + WS_BIASP) + (size_t)j * AB_IN, c.ws};
    g8::gemm_phase<EpiABIn, g8::DenseOrder>(c.lds + LDS_STAGE, D, S, E);
}

#define MFMA16(a, b, c) __builtin_amdgcn_mfma_f32_16x16x32_bf16((a), (b), (c), 0, 0, 0)
__device__ __forceinline__ bf16x8 pack8(const f32x4& lo, const f32x4& hi) { u32x4 w; w[0] = g8::cvt_pk_bf16(lo[0], lo[1]); w[1] = g8::cvt_pk_bf16(lo[2], lo[3]); w[2] = g8::cvt_pk_bf16(hi[0], hi[1]); w[3] = g8::cvt_pk_bf16(hi[2], hi[3]); return __builtin_bit_cast(bf16x8, w); }
__device__ __forceinline__ bf16x8 cat8(const u32x2& lo, const u32x2& hi) { u32x4 w; w[0] = lo[0]; w[1] = lo[1]; w[2] = hi[0]; w[3] = hi[1]; return __builtin_bit_cast(bf16x8, w); }
template <int ROWS, int RB>
__device__ __forceinline__ void tile_g2l(LAS unsigned char* dst, const unsigned char* src, size_t gs, int tid, int zrows = 0) {
    constexpr int CPR = RB / 16, TOTAL = ROWS * CPR;
#pragma unroll 4
    for (int i = tid; i < TOTAL; i += NTHREADS) { const int r = i / CPR, cc = i % CPR; u32x4 v = (u32x4){0u, 0u, 0u, 0u}; if (r >= zrows) v = *(const u32x4*)(src + (size_t)r * gs + cc * 16);
        *(LAS u32x4*)(dst + r * (RB + 16) + cc * 16) = v; }
}

__device__ __forceinline__ void attn_unit(const Ctx& c, int unit, const float* sinks) {
    const int b = unit >> 7, n = (unit >> 1) & 63, kvh = unit & 1, hd = kvh * 8 + c.wid, lane = c.lane, fr = lane & 15, fq = lane >> 4;
    const bf16_t* qb = (const bf16_t*)(c.ws + AB_QB); const bf16_t* kb = (const bf16_t*)(c.ws + AB_KB); const bf16_t* vT = (const bf16_t*)(c.ws + AB_VT); bf16_t* ycat = (bf16_t*)(c.ws + WS_YCAT);
    LAS unsigned char* Ks = c.lds; LAS unsigned char* Vs = c.lds + 256 * 144;
    const int t0 = b * SEQ + n * 128;
    __syncthreads();
    {
        const unsigned char* src = (const unsigned char*)(kb + (size_t)(t0 - 128) * 128 + kvh * 64);
        constexpr int TOTAL = 256 * 8;
#pragma unroll 4
        for (int i = c.tid; i < TOTAL; i += NTHREADS) { const int r = i >> 3, cc = i & 7; u32x4 v = (u32x4){0u, 0u, 0u, 0u}; if (n > 0 || r >= 128) v = *(const u32x4*)(src + (ptrdiff_t)r * 256 + cc * 16);
            *(LAS u32x4*)(Ks + r * 144 + cc * 16) = v; }
        const unsigned char* vsrc = (const unsigned char*)(vT + (size_t)(b * 2 + kvh) * 64 * SEQ + (n * 128 - 128));
        constexpr int TV = 64 * 32;
#pragma unroll 4
        for (int i = c.tid; i < TV; i += NTHREADS) { const int r = i >> 5, cc = i & 31; u32x4 v = (u32x4){0u, 0u, 0u, 0u}; if (n > 0 || cc >= 16) v = *(const u32x4*)(vsrc + (ptrdiff_t)r * SEQ * 2 + cc * 16);
            *(LAS u32x4*)(Vs + r * 528 + cc * 16) = v; }
    }
    __syncthreads();
    const float sink = sinks[hd];
    for (int si = 0; si < 8; ++si) {
        const int t = t0 + si * 16 + fr;
        bf16x8 qf[2];
#pragma unroll
        for (int ks = 0; ks < 2; ++ks) qf[ks] = *(const bf16x8*)(qb + (size_t)t * 1024 + hd * 64 + ks * 32 + fq * 8);
        f32x4 S[10];
#pragma unroll
        for (int nk = 0; nk < 9; ++nk) { S[nk] = (f32x4){0.f, 0.f, 0.f, 0.f};
#pragma unroll
            for (int ks = 0; ks < 2; ++ks) { const bf16x8 a = *(const LAS bf16x8*)(Ks + (16 * (si + nk) + fr) * 144 + ks * 64 + fq * 16); S[nk] = MFMA16(a, qf[ks], S[nk]); } }
        S[9] = (f32x4){0.f, 0.f, 0.f, 0.f};
        const int i = si * 16 + fr;
        float mx = sink;
#pragma unroll
        for (int nk = 0; nk < 9; ++nk)
#pragma unroll
            for (int r = 0; r < 4; ++r) { const int p = 16 * (si + nk) + 4 * fq + r; const bool ok = (p >= i + 1) && (p <= i + 128) && (n > 0 || p >= 128);
                S[nk][r] = ok ? S[nk][r] : -1e30f; mx = fmaxf(mx, S[nk][r]); }
        mx = fmaxf(mx, __shfl_xor(mx, 16)); mx = fmaxf(mx, __shfl_xor(mx, 32));
        float sum = 0.f;
#pragma unroll
        for (int nk = 0; nk < 9; ++nk)
#pragma unroll
            for (int r = 0; r < 4; ++r) { const float pv = S[nk][r] > -1e29f ? exp2f((S[nk][r] - mx) * 1.4426950408889634f) : 0.f; S[nk][r] = pv; sum += pv; }
        sum += __shfl_xor(sum, 16); sum += __shfl_xor(sum, 32);
        const float inv = 1.f / (sum + exp2f((sink - mx) * 1.4426950408889634f));
        f32x4 O[4];
#pragma unroll
        for (int nd = 0; nd < 4; ++nd) O[nd] = (f32x4){0.f, 0.f, 0.f, 0.f};
#pragma unroll
        for (int kk = 0; kk < 5; ++kk) { const bf16x8 pf = pack8(S[2 * kk], S[2 * kk + 1]);
            const int p0 = 16 * (si + 2 * kk) + 4 * fq, p1 = (kk == 4 && si == 7) ? p0 : p0 + 16;
#pragma unroll
            for (int nd = 0; nd < 4; ++nd) { const u32x2 lo = *(const LAS u32x2*)(Vs + (16 * nd + fr) * 528 + p0 * 2), hi = *(const LAS u32x2*)(Vs + (16 * nd + fr) * 528 + p1 * 2);
                O[nd] = MFMA16(cat8(lo, hi), pf, O[nd]); } }
#pragma unroll
        for (int nd = 0; nd < 4; ++nd) { u32x2 w; w[0] = pk2(O[nd][0] * inv, O[nd][1] * inv); w[1] = pk2(O[nd][2] * inv, O[nd][3] * inv);
            *(u32x2*)(ycat + (size_t)t * AB_OUT + hd * 64 + 16 * nd + 4 * fq) = w; }
    }
}

__device__ __forceinline__ void ret_kv_unit(const Ctx& c, int unit) {
    const int b = unit >> 8, n = (unit >> 2) & 63, h = unit & 3, lane = c.lane, fr = lane & 15, fq = lane >> 4, w = c.wid;
    const bf16_t* rkdT = (const bf16_t*)(c.ws + AB_RKDT); const bf16_t* rvT = (const bf16_t*)(c.ws + AB_RVT); float* kv = (float*)(c.ws + AB_KV);
    LAS unsigned char* Kd = c.lds;
    __syncthreads();
    tile_g2l<128, 256>(Kd, (const unsigned char*)(rkdT + (size_t)(b * 4 + h) * 128 * SEQ + n * 128), (size_t)SEQ * 2, c.tid);
    bf16x8 vf[2][4];
#pragma unroll
    for (int ne = 0; ne < 2; ++ne)
#pragma unroll
        for (int ks = 0; ks < 4; ++ks) vf[ne][ks] = *(const bf16x8*)(rvT + ((size_t)(b * 4 + h) * 256 + 32 * w + 16 * ne + fr) * SEQ + n * 128 + ks * 32 + fq * 8);
    __syncthreads();
    float* out = kv + ((size_t)((b * 64 + n) * 4 + h)) * 256 * 128;
#pragma unroll
    for (int nd = 0; nd < 8; ++nd) { f32x4 a0 = (f32x4){0.f, 0.f, 0.f, 0.f}, a1 = a0;
#pragma unroll
        for (int ks = 0; ks < 4; ++ks) { const bf16x8 kf = *(const LAS bf16x8*)(Kd + (16 * nd + fr) * 272 + ks * 64 + fq * 16); a0 = MFMA16(kf, vf[0][ks], a0); a1 = MFMA16(kf, vf[1][ks], a1); }
        *(f32x4*)(out + (size_t)(32 * w + fr) * 128 + 16 * nd + 4 * fq) = a0; *(f32x4*)(out + (size_t)(32 * w + 16 + fr) * 128 + 16 * nd + 4 * fq) = a1; }
}
__device__ __forceinline__ void ret_scan(const Ctx& c, int first_block, int nblocks) {
    const float* kv = (const float*)(c.ws + AB_KV); bf16_t* sp = (bf16_t*)(c.ws + AB_SPREV);
    const int nthr = nblocks * NTHREADS;
    for (int idx = (c.bid - first_block) * NTHREADS + c.tid; idx < 2 * 4 * 256 * 128 / 4; idx += nthr) {
        const int b = idx >> 15, rem = idx & 32767, h = rem >> 13;
        const float g = exp2f(128.f * log2f(1.f - exp2f(-5.f - (float)h)));
        const size_t base = (size_t)b * 64 * 131072 + (size_t)rem * 4;
        f32x4 st = (f32x4){0.f, 0.f, 0.f, 0.f};
        for (int n0 = 0; n0 < 64; n0 += 8) { f32x4 v[8];
#pragma unroll
            for (int q = 0; q < 8; ++q) v[q] = *(const f32x4*)(kv + base + (size_t)(n0 + q) * 131072);
#pragma unroll
            for (int q = 0; q < 8; ++q) { u32x2 wv; wv[0] = pk2(st[0], st[1]); wv[1] = pk2(st[2], st[3]); *(u32x2*)(sp + base + (size_t)(n0 + q) * 131072) = wv; st = st * g + v[q]; } }
    }
}
__device__ __forceinline__ void ret_out_unit(const Ctx& c, int unit) {
    const int b = unit >> 8, n = (unit >> 2) & 63, h = unit & 3, lane = c.lane, fr = lane & 15, fq = lane >> 4, w = c.wid;
    const bf16_t* rqb = (const bf16_t*)(c.ws + AB_RQB); const bf16_t* rkb = (const bf16_t*)(c.ws + AB_RKB); const bf16_t* rvT = (const bf16_t*)(c.ws + AB_RVT);
    const bf16_t* sp = (const bf16_t*)(c.ws + AB_SPREV); const bf16_t* rgb = (const bf16_t*)(c.ws + AB_RGB); bf16_t* ycat = (bf16_t*)(c.ws + WS_YCAT);
    LAS unsigned char* Kl = c.lds; LAS unsigned char* Bl = c.lds + 128 * 272;
    const int t0 = b * SEQ + n * 128; const float lg = log2f(1.f - exp2f(-5.f - (float)h));
    __syncthreads();
    tile_g2l<128, 256>(Kl, (const unsigned char*)(rkb + (size_t)t0 * 512 + h * 128), (size_t)512 * 2, c.tid);
    tile_g2l<256, 256>(Bl, (const unsigned char*)(sp + ((size_t)((b * 64 + n) * 4 + h)) * 256 * 128), (size_t)128 * 2, c.tid);
    const int t = t0 + 16 * w + fr, i = 16 * w + fr;
    bf16x8 qf[4];
#pragma unroll
    for (int ks = 0; ks < 4; ++ks) qf[ks] = *(const bf16x8*)(rqb + (size_t)t * 512 + h * 128 + ks * 32 + fq * 8);
    __syncthreads();
    bf16x8 pf[4];
#pragma unroll
    for (int kk = 0; kk < 4; ++kk) { f32x4 s2[2];
#pragma unroll
        for (int q = 0; q < 2; ++q) { const int nj = 2 * kk + q; s2[q] = (f32x4){0.f, 0.f, 0.f, 0.f};
            if (nj <= w) {
#pragma unroll
                for (int ks = 0; ks < 4; ++ks) { const bf16x8 kf = *(const LAS bf16x8*)(Kl + (16 * nj + fr) * 272 + ks * 64 + fq * 16); s2[q] = MFMA16(kf, qf[ks], s2[q]); }
#pragma unroll
                for (int r = 0; r < 4; ++r) { const int jj = 16 * nj + 4 * fq + r; s2[q][r] = (i >= jj) ? s2[q][r] * exp2f((float)(i - jj) * lg) : 0.f; } } }
        pf[kk] = pack8(s2[0], s2[1]); }
    f32x4 acc[16];
#pragma unroll
    for (int ne = 0; ne < 16; ++ne) { acc[ne] = (f32x4){0.f, 0.f, 0.f, 0.f};
#pragma unroll
        for (int ks = 0; ks < 4; ++ks) { const bf16x8 sf = *(const LAS bf16x8*)(Bl + (16 * ne + fr) * 272 + ks * 64 + fq * 16); acc[ne] = MFMA16(sf, qf[ks], acc[ne]); } }
    const float rs = exp2f((float)(i + 1) * lg);
#pragma unroll
    for (int ne = 0; ne < 16; ++ne) acc[ne] = acc[ne] * rs;
    __syncthreads();
    tile_g2l<256, 256>(Bl, (const unsigned char*)(rvT + (size_t)(b * 4 + h) * 256 * SEQ + n * 128), (size_t)SEQ * 2, c.tid);
    __syncthreads();
    const int nkk = (w >> 1) + 1;
#pragma unroll
    for (int kk = 0; kk < 4; ++kk) if (kk < nkk) {
#pragma unroll
        for (int ne = 0; ne < 16; ++ne) { const u32x2 lo = *(const LAS u32x2*)(Bl + (16 * ne + fr) * 272 + (32 * kk + 4 * fq) * 2), hi = *(const LAS u32x2*)(Bl + (16 * ne + fr) * 272 + (32 * kk + 16 + 4 * fq) * 2);
            acc[ne] = MFMA16(cat8(lo, hi), pf[kk], acc[ne]); } }
    float sm = 0.f;
#pragma unroll
    for (int ne = 0; ne < 16; ++ne) sm += acc[ne][0] + acc[ne][1] + acc[ne][2] + acc[ne][3];
    sm += __shfl_xor(sm, 16); sm += __shfl_xor(sm, 32);
    const float mean = sm * (1.f / 256.f); float sq = 0.f;
#pragma unroll
    for (int ne = 0; ne < 16; ++ne) { acc[ne] = acc[ne] - mean; sq += acc[ne][0] * acc[ne][0] + acc[ne][1] * acc[ne][1] + acc[ne][2] * acc[ne][2] + acc[ne][3] * acc[ne][3]; }
    sq += __shfl_xor(sq, 16); sq += __shfl_xor(sq, 32);
    const float rstd = rsqrtf(sq * (1.f / 256.f) + LN_EPS);
#pragma unroll
    for (int ne = 0; ne < 16; ++ne) { const u32x2 gw = *(const u32x2*)(rgb + (size_t)t * 1024 + h * 256 + 16 * ne + 4 * fq);
        const float g0 = __uint_as_float(gw[0] << 16), g1 = __uint_as_float(gw[0] & 0xffff0000u), g2 = __uint_as_float(gw[1] << 16), g3 = __uint_as_float(gw[1] & 0xffff0000u);
        u32x2 o; o[0] = pk2(acc[ne][0] * rstd * g0, acc[ne][1] * rstd * g1); o[1] = pk2(acc[ne][2] * rstd * g2, acc[ne][3] * rstd * g3);
        *(u32x2*)(ycat + (size_t)t * AB_OUT + 1024 + h * 256 + 16 * ne + 4 * fq) = o; }
}

__device__ __forceinline__ void phase_ab_p1(const Ctx& c) {
    for (int u = c.bid; u < 512; u += c.G) ret_kv_unit(c, u);
}
__device__ __forceinline__ void phase_ab_p2(const Ctx& c, int j) {
    if (c.bid < 64) ret_scan(c, 0, 64);
    else { const float* sinks = c.in[3] + j * 16; for (int u = c.bid - 64; u < 256; u += c.G - 64) attn_unit(c, u, sinks); }
}
__device__ __forceinline__ void phase_ab_p3(const Ctx& c) {
    for (int u = c.bid; u < 512; u += c.G) ret_out_unit(c, u);
}

__device__ __forceinline__ float gelu_fast(float x) { const float u = 1.5957691216057308f * (x + 0.044715f * x * x * x); return x / (1.f + __expf(-u)); }
struct EpiCDIn {
    static constexpr bool PERM = true;
    const float* bias; unsigned char* ws;
    __device__ __forceinline__ void operator()(const f32x4 (&acc)[2][2][4][2], const g8::Unit& u, int wr, int wc, int fr, int fq) const {
        const int pn = u.pn; const int col0 = pn * 256 + wc * 32 + fq * 8;
        f32x4 bv[2][2];
#pragma unroll
        for (int bj = 0; bj < 2; ++bj)
#pragma unroll
            for (int n = 0; n < 2; ++n) bv[bj][n] = *(const f32x4*)(bias + col0 + bj * 128 + 4 * n);
        bf16_t* gu = (bf16_t*)(ws + CD_GU); bf16_t* gvT = (bf16_t*)(ws + CD_GVT); bf16_t* gg = (bf16_t*)(ws + CD_GG); bf16_t* xr = (bf16_t*)(ws + CD_XR); float* stats = (float*)(ws + CD_STATS);
#pragma unroll
        for (int ai = 0; ai < 2; ++ai)
#pragma unroll
            for (int m = 0; m < 4; ++m) {
                const int t = u.pm * 256 + ai * 128 + wr * 64 + m * 16 + fr, sq = t & (SEQ - 1), b = t >> 13;
                f32x4 x[2][2];
#pragma unroll
                for (int bj = 0; bj < 2; ++bj)
#pragma unroll
                    for (int n = 0; n < 2; ++n) { x[bj][n] = acc[ai][bj][m][n] + bv[bj][n];
                        if (pn < 13) {
#pragma unroll
                            for (int e = 0; e < 4; ++e) x[bj][n][e] = gelu_fast(x[bj][n][e]); } }
                if (pn >= 4 && pn < 8) {
                    float s1 = 0.f, s2 = 0.f;
#pragma unroll
                    for (int bj = 0; bj < 2; ++bj)
#pragma unroll
                        for (int n = 0; n < 2; ++n)
#pragma unroll
                            for (int e = 0; e < 4; ++e) { const float v = x[bj][n][e]; s1 += v; s2 += v * v;
                                gvT[((size_t)b * 1024 + (pn - 4) * 256 + bj * 128 + wc * 32 + fq * 8 + 4 * n + e) * SEQ + sq] = f2bf(v); }
                    s1 += __shfl_xor(s1, 16); s1 += __shfl_xor(s1, 32); s2 += __shfl_xor(s2, 16); s2 += __shfl_xor(s2, 32);
                    if (fq == 0) *(f32x2*)(stats + (size_t)t * 32 + ((pn - 4) * 4 + wc) * 2) = (f32x2){s1, s2};
                } else {
                    bf16_t* dst; int ld, cb;
                    if (pn < 4) { dst = gu; ld = 1024; cb = pn * 256; } else if (pn < 13) { dst = gg; ld = 1280; cb = (pn - 8) * 256; } else { dst = xr; ld = 1280; cb = (pn - 13) * 256; }
#pragma unroll
                    for (int bj = 0; bj < 2; ++bj) { u32x4 w;
#pragma unroll
                        for (int n = 0; n < 2; ++n) { w[2 * n] = pk2(x[bj][n][0], x[bj][n][1]); w[2 * n + 1] = pk2(x[bj][n][2], x[bj][n][3]); }
                        *(u32x4*)(dst + (size_t)t * ld + cb + bj * 128 + wc * 32 + fq * 8) = w; }
                }
            }
    }
};
__device__ __forceinline__ void phase_cd_inproj(const Ctx& c, int j) {
    g8::DenseOrder S; S.init(c.ws + WS_XB, c.ws + WS_WCDIN + (size_t)j * CD_IN * D * 2, T, CD_IN, D, c.G, c.bid);
    EpiCDIn E{c.in[7] + (size_t)j * CD_IN, c.ws};
    g8::gemm_phase<EpiCDIn, g8::DenseOrder>(c.lds + LDS_STAGE, D, S, E);
}

__device__ __forceinline__ void lru_unit(const Ctx& c, int unit, int j) {
    const int hh = unit % 5, bn = unit / 5, lane = c.lane, fr = lane & 15, fq = lane >> 4, w = c.wid;
    const int t0 = bn * 128, s0 = t0 & (SEQ - 1);
    const bf16_t* xr = (const bf16_t*)(c.ws + CD_XR); float* av = (float*)(c.ws + WS_U2) + (size_t)T * 1280; float* bvv = av + (size_t)T * 1280;
    const float* conv_w = c.in[10] + (size_t)j * 4 * 1280 + hh * 256; const float* conv_b = c.in[11] + (size_t)j * 1280 + hh * 256;
    const float* ba = c.in[13] + (size_t)j * 1280 + hh * 256; const float* bx = c.in[15] + (size_t)j * 1280 + hh * 256; const float* spl = (const float*)(c.ws + WS_SPL) + (size_t)j * 1280 + hh * 256;
    const bf16_t* Wl = (const bf16_t*)(c.ws + WS_WLRU) + (size_t)((j * 5 + hh) * 2) * 65536;
    LAS unsigned char* Xc = c.lds; LAS unsigned char* Wa = c.lds + 128 * 528; LAS unsigned char* Wx = Wa + 64 * 528;
    __syncthreads();
    for (int it = c.tid; it < 128 * 32; it += NTHREADS) { const int r = it >> 5, cg = it & 31;
        float a[8];
        { const f32x4 b0 = *(const f32x4*)(conv_b + cg * 8), b1 = *(const f32x4*)(conv_b + cg * 8 + 4); a[0] = b0[0]; a[1] = b0[1]; a[2] = b0[2]; a[3] = b0[3]; a[4] = b1[0]; a[5] = b1[1]; a[6] = b1[2]; a[7] = b1[3]; }
#pragma unroll
        for (int k = 0; k < 4; ++k) { if (s0 + r - 3 + k >= 0) {
                const u32x4 xv = *(const u32x4*)(xr + (size_t)(t0 + r - 3 + k) * 1280 + hh * 256 + cg * 8);
                const f32x4 w0 = *(const f32x4*)(conv_w + k * 1280 + cg * 8), w1 = *(const f32x4*)(conv_w + k * 1280 + cg * 8 + 4);
                a[0] += w0[0] * __uint_as_float(xv[0] << 16); a[1] += w0[1] * __uint_as_float(xv[0] & 0xffff0000u); a[2] += w0[2] * __uint_as_float(xv[1] << 16); a[3] += w0[3] * __uint_as_float(xv[1] & 0xffff0000u);
                a[4] += w1[0] * __uint_as_float(xv[2] << 16); a[5] += w1[1] * __uint_as_float(xv[2] & 0xffff0000u); a[6] += w1[2] * __uint_as_float(xv[3] << 16); a[7] += w1[3] * __uint_as_float(xv[3] & 0xffff0000u); } }
        u32x4 o; o[0] = pk2(a[0], a[1]); o[1] = pk2(a[2], a[3]); o[2] = pk2(a[4], a[5]); o[3] = pk2(a[6], a[7]);
        *(LAS u32x4*)(Xc + r * 528 + cg * 16) = o; }
    __syncthreads();
    bf16x8 xf[8];
#pragma unroll
    for (int ks = 0; ks < 8; ++ks) xf[ks] = *(const LAS bf16x8*)(Xc + (16 * w + fr) * 528 + ks * 64 + fq * 16);
    const int t = t0 + 16 * w + fr;
    for (int sl = 0; sl < 4; ++sl) {
        if (sl) __syncthreads();
        tile_g2l<64, 512>(Wa, (const unsigned char*)(Wl + (size_t)(sl * 64) * 256), 512, c.tid);
        tile_g2l<64, 512>(Wx, (const unsigned char*)(Wl + 65536 + (size_t)(sl * 64) * 256), 512, c.tid);
        __syncthreads();
#pragma unroll
        for (int nc = 0; nc < 4; ++nc) { f32x4 ra = (f32x4){0.f, 0.f, 0.f, 0.f}, ri = ra;
#pragma unroll
            for (int ks = 0; ks < 8; ++ks) { const bf16x8 wa = *(const LAS bf16x8*)(Wa + (16 * nc + fr) * 528 + ks * 64 + fq * 16), wx = *(const LAS bf16x8*)(Wx + (16 * nc + fr) * 528 + ks * 64 + fq * 16);
                ra = MFMA16(wa, xf[ks], ra); ri = MFMA16(wx, xf[ks], ri); }
            const int ch = sl * 64 + 16 * nc + 4 * fq;
            const f32x4 b_a = *(const f32x4*)(ba + ch), b_x = *(const f32x4*)(bx + ch), sp = *(const f32x4*)(spl + ch);
            const u32x2 xw = *(const LAS u32x2*)(Xc + (16 * w + fr) * 528 + ch * 2);
            const float xcv[4] = {__uint_as_float(xw[0] << 16), __uint_as_float(xw[0] & 0xffff0000u), __uint_as_float(xw[1] << 16), __uint_as_float(xw[1] & 0xffff0000u)};
            f32x4 oa, ob;
#pragma unroll
            for (int r = 0; r < 4; ++r) { const float gr = sigmoidf_(ra[r] + b_a[r]), gi = sigmoidf_(ri[r] + b_x[r]); const float la = -8.f * gr * sp[r]; const float a = __expf(la);
                oa[r] = a; ob[r] = sqrtf(fmaxf(1.f - a * a, 0.f)) * (gi * xcv[r]); }
            *(f32x4*)(av + (size_t)t * 1280 + hh * 256 + ch) = oa; *(f32x4*)(bvv + (size_t)t * 1280 + hh * 256 + ch) = ob; }
    }
}

__device__ __forceinline__ void sgu_unit(const Ctx& c, int unit, int j) {
    const int g = unit & 3, bn = unit >> 2, b = bn >> 6, n = bn & 63, lane = c.lane, fr = lane & 15, fq = lane >> 4, w = c.wid;
    const int t0 = bn * 128;
    const bf16_t* gu = (const bf16_t*)(c.ws + CD_GU); const bf16_t* gvT = (const bf16_t*)(c.ws + CD_GVT); const float* stats = (const float*)(c.ws + CD_STATS); bf16_t* ycat = (bf16_t*)(c.ws + WS_YCAT);
    const float* sw = c.in[8] + (size_t)(j * 4 + g) * 16384; const float* sb = c.in[9] + (size_t)(j * 4 + g) * 128;
    LAS unsigned char* Vt = c.lds; LAS float* mr = (LAS float*)(c.lds + 256 * 272);
    __syncthreads();
    tile_g2l<256, 256>(Vt, (const unsigned char*)(gvT + ((size_t)b * 1024 + g * 256) * SEQ + n * 128), (size_t)SEQ * 2, c.tid);
    if (c.tid < 128) { const float* st = stats + (size_t)(t0 + c.tid) * 32; float s1 = 0.f, s2 = 0.f;
#pragma unroll
        for (int q = 0; q < 16; ++q) { s1 += st[2 * q]; s2 += st[2 * q + 1]; }
        const float mean = s1 * (1.f / 1024.f), var = fmaxf(s2 * (1.f / 1024.f) - mean * mean, 0.f); mr[2 * c.tid] = mean; mr[2 * c.tid + 1] = rsqrtf(var + LN_EPS); }
    __syncthreads();
    const int i = 16 * w + fr, t = t0 + i, nks = (w >> 1) + 1;
    bf16x8 wf[4]; float ci = 0.f;
#pragma unroll
    for (int ks = 0; ks < 4; ++ks) { f32x4 lo = (f32x4){0.f, 0.f, 0.f, 0.f}, hi = lo;
        if (ks < nks) { const int j0 = ks * 32 + fq * 8; const f32x4 w0 = *(const f32x4*)(sw + (size_t)i * 128 + j0), w1 = *(const f32x4*)(sw + (size_t)i * 128 + j0 + 4);
#pragma unroll
            for (int e = 0; e < 4; ++e) { const float m0 = mr[2 * (j0 + e)], r0 = mr[2 * (j0 + e) + 1], m1 = mr[2 * (j0 + 4 + e)], r1 = mr[2 * (j0 + 4 + e) + 1];
                lo[e] = (j0 + e <= i) ? w0[e] * r0 : 0.f; hi[e] = (j0 + 4 + e <= i) ? w1[e] * r1 : 0.f; ci += lo[e] * m0 + hi[e] * m1; } }
        wf[ks] = pack8(lo, hi); }
    ci += __shfl_xor(ci, 16); ci += __shfl_xor(ci, 32);
    const float add = sb[i] - ci;
    f32x4 acc[16];
#pragma unroll
    for (int nd = 0; nd < 16; ++nd) { acc[nd] = (f32x4){0.f, 0.f, 0.f, 0.f};
#pragma unroll
        for (int ks = 0; ks < 4; ++ks) if (ks < nks) { const bf16x8 vf = *(const LAS bf16x8*)(Vt + (16 * nd + fr) * 272 + ks * 64 + fq * 16); acc[nd] = MFMA16(vf, wf[ks], acc[nd]); } }
#pragma unroll
    for (int nd = 0; nd < 16; ++nd) { const u32x2 uw = *(const u32x2*)(gu + (size_t)t * 1024 + g * 256 + 16 * nd + 4 * fq);
        const float u0 = __uint_as_float(uw[0] << 16), u1 = __uint_as_float(uw[0] & 0xffff0000u), u2 = __uint_as_float(uw[1] << 16), u3 = __uint_as_float(uw[1] & 0xffff0000u);
        u32x2 o; o[0] = pk2(u0 * (acc[nd][0] + add), u1 * (acc[nd][1] + add)); o[1] = pk2(u2 * (acc[nd][2] + add), u3 * (acc[nd][3] + add));
        *(u32x2*)(ycat + (size_t)t * CD_OUT + g * 256 + 16 * nd + 4 * fq) = o; }
}
__device__ __forceinline__ void phase_cd_p1(const Ctx& c, int j) {
    for (int u = c.bid; u < 640 + 512; u += c.G) { if (u < 640) lru_unit(c, u, j); else sgu_unit(c, u - 640, j); }
}

__device__ __forceinline__ void phase_cd_scan1(const Ctx& c) {
    float* av = (float*)(c.ws + WS_U2) + (size_t)T * 1280; float* bv = av + (size_t)T * 1280;
    float* sum = (float*)(c.ws + WS_H);
    for (int idx = c.gtid; idx < 2 * 64 * 1280; idx += c.gthreads) {
        const int ch = idx % 1280, bn = idx / 1280; const size_t t0 = (size_t)bn * 128;
        float P = 1.f, h = 0.f;
        for (int i = 0; i < 128; ++i) { const size_t o = (t0 + i) * 1280 + ch; const float a = av[o], b = bv[o]; h = a * h + b; P *= a; av[o] = P; bv[o] = h; }
        sum[(size_t)idx * 2] = P; sum[(size_t)idx * 2 + 1] = h;
    }
}
__device__ __forceinline__ void phase_cd_scan2(const Ctx& c) {
    const bf16_t* gg = (const bf16_t*)(c.ws + CD_GG); bf16_t* ycat = (bf16_t*)(c.ws + WS_YCAT);
    const float* av = (const float*)(c.ws + WS_U2) + (size_t)T * 1280; const float* bv = av + (size_t)T * 1280;
    const float* sum = (const float*)(c.ws + WS_H);
    for (int idx = c.gtid; idx < 2 * 64 * 1280; idx += c.gthreads) {
        const int ch = idx % 1280, bn = idx / 1280, b = bn >> 6, n = bn & 63; const size_t t0 = (size_t)bn * 128;
        float carry = 0.f;
        for (int m = 0; m < n; ++m) { const size_t o = ((size_t)(b * 64 + m) * 1280 + ch) * 2; carry = sum[o] * carry + sum[o + 1]; }
        for (int i = 0; i < 128; ++i) { const size_t t = t0 + i; const float h = bv[t * 1280 + ch] + av[t * 1280 + ch] * carry;
            ycat[t * CD_OUT + 1024 + ch] = f2bf(bf2f(gg[t * 1280 + ch]) * h); }
    }
}

template <bool MOE>
__device__ __forceinline__ void phase_ln(const Ctx& c, const float* g, const float* bta, float* xout) {
    float* x = (float*)(c.ws + WS_X); bf16_t* xb = (bf16_t*)(c.ws + WS_XB);
    const float* hbuf = (const float*)(c.ws + WS_H); const bf16_t* Y = (const bf16_t*)(c.ws + WS_U1);
    for (long t = c.gw; t < T; t += c.nwaves) {
        f32x4 v[4];
#pragma unroll
        for (int q = 0; q < 4; ++q) { const int col = q * 256 + c.lane * 4;
            f32x4 f;
            if (!MOE) f = *(const f32x4*)(hbuf + (size_t)t * D + col);
            else { f = (f32x4){0.f, 0.f, 0.f, 0.f};
#pragma unroll
                for (int k = 0; k < 9; ++k) { const size_t srow = (k < 8) ? (size_t)t * 8 + k : (size_t)TK + t; const u32x2 w = *(const u32x2*)(Y + srow * D + col);
                    f[0] += __uint_as_float(w[0] << 16); f[1] += __uint_as_float(w[0] & 0xffff0000u); f[2] += __uint_as_float(w[1] << 16); f[3] += __uint_as_float(w[1] & 0xffff0000u); } }
            const f32x4 xv = *(const f32x4*)(x + (size_t)t * D + col);
            v[q] = xv * ALPHA + f; }
        float sm = 0.f;
#pragma unroll
        for (int q = 0; q < 4; ++q) sm += v[q][0] + v[q][1] + v[q][2] + v[q][3];
        const float mean = wave_sum(sm) * (1.f / 1024.f); float sq = 0.f;
#pragma unroll
        for (int q = 0; q < 4; ++q) { v[q] = v[q] - mean; sq += v[q][0] * v[q][0] + v[q][1] * v[q][1] + v[q][2] * v[q][2] + v[q][3] * v[q][3]; }
        const float rstd = rsqrtf(wave_sum(sq) * (1.f / 1024.f) + LN_EPS);
#pragma unroll
        for (int q = 0; q < 4; ++q) { const int col = q * 256 + c.lane * 4; const f32x4 gg = *(const f32x4*)(g + col), bb = *(const f32x4*)(bta + col);
            const f32x4 o = v[q] * rstd * gg + bb;
            *(f32x4*)(xout + (size_t)t * D + col) = o; if (xout != x) *(f32x4*)(x + (size_t)t * D + col) = o;
            u32x2 w; w[0] = pk2(o[0], o[1]); w[1] = pk2(o[2], o[3]); *(u32x2*)(xb + (size_t)t * D + col) = w; }
    }
}

__device__ __forceinline__ void phase_route(const Ctx& c, int L) {
    const float* zr = (const float*)(c.ws + WS_ZR); const float* rb = c.in[22] + L * NE;
    int* cnt = (int*)(c.ws + CTL_CNT) + L * NE; int* list = (int*)(c.ws + WS_LIST); float* gate = (float*)(c.ws + WS_GATE);
    for (long t = c.gw; t < T; t += c.nwaves) {
        const float s0 = sigmoidf_(zr[(size_t)t * 256 + c.lane]), s1 = sigmoidf_(zr[(size_t)t * 256 + 64 + c.lane]);
        float v0 = s0 + rb[c.lane], v1 = s1 + rb[64 + c.lane];
        float mysc = 0.f; int myexp = -1; float tot = 0.f;
        for (int k = 0; k < 8; ++k) {
            float bv = v0; int bi = c.lane; if (v1 > bv) { bv = v1; bi = c.lane + 64; }
#pragma unroll
            for (int o = 32; o; o >>= 1) { const float ov = __shfl_xor(bv, o); const int oi = __shfl_xor(bi, o); if (ov > bv || (ov == bv && oi < bi)) { bv = ov; bi = oi; } }
            const float sc = __shfl((bi & 64) ? s1 : s0, bi & 63);
            tot += sc;
            if (c.lane == k) { mysc = sc; myexp = bi; }
            if (c.lane == (bi & 63)) { if (bi & 64) v1 = -1e30f; else v0 = -1e30f; }
        }
        if (c.lane < 8) { const int pos = atomicAdd(&cnt[myexp], 1); list[(size_t)myexp * LISTCAP + pos] = (int)t * 8 + c.lane; gate[(size_t)t * 8 + c.lane] = mysc / tot * 2.5f; }
    }
}

struct MoeOrder {
    const char* Abase; const char* Bbase; size_t Bstride; int K, NT, total, G, c, mode;
    LAS int* tab; LAS int* desc;
    __device__ __forceinline__ bool next(int i, g8::Unit& u) const {
        const long L = (long)i * G + c; if (L >= total || i >= TAB_SLOTS) return false;
        const int d = desc[i]; const int e = d >> 12, pn = d & 15;
        u.pm = (d >> 4) & 255; u.pn = pn; u.aux = i; u.A = Abase; u.B = Bbase + (size_t)e * Bstride + (size_t)pn * 256 * K * 2; return true;
    }
    __device__ __forceinline__ void aoff(const g8::Unit& u, int tid, unsigned (&o)[2][2]) const {
#pragma unroll
        for (int i = 0; i < 2; ++i) { int R, C; g8::stage_rc(tid * 16 + i * 8192, R, C);
#pragma unroll
            for (int h = 0; h < 2; ++h) { int s = tab[u.aux * 256 + h * 128 + R]; s = s < 0 ? 0 : s; const int row = mode ? s : (s < TK ? (s >> 3) : s - TK);
                o[h][i] = (unsigned)(row * K + C) * 2u; } }
    }
};
__device__ __forceinline__ void moe_setup(const Ctx& c, MoeOrder& S, const int* cnt, int NT) {
    LAS int* pref = (LAS int*)(c.lds + LDS_PREF); LAS int* desc = (LAS int*)(c.lds + LDS_DESC); LAS int* tab = (LAS int*)(c.lds + LDS_TAB);
    const int* list = (const int*)(c.ws + WS_LIST);
    if (c.tid == 0) { int acc = 0; for (int e = 0; e < NE1; ++e) { pref[e] = acc; const int n = e < NE ? cnt[e] : T; acc += (n + 255) >> 8; } pref[NE1] = acc; }
    __syncthreads();
    const int total = pref[NE1] * NT;
    S.NT = NT; S.total = total; S.G = c.G; S.c = c.bid; S.tab = tab; S.desc = desc;
    for (int i = 0; i < TAB_SLOTS; ++i) {
        const long L = (long)i * c.G + c.bid; if (L >= total) break;
        int wgid = (int)L; { const int q = total / 8, r = total % 8, xcd = wgid % 8, off = wgid / 8; wgid = (xcd < r ? xcd * (q + 1) : r * (q + 1) + (xcd - r) * q) + off; }
        const int rbg = wgid / NT, pn = wgid % NT;
        int lo = 0, hi = NE1;
        while (hi - lo > 1) { const int mid = (lo + hi) >> 1; if (pref[mid] <= rbg) lo = mid; else hi = mid; }
        const int e = lo, rb = rbg - pref[e], n = e < NE ? cnt[e] : T;
        if (c.tid == 0) desc[i] = (e << 12) | (rb << 4) | pn;
        if (c.tid < 256) { const int r = rb * 256 + c.tid; int s = -1; if (r < n) s = (e < NE) ? list[(size_t)e * LISTCAP + r] : TK + r; tab[i * 256 + c.tid] = s; }
    }
    __syncthreads();
}
struct EpiMoeGU {
    static constexpr bool PERM = true;
    bf16_t* H; LAS int* tab;
    __device__ __forceinline__ void operator()(const f32x4 (&acc)[2][2][4][2], const g8::Unit& u, int wr, int wc, int fr, int fq) const {
#pragma unroll
        for (int ai = 0; ai < 2; ++ai)
#pragma unroll
            for (int m = 0; m < 4; ++m) { const int r = ai * 128 + wr * 64 + m * 16 + fr; const int s = tab[u.aux * 256 + r];
                if (s >= 0) { u32x4 w;
#pragma unroll
                    for (int n = 0; n < 2; ++n) { const f32x4 g = acc[ai][0][m][n], up = acc[ai][1][m][n];
                        w[2 * n] = pk2(siluf_(g[0]) * up[0], siluf_(g[1]) * up[1]); w[2 * n + 1] = pk2(siluf_(g[2]) * up[2], siluf_(g[3]) * up[3]); }
                    *(u32x4*)(H + (size_t)s * ED + u.pn * 128 + wc * 32 + fq * 8) = w; } }
    }
};
struct EpiMoeDN {
    static constexpr bool PERM = true;
    bf16_t* Y; const float* gate; LAS int* tab;
    __device__ __forceinline__ void operator()(const f32x4 (&acc)[2][2][4][2], const g8::Unit& u, int wr, int wc, int fr, int fq) const {
#pragma unroll
        for (int ai = 0; ai < 2; ++ai)
#pragma unroll
            for (int m = 0; m < 4; ++m) { const int r = ai * 128 + wr * 64 + m * 16 + fr; const int s = tab[u.aux * 256 + r];
                if (s >= 0) { const float gt = gate[s];
#pragma unroll
                    for (int bj = 0; bj < 2; ++bj) { u32x4 w;
#pragma unroll
                        for (int n = 0; n < 2; ++n) { const f32x4 a = acc[ai][bj][m][n] * gt; w[2 * n] = pk2(a[0], a[1]); w[2 * n + 1] = pk2(a[2], a[3]); }
                        *(u32x4*)(Y + (size_t)s * D + u.pn * 256 + bj * 128 + wc * 32 + fq * 8) = w; } } }
    }
};
__device__ __forceinline__ void phase_moe_gu(const Ctx& c, int L) {
    MoeOrder S; S.Abase = (const char*)(c.ws + WS_XB); S.Bbase = (const char*)(c.ws + WS_WGU) + (size_t)L * NE1 * 512 * D * 2; S.Bstride = (size_t)512 * D * 2; S.K = D; S.mode = 0;
    moe_setup(c, S, (const int*)(c.ws + CTL_CNT) + L * NE, 2);
    EpiMoeGU E{(bf16_t*)(c.ws + WS_HID), S.tab};
    g8::gemm_phase<EpiMoeGU, MoeOrder>(c.lds + LDS_STAGE, D, S, E);
}
__device__ __forceinline__ void phase_moe_dn(const Ctx& c, int L) {
    MoeOrder S; S.Abase = (const char*)(c.ws + WS_HID); S.Bbase = (const char*)(c.ws + WS_WDN) + (size_t)L * NE1 * D * ED * 2; S.Bstride = (size_t)D * ED * 2; S.K = ED; S.mode = 1;
    moe_setup(c, S, (const int*)(c.ws + CTL_CNT) + L * NE, 4);
    EpiMoeDN E{(bf16_t*)(c.ws + WS_U1), (const float*)(c.ws + WS_GATE), S.tab};
    g8::gemm_phase<EpiMoeDN, MoeOrder>(c.lds + LDS_STAGE, ED, S, E);
}

constexpr int PH_PER_LAYER = 12;
constexpr int N_PHASES = 1 + 4 * PH_PER_LAYER;

__global__ void __launch_bounds__(NTHREADS, 2) fwd_kernel(Params p) {
    extern __shared__ __attribute__((aligned(16))) unsigned char lds_raw[];
    LAS unsigned char* const lds0 = (LAS unsigned char*)lds_raw;
    volatile LAS unsigned* misc = (volatile LAS unsigned*)(lds0 + LDS_MISC);
    if (threadIdx.x < 4) misc[threadIdx.x] = 0u;
    __syncthreads();
    const int lo = p.ph_lo, hi = p.ph_hi;
    XcdBarrier bar; bar.bar = (unsigned*)(p.ws + WS_CTL); bar.x = 0; bar.st = misc;
    if (hi - lo > 1) bar = xcd_barrier_post((unsigned*)(p.ws + WS_CTL), misc);
#define MKCTX() Ctx c; { int tid_ = threadIdx.x; asm volatile("" : "+v"(tid_)); int bid_ = blockIdx.x; asm volatile("" : "+s"(bid_)); unsigned long long ws_ = (unsigned long long)p.ws; asm volatile("" : "+s"(ws_)); \
        c.in = p.in; c.out = p.out; c.ws = (unsigned char*)ws_; c.lds = lds0; c.tid = tid_; c.lane = tid_ & 63; c.wid = __builtin_amdgcn_readfirstlane(tid_ >> 6); c.bid = bid_; c.G = gridDim.x; \
        c.gtid = c.bid * NTHREADS + c.tid; c.gthreads = c.G * NTHREADS; c.gw = c.bid * 8 + c.wid; c.nwaves = c.G * 8; } unsigned char* const ws = c.ws; (void)ws
    int id = 0;
#ifndef PMASK
#define PMASK 0xffffffffu
#endif
#define PHASE(k, body) do { if (((PMASK >> (k)) & 1u) && lo <= id && id < hi) { MKCTX(); body; if (id + 1 < hi) xcd_barrier(bar); } ++id; } while (0)
    PHASE(0, phase_convert(c));
#pragma unroll 1
    for (int L = 0; L < 4; ++L) {
        const int j = L >> 1; const bool cd = (L & 1);
        if (cd) {
            PHASE(1, phase_cd_inproj(c, j));
        } else {
            PHASE(2, phase_ab_inproj(c, j));
        }
        if (!cd) { PHASE(3, phase_ab_p1(c)); PHASE(4, phase_ab_p2(c, j)); PHASE(16, phase_ab_p3(c)); id += 1; }
        else     { PHASE(5, phase_cd_p1(c, j)); PHASE(7, phase_cd_scan1(c)); PHASE(15, phase_cd_scan2(c)); id += 1; }
        {
            const size_t Woff = cd ? WS_WCDOUT + (size_t)j * D * CD_OUT * 2 : WS_WABOUT + (size_t)j * D * AB_OUT * 2;
            const int K = cd ? CD_OUT : AB_OUT; const float* bias = cd ? p.in[18] + (size_t)j * D : p.in[5] + (size_t)j * D;
            PHASE(8, phase_dense(c, (const bf16_t*)(ws + WS_YCAT), (const bf16_t*)(ws + Woff), T, D, K, (float*)(ws + WS_H), D, bias));
        }
        PHASE(9, phase_ln<false>(c, p.in[19] + (size_t)L * D, p.in[20] + (size_t)L * D, (float*)(ws + WS_X)));
        PHASE(10, phase_dense(c, (const bf16_t*)(ws + WS_XB), (const bf16_t*)(ws + WS_WRT) + (size_t)L * 256 * D, T, 256, D, (float*)(ws + WS_ZR), 256, nullptr));
        PHASE(11, phase_route(c, L));
        PHASE(12, phase_moe_gu(c, L));
        PHASE(13, phase_moe_dn(c, L));
        PHASE(14, phase_ln<true>(c, p.in[29] + (size_t)L * D, p.in[30] + (size_t)L * D, L == 3 ? p.out : (float*)(ws + WS_X)));
    }
#undef PHASE
}

extern "C" void kernel_launch(void* const* d_in, const int* in_sizes, int n_in, void* d_out, int out_size, void* d_ws, size_t ws_size, hipStream_t stream) {
    static int grid = 0;
    if (grid == 0) {
        if (n_in != 31 || out_size != T * D || ws_size < WS_END) { fprintf(stderr, "kernel_launch: unexpected shapes (n_in %d out %d ws %zu need %zu)\n", n_in, out_size, ws_size, (size_t)WS_END); grid = -1; return; }
        int dev = 0, cus = 0, per_cu = 0;
        if (hipGetDevice(&dev) != hipSuccess || hipDeviceGetAttribute(&cus, hipDeviceAttributeMultiprocessorCount, dev) != hipSuccess) { grid = -1; return; }
        if (hipFuncSetAttribute((const void*)fwd_kernel, hipFuncAttributeMaxDynamicSharedMemorySize, LDS_BYTES) != hipSuccess) { fprintf(stderr, "kernel_launch: hipFuncSetAttribute failed\n"); grid = -1; return; }
        if (hipOccupancyMaxActiveBlocksPerMultiprocessor(&per_cu, (const void*)fwd_kernel, NTHREADS, LDS_BYTES) != hipSuccess || per_cu < 1) fprintf(stderr, "kernel_launch: occupancy query says %d\n", per_cu);
        (void)hipGetLastError();
        grid = cus;
    }
    if (grid < 0) return;
    (void)hipMemsetAsync((char*)d_ws + WS_CTL, 0, CTL_BYTES, stream);
    Params p{};
    for (int i = 0; i < 31; ++i) p.in[i] = (const float*)d_in[i];
    p.out = (float*)d_out; p.ws = (unsigned char*)d_ws;
#if N_LAUNCH_MODE == 1
    p.ph_lo = 0; p.ph_hi = N_PHASES;
    hipLaunchKernelGGL(fwd_kernel, dim3(grid), dim3(NTHREADS), LDS_BYTES, stream, p);
#else
    for (int i = 0; i < N_PHASES; ++i) { p.ph_lo = i; p.ph_hi = i + 1; hipLaunchKernelGGL(fwd_kernel, dim3(grid), dim3(NTHREADS), LDS_BYTES, stream, p); }
#endif
}
```

```cpp
#include <hip/hip_runtime.h>
#include <cstdio>
#include <cstdint>

#define LAS __attribute__((address_space(3)))
typedef unsigned short bf16_t;
typedef short bf16x8 __attribute__((ext_vector_type(8)));
typedef float f32x4 __attribute__((ext_vector_type(4)));
typedef float f32x2 __attribute__((ext_vector_type(2)));
typedef unsigned u32x4 __attribute__((ext_vector_type(4)));
typedef unsigned u32x2 __attribute__((ext_vector_type(2)));

constexpr int T = 16384, D = 1024, SEQ = 8192;
constexpr int AB_IN = 4352, AB_OUT = 2048, CD_IN = 4608, CD_OUT = 2304;
constexpr int NE = 128, NE1 = 129, TOPK = 8, ED = 256;
constexpr int TK = T * TOPK;
constexpr int NSLOT = TK + T;
constexpr int LISTCAP = 16384;
constexpr float ALPHA = 1.681792830507429f;
constexpr float LN_EPS = 1e-5f;

#ifndef N_LAUNCH_MODE
#define N_LAUNCH_MODE 1
#endif

constexpr size_t al256(size_t x) { return (x + 255) & ~(size_t)255; }
constexpr size_t WS_CTL    = 0;
constexpr size_t CTL_BYTES = 65536;
constexpr size_t CTL_CNT   = 32768;
constexpr size_t WS_WABIN  = CTL_BYTES;
constexpr size_t WS_WABOUT = WS_WABIN  + al256((size_t)2 * AB_IN * D * 2);
constexpr size_t WS_WCDIN  = WS_WABOUT + al256((size_t)2 * D * AB_OUT * 2);
constexpr size_t WS_WCDOUT = WS_WCDIN  + al256((size_t)2 * CD_IN * D * 2);
constexpr size_t WS_WRT    = WS_WCDOUT + al256((size_t)2 * D * CD_OUT * 2);
constexpr size_t WS_WGU    = WS_WRT    + al256((size_t)4 * 256 * D * 2);
constexpr size_t WS_WDN    = WS_WGU    + al256((size_t)4 * NE1 * 512 * D * 2);
constexpr size_t WS_X      = WS_WDN    + al256((size_t)4 * NE1 * D * ED * 2);
constexpr size_t WS_XB     = WS_X      + al256((size_t)T * D * 4);
constexpr size_t WS_U1     = WS_XB     + al256((size_t)T * D * 2);
constexpr size_t U1_BYTES  = al256((size_t)NSLOT * D * 2) > al256((size_t)T * CD_IN * 4) ? al256((size_t)NSLOT * D * 2) : al256((size_t)T * CD_IN * 4);
constexpr size_t WS_U2     = WS_U1     + U1_BYTES;
constexpr size_t U2_BYTES  = al256((size_t)T * 1280 * 4 * 3);
constexpr size_t WS_YCAT   = WS_U2     + U2_BYTES;
constexpr size_t WS_H      = WS_YCAT   + al256((size_t)T * CD_OUT * 2);
constexpr size_t WS_ZR     = WS_H      + al256((size_t)T * D * 4);
constexpr size_t WS_HID    = WS_ZR     + al256((size_t)T * 256 * 4);
constexpr size_t WS_LIST   = WS_HID    + al256((size_t)NSLOT * ED * 2);
constexpr size_t WS_GATE   = WS_LIST   + al256((size_t)NE * LISTCAP * 4);
constexpr size_t WS_ROPEA  = WS_GATE   + al256((size_t)NSLOT * 4);
constexpr size_t WS_ROPER  = WS_ROPEA  + al256((size_t)SEQ * 32 * 8);
constexpr size_t WS_BIASP  = WS_ROPER  + al256((size_t)SEQ * 64 * 8);
constexpr size_t WS_WLRU   = WS_BIASP  + al256((size_t)2 * AB_IN * 4);
constexpr size_t WS_SPL    = WS_WLRU   + al256((size_t)2 * 5 * 2 * 65536 * 2);
constexpr size_t WS_END    = WS_SPL    + al256((size_t)2 * 1280 * 4);
constexpr size_t CD_GU = WS_U1, CD_GVT = WS_U1 + 32 * (1024 * 1024), CD_GG = WS_U1 + 64 * (1024 * 1024), CD_XR = WS_U1 + 104 * (1024 * 1024), CD_STATS = WS_U1 + 144 * (1024 * 1024);
constexpr size_t MB = 1024 * 1024;
constexpr size_t AB_QB = WS_U1, AB_KB = WS_U1 + 32 * MB, AB_VT = WS_U1 + 36 * MB, AB_RQB = WS_U1 + 40 * MB, AB_RKB = WS_U1 + 56 * MB, AB_RKDT = WS_U1 + 72 * MB,
                 AB_RVT = WS_U1 + 88 * MB, AB_RGB = WS_U1 + 120 * MB, AB_KV = WS_U1 + 152 * MB  , AB_SPREV = WS_U1 + 216 * MB  ;
static_assert(AB_SPREV + 32 * MB <= WS_U1 + U1_BYTES, "U1 map");

__device__ __forceinline__ float bf2f(bf16_t b) { return __uint_as_float(((unsigned)b) << 16); }
__device__ __forceinline__ bf16_t f2bf(float f) { unsigned u = __float_as_uint(f); u += 0x7FFFu + ((u >> 16) & 1u); return (bf16_t)(u >> 16); }
__device__ __forceinline__ unsigned pk2(float lo, float hi) { return (unsigned)f2bf(lo) | ((unsigned)f2bf(hi) << 16); }
__device__ __forceinline__ float wave_sum(float v) {
#pragma unroll
    for (int o = 32; o; o >>= 1) v += __shfl_xor(v, o);
    return v; }
__device__ __forceinline__ float wave_max(float v) {
#pragma unroll
    for (int o = 32; o; o >>= 1) v = fmaxf(v, __shfl_xor(v, o));
    return v; }
__device__ __forceinline__ float gelu_tanh(float x) { const float u = 0.7978845608028654f * (x + 0.044715f * x * x * x); return 0.5f * x * (1.f + tanhf(u)); }
__device__ __forceinline__ float sigmoidf_(float x) { return 1.f / (1.f + __expf(-x)); }
__device__ __forceinline__ float siluf_(float x) { return x / (1.f + __expf(-x)); }

#define XB_TMO      128
#define XB_XCNT(j)  (256  + 64 * (j))
#define XB_XSUB(j)  (1280 + 64 * (j))
#define XB_XGEN(j)  (2304 + 64 * (j))
#define XB_TOP      3328
#define XB_TOPGEN   3392
#define XCD_BAR_WORDS 3456
#define XB_SPIN_CAP (1u << 22)

__device__ __forceinline__ unsigned xb_ld(unsigned* p)              { return __hip_atomic_load(p, __ATOMIC_RELAXED, __HIP_MEMORY_SCOPE_AGENT); }
__device__ __forceinline__ unsigned xb_add(unsigned* p, unsigned v) { return __hip_atomic_fetch_add(p, v, __ATOMIC_RELAXED, __HIP_MEMORY_SCOPE_AGENT); }
__device__ __forceinline__ unsigned xb_xcc_id() { return (unsigned)__builtin_amdgcn_s_getreg((3 << 11) | 20) & 0xFu; }
#define XB_SPIN(cond, bar) do { unsigned _sp = 0; while (cond) { __builtin_amdgcn_s_sleep(1); \
    if ((++_sp & 255u) == 0u) { if (xb_ld(&(bar)[XB_TMO])) break; if (_sp > XB_SPIN_CAP) { atomicAdd(&(bar)[XB_TMO], 1u); break; } } } } while (0)

struct XcdBarrier { unsigned* bar; unsigned x; volatile LAS unsigned* st; };

__device__ __forceinline__ XcdBarrier xcd_barrier_post(unsigned* bar, volatile LAS unsigned* st) {
    XcdBarrier b; b.bar = bar; b.x = xb_xcc_id(); b.st = st;
    if (threadIdx.x == 0) (void)xb_add(&bar[XB_XCNT(b.x)], 1u);
    return b;
}
__device__ __forceinline__ void xcd_barrier_complete(unsigned* bar, unsigned x, unsigned& nloc, unsigned& nx) {
    const unsigned G = gridDim.x * gridDim.y * gridDim.z;
    unsigned sum, cnt, mine, sp = 0u;
    for (;;) {
        sum = 0u; cnt = 0u; mine = 0u;
#pragma unroll
        for (unsigned j = 0; j < 16; ++j) { const unsigned c = xb_ld(&bar[XB_XCNT(j)]); sum += c; cnt += (c > 0u) ? 1u : 0u; mine = (j == x) ? c : mine; }
        if (sum == G) break;
        __builtin_amdgcn_s_sleep(1);
        if ((++sp & 255u) == 0u) { if (xb_ld(&bar[XB_TMO])) break; if (sp > XB_SPIN_CAP) { atomicAdd(&bar[XB_TMO], 1u); break; } }
    }
    nloc = mine > 0u ? mine : 1u; nx = cnt > 0u ? cnt : 1u;
}
__device__ __forceinline__ void xcd_barrier(const XcdBarrier& b) {
    asm volatile("s_waitcnt vmcnt(0)" ::: "memory");
    __syncthreads();
    if (threadIdx.x == 0) {
        unsigned* bar = b.bar;
        __builtin_amdgcn_s_waitcnt(0);
        unsigned nloc = b.st[0], nx = b.st[1];
        if (nloc == 0u) { xcd_barrier_complete(bar, b.x, nloc, nx); b.st[0] = nloc; b.st[1] = nx; }
        const unsigned old = xb_add(&bar[XB_XSUB(b.x)], 1u);
        const unsigned gen = old / nloc;
        if (old + 1u == (gen + 1u) * nloc) {
            __builtin_amdgcn_fence(__ATOMIC_RELEASE, "agent");
            asm volatile("s_waitcnt vmcnt(0)" ::: "memory");
            const unsigned og = xb_add(&bar[XB_TOP], 1u);
            const unsigned tg = og / nx;
            if (og + 1u == (tg + 1u) * nx) xb_add(&bar[XB_TOPGEN], 1u);
            else XB_SPIN(xb_ld(&bar[XB_TOPGEN]) == tg, bar);
            __builtin_amdgcn_fence(__ATOMIC_ACQUIRE, "agent");
            xb_add(&bar[XB_XGEN(b.x)], 1u);
            asm volatile("s_waitcnt vmcnt(0)" ::: "memory");
        } else {
            XB_SPIN(xb_ld(&bar[XB_XGEN(b.x)]) == gen, bar);
            __builtin_amdgcn_fence(__ATOMIC_ACQUIRE, "agent");
            asm volatile("s_waitcnt vmcnt(0)" ::: "memory");
        }
    }
    __syncthreads();
}

namespace g8 {
constexpr int BM = 256, BK = 64, HALF = 128, HTB = HALF * BK * 2, STAGE_BYTES = 8 * HTB, NXCD = 8, WGM = 8;
__device__ __forceinline__ int lds_byte(int r, int c) { const int st = (r >> 4) * 2 + (c >> 5), rr = r & 15, cc = c & 31, ob = rr * 64 + cc * 2; return st * 1024 + (ob ^ (((ob >> 9) & 1) << 5)); }
__device__ __forceinline__ void stage_rc(int b, int& R, int& C) { const int st = b / 1024, sb = b % 1024, swz = sb ^ (((sb >> 9) & 1) << 5); R = (st >> 1) * 16 + swz / 64; C = (st & 1) * 32 + (swz % 64) / 2; }
__device__ __forceinline__ int perm32(int rho) { const int n = rho >> 4, i = rho & 15; return 8 * (i >> 2) + 4 * n + (i & 3); }

struct Unit { const char* A; const char* B; int pm, pn, aux; };

struct DenseOrder {
    const char* A; const char* Bt; int nM, nN, nwg, G, c, K;
    __device__ void init(const void* A_, const void* Bt_, int M, int N, int K_, int G_, int c_) { A = (const char*)A_; Bt = (const char*)Bt_; nM = M / BM; nN = N / BM; nwg = nM * nN; G = G_; c = c_; K = K_; }
    __device__ __forceinline__ bool next(int i, Unit& u) const {
        const long L = (long)i * G + c; if (L >= nwg) return false;
        int wgid = (int)L; { const int q = nwg / NXCD, r = nwg % NXCD, xcd = wgid % NXCD, off = wgid / NXCD; wgid = (xcd < r ? xcd * (q + 1) : r * (q + 1) + (xcd - r) * q) + off; }
        const int nig = WGM * nN, gid = wgid / nig, fm = gid * WGM, gsz = (nM - fm) < WGM ? (nM - fm) : WGM;
        u.pm = fm + ((wgid % nig) % gsz); u.pn = (wgid % nig) / gsz; u.aux = 0;
        u.A = A + (size_t)u.pm * BM * K * 2; u.B = Bt + (size_t)u.pn * BM * K * 2; return true;
    }
    __device__ __forceinline__ void aoff(const Unit&, int tid, unsigned (&o)[2][2]) const {
#pragma unroll
        for (int i = 0; i < 2; ++i) { int R, C; stage_rc(tid * 16 + i * 8192, R, C);
            o[0][i] = (unsigned)(R * K + C) * 2u; o[1][i] = (unsigned)((R + HALF) * K + C) * 2u; }
    }
};

__device__ __forceinline__ unsigned cvt_pk_bf16(float lo, float hi) { unsigned r; asm volatile("v_cvt_pk_bf16_f32 %0, %1, %2" : "=v"(r) : "v"(lo), "v"(hi)); return r; }

struct EpiF32 {
    static constexpr bool PERM = false;
    float* C; int ldc; const float* bias;
    __device__ __forceinline__ void operator()(const f32x4 (&acc)[2][2][4][2], const Unit& u, int wr, int wc, int fr, int fq) const {
        const int row0 = u.pm * BM + wr * 64 + fr, col0 = u.pn * BM + wc * 32 + 4 * fq;
        f32x4 bv[2][2];
#pragma unroll
        for (int bj = 0; bj < 2; ++bj)
#pragma unroll
            for (int n = 0; n < 2; ++n) bv[bj][n] = bias ? *(const f32x4*)(bias + col0 + bj * HALF + n * 16) : (f32x4){0.f, 0.f, 0.f, 0.f};
#pragma unroll
        for (int ai = 0; ai < 2; ++ai)
#pragma unroll
            for (int m = 0; m < 4; ++m) { float* rowp = C + (size_t)(row0 + ai * HALF + m * 16) * ldc + col0;
#pragma unroll
                for (int bj = 0; bj < 2; ++bj)
#pragma unroll
                    for (int n = 0; n < 2; ++n) *(f32x4*)(rowp + bj * HALF + n * 16) = acc[ai][bj][m][n] + bv[bj][n]; }
    }
};

template <class Epi, class Sched>
__device__ __forceinline__ void gemm_phase(LAS unsigned char* lds, const int K, const Sched& S, const Epi& E) {
    int tid_ = threadIdx.x; asm volatile("" : "+v"(tid_));
    const int tid = tid_, wid = __builtin_amdgcn_readfirstlane(tid >> 6), lane = tid & 63, wr = wid >> 2, wc = wid & 3, fr = lane & 15, fq = lane >> 4;
    const int nt = K / BK;
    unsigned voffB[2];
#pragma unroll
    for (int i = 0; i < 2; ++i) { int R, C; stage_rc(tid * 16 + i * 8192, R, C); const int Rb = Epi::PERM ? ((R & ~31) + perm32(R & 31)) : R;
        voffB[i] = (unsigned)(Rb * K + C) * 2u; }
    const size_t kstep = (size_t)(BK * 2);
    const size_t hstep = (size_t)HALF * K * 2;
    const unsigned ldsw = (unsigned)wid * 1024u;
    const int aoff = lds_byte(wr * 64 + fr, fq * 8), boff = lds_byte(wc * 32 + fr, fq * 8);
#define G8_SA(b, h) (((b) * 2 + (h)) * HTB)
#define G8_SB(b, h) ((4 + (b) * 2 + (h)) * HTB)
#define G8_STAGE(bufoff, gbase, voff) do { _Pragma("unroll") for (int _i = 0; _i < 2; ++_i) \
        __builtin_amdgcn_global_load_lds((const unsigned*)((const char*)(gbase) + (voff)[_i]), (LAS unsigned*)(lds + (bufoff) + ldsw + _i * 8192), 16, 0, 0); } while (0)
#define G8_LDA(dst, b, h) do { _Pragma("unroll") for (int m = 0; m < 4; ++m) _Pragma("unroll") for (int k = 0; k < 2; ++k) dst[m][k] = *(const LAS bf16x8*)(lds + G8_SA(b, h) + aoff + m * 2048 + k * 1024); } while (0)
#define G8_LDB(dst, b, h) do { _Pragma("unroll") for (int n = 0; n < 2; ++n) _Pragma("unroll") for (int k = 0; k < 2; ++k) dst[n][k] = *(const LAS bf16x8*)(lds + G8_SB(b, h) + boff + n * 2048 + k * 1024); } while (0)
#define G8_MMA(ai, bj, At, Bt) do { __builtin_amdgcn_s_setprio(1); _Pragma("unroll") for (int m = 0; m < 4; ++m) _Pragma("unroll") for (int n = 0; n < 2; ++n) _Pragma("unroll") for (int k = 0; k < 2; ++k) \
        acc[ai][bj][m][n] = __builtin_amdgcn_mfma_f32_16x16x32_bf16(Bt[n][k], At[m][k], acc[ai][bj][m][n], 0, 0, 0); __builtin_amdgcn_s_setprio(0); } while (0)
#define G8_WAIT_V(n) asm volatile("s_waitcnt vmcnt(" #n ")" ::: "memory")
#define G8_WAIT_L(n) asm volatile("s_waitcnt lgkmcnt(" #n ")" ::: "memory")
#define G8_BAR __builtin_amdgcn_s_barrier()
#define G8_SCHED __builtin_amdgcn_sched_barrier(0)
    Unit cur, nxt; int ui = 0;
    if (!S.next(0, cur)) return;
    f32x4 acc[2][2][4][2];
#pragma unroll
    for (int a = 0; a < 2; ++a)
#pragma unroll
        for (int b = 0; b < 2; ++b)
#pragma unroll
            for (int m = 0; m < 4; ++m)
#pragma unroll
                for (int n = 0; n < 2; ++n) acc[a][b][m][n] = (f32x4){0.f, 0.f, 0.f, 0.f};
    bf16x8 At[4][2], B0[2][2], B1[2][2];
    unsigned oc[2][2];
    S.aoff(cur, tid, oc);
    const char* cA = cur.A; const char* cB = cur.B;
    G8_STAGE(G8_SB(0, 0), cB, voffB); G8_STAGE(G8_SA(0, 0), cA, oc[0]); G8_STAGE(G8_SB(0, 1), cB + hstep, voffB); G8_STAGE(G8_SA(0, 1), cA, oc[1]);
    if (wr == 1) G8_BAR;
    G8_WAIT_V(4); G8_BAR;
    G8_STAGE(G8_SB(1, 0), cB + kstep, voffB); G8_STAGE(G8_SA(1, 0), cA + kstep, oc[0]); G8_STAGE(G8_SB(1, 1), cB + hstep + kstep, voffB);
    G8_WAIT_V(6); G8_BAR;
    for (;;) {
        const bool has_next = S.next(ui + 1, nxt);
        const char* nA = has_next ? nxt.A : cA; const char* nB = has_next ? nxt.B : cB;
#pragma unroll 1
        for (int t = 0; t < nt; t += 2) {
            const bool last = (t == nt - 2);
            const char* a1 = cA + (size_t)(t + 1) * kstep;
            const char* a2 = last ? nA : cA + (size_t)(t + 2) * kstep; const char* b2 = last ? nB : cB + (size_t)(t + 2) * kstep;
            const char* a3 = a2 + kstep; const char* b3 = b2 + kstep;
            G8_LDB(B0, 0, 0); G8_SCHED; G8_LDA(At, 0, 0); G8_STAGE(G8_SA(1, 1), a1, oc[1]);
            if (last && has_next) S.aoff(nxt, tid, oc);
            G8_WAIT_L(8); G8_BAR; G8_WAIT_L(0); G8_MMA(0, 0, At, B0); G8_BAR; G8_SCHED;
            G8_LDB(B1, 0, 1); G8_STAGE(G8_SB(0, 0), b2, voffB);
            G8_BAR; G8_WAIT_L(0); G8_MMA(0, 1, At, B1); G8_BAR;
            G8_LDA(At, 0, 1); G8_STAGE(G8_SA(0, 0), a2, oc[0]);
            G8_BAR; G8_WAIT_L(0); G8_MMA(1, 0, At, B0); G8_BAR; G8_SCHED;
            G8_STAGE(G8_SB(0, 1), b2 + hstep, voffB);
            G8_WAIT_V(6); G8_BAR; G8_MMA(1, 1, At, B1); G8_BAR;
            G8_LDB(B0, 1, 0); G8_SCHED; G8_LDA(At, 1, 0); G8_STAGE(G8_SA(0, 1), a2, oc[1]);
            G8_WAIT_L(8); G8_BAR; G8_WAIT_L(0); G8_MMA(0, 0, At, B0); G8_BAR; G8_SCHED;
            G8_LDB(B1, 1, 1); G8_STAGE(G8_SB(1, 0), b3, voffB);
            G8_BAR; G8_WAIT_L(0); G8_MMA(0, 1, At, B1); G8_BAR;
            G8_LDA(At, 1, 1); G8_STAGE(G8_SA(1, 0), a3, oc[0]);
            G8_BAR; G8_WAIT_L(0); G8_MMA(1, 0, At, B0); G8_BAR; G8_SCHED;
            G8_STAGE(G8_SB(1, 1), b3 + hstep, voffB);
            G8_WAIT_V(6); G8_BAR; G8_MMA(1, 1, At, B1); G8_BAR;
        }
        E(acc, cur, wr, wc, fr, fq);
        if (!has_next) break;
#pragma unroll
        for (int a = 0; a < 2; ++a)
#pragma unroll
            for (int b = 0; b < 2; ++b)
#pragma unroll
                for (int m = 0; m < 4; ++m)
#pragma unroll
                    for (int n = 0; n < 2; ++n) acc[a][b][m][n] = (f32x4){0.f, 0.f, 0.f, 0.f};
        cur = nxt; cA = nA; cB = nB; ++ui;
    }
    G8_WAIT_V(0);
    if (wr == 0) G8_BAR;
    G8_BAR;
#undef G8_SA
#undef G8_SB
#undef G8_STAGE
#undef G8_LDA
#undef G8_LDB
#undef G8_MMA
#undef G8_WAIT_V
#undef G8_WAIT_L
#undef G8_BAR
#undef G8_SCHED
}
}

constexpr int NTHREADS = 512;
constexpr int LDS_STAGE = 0;
constexpr int LDS_TAB   = g8::STAGE_BYTES;
constexpr int TAB_SLOTS = 12;
constexpr int LDS_DESC  = LDS_TAB + TAB_SLOTS * 256 * 4;
constexpr int LDS_PREF  = LDS_DESC + 64;
constexpr int LDS_MISC  = LDS_PREF + 132 * 4 + 48;
constexpr int LDS_BYTES = 147456;
static_assert(LDS_MISC % 16 == 0 && LDS_MISC + 64 <= LDS_BYTES, "LDS map");

struct Params { const float* in[31]; float* out; unsigned char* ws; int ph_lo, ph_hi; };

struct Ctx {
    const float* const* in; float* out; unsigned char* ws; LAS unsigned char* lds;
    int tid, lane, wid, bid, G, gtid, gthreads, gw, nwaves;
};

__device__ __forceinline__ int ab_phys(int n) {
    if (n < 1024) { const int hd = n >> 6, jj = n & 63; return (hd >> 2) * 256 + (jj >> 5) * 128 + (hd & 3) * 32 + (jj & 31); }
    if (n < 1152) { const int nn = n - 1024, hh = nn >> 6, jj = nn & 63; return 1024 + (jj >> 5) * 128 + hh * 32 + (jj & 31); }
    if (n < 1280) { const int vv = n - 1152; return 1024 + (vv >> 6) * 128 + 64 + (vv & 63); }
    if (n < 2304) { const int base = n < 1792 ? 1280 : 1792, nn = n - base, h = nn >> 7, jj = nn & 127; return base + (h >> 1) * 256 + (jj >> 6) * 128 + (h & 1) * 64 + (jj & 63); }
    return n;
}
template <class DstFn>
__device__ __forceinline__ void convert_T(const Ctx& c, const float* src, int nmat, int K, int N, DstFn dstfn) {
    LAS float* tile = (LAS float*)(c.lds);
    const int tk = K / 64, tn = N / 64; const long ntiles = (long)nmat * tk * tn;
    for (long tix = c.bid; tix < ntiles; tix += c.G) {
        const int m = (int)(tix / (tk * tn)); const int rem = (int)(tix % (tk * tn)); const int kt = rem / tn, nt = rem % tn;
        const float* s = src + (size_t)m * K * N + (size_t)(kt * 64) * N + nt * 64;
#pragma unroll
        for (int i = 0; i < 2; ++i) { const int k = (c.tid >> 4) + 32 * i, n4 = (c.tid & 15) * 4; const f32x4 v = *(const f32x4*)(s + (size_t)k * N + n4);
            tile[k * 65 + n4 + 0] = v[0]; tile[k * 65 + n4 + 1] = v[1]; tile[k * 65 + n4 + 2] = v[2]; tile[k * 65 + n4 + 3] = v[3]; }
        __syncthreads();
        { const int n = c.tid >> 3, k8 = (c.tid & 7) * 8; u32x4 w;
          w[0] = pk2(tile[(k8 + 0) * 65 + n], tile[(k8 + 1) * 65 + n]); w[1] = pk2(tile[(k8 + 2) * 65 + n], tile[(k8 + 3) * 65 + n]);
          w[2] = pk2(tile[(k8 + 4) * 65 + n], tile[(k8 + 5) * 65 + n]); w[3] = pk2(tile[(k8 + 6) * 65 + n], tile[(k8 + 7) * 65 + n]);
          bf16_t* d = dstfn(m, nt * 64 + n) + kt * 64 + k8; *(u32x4*)d = w; }
        __syncthreads();
    }
}

__device__ __forceinline__ void phase_convert(const Ctx& c) {
    unsigned char* ws = c.ws;
    { const float* x = c.in[0]; float* xo = (float*)(ws + WS_X); bf16_t* xb = (bf16_t*)(ws + WS_XB);
      for (long i = c.gtid; i < (long)T * D / 4; i += c.gthreads) { const f32x4 v = *(const f32x4*)(x + i * 4); *(f32x4*)(xo + i * 4) = v; u32x2 w; w[0] = pk2(v[0], v[1]); w[1] = pk2(v[2], v[3]); *(u32x2*)(xb + i * 4) = w; } }
    { bf16_t* wrt = (bf16_t*)(ws + WS_WRT); for (long i = c.gtid; i < (long)4 * 128 * D / 8; i += c.gthreads) { const long l = i / (128 * D / 8), r = i % (128 * D / 8); *(u32x4*)(wrt + (size_t)l * 256 * D + (size_t)128 * D + r * 8) = (u32x4){0u, 0u, 0u, 0u}; }
      float* gate = (float*)(ws + WS_GATE); for (int i = c.gtid; i < T; i += c.gthreads) gate[TK + i] = 1.f;
      f32x2* ra = (f32x2*)(ws + WS_ROPEA); f32x2* rr = (f32x2*)(ws + WS_ROPER);
      for (int i = c.gtid; i < SEQ * 96; i += c.gthreads) { const int sidx = i / 96, q = i % 96; const bool isA = q < 32; const int jx = isA ? q : q - 32;
          const float e = isA ? (float)jx * (1.f / 32.f) : (float)jx * (1.f / 63.f); const float ang = (float)sidx * exp2f(-e * 13.287712379549449f); float sn, cs; sincosf(ang, &sn, &cs);
          if (isA) ra[sidx * 32 + jx] = (f32x2){cs, sn}; else rr[sidx * 64 + jx] = (f32x2){cs, sn}; }
      float* bp = (float*)(ws + WS_BIASP); for (int i = c.gtid; i < 2 * AB_IN; i += c.gthreads) { const int m = i / AB_IN, n = i % AB_IN; bp[m * AB_IN + ab_phys(n)] = c.in[2][i]; } }
    { bf16_t* d = (bf16_t*)(ws + WS_WABIN);  convert_T(c, c.in[1], 2, D, AB_IN, [=](int m, int n) { return d + (size_t)m * AB_IN * D + (size_t)ab_phys(n) * D; }); }
    { bf16_t* d = (bf16_t*)(ws + WS_WABOUT); convert_T(c, c.in[4], 2, AB_OUT, D, [=](int m, int n) { return d + (size_t)m * D * AB_OUT + (size_t)n * AB_OUT; }); }
    { bf16_t* d = (bf16_t*)(ws + WS_WCDIN);  convert_T(c, c.in[6], 2, D, CD_IN, [=](int m, int n) { return d + (size_t)m * CD_IN * D + (size_t)n * D; }); }
    { bf16_t* d = (bf16_t*)(ws + WS_WCDOUT); convert_T(c, c.in[17], 2, CD_OUT, D, [=](int m, int n) { return d + (size_t)m * D * CD_OUT + (size_t)n * CD_OUT; }); }
    { bf16_t* d = (bf16_t*)(ws + WS_WRT);    convert_T(c, c.in[21], 4, D, NE, [=](int m, int n) { return d + (size_t)m * 256 * D + (size_t)n * D; }); }
    { bf16_t* d = (bf16_t*)(ws + WS_WGU);
      convert_T(c, c.in[23], 4 * NE, D, ED, [=](int m, int n) { return d + (size_t)((m >> 7) * NE1 + (m & 127)) * 512 * D + (size_t)((n >> 7) * 256 + (n & 127)) * D; });
      convert_T(c, c.in[24], 4 * NE, D, ED, [=](int m, int n) { return d + (size_t)((m >> 7) * NE1 + (m & 127)) * 512 * D + (size_t)((n >> 7) * 256 + 128 + (n & 127)) * D; });
      convert_T(c, c.in[26], 4, D, ED, [=](int m, int n) { return d + (size_t)(m * NE1 + NE) * 512 * D + (size_t)((n >> 7) * 256 + (n & 127)) * D; });
      convert_T(c, c.in[27], 4, D, ED, [=](int m, int n) { return d + (size_t)(m * NE1 + NE) * 512 * D + (size_t)((n >> 7) * 256 + 128 + (n & 127)) * D; }); }
    { bf16_t* d = (bf16_t*)(ws + WS_WLRU);
      convert_T(c, c.in[12], 10, 256, 256, [=](int m, int n) { return d + (size_t)(m * 2 + 0) * 65536 + (size_t)n * 256; });
      convert_T(c, c.in[14], 10, 256, 256, [=](int m, int n) { return d + (size_t)(m * 2 + 1) * 65536 + (size_t)n * 256; });
      float* spl = (float*)(ws + WS_SPL); for (int i = c.gtid; i < 2 * 1280; i += c.gthreads) spl[i] = log1pf(expf(-c.in[16][i])); }
    { bf16_t* d = (bf16_t*)(ws + WS_WDN);
      convert_T(c, c.in[25], 4 * NE, ED, D, [=](int m, int n) { return d + (size_t)((m >> 7) * NE1 + (m & 127)) * D * ED + (size_t)n * ED; });
      convert_T(c, c.in[28], 4, ED, D, [=](int m, int n) { return d + (size_t)(m * NE1 + NE) * D * ED + (size_t)n * ED; }); }
}

__device__ __forceinline__ void phase_dense(const Ctx& c, const bf16_t* A, const bf16_t* Bt, int M, int N, int K, float* C, int ldc, const float* bias) {
    g8::DenseOrder S; S.init(A, Bt, M, N, K, c.G, c.bid);
    g8::EpiF32 E{C, ldc, bias};
    g8::gemm_phase<g8::EpiF32, g8::DenseOrder>(c.lds + LDS_STAGE, K, S, E);
}

struct EpiABIn {
    static constexpr bool PERM = true;
    const float* biasP; unsigned char* ws;
    __device__ __forceinline__ void operator()(const f32x4 (&acc)[2][2][4][2], const g8::Unit& u, int wr, int wc, int fr, int fq) const {
        const int pn = u.pn; const int colp = pn * 256 + wc * 32 + fq * 8;
        f32x4 bv[2][2];
#pragma unroll
        for (int bj = 0; bj < 2; ++bj)
#pragma unroll
            for (int n = 0; n < 2; ++n) bv[bj][n] = *(const f32x4*)(biasP + colp + bj * 128 + 4 * n);
        bf16_t* qb = (bf16_t*)(ws + AB_QB); bf16_t* kb = (bf16_t*)(ws + AB_KB); bf16_t* vT = (bf16_t*)(ws + AB_VT); bf16_t* rqb = (bf16_t*)(ws + AB_RQB); bf16_t* rkb = (bf16_t*)(ws + AB_RKB);
        bf16_t* rkdT = (bf16_t*)(ws + AB_RKDT); bf16_t* rvT = (bf16_t*)(ws + AB_RVT); bf16_t* rgb = (bf16_t*)(ws + AB_RGB);
        const f32x4* ropeA = (const f32x4*)(ws + WS_ROPEA); const f32x4* ropeR = (const f32x4*)(ws + WS_ROPER);
#pragma unroll
        for (int ai = 0; ai < 2; ++ai)
#pragma unroll
            for (int m = 0; m < 4; ++m) {
                const int t = u.pm * 256 + ai * 128 + wr * 64 + m * 16 + fr, sq = t & (SEQ - 1), b = t >> 13;
                f32x4 x[2][2];
#pragma unroll
                for (int bj = 0; bj < 2; ++bj)
#pragma unroll
                    for (int n = 0; n < 2; ++n) x[bj][n] = acc[ai][bj][m][n] + bv[bj][n];
                if (pn < 4 || (pn == 4 && wc < 2)) {
                    const int j0 = fq * 8; f32x4 o1[2], o2[2];
#pragma unroll
                    for (int n = 0; n < 2; ++n) { const f32x4 cs01 = ropeA[(sq * 32 + j0 + 4 * n) / 2], cs23 = ropeA[(sq * 32 + j0 + 4 * n) / 2 + 1];
                        const float cc[4] = {cs01[0], cs01[2], cs23[0], cs23[2]}, ss[4] = {cs01[1], cs01[3], cs23[1], cs23[3]};
#pragma unroll
                        for (int e = 0; e < 4; ++e) { o1[n][e] = x[0][n][e] * cc[e] - x[1][n][e] * ss[e]; o2[n][e] = x[1][n][e] * cc[e] + x[0][n][e] * ss[e]; } }
                    const float sc = pn < 4 ? 0.125f : 1.f;
                    u32x4 w1, w2;
#pragma unroll
                    for (int n = 0; n < 2; ++n) { w1[2 * n] = pk2(o1[n][0] * sc, o1[n][1] * sc); w1[2 * n + 1] = pk2(o1[n][2] * sc, o1[n][3] * sc); w2[2 * n] = pk2(o2[n][0] * sc, o2[n][1] * sc); w2[2 * n + 1] = pk2(o2[n][2] * sc, o2[n][3] * sc); }
                    bf16_t* dst = pn < 4 ? qb + (size_t)t * 1024 + (pn * 4 + wc) * 64 + j0 : kb + (size_t)t * 128 + wc * 64 + j0;
                    *(u32x4*)dst = w1; *(u32x4*)(dst + 32) = w2;
                } else if (pn == 4) {
                    const int d0 = (wc - 2) * 32 + fq * 8;
#pragma unroll
                    for (int bj = 0; bj < 2; ++bj)
#pragma unroll
                        for (int n = 0; n < 2; ++n)
#pragma unroll
                            for (int e = 0; e < 4; ++e) vT[((size_t)(b * 2 + bj) * 64 + d0 + 4 * n + e) * SEQ + sq] = f2bf(x[bj][n][e]);
                } else if (pn < 9) {
                    const bool isk = pn >= 7; const int h = ((pn - 5) & 1) * 2 + (wc >> 1), j0 = (wc & 1) * 32 + fq * 8; f32x4 o1[2], o2[2];
                    const float sc = isk ? 0.08838834764831845f : 1.f;
#pragma unroll
                    for (int n = 0; n < 2; ++n) { const f32x4 cs01 = ropeR[(sq * 64 + j0 + 4 * n) / 2], cs23 = ropeR[(sq * 64 + j0 + 4 * n) / 2 + 1];
                        const float cc[4] = {cs01[0], cs01[2], cs23[0], cs23[2]}, ss[4] = {cs01[1], cs01[3], cs23[1], cs23[3]};
#pragma unroll
                        for (int e = 0; e < 4; ++e) { o1[n][e] = (x[0][n][e] * cc[e] - x[1][n][e] * ss[e]) * sc; o2[n][e] = (x[1][n][e] * cc[e] + x[0][n][e] * ss[e]) * sc; } }
                    u32x4 w1, w2;
#pragma unroll
                    for (int n = 0; n < 2; ++n) { w1[2 * n] = pk2(o1[n][0], o1[n][1]); w1[2 * n + 1] = pk2(o1[n][2], o1[n][3]); w2[2 * n] = pk2(o2[n][0], o2[n][1]); w2[2 * n + 1] = pk2(o2[n][2], o2[n][3]); }
                    bf16_t* dst = (isk ? rkb : rqb) + (size_t)t * 512 + h * 128 + j0;
                    *(u32x4*)dst = w1; *(u32x4*)(dst + 64) = w2;
                    if (isk) {
                        const float lg = log2f(1.f - exp2f(-5.f - (float)h)); const float dec = exp2f((float)(127 - (sq & 127)) * lg);
                        bf16_t* dT = rkdT + ((size_t)(b * 4 + h) * 128 + j0) * SEQ + sq;
#pragma unroll
                        for (int n = 0; n < 2; ++n)
#pragma unroll
                            for (int e = 0; e < 4; ++e) { dT[(size_t)(4 * n + e) * SEQ] = f2bf(o1[n][e] * dec); dT[(size_t)(64 + 4 * n + e) * SEQ] = f2bf(o2[n][e] * dec); }
                    }
                } else if (pn < 13) {
                    const int h = pn - 9;
#pragma unroll
                    for (int bj = 0; bj < 2; ++bj)
#pragma unroll
                        for (int n = 0; n < 2; ++n)
#pragma unroll
                            for (int e = 0; e < 4; ++e) rvT[((size_t)(b * 4 + h) * 256 + bj * 128 + wc * 32 + fq * 8 + 4 * n + e) * SEQ + sq] = f2bf(x[bj][n][e]);
                } else {
#pragma unroll
                    for (int bj = 0; bj < 2; ++bj) { u32x4 w;
#pragma unroll
                        for (int n = 0; n < 2; ++n) { w[2 * n] = pk2(siluf_(x[bj][n][0]), siluf_(x[bj][n][1])); w[2 * n + 1] = pk2(siluf_(x[bj][n][2]), siluf_(x[bj][n][3])); }
                        *(u32x4*)(rgb + (size_t)t * 1024 + (pn - 13) * 256 + bj * 128 + wc * 32 + fq * 8) = w; }
                }
            }
    }
};
__device__ __forceinline__ void phase_ab_inproj(const Ctx& c, int j) {
    g8::DenseOrder S; S.init(c.ws + WS_XB, c.ws + WS_WABIN + (size_t)j * AB_IN * D * 2, T, AB_IN, D, c.G, c.bid);
    EpiABIn E{(const float*)(c.ws + WS_BIASP) + (size_t)j * AB_IN, c.ws};
    g8::gemm_phase<EpiABIn, g8::DenseOrder>(c.lds + LDS_STAGE, D, S, E);
}

#define MFMA16(a, b, c) __builtin_amdgcn_mfma_f32_16x16x32_bf16((a), (b), (c), 0, 0, 0)
__device__ __forceinline__ bf16x8 pack8(const f32x4& lo, const f32x4& hi) { u32x4 w; w[0] = g8::cvt_pk_bf16(lo[0], lo[1]); w[1] = g8::cvt_pk_bf16(lo[2], lo[3]); w[2] = g8::cvt_pk_bf16(hi[0], hi[1]); w[3] = g8::cvt_pk_bf16(hi[2], hi[3]); return __builtin_bit_cast(bf16x8, w); }
__device__ __forceinline__ bf16x8 cat8(const u32x2& lo, const u32x2& hi) { u32x4 w; w[0] = lo[0]; w[1] = lo[1]; w[2] = hi[0]; w[3] = hi[1]; return __builtin_bit_cast(bf16x8, w); }
template <int ROWS, int RB>
__device__ __forceinline__ void tile_g2l(LAS unsigned char* dst, const unsigned char* src, size_t gs, int tid, int zrows = 0) {
    constexpr int CPR = RB / 16, TOTAL = ROWS * CPR;
#pragma unroll 4
    for (int i = tid; i < TOTAL; i += NTHREADS) { const int r = i / CPR, cc = i % CPR; u32x4 v = (u32x4){0u, 0u, 0u, 0u}; if (r >= zrows) v = *(const u32x4*)(src + (size_t)r * gs + cc * 16);
        *(LAS u32x4*)(dst + r * (RB + 16) + cc * 16) = v; }
}

__device__ __forceinline__ void attn_unit(const Ctx& c, int unit, const float* sinks) {
    const int b = unit >> 7, n = (unit >> 1) & 63, kvh = unit & 1, hd = kvh * 8 + c.wid, lane = c.lane, fr = lane & 15, fq = lane >> 4;
    const bf16_t* qb = (const bf16_t*)(c.ws + AB_QB); const bf16_t* kb = (const bf16_t*)(c.ws + AB_KB); const bf16_t* vT = (const bf16_t*)(c.ws + AB_VT); bf16_t* ycat = (bf16_t*)(c.ws + WS_YCAT);
    LAS unsigned char* Ks = c.lds; LAS unsigned char* Vs = c.lds + 256 * 144;
    const int t0 = b * SEQ + n * 128;
    __syncthreads();
    {
        const unsigned char* src = (const unsigned char*)(kb + (size_t)(t0 - 128) * 128 + kvh * 64);
        constexpr int TOTAL = 256 * 8;
#pragma unroll 4
        for (int i = c.tid; i < TOTAL; i += NTHREADS) { const int r = i >> 3, cc = i & 7; u32x4 v = (u32x4){0u, 0u, 0u, 0u}; if (n > 0 || r >= 128) v = *(const u32x4*)(src + (ptrdiff_t)r * 256 + cc * 16);
            *(LAS u32x4*)(Ks + r * 144 + cc * 16) = v; }
        const unsigned char* vsrc = (const unsigned char*)(vT + (size_t)(b * 2 + kvh) * 64 * SEQ + (n * 128 - 128));
        constexpr int TV = 64 * 32;
#pragma unroll 4
        for (int i = c.tid; i < TV; i += NTHREADS) { const int r = i >> 5, cc = i & 31; u32x4 v = (u32x4){0u, 0u, 0u, 0u}; if (n > 0 || cc >= 16) v = *(const u32x4*)(vsrc + (ptrdiff_t)r * SEQ * 2 + cc * 16);
            *(LAS u32x4*)(Vs + r * 528 + cc * 16) = v; }
    }
    __syncthreads();
    const float sink = sinks[hd];
    for (int si = 0; si < 8; ++si) {
        const int t = t0 + si * 16 + fr;
        bf16x8 qf[2];
#pragma unroll
        for (int ks = 0; ks < 2; ++ks) qf[ks] = *(const bf16x8*)(qb + (size_t)t * 1024 + hd * 64 + ks * 32 + fq * 8);
        f32x4 S[10];
#pragma unroll
        for (int nk = 0; nk < 9; ++nk) { S[nk] = (f32x4){0.f, 0.f, 0.f, 0.f};
#pragma unroll
            for (int ks = 0; ks < 2; ++ks) { const bf16x8 a = *(const LAS bf16x8*)(Ks + (16 * (si + nk) + fr) * 144 + ks * 64 + fq * 16); S[nk] = MFMA16(a, qf[ks], S[nk]); } }
        S[9] = (f32x4){0.f, 0.f, 0.f, 0.f};
        const int i = si * 16 + fr;
        float mx = sink;
#pragma unroll
        for (int nk = 0; nk < 9; ++nk)
#pragma unroll
            for (int r = 0; r < 4; ++r) { const int p = 16 * (si + nk) + 4 * fq + r; const bool ok = (p >= i + 1) && (p <= i + 128) && (n > 0 || p >= 128);
                S[nk][r] = ok ? S[nk][r] : -1e30f; mx = fmaxf(mx, S[nk][r]); }
        mx = fmaxf(mx, __shfl_xor(mx, 16)); mx = fmaxf(mx, __shfl_xor(mx, 32));
        float sum = 0.f;
#pragma unroll
        for (int nk = 0; nk < 9; ++nk)
#pragma unroll
            for (int r = 0; r < 4; ++r) { const float pv = S[nk][r] > -1e29f ? exp2f((S[nk][r] - mx) * 1.4426950408889634f) : 0.f; S[nk][r] = pv; sum += pv; }
        sum += __shfl_xor(sum, 16); sum += __shfl_xor(sum, 32);
        const float inv = 1.f / (sum + exp2f((sink - mx) * 1.4426950408889634f));
        f32x4 O[4];
#pragma unroll
        for (int nd = 0; nd < 4; ++nd) O[nd] = (f32x4){0.f, 0.f, 0.f, 0.f};
#pragma unroll
        for (int kk = 0; kk < 5; ++kk) { const bf16x8 pf = pack8(S[2 * kk], S[2 * kk + 1]);
            const int p0 = 16 * (si + 2 * kk) + 4 * fq, p1 = (kk == 4 && si == 7) ? p0 : p0 + 16;
#pragma unroll
            for (int nd = 0; nd < 4; ++nd) { const u32x2 lo = *(const LAS u32x2*)(Vs + (16 * nd + fr) * 528 + p0 * 2), hi = *(const LAS u32x2*)(Vs + (16 * nd + fr) * 528 + p1 * 2);
                O[nd] = MFMA16(cat8(lo, hi), pf, O[nd]); } }
#pragma unroll
        for (int nd = 0; nd < 4; ++nd) { u32x2 w; w[0] = pk2(O[nd][0] * inv, O[nd][1] * inv); w[1] = pk2(O[nd][2] * inv, O[nd][3] * inv);
            *(u32x2*)(ycat + (size_t)t * AB_OUT + hd * 64 + 16 * nd + 4 * fq) = w; }
    }
}

__device__ __forceinline__ void ret_kv_unit(const Ctx& c, int unit) {
    const int b = unit >> 8, n = (unit >> 2) & 63, h = unit & 3, lane = c.lane, fr = lane & 15, fq = lane >> 4, w = c.wid;
    const bf16_t* rkdT = (const bf16_t*)(c.ws + AB_RKDT); const bf16_t* rvT = (const bf16_t*)(c.ws + AB_RVT); float* kv = (float*)(c.ws + AB_KV);
    LAS unsigned char* Kd = c.lds;
    __syncthreads();
    tile_g2l<128, 256>(Kd, (const unsigned char*)(rkdT + (size_t)(b * 4 + h) * 128 * SEQ + n * 128), (size_t)SEQ * 2, c.tid);
    bf16x8 vf[2][4];
#pragma unroll
    for (int ne = 0; ne < 2; ++ne)
#pragma unroll
        for (int ks = 0; ks < 4; ++ks) vf[ne][ks] = *(const bf16x8*)(rvT + ((size_t)(b * 4 + h) * 256 + 32 * w + 16 * ne + fr) * SEQ + n * 128 + ks * 32 + fq * 8);
    __syncthreads();
    float* out = kv + ((size_t)((b * 64 + n) * 4 + h)) * 256 * 128;
#pragma unroll
    for (int nd = 0; nd < 8; ++nd) { f32x4 a0 = (f32x4){0.f, 0.f, 0.f, 0.f}, a1 = a0;
#pragma unroll
        for (int ks = 0; ks < 4; ++ks) { const bf16x8 kf = *(const LAS bf16x8*)(Kd + (16 * nd + fr) * 272 + ks * 64 + fq * 16); a0 = MFMA16(kf, vf[0][ks], a0); a1 = MFMA16(kf, vf[1][ks], a1); }
        *(f32x4*)(out + (size_t)(32 * w + fr) * 128 + 16 * nd + 4 * fq) = a0; *(f32x4*)(out + (size_t)(32 * w + 16 + fr) * 128 + 16 * nd + 4 * fq) = a1; }
}
__device__ __forceinline__ void ret_scan(const Ctx& c, int first_block, int nblocks) {
    const float* kv = (const float*)(c.ws + AB_KV); bf16_t* sp = (bf16_t*)(c.ws + AB_SPREV);
    const int nthr = nblocks * NTHREADS;
    for (int idx = (c.bid - first_block) * NTHREADS + c.tid; idx < 2 * 4 * 256 * 128 / 4; idx += nthr) {
        const int b = idx >> 15, rem = idx & 32767, h = rem >> 13;
        const float g = exp2f(128.f * log2f(1.f - exp2f(-5.f - (float)h)));
        const size_t base = (size_t)b * 64 * 131072 + (size_t)rem * 4;
        f32x4 st = (f32x4){0.f, 0.f, 0.f, 0.f};
        for (int n0 = 0; n0 < 64; n0 += 8) { f32x4 v[8];
#pragma unroll
            for (int q = 0; q < 8; ++q) v[q] = *(const f32x4*)(kv + base + (size_t)(n0 + q) * 131072);
#pragma unroll
            for (int q = 0; q < 8; ++q) { u32x2 wv; wv[0] = pk2(st[0], st[1]); wv[1] = pk2(st[2], st[3]); *(u32x2*)(sp + base + (size_t)(n0 + q) * 131072) = wv; st = st * g + v[q]; } }
    }
}
__device__ __forceinline__ void ret_out_unit(const Ctx& c, int unit) {
    const int b = unit >> 8, n = (unit >> 2) & 63, h = unit & 3, lane = c.lane, fr = lane & 15, fq = lane >> 4, w = c.wid;
    const bf16_t* rqb = (const bf16_t*)(c.ws + AB_RQB); const bf16_t* rkb = (const bf16_t*)(c.ws + AB_RKB); const bf16_t* rvT = (const bf16_t*)(c.ws + AB_RVT);
    const bf16_t* sp = (const bf16_t*)(c.ws + AB_SPREV); const bf16_t* rgb = (const bf16_t*)(c.ws + AB_RGB); bf16_t* ycat = (bf16_t*)(c.ws + WS_YCAT);
    LAS unsigned char* Kl = c.lds; LAS unsigned char* Bl = c.lds + 128 * 272;
    const int t0 = b * SEQ + n * 128; const float lg = log2f(1.f - exp2f(-5.f - (float)h));
    __syncthreads();
    tile_g2l<128, 256>(Kl, (const unsigned char*)(rkb + (size_t)t0 * 512 + h * 128), (size_t)512 * 2, c.tid);
    tile_g2l<256, 256>(Bl, (const unsigned char*)(sp + ((size_t)((b * 64 + n) * 4 + h)) * 256 * 128), (size_t)128 * 2, c.tid);
    const int t = t0 + 16 * w + fr, i = 16 * w + fr;
    bf16x8 qf[4];
#pragma unroll
    for (int ks = 0; ks < 4; ++ks) qf[ks] = *(const bf16x8*)(rqb + (size_t)t * 512 + h * 128 + ks * 32 + fq * 8);
    __syncthreads();
    bf16x8 pf[4];
#pragma unroll
    for (int kk = 0; kk < 4; ++kk) { f32x4 s2[2];
#pragma unroll
        for (int q = 0; q < 2; ++q) { const int nj = 2 * kk + q; s2[q] = (f32x4){0.f, 0.f, 0.f, 0.f};
            if (nj <= w) {
#pragma unroll
                for (int ks = 0; ks < 4; ++ks) { const bf16x8 kf = *(const LAS bf16x8*)(Kl + (16 * nj + fr) * 272 + ks * 64 + fq * 16); s2[q] = MFMA16(kf, qf[ks], s2[q]); }
#pragma unroll
                for (int r = 0; r < 4; ++r) { const int jj = 16 * nj + 4 * fq + r; s2[q][r] = (i >= jj) ? s2[q][r] * exp2f((float)(i - jj) * lg) : 0.f; } } }
        pf[kk] = pack8(s2[0], s2[1]); }
    f32x4 acc[16];
#pragma unroll
    for (int ne = 0; ne < 16; ++ne) { acc[ne] = (f32x4){0.f, 0.f, 0.f, 0.f};
#pragma unroll
        for (int ks = 0; ks < 4; ++ks) { const bf16x8 sf = *(const LAS bf16x8*)(Bl + (16 * ne + fr) * 272 + ks * 64 + fq * 16); acc[ne] = MFMA16(sf, qf[ks], acc[ne]); } }
    const float rs = exp2f((float)(i + 1) * lg);
#pragma unroll
    for (int ne = 0; ne < 16; ++ne) acc[ne] = acc[ne] * rs;
    __syncthreads();
    tile_g2l<256, 256>(Bl, (const unsigned char*)(rvT + (size_t)(b * 4 + h) * 256 * SEQ + n * 128), (size_t)SEQ * 2, c.tid);
    __syncthreads();
    const int nkk = (w >> 1) + 1;
#pragma unroll
    for (int kk = 0; kk < 4; ++kk) if (kk < nkk) {
#pragma unroll
        for (int ne = 0; ne < 16; ++ne) { const u32x2 lo = *(const LAS u32x2*)(Bl + (16 * ne + fr) * 272 + (32 * kk + 4 * fq) * 2), hi = *(const LAS u32x2*)(Bl + (16 * ne + fr) * 272 + (32 * kk + 16 + 4 * fq) * 2);
            acc[ne] = MFMA16(cat8(lo, hi), pf[kk], acc[ne]); } }
    float sm = 0.f;
#pragma unroll
    for (int ne = 0; ne < 16; ++ne) sm += acc[ne][0] + acc[ne][1] + acc[ne][2] + acc[ne][3];
    sm += __shfl_xor(sm, 16); sm += __shfl_xor(sm, 32);
    const float mean = sm * (1.f / 256.f); float sq = 0.f;
#pragma unroll
    for (int ne = 0; ne < 16; ++ne) { acc[ne] = acc[ne] - mean; sq += acc[ne][0] * acc[ne][0] + acc[ne][1] * acc[ne][1] + acc[ne][2] * acc[ne][2] + acc[ne][3] * acc[ne][3]; }
    sq += __shfl_xor(sq, 16); sq += __shfl_xor(sq, 32);
    const float rstd = rsqrtf(sq * (1.f / 256.f) + LN_EPS);
#pragma unroll
    for (int ne = 0; ne < 16; ++ne) { const u32x2 gw = *(const u32x2*)(rgb + (size_t)t * 1024 + h * 256 + 16 * ne + 4 * fq);
        const float g0 = __uint_as_float(gw[0] << 16), g1 = __uint_as_float(gw[0] & 0xffff0000u), g2 = __uint_as_float(gw[1] << 16), g3 = __uint_as_float(gw[1] & 0xffff0000u);
        u32x2 o; o[0] = pk2(acc[ne][0] * rstd * g0, acc[ne][1] * rstd * g1); o[1] = pk2(acc[ne][2] * rstd * g2, acc[ne][3] * rstd * g3);
        *(u32x2*)(ycat + (size_t)t * AB_OUT + 1024 + h * 256 + 16 * ne + 4 * fq) = o; }
}

__device__ __forceinline__ void phase_ab_p1(const Ctx& c) {
    for (int u = c.bid; u < 512; u += c.G) ret_kv_unit(c, u);
}
__device__ __forceinline__ void phase_ab_p2(const Ctx& c, int j) {
    if (c.bid < 64) ret_scan(c, 0, 64);
    else { const float* sinks = c.in[3] + j * 16; for (int u = c.bid - 64; u < 256; u += c.G - 64) attn_unit(c, u, sinks); }
}
__device__ __forceinline__ void phase_ab_p3(const Ctx& c) {
    for (int u = c.bid; u < 512; u += c.G) ret_out_unit(c, u);
}

__device__ __forceinline__ float gelu_fast(float x) { const float u = 1.5957691216057308f * (x + 0.044715f * x * x * x); return x / (1.f + __expf(-u)); }
struct EpiCDIn {
    static constexpr bool PERM = true;
    const float* bias; unsigned char* ws;
    __device__ __forceinline__ void operator()(const f32x4 (&acc)[2][2][4][2], const g8::Unit& u, int wr, int wc, int fr, int fq) const {
        const int pn = u.pn; const int col0 = pn * 256 + wc * 32 + fq * 8;
        f32x4 bv[2][2];
#pragma unroll
        for (int bj = 0; bj < 2; ++bj)
#pragma unroll
            for (int n = 0; n < 2; ++n) bv[bj][n] = *(const f32x4*)(bias + col0 + bj * 128 + 4 * n);
        bf16_t* gu = (bf16_t*)(ws + CD_GU); bf16_t* gvT = (bf16_t*)(ws + CD_GVT); bf16_t* gg = (bf16_t*)(ws + CD_GG); bf16_t* xr = (bf16_t*)(ws + CD_XR); float* stats = (float*)(ws + CD_STATS);
#pragma unroll
        for (int ai = 0; ai < 2; ++ai)
#pragma unroll
            for (int m = 0; m < 4; ++m) {
                const int t = u.pm * 256 + ai * 128 + wr * 64 + m * 16 + fr, sq = t & (SEQ - 1), b = t >> 13;
                f32x4 x[2][2];
#pragma unroll
                for (int bj = 0; bj < 2; ++bj)
#pragma unroll
                    for (int n = 0; n < 2; ++n) { x[bj][n] = acc[ai][bj][m][n] + bv[bj][n];
                        if (pn < 13) {
#pragma unroll
                            for (int e = 0; e < 4; ++e) x[bj][n][e] = gelu_fast(x[bj][n][e]); } }
                if (pn >= 4 && pn < 8) {
                    float s1 = 0.f, s2 = 0.f;
#pragma unroll
                    for (int bj = 0; bj < 2; ++bj)
#pragma unroll
                        for (int n = 0; n < 2; ++n)
#pragma unroll
                            for (int e = 0; e < 4; ++e) { const float v = x[bj][n][e]; s1 += v; s2 += v * v;
                                gvT[((size_t)b * 1024 + (pn - 4) * 256 + bj * 128 + wc * 32 + fq * 8 + 4 * n + e) * SEQ + sq] = f2bf(v); }
                    s1 += __shfl_xor(s1, 16); s1 += __shfl_xor(s1, 32); s2 += __shfl_xor(s2, 16); s2 += __shfl_xor(s2, 32);
                    if (fq == 0) *(f32x2*)(stats + (size_t)t * 32 + ((pn - 4) * 4 + wc) * 2) = (f32x2){s1, s2};
                } else {
                    bf16_t* dst; int ld, cb;
                    if (pn < 4) { dst = gu; ld = 1024; cb = pn * 256; } else if (pn < 13) { dst = gg; ld = 1280; cb = (pn - 8) * 256; } else { dst = xr; ld = 1280; cb = (pn - 13) * 256; }
#pragma unroll
                    for (int bj = 0; bj < 2; ++bj) { u32x4 w;
#pragma unroll
                        for (int n = 0; n < 2; ++n) { w[2 * n] = pk2(x[bj][n][0], x[bj][n][1]); w[2 * n + 1] = pk2(x[bj][n][2], x[bj][n][3]); }
                        *(u32x4*)(dst + (size_t)t * ld + cb + bj * 128 + wc * 32 + fq * 8) = w; }
                }
            }
    }
};
__device__ __forceinline__ void phase_cd_inproj(const Ctx& c, int j) {
    g8::DenseOrder S; S.init(c.ws + WS_XB, c.ws + WS_WCDIN + (size_t)j * CD_IN * D * 2, T, CD_IN, D, c.G, c.bid);
    EpiCDIn E{c.in[7] + (size_t)j * CD_IN, c.ws};
    g8::gemm_phase<EpiCDIn, g8::DenseOrder>(c.lds + LDS_STAGE, D, S, E);
}

__device__ __forceinline__ void lru_unit(const Ctx& c, int unit, int j) {
    const int hh = unit % 5, bn = unit / 5, lane = c.lane, fr = lane & 15, fq = lane >> 4, w = c.wid;
    const int t0 = bn * 128, s0 = t0 & (SEQ - 1);
    const bf16_t* xr = (const bf16_t*)(c.ws + CD_XR); bf16_t* HL = (bf16_t*)(c.ws + WS_U2); bf16_t* PC = HL + (size_t)T * 1280; float* sum = (float*)(c.ws + WS_H);
    const float* conv_w = c.in[10] + (size_t)j * 4 * 1280 + hh * 256; const float* conv_b = c.in[11] + (size_t)j * 1280 + hh * 256;
    const float* ba = c.in[13] + (size_t)j * 1280 + hh * 256; const float* bx = c.in[15] + (size_t)j * 1280 + hh * 256; const float* spl = (const float*)(c.ws + WS_SPL) + (size_t)j * 1280 + hh * 256;
    const bf16_t* Wl = (const bf16_t*)(c.ws + WS_WLRU) + (size_t)((j * 5 + hh) * 2) * 65536;
    LAS unsigned char* Xc = c.lds; LAS unsigned char* Wa = c.lds + 128 * 528; LAS unsigned char* Wx = Wa + 64 * 528; LAS unsigned char* Tot = Wx + 64 * 528;
    __syncthreads();
    for (int it = c.tid; it < 128 * 32; it += NTHREADS) { const int r = it >> 5, cg = it & 31;
        float a[8];
        { const f32x4 b0 = *(const f32x4*)(conv_b + cg * 8), b1 = *(const f32x4*)(conv_b + cg * 8 + 4); a[0] = b0[0]; a[1] = b0[1]; a[2] = b0[2]; a[3] = b0[3]; a[4] = b1[0]; a[5] = b1[1]; a[6] = b1[2]; a[7] = b1[3]; }
#pragma unroll
        for (int k = 0; k < 4; ++k) { if (s0 + r - 3 + k >= 0) {
                const u32x4 xv = *(const u32x4*)(xr + (size_t)(t0 + r - 3 + k) * 1280 + hh * 256 + cg * 8);
                const f32x4 w0 = *(const f32x4*)(conv_w + k * 1280 + cg * 8), w1 = *(const f32x4*)(conv_w + k * 1280 + cg * 8 + 4);
                a[0] += w0[0] * __uint_as_float(xv[0] << 16); a[1] += w0[1] * __uint_as_float(xv[0] & 0xffff0000u); a[2] += w0[2] * __uint_as_float(xv[1] << 16); a[3] += w0[3] * __uint_as_float(xv[1] & 0xffff0000u);
                a[4] += w1[0] * __uint_as_float(xv[2] << 16); a[5] += w1[1] * __uint_as_float(xv[2] & 0xffff0000u); a[6] += w1[2] * __uint_as_float(xv[3] << 16); a[7] += w1[3] * __uint_as_float(xv[3] & 0xffff0000u); } }
        u32x4 o; o[0] = pk2(a[0], a[1]); o[1] = pk2(a[2], a[3]); o[2] = pk2(a[4], a[5]); o[3] = pk2(a[6], a[7]);
        *(LAS u32x4*)(Xc + r * 528 + cg * 16) = o; }
    __syncthreads();
    bf16x8 xf[8];
#pragma unroll
    for (int ks = 0; ks < 8; ++ks) xf[ks] = *(const LAS bf16x8*)(Xc + (16 * w + fr) * 528 + ks * 64 + fq * 16);
    const int t = t0 + 16 * w + fr;
    for (int sl = 0; sl < 4; ++sl) {
        if (sl) __syncthreads();
        tile_g2l<64, 512>(Wa, (const unsigned char*)(Wl + (size_t)(sl * 64) * 256), 512, c.tid);
        tile_g2l<64, 512>(Wx, (const unsigned char*)(Wl + 65536 + (size_t)(sl * 64) * 256), 512, c.tid);
        __syncthreads();
        f32x4 sA[4], sB[4];
#pragma unroll
        for (int nc = 0; nc < 4; ++nc) { f32x4 ra = (f32x4){0.f, 0.f, 0.f, 0.f}, ri = ra;
#pragma unroll
            for (int ks = 0; ks < 8; ++ks) { const bf16x8 wa = *(const LAS bf16x8*)(Wa + (16 * nc + fr) * 528 + ks * 64 + fq * 16), wx = *(const LAS bf16x8*)(Wx + (16 * nc + fr) * 528 + ks * 64 + fq * 16);
                ra = MFMA16(wa, xf[ks], ra); ri = MFMA16(wx, xf[ks], ri); }
            const int ch = sl * 64 + 16 * nc + 4 * fq;
            const f32x4 b_a = *(const f32x4*)(ba + ch), b_x = *(const f32x4*)(bx + ch), sp = *(const f32x4*)(spl + ch);
            const u32x2 xw = *(const LAS u32x2*)(Xc + (16 * w + fr) * 528 + ch * 2);
            const float xcv[4] = {__uint_as_float(xw[0] << 16), __uint_as_float(xw[0] & 0xffff0000u), __uint_as_float(xw[1] << 16), __uint_as_float(xw[1] & 0xffff0000u)};
            f32x4 oa, ob;
#pragma unroll
            for (int r = 0; r < 4; ++r) { const float gr = sigmoidf_(ra[r] + b_a[r]), gi = sigmoidf_(ri[r] + b_x[r]); const float la = -8.f * gr * sp[r]; const float a = __expf(la);
                oa[r] = a; ob[r] = sqrtf(fmaxf(1.f - a * a, 0.f)) * (gi * xcv[r]); }
#pragma unroll
            for (int dlt = 1; dlt < 16; dlt <<= 1) {
#pragma unroll
                for (int r = 0; r < 4; ++r) { const float pa = __shfl_up(oa[r], dlt, 16), pb = __shfl_up(ob[r], dlt, 16); if (fr >= dlt) { ob[r] = oa[r] * pb + ob[r]; oa[r] = oa[r] * pa; } } }
            sA[nc] = oa; sB[nc] = ob;
            if (fr == 15) { *(LAS f32x4*)(Tot + ((w * 64 + 16 * nc + 4 * fq) * 2) * 4) = oa; *(LAS f32x4*)(Tot + ((w * 64 + 16 * nc + 4 * fq) * 2 + 4) * 4) = ob; }
        }
        __syncthreads();
#pragma unroll
        for (int nc = 0; nc < 4; ++nc) { const int ch = sl * 64 + 16 * nc + 4 * fq;
            f32x4 cp = (f32x4){1.f, 1.f, 1.f, 1.f}, chh = (f32x4){0.f, 0.f, 0.f, 0.f};
            for (int w2 = 0; w2 < w; ++w2) { const f32x4 ta = *(const LAS f32x4*)(Tot + ((w2 * 64 + 16 * nc + 4 * fq) * 2) * 4), tb = *(const LAS f32x4*)(Tot + ((w2 * 64 + 16 * nc + 4 * fq) * 2 + 4) * 4);
                chh = ta * chh + tb; cp = cp * ta; }
            const f32x4 hl = sB[nc] + sA[nc] * chh, pc = sA[nc] * cp;
            u32x2 o1, o2; o1[0] = pk2(hl[0], hl[1]); o1[1] = pk2(hl[2], hl[3]); o2[0] = pk2(pc[0], pc[1]); o2[1] = pk2(pc[2], pc[3]);
            *(u32x2*)(HL + (size_t)t * 1280 + hh * 256 + ch) = o1; *(u32x2*)(PC + (size_t)t * 1280 + hh * 256 + ch) = o2;
            if (w == 7 && fr == 15) { float* sm = sum + ((size_t)bn * 1280 + hh * 256 + ch) * 2;
#pragma unroll
                for (int r = 0; r < 4; ++r) { sm[2 * r] = pc[r]; sm[2 * r + 1] = hl[r]; } } }
    }
}

__device__ __forceinline__ void sgu_unit(const Ctx& c, int unit, int j) {
    const int g = unit & 3, bn = unit >> 2, b = bn >> 6, n = bn & 63, lane = c.lane, fr = lane & 15, fq = lane >> 4, w = c.wid;
    const int t0 = bn * 128;
    const bf16_t* gu = (const bf16_t*)(c.ws + CD_GU); const bf16_t* gvT = (const bf16_t*)(c.ws + CD_GVT); const float* stats = (const float*)(c.ws + CD_STATS); bf16_t* ycat = (bf16_t*)(c.ws + WS_YCAT);
    const float* sw = c.in[8] + (size_t)(j * 4 + g) * 16384; const float* sb = c.in[9] + (size_t)(j * 4 + g) * 128;
    LAS unsigned char* Vt = c.lds; LAS float* mr = (LAS float*)(c.lds + 256 * 272);
    __syncthreads();
    tile_g2l<256, 256>(Vt, (const unsigned char*)(gvT + ((size_t)b * 1024 + g * 256) * SEQ + n * 128), (size_t)SEQ * 2, c.tid);
    if (c.tid < 128) { const float* st = stats + (size_t)(t0 + c.tid) * 32; float s1 = 0.f, s2 = 0.f;
#pragma unroll
        for (int q = 0; q < 16; ++q) { s1 += st[2 * q]; s2 += st[2 * q + 1]; }
        const float mean = s1 * (1.f / 1024.f), var = fmaxf(s2 * (1.f / 1024.f) - mean * mean, 0.f); mr[2 * c.tid] = mean; mr[2 * c.tid + 1] = rsqrtf(var + LN_EPS); }
    __syncthreads();
    const int i = 16 * w + fr, t = t0 + i, nks = (w >> 1) + 1;
    bf16x8 wf[4]; float ci = 0.f;
#pragma unroll
    for (int ks = 0; ks < 4; ++ks) { f32x4 lo = (f32x4){0.f, 0.f, 0.f, 0.f}, hi = lo;
        if (ks < nks) { const int j0 = ks * 32 + fq * 8; const f32x4 w0 = *(const f32x4*)(sw + (size_t)i * 128 + j0), w1 = *(const f32x4*)(sw + (size_t)i * 128 + j0 + 4);
#pragma unroll
            for (int e = 0; e < 4; ++e) { const float m0 = mr[2 * (j0 + e)], r0 = mr[2 * (j0 + e) + 1], m1 = mr[2 * (j0 + 4 + e)], r1 = mr[2 * (j0 + 4 + e) + 1];
                lo[e] = (j0 + e <= i) ? w0[e] * r0 : 0.f; hi[e] = (j0 + 4 + e <= i) ? w1[e] * r1 : 0.f; ci += lo[e] * m0 + hi[e] * m1; } }
        wf[ks] = pack8(lo, hi); }
    ci += __shfl_xor(ci, 16); ci += __shfl_xor(ci, 32);
    const float add = sb[i] - ci;
    f32x4 acc[16];
#pragma unroll
    for (int nd = 0; nd < 16; ++nd) { acc[nd] = (f32x4){0.f, 0.f, 0.f, 0.f};
#pragma unroll
        for (int ks = 0; ks < 4; ++ks) if (ks < nks) { const bf16x8 vf = *(const LAS bf16x8*)(Vt + (16 * nd + fr) * 272 + ks * 64 + fq * 16); acc[nd] = MFMA16(vf, wf[ks], acc[nd]); } }
#pragma unroll
    for (int nd = 0; nd < 16; ++nd) { const u32x2 uw = *(const u32x2*)(gu + (size_t)t * 1024 + g * 256 + 16 * nd + 4 * fq);
        const float u0 = __uint_as_float(uw[0] << 16), u1 = __uint_as_float(uw[0] & 0xffff0000u), u2 = __uint_as_float(uw[1] << 16), u3 = __uint_as_float(uw[1] & 0xffff0000u);
        u32x2 o; o[0] = pk2(u0 * (acc[nd][0] + add), u1 * (acc[nd][1] + add)); o[1] = pk2(u2 * (acc[nd][2] + add), u3 * (acc[nd][3] + add));
        *(u32x2*)(ycat + (size_t)t * CD_OUT + g * 256 + 16 * nd + 4 * fq) = o; }
}
__device__ __forceinline__ void phase_cd_p1(const Ctx& c, int j) {
    for (int u = c.bid; u < 640 + 512; u += c.G) { if (u < 640) lru_unit(c, u, j); else sgu_unit(c, u - 640, j); }
}

__device__ __forceinline__ void phase_cd_scan2(const Ctx& c) {
    const bf16_t* gg = (const bf16_t*)(c.ws + CD_GG); bf16_t* ycat = (bf16_t*)(c.ws + WS_YCAT);
    const bf16_t* HL = (const bf16_t*)(c.ws + WS_U2); const bf16_t* PC = HL + (size_t)T * 1280; const float* sum = (const float*)(c.ws + WS_H);
    LAS float* carry = (LAS float*)c.lds;
    for (int u = c.bid; u < 256; u += c.G) {
        const int bn = u >> 1, half = u & 1, b = bn >> 6, n = bn & 63;
        __syncthreads();
        for (int ch = c.tid; ch < 1280; ch += NTHREADS) { float cr = 0.f; const float* sp = sum + ((size_t)(b * 64) * 1280 + ch) * 2;
#pragma unroll 8
            for (int m = 0; m < n; ++m) { const f32x2 v = *(const f32x2*)(sp + (size_t)m * 2560); cr = v[0] * cr + v[1]; }
            carry[ch] = cr; }
        __syncthreads();
        const size_t t0 = (size_t)bn * 128 + half * 64;
#pragma unroll 4
        for (int it = c.tid; it < 64 * 320; it += NTHREADS) { const int r = it / 320, c4 = (it % 320) * 4; const size_t o = (t0 + r) * 1280 + c4;
            const u32x2 hw = *(const u32x2*)(HL + o), pw = *(const u32x2*)(PC + o), gw = *(const u32x2*)(gg + o); const f32x4 cr = *(const LAS f32x4*)(carry + c4);
            const float h0 = __uint_as_float(hw[0] << 16) + __uint_as_float(pw[0] << 16) * cr[0], h1 = __uint_as_float(hw[0] & 0xffff0000u) + __uint_as_float(pw[0] & 0xffff0000u) * cr[1];
            const float h2 = __uint_as_float(hw[1] << 16) + __uint_as_float(pw[1] << 16) * cr[2], h3 = __uint_as_float(hw[1] & 0xffff0000u) + __uint_as_float(pw[1] & 0xffff0000u) * cr[3];
            u32x2 ow; ow[0] = pk2(__uint_as_float(gw[0] << 16) * h0, __uint_as_float(gw[0] & 0xffff0000u) * h1); ow[1] = pk2(__uint_as_float(gw[1] << 16) * h2, __uint_as_float(gw[1] & 0xffff0000u) * h3);
            *(u32x2*)(ycat + (t0 + r) * CD_OUT + 1024 + c4) = ow; }
    }
}

template <bool MOE>
__device__ __forceinline__ void phase_ln(const Ctx& c, const float* g, const float* bta, float* xout) {
    float* x = (float*)(c.ws + WS_X); bf16_t* xb = (bf16_t*)(c.ws + WS_XB);
    const float* hbuf = (const float*)(c.ws + WS_H); const bf16_t* Y = (const bf16_t*)(c.ws + WS_U1);
    for (long t = c.gw; t < T; t += c.nwaves) {
        f32x4 v[4];
#pragma unroll
        for (int q = 0; q < 4; ++q) { const int col = q * 256 + c.lane * 4;
            f32x4 f;
            if (!MOE) f = *(const f32x4*)(hbuf + (size_t)t * D + col);
            else { f = (f32x4){0.f, 0.f, 0.f, 0.f};
#pragma unroll
                for (int k = 0; k < 9; ++k) { const size_t srow = (k < 8) ? (size_t)t * 8 + k : (size_t)TK + t; const u32x2 w = *(const u32x2*)(Y + srow * D + col);
                    f[0] += __uint_as_float(w[0] << 16); f[1] += __uint_as_float(w[0] & 0xffff0000u); f[2] += __uint_as_float(w[1] << 16); f[3] += __uint_as_float(w[1] & 0xffff0000u); } }
            const f32x4 xv = *(const f32x4*)(x + (size_t)t * D + col);
            v[q] = xv * ALPHA + f; }
        float sm = 0.f;
#pragma unroll
        for (int q = 0; q < 4; ++q) sm += v[q][0] + v[q][1] + v[q][2] + v[q][3];
        const float mean = wave_sum(sm) * (1.f / 1024.f); float sq = 0.f;
#pragma unroll
        for (int q = 0; q < 4; ++q) { v[q] = v[q] - mean; sq += v[q][0] * v[q][0] + v[q][1] * v[q][1] + v[q][2] * v[q][2] + v[q][3] * v[q][3]; }
        const float rstd = rsqrtf(wave_sum(sq) * (1.f / 1024.f) + LN_EPS);
#pragma unroll
        for (int q = 0; q < 4; ++q) { const int col = q * 256 + c.lane * 4; const f32x4 gg = *(const f32x4*)(g + col), bb = *(const f32x4*)(bta + col);
            const f32x4 o = v[q] * rstd * gg + bb;
            *(f32x4*)(xout + (size_t)t * D + col) = o; if (xout != x) *(f32x4*)(x + (size_t)t * D + col) = o;
            u32x2 w; w[0] = pk2(o[0], o[1]); w[1] = pk2(o[2], o[3]); *(u32x2*)(xb + (size_t)t * D + col) = w; }
    }
}

__device__ __forceinline__ void phase_ln_route(const Ctx& c, int L) {
    float* x = (float*)(c.ws + WS_X); bf16_t* xb = (bf16_t*)(c.ws + WS_XB); const float* hbuf = (const float*)(c.ws + WS_H);
    const float* g = c.in[19] + (size_t)L * D; const float* bta = c.in[20] + (size_t)L * D; const float* rb = c.in[22] + L * NE;
    const bf16_t* Wr = (const bf16_t*)(c.ws + WS_WRT) + (size_t)L * 256 * D;
    int* cnt = (int*)(c.ws + CTL_CNT) + L * NE; int* list = (int*)(c.ws + WS_LIST); float* gate = (float*)(c.ws + WS_GATE);
    LAS unsigned char* Xl = c.lds; LAS float* Sc = (LAS float*)c.lds;
    const int lane = c.lane, fr = lane & 15, fq = lane >> 4, w = c.wid;
    for (int grp = c.bid; grp < T / 64; grp += c.G) {
        __syncthreads();
        for (int q8 = 0; q8 < 8; ++q8) { const int rr = w * 8 + q8; const size_t t = (size_t)grp * 64 + rr;
            f32x4 v[4];
#pragma unroll
            for (int q = 0; q < 4; ++q) { const int col = q * 256 + lane * 4; v[q] = *(const f32x4*)(x + t * D + col) * ALPHA + *(const f32x4*)(hbuf + t * D + col); }
            float sm = 0.f;
#pragma unroll
            for (int q = 0; q < 4; ++q) sm += v[q][0] + v[q][1] + v[q][2] + v[q][3];
            const float mean = wave_sum(sm) * (1.f / 1024.f); float sq = 0.f;
#pragma unroll
            for (int q = 0; q < 4; ++q) { v[q] = v[q] - mean; sq += v[q][0] * v[q][0] + v[q][1] * v[q][1] + v[q][2] * v[q][2] + v[q][3] * v[q][3]; }
            const float rstd = rsqrtf(wave_sum(sq) * (1.f / 1024.f) + LN_EPS);
#pragma unroll
            for (int q = 0; q < 4; ++q) { const int col = q * 256 + lane * 4; const f32x4 o = v[q] * rstd * *(const f32x4*)(g + col) + *(const f32x4*)(bta + col);
                *(f32x4*)(x + t * D + col) = o; u32x2 wv; wv[0] = pk2(o[0], o[1]); wv[1] = pk2(o[2], o[3]); *(u32x2*)(xb + t * D + col) = wv; *(LAS u32x2*)(Xl + rr * 2064 + col * 2) = wv; } }
        __syncthreads();
        const int st = w & 3, eh = w >> 2;
        f32x4 acc[4];
#pragma unroll
        for (int ne = 0; ne < 4; ++ne) acc[ne] = (f32x4){0.f, 0.f, 0.f, 0.f};
#pragma unroll 4
        for (int ks = 0; ks < 32; ++ks) { const bf16x8 bop = *(const LAS bf16x8*)(Xl + (16 * st + fr) * 2064 + ks * 64 + fq * 16);
#pragma unroll
            for (int ne = 0; ne < 4; ++ne) { const bf16x8 aop = *(const bf16x8*)(Wr + (size_t)(64 * eh + 16 * ne + fr) * D + ks * 32 + fq * 8); acc[ne] = MFMA16(aop, bop, acc[ne]); } }
        __syncthreads();
#pragma unroll
        for (int ne = 0; ne < 4; ++ne) { f32x4 sg; for (int r = 0; r < 4; ++r) sg[r] = sigmoidf_(acc[ne][r]); *(LAS f32x4*)(Sc + (16 * st + fr) * 128 + 64 * eh + 16 * ne + 4 * fq) = sg; }
        __syncthreads();
        for (int q8 = 0; q8 < 8; ++q8) { const int rr = w * 8 + q8; const int t = grp * 64 + rr;
            const float s0 = Sc[rr * 128 + lane], s1 = Sc[rr * 128 + 64 + lane];
            float v0 = s0 + rb[lane], v1 = s1 + rb[64 + lane];
            float mysc = 0.f; int myexp = -1; float tot = 0.f;
            for (int k = 0; k < 8; ++k) {
                float bv = v0; int bi = lane; if (v1 > bv) { bv = v1; bi = lane + 64; }
#pragma unroll
                for (int o = 32; o; o >>= 1) { const float ov = __shfl_xor(bv, o); const int oi = __shfl_xor(bi, o); if (ov > bv || (ov == bv && oi < bi)) { bv = ov; bi = oi; } }
                const float sc = __shfl((bi & 64) ? s1 : s0, bi & 63);
                tot += sc;
                if (lane == k) { mysc = sc; myexp = bi; }
                if (lane == (bi & 63)) { if (bi & 64) v1 = -1e30f; else v0 = -1e30f; }
            }
            if (lane < 8) { const int pos = atomicAdd(&cnt[myexp], 1); list[(size_t)myexp * LISTCAP + pos] = t * 8 + lane; gate[(size_t)t * 8 + lane] = mysc / tot * 2.5f; } }
    }
}

struct MoeOrder {
    const char* Abase; const char* Bbase; size_t Bstride; int K, NT, total, G, c, mode;
    LAS int* tab; LAS int* desc;
    __device__ __forceinline__ bool next(int i, g8::Unit& u) const {
        const long L = (long)i * G + c; if (L >= total || i >= TAB_SLOTS) return false;
        const int d = desc[i]; const int e = d >> 12, pn = d & 15;
        u.pm = (d >> 4) & 255; u.pn = pn; u.aux = i; u.A = Abase; u.B = Bbase + (size_t)e * Bstride + (size_t)pn * 256 * K * 2; return true;
    }
    __device__ __forceinline__ void aoff(const g8::Unit& u, int tid, unsigned (&o)[2][2]) const {
#pragma unroll
        for (int i = 0; i < 2; ++i) { int R, C; g8::stage_rc(tid * 16 + i * 8192, R, C);
#pragma unroll
            for (int h = 0; h < 2; ++h) { int s = tab[u.aux * 256 + h * 128 + R]; s = s < 0 ? 0 : s; const int row = mode ? s : (s < TK ? (s >> 3) : s - TK);
                o[h][i] = (unsigned)(row * K + C) * 2u; } }
    }
};
__device__ __forceinline__ void moe_setup(const Ctx& c, MoeOrder& S, const int* cnt, int NT) {
    LAS int* pref = (LAS int*)(c.lds + LDS_PREF); LAS int* desc = (LAS int*)(c.lds + LDS_DESC); LAS int* tab = (LAS int*)(c.lds + LDS_TAB);
    const int* list = (const int*)(c.ws + WS_LIST);
    if (c.tid == 0) { int acc = 0; for (int e = 0; e < NE1; ++e) { pref[e] = acc; const int n = e < NE ? cnt[e] : T; acc += (n + 255) >> 8; } pref[NE1] = acc; }
    __syncthreads();
    const int total = pref[NE1] * NT;
    S.NT = NT; S.total = total; S.G = c.G; S.c = c.bid; S.tab = tab; S.desc = desc;
    for (int i = 0; i < TAB_SLOTS; ++i) {
        const long L = (long)i * c.G + c.bid; if (L >= total) break;
        int wgid = (int)L; { const int q = total / 8, r = total % 8, xcd = wgid % 8, off = wgid / 8; wgid = (xcd < r ? xcd * (q + 1) : r * (q + 1) + (xcd - r) * q) + off; }
        const int rbg = wgid / NT, pn = wgid % NT;
        int lo = 0, hi = NE1;
        while (hi - lo > 1) { const int mid = (lo + hi) >> 1; if (pref[mid] <= rbg) lo = mid; else hi = mid; }
        const int e = lo, rb = rbg - pref[e], n = e < NE ? cnt[e] : T;
        if (c.tid == 0) desc[i] = (e << 12) | (rb << 4) | pn;
        if (c.tid < 256) { const int r = rb * 256 + c.tid; int s = -1; if (r < n) s = (e < NE) ? list[(size_t)e * LISTCAP + r] : TK + r; tab[i * 256 + c.tid] = s; }
    }
    __syncthreads();
}
struct EpiMoeGU {
    static constexpr bool PERM = true;
    bf16_t* H; LAS int* tab;
    __device__ __forceinline__ void operator()(const f32x4 (&acc)[2][2][4][2], const g8::Unit& u, int wr, int wc, int fr, int fq) const {
#pragma unroll
        for (int ai = 0; ai < 2; ++ai)
#pragma unroll
            for (int m = 0; m < 4; ++m) { const int r = ai * 128 + wr * 64 + m * 16 + fr; const int s = tab[u.aux * 256 + r];
                if (s >= 0) { u32x4 w;
#pragma unroll
                    for (int n = 0; n < 2; ++n) { const f32x4 g = acc[ai][0][m][n], up = acc[ai][1][m][n];
                        w[2 * n] = pk2(siluf_(g[0]) * up[0], siluf_(g[1]) * up[1]); w[2 * n + 1] = pk2(siluf_(g[2]) * up[2], siluf_(g[3]) * up[3]); }
                    *(u32x4*)(H + (size_t)s * ED + u.pn * 128 + wc * 32 + fq * 8) = w; } }
    }
};
struct EpiMoeDN {
    static constexpr bool PERM = true;
    bf16_t* Y; const float* gate; LAS int* tab;
    __device__ __forceinline__ void operator()(const f32x4 (&acc)[2][2][4][2], const g8::Unit& u, int wr, int wc, int fr, int fq) const {
#pragma unroll
        for (int ai = 0; ai < 2; ++ai)
#pragma unroll
            for (int m = 0; m < 4; ++m) { const int r = ai * 128 + wr * 64 + m * 16 + fr; const int s = tab[u.aux * 256 + r];
                if (s >= 0) { const float gt = gate[s];
#pragma unroll
                    for (int bj = 0; bj < 2; ++bj) { u32x4 w;
#pragma unroll
                        for (int n = 0; n < 2; ++n) { const f32x4 a = acc[ai][bj][m][n] * gt; w[2 * n] = pk2(a[0], a[1]); w[2 * n + 1] = pk2(a[2], a[3]); }
                        *(u32x4*)(Y + (size_t)s * D + u.pn * 256 + bj * 128 + wc * 32 + fq * 8) = w; } } }
    }
};
__device__ __forceinline__ void phase_moe_gu(const Ctx& c, int L) {
    MoeOrder S; S.Abase = (const char*)(c.ws + WS_XB); S.Bbase = (const char*)(c.ws + WS_WGU) + (size_t)L * NE1 * 512 * D * 2; S.Bstride = (size_t)512 * D * 2; S.K = D; S.mode = 0;
    moe_setup(c, S, (const int*)(c.ws + CTL_CNT) + L * NE, 2);
    EpiMoeGU E{(bf16_t*)(c.ws + WS_HID), S.tab};
    g8::gemm_phase<EpiMoeGU, MoeOrder>(c.lds + LDS_STAGE, D, S, E);
}
__device__ __forceinline__ void phase_moe_dn(const Ctx& c, int L) {
    MoeOrder S; S.Abase = (const char*)(c.ws + WS_HID); S.Bbase = (const char*)(c.ws + WS_WDN) + (size_t)L * NE1 * D * ED * 2; S.Bstride = (size_t)D * ED * 2; S.K = ED; S.mode = 1;
    moe_setup(c, S, (const int*)(c.ws + CTL_CNT) + L * NE, 4);
    EpiMoeDN E{(bf16_t*)(c.ws + WS_U1), (const float*)(c.ws + WS_GATE), S.tab};
    g8::gemm_phase<EpiMoeDN, MoeOrder>(c.lds + LDS_STAGE, ED, S, E);
}

constexpr int PH_PER_LAYER = 9;
constexpr int N_PHASES = 1 + 4 * PH_PER_LAYER;

__global__ void __launch_bounds__(NTHREADS, 2) fwd_kernel(Params p) {
    extern __shared__ __attribute__((aligned(16))) unsigned char lds_raw[];
    LAS unsigned char* const lds0 = (LAS unsigned char*)lds_raw;
    volatile LAS unsigned* misc = (volatile LAS unsigned*)(lds0 + LDS_MISC);
    if (threadIdx.x < 4) misc[threadIdx.x] = 0u;
    __syncthreads();
    const int lo = p.ph_lo, hi = p.ph_hi;
    XcdBarrier bar; bar.bar = (unsigned*)(p.ws + WS_CTL); bar.x = 0; bar.st = misc;
    if (hi - lo > 1) bar = xcd_barrier_post((unsigned*)(p.ws + WS_CTL), misc);
#define MKCTX() Ctx c; { int tid_ = threadIdx.x; asm volatile("" : "+v"(tid_)); int bid_ = blockIdx.x; asm volatile("" : "+s"(bid_)); unsigned long long ws_ = (unsigned long long)p.ws; asm volatile("" : "+s"(ws_)); \
        c.in = p.in; c.out = p.out; c.ws = (unsigned char*)ws_; c.lds = lds0; c.tid = tid_; c.lane = tid_ & 63; c.wid = __builtin_amdgcn_readfirstlane(tid_ >> 6); c.bid = bid_; c.G = gridDim.x; \
        c.gtid = c.bid * NTHREADS + c.tid; c.gthreads = c.G * NTHREADS; c.gw = c.bid * 8 + c.wid; c.nwaves = c.G * 8; } unsigned char* const ws = c.ws; (void)ws
    int id = 0;
#ifndef PMASK
#define PMASK 0xffffffffu
#endif
#ifndef DUPMASK
#define DUPMASK 0u
#endif
#define PHASE(k, body) do { if (((PMASK >> (k)) & 1u) && lo <= id && id < hi) { MKCTX(); body; if ((DUPMASK >> (k)) & 1u) { body; } if (id + 1 < hi) xcd_barrier(bar); } ++id; } while (0)
    PHASE(0, phase_convert(c));
#pragma unroll 1
    for (int L = 0; L < 4; ++L) {
        const int j = L >> 1; const bool cd = (L & 1);
        if (cd) {
            PHASE(1, phase_cd_inproj(c, j));
        } else {
            PHASE(2, phase_ab_inproj(c, j));
        }
        if (!cd) { PHASE(3, phase_ab_p1(c)); PHASE(4, phase_ab_p2(c, j)); PHASE(16, phase_ab_p3(c)); }
        else     { PHASE(5, phase_cd_p1(c, j)); PHASE(15, phase_cd_scan2(c)); id += 1; }
        {
            const size_t Woff = cd ? WS_WCDOUT + (size_t)j * D * CD_OUT * 2 : WS_WABOUT + (size_t)j * D * AB_OUT * 2;
            const int K = cd ? CD_OUT : AB_OUT; const float* bias = cd ? p.in[18] + (size_t)j * D : p.in[5] + (size_t)j * D;
            PHASE(8, phase_dense(c, (const bf16_t*)(ws + WS_YCAT), (const bf16_t*)(ws + Woff), T, D, K, (float*)(ws + WS_H), D, bias));
        }
        PHASE(9, phase_ln_route(c, L));
        PHASE(12, phase_moe_gu(c, L));
        PHASE(13, phase_moe_dn(c, L));
        PHASE(14, phase_ln<true>(c, p.in[29] + (size_t)L * D, p.in[30] + (size_t)L * D, L == 3 ? p.out : (float*)(ws + WS_X)));
    }
#undef PHASE
}

extern "C" void kernel_launch(void* const* d_in, const int* in_sizes, int n_in, void* d_out, int out_size, void* d_ws, size_t ws_size, hipStream_t stream) {
    static int grid = 0;
    if (grid == 0) {
        if (n_in != 31 || out_size != T * D || ws_size < WS_END) { fprintf(stderr, "kernel_launch: unexpected shapes (n_in %d out %d ws %zu need %zu)\n", n_in, out_size, ws_size, (size_t)WS_END); grid = -1; return; }
        int dev = 0, cus = 0, per_cu = 0;
        if (hipGetDevice(&dev) != hipSuccess || hipDeviceGetAttribute(&cus, hipDeviceAttributeMultiprocessorCount, dev) != hipSuccess) { grid = -1; return; }
        if (hipFuncSetAttribute((const void*)fwd_kernel, hipFuncAttributeMaxDynamicSharedMemorySize, LDS_BYTES) != hipSuccess) { fprintf(stderr, "kernel_launch: hipFuncSetAttribute failed\n"); grid = -1; return; }
        if (hipOccupancyMaxActiveBlocksPerMultiprocessor(&per_cu, (const void*)fwd_kernel, NTHREADS, LDS_BYTES) != hipSuccess || per_cu < 1) fprintf(stderr, "kernel_launch: occupancy query says %d\n", per_cu);
        (void)hipGetLastError();
        grid = cus;
    }
    if (grid < 0) return;
    (void)hipMemsetAsync((char*)d_ws + WS_CTL, 0, CTL_BYTES, stream);
    Params p{};
    for (int i = 0; i < 31; ++i) p.in[i] = (const float*)d_in[i];
    p.out = (float*)d_out; p.ws = (unsigned char*)d_ws;
#if N_LAUNCH_MODE == 1
    p.ph_lo = 0; p.ph_hi = N_PHASES;
    hipLaunchKernelGGL(fwd_kernel, dim3(grid), dim3(NTHREADS), LDS_BYTES, stream, p);
#else
    for (int i = 0; i < N_PHASES; ++i) { p.ph_lo = i; p.ph_hi = i + 1; hipLaunchKernelGGL(fwd_kernel, dim3(grid), dim3(NTHREADS), LDS_BYTES, stream, p); }
#endif
}
```

```cpp
#include <hip/hip_runtime.h>
#include <cstdio>
#include <cstdint>

#define LAS __attribute__((address_space(3)))
typedef unsigned short bf16_t;
typedef short bf16x8 __attribute__((ext_vector_type(8)));
typedef float f32x4 __attribute__((ext_vector_type(4)));
typedef float f32x2 __attribute__((ext_vector_type(2)));
typedef unsigned u32x4 __attribute__((ext_vector_type(4)));
typedef unsigned u32x2 __attribute__((ext_vector_type(2)));

constexpr int T = 16384, D = 1024, SEQ = 8192;
constexpr int AB_IN = 4352, AB_OUT = 2048, CD_IN = 4608, CD_OUT = 2304;
constexpr int NE = 128, NE1 = 129, TOPK = 8, ED = 256;
constexpr int TK = T * TOPK;
constexpr int NSLOT = TK + T;
constexpr int LISTCAP = 16384;
constexpr float ALPHA = 1.681792830507429f;
constexpr float LN_EPS = 1e-5f;

#ifndef N_LAUNCH_MODE
#define N_LAUNCH_MODE 1
#endif

constexpr size_t al256(size_t x) { return (x + 255) & ~(size_t)255; }
constexpr size_t WS_CTL    = 0;
constexpr size_t CTL_BYTES = 65536 + (size_t)4 * 128 * 4096;
constexpr size_t CTL_CNT   = 65536;
constexpr size_t WS_WABIN  = CTL_BYTES;
constexpr size_t WS_WABOUT = WS_WABIN  + al256((size_t)2 * AB_IN * D * 2);
constexpr size_t WS_WCDIN  = WS_WABOUT + al256((size_t)2 * D * AB_OUT * 2);
constexpr size_t WS_WCDOUT = WS_WCDIN  + al256((size_t)2 * CD_IN * D * 2);
constexpr size_t WS_WRT    = WS_WCDOUT + al256((size_t)2 * D * CD_OUT * 2);
constexpr size_t WS_WGU    = WS_WRT    + al256((size_t)4 * 256 * D * 2);
constexpr size_t WS_WDN    = WS_WGU    + al256((size_t)4 * NE1 * 512 * D * 2);
constexpr size_t WS_X      = WS_WDN    + al256((size_t)4 * NE1 * D * ED * 2);
constexpr size_t WS_XB     = WS_X      + al256((size_t)T * D * 4);
constexpr size_t WS_U1     = WS_XB     + al256((size_t)T * D * 2);
constexpr size_t U1_BYTES  = al256((size_t)NSLOT * D * 2) > al256((size_t)T * CD_IN * 4) ? al256((size_t)NSLOT * D * 2) : al256((size_t)T * CD_IN * 4);
constexpr size_t WS_U2     = WS_U1     + U1_BYTES;
constexpr size_t U2_BYTES  = al256((size_t)T * 1280 * 4 * 3);
constexpr size_t WS_YCAT   = WS_U2     + U2_BYTES;
constexpr size_t WS_H      = WS_YCAT   + al256((size_t)T * CD_OUT * 2);
constexpr size_t WS_ZR     = WS_H      + al256((size_t)T * D * 4);
constexpr size_t WS_HID    = WS_ZR     + al256((size_t)T * 256 * 4);
constexpr size_t WS_LIST   = WS_HID    + al256((size_t)NSLOT * ED * 2);
constexpr size_t WS_GATE   = WS_LIST   + al256((size_t)NE * LISTCAP * 4);
constexpr size_t WS_ROPEA  = WS_GATE   + al256((size_t)NSLOT * 4);
constexpr size_t WS_ROPER  = WS_ROPEA  + al256((size_t)SEQ * 32 * 8);
constexpr size_t WS_BIASP  = WS_ROPER  + al256((size_t)SEQ * 64 * 8);
constexpr size_t WS_WLRU   = WS_BIASP  + al256((size_t)2 * AB_IN * 4);
constexpr size_t WS_SPL    = WS_WLRU   + al256((size_t)2 * 5 * 2 * 65536 * 2);
constexpr size_t WS_END    = WS_SPL    + al256((size_t)2 * 1280 * 4);
constexpr size_t CD_GU = WS_U1, CD_GVT = WS_U1 + 32 * (1024 * 1024), CD_GG = WS_U1 + 64 * (1024 * 1024), CD_XR = WS_U1 + 104 * (1024 * 1024), CD_STATS = WS_U1 + 144 * (1024 * 1024);
constexpr size_t MB = 1024 * 1024;
constexpr size_t AB_QB = WS_U1, AB_KB = WS_U1 + 32 * MB, AB_VT = WS_U1 + 36 * MB, AB_RQB = WS_U1 + 40 * MB, AB_RKB = WS_U1 + 56 * MB, AB_RKDT = WS_U1 + 72 * MB,
                 AB_RVT = WS_U1 + 88 * MB, AB_RGB = WS_U1 + 120 * MB, AB_KV = WS_U1 + 152 * MB  , AB_SPREV = WS_U1 + 216 * MB  ;
static_assert(AB_SPREV + 32 * MB <= WS_U1 + U1_BYTES, "U1 map");

__device__ __forceinline__ float bf2f(bf16_t b) { return __uint_as_float(((unsigned)b) << 16); }
__device__ __forceinline__ bf16_t f2bf(float f) { unsigned u = __float_as_uint(f); u += 0x7FFFu + ((u >> 16) & 1u); return (bf16_t)(u >> 16); }
__device__ __forceinline__ unsigned pk2(float lo, float hi) { return (unsigned)f2bf(lo) | ((unsigned)f2bf(hi) << 16); }
__device__ __forceinline__ float wave_sum(float v) {
#pragma unroll
    for (int o = 32; o; o >>= 1) v += __shfl_xor(v, o);
    return v; }
__device__ __forceinline__ float wave_max(float v) {
#pragma unroll
    for (int o = 32; o; o >>= 1) v = fmaxf(v, __shfl_xor(v, o));
    return v; }
__device__ __forceinline__ float gelu_tanh(float x) { const float u = 0.7978845608028654f * (x + 0.044715f * x * x * x); return 0.5f * x * (1.f + tanhf(u)); }
__device__ __forceinline__ float sigmoidf_(float x) { return 1.f / (1.f + __expf(-x)); }
__device__ __forceinline__ float siluf_(float x) { return x / (1.f + __expf(-x)); }

#define XB_TMO      128
#define XB_XCNT(j)  (256  + 64 * (j))
#define XB_XSUB(j)  (1280 + 64 * (j))
#define XB_XGEN(j)  (2304 + 64 * (j))
#define XB_TOP      3328
#define XB_TOPGEN   3392
#define XCD_BAR_WORDS 3456
#define XB_SPIN_CAP (1u << 22)

__device__ __forceinline__ unsigned xb_ld(unsigned* p)              { return __hip_atomic_load(p, __ATOMIC_RELAXED, __HIP_MEMORY_SCOPE_AGENT); }
__device__ __forceinline__ unsigned xb_add(unsigned* p, unsigned v) { return __hip_atomic_fetch_add(p, v, __ATOMIC_RELAXED, __HIP_MEMORY_SCOPE_AGENT); }
__device__ __forceinline__ unsigned xb_xcc_id() { return (unsigned)__builtin_amdgcn_s_getreg((3 << 11) | 20) & 0xFu; }
#define XB_SPIN(cond, bar) do { unsigned _sp = 0; while (cond) { __builtin_amdgcn_s_sleep(1); \
    if ((++_sp & 255u) == 0u) { if (xb_ld(&(bar)[XB_TMO])) break; if (_sp > XB_SPIN_CAP) { atomicAdd(&(bar)[XB_TMO], 1u); break; } } } } while (0)

struct XcdBarrier { unsigned* bar; unsigned x; volatile LAS unsigned* st; };

__device__ __forceinline__ XcdBarrier xcd_barrier_post(unsigned* bar, volatile LAS unsigned* st) {
    XcdBarrier b; b.bar = bar; b.x = xb_xcc_id(); b.st = st;
    if (threadIdx.x == 0) (void)xb_add(&bar[XB_XCNT(b.x)], 1u);
    return b;
}
__device__ __forceinline__ void xcd_barrier_complete(unsigned* bar, unsigned x, unsigned& nloc, unsigned& nx) {
    const unsigned G = gridDim.x * gridDim.y * gridDim.z;
    unsigned sum, cnt, mine, sp = 0u;
    for (;;) {
        sum = 0u; cnt = 0u; mine = 0u;
#pragma unroll
        for (unsigned j = 0; j < 16; ++j) { const unsigned c = xb_ld(&bar[XB_XCNT(j)]); sum += c; cnt += (c > 0u) ? 1u : 0u; mine = (j == x) ? c : mine; }
        if (sum == G) break;
        __builtin_amdgcn_s_sleep(1);
        if ((++sp & 255u) == 0u) { if (xb_ld(&bar[XB_TMO])) break; if (sp > XB_SPIN_CAP) { atomicAdd(&bar[XB_TMO], 1u); break; } }
    }
    nloc = mine > 0u ? mine : 1u; nx = cnt > 0u ? cnt : 1u;
}
__device__ __forceinline__ void xcd_barrier(const XcdBarrier& b) {
    asm volatile("s_waitcnt vmcnt(0)" ::: "memory");
    __syncthreads();
    if (threadIdx.x == 0) {
        unsigned* bar = b.bar;
        __builtin_amdgcn_s_waitcnt(0);
        unsigned nloc = b.st[0], nx = b.st[1];
        if (nloc == 0u) { xcd_barrier_complete(bar, b.x, nloc, nx); b.st[0] = nloc; b.st[1] = nx; }
        const unsigned old = xb_add(&bar[XB_XSUB(b.x)], 1u);
        const unsigned gen = old / nloc;
        if (old + 1u == (gen + 1u) * nloc) {
            __builtin_amdgcn_fence(__ATOMIC_RELEASE, "agent");
            asm volatile("s_waitcnt vmcnt(0)" ::: "memory");
            const unsigned og = xb_add(&bar[XB_TOP], 1u);
            const unsigned tg = og / nx;
            if (og + 1u == (tg + 1u) * nx) xb_add(&bar[XB_TOPGEN], 1u);
            else XB_SPIN(xb_ld(&bar[XB_TOPGEN]) == tg, bar);
            __builtin_amdgcn_fence(__ATOMIC_ACQUIRE, "agent");
            xb_add(&bar[XB_XGEN(b.x)], 1u);
            asm volatile("s_waitcnt vmcnt(0)" ::: "memory");
        } else {
            XB_SPIN(xb_ld(&bar[XB_XGEN(b.x)]) == gen, bar);
            __builtin_amdgcn_fence(__ATOMIC_ACQUIRE, "agent");
            asm volatile("s_waitcnt vmcnt(0)" ::: "memory");
        }
    }
    __syncthreads();
}

namespace g8 {
constexpr int BM = 256, BK = 64, HALF = 128, HTB = HALF * BK * 2, STAGE_BYTES = 8 * HTB, NXCD = 8, WGM = 8;
__device__ __forceinline__ int lds_byte(int r, int c) { const int st = (r >> 4) * 2 + (c >> 5), rr = r & 15, cc = c & 31, ob = rr * 64 + cc * 2; return st * 1024 + (ob ^ (((ob >> 9) & 1) << 5)); }
__device__ __forceinline__ void stage_rc(int b, int& R, int& C) { const int st = b / 1024, sb = b % 1024, swz = sb ^ (((sb >> 9) & 1) << 5); R = (st >> 1) * 16 + swz / 64; C = (st & 1) * 32 + (swz % 64) / 2; }
__device__ __forceinline__ int perm32(int rho) { const int n = rho >> 4, i = rho & 15; return 8 * (i >> 2) + 4 * n + (i & 3); }

struct Unit { const char* A; const char* B; int pm, pn, aux; };

struct DenseOrder {
    const char* A; const char* Bt; int nM, nN, nwg, G, c, K;
    __device__ void init(const void* A_, const void* Bt_, int M, int N, int K_, int G_, int c_) { A = (const char*)A_; Bt = (const char*)Bt_; nM = M / BM; nN = N / BM; nwg = nM * nN; G = G_; c = c_; K = K_; }
    __device__ __forceinline__ bool next(int i, Unit& u) const {
        const long L = (long)i * G + c; if (L >= nwg) return false;
        int wgid = (int)L; { const int q = nwg / NXCD, r = nwg % NXCD, xcd = wgid % NXCD, off = wgid / NXCD; wgid = (xcd < r ? xcd * (q + 1) : r * (q + 1) + (xcd - r) * q) + off; }
        const int nig = WGM * nN, gid = wgid / nig, fm = gid * WGM, gsz = (nM - fm) < WGM ? (nM - fm) : WGM;
        u.pm = fm + ((wgid % nig) % gsz); u.pn = (wgid % nig) / gsz; u.aux = 0;
        u.A = A + (size_t)u.pm * BM * K * 2; u.B = Bt + (size_t)u.pn * BM * K * 2; return true;
    }
    __device__ __forceinline__ void aoff(const Unit&, int tid, unsigned (&o)[2][2]) const {
#pragma unroll
        for (int i = 0; i < 2; ++i) { int R, C; stage_rc(tid * 16 + i * 8192, R, C);
            o[0][i] = (unsigned)(R * K + C) * 2u; o[1][i] = (unsigned)((R + HALF) * K + C) * 2u; }
    }
};

__device__ __forceinline__ unsigned cvt_pk_bf16(float lo, float hi) { unsigned r; asm volatile("v_cvt_pk_bf16_f32 %0, %1, %2" : "=v"(r) : "v"(lo), "v"(hi)); return r; }

struct EpiF32 {
    static constexpr bool PERM = false;
    float* C; int ldc; const float* bias;
    __device__ __forceinline__ void operator()(const f32x4 (&acc)[2][2][4][2], const Unit& u, int wr, int wc, int fr, int fq) const {
        const int row0 = u.pm * BM + wr * 64 + fr, col0 = u.pn * BM + wc * 32 + 4 * fq;
        f32x4 bv[2][2];
#pragma unroll
        for (int bj = 0; bj < 2; ++bj)
#pragma unroll
            for (int n = 0; n < 2; ++n) bv[bj][n] = bias ? *(const f32x4*)(bias + col0 + bj * HALF + n * 16) : (f32x4){0.f, 0.f, 0.f, 0.f};
#pragma unroll
        for (int ai = 0; ai < 2; ++ai)
#pragma unroll
            for (int m = 0; m < 4; ++m) { float* rowp = C + (size_t)(row0 + ai * HALF + m * 16) * ldc + col0;
#pragma unroll
                for (int bj = 0; bj < 2; ++bj)
#pragma unroll
                    for (int n = 0; n < 2; ++n) *(f32x4*)(rowp + bj * HALF + n * 16) = acc[ai][bj][m][n] + bv[bj][n]; }
    }
};

template <class Epi, class Sched>
__device__ __forceinline__ void gemm_phase(LAS unsigned char* lds, const int K, const Sched& S, const Epi& E) {
    int tid_ = threadIdx.x; asm volatile("" : "+v"(tid_));
    const int tid = tid_, wid = __builtin_amdgcn_readfirstlane(tid >> 6), lane = tid & 63, wr = wid >> 2, wc = wid & 3, fr = lane & 15, fq = lane >> 4;
    const int nt = K / BK;
    unsigned voffB[2];
#pragma unroll
    for (int i = 0; i < 2; ++i) { int R, C; stage_rc(tid * 16 + i * 8192, R, C); const int Rb = Epi::PERM ? ((R & ~31) + perm32(R & 31)) : R;
        voffB[i] = (unsigned)(Rb * K + C) * 2u; }
    const size_t kstep = (size_t)(BK * 2);
    const size_t hstep = (size_t)HALF * K * 2;
    const unsigned ldsw = (unsigned)wid * 1024u;
    const int aoff = lds_byte(wr * 64 + fr, fq * 8), boff = lds_byte(wc * 32 + fr, fq * 8);
#define G8_SA(b, h) (((b) * 2 + (h)) * HTB)
#define G8_SB(b, h) ((4 + (b) * 2 + (h)) * HTB)
#define G8_STAGE(bufoff, gbase, voff) do { _Pragma("unroll") for (int _i = 0; _i < 2; ++_i) \
        __builtin_amdgcn_global_load_lds((const unsigned*)((const char*)(gbase) + (voff)[_i]), (LAS unsigned*)(lds + (bufoff) + ldsw + _i * 8192), 16, 0, 0); } while (0)
#define G8_LDA(dst, b, h) do { _Pragma("unroll") for (int m = 0; m < 4; ++m) _Pragma("unroll") for (int k = 0; k < 2; ++k) dst[m][k] = *(const LAS bf16x8*)(lds + G8_SA(b, h) + aoff + m * 2048 + k * 1024); } while (0)
#define G8_LDB(dst, b, h) do { _Pragma("unroll") for (int n = 0; n < 2; ++n) _Pragma("unroll") for (int k = 0; k < 2; ++k) dst[n][k] = *(const LAS bf16x8*)(lds + G8_SB(b, h) + boff + n * 2048 + k * 1024); } while (0)
#define G8_MMA(ai, bj, At, Bt) do { __builtin_amdgcn_s_setprio(1); _Pragma("unroll") for (int m = 0; m < 4; ++m) _Pragma("unroll") for (int n = 0; n < 2; ++n) _Pragma("unroll") for (int k = 0; k < 2; ++k) \
        acc[ai][bj][m][n] = __builtin_amdgcn_mfma_f32_16x16x32_bf16(Bt[n][k], At[m][k], acc[ai][bj][m][n], 0, 0, 0); __builtin_amdgcn_s_setprio(0); } while (0)
#define G8_WAIT_V(n) asm volatile("s_waitcnt vmcnt(" #n ")" ::: "memory")
#define G8_WAIT_L(n) asm volatile("s_waitcnt lgkmcnt(" #n ")" ::: "memory")
#define G8_BAR __builtin_amdgcn_s_barrier()
#define G8_SCHED __builtin_amdgcn_sched_barrier(0)
    Unit cur, nxt; int ui = 0;
    if (!S.next(0, cur)) return;
    f32x4 acc[2][2][4][2];
#pragma unroll
    for (int a = 0; a < 2; ++a)
#pragma unroll
        for (int b = 0; b < 2; ++b)
#pragma unroll
            for (int m = 0; m < 4; ++m)
#pragma unroll
                for (int n = 0; n < 2; ++n) acc[a][b][m][n] = (f32x4){0.f, 0.f, 0.f, 0.f};
    bf16x8 At[4][2], B0[2][2], B1[2][2];
    unsigned oc[2][2];
    S.aoff(cur, tid, oc);
    const char* cA = cur.A; const char* cB = cur.B;
    G8_STAGE(G8_SB(0, 0), cB, voffB); G8_STAGE(G8_SA(0, 0), cA, oc[0]); G8_STAGE(G8_SB(0, 1), cB + hstep, voffB); G8_STAGE(G8_SA(0, 1), cA, oc[1]);
    if (wr == 1) G8_BAR;
    G8_WAIT_V(4); G8_BAR;
    G8_STAGE(G8_SB(1, 0), cB + kstep, voffB); G8_STAGE(G8_SA(1, 0), cA + kstep, oc[0]); G8_STAGE(G8_SB(1, 1), cB + hstep + kstep, voffB);
    G8_WAIT_V(6); G8_BAR;
    for (;;) {
        const bool has_next = S.next(ui + 1, nxt);
        const char* nA = has_next ? nxt.A : cA; const char* nB = has_next ? nxt.B : cB;
#pragma unroll 1
        for (int t = 0; t < nt; t += 2) {
            const bool last = (t == nt - 2);
            const char* a1 = cA + (size_t)(t + 1) * kstep;
            const char* a2 = last ? nA : cA + (size_t)(t + 2) * kstep; const char* b2 = last ? nB : cB + (size_t)(t + 2) * kstep;
            const char* a3 = a2 + kstep; const char* b3 = b2 + kstep;
            G8_LDB(B0, 0, 0); G8_SCHED; G8_LDA(At, 0, 0); G8_STAGE(G8_SA(1, 1), a1, oc[1]);
            if (last && has_next) S.aoff(nxt, tid, oc);
            G8_WAIT_L(8); G8_BAR; G8_WAIT_L(0); G8_MMA(0, 0, At, B0); G8_BAR; G8_SCHED;
            G8_LDB(B1, 0, 1); G8_STAGE(G8_SB(0, 0), b2, voffB);
            G8_BAR; G8_WAIT_L(0); G8_MMA(0, 1, At, B1); G8_BAR;
            G8_LDA(At, 0, 1); G8_STAGE(G8_SA(0, 0), a2, oc[0]);
            G8_BAR; G8_WAIT_L(0); G8_MMA(1, 0, At, B0); G8_BAR; G8_SCHED;
            G8_STAGE(G8_SB(0, 1), b2 + hstep, voffB);
            G8_WAIT_V(6); G8_BAR; G8_MMA(1, 1, At, B1); G8_BAR;
            G8_LDB(B0, 1, 0); G8_SCHED; G8_LDA(At, 1, 0); G8_STAGE(G8_SA(0, 1), a2, oc[1]);
            G8_WAIT_L(8); G8_BAR; G8_WAIT_L(0); G8_MMA(0, 0, At, B0); G8_BAR; G8_SCHED;
            G8_LDB(B1, 1, 1); G8_STAGE(G8_SB(1, 0), b3, voffB);
            G8_BAR; G8_WAIT_L(0); G8_MMA(0, 1, At, B1); G8_BAR;
            G8_LDA(At, 1, 1); G8_STAGE(G8_SA(1, 0), a3, oc[0]);
            G8_BAR; G8_WAIT_L(0); G8_MMA(1, 0, At, B0); G8_BAR; G8_SCHED;
            G8_STAGE(G8_SB(1, 1), b3 + hstep, voffB);
            G8_WAIT_V(6); G8_BAR; G8_MMA(1, 1, At, B1); G8_BAR;
        }
        E(acc, cur, wr, wc, fr, fq);
        if (!has_next) break;
#pragma unroll
        for (int a = 0; a < 2; ++a)
#pragma unroll
            for (int b = 0; b < 2; ++b)
#pragma unroll
                for (int m = 0; m < 4; ++m)
#pragma unroll
                    for (int n = 0; n < 2; ++n) acc[a][b][m][n] = (f32x4){0.f, 0.f, 0.f, 0.f};
        cur = nxt; cA = nA; cB = nB; ++ui;
    }
    G8_WAIT_V(0);
    if (wr == 0) G8_BAR;
    G8_BAR;
#undef G8_SA
#undef G8_SB
#undef G8_STAGE
#undef G8_LDA
#undef G8_LDB
#undef G8_MMA
#undef G8_WAIT_V
#undef G8_WAIT_L
#undef G8_BAR
#undef G8_SCHED
}
}

constexpr int NTHREADS = 512;
constexpr int LDS_STAGE = 0;
constexpr int LDS_TAB   = g8::STAGE_BYTES;
constexpr int TAB_SLOTS = 12;
constexpr int LDS_DESC  = LDS_TAB + TAB_SLOTS * 256 * 4;
constexpr int LDS_PREF  = LDS_DESC + 64;
constexpr int LDS_MISC  = LDS_PREF + 132 * 4 + 48;
constexpr int LDS_BYTES = 147456;
static_assert(LDS_MISC % 16 == 0 && LDS_MISC + 64 <= LDS_BYTES, "LDS map");

struct Params { const float* in[31]; float* out; unsigned char* ws; int ph_lo, ph_hi; };

struct Ctx {
    const float* const* in; float* out; unsigned char* ws; LAS unsigned char* lds;
    int tid, lane, wid, bid, G, gtid, gthreads, gw, nwaves;
};

__device__ __forceinline__ int ab_phys(int n) {
    if (n < 1024) { const int hd = n >> 6, jj = n & 63; return (hd >> 2) * 256 + (jj >> 5) * 128 + (hd & 3) * 32 + (jj & 31); }
    if (n < 1152) { const int nn = n - 1024, hh = nn >> 6, jj = nn & 63; return 1024 + (jj >> 5) * 128 + hh * 32 + (jj & 31); }
    if (n < 1280) { const int vv = n - 1152; return 1024 + (vv >> 6) * 128 + 64 + (vv & 63); }
    if (n < 2304) { const int base = n < 1792 ? 1280 : 1792, nn = n - base, h = nn >> 7, jj = nn & 127; return base + (h >> 1) * 256 + (jj >> 6) * 128 + (h & 1) * 64 + (jj & 63); }
    return n;
}
template <class DstFn>
__device__ __forceinline__ void convert_T(const Ctx& c, const float* src, int nmat, int K, int N, DstFn dstfn) {
    LAS float* tile = (LAS float*)(c.lds);
    const int tk = K / 64, tn = N / 64; const long ntiles = (long)nmat * tk * tn;
    for (long tix = c.bid; tix < ntiles; tix += c.G) {
        const int m = (int)(tix / (tk * tn)); const int rem = (int)(tix % (tk * tn)); const int kt = rem / tn, nt = rem % tn;
        const float* s = src + (size_t)m * K * N + (size_t)(kt * 64) * N + nt * 64;
#pragma unroll
        for (int i = 0; i < 2; ++i) { const int k = (c.tid >> 4) + 32 * i, n4 = (c.tid & 15) * 4; const f32x4 v = *(const f32x4*)(s + (size_t)k * N + n4);
            tile[k * 65 + n4 + 0] = v[0]; tile[k * 65 + n4 + 1] = v[1]; tile[k * 65 + n4 + 2] = v[2]; tile[k * 65 + n4 + 3] = v[3]; }
        __syncthreads();
        { const int n = c.tid >> 3, k8 = (c.tid & 7) * 8; u32x4 w;
          w[0] = pk2(tile[(k8 + 0) * 65 + n], tile[(k8 + 1) * 65 + n]); w[1] = pk2(tile[(k8 + 2) * 65 + n], tile[(k8 + 3) * 65 + n]);
          w[2] = pk2(tile[(k8 + 4) * 65 + n], tile[(k8 + 5) * 65 + n]); w[3] = pk2(tile[(k8 + 6) * 65 + n], tile[(k8 + 7) * 65 + n]);
          bf16_t* d = dstfn(m, nt * 64 + n) + kt * 64 + k8; *(u32x4*)d = w; }
        __syncthreads();
    }
}

__device__ __forceinline__ void phase_convert(const Ctx& c) {
    unsigned char* ws = c.ws;
    { const float* x = c.in[0]; float* xo = (float*)(ws + WS_X); bf16_t* xb = (bf16_t*)(ws + WS_XB);
      for (long i = c.gtid; i < (long)T * D / 4; i += c.gthreads) { const f32x4 v = *(const f32x4*)(x + i * 4); *(f32x4*)(xo + i * 4) = v; u32x2 w; w[0] = pk2(v[0], v[1]); w[1] = pk2(v[2], v[3]); *(u32x2*)(xb + i * 4) = w; } }
    { bf16_t* wrt = (bf16_t*)(ws + WS_WRT); for (long i = c.gtid; i < (long)4 * 128 * D / 8; i += c.gthreads) { const long l = i / (128 * D / 8), r = i % (128 * D / 8); *(u32x4*)(wrt + (size_t)l * 256 * D + (size_t)128 * D + r * 8) = (u32x4){0u, 0u, 0u, 0u}; }
      float* gate = (float*)(ws + WS_GATE); for (int i = c.gtid; i < T; i += c.gthreads) gate[TK + i] = 1.f;
      f32x2* ra = (f32x2*)(ws + WS_ROPEA); f32x2* rr = (f32x2*)(ws + WS_ROPER);
      for (int i = c.gtid; i < SEQ * 96; i += c.gthreads) { const int sidx = i / 96, q = i % 96; const bool isA = q < 32; const int jx = isA ? q : q - 32;
          const float e = isA ? (float)jx * (1.f / 32.f) : (float)jx * (1.f / 63.f); const float ang = (float)sidx * exp2f(-e * 13.287712379549449f); float sn, cs; sincosf(ang, &sn, &cs);
          if (isA) ra[sidx * 32 + jx] = (f32x2){cs, sn}; else rr[sidx * 64 + jx] = (f32x2){cs, sn}; }
      float* bp = (float*)(ws + WS_BIASP); for (int i = c.gtid; i < 2 * AB_IN; i += c.gthreads) { const int m = i / AB_IN, n = i % AB_IN; bp[m * AB_IN + ab_phys(n)] = c.in[2][i]; } }
    { bf16_t* d = (bf16_t*)(ws + WS_WABIN);  convert_T(c, c.in[1], 2, D, AB_IN, [=](int m, int n) { return d + (size_t)m * AB_IN * D + (size_t)ab_phys(n) * D; }); }
    { bf16_t* d = (bf16_t*)(ws + WS_WABOUT); convert_T(c, c.in[4], 2, AB_OUT, D, [=](int m, int n) { return d + (size_t)m * D * AB_OUT + (size_t)n * AB_OUT; }); }
    { bf16_t* d = (bf16_t*)(ws + WS_WCDIN);  convert_T(c, c.in[6], 2, D, CD_IN, [=](int m, int n) { return d + (size_t)m * CD_IN * D + (size_t)n * D; }); }
    { bf16_t* d = (bf16_t*)(ws + WS_WCDOUT); convert_T(c, c.in[17], 2, CD_OUT, D, [=](int m, int n) { return d + (size_t)m * D * CD_OUT + (size_t)n * CD_OUT; }); }
    { bf16_t* d = (bf16_t*)(ws + WS_WRT);    convert_T(c, c.in[21], 4, D, NE, [=](int m, int n) { return d + (size_t)m * 256 * D + (size_t)n * D; }); }
    { bf16_t* d = (bf16_t*)(ws + WS_WGU);
      convert_T(c, c.in[23], 4 * NE, D, ED, [=](int m, int n) { return d + (size_t)((m >> 7) * NE1 + (m & 127)) * 512 * D + (size_t)((n >> 7) * 256 + (n & 127)) * D; });
      convert_T(c, c.in[24], 4 * NE, D, ED, [=](int m, int n) { return d + (size_t)((m >> 7) * NE1 + (m & 127)) * 512 * D + (size_t)((n >> 7) * 256 + 128 + (n & 127)) * D; });
      convert_T(c, c.in[26], 4, D, ED, [=](int m, int n) { return d + (size_t)(m * NE1 + NE) * 512 * D + (size_t)((n >> 7) * 256 + (n & 127)) * D; });
      convert_T(c, c.in[27], 4, D, ED, [=](int m, int n) { return d + (size_t)(m * NE1 + NE) * 512 * D + (size_t)((n >> 7) * 256 + 128 + (n & 127)) * D; }); }
    { bf16_t* d = (bf16_t*)(ws + WS_WLRU);
      convert_T(c, c.in[12], 10, 256, 256, [=](int m, int n) { return d + (size_t)(m * 2 + 0) * 65536 + (size_t)n * 256; });
      convert_T(c, c.in[14], 10, 256, 256, [=](int m, int n) { return d + (size_t)(m * 2 + 1) * 65536 + (size_t)n * 256; });
      float* spl = (float*)(ws + WS_SPL); for (int i = c.gtid; i < 2 * 1280; i += c.gthreads) spl[i] = log1pf(expf(-c.in[16][i])); }
    { bf16_t* d = (bf16_t*)(ws + WS_WDN);
      convert_T(c, c.in[25], 4 * NE, ED, D, [=](int m, int n) { return d + (size_t)((m >> 7) * NE1 + (m & 127)) * D * ED + (size_t)n * ED; });
      convert_T(c, c.in[28], 4, ED, D, [=](int m, int n) { return d + (size_t)(m * NE1 + NE) * D * ED + (size_t)n * ED; }); }
}

__device__ __forceinline__ void phase_dense(const Ctx& c, const bf16_t* A, const bf16_t* Bt, int M, int N, int K, float* C, int ldc, const float* bias) {
    g8::DenseOrder S; S.init(A, Bt, M, N, K, c.G, c.bid);
    g8::EpiF32 E{C, ldc, bias};
    g8::gemm_phase<g8::EpiF32, g8::DenseOrder>(c.lds + LDS_STAGE, K, S, E);
}

struct EpiABIn {
    static constexpr bool PERM = true;
    const float* biasP; unsigned char* ws;
    __device__ __forceinline__ void operator()(const f32x4 (&acc)[2][2][4][2], const g8::Unit& u, int wr, int wc, int fr, int fq) const {
        const int pn = u.pn; const int colp = pn * 256 + wc * 32 + fq * 8;
        f32x4 bv[2][2];
#pragma unroll
        for (int bj = 0; bj < 2; ++bj)
#pragma unroll
            for (int n = 0; n < 2; ++n) bv[bj][n] = *(const f32x4*)(biasP + colp + bj * 128 + 4 * n);
        bf16_t* qb = (bf16_t*)(ws + AB_QB); bf16_t* kb = (bf16_t*)(ws + AB_KB); bf16_t* vT = (bf16_t*)(ws + AB_VT); bf16_t* rqb = (bf16_t*)(ws + AB_RQB); bf16_t* rkb = (bf16_t*)(ws + AB_RKB);
        bf16_t* rkdT = (bf16_t*)(ws + AB_RKDT); bf16_t* rvT = (bf16_t*)(ws + AB_RVT); bf16_t* rgb = (bf16_t*)(ws + AB_RGB);
        const f32x4* ropeA = (const f32x4*)(ws + WS_ROPEA); const f32x4* ropeR = (const f32x4*)(ws + WS_ROPER);
#pragma unroll
        for (int ai = 0; ai < 2; ++ai)
#pragma unroll
            for (int m = 0; m < 4; ++m) {
                const int t = u.pm * 256 + ai * 128 + wr * 64 + m * 16 + fr, sq = t & (SEQ - 1), b = t >> 13;
                f32x4 x[2][2];
#pragma unroll
                for (int bj = 0; bj < 2; ++bj)
#pragma unroll
                    for (int n = 0; n < 2; ++n) x[bj][n] = acc[ai][bj][m][n] + bv[bj][n];
                if (pn < 4 || (pn == 4 && wc < 2)) {
                    const int j0 = fq * 8; f32x4 o1[2], o2[2];
#pragma unroll
                    for (int n = 0; n < 2; ++n) { const f32x4 cs01 = ropeA[(sq * 32 + j0 + 4 * n) / 2], cs23 = ropeA[(sq * 32 + j0 + 4 * n) / 2 + 1];
                        const float cc[4] = {cs01[0], cs01[2], cs23[0], cs23[2]}, ss[4] = {cs01[1], cs01[3], cs23[1], cs23[3]};
#pragma unroll
                        for (int e = 0; e < 4; ++e) { o1[n][e] = x[0][n][e] * cc[e] - x[1][n][e] * ss[e]; o2[n][e] = x[1][n][e] * cc[e] + x[0][n][e] * ss[e]; } }
                    const float sc = pn < 4 ? 0.125f : 1.f;
                    u32x4 w1, w2;
#pragma unroll
                    for (int n = 0; n < 2; ++n) { w1[2 * n] = pk2(o1[n][0] * sc, o1[n][1] * sc); w1[2 * n + 1] = pk2(o1[n][2] * sc, o1[n][3] * sc); w2[2 * n] = pk2(o2[n][0] * sc, o2[n][1] * sc); w2[2 * n + 1] = pk2(o2[n][2] * sc, o2[n][3] * sc); }
                    bf16_t* dst = pn < 4 ? qb + (size_t)t * 1024 + (pn * 4 + wc) * 64 + j0 : kb + (size_t)t * 128 + wc * 64 + j0;
                    *(u32x4*)dst = w1; *(u32x4*)(dst + 32) = w2;
                } else if (pn == 4) {
                    const int d0 = (wc - 2) * 32 + fq * 8;
#pragma unroll
                    for (int bj = 0; bj < 2; ++bj)
#pragma unroll
                        for (int n = 0; n < 2; ++n)
#pragma unroll
                            for (int e = 0; e < 4; ++e) vT[((size_t)(b * 2 + bj) * 64 + d0 + 4 * n + e) * SEQ + sq] = f2bf(x[bj][n][e]);
                } else if (pn < 9) {
                    const bool isk = pn >= 7; const int h = ((pn - 5) & 1) * 2 + (wc >> 1), j0 = (wc & 1) * 32 + fq * 8; f32x4 o1[2], o2[2];
                    const float sc = isk ? 0.08838834764831845f : 1.f;
#pragma unroll
                    for (int n = 0; n < 2; ++n) { const f32x4 cs01 = ropeR[(sq * 64 + j0 + 4 * n) / 2], cs23 = ropeR[(sq * 64 + j0 + 4 * n) / 2 + 1];
                        const float cc[4] = {cs01[0], cs01[2], cs23[0], cs23[2]}, ss[4] = {cs01[1], cs01[3], cs23[1], cs23[3]};
#pragma unroll
                        for (int e = 0; e < 4; ++e) { o1[n][e] = (x[0][n][e] * cc[e] - x[1][n][e] * ss[e]) * sc; o2[n][e] = (x[1][n][e] * cc[e] + x[0][n][e] * ss[e]) * sc; } }
                    u32x4 w1, w2;
#pragma unroll
                    for (int n = 0; n < 2; ++n) { w1[2 * n] = pk2(o1[n][0], o1[n][1]); w1[2 * n + 1] = pk2(o1[n][2], o1[n][3]); w2[2 * n] = pk2(o2[n][0], o2[n][1]); w2[2 * n + 1] = pk2(o2[n][2], o2[n][3]); }
                    bf16_t* dst = (isk ? rkb : rqb) + (size_t)t * 512 + h * 128 + j0;
                    *(u32x4*)dst = w1; *(u32x4*)(dst + 64) = w2;
                    if (isk) {
                        const float lg = log2f(1.f - exp2f(-5.f - (float)h)); const float dec = exp2f((float)(127 - (sq & 127)) * lg);
                        bf16_t* dT = rkdT + ((size_t)(b * 4 + h) * 128 + j0) * SEQ + sq;
#pragma unroll
                        for (int n = 0; n < 2; ++n)
#pragma unroll
                            for (int e = 0; e < 4; ++e) { dT[(size_t)(4 * n + e) * SEQ] = f2bf(o1[n][e] * dec); dT[(size_t)(64 + 4 * n + e) * SEQ] = f2bf(o2[n][e] * dec); }
                    }
                } else if (pn < 13) {
                    const int h = pn - 9;
#pragma unroll
                    for (int bj = 0; bj < 2; ++bj)
#pragma unroll
                        for (int n = 0; n < 2; ++n)
#pragma unroll
                            for (int e = 0; e < 4; ++e) rvT[((size_t)(b * 4 + h) * 256 + bj * 128 + wc * 32 + fq * 8 + 4 * n + e) * SEQ + sq] = f2bf(x[bj][n][e]);
                } else {
#pragma unroll
                    for (int bj = 0; bj < 2; ++bj) { u32x4 w;
#pragma unroll
                        for (int n = 0; n < 2; ++n) { w[2 * n] = pk2(siluf_(x[bj][n][0]), siluf_(x[bj][n][1])); w[2 * n + 1] = pk2(siluf_(x[bj][n][2]), siluf_(x[bj][n][3])); }
                        *(u32x4*)(rgb + (size_t)t * 1024 + (pn - 13) * 256 + bj * 128 + wc * 32 + fq * 8) = w; }
                }
            }
    }
};
__device__ __forceinline__ void phase_ab_inproj(const Ctx& c, int j) {
    g8::DenseOrder S; S.init(c.ws + WS_XB, c.ws + WS_WABIN + (size_t)j * AB_IN * D * 2, T, AB_IN, D, c.G, c.bid);
    EpiABIn E{(const float*)(c.ws + WS_BIASP) + (size_t)j * AB_IN, c.ws};
    g8::gemm_phase<EpiABIn, g8::DenseOrder>(c.lds + LDS_STAGE, D, S, E);
}

#define MFMA16(a, b, c) __builtin_amdgcn_mfma_f32_16x16x32_bf16((a), (b), (c), 0, 0, 0)
__device__ __forceinline__ bf16x8 pack8(const f32x4& lo, const f32x4& hi) { u32x4 w; w[0] = g8::cvt_pk_bf16(lo[0], lo[1]); w[1] = g8::cvt_pk_bf16(lo[2], lo[3]); w[2] = g8::cvt_pk_bf16(hi[0], hi[1]); w[3] = g8::cvt_pk_bf16(hi[2], hi[3]); return __builtin_bit_cast(bf16x8, w); }
__device__ __forceinline__ bf16x8 cat8(const u32x2& lo, const u32x2& hi) { u32x4 w; w[0] = lo[0]; w[1] = lo[1]; w[2] = hi[0]; w[3] = hi[1]; return __builtin_bit_cast(bf16x8, w); }
template <int ROWS, int RB>
__device__ __forceinline__ void tile_g2l(LAS unsigned char* dst, const unsigned char* src, size_t gs, int tid, int zrows = 0) {
    constexpr int CPR = RB / 16, TOTAL = ROWS * CPR;
#pragma unroll 4
    for (int i = tid; i < TOTAL; i += NTHREADS) { const int r = i / CPR, cc = i % CPR; u32x4 v = (u32x4){0u, 0u, 0u, 0u}; if (r >= zrows) v = *(const u32x4*)(src + (size_t)r * gs + cc * 16);
        *(LAS u32x4*)(dst + r * (RB + 16) + cc * 16) = v; }
}

__device__ __forceinline__ void attn_unit(const Ctx& c, int unit, const float* sinks) {
    const int b = unit >> 7, n = (unit >> 1) & 63, kvh = unit & 1, hd = kvh * 8 + c.wid, lane = c.lane, fr = lane & 15, fq = lane >> 4;
    const bf16_t* qb = (const bf16_t*)(c.ws + AB_QB); const bf16_t* kb = (const bf16_t*)(c.ws + AB_KB); const bf16_t* vT = (const bf16_t*)(c.ws + AB_VT); bf16_t* ycat = (bf16_t*)(c.ws + WS_YCAT);
    LAS unsigned char* Ks = c.lds; LAS unsigned char* Vs = c.lds + 256 * 144;
    const int t0 = b * SEQ + n * 128;
    __syncthreads();
    {
        const unsigned char* src = (const unsigned char*)(kb + (size_t)(t0 - 128) * 128 + kvh * 64);
        constexpr int TOTAL = 256 * 8;
#pragma unroll 4
        for (int i = c.tid; i < TOTAL; i += NTHREADS) { const int r = i >> 3, cc = i & 7; u32x4 v = (u32x4){0u, 0u, 0u, 0u}; if (n > 0 || r >= 128) v = *(const u32x4*)(src + (ptrdiff_t)r * 256 + cc * 16);
            *(LAS u32x4*)(Ks + r * 144 + cc * 16) = v; }
        const unsigned char* vsrc = (const unsigned char*)(vT + (size_t)(b * 2 + kvh) * 64 * SEQ + (n * 128 - 128));
        constexpr int TV = 64 * 32;
#pragma unroll 4
        for (int i = c.tid; i < TV; i += NTHREADS) { const int r = i >> 5, cc = i & 31; u32x4 v = (u32x4){0u, 0u, 0u, 0u}; if (n > 0 || cc >= 16) v = *(const u32x4*)(vsrc + (ptrdiff_t)r * SEQ * 2 + cc * 16);
            *(LAS u32x4*)(Vs + r * 528 + cc * 16) = v; }
    }
    __syncthreads();
    const float sink = sinks[hd];
    for (int si = 0; si < 8; ++si) {
        const int t = t0 + si * 16 + fr;
        bf16x8 qf[2];
#pragma unroll
        for (int ks = 0; ks < 2; ++ks) qf[ks] = *(const bf16x8*)(qb + (size_t)t * 1024 + hd * 64 + ks * 32 + fq * 8);
        f32x4 S[10];
#pragma unroll
        for (int nk = 0; nk < 9; ++nk) { S[nk] = (f32x4){0.f, 0.f, 0.f, 0.f};
#pragma unroll
            for (int ks = 0; ks < 2; ++ks) { const bf16x8 a = *(const LAS bf16x8*)(Ks + (16 * (si + nk) + fr) * 144 + ks * 64 + fq * 16); S[nk] = MFMA16(a, qf[ks], S[nk]); } }
        S[9] = (f32x4){0.f, 0.f, 0.f, 0.f};
        const int i = si * 16 + fr;
        float mx = sink;
#pragma unroll
        for (int nk = 0; nk < 9; ++nk)
#pragma unroll
            for (int r = 0; r < 4; ++r) { const int p = 16 * (si + nk) + 4 * fq + r; const bool ok = (p >= i + 1) && (p <= i + 128) && (n > 0 || p >= 128);
                S[nk][r] = ok ? S[nk][r] : -1e30f; mx = fmaxf(mx, S[nk][r]); }
        mx = fmaxf(mx, __shfl_xor(mx, 16)); mx = fmaxf(mx, __shfl_xor(mx, 32));
        float sum = 0.f;
#pragma unroll
        for (int nk = 0; nk < 9; ++nk)
#pragma unroll
            for (int r = 0; r < 4; ++r) { const float pv = S[nk][r] > -1e29f ? exp2f((S[nk][r] - mx) * 1.4426950408889634f) : 0.f; S[nk][r] = pv; sum += pv; }
        sum += __shfl_xor(sum, 16); sum += __shfl_xor(sum, 32);
        const float inv = 1.f / (sum + exp2f((sink - mx) * 1.4426950408889634f));
        f32x4 O[4];
#pragma unroll
        for (int nd = 0; nd < 4; ++nd) O[nd] = (f32x4){0.f, 0.f, 0.f, 0.f};
#pragma unroll
        for (int kk = 0; kk < 5; ++kk) { const bf16x8 pf = pack8(S[2 * kk], S[2 * kk + 1]);
            const int p0 = 16 * (si + 2 * kk) + 4 * fq, p1 = (kk == 4 && si == 7) ? p0 : p0 + 16;
#pragma unroll
            for (int nd = 0; nd < 4; ++nd) { const u32x2 lo = *(const LAS u32x2*)(Vs + (16 * nd + fr) * 528 + p0 * 2), hi = *(const LAS u32x2*)(Vs + (16 * nd + fr) * 528 + p1 * 2);
                O[nd] = MFMA16(cat8(lo, hi), pf, O[nd]); } }
#pragma unroll
        for (int nd = 0; nd < 4; ++nd) { u32x2 w; w[0] = pk2(O[nd][0] * inv, O[nd][1] * inv); w[1] = pk2(O[nd][2] * inv, O[nd][3] * inv);
            *(u32x2*)(ycat + (size_t)t * AB_OUT + hd * 64 + 16 * nd + 4 * fq) = w; }
    }
}

__device__ __forceinline__ void ret_kv_unit(const Ctx& c, int unit) {
    const int b = unit >> 8, n = (unit >> 2) & 63, h = unit & 3, lane = c.lane, fr = lane & 15, fq = lane >> 4, w = c.wid;
    const bf16_t* rkdT = (const bf16_t*)(c.ws + AB_RKDT); const bf16_t* rvT = (const bf16_t*)(c.ws + AB_RVT); float* kv = (float*)(c.ws + AB_KV);
    LAS unsigned char* Kd = c.lds;
    __syncthreads();
    tile_g2l<128, 256>(Kd, (const unsigned char*)(rkdT + (size_t)(b * 4 + h) * 128 * SEQ + n * 128), (size_t)SEQ * 2, c.tid);
    bf16x8 vf[2][4];
#pragma unroll
    for (int ne = 0; ne < 2; ++ne)
#pragma unroll
        for (int ks = 0; ks < 4; ++ks) vf[ne][ks] = *(const bf16x8*)(rvT + ((size_t)(b * 4 + h) * 256 + 32 * w + 16 * ne + fr) * SEQ + n * 128 + ks * 32 + fq * 8);
    __syncthreads();
    float* out = kv + ((size_t)((b * 64 + n) * 4 + h)) * 256 * 128;
#pragma unroll
    for (int nd = 0; nd < 8; ++nd) { f32x4 a0 = (f32x4){0.f, 0.f, 0.f, 0.f}, a1 = a0;
#pragma unroll
        for (int ks = 0; ks < 4; ++ks) { const bf16x8 kf = *(const LAS bf16x8*)(Kd + (16 * nd + fr) * 272 + ks * 64 + fq * 16); a0 = MFMA16(kf, vf[0][ks], a0); a1 = MFMA16(kf, vf[1][ks], a1); }
        *(f32x4*)(out + (size_t)(32 * w + fr) * 128 + 16 * nd + 4 * fq) = a0; *(f32x4*)(out + (size_t)(32 * w + 16 + fr) * 128 + 16 * nd + 4 * fq) = a1; }
}
__device__ __forceinline__ void ret_scan(const Ctx& c, int first_block, int nblocks) {
    const float* kv = (const float*)(c.ws + AB_KV); bf16_t* sp = (bf16_t*)(c.ws + AB_SPREV);
    const int nthr = nblocks * NTHREADS;
    for (int idx = (c.bid - first_block) * NTHREADS + c.tid; idx < 2 * 4 * 256 * 128 / 4; idx += nthr) {
        const int b = idx >> 15, rem = idx & 32767, h = rem >> 13;
        const float g = exp2f(128.f * log2f(1.f - exp2f(-5.f - (float)h)));
        const size_t base = (size_t)b * 64 * 131072 + (size_t)rem * 4;
        f32x4 st = (f32x4){0.f, 0.f, 0.f, 0.f};
        for (int n0 = 0; n0 < 64; n0 += 8) { f32x4 v[8];
#pragma unroll
            for (int q = 0; q < 8; ++q) v[q] = *(const f32x4*)(kv + base + (size_t)(n0 + q) * 131072);
#pragma unroll
            for (int q = 0; q < 8; ++q) { u32x2 wv; wv[0] = pk2(st[0], st[1]); wv[1] = pk2(st[2], st[3]); *(u32x2*)(sp + base + (size_t)(n0 + q) * 131072) = wv; st = st * g + v[q]; } }
    }
}
__device__ __forceinline__ void ret_out_unit(const Ctx& c, int unit) {
    const int b = unit >> 8, n = (unit >> 2) & 63, h = unit & 3, lane = c.lane, fr = lane & 15, fq = lane >> 4, w = c.wid;
    const bf16_t* rqb = (const bf16_t*)(c.ws + AB_RQB); const bf16_t* rkb = (const bf16_t*)(c.ws + AB_RKB); const bf16_t* rvT = (const bf16_t*)(c.ws + AB_RVT);
    const bf16_t* sp = (const bf16_t*)(c.ws + AB_SPREV); const bf16_t* rgb = (const bf16_t*)(c.ws + AB_RGB); bf16_t* ycat = (bf16_t*)(c.ws + WS_YCAT);
    LAS unsigned char* Kl = c.lds; LAS unsigned char* Bl = c.lds + 128 * 272;
    const int t0 = b * SEQ + n * 128; const float lg = log2f(1.f - exp2f(-5.f - (float)h));
    __syncthreads();
    tile_g2l<128, 256>(Kl, (const unsigned char*)(rkb + (size_t)t0 * 512 + h * 128), (size_t)512 * 2, c.tid);
    tile_g2l<256, 256>(Bl, (const unsigned char*)(sp + ((size_t)((b * 64 + n) * 4 + h)) * 256 * 128), (size_t)128 * 2, c.tid);
    const int t = t0 + 16 * w + fr, i = 16 * w + fr;
    bf16x8 qf[4];
#pragma unroll
    for (int ks = 0; ks < 4; ++ks) qf[ks] = *(const bf16x8*)(rqb + (size_t)t * 512 + h * 128 + ks * 32 + fq * 8);
    __syncthreads();
    bf16x8 pf[4];
#pragma unroll
    for (int kk = 0; kk < 4; ++kk) { f32x4 s2[2];
#pragma unroll
        for (int q = 0; q < 2; ++q) { const int nj = 2 * kk + q; s2[q] = (f32x4){0.f, 0.f, 0.f, 0.f};
            if (nj <= w) {
#pragma unroll
                for (int ks = 0; ks < 4; ++ks) { const bf16x8 kf = *(const LAS bf16x8*)(Kl + (16 * nj + fr) * 272 + ks * 64 + fq * 16); s2[q] = MFMA16(kf, qf[ks], s2[q]); }
#pragma unroll
                for (int r = 0; r < 4; ++r) { const int jj = 16 * nj + 4 * fq + r; s2[q][r] = (i >= jj) ? s2[q][r] * exp2f((float)(i - jj) * lg) : 0.f; } } }
        pf[kk] = pack8(s2[0], s2[1]); }
    f32x4 acc[16];
#pragma unroll
    for (int ne = 0; ne < 16; ++ne) { acc[ne] = (f32x4){0.f, 0.f, 0.f, 0.f};
#pragma unroll
        for (int ks = 0; ks < 4; ++ks) { const bf16x8 sf = *(const LAS bf16x8*)(Bl + (16 * ne + fr) * 272 + ks * 64 + fq * 16); acc[ne] = MFMA16(sf, qf[ks], acc[ne]); } }
    const float rs = exp2f((float)(i + 1) * lg);
#pragma unroll
    for (int ne = 0; ne < 16; ++ne) acc[ne] = acc[ne] * rs;
    __syncthreads();
    tile_g2l<256, 256>(Bl, (const unsigned char*)(rvT + (size_t)(b * 4 + h) * 256 * SEQ + n * 128), (size_t)SEQ * 2, c.tid);
    __syncthreads();
    const int nkk = (w >> 1) + 1;
#pragma unroll
    for (int kk = 0; kk < 4; ++kk) if (kk < nkk) {
#pragma unroll
        for (int ne = 0; ne < 16; ++ne) { const u32x2 lo = *(const LAS u32x2*)(Bl + (16 * ne + fr) * 272 + (32 * kk + 4 * fq) * 2), hi = *(const LAS u32x2*)(Bl + (16 * ne + fr) * 272 + (32 * kk + 16 + 4 * fq) * 2);
            acc[ne] = MFMA16(cat8(lo, hi), pf[kk], acc[ne]); } }
    float sm = 0.f;
#pragma unroll
    for (int ne = 0; ne < 16; ++ne) sm += acc[ne][0] + acc[ne][1] + acc[ne][2] + acc[ne][3];
    sm += __shfl_xor(sm, 16); sm += __shfl_xor(sm, 32);
    const float mean = sm * (1.f / 256.f); float sq = 0.f;
#pragma unroll
    for (int ne = 0; ne < 16; ++ne) { acc[ne] = acc[ne] - mean; sq += acc[ne][0] * acc[ne][0] + acc[ne][1] * acc[ne][1] + acc[ne][2] * acc[ne][2] + acc[ne][3] * acc[ne][3]; }
    sq += __shfl_xor(sq, 16); sq += __shfl_xor(sq, 32);
    const float rstd = rsqrtf(sq * (1.f / 256.f) + LN_EPS);
#pragma unroll
    for (int ne = 0; ne < 16; ++ne) { const u32x2 gw = *(const u32x2*)(rgb + (size_t)t * 1024 + h * 256 + 16 * ne + 4 * fq);
        const float g0 = __uint_as_float(gw[0] << 16), g1 = __uint_as_float(gw[0] & 0xffff0000u), g2 = __uint_as_float(gw[1] << 16), g3 = __uint_as_float(gw[1] & 0xffff0000u);
        u32x2 o; o[0] = pk2(acc[ne][0] * rstd * g0, acc[ne][1] * rstd * g1); o[1] = pk2(acc[ne][2] * rstd * g2, acc[ne][3] * rstd * g3);
        *(u32x2*)(ycat + (size_t)t * AB_OUT + 1024 + h * 256 + 16 * ne + 4 * fq) = o; }
}

__device__ __forceinline__ void phase_ab_p1(const Ctx& c) {
    for (int u = c.bid; u < 512; u += c.G) ret_kv_unit(c, u);
}
__device__ __forceinline__ void phase_ab_p2(const Ctx& c, int j) {
    if (c.bid < 64) ret_scan(c, 0, 64);
    else { const float* sinks = c.in[3] + j * 16; for (int u = c.bid - 64; u < 256; u += c.G - 64) attn_unit(c, u, sinks); }
}
__device__ __forceinline__ void phase_ab_p3(const Ctx& c) {
    for (int u = c.bid; u < 512; u += c.G) ret_out_unit(c, u);
}

__device__ __forceinline__ float gelu_fast(float x) { const float u = 1.5957691216057308f * (x + 0.044715f * x * x * x); return x / (1.f + __expf(-u)); }
struct EpiCDIn {
    static constexpr bool PERM = true;
    const float* bias; unsigned char* ws;
    __device__ __forceinline__ void operator()(const f32x4 (&acc)[2][2][4][2], const g8::Unit& u, int wr, int wc, int fr, int fq) const {
        const int pn = u.pn; const int col0 = pn * 256 + wc * 32 + fq * 8;
        f32x4 bv[2][2];
#pragma unroll
        for (int bj = 0; bj < 2; ++bj)
#pragma unroll
            for (int n = 0; n < 2; ++n) bv[bj][n] = *(const f32x4*)(bias + col0 + bj * 128 + 4 * n);
        bf16_t* gu = (bf16_t*)(ws + CD_GU); bf16_t* gvT = (bf16_t*)(ws + CD_GVT); bf16_t* gg = (bf16_t*)(ws + CD_GG); bf16_t* xr = (bf16_t*)(ws + CD_XR); float* stats = (float*)(ws + CD_STATS);
#pragma unroll
        for (int ai = 0; ai < 2; ++ai)
#pragma unroll
            for (int m = 0; m < 4; ++m) {
                const int t = u.pm * 256 + ai * 128 + wr * 64 + m * 16 + fr, sq = t & (SEQ - 1), b = t >> 13;
                f32x4 x[2][2];
#pragma unroll
                for (int bj = 0; bj < 2; ++bj)
#pragma unroll
                    for (int n = 0; n < 2; ++n) { x[bj][n] = acc[ai][bj][m][n] + bv[bj][n];
                        if (pn < 13) {
#pragma unroll
                            for (int e = 0; e < 4; ++e) x[bj][n][e] = gelu_fast(x[bj][n][e]); } }
                if (pn >= 4 && pn < 8) {
                    float s1 = 0.f, s2 = 0.f;
#pragma unroll
                    for (int bj = 0; bj < 2; ++bj)
#pragma unroll
                        for (int n = 0; n < 2; ++n)
#pragma unroll
                            for (int e = 0; e < 4; ++e) { const float v = x[bj][n][e]; s1 += v; s2 += v * v;
                                gvT[((size_t)b * 1024 + (pn - 4) * 256 + bj * 128 + wc * 32 + fq * 8 + 4 * n + e) * SEQ + sq] = f2bf(v); }
                    s1 += __shfl_xor(s1, 16); s1 += __shfl_xor(s1, 32); s2 += __shfl_xor(s2, 16); s2 += __shfl_xor(s2, 32);
                    if (fq == 0) *(f32x2*)(stats + (size_t)t * 32 + ((pn - 4) * 4 + wc) * 2) = (f32x2){s1, s2};
                } else {
                    bf16_t* dst; int ld, cb;
                    if (pn < 4) { dst = gu; ld = 1024; cb = pn * 256; } else if (pn < 13) { dst = gg; ld = 1280; cb = (pn - 8) * 256; } else { dst = xr; ld = 1280; cb = (pn - 13) * 256; }
#pragma unroll
                    for (int bj = 0; bj < 2; ++bj) { u32x4 w;
#pragma unroll
                        for (int n = 0; n < 2; ++n) { w[2 * n] = pk2(x[bj][n][0], x[bj][n][1]); w[2 * n + 1] = pk2(x[bj][n][2], x[bj][n][3]); }
                        *(u32x4*)(dst + (size_t)t * ld + cb + bj * 128 + wc * 32 + fq * 8) = w; }
                }
            }
    }
};
__device__ __forceinline__ void phase_cd_inproj(const Ctx& c, int j) {
    g8::DenseOrder S; S.init(c.ws + WS_XB, c.ws + WS_WCDIN + (size_t)j * CD_IN * D * 2, T, CD_IN, D, c.G, c.bid);
    EpiCDIn E{c.in[7] + (size_t)j * CD_IN, c.ws};
    g8::gemm_phase<EpiCDIn, g8::DenseOrder>(c.lds + LDS_STAGE, D, S, E);
}

__device__ __forceinline__ void lru_unit(const Ctx& c, int unit, int j) {
    const int hh = unit % 5, bn = unit / 5, lane = c.lane, fr = lane & 15, fq = lane >> 4, w = c.wid;
    const int t0 = bn * 128, s0 = t0 & (SEQ - 1);
    const bf16_t* xr = (const bf16_t*)(c.ws + CD_XR); bf16_t* HL = (bf16_t*)(c.ws + WS_U2); bf16_t* PC = HL + (size_t)T * 1280; float* sum = (float*)(c.ws + WS_H);
    const float* conv_w = c.in[10] + (size_t)j * 4 * 1280 + hh * 256; const float* conv_b = c.in[11] + (size_t)j * 1280 + hh * 256;
    const float* ba = c.in[13] + (size_t)j * 1280 + hh * 256; const float* bx = c.in[15] + (size_t)j * 1280 + hh * 256; const float* spl = (const float*)(c.ws + WS_SPL) + (size_t)j * 1280 + hh * 256;
    const bf16_t* Wl = (const bf16_t*)(c.ws + WS_WLRU) + (size_t)((j * 5 + hh) * 2) * 65536;
    LAS unsigned char* Xc = c.lds; LAS unsigned char* Wa = c.lds + 128 * 528; LAS unsigned char* Wx = Wa + 64 * 528; LAS unsigned char* Tot = Wx + 64 * 528;
    __syncthreads();
    for (int it = c.tid; it < 128 * 32; it += NTHREADS) { const int r = it >> 5, cg = it & 31;
        float a[8];
        { const f32x4 b0 = *(const f32x4*)(conv_b + cg * 8), b1 = *(const f32x4*)(conv_b + cg * 8 + 4); a[0] = b0[0]; a[1] = b0[1]; a[2] = b0[2]; a[3] = b0[3]; a[4] = b1[0]; a[5] = b1[1]; a[6] = b1[2]; a[7] = b1[3]; }
#pragma unroll
        for (int k = 0; k < 4; ++k) { if (s0 + r - 3 + k >= 0) {
                const u32x4 xv = *(const u32x4*)(xr + (size_t)(t0 + r - 3 + k) * 1280 + hh * 256 + cg * 8);
                const f32x4 w0 = *(const f32x4*)(conv_w + k * 1280 + cg * 8), w1 = *(const f32x4*)(conv_w + k * 1280 + cg * 8 + 4);
                a[0] += w0[0] * __uint_as_float(xv[0] << 16); a[1] += w0[1] * __uint_as_float(xv[0] & 0xffff0000u); a[2] += w0[2] * __uint_as_float(xv[1] << 16); a[3] += w0[3] * __uint_as_float(xv[1] & 0xffff0000u);
                a[4] += w1[0] * __uint_as_float(xv[2] << 16); a[5] += w1[1] * __uint_as_float(xv[2] & 0xffff0000u); a[6] += w1[2] * __uint_as_float(xv[3] << 16); a[7] += w1[3] * __uint_as_float(xv[3] & 0xffff0000u); } }
        u32x4 o; o[0] = pk2(a[0], a[1]); o[1] = pk2(a[2], a[3]); o[2] = pk2(a[4], a[5]); o[3] = pk2(a[6], a[7]);
        *(LAS u32x4*)(Xc + r * 528 + cg * 16) = o; }
    __syncthreads();
    bf16x8 xf[8];
#pragma unroll
    for (int ks = 0; ks < 8; ++ks) xf[ks] = *(const LAS bf16x8*)(Xc + (16 * w + fr) * 528 + ks * 64 + fq * 16);
    const int t = t0 + 16 * w + fr;
    for (int sl = 0; sl < 4; ++sl) {
        if (sl) __syncthreads();
        tile_g2l<64, 512>(Wa, (const unsigned char*)(Wl + (size_t)(sl * 64) * 256), 512, c.tid);
        tile_g2l<64, 512>(Wx, (const unsigned char*)(Wl + 65536 + (size_t)(sl * 64) * 256), 512, c.tid);
        __syncthreads();
        f32x4 sA[4], sB[4];
#pragma unroll
        for (int nc = 0; nc < 4; ++nc) { f32x4 ra = (f32x4){0.f, 0.f, 0.f, 0.f}, ri = ra;
#pragma unroll
            for (int ks = 0; ks < 8; ++ks) { const bf16x8 wa = *(const LAS bf16x8*)(Wa + (16 * nc + fr) * 528 + ks * 64 + fq * 16), wx = *(const LAS bf16x8*)(Wx + (16 * nc + fr) * 528 + ks * 64 + fq * 16);
                ra = MFMA16(wa, xf[ks], ra); ri = MFMA16(wx, xf[ks], ri); }
            const int ch = sl * 64 + 16 * nc + 4 * fq;
            const f32x4 b_a = *(const f32x4*)(ba + ch), b_x = *(const f32x4*)(bx + ch), sp = *(const f32x4*)(spl + ch);
            const u32x2 xw = *(const LAS u32x2*)(Xc + (16 * w + fr) * 528 + ch * 2);
            const float xcv[4] = {__uint_as_float(xw[0] << 16), __uint_as_float(xw[0] & 0xffff0000u), __uint_as_float(xw[1] << 16), __uint_as_float(xw[1] & 0xffff0000u)};
            f32x4 oa, ob;
#pragma unroll
            for (int r = 0; r < 4; ++r) { const float gr = sigmoidf_(ra[r] + b_a[r]), gi = sigmoidf_(ri[r] + b_x[r]); const float la = -8.f * gr * sp[r]; const float a = __expf(la);
                oa[r] = a; ob[r] = sqrtf(fmaxf(1.f - a * a, 0.f)) * (gi * xcv[r]); }
#pragma unroll
            for (int dlt = 1; dlt < 16; dlt <<= 1) {
#pragma unroll
                for (int r = 0; r < 4; ++r) { const float pa = __shfl_up(oa[r], dlt, 16), pb = __shfl_up(ob[r], dlt, 16); if (fr >= dlt) { ob[r] = oa[r] * pb + ob[r]; oa[r] = oa[r] * pa; } } }
            sA[nc] = oa; sB[nc] = ob;
            if (fr == 15) { *(LAS f32x4*)(Tot + ((w * 64 + 16 * nc + 4 * fq) * 2) * 4) = oa; *(LAS f32x4*)(Tot + ((w * 64 + 16 * nc + 4 * fq) * 2 + 4) * 4) = ob; }
        }
        __syncthreads();
#pragma unroll
        for (int nc = 0; nc < 4; ++nc) { const int ch = sl * 64 + 16 * nc + 4 * fq;
            f32x4 cp = (f32x4){1.f, 1.f, 1.f, 1.f}, chh = (f32x4){0.f, 0.f, 0.f, 0.f};
            for (int w2 = 0; w2 < w; ++w2) { const f32x4 ta = *(const LAS f32x4*)(Tot + ((w2 * 64 + 16 * nc + 4 * fq) * 2) * 4), tb = *(const LAS f32x4*)(Tot + ((w2 * 64 + 16 * nc + 4 * fq) * 2 + 4) * 4);
                chh = ta * chh + tb; cp = cp * ta; }
            const f32x4 hl = sB[nc] + sA[nc] * chh, pc = sA[nc] * cp;
            u32x2 o1, o2; o1[0] = pk2(hl[0], hl[1]); o1[1] = pk2(hl[2], hl[3]); o2[0] = pk2(pc[0], pc[1]); o2[1] = pk2(pc[2], pc[3]);
            *(u32x2*)(HL + (size_t)t * 1280 + hh * 256 + ch) = o1; *(u32x2*)(PC + (size_t)t * 1280 + hh * 256 + ch) = o2;
            if (w == 7 && fr == 15) { float* sm = sum + ((size_t)bn * 1280 + hh * 256 + ch) * 2;
#pragma unroll
                for (int r = 0; r < 4; ++r) { sm[2 * r] = pc[r]; sm[2 * r + 1] = hl[r]; } } }
    }
}

__device__ __forceinline__ void sgu_unit(const Ctx& c, int unit, int j) {
    const int g = unit & 3, bn = unit >> 2, b = bn >> 6, n = bn & 63, lane = c.lane, fr = lane & 15, fq = lane >> 4, w = c.wid;
    const int t0 = bn * 128;
    const bf16_t* gu = (const bf16_t*)(c.ws + CD_GU); const bf16_t* gvT = (const bf16_t*)(c.ws + CD_GVT); const float* stats = (const float*)(c.ws + CD_STATS); bf16_t* ycat = (bf16_t*)(c.ws + WS_YCAT);
    const float* sw = c.in[8] + (size_t)(j * 4 + g) * 16384; const float* sb = c.in[9] + (size_t)(j * 4 + g) * 128;
    LAS unsigned char* Vt = c.lds; LAS float* mr = (LAS float*)(c.lds + 256 * 272);
    __syncthreads();
    tile_g2l<256, 256>(Vt, (const unsigned char*)(gvT + ((size_t)b * 1024 + g * 256) * SEQ + n * 128), (size_t)SEQ * 2, c.tid);
    if (c.tid < 128) { const float* st = stats + (size_t)(t0 + c.tid) * 32; float s1 = 0.f, s2 = 0.f;
#pragma unroll
        for (int q = 0; q < 16; ++q) { s1 += st[2 * q]; s2 += st[2 * q + 1]; }
        const float mean = s1 * (1.f / 1024.f), var = fmaxf(s2 * (1.f / 1024.f) - mean * mean, 0.f); mr[2 * c.tid] = mean; mr[2 * c.tid + 1] = rsqrtf(var + LN_EPS); }
    __syncthreads();
    const int i = 16 * w + fr, t = t0 + i, nks = (w >> 1) + 1;
    bf16x8 wf[4]; float ci = 0.f;
#pragma unroll
    for (int ks = 0; ks < 4; ++ks) { f32x4 lo = (f32x4){0.f, 0.f, 0.f, 0.f}, hi = lo;
        if (ks < nks) { const int j0 = ks * 32 + fq * 8; const f32x4 w0 = *(const f32x4*)(sw + (size_t)i * 128 + j0), w1 = *(const f32x4*)(sw + (size_t)i * 128 + j0 + 4);
#pragma unroll
            for (int e = 0; e < 4; ++e) { const float m0 = mr[2 * (j0 + e)], r0 = mr[2 * (j0 + e) + 1], m1 = mr[2 * (j0 + 4 + e)], r1 = mr[2 * (j0 + 4 + e) + 1];
                lo[e] = (j0 + e <= i) ? w0[e] * r0 : 0.f; hi[e] = (j0 + 4 + e <= i) ? w1[e] * r1 : 0.f; ci += lo[e] * m0 + hi[e] * m1; } }
        wf[ks] = pack8(lo, hi); }
    ci += __shfl_xor(ci, 16); ci += __shfl_xor(ci, 32);
    const float add = sb[i] - ci;
    f32x4 acc[16];
#pragma unroll
    for (int nd = 0; nd < 16; ++nd) { acc[nd] = (f32x4){0.f, 0.f, 0.f, 0.f};
#pragma unroll
        for (int ks = 0; ks < 4; ++ks) if (ks < nks) { const bf16x8 vf = *(const LAS bf16x8*)(Vt + (16 * nd + fr) * 272 + ks * 64 + fq * 16); acc[nd] = MFMA16(vf, wf[ks], acc[nd]); } }
#pragma unroll
    for (int nd = 0; nd < 16; ++nd) { const u32x2 uw = *(const u32x2*)(gu + (size_t)t * 1024 + g * 256 + 16 * nd + 4 * fq);
        const float u0 = __uint_as_float(uw[0] << 16), u1 = __uint_as_float(uw[0] & 0xffff0000u), u2 = __uint_as_float(uw[1] << 16), u3 = __uint_as_float(uw[1] & 0xffff0000u);
        u32x2 o; o[0] = pk2(u0 * (acc[nd][0] + add), u1 * (acc[nd][1] + add)); o[1] = pk2(u2 * (acc[nd][2] + add), u3 * (acc[nd][3] + add));
        *(u32x2*)(ycat + (size_t)t * CD_OUT + g * 256 + 16 * nd + 4 * fq) = o; }
}
__device__ __forceinline__ void phase_cd_p1(const Ctx& c, int j) {
    for (int u = c.bid; u < 640 + 512; u += c.G) { if (u < 640) lru_unit(c, u, j); else sgu_unit(c, u - 640, j); }
}

__device__ __forceinline__ void phase_cd_scan2(const Ctx& c) {
    const bf16_t* gg = (const bf16_t*)(c.ws + CD_GG); bf16_t* ycat = (bf16_t*)(c.ws + WS_YCAT);
    const bf16_t* HL = (const bf16_t*)(c.ws + WS_U2); const bf16_t* PC = HL + (size_t)T * 1280; const float* sum = (const float*)(c.ws + WS_H);
    LAS float* carry = (LAS float*)c.lds;
    for (int u = c.bid; u < 256; u += c.G) {
        const int bn = u >> 1, half = u & 1, b = bn >> 6, n = bn & 63;
        __syncthreads();
        for (int ch = c.tid; ch < 1280; ch += NTHREADS) { float cr = 0.f; const float* sp = sum + ((size_t)(b * 64) * 1280 + ch) * 2;
#pragma unroll 8
            for (int m = 0; m < n; ++m) { const f32x2 v = *(const f32x2*)(sp + (size_t)m * 2560); cr = v[0] * cr + v[1]; }
            carry[ch] = cr; }
        __syncthreads();
        const size_t t0 = (size_t)bn * 128 + half * 64;
#pragma unroll 4
        for (int it = c.tid; it < 64 * 320; it += NTHREADS) { const int r = it / 320, c4 = (it % 320) * 4; const size_t o = (t0 + r) * 1280 + c4;
            const u32x2 hw = *(const u32x2*)(HL + o), pw = *(const u32x2*)(PC + o), gw = *(const u32x2*)(gg + o); const f32x4 cr = *(const LAS f32x4*)(carry + c4);
            const float h0 = __uint_as_float(hw[0] << 16) + __uint_as_float(pw[0] << 16) * cr[0], h1 = __uint_as_float(hw[0] & 0xffff0000u) + __uint_as_float(pw[0] & 0xffff0000u) * cr[1];
            const float h2 = __uint_as_float(hw[1] << 16) + __uint_as_float(pw[1] << 16) * cr[2], h3 = __uint_as_float(hw[1] & 0xffff0000u) + __uint_as_float(pw[1] & 0xffff0000u) * cr[3];
            u32x2 ow; ow[0] = pk2(__uint_as_float(gw[0] << 16) * h0, __uint_as_float(gw[0] & 0xffff0000u) * h1); ow[1] = pk2(__uint_as_float(gw[1] << 16) * h2, __uint_as_float(gw[1] & 0xffff0000u) * h3);
            *(u32x2*)(ycat + (t0 + r) * CD_OUT + 1024 + c4) = ow; }
    }
}

template <bool MOE>
__device__ __forceinline__ void phase_ln(const Ctx& c, const float* g, const float* bta, float* xout) {
    float* x = (float*)(c.ws + WS_X); bf16_t* xb = (bf16_t*)(c.ws + WS_XB);
    const float* hbuf = (const float*)(c.ws + WS_H); const bf16_t* Y = (const bf16_t*)(c.ws + WS_U1);
    for (long tt = (long)c.gw * 2; tt < T; tt += (long)c.nwaves * 2) {
        f32x4 v[2][4];
#pragma unroll
        for (int u = 0; u < 2; ++u) { const long t = tt + u;
#pragma unroll
            for (int q = 0; q < 4; ++q) { const int col = q * 256 + c.lane * 4;
                f32x4 f;
                if (!MOE) f = *(const f32x4*)(hbuf + (size_t)t * D + col);
                else { f = (f32x4){0.f, 0.f, 0.f, 0.f};
#pragma unroll
                    for (int k = 0; k < 9; ++k) { const size_t srow = (k < 8) ? (size_t)t * 8 + k : (size_t)TK + t; const u32x2 w = *(const u32x2*)(Y + srow * D + col);
                        f[0] += __uint_as_float(w[0] << 16); f[1] += __uint_as_float(w[0] & 0xffff0000u); f[2] += __uint_as_float(w[1] << 16); f[3] += __uint_as_float(w[1] & 0xffff0000u); } }
                const f32x4 xv = *(const f32x4*)(x + (size_t)t * D + col);
                v[u][q] = xv * ALPHA + f; } }
#pragma unroll
        for (int u = 0; u < 2; ++u) { const long t = tt + u;
            float sm = 0.f;
#pragma unroll
            for (int q = 0; q < 4; ++q) sm += v[u][q][0] + v[u][q][1] + v[u][q][2] + v[u][q][3];
            const float mean = wave_sum(sm) * (1.f / 1024.f); float sq = 0.f;
#pragma unroll
            for (int q = 0; q < 4; ++q) { v[u][q] = v[u][q] - mean; sq += v[u][q][0] * v[u][q][0] + v[u][q][1] * v[u][q][1] + v[u][q][2] * v[u][q][2] + v[u][q][3] * v[u][q][3]; }
            const float rstd = rsqrtf(wave_sum(sq) * (1.f / 1024.f) + LN_EPS);
#pragma unroll
            for (int q = 0; q < 4; ++q) { const int col = q * 256 + c.lane * 4; const f32x4 gg = *(const f32x4*)(g + col), bb = *(const f32x4*)(bta + col);
                const f32x4 o = v[u][q] * rstd * gg + bb;
                *(f32x4*)(xout + (size_t)t * D + col) = o; if (xout != x) *(f32x4*)(x + (size_t)t * D + col) = o;
                u32x2 w; w[0] = pk2(o[0], o[1]); w[1] = pk2(o[2], o[3]); *(u32x2*)(xb + (size_t)t * D + col) = w; } }
    }
}

__device__ __forceinline__ void phase_ln_route(const Ctx& c, int L) {
    float* x = (float*)(c.ws + WS_X); bf16_t* xb = (bf16_t*)(c.ws + WS_XB); const float* hbuf = (const float*)(c.ws + WS_H);
    const float* g = c.in[19] + (size_t)L * D; const float* bta = c.in[20] + (size_t)L * D; const float* rb = c.in[22] + L * NE;
    const bf16_t* Wr = (const bf16_t*)(c.ws + WS_WRT) + (size_t)L * 256 * D;
    int* cnt = (int*)(c.ws + CTL_CNT) + L * NE * 1024; int* list = (int*)(c.ws + WS_LIST); float* gate = (float*)(c.ws + WS_GATE);
    LAS unsigned char* Xl = c.lds; LAS float* Sc = (LAS float*)c.lds;
    const int lane = c.lane, fr = lane & 15, fq = lane >> 4, w = c.wid;
    for (int grp = c.bid; grp < T / 64; grp += c.G) {
        __syncthreads();
        for (int q8 = 0; q8 < 8; q8 += 4) {
            f32x4 v[4][4];
#pragma unroll
            for (int u = 0; u < 4; ++u) { const size_t t = (size_t)grp * 64 + w * 8 + q8 + u;
#pragma unroll
                for (int q = 0; q < 4; ++q) { const int col = q * 256 + lane * 4; v[u][q] = *(const f32x4*)(x + t * D + col) * ALPHA + *(const f32x4*)(hbuf + t * D + col); } }
#pragma unroll
            for (int u = 0; u < 4; ++u) { const int rr = w * 8 + q8 + u; const size_t t = (size_t)grp * 64 + rr;
                float sm = 0.f;
#pragma unroll
                for (int q = 0; q < 4; ++q) sm += v[u][q][0] + v[u][q][1] + v[u][q][2] + v[u][q][3];
                const float mean = wave_sum(sm) * (1.f / 1024.f); float sq = 0.f;
#pragma unroll
                for (int q = 0; q < 4; ++q) { v[u][q] = v[u][q] - mean; sq += v[u][q][0] * v[u][q][0] + v[u][q][1] * v[u][q][1] + v[u][q][2] * v[u][q][2] + v[u][q][3] * v[u][q][3]; }
                const float rstd = rsqrtf(wave_sum(sq) * (1.f / 1024.f) + LN_EPS);
#pragma unroll
                for (int q = 0; q < 4; ++q) { const int col = q * 256 + lane * 4; const f32x4 o = v[u][q] * rstd * *(const f32x4*)(g + col) + *(const f32x4*)(bta + col);
                    *(f32x4*)(x + t * D + col) = o; u32x2 wv; wv[0] = pk2(o[0], o[1]); wv[1] = pk2(o[2], o[3]); *(u32x2*)(xb + t * D + col) = wv; *(LAS u32x2*)(Xl + rr * 2064 + col * 2) = wv; } } }
        __syncthreads();
        const int st = w & 3, eh = w >> 2;
        f32x4 acc[4];
#pragma unroll
        for (int ne = 0; ne < 4; ++ne) acc[ne] = (f32x4){0.f, 0.f, 0.f, 0.f};
#pragma unroll 8
        for (int ks = 0; ks < 32; ++ks) { const bf16x8 bop = *(const LAS bf16x8*)(Xl + (16 * st + fr) * 2064 + ks * 64 + fq * 16);
#pragma unroll
            for (int ne = 0; ne < 4; ++ne) { const bf16x8 aop = *(const bf16x8*)(Wr + (size_t)(64 * eh + 16 * ne + fr) * D + ks * 32 + fq * 8); acc[ne] = MFMA16(aop, bop, acc[ne]); } }
        __syncthreads();
#pragma unroll
        for (int ne = 0; ne < 4; ++ne) { f32x4 sg; for (int r = 0; r < 4; ++r) sg[r] = sigmoidf_(acc[ne][r]); *(LAS f32x4*)(Sc + (16 * st + fr) * 128 + 64 * eh + 16 * ne + 4 * fq) = sg; }
        __syncthreads();
        LAS int* hist = (LAS int*)(c.lds + 40960); LAS int* gbase = hist + 128; LAS int* sel = gbase + 128; LAS float* selg = (LAS float*)(sel + 512);
        if (c.tid < 128) hist[c.tid] = 0;
        __syncthreads();
        for (int q8 = 0; q8 < 8; ++q8) { const int rr = w * 8 + q8;
            const float s0 = Sc[rr * 128 + lane], s1 = Sc[rr * 128 + 64 + lane];
            float v0 = s0 + rb[lane], v1 = s1 + rb[64 + lane];
            float mysc = 0.f; int myexp = -1; float tot = 0.f;
            for (int k = 0; k < 8; ++k) {
                float bv = v0; int bi = lane; if (v1 > bv) { bv = v1; bi = lane + 64; }
#pragma unroll
                for (int o = 32; o; o >>= 1) { const float ov = __shfl_xor(bv, o); const int oi = __shfl_xor(bi, o); if (ov > bv || (ov == bv && oi < bi)) { bv = ov; bi = oi; } }
                const float sc = __shfl((bi & 64) ? s1 : s0, bi & 63);
                tot += sc;
                if (lane == k) { mysc = sc; myexp = bi; }
                if (lane == (bi & 63)) { if (bi & 64) v1 = -1e30f; else v0 = -1e30f; }
            }
            if (lane < 8) { const int lr = __hip_atomic_fetch_add(&hist[myexp], 1, __ATOMIC_RELAXED, __HIP_MEMORY_SCOPE_WORKGROUP); sel[rr * 8 + lane] = (myexp << 16) | lr; selg[rr * 8 + lane] = mysc / tot * 2.5f; } }
        __syncthreads();
        if (c.tid < 128) gbase[c.tid] = atomicAdd(&cnt[c.tid * 1024], hist[c.tid]);
        __syncthreads();
        { const int sv = sel[c.tid], e = sv >> 16, lr = sv & 0xffff; const int slot = (grp * 64 + (c.tid >> 3)) * 8 + (c.tid & 7);
          list[(size_t)e * LISTCAP + gbase[e] + lr] = slot; gate[slot] = selg[c.tid]; }
    }
}

struct MoeOrder {
    const char* Abase; const char* Bbase; size_t Bstride; int K, NT, total, G, c, mode;
    LAS int* tab; LAS int* desc;
    __device__ __forceinline__ bool next(int i, g8::Unit& u) const {
        const long L = (long)i * G + c; if (L >= total || i >= TAB_SLOTS) return false;
        const int d = desc[i]; const int e = d >> 12, pn = d & 15;
        u.pm = (d >> 4) & 255; u.pn = pn; u.aux = i; u.A = Abase; u.B = Bbase + (size_t)e * Bstride + (size_t)pn * 256 * K * 2; return true;
    }
    __device__ __forceinline__ void aoff(const g8::Unit& u, int tid, unsigned (&o)[2][2]) const {
#pragma unroll
        for (int i = 0; i < 2; ++i) { int R, C; g8::stage_rc(tid * 16 + i * 8192, R, C);
#pragma unroll
            for (int h = 0; h < 2; ++h) { int s = tab[u.aux * 256 + h * 128 + R]; s = s < 0 ? 0 : s; const int row = mode ? s : (s < TK ? (s >> 3) : s - TK);
                o[h][i] = (unsigned)(row * K + C) * 2u; } }
    }
};
__device__ __forceinline__ void moe_setup(const Ctx& c, MoeOrder& S, const int* cnt, int NT) {
    LAS int* pref = (LAS int*)(c.lds + LDS_PREF); LAS int* desc = (LAS int*)(c.lds + LDS_DESC); LAS int* tab = (LAS int*)(c.lds + LDS_TAB);
    const int* list = (const int*)(c.ws + WS_LIST);
    if (c.tid < 64) { int nb[3]; int loc = 0;
#pragma unroll
        for (int q = 0; q < 3; ++q) { const int e = c.tid * 3 + q; int n = 0; if (e < NE) n = cnt[e * 1024]; else if (e == NE) n = T; nb[q] = (n + 255) >> 8; loc += nb[q]; }
        int inc = loc;
#pragma unroll
        for (int o = 1; o < 64; o <<= 1) { const int v = __shfl_up(inc, o); if (c.tid >= o) inc += v; }
        int acc = inc - loc;
#pragma unroll
        for (int q = 0; q < 3; ++q) { const int e = c.tid * 3 + q; if (e <= NE1) pref[e] = acc; acc += nb[q]; } }
    __syncthreads();
    const int total = pref[NE1] * NT;
    S.NT = NT; S.total = total; S.G = c.G; S.c = c.bid; S.tab = tab; S.desc = desc;
    {
        int sv[TAB_SLOTS / 2];
#pragma unroll
        for (int k = 0; k < TAB_SLOTS / 2; ++k) { const int i = (c.tid >> 8) + 2 * k; sv[k] = -2;
            const long L = (long)i * c.G + c.bid;
            if (L < total) {
                int wgid = (int)L; { const int q = total / 8, r = total % 8, xcd = wgid % 8, off = wgid / 8; wgid = (xcd < r ? xcd * (q + 1) : r * (q + 1) + (xcd - r) * q) + off; }
                const int rbg = wgid / NT, pn = wgid % NT;
                int lo = 0, hi = NE1;
                while (hi - lo > 1) { const int mid = (lo + hi) >> 1; if (pref[mid] <= rbg) lo = mid; else hi = mid; }
                const int e = lo, rb = rbg - pref[e], n = e < NE ? cnt[e * 1024] : T;
                if ((c.tid & 255) == 0) desc[i] = (e << 12) | (rb << 4) | pn;
                const int r = rb * 256 + (c.tid & 255); sv[k] = -1; if (r < n) sv[k] = (e < NE) ? list[(size_t)e * LISTCAP + r] : TK + r; } }
#pragma unroll
        for (int k = 0; k < TAB_SLOTS / 2; ++k) { const int i = (c.tid >> 8) + 2 * k; if (sv[k] != -2) tab[i * 256 + (c.tid & 255)] = sv[k]; }
    }
    __syncthreads();
}
struct EpiMoeGU {
    static constexpr bool PERM = true;
    bf16_t* H; LAS int* tab;
    __device__ __forceinline__ void operator()(const f32x4 (&acc)[2][2][4][2], const g8::Unit& u, int wr, int wc, int fr, int fq) const {
#pragma unroll
        for (int ai = 0; ai < 2; ++ai)
#pragma unroll
            for (int m = 0; m < 4; ++m) { const int r = ai * 128 + wr * 64 + m * 16 + fr; const int s = tab[u.aux * 256 + r];
                if (s >= 0) { u32x4 w;
#pragma unroll
                    for (int n = 0; n < 2; ++n) { const f32x4 g = acc[ai][0][m][n], up = acc[ai][1][m][n];
                        w[2 * n] = pk2(siluf_(g[0]) * up[0], siluf_(g[1]) * up[1]); w[2 * n + 1] = pk2(siluf_(g[2]) * up[2], siluf_(g[3]) * up[3]); }
                    *(u32x4*)(H + (size_t)s * ED + u.pn * 128 + wc * 32 + fq * 8) = w; } }
    }
};
struct EpiMoeDN {
    static constexpr bool PERM = true;
    bf16_t* Y; const float* gate; LAS int* tab;
    __device__ __forceinline__ void operator()(const f32x4 (&acc)[2][2][4][2], const g8::Unit& u, int wr, int wc, int fr, int fq) const {
#pragma unroll
        for (int ai = 0; ai < 2; ++ai)
#pragma unroll
            for (int m = 0; m < 4; ++m) { const int r = ai * 128 + wr * 64 + m * 16 + fr; const int s = tab[u.aux * 256 + r];
                if (s >= 0) { const float gt = gate[s];
#pragma unroll
                    for (int bj = 0; bj < 2; ++bj) { u32x4 w;
#pragma unroll
                        for (int n = 0; n < 2; ++n) { const f32x4 a = acc[ai][bj][m][n] * gt; w[2 * n] = pk2(a[0], a[1]); w[2 * n + 1] = pk2(a[2], a[3]); }
                        *(u32x4*)(Y + (size_t)s * D + u.pn * 256 + bj * 128 + wc * 32 + fq * 8) = w; } } }
    }
};
__device__ __forceinline__ void phase_moe_gu(const Ctx& c, int L) {
    MoeOrder S; S.Abase = (const char*)(c.ws + WS_XB); S.Bbase = (const char*)(c.ws + WS_WGU) + (size_t)L * NE1 * 512 * D * 2; S.Bstride = (size_t)512 * D * 2; S.K = D; S.mode = 0;
    moe_setup(c, S, (const int*)(c.ws + CTL_CNT) + L * NE * 1024, 2);
    EpiMoeGU E{(bf16_t*)(c.ws + WS_HID), S.tab};
    g8::gemm_phase<EpiMoeGU, MoeOrder>(c.lds + LDS_STAGE, D, S, E);
}
__device__ __forceinline__ void phase_moe_dn(const Ctx& c, int L) {
    MoeOrder S; S.Abase = (const char*)(c.ws + WS_HID); S.Bbase = (const char*)(c.ws + WS_WDN) + (size_t)L * NE1 * D * ED * 2; S.Bstride = (size_t)D * ED * 2; S.K = ED; S.mode = 1;
    moe_setup(c, S, (const int*)(c.ws + CTL_CNT) + L * NE * 1024, 4);
    EpiMoeDN E{(bf16_t*)(c.ws + WS_U1), (const float*)(c.ws + WS_GATE), S.tab};
    g8::gemm_phase<EpiMoeDN, MoeOrder>(c.lds + LDS_STAGE, ED, S, E);
}

constexpr int PH_PER_LAYER = 9;
constexpr int N_PHASES = 1 + 4 * PH_PER_LAYER;

__global__ void __launch_bounds__(NTHREADS, 2) fwd_kernel(Params p) {
    extern __shared__ __attribute__((aligned(16))) unsigned char lds_raw[];
    LAS unsigned char* const lds0 = (LAS unsigned char*)lds_raw;
    volatile LAS unsigned* misc = (volatile LAS unsigned*)(lds0 + LDS_MISC);
    if (threadIdx.x < 4) misc[threadIdx.x] = 0u;
    __syncthreads();
    const int lo = p.ph_lo, hi = p.ph_hi;
    XcdBarrier bar; bar.bar = (unsigned*)(p.ws + WS_CTL); bar.x = 0; bar.st = misc;
    if (hi - lo > 1) bar = xcd_barrier_post((unsigned*)(p.ws + WS_CTL), misc);
#define MKCTX() Ctx c; { int tid_ = threadIdx.x; asm volatile("" : "+v"(tid_)); int bid_ = blockIdx.x; asm volatile("" : "+s"(bid_)); unsigned long long ws_ = (unsigned long long)p.ws; asm volatile("" : "+s"(ws_)); \
        c.in = p.in; c.out = p.out; c.ws = (unsigned char*)ws_; c.lds = lds0; c.tid = tid_; c.lane = tid_ & 63; c.wid = __builtin_amdgcn_readfirstlane(tid_ >> 6); c.bid = bid_; c.G = gridDim.x; \
        c.gtid = c.bid * NTHREADS + c.tid; c.gthreads = c.G * NTHREADS; c.gw = c.bid * 8 + c.wid; c.nwaves = c.G * 8; } unsigned char* const ws = c.ws; (void)ws
    int id = 0;
#ifndef PMASK
#define PMASK 0xffffffffu
#endif
#ifndef DUPMASK
#define DUPMASK 0u
#endif
#define PHASE(k, body) do { if (((PMASK >> (k)) & 1u) && lo <= id && id < hi) { MKCTX(); body; if ((DUPMASK >> (k)) & 1u) { body; } if (id + 1 < hi) xcd_barrier(bar); } ++id; } while (0)
    PHASE(0, phase_convert(c));
#pragma unroll 1
    for (int L = 0; L < 4; ++L) {
        const int j = L >> 1; const bool cd = (L & 1);
        if (cd) {
            PHASE(1, phase_cd_inproj(c, j));
        } else {
            PHASE(2, phase_ab_inproj(c, j));
        }
        if (!cd) { PHASE(3, phase_ab_p1(c)); PHASE(4, phase_ab_p2(c, j)); PHASE(16, phase_ab_p3(c)); }
        else     { PHASE(5, phase_cd_p1(c, j)); PHASE(15, phase_cd_scan2(c)); id += 1; }
        {
            const size_t Woff = cd ? WS_WCDOUT + (size_t)j * D * CD_OUT * 2 : WS_WABOUT + (size_t)j * D * AB_OUT * 2;
            const int K = cd ? CD_OUT : AB_OUT; const float* bias = cd ? p.in[18] + (size_t)j * D : p.in[5] + (size_t)j * D;
            PHASE(8, phase_dense(c, (const bf16_t*)(ws + WS_YCAT), (const bf16_t*)(ws + Woff), T, D, K, (float*)(ws + WS_H), D, bias));
        }
        PHASE(9, phase_ln_route(c, L));
        PHASE(12, phase_moe_gu(c, L));
        PHASE(13, phase_moe_dn(c, L));
        PHASE(14, phase_ln<true>(c, p.in[29] + (size_t)L * D, p.in[30] + (size_t)L * D, L == 3 ? p.out : (float*)(ws + WS_X)));
    }
#undef PHASE
}

extern "C" void kernel_launch(void* const* d_in, const int* in_sizes, int n_in, void* d_out, int out_size, void* d_ws, size_t ws_size, hipStream_t stream) {
    static int grid = 0;
    if (grid == 0) {
        if (n_in != 31 || out_size != T * D || ws_size < WS_END) { fprintf(stderr, "kernel_launch: unexpected shapes (n_in %d out %d ws %zu need %zu)\n", n_in, out_size, ws_size, (size_t)WS_END); grid = -1; return; }
        int dev = 0, cus = 0, per_cu = 0;
        if (hipGetDevice(&dev) != hipSuccess || hipDeviceGetAttribute(&cus, hipDeviceAttributeMultiprocessorCount, dev) != hipSuccess) { grid = -1; return; }
        if (hipFuncSetAttribute((const void*)fwd_kernel, hipFuncAttributeMaxDynamicSharedMemorySize, LDS_BYTES) != hipSuccess) { fprintf(stderr, "kernel_launch: hipFuncSetAttribute failed\n"); grid = -1; return; }
        if (hipOccupancyMaxActiveBlocksPerMultiprocessor(&per_cu, (const void*)fwd_kernel, NTHREADS, LDS_BYTES) != hipSuccess || per_cu < 1) fprintf(stderr, "kernel_launch: occupancy query says %d\n", per_cu);
        (void)hipGetLastError();
        grid = cus;
    }
    if (grid < 0) return;
    (void)hipMemsetAsync((char*)d_ws + WS_CTL, 0, CTL_BYTES, stream);
    Params p{};
    for (int i = 0; i < 31; ++i) p.in[i] = (const float*)d_in[i];
    p.out = (float*)d_out; p.ws = (unsigned char*)d_ws;
#if N_LAUNCH_MODE == 1
    p.ph_lo = 0; p.ph_hi = N_PHASES;
    hipLaunchKernelGGL(fwd_kernel, dim3(grid), dim3(NTHREADS), LDS_BYTES, stream, p);
#else
    for (int i = 0; i < N_PHASES; ++i) { p.ph_lo = i; p.ph_hi = i + 1; hipLaunchKernelGGL(fwd_kernel, dim3(grid), dim3(NTHREADS), LDS_BYTES, stream, p); }
#endif
}
```

```cpp
#include <hip/hip_runtime.h>
#include <cstdio>
#include <cstdint>

#define LAS __attribute__((address_space(3)))
typedef unsigned short bf16_t;
typedef short bf16x8 __attribute__((ext_vector_type(8)));
typedef float f32x4 __attribute__((ext_vector_type(4)));
typedef float f32x2 __attribute__((ext_vector_type(2)));
typedef unsigned u32x4 __attribute__((ext_vector_type(4)));
typedef unsigned u32x2 __attribute__((ext_vector_type(2)));

constexpr int T = 16384, D = 1024, SEQ = 8192;
constexpr int AB_IN = 4352, AB_OUT = 2048, CD_IN = 4608, CD_OUT = 2304;
constexpr int NE = 128, NE1 = 129, TOPK = 8, ED = 256;
constexpr int TK = T * TOPK;
constexpr int NSLOT = TK + T;
constexpr int LISTCAP = 16384;
constexpr float ALPHA = 1.681792830507429f;
constexpr float LN_EPS = 1e-5f;

#ifndef N_LAUNCH_MODE
#define N_LAUNCH_MODE 1
#endif

constexpr size_t al256(size_t x) { return (x + 255) & ~(size_t)255; }
constexpr size_t WS_CTL    = 0;
constexpr size_t CTL_BYTES = 65536 + (size_t)4 * 128 * 4096;
constexpr size_t CTL_CNT   = 65536;
constexpr size_t WS_WABIN  = CTL_BYTES;
constexpr size_t WS_WABOUT = WS_WABIN  + al256((size_t)2 * AB_IN * D * 2);
constexpr size_t WS_WCDIN  = WS_WABOUT + al256((size_t)2 * D * AB_OUT * 2);
constexpr size_t WS_WCDOUT = WS_WCDIN  + al256((size_t)2 * CD_IN * D * 2);
constexpr size_t WS_WRT    = WS_WCDOUT + al256((size_t)2 * D * CD_OUT * 2);
constexpr size_t WS_WGU    = WS_WRT    + al256((size_t)4 * 256 * D * 2);
constexpr size_t WS_WDN    = WS_WGU    + al256((size_t)4 * NE1 * 512 * D * 2);
constexpr size_t WS_X      = WS_WDN    + al256((size_t)4 * NE1 * D * ED * 2);
constexpr size_t WS_XB     = WS_X      + al256((size_t)T * D * 4);
constexpr size_t WS_U1     = WS_XB     + al256((size_t)T * D * 2);
constexpr size_t U1_BYTES  = al256((size_t)NSLOT * D * 2) > al256((size_t)T * CD_IN * 4) ? al256((size_t)NSLOT * D * 2) : al256((size_t)T * CD_IN * 4);
constexpr size_t WS_U2     = WS_U1     + U1_BYTES;
constexpr size_t U2_BYTES  = al256((size_t)T * 1280 * 4 * 3);
constexpr size_t WS_YCAT   = WS_U2     + U2_BYTES;
constexpr size_t WS_H      = WS_YCAT   + al256((size_t)T * CD_OUT * 2);
constexpr size_t WS_ZR     = WS_H      + al256((size_t)T * D * 4);
constexpr size_t WS_HID    = WS_ZR     + al256((size_t)T * 256 * 4);
constexpr size_t WS_LIST   = WS_HID    + al256((size_t)NSLOT * ED * 2);
constexpr size_t WS_GATE   = WS_LIST   + al256((size_t)NE * LISTCAP * 4);
constexpr size_t WS_ROPEA  = WS_GATE   + al256((size_t)NSLOT * 4);
constexpr size_t WS_ROPER  = WS_ROPEA  + al256((size_t)SEQ * 32 * 8);
constexpr size_t WS_BIASP  = WS_ROPER  + al256((size_t)SEQ * 64 * 8);
constexpr size_t WS_WLRU   = WS_BIASP  + al256((size_t)2 * AB_IN * 4);
constexpr size_t WS_SPL    = WS_WLRU   + al256((size_t)2 * 5 * 2 * 65536 * 2);
constexpr size_t WS_END    = WS_SPL    + al256((size_t)2 * 1280 * 4);
constexpr size_t CD_GU = WS_U1, CD_GVT = WS_U1 + 32 * (1024 * 1024), CD_GG = WS_U1 + 64 * (1024 * 1024), CD_XR = WS_U1 + 104 * (1024 * 1024), CD_STATS = WS_U1 + 144 * (1024 * 1024);
constexpr size_t MB = 1024 * 1024;
constexpr size_t AB_QB = WS_U1, AB_KB = WS_U1 + 32 * MB, AB_VT = WS_U1 + 36 * MB, AB_RQB = WS_U1 + 40 * MB, AB_RKB = WS_U1 + 56 * MB, AB_RKDT = WS_U1 + 72 * MB,
                 AB_RVT = WS_U1 + 88 * MB, AB_RGB = WS_U1 + 120 * MB, AB_KV = WS_U1 + 152 * MB  , AB_SPREV = WS_U1 + 216 * MB  ;
static_assert(AB_SPREV + 32 * MB <= WS_U1 + U1_BYTES, "U1 map");

__device__ __forceinline__ float bf2f(bf16_t b) { return __uint_as_float(((unsigned)b) << 16); }
__device__ __forceinline__ bf16_t f2bf(float f) { unsigned u = __float_as_uint(f); u += 0x7FFFu + ((u >> 16) & 1u); return (bf16_t)(u >> 16); }
__device__ __forceinline__ unsigned pk2(float lo, float hi) { return (unsigned)f2bf(lo) | ((unsigned)f2bf(hi) << 16); }
__device__ __forceinline__ float wave_sum(float v) {
#pragma unroll
    for (int o = 32; o; o >>= 1) v += __shfl_xor(v, o);
    return v; }
__device__ __forceinline__ float wave_max(float v) {
#pragma unroll
    for (int o = 32; o; o >>= 1) v = fmaxf(v, __shfl_xor(v, o));
    return v; }
__device__ __forceinline__ float gelu_tanh(float x) { const float u = 0.7978845608028654f * (x + 0.044715f * x * x * x); return 0.5f * x * (1.f + tanhf(u)); }
__device__ __forceinline__ float sigmoidf_(float x) { return 1.f / (1.f + __expf(-x)); }
__device__ __forceinline__ float siluf_(float x) { return x * __builtin_amdgcn_rcpf(1.f + __expf(-x)); }

#define XB_TMO      128
#define XB_XCNT(j)  (256  + 64 * (j))
#define XB_XSUB(j)  (1280 + 64 * (j))
#define XB_XGEN(j)  (2304 + 64 * (j))
#define XB_TOP      3328
#define XB_TOPGEN   3392
#define XCD_BAR_WORDS 3456
#define XB_SPIN_CAP (1u << 22)

__device__ __forceinline__ unsigned xb_ld(unsigned* p)              { return __hip_atomic_load(p, __ATOMIC_RELAXED, __HIP_MEMORY_SCOPE_AGENT); }
__device__ __forceinline__ unsigned xb_add(unsigned* p, unsigned v) { return __hip_atomic_fetch_add(p, v, __ATOMIC_RELAXED, __HIP_MEMORY_SCOPE_AGENT); }
__device__ __forceinline__ unsigned xb_xcc_id() { return (unsigned)__builtin_amdgcn_s_getreg((3 << 11) | 20) & 0xFu; }
#define XB_SPIN(cond, bar) do { unsigned _sp = 0; while (cond) { __builtin_amdgcn_s_sleep(1); \
    if ((++_sp & 255u) == 0u) { if (xb_ld(&(bar)[XB_TMO])) break; if (_sp > XB_SPIN_CAP) { atomicAdd(&(bar)[XB_TMO], 1u); break; } } } } while (0)

struct XcdBarrier { unsigned* bar; unsigned x; volatile LAS unsigned* st; };

__device__ __forceinline__ XcdBarrier xcd_barrier_post(unsigned* bar, volatile LAS unsigned* st) {
    XcdBarrier b; b.bar = bar; b.x = xb_xcc_id(); b.st = st;
    if (threadIdx.x == 0) (void)xb_add(&bar[XB_XCNT(b.x)], 1u);
    return b;
}
__device__ __forceinline__ void xcd_barrier_complete(unsigned* bar, unsigned x, unsigned& nloc, unsigned& nx) {
    const unsigned G = gridDim.x * gridDim.y * gridDim.z;
    unsigned sum, cnt, mine, sp = 0u;
    for (;;) {
        sum = 0u; cnt = 0u; mine = 0u;
#pragma unroll
        for (unsigned j = 0; j < 16; ++j) { const unsigned c = xb_ld(&bar[XB_XCNT(j)]); sum += c; cnt += (c > 0u) ? 1u : 0u; mine = (j == x) ? c : mine; }
        if (sum == G) break;
        __builtin_amdgcn_s_sleep(1);
        if ((++sp & 255u) == 0u) { if (xb_ld(&bar[XB_TMO])) break; if (sp > XB_SPIN_CAP) { atomicAdd(&bar[XB_TMO], 1u); break; } }
    }
    nloc = mine > 0u ? mine : 1u; nx = cnt > 0u ? cnt : 1u;
}
__device__ __forceinline__ void xcd_barrier(const XcdBarrier& b) {
    asm volatile("s_waitcnt vmcnt(0)" ::: "memory");
    __syncthreads();
    if (threadIdx.x == 0) {
        unsigned* bar = b.bar;
        __builtin_amdgcn_s_waitcnt(0);
        unsigned nloc = b.st[0], nx = b.st[1];
        if (nloc == 0u) { xcd_barrier_complete(bar, b.x, nloc, nx); b.st[0] = nloc; b.st[1] = nx; }
        const unsigned old = xb_add(&bar[XB_XSUB(b.x)], 1u);
        const unsigned gen = old / nloc;
        if (old + 1u == (gen + 1u) * nloc) {
            __builtin_amdgcn_fence(__ATOMIC_RELEASE, "agent");
            asm volatile("s_waitcnt vmcnt(0)" ::: "memory");
            const unsigned og = xb_add(&bar[XB_TOP], 1u);
            const unsigned tg = og / nx;
            if (og + 1u == (tg + 1u) * nx) xb_add(&bar[XB_TOPGEN], 1u);
            else XB_SPIN(xb_ld(&bar[XB_TOPGEN]) == tg, bar);
            __builtin_amdgcn_fence(__ATOMIC_ACQUIRE, "agent");
            xb_add(&bar[XB_XGEN(b.x)], 1u);
            asm volatile("s_waitcnt vmcnt(0)" ::: "memory");
        } else {
            XB_SPIN(xb_ld(&bar[XB_XGEN(b.x)]) == gen, bar);
            __builtin_amdgcn_fence(__ATOMIC_ACQUIRE, "agent");
            asm volatile("s_waitcnt vmcnt(0)" ::: "memory");
        }
    }
    __syncthreads();
}

namespace g8 {
constexpr int BM = 256, BK = 64, HALF = 128, HTB = HALF * BK * 2, STAGE_BYTES = 8 * HTB, NXCD = 8, WGM = 8;
__device__ __forceinline__ int lds_byte(int r, int c) { const int st = (r >> 4) * 2 + (c >> 5), rr = r & 15, cc = c & 31, ob = rr * 64 + cc * 2; return st * 1024 + (ob ^ (((ob >> 9) & 1) << 5)); }
__device__ __forceinline__ void stage_rc(int b, int& R, int& C) { const int st = b / 1024, sb = b % 1024, swz = sb ^ (((sb >> 9) & 1) << 5); R = (st >> 1) * 16 + swz / 64; C = (st & 1) * 32 + (swz % 64) / 2; }
__device__ __forceinline__ int perm32(int rho) { const int n = rho >> 4, i = rho & 15; return 8 * (i >> 2) + 4 * n + (i & 3); }

struct Unit { const char* A; const char* B; int pm, pn, aux; };

struct DenseOrder {
    const char* A; const char* Bt; int nM, nN, nwg, G, c, K;
    __device__ void init(const void* A_, const void* Bt_, int M, int N, int K_, int G_, int c_) { A = (const char*)A_; Bt = (const char*)Bt_; nM = M / BM; nN = N / BM; nwg = nM * nN; G = G_; c = c_; K = K_; }
    __device__ __forceinline__ bool next(int i, Unit& u) const {
        const long L = (long)i * G + c; if (L >= nwg) return false;
        int wgid = (int)L; { const int q = nwg / NXCD, r = nwg % NXCD, xcd = wgid % NXCD, off = wgid / NXCD; wgid = (xcd < r ? xcd * (q + 1) : r * (q + 1) + (xcd - r) * q) + off; }
        const int nig = WGM * nN, gid = wgid / nig, fm = gid * WGM, gsz = (nM - fm) < WGM ? (nM - fm) : WGM;
        u.pm = fm + ((wgid % nig) % gsz); u.pn = (wgid % nig) / gsz; u.aux = 0;
        u.A = A + (size_t)u.pm * BM * K * 2; u.B = Bt + (size_t)u.pn * BM * K * 2; return true;
    }
    __device__ __forceinline__ void aoff(const Unit&, int tid, unsigned (&o)[2][2]) const {
#pragma unroll
        for (int i = 0; i < 2; ++i) { int R, C; stage_rc(tid * 16 + i * 8192, R, C);
            o[0][i] = (unsigned)(R * K + C) * 2u; o[1][i] = (unsigned)((R + HALF) * K + C) * 2u; }
    }
};

__device__ __forceinline__ unsigned cvt_pk_bf16(float lo, float hi) { unsigned r; asm volatile("v_cvt_pk_bf16_f32 %0, %1, %2" : "=v"(r) : "v"(lo), "v"(hi)); return r; }

struct EpiF32 {
    static constexpr bool PERM = false;
    float* C; int ldc; const float* bias;
    __device__ __forceinline__ void operator()(const f32x4 (&acc)[2][2][4][2], const Unit& u, int wr, int wc, int fr, int fq) const {
        const int row0 = u.pm * BM + wr * 64 + fr, col0 = u.pn * BM + wc * 32 + 4 * fq;
        f32x4 bv[2][2];
#pragma unroll
        for (int bj = 0; bj < 2; ++bj)
#pragma unroll
            for (int n = 0; n < 2; ++n) bv[bj][n] = bias ? *(const f32x4*)(bias + col0 + bj * HALF + n * 16) : (f32x4){0.f, 0.f, 0.f, 0.f};
#pragma unroll
        for (int ai = 0; ai < 2; ++ai)
#pragma unroll
            for (int m = 0; m < 4; ++m) { float* rowp = C + (size_t)(row0 + ai * HALF + m * 16) * ldc + col0;
#pragma unroll
                for (int bj = 0; bj < 2; ++bj)
#pragma unroll
                    for (int n = 0; n < 2; ++n) *(f32x4*)(rowp + bj * HALF + n * 16) = acc[ai][bj][m][n] + bv[bj][n]; }
    }
};

template <class Epi, class Sched>
__device__ __forceinline__ void gemm_phase(LAS unsigned char* lds, const int K, const Sched& S, const Epi& E) {
    int tid_ = threadIdx.x; asm volatile("" : "+v"(tid_));
    const int tid = tid_, wid = __builtin_amdgcn_readfirstlane(tid >> 6), lane = tid & 63, wr = wid >> 2, wc = wid & 3, fr = lane & 15, fq = lane >> 4;
    const int nt = K / BK;
    unsigned voffB[2];
#pragma unroll
    for (int i = 0; i < 2; ++i) { int R, C; stage_rc(tid * 16 + i * 8192, R, C); const int Rb = Epi::PERM ? ((R & ~31) + perm32(R & 31)) : R;
        voffB[i] = (unsigned)(Rb * K + C) * 2u; }
    const size_t kstep = (size_t)(BK * 2);
    const size_t hstep = (size_t)HALF * K * 2;
    const unsigned ldsw = (unsigned)wid * 1024u;
    const int aoff = lds_byte(wr * 64 + fr, fq * 8), boff = lds_byte(wc * 32 + fr, fq * 8);
#define G8_SA(b, h) (((b) * 2 + (h)) * HTB)
#define G8_SB(b, h) ((4 + (b) * 2 + (h)) * HTB)
#define G8_STAGE(bufoff, gbase, voff) do { _Pragma("unroll") for (int _i = 0; _i < 2; ++_i) \
        __builtin_amdgcn_global_load_lds((const unsigned*)((const char*)(gbase) + (voff)[_i]), (LAS unsigned*)(lds + (bufoff) + ldsw + _i * 8192), 16, 0, 0); } while (0)
#define G8_LDA(dst, b, h) do { _Pragma("unroll") for (int m = 0; m < 4; ++m) _Pragma("unroll") for (int k = 0; k < 2; ++k) dst[m][k] = *(const LAS bf16x8*)(lds + G8_SA(b, h) + aoff + m * 2048 + k * 1024); } while (0)
#define G8_LDB(dst, b, h) do { _Pragma("unroll") for (int n = 0; n < 2; ++n) _Pragma("unroll") for (int k = 0; k < 2; ++k) dst[n][k] = *(const LAS bf16x8*)(lds + G8_SB(b, h) + boff + n * 2048 + k * 1024); } while (0)
#define G8_MMA(ai, bj, At, Bt) do { __builtin_amdgcn_s_setprio(1); _Pragma("unroll") for (int m = 0; m < 4; ++m) _Pragma("unroll") for (int n = 0; n < 2; ++n) _Pragma("unroll") for (int k = 0; k < 2; ++k) \
        acc[ai][bj][m][n] = __builtin_amdgcn_mfma_f32_16x16x32_bf16(Bt[n][k], At[m][k], acc[ai][bj][m][n], 0, 0, 0); __builtin_amdgcn_s_setprio(0); } while (0)
#define G8_WAIT_V(n) asm volatile("s_waitcnt vmcnt(" #n ")" ::: "memory")
#define G8_WAIT_L(n) asm volatile("s_waitcnt lgkmcnt(" #n ")" ::: "memory")
#define G8_BAR __builtin_amdgcn_s_barrier()
#define G8_SCHED __builtin_amdgcn_sched_barrier(0)
    Unit cur, nxt; int ui = 0;
    if (!S.next(0, cur)) return;
    f32x4 acc[2][2][4][2];
#pragma unroll
    for (int a = 0; a < 2; ++a)
#pragma unroll
        for (int b = 0; b < 2; ++b)
#pragma unroll
            for (int m = 0; m < 4; ++m)
#pragma unroll
                for (int n = 0; n < 2; ++n) acc[a][b][m][n] = (f32x4){0.f, 0.f, 0.f, 0.f};
    bf16x8 At[4][2], B0[2][2], B1[2][2];
    unsigned oc[2][2];
    S.aoff(cur, tid, oc);
    const char* cA = cur.A; const char* cB = cur.B;
    G8_STAGE(G8_SB(0, 0), cB, voffB); G8_STAGE(G8_SA(0, 0), cA, oc[0]); G8_STAGE(G8_SB(0, 1), cB + hstep, voffB); G8_STAGE(G8_SA(0, 1), cA, oc[1]);
    if (wr == 1) G8_BAR;
    G8_WAIT_V(4); G8_BAR;
    G8_STAGE(G8_SB(1, 0), cB + kstep, voffB); G8_STAGE(G8_SA(1, 0), cA + kstep, oc[0]); G8_STAGE(G8_SB(1, 1), cB + hstep + kstep, voffB);
    G8_WAIT_V(6); G8_BAR;
    for (;;) {
        const bool has_next = S.next(ui + 1, nxt);
        const char* nA = has_next ? nxt.A : cA; const char* nB = has_next ? nxt.B : cB;
#pragma unroll 1
        for (int t = 0; t < nt; t += 2) {
            const bool last = (t == nt - 2);
            const char* a1 = cA + (size_t)(t + 1) * kstep;
            const char* a2 = last ? nA : cA + (size_t)(t + 2) * kstep; const char* b2 = last ? nB : cB + (size_t)(t + 2) * kstep;
            const char* a3 = a2 + kstep; const char* b3 = b2 + kstep;
            G8_LDB(B0, 0, 0); G8_SCHED; G8_LDA(At, 0, 0); G8_STAGE(G8_SA(1, 1), a1, oc[1]);
            if (last && has_next) S.aoff(nxt, tid, oc);
            G8_WAIT_L(8); G8_BAR; G8_WAIT_L(0); G8_MMA(0, 0, At, B0); G8_BAR; G8_SCHED;
            G8_LDB(B1, 0, 1); G8_STAGE(G8_SB(0, 0), b2, voffB);
            G8_BAR; G8_WAIT_L(0); G8_MMA(0, 1, At, B1); G8_BAR;
            G8_LDA(At, 0, 1); G8_STAGE(G8_SA(0, 0), a2, oc[0]);
            G8_BAR; G8_WAIT_L(0); G8_MMA(1, 0, At, B0); G8_BAR; G8_SCHED;
            G8_STAGE(G8_SB(0, 1), b2 + hstep, voffB);
            G8_WAIT_V(6); G8_BAR; G8_MMA(1, 1, At, B1); G8_BAR;
            G8_LDB(B0, 1, 0); G8_SCHED; G8_LDA(At, 1, 0); G8_STAGE(G8_SA(0, 1), a2, oc[1]);
            G8_WAIT_L(8); G8_BAR; G8_WAIT_L(0); G8_MMA(0, 0, At, B0); G8_BAR; G8_SCHED;
            G8_LDB(B1, 1, 1); G8_STAGE(G8_SB(1, 0), b3, voffB);
            G8_BAR; G8_WAIT_L(0); G8_MMA(0, 1, At, B1); G8_BAR;
            G8_LDA(At, 1, 1); G8_STAGE(G8_SA(1, 0), a3, oc[0]);
            G8_BAR; G8_WAIT_L(0); G8_MMA(1, 0, At, B0); G8_BAR; G8_SCHED;
            G8_STAGE(G8_SB(1, 1), b3 + hstep, voffB);
            G8_WAIT_V(6); G8_BAR; G8_MMA(1, 1, At, B1); G8_BAR;
        }
        E(acc, cur, wr, wc, fr, fq);
        if (!has_next) break;
#pragma unroll
        for (int a = 0; a < 2; ++a)
#pragma unroll
            for (int b = 0; b < 2; ++b)
#pragma unroll
                for (int m = 0; m < 4; ++m)
#pragma unroll
                    for (int n = 0; n < 2; ++n) acc[a][b][m][n] = (f32x4){0.f, 0.f, 0.f, 0.f};
        cur = nxt; cA = nA; cB = nB; ++ui;
    }
    G8_WAIT_V(0);
    if (wr == 0) G8_BAR;
    G8_BAR;
#undef G8_SA
#undef G8_SB
#undef G8_STAGE
#undef G8_LDA
#undef G8_LDB
#undef G8_MMA
#undef G8_WAIT_V
#undef G8_WAIT_L
#undef G8_BAR
#undef G8_SCHED
}
}

constexpr int NTHREADS = 512;
constexpr int LDS_STAGE = 0;
constexpr int LDS_TAB   = g8::STAGE_BYTES;
constexpr int TAB_SLOTS = 6;
constexpr int LDS_GTAB  = LDS_TAB + TAB_SLOTS * 256 * 4;
constexpr int LDS_DESC  = LDS_GTAB + TAB_SLOTS * 256 * 4;
constexpr int LDS_PREF  = LDS_DESC + 64;
constexpr int LDS_MISC  = LDS_PREF + 132 * 4 + 48;
constexpr int LDS_BYTES = 147456;
static_assert(LDS_MISC % 16 == 0 && LDS_MISC + 64 <= LDS_BYTES, "LDS map");

struct Params { const float* in[31]; float* out; unsigned char* ws; int ph_lo, ph_hi; };

struct Ctx {
    const float* const* in; float* out; unsigned char* ws; LAS unsigned char* lds;
    int tid, lane, wid, bid, G, gtid, gthreads, gw, nwaves;
};

__device__ __forceinline__ int ab_phys(int n) {
    if (n < 1024) { const int hd = n >> 6, jj = n & 63; return (hd >> 2) * 256 + (jj >> 5) * 128 + (hd & 3) * 32 + (jj & 31); }
    if (n < 1152) { const int nn = n - 1024, hh = nn >> 6, jj = nn & 63; return 1024 + (jj >> 5) * 128 + hh * 32 + (jj & 31); }
    if (n < 1280) { const int vv = n - 1152; return 1024 + (vv >> 6) * 128 + 64 + (vv & 63); }
    if (n < 2304) { const int base = n < 1792 ? 1280 : 1792, nn = n - base, h = nn >> 7, jj = nn & 127; return base + (h >> 1) * 256 + (jj >> 6) * 128 + (h & 1) * 64 + (jj & 63); }
    return n;
}
template <int TN, class DstFn>
__device__ __forceinline__ void convert_T(const Ctx& c, const float* src, int nmat, int K, int N, DstFn dstfn) {
    LAS float* tile = (LAS float*)(c.lds);
    constexpr int LDT = TN + 1, TPR = TN / 4  , KPI = NTHREADS / TPR  , NI = 64 / KPI, KPT = 64 * TN / NTHREADS  ;
    const int tk = K / 64, tn = N / TN; const long ntiles = (long)nmat * tk * tn;
    for (long tix = c.bid; tix < ntiles; tix += c.G) {
        const int m = (int)(tix / (tk * tn)); const int rem = (int)(tix % (tk * tn)); const int kt = rem / tn, nt = rem % tn;
        const float* s = src + (size_t)m * K * N + (size_t)(kt * 64) * N + nt * TN;
        f32x4 v[NI];
#pragma unroll
        for (int i = 0; i < NI; ++i) { const int k = c.tid / TPR + KPI * i, n4 = (c.tid % TPR) * 4; v[i] = __builtin_nontemporal_load((const f32x4*)(s + (size_t)k * N + n4)); }
#pragma unroll
        for (int i = 0; i < NI; ++i) { const int k = c.tid / TPR + KPI * i, n4 = (c.tid % TPR) * 4;
            tile[k * LDT + n4 + 0] = v[i][0]; tile[k * LDT + n4 + 1] = v[i][1]; tile[k * LDT + n4 + 2] = v[i][2]; tile[k * LDT + n4 + 3] = v[i][3]; }
        __syncthreads();
        { constexpr int TPN = 64 / KPT; const int n = c.tid / TPN, k0 = (c.tid % TPN) * KPT;
          bf16_t* d = dstfn(m, nt * TN + n) + kt * 64 + k0;
#pragma unroll
          for (int q = 0; q < KPT / 8; ++q) { u32x4 w;
#pragma unroll
              for (int e = 0; e < 4; ++e) w[e] = pk2(tile[(k0 + q * 8 + 2 * e) * LDT + n], tile[(k0 + q * 8 + 2 * e + 1) * LDT + n]);
              *(u32x4*)(d + q * 8) = w; } }
        __syncthreads();
    }
}

__device__ __forceinline__ void phase_convert(const Ctx& c) {
    unsigned char* ws = c.ws;
    { const float* x = c.in[0]; float* xo = (float*)(ws + WS_X); bf16_t* xb = (bf16_t*)(ws + WS_XB);
      for (long i = c.gtid; i < (long)T * D / 4; i += c.gthreads) { const f32x4 v = *(const f32x4*)(x + i * 4); *(f32x4*)(xo + i * 4) = v; u32x2 w; w[0] = pk2(v[0], v[1]); w[1] = pk2(v[2], v[3]); *(u32x2*)(xb + i * 4) = w; } }
    { bf16_t* wrt = (bf16_t*)(ws + WS_WRT); for (long i = c.gtid; i < (long)4 * 128 * D / 8; i += c.gthreads) { const long l = i / (128 * D / 8), r = i % (128 * D / 8); *(u32x4*)(wrt + (size_t)l * 256 * D + (size_t)128 * D + r * 8) = (u32x4){0u, 0u, 0u, 0u}; }
      float* gate = (float*)(ws + WS_GATE); for (int i = c.gtid; i < T; i += c.gthreads) gate[TK + i] = 1.f;
      f32x2* ra = (f32x2*)(ws + WS_ROPEA); f32x2* rr = (f32x2*)(ws + WS_ROPER);
      for (int i = c.gtid; i < SEQ * 96; i += c.gthreads) { const int sidx = i / 96, q = i % 96; const bool isA = q < 32; const int jx = isA ? q : q - 32;
          const float e = isA ? (float)jx * (1.f / 32.f) : (float)jx * (1.f / 63.f); const float ang = (float)sidx * exp2f(-e * 13.287712379549449f); float sn, cs; sincosf(ang, &sn, &cs);
          if (isA) ra[sidx * 32 + jx] = (f32x2){cs, sn}; else rr[sidx * 64 + jx] = (f32x2){cs, sn}; }
      float* bp = (float*)(ws + WS_BIASP); for (int i = c.gtid; i < 2 * AB_IN; i += c.gthreads) { const int m = i / AB_IN, n = i % AB_IN; bp[m * AB_IN + ab_phys(n)] = c.in[2][i]; } }
    { bf16_t* d = (bf16_t*)(ws + WS_WABIN);  convert_T<256>(c, c.in[1], 2, D, AB_IN, [=](int m, int n) { return d + (size_t)m * AB_IN * D + (size_t)ab_phys(n) * D; }); }
    { bf16_t* d = (bf16_t*)(ws + WS_WABOUT); convert_T<256>(c, c.in[4], 2, AB_OUT, D, [=](int m, int n) { return d + (size_t)m * D * AB_OUT + (size_t)n * AB_OUT; }); }
    { bf16_t* d = (bf16_t*)(ws + WS_WCDIN);  convert_T<256>(c, c.in[6], 2, D, CD_IN, [=](int m, int n) { return d + (size_t)m * CD_IN * D + (size_t)n * D; }); }
    { bf16_t* d = (bf16_t*)(ws + WS_WCDOUT); convert_T<256>(c, c.in[17], 2, CD_OUT, D, [=](int m, int n) { return d + (size_t)m * D * CD_OUT + (size_t)n * CD_OUT; }); }
    { bf16_t* d = (bf16_t*)(ws + WS_WRT);    convert_T<128>(c, c.in[21], 4, D, NE, [=](int m, int n) { return d + (size_t)m * 256 * D + (size_t)n * D; }); }
    { bf16_t* d = (bf16_t*)(ws + WS_WGU);
      convert_T<256>(c, c.in[23], 4 * NE, D, ED, [=](int m, int n) { return d + (size_t)((m >> 7) * NE1 + (m & 127)) * 512 * D + (size_t)((n >> 7) * 256 + (n & 127)) * D; });
      convert_T<256>(c, c.in[24], 4 * NE, D, ED, [=](int m, int n) { return d + (size_t)((m >> 7) * NE1 + (m & 127)) * 512 * D + (size_t)((n >> 7) * 256 + 128 + (n & 127)) * D; });
      convert_T<256>(c, c.in[26], 4, D, ED, [=](int m, int n) { return d + (size_t)(m * NE1 + NE) * 512 * D + (size_t)((n >> 7) * 256 + (n & 127)) * D; });
      convert_T<256>(c, c.in[27], 4, D, ED, [=](int m, int n) { return d + (size_t)(m * NE1 + NE) * 512 * D + (size_t)((n >> 7) * 256 + 128 + (n & 127)) * D; }); }
    { bf16_t* d = (bf16_t*)(ws + WS_WLRU);
      convert_T<256>(c, c.in[12], 10, 256, 256, [=](int m, int n) { return d + (size_t)(m * 2 + 0) * 65536 + (size_t)n * 256; });
      convert_T<256>(c, c.in[14], 10, 256, 256, [=](int m, int n) { return d + (size_t)(m * 2 + 1) * 65536 + (size_t)n * 256; });
      float* spl = (float*)(ws + WS_SPL); for (int i = c.gtid; i < 2 * 1280; i += c.gthreads) spl[i] = log1pf(expf(-c.in[16][i])); }
    { bf16_t* d = (bf16_t*)(ws + WS_WDN);
      convert_T<256>(c, c.in[25], 4 * NE, ED, D, [=](int m, int n) { return d + (size_t)((m >> 7) * NE1 + (m & 127)) * D * ED + (size_t)n * ED; });
      convert_T<256>(c, c.in[28], 4, ED, D, [=](int m, int n) { return d + (size_t)(m * NE1 + NE) * D * ED + (size_t)n * ED; }); }
}

__device__ __forceinline__ void phase_dense(const Ctx& c, const bf16_t* A, const bf16_t* Bt, int M, int N, int K, float* C, int ldc, const float* bias) {
    g8::DenseOrder S; S.init(A, Bt, M, N, K, c.G, c.bid);
    g8::EpiF32 E{C, ldc, bias};
    g8::gemm_phase<g8::EpiF32, g8::DenseOrder>(c.lds + LDS_STAGE, K, S, E);
}

struct EpiABIn {
    static constexpr bool PERM = true;
    const float* biasP; unsigned char* ws;
    __device__ __forceinline__ void operator()(const f32x4 (&acc)[2][2][4][2], const g8::Unit& u, int wr, int wc, int fr, int fq) const {
        const int pn = u.pn; const int colp = pn * 256 + wc * 32 + fq * 8;
        f32x4 bv[2][2];
#pragma unroll
        for (int bj = 0; bj < 2; ++bj)
#pragma unroll
            for (int n = 0; n < 2; ++n) bv[bj][n] = *(const f32x4*)(biasP + colp + bj * 128 + 4 * n);
        bf16_t* qb = (bf16_t*)(ws + AB_QB); bf16_t* kb = (bf16_t*)(ws + AB_KB); bf16_t* vT = (bf16_t*)(ws + AB_VT); bf16_t* rqb = (bf16_t*)(ws + AB_RQB); bf16_t* rkb = (bf16_t*)(ws + AB_RKB);
        bf16_t* rkdT = (bf16_t*)(ws + AB_RKDT); bf16_t* rvT = (bf16_t*)(ws + AB_RVT); bf16_t* rgb = (bf16_t*)(ws + AB_RGB);
        const f32x4* ropeA = (const f32x4*)(ws + WS_ROPEA); const f32x4* ropeR = (const f32x4*)(ws + WS_ROPER);
#pragma unroll
        for (int ai = 0; ai < 2; ++ai)
#pragma unroll
            for (int m = 0; m < 4; ++m) {
                const int t = u.pm * 256 + ai * 128 + wr * 64 + m * 16 + fr, sq = t & (SEQ - 1), b = t >> 13;
                f32x4 x[2][2];
#pragma unroll
                for (int bj = 0; bj < 2; ++bj)
#pragma unroll
                    for (int n = 0; n < 2; ++n) x[bj][n] = acc[ai][bj][m][n] + bv[bj][n];
                if (pn < 4 || (pn == 4 && wc < 2)) {
                    const int j0 = fq * 8; f32x4 o1[2], o2[2];
#pragma unroll
                    for (int n = 0; n < 2; ++n) { const f32x4 cs01 = ropeA[(sq * 32 + j0 + 4 * n) / 2], cs23 = ropeA[(sq * 32 + j0 + 4 * n) / 2 + 1];
                        const float cc[4] = {cs01[0], cs01[2], cs23[0], cs23[2]}, ss[4] = {cs01[1], cs01[3], cs23[1], cs23[3]};
#pragma unroll
                        for (int e = 0; e < 4; ++e) { o1[n][e] = x[0][n][e] * cc[e] - x[1][n][e] * ss[e]; o2[n][e] = x[1][n][e] * cc[e] + x[0][n][e] * ss[e]; } }
                    const float sc = pn < 4 ? 0.125f : 1.f;
                    u32x4 w1, w2;
#pragma unroll
                    for (int n = 0; n < 2; ++n) { w1[2 * n] = pk2(o1[n][0] * sc, o1[n][1] * sc); w1[2 * n + 1] = pk2(o1[n][2] * sc, o1[n][3] * sc); w2[2 * n] = pk2(o2[n][0] * sc, o2[n][1] * sc); w2[2 * n + 1] = pk2(o2[n][2] * sc, o2[n][3] * sc); }
                    bf16_t* dst = pn < 4 ? qb + (size_t)t * 1024 + (pn * 4 + wc) * 64 + j0 : kb + (size_t)t * 128 + wc * 64 + j0;
                    *(u32x4*)dst = w1; *(u32x4*)(dst + 32) = w2;
                } else if (pn == 4) {
                    const int d0 = (wc - 2) * 32 + fq * 8;
#pragma unroll
                    for (int bj = 0; bj < 2; ++bj)
#pragma unroll
                        for (int n = 0; n < 2; ++n)
#pragma unroll
                            for (int e = 0; e < 4; ++e) vT[((size_t)(b * 2 + bj) * 64 + d0 + 4 * n + e) * SEQ + sq] = f2bf(x[bj][n][e]);
                } else if (pn < 9) {
                    const bool isk = pn >= 7; const int h = ((pn - 5) & 1) * 2 + (wc >> 1), j0 = (wc & 1) * 32 + fq * 8; f32x4 o1[2], o2[2];
                    const float sc = isk ? 0.08838834764831845f : 1.f;
#pragma unroll
                    for (int n = 0; n < 2; ++n) { const f32x4 cs01 = ropeR[(sq * 64 + j0 + 4 * n) / 2], cs23 = ropeR[(sq * 64 + j0 + 4 * n) / 2 + 1];
                        const float cc[4] = {cs01[0], cs01[2], cs23[0], cs23[2]}, ss[4] = {cs01[1], cs01[3], cs23[1], cs23[3]};
#pragma unroll
                        for (int e = 0; e < 4; ++e) { o1[n][e] = (x[0][n][e] * cc[e] - x[1][n][e] * ss[e]) * sc; o2[n][e] = (x[1][n][e] * cc[e] + x[0][n][e] * ss[e]) * sc; } }
                    u32x4 w1, w2;
#pragma unroll
                    for (int n = 0; n < 2; ++n) { w1[2 * n] = pk2(o1[n][0], o1[n][1]); w1[2 * n + 1] = pk2(o1[n][2], o1[n][3]); w2[2 * n] = pk2(o2[n][0], o2[n][1]); w2[2 * n + 1] = pk2(o2[n][2], o2[n][3]); }
                    bf16_t* dst = (isk ? rkb : rqb) + (size_t)t * 512 + h * 128 + j0;
                    *(u32x4*)dst = w1; *(u32x4*)(dst + 64) = w2;
                    if (isk) {
                        const float lg = log2f(1.f - exp2f(-5.f - (float)h)); const float dec = exp2f((float)(127 - (sq & 127)) * lg);
                        bf16_t* dT = rkdT + ((size_t)(b * 4 + h) * 128 + j0) * SEQ + sq;
#pragma unroll
                        for (int n = 0; n < 2; ++n)
#pragma unroll
                            for (int e = 0; e < 4; ++e) { dT[(size_t)(4 * n + e) * SEQ] = f2bf(o1[n][e] * dec); dT[(size_t)(64 + 4 * n + e) * SEQ] = f2bf(o2[n][e] * dec); }
                    }
                } else if (pn < 13) {
                    const int h = pn - 9;
#pragma unroll
                    for (int bj = 0; bj < 2; ++bj)
#pragma unroll
                        for (int n = 0; n < 2; ++n)
#pragma unroll
                            for (int e = 0; e < 4; ++e) rvT[((size_t)(b * 4 + h) * 256 + bj * 128 + wc * 32 + fq * 8 + 4 * n + e) * SEQ + sq] = f2bf(x[bj][n][e]);
                } else {
#pragma unroll
                    for (int bj = 0; bj < 2; ++bj) { u32x4 w;
#pragma unroll
                        for (int n = 0; n < 2; ++n) { w[2 * n] = pk2(siluf_(x[bj][n][0]), siluf_(x[bj][n][1])); w[2 * n + 1] = pk2(siluf_(x[bj][n][2]), siluf_(x[bj][n][3])); }
                        *(u32x4*)(rgb + (size_t)t * 1024 + (pn - 13) * 256 + bj * 128 + wc * 32 + fq * 8) = w; }
                }
            }
    }
};
__device__ __forceinline__ void phase_ab_inproj(const Ctx& c, int j) {
    g8::DenseOrder S; S.init(c.ws + WS_XB, c.ws + WS_WABIN + (size_t)j * AB_IN * D * 2, T, AB_IN, D, c.G, c.bid);
    EpiABIn E{(const float*)(c.ws + WS_BIASP) + (size_t)j * AB_IN, c.ws};
    g8::gemm_phase<EpiABIn, g8::DenseOrder>(c.lds + LDS_STAGE, D, S, E);
}

#define MFMA16(a, b, c) __builtin_amdgcn_mfma_f32_16x16x32_bf16((a), (b), (c), 0, 0, 0)
__device__ __forceinline__ bf16x8 pack8(const f32x4& lo, const f32x4& hi) { u32x4 w; w[0] = g8::cvt_pk_bf16(lo[0], lo[1]); w[1] = g8::cvt_pk_bf16(lo[2], lo[3]); w[2] = g8::cvt_pk_bf16(hi[0], hi[1]); w[3] = g8::cvt_pk_bf16(hi[2], hi[3]); return __builtin_bit_cast(bf16x8, w); }
__device__ __forceinline__ bf16x8 cat8(const u32x2& lo, const u32x2& hi) { u32x4 w; w[0] = lo[0]; w[1] = lo[1]; w[2] = hi[0]; w[3] = hi[1]; return __builtin_bit_cast(bf16x8, w); }
template <int ROWS, int RB>
__device__ __forceinline__ void tile_g2l(LAS unsigned char* dst, const unsigned char* src, size_t gs, int tid, int zrows = 0) {
    constexpr int CPR = RB / 16, TOTAL = ROWS * CPR;
#pragma unroll 4
    for (int i = tid; i < TOTAL; i += NTHREADS) { const int r = i / CPR, cc = i % CPR; u32x4 v = (u32x4){0u, 0u, 0u, 0u}; if (r >= zrows) v = *(const u32x4*)(src + (size_t)r * gs + cc * 16);
        *(LAS u32x4*)(dst + r * (RB + 16) + cc * 16) = v; }
}

__device__ __forceinline__ void attn_unit(const Ctx& c, int unit, const float* sinks) {
    const int b = unit >> 7, n = (unit >> 1) & 63, kvh = unit & 1, hd = kvh * 8 + c.wid, lane = c.lane, fr = lane & 15, fq = lane >> 4;
    const bf16_t* qb = (const bf16_t*)(c.ws + AB_QB); const bf16_t* kb = (const bf16_t*)(c.ws + AB_KB); const bf16_t* vT = (const bf16_t*)(c.ws + AB_VT); bf16_t* ycat = (bf16_t*)(c.ws + WS_YCAT);
    LAS unsigned char* Ks = c.lds; LAS unsigned char* Vs = c.lds + 256 * 144;
    const int t0 = b * SEQ + n * 128;
    __syncthreads();
    {
        const unsigned char* src = (const unsigned char*)(kb + (size_t)(t0 - 128) * 128 + kvh * 64);
        constexpr int TOTAL = 256 * 8;
#pragma unroll 4
        for (int i = c.tid; i < TOTAL; i += NTHREADS) { const int r = i >> 3, cc = i & 7; u32x4 v = (u32x4){0u, 0u, 0u, 0u}; if (n > 0 || r >= 128) v = *(const u32x4*)(src + (ptrdiff_t)r * 256 + cc * 16);
            *(LAS u32x4*)(Ks + r * 144 + cc * 16) = v; }
        const unsigned char* vsrc = (const unsigned char*)(vT + (size_t)(b * 2 + kvh) * 64 * SEQ + (n * 128 - 128));
        constexpr int TV = 64 * 32;
#pragma unroll 4
        for (int i = c.tid; i < TV; i += NTHREADS) { const int r = i >> 5, cc = i & 31; u32x4 v = (u32x4){0u, 0u, 0u, 0u}; if (n > 0 || cc >= 16) v = *(const u32x4*)(vsrc + (ptrdiff_t)r * SEQ * 2 + cc * 16);
            *(LAS u32x4*)(Vs + r * 528 + cc * 16) = v; }
    }
    __syncthreads();
    const float sink = sinks[hd];
    for (int si = 0; si < 8; ++si) {
        const int t = t0 + si * 16 + fr;
        bf16x8 qf[2];
#pragma unroll
        for (int ks = 0; ks < 2; ++ks) qf[ks] = *(const bf16x8*)(qb + (size_t)t * 1024 + hd * 64 + ks * 32 + fq * 8);
        f32x4 S[10];
#pragma unroll
        for (int nk = 0; nk < 9; ++nk) { S[nk] = (f32x4){0.f, 0.f, 0.f, 0.f};
#pragma unroll
            for (int ks = 0; ks < 2; ++ks) { const bf16x8 a = *(const LAS bf16x8*)(Ks + (16 * (si + nk) + fr) * 144 + ks * 64 + fq * 16); S[nk] = MFMA16(a, qf[ks], S[nk]); } }
        S[9] = (f32x4){0.f, 0.f, 0.f, 0.f};
        const int i = si * 16 + fr;
        float mx = sink;
#pragma unroll
        for (int nk = 0; nk < 9; ++nk)
#pragma unroll
            for (int r = 0; r < 4; ++r) { const int p = 16 * (si + nk) + 4 * fq + r; const bool ok = (p >= i + 1) && (p <= i + 128) && (n > 0 || p >= 128);
                S[nk][r] = ok ? S[nk][r] : -1e30f; mx = fmaxf(mx, S[nk][r]); }
        mx = fmaxf(mx, __shfl_xor(mx, 16)); mx = fmaxf(mx, __shfl_xor(mx, 32));
        float sum = 0.f;
#pragma unroll
        for (int nk = 0; nk < 9; ++nk)
#pragma unroll
            for (int r = 0; r < 4; ++r) { const float pv = S[nk][r] > -1e29f ? exp2f((S[nk][r] - mx) * 1.4426950408889634f) : 0.f; S[nk][r] = pv; sum += pv; }
        sum += __shfl_xor(sum, 16); sum += __shfl_xor(sum, 32);
        const float inv = 1.f / (sum + exp2f((sink - mx) * 1.4426950408889634f));
        f32x4 O[4];
#pragma unroll
        for (int nd = 0; nd < 4; ++nd) O[nd] = (f32x4){0.f, 0.f, 0.f, 0.f};
#pragma unroll
        for (int kk = 0; kk < 5; ++kk) { const bf16x8 pf = pack8(S[2 * kk], S[2 * kk + 1]);
            const int p0 = 16 * (si + 2 * kk) + 4 * fq, p1 = (kk == 4 && si == 7) ? p0 : p0 + 16;
#pragma unroll
            for (int nd = 0; nd < 4; ++nd) { const u32x2 lo = *(const LAS u32x2*)(Vs + (16 * nd + fr) * 528 + p0 * 2), hi = *(const LAS u32x2*)(Vs + (16 * nd + fr) * 528 + p1 * 2);
                O[nd] = MFMA16(cat8(lo, hi), pf, O[nd]); } }
#pragma unroll
        for (int nd = 0; nd < 4; ++nd) { u32x2 w; w[0] = pk2(O[nd][0] * inv, O[nd][1] * inv); w[1] = pk2(O[nd][2] * inv, O[nd][3] * inv);
            *(u32x2*)(ycat + (size_t)t * AB_OUT + hd * 64 + 16 * nd + 4 * fq) = w; }
    }
}

__device__ __forceinline__ void ret_kv_unit(const Ctx& c, int unit) {
    const int b = unit >> 8, n = (unit >> 2) & 63, h = unit & 3, lane = c.lane, fr = lane & 15, fq = lane >> 4, w = c.wid;
    const bf16_t* rkdT = (const bf16_t*)(c.ws + AB_RKDT); const bf16_t* rvT = (const bf16_t*)(c.ws + AB_RVT); float* kv = (float*)(c.ws + AB_KV);
    LAS unsigned char* Kd = c.lds;
    __syncthreads();
    tile_g2l<128, 256>(Kd, (const unsigned char*)(rkdT + (size_t)(b * 4 + h) * 128 * SEQ + n * 128), (size_t)SEQ * 2, c.tid);
    bf16x8 vf[2][4];
#pragma unroll
    for (int ne = 0; ne < 2; ++ne)
#pragma unroll
        for (int ks = 0; ks < 4; ++ks) vf[ne][ks] = *(const bf16x8*)(rvT + ((size_t)(b * 4 + h) * 256 + 32 * w + 16 * ne + fr) * SEQ + n * 128 + ks * 32 + fq * 8);
    __syncthreads();
    float* out = kv + ((size_t)((b * 64 + n) * 4 + h)) * 256 * 128;
#pragma unroll
    for (int nd = 0; nd < 8; ++nd) { f32x4 a0 = (f32x4){0.f, 0.f, 0.f, 0.f}, a1 = a0;
#pragma unroll
        for (int ks = 0; ks < 4; ++ks) { const bf16x8 kf = *(const LAS bf16x8*)(Kd + (16 * nd + fr) * 272 + ks * 64 + fq * 16); a0 = MFMA16(kf, vf[0][ks], a0); a1 = MFMA16(kf, vf[1][ks], a1); }
        *(f32x4*)(out + (size_t)(32 * w + fr) * 128 + 16 * nd + 4 * fq) = a0; *(f32x4*)(out + (size_t)(32 * w + 16 + fr) * 128 + 16 * nd + 4 * fq) = a1; }
}
__device__ __forceinline__ void ret_scan(const Ctx& c, int first_block, int nblocks) {
    const float* kv = (const float*)(c.ws + AB_KV); bf16_t* sp = (bf16_t*)(c.ws + AB_SPREV);
    const int nthr = nblocks * NTHREADS;
    for (int idx = (c.bid - first_block) * NTHREADS + c.tid; idx < 2 * 4 * 256 * 128 / 4; idx += nthr) {
        const int b = idx >> 15, rem = idx & 32767, h = rem >> 13;
        const float g = exp2f(128.f * log2f(1.f - exp2f(-5.f - (float)h)));
        const size_t base = (size_t)b * 64 * 131072 + (size_t)rem * 4;
        f32x4 st = (f32x4){0.f, 0.f, 0.f, 0.f};
        for (int n0 = 0; n0 < 64; n0 += 8) { f32x4 v[8];
#pragma unroll
            for (int q = 0; q < 8; ++q) v[q] = *(const f32x4*)(kv + base + (size_t)(n0 + q) * 131072);
#pragma unroll
            for (int q = 0; q < 8; ++q) { u32x2 wv; wv[0] = pk2(st[0], st[1]); wv[1] = pk2(st[2], st[3]); *(u32x2*)(sp + base + (size_t)(n0 + q) * 131072) = wv; st = st * g + v[q]; } }
    }
}
__device__ __forceinline__ void ret_out_unit(const Ctx& c, int unit) {
    const int b = unit >> 8, n = (unit >> 2) & 63, h = unit & 3, lane = c.lane, fr = lane & 15, fq = lane >> 4, w = c.wid;
    const bf16_t* rqb = (const bf16_t*)(c.ws + AB_RQB); const bf16_t* rkb = (const bf16_t*)(c.ws + AB_RKB); const bf16_t* rvT = (const bf16_t*)(c.ws + AB_RVT);
    const bf16_t* sp = (const bf16_t*)(c.ws + AB_SPREV); const bf16_t* rgb = (const bf16_t*)(c.ws + AB_RGB); bf16_t* ycat = (bf16_t*)(c.ws + WS_YCAT);
    LAS unsigned char* Kl = c.lds; LAS unsigned char* Bl = c.lds + 128 * 272;
    const int t0 = b * SEQ + n * 128; const float lg = log2f(1.f - exp2f(-5.f - (float)h));
    __syncthreads();
    tile_g2l<128, 256>(Kl, (const unsigned char*)(rkb + (size_t)t0 * 512 + h * 128), (size_t)512 * 2, c.tid);
    tile_g2l<256, 256>(Bl, (const unsigned char*)(sp + ((size_t)((b * 64 + n) * 4 + h)) * 256 * 128), (size_t)128 * 2, c.tid);
    const int t = t0 + 16 * w + fr, i = 16 * w + fr;
    bf16x8 qf[4];
#pragma unroll
    for (int ks = 0; ks < 4; ++ks) qf[ks] = *(const bf16x8*)(rqb + (size_t)t * 512 + h * 128 + ks * 32 + fq * 8);
    __syncthreads();
    bf16x8 pf[4];
#pragma unroll
    for (int kk = 0; kk < 4; ++kk) { f32x4 s2[2];
#pragma unroll
        for (int q = 0; q < 2; ++q) { const int nj = 2 * kk + q; s2[q] = (f32x4){0.f, 0.f, 0.f, 0.f};
            if (nj <= w) {
#pragma unroll
                for (int ks = 0; ks < 4; ++ks) { const bf16x8 kf = *(const LAS bf16x8*)(Kl + (16 * nj + fr) * 272 + ks * 64 + fq * 16); s2[q] = MFMA16(kf, qf[ks], s2[q]); }
#pragma unroll
                for (int r = 0; r < 4; ++r) { const int jj = 16 * nj + 4 * fq + r; s2[q][r] = (i >= jj) ? s2[q][r] * exp2f((float)(i - jj) * lg) : 0.f; } } }
        pf[kk] = pack8(s2[0], s2[1]); }
    f32x4 acc[16];
#pragma unroll
    for (int ne = 0; ne < 16; ++ne) { acc[ne] = (f32x4){0.f, 0.f, 0.f, 0.f};
#pragma unroll
        for (int ks = 0; ks < 4; ++ks) { const bf16x8 sf = *(const LAS bf16x8*)(Bl + (16 * ne + fr) * 272 + ks * 64 + fq * 16); acc[ne] = MFMA16(sf, qf[ks], acc[ne]); } }
    const float rs = exp2f((float)(i + 1) * lg);
#pragma unroll
    for (int ne = 0; ne < 16; ++ne) acc[ne] = acc[ne] * rs;
    __syncthreads();
    tile_g2l<256, 256>(Bl, (const unsigned char*)(rvT + (size_t)(b * 4 + h) * 256 * SEQ + n * 128), (size_t)SEQ * 2, c.tid);
    __syncthreads();
    const int nkk = (w >> 1) + 1;
#pragma unroll
    for (int kk = 0; kk < 4; ++kk) if (kk < nkk) {
#pragma unroll
        for (int ne = 0; ne < 16; ++ne) { const u32x2 lo = *(const LAS u32x2*)(Bl + (16 * ne + fr) * 272 + (32 * kk + 4 * fq) * 2), hi = *(const LAS u32x2*)(Bl + (16 * ne + fr) * 272 + (32 * kk + 16 + 4 * fq) * 2);
            acc[ne] = MFMA16(cat8(lo, hi), pf[kk], acc[ne]); } }
    float sm = 0.f;
#pragma unroll
    for (int ne = 0; ne < 16; ++ne) sm += acc[ne][0] + acc[ne][1] + acc[ne][2] + acc[ne][3];
    sm += __shfl_xor(sm, 16); sm += __shfl_xor(sm, 32);
    const float mean = sm * (1.f / 256.f); float sq = 0.f;
#pragma unroll
    for (int ne = 0; ne < 16; ++ne) { acc[ne] = acc[ne] - mean; sq += acc[ne][0] * acc[ne][0] + acc[ne][1] * acc[ne][1] + acc[ne][2] * acc[ne][2] + acc[ne][3] * acc[ne][3]; }
    sq += __shfl_xor(sq, 16); sq += __shfl_xor(sq, 32);
    const float rstd = rsqrtf(sq * (1.f / 256.f) + LN_EPS);
#pragma unroll
    for (int ne = 0; ne < 16; ++ne) { const u32x2 gw = *(const u32x2*)(rgb + (size_t)t * 1024 + h * 256 + 16 * ne + 4 * fq);
        const float g0 = __uint_as_float(gw[0] << 16), g1 = __uint_as_float(gw[0] & 0xffff0000u), g2 = __uint_as_float(gw[1] << 16), g3 = __uint_as_float(gw[1] & 0xffff0000u);
        u32x2 o; o[0] = pk2(acc[ne][0] * rstd * g0, acc[ne][1] * rstd * g1); o[1] = pk2(acc[ne][2] * rstd * g2, acc[ne][3] * rstd * g3);
        *(u32x2*)(ycat + (size_t)t * AB_OUT + 1024 + h * 256 + 16 * ne + 4 * fq) = o; }
}

__device__ __forceinline__ void phase_ab_p1(const Ctx& c) {
    for (int u = c.bid; u < 512; u += c.G) ret_kv_unit(c, u);
}
__device__ __forceinline__ void phase_ab_p2(const Ctx& c, int j) {
    if (c.bid < 64) ret_scan(c, 0, 64);
    else { const float* sinks = c.in[3] + j * 16; for (int u = c.bid - 64; u < 256; u += c.G - 64) attn_unit(c, u, sinks); }
}
__device__ __forceinline__ void phase_ab_p3(const Ctx& c) {
    for (int u = c.bid; u < 512; u += c.G) ret_out_unit(c, u);
}

__device__ __forceinline__ float gelu_fast(float x) { const float u = 1.5957691216057308f * (x + 0.044715f * x * x * x); return x / (1.f + __expf(-u)); }
struct EpiCDIn {
    static constexpr bool PERM = true;
    const float* bias; unsigned char* ws;
    __device__ __forceinline__ void operator()(const f32x4 (&acc)[2][2][4][2], const g8::Unit& u, int wr, int wc, int fr, int fq) const {
        const int pn = u.pn; const int col0 = pn * 256 + wc * 32 + fq * 8;
        f32x4 bv[2][2];
#pragma unroll
        for (int bj = 0; bj < 2; ++bj)
#pragma unroll
            for (int n = 0; n < 2; ++n) bv[bj][n] = *(const f32x4*)(bias + col0 + bj * 128 + 4 * n);
        bf16_t* gu = (bf16_t*)(ws + CD_GU); bf16_t* gvT = (bf16_t*)(ws + CD_GVT); bf16_t* gg = (bf16_t*)(ws + CD_GG); bf16_t* xr = (bf16_t*)(ws + CD_XR); float* stats = (float*)(ws + CD_STATS);
#pragma unroll
        for (int ai = 0; ai < 2; ++ai)
#pragma unroll
            for (int m = 0; m < 4; ++m) {
                const int t = u.pm * 256 + ai * 128 + wr * 64 + m * 16 + fr, sq = t & (SEQ - 1), b = t >> 13;
                f32x4 x[2][2];
#pragma unroll
                for (int bj = 0; bj < 2; ++bj)
#pragma unroll
                    for (int n = 0; n < 2; ++n) { x[bj][n] = acc[ai][bj][m][n] + bv[bj][n];
                        if (pn < 13) {
#pragma unroll
                            for (int e = 0; e < 4; ++e) x[bj][n][e] = gelu_fast(x[bj][n][e]); } }
                if (pn >= 4 && pn < 8) {
                    float s1 = 0.f, s2 = 0.f;
#pragma unroll
                    for (int bj = 0; bj < 2; ++bj)
#pragma unroll
                        for (int n = 0; n < 2; ++n)
#pragma unroll
                            for (int e = 0; e < 4; ++e) { const float v = x[bj][n][e]; s1 += v; s2 += v * v;
                                gvT[((size_t)b * 1024 + (pn - 4) * 256 + bj * 128 + wc * 32 + fq * 8 + 4 * n + e) * SEQ + sq] = f2bf(v); }
                    s1 += __shfl_xor(s1, 16); s1 += __shfl_xor(s1, 32); s2 += __shfl_xor(s2, 16); s2 += __shfl_xor(s2, 32);
                    if (fq == 0) *(f32x2*)(stats + (size_t)t * 32 + ((pn - 4) * 4 + wc) * 2) = (f32x2){s1, s2};
                } else {
                    bf16_t* dst; int ld, cb;
                    if (pn < 4) { dst = gu; ld = 1024; cb = pn * 256; } else if (pn < 13) { dst = gg; ld = 1280; cb = (pn - 8) * 256; } else { dst = xr; ld = 1280; cb = (pn - 13) * 256; }
#pragma unroll
                    for (int bj = 0; bj < 2; ++bj) { u32x4 w;
#pragma unroll
                        for (int n = 0; n < 2; ++n) { w[2 * n] = pk2(x[bj][n][0], x[bj][n][1]); w[2 * n + 1] = pk2(x[bj][n][2], x[bj][n][3]); }
                        *(u32x4*)(dst + (size_t)t * ld + cb + bj * 128 + wc * 32 + fq * 8) = w; }
                }
            }
    }
};
__device__ __forceinline__ void phase_cd_inproj(const Ctx& c, int j) {
    g8::DenseOrder S; S.init(c.ws + WS_XB, c.ws + WS_WCDIN + (size_t)j * CD_IN * D * 2, T, CD_IN, D, c.G, c.bid);
    EpiCDIn E{c.in[7] + (size_t)j * CD_IN, c.ws};
    g8::gemm_phase<EpiCDIn, g8::DenseOrder>(c.lds + LDS_STAGE, D, S, E);
}

__device__ __forceinline__ void lru_unit(const Ctx& c, int unit, int j) {
    const int hh = unit % 5, bn = unit / 5, lane = c.lane, fr = lane & 15, fq = lane >> 4, w = c.wid;
    const int t0 = bn * 128, s0 = t0 & (SEQ - 1);
    const bf16_t* xr = (const bf16_t*)(c.ws + CD_XR); bf16_t* HL = (bf16_t*)(c.ws + WS_U2); bf16_t* PC = HL + (size_t)T * 1280; float* sum = (float*)(c.ws + WS_H);
    const float* conv_w = c.in[10] + (size_t)j * 4 * 1280 + hh * 256; const float* conv_b = c.in[11] + (size_t)j * 1280 + hh * 256;
    const float* ba = c.in[13] + (size_t)j * 1280 + hh * 256; const float* bx = c.in[15] + (size_t)j * 1280 + hh * 256; const float* spl = (const float*)(c.ws + WS_SPL) + (size_t)j * 1280 + hh * 256;
    const bf16_t* Wl = (const bf16_t*)(c.ws + WS_WLRU) + (size_t)((j * 5 + hh) * 2) * 65536;
    LAS unsigned char* Xc = c.lds; LAS unsigned char* Wa = c.lds + 128 * 528; LAS unsigned char* Wx = Wa + 64 * 528; LAS unsigned char* Tot = Wx + 64 * 528;
    __syncthreads();
    for (int it = c.tid; it < 128 * 32; it += NTHREADS) { const int r = it >> 5, cg = it & 31;
        float a[8];
        { const f32x4 b0 = *(const f32x4*)(conv_b + cg * 8), b1 = *(const f32x4*)(conv_b + cg * 8 + 4); a[0] = b0[0]; a[1] = b0[1]; a[2] = b0[2]; a[3] = b0[3]; a[4] = b1[0]; a[5] = b1[1]; a[6] = b1[2]; a[7] = b1[3]; }
#pragma unroll
        for (int k = 0; k < 4; ++k) { if (s0 + r - 3 + k >= 0) {
                const u32x4 xv = *(const u32x4*)(xr + (size_t)(t0 + r - 3 + k) * 1280 + hh * 256 + cg * 8);
                const f32x4 w0 = *(const f32x4*)(conv_w + k * 1280 + cg * 8), w1 = *(const f32x4*)(conv_w + k * 1280 + cg * 8 + 4);
                a[0] += w0[0] * __uint_as_float(xv[0] << 16); a[1] += w0[1] * __uint_as_float(xv[0] & 0xffff0000u); a[2] += w0[2] * __uint_as_float(xv[1] << 16); a[3] += w0[3] * __uint_as_float(xv[1] & 0xffff0000u);
                a[4] += w1[0] * __uint_as_float(xv[2] << 16); a[5] += w1[1] * __uint_as_float(xv[2] & 0xffff0000u); a[6] += w1[2] * __uint_as_float(xv[3] << 16); a[7] += w1[3] * __uint_as_float(xv[3] & 0xffff0000u); } }
        u32x4 o; o[0] = pk2(a[0], a[1]); o[1] = pk2(a[2], a[3]); o[2] = pk2(a[4], a[5]); o[3] = pk2(a[6], a[7]);
        *(LAS u32x4*)(Xc + r * 528 + cg * 16) = o; }
    __syncthreads();
    bf16x8 xf[8];
#pragma unroll
    for (int ks = 0; ks < 8; ++ks) xf[ks] = *(const LAS bf16x8*)(Xc + (16 * w + fr) * 528 + ks * 64 + fq * 16);
    const int t = t0 + 16 * w + fr;
    for (int sl = 0; sl < 4; ++sl) {
        if (sl) __syncthreads();
        tile_g2l<64, 512>(Wa, (const unsigned char*)(Wl + (size_t)(sl * 64) * 256), 512, c.tid);
        tile_g2l<64, 512>(Wx, (const unsigned char*)(Wl + 65536 + (size_t)(sl * 64) * 256), 512, c.tid);
        __syncthreads();
        f32x4 sA[4], sB[4];
#pragma unroll
        for (int nc = 0; nc < 4; ++nc) { f32x4 ra = (f32x4){0.f, 0.f, 0.f, 0.f}, ri = ra;
#pragma unroll
            for (int ks = 0; ks < 8; ++ks) { const bf16x8 wa = *(const LAS bf16x8*)(Wa + (16 * nc + fr) * 528 + ks * 64 + fq * 16), wx = *(const LAS bf16x8*)(Wx + (16 * nc + fr) * 528 + ks * 64 + fq * 16);
                ra = MFMA16(wa, xf[ks], ra); ri = MFMA16(wx, xf[ks], ri); }
            const int ch = sl * 64 + 16 * nc + 4 * fq;
            const f32x4 b_a = *(const f32x4*)(ba + ch), b_x = *(const f32x4*)(bx + ch), sp = *(const f32x4*)(spl + ch);
            const u32x2 xw = *(const LAS u32x2*)(Xc + (16 * w + fr) * 528 + ch * 2);
            const float xcv[4] = {__uint_as_float(xw[0] << 16), __uint_as_float(xw[0] & 0xffff0000u), __uint_as_float(xw[1] << 16), __uint_as_float(xw[1] & 0xffff0000u)};
            f32x4 oa, ob;
#pragma unroll
            for (int r = 0; r < 4; ++r) { const float gr = sigmoidf_(ra[r] + b_a[r]), gi = sigmoidf_(ri[r] + b_x[r]); const float la = -8.f * gr * sp[r]; const float a = __expf(la);
                oa[r] = a; ob[r] = sqrtf(fmaxf(1.f - a * a, 0.f)) * (gi * xcv[r]); }
#pragma unroll
            for (int dlt = 1; dlt < 16; dlt <<= 1) {
#pragma unroll
                for (int r = 0; r < 4; ++r) { const float pa = __shfl_up(oa[r], dlt, 16), pb = __shfl_up(ob[r], dlt, 16); if (fr >= dlt) { ob[r] = oa[r] * pb + ob[r]; oa[r] = oa[r] * pa; } } }
            sA[nc] = oa; sB[nc] = ob;
            if (fr == 15) { *(LAS f32x4*)(Tot + ((w * 64 + 16 * nc + 4 * fq) * 2) * 4) = oa; *(LAS f32x4*)(Tot + ((w * 64 + 16 * nc + 4 * fq) * 2 + 4) * 4) = ob; }
        }
        __syncthreads();
#pragma unroll
        for (int nc = 0; nc < 4; ++nc) { const int ch = sl * 64 + 16 * nc + 4 * fq;
            f32x4 cp = (f32x4){1.f, 1.f, 1.f, 1.f}, chh = (f32x4){0.f, 0.f, 0.f, 0.f};
            for (int w2 = 0; w2 < w; ++w2) { const f32x4 ta = *(const LAS f32x4*)(Tot + ((w2 * 64 + 16 * nc + 4 * fq) * 2) * 4), tb = *(const LAS f32x4*)(Tot + ((w2 * 64 + 16 * nc + 4 * fq) * 2 + 4) * 4);
                chh = ta * chh + tb; cp = cp * ta; }
            const f32x4 hl = sB[nc] + sA[nc] * chh, pc = sA[nc] * cp;
            u32x2 o1, o2; o1[0] = pk2(hl[0], hl[1]); o1[1] = pk2(hl[2], hl[3]); o2[0] = pk2(pc[0], pc[1]); o2[1] = pk2(pc[2], pc[3]);
            *(u32x2*)(HL + (size_t)t * 1280 + hh * 256 + ch) = o1; *(u32x2*)(PC + (size_t)t * 1280 + hh * 256 + ch) = o2;
            if (w == 7 && fr == 15) { float* sm = sum + ((size_t)bn * 1280 + hh * 256 + ch) * 2;
#pragma unroll
                for (int r = 0; r < 4; ++r) { sm[2 * r] = pc[r]; sm[2 * r + 1] = hl[r]; } } }
    }
}

__device__ __forceinline__ void sgu_unit(const Ctx& c, int unit, int j) {
    const int g = unit & 3, bn = unit >> 2, b = bn >> 6, n = bn & 63, lane = c.lane, fr = lane & 15, fq = lane >> 4, w = c.wid;
    const int t0 = bn * 128;
    const bf16_t* gu = (const bf16_t*)(c.ws + CD_GU); const bf16_t* gvT = (const bf16_t*)(c.ws + CD_GVT); const float* stats = (const float*)(c.ws + CD_STATS); bf16_t* ycat = (bf16_t*)(c.ws + WS_YCAT);
    const float* sw = c.in[8] + (size_t)(j * 4 + g) * 16384; const float* sb = c.in[9] + (size_t)(j * 4 + g) * 128;
    LAS unsigned char* Vt = c.lds; LAS float* mr = (LAS float*)(c.lds + 256 * 272);
    __syncthreads();
    tile_g2l<256, 256>(Vt, (const unsigned char*)(gvT + ((size_t)b * 1024 + g * 256) * SEQ + n * 128), (size_t)SEQ * 2, c.tid);
    if (c.tid < 128) { const float* st = stats + (size_t)(t0 + c.tid) * 32; float s1 = 0.f, s2 = 0.f;
#pragma unroll
        for (int q = 0; q < 16; ++q) { s1 += st[2 * q]; s2 += st[2 * q + 1]; }
        const float mean = s1 * (1.f / 1024.f), var = fmaxf(s2 * (1.f / 1024.f) - mean * mean, 0.f); mr[2 * c.tid] = mean; mr[2 * c.tid + 1] = rsqrtf(var + LN_EPS); }
    __syncthreads();
    const int i = 16 * w + fr, t = t0 + i, nks = (w >> 1) + 1;
    bf16x8 wf[4]; float ci = 0.f;
#pragma unroll
    for (int ks = 0; ks < 4; ++ks) { f32x4 lo = (f32x4){0.f, 0.f, 0.f, 0.f}, hi = lo;
        if (ks < nks) { const int j0 = ks * 32 + fq * 8; const f32x4 w0 = *(const f32x4*)(sw + (size_t)i * 128 + j0), w1 = *(const f32x4*)(sw + (size_t)i * 128 + j0 + 4);
#pragma unroll
            for (int e = 0; e < 4; ++e) { const float m0 = mr[2 * (j0 + e)], r0 = mr[2 * (j0 + e) + 1], m1 = mr[2 * (j0 + 4 + e)], r1 = mr[2 * (j0 + 4 + e) + 1];
                lo[e] = (j0 + e <= i) ? w0[e] * r0 : 0.f; hi[e] = (j0 + 4 + e <= i) ? w1[e] * r1 : 0.f; ci += lo[e] * m0 + hi[e] * m1; } }
        wf[ks] = pack8(lo, hi); }
    ci += __shfl_xor(ci, 16); ci += __shfl_xor(ci, 32);
    const float add = sb[i] - ci;
    f32x4 acc[16];
#pragma unroll
    for (int nd = 0; nd < 16; ++nd) { acc[nd] = (f32x4){0.f, 0.f, 0.f, 0.f};
#pragma unroll
        for (int ks = 0; ks < 4; ++ks) if (ks < nks) { const bf16x8 vf = *(const LAS bf16x8*)(Vt + (16 * nd + fr) * 272 + ks * 64 + fq * 16); acc[nd] = MFMA16(vf, wf[ks], acc[nd]); } }
#pragma unroll
    for (int nd = 0; nd < 16; ++nd) { const u32x2 uw = *(const u32x2*)(gu + (size_t)t * 1024 + g * 256 + 16 * nd + 4 * fq);
        const float u0 = __uint_as_float(uw[0] << 16), u1 = __uint_as_float(uw[0] & 0xffff0000u), u2 = __uint_as_float(uw[1] << 16), u3 = __uint_as_float(uw[1] & 0xffff0000u);
        u32x2 o; o[0] = pk2(u0 * (acc[nd][0] + add), u1 * (acc[nd][1] + add)); o[1] = pk2(u2 * (acc[nd][2] + add), u3 * (acc[nd][3] + add));
        *(u32x2*)(ycat + (size_t)t * CD_OUT + g * 256 + 16 * nd + 4 * fq) = o; }
}
__device__ __forceinline__ void phase_cd_p1(const Ctx& c, int j) {
    for (int u = c.bid; u < 640 + 512; u += c.G) { if (u < 640) lru_unit(c, u, j); else sgu_unit(c, u - 640, j); }
}

__device__ __forceinline__ void phase_cd_scan2(const Ctx& c) {
    const bf16_t* gg = (const bf16_t*)(c.ws + CD_GG); bf16_t* ycat = (bf16_t*)(c.ws + WS_YCAT);
    const bf16_t* HL = (const bf16_t*)(c.ws + WS_U2); const bf16_t* PC = HL + (size_t)T * 1280; const float* sum = (const float*)(c.ws + WS_H);
    LAS float* carry = (LAS float*)c.lds;
    for (int u = c.bid; u < 256; u += c.G) {
        const int bn = u >> 1, half = u & 1, b = bn >> 6, n = bn & 63;
        __syncthreads();
        for (int ch = c.tid; ch < 1280; ch += NTHREADS) { float cr = 0.f; const float* sp = sum + ((size_t)(b * 64) * 1280 + ch) * 2;
#pragma unroll 8
            for (int m = 0; m < n; ++m) { const f32x2 v = *(const f32x2*)(sp + (size_t)m * 2560); cr = v[0] * cr + v[1]; }
            carry[ch] = cr; }
        __syncthreads();
        const size_t t0 = (size_t)bn * 128 + half * 64;
#pragma unroll 4
        for (int it = c.tid; it < 64 * 320; it += NTHREADS) { const int r = it / 320, c4 = (it % 320) * 4; const size_t o = (t0 + r) * 1280 + c4;
            const u32x2 hw = *(const u32x2*)(HL + o), pw = *(const u32x2*)(PC + o), gw = *(const u32x2*)(gg + o); const f32x4 cr = *(const LAS f32x4*)(carry + c4);
            const float h0 = __uint_as_float(hw[0] << 16) + __uint_as_float(pw[0] << 16) * cr[0], h1 = __uint_as_float(hw[0] & 0xffff0000u) + __uint_as_float(pw[0] & 0xffff0000u) * cr[1];
            const float h2 = __uint_as_float(hw[1] << 16) + __uint_as_float(pw[1] << 16) * cr[2], h3 = __uint_as_float(hw[1] & 0xffff0000u) + __uint_as_float(pw[1] & 0xffff0000u) * cr[3];
            u32x2 ow; ow[0] = pk2(__uint_as_float(gw[0] << 16) * h0, __uint_as_float(gw[0] & 0xffff0000u) * h1); ow[1] = pk2(__uint_as_float(gw[1] << 16) * h2, __uint_as_float(gw[1] & 0xffff0000u) * h3);
            *(u32x2*)(ycat + (t0 + r) * CD_OUT + 1024 + c4) = ow; }
    }
}

template <bool MOE>
__device__ __forceinline__ void phase_ln(const Ctx& c, const float* g, const float* bta, float* xout) {
    float* x = (float*)(c.ws + WS_X); bf16_t* xb = (bf16_t*)(c.ws + WS_XB);
    const float* hbuf = (const float*)(c.ws + WS_H); const bf16_t* Y = (const bf16_t*)(c.ws + WS_U1);
    for (long tt = (long)c.gw * 2; tt < T; tt += (long)c.nwaves * 2) {
        f32x4 v[2][4];
#pragma unroll
        for (int u = 0; u < 2; ++u) { const long t = tt + u;
#pragma unroll
            for (int q = 0; q < 4; ++q) { const int col = q * 256 + c.lane * 4;
                f32x4 f;
                if (!MOE) f = *(const f32x4*)(hbuf + (size_t)t * D + col);
                else { f = (f32x4){0.f, 0.f, 0.f, 0.f};
#pragma unroll
                    for (int k = 0; k < 9; ++k) { const size_t srow = (k < 8) ? (size_t)t * 8 + k : (size_t)TK + t; const u32x2 w = *(const u32x2*)(Y + srow * D + col);
                        f[0] += __uint_as_float(w[0] << 16); f[1] += __uint_as_float(w[0] & 0xffff0000u); f[2] += __uint_as_float(w[1] << 16); f[3] += __uint_as_float(w[1] & 0xffff0000u); } }
                const f32x4 xv = *(const f32x4*)(x + (size_t)t * D + col);
                v[u][q] = xv * ALPHA + f; } }
#pragma unroll
        for (int u = 0; u < 2; ++u) { const long t = tt + u;
            float sm = 0.f;
#pragma unroll
            for (int q = 0; q < 4; ++q) sm += v[u][q][0] + v[u][q][1] + v[u][q][2] + v[u][q][3];
            const float mean = wave_sum(sm) * (1.f / 1024.f); float sq = 0.f;
#pragma unroll
            for (int q = 0; q < 4; ++q) { v[u][q] = v[u][q] - mean; sq += v[u][q][0] * v[u][q][0] + v[u][q][1] * v[u][q][1] + v[u][q][2] * v[u][q][2] + v[u][q][3] * v[u][q][3]; }
            const float rstd = rsqrtf(wave_sum(sq) * (1.f / 1024.f) + LN_EPS);
#pragma unroll
            for (int q = 0; q < 4; ++q) { const int col = q * 256 + c.lane * 4; const f32x4 gg = *(const f32x4*)(g + col), bb = *(const f32x4*)(bta + col);
                const f32x4 o = v[u][q] * rstd * gg + bb;
                *(f32x4*)(xout + (size_t)t * D + col) = o; if (xout != x) *(f32x4*)(x + (size_t)t * D + col) = o;
                u32x2 w; w[0] = pk2(o[0], o[1]); w[1] = pk2(o[2], o[3]); *(u32x2*)(xb + (size_t)t * D + col) = w; } }
    }
}

__device__ __forceinline__ void phase_ln_route(const Ctx& c, int L) {
    float* x = (float*)(c.ws + WS_X); bf16_t* xb = (bf16_t*)(c.ws + WS_XB); const float* hbuf = (const float*)(c.ws + WS_H);
    const float* g = c.in[19] + (size_t)L * D; const float* bta = c.in[20] + (size_t)L * D; const float* rb = c.in[22] + L * NE;
    const bf16_t* Wr = (const bf16_t*)(c.ws + WS_WRT) + (size_t)L * 256 * D;
    int* cnt = (int*)(c.ws + CTL_CNT) + L * NE * 1024; int* list = (int*)(c.ws + WS_LIST); float* gate = (float*)(c.ws + WS_GATE);
    LAS unsigned char* Xl = c.lds; LAS float* Sc = (LAS float*)c.lds;
    const int lane = c.lane, fr = lane & 15, fq = lane >> 4, w = c.wid;
    for (int grp = c.bid; grp < T / 64; grp += c.G) {
        __syncthreads();
        for (int q8 = 0; q8 < 8; q8 += 4) {
            f32x4 v[4][4];
#pragma unroll
            for (int u = 0; u < 4; ++u) { const size_t t = (size_t)grp * 64 + w * 8 + q8 + u;
#pragma unroll
                for (int q = 0; q < 4; ++q) { const int col = q * 256 + lane * 4; v[u][q] = *(const f32x4*)(x + t * D + col) * ALPHA + *(const f32x4*)(hbuf + t * D + col); } }
#pragma unroll
            for (int u = 0; u < 4; ++u) { const int rr = w * 8 + q8 + u; const size_t t = (size_t)grp * 64 + rr;
                float sm = 0.f;
#pragma unroll
                for (int q = 0; q < 4; ++q) sm += v[u][q][0] + v[u][q][1] + v[u][q][2] + v[u][q][3];
                const float mean = wave_sum(sm) * (1.f / 1024.f); float sq = 0.f;
#pragma unroll
                for (int q = 0; q < 4; ++q) { v[u][q] = v[u][q] - mean; sq += v[u][q][0] * v[u][q][0] + v[u][q][1] * v[u][q][1] + v[u][q][2] * v[u][q][2] + v[u][q][3] * v[u][q][3]; }
                const float rstd = rsqrtf(wave_sum(sq) * (1.f / 1024.f) + LN_EPS);
#pragma unroll
                for (int q = 0; q < 4; ++q) { const int col = q * 256 + lane * 4; const f32x4 o = v[u][q] * rstd * *(const f32x4*)(g + col) + *(const f32x4*)(bta + col);
                    *(f32x4*)(x + t * D + col) = o; u32x2 wv; wv[0] = pk2(o[0], o[1]); wv[1] = pk2(o[2], o[3]); *(u32x2*)(xb + t * D + col) = wv; *(LAS u32x2*)(Xl + rr * 2064 + col * 2) = wv; } } }
        __syncthreads();
        const int st = w & 3, eh = w >> 2;
        f32x4 acc[4];
#pragma unroll
        for (int ne = 0; ne < 4; ++ne) acc[ne] = (f32x4){0.f, 0.f, 0.f, 0.f};
#pragma unroll 8
        for (int ks = 0; ks < 32; ++ks) { const bf16x8 bop = *(const LAS bf16x8*)(Xl + (16 * st + fr) * 2064 + ks * 64 + fq * 16);
#pragma unroll
            for (int ne = 0; ne < 4; ++ne) { const bf16x8 aop = *(const bf16x8*)(Wr + (size_t)(64 * eh + 16 * ne + fr) * D + ks * 32 + fq * 8); acc[ne] = MFMA16(aop, bop, acc[ne]); } }
        __syncthreads();
#pragma unroll
        for (int ne = 0; ne < 4; ++ne) { f32x4 sg; for (int r = 0; r < 4; ++r) sg[r] = sigmoidf_(acc[ne][r]); *(LAS f32x4*)(Sc + (16 * st + fr) * 128 + 64 * eh + 16 * ne + 4 * fq) = sg; }
        __syncthreads();
        LAS int* hist = (LAS int*)(c.lds + 40960); LAS int* gbase = hist + 128; LAS int* sel = gbase + 128; LAS float* selg = (LAS float*)(sel + 512);
        if (c.tid < 128) hist[c.tid] = 0;
        __syncthreads();
        for (int q8 = 0; q8 < 8; ++q8) { const int rr = w * 8 + q8;
            const float s0 = Sc[rr * 128 + lane], s1 = Sc[rr * 128 + 64 + lane];
            float v0 = s0 + rb[lane], v1 = s1 + rb[64 + lane];
            float mysc = 0.f; int myexp = -1; float tot = 0.f;
            for (int k = 0; k < 8; ++k) {
                float bv = v0; int bi = lane; if (v1 > bv) { bv = v1; bi = lane + 64; }
#pragma unroll
                for (int o = 32; o; o >>= 1) { const float ov = __shfl_xor(bv, o); const int oi = __shfl_xor(bi, o); if (ov > bv || (ov == bv && oi < bi)) { bv = ov; bi = oi; } }
                const float sc = __shfl((bi & 64) ? s1 : s0, bi & 63);
                tot += sc;
                if (lane == k) { mysc = sc; myexp = bi; }
                if (lane == (bi & 63)) { if (bi & 64) v1 = -1e30f; else v0 = -1e30f; }
            }
            if (lane < 8) { const int lr = __hip_atomic_fetch_add(&hist[myexp], 1, __ATOMIC_RELAXED, __HIP_MEMORY_SCOPE_WORKGROUP); sel[rr * 8 + lane] = (myexp << 16) | lr; selg[rr * 8 + lane] = mysc / tot * 2.5f; } }
        __syncthreads();
        if (c.tid < 128) gbase[c.tid] = atomicAdd(&cnt[c.tid * 1024], hist[c.tid]);
        __syncthreads();
        { const int sv = sel[c.tid], e = sv >> 16, lr = sv & 0xffff; const int slot = (grp * 64 + (c.tid >> 3)) * 8 + (c.tid & 7);
          list[(size_t)e * LISTCAP + gbase[e] + lr] = slot; gate[slot] = selg[c.tid]; }
    }
}

struct MoeOrder {
    const char* Abase; const char* Bbase; size_t Bstride; int K, NT, NTG, total, G, c, mode;
    LAS int* tab; LAS int* desc;
    __device__ __forceinline__ bool next(int i, g8::Unit& u) const {
        const int ip = i / NTG, q = i - ip * NTG;
        const long L = (long)ip * G + c; if (L >= total || ip >= TAB_SLOTS) return false;
        const int d = desc[ip]; const int e = d >> 12, pn = (d & 15) * NTG + q;
        u.pm = (d >> 4) & 255; u.pn = pn; u.aux = ip; u.A = Abase; u.B = Bbase + (size_t)e * Bstride + (size_t)pn * 256 * K * 2; return true;
    }
    __device__ __forceinline__ void aoff(const g8::Unit& u, int tid, unsigned (&o)[2][2]) const {
#pragma unroll
        for (int i = 0; i < 2; ++i) { int R, C; g8::stage_rc(tid * 16 + i * 8192, R, C);
#pragma unroll
            for (int h = 0; h < 2; ++h) { int s = tab[u.aux * 256 + h * 128 + R]; s = s < 0 ? 0 : s; const int row = mode ? s : (s < TK ? (s >> 3) : s - TK);
                o[h][i] = (unsigned)(row * K + C) * 2u; } }
    }
};
__device__ __forceinline__ void moe_setup(const Ctx& c, MoeOrder& S, const int* cnt, int NT, int NTG) {
    LAS int* pref = (LAS int*)(c.lds + LDS_PREF); LAS int* desc = (LAS int*)(c.lds + LDS_DESC); LAS int* tab = (LAS int*)(c.lds + LDS_TAB);
    const int* list = (const int*)(c.ws + WS_LIST);
    if (c.tid < 64) { int nb[3]; int loc = 0;
#pragma unroll
        for (int q = 0; q < 3; ++q) { const int e = c.tid * 3 + q; int n = 0; if (e < NE) n = cnt[e * 1024]; else if (e == NE) n = T; nb[q] = (n + 255) >> 8; loc += nb[q]; }
        int inc = loc;
#pragma unroll
        for (int o = 1; o < 64; o <<= 1) { const int v = __shfl_up(inc, o); if (c.tid >= o) inc += v; }
        int acc = inc - loc;
#pragma unroll
        for (int q = 0; q < 3; ++q) { const int e = c.tid * 3 + q; if (e <= NE1) pref[e] = acc; acc += nb[q]; } }
    __syncthreads();
    const int NG = NT / NTG; const int total = pref[NE1] * NG;
    LAS float* gtab = (LAS float*)(c.lds + LDS_GTAB); const float* gate = (const float*)(c.ws + WS_GATE);
    S.NT = NT; S.NTG = NTG; S.total = total; S.G = c.G; S.c = c.bid; S.tab = tab; S.desc = desc;
    {
        int sv[TAB_SLOTS / 2];
#pragma unroll
        for (int k = 0; k < TAB_SLOTS / 2; ++k) { const int i = (c.tid >> 8) + 2 * k; sv[k] = -2;
            const long L = (long)i * c.G + c.bid;
            if (L < total) {
                int wgid = (int)L; { const int q = total / 8, r = total % 8, xcd = wgid % 8, off = wgid / 8; wgid = (xcd < r ? xcd * (q + 1) : r * (q + 1) + (xcd - r) * q) + off; }
                const int rbg = wgid / NG, pn = wgid % NG;
                int lo = 0, hi = NE1;
                while (hi - lo > 1) { const int mid = (lo + hi) >> 1; if (pref[mid] <= rbg) lo = mid; else hi = mid; }
                const int e = lo, rb = rbg - pref[e], n = e < NE ? cnt[e * 1024] : T;
                if ((c.tid & 255) == 0) desc[i] = (e << 12) | (rb << 4) | pn;
                const int r = rb * 256 + (c.tid & 255); sv[k] = -1; if (r < n) sv[k] = (e < NE) ? list[(size_t)e * LISTCAP + r] : TK + r; } }
#pragma unroll
        for (int k = 0; k < TAB_SLOTS / 2; ++k) { const int i = (c.tid >> 8) + 2 * k; if (sv[k] != -2) { tab[i * 256 + (c.tid & 255)] = sv[k]; if (S.mode) gtab[i * 256 + (c.tid & 255)] = sv[k] >= 0 ? gate[sv[k]] : 0.f; } }
    }
    __syncthreads();
}
struct EpiMoeGU {
    static constexpr bool PERM = true;
    bf16_t* H; LAS int* tab;
    __device__ __forceinline__ void operator()(const f32x4 (&acc)[2][2][4][2], const g8::Unit& u, int wr, int wc, int fr, int fq) const {
#pragma unroll
        for (int ai = 0; ai < 2; ++ai)
#pragma unroll
            for (int m = 0; m < 4; ++m) { const int r = ai * 128 + wr * 64 + m * 16 + fr; const int s = tab[u.aux * 256 + r];
                if (s >= 0) { u32x4 w;
#pragma unroll
                    for (int n = 0; n < 2; ++n) { const f32x4 g = acc[ai][0][m][n], up = acc[ai][1][m][n];
                        w[2 * n] = pk2(siluf_(g[0]) * up[0], siluf_(g[1]) * up[1]); w[2 * n + 1] = pk2(siluf_(g[2]) * up[2], siluf_(g[3]) * up[3]); }
                    *(u32x4*)(H + (size_t)s * ED + u.pn * 128 + wc * 32 + fq * 8) = w; } }
    }
};
struct EpiMoeDN {
    static constexpr bool PERM = true;
    bf16_t* Y; LAS float* gtab; LAS int* tab;
    __device__ __forceinline__ void operator()(const f32x4 (&acc)[2][2][4][2], const g8::Unit& u, int wr, int wc, int fr, int fq) const {
#pragma unroll
        for (int ai = 0; ai < 2; ++ai)
#pragma unroll
            for (int m = 0; m < 4; ++m) { const int r = ai * 128 + wr * 64 + m * 16 + fr; const int s = tab[u.aux * 256 + r];
                if (s >= 0) { const float gt = gtab[u.aux * 256 + r];
#pragma unroll
                    for (int bj = 0; bj < 2; ++bj) { u32x4 w;
#pragma unroll
                        for (int n = 0; n < 2; ++n) { const f32x4 a = acc[ai][bj][m][n] * gt; w[2 * n] = pk2(a[0], a[1]); w[2 * n + 1] = pk2(a[2], a[3]); }
                        *(u32x4*)(Y + (size_t)s * D + u.pn * 256 + bj * 128 + wc * 32 + fq * 8) = w; } } }
    }
};
__device__ __forceinline__ void phase_moe_gu(const Ctx& c, int L) {
    MoeOrder S; S.Abase = (const char*)(c.ws + WS_XB); S.Bbase = (const char*)(c.ws + WS_WGU) + (size_t)L * NE1 * 512 * D * 2; S.Bstride = (size_t)512 * D * 2; S.K = D; S.mode = 0;
    moe_setup(c, S, (const int*)(c.ws + CTL_CNT) + L * NE * 1024, 2, 1);
    EpiMoeGU E{(bf16_t*)(c.ws + WS_HID), S.tab};
    g8::gemm_phase<EpiMoeGU, MoeOrder>(c.lds + LDS_STAGE, D, S, E);
}
__device__ __forceinline__ void phase_moe_dn(const Ctx& c, int L) {
    MoeOrder S; S.Abase = (const char*)(c.ws + WS_HID); S.Bbase = (const char*)(c.ws + WS_WDN) + (size_t)L * NE1 * D * ED * 2; S.Bstride = (size_t)D * ED * 2; S.K = ED; S.mode = 1;
    moe_setup(c, S, (const int*)(c.ws + CTL_CNT) + L * NE * 1024, 4, 2);
    EpiMoeDN E{(bf16_t*)(c.ws + WS_U1), (LAS float*)(c.lds + LDS_GTAB), S.tab};
    g8::gemm_phase<EpiMoeDN, MoeOrder>(c.lds + LDS_STAGE, ED, S, E);
}

constexpr int PH_PER_LAYER = 9;
constexpr int N_PHASES = 1 + 4 * PH_PER_LAYER;

__global__ void __launch_bounds__(NTHREADS, 2) fwd_kernel(Params p) {
    extern __shared__ __attribute__((aligned(16))) unsigned char lds_raw[];
    LAS unsigned char* const lds0 = (LAS unsigned char*)lds_raw;
    volatile LAS unsigned* misc = (volatile LAS unsigned*)(lds0 + LDS_MISC);
    if (threadIdx.x < 4) misc[threadIdx.x] = 0u;
    __syncthreads();
    const int lo = p.ph_lo, hi = p.ph_hi;
    XcdBarrier bar; bar.bar = (unsigned*)(p.ws + WS_CTL); bar.x = 0; bar.st = misc;
    if (hi - lo > 1) bar = xcd_barrier_post((unsigned*)(p.ws + WS_CTL), misc);
#define MKCTX() Ctx c; { int tid_ = threadIdx.x; asm volatile("" : "+v"(tid_)); int bid_ = blockIdx.x; asm volatile("" : "+s"(bid_)); unsigned long long ws_ = (unsigned long long)p.ws; asm volatile("" : "+s"(ws_)); \
        c.in = p.in; c.out = p.out; c.ws = (unsigned char*)ws_; c.lds = lds0; c.tid = tid_; c.lane = tid_ & 63; c.wid = __builtin_amdgcn_readfirstlane(tid_ >> 6); c.bid = bid_; c.G = gridDim.x; \
        c.gtid = c.bid * NTHREADS + c.tid; c.gthreads = c.G * NTHREADS; c.gw = c.bid * 8 + c.wid; c.nwaves = c.G * 8; } unsigned char* const ws = c.ws; (void)ws
    int id = 0;
#ifndef PMASK
#define PMASK 0xffffffffu
#endif
#ifndef DUPMASK
#define DUPMASK 0u
#endif
#define PHASE(k, body) do { if (((PMASK >> (k)) & 1u) && lo <= id && id < hi) { MKCTX(); body; if ((DUPMASK >> (k)) & 1u) { body; } if (id + 1 < hi) xcd_barrier(bar); } ++id; } while (0)
    PHASE(0, phase_convert(c));
#pragma unroll 1
    for (int L = 0; L < 4; ++L) {
        const int j = L >> 1; const bool cd = (L & 1);
        if (cd) {
            PHASE(1, phase_cd_inproj(c, j));
        } else {
            PHASE(2, phase_ab_inproj(c, j));
        }
        if (!cd) { PHASE(3, phase_ab_p1(c)); PHASE(4, phase_ab_p2(c, j)); PHASE(16, phase_ab_p3(c)); }
        else     { PHASE(5, phase_cd_p1(c, j)); PHASE(15, phase_cd_scan2(c)); id += 1; }
        {
            const size_t Woff = cd ? WS_WCDOUT + (size_t)j * D * CD_OUT * 2 : WS_WABOUT + (size_t)j * D * AB_OUT * 2;
            const int K = cd ? CD_OUT : AB_OUT; const float* bias = cd ? p.in[18] + (size_t)j * D : p.in[5] + (size_t)j * D;
            PHASE(8, phase_dense(c, (const bf16_t*)(ws + WS_YCAT), (const bf16_t*)(ws + Woff), T, D, K, (float*)(ws + WS_H), D, bias));
        }
        PHASE(9, phase_ln_route(c, L));
        PHASE(12, phase_moe_gu(c, L));
        PHASE(13, phase_moe_dn(c, L));
        PHASE(14, phase_ln<true>(c, p.in[29] + (size_t)L * D, p.in[30] + (size_t)L * D, L == 3 ? p.out : (float*)(ws + WS_X)));
    }
#undef PHASE
}

extern "C" void kernel_launch(void* const* d_in, const int* in_sizes, int n_in, void* d_out, int out_size, void* d_ws, size_t ws_size, hipStream_t stream) {
    static int grid = 0;
    if (grid == 0) {
        if (n_in != 31 || out_size != T * D || ws_size < WS_END) { fprintf(stderr, "kernel_launch: unexpected shapes (n_in %d out %d ws %zu need %zu)\n", n_in, out_size, ws_size, (size_t)WS_END); grid = -1; return; }
        int dev = 0, cus = 0, per_cu = 0;
        if (hipGetDevice(&dev) != hipSuccess || hipDeviceGetAttribute(&cus, hipDeviceAttributeMultiprocessorCount, dev) != hipSuccess) { grid = -1; return; }
        if (hipFuncSetAttribute((const void*)fwd_kernel, hipFuncAttributeMaxDynamicSharedMemorySize, LDS_BYTES) != hipSuccess) { fprintf(stderr, "kernel_launch: hipFuncSetAttribute failed\n"); grid = -1; return; }
        if (hipOccupancyMaxActiveBlocksPerMultiprocessor(&per_cu, (const void*)fwd_kernel, NTHREADS, LDS_BYTES) != hipSuccess || per_cu < 1) fprintf(stderr, "kernel_launch: occupancy query says %d\n", per_cu);
        (void)hipGetLastError();
        grid = cus;
    }
    if (grid < 0) return;
    (void)hipMemsetAsync((char*)d_ws + WS_CTL, 0, CTL_BYTES, stream);
    Params p{};
    for (int i = 0; i < 31; ++i) p.in[i] = (const float*)d_in[i];
    p.out = (float*)d_out; p.ws = (unsigned char*)d_ws;
#if N_LAUNCH_MODE == 1
    p.ph_lo = 0; p.ph_hi = N_PHASES;
    hipLaunchKernelGGL(fwd_kernel, dim3(grid), dim3(NTHREADS), LDS_BYTES, stream, p);
#else
    for (int i = 0; i < N_PHASES; ++i) { p.ph_lo = i; p.ph_hi = i + 1; hipLaunchKernelGGL(fwd_kernel, dim3(grid), dim3(NTHREADS), LDS_BYTES, stream, p); }
#endif
}
```

```cpp
#include <hip/hip_runtime.h>
#include <cstdio>
#include <cstdint>

#define LAS __attribute__((address_space(3)))
typedef unsigned short bf16_t;
typedef short bf16x8 __attribute__((ext_vector_type(8)));
typedef float f32x4 __attribute__((ext_vector_type(4)));
typedef float f32x2 __attribute__((ext_vector_type(2)));
typedef unsigned u32x4 __attribute__((ext_vector_type(4)));
typedef unsigned u32x2 __attribute__((ext_vector_type(2)));

constexpr int T = 16384, D = 1024, SEQ = 8192;
constexpr int AB_IN = 4352, AB_OUT = 2048, CD_IN = 4608, CD_OUT = 2304;
constexpr int NE = 128, NE1 = 129, TOPK = 8, ED = 256;
constexpr int TK = T * TOPK;
constexpr int NSLOT = TK + T;
constexpr int LISTCAP = 16384;
constexpr float ALPHA = 1.681792830507429f;
constexpr float LN_EPS = 1e-5f;

#ifndef N_LAUNCH_MODE
#define N_LAUNCH_MODE 1
#endif

constexpr size_t al256(size_t x) { return (x + 255) & ~(size_t)255; }
constexpr size_t WS_CTL    = 0;
constexpr size_t CTL_BYTES = 65536 + (size_t)4 * 128 * 4096;
constexpr size_t CTL_CNT   = 65536;
constexpr size_t WS_WABIN  = CTL_BYTES;
constexpr size_t WS_WABOUT = WS_WABIN  + al256((size_t)2 * AB_IN * D * 2);
constexpr size_t WS_WCDIN  = WS_WABOUT + al256((size_t)2 * D * AB_OUT * 2);
constexpr size_t WS_WCDOUT = WS_WCDIN  + al256((size_t)2 * CD_IN * D * 2);
constexpr size_t WS_WRT    = WS_WCDOUT + al256((size_t)2 * D * CD_OUT * 2);
constexpr size_t WS_WGU    = WS_WRT    + al256((size_t)4 * 256 * D * 2);
constexpr size_t WS_WDN    = WS_WGU    + al256((size_t)4 * NE1 * 512 * D * 2);
constexpr size_t WS_X      = WS_WDN    + al256((size_t)4 * NE1 * D * ED * 2);
constexpr size_t WS_XB     = WS_X      + al256((size_t)T * D * 4);
constexpr size_t WS_U1     = WS_XB     + al256((size_t)T * D * 2);
constexpr size_t U1_BYTES  = al256((size_t)NSLOT * D * 2) > al256((size_t)T * CD_IN * 4) ? al256((size_t)NSLOT * D * 2) : al256((size_t)T * CD_IN * 4);
constexpr size_t WS_U2     = WS_U1     + U1_BYTES;
constexpr size_t U2_BYTES  = al256((size_t)T * 1280 * 4 * 3);
constexpr size_t WS_YCAT   = WS_U2     + U2_BYTES;
constexpr size_t WS_H      = WS_YCAT   + al256((size_t)T * CD_OUT * 2);
constexpr size_t WS_ZR     = WS_H      + al256((size_t)T * D * 4);
constexpr size_t WS_HID    = WS_ZR     + al256((size_t)T * 256 * 4);
constexpr size_t WS_LIST   = WS_HID    + al256((size_t)NSLOT * ED * 2);
constexpr size_t WS_GATE   = WS_LIST   + al256((size_t)NE * LISTCAP * 4);
constexpr size_t WS_ROPEA  = WS_GATE   + al256((size_t)NSLOT * 4);
constexpr size_t WS_ROPER  = WS_ROPEA  + al256((size_t)SEQ * 32 * 8);
constexpr size_t WS_BIASP  = WS_ROPER  + al256((size_t)SEQ * 64 * 8);
constexpr size_t WS_WLRU   = WS_BIASP  + al256((size_t)2 * AB_IN * 4);
constexpr size_t WS_SPL    = WS_WLRU   + al256((size_t)2 * 5 * 2 * 65536 * 2);
constexpr size_t WS_END    = WS_SPL    + al256((size_t)2 * 1280 * 4);
constexpr size_t CD_GU = WS_U1, CD_GVT = WS_U1 + 32 * (1024 * 1024), CD_GG = WS_U1 + 64 * (1024 * 1024), CD_XR = WS_U1 + 104 * (1024 * 1024), CD_STATS = WS_U1 + 144 * (1024 * 1024);
constexpr size_t MB = 1024 * 1024;
constexpr size_t AB_QB = WS_U1, AB_KB = WS_U1 + 32 * MB, AB_VT = WS_U1 + 36 * MB, AB_RQB = WS_U1 + 40 * MB, AB_RKB = WS_U1 + 56 * MB, AB_RKDT = WS_U1 + 72 * MB,
                 AB_RVT = WS_U1 + 88 * MB, AB_RGB = WS_U1 + 120 * MB, AB_KV = WS_U1 + 152 * MB  , AB_SPREV = WS_U1 + 216 * MB  ;
static_assert(AB_SPREV + 32 * MB <= WS_U1 + U1_BYTES, "U1 map");

__device__ __forceinline__ float bf2f(bf16_t b) { return __uint_as_float(((unsigned)b) << 16); }
__device__ __forceinline__ bf16_t f2bf(float f) { unsigned u = __float_as_uint(f); u += 0x7FFFu + ((u >> 16) & 1u); return (bf16_t)(u >> 16); }
__device__ __forceinline__ unsigned pk2(float lo, float hi) { return (unsigned)f2bf(lo) | ((unsigned)f2bf(hi) << 16); }
__device__ __forceinline__ float wave_sum(float v) {
#pragma unroll
    for (int o = 32; o; o >>= 1) v += __shfl_xor(v, o);
    return v; }
__device__ __forceinline__ float wave_max(float v) {
#pragma unroll
    for (int o = 32; o; o >>= 1) v = fmaxf(v, __shfl_xor(v, o));
    return v; }
__device__ __forceinline__ float gelu_tanh(float x) { const float u = 0.7978845608028654f * (x + 0.044715f * x * x * x); return 0.5f * x * (1.f + tanhf(u)); }
__device__ __forceinline__ float sigmoidf_(float x) { return 1.f / (1.f + __expf(-x)); }
__device__ __forceinline__ float siluf_(float x) { return x * __builtin_amdgcn_rcpf(1.f + __expf(-x)); }

#define XB_TMO      128
#define XB_XCNT(j)  (256  + 64 * (j))
#define XB_XSUB(j)  (1280 + 64 * (j))
#define XB_XGEN(j)  (2304 + 64 * (j))
#define XB_TOP      3328
#define XB_TOPGEN   3392
#define XCD_BAR_WORDS 3456
#define XB_SPIN_CAP (1u << 22)

__device__ __forceinline__ unsigned xb_ld(unsigned* p)              { return __hip_atomic_load(p, __ATOMIC_RELAXED, __HIP_MEMORY_SCOPE_AGENT); }
__device__ __forceinline__ unsigned xb_add(unsigned* p, unsigned v) { return __hip_atomic_fetch_add(p, v, __ATOMIC_RELAXED, __HIP_MEMORY_SCOPE_AGENT); }
__device__ __forceinline__ unsigned xb_xcc_id() { return (unsigned)__builtin_amdgcn_s_getreg((3 << 11) | 20) & 0xFu; }
#define XB_SPIN(cond, bar) do { unsigned _sp = 0; while (cond) { __builtin_amdgcn_s_sleep(1); \
    if ((++_sp & 255u) == 0u) { if (xb_ld(&(bar)[XB_TMO])) break; if (_sp > XB_SPIN_CAP) { atomicAdd(&(bar)[XB_TMO], 1u); break; } } } } while (0)

struct XcdBarrier { unsigned* bar; unsigned x; volatile LAS unsigned* st; };

__device__ __forceinline__ XcdBarrier xcd_barrier_post(unsigned* bar, volatile LAS unsigned* st) {
    XcdBarrier b; b.bar = bar; b.x = xb_xcc_id(); b.st = st;
    if (threadIdx.x == 0) (void)xb_add(&bar[XB_XCNT(b.x)], 1u);
    return b;
}
__device__ __forceinline__ void xcd_barrier_complete(unsigned* bar, unsigned x, unsigned& nloc, unsigned& nx) {
    const unsigned G = gridDim.x * gridDim.y * gridDim.z;
    unsigned sum, cnt, mine, sp = 0u;
    for (;;) {
        sum = 0u; cnt = 0u; mine = 0u;
#pragma unroll
        for (unsigned j = 0; j < 16; ++j) { const unsigned c = xb_ld(&bar[XB_XCNT(j)]); sum += c; cnt += (c > 0u) ? 1u : 0u; mine = (j == x) ? c : mine; }
        if (sum == G) break;
        __builtin_amdgcn_s_sleep(1);
        if ((++sp & 255u) == 0u) { if (xb_ld(&bar[XB_TMO])) break; if (sp > XB_SPIN_CAP) { atomicAdd(&bar[XB_TMO], 1u); break; } }
    }
    nloc = mine > 0u ? mine : 1u; nx = cnt > 0u ? cnt : 1u;
}
__device__ __forceinline__ void xcd_barrier(const XcdBarrier& b) {
    asm volatile("s_waitcnt vmcnt(0)" ::: "memory");
    __syncthreads();
    if (threadIdx.x == 0) {
        unsigned* bar = b.bar;
        __builtin_amdgcn_s_waitcnt(0);
        unsigned nloc = b.st[0], nx = b.st[1];
        if (nloc == 0u) { xcd_barrier_complete(bar, b.x, nloc, nx); b.st[0] = nloc; b.st[1] = nx; }
        const unsigned old = xb_add(&bar[XB_XSUB(b.x)], 1u);
        const unsigned gen = old / nloc;
        if (old + 1u == (gen + 1u) * nloc) {
            __builtin_amdgcn_fence(__ATOMIC_RELEASE, "agent");
            asm volatile("s_waitcnt vmcnt(0)" ::: "memory");
            const unsigned og = xb_add(&bar[XB_TOP], 1u);
            const unsigned tg = og / nx;
            if (og + 1u == (tg + 1u) * nx) xb_add(&bar[XB_TOPGEN], 1u);
            else XB_SPIN(xb_ld(&bar[XB_TOPGEN]) == tg, bar);
            __builtin_amdgcn_fence(__ATOMIC_ACQUIRE, "agent");
            xb_add(&bar[XB_XGEN(b.x)], 1u);
            asm volatile("s_waitcnt vmcnt(0)" ::: "memory");
        } else {
            XB_SPIN(xb_ld(&bar[XB_XGEN(b.x)]) == gen, bar);
            __builtin_amdgcn_fence(__ATOMIC_ACQUIRE, "agent");
            asm volatile("s_waitcnt vmcnt(0)" ::: "memory");
        }
    }
    __syncthreads();
}

namespace g8 {
constexpr int BM = 256, BK = 64, HALF = 128, HTB = HALF * BK * 2, STAGE_BYTES = 8 * HTB, NXCD = 8, WGM = 8;
__device__ __forceinline__ int lds_byte(int r, int c) { const int st = (r >> 4) * 2 + (c >> 5), rr = r & 15, cc = c & 31, ob = rr * 64 + cc * 2; return st * 1024 + (ob ^ (((ob >> 9) & 1) << 5)); }
__device__ __forceinline__ void stage_rc(int b, int& R, int& C) { const int st = b / 1024, sb = b % 1024, swz = sb ^ (((sb >> 9) & 1) << 5); R = (st >> 1) * 16 + swz / 64; C = (st & 1) * 32 + (swz % 64) / 2; }
__device__ __forceinline__ int perm32(int rho) { const int n = rho >> 4, i = rho & 15; return 8 * (i >> 2) + 4 * n + (i & 3); }

struct Unit { const char* A; const char* B; int pm, pn, aux; };

struct DenseOrder {
    const char* A; const char* Bt; int nM, nN, nwg, G, c, K;
    __device__ void init(const void* A_, const void* Bt_, int M, int N, int K_, int G_, int c_) { A = (const char*)A_; Bt = (const char*)Bt_; nM = M / BM; nN = N / BM; nwg = nM * nN; G = G_; c = c_; K = K_; }
    __device__ __forceinline__ bool next(int i, Unit& u) const {
        const long L = (long)i * G + c; if (L >= nwg) return false;
        int wgid = (int)L; { const int q = nwg / NXCD, r = nwg % NXCD, xcd = wgid % NXCD, off = wgid / NXCD; wgid = (xcd < r ? xcd * (q + 1) : r * (q + 1) + (xcd - r) * q) + off; }
        const int nig = WGM * nN, gid = wgid / nig, fm = gid * WGM, gsz = (nM - fm) < WGM ? (nM - fm) : WGM;
        u.pm = fm + ((wgid % nig) % gsz); u.pn = (wgid % nig) / gsz; u.aux = 0;
        u.A = A + (size_t)u.pm * BM * K * 2; u.B = Bt + (size_t)u.pn * BM * K * 2; return true;
    }
    __device__ __forceinline__ void aoff(const Unit&, int tid, unsigned (&o)[2][2]) const {
#pragma unroll
        for (int i = 0; i < 2; ++i) { int R, C; stage_rc(tid * 16 + i * 8192, R, C);
            o[0][i] = (unsigned)(R * K + C) * 2u; o[1][i] = (unsigned)((R + HALF) * K + C) * 2u; }
    }
};

__device__ __forceinline__ unsigned cvt_pk_bf16(float lo, float hi) { unsigned r; asm volatile("v_cvt_pk_bf16_f32 %0, %1, %2" : "=v"(r) : "v"(lo), "v"(hi)); return r; }

struct EpiF32 {
    static constexpr bool PERM = false;
    float* C; int ldc; const float* bias;
    __device__ __forceinline__ void operator()(const f32x4 (&acc)[2][2][4][2], const Unit& u, int wr, int wc, int fr, int fq) const {
        const int row0 = u.pm * BM + wr * 64 + fr, col0 = u.pn * BM + wc * 32 + 4 * fq;
        f32x4 bv[2][2];
#pragma unroll
        for (int bj = 0; bj < 2; ++bj)
#pragma unroll
            for (int n = 0; n < 2; ++n) bv[bj][n] = bias ? *(const f32x4*)(bias + col0 + bj * HALF + n * 16) : (f32x4){0.f, 0.f, 0.f, 0.f};
#pragma unroll
        for (int ai = 0; ai < 2; ++ai)
#pragma unroll
            for (int m = 0; m < 4; ++m) { float* rowp = C + (size_t)(row0 + ai * HALF + m * 16) * ldc + col0;
#pragma unroll
                for (int bj = 0; bj < 2; ++bj)
#pragma unroll
                    for (int n = 0; n < 2; ++n) *(f32x4*)(rowp + bj * HALF + n * 16) = acc[ai][bj][m][n] + bv[bj][n]; }
    }
};

template <class Epi, class Sched>
__device__ __forceinline__ void gemm_phase(LAS unsigned char* lds, const int K, const Sched& S, const Epi& E) {
    int tid_ = threadIdx.x; asm volatile("" : "+v"(tid_));
    const int tid = tid_, wid = __builtin_amdgcn_readfirstlane(tid >> 6), lane = tid & 63, wr = wid >> 2, wc = wid & 3, fr = lane & 15, fq = lane >> 4;
    const int nt = K / BK;
    unsigned voffB[2];
#pragma unroll
    for (int i = 0; i < 2; ++i) { int R, C; stage_rc(tid * 16 + i * 8192, R, C); const int Rb = Epi::PERM ? ((R & ~31) + perm32(R & 31)) : R;
        voffB[i] = (unsigned)(Rb * K + C) * 2u; }
    const size_t kstep = (size_t)(BK * 2);
    const size_t hstep = (size_t)HALF * K * 2;
    const unsigned ldsw = (unsigned)wid * 1024u;
    const int aoff = lds_byte(wr * 64 + fr, fq * 8), boff = lds_byte(wc * 32 + fr, fq * 8);
#define G8_SA(b, h) (((b) * 2 + (h)) * HTB)
#define G8_SB(b, h) ((4 + (b) * 2 + (h)) * HTB)
#define G8_STAGE(bufoff, gbase, voff) do { _Pragma("unroll") for (int _i = 0; _i < 2; ++_i) \
        __builtin_amdgcn_global_load_lds((const unsigned*)((const char*)(gbase) + (voff)[_i]), (LAS unsigned*)(lds + (bufoff) + ldsw + _i * 8192), 16, 0, 0); } while (0)
#define G8_LDA(dst, b, h) do { _Pragma("unroll") for (int m = 0; m < 4; ++m) _Pragma("unroll") for (int k = 0; k < 2; ++k) dst[m][k] = *(const LAS bf16x8*)(lds + G8_SA(b, h) + aoff + m * 2048 + k * 1024); } while (0)
#define G8_LDB(dst, b, h) do { _Pragma("unroll") for (int n = 0; n < 2; ++n) _Pragma("unroll") for (int k = 0; k < 2; ++k) dst[n][k] = *(const LAS bf16x8*)(lds + G8_SB(b, h) + boff + n * 2048 + k * 1024); } while (0)
#define G8_MMA(ai, bj, At, Bt) do { __builtin_amdgcn_s_setprio(1); _Pragma("unroll") for (int m = 0; m < 4; ++m) _Pragma("unroll") for (int n = 0; n < 2; ++n) _Pragma("unroll") for (int k = 0; k < 2; ++k) \
        acc[ai][bj][m][n] = __builtin_amdgcn_mfma_f32_16x16x32_bf16(Bt[n][k], At[m][k], acc[ai][bj][m][n], 0, 0, 0); __builtin_amdgcn_s_setprio(0); } while (0)
#define G8_WAIT_V(n) asm volatile("s_waitcnt vmcnt(" #n ")" ::: "memory")
#define G8_WAIT_L(n) asm volatile("s_waitcnt lgkmcnt(" #n ")" ::: "memory")
#define G8_BAR __builtin_amdgcn_s_barrier()
#define G8_SCHED __builtin_amdgcn_sched_barrier(0)
    Unit cur, nxt; int ui = 0;
    if (!S.next(0, cur)) return;
    f32x4 acc[2][2][4][2];
#pragma unroll
    for (int a = 0; a < 2; ++a)
#pragma unroll
        for (int b = 0; b < 2; ++b)
#pragma unroll
            for (int m = 0; m < 4; ++m)
#pragma unroll
                for (int n = 0; n < 2; ++n) acc[a][b][m][n] = (f32x4){0.f, 0.f, 0.f, 0.f};
    bf16x8 At[4][2], B0[2][2], B1[2][2];
    unsigned oc[2][2];
    S.aoff(cur, tid, oc);
    const char* cA = cur.A; const char* cB = cur.B;
    G8_STAGE(G8_SB(0, 0), cB, voffB); G8_STAGE(G8_SA(0, 0), cA, oc[0]); G8_STAGE(G8_SB(0, 1), cB + hstep, voffB); G8_STAGE(G8_SA(0, 1), cA, oc[1]);
    if (wr == 1) G8_BAR;
    G8_WAIT_V(4); G8_BAR;
    G8_STAGE(G8_SB(1, 0), cB + kstep, voffB); G8_STAGE(G8_SA(1, 0), cA + kstep, oc[0]); G8_STAGE(G8_SB(1, 1), cB + hstep + kstep, voffB);
    G8_WAIT_V(6); G8_BAR;
    for (;;) {
        const bool has_next = S.next(ui + 1, nxt);
        const char* nA = has_next ? nxt.A : cA; const char* nB = has_next ? nxt.B : cB;
#pragma unroll 1
        for (int t = 0; t < nt; t += 2) {
            const bool last = (t == nt - 2);
            const char* a1 = cA + (size_t)(t + 1) * kstep;
            const char* a2 = last ? nA : cA + (size_t)(t + 2) * kstep; const char* b2 = last ? nB : cB + (size_t)(t + 2) * kstep;
            const char* a3 = a2 + kstep; const char* b3 = b2 + kstep;
            G8_LDB(B0, 0, 0); G8_SCHED; G8_LDA(At, 0, 0); G8_STAGE(G8_SA(1, 1), a1, oc[1]);
            if (last && has_next) S.aoff(nxt, tid, oc);
            G8_WAIT_L(8); G8_BAR; G8_WAIT_L(0); G8_MMA(0, 0, At, B0); G8_BAR; G8_SCHED;
            G8_LDB(B1, 0, 1); G8_STAGE(G8_SB(0, 0), b2, voffB);
            G8_BAR; G8_WAIT_L(0); G8_MMA(0, 1, At, B1); G8_BAR;
            G8_LDA(At, 0, 1); G8_STAGE(G8_SA(0, 0), a2, oc[0]);
            G8_BAR; G8_WAIT_L(0); G8_MMA(1, 0, At, B0); G8_BAR; G8_SCHED;
            G8_STAGE(G8_SB(0, 1), b2 + hstep, voffB);
            G8_WAIT_V(6); G8_BAR; G8_MMA(1, 1, At, B1); G8_BAR;
            G8_LDB(B0, 1, 0); G8_SCHED; G8_LDA(At, 1, 0); G8_STAGE(G8_SA(0, 1), a2, oc[1]);
            G8_WAIT_L(8); G8_BAR; G8_WAIT_L(0); G8_MMA(0, 0, At, B0); G8_BAR; G8_SCHED;
            G8_LDB(B1, 1, 1); G8_STAGE(G8_SB(1, 0), b3, voffB);
            G8_BAR; G8_WAIT_L(0); G8_MMA(0, 1, At, B1); G8_BAR;
            G8_LDA(At, 1, 1); G8_STAGE(G8_SA(1, 0), a3, oc[0]);
            G8_BAR; G8_WAIT_L(0); G8_MMA(1, 0, At, B0); G8_BAR; G8_SCHED;
            G8_STAGE(G8_SB(1, 1), b3 + hstep, voffB);
            G8_WAIT_V(6); G8_BAR; G8_MMA(1, 1, At, B1); G8_BAR;
        }
        E(acc, cur, wr, wc, fr, fq);
        if (!has_next) break;
#pragma unroll
        for (int a = 0; a < 2; ++a)
#pragma unroll
            for (int b = 0; b < 2; ++b)
#pragma unroll
                for (int m = 0; m < 4; ++m)
#pragma unroll
                    for (int n = 0; n < 2; ++n) acc[a][b][m][n] = (f32x4){0.f, 0.f, 0.f, 0.f};
        cur = nxt; cA = nA; cB = nB; ++ui;
    }
    G8_WAIT_V(0);
    if (wr == 0) G8_BAR;
    G8_BAR;
#undef G8_SA
#undef G8_SB
#undef G8_STAGE
#undef G8_LDA
#undef G8_LDB
#undef G8_MMA
#undef G8_WAIT_V
#undef G8_WAIT_L
#undef G8_BAR
#undef G8_SCHED
}
}

constexpr int NTHREADS = 512;
constexpr int LDS_STAGE = 0;
constexpr int LDS_TAB   = g8::STAGE_BYTES;
constexpr int TAB_SLOTS = 6;
constexpr int LDS_GTAB  = LDS_TAB + TAB_SLOTS * 256 * 4;
constexpr int LDS_DESC  = LDS_GTAB + TAB_SLOTS * 256 * 4;
constexpr int LDS_PREF  = LDS_DESC + 64;
constexpr int LDS_MISC  = LDS_PREF + 132 * 4 + 48;
constexpr int LDS_BYTES = 147456;
static_assert(LDS_MISC % 16 == 0 && LDS_MISC + 64 <= LDS_BYTES, "LDS map");

struct Params { const float* in[31]; float* out; unsigned char* ws; int ph_lo, ph_hi; };

struct Ctx {
    const float* const* in; float* out; unsigned char* ws; LAS unsigned char* lds;
    int tid, lane, wid, bid, G, gtid, gthreads, gw, nwaves;
};

__device__ __forceinline__ int ab_phys(int n) {
    if (n < 1024) { const int hd = n >> 6, jj = n & 63; return (hd >> 2) * 256 + (jj >> 5) * 128 + (hd & 3) * 32 + (jj & 31); }
    if (n < 1152) { const int nn = n - 1024, hh = nn >> 6, jj = nn & 63; return 1024 + (jj >> 5) * 128 + hh * 32 + (jj & 31); }
    if (n < 1280) { const int vv = n - 1152; return 1024 + (vv >> 6) * 128 + 64 + (vv & 63); }
    if (n < 2304) { const int base = n < 1792 ? 1280 : 1792, nn = n - base, h = nn >> 7, jj = nn & 127; return base + (h >> 1) * 256 + (jj >> 6) * 128 + (h & 1) * 64 + (jj & 63); }
    return n;
}
template <int TN, class DstFn>
__device__ __forceinline__ void convert_T(const Ctx& c, const float* src, int nmat, int K, int N, DstFn dstfn) {
    LAS float* tile = (LAS float*)(c.lds);
    constexpr int LDT = TN + 1, TPR = TN / 4  , KPI = NTHREADS / TPR  , NI = 64 / KPI, KPT = 64 * TN / NTHREADS  ;
    const int tk = K / 64, tn = N / TN; const long ntiles = (long)nmat * tk * tn;
    for (long tix = c.bid; tix < ntiles; tix += c.G) {
        const int m = (int)(tix / (tk * tn)); const int rem = (int)(tix % (tk * tn)); const int kt = rem / tn, nt = rem % tn;
        const float* s = src + (size_t)m * K * N + (size_t)(kt * 64) * N + nt * TN;
        f32x4 v[NI];
#pragma unroll
        for (int i = 0; i < NI; ++i) { const int k = c.tid / TPR + KPI * i, n4 = (c.tid % TPR) * 4; v[i] = __builtin_nontemporal_load((const f32x4*)(s + (size_t)k * N + n4)); }
#pragma unroll
        for (int i = 0; i < NI; ++i) { const int k = c.tid / TPR + KPI * i, n4 = (c.tid % TPR) * 4;
            tile[k * LDT + n4 + 0] = v[i][0]; tile[k * LDT + n4 + 1] = v[i][1]; tile[k * LDT + n4 + 2] = v[i][2]; tile[k * LDT + n4 + 3] = v[i][3]; }
        __syncthreads();
        { constexpr int TPN = 64 / KPT; const int n = c.tid / TPN, k0 = (c.tid % TPN) * KPT;
          bf16_t* d = dstfn(m, nt * TN + n) + kt * 64 + k0;
#pragma unroll
          for (int q = 0; q < KPT / 8; ++q) { u32x4 w;
#pragma unroll
              for (int e = 0; e < 4; ++e) w[e] = pk2(tile[(k0 + q * 8 + 2 * e) * LDT + n], tile[(k0 + q * 8 + 2 * e + 1) * LDT + n]);
              *(u32x4*)(d + q * 8) = w; } }
        __syncthreads();
    }
}

__device__ __forceinline__ void phase_convert(const Ctx& c) {
    unsigned char* ws = c.ws;
    { const float* x = c.in[0]; float* xo = (float*)(ws + WS_X); bf16_t* xb = (bf16_t*)(ws + WS_XB);
      for (long i = c.gtid; i < (long)T * D / 4; i += c.gthreads) { const f32x4 v = *(const f32x4*)(x + i * 4); *(f32x4*)(xo + i * 4) = v; u32x2 w; w[0] = pk2(v[0], v[1]); w[1] = pk2(v[2], v[3]); *(u32x2*)(xb + i * 4) = w; } }
    { bf16_t* wrt = (bf16_t*)(ws + WS_WRT); for (long i = c.gtid; i < (long)4 * 128 * D / 8; i += c.gthreads) { const long l = i / (128 * D / 8), r = i % (128 * D / 8); *(u32x4*)(wrt + (size_t)l * 256 * D + (size_t)128 * D + r * 8) = (u32x4){0u, 0u, 0u, 0u}; }
      float* gate = (float*)(ws + WS_GATE); for (int i = c.gtid; i < T; i += c.gthreads) gate[TK + i] = 1.f;
      f32x2* ra = (f32x2*)(ws + WS_ROPEA); f32x2* rr = (f32x2*)(ws + WS_ROPER);
      for (int i = c.gtid; i < SEQ * 96; i += c.gthreads) { const int sidx = i / 96, q = i % 96; const bool isA = q < 32; const int jx = isA ? q : q - 32;
          const float e = isA ? (float)jx * (1.f / 32.f) : (float)jx * (1.f / 63.f); const float ang = (float)sidx * exp2f(-e * 13.287712379549449f); float sn, cs; sincosf(ang, &sn, &cs);
          if (isA) ra[sidx * 32 + jx] = (f32x2){cs, sn}; else rr[sidx * 64 + jx] = (f32x2){cs, sn}; }
      float* bp = (float*)(ws + WS_BIASP); for (int i = c.gtid; i < 2 * AB_IN; i += c.gthreads) { const int m = i / AB_IN, n = i % AB_IN; bp[m * AB_IN + ab_phys(n)] = c.in[2][i]; } }
    { bf16_t* d = (bf16_t*)(ws + WS_WABIN);  convert_T<256>(c, c.in[1], 2, D, AB_IN, [=](int m, int n) { return d + (size_t)m * AB_IN * D + (size_t)ab_phys(n) * D; }); }
    { bf16_t* d = (bf16_t*)(ws + WS_WABOUT); convert_T<256>(c, c.in[4], 2, AB_OUT, D, [=](int m, int n) { return d + (size_t)m * D * AB_OUT + (size_t)n * AB_OUT; }); }
    { bf16_t* d = (bf16_t*)(ws + WS_WCDIN);  convert_T<256>(c, c.in[6], 2, D, CD_IN, [=](int m, int n) { return d + (size_t)m * CD_IN * D + (size_t)n * D; }); }
    { bf16_t* d = (bf16_t*)(ws + WS_WCDOUT); convert_T<256>(c, c.in[17], 2, CD_OUT, D, [=](int m, int n) { return d + (size_t)m * D * CD_OUT + (size_t)n * CD_OUT; }); }
    { bf16_t* d = (bf16_t*)(ws + WS_WRT);    convert_T<128>(c, c.in[21], 4, D, NE, [=](int m, int n) { return d + (size_t)m * 256 * D + (size_t)n * D; }); }
    { bf16_t* d = (bf16_t*)(ws + WS_WGU);
      convert_T<256>(c, c.in[23], 4 * NE, D, ED, [=](int m, int n) { return d + (size_t)((m >> 7) * NE1 + (m & 127)) * 512 * D + (size_t)((n >> 7) * 256 + (n & 127)) * D; });
      convert_T<256>(c, c.in[24], 4 * NE, D, ED, [=](int m, int n) { return d + (size_t)((m >> 7) * NE1 + (m & 127)) * 512 * D + (size_t)((n >> 7) * 256 + 128 + (n & 127)) * D; });
      convert_T<256>(c, c.in[26], 4, D, ED, [=](int m, int n) { return d + (size_t)(m * NE1 + NE) * 512 * D + (size_t)((n >> 7) * 256 + (n & 127)) * D; });
      convert_T<256>(c, c.in[27], 4, D, ED, [=](int m, int n) { return d + (size_t)(m * NE1 + NE) * 512 * D + (size_t)((n >> 7) * 256 + 128 + (n & 127)) * D; }); }
    { bf16_t* d = (bf16_t*)(ws + WS_WLRU);
      convert_T<256>(c, c.in[12], 10, 256, 256, [=](int m, int n) { return d + (size_t)(m * 2 + 0) * 65536 + (size_t)n * 256; });
      convert_T<256>(c, c.in[14], 10, 256, 256, [=](int m, int n) { return d + (size_t)(m * 2 + 1) * 65536 + (size_t)n * 256; });
      float* spl = (float*)(ws + WS_SPL); for (int i = c.gtid; i < 2 * 1280; i += c.gthreads) spl[i] = log1pf(expf(-c.in[16][i])); }
    { bf16_t* d = (bf16_t*)(ws + WS_WDN);
      convert_T<256>(c, c.in[25], 4 * NE, ED, D, [=](int m, int n) { return d + (size_t)((m >> 7) * NE1 + (m & 127)) * D * ED + (size_t)n * ED; });
      convert_T<256>(c, c.in[28], 4, ED, D, [=](int m, int n) { return d + (size_t)(m * NE1 + NE) * D * ED + (size_t)n * ED; }); }
}

__device__ __forceinline__ void phase_dense(const Ctx& c, const bf16_t* A, const bf16_t* Bt, int M, int N, int K, float* C, int ldc, const float* bias) {
    g8::DenseOrder S; S.init(A, Bt, M, N, K, c.G, c.bid);
    g8::EpiF32 E{C, ldc, bias};
    g8::gemm_phase<g8::EpiF32, g8::DenseOrder>(c.lds + LDS_STAGE, K, S, E);
}

struct EpiABIn {
    static constexpr bool PERM = true;
    const float* biasP; unsigned char* ws;
    __device__ __forceinline__ void operator()(const f32x4 (&acc)[2][2][4][2], const g8::Unit& u, int wr, int wc, int fr, int fq) const {
        const int pn = u.pn; const int colp = pn * 256 + wc * 32 + fq * 8;
        f32x4 bv[2][2];
#pragma unroll
        for (int bj = 0; bj < 2; ++bj)
#pragma unroll
            for (int n = 0; n < 2; ++n) bv[bj][n] = *(const f32x4*)(biasP + colp + bj * 128 + 4 * n);
        bf16_t* qb = (bf16_t*)(ws + AB_QB); bf16_t* kb = (bf16_t*)(ws + AB_KB); bf16_t* vT = (bf16_t*)(ws + AB_VT); bf16_t* rqb = (bf16_t*)(ws + AB_RQB); bf16_t* rkb = (bf16_t*)(ws + AB_RKB);
        bf16_t* rkdT = (bf16_t*)(ws + AB_RKDT); bf16_t* rvT = (bf16_t*)(ws + AB_RVT); bf16_t* rgb = (bf16_t*)(ws + AB_RGB);
        const f32x4* ropeA = (const f32x4*)(ws + WS_ROPEA); const f32x4* ropeR = (const f32x4*)(ws + WS_ROPER);
#pragma unroll
        for (int ai = 0; ai < 2; ++ai)
#pragma unroll
            for (int m = 0; m < 4; ++m) {
                const int t = u.pm * 256 + ai * 128 + wr * 64 + m * 16 + fr, sq = t & (SEQ - 1), b = t >> 13;
                f32x4 x[2][2];
#pragma unroll
                for (int bj = 0; bj < 2; ++bj)
#pragma unroll
                    for (int n = 0; n < 2; ++n) x[bj][n] = acc[ai][bj][m][n] + bv[bj][n];
                if (pn < 4 || (pn == 4 && wc < 2)) {
                    const int j0 = fq * 8; f32x4 o1[2], o2[2];
#pragma unroll
                    for (int n = 0; n < 2; ++n) { const f32x4 cs01 = ropeA[(sq * 32 + j0 + 4 * n) / 2], cs23 = ropeA[(sq * 32 + j0 + 4 * n) / 2 + 1];
                        const float cc[4] = {cs01[0], cs01[2], cs23[0], cs23[2]}, ss[4] = {cs01[1], cs01[3], cs23[1], cs23[3]};
#pragma unroll
                        for (int e = 0; e < 4; ++e) { o1[n][e] = x[0][n][e] * cc[e] - x[1][n][e] * ss[e]; o2[n][e] = x[1][n][e] * cc[e] + x[0][n][e] * ss[e]; } }
                    const float sc = pn < 4 ? 0.125f : 1.f;
                    u32x4 w1, w2;
#pragma unroll
                    for (int n = 0; n < 2; ++n) { w1[2 * n] = pk2(o1[n][0] * sc, o1[n][1] * sc); w1[2 * n + 1] = pk2(o1[n][2] * sc, o1[n][3] * sc); w2[2 * n] = pk2(o2[n][0] * sc, o2[n][1] * sc); w2[2 * n + 1] = pk2(o2[n][2] * sc, o2[n][3] * sc); }
                    bf16_t* dst = pn < 4 ? qb + (size_t)t * 1024 + (pn * 4 + wc) * 64 + j0 : kb + (size_t)t * 128 + wc * 64 + j0;
                    *(u32x4*)dst = w1; *(u32x4*)(dst + 32) = w2;
                } else if (pn == 4) {
                    const int d0 = (wc - 2) * 32 + fq * 8;
#pragma unroll
                    for (int bj = 0; bj < 2; ++bj)
#pragma unroll
                        for (int n = 0; n < 2; ++n)
#pragma unroll
                            for (int e = 0; e < 4; ++e) vT[((size_t)(b * 2 + bj) * 64 + d0 + 4 * n + e) * SEQ + sq] = f2bf(x[bj][n][e]);
                } else if (pn < 9) {
                    const bool isk = pn >= 7; const int h = ((pn - 5) & 1) * 2 + (wc >> 1), j0 = (wc & 1) * 32 + fq * 8; f32x4 o1[2], o2[2];
                    const float sc = isk ? 0.08838834764831845f : 1.f;
#pragma unroll
                    for (int n = 0; n < 2; ++n) { const f32x4 cs01 = ropeR[(sq * 64 + j0 + 4 * n) / 2], cs23 = ropeR[(sq * 64 + j0 + 4 * n) / 2 + 1];
                        const float cc[4] = {cs01[0], cs01[2], cs23[0], cs23[2]}, ss[4] = {cs01[1], cs01[3], cs23[1], cs23[3]};
#pragma unroll
                        for (int e = 0; e < 4; ++e) { o1[n][e] = (x[0][n][e] * cc[e] - x[1][n][e] * ss[e]) * sc; o2[n][e] = (x[1][n][e] * cc[e] + x[0][n][e] * ss[e]) * sc; } }
                    u32x4 w1, w2;
#pragma unroll
                    for (int n = 0; n < 2; ++n) { w1[2 * n] = pk2(o1[n][0], o1[n][1]); w1[2 * n + 1] = pk2(o1[n][2], o1[n][3]); w2[2 * n] = pk2(o2[n][0], o2[n][1]); w2[2 * n + 1] = pk2(o2[n][2], o2[n][3]); }
                    bf16_t* dst = (isk ? rkb : rqb) + (size_t)t * 512 + h * 128 + j0;
                    *(u32x4*)dst = w1; *(u32x4*)(dst + 64) = w2;
                    if (isk) {
                        const float lg = log2f(1.f - exp2f(-5.f - (float)h)); const float dec = exp2f((float)(127 - (sq & 127)) * lg);
                        bf16_t* dT = rkdT + ((size_t)(b * 4 + h) * 128 + j0) * SEQ + sq;
#pragma unroll
                        for (int n = 0; n < 2; ++n)
#pragma unroll
                            for (int e = 0; e < 4; ++e) { dT[(size_t)(4 * n + e) * SEQ] = f2bf(o1[n][e] * dec); dT[(size_t)(64 + 4 * n + e) * SEQ] = f2bf(o2[n][e] * dec); }
                    }
                } else if (pn < 13) {
                    const int h = pn - 9;
#pragma unroll
                    for (int bj = 0; bj < 2; ++bj)
#pragma unroll
                        for (int n = 0; n < 2; ++n)
#pragma unroll
                            for (int e = 0; e < 4; ++e) rvT[((size_t)(b * 4 + h) * 256 + bj * 128 + wc * 32 + fq * 8 + 4 * n + e) * SEQ + sq] = f2bf(x[bj][n][e]);
                } else {
#pragma unroll
                    for (int bj = 0; bj < 2; ++bj) { u32x4 w;
#pragma unroll
                        for (int n = 0; n < 2; ++n) { w[2 * n] = pk2(siluf_(x[bj][n][0]), siluf_(x[bj][n][1])); w[2 * n + 1] = pk2(siluf_(x[bj][n][2]), siluf_(x[bj][n][3])); }
                        *(u32x4*)(rgb + (size_t)t * 1024 + (pn - 13) * 256 + bj * 128 + wc * 32 + fq * 8) = w; }
                }
            }
    }
};
__device__ __forceinline__ void phase_ab_inproj(const Ctx& c, int j) {
    g8::DenseOrder S; S.init(c.ws + WS_XB, c.ws + WS_WABIN + (size_t)j * AB_IN * D * 2, T, AB_IN, D, c.G, c.bid);
    EpiABIn E{(const float*)(c.ws + WS_BIASP) + (size_t)j * AB_IN, c.ws};
    g8::gemm_phase<EpiABIn, g8::DenseOrder>(c.lds + LDS_STAGE, D, S, E);
}

#define MFMA16(a, b, c) __builtin_amdgcn_mfma_f32_16x16x32_bf16((a), (b), (c), 0, 0, 0)
__device__ __forceinline__ bf16x8 pack8(const f32x4& lo, const f32x4& hi) { u32x4 w; w[0] = g8::cvt_pk_bf16(lo[0], lo[1]); w[1] = g8::cvt_pk_bf16(lo[2], lo[3]); w[2] = g8::cvt_pk_bf16(hi[0], hi[1]); w[3] = g8::cvt_pk_bf16(hi[2], hi[3]); return __builtin_bit_cast(bf16x8, w); }
__device__ __forceinline__ bf16x8 cat8(const u32x2& lo, const u32x2& hi) { u32x4 w; w[0] = lo[0]; w[1] = lo[1]; w[2] = hi[0]; w[3] = hi[1]; return __builtin_bit_cast(bf16x8, w); }
template <int ROWS, int RB>
__device__ __forceinline__ void tile_g2l(LAS unsigned char* dst, const unsigned char* src, size_t gs, int tid, int zrows = 0) {
    constexpr int CPR = RB / 16, TOTAL = ROWS * CPR;
#pragma unroll 4
    for (int i = tid; i < TOTAL; i += NTHREADS) { const int r = i / CPR, cc = i % CPR; u32x4 v = (u32x4){0u, 0u, 0u, 0u}; if (r >= zrows) v = *(const u32x4*)(src + (size_t)r * gs + cc * 16);
        *(LAS u32x4*)(dst + r * (RB + 16) + cc * 16) = v; }
}

__device__ __forceinline__ void attn_unit(const Ctx& c, int unit, const float* sinks) {
    const int b = unit >> 7, n = (unit >> 1) & 63, kvh = unit & 1, hd = kvh * 8 + c.wid, lane = c.lane, fr = lane & 15, fq = lane >> 4;
    const bf16_t* qb = (const bf16_t*)(c.ws + AB_QB); const bf16_t* kb = (const bf16_t*)(c.ws + AB_KB); const bf16_t* vT = (const bf16_t*)(c.ws + AB_VT); bf16_t* ycat = (bf16_t*)(c.ws + WS_YCAT);
    LAS unsigned char* Ks = c.lds; LAS unsigned char* Vs = c.lds + 256 * 144;
    const int t0 = b * SEQ + n * 128;
    __syncthreads();
    {
        const unsigned char* src = (const unsigned char*)(kb + (size_t)(t0 - 128) * 128 + kvh * 64);
        constexpr int TOTAL = 256 * 8;
#pragma unroll 4
        for (int i = c.tid; i < TOTAL; i += NTHREADS) { const int r = i >> 3, cc = i & 7; u32x4 v = (u32x4){0u, 0u, 0u, 0u}; if (n > 0 || r >= 128) v = *(const u32x4*)(src + (ptrdiff_t)r * 256 + cc * 16);
            *(LAS u32x4*)(Ks + r * 144 + cc * 16) = v; }
        const unsigned char* vsrc = (const unsigned char*)(vT + (size_t)(b * 2 + kvh) * 64 * SEQ + (n * 128 - 128));
        constexpr int TV = 64 * 32;
#pragma unroll 4
        for (int i = c.tid; i < TV; i += NTHREADS) { const int r = i >> 5, cc = i & 31; u32x4 v = (u32x4){0u, 0u, 0u, 0u}; if (n > 0 || cc >= 16) v = *(const u32x4*)(vsrc + (ptrdiff_t)r * SEQ * 2 + cc * 16);
            *(LAS u32x4*)(Vs + r * 528 + cc * 16) = v; }
    }
    __syncthreads();
    const float sink = sinks[hd];
    for (int si = 0; si < 8; ++si) {
        const int t = t0 + si * 16 + fr;
        bf16x8 qf[2];
#pragma unroll
        for (int ks = 0; ks < 2; ++ks) qf[ks] = *(const bf16x8*)(qb + (size_t)t * 1024 + hd * 64 + ks * 32 + fq * 8);
        f32x4 S[10];
#pragma unroll
        for (int nk = 0; nk < 9; ++nk) { S[nk] = (f32x4){0.f, 0.f, 0.f, 0.f};
#pragma unroll
            for (int ks = 0; ks < 2; ++ks) { const bf16x8 a = *(const LAS bf16x8*)(Ks + (16 * (si + nk) + fr) * 144 + ks * 64 + fq * 16); S[nk] = MFMA16(a, qf[ks], S[nk]); } }
        S[9] = (f32x4){0.f, 0.f, 0.f, 0.f};
        const int i = si * 16 + fr;
        float mx = sink;
#pragma unroll
        for (int nk = 0; nk < 9; ++nk)
#pragma unroll
            for (int r = 0; r < 4; ++r) { const int p = 16 * (si + nk) + 4 * fq + r; const bool ok = (p >= i + 1) && (p <= i + 128) && (n > 0 || p >= 128);
                S[nk][r] = ok ? S[nk][r] : -1e30f; mx = fmaxf(mx, S[nk][r]); }
        mx = fmaxf(mx, __shfl_xor(mx, 16)); mx = fmaxf(mx, __shfl_xor(mx, 32));
        float sum = 0.f;
#pragma unroll
        for (int nk = 0; nk < 9; ++nk)
#pragma unroll
            for (int r = 0; r < 4; ++r) { const float pv = S[nk][r] > -1e29f ? exp2f((S[nk][r] - mx) * 1.4426950408889634f) : 0.f; S[nk][r] = pv; sum += pv; }
        sum += __shfl_xor(sum, 16); sum += __shfl_xor(sum, 32);
        const float inv = 1.f / (sum + exp2f((sink - mx) * 1.4426950408889634f));
        f32x4 O[4];
#pragma unroll
        for (int nd = 0; nd < 4; ++nd) O[nd] = (f32x4){0.f, 0.f, 0.f, 0.f};
#pragma unroll
        for (int kk = 0; kk < 5; ++kk) { const bf16x8 pf = pack8(S[2 * kk], S[2 * kk + 1]);
            const int p0 = 16 * (si + 2 * kk) + 4 * fq, p1 = (kk == 4 && si == 7) ? p0 : p0 + 16;
#pragma unroll
            for (int nd = 0; nd < 4; ++nd) { const u32x2 lo = *(const LAS u32x2*)(Vs + (16 * nd + fr) * 528 + p0 * 2), hi = *(const LAS u32x2*)(Vs + (16 * nd + fr) * 528 + p1 * 2);
                O[nd] = MFMA16(cat8(lo, hi), pf, O[nd]); } }
#pragma unroll
        for (int nd = 0; nd < 4; ++nd) { u32x2 w; w[0] = pk2(O[nd][0] * inv, O[nd][1] * inv); w[1] = pk2(O[nd][2] * inv, O[nd][3] * inv);
            *(u32x2*)(ycat + (size_t)t * AB_OUT + hd * 64 + 16 * nd + 4 * fq) = w; }
    }
}

__device__ __forceinline__ void ret_kv_unit(const Ctx& c, int unit) {
    const int b = unit >> 8, n = (unit >> 2) & 63, h = unit & 3, lane = c.lane, fr = lane & 15, fq = lane >> 4, w = c.wid;
    const bf16_t* rkdT = (const bf16_t*)(c.ws + AB_RKDT); const bf16_t* rvT = (const bf16_t*)(c.ws + AB_RVT); float* kv = (float*)(c.ws + AB_KV);
    LAS unsigned char* Kd = c.lds;
    __syncthreads();
    tile_g2l<128, 256>(Kd, (const unsigned char*)(rkdT + (size_t)(b * 4 + h) * 128 * SEQ + n * 128), (size_t)SEQ * 2, c.tid);
    bf16x8 vf[2][4];
#pragma unroll
    for (int ne = 0; ne < 2; ++ne)
#pragma unroll
        for (int ks = 0; ks < 4; ++ks) vf[ne][ks] = *(const bf16x8*)(rvT + ((size_t)(b * 4 + h) * 256 + 32 * w + 16 * ne + fr) * SEQ + n * 128 + ks * 32 + fq * 8);
    __syncthreads();
    float* out = kv + ((size_t)((b * 64 + n) * 4 + h)) * 256 * 128;
#pragma unroll
    for (int nd = 0; nd < 8; ++nd) { f32x4 a0 = (f32x4){0.f, 0.f, 0.f, 0.f}, a1 = a0;
#pragma unroll
        for (int ks = 0; ks < 4; ++ks) { const bf16x8 kf = *(const LAS bf16x8*)(Kd + (16 * nd + fr) * 272 + ks * 64 + fq * 16); a0 = MFMA16(kf, vf[0][ks], a0); a1 = MFMA16(kf, vf[1][ks], a1); }
        *(f32x4*)(out + (size_t)(32 * w + fr) * 128 + 16 * nd + 4 * fq) = a0; *(f32x4*)(out + (size_t)(32 * w + 16 + fr) * 128 + 16 * nd + 4 * fq) = a1; }
}
__device__ __forceinline__ void ret_scan(const Ctx& c, int first_block, int nblocks) {
    const float* kv = (const float*)(c.ws + AB_KV); bf16_t* sp = (bf16_t*)(c.ws + AB_SPREV);
    const int nthr = nblocks * NTHREADS;
    for (int idx = (c.bid - first_block) * NTHREADS + c.tid; idx < 2 * 4 * 256 * 128 / 4; idx += nthr) {
        const int b = idx >> 15, rem = idx & 32767, h = rem >> 13;
        const float g = exp2f(128.f * log2f(1.f - exp2f(-5.f - (float)h)));
        const size_t base = (size_t)b * 64 * 131072 + (size_t)rem * 4;
        f32x4 st = (f32x4){0.f, 0.f, 0.f, 0.f};
        for (int n0 = 0; n0 < 64; n0 += 8) { f32x4 v[8];
#pragma unroll
            for (int q = 0; q < 8; ++q) v[q] = *(const f32x4*)(kv + base + (size_t)(n0 + q) * 131072);
#pragma unroll
            for (int q = 0; q < 8; ++q) { u32x2 wv; wv[0] = pk2(st[0], st[1]); wv[1] = pk2(st[2], st[3]); *(u32x2*)(sp + base + (size_t)(n0 + q) * 131072) = wv; st = st * g + v[q]; } }
    }
}
__device__ __forceinline__ void ret_out_unit(const Ctx& c, int unit) {
    const int b = unit >> 8, n = (unit >> 2) & 63, h = unit & 3, lane = c.lane, fr = lane & 15, fq = lane >> 4, w = c.wid;
    const bf16_t* rqb = (const bf16_t*)(c.ws + AB_RQB); const bf16_t* rkb = (const bf16_t*)(c.ws + AB_RKB); const bf16_t* rvT = (const bf16_t*)(c.ws + AB_RVT);
    const bf16_t* sp = (const bf16_t*)(c.ws + AB_SPREV); const bf16_t* rgb = (const bf16_t*)(c.ws + AB_RGB); bf16_t* ycat = (bf16_t*)(c.ws + WS_YCAT);
    LAS unsigned char* Kl = c.lds; LAS unsigned char* Bl = c.lds + 128 * 272;
    const int t0 = b * SEQ + n * 128; const float lg = log2f(1.f - exp2f(-5.f - (float)h));
    __syncthreads();
    tile_g2l<128, 256>(Kl, (const unsigned char*)(rkb + (size_t)t0 * 512 + h * 128), (size_t)512 * 2, c.tid);
    tile_g2l<256, 256>(Bl, (const unsigned char*)(sp + ((size_t)((b * 64 + n) * 4 + h)) * 256 * 128), (size_t)128 * 2, c.tid);
    const int t = t0 + 16 * w + fr, i = 16 * w + fr;
    bf16x8 qf[4];
#pragma unroll
    for (int ks = 0; ks < 4; ++ks) qf[ks] = *(const bf16x8*)(rqb + (size_t)t * 512 + h * 128 + ks * 32 + fq * 8);
    __syncthreads();
    bf16x8 pf[4];
#pragma unroll
    for (int kk = 0; kk < 4; ++kk) { f32x4 s2[2];
#pragma unroll
        for (int q = 0; q < 2; ++q) { const int nj = 2 * kk + q; s2[q] = (f32x4){0.f, 0.f, 0.f, 0.f};
            if (nj <= w) {
#pragma unroll
                for (int ks = 0; ks < 4; ++ks) { const bf16x8 kf = *(const LAS bf16x8*)(Kl + (16 * nj + fr) * 272 + ks * 64 + fq * 16); s2[q] = MFMA16(kf, qf[ks], s2[q]); }
#pragma unroll
                for (int r = 0; r < 4; ++r) { const int jj = 16 * nj + 4 * fq + r; s2[q][r] = (i >= jj) ? s2[q][r] * exp2f((float)(i - jj) * lg) : 0.f; } } }
        pf[kk] = pack8(s2[0], s2[1]); }
    f32x4 acc[16];
#pragma unroll
    for (int ne = 0; ne < 16; ++ne) { acc[ne] = (f32x4){0.f, 0.f, 0.f, 0.f};
#pragma unroll
        for (int ks = 0; ks < 4; ++ks) { const bf16x8 sf = *(const LAS bf16x8*)(Bl + (16 * ne + fr) * 272 + ks * 64 + fq * 16); acc[ne] = MFMA16(sf, qf[ks], acc[ne]); } }
    const float rs = exp2f((float)(i + 1) * lg);
#pragma unroll
    for (int ne = 0; ne < 16; ++ne) acc[ne] = acc[ne] * rs;
    __syncthreads();
    tile_g2l<256, 256>(Bl, (const unsigned char*)(rvT + (size_t)(b * 4 + h) * 256 * SEQ + n * 128), (size_t)SEQ * 2, c.tid);
    __syncthreads();
    const int nkk = (w >> 1) + 1;
#pragma unroll
    for (int kk = 0; kk < 4; ++kk) if (kk < nkk) {
#pragma unroll
        for (int ne = 0; ne < 16; ++ne) { const u32x2 lo = *(const LAS u32x2*)(Bl + (16 * ne + fr) * 272 + (32 * kk + 4 * fq) * 2), hi = *(const LAS u32x2*)(Bl + (16 * ne + fr) * 272 + (32 * kk + 16 + 4 * fq) * 2);
            acc[ne] = MFMA16(cat8(lo, hi), pf[kk], acc[ne]); } }
    float sm = 0.f;
#pragma unroll
    for (int ne = 0; ne < 16; ++ne) sm += acc[ne][0] + acc[ne][1] + acc[ne][2] + acc[ne][3];
    sm += __shfl_xor(sm, 16); sm += __shfl_xor(sm, 32);
    const float mean = sm * (1.f / 256.f); float sq = 0.f;
#pragma unroll
    for (int ne = 0; ne < 16; ++ne) { acc[ne] = acc[ne] - mean; sq += acc[ne][0] * acc[ne][0] + acc[ne][1] * acc[ne][1] + acc[ne][2] * acc[ne][2] + acc[ne][3] * acc[ne][3]; }
    sq += __shfl_xor(sq, 16); sq += __shfl_xor(sq, 32);
    const float rstd = rsqrtf(sq * (1.f / 256.f) + LN_EPS);
#pragma unroll
    for (int ne = 0; ne < 16; ++ne) { const u32x2 gw = *(const u32x2*)(rgb + (size_t)t * 1024 + h * 256 + 16 * ne + 4 * fq);
        const float g0 = __uint_as_float(gw[0] << 16), g1 = __uint_as_float(gw[0] & 0xffff0000u), g2 = __uint_as_float(gw[1] << 16), g3 = __uint_as_float(gw[1] & 0xffff0000u);
        u32x2 o; o[0] = pk2(acc[ne][0] * rstd * g0, acc[ne][1] * rstd * g1); o[1] = pk2(acc[ne][2] * rstd * g2, acc[ne][3] * rstd * g3);
        *(u32x2*)(ycat + (size_t)t * AB_OUT + 1024 + h * 256 + 16 * ne + 4 * fq) = o; }
}

__device__ __forceinline__ void phase_ab_p1(const Ctx& c) {
    for (int u = c.bid; u < 512; u += c.G) ret_kv_unit(c, u);
}
__device__ __forceinline__ void phase_ab_p2(const Ctx& c, int j) {
    if (c.bid < 64) ret_scan(c, 0, 64);
    else { const float* sinks = c.in[3] + j * 16; for (int u = c.bid - 64; u < 256; u += c.G - 64) attn_unit(c, u, sinks); }
}
__device__ __forceinline__ void phase_ab_p3(const Ctx& c) {
    for (int u = c.bid; u < 512; u += c.G) ret_out_unit(c, u);
}

__device__ __forceinline__ float gelu_fast(float x) { const float u = 1.5957691216057308f * (x + 0.044715f * x * x * x); return x / (1.f + __expf(-u)); }
struct EpiCDIn {
    static constexpr bool PERM = true;
    const float* bias; unsigned char* ws;
    __device__ __forceinline__ void operator()(const f32x4 (&acc)[2][2][4][2], const g8::Unit& u, int wr, int wc, int fr, int fq) const {
        const int pn = u.pn; const int col0 = pn * 256 + wc * 32 + fq * 8;
        f32x4 bv[2][2];
#pragma unroll
        for (int bj = 0; bj < 2; ++bj)
#pragma unroll
            for (int n = 0; n < 2; ++n) bv[bj][n] = *(const f32x4*)(bias + col0 + bj * 128 + 4 * n);
        bf16_t* gu = (bf16_t*)(ws + CD_GU); bf16_t* gvT = (bf16_t*)(ws + CD_GVT); bf16_t* gg = (bf16_t*)(ws + CD_GG); bf16_t* xr = (bf16_t*)(ws + CD_XR); float* stats = (float*)(ws + CD_STATS);
#pragma unroll
        for (int ai = 0; ai < 2; ++ai)
#pragma unroll
            for (int m = 0; m < 4; ++m) {
                const int t = u.pm * 256 + ai * 128 + wr * 64 + m * 16 + fr, sq = t & (SEQ - 1), b = t >> 13;
                f32x4 x[2][2];
#pragma unroll
                for (int bj = 0; bj < 2; ++bj)
#pragma unroll
                    for (int n = 0; n < 2; ++n) { x[bj][n] = acc[ai][bj][m][n] + bv[bj][n];
                        if (pn < 13) {
#pragma unroll
                            for (int e = 0; e < 4; ++e) x[bj][n][e] = gelu_fast(x[bj][n][e]); } }
                if (pn >= 4 && pn < 8) {
                    float s1 = 0.f, s2 = 0.f;
#pragma unroll
                    for (int bj = 0; bj < 2; ++bj)
#pragma unroll
                        for (int n = 0; n < 2; ++n)
#pragma unroll
                            for (int e = 0; e < 4; ++e) { const float v = x[bj][n][e]; s1 += v; s2 += v * v;
                                gvT[((size_t)b * 1024 + (pn - 4) * 256 + bj * 128 + wc * 32 + fq * 8 + 4 * n + e) * SEQ + sq] = f2bf(v); }
                    s1 += __shfl_xor(s1, 16); s1 += __shfl_xor(s1, 32); s2 += __shfl_xor(s2, 16); s2 += __shfl_xor(s2, 32);
                    if (fq == 0) *(f32x2*)(stats + (size_t)t * 32 + ((pn - 4) * 4 + wc) * 2) = (f32x2){s1, s2};
                } else {
                    bf16_t* dst; int ld, cb;
                    if (pn < 4) { dst = gu; ld = 1024; cb = pn * 256; } else if (pn < 13) { dst = gg; ld = 1280; cb = (pn - 8) * 256; } else { dst = xr; ld = 1280; cb = (pn - 13) * 256; }
#pragma unroll
                    for (int bj = 0; bj < 2; ++bj) { u32x4 w;
#pragma unroll
                        for (int n = 0; n < 2; ++n) { w[2 * n] = pk2(x[bj][n][0], x[bj][n][1]); w[2 * n + 1] = pk2(x[bj][n][2], x[bj][n][3]); }
                        *(u32x4*)(dst + (size_t)t * ld + cb + bj * 128 + wc * 32 + fq * 8) = w; }
                }
            }
    }
};
__device__ __forceinline__ void phase_cd_inproj(const Ctx& c, int j) {
    g8::DenseOrder S; S.init(c.ws + WS_XB, c.ws + WS_WCDIN + (size_t)j * CD_IN * D * 2, T, CD_IN, D, c.G, c.bid);
    EpiCDIn E{c.in[7] + (size_t)j * CD_IN, c.ws};
    g8::gemm_phase<EpiCDIn, g8::DenseOrder>(c.lds + LDS_STAGE, D, S, E);
}

__device__ __forceinline__ void lru_unit(const Ctx& c, int unit, int j) {
    const int hh = unit % 5, bn = unit / 5, lane = c.lane, fr = lane & 15, fq = lane >> 4, w = c.wid;
    const int t0 = bn * 128, s0 = t0 & (SEQ - 1);
    const bf16_t* xr = (const bf16_t*)(c.ws + CD_XR); bf16_t* HL = (bf16_t*)(c.ws + WS_U2); bf16_t* PC = HL + (size_t)T * 1280; float* sum = (float*)(c.ws + WS_H);
    const float* conv_w = c.in[10] + (size_t)j * 4 * 1280 + hh * 256; const float* conv_b = c.in[11] + (size_t)j * 1280 + hh * 256;
    const float* ba = c.in[13] + (size_t)j * 1280 + hh * 256; const float* bx = c.in[15] + (size_t)j * 1280 + hh * 256; const float* spl = (const float*)(c.ws + WS_SPL) + (size_t)j * 1280 + hh * 256;
    const bf16_t* Wl = (const bf16_t*)(c.ws + WS_WLRU) + (size_t)((j * 5 + hh) * 2) * 65536;
    LAS unsigned char* Xc = c.lds; LAS unsigned char* Wa = c.lds + 128 * 528; LAS unsigned char* Wx = Wa + 64 * 528; LAS unsigned char* Tot = Wx + 64 * 528;
    __syncthreads();
    {
        const int cg = c.tid & 31, r0 = (c.tid >> 5) * 8;
        float wv[4][8], bv8[8];
        { const f32x4 b0 = *(const f32x4*)(conv_b + cg * 8), b1 = *(const f32x4*)(conv_b + cg * 8 + 4); bv8[0] = b0[0]; bv8[1] = b0[1]; bv8[2] = b0[2]; bv8[3] = b0[3]; bv8[4] = b1[0]; bv8[5] = b1[1]; bv8[6] = b1[2]; bv8[7] = b1[3]; }
#pragma unroll
        for (int k = 0; k < 4; ++k) { const f32x4 w0 = *(const f32x4*)(conv_w + k * 1280 + cg * 8), w1 = *(const f32x4*)(conv_w + k * 1280 + cg * 8 + 4);
            wv[k][0] = w0[0]; wv[k][1] = w0[1]; wv[k][2] = w0[2]; wv[k][3] = w0[3]; wv[k][4] = w1[0]; wv[k][5] = w1[1]; wv[k][6] = w1[2]; wv[k][7] = w1[3]; }
        u32x4 xin[11];
#pragma unroll
        for (int q = 0; q < 11; ++q) { xin[q] = (u32x4){0u, 0u, 0u, 0u}; if (s0 + r0 - 3 + q >= 0) xin[q] = *(const u32x4*)(xr + (size_t)(t0 + r0 - 3 + q) * 1280 + hh * 256 + cg * 8); }
#pragma unroll
        for (int rr = 0; rr < 8; ++rr) { float a[8];
#pragma unroll
            for (int e = 0; e < 8; ++e) a[e] = bv8[e];
#pragma unroll
            for (int k = 0; k < 4; ++k) { const u32x4 xv = xin[rr + k];
#pragma unroll
                for (int e2 = 0; e2 < 4; ++e2) { a[2 * e2] += wv[k][2 * e2] * __uint_as_float(xv[e2] << 16); a[2 * e2 + 1] += wv[k][2 * e2 + 1] * __uint_as_float(xv[e2] & 0xffff0000u); } }
            u32x4 o; o[0] = pk2(a[0], a[1]); o[1] = pk2(a[2], a[3]); o[2] = pk2(a[4], a[5]); o[3] = pk2(a[6], a[7]);
            *(LAS u32x4*)(Xc + (r0 + rr) * 528 + cg * 16) = o; }
    }
    u32x4 wreg[8];
#pragma unroll
    for (int q = 0; q < 4; ++q) { const int i = c.tid + q * NTHREADS, r = i >> 5, cc = i & 31; wreg[q] = *(const u32x4*)((const unsigned char*)Wl + (size_t)r * 512 + cc * 16); wreg[4 + q] = *(const u32x4*)((const unsigned char*)(Wl + 65536) + (size_t)r * 512 + cc * 16); }
    __syncthreads();
    bf16x8 xf[8];
#pragma unroll
    for (int ks = 0; ks < 8; ++ks) xf[ks] = *(const LAS bf16x8*)(Xc + (16 * w + fr) * 528 + ks * 64 + fq * 16);
    const int t = t0 + 16 * w + fr;
    for (int sl = 0; sl < 4; ++sl) {
        if (sl) __syncthreads();
#pragma unroll
        for (int q = 0; q < 4; ++q) { const int i = c.tid + q * NTHREADS, r = i >> 5, cc = i & 31; *(LAS u32x4*)(Wa + r * 528 + cc * 16) = wreg[q]; *(LAS u32x4*)(Wx + r * 528 + cc * 16) = wreg[4 + q]; }
        if (sl < 3) {
#pragma unroll
            for (int q = 0; q < 4; ++q) { const int i = c.tid + q * NTHREADS, r = i >> 5, cc = i & 31;
                wreg[q] = *(const u32x4*)((const unsigned char*)(Wl + (size_t)((sl + 1) * 64) * 256) + (size_t)r * 512 + cc * 16); wreg[4 + q] = *(const u32x4*)((const unsigned char*)(Wl + 65536 + (size_t)((sl + 1) * 64) * 256) + (size_t)r * 512 + cc * 16); } }
        __syncthreads();
        f32x4 sA[4], sB[4];
#pragma unroll
        for (int nc = 0; nc < 4; ++nc) { f32x4 ra = (f32x4){0.f, 0.f, 0.f, 0.f}, ri = ra;
#pragma unroll
            for (int ks = 0; ks < 8; ++ks) { const bf16x8 wa = *(const LAS bf16x8*)(Wa + (16 * nc + fr) * 528 + ks * 64 + fq * 16), wx = *(const LAS bf16x8*)(Wx + (16 * nc + fr) * 528 + ks * 64 + fq * 16);
                ra = MFMA16(wa, xf[ks], ra); ri = MFMA16(wx, xf[ks], ri); }
            const int ch = sl * 64 + 16 * nc + 4 * fq;
            const f32x4 b_a = *(const f32x4*)(ba + ch), b_x = *(const f32x4*)(bx + ch), sp = *(const f32x4*)(spl + ch);
            const u32x2 xw = *(const LAS u32x2*)(Xc + (16 * w + fr) * 528 + ch * 2);
            const float xcv[4] = {__uint_as_float(xw[0] << 16), __uint_as_float(xw[0] & 0xffff0000u), __uint_as_float(xw[1] << 16), __uint_as_float(xw[1] & 0xffff0000u)};
            f32x4 oa, ob;
#pragma unroll
            for (int r = 0; r < 4; ++r) { const float gr = sigmoidf_(ra[r] + b_a[r]), gi = sigmoidf_(ri[r] + b_x[r]); const float la = -8.f * gr * sp[r]; const float a = __expf(la);
                oa[r] = a; ob[r] = sqrtf(fmaxf(1.f - a * a, 0.f)) * (gi * xcv[r]); }
#pragma unroll
            for (int dlt = 1; dlt < 16; dlt <<= 1) {
#pragma unroll
                for (int r = 0; r < 4; ++r) { const float pa = __shfl_up(oa[r], dlt, 16), pb = __shfl_up(ob[r], dlt, 16); if (fr >= dlt) { ob[r] = oa[r] * pb + ob[r]; oa[r] = oa[r] * pa; } } }
            sA[nc] = oa; sB[nc] = ob;
            if (fr == 15) { *(LAS f32x4*)(Tot + ((w * 64 + 16 * nc + 4 * fq) * 2) * 4) = oa; *(LAS f32x4*)(Tot + ((w * 64 + 16 * nc + 4 * fq) * 2 + 4) * 4) = ob; }
        }
        __syncthreads();
#pragma unroll
        for (int nc = 0; nc < 4; ++nc) { const int ch = sl * 64 + 16 * nc + 4 * fq;
            f32x4 cp = (f32x4){1.f, 1.f, 1.f, 1.f}, chh = (f32x4){0.f, 0.f, 0.f, 0.f};
            for (int w2 = 0; w2 < w; ++w2) { const f32x4 ta = *(const LAS f32x4*)(Tot + ((w2 * 64 + 16 * nc + 4 * fq) * 2) * 4), tb = *(const LAS f32x4*)(Tot + ((w2 * 64 + 16 * nc + 4 * fq) * 2 + 4) * 4);
                chh = ta * chh + tb; cp = cp * ta; }
            const f32x4 hl = sB[nc] + sA[nc] * chh, pc = sA[nc] * cp;
            u32x2 o1, o2; o1[0] = pk2(hl[0], hl[1]); o1[1] = pk2(hl[2], hl[3]); o2[0] = pk2(pc[0], pc[1]); o2[1] = pk2(pc[2], pc[3]);
            *(u32x2*)(HL + (size_t)t * 1280 + hh * 256 + ch) = o1; *(u32x2*)(PC + (size_t)t * 1280 + hh * 256 + ch) = o2;
            if (w == 7 && fr == 15) { float* sm = sum + ((size_t)bn * 1280 + hh * 256 + ch) * 2;
#pragma unroll
                for (int r = 0; r < 4; ++r) { sm[2 * r] = pc[r]; sm[2 * r + 1] = hl[r]; } } }
    }
}

__device__ __forceinline__ void sgu_unit(const Ctx& c, int unit, int j) {
    const int g = unit & 3, bn = unit >> 2, b = bn >> 6, n = bn & 63, lane = c.lane, fr = lane & 15, fq = lane >> 4, w = c.wid;
    const int t0 = bn * 128;
    const bf16_t* gu = (const bf16_t*)(c.ws + CD_GU); const bf16_t* gvT = (const bf16_t*)(c.ws + CD_GVT); const float* stats = (const float*)(c.ws + CD_STATS); bf16_t* ycat = (bf16_t*)(c.ws + WS_YCAT);
    const float* sw = c.in[8] + (size_t)(j * 4 + g) * 16384; const float* sb = c.in[9] + (size_t)(j * 4 + g) * 128;
    LAS unsigned char* Vt = c.lds; LAS float* mr = (LAS float*)(c.lds + 256 * 272);
    __syncthreads();
    tile_g2l<256, 256>(Vt, (const unsigned char*)(gvT + ((size_t)b * 1024 + g * 256) * SEQ + n * 128), (size_t)SEQ * 2, c.tid);
    if (c.tid < 128) { const float* st = stats + (size_t)(t0 + c.tid) * 32; float s1 = 0.f, s2 = 0.f;
#pragma unroll
        for (int q = 0; q < 16; ++q) { s1 += st[2 * q]; s2 += st[2 * q + 1]; }
        const float mean = s1 * (1.f / 1024.f), var = fmaxf(s2 * (1.f / 1024.f) - mean * mean, 0.f); mr[2 * c.tid] = mean; mr[2 * c.tid + 1] = rsqrtf(var + LN_EPS); }
    __syncthreads();
    const int i = 16 * w + fr, t = t0 + i, nks = (w >> 1) + 1;
    bf16x8 wf[4]; float ci = 0.f;
#pragma unroll
    for (int ks = 0; ks < 4; ++ks) { f32x4 lo = (f32x4){0.f, 0.f, 0.f, 0.f}, hi = lo;
        if (ks < nks) { const int j0 = ks * 32 + fq * 8; const f32x4 w0 = *(const f32x4*)(sw + (size_t)i * 128 + j0), w1 = *(const f32x4*)(sw + (size_t)i * 128 + j0 + 4);
#pragma unroll
            for (int e = 0; e < 4; ++e) { const float m0 = mr[2 * (j0 + e)], r0 = mr[2 * (j0 + e) + 1], m1 = mr[2 * (j0 + 4 + e)], r1 = mr[2 * (j0 + 4 + e) + 1];
                lo[e] = (j0 + e <= i) ? w0[e] * r0 : 0.f; hi[e] = (j0 + 4 + e <= i) ? w1[e] * r1 : 0.f; ci += lo[e] * m0 + hi[e] * m1; } }
        wf[ks] = pack8(lo, hi); }
    ci += __shfl_xor(ci, 16); ci += __shfl_xor(ci, 32);
    const float add = sb[i] - ci;
    f32x4 acc[16];
#pragma unroll
    for (int nd = 0; nd < 16; ++nd) { acc[nd] = (f32x4){0.f, 0.f, 0.f, 0.f};
#pragma unroll
        for (int ks = 0; ks < 4; ++ks) if (ks < nks) { const bf16x8 vf = *(const LAS bf16x8*)(Vt + (16 * nd + fr) * 272 + ks * 64 + fq * 16); acc[nd] = MFMA16(vf, wf[ks], acc[nd]); } }
#pragma unroll
    for (int nd = 0; nd < 16; ++nd) { const u32x2 uw = *(const u32x2*)(gu + (size_t)t * 1024 + g * 256 + 16 * nd + 4 * fq);
        const float u0 = __uint_as_float(uw[0] << 16), u1 = __uint_as_float(uw[0] & 0xffff0000u), u2 = __uint_as_float(uw[1] << 16), u3 = __uint_as_float(uw[1] & 0xffff0000u);
        u32x2 o; o[0] = pk2(u0 * (acc[nd][0] + add), u1 * (acc[nd][1] + add)); o[1] = pk2(u2 * (acc[nd][2] + add), u3 * (acc[nd][3] + add));
        *(u32x2*)(ycat + (size_t)t * CD_OUT + g * 256 + 16 * nd + 4 * fq) = o; }
}
__device__ __forceinline__ void phase_cd_p1(const Ctx& c, int j) {
    for (int u = c.bid; u < 640; u += c.G) lru_unit(c, u, j);
    if (c.G == 256) {
        if (c.bid < 128) sgu_unit(c, c.bid, j);
        else { for (int q = 0; q < 3; ++q) sgu_unit(c, 128 + (c.bid - 128) * 3 + q, j); }
    } else { for (int u = c.bid; u < 512; u += c.G) sgu_unit(c, u, j); }
}

__device__ __forceinline__ void phase_cd_scan2(const Ctx& c) {
    const bf16_t* gg = (const bf16_t*)(c.ws + CD_GG); bf16_t* ycat = (bf16_t*)(c.ws + WS_YCAT);
    const bf16_t* HL = (const bf16_t*)(c.ws + WS_U2); const bf16_t* PC = HL + (size_t)T * 1280; const float* sum = (const float*)(c.ws + WS_H);
    LAS float* carry = (LAS float*)c.lds;
    for (int u = c.bid; u < 256; u += c.G) {
        const int bn = u >> 1, half = u & 1, b = bn >> 6, n = bn & 63;
        __syncthreads();
        for (int ch = c.tid; ch < 1280; ch += NTHREADS) { float cr = 0.f; const float* sp = sum + ((size_t)(b * 64) * 1280 + ch) * 2;
#pragma unroll 8
            for (int m = 0; m < n; ++m) { const f32x2 v = *(const f32x2*)(sp + (size_t)m * 2560); cr = v[0] * cr + v[1]; }
            carry[ch] = cr; }
        __syncthreads();
        const size_t t0 = (size_t)bn * 128 + half * 64;
#pragma unroll 4
        for (int it = c.tid; it < 64 * 320; it += NTHREADS) { const int r = it / 320, c4 = (it % 320) * 4; const size_t o = (t0 + r) * 1280 + c4;
            const u32x2 hw = *(const u32x2*)(HL + o), pw = *(const u32x2*)(PC + o), gw = *(const u32x2*)(gg + o); const f32x4 cr = *(const LAS f32x4*)(carry + c4);
            const float h0 = __uint_as_float(hw[0] << 16) + __uint_as_float(pw[0] << 16) * cr[0], h1 = __uint_as_float(hw[0] & 0xffff0000u) + __uint_as_float(pw[0] & 0xffff0000u) * cr[1];
            const float h2 = __uint_as_float(hw[1] << 16) + __uint_as_float(pw[1] << 16) * cr[2], h3 = __uint_as_float(hw[1] & 0xffff0000u) + __uint_as_float(pw[1] & 0xffff0000u) * cr[3];
            u32x2 ow; ow[0] = pk2(__uint_as_float(gw[0] << 16) * h0, __uint_as_float(gw[0] & 0xffff0000u) * h1); ow[1] = pk2(__uint_as_float(gw[1] << 16) * h2, __uint_as_float(gw[1] & 0xffff0000u) * h3);
            *(u32x2*)(ycat + (t0 + r) * CD_OUT + 1024 + c4) = ow; }
    }
}

template <bool MOE>
__device__ __forceinline__ void phase_ln(const Ctx& c, const float* g, const float* bta, float* xout) {
    float* x = (float*)(c.ws + WS_X); bf16_t* xb = (bf16_t*)(c.ws + WS_XB);
    const float* hbuf = (const float*)(c.ws + WS_H); const bf16_t* Y = (const bf16_t*)(c.ws + WS_U1);
    for (long tt = (long)c.gw * 2; tt < T; tt += (long)c.nwaves * 2) {
        f32x4 v[2][4];
#pragma unroll
        for (int u = 0; u < 2; ++u) { const long t = tt + u;
#pragma unroll
            for (int q = 0; q < 4; ++q) { const int col = q * 256 + c.lane * 4;
                f32x4 f;
                if (!MOE) f = *(const f32x4*)(hbuf + (size_t)t * D + col);
                else { f = (f32x4){0.f, 0.f, 0.f, 0.f};
#pragma unroll
                    for (int k = 0; k < 9; ++k) { const size_t srow = (k < 8) ? (size_t)t * 8 + k : (size_t)TK + t; const u32x2 w = *(const u32x2*)(Y + srow * D + col);
                        f[0] += __uint_as_float(w[0] << 16); f[1] += __uint_as_float(w[0] & 0xffff0000u); f[2] += __uint_as_float(w[1] << 16); f[3] += __uint_as_float(w[1] & 0xffff0000u); } }
                const f32x4 xv = *(const f32x4*)(x + (size_t)t * D + col);
                v[u][q] = xv * ALPHA + f; } }
#pragma unroll
        for (int u = 0; u < 2; ++u) { const long t = tt + u;
            float sm = 0.f;
#pragma unroll
            for (int q = 0; q < 4; ++q) sm += v[u][q][0] + v[u][q][1] + v[u][q][2] + v[u][q][3];
            const float mean = wave_sum(sm) * (1.f / 1024.f); float sq = 0.f;
#pragma unroll
            for (int q = 0; q < 4; ++q) { v[u][q] = v[u][q] - mean; sq += v[u][q][0] * v[u][q][0] + v[u][q][1] * v[u][q][1] + v[u][q][2] * v[u][q][2] + v[u][q][3] * v[u][q][3]; }
            const float rstd = rsqrtf(wave_sum(sq) * (1.f / 1024.f) + LN_EPS);
#pragma unroll
            for (int q = 0; q < 4; ++q) { const int col = q * 256 + c.lane * 4; const f32x4 gg = *(const f32x4*)(g + col), bb = *(const f32x4*)(bta + col);
                const f32x4 o = v[u][q] * rstd * gg + bb;
                *(f32x4*)(xout + (size_t)t * D + col) = o; if (xout != x) *(f32x4*)(x + (size_t)t * D + col) = o;
                u32x2 w; w[0] = pk2(o[0], o[1]); w[1] = pk2(o[2], o[3]); *(u32x2*)(xb + (size_t)t * D + col) = w; } }
    }
}

__device__ __forceinline__ void phase_ln_route(const Ctx& c, int L) {
    float* x = (float*)(c.ws + WS_X); bf16_t* xb = (bf16_t*)(c.ws + WS_XB); const float* hbuf = (const float*)(c.ws + WS_H);
    const float* g = c.in[19] + (size_t)L * D; const float* bta = c.in[20] + (size_t)L * D; const float* rb = c.in[22] + L * NE;
    const bf16_t* Wr = (const bf16_t*)(c.ws + WS_WRT) + (size_t)L * 256 * D;
    int* cnt = (int*)(c.ws + CTL_CNT) + L * NE * 1024; int* list = (int*)(c.ws + WS_LIST); float* gate = (float*)(c.ws + WS_GATE);
    LAS unsigned char* Xl = c.lds; LAS float* Sc = (LAS float*)c.lds;
    const int lane = c.lane, fr = lane & 15, fq = lane >> 4, w = c.wid;
    for (int grp = c.bid; grp < T / 64; grp += c.G) {
        __syncthreads();
        for (int q8 = 0; q8 < 8; q8 += 4) {
            f32x4 v[4][4];
#pragma unroll
            for (int u = 0; u < 4; ++u) { const size_t t = (size_t)grp * 64 + w * 8 + q8 + u;
#pragma unroll
                for (int q = 0; q < 4; ++q) { const int col = q * 256 + lane * 4; v[u][q] = *(const f32x4*)(x + t * D + col) * ALPHA + *(const f32x4*)(hbuf + t * D + col); } }
#pragma unroll
            for (int u = 0; u < 4; ++u) { const int rr = w * 8 + q8 + u; const size_t t = (size_t)grp * 64 + rr;
                float sm = 0.f;
#pragma unroll
                for (int q = 0; q < 4; ++q) sm += v[u][q][0] + v[u][q][1] + v[u][q][2] + v[u][q][3];
                const float mean = wave_sum(sm) * (1.f / 1024.f); float sq = 0.f;
#pragma unroll
                for (int q = 0; q < 4; ++q) { v[u][q] = v[u][q] - mean; sq += v[u][q][0] * v[u][q][0] + v[u][q][1] * v[u][q][1] + v[u][q][2] * v[u][q][2] + v[u][q][3] * v[u][q][3]; }
                const float rstd = rsqrtf(wave_sum(sq) * (1.f / 1024.f) + LN_EPS);
#pragma unroll
                for (int q = 0; q < 4; ++q) { const int col = q * 256 + lane * 4; const f32x4 o = v[u][q] * rstd * *(const f32x4*)(g + col) + *(const f32x4*)(bta + col);
                    *(f32x4*)(x + t * D + col) = o; u32x2 wv; wv[0] = pk2(o[0], o[1]); wv[1] = pk2(o[2], o[3]); *(u32x2*)(xb + t * D + col) = wv; *(LAS u32x2*)(Xl + rr * 2064 + col * 2) = wv; } } }
        __syncthreads();
        const int st = w & 3, eh = w >> 2;
        f32x4 acc[4];
#pragma unroll
        for (int ne = 0; ne < 4; ++ne) acc[ne] = (f32x4){0.f, 0.f, 0.f, 0.f};
#pragma unroll 8
        for (int ks = 0; ks < 32; ++ks) { const bf16x8 bop = *(const LAS bf16x8*)(Xl + (16 * st + fr) * 2064 + ks * 64 + fq * 16);
#pragma unroll
            for (int ne = 0; ne < 4; ++ne) { const bf16x8 aop = *(const bf16x8*)(Wr + (size_t)(64 * eh + 16 * ne + fr) * D + ks * 32 + fq * 8); acc[ne] = MFMA16(aop, bop, acc[ne]); } }
        __syncthreads();
#pragma unroll
        for (int ne = 0; ne < 4; ++ne) { f32x4 sg; for (int r = 0; r < 4; ++r) sg[r] = sigmoidf_(acc[ne][r]); *(LAS f32x4*)(Sc + (16 * st + fr) * 128 + 64 * eh + 16 * ne + 4 * fq) = sg; }
        __syncthreads();
        LAS int* hist = (LAS int*)(c.lds + 40960); LAS int* gbase = hist + 128; LAS int* sel = gbase + 128; LAS float* selg = (LAS float*)(sel + 512);
        if (c.tid < 128) hist[c.tid] = 0;
        __syncthreads();
        for (int q8 = 0; q8 < 8; ++q8) { const int rr = w * 8 + q8;
            const float s0 = Sc[rr * 128 + lane], s1 = Sc[rr * 128 + 64 + lane];
            float v0 = s0 + rb[lane], v1 = s1 + rb[64 + lane];
            float mysc = 0.f; int myexp = -1; float tot = 0.f;
            for (int k = 0; k < 8; ++k) {
                float bv = v0; int bi = lane; if (v1 > bv) { bv = v1; bi = lane + 64; }
#pragma unroll
                for (int o = 32; o; o >>= 1) { const float ov = __shfl_xor(bv, o); const int oi = __shfl_xor(bi, o); if (ov > bv || (ov == bv && oi < bi)) { bv = ov; bi = oi; } }
                const float sc = __shfl((bi & 64) ? s1 : s0, bi & 63);
                tot += sc;
                if (lane == k) { mysc = sc; myexp = bi; }
                if (lane == (bi & 63)) { if (bi & 64) v1 = -1e30f; else v0 = -1e30f; }
            }
            if (lane < 8) { const int lr = __hip_atomic_fetch_add(&hist[myexp], 1, __ATOMIC_RELAXED, __HIP_MEMORY_SCOPE_WORKGROUP); sel[rr * 8 + lane] = (myexp << 16) | lr; selg[rr * 8 + lane] = mysc / tot * 2.5f; } }
        __syncthreads();
        if (c.tid < 128) gbase[c.tid] = atomicAdd(&cnt[c.tid * 1024], hist[c.tid]);
        __syncthreads();
        { const int sv = sel[c.tid], e = sv >> 16, lr = sv & 0xffff; const int slot = (grp * 64 + (c.tid >> 3)) * 8 + (c.tid & 7);
          list[(size_t)e * LISTCAP + gbase[e] + lr] = slot; gate[slot] = selg[c.tid]; }
    }
}

struct MoeOrder {
    const char* Abase; const char* Bbase; size_t Bstride; int K, NT, NTG, total, G, c, mode;
    LAS int* tab; LAS int* desc;
    __device__ __forceinline__ bool next(int i, g8::Unit& u) const {
        const int ip = i / NTG, q = i - ip * NTG;
        const long L = (long)ip * G + c; if (L >= total || ip >= TAB_SLOTS) return false;
        const int d = desc[ip]; const int e = d >> 12, pn = (d & 15) * NTG + q;
        u.pm = (d >> 4) & 255; u.pn = pn; u.aux = ip; u.A = Abase; u.B = Bbase + (size_t)e * Bstride + (size_t)pn * 256 * K * 2; return true;
    }
    __device__ __forceinline__ void aoff(const g8::Unit& u, int tid, unsigned (&o)[2][2]) const {
#pragma unroll
        for (int i = 0; i < 2; ++i) { int R, C; g8::stage_rc(tid * 16 + i * 8192, R, C);
#pragma unroll
            for (int h = 0; h < 2; ++h) { int s = tab[u.aux * 256 + h * 128 + R]; s = s < 0 ? 0 : s; const int row = mode ? s : (s < TK ? (s >> 3) : s - TK);
                o[h][i] = (unsigned)(row * K + C) * 2u; } }
    }
};
__device__ __forceinline__ void moe_setup(const Ctx& c, MoeOrder& S, const int* cnt, int NT, int NTG) {
    LAS int* pref = (LAS int*)(c.lds + LDS_PREF); LAS int* desc = (LAS int*)(c.lds + LDS_DESC); LAS int* tab = (LAS int*)(c.lds + LDS_TAB);
    const int* list = (const int*)(c.ws + WS_LIST);
    if (c.tid < 64) { int nb[3]; int loc = 0;
#pragma unroll
        for (int q = 0; q < 3; ++q) { const int e = c.tid * 3 + q; int n = 0; if (e < NE) n = cnt[e * 1024]; else if (e == NE) n = T; nb[q] = (n + 255) >> 8; loc += nb[q]; }
        int inc = loc;
#pragma unroll
        for (int o = 1; o < 64; o <<= 1) { const int v = __shfl_up(inc, o); if (c.tid >= o) inc += v; }
        int acc = inc - loc;
#pragma unroll
        for (int q = 0; q < 3; ++q) { const int e = c.tid * 3 + q; if (e <= NE1) pref[e] = acc; acc += nb[q]; } }
    __syncthreads();
    const int NG = NT / NTG; const int total = pref[NE1] * NG;
    LAS float* gtab = (LAS float*)(c.lds + LDS_GTAB); const float* gate = (const float*)(c.ws + WS_GATE);
    S.NT = NT; S.NTG = NTG; S.total = total; S.G = c.G; S.c = c.bid; S.tab = tab; S.desc = desc;
    {
        int sv[TAB_SLOTS / 2];
#pragma unroll
        for (int k = 0; k < TAB_SLOTS / 2; ++k) { const int i = (c.tid >> 8) + 2 * k; sv[k] = -2;
            const long L = (long)i * c.G + c.bid;
            if (L < total) {
                int wgid = (int)L; { const int q = total / 8, r = total % 8, xcd = wgid % 8, off = wgid / 8; wgid = (xcd < r ? xcd * (q + 1) : r * (q + 1) + (xcd - r) * q) + off; }
                const int rbg = wgid / NG, pn = wgid % NG;
                int lo = 0, hi = NE1;
                while (hi - lo > 1) { const int mid = (lo + hi) >> 1; if (pref[mid] <= rbg) lo = mid; else hi = mid; }
                const int e = lo, rb = rbg - pref[e], n = e < NE ? cnt[e * 1024] : T;
                if ((c.tid & 255) == 0) desc[i] = (e << 12) | (rb << 4) | pn;
                const int r = rb * 256 + (c.tid & 255); sv[k] = -1; if (r < n) sv[k] = (e < NE) ? list[(size_t)e * LISTCAP + r] : TK + r; } }
#pragma unroll
        for (int k = 0; k < TAB_SLOTS / 2; ++k) { const int i = (c.tid >> 8) + 2 * k; if (sv[k] != -2) { tab[i * 256 + (c.tid & 255)] = sv[k]; if (S.mode) gtab[i * 256 + (c.tid & 255)] = sv[k] >= 0 ? gate[sv[k]] : 0.f; } }
    }
    __syncthreads();
}
struct EpiMoeGU {
    static constexpr bool PERM = true;
    bf16_t* H; LAS int* tab;
    __device__ __forceinline__ void operator()(const f32x4 (&acc)[2][2][4][2], const g8::Unit& u, int wr, int wc, int fr, int fq) const {
#pragma unroll
        for (int ai = 0; ai < 2; ++ai)
#pragma unroll
            for (int m = 0; m < 4; ++m) { const int r = ai * 128 + wr * 64 + m * 16 + fr; const int s = tab[u.aux * 256 + r];
                if (s >= 0) { u32x4 w;
#pragma unroll
                    for (int n = 0; n < 2; ++n) { const f32x4 g = acc[ai][0][m][n], up = acc[ai][1][m][n];
                        w[2 * n] = pk2(siluf_(g[0]) * up[0], siluf_(g[1]) * up[1]); w[2 * n + 1] = pk2(siluf_(g[2]) * up[2], siluf_(g[3]) * up[3]); }
                    *(u32x4*)(H + (size_t)s * ED + u.pn * 128 + wc * 32 + fq * 8) = w; } }
    }
};
struct EpiMoeDN {
    static constexpr bool PERM = true;
    bf16_t* Y; LAS float* gtab; LAS int* tab;
    __device__ __forceinline__ void operator()(const f32x4 (&acc)[2][2][4][2], const g8::Unit& u, int wr, int wc, int fr, int fq) const {
#pragma unroll
        for (int ai = 0; ai < 2; ++ai)
#pragma unroll
            for (int m = 0; m < 4; ++m) { const int r = ai * 128 + wr * 64 + m * 16 + fr; const int s = tab[u.aux * 256 + r];
                if (s >= 0) { const float gt = gtab[u.aux * 256 + r];
#pragma unroll
                    for (int bj = 0; bj < 2; ++bj) { u32x4 w;
#pragma unroll
                        for (int n = 0; n < 2; ++n) { const f32x4 a = acc[ai][bj][m][n] * gt; w[2 * n] = pk2(a[0], a[1]); w[2 * n + 1] = pk2(a[2], a[3]); }
                        *(u32x4*)(Y + (size_t)s * D + u.pn * 256 + bj * 128 + wc * 32 + fq * 8) = w; } } }
    }
};
__device__ __forceinline__ void phase_moe_gu(const Ctx& c, int L) {
    MoeOrder S; S.Abase = (const char*)(c.ws + WS_XB); S.Bbase = (const char*)(c.ws + WS_WGU) + (size_t)L * NE1 * 512 * D * 2; S.Bstride = (size_t)512 * D * 2; S.K = D; S.mode = 0;
    moe_setup(c, S, (const int*)(c.ws + CTL_CNT) + L * NE * 1024, 2, 1);
    EpiMoeGU E{(bf16_t*)(c.ws + WS_HID), S.tab};
    g8::gemm_phase<EpiMoeGU, MoeOrder>(c.lds + LDS_STAGE, D, S, E);
}
__device__ __forceinline__ void phase_moe_dn(const Ctx& c, int L) {
    MoeOrder S; S.Abase = (const char*)(c.ws + WS_HID); S.Bbase = (const char*)(c.ws + WS_WDN) + (size_t)L * NE1 * D * ED * 2; S.Bstride = (size_t)D * ED * 2; S.K = ED; S.mode = 1;
    moe_setup(c, S, (const int*)(c.ws + CTL_CNT) + L * NE * 1024, 4, 2);
    EpiMoeDN E{(bf16_t*)(c.ws + WS_U1), (LAS float*)(c.lds + LDS_GTAB), S.tab};
    g8::gemm_phase<EpiMoeDN, MoeOrder>(c.lds + LDS_STAGE, ED, S, E);
}

constexpr int PH_PER_LAYER = 9;
constexpr int N_PHASES = 1 + 4 * PH_PER_LAYER;

__global__ void __launch_bounds__(NTHREADS, 2) fwd_kernel(Params p) {
    extern __shared__ __attribute__((aligned(16))) unsigned char lds_raw[];
    LAS unsigned char* const lds0 = (LAS unsigned char*)lds_raw;
    volatile LAS unsigned* misc = (volatile LAS unsigned*)(lds0 + LDS_MISC);
    if (threadIdx.x < 4) misc[threadIdx.x] = 0u;
    __syncthreads();
    const int lo = p.ph_lo, hi = p.ph_hi;
    XcdBarrier bar; bar.bar = (unsigned*)(p.ws + WS_CTL); bar.x = 0; bar.st = misc;
    if (hi - lo > 1) bar = xcd_barrier_post((unsigned*)(p.ws + WS_CTL), misc);
#define MKCTX() Ctx c; { int tid_ = threadIdx.x; asm volatile("" : "+v"(tid_)); int bid_ = blockIdx.x; asm volatile("" : "+s"(bid_)); unsigned long long ws_ = (unsigned long long)p.ws; asm volatile("" : "+s"(ws_)); \
        c.in = p.in; c.out = p.out; c.ws = (unsigned char*)ws_; c.lds = lds0; c.tid = tid_; c.lane = tid_ & 63; c.wid = __builtin_amdgcn_readfirstlane(tid_ >> 6); c.bid = bid_; c.G = gridDim.x; \
        c.gtid = c.bid * NTHREADS + c.tid; c.gthreads = c.G * NTHREADS; c.gw = c.bid * 8 + c.wid; c.nwaves = c.G * 8; } unsigned char* const ws = c.ws; (void)ws
    int id = 0;
#ifndef PMASK
#define PMASK 0xffffffffu
#endif
#ifndef DUPMASK
#define DUPMASK 0u
#endif
#define PHASE(k, body) do { if (((PMASK >> (k)) & 1u) && lo <= id && id < hi) { MKCTX(); body; if ((DUPMASK >> (k)) & 1u) { body; } if (id + 1 < hi) xcd_barrier(bar); } ++id; } while (0)
    PHASE(0, phase_convert(c));
#pragma unroll 1
    for (int L = 0; L < 4; ++L) {
        const int j = L >> 1; const bool cd = (L & 1);
        if (cd) {
            PHASE(1, phase_cd_inproj(c, j));
        } else {
            PHASE(2, phase_ab_inproj(c, j));
        }
        if (!cd) { PHASE(3, phase_ab_p1(c)); PHASE(4, phase_ab_p2(c, j)); PHASE(16, phase_ab_p3(c)); }
        else     { PHASE(5, phase_cd_p1(c, j)); PHASE(15, phase_cd_scan2(c)); id += 1; }
        {
            const size_t Woff = cd ? WS_WCDOUT + (size_t)j * D * CD_OUT * 2 : WS_WABOUT + (size_t)j * D * AB_OUT * 2;
            const int K = cd ? CD_OUT : AB_OUT; const float* bias = cd ? p.in[18] + (size_t)j * D : p.in[5] + (size_t)j * D;
            PHASE(8, phase_dense(c, (const bf16_t*)(ws + WS_YCAT), (const bf16_t*)(ws + Woff), T, D, K, (float*)(ws + WS_H), D, bias));
        }
        PHASE(9, phase_ln_route(c, L));
        PHASE(12, phase_moe_gu(c, L));
        PHASE(13, phase_moe_dn(c, L));
        PHASE(14, phase_ln<true>(c, p.in[29] + (size_t)L * D, p.in[30] + (size_t)L * D, L == 3 ? p.out : (float*)(ws + WS_X)));
    }
#undef PHASE
}

extern "C" void kernel_launch(void* const* d_in, const int* in_sizes, int n_in, void* d_out, int out_size, void* d_ws, size_t ws_size, hipStream_t stream) {
    static int grid = 0;
    if (grid == 0) {
        if (n_in != 31 || out_size != T * D || ws_size < WS_END) { fprintf(stderr, "kernel_launch: unexpected shapes (n_in %d out %d ws %zu need %zu)\n", n_in, out_size, ws_size, (size_t)WS_END); grid = -1; return; }
        int dev = 0, cus = 0, per_cu = 0;
        if (hipGetDevice(&dev) != hipSuccess || hipDeviceGetAttribute(&cus, hipDeviceAttributeMultiprocessorCount, dev) != hipSuccess) { grid = -1; return; }
        if (hipFuncSetAttribute((const void*)fwd_kernel, hipFuncAttributeMaxDynamicSharedMemorySize, LDS_BYTES) != hipSuccess) { fprintf(stderr, "kernel_launch: hipFuncSetAttribute failed\n"); grid = -1; return; }
        if (hipOccupancyMaxActiveBlocksPerMultiprocessor(&per_cu, (const void*)fwd_kernel, NTHREADS, LDS_BYTES) != hipSuccess || per_cu < 1) fprintf(stderr, "kernel_launch: occupancy query says %d\n", per_cu);
        (void)hipGetLastError();
        grid = cus;
    }
    if (grid < 0) return;
    (void)hipMemsetAsync((char*)d_ws + WS_CTL, 0, CTL_BYTES, stream);
    Params p{};
    for (int i = 0; i < 31; ++i) p.in[i] = (const float*)d_in[i];
    p.out = (float*)d_out; p.ws = (unsigned char*)d_ws;
#if N_LAUNCH_MODE == 1
    p.ph_lo = 0; p.ph_hi = N_PHASES;
    hipLaunchKernelGGL(fwd_kernel, dim3(grid), dim3(NTHREADS), LDS_BYTES, stream, p);
#else
    for (int i = 0; i < N_PHASES; ++i) { p.ph_lo = i; p.ph_hi = i + 1; hipLaunchKernelGGL(fwd_kernel, dim3(grid), dim3(NTHREADS), LDS_BYTES, stream, p); }
#endif
}
```

```cpp
#include <hip/hip_runtime.h>
#include <cstdio>
#include <cstdint>

#define LAS __attribute__((address_space(3)))
typedef unsigned short bf16_t;
typedef short bf16x8 __attribute__((ext_vector_type(8)));
typedef float f32x4 __attribute__((ext_vector_type(4)));
typedef float f32x2 __attribute__((ext_vector_type(2)));
typedef unsigned u32x4 __attribute__((ext_vector_type(4)));
typedef unsigned u32x2 __attribute__((ext_vector_type(2)));

constexpr int T = 16384, D = 1024, SEQ = 8192;
constexpr int AB_IN = 4352, AB_OUT = 2048, CD_IN = 4608, CD_OUT = 2304;
constexpr int NE = 128, NE1 = 129, TOPK = 8, ED = 256;
constexpr int TK = T * TOPK;
constexpr int NSLOT = TK + T;
constexpr int LISTCAP = 16384;
constexpr float ALPHA = 1.681792830507429f;
constexpr float LN_EPS = 1e-5f;

#ifndef N_LAUNCH_MODE
#define N_LAUNCH_MODE 1
#endif

constexpr size_t al256(size_t x) { return (x + 255) & ~(size_t)255; }
constexpr size_t WS_CTL    = 0;
constexpr size_t CTL_BYTES = 65536 + (size_t)4 * 128 * 4096;
constexpr size_t CTL_CNT   = 65536;
constexpr size_t WS_WABIN  = CTL_BYTES;
constexpr size_t WS_WABOUT = WS_WABIN  + al256((size_t)2 * AB_IN * D * 2);
constexpr size_t WS_WCDIN  = WS_WABOUT + al256((size_t)2 * D * AB_OUT * 2);
constexpr size_t WS_WCDOUT = WS_WCDIN  + al256((size_t)2 * CD_IN * D * 2);
constexpr size_t WS_WRT    = WS_WCDOUT + al256((size_t)2 * D * CD_OUT * 2);
constexpr size_t WS_WGU    = WS_WRT    + al256((size_t)4 * 256 * D * 2);
constexpr size_t WS_WDN    = WS_WGU    + al256((size_t)4 * NE1 * 512 * D * 2);
constexpr size_t WS_X      = WS_WDN    + al256((size_t)4 * NE1 * D * ED * 2);
constexpr size_t WS_HB     = WS_X;
constexpr size_t WS_XB     = WS_X      + al256((size_t)T * D * 4);
constexpr size_t WS_U1     = WS_XB     + al256((size_t)T * D * 2);
constexpr size_t U1_BYTES  = al256((size_t)NSLOT * D * 2) > al256((size_t)T * CD_IN * 4) ? al256((size_t)NSLOT * D * 2) : al256((size_t)T * CD_IN * 4);
constexpr size_t WS_U2     = WS_U1     + U1_BYTES;
constexpr size_t U2_BYTES  = al256((size_t)T * 1280 * 4 * 3);
constexpr size_t WS_YCAT   = WS_U2     + U2_BYTES;
constexpr size_t WS_H      = WS_YCAT   + al256((size_t)T * CD_OUT * 2);
constexpr size_t WS_ZR     = WS_H      + al256((size_t)T * D * 4);
constexpr size_t WS_HID    = WS_ZR     + al256((size_t)T * 256 * 4);
constexpr size_t WS_LIST   = WS_HID    + al256((size_t)NSLOT * ED * 2);
constexpr size_t WS_GATE   = WS_LIST   + al256((size_t)NE * LISTCAP * 4);
constexpr size_t WS_ROPEA  = WS_GATE   + al256((size_t)NSLOT * 4);
constexpr size_t WS_ROPER  = WS_ROPEA  + al256((size_t)SEQ * 32 * 8);
constexpr size_t WS_BIASP  = WS_ROPER  + al256((size_t)SEQ * 64 * 8);
constexpr size_t WS_WLRU   = WS_BIASP  + al256((size_t)2 * AB_IN * 4);
constexpr size_t WS_SPL    = WS_WLRU   + al256((size_t)2 * 5 * 2 * 65536 * 2);
constexpr size_t WS_END    = WS_SPL    + al256((size_t)2 * 1280 * 4);
constexpr size_t CD_GU = WS_U1, CD_GVT = WS_U1 + 32 * (1024 * 1024), CD_GG = WS_U1 + 64 * (1024 * 1024), CD_XR = WS_U1 + 104 * (1024 * 1024), CD_STATS = WS_U1 + 144 * (1024 * 1024);
constexpr size_t MB = 1024 * 1024;
constexpr size_t AB_QB = WS_U1, AB_KB = WS_U1 + 32 * MB, AB_VT = WS_U1 + 36 * MB, AB_RQB = WS_U1 + 40 * MB, AB_RKB = WS_U1 + 56 * MB, AB_RKDT = WS_U1 + 72 * MB,
                 AB_RVT = WS_U1 + 88 * MB, AB_RGB = WS_U1 + 120 * MB, AB_KV = WS_U1 + 152 * MB  , AB_SPREV = WS_U1 + 216 * MB  ;
static_assert(AB_SPREV + 32 * MB <= WS_U1 + U1_BYTES, "U1 map");

__device__ __forceinline__ float bf2f(bf16_t b) { return __uint_as_float(((unsigned)b) << 16); }
__device__ __forceinline__ bf16_t f2bf(float f) { unsigned u = __float_as_uint(f); u += 0x7FFFu + ((u >> 16) & 1u); return (bf16_t)(u >> 16); }
__device__ __forceinline__ unsigned pk2(float lo, float hi) { return (unsigned)f2bf(lo) | ((unsigned)f2bf(hi) << 16); }
__device__ __forceinline__ float wave_sum(float v) {
#pragma unroll
    for (int o = 32; o; o >>= 1) v += __shfl_xor(v, o);
    return v; }
__device__ __forceinline__ float wave_max(float v) {
#pragma unroll
    for (int o = 32; o; o >>= 1) v = fmaxf(v, __shfl_xor(v, o));
    return v; }
__device__ __forceinline__ float gelu_tanh(float x) { const float u = 0.7978845608028654f * (x + 0.044715f * x * x * x); return 0.5f * x * (1.f + tanhf(u)); }
__device__ __forceinline__ float sigmoidf_(float x) { return 1.f / (1.f + __expf(-x)); }
__device__ __forceinline__ float siluf_(float x) { return x * __builtin_amdgcn_rcpf(1.f + __expf(-x)); }

#define XB_TMO      128
#define XB_XCNT(j)  (256  + 64 * (j))
#define XB_XSUB(j)  (1280 + 64 * (j))
#define XB_XGEN(j)  (2304 + 64 * (j))
#define XB_TOP      3328
#define XB_TOPGEN   3392
#define XCD_BAR_WORDS 3456
#define XB_SPIN_CAP (1u << 22)

__device__ __forceinline__ unsigned xb_ld(unsigned* p)              { return __hip_atomic_load(p, __ATOMIC_RELAXED, __HIP_MEMORY_SCOPE_AGENT); }
__device__ __forceinline__ unsigned xb_add(unsigned* p, unsigned v) { return __hip_atomic_fetch_add(p, v, __ATOMIC_RELAXED, __HIP_MEMORY_SCOPE_AGENT); }
__device__ __forceinline__ unsigned xb_xcc_id() { return (unsigned)__builtin_amdgcn_s_getreg((3 << 11) | 20) & 0xFu; }
#define XB_SPIN(cond, bar) do { unsigned _sp = 0; while (cond) { __builtin_amdgcn_s_sleep(1); \
    if ((++_sp & 255u) == 0u) { if (xb_ld(&(bar)[XB_TMO])) break; if (_sp > XB_SPIN_CAP) { atomicAdd(&(bar)[XB_TMO], 1u); break; } } } } while (0)

struct XcdBarrier { unsigned* bar; unsigned x; volatile LAS unsigned* st; };

__device__ __forceinline__ XcdBarrier xcd_barrier_post(unsigned* bar, volatile LAS unsigned* st) {
    XcdBarrier b; b.bar = bar; b.x = xb_xcc_id(); b.st = st;
    if (threadIdx.x == 0) (void)xb_add(&bar[XB_XCNT(b.x)], 1u);
    return b;
}
__device__ __forceinline__ void xcd_barrier_complete(unsigned* bar, unsigned x, unsigned& nloc, unsigned& nx) {
    const unsigned G = gridDim.x * gridDim.y * gridDim.z;
    unsigned sum, cnt, mine, sp = 0u;
    for (;;) {
        sum = 0u; cnt = 0u; mine = 0u;
#pragma unroll
        for (unsigned j = 0; j < 16; ++j) { const unsigned c = xb_ld(&bar[XB_XCNT(j)]); sum += c; cnt += (c > 0u) ? 1u : 0u; mine = (j == x) ? c : mine; }
        if (sum == G) break;
        __builtin_amdgcn_s_sleep(1);
        if ((++sp & 255u) == 0u) { if (xb_ld(&bar[XB_TMO])) break; if (sp > XB_SPIN_CAP) { atomicAdd(&bar[XB_TMO], 1u); break; } }
    }
    nloc = mine > 0u ? mine : 1u; nx = cnt > 0u ? cnt : 1u;
}
__device__ __forceinline__ void xcd_barrier(const XcdBarrier& b) {
    asm volatile("s_waitcnt vmcnt(0)" ::: "memory");
    __syncthreads();
    if (threadIdx.x == 0) {
        unsigned* bar = b.bar;
        __builtin_amdgcn_s_waitcnt(0);
        unsigned nloc = b.st[0], nx = b.st[1];
        if (nloc == 0u) { xcd_barrier_complete(bar, b.x, nloc, nx); b.st[0] = nloc; b.st[1] = nx; }
        const unsigned old = xb_add(&bar[XB_XSUB(b.x)], 1u);
        const unsigned gen = old / nloc;
        if (old + 1u == (gen + 1u) * nloc) {
            __builtin_amdgcn_fence(__ATOMIC_RELEASE, "agent");
            asm volatile("s_waitcnt vmcnt(0)" ::: "memory");
            const unsigned og = xb_add(&bar[XB_TOP], 1u);
            const unsigned tg = og / nx;
            if (og + 1u == (tg + 1u) * nx) xb_add(&bar[XB_TOPGEN], 1u);
            else XB_SPIN(xb_ld(&bar[XB_TOPGEN]) == tg, bar);
            __builtin_amdgcn_fence(__ATOMIC_ACQUIRE, "agent");
            xb_add(&bar[XB_XGEN(b.x)], 1u);
            asm volatile("s_waitcnt vmcnt(0)" ::: "memory");
        } else {
            XB_SPIN(xb_ld(&bar[XB_XGEN(b.x)]) == gen, bar);
            __builtin_amdgcn_fence(__ATOMIC_ACQUIRE, "agent");
            asm volatile("s_waitcnt vmcnt(0)" ::: "memory");
        }
    }
    __syncthreads();
}

namespace g8 {
constexpr int BM = 256, BK = 64, HALF = 128, HTB = HALF * BK * 2, STAGE_BYTES = 8 * HTB, NXCD = 8, WGM = 8;
__device__ __forceinline__ int lds_byte(int r, int c) { const int st = (r >> 4) * 2 + (c >> 5), rr = r & 15, cc = c & 31, ob = rr * 64 + cc * 2; return st * 1024 + (ob ^ (((ob >> 9) & 1) << 5)); }
__device__ __forceinline__ void stage_rc(int b, int& R, int& C) { const int st = b / 1024, sb = b % 1024, swz = sb ^ (((sb >> 9) & 1) << 5); R = (st >> 1) * 16 + swz / 64; C = (st & 1) * 32 + (swz % 64) / 2; }
__device__ __forceinline__ int perm32(int rho) { const int n = rho >> 4, i = rho & 15; return 8 * (i >> 2) + 4 * n + (i & 3); }

struct Unit { const char* A; const char* B; int pm, pn, aux; };

struct DenseOrder {
    const char* A; const char* Bt; int nM, nN, nwg, G, c, K;
    __device__ void init(const void* A_, const void* Bt_, int M, int N, int K_, int G_, int c_) { A = (const char*)A_; Bt = (const char*)Bt_; nM = M / BM; nN = N / BM; nwg = nM * nN; G = G_; c = c_; K = K_; }
    __device__ __forceinline__ bool next(int i, Unit& u) const {
        const long L = (long)i * G + c; if (L >= nwg) return false;
        int wgid = (int)L; { const int q = nwg / NXCD, r = nwg % NXCD, xcd = wgid % NXCD, off = wgid / NXCD; wgid = (xcd < r ? xcd * (q + 1) : r * (q + 1) + (xcd - r) * q) + off; }
        const int nig = WGM * nN, gid = wgid / nig, fm = gid * WGM, gsz = (nM - fm) < WGM ? (nM - fm) : WGM;
        u.pm = fm + ((wgid % nig) % gsz); u.pn = (wgid % nig) / gsz; u.aux = 0;
        u.A = A + (size_t)u.pm * BM * K * 2; u.B = Bt + (size_t)u.pn * BM * K * 2; return true;
    }
    __device__ __forceinline__ void aoff(const Unit&, int tid, unsigned (&o)[2][2]) const {
#pragma unroll
        for (int i = 0; i < 2; ++i) { int R, C; stage_rc(tid * 16 + i * 8192, R, C);
            o[0][i] = (unsigned)(R * K + C) * 2u; o[1][i] = (unsigned)((R + HALF) * K + C) * 2u; }
    }
};

__device__ __forceinline__ unsigned cvt_pk_bf16(float lo, float hi) { unsigned r; asm volatile("v_cvt_pk_bf16_f32 %0, %1, %2" : "=v"(r) : "v"(lo), "v"(hi)); return r; }

struct EpiF32 {
    static constexpr bool PERM = false;
    float* C; int ldc; const float* bias;
    __device__ __forceinline__ void operator()(const f32x4 (&acc)[2][2][4][2], const Unit& u, int wr, int wc, int fr, int fq) const {
        const int row0 = u.pm * BM + wr * 64 + fr, col0 = u.pn * BM + wc * 32 + 4 * fq;
        f32x4 bv[2][2];
#pragma unroll
        for (int bj = 0; bj < 2; ++bj)
#pragma unroll
            for (int n = 0; n < 2; ++n) bv[bj][n] = bias ? *(const f32x4*)(bias + col0 + bj * HALF + n * 16) : (f32x4){0.f, 0.f, 0.f, 0.f};
#pragma unroll
        for (int ai = 0; ai < 2; ++ai)
#pragma unroll
            for (int m = 0; m < 4; ++m) { float* rowp = C + (size_t)(row0 + ai * HALF + m * 16) * ldc + col0;
#pragma unroll
                for (int bj = 0; bj < 2; ++bj)
#pragma unroll
                    for (int n = 0; n < 2; ++n) *(f32x4*)(rowp + bj * HALF + n * 16) = acc[ai][bj][m][n] + bv[bj][n]; }
    }
};

struct EpiBf16 {
    static constexpr bool PERM = true;
    bf16_t* O; int ldc; const float* bias;
    __device__ __forceinline__ void operator()(const f32x4 (&acc)[2][2][4][2], const Unit& u, int wr, int wc, int fr, int fq) const {
        const int row0 = u.pm * BM + wr * 64 + fr, col0 = u.pn * BM + wc * 32 + 8 * fq;
        f32x4 bv[2][2];
#pragma unroll
        for (int bj = 0; bj < 2; ++bj)
#pragma unroll
            for (int n = 0; n < 2; ++n) bv[bj][n] = *(const f32x4*)(bias + col0 + bj * HALF + 4 * n);
#pragma unroll
        for (int ai = 0; ai < 2; ++ai)
#pragma unroll
            for (int m = 0; m < 4; ++m) { bf16_t* rowp = O + (size_t)(row0 + ai * HALF + m * 16) * ldc + col0;
#pragma unroll
                for (int bj = 0; bj < 2; ++bj) { const f32x4 v0 = acc[ai][bj][m][0] + bv[bj][0], v1 = acc[ai][bj][m][1] + bv[bj][1];
                    u32x4 w; w[0] = cvt_pk_bf16(v0[0], v0[1]); w[1] = cvt_pk_bf16(v0[2], v0[3]); w[2] = cvt_pk_bf16(v1[0], v1[1]); w[3] = cvt_pk_bf16(v1[2], v1[3]);
                    *(u32x4*)(rowp + bj * HALF) = w; } }
    }
};

template <class Epi, class Sched>
__device__ __forceinline__ void gemm_phase(LAS unsigned char* lds, const int K, const Sched& S, const Epi& E) {
    int tid_ = threadIdx.x; asm volatile("" : "+v"(tid_));
    const int tid = tid_, wid = __builtin_amdgcn_readfirstlane(tid >> 6), lane = tid & 63, wr = wid >> 2, wc = wid & 3, fr = lane & 15, fq = lane >> 4;
    const int nt = K / BK;
    unsigned voffB[2];
#pragma unroll
    for (int i = 0; i < 2; ++i) { int R, C; stage_rc(tid * 16 + i * 8192, R, C); const int Rb = Epi::PERM ? ((R & ~31) + perm32(R & 31)) : R;
        voffB[i] = (unsigned)(Rb * K + C) * 2u; }
    const size_t kstep = (size_t)(BK * 2);
    const size_t hstep = (size_t)HALF * K * 2;
    const unsigned ldsw = (unsigned)wid * 1024u;
    const int aoff = lds_byte(wr * 64 + fr, fq * 8), boff = lds_byte(wc * 32 + fr, fq * 8);
#define G8_SA(b, h) (((b) * 2 + (h)) * HTB)
#define G8_SB(b, h) ((4 + (b) * 2 + (h)) * HTB)
#define G8_STAGE(bufoff, gbase, voff) do { _Pragma("unroll") for (int _i = 0; _i < 2; ++_i) \
        __builtin_amdgcn_global_load_lds((const unsigned*)((const char*)(gbase) + (voff)[_i]), (LAS unsigned*)(lds + (bufoff) + ldsw + _i * 8192), 16, 0, 0); } while (0)
#define G8_LDA(dst, b, h) do { _Pragma("unroll") for (int m = 0; m < 4; ++m) _Pragma("unroll") for (int k = 0; k < 2; ++k) dst[m][k] = *(const LAS bf16x8*)(lds + G8_SA(b, h) + aoff + m * 2048 + k * 1024); } while (0)
#define G8_LDB(dst, b, h) do { _Pragma("unroll") for (int n = 0; n < 2; ++n) _Pragma("unroll") for (int k = 0; k < 2; ++k) dst[n][k] = *(const LAS bf16x8*)(lds + G8_SB(b, h) + boff + n * 2048 + k * 1024); } while (0)
#define G8_MMA(ai, bj, At, Bt) do { __builtin_amdgcn_s_setprio(1); _Pragma("unroll") for (int m = 0; m < 4; ++m) _Pragma("unroll") for (int n = 0; n < 2; ++n) _Pragma("unroll") for (int k = 0; k < 2; ++k) \
        acc[ai][bj][m][n] = __builtin_amdgcn_mfma_f32_16x16x32_bf16(Bt[n][k], At[m][k], acc[ai][bj][m][n], 0, 0, 0); __builtin_amdgcn_s_setprio(0); } while (0)
#define G8_WAIT_V(n) asm volatile("s_waitcnt vmcnt(" #n ")" ::: "memory")
#define G8_WAIT_L(n) asm volatile("s_waitcnt lgkmcnt(" #n ")" ::: "memory")
#define G8_BAR __builtin_amdgcn_s_barrier()
#define G8_SCHED __builtin_amdgcn_sched_barrier(0)
    Unit cur, nxt; int ui = 0;
    if (!S.next(0, cur)) return;
    f32x4 acc[2][2][4][2];
#pragma unroll
    for (int a = 0; a < 2; ++a)
#pragma unroll
        for (int b = 0; b < 2; ++b)
#pragma unroll
            for (int m = 0; m < 4; ++m)
#pragma unroll
                for (int n = 0; n < 2; ++n) acc[a][b][m][n] = (f32x4){0.f, 0.f, 0.f, 0.f};
    bf16x8 At[4][2], B0[2][2], B1[2][2];
    unsigned oc[2][2];
    S.aoff(cur, tid, oc);
    const char* cA = cur.A; const char* cB = cur.B;
    G8_STAGE(G8_SB(0, 0), cB, voffB); G8_STAGE(G8_SA(0, 0), cA, oc[0]); G8_STAGE(G8_SB(0, 1), cB + hstep, voffB); G8_STAGE(G8_SA(0, 1), cA, oc[1]);
    if (wr == 1) G8_BAR;
    G8_WAIT_V(4); G8_BAR;
    G8_STAGE(G8_SB(1, 0), cB + kstep, voffB); G8_STAGE(G8_SA(1, 0), cA + kstep, oc[0]); G8_STAGE(G8_SB(1, 1), cB + hstep + kstep, voffB);
    G8_WAIT_V(6); G8_BAR;
    for (;;) {
        const bool has_next = S.next(ui + 1, nxt);
        const char* nA = has_next ? nxt.A : cA; const char* nB = has_next ? nxt.B : cB;
#pragma unroll 1
        for (int t = 0; t < nt; t += 2) {
            const bool last = (t == nt - 2);
            const char* a1 = cA + (size_t)(t + 1) * kstep;
            const char* a2 = last ? nA : cA + (size_t)(t + 2) * kstep; const char* b2 = last ? nB : cB + (size_t)(t + 2) * kstep;
            const char* a3 = a2 + kstep; const char* b3 = b2 + kstep;
            G8_LDB(B0, 0, 0); G8_SCHED; G8_LDA(At, 0, 0); G8_STAGE(G8_SA(1, 1), a1, oc[1]);
            if (last && has_next) S.aoff(nxt, tid, oc);
            G8_WAIT_L(8); G8_BAR; G8_WAIT_L(0); G8_MMA(0, 0, At, B0); G8_BAR; G8_SCHED;
            G8_LDB(B1, 0, 1); G8_STAGE(G8_SB(0, 0), b2, voffB);
            G8_BAR; G8_WAIT_L(0); G8_MMA(0, 1, At, B1); G8_BAR;
            G8_LDA(At, 0, 1); G8_STAGE(G8_SA(0, 0), a2, oc[0]);
            G8_BAR; G8_WAIT_L(0); G8_MMA(1, 0, At, B0); G8_BAR; G8_SCHED;
            G8_STAGE(G8_SB(0, 1), b2 + hstep, voffB);
            G8_WAIT_V(6); G8_BAR; G8_MMA(1, 1, At, B1); G8_BAR;
            G8_LDB(B0, 1, 0); G8_SCHED; G8_LDA(At, 1, 0); G8_STAGE(G8_SA(0, 1), a2, oc[1]);
            G8_WAIT_L(8); G8_BAR; G8_WAIT_L(0); G8_MMA(0, 0, At, B0); G8_BAR; G8_SCHED;
            G8_LDB(B1, 1, 1); G8_STAGE(G8_SB(1, 0), b3, voffB);
            G8_BAR; G8_WAIT_L(0); G8_MMA(0, 1, At, B1); G8_BAR;
            G8_LDA(At, 1, 1); G8_STAGE(G8_SA(1, 0), a3, oc[0]);
            G8_BAR; G8_WAIT_L(0); G8_MMA(1, 0, At, B0); G8_BAR; G8_SCHED;
            G8_STAGE(G8_SB(1, 1), b3 + hstep, voffB);
            G8_WAIT_V(6); G8_BAR; G8_MMA(1, 1, At, B1); G8_BAR;
        }
        E(acc, cur, wr, wc, fr, fq);
        if (!has_next) break;
#pragma unroll
        for (int a = 0; a < 2; ++a)
#pragma unroll
            for (int b = 0; b < 2; ++b)
#pragma unroll
                for (int m = 0; m < 4; ++m)
#pragma unroll
                    for (int n = 0; n < 2; ++n) acc[a][b][m][n] = (f32x4){0.f, 0.f, 0.f, 0.f};
        cur = nxt; cA = nA; cB = nB; ++ui;
    }
    G8_WAIT_V(0);
    if (wr == 0) G8_BAR;
    G8_BAR;
#undef G8_SA
#undef G8_SB
#undef G8_STAGE
#undef G8_LDA
#undef G8_LDB
#undef G8_MMA
#undef G8_WAIT_V
#undef G8_WAIT_L
#undef G8_BAR
#undef G8_SCHED
}
}

constexpr int NTHREADS = 512;
constexpr int LDS_STAGE = 0;
constexpr int LDS_TAB   = g8::STAGE_BYTES;
constexpr int TAB_SLOTS = 6;
constexpr int LDS_GTAB  = LDS_TAB + TAB_SLOTS * 256 * 4;
constexpr int LDS_DESC  = LDS_GTAB + TAB_SLOTS * 256 * 4;
constexpr int LDS_PREF  = LDS_DESC + 64;
constexpr int LDS_MISC  = LDS_PREF + 132 * 4 + 48;
constexpr int LDS_BYTES = 147456;
static_assert(LDS_MISC % 16 == 0 && LDS_MISC + 64 <= LDS_BYTES, "LDS map");

struct Params { const float* in[31]; float* out; unsigned char* ws; int ph_lo, ph_hi; };

struct Ctx {
    const float* const* in; float* out; unsigned char* ws; LAS unsigned char* lds;
    int tid, lane, wid, bid, G, gtid, gthreads, gw, nwaves;
};

__device__ __forceinline__ int ab_phys(int n) {
    if (n < 1024) { const int hd = n >> 6, jj = n & 63; return (hd >> 2) * 256 + (jj >> 5) * 128 + (hd & 3) * 32 + (jj & 31); }
    if (n < 1152) { const int nn = n - 1024, hh = nn >> 6, jj = nn & 63; return 1024 + (jj >> 5) * 128 + hh * 32 + (jj & 31); }
    if (n < 1280) { const int vv = n - 1152; return 1024 + (vv >> 6) * 128 + 64 + (vv & 63); }
    if (n < 2304) { const int base = n < 1792 ? 1280 : 1792, nn = n - base, h = nn >> 7, jj = nn & 127; return base + (h >> 1) * 256 + (jj >> 6) * 128 + (h & 1) * 64 + (jj & 63); }
    return n;
}
template <int TN, class DstFn>
__device__ __forceinline__ void convert_T(const Ctx& c, const float* src, int nmat, int K, int N, DstFn dstfn) {
    LAS float* tile = (LAS float*)(c.lds);
    constexpr int LDT = TN + 1, TPR = TN / 4  , KPI = NTHREADS / TPR  , NI = 64 / KPI, KPT = 64 * TN / NTHREADS  ;
    const int tk = K / 64, tn = N / TN; const long ntiles = (long)nmat * tk * tn;
    for (long tix = c.bid; tix < ntiles; tix += c.G) {
        const int m = (int)(tix / (tk * tn)); const int rem = (int)(tix % (tk * tn)); const int kt = rem / tn, nt = rem % tn;
        const float* s = src + (size_t)m * K * N + (size_t)(kt * 64) * N + nt * TN;
        f32x4 v[NI];
#pragma unroll
        for (int i = 0; i < NI; ++i) { const int k = c.tid / TPR + KPI * i, n4 = (c.tid % TPR) * 4; v[i] = __builtin_nontemporal_load((const f32x4*)(s + (size_t)k * N + n4)); }
#pragma unroll
        for (int i = 0; i < NI; ++i) { const int k = c.tid / TPR + KPI * i, n4 = (c.tid % TPR) * 4;
            tile[k * LDT + n4 + 0] = v[i][0]; tile[k * LDT + n4 + 1] = v[i][1]; tile[k * LDT + n4 + 2] = v[i][2]; tile[k * LDT + n4 + 3] = v[i][3]; }
        __syncthreads();
        { constexpr int TPN = 64 / KPT; const int n = c.tid / TPN, k0 = (c.tid % TPN) * KPT;
          bf16_t* d = dstfn(m, nt * TN + n) + kt * 64 + k0;
#pragma unroll
          for (int q = 0; q < KPT / 8; ++q) { u32x4 w;
#pragma unroll
              for (int e = 0; e < 4; ++e) w[e] = pk2(tile[(k0 + q * 8 + 2 * e) * LDT + n], tile[(k0 + q * 8 + 2 * e + 1) * LDT + n]);
              *(u32x4*)(d + q * 8) = w; } }
        __syncthreads();
    }
}

__device__ __forceinline__ void phase_convert(const Ctx& c) {
    unsigned char* ws = c.ws;
    { const float* x = c.in[0]; bf16_t* xb = (bf16_t*)(ws + WS_XB);
      for (long i = c.gtid; i < (long)T * D / 4; i += c.gthreads) { const f32x4 v = *(const f32x4*)(x + i * 4); u32x2 w; w[0] = pk2(v[0], v[1]); w[1] = pk2(v[2], v[3]); *(u32x2*)(xb + i * 4) = w; } }
    { bf16_t* wrt = (bf16_t*)(ws + WS_WRT); for (long i = c.gtid; i < (long)4 * 128 * D / 8; i += c.gthreads) { const long l = i / (128 * D / 8), r = i % (128 * D / 8); *(u32x4*)(wrt + (size_t)l * 256 * D + (size_t)128 * D + r * 8) = (u32x4){0u, 0u, 0u, 0u}; }
      float* gate = (float*)(ws + WS_GATE); for (int i = c.gtid; i < T; i += c.gthreads) gate[TK + i] = 1.f;
      f32x2* ra = (f32x2*)(ws + WS_ROPEA); f32x2* rr = (f32x2*)(ws + WS_ROPER);
      for (int i = c.gtid; i < SEQ * 96; i += c.gthreads) { const int sidx = i / 96, q = i % 96; const bool isA = q < 32; const int jx = isA ? q : q - 32;
          const float e = isA ? (float)jx * (1.f / 32.f) : (float)jx * (1.f / 63.f); const float ang = (float)sidx * exp2f(-e * 13.287712379549449f); float sn, cs; sincosf(ang, &sn, &cs);
          if (isA) ra[sidx * 32 + jx] = (f32x2){cs, sn}; else rr[sidx * 64 + jx] = (f32x2){cs, sn}; }
      float* bp = (float*)(ws + WS_BIASP); for (int i = c.gtid; i < 2 * AB_IN; i += c.gthreads) { const int m = i / AB_IN, n = i % AB_IN; bp[m * AB_IN + ab_phys(n)] = c.in[2][i]; } }
    { bf16_t* d = (bf16_t*)(ws + WS_WABIN);  convert_T<256>(c, c.in[1], 2, D, AB_IN, [=](int m, int n) { return d + (size_t)m * AB_IN * D + (size_t)ab_phys(n) * D; }); }
    { bf16_t* d = (bf16_t*)(ws + WS_WABOUT); convert_T<256>(c, c.in[4], 2, AB_OUT, D, [=](int m, int n) { return d + (size_t)m * D * AB_OUT + (size_t)n * AB_OUT; }); }
    { bf16_t* d = (bf16_t*)(ws + WS_WCDIN);  convert_T<256>(c, c.in[6], 2, D, CD_IN, [=](int m, int n) { return d + (size_t)m * CD_IN * D + (size_t)n * D; }); }
    { bf16_t* d = (bf16_t*)(ws + WS_WCDOUT); convert_T<256>(c, c.in[17], 2, CD_OUT, D, [=](int m, int n) { return d + (size_t)m * D * CD_OUT + (size_t)n * CD_OUT; }); }
    { bf16_t* d = (bf16_t*)(ws + WS_WRT);    convert_T<128>(c, c.in[21], 4, D, NE, [=](int m, int n) { return d + (size_t)m * 256 * D + (size_t)n * D; }); }
    { bf16_t* d = (bf16_t*)(ws + WS_WGU);
      convert_T<256>(c, c.in[23], 4 * NE, D, ED, [=](int m, int n) { return d + (size_t)((m >> 7) * NE1 + (m & 127)) * 512 * D + (size_t)((n >> 7) * 256 + (n & 127)) * D; });
      convert_T<256>(c, c.in[24], 4 * NE, D, ED, [=](int m, int n) { return d + (size_t)((m >> 7) * NE1 + (m & 127)) * 512 * D + (size_t)((n >> 7) * 256 + 128 + (n & 127)) * D; });
      convert_T<256>(c, c.in[26], 4, D, ED, [=](int m, int n) { return d + (size_t)(m * NE1 + NE) * 512 * D + (size_t)((n >> 7) * 256 + (n & 127)) * D; });
      convert_T<256>(c, c.in[27], 4, D, ED, [=](int m, int n) { return d + (size_t)(m * NE1 + NE) * 512 * D + (size_t)((n >> 7) * 256 + 128 + (n & 127)) * D; }); }
    { bf16_t* d = (bf16_t*)(ws + WS_WLRU);
      convert_T<256>(c, c.in[12], 10, 256, 256, [=](int m, int n) { return d + (size_t)(m * 2 + 0) * 65536 + (size_t)n * 256; });
      convert_T<256>(c, c.in[14], 10, 256, 256, [=](int m, int n) { return d + (size_t)(m * 2 + 1) * 65536 + (size_t)n * 256; });
      float* spl = (float*)(ws + WS_SPL); for (int i = c.gtid; i < 2 * 1280; i += c.gthreads) spl[i] = log1pf(expf(-c.in[16][i])); }
    { bf16_t* d = (bf16_t*)(ws + WS_WDN);
      convert_T<256>(c, c.in[25], 4 * NE, ED, D, [=](int m, int n) { return d + (size_t)((m >> 7) * NE1 + (m & 127)) * D * ED + (size_t)n * ED; });
      convert_T<256>(c, c.in[28], 4, ED, D, [=](int m, int n) { return d + (size_t)(m * NE1 + NE) * D * ED + (size_t)n * ED; }); }
}

__device__ __forceinline__ void phase_dense(const Ctx& c, const bf16_t* A, const bf16_t* Bt, int M, int N, int K, bf16_t* C, int ldc, const float* bias) {
    g8::DenseOrder S; S.init(A, Bt, M, N, K, c.G, c.bid);
    g8::EpiBf16 E{C, ldc, bias};
    g8::gemm_phase<g8::EpiBf16, g8::DenseOrder>(c.lds + LDS_STAGE, K, S, E);
}

struct EpiABIn {
    static constexpr bool PERM = true;
    const float* biasP; unsigned char* ws;
    __device__ __forceinline__ void operator()(const f32x4 (&acc)[2][2][4][2], const g8::Unit& u, int wr, int wc, int fr, int fq) const {
        const int pn = u.pn; const int colp = pn * 256 + wc * 32 + fq * 8;
        f32x4 bv[2][2];
#pragma unroll
        for (int bj = 0; bj < 2; ++bj)
#pragma unroll
            for (int n = 0; n < 2; ++n) bv[bj][n] = *(const f32x4*)(biasP + colp + bj * 128 + 4 * n);
        bf16_t* qb = (bf16_t*)(ws + AB_QB); bf16_t* kb = (bf16_t*)(ws + AB_KB); bf16_t* vT = (bf16_t*)(ws + AB_VT); bf16_t* rqb = (bf16_t*)(ws + AB_RQB); bf16_t* rkb = (bf16_t*)(ws + AB_RKB);
        bf16_t* rkdT = (bf16_t*)(ws + AB_RKDT); bf16_t* rvT = (bf16_t*)(ws + AB_RVT); bf16_t* rgb = (bf16_t*)(ws + AB_RGB);
        const f32x4* ropeA = (const f32x4*)(ws + WS_ROPEA); const f32x4* ropeR = (const f32x4*)(ws + WS_ROPER);
#pragma unroll
        for (int ai = 0; ai < 2; ++ai)
#pragma unroll
            for (int m = 0; m < 4; ++m) {
                const int t = u.pm * 256 + ai * 128 + wr * 64 + m * 16 + fr, sq = t & (SEQ - 1), b = t >> 13;
                f32x4 x[2][2];
#pragma unroll
                for (int bj = 0; bj < 2; ++bj)
#pragma unroll
                    for (int n = 0; n < 2; ++n) x[bj][n] = acc[ai][bj][m][n] + bv[bj][n];
                if (pn < 4 || (pn == 4 && wc < 2)) {
                    const int j0 = fq * 8; f32x4 o1[2], o2[2];
#pragma unroll
                    for (int n = 0; n < 2; ++n) { const f32x4 cs01 = ropeA[(sq * 32 + j0 + 4 * n) / 2], cs23 = ropeA[(sq * 32 + j0 + 4 * n) / 2 + 1];
                        const float cc[4] = {cs01[0], cs01[2], cs23[0], cs23[2]}, ss[4] = {cs01[1], cs01[3], cs23[1], cs23[3]};
#pragma unroll
                        for (int e = 0; e < 4; ++e) { o1[n][e] = x[0][n][e] * cc[e] - x[1][n][e] * ss[e]; o2[n][e] = x[1][n][e] * cc[e] + x[0][n][e] * ss[e]; } }
                    const float sc = pn < 4 ? 0.125f : 1.f;
                    u32x4 w1, w2;
#pragma unroll
                    for (int n = 0; n < 2; ++n) { w1[2 * n] = pk2(o1[n][0] * sc, o1[n][1] * sc); w1[2 * n + 1] = pk2(o1[n][2] * sc, o1[n][3] * sc); w2[2 * n] = pk2(o2[n][0] * sc, o2[n][1] * sc); w2[2 * n + 1] = pk2(o2[n][2] * sc, o2[n][3] * sc); }
                    bf16_t* dst = pn < 4 ? qb + (size_t)t * 1024 + (pn * 4 + wc) * 64 + j0 : kb + (size_t)t * 128 + wc * 64 + j0;
                    *(u32x4*)dst = w1; *(u32x4*)(dst + 32) = w2;
                } else if (pn == 4) {
                    const int d0 = (wc - 2) * 32 + fq * 8;
#pragma unroll
                    for (int bj = 0; bj < 2; ++bj)
#pragma unroll
                        for (int n = 0; n < 2; ++n)
#pragma unroll
                            for (int e = 0; e < 4; ++e) vT[((size_t)(b * 2 + bj) * 64 + d0 + 4 * n + e) * SEQ + sq] = f2bf(x[bj][n][e]);
                } else if (pn < 9) {
                    const bool isk = pn >= 7; const int h = ((pn - 5) & 1) * 2 + (wc >> 1), j0 = (wc & 1) * 32 + fq * 8; f32x4 o1[2], o2[2];
                    const float sc = isk ? 0.08838834764831845f : 1.f;
#pragma unroll
                    for (int n = 0; n < 2; ++n) { const f32x4 cs01 = ropeR[(sq * 64 + j0 + 4 * n) / 2], cs23 = ropeR[(sq * 64 + j0 + 4 * n) / 2 + 1];
                        const float cc[4] = {cs01[0], cs01[2], cs23[0], cs23[2]}, ss[4] = {cs01[1], cs01[3], cs23[1], cs23[3]};
#pragma unroll
                        for (int e = 0; e < 4; ++e) { o1[n][e] = (x[0][n][e] * cc[e] - x[1][n][e] * ss[e]) * sc; o2[n][e] = (x[1][n][e] * cc[e] + x[0][n][e] * ss[e]) * sc; } }
                    u32x4 w1, w2;
#pragma unroll
                    for (int n = 0; n < 2; ++n) { w1[2 * n] = pk2(o1[n][0], o1[n][1]); w1[2 * n + 1] = pk2(o1[n][2], o1[n][3]); w2[2 * n] = pk2(o2[n][0], o2[n][1]); w2[2 * n + 1] = pk2(o2[n][2], o2[n][3]); }
                    bf16_t* dst = (isk ? rkb : rqb) + (size_t)t * 512 + h * 128 + j0;
                    *(u32x4*)dst = w1; *(u32x4*)(dst + 64) = w2;
                    if (isk) {
                        const float lg = log2f(1.f - exp2f(-5.f - (float)h)); const float dec = exp2f((float)(127 - (sq & 127)) * lg);
                        bf16_t* dT = rkdT + ((size_t)(b * 4 + h) * 128 + j0) * SEQ + sq;
#pragma unroll
                        for (int n = 0; n < 2; ++n)
#pragma unroll
                            for (int e = 0; e < 4; ++e) { dT[(size_t)(4 * n + e) * SEQ] = f2bf(o1[n][e] * dec); dT[(size_t)(64 + 4 * n + e) * SEQ] = f2bf(o2[n][e] * dec); }
                    }
                } else if (pn < 13) {
                    const int h = pn - 9;
#pragma unroll
                    for (int bj = 0; bj < 2; ++bj)
#pragma unroll
                        for (int n = 0; n < 2; ++n)
#pragma unroll
                            for (int e = 0; e < 4; ++e) rvT[((size_t)(b * 4 + h) * 256 + bj * 128 + wc * 32 + fq * 8 + 4 * n + e) * SEQ + sq] = f2bf(x[bj][n][e]);
                } else {
#pragma unroll
                    for (int bj = 0; bj < 2; ++bj) { u32x4 w;
#pragma unroll
                        for (int n = 0; n < 2; ++n) { w[2 * n] = pk2(siluf_(x[bj][n][0]), siluf_(x[bj][n][1])); w[2 * n + 1] = pk2(siluf_(x[bj][n][2]), siluf_(x[bj][n][3])); }
                        *(u32x4*)(rgb + (size_t)t * 1024 + (pn - 13) * 256 + bj * 128 + wc * 32 + fq * 8) = w; }
                }
            }
    }
};
__device__ __forceinline__ void phase_ab_inproj(const Ctx& c, int j) {
    g8::DenseOrder S; S.init(c.ws + WS_XB, c.ws + WS_WABIN + (size_t)j * AB_IN * D * 2, T, AB_IN, D, c.G, c.bid);
    EpiABIn E{(const float*)(c.ws + WS_BIASP) + (size_t)j * AB_IN, c.ws};
    g8::gemm_phase<EpiABIn, g8::DenseOrder>(c.lds + LDS_STAGE, D, S, E);
}

#define MFMA16(a, b, c) __builtin_amdgcn_mfma_f32_16x16x32_bf16((a), (b), (c), 0, 0, 0)
__device__ __forceinline__ bf16x8 pack8(const f32x4& lo, const f32x4& hi) { u32x4 w; w[0] = g8::cvt_pk_bf16(lo[0], lo[1]); w[1] = g8::cvt_pk_bf16(lo[2], lo[3]); w[2] = g8::cvt_pk_bf16(hi[0], hi[1]); w[3] = g8::cvt_pk_bf16(hi[2], hi[3]); return __builtin_bit_cast(bf16x8, w); }
__device__ __forceinline__ bf16x8 cat8(const u32x2& lo, const u32x2& hi) { u32x4 w; w[0] = lo[0]; w[1] = lo[1]; w[2] = hi[0]; w[3] = hi[1]; return __builtin_bit_cast(bf16x8, w); }
template <int ROWS, int RB>
__device__ __forceinline__ void tile_g2l(LAS unsigned char* dst, const unsigned char* src, size_t gs, int tid, int zrows = 0) {
    constexpr int CPR = RB / 16, TOTAL = ROWS * CPR;
#pragma unroll 4
    for (int i = tid; i < TOTAL; i += NTHREADS) { const int r = i / CPR, cc = i % CPR; u32x4 v = (u32x4){0u, 0u, 0u, 0u}; if (r >= zrows) v = *(const u32x4*)(src + (size_t)r * gs + cc * 16);
        *(LAS u32x4*)(dst + r * (RB + 16) + cc * 16) = v; }
}

__device__ __forceinline__ void attn_unit(const Ctx& c, int unit, const float* sinks) {
    const int b = unit >> 7, n = (unit >> 1) & 63, kvh = unit & 1, hd = kvh * 8 + c.wid, lane = c.lane, fr = lane & 15, fq = lane >> 4;
    const bf16_t* qb = (const bf16_t*)(c.ws + AB_QB); const bf16_t* kb = (const bf16_t*)(c.ws + AB_KB); const bf16_t* vT = (const bf16_t*)(c.ws + AB_VT); bf16_t* ycat = (bf16_t*)(c.ws + WS_YCAT);
    LAS unsigned char* Ks = c.lds; LAS unsigned char* Vs = c.lds + 256 * 144;
    const int t0 = b * SEQ + n * 128;
    __syncthreads();
    {
        const unsigned char* src = (const unsigned char*)(kb + (size_t)(t0 - 128) * 128 + kvh * 64);
        constexpr int TOTAL = 256 * 8;
#pragma unroll 4
        for (int i = c.tid; i < TOTAL; i += NTHREADS) { const int r = i >> 3, cc = i & 7; u32x4 v = (u32x4){0u, 0u, 0u, 0u}; if (n > 0 || r >= 128) v = *(const u32x4*)(src + (ptrdiff_t)r * 256 + cc * 16);
            *(LAS u32x4*)(Ks + r * 144 + cc * 16) = v; }
        const unsigned char* vsrc = (const unsigned char*)(vT + (size_t)(b * 2 + kvh) * 64 * SEQ + (n * 128 - 128));
        constexpr int TV = 64 * 32;
#pragma unroll 4
        for (int i = c.tid; i < TV; i += NTHREADS) { const int r = i >> 5, cc = i & 31; u32x4 v = (u32x4){0u, 0u, 0u, 0u}; if (n > 0 || cc >= 16) v = *(const u32x4*)(vsrc + (ptrdiff_t)r * SEQ * 2 + cc * 16);
            *(LAS u32x4*)(Vs + r * 528 + cc * 16) = v; }
    }
    __syncthreads();
    const float sink = sinks[hd];
    for (int si = 0; si < 8; ++si) {
        const int t = t0 + si * 16 + fr;
        bf16x8 qf[2];
#pragma unroll
        for (int ks = 0; ks < 2; ++ks) qf[ks] = *(const bf16x8*)(qb + (size_t)t * 1024 + hd * 64 + ks * 32 + fq * 8);
        f32x4 S[10];
#pragma unroll
        for (int nk = 0; nk < 9; ++nk) { S[nk] = (f32x4){0.f, 0.f, 0.f, 0.f};
#pragma unroll
            for (int ks = 0; ks < 2; ++ks) { const bf16x8 a = *(const LAS bf16x8*)(Ks + (16 * (si + nk) + fr) * 144 + ks * 64 + fq * 16); S[nk] = MFMA16(a, qf[ks], S[nk]); } }
        S[9] = (f32x4){0.f, 0.f, 0.f, 0.f};
        const int i = si * 16 + fr;
        float mx = sink;
#pragma unroll
        for (int nk = 0; nk < 9; ++nk)
#pragma unroll
            for (int r = 0; r < 4; ++r) { const int p = 16 * (si + nk) + 4 * fq + r; const bool ok = (p >= i + 1) && (p <= i + 128) && (n > 0 || p >= 128);
                S[nk][r] = ok ? S[nk][r] : -1e30f; mx = fmaxf(mx, S[nk][r]); }
        mx = fmaxf(mx, __shfl_xor(mx, 16)); mx = fmaxf(mx, __shfl_xor(mx, 32));
        float sum = 0.f;
#pragma unroll
        for (int nk = 0; nk < 9; ++nk)
#pragma unroll
            for (int r = 0; r < 4; ++r) { const float pv = S[nk][r] > -1e29f ? exp2f((S[nk][r] - mx) * 1.4426950408889634f) : 0.f; S[nk][r] = pv; sum += pv; }
        sum += __shfl_xor(sum, 16); sum += __shfl_xor(sum, 32);
        const float inv = 1.f / (sum + exp2f((sink - mx) * 1.4426950408889634f));
        f32x4 O[4];
#pragma unroll
        for (int nd = 0; nd < 4; ++nd) O[nd] = (f32x4){0.f, 0.f, 0.f, 0.f};
#pragma unroll
        for (int kk = 0; kk < 5; ++kk) { const bf16x8 pf = pack8(S[2 * kk], S[2 * kk + 1]);
            const int p0 = 16 * (si + 2 * kk) + 4 * fq, p1 = (kk == 4 && si == 7) ? p0 : p0 + 16;
#pragma unroll
            for (int nd = 0; nd < 4; ++nd) { const u32x2 lo = *(const LAS u32x2*)(Vs + (16 * nd + fr) * 528 + p0 * 2), hi = *(const LAS u32x2*)(Vs + (16 * nd + fr) * 528 + p1 * 2);
                O[nd] = MFMA16(cat8(lo, hi), pf, O[nd]); } }
#pragma unroll
        for (int nd = 0; nd < 4; ++nd) { u32x2 w; w[0] = pk2(O[nd][0] * inv, O[nd][1] * inv); w[1] = pk2(O[nd][2] * inv, O[nd][3] * inv);
            *(u32x2*)(ycat + (size_t)t * AB_OUT + hd * 64 + 16 * nd + 4 * fq) = w; }
    }
}

__device__ __forceinline__ void ret_kv_unit(const Ctx& c, int unit) {
    const int b = unit >> 8, n = (unit >> 2) & 63, h = unit & 3, lane = c.lane, fr = lane & 15, fq = lane >> 4, w = c.wid;
    const bf16_t* rkdT = (const bf16_t*)(c.ws + AB_RKDT); const bf16_t* rvT = (const bf16_t*)(c.ws + AB_RVT); float* kv = (float*)(c.ws + AB_KV);
    LAS unsigned char* Kd = c.lds;
    __syncthreads();
    tile_g2l<128, 256>(Kd, (const unsigned char*)(rkdT + (size_t)(b * 4 + h) * 128 * SEQ + n * 128), (size_t)SEQ * 2, c.tid);
    bf16x8 vf[2][4];
#pragma unroll
    for (int ne = 0; ne < 2; ++ne)
#pragma unroll
        for (int ks = 0; ks < 4; ++ks) vf[ne][ks] = *(const bf16x8*)(rvT + ((size_t)(b * 4 + h) * 256 + 32 * w + 16 * ne + fr) * SEQ + n * 128 + ks * 32 + fq * 8);
    __syncthreads();
    float* out = kv + ((size_t)((b * 64 + n) * 4 + h)) * 256 * 128;
#pragma unroll
    for (int nd = 0; nd < 8; ++nd) { f32x4 a0 = (f32x4){0.f, 0.f, 0.f, 0.f}, a1 = a0;
#pragma unroll
        for (int ks = 0; ks < 4; ++ks) { const bf16x8 kf = *(const LAS bf16x8*)(Kd + (16 * nd + fr) * 272 + ks * 64 + fq * 16); a0 = MFMA16(kf, vf[0][ks], a0); a1 = MFMA16(kf, vf[1][ks], a1); }
        *(f32x4*)(out + (size_t)(32 * w + fr) * 128 + 16 * nd + 4 * fq) = a0; *(f32x4*)(out + (size_t)(32 * w + 16 + fr) * 128 + 16 * nd + 4 * fq) = a1; }
}
__device__ __forceinline__ void ret_scan(const Ctx& c, int first_block, int nblocks) {
    const float* kv = (const float*)(c.ws + AB_KV); bf16_t* sp = (bf16_t*)(c.ws + AB_SPREV);
    const int nthr = nblocks * NTHREADS;
    for (int idx = (c.bid - first_block) * NTHREADS + c.tid; idx < 2 * 4 * 256 * 128 / 4; idx += nthr) {
        const int b = idx >> 15, rem = idx & 32767, h = rem >> 13;
        const float g = exp2f(128.f * log2f(1.f - exp2f(-5.f - (float)h)));
        const size_t base = (size_t)b * 64 * 131072 + (size_t)rem * 4;
        f32x4 st = (f32x4){0.f, 0.f, 0.f, 0.f};
        for (int n0 = 0; n0 < 64; n0 += 8) { f32x4 v[8];
#pragma unroll
            for (int q = 0; q < 8; ++q) v[q] = *(const f32x4*)(kv + base + (size_t)(n0 + q) * 131072);
#pragma unroll
            for (int q = 0; q < 8; ++q) { u32x2 wv; wv[0] = pk2(st[0], st[1]); wv[1] = pk2(st[2], st[3]); *(u32x2*)(sp + base + (size_t)(n0 + q) * 131072) = wv; st = st * g + v[q]; } }
    }
}
__device__ __forceinline__ void ret_out_unit(const Ctx& c, int unit) {
    const int b = unit >> 8, n = (unit >> 2) & 63, h = unit & 3, lane = c.lane, fr = lane & 15, fq = lane >> 4, w = c.wid;
    const bf16_t* rqb = (const bf16_t*)(c.ws + AB_RQB); const bf16_t* rkb = (const bf16_t*)(c.ws + AB_RKB); const bf16_t* rvT = (const bf16_t*)(c.ws + AB_RVT);
    const bf16_t* sp = (const bf16_t*)(c.ws + AB_SPREV); const bf16_t* rgb = (const bf16_t*)(c.ws + AB_RGB); bf16_t* ycat = (bf16_t*)(c.ws + WS_YCAT);
    LAS unsigned char* Kl = c.lds; LAS unsigned char* Bl = c.lds + 128 * 272;
    const int t0 = b * SEQ + n * 128; const float lg = log2f(1.f - exp2f(-5.f - (float)h));
    __syncthreads();
    tile_g2l<128, 256>(Kl, (const unsigned char*)(rkb + (size_t)t0 * 512 + h * 128), (size_t)512 * 2, c.tid);
    tile_g2l<256, 256>(Bl, (const unsigned char*)(sp + ((size_t)((b * 64 + n) * 4 + h)) * 256 * 128), (size_t)128 * 2, c.tid);
    const int t = t0 + 16 * w + fr, i = 16 * w + fr;
    bf16x8 qf[4];
#pragma unroll
    for (int ks = 0; ks < 4; ++ks) qf[ks] = *(const bf16x8*)(rqb + (size_t)t * 512 + h * 128 + ks * 32 + fq * 8);
    __syncthreads();
    bf16x8 pf[4];
#pragma unroll
    for (int kk = 0; kk < 4; ++kk) { f32x4 s2[2];
#pragma unroll
        for (int q = 0; q < 2; ++q) { const int nj = 2 * kk + q; s2[q] = (f32x4){0.f, 0.f, 0.f, 0.f};
            if (nj <= w) {
#pragma unroll
                for (int ks = 0; ks < 4; ++ks) { const bf16x8 kf = *(const LAS bf16x8*)(Kl + (16 * nj + fr) * 272 + ks * 64 + fq * 16); s2[q] = MFMA16(kf, qf[ks], s2[q]); }
#pragma unroll
                for (int r = 0; r < 4; ++r) { const int jj = 16 * nj + 4 * fq + r; s2[q][r] = (i >= jj) ? s2[q][r] * exp2f((float)(i - jj) * lg) : 0.f; } } }
        pf[kk] = pack8(s2[0], s2[1]); }
    f32x4 acc[16];
#pragma unroll
    for (int ne = 0; ne < 16; ++ne) { acc[ne] = (f32x4){0.f, 0.f, 0.f, 0.f};
#pragma unroll
        for (int ks = 0; ks < 4; ++ks) { const bf16x8 sf = *(const LAS bf16x8*)(Bl + (16 * ne + fr) * 272 + ks * 64 + fq * 16); acc[ne] = MFMA16(sf, qf[ks], acc[ne]); } }
    const float rs = exp2f((float)(i + 1) * lg);
#pragma unroll
    for (int ne = 0; ne < 16; ++ne) acc[ne] = acc[ne] * rs;
    __syncthreads();
    tile_g2l<256, 256>(Bl, (const unsigned char*)(rvT + (size_t)(b * 4 + h) * 256 * SEQ + n * 128), (size_t)SEQ * 2, c.tid);
    __syncthreads();
    const int nkk = (w >> 1) + 1;
#pragma unroll
    for (int kk = 0; kk < 4; ++kk) if (kk < nkk) {
#pragma unroll
        for (int ne = 0; ne < 16; ++ne) { const u32x2 lo = *(const LAS u32x2*)(Bl + (16 * ne + fr) * 272 + (32 * kk + 4 * fq) * 2), hi = *(const LAS u32x2*)(Bl + (16 * ne + fr) * 272 + (32 * kk + 16 + 4 * fq) * 2);
            acc[ne] = MFMA16(cat8(lo, hi), pf[kk], acc[ne]); } }
    float sm = 0.f;
#pragma unroll
    for (int ne = 0; ne < 16; ++ne) sm += acc[ne][0] + acc[ne][1] + acc[ne][2] + acc[ne][3];
    sm += __shfl_xor(sm, 16); sm += __shfl_xor(sm, 32);
    const float mean = sm * (1.f / 256.f); float sq = 0.f;
#pragma unroll
    for (int ne = 0; ne < 16; ++ne) { acc[ne] = acc[ne] - mean; sq += acc[ne][0] * acc[ne][0] + acc[ne][1] * acc[ne][1] + acc[ne][2] * acc[ne][2] + acc[ne][3] * acc[ne][3]; }
    sq += __shfl_xor(sq, 16); sq += __shfl_xor(sq, 32);
    const float rstd = rsqrtf(sq * (1.f / 256.f) + LN_EPS);
#pragma unroll
    for (int ne = 0; ne < 16; ++ne) { const u32x2 gw = *(const u32x2*)(rgb + (size_t)t * 1024 + h * 256 + 16 * ne + 4 * fq);
        const float g0 = __uint_as_float(gw[0] << 16), g1 = __uint_as_float(gw[0] & 0xffff0000u), g2 = __uint_as_float(gw[1] << 16), g3 = __uint_as_float(gw[1] & 0xffff0000u);
        u32x2 o; o[0] = pk2(acc[ne][0] * rstd * g0, acc[ne][1] * rstd * g1); o[1] = pk2(acc[ne][2] * rstd * g2, acc[ne][3] * rstd * g3);
        *(u32x2*)(ycat + (size_t)t * AB_OUT + 1024 + h * 256 + 16 * ne + 4 * fq) = o; }
}

__device__ __forceinline__ void phase_ab_p1(const Ctx& c) {
    for (int u = c.bid; u < 512; u += c.G) ret_kv_unit(c, u);
}
__device__ __forceinline__ void phase_ab_p2(const Ctx& c, int j) {
    if (c.bid < 64) ret_scan(c, 0, 64);
    else { const float* sinks = c.in[3] + j * 16; for (int u = c.bid - 64; u < 256; u += c.G - 64) attn_unit(c, u, sinks); }
}
__device__ __forceinline__ void phase_ab_p3(const Ctx& c) {
    for (int u = c.bid; u < 512; u += c.G) ret_out_unit(c, u);
}

__device__ __forceinline__ float gelu_fast(float x) { const float u = 1.5957691216057308f * (x + 0.044715f * x * x * x); return x / (1.f + __expf(-u)); }
struct EpiCDIn {
    static constexpr bool PERM = true;
    const float* bias; unsigned char* ws;
    __device__ __forceinline__ void operator()(const f32x4 (&acc)[2][2][4][2], const g8::Unit& u, int wr, int wc, int fr, int fq) const {
        const int pn = u.pn; const int col0 = pn * 256 + wc * 32 + fq * 8;
        f32x4 bv[2][2];
#pragma unroll
        for (int bj = 0; bj < 2; ++bj)
#pragma unroll
            for (int n = 0; n < 2; ++n) bv[bj][n] = *(const f32x4*)(bias + col0 + bj * 128 + 4 * n);
        bf16_t* gu = (bf16_t*)(ws + CD_GU); bf16_t* gvT = (bf16_t*)(ws + CD_GVT); bf16_t* gg = (bf16_t*)(ws + CD_GG); bf16_t* xr = (bf16_t*)(ws + CD_XR); float* stats = (float*)(ws + CD_STATS);
#pragma unroll
        for (int ai = 0; ai < 2; ++ai)
#pragma unroll
            for (int m = 0; m < 4; ++m) {
                const int t = u.pm * 256 + ai * 128 + wr * 64 + m * 16 + fr, sq = t & (SEQ - 1), b = t >> 13;
                f32x4 x[2][2];
#pragma unroll
                for (int bj = 0; bj < 2; ++bj)
#pragma unroll
                    for (int n = 0; n < 2; ++n) { x[bj][n] = acc[ai][bj][m][n] + bv[bj][n];
                        if (pn < 13) {
#pragma unroll
                            for (int e = 0; e < 4; ++e) x[bj][n][e] = gelu_fast(x[bj][n][e]); } }
                if (pn >= 4 && pn < 8) {
                    float s1 = 0.f, s2 = 0.f;
#pragma unroll
                    for (int bj = 0; bj < 2; ++bj)
#pragma unroll
                        for (int n = 0; n < 2; ++n)
#pragma unroll
                            for (int e = 0; e < 4; ++e) { const float v = x[bj][n][e]; s1 += v; s2 += v * v;
                                gvT[((size_t)b * 1024 + (pn - 4) * 256 + bj * 128 + wc * 32 + fq * 8 + 4 * n + e) * SEQ + sq] = f2bf(v); }
                    s1 += __shfl_xor(s1, 16); s1 += __shfl_xor(s1, 32); s2 += __shfl_xor(s2, 16); s2 += __shfl_xor(s2, 32);
                    if (fq == 0) *(f32x2*)(stats + (size_t)t * 32 + ((pn - 4) * 4 + wc) * 2) = (f32x2){s1, s2};
                } else {
                    bf16_t* dst; int ld, cb;
                    if (pn < 4) { dst = gu; ld = 1024; cb = pn * 256; } else if (pn < 13) { dst = gg; ld = 1280; cb = (pn - 8) * 256; } else { dst = xr; ld = 1280; cb = (pn - 13) * 256; }
#pragma unroll
                    for (int bj = 0; bj < 2; ++bj) { u32x4 w;
#pragma unroll
                        for (int n = 0; n < 2; ++n) { w[2 * n] = pk2(x[bj][n][0], x[bj][n][1]); w[2 * n + 1] = pk2(x[bj][n][2], x[bj][n][3]); }
                        *(u32x4*)(dst + (size_t)t * ld + cb + bj * 128 + wc * 32 + fq * 8) = w; }
                }
            }
    }
};
__device__ __forceinline__ void phase_cd_inproj(const Ctx& c, int j) {
    g8::DenseOrder S; S.init(c.ws + WS_XB, c.ws + WS_WCDIN + (size_t)j * CD_IN * D * 2, T, CD_IN, D, c.G, c.bid);
    EpiCDIn E{c.in[7] + (size_t)j * CD_IN, c.ws};
    g8::gemm_phase<EpiCDIn, g8::DenseOrder>(c.lds + LDS_STAGE, D, S, E);
}

__device__ __forceinline__ void lru_unit(const Ctx& c, int unit, int j) {
    const int hh = unit % 5, bn = unit / 5, lane = c.lane, fr = lane & 15, fq = lane >> 4, w = c.wid;
    const int t0 = bn * 128, s0 = t0 & (SEQ - 1);
    const bf16_t* xr = (const bf16_t*)(c.ws + CD_XR); bf16_t* HL = (bf16_t*)(c.ws + WS_U2); bf16_t* PC = HL + (size_t)T * 1280; float* sum = (float*)(c.ws + WS_H);
    const float* conv_w = c.in[10] + (size_t)j * 4 * 1280 + hh * 256; const float* conv_b = c.in[11] + (size_t)j * 1280 + hh * 256;
    const float* ba = c.in[13] + (size_t)j * 1280 + hh * 256; const float* bx = c.in[15] + (size_t)j * 1280 + hh * 256; const float* spl = (const float*)(c.ws + WS_SPL) + (size_t)j * 1280 + hh * 256;
    const bf16_t* Wl = (const bf16_t*)(c.ws + WS_WLRU) + (size_t)((j * 5 + hh) * 2) * 65536;
    LAS unsigned char* Xc = c.lds; LAS unsigned char* Wa = c.lds + 128 * 528; LAS unsigned char* Wx = Wa + 64 * 528; LAS unsigned char* Tot = Wx + 64 * 528;
    __syncthreads();
    {
        const int cg = c.tid & 31, r0 = (c.tid >> 5) * 8;
        float wv[4][8], bv8[8];
        { const f32x4 b0 = *(const f32x4*)(conv_b + cg * 8), b1 = *(const f32x4*)(conv_b + cg * 8 + 4); bv8[0] = b0[0]; bv8[1] = b0[1]; bv8[2] = b0[2]; bv8[3] = b0[3]; bv8[4] = b1[0]; bv8[5] = b1[1]; bv8[6] = b1[2]; bv8[7] = b1[3]; }
#pragma unroll
        for (int k = 0; k < 4; ++k) { const f32x4 w0 = *(const f32x4*)(conv_w + k * 1280 + cg * 8), w1 = *(const f32x4*)(conv_w + k * 1280 + cg * 8 + 4);
            wv[k][0] = w0[0]; wv[k][1] = w0[1]; wv[k][2] = w0[2]; wv[k][3] = w0[3]; wv[k][4] = w1[0]; wv[k][5] = w1[1]; wv[k][6] = w1[2]; wv[k][7] = w1[3]; }
        u32x4 xin[11];
#pragma unroll
        for (int q = 0; q < 11; ++q) { xin[q] = (u32x4){0u, 0u, 0u, 0u}; if (s0 + r0 - 3 + q >= 0) xin[q] = *(const u32x4*)(xr + (size_t)(t0 + r0 - 3 + q) * 1280 + hh * 256 + cg * 8); }
#pragma unroll
        for (int rr = 0; rr < 8; ++rr) { float a[8];
#pragma unroll
            for (int e = 0; e < 8; ++e) a[e] = bv8[e];
#pragma unroll
            for (int k = 0; k < 4; ++k) { const u32x4 xv = xin[rr + k];
#pragma unroll
                for (int e2 = 0; e2 < 4; ++e2) { a[2 * e2] += wv[k][2 * e2] * __uint_as_float(xv[e2] << 16); a[2 * e2 + 1] += wv[k][2 * e2 + 1] * __uint_as_float(xv[e2] & 0xffff0000u); } }
            u32x4 o; o[0] = pk2(a[0], a[1]); o[1] = pk2(a[2], a[3]); o[2] = pk2(a[4], a[5]); o[3] = pk2(a[6], a[7]);
            *(LAS u32x4*)(Xc + (r0 + rr) * 528 + cg * 16) = o; }
    }
    u32x4 wreg[8];
#pragma unroll
    for (int q = 0; q < 4; ++q) { const int i = c.tid + q * NTHREADS, r = i >> 5, cc = i & 31; wreg[q] = *(const u32x4*)((const unsigned char*)Wl + (size_t)r * 512 + cc * 16); wreg[4 + q] = *(const u32x4*)((const unsigned char*)(Wl + 65536) + (size_t)r * 512 + cc * 16); }
    __syncthreads();
    bf16x8 xf[8];
#pragma unroll
    for (int ks = 0; ks < 8; ++ks) xf[ks] = *(const LAS bf16x8*)(Xc + (16 * w + fr) * 528 + ks * 64 + fq * 16);
    const int t = t0 + 16 * w + fr;
    for (int sl = 0; sl < 4; ++sl) {
        if (sl) __syncthreads();
#pragma unroll
        for (int q = 0; q < 4; ++q) { const int i = c.tid + q * NTHREADS, r = i >> 5, cc = i & 31; *(LAS u32x4*)(Wa + r * 528 + cc * 16) = wreg[q]; *(LAS u32x4*)(Wx + r * 528 + cc * 16) = wreg[4 + q]; }
        if (sl < 3) {
#pragma unroll
            for (int q = 0; q < 4; ++q) { const int i = c.tid + q * NTHREADS, r = i >> 5, cc = i & 31;
                wreg[q] = *(const u32x4*)((const unsigned char*)(Wl + (size_t)((sl + 1) * 64) * 256) + (size_t)r * 512 + cc * 16); wreg[4 + q] = *(const u32x4*)((const unsigned char*)(Wl + 65536 + (size_t)((sl + 1) * 64) * 256) + (size_t)r * 512 + cc * 16); } }
        __syncthreads();
        f32x4 sA[4], sB[4];
#pragma unroll
        for (int nc = 0; nc < 4; ++nc) { f32x4 ra = (f32x4){0.f, 0.f, 0.f, 0.f}, ri = ra;
#pragma unroll
            for (int ks = 0; ks < 8; ++ks) { const bf16x8 wa = *(const LAS bf16x8*)(Wa + (16 * nc + fr) * 528 + ks * 64 + fq * 16), wx = *(const LAS bf16x8*)(Wx + (16 * nc + fr) * 528 + ks * 64 + fq * 16);
                ra = MFMA16(wa, xf[ks], ra); ri = MFMA16(wx, xf[ks], ri); }
            const int ch = sl * 64 + 16 * nc + 4 * fq;
            const f32x4 b_a = *(const f32x4*)(ba + ch), b_x = *(const f32x4*)(bx + ch), sp = *(const f32x4*)(spl + ch);
            const u32x2 xw = *(const LAS u32x2*)(Xc + (16 * w + fr) * 528 + ch * 2);
            const float xcv[4] = {__uint_as_float(xw[0] << 16), __uint_as_float(xw[0] & 0xffff0000u), __uint_as_float(xw[1] << 16), __uint_as_float(xw[1] & 0xffff0000u)};
            f32x4 oa, ob;
#pragma unroll
            for (int r = 0; r < 4; ++r) { const float gr = sigmoidf_(ra[r] + b_a[r]), gi = sigmoidf_(ri[r] + b_x[r]); const float la = -8.f * gr * sp[r]; const float a = __expf(la);
                oa[r] = a; ob[r] = sqrtf(fmaxf(1.f - a * a, 0.f)) * (gi * xcv[r]); }
#pragma unroll
            for (int dlt = 1; dlt < 16; dlt <<= 1) {
#pragma unroll
                for (int r = 0; r < 4; ++r) { const float pa = __shfl_up(oa[r], dlt, 16), pb = __shfl_up(ob[r], dlt, 16); if (fr >= dlt) { ob[r] = oa[r] * pb + ob[r]; oa[r] = oa[r] * pa; } } }
            sA[nc] = oa; sB[nc] = ob;
            if (fr == 15) { *(LAS f32x4*)(Tot + ((w * 64 + 16 * nc + 4 * fq) * 2) * 4) = oa; *(LAS f32x4*)(Tot + ((w * 64 + 16 * nc + 4 * fq) * 2 + 4) * 4) = ob; }
        }
        __syncthreads();
#pragma unroll
        for (int nc = 0; nc < 4; ++nc) { const int ch = sl * 64 + 16 * nc + 4 * fq;
            f32x4 cp = (f32x4){1.f, 1.f, 1.f, 1.f}, chh = (f32x4){0.f, 0.f, 0.f, 0.f};
            for (int w2 = 0; w2 < w; ++w2) { const f32x4 ta = *(const LAS f32x4*)(Tot + ((w2 * 64 + 16 * nc + 4 * fq) * 2) * 4), tb = *(const LAS f32x4*)(Tot + ((w2 * 64 + 16 * nc + 4 * fq) * 2 + 4) * 4);
                chh = ta * chh + tb; cp = cp * ta; }
            const f32x4 hl = sB[nc] + sA[nc] * chh, pc = sA[nc] * cp;
            u32x2 o1, o2; o1[0] = pk2(hl[0], hl[1]); o1[1] = pk2(hl[2], hl[3]); o2[0] = pk2(pc[0], pc[1]); o2[1] = pk2(pc[2], pc[3]);
            *(u32x2*)(HL + (size_t)t * 1280 + hh * 256 + ch) = o1; *(u32x2*)(PC + (size_t)t * 1280 + hh * 256 + ch) = o2;
            if (w == 7 && fr == 15) { float* sm = sum + ((size_t)bn * 1280 + hh * 256 + ch) * 2;
#pragma unroll
                for (int r = 0; r < 4; ++r) { sm[2 * r] = pc[r]; sm[2 * r + 1] = hl[r]; } } }
    }
}

__device__ __forceinline__ void sgu_unit(const Ctx& c, int unit, int j) {
    const int g = unit & 3, bn = unit >> 2, b = bn >> 6, n = bn & 63, lane = c.lane, fr = lane & 15, fq = lane >> 4, w = c.wid;
    const int t0 = bn * 128;
    const bf16_t* gu = (const bf16_t*)(c.ws + CD_GU); const bf16_t* gvT = (const bf16_t*)(c.ws + CD_GVT); const float* stats = (const float*)(c.ws + CD_STATS); bf16_t* ycat = (bf16_t*)(c.ws + WS_YCAT);
    const float* sw = c.in[8] + (size_t)(j * 4 + g) * 16384; const float* sb = c.in[9] + (size_t)(j * 4 + g) * 128;
    LAS unsigned char* Vt = c.lds; LAS float* mr = (LAS float*)(c.lds + 256 * 272);
    __syncthreads();
    tile_g2l<256, 256>(Vt, (const unsigned char*)(gvT + ((size_t)b * 1024 + g * 256) * SEQ + n * 128), (size_t)SEQ * 2, c.tid);
    if (c.tid < 128) { const float* st = stats + (size_t)(t0 + c.tid) * 32; float s1 = 0.f, s2 = 0.f;
#pragma unroll
        for (int q = 0; q < 16; ++q) { s1 += st[2 * q]; s2 += st[2 * q + 1]; }
        const float mean = s1 * (1.f / 1024.f), var = fmaxf(s2 * (1.f / 1024.f) - mean * mean, 0.f); mr[2 * c.tid] = mean; mr[2 * c.tid + 1] = rsqrtf(var + LN_EPS); }
    __syncthreads();
    const int i = 16 * w + fr, t = t0 + i, nks = (w >> 1) + 1;
    bf16x8 wf[4]; float ci = 0.f;
#pragma unroll
    for (int ks = 0; ks < 4; ++ks) { f32x4 lo = (f32x4){0.f, 0.f, 0.f, 0.f}, hi = lo;
        if (ks < nks) { const int j0 = ks * 32 + fq * 8; const f32x4 w0 = *(const f32x4*)(sw + (size_t)i * 128 + j0), w1 = *(const f32x4*)(sw + (size_t)i * 128 + j0 + 4);
#pragma unroll
            for (int e = 0; e < 4; ++e) { const float m0 = mr[2 * (j0 + e)], r0 = mr[2 * (j0 + e) + 1], m1 = mr[2 * (j0 + 4 + e)], r1 = mr[2 * (j0 + 4 + e) + 1];
                lo[e] = (j0 + e <= i) ? w0[e] * r0 : 0.f; hi[e] = (j0 + 4 + e <= i) ? w1[e] * r1 : 0.f; ci += lo[e] * m0 + hi[e] * m1; } }
        wf[ks] = pack8(lo, hi); }
    ci += __shfl_xor(ci, 16); ci += __shfl_xor(ci, 32);
    const float add = sb[i] - ci;
    f32x4 acc[16];
#pragma unroll
    for (int nd = 0; nd < 16; ++nd) { acc[nd] = (f32x4){0.f, 0.f, 0.f, 0.f};
#pragma unroll
        for (int ks = 0; ks < 4; ++ks) if (ks < nks) { const bf16x8 vf = *(const LAS bf16x8*)(Vt + (16 * nd + fr) * 272 + ks * 64 + fq * 16); acc[nd] = MFMA16(vf, wf[ks], acc[nd]); } }
#pragma unroll
    for (int nd = 0; nd < 16; ++nd) { const u32x2 uw = *(const u32x2*)(gu + (size_t)t * 1024 + g * 256 + 16 * nd + 4 * fq);
        const float u0 = __uint_as_float(uw[0] << 16), u1 = __uint_as_float(uw[0] & 0xffff0000u), u2 = __uint_as_float(uw[1] << 16), u3 = __uint_as_float(uw[1] & 0xffff0000u);
        u32x2 o; o[0] = pk2(u0 * (acc[nd][0] + add), u1 * (acc[nd][1] + add)); o[1] = pk2(u2 * (acc[nd][2] + add), u3 * (acc[nd][3] + add));
        *(u32x2*)(ycat + (size_t)t * CD_OUT + g * 256 + 16 * nd + 4 * fq) = o; }
}
__device__ __forceinline__ void phase_cd_p1(const Ctx& c, int j) {
    for (int u = c.bid; u < 640; u += c.G) lru_unit(c, u, j);
    if (c.G == 256) {
        if (c.bid < 128) sgu_unit(c, c.bid, j);
        else { for (int q = 0; q < 3; ++q) sgu_unit(c, 128 + (c.bid - 128) * 3 + q, j); }
    } else { for (int u = c.bid; u < 512; u += c.G) sgu_unit(c, u, j); }
}

__device__ __forceinline__ void phase_cd_scan2(const Ctx& c) {
    const bf16_t* gg = (const bf16_t*)(c.ws + CD_GG); bf16_t* ycat = (bf16_t*)(c.ws + WS_YCAT);
    const bf16_t* HL = (const bf16_t*)(c.ws + WS_U2); const bf16_t* PC = HL + (size_t)T * 1280; const float* sum = (const float*)(c.ws + WS_H);
    LAS float* carry = (LAS float*)c.lds;
    for (int u = c.bid; u < 256; u += c.G) {
        const int bn = u >> 1, half = u & 1, b = bn >> 6, n = bn & 63;
        __syncthreads();
        for (int ch = c.tid; ch < 1280; ch += NTHREADS) { float cr = 0.f; const float* sp = sum + ((size_t)(b * 64) * 1280 + ch) * 2;
#pragma unroll 8
            for (int m = 0; m < n; ++m) { const f32x2 v = *(const f32x2*)(sp + (size_t)m * 2560); cr = v[0] * cr + v[1]; }
            carry[ch] = cr; }
        __syncthreads();
        const size_t t0 = (size_t)bn * 128 + half * 64;
#pragma unroll 4
        for (int it = c.tid; it < 64 * 320; it += NTHREADS) { const int r = it / 320, c4 = (it % 320) * 4; const size_t o = (t0 + r) * 1280 + c4;
            const u32x2 hw = *(const u32x2*)(HL + o), pw = *(const u32x2*)(PC + o), gw = *(const u32x2*)(gg + o); const f32x4 cr = *(const LAS f32x4*)(carry + c4);
            const float h0 = __uint_as_float(hw[0] << 16) + __uint_as_float(pw[0] << 16) * cr[0], h1 = __uint_as_float(hw[0] & 0xffff0000u) + __uint_as_float(pw[0] & 0xffff0000u) * cr[1];
            const float h2 = __uint_as_float(hw[1] << 16) + __uint_as_float(pw[1] << 16) * cr[2], h3 = __uint_as_float(hw[1] & 0xffff0000u) + __uint_as_float(pw[1] & 0xffff0000u) * cr[3];
            u32x2 ow; ow[0] = pk2(__uint_as_float(gw[0] << 16) * h0, __uint_as_float(gw[0] & 0xffff0000u) * h1); ow[1] = pk2(__uint_as_float(gw[1] << 16) * h2, __uint_as_float(gw[1] & 0xffff0000u) * h3);
            *(u32x2*)(ycat + (t0 + r) * CD_OUT + 1024 + c4) = ow; }
    }
}

template <bool MOE>
__device__ __forceinline__ void phase_ln(const Ctx& c, const float* g, const float* bta, float* xout) {
    bf16_t* xb = (bf16_t*)(c.ws + WS_XB);
    const bf16_t* hbuf = (const bf16_t*)(c.ws + WS_HB); const bf16_t* Y = (const bf16_t*)(c.ws + WS_U1);
    for (long tt = (long)c.gw * 2; tt < T; tt += (long)c.nwaves * 2) {
        f32x4 v[2][4];
#pragma unroll
        for (int u = 0; u < 2; ++u) { const long t = tt + u;
#pragma unroll
            for (int q = 0; q < 4; ++q) { const int col = q * 256 + c.lane * 4;
                f32x4 f;
                if (!MOE) { const u32x2 hw = *(const u32x2*)(hbuf + (size_t)t * D + col); f = (f32x4){__uint_as_float(hw[0] << 16), __uint_as_float(hw[0] & 0xffff0000u), __uint_as_float(hw[1] << 16), __uint_as_float(hw[1] & 0xffff0000u)}; }
                else { f = (f32x4){0.f, 0.f, 0.f, 0.f};
#pragma unroll
                    for (int k = 0; k < 9; ++k) { const size_t srow = (k < 8) ? (size_t)t * 8 + k : (size_t)TK + t; const u32x2 w = *(const u32x2*)(Y + srow * D + col);
                        f[0] += __uint_as_float(w[0] << 16); f[1] += __uint_as_float(w[0] & 0xffff0000u); f[2] += __uint_as_float(w[1] << 16); f[3] += __uint_as_float(w[1] & 0xffff0000u); } }
                const u32x2 xw = *(const u32x2*)(xb + (size_t)t * D + col); const f32x4 xv = (f32x4){__uint_as_float(xw[0] << 16), __uint_as_float(xw[0] & 0xffff0000u), __uint_as_float(xw[1] << 16), __uint_as_float(xw[1] & 0xffff0000u)};
                v[u][q] = xv * ALPHA + f; } }
#pragma unroll
        for (int u = 0; u < 2; ++u) { const long t = tt + u;
            float sm = 0.f;
#pragma unroll
            for (int q = 0; q < 4; ++q) sm += v[u][q][0] + v[u][q][1] + v[u][q][2] + v[u][q][3];
            const float mean = wave_sum(sm) * (1.f / 1024.f); float sq = 0.f;
#pragma unroll
            for (int q = 0; q < 4; ++q) { v[u][q] = v[u][q] - mean; sq += v[u][q][0] * v[u][q][0] + v[u][q][1] * v[u][q][1] + v[u][q][2] * v[u][q][2] + v[u][q][3] * v[u][q][3]; }
            const float rstd = rsqrtf(wave_sum(sq) * (1.f / 1024.f) + LN_EPS);
#pragma unroll
            for (int q = 0; q < 4; ++q) { const int col = q * 256 + c.lane * 4; const f32x4 gg = *(const f32x4*)(g + col), bb = *(const f32x4*)(bta + col);
                const f32x4 o = v[u][q] * rstd * gg + bb;
                if (xout) *(f32x4*)(xout + (size_t)t * D + col) = o;
                u32x2 w; w[0] = pk2(o[0], o[1]); w[1] = pk2(o[2], o[3]); *(u32x2*)(xb + (size_t)t * D + col) = w; } }
    }
}

__device__ __forceinline__ void phase_ln_route(const Ctx& c, int L) {
    bf16_t* xb = (bf16_t*)(c.ws + WS_XB); const bf16_t* hbuf = (const bf16_t*)(c.ws + WS_HB);
    const float* g = c.in[19] + (size_t)L * D; const float* bta = c.in[20] + (size_t)L * D; const float* rb = c.in[22] + L * NE;
    const bf16_t* Wr = (const bf16_t*)(c.ws + WS_WRT) + (size_t)L * 256 * D;
    int* cnt = (int*)(c.ws + CTL_CNT) + L * NE * 1024; int* list = (int*)(c.ws + WS_LIST); float* gate = (float*)(c.ws + WS_GATE);
    LAS unsigned char* Xl = c.lds; LAS float* Sc = (LAS float*)c.lds;
    const int lane = c.lane, fr = lane & 15, fq = lane >> 4, w = c.wid;
    for (int grp = c.bid; grp < T / 64; grp += c.G) {
        __syncthreads();
        for (int q8 = 0; q8 < 8; q8 += 4) {
            f32x4 v[4][4];
#pragma unroll
            for (int u = 0; u < 4; ++u) { const size_t t = (size_t)grp * 64 + w * 8 + q8 + u;
#pragma unroll
                for (int q = 0; q < 4; ++q) { const int col = q * 256 + lane * 4; const u32x2 xw = *(const u32x2*)(xb + t * D + col), hw = *(const u32x2*)(hbuf + t * D + col);
                    v[u][q] = (f32x4){__uint_as_float(xw[0] << 16), __uint_as_float(xw[0] & 0xffff0000u), __uint_as_float(xw[1] << 16), __uint_as_float(xw[1] & 0xffff0000u)} * ALPHA + (f32x4){__uint_as_float(hw[0] << 16), __uint_as_float(hw[0] & 0xffff0000u), __uint_as_float(hw[1] << 16), __uint_as_float(hw[1] & 0xffff0000u)}; } }
#pragma unroll
            for (int u = 0; u < 4; ++u) { const int rr = w * 8 + q8 + u; const size_t t = (size_t)grp * 64 + rr;
                float sm = 0.f;
#pragma unroll
                for (int q = 0; q < 4; ++q) sm += v[u][q][0] + v[u][q][1] + v[u][q][2] + v[u][q][3];
                const float mean = wave_sum(sm) * (1.f / 1024.f); float sq = 0.f;
#pragma unroll
                for (int q = 0; q < 4; ++q) { v[u][q] = v[u][q] - mean; sq += v[u][q][0] * v[u][q][0] + v[u][q][1] * v[u][q][1] + v[u][q][2] * v[u][q][2] + v[u][q][3] * v[u][q][3]; }
                const float rstd = rsqrtf(wave_sum(sq) * (1.f / 1024.f) + LN_EPS);
#pragma unroll
                for (int q = 0; q < 4; ++q) { const int col = q * 256 + lane * 4; const f32x4 o = v[u][q] * rstd * *(const f32x4*)(g + col) + *(const f32x4*)(bta + col);
                    u32x2 wv; wv[0] = pk2(o[0], o[1]); wv[1] = pk2(o[2], o[3]); *(u32x2*)(xb + t * D + col) = wv; *(LAS u32x2*)(Xl + rr * 2064 + col * 2) = wv; } } }
        __syncthreads();
        const int st = w & 3, eh = w >> 2;
        f32x4 acc[4];
#pragma unroll
        for (int ne = 0; ne < 4; ++ne) acc[ne] = (f32x4){0.f, 0.f, 0.f, 0.f};
        const int rot = (grp * 5 + w * 3) & 31;
#pragma unroll 8
        for (int k0 = 0; k0 < 32; ++k0) { const int ks = (k0 + rot) & 31; const bf16x8 bop = *(const LAS bf16x8*)(Xl + (16 * st + fr) * 2064 + ks * 64 + fq * 16);
#pragma unroll
            for (int ne = 0; ne < 4; ++ne) { const bf16x8 aop = *(const bf16x8*)(Wr + (size_t)(64 * eh + 16 * ne + fr) * D + ks * 32 + fq * 8); acc[ne] = MFMA16(aop, bop, acc[ne]); } }
        __syncthreads();
#pragma unroll
        for (int ne = 0; ne < 4; ++ne) { f32x4 sg; for (int r = 0; r < 4; ++r) sg[r] = sigmoidf_(acc[ne][r]); *(LAS f32x4*)(Sc + (16 * st + fr) * 128 + 64 * eh + 16 * ne + 4 * fq) = sg; }
        __syncthreads();
        LAS int* hist = (LAS int*)(c.lds + 40960); LAS int* gbase = hist + 128; LAS int* sel = gbase + 128; LAS float* selg = (LAS float*)(sel + 512);
        if (c.tid < 128) hist[c.tid] = 0;
        __syncthreads();
        {
            float s0[8], s1[8], v0[8], v1[8], mysc[8], tot[8]; int myexp[8];
            const float rb0 = rb[lane], rb1 = rb[64 + lane];
#pragma unroll
            for (int q = 0; q < 8; ++q) { const int rr = w * 8 + q; s0[q] = Sc[rr * 128 + lane]; s1[q] = Sc[rr * 128 + 64 + lane]; v0[q] = s0[q] + rb0; v1[q] = s1[q] + rb1; mysc[q] = 0.f; tot[q] = 0.f; myexp[q] = 0; }
            for (int k = 0; k < 8; ++k) {
                float bv[8]; int bi[8];
#pragma unroll
                for (int q = 0; q < 8; ++q) { bv[q] = v0[q]; bi[q] = lane; if (v1[q] > bv[q]) { bv[q] = v1[q]; bi[q] = lane + 64; } }
#pragma unroll
                for (int o = 32; o; o >>= 1) {
#pragma unroll
                    for (int q = 0; q < 8; ++q) { const float ov = __shfl_xor(bv[q], o); const int oi = __shfl_xor(bi[q], o); if (ov > bv[q] || (ov == bv[q] && oi < bi[q])) { bv[q] = ov; bi[q] = oi; } } }
#pragma unroll
                for (int q = 0; q < 8; ++q) { const float sc = __shfl((bi[q] & 64) ? s1[q] : s0[q], bi[q] & 63);
                    tot[q] += sc;
                    if (lane == k) { mysc[q] = sc; myexp[q] = bi[q]; }
                    if (lane == (bi[q] & 63)) { if (bi[q] & 64) v1[q] = -1e30f; else v0[q] = -1e30f; } }
            }
            if (lane < 8) {
#pragma unroll
                for (int q = 0; q < 8; ++q) { const int rr = w * 8 + q; const int lr = __hip_atomic_fetch_add(&hist[myexp[q]], 1, __ATOMIC_RELAXED, __HIP_MEMORY_SCOPE_WORKGROUP);
                    sel[rr * 8 + lane] = (myexp[q] << 16) | lr; selg[rr * 8 + lane] = mysc[q] / tot[q] * 2.5f; } }
        }
        __syncthreads();
        if (c.tid < 128) gbase[c.tid] = atomicAdd(&cnt[c.tid * 1024], hist[c.tid]);
        __syncthreads();
        { const int sv = sel[c.tid], e = sv >> 16, lr = sv & 0xffff; const int slot = (grp * 64 + (c.tid >> 3)) * 8 + (c.tid & 7);
          list[(size_t)e * LISTCAP + gbase[e] + lr] = slot; gate[slot] = selg[c.tid]; }
    }
}

struct MoeOrder {
    const char* Abase; const char* Bbase; size_t Bstride; int K, NT, NTG, total, G, c, mode;
    LAS int* tab; LAS int* desc;
    __device__ __forceinline__ bool next(int i, g8::Unit& u) const {
        const int ip = i / NTG, q = i - ip * NTG;
        const long L = (long)ip * G + c; if (L >= total || ip >= TAB_SLOTS) return false;
        const int d = desc[ip]; const int e = d >> 12, pn = (d & 15) * NTG + q;
        u.pm = (d >> 4) & 255; u.pn = pn; u.aux = ip; u.A = Abase; u.B = Bbase + (size_t)e * Bstride + (size_t)pn * 256 * K * 2; return true;
    }
    __device__ __forceinline__ void aoff(const g8::Unit& u, int tid, unsigned (&o)[2][2]) const {
#pragma unroll
        for (int i = 0; i < 2; ++i) { int R, C; g8::stage_rc(tid * 16 + i * 8192, R, C);
#pragma unroll
            for (int h = 0; h < 2; ++h) { int s = tab[u.aux * 256 + h * 128 + R]; s = s < 0 ? 0 : s; const int row = mode ? s : (s < TK ? (s >> 3) : s - TK);
                o[h][i] = (unsigned)(row * K + C) * 2u; } }
    }
};
__device__ __forceinline__ void moe_setup(const Ctx& c, MoeOrder& S, const int* cnt, int NT, int NTG) {
    LAS int* pref = (LAS int*)(c.lds + LDS_PREF); LAS int* desc = (LAS int*)(c.lds + LDS_DESC); LAS int* tab = (LAS int*)(c.lds + LDS_TAB);
    const int* list = (const int*)(c.ws + WS_LIST);
    if (c.tid < 64) { int nb[3]; int loc = 0;
#pragma unroll
        for (int q = 0; q < 3; ++q) { const int e = c.tid * 3 + q; int n = 0; if (e < NE) n = cnt[e * 1024]; else if (e == NE) n = T; nb[q] = (n + 255) >> 8; loc += nb[q]; }
        int inc = loc;
#pragma unroll
        for (int o = 1; o < 64; o <<= 1) { const int v = __shfl_up(inc, o); if (c.tid >= o) inc += v; }
        int acc = inc - loc;
#pragma unroll
        for (int q = 0; q < 3; ++q) { const int e = c.tid * 3 + q; if (e <= NE1) pref[e] = acc; acc += nb[q]; } }
    __syncthreads();
    const int NG = NT / NTG; const int total = pref[NE1] * NG;
    LAS float* gtab = (LAS float*)(c.lds + LDS_GTAB); const float* gate = (const float*)(c.ws + WS_GATE);
    S.NT = NT; S.NTG = NTG; S.total = total; S.G = c.G; S.c = c.bid; S.tab = tab; S.desc = desc;
    {
        int sv[TAB_SLOTS / 2];
#pragma unroll
        for (int k = 0; k < TAB_SLOTS / 2; ++k) { const int i = (c.tid >> 8) + 2 * k; sv[k] = -2;
            const long L = (long)i * c.G + c.bid;
            if (L < total) {
                int wgid = (int)L; { const int q = total / 8, r = total % 8, xcd = wgid % 8, off = wgid / 8; wgid = (xcd < r ? xcd * (q + 1) : r * (q + 1) + (xcd - r) * q) + off; }
                const int rbg = wgid / NG, pn = wgid % NG;
                int lo = 0, hi = NE1;
                while (hi - lo > 1) { const int mid = (lo + hi) >> 1; if (pref[mid] <= rbg) lo = mid; else hi = mid; }
                const int e = lo, rb = rbg - pref[e], n = e < NE ? cnt[e * 1024] : T;
                if ((c.tid & 255) == 0) desc[i] = (e << 12) | (rb << 4) | pn;
                const int r = rb * 256 + (c.tid & 255); sv[k] = -1; if (r < n) sv[k] = (e < NE) ? list[(size_t)e * LISTCAP + r] : TK + r; } }
#pragma unroll
        for (int k = 0; k < TAB_SLOTS / 2; ++k) { const int i = (c.tid >> 8) + 2 * k; if (sv[k] != -2) { tab[i * 256 + (c.tid & 255)] = sv[k]; if (S.mode) gtab[i * 256 + (c.tid & 255)] = sv[k] >= 0 ? gate[sv[k]] : 0.f; } }
    }
    __syncthreads();
}
struct EpiMoeGU {
    static constexpr bool PERM = true;
    bf16_t* H; LAS int* tab;
    __device__ __forceinline__ void operator()(const f32x4 (&acc)[2][2][4][2], const g8::Unit& u, int wr, int wc, int fr, int fq) const {
#pragma unroll
        for (int ai = 0; ai < 2; ++ai)
#pragma unroll
            for (int m = 0; m < 4; ++m) { const int r = ai * 128 + wr * 64 + m * 16 + fr; const int s = tab[u.aux * 256 + r];
                if (s >= 0) { u32x4 w;
#pragma unroll
                    for (int n = 0; n < 2; ++n) { const f32x4 g = acc[ai][0][m][n], up = acc[ai][1][m][n];
                        w[2 * n] = pk2(siluf_(g[0]) * up[0], siluf_(g[1]) * up[1]); w[2 * n + 1] = pk2(siluf_(g[2]) * up[2], siluf_(g[3]) * up[3]); }
                    *(u32x4*)(H + (size_t)s * ED + u.pn * 128 + wc * 32 + fq * 8) = w; } }
    }
};
struct EpiMoeDN {
    static constexpr bool PERM = true;
    bf16_t* Y; LAS float* gtab; LAS int* tab;
    __device__ __forceinline__ void operator()(const f32x4 (&acc)[2][2][4][2], const g8::Unit& u, int wr, int wc, int fr, int fq) const {
#pragma unroll
        for (int ai = 0; ai < 2; ++ai)
#pragma unroll
            for (int m = 0; m < 4; ++m) { const int r = ai * 128 + wr * 64 + m * 16 + fr; const int s = tab[u.aux * 256 + r];
                if (s >= 0) { const float gt = gtab[u.aux * 256 + r];
#pragma unroll
                    for (int bj = 0; bj < 2; ++bj) { u32x4 w;
#pragma unroll
                        for (int n = 0; n < 2; ++n) { const f32x4 a = acc[ai][bj][m][n] * gt; w[2 * n] = pk2(a[0], a[1]); w[2 * n + 1] = pk2(a[2], a[3]); }
                        *(u32x4*)(Y + (size_t)s * D + u.pn * 256 + bj * 128 + wc * 32 + fq * 8) = w; } } }
    }
};
__device__ __forceinline__ void phase_moe_gu(const Ctx& c, int L) {
    MoeOrder S; S.Abase = (const char*)(c.ws + WS_XB); S.Bbase = (const char*)(c.ws + WS_WGU) + (size_t)L * NE1 * 512 * D * 2; S.Bstride = (size_t)512 * D * 2; S.K = D; S.mode = 0;
    moe_setup(c, S, (const int*)(c.ws + CTL_CNT) + L * NE * 1024, 2, 1);
    EpiMoeGU E{(bf16_t*)(c.ws + WS_HID), S.tab};
    g8::gemm_phase<EpiMoeGU, MoeOrder>(c.lds + LDS_STAGE, D, S, E);
}
__device__ __forceinline__ void phase_moe_dn(const Ctx& c, int L) {
    MoeOrder S; S.Abase = (const char*)(c.ws + WS_HID); S.Bbase = (const char*)(c.ws + WS_WDN) + (size_t)L * NE1 * D * ED * 2; S.Bstride = (size_t)D * ED * 2; S.K = ED; S.mode = 1;
    moe_setup(c, S, (const int*)(c.ws + CTL_CNT) + L * NE * 1024, 4, 2);
    EpiMoeDN E{(bf16_t*)(c.ws + WS_U1), (LAS float*)(c.lds + LDS_GTAB), S.tab};
    g8::gemm_phase<EpiMoeDN, MoeOrder>(c.lds + LDS_STAGE, ED, S, E);
}

constexpr int PH_PER_LAYER = 9;
constexpr int N_PHASES = 1 + 4 * PH_PER_LAYER;

__global__ void __launch_bounds__(NTHREADS, 2) fwd_kernel(Params p) {
    extern __shared__ __attribute__((aligned(16))) unsigned char lds_raw[];
    LAS unsigned char* const lds0 = (LAS unsigned char*)lds_raw;
    volatile LAS unsigned* misc = (volatile LAS unsigned*)(lds0 + LDS_MISC);
    if (threadIdx.x < 4) misc[threadIdx.x] = 0u;
    __syncthreads();
    const int lo = p.ph_lo, hi = p.ph_hi;
    XcdBarrier bar; bar.bar = (unsigned*)(p.ws + WS_CTL); bar.x = 0; bar.st = misc;
    if (hi - lo > 1) bar = xcd_barrier_post((unsigned*)(p.ws + WS_CTL), misc);
#define MKCTX() Ctx c; { int tid_ = threadIdx.x; asm volatile("" : "+v"(tid_)); int bid_ = blockIdx.x; asm volatile("" : "+s"(bid_)); unsigned long long ws_ = (unsigned long long)p.ws; asm volatile("" : "+s"(ws_)); \
        c.in = p.in; c.out = p.out; c.ws = (unsigned char*)ws_; c.lds = lds0; c.tid = tid_; c.lane = tid_ & 63; c.wid = __builtin_amdgcn_readfirstlane(tid_ >> 6); c.bid = bid_; c.G = gridDim.x; \
        c.gtid = c.bid * NTHREADS + c.tid; c.gthreads = c.G * NTHREADS; c.gw = c.bid * 8 + c.wid; c.nwaves = c.G * 8; } unsigned char* const ws = c.ws; (void)ws
    int id = 0;
#ifndef PMASK
#define PMASK 0xffffffffu
#endif
#ifndef DUPMASK
#define DUPMASK 0u
#endif
#define PHASE(k, body) do { if (((PMASK >> (k)) & 1u) && lo <= id && id < hi) { MKCTX(); body; if ((DUPMASK >> (k)) & 1u) { body; } if (id + 1 < hi) xcd_barrier(bar); } ++id; } while (0)
    PHASE(0, phase_convert(c));
#pragma unroll 1
    for (int L = 0; L < 4; ++L) {
        const int j = L >> 1; const bool cd = (L & 1);
        if (cd) {
            PHASE(1, phase_cd_inproj(c, j));
        } else {
            PHASE(2, phase_ab_inproj(c, j));
        }
        if (!cd) { PHASE(3, phase_ab_p1(c)); PHASE(4, phase_ab_p2(c, j)); PHASE(16, phase_ab_p3(c)); }
        else     { PHASE(5, phase_cd_p1(c, j)); PHASE(15, phase_cd_scan2(c)); id += 1; }
        {
            const size_t Woff = cd ? WS_WCDOUT + (size_t)j * D * CD_OUT * 2 : WS_WABOUT + (size_t)j * D * AB_OUT * 2;
            const int K = cd ? CD_OUT : AB_OUT; const float* bias = cd ? p.in[18] + (size_t)j * D : p.in[5] + (size_t)j * D;
            PHASE(8, phase_dense(c, (const bf16_t*)(ws + WS_YCAT), (const bf16_t*)(ws + Woff), T, D, K, (bf16_t*)(ws + WS_HB), D, bias));
        }
        PHASE(9, phase_ln_route(c, L));
        PHASE(12, phase_moe_gu(c, L));
        PHASE(13, phase_moe_dn(c, L));
        PHASE(14, phase_ln<true>(c, p.in[29] + (size_t)L * D, p.in[30] + (size_t)L * D, L == 3 ? p.out : (float*)nullptr));
    }
#undef PHASE
}

extern "C" void kernel_launch(void* const* d_in, const int* in_sizes, int n_in, void* d_out, int out_size, void* d_ws, size_t ws_size, hipStream_t stream) {
    static int grid = 0;
    if (grid == 0) {
        if (n_in != 31 || out_size != T * D || ws_size < WS_END) { fprintf(stderr, "kernel_launch: unexpected shapes (n_in %d out %d ws %zu need %zu)\n", n_in, out_size, ws_size, (size_t)WS_END); grid = -1; return; }
        int dev = 0, cus = 0, per_cu = 0;
        if (hipGetDevice(&dev) != hipSuccess || hipDeviceGetAttribute(&cus, hipDeviceAttributeMultiprocessorCount, dev) != hipSuccess) { grid = -1; return; }
        if (hipFuncSetAttribute((const void*)fwd_kernel, hipFuncAttributeMaxDynamicSharedMemorySize, LDS_BYTES) != hipSuccess) { fprintf(stderr, "kernel_launch: hipFuncSetAttribute failed\n"); grid = -1; return; }
        if (hipOccupancyMaxActiveBlocksPerMultiprocessor(&per_cu, (const void*)fwd_kernel, NTHREADS, LDS_BYTES) != hipSuccess || per_cu < 1) fprintf(stderr, "kernel_launch: occupancy query says %d\n", per_cu);
        (void)hipGetLastError();
        grid = cus;
    }
    if (grid < 0) return;
    (void)hipMemsetAsync((char*)d_ws + WS_CTL, 0, CTL_BYTES, stream);
    Params p{};
    for (int i = 0; i < 31; ++i) p.in[i] = (const float*)d_in[i];
    p.out = (float*)d_out; p.ws = (unsigned char*)d_ws;
#if N_LAUNCH_MODE == 1
    p.ph_lo = 0; p.ph_hi = N_PHASES;
    hipLaunchKernelGGL(fwd_kernel, dim3(grid), dim3(NTHREADS), LDS_BYTES, stream, p);
#else
    for (int i = 0; i < N_PHASES; ++i) { p.ph_lo = i; p.ph_hi = i + 1; hipLaunchKernelGGL(fwd_kernel, dim3(grid), dim3(NTHREADS), LDS_BYTES, stream, p); }
#endif
}
```

```cpp
#include <hip/hip_runtime.h>
#include <cstdio>
#include <cstdint>

#define LAS __attribute__((address_space(3)))
typedef unsigned short bf16_t;
typedef short bf16x8 __attribute__((ext_vector_type(8)));
typedef float f32x4 __attribute__((ext_vector_type(4)));
typedef float f32x2 __attribute__((ext_vector_type(2)));
typedef unsigned u32x4 __attribute__((ext_vector_type(4)));
typedef unsigned u32x2 __attribute__((ext_vector_type(2)));

constexpr int T = 16384, D = 1024, SEQ = 8192;
constexpr int AB_IN = 4352, AB_OUT = 2048, CD_IN = 4608, CD_OUT = 2304;
constexpr int NE = 128, NE1 = 129, TOPK = 8, ED = 256;
constexpr int TK = T * TOPK;
constexpr int NSLOT = TK + T;
constexpr int LISTCAP = 16384;
constexpr float ALPHA = 1.681792830507429f;
constexpr float LN_EPS = 1e-5f;

#ifndef N_LAUNCH_MODE
#define N_LAUNCH_MODE 1
#endif

constexpr size_t al256(size_t x) { return (x + 255) & ~(size_t)255; }
constexpr size_t WS_CTL    = 0;
constexpr size_t CTL_BYTES = 65536 + (size_t)4 * 128 * 4096;
constexpr size_t CTL_CNT   = 65536;
constexpr size_t WS_WABIN  = CTL_BYTES;
constexpr size_t WS_WABOUT = WS_WABIN  + al256((size_t)2 * AB_IN * D * 2);
constexpr size_t WS_WCDIN  = WS_WABOUT + al256((size_t)2 * D * AB_OUT * 2);
constexpr size_t WS_WCDOUT = WS_WCDIN  + al256((size_t)2 * CD_IN * D * 2);
constexpr size_t WS_WRT    = WS_WCDOUT + al256((size_t)2 * D * CD_OUT * 2);
constexpr size_t WS_WGU    = WS_WRT    + al256((size_t)4 * 256 * D * 2);
constexpr size_t WS_WDN    = WS_WGU    + al256((size_t)4 * NE1 * 512 * D * 2);
constexpr size_t WS_X      = WS_WDN    + al256((size_t)4 * NE1 * D * ED * 2);
constexpr size_t WS_HB     = WS_X;
constexpr size_t WS_XB     = WS_X      + al256((size_t)T * D * 4);
constexpr size_t WS_U1     = WS_XB     + al256((size_t)T * D * 2);
constexpr size_t U1_BYTES  = al256((size_t)NSLOT * D * 2) > al256((size_t)T * CD_IN * 4) ? al256((size_t)NSLOT * D * 2) : al256((size_t)T * CD_IN * 4);
constexpr size_t WS_U2     = WS_U1     + U1_BYTES;
constexpr size_t U2_BYTES  = al256((size_t)T * 1280 * 4 * 3);
constexpr size_t WS_YCAT   = WS_U2     + U2_BYTES;
constexpr size_t WS_H      = WS_YCAT   + al256((size_t)T * CD_OUT * 2);
constexpr size_t WS_ZR     = WS_H      + al256((size_t)T * D * 4);
constexpr size_t WS_HID    = WS_ZR     + al256((size_t)T * 256 * 4);
constexpr size_t WS_LIST   = WS_HID    + al256((size_t)NSLOT * ED * 2);
constexpr size_t WS_GATE   = WS_LIST   + al256((size_t)NE * LISTCAP * 4);
constexpr size_t WS_ROPEA  = WS_GATE   + al256((size_t)NSLOT * 4);
constexpr size_t WS_ROPER  = WS_ROPEA  + al256((size_t)SEQ * 32 * 8);
constexpr size_t WS_BIASP  = WS_ROPER  + al256((size_t)SEQ * 64 * 8);
constexpr size_t WS_WLRU   = WS_BIASP  + al256((size_t)2 * AB_IN * 4);
constexpr size_t WS_SPL    = WS_WLRU   + al256((size_t)2 * 5 * 2 * 65536 * 2);
constexpr size_t WS_END    = WS_SPL    + al256((size_t)2 * 1280 * 4);
constexpr size_t CD_GU = WS_U1, CD_GVT = WS_U1 + 32 * (1024 * 1024), CD_GG = WS_U1 + 64 * (1024 * 1024), CD_XR = WS_U1 + 104 * (1024 * 1024), CD_STATS = WS_U1 + 144 * (1024 * 1024);
constexpr size_t MB = 1024 * 1024;
constexpr size_t AB_QB = WS_U1, AB_KB = WS_U1 + 32 * MB, AB_VT = WS_U1 + 36 * MB, AB_RQB = WS_U1 + 40 * MB, AB_RKB = WS_U1 + 56 * MB, AB_RKDT = WS_U1 + 72 * MB,
                 AB_RVT = WS_U1 + 88 * MB, AB_RGB = WS_U1 + 120 * MB, AB_KV = WS_U1 + 152 * MB  , AB_SPREV = WS_U1 + 216 * MB  ;
static_assert(AB_SPREV + 32 * MB <= WS_U1 + U1_BYTES, "U1 map");

__device__ __forceinline__ float bf2f(bf16_t b) { return __uint_as_float(((unsigned)b) << 16); }
__device__ __forceinline__ unsigned pk2(float lo, float hi) { unsigned r; asm("v_cvt_pk_bf16_f32 %0, %1, %2" : "=v"(r) : "v"(lo), "v"(hi)); return r; }
__device__ __forceinline__ bf16_t f2bf(float f) { return (bf16_t)(pk2(f, f) & 0xffffu); }
__device__ __forceinline__ float wave_sum(float v) {
#pragma unroll
    for (int o = 32; o; o >>= 1) v += __shfl_xor(v, o);
    return v; }
__device__ __forceinline__ float wave_max(float v) {
#pragma unroll
    for (int o = 32; o; o >>= 1) v = fmaxf(v, __shfl_xor(v, o));
    return v; }
__device__ __forceinline__ float gelu_tanh(float x) { const float u = 0.7978845608028654f * (x + 0.044715f * x * x * x); return 0.5f * x * (1.f + tanhf(u)); }
__device__ __forceinline__ float sigmoidf_(float x) { return 1.f / (1.f + __expf(-x)); }
__device__ __forceinline__ float siluf_(float x) { return x * __builtin_amdgcn_rcpf(1.f + __expf(-x)); }

#define XB_TMO      128
#define XB_XCNT(j)  (256  + 64 * (j))
#define XB_XSUB(j)  (1280 + 64 * (j))
#define XB_XGEN(j)  (2304 + 64 * (j))
#define XB_TOP      3328
#define XB_TOPGEN   3392
#define XCD_BAR_WORDS 3456
#define XB_SPIN_CAP (1u << 22)

__device__ __forceinline__ unsigned xb_ld(unsigned* p)              { return __hip_atomic_load(p, __ATOMIC_RELAXED, __HIP_MEMORY_SCOPE_AGENT); }
__device__ __forceinline__ unsigned xb_add(unsigned* p, unsigned v) { return __hip_atomic_fetch_add(p, v, __ATOMIC_RELAXED, __HIP_MEMORY_SCOPE_AGENT); }
__device__ __forceinline__ unsigned xb_xcc_id() { return (unsigned)__builtin_amdgcn_s_getreg((3 << 11) | 20) & 0xFu; }
#define XB_SPIN(cond, bar) do { unsigned _sp = 0; while (cond) { __builtin_amdgcn_s_sleep(1); \
    if ((++_sp & 255u) == 0u) { if (xb_ld(&(bar)[XB_TMO])) break; if (_sp > XB_SPIN_CAP) { atomicAdd(&(bar)[XB_TMO], 1u); break; } } } } while (0)

struct XcdBarrier { unsigned* bar; unsigned x; volatile LAS unsigned* st; };

__device__ __forceinline__ XcdBarrier xcd_barrier_post(unsigned* bar, volatile LAS unsigned* st) {
    XcdBarrier b; b.bar = bar; b.x = xb_xcc_id(); b.st = st;
    if (threadIdx.x == 0) (void)xb_add(&bar[XB_XCNT(b.x)], 1u);
    return b;
}
__device__ __forceinline__ void xcd_barrier_complete(unsigned* bar, unsigned x, unsigned& nloc, unsigned& nx) {
    const unsigned G = gridDim.x * gridDim.y * gridDim.z;
    unsigned sum, cnt, mine, sp = 0u;
    for (;;) {
        sum = 0u; cnt = 0u; mine = 0u;
#pragma unroll
        for (unsigned j = 0; j < 16; ++j) { const unsigned c = xb_ld(&bar[XB_XCNT(j)]); sum += c; cnt += (c > 0u) ? 1u : 0u; mine = (j == x) ? c : mine; }
        if (sum == G) break;
        __builtin_amdgcn_s_sleep(1);
        if ((++sp & 255u) == 0u) { if (xb_ld(&bar[XB_TMO])) break; if (sp > XB_SPIN_CAP) { atomicAdd(&bar[XB_TMO], 1u); break; } }
    }
    nloc = mine > 0u ? mine : 1u; nx = cnt > 0u ? cnt : 1u;
}
__device__ __forceinline__ void xcd_barrier(const XcdBarrier& b, const bool leader  ) {
    asm volatile("s_waitcnt vmcnt(0)" ::: "memory");
    __syncthreads();
    if (leader) {
        unsigned* bar = b.bar;
        __builtin_amdgcn_s_waitcnt(0);
        unsigned nloc = b.st[0], nx = b.st[1];
        if (nloc == 0u) { xcd_barrier_complete(bar, b.x, nloc, nx); b.st[0] = nloc; b.st[1] = nx; }
        const unsigned old = xb_add(&bar[XB_XSUB(b.x)], 1u);
        const unsigned gen = old / nloc;
        if (old + 1u == (gen + 1u) * nloc) {
            __builtin_amdgcn_fence(__ATOMIC_RELEASE, "agent");
            asm volatile("s_waitcnt vmcnt(0)" ::: "memory");
            const unsigned og = xb_add(&bar[XB_TOP], 1u);
            const unsigned tg = og / nx;
            if (og + 1u == (tg + 1u) * nx) xb_add(&bar[XB_TOPGEN], 1u);
            else XB_SPIN(xb_ld(&bar[XB_TOPGEN]) == tg, bar);
            __builtin_amdgcn_fence(__ATOMIC_ACQUIRE, "agent");
            xb_add(&bar[XB_XGEN(b.x)], 1u);
            asm volatile("s_waitcnt vmcnt(0)" ::: "memory");
        } else {
            XB_SPIN(xb_ld(&bar[XB_XGEN(b.x)]) == gen, bar);
            __builtin_amdgcn_fence(__ATOMIC_ACQUIRE, "agent");
            asm volatile("s_waitcnt vmcnt(0)" ::: "memory");
        }
    }
    __syncthreads();
}

namespace g8 {
constexpr int BM = 256, BK = 64, HALF = 128, HTB = HALF * BK * 2, STAGE_BYTES = 8 * HTB, NXCD = 8, WGM = 8;
__device__ __forceinline__ int lds_byte(int r, int c) { const int st = (r >> 4) * 2 + (c >> 5), rr = r & 15, cc = c & 31, ob = rr * 64 + cc * 2; return st * 1024 + (ob ^ (((ob >> 9) & 1) << 5)); }
__device__ __forceinline__ void stage_rc(int b, int& R, int& C) { const int st = b / 1024, sb = b % 1024, swz = sb ^ (((sb >> 9) & 1) << 5); R = (st >> 1) * 16 + swz / 64; C = (st & 1) * 32 + (swz % 64) / 2; }
__device__ __forceinline__ int perm32(int rho) { const int n = rho >> 4, i = rho & 15; return 8 * (i >> 2) + 4 * n + (i & 3); }

struct Unit { const char* A; const char* B; int pm, pn, aux; };

struct DenseOrder {
    const char* A; const char* Bt; int nM, nN, nwg, G, c, K, tid0;
    __device__ void init(const void* A_, const void* Bt_, int M, int N, int K_, int G_, int c_) { A = (const char*)A_; Bt = (const char*)Bt_; nM = M / BM; nN = N / BM; nwg = nM * nN; G = G_; c = c_; K = K_; }
    __device__ __forceinline__ bool next(int i, Unit& u) const {
        const long L = (long)i * G + c; if (L >= nwg) return false;
        int wgid = (int)L; { const int q = nwg / NXCD, r = nwg % NXCD, xcd = wgid % NXCD, off = wgid / NXCD; wgid = (xcd < r ? xcd * (q + 1) : r * (q + 1) + (xcd - r) * q) + off; }
        const int nig = WGM * nN, gid = wgid / nig, fm = gid * WGM, gsz = (nM - fm) < WGM ? (nM - fm) : WGM;
        u.pm = fm + ((wgid % nig) % gsz); u.pn = (wgid % nig) / gsz; u.aux = 0;
        u.A = A + (size_t)u.pm * BM * K * 2; u.B = Bt + (size_t)u.pn * BM * K * 2; return true;
    }
    __device__ __forceinline__ void aoff(const Unit&, int tid, unsigned (&o)[2][2]) const {
#pragma unroll
        for (int i = 0; i < 2; ++i) { int R, C; stage_rc(tid * 16 + i * 8192, R, C);
            o[0][i] = (unsigned)(R * K + C) * 2u; o[1][i] = (unsigned)((R + HALF) * K + C) * 2u; }
    }
};

__device__ __forceinline__ unsigned cvt_pk_bf16(float lo, float hi) { unsigned r; asm volatile("v_cvt_pk_bf16_f32 %0, %1, %2" : "=v"(r) : "v"(lo), "v"(hi)); return r; }

struct EpiF32 {
    static constexpr bool PERM = false;
    float* C; int ldc; const float* bias;
    __device__ __forceinline__ void operator()(const f32x4 (&acc)[2][2][4][2], const Unit& u, int wr, int wc, int fr, int fq) const {
        const int row0 = u.pm * BM + wr * 64 + fr, col0 = u.pn * BM + wc * 32 + 4 * fq;
        f32x4 bv[2][2];
#pragma unroll
        for (int bj = 0; bj < 2; ++bj)
#pragma unroll
            for (int n = 0; n < 2; ++n) bv[bj][n] = bias ? *(const f32x4*)(bias + col0 + bj * HALF + n * 16) : (f32x4){0.f, 0.f, 0.f, 0.f};
#pragma unroll
        for (int ai = 0; ai < 2; ++ai)
#pragma unroll
            for (int m = 0; m < 4; ++m) { float* rowp = C + (size_t)(row0 + ai * HALF + m * 16) * ldc + col0;
#pragma unroll
                for (int bj = 0; bj < 2; ++bj)
#pragma unroll
                    for (int n = 0; n < 2; ++n) *(f32x4*)(rowp + bj * HALF + n * 16) = acc[ai][bj][m][n] + bv[bj][n]; }
    }
};

struct EpiBf16 {
    static constexpr bool PERM = true;
    bf16_t* O; int ldc; const float* bias;
    __device__ __forceinline__ void operator()(const f32x4 (&acc)[2][2][4][2], const Unit& u, int wr, int wc, int fr, int fq) const {
        const int row0 = u.pm * BM + wr * 64 + fr, col0 = u.pn * BM + wc * 32 + 8 * fq;
        f32x4 bv[2][2];
#pragma unroll
        for (int bj = 0; bj < 2; ++bj)
#pragma unroll
            for (int n = 0; n < 2; ++n) bv[bj][n] = *(const f32x4*)(bias + col0 + bj * HALF + 4 * n);
#pragma unroll
        for (int ai = 0; ai < 2; ++ai)
#pragma unroll
            for (int m = 0; m < 4; ++m) { bf16_t* rowp = O + (size_t)(row0 + ai * HALF + m * 16) * ldc + col0;
#pragma unroll
                for (int bj = 0; bj < 2; ++bj) { const f32x4 v0 = acc[ai][bj][m][0] + bv[bj][0], v1 = acc[ai][bj][m][1] + bv[bj][1];
                    u32x4 w; w[0] = cvt_pk_bf16(v0[0], v0[1]); w[1] = cvt_pk_bf16(v0[2], v0[3]); w[2] = cvt_pk_bf16(v1[0], v1[1]); w[3] = cvt_pk_bf16(v1[2], v1[3]);
                    *(u32x4*)(rowp + bj * HALF) = w; } }
    }
};

template <class Epi, class Sched>
__device__ __forceinline__ void gemm_phase(LAS unsigned char* lds, const int K, const Sched& S, const Epi& E) {
    int tid_ = S.tid0; asm volatile("" : "+v"(tid_));
    const int tid = tid_, wid = __builtin_amdgcn_readfirstlane(tid >> 6), lane = tid & 63, wr = wid >> 2, wc = wid & 3, fr = lane & 15, fq = lane >> 4;
    const int nt = K / BK;
    unsigned voffB[2];
#pragma unroll
    for (int i = 0; i < 2; ++i) { int R, C; stage_rc(tid * 16 + i * 8192, R, C); const int Rb = Epi::PERM ? ((R & ~31) + perm32(R & 31)) : R;
        voffB[i] = (unsigned)(Rb * K + C) * 2u; }
    const size_t kstep = (size_t)(BK * 2);
    const size_t hstep = (size_t)HALF * K * 2;
    const unsigned ldsw = (unsigned)wid * 1024u;
    const int aoff = lds_byte(wr * 64 + fr, fq * 8), boff = lds_byte(wc * 32 + fr, fq * 8);
#define G8_SA(b, h) (((b) * 2 + (h)) * HTB)
#define G8_SB(b, h) ((4 + (b) * 2 + (h)) * HTB)
#define G8_STAGE(bufoff, gbase, voff) do { _Pragma("unroll") for (int _i = 0; _i < 2; ++_i) \
        __builtin_amdgcn_global_load_lds((const unsigned*)((const char*)(gbase) + (voff)[_i]), (LAS unsigned*)(lds + (bufoff) + ldsw + _i * 8192), 16, 0, 0); } while (0)
#define G8_LDA(dst, b, h) do { _Pragma("unroll") for (int m = 0; m < 4; ++m) _Pragma("unroll") for (int k = 0; k < 2; ++k) dst[m][k] = *(const LAS bf16x8*)(lds + G8_SA(b, h) + aoff + m * 2048 + k * 1024); } while (0)
#define G8_LDB(dst, b, h) do { _Pragma("unroll") for (int n = 0; n < 2; ++n) _Pragma("unroll") for (int k = 0; k < 2; ++k) dst[n][k] = *(const LAS bf16x8*)(lds + G8_SB(b, h) + boff + n * 2048 + k * 1024); } while (0)
#define G8_MMA(ai, bj, At, Bt) do { __builtin_amdgcn_s_setprio(1); _Pragma("unroll") for (int m = 0; m < 4; ++m) _Pragma("unroll") for (int n = 0; n < 2; ++n) _Pragma("unroll") for (int k = 0; k < 2; ++k) \
        acc[ai][bj][m][n] = __builtin_amdgcn_mfma_f32_16x16x32_bf16(Bt[n][k], At[m][k], acc[ai][bj][m][n], 0, 0, 0); __builtin_amdgcn_s_setprio(0); } while (0)
#define G8_WAIT_V(n) asm volatile("s_waitcnt vmcnt(" #n ")" ::: "memory")
#define G8_WAIT_L(n) asm volatile("s_waitcnt lgkmcnt(" #n ")" ::: "memory")
#define G8_BAR __builtin_amdgcn_s_barrier()
#define G8_SCHED __builtin_amdgcn_sched_barrier(0)
    Unit cur, nxt; int ui = 0;
    if (!S.next(0, cur)) return;
    f32x4 acc[2][2][4][2];
#pragma unroll
    for (int a = 0; a < 2; ++a)
#pragma unroll
        for (int b = 0; b < 2; ++b)
#pragma unroll
            for (int m = 0; m < 4; ++m)
#pragma unroll
                for (int n = 0; n < 2; ++n) acc[a][b][m][n] = (f32x4){0.f, 0.f, 0.f, 0.f};
    bf16x8 At[4][2], B0[2][2], B1[2][2];
    unsigned oc[2][2];
    S.aoff(cur, tid, oc);
    const char* cA = cur.A; const char* cB = cur.B;
    G8_STAGE(G8_SB(0, 0), cB, voffB); G8_STAGE(G8_SA(0, 0), cA, oc[0]); G8_STAGE(G8_SB(0, 1), cB + hstep, voffB); G8_STAGE(G8_SA(0, 1), cA, oc[1]);
    if (wr == 1) G8_BAR;
    G8_WAIT_V(4); G8_BAR;
    G8_STAGE(G8_SB(1, 0), cB + kstep, voffB); G8_STAGE(G8_SA(1, 0), cA + kstep, oc[0]); G8_STAGE(G8_SB(1, 1), cB + hstep + kstep, voffB);
    G8_WAIT_V(6); G8_BAR;
    for (;;) {
        const bool has_next = S.next(ui + 1, nxt);
        const char* nA = has_next ? nxt.A : cA; const char* nB = has_next ? nxt.B : cB;
#pragma unroll 1
        for (int t = 0; t < nt; t += 2) {
            const bool last = (t == nt - 2);
            const char* a1 = cA + (size_t)(t + 1) * kstep;
            const char* a2 = last ? nA : cA + (size_t)(t + 2) * kstep; const char* b2 = last ? nB : cB + (size_t)(t + 2) * kstep;
            const char* a3 = a2 + kstep; const char* b3 = b2 + kstep;
            G8_LDB(B0, 0, 0); G8_SCHED; G8_LDA(At, 0, 0); G8_STAGE(G8_SA(1, 1), a1, oc[1]);
            if (last && has_next) S.aoff(nxt, tid, oc);
            G8_WAIT_L(8); G8_BAR; G8_WAIT_L(0); G8_MMA(0, 0, At, B0); G8_BAR; G8_SCHED;
            G8_LDB(B1, 0, 1); G8_STAGE(G8_SB(0, 0), b2, voffB);
            G8_BAR; G8_WAIT_L(0); G8_MMA(0, 1, At, B1); G8_BAR;
            G8_LDA(At, 0, 1); G8_STAGE(G8_SA(0, 0), a2, oc[0]);
            G8_BAR; G8_WAIT_L(0); G8_MMA(1, 0, At, B0); G8_BAR; G8_SCHED;
            G8_STAGE(G8_SB(0, 1), b2 + hstep, voffB);
            G8_WAIT_V(6); G8_BAR; G8_MMA(1, 1, At, B1); G8_BAR;
            G8_LDB(B0, 1, 0); G8_SCHED; G8_LDA(At, 1, 0); G8_STAGE(G8_SA(0, 1), a2, oc[1]);
            G8_WAIT_L(8); G8_BAR; G8_WAIT_L(0); G8_MMA(0, 0, At, B0); G8_BAR; G8_SCHED;
            G8_LDB(B1, 1, 1); G8_STAGE(G8_SB(1, 0), b3, voffB);
            G8_BAR; G8_WAIT_L(0); G8_MMA(0, 1, At, B1); G8_BAR;
            G8_LDA(At, 1, 1); G8_STAGE(G8_SA(1, 0), a3, oc[0]);
            G8_BAR; G8_WAIT_L(0); G8_MMA(1, 0, At, B0); G8_BAR; G8_SCHED;
            G8_STAGE(G8_SB(1, 1), b3 + hstep, voffB);
            G8_WAIT_V(6); G8_BAR; G8_MMA(1, 1, At, B1); G8_BAR;
        }
        E(acc, cur, wr, wc, fr, fq);
        if (!has_next) break;
#pragma unroll
        for (int a = 0; a < 2; ++a)
#pragma unroll
            for (int b = 0; b < 2; ++b)
#pragma unroll
                for (int m = 0; m < 4; ++m)
#pragma unroll
                    for (int n = 0; n < 2; ++n) acc[a][b][m][n] = (f32x4){0.f, 0.f, 0.f, 0.f};
        cur = nxt; cA = nA; cB = nB; ++ui;
    }
    G8_WAIT_V(0);
    if (wr == 0) G8_BAR;
    G8_BAR;
#undef G8_SA
#undef G8_SB
#undef G8_STAGE
#undef G8_LDA
#undef G8_LDB
#undef G8_MMA
#undef G8_WAIT_V
#undef G8_WAIT_L
#undef G8_BAR
#undef G8_SCHED
}
}

constexpr int NTHREADS = 512;
constexpr int LDS_STAGE = 0;
constexpr int LDS_TAB   = g8::STAGE_BYTES;
constexpr int TAB_SLOTS = 6;
constexpr int LDS_GTAB  = LDS_TAB + TAB_SLOTS * 256 * 4;
constexpr int LDS_DESC  = LDS_GTAB + TAB_SLOTS * 256 * 4;
constexpr int LDS_PREF  = LDS_DESC + 64;
constexpr int LDS_MISC  = LDS_PREF + 132 * 4 + 48;
constexpr int LDS_BYTES = 147456;
static_assert(LDS_MISC % 16 == 0 && LDS_MISC + 64 <= LDS_BYTES, "LDS map");

struct Params { const float* in[31]; float* out; unsigned char* ws; int ph_lo, ph_hi; };

struct Ctx {
    const float* const* in; float* out; unsigned char* ws; LAS unsigned char* lds;
    int tid, lane, wid, bid, G, gtid, gthreads, gw, nwaves;
};

__device__ __forceinline__ int ab_phys(int n) {
    if (n < 1024) { const int hd = n >> 6, jj = n & 63; return (hd >> 2) * 256 + (jj >> 5) * 128 + (hd & 3) * 32 + (jj & 31); }
    if (n < 1152) { const int nn = n - 1024, hh = nn >> 6, jj = nn & 63; return 1024 + (jj >> 5) * 128 + hh * 32 + (jj & 31); }
    if (n < 1280) { const int vv = n - 1152; return 1024 + (vv >> 6) * 128 + 64 + (vv & 63); }
    if (n < 2304) { const int base = n < 1792 ? 1280 : 1792, nn = n - base, h = nn >> 7, jj = nn & 127; return base + (h >> 1) * 256 + (jj >> 6) * 128 + (h & 1) * 64 + (jj & 63); }
    return n;
}
template <int TN, class DstFn>
__device__ __forceinline__ void convert_T(const Ctx& c, const float* src, int nmat, int K, int N, DstFn dstfn) {
    LAS float* tile = (LAS float*)(c.lds);
    constexpr int LDT = TN + 1, TPR = TN / 4  , KPI = NTHREADS / TPR  , NI = 64 / KPI, KPT = 64 * TN / NTHREADS  ;
    const int tk = K / 64, tn = N / TN; const long ntiles = (long)nmat * tk * tn;
    for (long tix = c.bid; tix < ntiles; tix += c.G) {
        const int m = (int)(tix / (tk * tn)); const int rem = (int)(tix % (tk * tn)); const int kt = rem / tn, nt = rem % tn;
        const float* s = src + (size_t)m * K * N + (size_t)(kt * 64) * N + nt * TN;
        f32x4 v[NI];
#pragma unroll
        for (int i = 0; i < NI; ++i) { const int k = c.tid / TPR + KPI * i, n4 = (c.tid % TPR) * 4; v[i] = __builtin_nontemporal_load((const f32x4*)(s + (size_t)k * N + n4)); }
#pragma unroll
        for (int i = 0; i < NI; ++i) { const int k = c.tid / TPR + KPI * i, n4 = (c.tid % TPR) * 4;
            tile[k * LDT + n4 + 0] = v[i][0]; tile[k * LDT + n4 + 1] = v[i][1]; tile[k * LDT + n4 + 2] = v[i][2]; tile[k * LDT + n4 + 3] = v[i][3]; }
        __syncthreads();
        { constexpr int TPN = 64 / KPT; const int n = c.tid / TPN, k0 = (c.tid % TPN) * KPT;
          bf16_t* d = dstfn(m, nt * TN + n) + kt * 64 + k0;
#pragma unroll
          for (int q = 0; q < KPT / 8; ++q) { u32x4 w;
#pragma unroll
              for (int e = 0; e < 4; ++e) w[e] = pk2(tile[(k0 + q * 8 + 2 * e) * LDT + n], tile[(k0 + q * 8 + 2 * e + 1) * LDT + n]);
              *(u32x4*)(d + q * 8) = w; } }
        __syncthreads();
    }
}

__device__ __forceinline__ void phase_convert(const Ctx& c) {
    unsigned char* ws = c.ws;
    { const float* x = c.in[0]; bf16_t* xb = (bf16_t*)(ws + WS_XB);
      for (long i = c.gtid; i < (long)T * D / 4; i += c.gthreads) { const f32x4 v = *(const f32x4*)(x + i * 4); u32x2 w; w[0] = pk2(v[0], v[1]); w[1] = pk2(v[2], v[3]); *(u32x2*)(xb + i * 4) = w; } }
    { bf16_t* wrt = (bf16_t*)(ws + WS_WRT); for (long i = c.gtid; i < (long)4 * 128 * D / 8; i += c.gthreads) { const long l = i / (128 * D / 8), r = i % (128 * D / 8); *(u32x4*)(wrt + (size_t)l * 256 * D + (size_t)128 * D + r * 8) = (u32x4){0u, 0u, 0u, 0u}; }
      float* gate = (float*)(ws + WS_GATE); for (int i = c.gtid; i < T; i += c.gthreads) gate[TK + i] = 1.f;
      f32x2* ra = (f32x2*)(ws + WS_ROPEA); f32x2* rr = (f32x2*)(ws + WS_ROPER);
      for (int i = c.gtid; i < SEQ * 96; i += c.gthreads) { const int sidx = i / 96, q = i % 96; const bool isA = q < 32; const int jx = isA ? q : q - 32;
          const float e = isA ? (float)jx * (1.f / 32.f) : (float)jx * (1.f / 63.f); const float ang = (float)sidx * exp2f(-e * 13.287712379549449f); float sn, cs; sincosf(ang, &sn, &cs);
          if (isA) ra[sidx * 32 + jx] = (f32x2){cs, sn}; else rr[sidx * 64 + jx] = (f32x2){cs, sn}; }
      float* bp = (float*)(ws + WS_BIASP); for (int i = c.gtid; i < 2 * AB_IN; i += c.gthreads) { const int m = i / AB_IN, n = i % AB_IN; bp[m * AB_IN + ab_phys(n)] = c.in[2][i]; } }
    { bf16_t* d = (bf16_t*)(ws + WS_WABIN);  convert_T<256>(c, c.in[1], 2, D, AB_IN, [=](int m, int n) { return d + (size_t)m * AB_IN * D + (size_t)ab_phys(n) * D; }); }
    { bf16_t* d = (bf16_t*)(ws + WS_WABOUT); convert_T<256>(c, c.in[4], 2, AB_OUT, D, [=](int m, int n) { return d + (size_t)m * D * AB_OUT + (size_t)n * AB_OUT; }); }
    { bf16_t* d = (bf16_t*)(ws + WS_WCDIN);  convert_T<256>(c, c.in[6], 2, D, CD_IN, [=](int m, int n) { return d + (size_t)m * CD_IN * D + (size_t)n * D; }); }
    { bf16_t* d = (bf16_t*)(ws + WS_WCDOUT); convert_T<256>(c, c.in[17], 2, CD_OUT, D, [=](int m, int n) { return d + (size_t)m * D * CD_OUT + (size_t)n * CD_OUT; }); }
    { bf16_t* d = (bf16_t*)(ws + WS_WRT);    convert_T<128>(c, c.in[21], 4, D, NE, [=](int m, int n) { return d + (size_t)m * 256 * D + (size_t)n * D; }); }
    { bf16_t* d = (bf16_t*)(ws + WS_WGU);
      convert_T<256>(c, c.in[23], 4 * NE, D, ED, [=](int m, int n) { return d + (size_t)((m >> 7) * NE1 + (m & 127)) * 512 * D + (size_t)((n >> 7) * 256 + (n & 127)) * D; });
      convert_T<256>(c, c.in[24], 4 * NE, D, ED, [=](int m, int n) { return d + (size_t)((m >> 7) * NE1 + (m & 127)) * 512 * D + (size_t)((n >> 7) * 256 + 128 + (n & 127)) * D; });
      convert_T<256>(c, c.in[26], 4, D, ED, [=](int m, int n) { return d + (size_t)(m * NE1 + NE) * 512 * D + (size_t)((n >> 7) * 256 + (n & 127)) * D; });
      convert_T<256>(c, c.in[27], 4, D, ED, [=](int m, int n) { return d + (size_t)(m * NE1 + NE) * 512 * D + (size_t)((n >> 7) * 256 + 128 + (n & 127)) * D; }); }
    { bf16_t* d = (bf16_t*)(ws + WS_WLRU);
      convert_T<256>(c, c.in[12], 10, 256, 256, [=](int m, int n) { return d + (size_t)(m * 2 + 0) * 65536 + (size_t)n * 256; });
      convert_T<256>(c, c.in[14], 10, 256, 256, [=](int m, int n) { return d + (size_t)(m * 2 + 1) * 65536 + (size_t)n * 256; });
      float* spl = (float*)(ws + WS_SPL); for (int i = c.gtid; i < 2 * 1280; i += c.gthreads) spl[i] = log1pf(expf(-c.in[16][i])); }
    { bf16_t* d = (bf16_t*)(ws + WS_WDN);
      convert_T<256>(c, c.in[25], 4 * NE, ED, D, [=](int m, int n) { return d + (size_t)((m >> 7) * NE1 + (m & 127)) * D * ED + (size_t)n * ED; });
      convert_T<256>(c, c.in[28], 4, ED, D, [=](int m, int n) { return d + (size_t)(m * NE1 + NE) * D * ED + (size_t)n * ED; }); }
}

__device__ __forceinline__ void phase_dense(const Ctx& c, const bf16_t* A, const bf16_t* Bt, int M, int N, int K, bf16_t* C, int ldc, const float* bias) {
    g8::DenseOrder S; S.init(A, Bt, M, N, K, c.G, c.bid); S.tid0 = c.tid;
    g8::EpiBf16 E{C, ldc, bias};
    g8::gemm_phase<g8::EpiBf16, g8::DenseOrder>(c.lds + LDS_STAGE, K, S, E);
}

struct EpiABIn {
    static constexpr bool PERM = true;
    LAS bf16_t* biasL; unsigned char* ws;
    __device__ __forceinline__ void operator()(const f32x4 (&acc)[2][2][4][2], const g8::Unit& u, int wr, int wc, int fr_, int fq_) const {
        int fr = fr_, fq = fq_; asm volatile("" : "+v"(fr), "+v"(fq));
        const int pn = u.pn; const int colp = pn * 256 + wc * 32 + fq * 8;
        bf16_t* qb = (bf16_t*)(ws + AB_QB); bf16_t* kb = (bf16_t*)(ws + AB_KB); bf16_t* vT = (bf16_t*)(ws + AB_VT); bf16_t* rqb = (bf16_t*)(ws + AB_RQB); bf16_t* rkb = (bf16_t*)(ws + AB_RKB);
        bf16_t* rkdT = (bf16_t*)(ws + AB_RKDT); bf16_t* rvT = (bf16_t*)(ws + AB_RVT); bf16_t* rgb = (bf16_t*)(ws + AB_RGB);
        const float frqA0 = exp2f(-(float)(fq * 8) * (13.287712379549449f / 32.f)) * 0.15915494309189535f;
        const float frqR0 = exp2f(-(float)((wc & 1) * 32 + fq * 8) * (13.287712379549449f / 63.f)) * 0.15915494309189535f;
        constexpr float RA[8] = {1.f, 0.7498942093324559f, 0.5623413251903491f, 0.4216965034285822f, 0.31622776601683794f, 0.23713737056616552f, 0.1778279410038923f, 0.1333521432163324f};
        constexpr float RR[8] = {1.f, 0.8639884494839686f, 0.746476040841712f, 0.6449466771037624f, 0.5572264795507174f, 0.4814372420784346f, 0.4159562163071847f, 0.35938136638046275f};
#pragma unroll
        for (int ai = 0; ai < 2; ++ai)
#pragma unroll
            for (int m = 0; m < 4; ++m) {
                const int t = u.pm * 256 + ai * 128 + wr * 64 + m * 16 + fr, sq = t & (SEQ - 1), b = t >> 13;
                f32x4 x[2][2];
#pragma unroll
                for (int bj = 0; bj < 2; ++bj)
#pragma unroll
                    for (int n = 0; n < 2; ++n) { const u32x2 bw = *(const LAS u32x2*)(biasL + colp + bj * 128 + 4 * n);
                        x[bj][n] = acc[ai][bj][m][n] + (f32x4){__uint_as_float(bw[0] << 16), __uint_as_float(bw[0] & 0xffff0000u), __uint_as_float(bw[1] << 16), __uint_as_float(bw[1] & 0xffff0000u)}; }
                if (pn < 4 || (pn == 4 && wc < 2)) {
                    const int j0 = fq * 8; const float sc = pn < 4 ? 0.125f : 1.f;
                    u32x4 w1, w2;
#pragma unroll
                    for (int n = 0; n < 2; ++n) { f32x4 o1, o2;
#pragma unroll
                        for (int e = 0; e < 4; ++e) { const float rev = __builtin_amdgcn_fractf((float)sq * (frqA0 * RA[4 * n + e])); const float cc = __builtin_amdgcn_cosf(rev) * sc, ss = __builtin_amdgcn_sinf(rev) * sc;
                            o1[e] = x[0][n][e] * cc - x[1][n][e] * ss; o2[e] = x[1][n][e] * cc + x[0][n][e] * ss; }
                        w1[2 * n] = pk2(o1[0], o1[1]); w1[2 * n + 1] = pk2(o1[2], o1[3]); w2[2 * n] = pk2(o2[0], o2[1]); w2[2 * n + 1] = pk2(o2[2], o2[3]); }
                    bf16_t* dst = pn < 4 ? qb + (size_t)t * 1024 + (pn * 4 + wc) * 64 + j0 : kb + (size_t)t * 128 + wc * 64 + j0;
                    *(u32x4*)dst = w1; *(u32x4*)(dst + 32) = w2;
                } else if (pn == 4) {
                    const int d0 = (wc - 2) * 32 + fq * 8;
#pragma unroll
                    for (int bj = 0; bj < 2; ++bj)
#pragma unroll
                        for (int n = 0; n < 2; ++n)
#pragma unroll
                            for (int e = 0; e < 4; ++e) vT[((size_t)(b * 2 + bj) * 64 + d0 + 4 * n + e) * SEQ + sq] = f2bf(x[bj][n][e]);
                } else if (pn < 9) {
                    const bool isk = pn >= 7; const int h = ((pn - 5) & 1) * 2 + (wc >> 1), j0 = (wc & 1) * 32 + fq * 8;
                    const float sc = isk ? 0.08838834764831845f : 1.f;
                    bf16_t* dT = rkdT + ((size_t)(b * 4 + h) * 128 + j0) * SEQ + sq;
                    u32x4 w1, w2;
#pragma unroll
                    for (int n = 0; n < 2; ++n) { f32x4 o1, o2;
#pragma unroll
                        for (int e = 0; e < 4; ++e) { const float rev = __builtin_amdgcn_fractf((float)sq * (frqR0 * RR[4 * n + e])); const float cc = __builtin_amdgcn_cosf(rev) * sc, ss = __builtin_amdgcn_sinf(rev) * sc;
                            o1[e] = x[0][n][e] * cc - x[1][n][e] * ss; o2[e] = x[1][n][e] * cc + x[0][n][e] * ss; }
                        w1[2 * n] = pk2(o1[0], o1[1]); w1[2 * n + 1] = pk2(o1[2], o1[3]); w2[2 * n] = pk2(o2[0], o2[1]); w2[2 * n + 1] = pk2(o2[2], o2[3]);
                        if (isk) {
#pragma unroll
                            for (int e = 0; e < 4; ++e) { dT[(size_t)(4 * n + e) * SEQ] = f2bf(o1[e]); dT[(size_t)(64 + 4 * n + e) * SEQ] = f2bf(o2[e]); } } }
                    bf16_t* dst = (isk ? rkb : rqb) + (size_t)t * 512 + h * 128 + j0;
                    *(u32x4*)dst = w1; *(u32x4*)(dst + 64) = w2;
                } else if (pn < 13) {
                    const int h = pn - 9;
#pragma unroll
                    for (int bj = 0; bj < 2; ++bj)
#pragma unroll
                        for (int n = 0; n < 2; ++n)
#pragma unroll
                            for (int e = 0; e < 4; ++e) rvT[((size_t)(b * 4 + h) * 256 + bj * 128 + wc * 32 + fq * 8 + 4 * n + e) * SEQ + sq] = f2bf(x[bj][n][e]);
                } else {
#pragma unroll
                    for (int bj = 0; bj < 2; ++bj) { u32x4 w;
#pragma unroll
                        for (int n = 0; n < 2; ++n) { w[2 * n] = pk2(siluf_(x[bj][n][0]), siluf_(x[bj][n][1])); w[2 * n + 1] = pk2(siluf_(x[bj][n][2]), siluf_(x[bj][n][3])); }
                        *(u32x4*)(rgb + (size_t)t * 1024 + (pn - 13) * 256 + bj * 128 + wc * 32 + fq * 8) = w; }
                }
            }
    }
};
__device__ __forceinline__ void phase_ab_inproj(const Ctx& c, int j) {
    g8::DenseOrder S; S.init(c.ws + WS_XB, c.ws + WS_WABIN + (size_t)j * AB_IN * D * 2, T, AB_IN, D, c.G, c.bid); S.tid0 = c.tid;
    LAS bf16_t* biasL = (LAS bf16_t*)(c.lds + LDS_TAB);
    { const float* bp = (const float*)(c.ws + WS_BIASP) + (size_t)j * AB_IN; for (int i = c.tid; i < AB_IN; i += NTHREADS) biasL[i] = f2bf(bp[i]); }
    __syncthreads();
    EpiABIn E{biasL, c.ws};
    g8::gemm_phase<EpiABIn, g8::DenseOrder>(c.lds + LDS_STAGE, D, S, E);
}

#define MFMA16(a, b, c) __builtin_amdgcn_mfma_f32_16x16x32_bf16((a), (b), (c), 0, 0, 0)
__device__ __forceinline__ bf16x8 pack8(const f32x4& lo, const f32x4& hi) { u32x4 w; w[0] = g8::cvt_pk_bf16(lo[0], lo[1]); w[1] = g8::cvt_pk_bf16(lo[2], lo[3]); w[2] = g8::cvt_pk_bf16(hi[0], hi[1]); w[3] = g8::cvt_pk_bf16(hi[2], hi[3]); return __builtin_bit_cast(bf16x8, w); }
__device__ __forceinline__ bf16x8 cat8(const u32x2& lo, const u32x2& hi) { u32x4 w; w[0] = lo[0]; w[1] = lo[1]; w[2] = hi[0]; w[3] = hi[1]; return __builtin_bit_cast(bf16x8, w); }
template <int ROWS, int RB>
__device__ __forceinline__ void tile_g2l(LAS unsigned char* dst, const unsigned char* src, size_t gs, int tid, int zrows = 0) {
    constexpr int CPR = RB / 16, TOTAL = ROWS * CPR;
#pragma unroll 4
    for (int i = tid; i < TOTAL; i += NTHREADS) { const int r = i / CPR, cc = i % CPR; u32x4 v = (u32x4){0u, 0u, 0u, 0u}; if (r >= zrows) v = *(const u32x4*)(src + (size_t)r * gs + cc * 16);
        *(LAS u32x4*)(dst + r * (RB + 16) + cc * 16) = v; }
}

__device__ __forceinline__ void attn_unit(const Ctx& c, int unit, const float* sinks) {
    const int b = unit >> 7, n = (unit >> 1) & 63, kvh = unit & 1, hd = kvh * 8 + c.wid, lane = c.lane, fr = lane & 15, fq = lane >> 4;
    const bf16_t* qb = (const bf16_t*)(c.ws + AB_QB); const bf16_t* kb = (const bf16_t*)(c.ws + AB_KB); const bf16_t* vT = (const bf16_t*)(c.ws + AB_VT); bf16_t* ycat = (bf16_t*)(c.ws + WS_YCAT);
    LAS unsigned char* Ks = c.lds; LAS unsigned char* Vs = c.lds + 256 * 144;
    const int t0 = b * SEQ + n * 128;
    __syncthreads();
    {
        const unsigned char* src = (const unsigned char*)(kb + (size_t)(t0 - 128) * 128 + kvh * 64);
        constexpr int TOTAL = 256 * 8;
#pragma unroll 4
        for (int i = c.tid; i < TOTAL; i += NTHREADS) { const int r = i >> 3, cc = i & 7; u32x4 v = (u32x4){0u, 0u, 0u, 0u}; if (n > 0 || r >= 128) v = *(const u32x4*)(src + (ptrdiff_t)r * 256 + cc * 16);
            *(LAS u32x4*)(Ks + r * 144 + cc * 16) = v; }
        const unsigned char* vsrc = (const unsigned char*)(vT + (size_t)(b * 2 + kvh) * 64 * SEQ + (n * 128 - 128));
        constexpr int TV = 64 * 32;
#pragma unroll 4
        for (int i = c.tid; i < TV; i += NTHREADS) { const int r = i >> 5, cc = i & 31; u32x4 v = (u32x4){0u, 0u, 0u, 0u}; if (n > 0 || cc >= 16) v = *(const u32x4*)(vsrc + (ptrdiff_t)r * SEQ * 2 + cc * 16);
            *(LAS u32x4*)(Vs + r * 528 + cc * 16) = v; }
    }
    __syncthreads();
    const float sink = sinks[hd];
    for (int si = 0; si < 8; ++si) {
        const int t = t0 + si * 16 + fr;
        bf16x8 qf[2];
#pragma unroll
        for (int ks = 0; ks < 2; ++ks) qf[ks] = *(const bf16x8*)(qb + (size_t)t * 1024 + hd * 64 + ks * 32 + fq * 8);
        f32x4 S[10];
#pragma unroll
        for (int nk = 0; nk < 9; ++nk) { S[nk] = (f32x4){0.f, 0.f, 0.f, 0.f};
#pragma unroll
            for (int ks = 0; ks < 2; ++ks) { const bf16x8 a = *(const LAS bf16x8*)(Ks + (16 * (si + nk) + fr) * 144 + ks * 64 + fq * 16); S[nk] = MFMA16(a, qf[ks], S[nk]); } }
        S[9] = (f32x4){0.f, 0.f, 0.f, 0.f};
        const int i = si * 16 + fr;
        float mx = sink;
#pragma unroll
        for (int nk = 0; nk < 9; ++nk)
#pragma unroll
            for (int r = 0; r < 4; ++r) { const int p = 16 * (si + nk) + 4 * fq + r; const bool ok = (p >= i + 1) && (p <= i + 128) && (n > 0 || p >= 128);
                S[nk][r] = ok ? S[nk][r] : -1e30f; mx = fmaxf(mx, S[nk][r]); }
        mx = fmaxf(mx, __shfl_xor(mx, 16)); mx = fmaxf(mx, __shfl_xor(mx, 32));
        float sum = 0.f;
#pragma unroll
        for (int nk = 0; nk < 9; ++nk)
#pragma unroll
            for (int r = 0; r < 4; ++r) { const float pv = S[nk][r] > -1e29f ? exp2f((S[nk][r] - mx) * 1.4426950408889634f) : 0.f; S[nk][r] = pv; sum += pv; }
        sum += __shfl_xor(sum, 16); sum += __shfl_xor(sum, 32);
        const float inv = 1.f / (sum + exp2f((sink - mx) * 1.4426950408889634f));
        f32x4 O[4];
#pragma unroll
        for (int nd = 0; nd < 4; ++nd) O[nd] = (f32x4){0.f, 0.f, 0.f, 0.f};
#pragma unroll
        for (int kk = 0; kk < 5; ++kk) { const bf16x8 pf = pack8(S[2 * kk], S[2 * kk + 1]);
            const int p0 = 16 * (si + 2 * kk) + 4 * fq, p1 = (kk == 4 && si == 7) ? p0 : p0 + 16;
#pragma unroll
            for (int nd = 0; nd < 4; ++nd) { const u32x2 lo = *(const LAS u32x2*)(Vs + (16 * nd + fr) * 528 + p0 * 2), hi = *(const LAS u32x2*)(Vs + (16 * nd + fr) * 528 + p1 * 2);
                O[nd] = MFMA16(cat8(lo, hi), pf, O[nd]); } }
#pragma unroll
        for (int nd = 0; nd < 4; ++nd) { u32x2 w; w[0] = pk2(O[nd][0] * inv, O[nd][1] * inv); w[1] = pk2(O[nd][2] * inv, O[nd][3] * inv);
            *(u32x2*)(ycat + (size_t)t * AB_OUT + hd * 64 + 16 * nd + 4 * fq) = w; }
    }
}

__device__ __forceinline__ void ret_kv_unit(const Ctx& c, int unit) {
    const int b = unit >> 8, n = (unit >> 2) & 63, h = unit & 3, lane = c.lane, fr = lane & 15, fq = lane >> 4, w = c.wid;
    const bf16_t* rkdT = (const bf16_t*)(c.ws + AB_RKDT); const bf16_t* rvT = (const bf16_t*)(c.ws + AB_RVT); float* kv = (float*)(c.ws + AB_KV);
    LAS unsigned char* Kd = c.lds;
    __syncthreads();
    {
        const float lg = log2f(1.f - exp2f(-5.f - (float)h)); const int cc = c.tid & 15;
        float dec[8];
#pragma unroll
        for (int e = 0; e < 8; ++e) dec[e] = exp2f((float)(127 - (cc * 8 + e)) * lg);
        const unsigned char* src = (const unsigned char*)(rkdT + (size_t)(b * 4 + h) * 128 * SEQ + n * 128);
#pragma unroll
        for (int q = 0; q < 4; ++q) { const int r = (c.tid >> 4) + 32 * q; const u32x4 v = *(const u32x4*)(src + (size_t)r * SEQ * 2 + cc * 16); u32x4 o;
#pragma unroll
            for (int e2 = 0; e2 < 4; ++e2) o[e2] = pk2(__uint_as_float(v[e2] << 16) * dec[2 * e2], __uint_as_float(v[e2] & 0xffff0000u) * dec[2 * e2 + 1]);
            *(LAS u32x4*)(Kd + r * 272 + cc * 16) = o; }
    }
    bf16x8 vf[2][4];
#pragma unroll
    for (int ne = 0; ne < 2; ++ne)
#pragma unroll
        for (int ks = 0; ks < 4; ++ks) vf[ne][ks] = *(const bf16x8*)(rvT + ((size_t)(b * 4 + h) * 256 + 32 * w + 16 * ne + fr) * SEQ + n * 128 + ks * 32 + fq * 8);
    __syncthreads();
    float* out = kv + ((size_t)((b * 64 + n) * 4 + h)) * 256 * 128;
#pragma unroll
    for (int nd = 0; nd < 8; ++nd) { f32x4 a0 = (f32x4){0.f, 0.f, 0.f, 0.f}, a1 = a0;
#pragma unroll
        for (int ks = 0; ks < 4; ++ks) { const bf16x8 kf = *(const LAS bf16x8*)(Kd + (16 * nd + fr) * 272 + ks * 64 + fq * 16); a0 = MFMA16(kf, vf[0][ks], a0); a1 = MFMA16(kf, vf[1][ks], a1); }
        *(f32x4*)(out + (size_t)(32 * w + fr) * 128 + 16 * nd + 4 * fq) = a0; *(f32x4*)(out + (size_t)(32 * w + 16 + fr) * 128 + 16 * nd + 4 * fq) = a1; }
}
__device__ __forceinline__ void ret_scan(const Ctx& c, int first_block, int nblocks) {
    const float* kv = (const float*)(c.ws + AB_KV); bf16_t* sp = (bf16_t*)(c.ws + AB_SPREV);
    const int nthr = nblocks * NTHREADS;
    for (int idx = (c.bid - first_block) * NTHREADS + c.tid; idx < 2 * 4 * 256 * 128 / 4; idx += nthr) {
        const int b = idx >> 15, rem = idx & 32767, h = rem >> 13;
        const float g = exp2f(128.f * log2f(1.f - exp2f(-5.f - (float)h)));
        const size_t base = (size_t)b * 64 * 131072 + (size_t)rem * 4;
        f32x4 st = (f32x4){0.f, 0.f, 0.f, 0.f};
        for (int n0 = 0; n0 < 64; n0 += 8) { f32x4 v[8];
#pragma unroll
            for (int q = 0; q < 8; ++q) v[q] = *(const f32x4*)(kv + base + (size_t)(n0 + q) * 131072);
#pragma unroll
            for (int q = 0; q < 8; ++q) { u32x2 wv; wv[0] = pk2(st[0], st[1]); wv[1] = pk2(st[2], st[3]); *(u32x2*)(sp + base + (size_t)(n0 + q) * 131072) = wv; st = st * g + v[q]; } }
    }
}
__device__ __forceinline__ void ret_out_unit(const Ctx& c, int unit) {
    const int b = unit >> 8, n = (unit >> 2) & 63, h = unit & 3, lane = c.lane, fr = lane & 15, fq = lane >> 4, w = c.wid;
    const bf16_t* rqb = (const bf16_t*)(c.ws + AB_RQB); const bf16_t* rkb = (const bf16_t*)(c.ws + AB_RKB); const bf16_t* rvT = (const bf16_t*)(c.ws + AB_RVT);
    const bf16_t* sp = (const bf16_t*)(c.ws + AB_SPREV); const bf16_t* rgb = (const bf16_t*)(c.ws + AB_RGB); bf16_t* ycat = (bf16_t*)(c.ws + WS_YCAT);
    LAS unsigned char* Kl = c.lds; LAS unsigned char* Bl = c.lds + 128 * 272;
    const int t0 = b * SEQ + n * 128; const float lg = log2f(1.f - exp2f(-5.f - (float)h));
    __syncthreads();
    tile_g2l<128, 256>(Kl, (const unsigned char*)(rkb + (size_t)t0 * 512 + h * 128), (size_t)512 * 2, c.tid);
    tile_g2l<256, 256>(Bl, (const unsigned char*)(sp + ((size_t)((b * 64 + n) * 4 + h)) * 256 * 128), (size_t)128 * 2, c.tid);
    const int t = t0 + 16 * w + fr, i = 16 * w + fr;
    bf16x8 qf[4];
#pragma unroll
    for (int ks = 0; ks < 4; ++ks) qf[ks] = *(const bf16x8*)(rqb + (size_t)t * 512 + h * 128 + ks * 32 + fq * 8);
    __syncthreads();
    bf16x8 pf[4];
#pragma unroll
    for (int kk = 0; kk < 4; ++kk) { f32x4 s2[2];
#pragma unroll
        for (int q = 0; q < 2; ++q) { const int nj = 2 * kk + q; s2[q] = (f32x4){0.f, 0.f, 0.f, 0.f};
            if (nj <= w) {
#pragma unroll
                for (int ks = 0; ks < 4; ++ks) { const bf16x8 kf = *(const LAS bf16x8*)(Kl + (16 * nj + fr) * 272 + ks * 64 + fq * 16); s2[q] = MFMA16(kf, qf[ks], s2[q]); }
#pragma unroll
                for (int r = 0; r < 4; ++r) { const int jj = 16 * nj + 4 * fq + r; s2[q][r] = (i >= jj) ? s2[q][r] * exp2f((float)(i - jj) * lg) : 0.f; } } }
        pf[kk] = pack8(s2[0], s2[1]); }
    f32x4 acc[16];
#pragma unroll
    for (int ne = 0; ne < 16; ++ne) { acc[ne] = (f32x4){0.f, 0.f, 0.f, 0.f};
#pragma unroll
        for (int ks = 0; ks < 4; ++ks) { const bf16x8 sf = *(const LAS bf16x8*)(Bl + (16 * ne + fr) * 272 + ks * 64 + fq * 16); acc[ne] = MFMA16(sf, qf[ks], acc[ne]); } }
    const float rs = exp2f((float)(i + 1) * lg);
#pragma unroll
    for (int ne = 0; ne < 16; ++ne) acc[ne] = acc[ne] * rs;
    __syncthreads();
    tile_g2l<256, 256>(Bl, (const unsigned char*)(rvT + (size_t)(b * 4 + h) * 256 * SEQ + n * 128), (size_t)SEQ * 2, c.tid);
    __syncthreads();
    const int nkk = (w >> 1) + 1;
#pragma unroll
    for (int kk = 0; kk < 4; ++kk) if (kk < nkk) {
#pragma unroll
        for (int ne = 0; ne < 16; ++ne) { const u32x2 lo = *(const LAS u32x2*)(Bl + (16 * ne + fr) * 272 + (32 * kk + 4 * fq) * 2), hi = *(const LAS u32x2*)(Bl + (16 * ne + fr) * 272 + (32 * kk + 16 + 4 * fq) * 2);
            acc[ne] = MFMA16(cat8(lo, hi), pf[kk], acc[ne]); } }
    float sm = 0.f;
#pragma unroll
    for (int ne = 0; ne < 16; ++ne) sm += acc[ne][0] + acc[ne][1] + acc[ne][2] + acc[ne][3];
    sm += __shfl_xor(sm, 16); sm += __shfl_xor(sm, 32);
    const float mean = sm * (1.f / 256.f); float sq = 0.f;
#pragma unroll
    for (int ne = 0; ne < 16; ++ne) { acc[ne] = acc[ne] - mean; sq += acc[ne][0] * acc[ne][0] + acc[ne][1] * acc[ne][1] + acc[ne][2] * acc[ne][2] + acc[ne][3] * acc[ne][3]; }
    sq += __shfl_xor(sq, 16); sq += __shfl_xor(sq, 32);
    const float rstd = rsqrtf(sq * (1.f / 256.f) + LN_EPS);
#pragma unroll
    for (int ne = 0; ne < 16; ++ne) { const u32x2 gw = *(const u32x2*)(rgb + (size_t)t * 1024 + h * 256 + 16 * ne + 4 * fq);
        const float g0 = __uint_as_float(gw[0] << 16), g1 = __uint_as_float(gw[0] & 0xffff0000u), g2 = __uint_as_float(gw[1] << 16), g3 = __uint_as_float(gw[1] & 0xffff0000u);
        u32x2 o; o[0] = pk2(acc[ne][0] * rstd * g0, acc[ne][1] * rstd * g1); o[1] = pk2(acc[ne][2] * rstd * g2, acc[ne][3] * rstd * g3);
        *(u32x2*)(ycat + (size_t)t * AB_OUT + 1024 + h * 256 + 16 * ne + 4 * fq) = o; }
}

__device__ __forceinline__ void phase_ab_p1(const Ctx& c) {
    for (int u = c.bid; u < 512; u += c.G) ret_kv_unit(c, u);
}
__device__ __forceinline__ void phase_ab_p2(const Ctx& c, int j) {
    if (c.bid < 64) ret_scan(c, 0, 64);
    else { const float* sinks = c.in[3] + j * 16; for (int u = c.bid - 64; u < 256; u += c.G - 64) attn_unit(c, u, sinks); }
}
__device__ __forceinline__ void phase_ab_p3(const Ctx& c) {
    for (int u = c.bid; u < 512; u += c.G) ret_out_unit(c, u);
}

__device__ __forceinline__ float gelu_fast(float x) { const float u = 1.5957691216057308f * (x + 0.044715f * x * x * x); return x / (1.f + __expf(-u)); }
struct EpiCDIn {
    static constexpr bool PERM = true;
    LAS bf16_t* biasL; unsigned char* ws;
    __device__ __forceinline__ void operator()(const f32x4 (&acc)[2][2][4][2], const g8::Unit& u, int wr, int wc, int fr, int fq) const {
        const int pn = u.pn; const int col0 = pn * 256 + wc * 32 + fq * 8;
        f32x4 bv[2][2];
#pragma unroll
        for (int bj = 0; bj < 2; ++bj)
#pragma unroll
            for (int n = 0; n < 2; ++n) { const u32x2 bw = *(const LAS u32x2*)(biasL + col0 + bj * 128 + 4 * n); bv[bj][n] = (f32x4){__uint_as_float(bw[0] << 16), __uint_as_float(bw[0] & 0xffff0000u), __uint_as_float(bw[1] << 16), __uint_as_float(bw[1] & 0xffff0000u)}; }
        bf16_t* gu = (bf16_t*)(ws + CD_GU); bf16_t* gvT = (bf16_t*)(ws + CD_GVT); bf16_t* gg = (bf16_t*)(ws + CD_GG); bf16_t* xr = (bf16_t*)(ws + CD_XR); float* stats = (float*)(ws + CD_STATS);
#pragma unroll
        for (int ai = 0; ai < 2; ++ai)
#pragma unroll
            for (int m = 0; m < 4; ++m) {
                const int t = u.pm * 256 + ai * 128 + wr * 64 + m * 16 + fr, sq = t & (SEQ - 1), b = t >> 13;
                f32x4 x[2][2];
#pragma unroll
                for (int bj = 0; bj < 2; ++bj)
#pragma unroll
                    for (int n = 0; n < 2; ++n) { x[bj][n] = acc[ai][bj][m][n] + bv[bj][n];
                        if (pn < 13) {
#pragma unroll
                            for (int e = 0; e < 4; ++e) x[bj][n][e] = gelu_fast(x[bj][n][e]); } }
                if (pn >= 4 && pn < 8) {
                    float s1 = 0.f, s2 = 0.f;
#pragma unroll
                    for (int bj = 0; bj < 2; ++bj)
#pragma unroll
                        for (int n = 0; n < 2; ++n)
#pragma unroll
                            for (int e = 0; e < 4; ++e) { const float v = x[bj][n][e]; s1 += v; s2 += v * v;
                                gvT[((size_t)b * 1024 + (pn - 4) * 256 + bj * 128 + wc * 32 + fq * 8 + 4 * n + e) * SEQ + sq] = f2bf(v); }
                    s1 += __shfl_xor(s1, 16); s1 += __shfl_xor(s1, 32); s2 += __shfl_xor(s2, 16); s2 += __shfl_xor(s2, 32);
                    if (fq == 0) *(f32x2*)(stats + (size_t)t * 32 + ((pn - 4) * 4 + wc) * 2) = (f32x2){s1, s2};
                } else {
                    bf16_t* dst; int ld, cb;
                    if (pn < 4) { dst = gu; ld = 1024; cb = pn * 256; } else if (pn < 13) { dst = gg; ld = 1280; cb = (pn - 8) * 256; } else { dst = xr; ld = 1280; cb = (pn - 13) * 256; }
#pragma unroll
                    for (int bj = 0; bj < 2; ++bj) { u32x4 w;
#pragma unroll
                        for (int n = 0; n < 2; ++n) { w[2 * n] = pk2(x[bj][n][0], x[bj][n][1]); w[2 * n + 1] = pk2(x[bj][n][2], x[bj][n][3]); }
                        *(u32x4*)(dst + (size_t)t * ld + cb + bj * 128 + wc * 32 + fq * 8) = w; }
                }
            }
    }
};
__device__ __forceinline__ void phase_cd_inproj(const Ctx& c, int j) {
    g8::DenseOrder S; S.init(c.ws + WS_XB, c.ws + WS_WCDIN + (size_t)j * CD_IN * D * 2, T, CD_IN, D, c.G, c.bid); S.tid0 = c.tid;
    LAS bf16_t* biasL = (LAS bf16_t*)(c.lds + LDS_TAB);
    { const float* bp = c.in[7] + (size_t)j * CD_IN; for (int i = c.tid; i < CD_IN; i += NTHREADS) biasL[i] = f2bf(bp[i]); }
    __syncthreads();
    EpiCDIn E{biasL, c.ws};
    g8::gemm_phase<EpiCDIn, g8::DenseOrder>(c.lds + LDS_STAGE, D, S, E);
}

__device__ __forceinline__ void lru_unit(const Ctx& c, int unit, int j) {
    const int hh = unit % 5, bn = unit / 5, lane = c.lane, fr = lane & 15, fq = lane >> 4, w = c.wid;
    const int t0 = bn * 128, s0 = t0 & (SEQ - 1);
    const bf16_t* xr = (const bf16_t*)(c.ws + CD_XR); bf16_t* HL = (bf16_t*)(c.ws + WS_U2); bf16_t* PC = HL + (size_t)T * 1280; float* sum = (float*)(c.ws + WS_H);
    const float* conv_w = c.in[10] + (size_t)j * 4 * 1280 + hh * 256; const float* conv_b = c.in[11] + (size_t)j * 1280 + hh * 256;
    const float* ba = c.in[13] + (size_t)j * 1280 + hh * 256; const float* bx = c.in[15] + (size_t)j * 1280 + hh * 256; const float* spl = (const float*)(c.ws + WS_SPL) + (size_t)j * 1280 + hh * 256;
    const bf16_t* Wl = (const bf16_t*)(c.ws + WS_WLRU) + (size_t)((j * 5 + hh) * 2) * 65536;
    LAS unsigned char* Xc = c.lds; LAS unsigned char* Wa = c.lds + 128 * 528; LAS unsigned char* Wx = Wa + 64 * 528; LAS unsigned char* Tot = Wx + 64 * 528;
    __syncthreads();
    {
        const int cg = c.tid & 31, r0 = (c.tid >> 5) * 8;
        float wv[4][8], bv8[8];
        { const f32x4 b0 = *(const f32x4*)(conv_b + cg * 8), b1 = *(const f32x4*)(conv_b + cg * 8 + 4); bv8[0] = b0[0]; bv8[1] = b0[1]; bv8[2] = b0[2]; bv8[3] = b0[3]; bv8[4] = b1[0]; bv8[5] = b1[1]; bv8[6] = b1[2]; bv8[7] = b1[3]; }
#pragma unroll
        for (int k = 0; k < 4; ++k) { const f32x4 w0 = *(const f32x4*)(conv_w + k * 1280 + cg * 8), w1 = *(const f32x4*)(conv_w + k * 1280 + cg * 8 + 4);
            wv[k][0] = w0[0]; wv[k][1] = w0[1]; wv[k][2] = w0[2]; wv[k][3] = w0[3]; wv[k][4] = w1[0]; wv[k][5] = w1[1]; wv[k][6] = w1[2]; wv[k][7] = w1[3]; }
        u32x4 xin[11];
#pragma unroll
        for (int q = 0; q < 11; ++q) { xin[q] = (u32x4){0u, 0u, 0u, 0u}; if (s0 + r0 - 3 + q >= 0) xin[q] = *(const u32x4*)(xr + (size_t)(t0 + r0 - 3 + q) * 1280 + hh * 256 + cg * 8); }
#pragma unroll
        for (int rr = 0; rr < 8; ++rr) { float a[8];
#pragma unroll
            for (int e = 0; e < 8; ++e) a[e] = bv8[e];
#pragma unroll
            for (int k = 0; k < 4; ++k) { const u32x4 xv = xin[rr + k];
#pragma unroll
                for (int e2 = 0; e2 < 4; ++e2) { a[2 * e2] += wv[k][2 * e2] * __uint_as_float(xv[e2] << 16); a[2 * e2 + 1] += wv[k][2 * e2 + 1] * __uint_as_float(xv[e2] & 0xffff0000u); } }
            u32x4 o; o[0] = pk2(a[0], a[1]); o[1] = pk2(a[2], a[3]); o[2] = pk2(a[4], a[5]); o[3] = pk2(a[6], a[7]);
            *(LAS u32x4*)(Xc + (r0 + rr) * 528 + cg * 16) = o; }
    }
    u32x4 wreg[8];
#pragma unroll
    for (int q = 0; q < 4; ++q) { const int i = c.tid + q * NTHREADS, r = i >> 5, cc = i & 31; wreg[q] = *(const u32x4*)((const unsigned char*)Wl + (size_t)r * 512 + cc * 16); wreg[4 + q] = *(const u32x4*)((const unsigned char*)(Wl + 65536) + (size_t)r * 512 + cc * 16); }
    __syncthreads();
    bf16x8 xf[8];
#pragma unroll
    for (int ks = 0; ks < 8; ++ks) xf[ks] = *(const LAS bf16x8*)(Xc + (16 * w + fr) * 528 + ks * 64 + fq * 16);
    const int t = t0 + 16 * w + fr;
    for (int sl = 0; sl < 4; ++sl) {
        if (sl) __syncthreads();
#pragma unroll
        for (int q = 0; q < 4; ++q) { const int i = c.tid + q * NTHREADS, r = i >> 5, cc = i & 31; *(LAS u32x4*)(Wa + r * 528 + cc * 16) = wreg[q]; *(LAS u32x4*)(Wx + r * 528 + cc * 16) = wreg[4 + q]; }
        if (sl < 3) {
#pragma unroll
            for (int q = 0; q < 4; ++q) { const int i = c.tid + q * NTHREADS, r = i >> 5, cc = i & 31;
                wreg[q] = *(const u32x4*)((const unsigned char*)(Wl + (size_t)((sl + 1) * 64) * 256) + (size_t)r * 512 + cc * 16); wreg[4 + q] = *(const u32x4*)((const unsigned char*)(Wl + 65536 + (size_t)((sl + 1) * 64) * 256) + (size_t)r * 512 + cc * 16); } }
        __syncthreads();
        f32x4 sA[4], sB[4];
#pragma unroll
        for (int nc = 0; nc < 4; ++nc) { f32x4 ra = (f32x4){0.f, 0.f, 0.f, 0.f}, ri = ra;
#pragma unroll
            for (int ks = 0; ks < 8; ++ks) { const bf16x8 wa = *(const LAS bf16x8*)(Wa + (16 * nc + fr) * 528 + ks * 64 + fq * 16), wx = *(const LAS bf16x8*)(Wx + (16 * nc + fr) * 528 + ks * 64 + fq * 16);
                ra = MFMA16(wa, xf[ks], ra); ri = MFMA16(wx, xf[ks], ri); }
            const int ch = sl * 64 + 16 * nc + 4 * fq;
            const f32x4 b_a = *(const f32x4*)(ba + ch), b_x = *(const f32x4*)(bx + ch), sp = *(const f32x4*)(spl + ch);
            const u32x2 xw = *(const LAS u32x2*)(Xc + (16 * w + fr) * 528 + ch * 2);
            const float xcv[4] = {__uint_as_float(xw[0] << 16), __uint_as_float(xw[0] & 0xffff0000u), __uint_as_float(xw[1] << 16), __uint_as_float(xw[1] & 0xffff0000u)};
            f32x4 oa, ob;
#pragma unroll
            for (int r = 0; r < 4; ++r) { const float gr = sigmoidf_(ra[r] + b_a[r]), gi = sigmoidf_(ri[r] + b_x[r]); const float la = -8.f * gr * sp[r]; const float a = __expf(la);
                oa[r] = a; ob[r] = sqrtf(fmaxf(1.f - a * a, 0.f)) * (gi * xcv[r]); }
#pragma unroll
            for (int dlt = 1; dlt < 16; dlt <<= 1) {
#pragma unroll
                for (int r = 0; r < 4; ++r) { const float pa = __shfl_up(oa[r], dlt, 16), pb = __shfl_up(ob[r], dlt, 16); if (fr >= dlt) { ob[r] = oa[r] * pb + ob[r]; oa[r] = oa[r] * pa; } } }
            sA[nc] = oa; sB[nc] = ob;
            if (fr == 15) { *(LAS f32x4*)(Tot + ((w * 64 + 16 * nc + 4 * fq) * 2) * 4) = oa; *(LAS f32x4*)(Tot + ((w * 64 + 16 * nc + 4 * fq) * 2 + 4) * 4) = ob; }
        }
        __syncthreads();
#pragma unroll
        for (int nc = 0; nc < 4; ++nc) { const int ch = sl * 64 + 16 * nc + 4 * fq;
            f32x4 cp = (f32x4){1.f, 1.f, 1.f, 1.f}, chh = (f32x4){0.f, 0.f, 0.f, 0.f};
            for (int w2 = 0; w2 < w; ++w2) { const f32x4 ta = *(const LAS f32x4*)(Tot + ((w2 * 64 + 16 * nc + 4 * fq) * 2) * 4), tb = *(const LAS f32x4*)(Tot + ((w2 * 64 + 16 * nc + 4 * fq) * 2 + 4) * 4);
                chh = ta * chh + tb; cp = cp * ta; }
            const f32x4 hl = sB[nc] + sA[nc] * chh, pc = sA[nc] * cp;
            u32x2 o1, o2; o1[0] = pk2(hl[0], hl[1]); o1[1] = pk2(hl[2], hl[3]); o2[0] = pk2(pc[0], pc[1]); o2[1] = pk2(pc[2], pc[3]);
            *(u32x2*)(HL + (size_t)t * 1280 + hh * 256 + ch) = o1; *(u32x2*)(PC + (size_t)t * 1280 + hh * 256 + ch) = o2;
            if (w == 7 && fr == 15) { float* sm = sum + ((size_t)bn * 1280 + hh * 256 + ch) * 2;
#pragma unroll
                for (int r = 0; r < 4; ++r) { sm[2 * r] = pc[r]; sm[2 * r + 1] = hl[r]; } } }
    }
}

__device__ __forceinline__ void sgu_unit(const Ctx& c, int unit, int j) {
    const int g = unit & 3, bn = unit >> 2, b = bn >> 6, n = bn & 63, lane = c.lane, fr = lane & 15, fq = lane >> 4, w = c.wid;
    const int t0 = bn * 128;
    const bf16_t* gu = (const bf16_t*)(c.ws + CD_GU); const bf16_t* gvT = (const bf16_t*)(c.ws + CD_GVT); const float* stats = (const float*)(c.ws + CD_STATS); bf16_t* ycat = (bf16_t*)(c.ws + WS_YCAT);
    const float* sw = c.in[8] + (size_t)(j * 4 + g) * 16384; const float* sb = c.in[9] + (size_t)(j * 4 + g) * 128;
    LAS unsigned char* Vt = c.lds; LAS float* mr = (LAS float*)(c.lds + 256 * 272);
    __syncthreads();
    tile_g2l<256, 256>(Vt, (const unsigned char*)(gvT + ((size_t)b * 1024 + g * 256) * SEQ + n * 128), (size_t)SEQ * 2, c.tid);
    if (c.tid < 128) { const float* st = stats + (size_t)(t0 + c.tid) * 32; float s1 = 0.f, s2 = 0.f;
#pragma unroll
        for (int q = 0; q < 16; ++q) { s1 += st[2 * q]; s2 += st[2 * q + 1]; }
        const float mean = s1 * (1.f / 1024.f), var = fmaxf(s2 * (1.f / 1024.f) - mean * mean, 0.f); mr[2 * c.tid] = mean; mr[2 * c.tid + 1] = rsqrtf(var + LN_EPS); }
    __syncthreads();
    const int i = 16 * w + fr, t = t0 + i, nks = (w >> 1) + 1;
    bf16x8 wf[4]; float ci = 0.f;
#pragma unroll
    for (int ks = 0; ks < 4; ++ks) { f32x4 lo = (f32x4){0.f, 0.f, 0.f, 0.f}, hi = lo;
        if (ks < nks) { const int j0 = ks * 32 + fq * 8; const f32x4 w0 = *(const f32x4*)(sw + (size_t)i * 128 + j0), w1 = *(const f32x4*)(sw + (size_t)i * 128 + j0 + 4);
#pragma unroll
            for (int e = 0; e < 4; ++e) { const float m0 = mr[2 * (j0 + e)], r0 = mr[2 * (j0 + e) + 1], m1 = mr[2 * (j0 + 4 + e)], r1 = mr[2 * (j0 + 4 + e) + 1];
                lo[e] = (j0 + e <= i) ? w0[e] * r0 : 0.f; hi[e] = (j0 + 4 + e <= i) ? w1[e] * r1 : 0.f; ci += lo[e] * m0 + hi[e] * m1; } }
        wf[ks] = pack8(lo, hi); }
    ci += __shfl_xor(ci, 16); ci += __shfl_xor(ci, 32);
    const float add = sb[i] - ci;
    f32x4 acc[16];
#pragma unroll
    for (int nd = 0; nd < 16; ++nd) { acc[nd] = (f32x4){0.f, 0.f, 0.f, 0.f};
#pragma unroll
        for (int ks = 0; ks < 4; ++ks) if (ks < nks) { const bf16x8 vf = *(const LAS bf16x8*)(Vt + (16 * nd + fr) * 272 + ks * 64 + fq * 16); acc[nd] = MFMA16(vf, wf[ks], acc[nd]); } }
#pragma unroll
    for (int nd = 0; nd < 16; ++nd) { const u32x2 uw = *(const u32x2*)(gu + (size_t)t * 1024 + g * 256 + 16 * nd + 4 * fq);
        const float u0 = __uint_as_float(uw[0] << 16), u1 = __uint_as_float(uw[0] & 0xffff0000u), u2 = __uint_as_float(uw[1] << 16), u3 = __uint_as_float(uw[1] & 0xffff0000u);
        u32x2 o; o[0] = pk2(u0 * (acc[nd][0] + add), u1 * (acc[nd][1] + add)); o[1] = pk2(u2 * (acc[nd][2] + add), u3 * (acc[nd][3] + add));
        *(u32x2*)(ycat + (size_t)t * CD_OUT + g * 256 + 16 * nd + 4 * fq) = o; }
}
__device__ __forceinline__ void phase_cd_p1(const Ctx& c, int j) {
    for (int u = c.bid; u < 640; u += c.G) lru_unit(c, u, j);
    if (c.G == 256) {
        if (c.bid < 128) sgu_unit(c, c.bid, j);
        else { for (int q = 0; q < 3; ++q) sgu_unit(c, 128 + (c.bid - 128) * 3 + q, j); }
    } else { for (int u = c.bid; u < 512; u += c.G) sgu_unit(c, u, j); }
}

__device__ __forceinline__ void phase_cd_scan2(const Ctx& c) {
    const bf16_t* gg = (const bf16_t*)(c.ws + CD_GG); bf16_t* ycat = (bf16_t*)(c.ws + WS_YCAT);
    const bf16_t* HL = (const bf16_t*)(c.ws + WS_U2); const bf16_t* PC = HL + (size_t)T * 1280; const float* sum = (const float*)(c.ws + WS_H);
    LAS float* carry = (LAS float*)c.lds;
    for (int u = c.bid; u < 256; u += c.G) {
        const int bn = u >> 1, half = u & 1, b = bn >> 6, n = bn & 63;
        __syncthreads();
        for (int ch = c.tid; ch < 1280; ch += NTHREADS) { float cr = 0.f; const float* sp = sum + ((size_t)(b * 64) * 1280 + ch) * 2;
#pragma unroll 8
            for (int m = 0; m < n; ++m) { const f32x2 v = *(const f32x2*)(sp + (size_t)m * 2560); cr = v[0] * cr + v[1]; }
            carry[ch] = cr; }
        __syncthreads();
        const size_t t0 = (size_t)bn * 128 + half * 64;
#pragma unroll 4
        for (int it = c.tid; it < 64 * 320; it += NTHREADS) { const int r = it / 320, c4 = (it % 320) * 4; const size_t o = (t0 + r) * 1280 + c4;
            const u32x2 hw = *(const u32x2*)(HL + o), pw = *(const u32x2*)(PC + o), gw = *(const u32x2*)(gg + o); const f32x4 cr = *(const LAS f32x4*)(carry + c4);
            const float h0 = __uint_as_float(hw[0] << 16) + __uint_as_float(pw[0] << 16) * cr[0], h1 = __uint_as_float(hw[0] & 0xffff0000u) + __uint_as_float(pw[0] & 0xffff0000u) * cr[1];
            const float h2 = __uint_as_float(hw[1] << 16) + __uint_as_float(pw[1] << 16) * cr[2], h3 = __uint_as_float(hw[1] & 0xffff0000u) + __uint_as_float(pw[1] & 0xffff0000u) * cr[3];
            u32x2 ow; ow[0] = pk2(__uint_as_float(gw[0] << 16) * h0, __uint_as_float(gw[0] & 0xffff0000u) * h1); ow[1] = pk2(__uint_as_float(gw[1] << 16) * h2, __uint_as_float(gw[1] & 0xffff0000u) * h3);
            *(u32x2*)(ycat + (t0 + r) * CD_OUT + 1024 + c4) = ow; }
    }
}

__device__ __forceinline__ void phase_ln_moe(const Ctx& c, const float* g, const float* bta, float* xout) {
    typedef float f32x2v __attribute__((ext_vector_type(2)));
    bf16_t* xb = (bf16_t*)(c.ws + WS_XB); const unsigned char* Y = (const unsigned char*)(c.ws + WS_U1);
    for (long tt = (long)c.gw * 2; tt < T; tt += (long)c.nwaves * 2) {
        float v[2][2][8];
#pragma unroll
        for (int u = 0; u < 2; ++u) { const long t = tt + u;
#pragma unroll
            for (int q = 0; q < 2; ++q) { const int col = q * 512 + c.lane * 8;
                float f[8];
#pragma unroll
                for (int e = 0; e < 8; ++e) f[e] = 0.f;
#pragma unroll
                for (int k = 0; k < 8; ++k) { const size_t srow = (size_t)t * 8 + k; const u32x2 w = *(const u32x2*)(Y + srow * D + col);
#pragma unroll
                    for (int h2 = 0; h2 < 2; ++h2) { const f32x2v a = __builtin_amdgcn_cvt_pk_f32_fp8(w[h2], false), b = __builtin_amdgcn_cvt_pk_f32_fp8(w[h2], true);
                        f[4 * h2] += a[0]; f[4 * h2 + 1] += a[1]; f[4 * h2 + 2] += b[0]; f[4 * h2 + 3] += b[1]; } }
                const u32x4 xw = *(const u32x4*)(xb + (size_t)t * D + col), sw = *(const u32x4*)((const bf16_t*)(Y + (size_t)TK * D) + (size_t)t * D + col);
#pragma unroll
                for (int e2 = 0; e2 < 4; ++e2) { v[u][q][2 * e2] = __uint_as_float(xw[e2] << 16) * ALPHA + f[2 * e2] * (1.f / 64.f) + __uint_as_float(sw[e2] << 16);
                    v[u][q][2 * e2 + 1] = __uint_as_float(xw[e2] & 0xffff0000u) * ALPHA + f[2 * e2 + 1] * (1.f / 64.f) + __uint_as_float(sw[e2] & 0xffff0000u); } } }
#pragma unroll
        for (int u = 0; u < 2; ++u) { const long t = tt + u;
            float sm = 0.f;
#pragma unroll
            for (int q = 0; q < 2; ++q)
#pragma unroll
                for (int e = 0; e < 8; ++e) sm += v[u][q][e];
            const float mean = wave_sum(sm) * (1.f / 1024.f); float sq = 0.f;
#pragma unroll
            for (int q = 0; q < 2; ++q)
#pragma unroll
                for (int e = 0; e < 8; ++e) { v[u][q][e] -= mean; sq += v[u][q][e] * v[u][q][e]; }
            const float rstd = rsqrtf(wave_sum(sq) * (1.f / 1024.f) + LN_EPS);
#pragma unroll
            for (int q = 0; q < 2; ++q) { const int col = q * 512 + c.lane * 8; float o[8];
#pragma unroll
                for (int h2 = 0; h2 < 2; ++h2) { const f32x4 gg = *(const f32x4*)(g + col + 4 * h2), bb = *(const f32x4*)(bta + col + 4 * h2);
#pragma unroll
                    for (int e = 0; e < 4; ++e) o[4 * h2 + e] = v[u][q][4 * h2 + e] * rstd * gg[e] + bb[e];
                    if (xout) *(f32x4*)(xout + (size_t)t * D + col + 4 * h2) = (f32x4){o[4 * h2], o[4 * h2 + 1], o[4 * h2 + 2], o[4 * h2 + 3]}; }
                u32x4 w; w[0] = pk2(o[0], o[1]); w[1] = pk2(o[2], o[3]); w[2] = pk2(o[4], o[5]); w[3] = pk2(o[6], o[7]); *(u32x4*)(xb + (size_t)t * D + col) = w; } }
    }
}

__device__ __forceinline__ void phase_ln_route(const Ctx& c, int L) {
    bf16_t* xb = (bf16_t*)(c.ws + WS_XB); const bf16_t* hbuf = (const bf16_t*)(c.ws + WS_HB);
    const float* g = c.in[19] + (size_t)L * D; const float* bta = c.in[20] + (size_t)L * D; const float* rb = c.in[22] + L * NE;
    const bf16_t* Wr = (const bf16_t*)(c.ws + WS_WRT) + (size_t)L * 256 * D;
    int* cnt = (int*)(c.ws + CTL_CNT) + L * NE * 1024; int* list = (int*)(c.ws + WS_LIST); float* gate = (float*)(c.ws + WS_GATE);
    LAS unsigned char* Xl = c.lds; LAS float* Sc = (LAS float*)c.lds;
    const int lane = c.lane, fr = lane & 15, fq = lane >> 4, w = c.wid;
    for (int grp = c.bid; grp < T / 64; grp += c.G) {
        __syncthreads();
        for (int q8 = 0; q8 < 8; q8 += 4) {
            f32x4 v[4][4];
#pragma unroll
            for (int u = 0; u < 4; ++u) { const size_t t = (size_t)grp * 64 + w * 8 + q8 + u;
#pragma unroll
                for (int q = 0; q < 4; ++q) { const int col = q * 256 + lane * 4; const u32x2 xw = *(const u32x2*)(xb + t * D + col), hw = *(const u32x2*)(hbuf + t * D + col);
                    v[u][q] = (f32x4){__uint_as_float(xw[0] << 16), __uint_as_float(xw[0] & 0xffff0000u), __uint_as_float(xw[1] << 16), __uint_as_float(xw[1] & 0xffff0000u)} * ALPHA + (f32x4){__uint_as_float(hw[0] << 16), __uint_as_float(hw[0] & 0xffff0000u), __uint_as_float(hw[1] << 16), __uint_as_float(hw[1] & 0xffff0000u)}; } }
#pragma unroll
            for (int u = 0; u < 4; ++u) { const int rr = w * 8 + q8 + u; const size_t t = (size_t)grp * 64 + rr;
                float sm = 0.f;
#pragma unroll
                for (int q = 0; q < 4; ++q) sm += v[u][q][0] + v[u][q][1] + v[u][q][2] + v[u][q][3];
                const float mean = wave_sum(sm) * (1.f / 1024.f); float sq = 0.f;
#pragma unroll
                for (int q = 0; q < 4; ++q) { v[u][q] = v[u][q] - mean; sq += v[u][q][0] * v[u][q][0] + v[u][q][1] * v[u][q][1] + v[u][q][2] * v[u][q][2] + v[u][q][3] * v[u][q][3]; }
                const float rstd = rsqrtf(wave_sum(sq) * (1.f / 1024.f) + LN_EPS);
#pragma unroll
                for (int q = 0; q < 4; ++q) { const int col = q * 256 + lane * 4; const f32x4 o = v[u][q] * rstd * *(const f32x4*)(g + col) + *(const f32x4*)(bta + col);
                    u32x2 wv; wv[0] = pk2(o[0], o[1]); wv[1] = pk2(o[2], o[3]); *(u32x2*)(xb + t * D + col) = wv; *(LAS u32x2*)(Xl + rr * 2064 + col * 2) = wv; } } }
        __syncthreads();
        const int st = w & 3, eh = w >> 2;
        f32x4 acc[4];
#pragma unroll
        for (int ne = 0; ne < 4; ++ne) acc[ne] = (f32x4){0.f, 0.f, 0.f, 0.f};
        const int rot = (grp * 5 + w * 3) & 31;
#pragma unroll 8
        for (int k0 = 0; k0 < 32; ++k0) { const int ks = (k0 + rot) & 31; const bf16x8 bop = *(const LAS bf16x8*)(Xl + (16 * st + fr) * 2064 + ks * 64 + fq * 16);
#pragma unroll
            for (int ne = 0; ne < 4; ++ne) { const bf16x8 aop = *(const bf16x8*)(Wr + (size_t)(64 * eh + 16 * ne + fr) * D + ks * 32 + fq * 8); acc[ne] = MFMA16(aop, bop, acc[ne]); } }
        __syncthreads();
#pragma unroll
        for (int ne = 0; ne < 4; ++ne) { f32x4 sg; for (int r = 0; r < 4; ++r) sg[r] = sigmoidf_(acc[ne][r]); *(LAS f32x4*)(Sc + (16 * st + fr) * 128 + 64 * eh + 16 * ne + 4 * fq) = sg; }
        __syncthreads();
        LAS int* hist = (LAS int*)(c.lds + 40960); LAS int* gbase = hist + 128; LAS int* sel = gbase + 128; LAS float* selg = (LAS float*)(sel + 512);
        if (c.tid < 128) hist[c.tid] = 0;
        __syncthreads();
        {
            float s0[8], s1[8], v0[8], v1[8], mysc[8], tot[8]; int myexp[8];
            const float rb0 = rb[lane], rb1 = rb[64 + lane];
#pragma unroll
            for (int q = 0; q < 8; ++q) { const int rr = w * 8 + q; s0[q] = Sc[rr * 128 + lane]; s1[q] = Sc[rr * 128 + 64 + lane]; v0[q] = s0[q] + rb0; v1[q] = s1[q] + rb1; mysc[q] = 0.f; tot[q] = 0.f; myexp[q] = 0; }
            for (int k = 0; k < 8; ++k) {
                float bv[8]; int bi[8];
#pragma unroll
                for (int q = 0; q < 8; ++q) { bv[q] = v0[q]; bi[q] = lane; if (v1[q] > bv[q]) { bv[q] = v1[q]; bi[q] = lane + 64; } }
#pragma unroll
                for (int o = 32; o; o >>= 1) {
#pragma unroll
                    for (int q = 0; q < 8; ++q) { const float ov = __shfl_xor(bv[q], o); const int oi = __shfl_xor(bi[q], o); if (ov > bv[q] || (ov == bv[q] && oi < bi[q])) { bv[q] = ov; bi[q] = oi; } } }
#pragma unroll
                for (int q = 0; q < 8; ++q) { const float sc = __shfl((bi[q] & 64) ? s1[q] : s0[q], bi[q] & 63);
                    tot[q] += sc;
                    if (lane == k) { mysc[q] = sc; myexp[q] = bi[q]; }
                    if (lane == (bi[q] & 63)) { if (bi[q] & 64) v1[q] = -1e30f; else v0[q] = -1e30f; } }
            }
            if (lane < 8) {
#pragma unroll
                for (int q = 0; q < 8; ++q) { const int rr = w * 8 + q; const int lr = __hip_atomic_fetch_add(&hist[myexp[q]], 1, __ATOMIC_RELAXED, __HIP_MEMORY_SCOPE_WORKGROUP);
                    sel[rr * 8 + lane] = (myexp[q] << 16) | lr; selg[rr * 8 + lane] = mysc[q] / tot[q] * 2.5f; } }
        }
        __syncthreads();
        if (c.tid < 128) gbase[c.tid] = atomicAdd(&cnt[c.tid * 1024], hist[c.tid]);
        __syncthreads();
        { const int sv = sel[c.tid], e = sv >> 16, lr = sv & 0xffff; const int slot = (grp * 64 + (c.tid >> 3)) * 8 + (c.tid & 7);
          list[(size_t)e * LISTCAP + gbase[e] + lr] = slot; gate[slot] = selg[c.tid]; }
    }
}

struct MoeOrder {
    const char* Abase; const char* Bbase; size_t Bstride; int K, NT, NTG, total, G, c, mode, tid0;
    LAS int* tab; LAS int* desc;
    __device__ __forceinline__ bool next(int i, g8::Unit& u) const {
        const int ip = i / NTG, q = i - ip * NTG;
        const long L = (long)ip * G + c; if (L >= total || ip >= TAB_SLOTS) return false;
        const int d = desc[ip]; const int e = d >> 12, pn = (d & 15) * NTG + q;
        u.pm = (d >> 4) & 255; u.pn = pn; u.aux = ip; u.A = Abase; u.B = Bbase + (size_t)e * Bstride + (size_t)pn * 256 * K * 2; return true;
    }
    __device__ __forceinline__ void aoff(const g8::Unit& u, int tid, unsigned (&o)[2][2]) const {
#pragma unroll
        for (int i = 0; i < 2; ++i) { int R, C; g8::stage_rc(tid * 16 + i * 8192, R, C);
#pragma unroll
            for (int h = 0; h < 2; ++h) { int s = tab[u.aux * 256 + h * 128 + R]; s = s < 0 ? 0 : s; const int row = mode ? s : (s < TK ? (s >> 3) : s - TK);
                o[h][i] = (unsigned)(row * K + C) * 2u; } }
    }
};
__device__ __forceinline__ void moe_setup(const Ctx& c, MoeOrder& S, const int* cnt, int NT, int NTG) {
    LAS int* pref = (LAS int*)(c.lds + LDS_PREF); LAS int* desc = (LAS int*)(c.lds + LDS_DESC); LAS int* tab = (LAS int*)(c.lds + LDS_TAB);
    const int* list = (const int*)(c.ws + WS_LIST);
    if (c.tid < 64) { int nb[3]; int loc = 0;
#pragma unroll
        for (int q = 0; q < 3; ++q) { const int e = c.tid * 3 + q; int n = 0; if (e < NE) n = cnt[e * 1024]; else if (e == NE) n = T; nb[q] = (n + 255) >> 8; loc += nb[q]; }
        int inc = loc;
#pragma unroll
        for (int o = 1; o < 64; o <<= 1) { const int v = __shfl_up(inc, o); if (c.tid >= o) inc += v; }
        int acc = inc - loc;
#pragma unroll
        for (int q = 0; q < 3; ++q) { const int e = c.tid * 3 + q; if (e <= NE1) pref[e] = acc; acc += nb[q]; } }
    __syncthreads();
    const int NG = NT / NTG; const int total = pref[NE1] * NG;
    LAS float* gtab = (LAS float*)(c.lds + LDS_GTAB); const float* gate = (const float*)(c.ws + WS_GATE);
    S.NT = NT; S.NTG = NTG; S.total = total; S.G = c.G; S.c = c.bid; S.tab = tab; S.desc = desc;
    {
        int sv[TAB_SLOTS / 2];
#pragma unroll
        for (int k = 0; k < TAB_SLOTS / 2; ++k) { const int i = (c.tid >> 8) + 2 * k; sv[k] = -2;
            const long L = (long)i * c.G + c.bid;
            if (L < total) {
                int wgid = (int)L; { const int q = total / 8, r = total % 8, xcd = wgid % 8, off = wgid / 8; wgid = (xcd < r ? xcd * (q + 1) : r * (q + 1) + (xcd - r) * q) + off; }
                const int rbg = wgid / NG, pn = wgid % NG;
                int lo = 0, hi = NE1;
                while (hi - lo > 1) { const int mid = (lo + hi) >> 1; if (pref[mid] <= rbg) lo = mid; else hi = mid; }
                const int e = lo, rb = rbg - pref[e], n = e < NE ? cnt[e * 1024] : T;
                if ((c.tid & 255) == 0) desc[i] = (e << 12) | (rb << 4) | pn;
                const int r = rb * 256 + (c.tid & 255); sv[k] = -1; if (r < n) sv[k] = (e < NE) ? list[(size_t)e * LISTCAP + r] : TK + r; } }
#pragma unroll
        for (int k = 0; k < TAB_SLOTS / 2; ++k) { const int i = (c.tid >> 8) + 2 * k; if (sv[k] != -2) { tab[i * 256 + (c.tid & 255)] = sv[k]; if (S.mode) gtab[i * 256 + (c.tid & 255)] = sv[k] >= 0 ? gate[sv[k]] : 0.f; } }
    }
    __syncthreads();
}
struct EpiMoeGU {
    static constexpr bool PERM = true;
    bf16_t* H; LAS int* tab;
    __device__ __forceinline__ void operator()(const f32x4 (&acc)[2][2][4][2], const g8::Unit& u, int wr, int wc, int fr, int fq) const {
#pragma unroll
        for (int ai = 0; ai < 2; ++ai)
#pragma unroll
            for (int m = 0; m < 4; ++m) { const int r = ai * 128 + wr * 64 + m * 16 + fr; const int s = tab[u.aux * 256 + r];
                if (s >= 0) { u32x4 w;
#pragma unroll
                    for (int n = 0; n < 2; ++n) { const f32x4 g = acc[ai][0][m][n], up = acc[ai][1][m][n];
                        w[2 * n] = pk2(siluf_(g[0]) * up[0], siluf_(g[1]) * up[1]); w[2 * n + 1] = pk2(siluf_(g[2]) * up[2], siluf_(g[3]) * up[3]); }
                    *(u32x4*)(H + (size_t)s * ED + u.pn * 128 + wc * 32 + fq * 8) = w; } }
    }
};
struct EpiMoeDN {
    static constexpr bool PERM = true;
    unsigned char* Y; LAS float* gtab; LAS int* tab;
    __device__ __forceinline__ void operator()(const f32x4 (&acc)[2][2][4][2], const g8::Unit& u, int wr, int wc, int fr, int fq) const {
#pragma unroll
        for (int ai = 0; ai < 2; ++ai)
#pragma unroll
            for (int m = 0; m < 4; ++m) { const int r = ai * 128 + wr * 64 + m * 16 + fr; const int s = tab[u.aux * 256 + r];
                if (s >= TK) {
#pragma unroll
                    for (int bj = 0; bj < 2; ++bj) { u32x4 w;
#pragma unroll
                        for (int n = 0; n < 2; ++n) { const f32x4 a = acc[ai][bj][m][n]; w[2 * n] = pk2(a[0], a[1]); w[2 * n + 1] = pk2(a[2], a[3]); }
                        *(u32x4*)((bf16_t*)(Y + (size_t)TK * D) + (size_t)(s - TK) * D + u.pn * 256 + bj * 128 + wc * 32 + fq * 8) = w; }
                } else if (s >= 0) { const float gt = gtab[u.aux * 256 + r] * 64.f;
#pragma unroll
                    for (int bj = 0; bj < 2; ++bj) { u32x2 w;
#pragma unroll
                        for (int n = 0; n < 2; ++n) { f32x4 a = acc[ai][bj][m][n] * gt;
#pragma unroll
                            for (int e = 0; e < 4; ++e) a[e] = fminf(fmaxf(a[e], -448.f), 448.f);
                            unsigned pw = 0u; pw = __builtin_amdgcn_cvt_pk_fp8_f32(a[0], a[1], pw, false); pw = __builtin_amdgcn_cvt_pk_fp8_f32(a[2], a[3], pw, true); w[n] = pw; }
                        *(u32x2*)(Y + (size_t)s * D + u.pn * 256 + bj * 128 + wc * 32 + fq * 8) = w; } } }
    }
};
__device__ __forceinline__ void phase_moe_gu(const Ctx& c, int L) {
    MoeOrder S; S.Abase = (const char*)(c.ws + WS_XB); S.Bbase = (const char*)(c.ws + WS_WGU) + (size_t)L * NE1 * 512 * D * 2; S.Bstride = (size_t)512 * D * 2; S.K = D; S.mode = 0; S.tid0 = c.tid;
    moe_setup(c, S, (const int*)(c.ws + CTL_CNT) + L * NE * 1024, 2, 1);
    EpiMoeGU E{(bf16_t*)(c.ws + WS_HID), S.tab};
    g8::gemm_phase<EpiMoeGU, MoeOrder>(c.lds + LDS_STAGE, D, S, E);
}
__device__ __forceinline__ void phase_moe_dn(const Ctx& c, int L) {
    MoeOrder S; S.Abase = (const char*)(c.ws + WS_HID); S.Bbase = (const char*)(c.ws + WS_WDN) + (size_t)L * NE1 * D * ED * 2; S.Bstride = (size_t)D * ED * 2; S.K = ED; S.mode = 1; S.tid0 = c.tid;
    moe_setup(c, S, (const int*)(c.ws + CTL_CNT) + L * NE * 1024, 4, 2);
    EpiMoeDN E{(unsigned char*)(c.ws + WS_U1), (LAS float*)(c.lds + LDS_GTAB), S.tab};
    g8::gemm_phase<EpiMoeDN, MoeOrder>(c.lds + LDS_STAGE, ED, S, E);
}

constexpr int PH_PER_LAYER = 9;
constexpr int N_PHASES = 1 + 4 * PH_PER_LAYER;

__global__ void __launch_bounds__(NTHREADS, 2) fwd_kernel(Params p) {
    extern __shared__ __attribute__((aligned(16))) unsigned char lds_raw[];
    LAS unsigned char* const lds0 = (LAS unsigned char*)lds_raw;
    const int wave_id = __builtin_amdgcn_readfirstlane((int)threadIdx.x >> 6);
    volatile LAS unsigned* misc = (volatile LAS unsigned*)(lds0 + LDS_MISC);
    if (threadIdx.x < 4) misc[threadIdx.x] = 0u;
    __syncthreads();
    const int lo = p.ph_lo, hi = p.ph_hi;
    XcdBarrier bar; bar.bar = (unsigned*)(p.ws + WS_CTL); bar.x = 0; bar.st = misc;
    if (hi - lo > 1) bar = xcd_barrier_post((unsigned*)(p.ws + WS_CTL), misc);
#define MKCTX() Ctx c; { int wv_ = wave_id; asm volatile("" : "+s"(wv_)); int tid_ = wv_ * 64 + (int)__builtin_amdgcn_mbcnt_hi(~0u, __builtin_amdgcn_mbcnt_lo(~0u, 0u)); asm volatile("" : "+v"(tid_)); int bid_ = blockIdx.x; asm volatile("" : "+s"(bid_)); unsigned long long ws_ = (unsigned long long)p.ws; asm volatile("" : "+s"(ws_)); \
        c.in = p.in; c.out = p.out; c.ws = (unsigned char*)ws_; c.lds = lds0; c.tid = tid_; c.lane = tid_ & 63; c.wid = __builtin_amdgcn_readfirstlane(tid_ >> 6); c.bid = bid_; c.G = gridDim.x; \
        c.gtid = c.bid * NTHREADS + c.tid; c.gthreads = c.G * NTHREADS; c.gw = c.bid * 8 + c.wid; c.nwaves = c.G * 8; } unsigned char* const ws = c.ws; (void)ws
    int id = 0;
#ifndef PMASK
#define PMASK 0xffffffffu
#endif
#ifndef DUPMASK
#define DUPMASK 0u
#endif
#define PHASE(k, body) do { if (((PMASK >> (k)) & 1u) && lo <= id && id < hi) { MKCTX(); body; if ((DUPMASK >> (k)) & 1u) { body; } if (id + 1 < hi) xcd_barrier(bar, c.tid == 0); } ++id; } while (0)
    PHASE(0, phase_convert(c));
#pragma unroll 1
    for (int L = 0; L < 4; ++L) {
        const int j = L >> 1; const bool cd = (L & 1);
        if (cd) {
            PHASE(1, phase_cd_inproj(c, j));
        } else {
            PHASE(2, phase_ab_inproj(c, j));
        }
        if (!cd) { PHASE(3, phase_ab_p1(c)); PHASE(4, phase_ab_p2(c, j)); PHASE(16, phase_ab_p3(c)); }
        else     { PHASE(5, phase_cd_p1(c, j)); PHASE(15, phase_cd_scan2(c)); id += 1; }
        {
            const size_t Woff = cd ? WS_WCDOUT + (size_t)j * D * CD_OUT * 2 : WS_WABOUT + (size_t)j * D * AB_OUT * 2;
            const int K = cd ? CD_OUT : AB_OUT; const float* bias = cd ? p.in[18] + (size_t)j * D : p.in[5] + (size_t)j * D;
            PHASE(8, phase_dense(c, (const bf16_t*)(ws + WS_YCAT), (const bf16_t*)(ws + Woff), T, D, K, (bf16_t*)(ws + WS_HB), D, bias));
        }
        PHASE(9, phase_ln_route(c, L));
        PHASE(12, phase_moe_gu(c, L));
        PHASE(13, phase_moe_dn(c, L));
        PHASE(14, phase_ln_moe(c, p.in[29] + (size_t)L * D, p.in[30] + (size_t)L * D, L == 3 ? p.out : (float*)nullptr));
    }
#undef PHASE
}

extern "C" void kernel_launch(void* const* d_in, const int* in_sizes, int n_in, void* d_out, int out_size, void* d_ws, size_t ws_size, hipStream_t stream) {
    static int grid = 0;
    if (grid == 0) {
        if (n_in != 31 || out_size != T * D || ws_size < WS_END) { fprintf(stderr, "kernel_launch: unexpected shapes (n_in %d out %d ws %zu need %zu)\n", n_in, out_size, ws_size, (size_t)WS_END); grid = -1; return; }
        int dev = 0, cus = 0, per_cu = 0;
        if (hipGetDevice(&dev) != hipSuccess || hipDeviceGetAttribute(&cus, hipDeviceAttributeMultiprocessorCount, dev) != hipSuccess) { grid = -1; return; }
        if (hipFuncSetAttribute((const void*)fwd_kernel, hipFuncAttributeMaxDynamicSharedMemorySize, LDS_BYTES) != hipSuccess) { fprintf(stderr, "kernel_launch: hipFuncSetAttribute failed\n"); grid = -1; return; }
        if (hipOccupancyMaxActiveBlocksPerMultiprocessor(&per_cu, (const void*)fwd_kernel, NTHREADS, LDS_BYTES) != hipSuccess || per_cu < 1) fprintf(stderr, "kernel_launch: occupancy query says %d\n", per_cu);
        (void)hipGetLastError();
        grid = cus;
    }
    if (grid < 0) return;
    (void)hipMemsetAsync((char*)d_ws + WS_CTL, 0, CTL_BYTES, stream);
    Params p{};
    for (int i = 0; i < 31; ++i) p.in[i] = (const float*)d_in[i];
    p.out = (float*)d_out; p.ws = (unsigned char*)d_ws;
#if N_LAUNCH_MODE == 1
    p.ph_lo = 0; p.ph_hi = N_PHASES;
    hipLaunchKernelGGL(fwd_kernel, dim3(grid), dim3(NTHREADS), LDS_BYTES, stream, p);
#else
    for (int i = 0; i < N_PHASES; ++i) { p.ph_lo = i; p.ph_hi = i + 1; hipLaunchKernelGGL(fwd_kernel, dim3(grid), dim3(NTHREADS), LDS_BYTES, stream, p); }
#endif
}
```

```cpp
#include <hip/hip_runtime.h>
#include <cstdio>
#include <cstdint>

#define LAS __attribute__((address_space(3)))
typedef unsigned short bf16_t;
typedef short bf16x8 __attribute__((ext_vector_type(8)));
typedef float f32x4 __attribute__((ext_vector_type(4)));
typedef float f32x2 __attribute__((ext_vector_type(2)));
typedef unsigned u32x4 __attribute__((ext_vector_type(4)));
typedef unsigned u32x2 __attribute__((ext_vector_type(2)));

constexpr int T = 16384, D = 1024, SEQ = 8192;
constexpr int AB_IN = 4352, AB_OUT = 2048, CD_IN = 4608, CD_OUT = 2304;
constexpr int NE = 128, NE1 = 129, TOPK = 8, ED = 256;
constexpr int TK = T * TOPK;
constexpr int NSLOT = TK + T;
constexpr int LISTCAP = 16384;
constexpr float ALPHA = 1.681792830507429f;
constexpr float LN_EPS = 1e-5f;

#ifndef N_LAUNCH_MODE
#define N_LAUNCH_MODE 1
#endif

constexpr size_t al256(size_t x) { return (x + 255) & ~(size_t)255; }
constexpr size_t WS_CTL    = 0;
constexpr size_t CTL_BYTES = 65536 + (size_t)4 * 128 * 4096;
constexpr size_t CTL_CNT   = 65536;
constexpr size_t WS_WABIN  = CTL_BYTES;
constexpr size_t WS_WABOUT = WS_WABIN  + al256((size_t)2 * AB_IN * D * 2);
constexpr size_t WS_WCDIN  = WS_WABOUT + al256((size_t)2 * D * AB_OUT * 2);
constexpr size_t WS_WCDOUT = WS_WCDIN  + al256((size_t)2 * CD_IN * D * 2);
constexpr size_t WS_WRT    = WS_WCDOUT + al256((size_t)2 * D * CD_OUT * 2);
constexpr size_t WS_WGU    = WS_WRT    + al256((size_t)4 * 256 * D * 2);
constexpr size_t WS_WDN    = WS_WGU    + al256((size_t)4 * NE1 * 512 * D * 2);
constexpr size_t WS_X      = WS_WDN    + al256((size_t)4 * NE1 * D * ED * 2);
constexpr size_t WS_HB     = WS_X;
constexpr size_t WS_XB     = WS_X      + al256((size_t)T * D * 4);
constexpr size_t WS_U1     = WS_XB     + al256((size_t)T * D * 2);
constexpr size_t U1_BYTES  = al256((size_t)NSLOT * D * 2) > al256((size_t)T * CD_IN * 4) ? al256((size_t)NSLOT * D * 2) : al256((size_t)T * CD_IN * 4);
constexpr size_t WS_U2     = WS_U1     + U1_BYTES;
constexpr size_t U2_BYTES  = al256((size_t)T * 1280 * 4 * 3);
constexpr size_t WS_YCAT   = WS_U2     + U2_BYTES;
constexpr size_t WS_H      = WS_YCAT   + al256((size_t)T * CD_OUT * 2);
constexpr size_t WS_ZR     = WS_H      + al256((size_t)T * D * 4);
constexpr size_t WS_HID    = WS_ZR     + al256((size_t)T * 256 * 4);
constexpr size_t WS_LIST   = WS_HID    + al256((size_t)NSLOT * ED * 2);
constexpr size_t WS_GATE   = WS_LIST   + al256((size_t)NE * LISTCAP * 4);
constexpr size_t WS_ROPEA  = WS_GATE   + al256((size_t)NSLOT * 4);
constexpr size_t WS_ROPER  = WS_ROPEA  + al256((size_t)SEQ * 32 * 8);
constexpr size_t WS_BIASP  = WS_ROPER  + al256((size_t)SEQ * 64 * 8);
constexpr size_t WS_WLRU   = WS_BIASP  + al256((size_t)2 * AB_IN * 4);
constexpr size_t WS_SPL    = WS_WLRU   + al256((size_t)2 * 5 * 2 * 65536 * 2);
constexpr size_t WS_END    = WS_SPL    + al256((size_t)2 * 1280 * 4);
constexpr size_t CD_GU = WS_U1, CD_GVT = WS_U1 + 32 * (1024 * 1024), CD_GG = WS_U1 + 64 * (1024 * 1024), CD_XR = WS_U1 + 104 * (1024 * 1024), CD_STATS = WS_U1 + 144 * (1024 * 1024);
constexpr size_t MB = 1024 * 1024;
constexpr size_t AB_QB = WS_U1, AB_KB = WS_U1 + 32 * MB, AB_VT = WS_U1 + 36 * MB, AB_RQB = WS_U1 + 40 * MB, AB_RKB = WS_U1 + 56 * MB, AB_RKDT = WS_U1 + 72 * MB,
                 AB_RVT = WS_U1 + 88 * MB, AB_RGB = WS_U1 + 120 * MB, AB_KV = WS_U1 + 152 * MB  , AB_SPREV = WS_U1 + 216 * MB  ;
static_assert(AB_SPREV + 32 * MB <= WS_U1 + U1_BYTES, "U1 map");

__device__ __forceinline__ float bf2f(bf16_t b) { return __uint_as_float(((unsigned)b) << 16); }
__device__ __forceinline__ unsigned pk2(float lo, float hi) { unsigned r; asm("v_cvt_pk_bf16_f32 %0, %1, %2" : "=v"(r) : "v"(lo), "v"(hi)); return r; }
__device__ __forceinline__ bf16_t f2bf(float f) { return (bf16_t)(pk2(f, f) & 0xffffu); }
__device__ __forceinline__ float wave_sum(float v) {
#pragma unroll
    for (int o = 32; o; o >>= 1) v += __shfl_xor(v, o);
    return v; }
__device__ __forceinline__ float wave_max(float v) {
#pragma unroll
    for (int o = 32; o; o >>= 1) v = fmaxf(v, __shfl_xor(v, o));
    return v; }
__device__ __forceinline__ float gelu_tanh(float x) { const float u = 0.7978845608028654f * (x + 0.044715f * x * x * x); return 0.5f * x * (1.f + tanhf(u)); }
__device__ __forceinline__ float sigmoidf_(float x) { return 1.f / (1.f + __expf(-x)); }
__device__ __forceinline__ float siluf_(float x) { return x * __builtin_amdgcn_rcpf(1.f + __expf(-x)); }

#define XB_TMO      128
#define XB_XCNT(j)  (256  + 64 * (j))
#define XB_XSUB(j)  (1280 + 64 * (j))
#define XB_XGEN(j)  (2304 + 64 * (j))
#define XB_TOP      3328
#define XB_TOPGEN   3392
#define XCD_BAR_WORDS 3456
#define XB_SPIN_CAP (1u << 22)

__device__ __forceinline__ unsigned xb_ld(unsigned* p)              { return __hip_atomic_load(p, __ATOMIC_RELAXED, __HIP_MEMORY_SCOPE_AGENT); }
__device__ __forceinline__ unsigned xb_add(unsigned* p, unsigned v) { return __hip_atomic_fetch_add(p, v, __ATOMIC_RELAXED, __HIP_MEMORY_SCOPE_AGENT); }
__device__ __forceinline__ unsigned xb_xcc_id() { return (unsigned)__builtin_amdgcn_s_getreg((3 << 11) | 20) & 0xFu; }
#define XB_SPIN(cond, bar) do { unsigned _sp = 0; while (cond) { __builtin_amdgcn_s_sleep(1); \
    if ((++_sp & 255u) == 0u) { if (xb_ld(&(bar)[XB_TMO])) break; if (_sp > XB_SPIN_CAP) { atomicAdd(&(bar)[XB_TMO], 1u); break; } } } } while (0)

struct XcdBarrier { unsigned* bar; unsigned x; volatile LAS unsigned* st; };

__device__ __forceinline__ XcdBarrier xcd_barrier_post(unsigned* bar, volatile LAS unsigned* st) {
    XcdBarrier b; b.bar = bar; b.x = xb_xcc_id(); b.st = st;
    if (threadIdx.x == 0) (void)xb_add(&bar[XB_XCNT(b.x)], 1u);
    return b;
}
__device__ __forceinline__ void xcd_barrier_complete(unsigned* bar, unsigned x, unsigned& nloc, unsigned& nx) {
    const unsigned G = gridDim.x * gridDim.y * gridDim.z;
    unsigned sum, cnt, mine, sp = 0u;
    for (;;) {
        sum = 0u; cnt = 0u; mine = 0u;
#pragma unroll
        for (unsigned j = 0; j < 16; ++j) { const unsigned c = xb_ld(&bar[XB_XCNT(j)]); sum += c; cnt += (c > 0u) ? 1u : 0u; mine = (j == x) ? c : mine; }
        if (sum == G) break;
        __builtin_amdgcn_s_sleep(1);
        if ((++sp & 255u) == 0u) { if (xb_ld(&bar[XB_TMO])) break; if (sp > XB_SPIN_CAP) { atomicAdd(&bar[XB_TMO], 1u); break; } }
    }
    nloc = mine > 0u ? mine : 1u; nx = cnt > 0u ? cnt : 1u;
}
__device__ __forceinline__ void xcd_barrier(const XcdBarrier& b, const bool leader  ) {
    asm volatile("s_waitcnt vmcnt(0)" ::: "memory");
    __syncthreads();
    if (leader) {
        unsigned* bar = b.bar;
        __builtin_amdgcn_s_waitcnt(0);
        unsigned nloc = b.st[0], nx = b.st[1];
        if (nloc == 0u) { xcd_barrier_complete(bar, b.x, nloc, nx); b.st[0] = nloc; b.st[1] = nx; }
        const unsigned old = xb_add(&bar[XB_XSUB(b.x)], 1u);
        const unsigned gen = old / nloc;
        if (old + 1u == (gen + 1u) * nloc) {
            __builtin_amdgcn_fence(__ATOMIC_RELEASE, "agent");
            asm volatile("s_waitcnt vmcnt(0)" ::: "memory");
            const unsigned og = xb_add(&bar[XB_TOP], 1u);
            const unsigned tg = og / nx;
            if (og + 1u == (tg + 1u) * nx) xb_add(&bar[XB_TOPGEN], 1u);
            else XB_SPIN(xb_ld(&bar[XB_TOPGEN]) == tg, bar);
            __builtin_amdgcn_fence(__ATOMIC_ACQUIRE, "agent");
            xb_add(&bar[XB_XGEN(b.x)], 1u);
            asm volatile("s_waitcnt vmcnt(0)" ::: "memory");
        } else {
            XB_SPIN(xb_ld(&bar[XB_XGEN(b.x)]) == gen, bar);
            __builtin_amdgcn_fence(__ATOMIC_ACQUIRE, "agent");
            asm volatile("s_waitcnt vmcnt(0)" ::: "memory");
        }
    }
    __syncthreads();
}

namespace g8 {
constexpr int BM = 256, BK = 64, HALF = 128, HTB = HALF * BK * 2, STAGE_BYTES = 8 * HTB, NXCD = 8, WGM = 8;
__device__ __forceinline__ int lds_byte(int r, int c) { const int st = (r >> 4) * 2 + (c >> 5), rr = r & 15, cc = c & 31, ob = rr * 64 + cc * 2; return st * 1024 + (ob ^ (((ob >> 9) & 1) << 5)); }
__device__ __forceinline__ void stage_rc(int b, int& R, int& C) { const int st = b / 1024, sb = b % 1024, swz = sb ^ (((sb >> 9) & 1) << 5); R = (st >> 1) * 16 + swz / 64; C = (st & 1) * 32 + (swz % 64) / 2; }
__device__ __forceinline__ int perm32(int rho) { const int n = rho >> 4, i = rho & 15; return 8 * (i >> 2) + 4 * n + (i & 3); }

struct Unit { const char* A; const char* B; int pm, pn, aux; };

struct DenseOrder {
    const char* A; const char* Bt; int nM, nN, nwg, G, c, K, tid0;
    __device__ void init(const void* A_, const void* Bt_, int M, int N, int K_, int G_, int c_) { A = (const char*)A_; Bt = (const char*)Bt_; nM = M / BM; nN = N / BM; nwg = nM * nN; G = G_; c = c_; K = K_; }
    __device__ __forceinline__ bool next(int i, Unit& u) const {
        const long L = (long)i * G + c; if (L >= nwg) return false;
        int wgid = (int)L; { const int q = nwg / NXCD, r = nwg % NXCD, xcd = wgid % NXCD, off = wgid / NXCD; wgid = (xcd < r ? xcd * (q + 1) : r * (q + 1) + (xcd - r) * q) + off; }
        const int nig = WGM * nN, gid = wgid / nig, fm = gid * WGM, gsz = (nM - fm) < WGM ? (nM - fm) : WGM;
        u.pm = fm + ((wgid % nig) % gsz); u.pn = (wgid % nig) / gsz; u.aux = 0;
        u.A = A + (size_t)u.pm * BM * K * 2; u.B = Bt + (size_t)u.pn * BM * K * 2; return true;
    }
    __device__ __forceinline__ void aoff(const Unit&, int tid, unsigned (&o)[2][2]) const {
#pragma unroll
        for (int i = 0; i < 2; ++i) { int R, C; stage_rc(tid * 16 + i * 8192, R, C);
            o[0][i] = (unsigned)(R * K + C) * 2u; o[1][i] = (unsigned)((R + HALF) * K + C) * 2u; }
    }
};

__device__ __forceinline__ unsigned cvt_pk_bf16(float lo, float hi) { unsigned r; asm volatile("v_cvt_pk_bf16_f32 %0, %1, %2" : "=v"(r) : "v"(lo), "v"(hi)); return r; }

struct EpiF32 {
    static constexpr bool PERM = false;
    float* C; int ldc; const float* bias;
    __device__ __forceinline__ void operator()(const f32x4 (&acc)[2][2][4][2], const Unit& u, int wr, int wc, int fr, int fq) const {
        const int row0 = u.pm * BM + wr * 64 + fr, col0 = u.pn * BM + wc * 32 + 4 * fq;
        f32x4 bv[2][2];
#pragma unroll
        for (int bj = 0; bj < 2; ++bj)
#pragma unroll
            for (int n = 0; n < 2; ++n) bv[bj][n] = bias ? *(const f32x4*)(bias + col0 + bj * HALF + n * 16) : (f32x4){0.f, 0.f, 0.f, 0.f};
#pragma unroll
        for (int ai = 0; ai < 2; ++ai)
#pragma unroll
            for (int m = 0; m < 4; ++m) { float* rowp = C + (size_t)(row0 + ai * HALF + m * 16) * ldc + col0;
#pragma unroll
                for (int bj = 0; bj < 2; ++bj)
#pragma unroll
                    for (int n = 0; n < 2; ++n) *(f32x4*)(rowp + bj * HALF + n * 16) = acc[ai][bj][m][n] + bv[bj][n]; }
    }
};

struct EpiBf16 {
    static constexpr bool PERM = true;
    bf16_t* O; int ldc; const float* bias;
    __device__ __forceinline__ void operator()(const f32x4 (&acc)[2][2][4][2], const Unit& u, int wr, int wc, int fr, int fq) const {
        const int row0 = u.pm * BM + wr * 64 + fr, col0 = u.pn * BM + wc * 32 + 8 * fq;
        f32x4 bv[2][2];
#pragma unroll
        for (int bj = 0; bj < 2; ++bj)
#pragma unroll
            for (int n = 0; n < 2; ++n) bv[bj][n] = *(const f32x4*)(bias + col0 + bj * HALF + 4 * n);
#pragma unroll
        for (int ai = 0; ai < 2; ++ai)
#pragma unroll
            for (int m = 0; m < 4; ++m) { bf16_t* rowp = O + (size_t)(row0 + ai * HALF + m * 16) * ldc + col0;
#pragma unroll
                for (int bj = 0; bj < 2; ++bj) { const f32x4 v0 = acc[ai][bj][m][0] + bv[bj][0], v1 = acc[ai][bj][m][1] + bv[bj][1];
                    u32x4 w; w[0] = cvt_pk_bf16(v0[0], v0[1]); w[1] = cvt_pk_bf16(v0[2], v0[3]); w[2] = cvt_pk_bf16(v1[0], v1[1]); w[3] = cvt_pk_bf16(v1[2], v1[3]);
                    *(u32x4*)(rowp + bj * HALF) = w; } }
    }
};

template <class Epi, class Sched>
__device__ __forceinline__ void gemm_phase(LAS unsigned char* lds, const int K, const Sched& S, const Epi& E) {
    int tid_ = S.tid0; asm volatile("" : "+v"(tid_));
    const int tid = tid_, wid = __builtin_amdgcn_readfirstlane(tid >> 6), lane = tid & 63, wr = wid >> 2, wc = wid & 3, fr = lane & 15, fq = lane >> 4;
    const int nt = K / BK;
    unsigned voffB[2];
#pragma unroll
    for (int i = 0; i < 2; ++i) { int R, C; stage_rc(tid * 16 + i * 8192, R, C); const int Rb = Epi::PERM ? ((R & ~31) + perm32(R & 31)) : R;
        voffB[i] = (unsigned)(Rb * K + C) * 2u; }
    const size_t kstep = (size_t)(BK * 2);
    const size_t hstep = (size_t)HALF * K * 2;
    const unsigned ldsw = (unsigned)wid * 1024u;
    const int aoff = lds_byte(wr * 64 + fr, fq * 8), boff = lds_byte(wc * 32 + fr, fq * 8);
#define G8_SA(b, h) (((b) * 2 + (h)) * HTB)
#define G8_SB(b, h) ((4 + (b) * 2 + (h)) * HTB)
#define G8_STAGE(bufoff, gbase, voff) do { _Pragma("unroll") for (int _i = 0; _i < 2; ++_i) \
        __builtin_amdgcn_global_load_lds((const unsigned*)((const char*)(gbase) + (voff)[_i]), (LAS unsigned*)(lds + (bufoff) + ldsw + _i * 8192), 16, 0, 0); } while (0)
#define G8_LDA(dst, b, h) do { _Pragma("unroll") for (int m = 0; m < 4; ++m) _Pragma("unroll") for (int k = 0; k < 2; ++k) dst[m][k] = *(const LAS bf16x8*)(lds + G8_SA(b, h) + aoff + m * 2048 + k * 1024); } while (0)
#define G8_LDB(dst, b, h) do { _Pragma("unroll") for (int n = 0; n < 2; ++n) _Pragma("unroll") for (int k = 0; k < 2; ++k) dst[n][k] = *(const LAS bf16x8*)(lds + G8_SB(b, h) + boff + n * 2048 + k * 1024); } while (0)
#define G8_MMA(ai, bj, At, Bt) do { __builtin_amdgcn_s_setprio(1); _Pragma("unroll") for (int m = 0; m < 4; ++m) _Pragma("unroll") for (int n = 0; n < 2; ++n) _Pragma("unroll") for (int k = 0; k < 2; ++k) \
        acc[ai][bj][m][n] = __builtin_amdgcn_mfma_f32_16x16x32_bf16(Bt[n][k], At[m][k], acc[ai][bj][m][n], 0, 0, 0); __builtin_amdgcn_s_setprio(0); } while (0)
#define G8_WAIT_V(n) asm volatile("s_waitcnt vmcnt(" #n ")" ::: "memory")
#define G8_WAIT_L(n) asm volatile("s_waitcnt lgkmcnt(" #n ")" ::: "memory")
#define G8_BAR __builtin_amdgcn_s_barrier()
#define G8_SCHED __builtin_amdgcn_sched_barrier(0)
    Unit cur, nxt; int ui = 0;
    if (!S.next(0, cur)) return;
    f32x4 acc[2][2][4][2];
#pragma unroll
    for (int a = 0; a < 2; ++a)
#pragma unroll
        for (int b = 0; b < 2; ++b)
#pragma unroll
            for (int m = 0; m < 4; ++m)
#pragma unroll
                for (int n = 0; n < 2; ++n) acc[a][b][m][n] = (f32x4){0.f, 0.f, 0.f, 0.f};
    bf16x8 At[4][2], B0[2][2], B1[2][2];
    unsigned oc[2][2];
    S.aoff(cur, tid, oc);
    const char* cA = cur.A; const char* cB = cur.B;
    G8_STAGE(G8_SB(0, 0), cB, voffB); G8_STAGE(G8_SA(0, 0), cA, oc[0]); G8_STAGE(G8_SB(0, 1), cB + hstep, voffB); G8_STAGE(G8_SA(0, 1), cA, oc[1]);
    if (wr == 1) G8_BAR;
    G8_WAIT_V(4); G8_BAR;
    G8_STAGE(G8_SB(1, 0), cB + kstep, voffB); G8_STAGE(G8_SA(1, 0), cA + kstep, oc[0]); G8_STAGE(G8_SB(1, 1), cB + hstep + kstep, voffB);
    G8_WAIT_V(6); G8_BAR;
    for (;;) {
        const bool has_next = S.next(ui + 1, nxt);
        const char* nA = has_next ? nxt.A : cA; const char* nB = has_next ? nxt.B : cB;
#pragma unroll 1
        for (int t = 0; t < nt; t += 2) {
            const bool last = (t == nt - 2);
            const char* a1 = cA + (size_t)(t + 1) * kstep;
            const char* a2 = last ? nA : cA + (size_t)(t + 2) * kstep; const char* b2 = last ? nB : cB + (size_t)(t + 2) * kstep;
            const char* a3 = a2 + kstep; const char* b3 = b2 + kstep;
            G8_LDB(B0, 0, 0); G8_SCHED; G8_LDA(At, 0, 0); G8_STAGE(G8_SA(1, 1), a1, oc[1]);
            if (last && has_next) S.aoff(nxt, tid, oc);
            G8_WAIT_L(8); G8_BAR; G8_WAIT_L(0); G8_MMA(0, 0, At, B0); G8_BAR; G8_SCHED;
            G8_LDB(B1, 0, 1); G8_STAGE(G8_SB(0, 0), b2, voffB);
            G8_BAR; G8_WAIT_L(0); G8_MMA(0, 1, At, B1); G8_BAR;
            G8_LDA(At, 0, 1); G8_STAGE(G8_SA(0, 0), a2, oc[0]);
            G8_BAR; G8_WAIT_L(0); G8_MMA(1, 0, At, B0); G8_BAR; G8_SCHED;
            G8_STAGE(G8_SB(0, 1), b2 + hstep, voffB);
            G8_WAIT_V(6); G8_BAR; G8_MMA(1, 1, At, B1); G8_BAR;
            G8_LDB(B0, 1, 0); G8_SCHED; G8_LDA(At, 1, 0); G8_STAGE(G8_SA(0, 1), a2, oc[1]);
            G8_WAIT_L(8); G8_BAR; G8_WAIT_L(0); G8_MMA(0, 0, At, B0); G8_BAR; G8_SCHED;
            G8_LDB(B1, 1, 1); G8_STAGE(G8_SB(1, 0), b3, voffB);
            G8_BAR; G8_WAIT_L(0); G8_MMA(0, 1, At, B1); G8_BAR;
            G8_LDA(At, 1, 1); G8_STAGE(G8_SA(1, 0), a3, oc[0]);
            G8_BAR; G8_WAIT_L(0); G8_MMA(1, 0, At, B0); G8_BAR; G8_SCHED;
            G8_STAGE(G8_SB(1, 1), b3 + hstep, voffB);
            G8_WAIT_V(6); G8_BAR; G8_MMA(1, 1, At, B1); G8_BAR;
        }
        E(acc, cur, wr, wc, fr, fq);
        if (!has_next) break;
#pragma unroll
        for (int a = 0; a < 2; ++a)
#pragma unroll
            for (int b = 0; b < 2; ++b)
#pragma unroll
                for (int m = 0; m < 4; ++m)
#pragma unroll
                    for (int n = 0; n < 2; ++n) acc[a][b][m][n] = (f32x4){0.f, 0.f, 0.f, 0.f};
        cur = nxt; cA = nA; cB = nB; ++ui;
    }
    G8_WAIT_V(0);
    if (wr == 0) G8_BAR;
    G8_BAR;
#undef G8_SA
#undef G8_SB
#undef G8_STAGE
#undef G8_LDA
#undef G8_LDB
#undef G8_MMA
#undef G8_WAIT_V
#undef G8_WAIT_L
#undef G8_BAR
#undef G8_SCHED
}
}

constexpr int NTHREADS = 512;
constexpr int LDS_STAGE = 0;
constexpr int LDS_TAB   = g8::STAGE_BYTES;
constexpr int TAB_SLOTS = 6;
constexpr int LDS_GTAB  = LDS_TAB + TAB_SLOTS * 256 * 4;
constexpr int LDS_DESC  = LDS_GTAB + TAB_SLOTS * 256 * 4;
constexpr int LDS_PREF  = LDS_DESC + 64;
constexpr int LDS_MISC  = LDS_PREF + 132 * 4 + 48;
constexpr int LDS_BYTES = 147456;
static_assert(LDS_MISC % 16 == 0 && LDS_MISC + 64 <= LDS_BYTES, "LDS map");

struct Params { const float* in[31]; float* out; unsigned char* ws; int ph_lo, ph_hi; };

struct Ctx {
    const float* const* in; float* out; unsigned char* ws; LAS unsigned char* lds;
    int tid, lane, wid, bid, G, gtid, gthreads, gw, nwaves;
};

__device__ __forceinline__ int ab_phys(int n) {
    if (n < 1024) { const int hd = n >> 6, jj = n & 63; return (hd >> 2) * 256 + (jj >> 5) * 128 + (hd & 3) * 32 + (jj & 31); }
    if (n < 1152) { const int nn = n - 1024, hh = nn >> 6, jj = nn & 63; return 1024 + (jj >> 5) * 128 + hh * 32 + (jj & 31); }
    if (n < 1280) { const int vv = n - 1152; return 1024 + (vv >> 6) * 128 + 64 + (vv & 63); }
    if (n < 2304) { const int base = n < 1792 ? 1280 : 1792, nn = n - base, h = nn >> 7, jj = nn & 127; return base + (h >> 1) * 256 + (jj >> 6) * 128 + (h & 1) * 64 + (jj & 63); }
    return n;
}
template <int TN, class DstFn>
__device__ __forceinline__ void convert_T(const Ctx& c, const float* src, int nmat, int K, int N, DstFn dstfn) {
    LAS float* tile = (LAS float*)(c.lds);
    constexpr int LDT = TN + 1, TPR = TN / 4  , KPI = NTHREADS / TPR  , NI = 64 / KPI, KPT = 64 * TN / NTHREADS  ;
    const int tk = K / 64, tn = N / TN; const long ntiles = (long)nmat * tk * tn;
    for (long tix = c.bid; tix < ntiles; tix += c.G) {
        const int m = (int)(tix / (tk * tn)); const int rem = (int)(tix % (tk * tn)); const int kt = rem / tn, nt = rem % tn;
        const float* s = src + (size_t)m * K * N + (size_t)(kt * 64) * N + nt * TN;
        f32x4 v[NI];
#pragma unroll
        for (int i = 0; i < NI; ++i) { const int k = c.tid / TPR + KPI * i, n4 = (c.tid % TPR) * 4; v[i] = __builtin_nontemporal_load((const f32x4*)(s + (size_t)k * N + n4)); }
#pragma unroll
        for (int i = 0; i < NI; ++i) { const int k = c.tid / TPR + KPI * i, n4 = (c.tid % TPR) * 4;
            tile[k * LDT + n4 + 0] = v[i][0]; tile[k * LDT + n4 + 1] = v[i][1]; tile[k * LDT + n4 + 2] = v[i][2]; tile[k * LDT + n4 + 3] = v[i][3]; }
        __syncthreads();
        { constexpr int TPN = 64 / KPT; const int n = c.tid / TPN, k0 = (c.tid % TPN) * KPT;
          bf16_t* d = dstfn(m, nt * TN + n) + kt * 64 + k0;
#pragma unroll
          for (int q = 0; q < KPT / 8; ++q) { u32x4 w;
#pragma unroll
              for (int e = 0; e < 4; ++e) w[e] = pk2(tile[(k0 + q * 8 + 2 * e) * LDT + n], tile[(k0 + q * 8 + 2 * e + 1) * LDT + n]);
              *(u32x4*)(d + q * 8) = w; } }
        __syncthreads();
    }
}

__device__ __forceinline__ void phase_convert(const Ctx& c) {
    unsigned char* ws = c.ws;
    { const float* x = c.in[0]; bf16_t* xb = (bf16_t*)(ws + WS_XB);
      for (long i = c.gtid; i < (long)T * D / 4; i += c.gthreads) { const f32x4 v = *(const f32x4*)(x + i * 4); u32x2 w; w[0] = pk2(v[0], v[1]); w[1] = pk2(v[2], v[3]); *(u32x2*)(xb + i * 4) = w; } }
    { bf16_t* wrt = (bf16_t*)(ws + WS_WRT); for (long i = c.gtid; i < (long)4 * 128 * D / 8; i += c.gthreads) { const long l = i / (128 * D / 8), r = i % (128 * D / 8); *(u32x4*)(wrt + (size_t)l * 256 * D + (size_t)128 * D + r * 8) = (u32x4){0u, 0u, 0u, 0u}; }
      float* gate = (float*)(ws + WS_GATE); for (int i = c.gtid; i < T; i += c.gthreads) gate[TK + i] = 1.f;
      f32x2* ra = (f32x2*)(ws + WS_ROPEA); f32x2* rr = (f32x2*)(ws + WS_ROPER);
      for (int i = c.gtid; i < SEQ * 96; i += c.gthreads) { const int sidx = i / 96, q = i % 96; const bool isA = q < 32; const int jx = isA ? q : q - 32;
          const float e = isA ? (float)jx * (1.f / 32.f) : (float)jx * (1.f / 63.f); const float ang = (float)sidx * exp2f(-e * 13.287712379549449f); float sn, cs; sincosf(ang, &sn, &cs);
          if (isA) ra[sidx * 32 + jx] = (f32x2){cs, sn}; else rr[sidx * 64 + jx] = (f32x2){cs, sn}; }
      float* bp = (float*)(ws + WS_BIASP); for (int i = c.gtid; i < 2 * AB_IN; i += c.gthreads) { const int m = i / AB_IN, n = i % AB_IN; bp[m * AB_IN + ab_phys(n)] = c.in[2][i]; } }
    { bf16_t* d = (bf16_t*)(ws + WS_WABIN);  convert_T<256>(c, c.in[1], 2, D, AB_IN, [=](int m, int n) { return d + (size_t)m * AB_IN * D + (size_t)ab_phys(n) * D; }); }
    { bf16_t* d = (bf16_t*)(ws + WS_WABOUT); convert_T<256>(c, c.in[4], 2, AB_OUT, D, [=](int m, int n) { return d + (size_t)m * D * AB_OUT + (size_t)n * AB_OUT; }); }
    { bf16_t* d = (bf16_t*)(ws + WS_WCDIN);  convert_T<256>(c, c.in[6], 2, D, CD_IN, [=](int m, int n) { return d + (size_t)m * CD_IN * D + (size_t)n * D; }); }
    { bf16_t* d = (bf16_t*)(ws + WS_WCDOUT); convert_T<256>(c, c.in[17], 2, CD_OUT, D, [=](int m, int n) { return d + (size_t)m * D * CD_OUT + (size_t)n * CD_OUT; }); }
    { bf16_t* d = (bf16_t*)(ws + WS_WRT);    convert_T<128>(c, c.in[21], 4, D, NE, [=](int m, int n) { return d + (size_t)m * 256 * D + (size_t)n * D; }); }
    { bf16_t* d = (bf16_t*)(ws + WS_WGU);
      convert_T<256>(c, c.in[23], 4 * NE, D, ED, [=](int m, int n) { return d + (size_t)((m >> 7) * NE1 + (m & 127)) * 512 * D + (size_t)((n >> 7) * 256 + (n & 127)) * D; });
      convert_T<256>(c, c.in[24], 4 * NE, D, ED, [=](int m, int n) { return d + (size_t)((m >> 7) * NE1 + (m & 127)) * 512 * D + (size_t)((n >> 7) * 256 + 128 + (n & 127)) * D; });
      convert_T<256>(c, c.in[26], 4, D, ED, [=](int m, int n) { return d + (size_t)(m * NE1 + NE) * 512 * D + (size_t)((n >> 7) * 256 + (n & 127)) * D; });
      convert_T<256>(c, c.in[27], 4, D, ED, [=](int m, int n) { return d + (size_t)(m * NE1 + NE) * 512 * D + (size_t)((n >> 7) * 256 + 128 + (n & 127)) * D; }); }
    { bf16_t* d = (bf16_t*)(ws + WS_WLRU);
      convert_T<256>(c, c.in[12], 10, 256, 256, [=](int m, int n) { return d + (size_t)(m * 2 + 0) * 65536 + (size_t)n * 256; });
      convert_T<256>(c, c.in[14], 10, 256, 256, [=](int m, int n) { return d + (size_t)(m * 2 + 1) * 65536 + (size_t)n * 256; });
      float* spl = (float*)(ws + WS_SPL); for (int i = c.gtid; i < 2 * 1280; i += c.gthreads) spl[i] = log1pf(expf(-c.in[16][i])); }
    { bf16_t* d = (bf16_t*)(ws + WS_WDN);
      convert_T<256>(c, c.in[25], 4 * NE, ED, D, [=](int m, int n) { return d + (size_t)((m >> 7) * NE1 + (m & 127)) * D * ED + (size_t)n * ED; });
      convert_T<256>(c, c.in[28], 4, ED, D, [=](int m, int n) { return d + (size_t)(m * NE1 + NE) * D * ED + (size_t)n * ED; }); }
}

__device__ __forceinline__ void phase_dense(const Ctx& c, const bf16_t* A, const bf16_t* Bt, int M, int N, int K, bf16_t* C, int ldc, const float* bias) {
    g8::DenseOrder S; S.init(A, Bt, M, N, K, c.G, c.bid); S.tid0 = c.tid;
    g8::EpiBf16 E{C, ldc, bias};
    g8::gemm_phase<g8::EpiBf16, g8::DenseOrder>(c.lds + LDS_STAGE, K, S, E);
}

struct EpiABIn {
    static constexpr bool PERM = true;
    LAS bf16_t* biasL; unsigned char* ws;
    __device__ __forceinline__ void operator()(const f32x4 (&acc)[2][2][4][2], const g8::Unit& u, int wr, int wc, int fr_, int fq_) const {
        int fr = fr_, fq = fq_; asm volatile("" : "+v"(fr), "+v"(fq));
        const int pn = u.pn; const int colp = pn * 256 + wc * 32 + fq * 8;
        bf16_t* qb = (bf16_t*)(ws + AB_QB); bf16_t* kb = (bf16_t*)(ws + AB_KB); bf16_t* vT = (bf16_t*)(ws + AB_VT); bf16_t* rqb = (bf16_t*)(ws + AB_RQB); bf16_t* rkb = (bf16_t*)(ws + AB_RKB);
        bf16_t* rkdT = (bf16_t*)(ws + AB_RKDT); bf16_t* rvT = (bf16_t*)(ws + AB_RVT); bf16_t* rgb = (bf16_t*)(ws + AB_RGB);
        const float frqA0 = exp2f(-(float)(fq * 8) * (13.287712379549449f / 32.f)) * 0.15915494309189535f;
        const float frqR0 = exp2f(-(float)((wc & 1) * 32 + fq * 8) * (13.287712379549449f / 63.f)) * 0.15915494309189535f;
        constexpr float RA[8] = {1.f, 0.7498942093324559f, 0.5623413251903491f, 0.4216965034285822f, 0.31622776601683794f, 0.23713737056616552f, 0.1778279410038923f, 0.1333521432163324f};
        constexpr float RR[8] = {1.f, 0.8639884494839686f, 0.746476040841712f, 0.6449466771037624f, 0.5572264795507174f, 0.4814372420784346f, 0.4159562163071847f, 0.35938136638046275f};
#pragma unroll
        for (int ai = 0; ai < 2; ++ai)
#pragma unroll
            for (int m = 0; m < 4; ++m) {
                const int t = u.pm * 256 + ai * 128 + wr * 64 + m * 16 + fr, sq = t & (SEQ - 1), b = t >> 13;
                f32x4 x[2][2];
#pragma unroll
                for (int bj = 0; bj < 2; ++bj)
#pragma unroll
                    for (int n = 0; n < 2; ++n) { const u32x2 bw = *(const LAS u32x2*)(biasL + colp + bj * 128 + 4 * n);
                        x[bj][n] = acc[ai][bj][m][n] + (f32x4){__uint_as_float(bw[0] << 16), __uint_as_float(bw[0] & 0xffff0000u), __uint_as_float(bw[1] << 16), __uint_as_float(bw[1] & 0xffff0000u)}; }
                if (pn < 4 || (pn == 4 && wc < 2)) {
                    const int j0 = fq * 8; const float sc = pn < 4 ? 0.125f : 1.f;
                    u32x4 w1, w2;
#pragma unroll
                    for (int n = 0; n < 2; ++n) { f32x4 o1, o2;
#pragma unroll
                        for (int e = 0; e < 4; ++e) { const float rev = __builtin_amdgcn_fractf((float)sq * (frqA0 * RA[4 * n + e])); const float cc = __builtin_amdgcn_cosf(rev) * sc, ss = __builtin_amdgcn_sinf(rev) * sc;
                            o1[e] = x[0][n][e] * cc - x[1][n][e] * ss; o2[e] = x[1][n][e] * cc + x[0][n][e] * ss; }
                        w1[2 * n] = pk2(o1[0], o1[1]); w1[2 * n + 1] = pk2(o1[2], o1[3]); w2[2 * n] = pk2(o2[0], o2[1]); w2[2 * n + 1] = pk2(o2[2], o2[3]); }
                    bf16_t* dst = pn < 4 ? qb + (size_t)t * 1024 + (pn * 4 + wc) * 64 + j0 : kb + (size_t)t * 128 + wc * 64 + j0;
                    *(u32x4*)dst = w1; *(u32x4*)(dst + 32) = w2;
                } else if (pn == 4) {
                    const int d0 = (wc - 2) * 32 + fq * 8;
#pragma unroll
                    for (int bj = 0; bj < 2; ++bj)
#pragma unroll
                        for (int n = 0; n < 2; ++n)
#pragma unroll
                            for (int e = 0; e < 4; ++e) vT[((size_t)(b * 2 + bj) * 64 + d0 + 4 * n + e) * SEQ + sq] = f2bf(x[bj][n][e]);
                } else if (pn < 9) {
                    const bool isk = pn >= 7; const int h = ((pn - 5) & 1) * 2 + (wc >> 1), j0 = (wc & 1) * 32 + fq * 8;
                    const float sc = isk ? 0.08838834764831845f : 1.f;
                    bf16_t* dT = rkdT + ((size_t)(b * 4 + h) * 128 + j0) * SEQ + sq;
                    u32x4 w1, w2;
#pragma unroll
                    for (int n = 0; n < 2; ++n) { f32x4 o1, o2;
#pragma unroll
                        for (int e = 0; e < 4; ++e) { const float rev = __builtin_amdgcn_fractf((float)sq * (frqR0 * RR[4 * n + e])); const float cc = __builtin_amdgcn_cosf(rev) * sc, ss = __builtin_amdgcn_sinf(rev) * sc;
                            o1[e] = x[0][n][e] * cc - x[1][n][e] * ss; o2[e] = x[1][n][e] * cc + x[0][n][e] * ss; }
                        w1[2 * n] = pk2(o1[0], o1[1]); w1[2 * n + 1] = pk2(o1[2], o1[3]); w2[2 * n] = pk2(o2[0], o2[1]); w2[2 * n + 1] = pk2(o2[2], o2[3]);
                        if (isk) {
#pragma unroll
                            for (int e = 0; e < 4; ++e) { dT[(size_t)(4 * n + e) * SEQ] = f2bf(o1[e]); dT[(size_t)(64 + 4 * n + e) * SEQ] = f2bf(o2[e]); } } }
                    bf16_t* dst = (isk ? rkb : rqb) + (size_t)t * 512 + h * 128 + j0;
                    *(u32x4*)dst = w1; *(u32x4*)(dst + 64) = w2;
                } else if (pn < 13) {
                    const int h = pn - 9;
#pragma unroll
                    for (int bj = 0; bj < 2; ++bj)
#pragma unroll
                        for (int n = 0; n < 2; ++n)
#pragma unroll
                            for (int e = 0; e < 4; ++e) rvT[((size_t)(b * 4 + h) * 256 + bj * 128 + wc * 32 + fq * 8 + 4 * n + e) * SEQ + sq] = f2bf(x[bj][n][e]);
                } else {
#pragma unroll
                    for (int bj = 0; bj < 2; ++bj) { u32x4 w;
#pragma unroll
                        for (int n = 0; n < 2; ++n) { w[2 * n] = pk2(siluf_(x[bj][n][0]), siluf_(x[bj][n][1])); w[2 * n + 1] = pk2(siluf_(x[bj][n][2]), siluf_(x[bj][n][3])); }
                        *(u32x4*)(rgb + (size_t)t * 1024 + (pn - 13) * 256 + bj * 128 + wc * 32 + fq * 8) = w; }
                }
            }
    }
};
__device__ __forceinline__ void phase_ab_inproj(const Ctx& c, int j) {
    g8::DenseOrder S; S.init(c.ws + WS_XB, c.ws + WS_WABIN + (size_t)j * AB_IN * D * 2, T, AB_IN, D, c.G, c.bid); S.tid0 = c.tid;
    LAS bf16_t* biasL = (LAS bf16_t*)(c.lds + LDS_TAB);
    { const float* bp = (const float*)(c.ws + WS_BIASP) + (size_t)j * AB_IN; for (int i = c.tid; i < AB_IN; i += NTHREADS) biasL[i] = f2bf(bp[i]); }
    __syncthreads();
    EpiABIn E{biasL, c.ws};
    g8::gemm_phase<EpiABIn, g8::DenseOrder>(c.lds + LDS_STAGE, D, S, E);
}

#define MFMA16(a, b, c) __builtin_amdgcn_mfma_f32_16x16x32_bf16((a), (b), (c), 0, 0, 0)
__device__ __forceinline__ bf16x8 pack8(const f32x4& lo, const f32x4& hi) { u32x4 w; w[0] = g8::cvt_pk_bf16(lo[0], lo[1]); w[1] = g8::cvt_pk_bf16(lo[2], lo[3]); w[2] = g8::cvt_pk_bf16(hi[0], hi[1]); w[3] = g8::cvt_pk_bf16(hi[2], hi[3]); return __builtin_bit_cast(bf16x8, w); }
__device__ __forceinline__ bf16x8 cat8(const u32x2& lo, const u32x2& hi) { u32x4 w; w[0] = lo[0]; w[1] = lo[1]; w[2] = hi[0]; w[3] = hi[1]; return __builtin_bit_cast(bf16x8, w); }
template <int ROWS, int RB>
__device__ __forceinline__ void tile_g2l(LAS unsigned char* dst, const unsigned char* src, size_t gs, int tid, int zrows = 0) {
    constexpr int CPR = RB / 16, TOTAL = ROWS * CPR;
#pragma unroll 4
    for (int i = tid; i < TOTAL; i += NTHREADS) { const int r = i / CPR, cc = i % CPR; u32x4 v = (u32x4){0u, 0u, 0u, 0u}; if (r >= zrows) v = *(const u32x4*)(src + (size_t)r * gs + cc * 16);
        *(LAS u32x4*)(dst + r * (RB + 16) + cc * 16) = v; }
}

__device__ __forceinline__ void attn_unit(const Ctx& c, int unit, const float* sinks) {
    const int b = unit >> 7, n = (unit >> 1) & 63, kvh = unit & 1, hd = kvh * 8 + c.wid, lane = c.lane, fr = lane & 15, fq = lane >> 4;
    const bf16_t* qb = (const bf16_t*)(c.ws + AB_QB); const bf16_t* kb = (const bf16_t*)(c.ws + AB_KB); const bf16_t* vT = (const bf16_t*)(c.ws + AB_VT); bf16_t* ycat = (bf16_t*)(c.ws + WS_YCAT);
    LAS unsigned char* Ks = c.lds; LAS unsigned char* Vs = c.lds + 256 * 144;
    const int t0 = b * SEQ + n * 128;
    __syncthreads();
    {
        const unsigned char* src = (const unsigned char*)(kb + (size_t)(t0 - 128) * 128 + kvh * 64);
        constexpr int TOTAL = 256 * 8;
#pragma unroll 4
        for (int i = c.tid; i < TOTAL; i += NTHREADS) { const int r = i >> 3, cc = i & 7; u32x4 v = (u32x4){0u, 0u, 0u, 0u}; if (n > 0 || r >= 128) v = *(const u32x4*)(src + (ptrdiff_t)r * 256 + cc * 16);
            *(LAS u32x4*)(Ks + r * 144 + cc * 16) = v; }
        const unsigned char* vsrc = (const unsigned char*)(vT + (size_t)(b * 2 + kvh) * 64 * SEQ + (n * 128 - 128));
        constexpr int TV = 64 * 32;
#pragma unroll 4
        for (int i = c.tid; i < TV; i += NTHREADS) { const int r = i >> 5, cc = i & 31; u32x4 v = (u32x4){0u, 0u, 0u, 0u}; if (n > 0 || cc >= 16) v = *(const u32x4*)(vsrc + (ptrdiff_t)r * SEQ * 2 + cc * 16);
            *(LAS u32x4*)(Vs + r * 528 + cc * 16) = v; }
    }
    __syncthreads();
    const float sink = sinks[hd];
    for (int si = 0; si < 8; ++si) {
        const int t = t0 + si * 16 + fr;
        bf16x8 qf[2];
#pragma unroll
        for (int ks = 0; ks < 2; ++ks) qf[ks] = *(const bf16x8*)(qb + (size_t)t * 1024 + hd * 64 + ks * 32 + fq * 8);
        f32x4 S[10];
#pragma unroll
        for (int nk = 0; nk < 9; ++nk) { S[nk] = (f32x4){0.f, 0.f, 0.f, 0.f};
#pragma unroll
            for (int ks = 0; ks < 2; ++ks) { const bf16x8 a = *(const LAS bf16x8*)(Ks + (16 * (si + nk) + fr) * 144 + ks * 64 + fq * 16); S[nk] = MFMA16(a, qf[ks], S[nk]); } }
        S[9] = (f32x4){0.f, 0.f, 0.f, 0.f};
        const int i = si * 16 + fr;
        float mx = sink;
#pragma unroll
        for (int nk = 0; nk < 9; ++nk)
#pragma unroll
            for (int r = 0; r < 4; ++r) { const int p = 16 * (si + nk) + 4 * fq + r; const bool ok = (p >= i + 1) && (p <= i + 128) && (n > 0 || p >= 128);
                S[nk][r] = ok ? S[nk][r] : -1e30f; mx = fmaxf(mx, S[nk][r]); }
        mx = fmaxf(mx, __shfl_xor(mx, 16)); mx = fmaxf(mx, __shfl_xor(mx, 32));
        float sum = 0.f;
#pragma unroll
        for (int nk = 0; nk < 9; ++nk)
#pragma unroll
            for (int r = 0; r < 4; ++r) { const float pv = S[nk][r] > -1e29f ? exp2f((S[nk][r] - mx) * 1.4426950408889634f) : 0.f; S[nk][r] = pv; sum += pv; }
        sum += __shfl_xor(sum, 16); sum += __shfl_xor(sum, 32);
        const float inv = 1.f / (sum + exp2f((sink - mx) * 1.4426950408889634f));
        f32x4 O[4];
#pragma unroll
        for (int nd = 0; nd < 4; ++nd) O[nd] = (f32x4){0.f, 0.f, 0.f, 0.f};
#pragma unroll
        for (int kk = 0; kk < 5; ++kk) { const bf16x8 pf = pack8(S[2 * kk], S[2 * kk + 1]);
            const int p0 = 16 * (si + 2 * kk) + 4 * fq, p1 = (kk == 4 && si == 7) ? p0 : p0 + 16;
#pragma unroll
            for (int nd = 0; nd < 4; ++nd) { const u32x2 lo = *(const LAS u32x2*)(Vs + (16 * nd + fr) * 528 + p0 * 2), hi = *(const LAS u32x2*)(Vs + (16 * nd + fr) * 528 + p1 * 2);
                O[nd] = MFMA16(cat8(lo, hi), pf, O[nd]); } }
#pragma unroll
        for (int nd = 0; nd < 4; ++nd) { u32x2 w; w[0] = pk2(O[nd][0] * inv, O[nd][1] * inv); w[1] = pk2(O[nd][2] * inv, O[nd][3] * inv);
            *(u32x2*)(ycat + (size_t)t * AB_OUT + hd * 64 + 16 * nd + 4 * fq) = w; }
    }
}

__device__ __forceinline__ void ret_kv_unit(const Ctx& c, int unit) {
    const int b = unit >> 8, n = (unit >> 2) & 63, h = unit & 3, lane = c.lane, fr = lane & 15, fq = lane >> 4, w = c.wid;
    const bf16_t* rkdT = (const bf16_t*)(c.ws + AB_RKDT); const bf16_t* rvT = (const bf16_t*)(c.ws + AB_RVT); float* kv = (float*)(c.ws + AB_KV);
    LAS unsigned char* Kd = c.lds;
    __syncthreads();
    {
        const float lg = log2f(1.f - exp2f(-5.f - (float)h)); const int cc = c.tid & 15;
        float dec[8];
#pragma unroll
        for (int e = 0; e < 8; ++e) dec[e] = exp2f((float)(127 - (cc * 8 + e)) * lg);
        const unsigned char* src = (const unsigned char*)(rkdT + (size_t)(b * 4 + h) * 128 * SEQ + n * 128);
#pragma unroll
        for (int q = 0; q < 4; ++q) { const int r = (c.tid >> 4) + 32 * q; const u32x4 v = *(const u32x4*)(src + (size_t)r * SEQ * 2 + cc * 16); u32x4 o;
#pragma unroll
            for (int e2 = 0; e2 < 4; ++e2) o[e2] = pk2(__uint_as_float(v[e2] << 16) * dec[2 * e2], __uint_as_float(v[e2] & 0xffff0000u) * dec[2 * e2 + 1]);
            *(LAS u32x4*)(Kd + r * 272 + cc * 16) = o; }
    }
    bf16x8 vf[2][4];
#pragma unroll
    for (int ne = 0; ne < 2; ++ne)
#pragma unroll
        for (int ks = 0; ks < 4; ++ks) vf[ne][ks] = *(const bf16x8*)(rvT + ((size_t)(b * 4 + h) * 256 + 32 * w + 16 * ne + fr) * SEQ + n * 128 + ks * 32 + fq * 8);
    __syncthreads();
    float* out = kv + ((size_t)((b * 64 + n) * 4 + h)) * 256 * 128;
#pragma unroll
    for (int nd = 0; nd < 8; ++nd) { f32x4 a0 = (f32x4){0.f, 0.f, 0.f, 0.f}, a1 = a0;
#pragma unroll
        for (int ks = 0; ks < 4; ++ks) { const bf16x8 kf = *(const LAS bf16x8*)(Kd + (16 * nd + fr) * 272 + ks * 64 + fq * 16); a0 = MFMA16(kf, vf[0][ks], a0); a1 = MFMA16(kf, vf[1][ks], a1); }
        *(f32x4*)(out + (size_t)(32 * w + fr) * 128 + 16 * nd + 4 * fq) = a0; *(f32x4*)(out + (size_t)(32 * w + 16 + fr) * 128 + 16 * nd + 4 * fq) = a1; }
}
__device__ __forceinline__ void ret_scan(const Ctx& c, int first_block, int nblocks) {
    const float* kv = (const float*)(c.ws + AB_KV); bf16_t* sp = (bf16_t*)(c.ws + AB_SPREV);
    const int nthr = nblocks * NTHREADS;
    for (int idx = (c.bid - first_block) * NTHREADS + c.tid; idx < 2 * 4 * 256 * 128 / 4; idx += nthr) {
        const int b = idx >> 15, rem = idx & 32767, h = rem >> 13;
        const float g = exp2f(128.f * log2f(1.f - exp2f(-5.f - (float)h)));
        const size_t base = (size_t)b * 64 * 131072 + (size_t)rem * 4;
        f32x4 st = (f32x4){0.f, 0.f, 0.f, 0.f};
        for (int n0 = 0; n0 < 64; n0 += 16) { f32x4 v[16];
#pragma unroll
            for (int q = 0; q < 16; ++q) v[q] = *(const f32x4*)(kv + base + (size_t)(n0 + q) * 131072);
#pragma unroll
            for (int q = 0; q < 16; ++q) { u32x2 wv; wv[0] = pk2(st[0], st[1]); wv[1] = pk2(st[2], st[3]); *(u32x2*)(sp + base + (size_t)(n0 + q) * 131072) = wv; st = st * g + v[q]; } }
    }
}
__device__ __forceinline__ void ret_out_unit(const Ctx& c, int unit) {
    const int b = unit >> 8, n = (unit >> 2) & 63, h = unit & 3, lane = c.lane, fr = lane & 15, fq = lane >> 4, w = c.wid;
    const bf16_t* rqb = (const bf16_t*)(c.ws + AB_RQB); const bf16_t* rkb = (const bf16_t*)(c.ws + AB_RKB); const bf16_t* rvT = (const bf16_t*)(c.ws + AB_RVT);
    const bf16_t* sp = (const bf16_t*)(c.ws + AB_SPREV); const bf16_t* rgb = (const bf16_t*)(c.ws + AB_RGB); bf16_t* ycat = (bf16_t*)(c.ws + WS_YCAT);
    LAS unsigned char* Kl = c.lds; LAS unsigned char* Bl = c.lds + 128 * 272;
    const int t0 = b * SEQ + n * 128; const float lg = log2f(1.f - exp2f(-5.f - (float)h));
    __syncthreads();
    tile_g2l<128, 256>(Kl, (const unsigned char*)(rkb + (size_t)t0 * 512 + h * 128), (size_t)512 * 2, c.tid);
    tile_g2l<256, 256>(Bl, (const unsigned char*)(sp + ((size_t)((b * 64 + n) * 4 + h)) * 256 * 128), (size_t)128 * 2, c.tid);
    const int t = t0 + 16 * w + fr, i = 16 * w + fr;
    bf16x8 qf[4];
#pragma unroll
    for (int ks = 0; ks < 4; ++ks) qf[ks] = *(const bf16x8*)(rqb + (size_t)t * 512 + h * 128 + ks * 32 + fq * 8);
    __syncthreads();
    bf16x8 pf[4];
#pragma unroll
    for (int kk = 0; kk < 4; ++kk) { f32x4 s2[2];
#pragma unroll
        for (int q = 0; q < 2; ++q) { const int nj = 2 * kk + q; s2[q] = (f32x4){0.f, 0.f, 0.f, 0.f};
            if (nj <= w) {
#pragma unroll
                for (int ks = 0; ks < 4; ++ks) { const bf16x8 kf = *(const LAS bf16x8*)(Kl + (16 * nj + fr) * 272 + ks * 64 + fq * 16); s2[q] = MFMA16(kf, qf[ks], s2[q]); }
#pragma unroll
                for (int r = 0; r < 4; ++r) { const int jj = 16 * nj + 4 * fq + r; s2[q][r] = (i >= jj) ? s2[q][r] * exp2f((float)(i - jj) * lg) : 0.f; } } }
        pf[kk] = pack8(s2[0], s2[1]); }
    f32x4 acc[16];
#pragma unroll
    for (int ne = 0; ne < 16; ++ne) { acc[ne] = (f32x4){0.f, 0.f, 0.f, 0.f};
#pragma unroll
        for (int ks = 0; ks < 4; ++ks) { const bf16x8 sf = *(const LAS bf16x8*)(Bl + (16 * ne + fr) * 272 + ks * 64 + fq * 16); acc[ne] = MFMA16(sf, qf[ks], acc[ne]); } }
    const float rs = exp2f((float)(i + 1) * lg);
#pragma unroll
    for (int ne = 0; ne < 16; ++ne) acc[ne] = acc[ne] * rs;
    __syncthreads();
    tile_g2l<256, 256>(Bl, (const unsigned char*)(rvT + (size_t)(b * 4 + h) * 256 * SEQ + n * 128), (size_t)SEQ * 2, c.tid);
    __syncthreads();
    const int nkk = (w >> 1) + 1;
#pragma unroll
    for (int kk = 0; kk < 4; ++kk) if (kk < nkk) {
#pragma unroll
        for (int ne = 0; ne < 16; ++ne) { const u32x2 lo = *(const LAS u32x2*)(Bl + (16 * ne + fr) * 272 + (32 * kk + 4 * fq) * 2), hi = *(const LAS u32x2*)(Bl + (16 * ne + fr) * 272 + (32 * kk + 16 + 4 * fq) * 2);
            acc[ne] = MFMA16(cat8(lo, hi), pf[kk], acc[ne]); } }
    float sm = 0.f;
#pragma unroll
    for (int ne = 0; ne < 16; ++ne) sm += acc[ne][0] + acc[ne][1] + acc[ne][2] + acc[ne][3];
    sm += __shfl_xor(sm, 16); sm += __shfl_xor(sm, 32);
    const float mean = sm * (1.f / 256.f); float sq = 0.f;
#pragma unroll
    for (int ne = 0; ne < 16; ++ne) { acc[ne] = acc[ne] - mean; sq += acc[ne][0] * acc[ne][0] + acc[ne][1] * acc[ne][1] + acc[ne][2] * acc[ne][2] + acc[ne][3] * acc[ne][3]; }
    sq += __shfl_xor(sq, 16); sq += __shfl_xor(sq, 32);
    const float rstd = rsqrtf(sq * (1.f / 256.f) + LN_EPS);
#pragma unroll
    for (int ne = 0; ne < 16; ++ne) { const u32x2 gw = *(const u32x2*)(rgb + (size_t)t * 1024 + h * 256 + 16 * ne + 4 * fq);
        const float g0 = __uint_as_float(gw[0] << 16), g1 = __uint_as_float(gw[0] & 0xffff0000u), g2 = __uint_as_float(gw[1] << 16), g3 = __uint_as_float(gw[1] & 0xffff0000u);
        u32x2 o; o[0] = pk2(acc[ne][0] * rstd * g0, acc[ne][1] * rstd * g1); o[1] = pk2(acc[ne][2] * rstd * g2, acc[ne][3] * rstd * g3);
        *(u32x2*)(ycat + (size_t)t * AB_OUT + 1024 + h * 256 + 16 * ne + 4 * fq) = o; }
}

__device__ __forceinline__ void phase_ab_p1(const Ctx& c) {
    for (int u = c.bid; u < 512; u += c.G) ret_kv_unit(c, u);
}
__device__ __forceinline__ void phase_ab_p2(const Ctx& c, int j) {
    ret_scan(c, 0, c.G);
    { const float* sinks = c.in[3] + j * 16; for (int u = c.bid; u < 256; u += c.G) attn_unit(c, u, sinks); }
}
__device__ __forceinline__ void phase_ab_p3(const Ctx& c) {
    for (int u = c.bid; u < 512; u += c.G) ret_out_unit(c, u);
}

__device__ __forceinline__ float gelu_fast(float x) { const float u = 1.5957691216057308f * (x + 0.044715f * x * x * x); return x / (1.f + __expf(-u)); }
struct EpiCDIn {
    static constexpr bool PERM = true;
    LAS bf16_t* biasL; unsigned char* ws;
    __device__ __forceinline__ void operator()(const f32x4 (&acc)[2][2][4][2], const g8::Unit& u, int wr, int wc, int fr, int fq) const {
        const int pn = u.pn; const int col0 = pn * 256 + wc * 32 + fq * 8;
        f32x4 bv[2][2];
#pragma unroll
        for (int bj = 0; bj < 2; ++bj)
#pragma unroll
            for (int n = 0; n < 2; ++n) { const u32x2 bw = *(const LAS u32x2*)(biasL + col0 + bj * 128 + 4 * n); bv[bj][n] = (f32x4){__uint_as_float(bw[0] << 16), __uint_as_float(bw[0] & 0xffff0000u), __uint_as_float(bw[1] << 16), __uint_as_float(bw[1] & 0xffff0000u)}; }
        bf16_t* gu = (bf16_t*)(ws + CD_GU); bf16_t* gvT = (bf16_t*)(ws + CD_GVT); bf16_t* gg = (bf16_t*)(ws + CD_GG); bf16_t* xr = (bf16_t*)(ws + CD_XR); float* stats = (float*)(ws + CD_STATS);
#pragma unroll
        for (int ai = 0; ai < 2; ++ai)
#pragma unroll
            for (int m = 0; m < 4; ++m) {
                const int t = u.pm * 256 + ai * 128 + wr * 64 + m * 16 + fr, sq = t & (SEQ - 1), b = t >> 13;
                f32x4 x[2][2];
#pragma unroll
                for (int bj = 0; bj < 2; ++bj)
#pragma unroll
                    for (int n = 0; n < 2; ++n) { x[bj][n] = acc[ai][bj][m][n] + bv[bj][n];
                        if (pn < 13) {
#pragma unroll
                            for (int e = 0; e < 4; ++e) x[bj][n][e] = gelu_fast(x[bj][n][e]); } }
                if (pn >= 4 && pn < 8) {
                    float s1 = 0.f, s2 = 0.f;
#pragma unroll
                    for (int bj = 0; bj < 2; ++bj)
#pragma unroll
                        for (int n = 0; n < 2; ++n)
#pragma unroll
                            for (int e = 0; e < 4; ++e) { const float v = x[bj][n][e]; s1 += v; s2 += v * v;
                                gvT[((size_t)b * 1024 + (pn - 4) * 256 + bj * 128 + wc * 32 + fq * 8 + 4 * n + e) * SEQ + sq] = f2bf(v); }
                    s1 += __shfl_xor(s1, 16); s1 += __shfl_xor(s1, 32); s2 += __shfl_xor(s2, 16); s2 += __shfl_xor(s2, 32);
                    if (fq == 0) *(f32x2*)(stats + (size_t)t * 32 + ((pn - 4) * 4 + wc) * 2) = (f32x2){s1, s2};
                } else {
                    bf16_t* dst; int ld, cb;
                    if (pn < 4) { dst = gu; ld = 1024; cb = pn * 256; } else if (pn < 13) { dst = gg; ld = 1280; cb = (pn - 8) * 256; } else { dst = xr; ld = 1280; cb = (pn - 13) * 256; }
#pragma unroll
                    for (int bj = 0; bj < 2; ++bj) { u32x4 w;
#pragma unroll
                        for (int n = 0; n < 2; ++n) { w[2 * n] = pk2(x[bj][n][0], x[bj][n][1]); w[2 * n + 1] = pk2(x[bj][n][2], x[bj][n][3]); }
                        *(u32x4*)(dst + (size_t)t * ld + cb + bj * 128 + wc * 32 + fq * 8) = w; }
                }
            }
    }
};
__device__ __forceinline__ void phase_cd_inproj(const Ctx& c, int j) {
    g8::DenseOrder S; S.init(c.ws + WS_XB, c.ws + WS_WCDIN + (size_t)j * CD_IN * D * 2, T, CD_IN, D, c.G, c.bid); S.tid0 = c.tid;
    LAS bf16_t* biasL = (LAS bf16_t*)(c.lds + LDS_TAB);
    { const float* bp = c.in[7] + (size_t)j * CD_IN; for (int i = c.tid; i < CD_IN; i += NTHREADS) biasL[i] = f2bf(bp[i]); }
    __syncthreads();
    EpiCDIn E{biasL, c.ws};
    g8::gemm_phase<EpiCDIn, g8::DenseOrder>(c.lds + LDS_STAGE, D, S, E);
}

__device__ __forceinline__ void lru_unit(const Ctx& c, int unit, int j) {
    const int hh = unit % 5, bn = unit / 5, lane = c.lane, fr = lane & 15, fq = lane >> 4, w = c.wid;
    const int t0 = bn * 128, s0 = t0 & (SEQ - 1);
    const bf16_t* xr = (const bf16_t*)(c.ws + CD_XR); bf16_t* HL = (bf16_t*)(c.ws + WS_U2); bf16_t* PC = HL + (size_t)T * 1280; float* sum = (float*)(c.ws + WS_H);
    const float* conv_w = c.in[10] + (size_t)j * 4 * 1280 + hh * 256; const float* conv_b = c.in[11] + (size_t)j * 1280 + hh * 256;
    const float* ba = c.in[13] + (size_t)j * 1280 + hh * 256; const float* bx = c.in[15] + (size_t)j * 1280 + hh * 256; const float* spl = (const float*)(c.ws + WS_SPL) + (size_t)j * 1280 + hh * 256;
    const bf16_t* Wl = (const bf16_t*)(c.ws + WS_WLRU) + (size_t)((j * 5 + hh) * 2) * 65536;
    LAS unsigned char* Xc = c.lds; LAS unsigned char* Wa = c.lds + 128 * 528; LAS unsigned char* Wx = Wa + 64 * 528; LAS unsigned char* Tot = Wx + 64 * 528;
    __syncthreads();
    {
        const int cg = c.tid & 31, r0 = (c.tid >> 5) * 8;
        float wv[4][8], bv8[8];
        { const f32x4 b0 = *(const f32x4*)(conv_b + cg * 8), b1 = *(const f32x4*)(conv_b + cg * 8 + 4); bv8[0] = b0[0]; bv8[1] = b0[1]; bv8[2] = b0[2]; bv8[3] = b0[3]; bv8[4] = b1[0]; bv8[5] = b1[1]; bv8[6] = b1[2]; bv8[7] = b1[3]; }
#pragma unroll
        for (int k = 0; k < 4; ++k) { const f32x4 w0 = *(const f32x4*)(conv_w + k * 1280 + cg * 8), w1 = *(const f32x4*)(conv_w + k * 1280 + cg * 8 + 4);
            wv[k][0] = w0[0]; wv[k][1] = w0[1]; wv[k][2] = w0[2]; wv[k][3] = w0[3]; wv[k][4] = w1[0]; wv[k][5] = w1[1]; wv[k][6] = w1[2]; wv[k][7] = w1[3]; }
        u32x4 xin[11];
#pragma unroll
        for (int q = 0; q < 11; ++q) { xin[q] = (u32x4){0u, 0u, 0u, 0u}; if (s0 + r0 - 3 + q >= 0) xin[q] = *(const u32x4*)(xr + (size_t)(t0 + r0 - 3 + q) * 1280 + hh * 256 + cg * 8); }
#pragma unroll
        for (int rr = 0; rr < 8; ++rr) { float a[8];
#pragma unroll
            for (int e = 0; e < 8; ++e) a[e] = bv8[e];
#pragma unroll
            for (int k = 0; k < 4; ++k) { const u32x4 xv = xin[rr + k];
#pragma unroll
                for (int e2 = 0; e2 < 4; ++e2) { a[2 * e2] += wv[k][2 * e2] * __uint_as_float(xv[e2] << 16); a[2 * e2 + 1] += wv[k][2 * e2 + 1] * __uint_as_float(xv[e2] & 0xffff0000u); } }
            u32x4 o; o[0] = pk2(a[0], a[1]); o[1] = pk2(a[2], a[3]); o[2] = pk2(a[4], a[5]); o[3] = pk2(a[6], a[7]);
            *(LAS u32x4*)(Xc + (r0 + rr) * 528 + cg * 16) = o; }
    }
    u32x4 wreg[8];
#pragma unroll
    for (int q = 0; q < 4; ++q) { const int i = c.tid + q * NTHREADS, r = i >> 5, cc = i & 31; wreg[q] = *(const u32x4*)((const unsigned char*)Wl + (size_t)r * 512 + cc * 16); wreg[4 + q] = *(const u32x4*)((const unsigned char*)(Wl + 65536) + (size_t)r * 512 + cc * 16); }
    __syncthreads();
    bf16x8 xf[8];
#pragma unroll
    for (int ks = 0; ks < 8; ++ks) xf[ks] = *(const LAS bf16x8*)(Xc + (16 * w + fr) * 528 + ks * 64 + fq * 16);
    const int t = t0 + 16 * w + fr;
    for (int sl = 0; sl < 4; ++sl) {
        if (sl) __syncthreads();
#pragma unroll
        for (int q = 0; q < 4; ++q) { const int i = c.tid + q * NTHREADS, r = i >> 5, cc = i & 31; *(LAS u32x4*)(Wa + r * 528 + cc * 16) = wreg[q]; *(LAS u32x4*)(Wx + r * 528 + cc * 16) = wreg[4 + q]; }
        if (sl < 3) {
#pragma unroll
            for (int q = 0; q < 4; ++q) { const int i = c.tid + q * NTHREADS, r = i >> 5, cc = i & 31;
                wreg[q] = *(const u32x4*)((const unsigned char*)(Wl + (size_t)((sl + 1) * 64) * 256) + (size_t)r * 512 + cc * 16); wreg[4 + q] = *(const u32x4*)((const unsigned char*)(Wl + 65536 + (size_t)((sl + 1) * 64) * 256) + (size_t)r * 512 + cc * 16); } }
        __syncthreads();
        f32x4 sA[4], sB[4];
#pragma unroll
        for (int nc = 0; nc < 4; ++nc) { f32x4 ra = (f32x4){0.f, 0.f, 0.f, 0.f}, ri = ra;
#pragma unroll
            for (int ks = 0; ks < 8; ++ks) { const bf16x8 wa = *(const LAS bf16x8*)(Wa + (16 * nc + fr) * 528 + ks * 64 + fq * 16), wx = *(const LAS bf16x8*)(Wx + (16 * nc + fr) * 528 + ks * 64 + fq * 16);
                ra = MFMA16(wa, xf[ks], ra); ri = MFMA16(wx, xf[ks], ri); }
            const int ch = sl * 64 + 16 * nc + 4 * fq;
            const f32x4 b_a = *(const f32x4*)(ba + ch), b_x = *(const f32x4*)(bx + ch), sp = *(const f32x4*)(spl + ch);
            const u32x2 xw = *(const LAS u32x2*)(Xc + (16 * w + fr) * 528 + ch * 2);
            const float xcv[4] = {__uint_as_float(xw[0] << 16), __uint_as_float(xw[0] & 0xffff0000u), __uint_as_float(xw[1] << 16), __uint_as_float(xw[1] & 0xffff0000u)};
            f32x4 oa, ob;
#pragma unroll
            for (int r = 0; r < 4; ++r) { const float gr = sigmoidf_(ra[r] + b_a[r]), gi = sigmoidf_(ri[r] + b_x[r]); const float la = -8.f * gr * sp[r]; const float a = __expf(la);
                oa[r] = a; ob[r] = sqrtf(fmaxf(1.f - a * a, 0.f)) * (gi * xcv[r]); }
#pragma unroll
            for (int dlt = 1; dlt < 16; dlt <<= 1) {
#pragma unroll
                for (int r = 0; r < 4; ++r) { const float pa = __shfl_up(oa[r], dlt, 16), pb = __shfl_up(ob[r], dlt, 16); if (fr >= dlt) { ob[r] = oa[r] * pb + ob[r]; oa[r] = oa[r] * pa; } } }
            sA[nc] = oa; sB[nc] = ob;
            if (fr == 15) { *(LAS f32x4*)(Tot + ((w * 64 + 16 * nc + 4 * fq) * 2) * 4) = oa; *(LAS f32x4*)(Tot + ((w * 64 + 16 * nc + 4 * fq) * 2 + 4) * 4) = ob; }
        }
        __syncthreads();
#pragma unroll
        for (int nc = 0; nc < 4; ++nc) { const int ch = sl * 64 + 16 * nc + 4 * fq;
            f32x4 cp = (f32x4){1.f, 1.f, 1.f, 1.f}, chh = (f32x4){0.f, 0.f, 0.f, 0.f};
            for (int w2 = 0; w2 < w; ++w2) { const f32x4 ta = *(const LAS f32x4*)(Tot + ((w2 * 64 + 16 * nc + 4 * fq) * 2) * 4), tb = *(const LAS f32x4*)(Tot + ((w2 * 64 + 16 * nc + 4 * fq) * 2 + 4) * 4);
                chh = ta * chh + tb; cp = cp * ta; }
            const f32x4 hl = sB[nc] + sA[nc] * chh, pc = sA[nc] * cp;
            u32x2 o1, o2; o1[0] = pk2(hl[0], hl[1]); o1[1] = pk2(hl[2], hl[3]); o2[0] = pk2(pc[0], pc[1]); o2[1] = pk2(pc[2], pc[3]);
            *(u32x2*)(HL + (size_t)t * 1280 + hh * 256 + ch) = o1; *(u32x2*)(PC + (size_t)t * 1280 + hh * 256 + ch) = o2;
            if (w == 7 && fr == 15) { float* sm = sum + ((size_t)bn * 1280 + hh * 256 + ch) * 2;
#pragma unroll
                for (int r = 0; r < 4; ++r) { sm[2 * r] = pc[r]; sm[2 * r + 1] = hl[r]; } } }
    }
}

__device__ __forceinline__ void sgu_unit(const Ctx& c, int unit, int j) {
    const int g = unit & 3, bn = unit >> 2, b = bn >> 6, n = bn & 63, lane = c.lane, fr = lane & 15, fq = lane >> 4, w = c.wid;
    const int t0 = bn * 128;
    const bf16_t* gu = (const bf16_t*)(c.ws + CD_GU); const bf16_t* gvT = (const bf16_t*)(c.ws + CD_GVT); const float* stats = (const float*)(c.ws + CD_STATS); bf16_t* ycat = (bf16_t*)(c.ws + WS_YCAT);
    const float* sw = c.in[8] + (size_t)(j * 4 + g) * 16384; const float* sb = c.in[9] + (size_t)(j * 4 + g) * 128;
    LAS unsigned char* Vt = c.lds; LAS float* mr = (LAS float*)(c.lds + 256 * 272);
    __syncthreads();
    tile_g2l<256, 256>(Vt, (const unsigned char*)(gvT + ((size_t)b * 1024 + g * 256) * SEQ + n * 128), (size_t)SEQ * 2, c.tid);
    if (c.tid < 128) { const float* st = stats + (size_t)(t0 + c.tid) * 32; float s1 = 0.f, s2 = 0.f;
#pragma unroll
        for (int q = 0; q < 16; ++q) { s1 += st[2 * q]; s2 += st[2 * q + 1]; }
        const float mean = s1 * (1.f / 1024.f), var = fmaxf(s2 * (1.f / 1024.f) - mean * mean, 0.f); mr[2 * c.tid] = mean; mr[2 * c.tid + 1] = rsqrtf(var + LN_EPS); }
    __syncthreads();
    const int i = 16 * w + fr, t = t0 + i, nks = (w >> 1) + 1;
    bf16x8 wf[4]; float ci = 0.f;
#pragma unroll
    for (int ks = 0; ks < 4; ++ks) { f32x4 lo = (f32x4){0.f, 0.f, 0.f, 0.f}, hi = lo;
        if (ks < nks) { const int j0 = ks * 32 + fq * 8; const f32x4 w0 = *(const f32x4*)(sw + (size_t)i * 128 + j0), w1 = *(const f32x4*)(sw + (size_t)i * 128 + j0 + 4);
#pragma unroll
            for (int e = 0; e < 4; ++e) { const float m0 = mr[2 * (j0 + e)], r0 = mr[2 * (j0 + e) + 1], m1 = mr[2 * (j0 + 4 + e)], r1 = mr[2 * (j0 + 4 + e) + 1];
                lo[e] = (j0 + e <= i) ? w0[e] * r0 : 0.f; hi[e] = (j0 + 4 + e <= i) ? w1[e] * r1 : 0.f; ci += lo[e] * m0 + hi[e] * m1; } }
        wf[ks] = pack8(lo, hi); }
    ci += __shfl_xor(ci, 16); ci += __shfl_xor(ci, 32);
    const float add = sb[i] - ci;
    f32x4 acc[16];
#pragma unroll
    for (int nd = 0; nd < 16; ++nd) { acc[nd] = (f32x4){0.f, 0.f, 0.f, 0.f};
#pragma unroll
        for (int ks = 0; ks < 4; ++ks) if (ks < nks) { const bf16x8 vf = *(const LAS bf16x8*)(Vt + (16 * nd + fr) * 272 + ks * 64 + fq * 16); acc[nd] = MFMA16(vf, wf[ks], acc[nd]); } }
#pragma unroll
    for (int nd = 0; nd < 16; ++nd) { const u32x2 uw = *(const u32x2*)(gu + (size_t)t * 1024 + g * 256 + 16 * nd + 4 * fq);
        const float u0 = __uint_as_float(uw[0] << 16), u1 = __uint_as_float(uw[0] & 0xffff0000u), u2 = __uint_as_float(uw[1] << 16), u3 = __uint_as_float(uw[1] & 0xffff0000u);
        u32x2 o; o[0] = pk2(u0 * (acc[nd][0] + add), u1 * (acc[nd][1] + add)); o[1] = pk2(u2 * (acc[nd][2] + add), u3 * (acc[nd][3] + add));
        *(u32x2*)(ycat + (size_t)t * CD_OUT + g * 256 + 16 * nd + 4 * fq) = o; }
}
__device__ __forceinline__ void phase_cd_p1(const Ctx& c, int j) {
    for (int u = c.bid; u < 640; u += c.G) lru_unit(c, u, j);
    if (c.G == 256) {
        if (c.bid < 128) sgu_unit(c, c.bid, j);
        else { for (int q = 0; q < 3; ++q) sgu_unit(c, 128 + (c.bid - 128) * 3 + q, j); }
    } else { for (int u = c.bid; u < 512; u += c.G) sgu_unit(c, u, j); }
}

__device__ __forceinline__ void phase_cd_scan2(const Ctx& c) {
    const bf16_t* gg = (const bf16_t*)(c.ws + CD_GG); bf16_t* ycat = (bf16_t*)(c.ws + WS_YCAT);
    const bf16_t* HL = (const bf16_t*)(c.ws + WS_U2); const bf16_t* PC = HL + (size_t)T * 1280; const float* sum = (const float*)(c.ws + WS_H);
    LAS float* carry = (LAS float*)c.lds;
    for (int u = c.bid; u < 256; u += c.G) {
        const int bn = u >> 1, half = u & 1, b = bn >> 6, n = bn & 63;
        __syncthreads();
        {
            LAS float* part = carry + 1280;
            for (int it = c.tid; it < 4 * 1280; it += NTHREADS) { const int seg = it / 1280, ch = it % 1280; const float* sp = sum + ((size_t)(b * 64 + seg * 16) * 1280 + ch) * 2;
                f32x2 v[16];
#pragma unroll
                for (int q = 0; q < 16; ++q) { v[q] = (f32x2){1.f, 0.f}; if (seg * 16 + q < n) v[q] = *(const f32x2*)(sp + (size_t)q * 2560); }
                float A = 1.f, Bv = 0.f;
#pragma unroll
                for (int q = 0; q < 16; ++q) { Bv = v[q][0] * Bv + v[q][1]; A *= v[q][0]; }
                part[(seg * 1280 + ch) * 2] = A; part[(seg * 1280 + ch) * 2 + 1] = Bv; }
            __syncthreads();
            for (int ch = c.tid; ch < 1280; ch += NTHREADS) { float cr = 0.f;
#pragma unroll
                for (int seg = 0; seg < 4; ++seg) cr = part[(seg * 1280 + ch) * 2] * cr + part[(seg * 1280 + ch) * 2 + 1];
                carry[ch] = cr; }
        }
        __syncthreads();
        const size_t t0 = (size_t)bn * 128 + half * 64;
#pragma unroll 8
        for (int it = c.tid; it < 64 * 320; it += NTHREADS) { const int r = it / 320, c4 = (it % 320) * 4; const size_t o = (t0 + r) * 1280 + c4;
            const u32x2 hw = *(const u32x2*)(HL + o), pw = *(const u32x2*)(PC + o), gw = *(const u32x2*)(gg + o); const f32x4 cr = *(const LAS f32x4*)(carry + c4);
            const float h0 = __uint_as_float(hw[0] << 16) + __uint_as_float(pw[0] << 16) * cr[0], h1 = __uint_as_float(hw[0] & 0xffff0000u) + __uint_as_float(pw[0] & 0xffff0000u) * cr[1];
            const float h2 = __uint_as_float(hw[1] << 16) + __uint_as_float(pw[1] << 16) * cr[2], h3 = __uint_as_float(hw[1] & 0xffff0000u) + __uint_as_float(pw[1] & 0xffff0000u) * cr[3];
            u32x2 ow; ow[0] = pk2(__uint_as_float(gw[0] << 16) * h0, __uint_as_float(gw[0] & 0xffff0000u) * h1); ow[1] = pk2(__uint_as_float(gw[1] << 16) * h2, __uint_as_float(gw[1] & 0xffff0000u) * h3);
            *(u32x2*)(ycat + (t0 + r) * CD_OUT + 1024 + c4) = ow; }
    }
}

__device__ __forceinline__ void phase_ln_moe(const Ctx& c, const float* g, const float* bta, float* xout) {
    typedef float f32x2v __attribute__((ext_vector_type(2)));
    bf16_t* xb = (bf16_t*)(c.ws + WS_XB); const unsigned char* Y = (const unsigned char*)(c.ws + WS_U1);
    for (long tt = (long)c.gw * 2; tt < T; tt += (long)c.nwaves * 2) {
        float v[2][2][8];
#pragma unroll
        for (int u = 0; u < 2; ++u) { const long t = tt + u;
#pragma unroll
            for (int q = 0; q < 2; ++q) { const int col = q * 512 + c.lane * 8;
                float f[8];
#pragma unroll
                for (int e = 0; e < 8; ++e) f[e] = 0.f;
#pragma unroll
                for (int k = 0; k < 8; ++k) { const size_t srow = (size_t)t * 8 + k; const u32x2 w = *(const u32x2*)(Y + srow * D + col);
#pragma unroll
                    for (int h2 = 0; h2 < 2; ++h2) { const f32x2v a = __builtin_amdgcn_cvt_pk_f32_fp8(w[h2], false), b = __builtin_amdgcn_cvt_pk_f32_fp8(w[h2], true);
                        f[4 * h2] += a[0]; f[4 * h2 + 1] += a[1]; f[4 * h2 + 2] += b[0]; f[4 * h2 + 3] += b[1]; } }
                const u32x4 xw = *(const u32x4*)(xb + (size_t)t * D + col), sw = *(const u32x4*)((const bf16_t*)(Y + (size_t)TK * D) + (size_t)t * D + col);
#pragma unroll
                for (int e2 = 0; e2 < 4; ++e2) { v[u][q][2 * e2] = __uint_as_float(xw[e2] << 16) * ALPHA + f[2 * e2] * (1.f / 64.f) + __uint_as_float(sw[e2] << 16);
                    v[u][q][2 * e2 + 1] = __uint_as_float(xw[e2] & 0xffff0000u) * ALPHA + f[2 * e2 + 1] * (1.f / 64.f) + __uint_as_float(sw[e2] & 0xffff0000u); } } }
#pragma unroll
        for (int u = 0; u < 2; ++u) { const long t = tt + u;
            float sm = 0.f;
#pragma unroll
            for (int q = 0; q < 2; ++q)
#pragma unroll
                for (int e = 0; e < 8; ++e) sm += v[u][q][e];
            const float mean = wave_sum(sm) * (1.f / 1024.f); float sq = 0.f;
#pragma unroll
            for (int q = 0; q < 2; ++q)
#pragma unroll
                for (int e = 0; e < 8; ++e) { v[u][q][e] -= mean; sq += v[u][q][e] * v[u][q][e]; }
            const float rstd = rsqrtf(wave_sum(sq) * (1.f / 1024.f) + LN_EPS);
#pragma unroll
            for (int q = 0; q < 2; ++q) { const int col = q * 512 + c.lane * 8; float o[8];
#pragma unroll
                for (int h2 = 0; h2 < 2; ++h2) { const f32x4 gg = *(const f32x4*)(g + col + 4 * h2), bb = *(const f32x4*)(bta + col + 4 * h2);
#pragma unroll
                    for (int e = 0; e < 4; ++e) o[4 * h2 + e] = v[u][q][4 * h2 + e] * rstd * gg[e] + bb[e];
                    if (xout) *(f32x4*)(xout + (size_t)t * D + col + 4 * h2) = (f32x4){o[4 * h2], o[4 * h2 + 1], o[4 * h2 + 2], o[4 * h2 + 3]}; }
                u32x4 w; w[0] = pk2(o[0], o[1]); w[1] = pk2(o[2], o[3]); w[2] = pk2(o[4], o[5]); w[3] = pk2(o[6], o[7]); *(u32x4*)(xb + (size_t)t * D + col) = w; } }
    }
}

__device__ __forceinline__ unsigned sortable_u32(float f) { const unsigned b = __float_as_uint(f); return b ^ ((b >> 31) ? 0xffffffffu : 0x80000000u); }
__device__ __forceinline__ int popc64(unsigned long long m) { return __builtin_popcountll(m); }
__device__ __forceinline__ int rank_lt(unsigned long long m) { return (int)__builtin_amdgcn_mbcnt_hi((unsigned)(m >> 32), __builtin_amdgcn_mbcnt_lo((unsigned)m, 0u)); }
__device__ __forceinline__ void phase_ln_route(const Ctx& c, int L) {
    bf16_t* xb = (bf16_t*)(c.ws + WS_XB); const bf16_t* hbuf = (const bf16_t*)(c.ws + WS_HB);
    const float* g = c.in[19] + (size_t)L * D; const float* bta = c.in[20] + (size_t)L * D; const float* rb = c.in[22] + L * NE;
    const bf16_t* Wr = (const bf16_t*)(c.ws + WS_WRT) + (size_t)L * 256 * D;
    int* cnt = (int*)(c.ws + CTL_CNT) + L * NE * 1024; int* list = (int*)(c.ws + WS_LIST); float* gate = (float*)(c.ws + WS_GATE);
    LAS unsigned char* Xl = c.lds; LAS unsigned char* Wq = c.lds + 32 * 2064;
    LAS float* Sc = (LAS float*)Wq;
    LAS int* hist = (LAS int*)(Wq + 32768); LAS int* gbase = hist + 128; LAS int* sel = gbase + 128; LAS float* selg = (LAS float*)(sel + 512);
    const int lane = c.lane, fr = lane & 15, fq = lane >> 4, w = c.wid;
    for (int grp = c.bid; grp < T / 64; grp += c.G) {
        __syncthreads();
        u32x2 nb[8][4];
#pragma unroll
        for (int hb = 0; hb < 2; ++hb) {
            u32x2 xw[4][4], hw[4][4];
#pragma unroll
            for (int i = 0; i < 4; ++i) { const size_t t = (size_t)grp * 64 + hb * 32 + w * 4 + i;
#pragma unroll
                for (int q = 0; q < 4; ++q) { const int col = q * 256 + lane * 4; xw[i][q] = *(const u32x2*)(xb + t * D + col); hw[i][q] = *(const u32x2*)(hbuf + t * D + col); } }
#pragma unroll
            for (int i = 0; i < 4; ++i) { const size_t t = (size_t)grp * 64 + hb * 32 + w * 4 + i;
                f32x4 v[4]; float sm = 0.f;
#pragma unroll
                for (int q = 0; q < 4; ++q) { v[q] = (f32x4){__uint_as_float(xw[i][q][0] << 16), __uint_as_float(xw[i][q][0] & 0xffff0000u), __uint_as_float(xw[i][q][1] << 16), __uint_as_float(xw[i][q][1] & 0xffff0000u)} * ALPHA
                         + (f32x4){__uint_as_float(hw[i][q][0] << 16), __uint_as_float(hw[i][q][0] & 0xffff0000u), __uint_as_float(hw[i][q][1] << 16), __uint_as_float(hw[i][q][1] & 0xffff0000u)};
                    sm += v[q][0] + v[q][1] + v[q][2] + v[q][3]; }
                const float mean = wave_sum(sm) * (1.f / 1024.f); float sq = 0.f;
#pragma unroll
                for (int q = 0; q < 4; ++q) { v[q] = v[q] - mean; sq += v[q][0] * v[q][0] + v[q][1] * v[q][1] + v[q][2] * v[q][2] + v[q][3] * v[q][3]; }
                const float rstd = rsqrtf(wave_sum(sq) * (1.f / 1024.f) + LN_EPS);
#pragma unroll
                for (int q = 0; q < 4; ++q) { const f32x4 o = v[q] * rstd * *(const f32x4*)(g + q * 256 + lane * 4) + *(const f32x4*)(bta + q * 256 + lane * 4); nb[hb * 4 + i][q][0] = pk2(o[0], o[1]); nb[hb * 4 + i][q][1] = pk2(o[2], o[3]);
                    *(u32x2*)(xb + t * D + q * 256 + lane * 4) = nb[hb * 4 + i][q]; } }
        }
        f32x4 lg[2][2];
        const int st = w & 1, eg = w >> 1;
#pragma unroll
        for (int p2 = 0; p2 < 2; ++p2) {
            if (p2) __syncthreads();
#pragma unroll
            for (int u = 0; u < 4; ++u)
#pragma unroll
                for (int q = 0; q < 4; ++q) *(LAS u32x2*)(Xl + (w * 4 + u) * 2064 + (q * 256 + lane * 4) * 2) = nb[p2 * 4 + u][q];
            lg[p2][0] = (f32x4){0.f, 0.f, 0.f, 0.f}; lg[p2][1] = lg[p2][0];
            u32x4 wreg[8];
#pragma unroll
            for (int q = 0; q < 8; ++q) { const int i = c.tid + q * NTHREADS, r = i >> 5, cc = i & 31; wreg[q] = *(const u32x4*)((const unsigned char*)Wr + (size_t)r * 2048 + cc * 16); }
#pragma unroll
            for (int kq = 0; kq < 4; ++kq) {
                if (kq) __syncthreads();
#pragma unroll
                for (int q = 0; q < 8; ++q) { const int i = c.tid + q * NTHREADS, r = i >> 5, cc = i & 31; *(LAS u32x4*)(Wq + r * 528 + cc * 16) = wreg[q]; }
                if (kq < 3) {
#pragma unroll
                    for (int q = 0; q < 8; ++q) { const int i = c.tid + q * NTHREADS, r = i >> 5, cc = i & 31; wreg[q] = *(const u32x4*)((const unsigned char*)Wr + (size_t)r * 2048 + (kq + 1) * 512 + cc * 16); } }
                __syncthreads();
#pragma unroll
                for (int ks = 0; ks < 8; ++ks) { const bf16x8 bop = *(const LAS bf16x8*)(Xl + (16 * st + fr) * 2064 + kq * 512 + ks * 64 + fq * 16);
#pragma unroll
                    for (int ne2 = 0; ne2 < 2; ++ne2) { const bf16x8 aop = *(const LAS bf16x8*)(Wq + (32 * eg + 16 * ne2 + fr) * 528 + ks * 64 + fq * 16); lg[p2][ne2] = MFMA16(aop, bop, lg[p2][ne2]); } }
            }
        }
        __syncthreads();
#pragma unroll
        for (int p2 = 0; p2 < 2; ++p2)
#pragma unroll
            for (int ne2 = 0; ne2 < 2; ++ne2) { f32x4 sg;
#pragma unroll
                for (int r = 0; r < 4; ++r) sg[r] = sigmoidf_(lg[p2][ne2][r]);
                *(LAS f32x4*)(Sc + (p2 * 32 + 16 * st + fr) * 128 + 32 * eg + 16 * ne2 + 4 * fq) = sg; }
        if (c.tid < 128) hist[c.tid] = 0;
        __syncthreads();
        {
            const float rb0 = rb[lane], rb1 = rb[64 + lane];
#pragma unroll 2
            for (int q = 0; q < 8; ++q) { const int rr = w * 8 + q;
                const float s0 = Sc[rr * 128 + lane], s1 = Sc[rr * 128 + 64 + lane];
                const unsigned u0 = sortable_u32(s0 + rb0), u1 = sortable_u32(s1 + rb1);
                unsigned thr = 0u;
                for (int bit = 31; bit >= 0; --bit) { const unsigned cand = thr | (1u << bit); const int n = popc64(__ballot(u0 >= cand)) + popc64(__ballot(u1 >= cand)); if (n >= 8) thr = cand; }
                const bool gt0 = u0 > thr, gt1 = u1 > thr, eq0 = u0 == thr, eq1 = u1 == thr;
                const unsigned long long me0 = __ballot(eq0), me1 = __ballot(eq1);
                const int need = 8 - popc64(__ballot(gt0)) - popc64(__ballot(gt1));
                const bool sel0 = gt0 || (eq0 && rank_lt(me0) < need), sel1 = gt1 || (eq1 && popc64(me0) + rank_lt(me1) < need);
                const unsigned long long m0 = __ballot(sel0), m1 = __ballot(sel1);
                const float tot = wave_sum((sel0 ? s0 : 0.f) + (sel1 ? s1 : 0.f));
                if (sel0) { const int k = rank_lt(m0); const int lr = __hip_atomic_fetch_add(&hist[lane], 1, __ATOMIC_RELAXED, __HIP_MEMORY_SCOPE_WORKGROUP); sel[rr * 8 + k] = (lane << 16) | lr; selg[rr * 8 + k] = s0 / tot * 2.5f; }
                if (sel1) { const int k = popc64(m0) + rank_lt(m1); const int lr = __hip_atomic_fetch_add(&hist[64 + lane], 1, __ATOMIC_RELAXED, __HIP_MEMORY_SCOPE_WORKGROUP); sel[rr * 8 + k] = ((64 + lane) << 16) | lr; selg[rr * 8 + k] = s1 / tot * 2.5f; } }
        }
        __syncthreads();
        if (c.tid < 128) gbase[c.tid] = atomicAdd(&cnt[c.tid * 1024], hist[c.tid]);
        __syncthreads();
        { const int sv = sel[c.tid], e = sv >> 16, lr = sv & 0xffff; const int slot = (grp * 64 + (c.tid >> 3)) * 8 + (c.tid & 7);
          list[(size_t)e * LISTCAP + gbase[e] + lr] = slot; gate[slot] = selg[c.tid]; }
    }
}

struct MoeOrder {
    const char* Abase; const char* Bbase; size_t Bstride; int K, NT, NTG, total, G, c, mode, tid0;
    LAS int* tab; LAS int* desc;
    __device__ __forceinline__ bool next(int i, g8::Unit& u) const {
        const int ip = i / NTG, q = i - ip * NTG;
        const long L = (long)ip * G + c; if (L >= total || ip >= TAB_SLOTS) return false;
        const int d = desc[ip]; const int e = d >> 12, pn = (d & 15) * NTG + q;
        u.pm = (d >> 4) & 255; u.pn = pn; u.aux = ip; u.A = Abase; u.B = Bbase + (size_t)e * Bstride + (size_t)pn * 256 * K * 2; return true;
    }
    __device__ __forceinline__ void aoff(const g8::Unit& u, int tid, unsigned (&o)[2][2]) const {
#pragma unroll
        for (int i = 0; i < 2; ++i) { int R, C; g8::stage_rc(tid * 16 + i * 8192, R, C);
#pragma unroll
            for (int h = 0; h < 2; ++h) { int s = tab[u.aux * 256 + h * 128 + R]; s = s < 0 ? 0 : s; const int row = mode ? s : (s < TK ? (s >> 3) : s - TK);
                o[h][i] = (unsigned)(row * K + C) * 2u; } }
    }
};
__device__ __forceinline__ void moe_setup(const Ctx& c, MoeOrder& S, const int* cnt, int NT, int NTG) {
    LAS int* pref = (LAS int*)(c.lds + LDS_PREF); LAS int* desc = (LAS int*)(c.lds + LDS_DESC); LAS int* tab = (LAS int*)(c.lds + LDS_TAB);
    const int* list = (const int*)(c.ws + WS_LIST);
    if (c.tid < 64) { int nb[3]; int loc = 0;
#pragma unroll
        for (int q = 0; q < 3; ++q) { const int e = c.tid * 3 + q; int n = 0; if (e < NE) n = cnt[e * 1024]; else if (e == NE) n = T; nb[q] = (n + 255) >> 8; loc += nb[q]; }
        int inc = loc;
#pragma unroll
        for (int o = 1; o < 64; o <<= 1) { const int v = __shfl_up(inc, o); if (c.tid >= o) inc += v; }
        int acc = inc - loc;
#pragma unroll
        for (int q = 0; q < 3; ++q) { const int e = c.tid * 3 + q; if (e <= NE1) pref[e] = acc; acc += nb[q]; } }
    __syncthreads();
    const int NG = NT / NTG; const int total = pref[NE1] * NG;
    LAS float* gtab = (LAS float*)(c.lds + LDS_GTAB); const float* gate = (const float*)(c.ws + WS_GATE);
    S.NT = NT; S.NTG = NTG; S.total = total; S.G = c.G; S.c = c.bid; S.tab = tab; S.desc = desc;
    {
        int sv[TAB_SLOTS / 2];
#pragma unroll
        for (int k = 0; k < TAB_SLOTS / 2; ++k) { const int i = (c.tid >> 8) + 2 * k; sv[k] = -2;
            const long L = (long)i * c.G + c.bid;
            if (L < total) {
                int wgid = (int)L; { const int q = total / 8, r = total % 8, xcd = wgid % 8, off = wgid / 8; wgid = (xcd < r ? xcd * (q + 1) : r * (q + 1) + (xcd - r) * q) + off; }
                const int rbg = wgid / NG, pn = wgid % NG;
                int lo = 0, hi = NE1;
                while (hi - lo > 1) { const int mid = (lo + hi) >> 1; if (pref[mid] <= rbg) lo = mid; else hi = mid; }
                const int e = lo, rb = rbg - pref[e], n = e < NE ? cnt[e * 1024] : T;
                if ((c.tid & 255) == 0) desc[i] = (e << 12) | (rb << 4) | pn;
                const int r = rb * 256 + (c.tid & 255); sv[k] = -1; if (r < n) sv[k] = (e < NE) ? list[(size_t)e * LISTCAP + r] : TK + r; } }
#pragma unroll
        for (int k = 0; k < TAB_SLOTS / 2; ++k) { const int i = (c.tid >> 8) + 2 * k; if (sv[k] != -2) { tab[i * 256 + (c.tid & 255)] = sv[k]; if (S.mode) gtab[i * 256 + (c.tid & 255)] = sv[k] >= 0 ? gate[sv[k]] : 0.f; } }
    }
    __syncthreads();
}
struct EpiMoeGU {
    static constexpr bool PERM = true;
    bf16_t* H; LAS int* tab;
    __device__ __forceinline__ void operator()(const f32x4 (&acc)[2][2][4][2], const g8::Unit& u, int wr, int wc, int fr, int fq) const {
#pragma unroll
        for (int ai = 0; ai < 2; ++ai)
#pragma unroll
            for (int m = 0; m < 4; ++m) { const int r = ai * 128 + wr * 64 + m * 16 + fr; const int s = tab[u.aux * 256 + r];
                if (s >= 0) { u32x4 w;
#pragma unroll
                    for (int n = 0; n < 2; ++n) { const f32x4 g = acc[ai][0][m][n], up = acc[ai][1][m][n];
                        w[2 * n] = pk2(siluf_(g[0]) * up[0], siluf_(g[1]) * up[1]); w[2 * n + 1] = pk2(siluf_(g[2]) * up[2], siluf_(g[3]) * up[3]); }
                    *(u32x4*)(H + (size_t)s * ED + u.pn * 128 + wc * 32 + fq * 8) = w; } }
    }
};
struct EpiMoeDN {
    static constexpr bool PERM = true;
    unsigned char* Y; LAS float* gtab; LAS int* tab;
    __device__ __forceinline__ void operator()(const f32x4 (&acc)[2][2][4][2], const g8::Unit& u, int wr, int wc, int fr, int fq) const {
#pragma unroll
        for (int ai = 0; ai < 2; ++ai)
#pragma unroll
            for (int m = 0; m < 4; ++m) { const int r = ai * 128 + wr * 64 + m * 16 + fr; const int s = tab[u.aux * 256 + r];
                if (s >= TK) {
#pragma unroll
                    for (int bj = 0; bj < 2; ++bj) { u32x4 w;
#pragma unroll
                        for (int n = 0; n < 2; ++n) { const f32x4 a = acc[ai][bj][m][n]; w[2 * n] = pk2(a[0], a[1]); w[2 * n + 1] = pk2(a[2], a[3]); }
                        *(u32x4*)((bf16_t*)(Y + (size_t)TK * D) + (size_t)(s - TK) * D + u.pn * 256 + bj * 128 + wc * 32 + fq * 8) = w; }
                } else if (s >= 0) { const float gt = gtab[u.aux * 256 + r] * 64.f;
#pragma unroll
                    for (int bj = 0; bj < 2; ++bj) { u32x2 w;
#pragma unroll
                        for (int n = 0; n < 2; ++n) { f32x4 a = acc[ai][bj][m][n] * gt;
#pragma unroll
                            for (int e = 0; e < 4; ++e) a[e] = fminf(fmaxf(a[e], -448.f), 448.f);
                            unsigned pw = 0u; pw = __builtin_amdgcn_cvt_pk_fp8_f32(a[0], a[1], pw, false); pw = __builtin_amdgcn_cvt_pk_fp8_f32(a[2], a[3], pw, true); w[n] = pw; }
                        *(u32x2*)(Y + (size_t)s * D + u.pn * 256 + bj * 128 + wc * 32 + fq * 8) = w; } } }
    }
};
__device__ __forceinline__ void phase_moe_gu(const Ctx& c, int L) {
    MoeOrder S; S.Abase = (const char*)(c.ws + WS_XB); S.Bbase = (const char*)(c.ws + WS_WGU) + (size_t)L * NE1 * 512 * D * 2; S.Bstride = (size_t)512 * D * 2; S.K = D; S.mode = 0; S.tid0 = c.tid;
    moe_setup(c, S, (const int*)(c.ws + CTL_CNT) + L * NE * 1024, 2, 1);
    EpiMoeGU E{(bf16_t*)(c.ws + WS_HID), S.tab};
    g8::gemm_phase<EpiMoeGU, MoeOrder>(c.lds + LDS_STAGE, D, S, E);
}
__device__ __forceinline__ void phase_moe_dn(const Ctx& c, int L) {
    MoeOrder S; S.Abase = (const char*)(c.ws + WS_HID); S.Bbase = (const char*)(c.ws + WS_WDN) + (size_t)L * NE1 * D * ED * 2; S.Bstride = (size_t)D * ED * 2; S.K = ED; S.mode = 1; S.tid0 = c.tid;
    moe_setup(c, S, (const int*)(c.ws + CTL_CNT) + L * NE * 1024, 4, 2);
    EpiMoeDN E{(unsigned char*)(c.ws + WS_U1), (LAS float*)(c.lds + LDS_GTAB), S.tab};
    g8::gemm_phase<EpiMoeDN, MoeOrder>(c.lds + LDS_STAGE, ED, S, E);
}

constexpr int PH_PER_LAYER = 9;
constexpr int N_PHASES = 1 + 4 * PH_PER_LAYER;

__global__ void __launch_bounds__(NTHREADS, 2) fwd_kernel(Params p) {
    extern __shared__ __attribute__((aligned(16))) unsigned char lds_raw[];
    LAS unsigned char* const lds0 = (LAS unsigned char*)lds_raw;
    const int wave_id = __builtin_amdgcn_readfirstlane((int)threadIdx.x >> 6);
    volatile LAS unsigned* misc = (volatile LAS unsigned*)(lds0 + LDS_MISC);
    if (threadIdx.x < 4) misc[threadIdx.x] = 0u;
    __syncthreads();
    const int lo = p.ph_lo, hi = p.ph_hi;
    XcdBarrier bar; bar.bar = (unsigned*)(p.ws + WS_CTL); bar.x = 0; bar.st = misc;
    if (hi - lo > 1) bar = xcd_barrier_post((unsigned*)(p.ws + WS_CTL), misc);
#define MKCTX() Ctx c; { int wv_ = wave_id; asm volatile("" : "+s"(wv_)); int tid_ = wv_ * 64 + (int)__builtin_amdgcn_mbcnt_hi(~0u, __builtin_amdgcn_mbcnt_lo(~0u, 0u)); asm volatile("" : "+v"(tid_)); int bid_ = blockIdx.x; asm volatile("" : "+s"(bid_)); unsigned long long ws_ = (unsigned long long)p.ws; asm volatile("" : "+s"(ws_)); \
        c.in = p.in; c.out = p.out; c.ws = (unsigned char*)ws_; c.lds = lds0; c.tid = tid_; c.lane = tid_ & 63; c.wid = __builtin_amdgcn_readfirstlane(tid_ >> 6); c.bid = bid_; c.G = gridDim.x; \
        c.gtid = c.bid * NTHREADS + c.tid; c.gthreads = c.G * NTHREADS; c.gw = c.bid * 8 + c.wid; c.nwaves = c.G * 8; } unsigned char* const ws = c.ws; (void)ws
    int id = 0;
#ifndef PMASK
#define PMASK 0xffffffffu
#endif
#ifndef DUPMASK
#define DUPMASK 0u
#endif
#define PHASE(k, body) do { if (((PMASK >> (k)) & 1u) && lo <= id && id < hi) { MKCTX(); body; if ((DUPMASK >> (k)) & 1u) { body; } if (id + 1 < hi) xcd_barrier(bar, c.tid == 0); } ++id; } while (0)
    PHASE(0, phase_convert(c));
#pragma unroll 1
    for (int L = 0; L < 4; ++L) {
        const int j = L >> 1; const bool cd = (L & 1);
        if (cd) {
            PHASE(1, phase_cd_inproj(c, j));
        } else {
            PHASE(2, phase_ab_inproj(c, j));
        }
        if (!cd) { PHASE(3, phase_ab_p1(c)); PHASE(4, phase_ab_p2(c, j)); PHASE(16, phase_ab_p3(c)); }
        else     { PHASE(5, phase_cd_p1(c, j)); PHASE(15, phase_cd_scan2(c)); id += 1; }
        {
            const size_t Woff = cd ? WS_WCDOUT + (size_t)j * D * CD_OUT * 2 : WS_WABOUT + (size_t)j * D * AB_OUT * 2;
            const int K = cd ? CD_OUT : AB_OUT; const float* bias = cd ? p.in[18] + (size_t)j * D : p.in[5] + (size_t)j * D;
            PHASE(8, phase_dense(c, (const bf16_t*)(ws + WS_YCAT), (const bf16_t*)(ws + Woff), T, D, K, (bf16_t*)(ws + WS_HB), D, bias));
        }
        PHASE(9, phase_ln_route(c, L));
        PHASE(12, phase_moe_gu(c, L));
        PHASE(13, phase_moe_dn(c, L));
        PHASE(14, phase_ln_moe(c, p.in[29] + (size_t)L * D, p.in[30] + (size_t)L * D, L == 3 ? p.out : (float*)nullptr));
    }
#undef PHASE
}

extern "C" void kernel_launch(void* const* d_in, const int* in_sizes, int n_in, void* d_out, int out_size, void* d_ws, size_t ws_size, hipStream_t stream) {
    static int grid = 0;
    if (grid == 0) {
        if (n_in != 31 || out_size != T * D || ws_size < WS_END) { fprintf(stderr, "kernel_launch: unexpected shapes (n_in %d out %d ws %zu need %zu)\n", n_in, out_size, ws_size, (size_t)WS_END); grid = -1; return; }
        int dev = 0, cus = 0, per_cu = 0;
        if (hipGetDevice(&dev) != hipSuccess || hipDeviceGetAttribute(&cus, hipDeviceAttributeMultiprocessorCount, dev) != hipSuccess) { grid = -1; return; }
        if (hipFuncSetAttribute((const void*)fwd_kernel, hipFuncAttributeMaxDynamicSharedMemorySize, LDS_BYTES) != hipSuccess) { fprintf(stderr, "kernel_launch: hipFuncSetAttribute failed\n"); grid = -1; return; }
        if (hipOccupancyMaxActiveBlocksPerMultiprocessor(&per_cu, (const void*)fwd_kernel, NTHREADS, LDS_BYTES) != hipSuccess || per_cu < 1) fprintf(stderr, "kernel_launch: occupancy query says %d\n", per_cu);
        (void)hipGetLastError();
        grid = cus;
    }
    if (grid < 0) return;
    (void)hipMemsetAsync((char*)d_ws + WS_CTL, 0, CTL_BYTES, stream);
    Params p{};
    for (int i = 0; i < 31; ++i) p.in[i] = (const float*)d_in[i];
    p.out = (float*)d_out; p.ws = (unsigned char*)d_ws;
#if N_LAUNCH_MODE == 1
    p.ph_lo = 0; p.ph_hi = N_PHASES;
    hipLaunchKernelGGL(fwd_kernel, dim3(grid), dim3(NTHREADS), LDS_BYTES, stream, p);
#else
    for (int i = 0; i < N_PHASES; ++i) { p.ph_lo = i; p.ph_hi = i + 1; hipLaunchKernelGGL(fwd_kernel, dim3(grid), dim3(NTHREADS), LDS_BYTES, stream, p); }
#endif
}
```

```cpp
#include <hip/hip_runtime.h>
#include <cstdio>
#include <cstdint>

#define LAS __attribute__((address_space(3)))
typedef unsigned short bf16_t;
typedef short bf16x8 __attribute__((ext_vector_type(8)));
typedef float f32x4 __attribute__((ext_vector_type(4)));
typedef float f32x2 __attribute__((ext_vector_type(2)));
typedef unsigned u32x4 __attribute__((ext_vector_type(4)));
typedef unsigned u32x2 __attribute__((ext_vector_type(2)));

constexpr int T = 16384, D = 1024, SEQ = 8192;
constexpr int AB_IN = 4352, AB_OUT = 2048, CD_IN = 4608, CD_OUT = 2304;
constexpr int NE = 128, NE1 = 129, TOPK = 8, ED = 256;
constexpr int TK = T * TOPK;
constexpr int NSLOT = TK + T;
constexpr int LISTCAP = 16384;
constexpr float ALPHA = 1.681792830507429f;
constexpr float LN_EPS = 1e-5f;

#ifndef N_LAUNCH_MODE
#define N_LAUNCH_MODE 1
#endif

constexpr size_t al256(size_t x) { return (x + 255) & ~(size_t)255; }
constexpr size_t WS_CTL    = 0;
constexpr size_t CTL_BYTES = 65536 + (size_t)4 * 128 * 4096;
constexpr size_t CTL_CNT   = 65536;
constexpr size_t WS_WABIN  = CTL_BYTES;
constexpr size_t WS_WABOUT = WS_WABIN  + al256((size_t)2 * AB_IN * D * 2);
constexpr size_t WS_WCDIN  = WS_WABOUT + al256((size_t)2 * D * AB_OUT * 2);
constexpr size_t WS_WCDOUT = WS_WCDIN  + al256((size_t)2 * CD_IN * D * 2);
constexpr size_t WS_WRT    = WS_WCDOUT + al256((size_t)2 * D * CD_OUT * 2);
constexpr size_t WS_WGU    = WS_WRT    + al256((size_t)4 * 256 * D * 2);
constexpr size_t WS_WDN    = WS_WGU    + al256((size_t)4 * NE1 * 512 * D * 2);
constexpr size_t WS_X      = WS_WDN    + al256((size_t)4 * NE1 * D * ED * 2);
constexpr size_t WS_HB     = WS_X;
constexpr size_t WS_XB     = WS_X      + al256((size_t)T * D * 4);
constexpr size_t WS_U1     = WS_XB     + al256((size_t)T * D * 2);
constexpr size_t U1_BYTES  = al256((size_t)NSLOT * D * 2) > al256((size_t)T * CD_IN * 4) ? al256((size_t)NSLOT * D * 2) : al256((size_t)T * CD_IN * 4);
constexpr size_t WS_U2     = WS_U1     + U1_BYTES;
constexpr size_t U2_BYTES  = al256((size_t)T * 1280 * 4 * 3);
constexpr size_t WS_YCAT   = WS_U2     + U2_BYTES;
constexpr size_t WS_H      = WS_YCAT   + al256((size_t)T * CD_OUT * 2);
constexpr size_t WS_ZR     = WS_H      + al256((size_t)T * D * 4);
constexpr size_t WS_HID    = WS_ZR     + al256((size_t)T * 256 * 4);
constexpr size_t WS_LIST   = WS_HID    + al256((size_t)NSLOT * ED * 2);
constexpr size_t WS_GATE   = WS_LIST   + al256((size_t)NE * LISTCAP * 4);
constexpr size_t WS_ROPEA  = WS_GATE   + al256((size_t)NSLOT * 4);
constexpr size_t WS_ROPER  = WS_ROPEA  + al256((size_t)SEQ * 32 * 8);
constexpr size_t WS_BIASP  = WS_ROPER  + al256((size_t)SEQ * 64 * 8);
constexpr size_t WS_WLRU   = WS_BIASP  + al256((size_t)2 * AB_IN * 4);
constexpr size_t WS_SPL    = WS_WLRU   + al256((size_t)2 * 5 * 2 * 65536 * 2);
constexpr size_t WS_END    = WS_SPL    + al256((size_t)2 * 1280 * 4);
constexpr size_t CD_GU = WS_U1, CD_GVT = WS_U1 + 32 * (1024 * 1024), CD_GG = WS_U1 + 64 * (1024 * 1024), CD_XR = WS_U1 + 104 * (1024 * 1024), CD_STATS = WS_U1 + 144 * (1024 * 1024);
constexpr size_t MB = 1024 * 1024;
constexpr size_t AB_QB = WS_U1, AB_KB = WS_U1 + 32 * MB, AB_VT = WS_U1 + 36 * MB, AB_RQB = WS_U1 + 40 * MB, AB_RKB = WS_U1 + 56 * MB, AB_RKDT = WS_U1 + 72 * MB,
                 AB_RVT = WS_U1 + 88 * MB, AB_RGB = WS_U1 + 120 * MB, AB_KV = WS_U1 + 152 * MB  , AB_SPREV = WS_U1 + 216 * MB  ;
static_assert(AB_SPREV + 32 * MB <= WS_U1 + U1_BYTES, "U1 map");

__device__ __forceinline__ float bf2f(bf16_t b) { return __uint_as_float(((unsigned)b) << 16); }
__device__ __forceinline__ unsigned pk2(float lo, float hi) { unsigned r; asm("v_cvt_pk_bf16_f32 %0, %1, %2" : "=v"(r) : "v"(lo), "v"(hi)); return r; }
__device__ __forceinline__ bf16_t f2bf(float f) { return (bf16_t)(pk2(f, f) & 0xffffu); }
__device__ __forceinline__ float wave_sum(float v) {
#pragma unroll
    for (int o = 32; o; o >>= 1) v += __shfl_xor(v, o);
    return v; }
__device__ __forceinline__ float wave_max(float v) {
#pragma unroll
    for (int o = 32; o; o >>= 1) v = fmaxf(v, __shfl_xor(v, o));
    return v; }
__device__ __forceinline__ float gelu_tanh(float x) { const float u = 0.7978845608028654f * (x + 0.044715f * x * x * x); return 0.5f * x * (1.f + tanhf(u)); }
__device__ __forceinline__ float sigmoidf_(float x) { return __builtin_amdgcn_rcpf(1.f + __expf(-x)); }
__device__ __forceinline__ float siluf_(float x) { return x * __builtin_amdgcn_rcpf(1.f + __expf(-x)); }

#define XB_TMO      128
#define XB_XCNT(j)  (256  + 64 * (j))
#define XB_XSUB(j)  (1280 + 64 * (j))
#define XB_XGEN(j)  (2304 + 64 * (j))
#define XB_TOP      3328
#define XB_TOPGEN   3392
#define XCD_BAR_WORDS 3456
#define XB_SPIN_CAP (1u << 22)

__device__ __forceinline__ unsigned xb_ld(unsigned* p)              { return __hip_atomic_load(p, __ATOMIC_RELAXED, __HIP_MEMORY_SCOPE_AGENT); }
__device__ __forceinline__ unsigned xb_add(unsigned* p, unsigned v) { return __hip_atomic_fetch_add(p, v, __ATOMIC_RELAXED, __HIP_MEMORY_SCOPE_AGENT); }
__device__ __forceinline__ unsigned xb_xcc_id() { return (unsigned)__builtin_amdgcn_s_getreg((3 << 11) | 20) & 0xFu; }
#define XB_SPIN(cond, bar) do { unsigned _sp = 0; while (cond) { __builtin_amdgcn_s_sleep(1); \
    if ((++_sp & 255u) == 0u) { if (xb_ld(&(bar)[XB_TMO])) break; if (_sp > XB_SPIN_CAP) { atomicAdd(&(bar)[XB_TMO], 1u); break; } } } } while (0)

struct XcdBarrier { unsigned* bar; unsigned x; volatile LAS unsigned* st; };

__device__ __forceinline__ XcdBarrier xcd_barrier_post(unsigned* bar, volatile LAS unsigned* st) {
    XcdBarrier b; b.bar = bar; b.x = xb_xcc_id(); b.st = st;
    if (threadIdx.x == 0) (void)xb_add(&bar[XB_XCNT(b.x)], 1u);
    return b;
}
__device__ __forceinline__ void xcd_barrier_complete(unsigned* bar, unsigned x, unsigned& nloc, unsigned& nx) {
    const unsigned G = gridDim.x * gridDim.y * gridDim.z;
    unsigned sum, cnt, mine, sp = 0u;
    for (;;) {
        sum = 0u; cnt = 0u; mine = 0u;
#pragma unroll
        for (unsigned j = 0; j < 16; ++j) { const unsigned c = xb_ld(&bar[XB_XCNT(j)]); sum += c; cnt += (c > 0u) ? 1u : 0u; mine = (j == x) ? c : mine; }
        if (sum == G) break;
        __builtin_amdgcn_s_sleep(1);
        if ((++sp & 255u) == 0u) { if (xb_ld(&bar[XB_TMO])) break; if (sp > XB_SPIN_CAP) { atomicAdd(&bar[XB_TMO], 1u); break; } }
    }
    nloc = mine > 0u ? mine : 1u; nx = cnt > 0u ? cnt : 1u;
}
__device__ __forceinline__ void xcd_barrier(const XcdBarrier& b, const bool leader  ) {
    asm volatile("s_waitcnt vmcnt(0)" ::: "memory");
    __syncthreads();
    if (leader) {
        unsigned* bar = b.bar;
        __builtin_amdgcn_s_waitcnt(0);
        unsigned nloc = b.st[0], nx = b.st[1];
        if (nloc == 0u) { xcd_barrier_complete(bar, b.x, nloc, nx); b.st[0] = nloc; b.st[1] = nx; }
        const unsigned old = xb_add(&bar[XB_XSUB(b.x)], 1u);
        const unsigned gen = old / nloc;
        if (old + 1u == (gen + 1u) * nloc) {
            __builtin_amdgcn_fence(__ATOMIC_RELEASE, "agent");
            asm volatile("s_waitcnt vmcnt(0)" ::: "memory");
            const unsigned og = xb_add(&bar[XB_TOP], 1u);
            const unsigned tg = og / nx;
            if (og + 1u == (tg + 1u) * nx) xb_add(&bar[XB_TOPGEN], 1u);
            else XB_SPIN(xb_ld(&bar[XB_TOPGEN]) == tg, bar);
            __builtin_amdgcn_fence(__ATOMIC_ACQUIRE, "agent");
            xb_add(&bar[XB_XGEN(b.x)], 1u);
            asm volatile("s_waitcnt vmcnt(0)" ::: "memory");
        } else {
            XB_SPIN(xb_ld(&bar[XB_XGEN(b.x)]) == gen, bar);
            __builtin_amdgcn_fence(__ATOMIC_ACQUIRE, "agent");
            asm volatile("s_waitcnt vmcnt(0)" ::: "memory");
        }
    }
    __syncthreads();
}

namespace g8 {
constexpr int BM = 256, BK = 64, HALF = 128, HTB = HALF * BK * 2, STAGE_BYTES = 8 * HTB, NXCD = 8, WGM = 8;
__device__ __forceinline__ int lds_byte(int r, int c) { const int st = (r >> 4) * 2 + (c >> 5), rr = r & 15, cc = c & 31, ob = rr * 64 + cc * 2; return st * 1024 + (ob ^ (((ob >> 9) & 1) << 5)); }
__device__ __forceinline__ void stage_rc(int b, int& R, int& C) { const int st = b / 1024, sb = b % 1024, swz = sb ^ (((sb >> 9) & 1) << 5); R = (st >> 1) * 16 + swz / 64; C = (st & 1) * 32 + (swz % 64) / 2; }
__device__ __forceinline__ int perm32(int rho) { const int n = rho >> 4, i = rho & 15; return 8 * (i >> 2) + 4 * n + (i & 3); }

struct Unit { const char* A; const char* B; int pm, pn, aux; };

struct DenseOrder {
    const char* A; const char* Bt; int nM, nN, nwg, G, c, K, tid0;
    __device__ void init(const void* A_, const void* Bt_, int M, int N, int K_, int G_, int c_) { A = (const char*)A_; Bt = (const char*)Bt_; nM = M / BM; nN = N / BM; nwg = nM * nN; G = G_; c = c_; K = K_; }
    __device__ __forceinline__ bool next(int i, Unit& u) const {
        const long L = (long)i * G + c; if (L >= nwg) return false;
        int wgid = (int)L; { const int q = nwg / NXCD, r = nwg % NXCD, xcd = wgid % NXCD, off = wgid / NXCD; wgid = (xcd < r ? xcd * (q + 1) : r * (q + 1) + (xcd - r) * q) + off; }
        const int nig = WGM * nN, gid = wgid / nig, fm = gid * WGM, gsz = (nM - fm) < WGM ? (nM - fm) : WGM;
        u.pm = fm + ((wgid % nig) % gsz); u.pn = (wgid % nig) / gsz; u.aux = 0;
        u.A = A + (size_t)u.pm * BM * K * 2; u.B = Bt + (size_t)u.pn * BM * K * 2; return true;
    }
    __device__ __forceinline__ void aoff(const Unit&, int tid, unsigned (&o)[2][2]) const {
#pragma unroll
        for (int i = 0; i < 2; ++i) { int R, C; stage_rc(tid * 16 + i * 8192, R, C);
            o[0][i] = (unsigned)(R * K + C) * 2u; o[1][i] = (unsigned)((R + HALF) * K + C) * 2u; }
    }
};

__device__ __forceinline__ unsigned cvt_pk_bf16(float lo, float hi) { unsigned r; asm volatile("v_cvt_pk_bf16_f32 %0, %1, %2" : "=v"(r) : "v"(lo), "v"(hi)); return r; }

struct EpiF32 {
    static constexpr bool PERM = false;
    float* C; int ldc; const float* bias;
    __device__ __forceinline__ void operator()(const f32x4 (&acc)[2][2][4][2], const Unit& u, int wr, int wc, int fr, int fq) const {
        const int row0 = u.pm * BM + wr * 64 + fr, col0 = u.pn * BM + wc * 32 + 4 * fq;
        f32x4 bv[2][2];
#pragma unroll
        for (int bj = 0; bj < 2; ++bj)
#pragma unroll
            for (int n = 0; n < 2; ++n) bv[bj][n] = bias ? *(const f32x4*)(bias + col0 + bj * HALF + n * 16) : (f32x4){0.f, 0.f, 0.f, 0.f};
#pragma unroll
        for (int ai = 0; ai < 2; ++ai)
#pragma unroll
            for (int m = 0; m < 4; ++m) { float* rowp = C + (size_t)(row0 + ai * HALF + m * 16) * ldc + col0;
#pragma unroll
                for (int bj = 0; bj < 2; ++bj)
#pragma unroll
                    for (int n = 0; n < 2; ++n) *(f32x4*)(rowp + bj * HALF + n * 16) = acc[ai][bj][m][n] + bv[bj][n]; }
    }
};

struct EpiBf16 {
    static constexpr bool PERM = true;
    bf16_t* O; int ldc; const float* bias;
    __device__ __forceinline__ void operator()(const f32x4 (&acc)[2][2][4][2], const Unit& u, int wr, int wc, int fr, int fq) const {
        const int row0 = u.pm * BM + wr * 64 + fr, col0 = u.pn * BM + wc * 32 + 8 * fq;
        f32x4 bv[2][2];
#pragma unroll
        for (int bj = 0; bj < 2; ++bj)
#pragma unroll
            for (int n = 0; n < 2; ++n) bv[bj][n] = *(const f32x4*)(bias + col0 + bj * HALF + 4 * n);
#pragma unroll
        for (int ai = 0; ai < 2; ++ai)
#pragma unroll
            for (int m = 0; m < 4; ++m) { bf16_t* rowp = O + (size_t)(row0 + ai * HALF + m * 16) * ldc + col0;
#pragma unroll
                for (int bj = 0; bj < 2; ++bj) { const f32x4 v0 = acc[ai][bj][m][0] + bv[bj][0], v1 = acc[ai][bj][m][1] + bv[bj][1];
                    u32x4 w; w[0] = cvt_pk_bf16(v0[0], v0[1]); w[1] = cvt_pk_bf16(v0[2], v0[3]); w[2] = cvt_pk_bf16(v1[0], v1[1]); w[3] = cvt_pk_bf16(v1[2], v1[3]);
                    *(u32x4*)(rowp + bj * HALF) = w; } }
    }
};

template <class Epi, class Sched>
__device__ __forceinline__ void gemm_phase(LAS unsigned char* lds, const int K, const Sched& S, const Epi& E) {
    int tid_ = S.tid0; asm volatile("" : "+v"(tid_));
    const int tid = tid_, wid = __builtin_amdgcn_readfirstlane(tid >> 6), lane = tid & 63, wr = wid >> 2, wc = wid & 3, fr = lane & 15, fq = lane >> 4;
    const int nt = K / BK;
    unsigned voffB[2];
#pragma unroll
    for (int i = 0; i < 2; ++i) { int R, C; stage_rc(tid * 16 + i * 8192, R, C); const int Rb = Epi::PERM ? ((R & ~31) + perm32(R & 31)) : R;
        voffB[i] = (unsigned)(Rb * K + C) * 2u; }
    const size_t kstep = (size_t)(BK * 2);
    const size_t hstep = (size_t)HALF * K * 2;
    const unsigned ldsw = (unsigned)wid * 1024u;
    const int aoff = lds_byte(wr * 64 + fr, fq * 8), boff = lds_byte(wc * 32 + fr, fq * 8);
#define G8_SA(b, h) (((b) * 2 + (h)) * HTB)
#define G8_SB(b, h) ((4 + (b) * 2 + (h)) * HTB)
#define G8_STAGE(bufoff, gbase, voff) do { _Pragma("unroll") for (int _i = 0; _i < 2; ++_i) \
        __builtin_amdgcn_global_load_lds((const unsigned*)((const char*)(gbase) + (voff)[_i]), (LAS unsigned*)(lds + (bufoff) + ldsw + _i * 8192), 16, 0, 0); } while (0)
#define G8_LDA(dst, b, h) do { _Pragma("unroll") for (int m = 0; m < 4; ++m) _Pragma("unroll") for (int k = 0; k < 2; ++k) dst[m][k] = *(const LAS bf16x8*)(lds + G8_SA(b, h) + aoff + m * 2048 + k * 1024); } while (0)
#define G8_LDB(dst, b, h) do { _Pragma("unroll") for (int n = 0; n < 2; ++n) _Pragma("unroll") for (int k = 0; k < 2; ++k) dst[n][k] = *(const LAS bf16x8*)(lds + G8_SB(b, h) + boff + n * 2048 + k * 1024); } while (0)
#define G8_MMA(ai, bj, At, Bt) do { __builtin_amdgcn_s_setprio(1); _Pragma("unroll") for (int m = 0; m < 4; ++m) _Pragma("unroll") for (int n = 0; n < 2; ++n) _Pragma("unroll") for (int k = 0; k < 2; ++k) \
        acc[ai][bj][m][n] = __builtin_amdgcn_mfma_f32_16x16x32_bf16(Bt[n][k], At[m][k], acc[ai][bj][m][n], 0, 0, 0); __builtin_amdgcn_s_setprio(0); } while (0)
#define G8_WAIT_V(n) asm volatile("s_waitcnt vmcnt(" #n ")" ::: "memory")
#define G8_WAIT_L(n) asm volatile("s_waitcnt lgkmcnt(" #n ")" ::: "memory")
#define G8_BAR __builtin_amdgcn_s_barrier()
#define G8_SCHED __builtin_amdgcn_sched_barrier(0)
    Unit cur, nxt; int ui = 0;
    if (!S.next(0, cur)) return;
    f32x4 acc[2][2][4][2];
#pragma unroll
    for (int a = 0; a < 2; ++a)
#pragma unroll
        for (int b = 0; b < 2; ++b)
#pragma unroll
            for (int m = 0; m < 4; ++m)
#pragma unroll
                for (int n = 0; n < 2; ++n) acc[a][b][m][n] = (f32x4){0.f, 0.f, 0.f, 0.f};
    bf16x8 At[4][2], B0[2][2], B1[2][2];
    unsigned oc[2][2];
    S.aoff(cur, tid, oc);
    const char* cA = cur.A; const char* cB = cur.B;
    G8_STAGE(G8_SB(0, 0), cB, voffB); G8_STAGE(G8_SA(0, 0), cA, oc[0]); G8_STAGE(G8_SB(0, 1), cB + hstep, voffB); G8_STAGE(G8_SA(0, 1), cA, oc[1]);
    if (wr == 1) G8_BAR;
    G8_WAIT_V(4); G8_BAR;
    G8_STAGE(G8_SB(1, 0), cB + kstep, voffB); G8_STAGE(G8_SA(1, 0), cA + kstep, oc[0]); G8_STAGE(G8_SB(1, 1), cB + hstep + kstep, voffB);
    G8_WAIT_V(6); G8_BAR;
    for (;;) {
        const bool has_next = S.next(ui + 1, nxt);
        const char* nA = has_next ? nxt.A : cA; const char* nB = has_next ? nxt.B : cB;
#pragma unroll 1
        for (int t = 0; t < nt; t += 2) {
            const bool last = (t == nt - 2);
            const char* a1 = cA + (size_t)(t + 1) * kstep;
            const char* a2 = last ? nA : cA + (size_t)(t + 2) * kstep; const char* b2 = last ? nB : cB + (size_t)(t + 2) * kstep;
            const char* a3 = a2 + kstep; const char* b3 = b2 + kstep;
            G8_LDB(B0, 0, 0); G8_SCHED; G8_LDA(At, 0, 0); G8_STAGE(G8_SA(1, 1), a1, oc[1]);
            if (last && has_next) S.aoff(nxt, tid, oc);
            G8_WAIT_L(8); G8_BAR; G8_WAIT_L(0); G8_MMA(0, 0, At, B0); G8_BAR; G8_SCHED;
            G8_LDB(B1, 0, 1); G8_STAGE(G8_SB(0, 0), b2, voffB);
            G8_BAR; G8_WAIT_L(0); G8_MMA(0, 1, At, B1); G8_BAR;
            G8_LDA(At, 0, 1); G8_STAGE(G8_SA(0, 0), a2, oc[0]);
            G8_BAR; G8_WAIT_L(0); G8_MMA(1, 0, At, B0); G8_BAR; G8_SCHED;
            G8_STAGE(G8_SB(0, 1), b2 + hstep, voffB);
            G8_WAIT_V(6); G8_BAR; G8_MMA(1, 1, At, B1); G8_BAR;
            G8_LDB(B0, 1, 0); G8_SCHED; G8_LDA(At, 1, 0); G8_STAGE(G8_SA(0, 1), a2, oc[1]);
            G8_WAIT_L(8); G8_BAR; G8_WAIT_L(0); G8_MMA(0, 0, At, B0); G8_BAR; G8_SCHED;
            G8_LDB(B1, 1, 1); G8_STAGE(G8_SB(1, 0), b3, voffB);
            G8_BAR; G8_WAIT_L(0); G8_MMA(0, 1, At, B1); G8_BAR;
            G8_LDA(At, 1, 1); G8_STAGE(G8_SA(1, 0), a3, oc[0]);
            G8_BAR; G8_WAIT_L(0); G8_MMA(1, 0, At, B0); G8_BAR; G8_SCHED;
            G8_STAGE(G8_SB(1, 1), b3 + hstep, voffB);
            G8_WAIT_V(6); G8_BAR; G8_MMA(1, 1, At, B1); G8_BAR;
        }
        E(acc, cur, wr, wc, fr, fq);
        if (!has_next) break;
#pragma unroll
        for (int a = 0; a < 2; ++a)
#pragma unroll
            for (int b = 0; b < 2; ++b)
#pragma unroll
                for (int m = 0; m < 4; ++m)
#pragma unroll
                    for (int n = 0; n < 2; ++n) acc[a][b][m][n] = (f32x4){0.f, 0.f, 0.f, 0.f};
        cur = nxt; cA = nA; cB = nB; ++ui;
    }
    G8_WAIT_V(0);
    if (wr == 0) G8_BAR;
    G8_BAR;
#undef G8_SA
#undef G8_SB
#undef G8_STAGE
#undef G8_LDA
#undef G8_LDB
#undef G8_MMA
#undef G8_WAIT_V
#undef G8_WAIT_L
#undef G8_BAR
#undef G8_SCHED
}
}

constexpr int NTHREADS = 512;
constexpr int LDS_STAGE = 0;
constexpr int LDS_TAB   = g8::STAGE_BYTES;
constexpr int TAB_SLOTS = 6;
constexpr int LDS_GTAB  = LDS_TAB + TAB_SLOTS * 256 * 4;
constexpr int LDS_DESC  = LDS_GTAB + TAB_SLOTS * 256 * 4;
constexpr int LDS_PREF  = LDS_DESC + 64;
constexpr int LDS_MISC  = LDS_PREF + 132 * 4 + 48;
constexpr int LDS_BYTES = 147456;
static_assert(LDS_MISC % 16 == 0 && LDS_MISC + 64 <= LDS_BYTES, "LDS map");

#define GAS __attribute__((address_space(1)))
struct Params { const GAS float* in[31]; GAS float* out; GAS unsigned char* ws; int ph_lo, ph_hi; };

struct Ctx {
    const GAS float* const* in; float* out; unsigned char* ws; LAS unsigned char* lds;
    __device__ __forceinline__ const float* inp(int k) const { return (const float*)in[k]; }
    int tid, lane, wid, bid, G, gtid, gthreads, gw, nwaves;
};

__device__ __forceinline__ int ab_phys(int n) {
    if (n < 1024) { const int hd = n >> 6, jj = n & 63; return (hd >> 2) * 256 + (jj >> 5) * 128 + (hd & 3) * 32 + (jj & 31); }
    if (n < 1152) { const int nn = n - 1024, hh = nn >> 6, jj = nn & 63; return 1024 + (jj >> 5) * 128 + hh * 32 + (jj & 31); }
    if (n < 1280) { const int vv = n - 1152; return 1024 + (vv >> 6) * 128 + 64 + (vv & 63); }
    if (n < 2304) { const int base = n < 1792 ? 1280 : 1792, nn = n - base, h = nn >> 7, jj = nn & 127; return base + (h >> 1) * 256 + (jj >> 6) * 128 + (h & 1) * 64 + (jj & 63); }
    return n;
}
template <int TN, class DstFn>
__device__ __forceinline__ void convert_T(const Ctx& c, const float* src, int nmat, int K, int N, DstFn dstfn) {
    LAS float* tile = (LAS float*)(c.lds);
    constexpr int LDT = TN + 1, TPR = TN / 4  , KPI = NTHREADS / TPR  , NI = 64 / KPI, KPT = 64 * TN / NTHREADS  ;
    const int tk = K / 64, tn = N / TN; const long ntiles = (long)nmat * tk * tn;
    for (long tix = c.bid; tix < ntiles; tix += c.G) {
        const int m = (int)(tix / (tk * tn)); const int rem = (int)(tix % (tk * tn)); const int kt = rem / tn, nt = rem % tn;
        const float* s = src + (size_t)m * K * N + (size_t)(kt * 64) * N + nt * TN;
        f32x4 v[NI];
#pragma unroll
        for (int i = 0; i < NI; ++i) { const int k = c.tid / TPR + KPI * i, n4 = (c.tid % TPR) * 4; v[i] = __builtin_nontemporal_load((const f32x4*)(s + (size_t)k * N + n4)); }
#pragma unroll
        for (int i = 0; i < NI; ++i) { const int k = c.tid / TPR + KPI * i, n4 = (c.tid % TPR) * 4;
            tile[k * LDT + n4 + 0] = v[i][0]; tile[k * LDT + n4 + 1] = v[i][1]; tile[k * LDT + n4 + 2] = v[i][2]; tile[k * LDT + n4 + 3] = v[i][3]; }
        __syncthreads();
        { constexpr int TPN = 64 / KPT; const int n = c.tid / TPN, k0 = (c.tid % TPN) * KPT;
          bf16_t* d = dstfn(m, nt * TN + n) + kt * 64 + k0;
#pragma unroll
          for (int q = 0; q < KPT / 8; ++q) { u32x4 w;
#pragma unroll
              for (int e = 0; e < 4; ++e) w[e] = pk2(tile[(k0 + q * 8 + 2 * e) * LDT + n], tile[(k0 + q * 8 + 2 * e + 1) * LDT + n]);
              *(u32x4*)(d + q * 8) = w; } }
        __syncthreads();
    }
}

__device__ __forceinline__ void phase_convert(const Ctx& c) {
    unsigned char* ws = c.ws;
    { const float* x = c.inp(0); bf16_t* xb = (bf16_t*)(ws + WS_XB);
      for (long i = c.gtid; i < (long)T * D / 4; i += c.gthreads) { const f32x4 v = *(const f32x4*)(x + i * 4); u32x2 w; w[0] = pk2(v[0], v[1]); w[1] = pk2(v[2], v[3]); *(u32x2*)(xb + i * 4) = w; } }
    { bf16_t* wrt = (bf16_t*)(ws + WS_WRT); for (long i = c.gtid; i < (long)4 * 128 * D / 8; i += c.gthreads) { const long l = i / (128 * D / 8), r = i % (128 * D / 8); *(u32x4*)(wrt + (size_t)l * 256 * D + (size_t)128 * D + r * 8) = (u32x4){0u, 0u, 0u, 0u}; }
      float* gate = (float*)(ws + WS_GATE); for (int i = c.gtid; i < T; i += c.gthreads) gate[TK + i] = 1.f;
      f32x2* ra = (f32x2*)(ws + WS_ROPEA); f32x2* rr = (f32x2*)(ws + WS_ROPER);
      for (int i = c.gtid; i < SEQ * 96; i += c.gthreads) { const int sidx = i / 96, q = i % 96; const bool isA = q < 32; const int jx = isA ? q : q - 32;
          const float e = isA ? (float)jx * (1.f / 32.f) : (float)jx * (1.f / 63.f); const float ang = (float)sidx * exp2f(-e * 13.287712379549449f); float sn, cs; sincosf(ang, &sn, &cs);
          if (isA) ra[sidx * 32 + jx] = (f32x2){cs, sn}; else rr[sidx * 64 + jx] = (f32x2){cs, sn}; }
      float* bp = (float*)(ws + WS_BIASP); for (int i = c.gtid; i < 2 * AB_IN; i += c.gthreads) { const int m = i / AB_IN, n = i % AB_IN; bp[m * AB_IN + ab_phys(n)] = c.inp(2)[i]; } }
    { bf16_t* d = (bf16_t*)(ws + WS_WABIN);  convert_T<256>(c, c.inp(1), 2, D, AB_IN, [=](int m, int n) { return d + (size_t)m * AB_IN * D + (size_t)ab_phys(n) * D; }); }
    { bf16_t* d = (bf16_t*)(ws + WS_WABOUT); convert_T<256>(c, c.inp(4), 2, AB_OUT, D, [=](int m, int n) { return d + (size_t)m * D * AB_OUT + (size_t)n * AB_OUT; }); }
    { bf16_t* d = (bf16_t*)(ws + WS_WCDIN);  convert_T<256>(c, c.inp(6), 2, D, CD_IN, [=](int m, int n) { return d + (size_t)m * CD_IN * D + (size_t)n * D; }); }
    { bf16_t* d = (bf16_t*)(ws + WS_WCDOUT); convert_T<256>(c, c.inp(17), 2, CD_OUT, D, [=](int m, int n) { return d + (size_t)m * D * CD_OUT + (size_t)n * CD_OUT; }); }
    { bf16_t* d = (bf16_t*)(ws + WS_WRT);    convert_T<128>(c, c.inp(21), 4, D, NE, [=](int m, int n) { return d + (size_t)m * 256 * D + (size_t)n * D; }); }
    { bf16_t* d = (bf16_t*)(ws + WS_WGU);
      convert_T<256>(c, c.inp(23), 4 * NE, D, ED, [=](int m, int n) { return d + (size_t)((m >> 7) * NE1 + (m & 127)) * 512 * D + (size_t)((n >> 7) * 256 + (n & 127)) * D; });
      convert_T<256>(c, c.inp(24), 4 * NE, D, ED, [=](int m, int n) { return d + (size_t)((m >> 7) * NE1 + (m & 127)) * 512 * D + (size_t)((n >> 7) * 256 + 128 + (n & 127)) * D; });
      convert_T<256>(c, c.inp(26), 4, D, ED, [=](int m, int n) { return d + (size_t)(m * NE1 + NE) * 512 * D + (size_t)((n >> 7) * 256 + (n & 127)) * D; });
      convert_T<256>(c, c.inp(27), 4, D, ED, [=](int m, int n) { return d + (size_t)(m * NE1 + NE) * 512 * D + (size_t)((n >> 7) * 256 + 128 + (n & 127)) * D; }); }
    { bf16_t* d = (bf16_t*)(ws + WS_WLRU);
      convert_T<256>(c, c.inp(12), 10, 256, 256, [=](int m, int n) { return d + (size_t)(m * 2 + 0) * 65536 + (size_t)n * 256; });
      convert_T<256>(c, c.inp(14), 10, 256, 256, [=](int m, int n) { return d + (size_t)(m * 2 + 1) * 65536 + (size_t)n * 256; });
      float* spl = (float*)(ws + WS_SPL); for (int i = c.gtid; i < 2 * 1280; i += c.gthreads) spl[i] = log1pf(expf(-c.inp(16)[i])); }
    { bf16_t* d = (bf16_t*)(ws + WS_WDN);
      convert_T<256>(c, c.inp(25), 4 * NE, ED, D, [=](int m, int n) { return d + (size_t)((m >> 7) * NE1 + (m & 127)) * D * ED + (size_t)n * ED; });
      convert_T<256>(c, c.inp(28), 4, ED, D, [=](int m, int n) { return d + (size_t)(m * NE1 + NE) * D * ED + (size_t)n * ED; }); }
}

__device__ __forceinline__ void phase_dense(const Ctx& c, const bf16_t* A, const bf16_t* Bt, int M, int N, int K, bf16_t* C, int ldc, const float* bias) {
    g8::DenseOrder S; S.init(A, Bt, M, N, K, c.G, c.bid); S.tid0 = c.tid;
    g8::EpiBf16 E{C, ldc, bias};
    g8::gemm_phase<g8::EpiBf16, g8::DenseOrder>(c.lds + LDS_STAGE, K, S, E);
}

struct EpiABIn {
    static constexpr bool PERM = true;
    LAS bf16_t* biasL; unsigned char* ws;
    __device__ __forceinline__ void operator()(const f32x4 (&acc)[2][2][4][2], const g8::Unit& u, int wr, int wc, int fr_, int fq_) const {
        int fr = fr_, fq = fq_; asm volatile("" : "+v"(fr), "+v"(fq));
        const int pn = u.pn; const int colp = pn * 256 + wc * 32 + fq * 8;
        bf16_t* qb = (bf16_t*)(ws + AB_QB); bf16_t* kb = (bf16_t*)(ws + AB_KB); bf16_t* vT = (bf16_t*)(ws + AB_VT); bf16_t* rqb = (bf16_t*)(ws + AB_RQB); bf16_t* rkb = (bf16_t*)(ws + AB_RKB);
        bf16_t* rkdT = (bf16_t*)(ws + AB_RKDT); bf16_t* rvT = (bf16_t*)(ws + AB_RVT); bf16_t* rgb = (bf16_t*)(ws + AB_RGB);
        const float frqA0 = exp2f(-(float)(fq * 8) * (13.287712379549449f / 32.f)) * 0.15915494309189535f;
        const float frqR0 = exp2f(-(float)((wc & 1) * 32 + fq * 8) * (13.287712379549449f / 63.f)) * 0.15915494309189535f;
        constexpr float RA[8] = {1.f, 0.7498942093324559f, 0.5623413251903491f, 0.4216965034285822f, 0.31622776601683794f, 0.23713737056616552f, 0.1778279410038923f, 0.1333521432163324f};
        constexpr float RR[8] = {1.f, 0.8639884494839686f, 0.746476040841712f, 0.6449466771037624f, 0.5572264795507174f, 0.4814372420784346f, 0.4159562163071847f, 0.35938136638046275f};
#pragma unroll
        for (int ai = 0; ai < 2; ++ai)
#pragma unroll
            for (int m = 0; m < 4; ++m) {
                const int t = u.pm * 256 + ai * 128 + wr * 64 + m * 16 + fr, sq = t & (SEQ - 1), b = t >> 13;
                f32x4 x[2][2];
#pragma unroll
                for (int bj = 0; bj < 2; ++bj)
#pragma unroll
                    for (int n = 0; n < 2; ++n) { const u32x2 bw = *(const LAS u32x2*)(biasL + colp + bj * 128 + 4 * n);
                        x[bj][n] = acc[ai][bj][m][n] + (f32x4){__uint_as_float(bw[0] << 16), __uint_as_float(bw[0] & 0xffff0000u), __uint_as_float(bw[1] << 16), __uint_as_float(bw[1] & 0xffff0000u)}; }
                if (pn < 4 || (pn == 4 && wc < 2)) {
                    const int j0 = fq * 8; const float sc = pn < 4 ? 0.125f : 1.f;
                    u32x4 w1, w2;
#pragma unroll
                    for (int n = 0; n < 2; ++n) { f32x4 o1, o2;
#pragma unroll
                        for (int e = 0; e < 4; ++e) { const float rev = __builtin_amdgcn_fractf((float)sq * (frqA0 * RA[4 * n + e])); const float cc = __builtin_amdgcn_cosf(rev) * sc, ss = __builtin_amdgcn_sinf(rev) * sc;
                            o1[e] = x[0][n][e] * cc - x[1][n][e] * ss; o2[e] = x[1][n][e] * cc + x[0][n][e] * ss; }
                        w1[2 * n] = pk2(o1[0], o1[1]); w1[2 * n + 1] = pk2(o1[2], o1[3]); w2[2 * n] = pk2(o2[0], o2[1]); w2[2 * n + 1] = pk2(o2[2], o2[3]); }
                    bf16_t* dst = pn < 4 ? qb + (size_t)t * 1024 + (pn * 4 + wc) * 64 + j0 : kb + (size_t)t * 128 + wc * 64 + j0;
                    *(u32x4*)dst = w1; *(u32x4*)(dst + 32) = w2;
                } else if (pn == 4) {
                    const int d0 = (wc - 2) * 32 + fq * 8;
#pragma unroll
                    for (int bj = 0; bj < 2; ++bj)
#pragma unroll
                        for (int n = 0; n < 2; ++n)
#pragma unroll
                            for (int e = 0; e < 4; ++e) vT[((size_t)(b * 2 + bj) * 64 + d0 + 4 * n + e) * SEQ + sq] = f2bf(x[bj][n][e]);
                } else if (pn < 9) {
                    const bool isk = pn >= 7; const int h = ((pn - 5) & 1) * 2 + (wc >> 1), j0 = (wc & 1) * 32 + fq * 8;
                    const float sc = isk ? 0.08838834764831845f : 1.f;
                    bf16_t* dT = rkdT + ((size_t)(b * 4 + h) * 128 + j0) * SEQ + sq;
                    u32x4 w1, w2;
#pragma unroll
                    for (int n = 0; n < 2; ++n) { f32x4 o1, o2;
#pragma unroll
                        for (int e = 0; e < 4; ++e) { const float rev = __builtin_amdgcn_fractf((float)sq * (frqR0 * RR[4 * n + e])); const float cc = __builtin_amdgcn_cosf(rev) * sc, ss = __builtin_amdgcn_sinf(rev) * sc;
                            o1[e] = x[0][n][e] * cc - x[1][n][e] * ss; o2[e] = x[1][n][e] * cc + x[0][n][e] * ss; }
                        w1[2 * n] = pk2(o1[0], o1[1]); w1[2 * n + 1] = pk2(o1[2], o1[3]); w2[2 * n] = pk2(o2[0], o2[1]); w2[2 * n + 1] = pk2(o2[2], o2[3]);
                        if (isk) {
#pragma unroll
                            for (int e = 0; e < 4; ++e) { dT[(size_t)(4 * n + e) * SEQ] = f2bf(o1[e]); dT[(size_t)(64 + 4 * n + e) * SEQ] = f2bf(o2[e]); } } }
                    bf16_t* dst = (isk ? rkb : rqb) + (size_t)t * 512 + h * 128 + j0;
                    *(u32x4*)dst = w1; *(u32x4*)(dst + 64) = w2;
                } else if (pn < 13) {
                    const int h = pn - 9;
#pragma unroll
                    for (int bj = 0; bj < 2; ++bj)
#pragma unroll
                        for (int n = 0; n < 2; ++n)
#pragma unroll
                            for (int e = 0; e < 4; ++e) rvT[((size_t)(b * 4 + h) * 256 + bj * 128 + wc * 32 + fq * 8 + 4 * n + e) * SEQ + sq] = f2bf(x[bj][n][e]);
                } else {
#pragma unroll
                    for (int bj = 0; bj < 2; ++bj) { u32x4 w;
#pragma unroll
                        for (int n = 0; n < 2; ++n) { w[2 * n] = pk2(siluf_(x[bj][n][0]), siluf_(x[bj][n][1])); w[2 * n + 1] = pk2(siluf_(x[bj][n][2]), siluf_(x[bj][n][3])); }
                        *(u32x4*)(rgb + (size_t)t * 1024 + (pn - 13) * 256 + bj * 128 + wc * 32 + fq * 8) = w; }
                }
            }
    }
};
__device__ __forceinline__ void phase_ab_inproj(const Ctx& c, int j) {
    g8::DenseOrder S; S.init(c.ws + WS_XB, c.ws + WS_WABIN + (size_t)j * AB_IN * D * 2, T, AB_IN, D, c.G, c.bid); S.tid0 = c.tid;
    LAS bf16_t* biasL = (LAS bf16_t*)(c.lds + LDS_TAB);
    { const float* bp = (const float*)(c.ws + WS_BIASP) + (size_t)j * AB_IN; for (int i = c.tid; i < AB_IN; i += NTHREADS) biasL[i] = f2bf(bp[i]); }
    __syncthreads();
    EpiABIn E{biasL, c.ws};
    g8::gemm_phase<EpiABIn, g8::DenseOrder>(c.lds + LDS_STAGE, D, S, E);
}

#define MFMA16(a, b, c) __builtin_amdgcn_mfma_f32_16x16x32_bf16((a), (b), (c), 0, 0, 0)
__device__ __forceinline__ bf16x8 pack8(const f32x4& lo, const f32x4& hi) { u32x4 w; w[0] = g8::cvt_pk_bf16(lo[0], lo[1]); w[1] = g8::cvt_pk_bf16(lo[2], lo[3]); w[2] = g8::cvt_pk_bf16(hi[0], hi[1]); w[3] = g8::cvt_pk_bf16(hi[2], hi[3]); return __builtin_bit_cast(bf16x8, w); }
__device__ __forceinline__ bf16x8 cat8(const u32x2& lo, const u32x2& hi) { u32x4 w; w[0] = lo[0]; w[1] = lo[1]; w[2] = hi[0]; w[3] = hi[1]; return __builtin_bit_cast(bf16x8, w); }
template <int ROWS, int RB>
__device__ __forceinline__ void tile_g2l(LAS unsigned char* dst, const unsigned char* src, size_t gs, int tid, int zrows = 0) {
    constexpr int CPR = RB / 16, TOTAL = ROWS * CPR;
#pragma unroll 8
    for (int i = tid; i < TOTAL; i += NTHREADS) { const int r = i / CPR, cc = i % CPR; u32x4 v = (u32x4){0u, 0u, 0u, 0u}; if (r >= zrows) v = *(const u32x4*)(src + (size_t)r * gs + cc * 16);
        *(LAS u32x4*)(dst + r * (RB + 16) + cc * 16) = v; }
}

__device__ __forceinline__ void attn_unit(const Ctx& c, int unit, const float* sinks) {
    const int b = unit >> 7, n = (unit >> 1) & 63, kvh = unit & 1, hd = kvh * 8 + c.wid, lane = c.lane, fr = lane & 15, fq = lane >> 4;
    const bf16_t* qb = (const bf16_t*)(c.ws + AB_QB); const bf16_t* kb = (const bf16_t*)(c.ws + AB_KB); const bf16_t* vT = (const bf16_t*)(c.ws + AB_VT); bf16_t* ycat = (bf16_t*)(c.ws + WS_YCAT);
    LAS unsigned char* Ks = c.lds; LAS unsigned char* Vs = c.lds + 256 * 144;
    const int t0 = b * SEQ + n * 128;
    __syncthreads();
    {
        const unsigned char* src = (const unsigned char*)(kb + (size_t)(t0 - 128) * 128 + kvh * 64);
        constexpr int TOTAL = 256 * 8;
#pragma unroll 4
        for (int i = c.tid; i < TOTAL; i += NTHREADS) { const int r = i >> 3, cc = i & 7; u32x4 v = (u32x4){0u, 0u, 0u, 0u}; if (n > 0 || r >= 128) v = *(const u32x4*)(src + (ptrdiff_t)r * 256 + cc * 16);
            *(LAS u32x4*)(Ks + r * 144 + cc * 16) = v; }
        const unsigned char* vsrc = (const unsigned char*)(vT + (size_t)(b * 2 + kvh) * 64 * SEQ + (n * 128 - 128));
        constexpr int TV = 64 * 32;
#pragma unroll 4
        for (int i = c.tid; i < TV; i += NTHREADS) { const int r = i >> 5, cc = i & 31; u32x4 v = (u32x4){0u, 0u, 0u, 0u}; if (n > 0 || cc >= 16) v = *(const u32x4*)(vsrc + (ptrdiff_t)r * SEQ * 2 + cc * 16);
            *(LAS u32x4*)(Vs + r * 528 + cc * 16) = v; }
    }
    __syncthreads();
    const float sink = sinks[hd];
    bf16x8 qn[2];
#pragma unroll
    for (int ks = 0; ks < 2; ++ks) qn[ks] = *(const bf16x8*)(qb + (size_t)(t0 + fr) * 1024 + hd * 64 + ks * 32 + fq * 8);
    for (int si = 0; si < 8; ++si) {
        const int t = t0 + si * 16 + fr;
        bf16x8 qf[2]; qf[0] = qn[0]; qf[1] = qn[1];
        if (si < 7) {
#pragma unroll
            for (int ks = 0; ks < 2; ++ks) qn[ks] = *(const bf16x8*)(qb + (size_t)(t + 16) * 1024 + hd * 64 + ks * 32 + fq * 8); }
        f32x4 S[10];
#pragma unroll
        for (int nk = 0; nk < 9; ++nk) { S[nk] = (f32x4){0.f, 0.f, 0.f, 0.f};
#pragma unroll
            for (int ks = 0; ks < 2; ++ks) { const bf16x8 a = *(const LAS bf16x8*)(Ks + (16 * (si + nk) + fr) * 144 + ks * 64 + fq * 16); S[nk] = MFMA16(a, qf[ks], S[nk]); } }
        S[9] = (f32x4){0.f, 0.f, 0.f, 0.f};
        const int i = si * 16 + fr;
        float mx = sink;
#pragma unroll
        for (int nk = 0; nk < 9; ++nk)
#pragma unroll
            for (int r = 0; r < 4; ++r) { const int p = 16 * (si + nk) + 4 * fq + r; const bool ok = (p >= i + 1) && (p <= i + 128) && (n > 0 || p >= 128);
                S[nk][r] = ok ? S[nk][r] : -1e30f; mx = fmaxf(mx, S[nk][r]); }
        mx = fmaxf(mx, __shfl_xor(mx, 16)); mx = fmaxf(mx, __shfl_xor(mx, 32));
        float sum = 0.f;
#pragma unroll
        for (int nk = 0; nk < 9; ++nk)
#pragma unroll
            for (int r = 0; r < 4; ++r) { const float pv = S[nk][r] > -1e29f ? exp2f((S[nk][r] - mx) * 1.4426950408889634f) : 0.f; S[nk][r] = pv; sum += pv; }
        sum += __shfl_xor(sum, 16); sum += __shfl_xor(sum, 32);
        const float inv = 1.f / (sum + exp2f((sink - mx) * 1.4426950408889634f));
        f32x4 O[4];
#pragma unroll
        for (int nd = 0; nd < 4; ++nd) O[nd] = (f32x4){0.f, 0.f, 0.f, 0.f};
#pragma unroll
        for (int kk = 0; kk < 5; ++kk) { const bf16x8 pf = pack8(S[2 * kk], S[2 * kk + 1]);
            const int p0 = 16 * (si + 2 * kk) + 4 * fq, p1 = (kk == 4 && si == 7) ? p0 : p0 + 16;
#pragma unroll
            for (int nd = 0; nd < 4; ++nd) { const u32x2 lo = *(const LAS u32x2*)(Vs + (16 * nd + fr) * 528 + p0 * 2), hi = *(const LAS u32x2*)(Vs + (16 * nd + fr) * 528 + p1 * 2);
                O[nd] = MFMA16(cat8(lo, hi), pf, O[nd]); } }
#pragma unroll
        for (int nd = 0; nd < 4; ++nd) { u32x2 w; w[0] = pk2(O[nd][0] * inv, O[nd][1] * inv); w[1] = pk2(O[nd][2] * inv, O[nd][3] * inv);
            *(u32x2*)(ycat + (size_t)t * AB_OUT + hd * 64 + 16 * nd + 4 * fq) = w; }
    }
}

__device__ __forceinline__ void ret_kv_unit(const Ctx& c, int unit) {
    const int b = unit >> 8, n = (unit >> 2) & 63, h = unit & 3, lane = c.lane, fr = lane & 15, fq = lane >> 4, w = c.wid;
    const bf16_t* rkdT = (const bf16_t*)(c.ws + AB_RKDT); const bf16_t* rvT = (const bf16_t*)(c.ws + AB_RVT); float* kv = (float*)(c.ws + AB_KV);
    LAS unsigned char* Kd = c.lds;
    __syncthreads();
    {
        const float lg = log2f(1.f - exp2f(-5.f - (float)h)); const int cc = c.tid & 15;
        float dec[8];
#pragma unroll
        for (int e = 0; e < 8; ++e) dec[e] = exp2f((float)(127 - (cc * 8 + e)) * lg);
        const unsigned char* src = (const unsigned char*)(rkdT + (size_t)(b * 4 + h) * 128 * SEQ + n * 128);
#pragma unroll
        for (int q = 0; q < 4; ++q) { const int r = (c.tid >> 4) + 32 * q; const u32x4 v = *(const u32x4*)(src + (size_t)r * SEQ * 2 + cc * 16); u32x4 o;
#pragma unroll
            for (int e2 = 0; e2 < 4; ++e2) o[e2] = pk2(__uint_as_float(v[e2] << 16) * dec[2 * e2], __uint_as_float(v[e2] & 0xffff0000u) * dec[2 * e2 + 1]);
            *(LAS u32x4*)(Kd + r * 272 + cc * 16) = o; }
    }
    bf16x8 vf[2][4];
#pragma unroll
    for (int ne = 0; ne < 2; ++ne)
#pragma unroll
        for (int ks = 0; ks < 4; ++ks) vf[ne][ks] = *(const bf16x8*)(rvT + ((size_t)(b * 4 + h) * 256 + 32 * w + 16 * ne + fr) * SEQ + n * 128 + ks * 32 + fq * 8);
    __syncthreads();
    float* out = kv + ((size_t)((b * 64 + n) * 4 + h)) * 256 * 128;
#pragma unroll
    for (int nd = 0; nd < 8; ++nd) { f32x4 a0 = (f32x4){0.f, 0.f, 0.f, 0.f}, a1 = a0;
#pragma unroll
        for (int ks = 0; ks < 4; ++ks) { const bf16x8 kf = *(const LAS bf16x8*)(Kd + (16 * nd + fr) * 272 + ks * 64 + fq * 16); a0 = MFMA16(kf, vf[0][ks], a0); a1 = MFMA16(kf, vf[1][ks], a1); }
        *(f32x4*)(out + (size_t)(32 * w + fr) * 128 + 16 * nd + 4 * fq) = a0; *(f32x4*)(out + (size_t)(32 * w + 16 + fr) * 128 + 16 * nd + 4 * fq) = a1; }
}
__device__ __forceinline__ void ret_scan(const Ctx& c, int first_block, int nblocks) {
    const float* kv = (const float*)(c.ws + AB_KV); bf16_t* sp = (bf16_t*)(c.ws + AB_SPREV);
    const int nthr = nblocks * NTHREADS;
    for (int idx = (c.bid - first_block) * NTHREADS + c.tid; idx < 2 * 4 * 256 * 128 / 4; idx += nthr) {
        const int b = idx >> 15, rem = idx & 32767, h = rem >> 13;
        const float g = exp2f(128.f * log2f(1.f - exp2f(-5.f - (float)h)));
        const size_t base = (size_t)b * 64 * 131072 + (size_t)rem * 4;
        f32x4 st = (f32x4){0.f, 0.f, 0.f, 0.f};
        for (int n0 = 0; n0 < 64; n0 += 16) { f32x4 v[16];
#pragma unroll
            for (int q = 0; q < 16; ++q) v[q] = *(const f32x4*)(kv + base + (size_t)(n0 + q) * 131072);
#pragma unroll
            for (int q = 0; q < 16; ++q) { u32x2 wv; wv[0] = pk2(st[0], st[1]); wv[1] = pk2(st[2], st[3]); *(u32x2*)(sp + base + (size_t)(n0 + q) * 131072) = wv; st = st * g + v[q]; } }
    }
}
__device__ __forceinline__ void ret_out_unit(const Ctx& c, int unit) {
    const int b = unit >> 8, n = (unit >> 2) & 63, h = unit & 3, lane = c.lane, fr = lane & 15, fq = lane >> 4, w = c.wid;
    const bf16_t* rqb = (const bf16_t*)(c.ws + AB_RQB); const bf16_t* rkb = (const bf16_t*)(c.ws + AB_RKB); const bf16_t* rvT = (const bf16_t*)(c.ws + AB_RVT);
    const bf16_t* sp = (const bf16_t*)(c.ws + AB_SPREV); const bf16_t* rgb = (const bf16_t*)(c.ws + AB_RGB); bf16_t* ycat = (bf16_t*)(c.ws + WS_YCAT);
    LAS unsigned char* Kl = c.lds; LAS unsigned char* Bl = c.lds + 128 * 272;
    const int t0 = b * SEQ + n * 128; const float lg = log2f(1.f - exp2f(-5.f - (float)h));
    __syncthreads();
    tile_g2l<128, 256>(Kl, (const unsigned char*)(rkb + (size_t)t0 * 512 + h * 128), (size_t)512 * 2, c.tid);
    tile_g2l<256, 256>(Bl, (const unsigned char*)(sp + ((size_t)((b * 64 + n) * 4 + h)) * 256 * 128), (size_t)128 * 2, c.tid);
    const int t = t0 + 16 * w + fr, i = 16 * w + fr;
    bf16x8 qf[4];
#pragma unroll
    for (int ks = 0; ks < 4; ++ks) qf[ks] = *(const bf16x8*)(rqb + (size_t)t * 512 + h * 128 + ks * 32 + fq * 8);
    __syncthreads();
    bf16x8 pf[4];
#pragma unroll
    for (int kk = 0; kk < 4; ++kk) { f32x4 s2[2];
#pragma unroll
        for (int q = 0; q < 2; ++q) { const int nj = 2 * kk + q; s2[q] = (f32x4){0.f, 0.f, 0.f, 0.f};
            if (nj <= w) {
#pragma unroll
                for (int ks = 0; ks < 4; ++ks) { const bf16x8 kf = *(const LAS bf16x8*)(Kl + (16 * nj + fr) * 272 + ks * 64 + fq * 16); s2[q] = MFMA16(kf, qf[ks], s2[q]); }
#pragma unroll
                for (int r = 0; r < 4; ++r) { const int jj = 16 * nj + 4 * fq + r; s2[q][r] = (i >= jj) ? s2[q][r] * exp2f((float)(i - jj) * lg) : 0.f; } } }
        pf[kk] = pack8(s2[0], s2[1]); }
    f32x4 acc[16];
#pragma unroll
    for (int ne = 0; ne < 16; ++ne) { acc[ne] = (f32x4){0.f, 0.f, 0.f, 0.f};
#pragma unroll
        for (int ks = 0; ks < 4; ++ks) { const bf16x8 sf = *(const LAS bf16x8*)(Bl + (16 * ne + fr) * 272 + ks * 64 + fq * 16); acc[ne] = MFMA16(sf, qf[ks], acc[ne]); } }
    const float rs = exp2f((float)(i + 1) * lg);
#pragma unroll
    for (int ne = 0; ne < 16; ++ne) acc[ne] = acc[ne] * rs;
    __syncthreads();
    tile_g2l<256, 256>(Bl, (const unsigned char*)(rvT + (size_t)(b * 4 + h) * 256 * SEQ + n * 128), (size_t)SEQ * 2, c.tid);
    __syncthreads();
    const int nkk = (w >> 1) + 1;
#pragma unroll
    for (int kk = 0; kk < 4; ++kk) if (kk < nkk) {
#pragma unroll
        for (int ne = 0; ne < 16; ++ne) { const u32x2 lo = *(const LAS u32x2*)(Bl + (16 * ne + fr) * 272 + (32 * kk + 4 * fq) * 2), hi = *(const LAS u32x2*)(Bl + (16 * ne + fr) * 272 + (32 * kk + 16 + 4 * fq) * 2);
            acc[ne] = MFMA16(cat8(lo, hi), pf[kk], acc[ne]); } }
    float sm = 0.f;
#pragma unroll
    for (int ne = 0; ne < 16; ++ne) sm += acc[ne][0] + acc[ne][1] + acc[ne][2] + acc[ne][3];
    sm += __shfl_xor(sm, 16); sm += __shfl_xor(sm, 32);
    const float mean = sm * (1.f / 256.f); float sq = 0.f;
#pragma unroll
    for (int ne = 0; ne < 16; ++ne) { acc[ne] = acc[ne] - mean; sq += acc[ne][0] * acc[ne][0] + acc[ne][1] * acc[ne][1] + acc[ne][2] * acc[ne][2] + acc[ne][3] * acc[ne][3]; }
    sq += __shfl_xor(sq, 16); sq += __shfl_xor(sq, 32);
    const float rstd = rsqrtf(sq * (1.f / 256.f) + LN_EPS);
#pragma unroll
    for (int ne = 0; ne < 16; ++ne) { const u32x2 gw = *(const u32x2*)(rgb + (size_t)t * 1024 + h * 256 + 16 * ne + 4 * fq);
        const float g0 = __uint_as_float(gw[0] << 16), g1 = __uint_as_float(gw[0] & 0xffff0000u), g2 = __uint_as_float(gw[1] << 16), g3 = __uint_as_float(gw[1] & 0xffff0000u);
        u32x2 o; o[0] = pk2(acc[ne][0] * rstd * g0, acc[ne][1] * rstd * g1); o[1] = pk2(acc[ne][2] * rstd * g2, acc[ne][3] * rstd * g3);
        *(u32x2*)(ycat + (size_t)t * AB_OUT + 1024 + h * 256 + 16 * ne + 4 * fq) = o; }
}

__device__ __forceinline__ void phase_ab_p1(const Ctx& c) {
    for (int u = c.bid; u < 512; u += c.G) ret_kv_unit(c, u);
}
__device__ __forceinline__ void phase_ab_p2(const Ctx& c, int j) {
    ret_scan(c, 0, c.G);
    { const float* sinks = c.inp(3) + j * 16; for (int u = c.bid; u < 256; u += c.G) attn_unit(c, u, sinks); }
}
__device__ __forceinline__ void phase_ab_p3(const Ctx& c) {
    for (int u = c.bid; u < 512; u += c.G) ret_out_unit(c, u);
}

__device__ __forceinline__ float gelu_fast(float x) { const float u = 1.5957691216057308f * (x + 0.044715f * x * x * x); return x * __builtin_amdgcn_rcpf(1.f + __expf(-u)); }
struct EpiCDIn {
    static constexpr bool PERM = true;
    LAS bf16_t* biasL; unsigned char* ws;
    __device__ __forceinline__ void operator()(const f32x4 (&acc)[2][2][4][2], const g8::Unit& u, int wr, int wc, int fr, int fq) const {
        const int pn = u.pn; const int col0 = pn * 256 + wc * 32 + fq * 8;
        f32x4 bv[2][2];
#pragma unroll
        for (int bj = 0; bj < 2; ++bj)
#pragma unroll
            for (int n = 0; n < 2; ++n) { const u32x2 bw = *(const LAS u32x2*)(biasL + col0 + bj * 128 + 4 * n); bv[bj][n] = (f32x4){__uint_as_float(bw[0] << 16), __uint_as_float(bw[0] & 0xffff0000u), __uint_as_float(bw[1] << 16), __uint_as_float(bw[1] & 0xffff0000u)}; }
        bf16_t* gu = (bf16_t*)(ws + CD_GU); bf16_t* gvT = (bf16_t*)(ws + CD_GVT); bf16_t* gg = (bf16_t*)(ws + CD_GG); bf16_t* xr = (bf16_t*)(ws + CD_XR); float* stats = (float*)(ws + CD_STATS);
#pragma unroll
        for (int ai = 0; ai < 2; ++ai)
#pragma unroll
            for (int m = 0; m < 4; ++m) {
                const int t = u.pm * 256 + ai * 128 + wr * 64 + m * 16 + fr, sq = t & (SEQ - 1), b = t >> 13;
                f32x4 x[2][2];
#pragma unroll
                for (int bj = 0; bj < 2; ++bj)
#pragma unroll
                    for (int n = 0; n < 2; ++n) { x[bj][n] = acc[ai][bj][m][n] + bv[bj][n];
                        if (pn < 13) {
#pragma unroll
                            for (int e = 0; e < 4; ++e) x[bj][n][e] = gelu_fast(x[bj][n][e]); } }
                if (pn >= 4 && pn < 8) {
                    float s1 = 0.f, s2 = 0.f;
#pragma unroll
                    for (int bj = 0; bj < 2; ++bj)
#pragma unroll
                        for (int n = 0; n < 2; ++n)
#pragma unroll
                            for (int e = 0; e < 4; ++e) { const float v = x[bj][n][e]; s1 += v; s2 += v * v;
                                gvT[((size_t)b * 1024 + (pn - 4) * 256 + bj * 128 + wc * 32 + fq * 8 + 4 * n + e) * SEQ + sq] = f2bf(v); }
                    s1 += __shfl_xor(s1, 16); s1 += __shfl_xor(s1, 32); s2 += __shfl_xor(s2, 16); s2 += __shfl_xor(s2, 32);
                    if (fq == 0) *(f32x2*)(stats + (size_t)t * 32 + ((pn - 4) * 4 + wc) * 2) = (f32x2){s1, s2};
                } else {
                    bf16_t* dst; int ld, cb;
                    if (pn < 4) { dst = gu; ld = 1024; cb = pn * 256; } else if (pn < 13) { dst = gg; ld = 1280; cb = (pn - 8) * 256; } else { dst = xr; ld = 1280; cb = (pn - 13) * 256; }
#pragma unroll
                    for (int bj = 0; bj < 2; ++bj) { u32x4 w;
#pragma unroll
                        for (int n = 0; n < 2; ++n) { w[2 * n] = pk2(x[bj][n][0], x[bj][n][1]); w[2 * n + 1] = pk2(x[bj][n][2], x[bj][n][3]); }
                        *(u32x4*)(dst + (size_t)t * ld + cb + bj * 128 + wc * 32 + fq * 8) = w; }
                }
            }
    }
};
__device__ __forceinline__ void phase_cd_inproj(const Ctx& c, int j) {
    g8::DenseOrder S; S.init(c.ws + WS_XB, c.ws + WS_WCDIN + (size_t)j * CD_IN * D * 2, T, CD_IN, D, c.G, c.bid); S.tid0 = c.tid;
    LAS bf16_t* biasL = (LAS bf16_t*)(c.lds + LDS_TAB);
    { const float* bp = c.inp(7) + (size_t)j * CD_IN; for (int i = c.tid; i < CD_IN; i += NTHREADS) biasL[i] = f2bf(bp[i]); }
    __syncthreads();
    EpiCDIn E{biasL, c.ws};
    g8::gemm_phase<EpiCDIn, g8::DenseOrder>(c.lds + LDS_STAGE, D, S, E);
}

__device__ __forceinline__ void lru_unit(const Ctx& c, int unit, int j) {
    const int hh = unit % 5, bn = unit / 5, lane = c.lane, fr = lane & 15, fq = lane >> 4, w = c.wid;
    const int t0 = bn * 128, s0 = t0 & (SEQ - 1);
    const bf16_t* xr = (const bf16_t*)(c.ws + CD_XR); bf16_t* HL = (bf16_t*)(c.ws + WS_U2); bf16_t* PC = HL + (size_t)T * 1280; float* sum = (float*)(c.ws + WS_H);
    const float* conv_w = c.inp(10) + (size_t)j * 4 * 1280 + hh * 256; const float* conv_b = c.inp(11) + (size_t)j * 1280 + hh * 256;
    const float* ba = c.inp(13) + (size_t)j * 1280 + hh * 256; const float* bx = c.inp(15) + (size_t)j * 1280 + hh * 256; const float* spl = (const float*)(c.ws + WS_SPL) + (size_t)j * 1280 + hh * 256;
    const bf16_t* Wl = (const bf16_t*)(c.ws + WS_WLRU) + (size_t)((j * 5 + hh) * 2) * 65536;
    LAS unsigned char* Xc = c.lds; LAS unsigned char* Wa = c.lds + 128 * 528; LAS unsigned char* Wx = Wa + 64 * 528; LAS unsigned char* Tot = Wx + 64 * 528; LAS float* Bl = (LAS float*)(Tot + 4096);
    __syncthreads();
    if (c.tid < 192) { const int which = c.tid >> 6, i4 = (c.tid & 63) * 4; const float* srcp = which == 0 ? ba : (which == 1 ? bx : spl); *(LAS f32x4*)(Bl + which * 256 + i4) = *(const f32x4*)(srcp + i4); }
    {
        const int cg = c.tid & 31, r0 = (c.tid >> 5) * 8;
        float wv[4][8], bv8[8];
        { const f32x4 b0 = *(const f32x4*)(conv_b + cg * 8), b1 = *(const f32x4*)(conv_b + cg * 8 + 4); bv8[0] = b0[0]; bv8[1] = b0[1]; bv8[2] = b0[2]; bv8[3] = b0[3]; bv8[4] = b1[0]; bv8[5] = b1[1]; bv8[6] = b1[2]; bv8[7] = b1[3]; }
#pragma unroll
        for (int k = 0; k < 4; ++k) { const f32x4 w0 = *(const f32x4*)(conv_w + k * 1280 + cg * 8), w1 = *(const f32x4*)(conv_w + k * 1280 + cg * 8 + 4);
            wv[k][0] = w0[0]; wv[k][1] = w0[1]; wv[k][2] = w0[2]; wv[k][3] = w0[3]; wv[k][4] = w1[0]; wv[k][5] = w1[1]; wv[k][6] = w1[2]; wv[k][7] = w1[3]; }
        u32x4 xin[11];
#pragma unroll
        for (int q = 0; q < 11; ++q) { xin[q] = (u32x4){0u, 0u, 0u, 0u}; if (s0 + r0 - 3 + q >= 0) xin[q] = *(const u32x4*)(xr + (size_t)(t0 + r0 - 3 + q) * 1280 + hh * 256 + cg * 8); }
#pragma unroll
        for (int rr = 0; rr < 8; ++rr) { float a[8];
#pragma unroll
            for (int e = 0; e < 8; ++e) a[e] = bv8[e];
#pragma unroll
            for (int k = 0; k < 4; ++k) { const u32x4 xv = xin[rr + k];
#pragma unroll
                for (int e2 = 0; e2 < 4; ++e2) { a[2 * e2] += wv[k][2 * e2] * __uint_as_float(xv[e2] << 16); a[2 * e2 + 1] += wv[k][2 * e2 + 1] * __uint_as_float(xv[e2] & 0xffff0000u); } }
            u32x4 o; o[0] = pk2(a[0], a[1]); o[1] = pk2(a[2], a[3]); o[2] = pk2(a[4], a[5]); o[3] = pk2(a[6], a[7]);
            *(LAS u32x4*)(Xc + (r0 + rr) * 528 + cg * 16) = o; }
    }
    u32x4 wreg[8];
#pragma unroll
    for (int q = 0; q < 4; ++q) { const int i = c.tid + q * NTHREADS, r = i >> 5, cc = i & 31; wreg[q] = *(const u32x4*)((const unsigned char*)Wl + (size_t)r * 512 + cc * 16); wreg[4 + q] = *(const u32x4*)((const unsigned char*)(Wl + 65536) + (size_t)r * 512 + cc * 16); }
    __syncthreads();
    bf16x8 xf[8];
#pragma unroll
    for (int ks = 0; ks < 8; ++ks) xf[ks] = *(const LAS bf16x8*)(Xc + (16 * w + fr) * 528 + ks * 64 + fq * 16);
    const int t = t0 + 16 * w + fr;
    for (int sl = 0; sl < 4; ++sl) {
        if (sl) __syncthreads();
#pragma unroll
        for (int q = 0; q < 4; ++q) { const int i = c.tid + q * NTHREADS, r = i >> 5, cc = i & 31; *(LAS u32x4*)(Wa + r * 528 + cc * 16) = wreg[q]; *(LAS u32x4*)(Wx + r * 528 + cc * 16) = wreg[4 + q]; }
        if (sl < 3) {
#pragma unroll
            for (int q = 0; q < 4; ++q) { const int i = c.tid + q * NTHREADS, r = i >> 5, cc = i & 31;
                wreg[q] = *(const u32x4*)((const unsigned char*)(Wl + (size_t)((sl + 1) * 64) * 256) + (size_t)r * 512 + cc * 16); wreg[4 + q] = *(const u32x4*)((const unsigned char*)(Wl + 65536 + (size_t)((sl + 1) * 64) * 256) + (size_t)r * 512 + cc * 16); } }
        __syncthreads();
        f32x4 sA[4], sB[4];
#pragma unroll
        for (int nc = 0; nc < 4; ++nc) { f32x4 ra = (f32x4){0.f, 0.f, 0.f, 0.f}, ri = ra;
#pragma unroll
            for (int ks = 0; ks < 8; ++ks) { const bf16x8 wa = *(const LAS bf16x8*)(Wa + (16 * nc + fr) * 528 + ks * 64 + fq * 16), wx = *(const LAS bf16x8*)(Wx + (16 * nc + fr) * 528 + ks * 64 + fq * 16);
                ra = MFMA16(wa, xf[ks], ra); ri = MFMA16(wx, xf[ks], ri); }
            const int ch = sl * 64 + 16 * nc + 4 * fq;
            const f32x4 b_a = *(const LAS f32x4*)(Bl + ch), b_x = *(const LAS f32x4*)(Bl + 256 + ch), sp = *(const LAS f32x4*)(Bl + 512 + ch);
            const u32x2 xw = *(const LAS u32x2*)(Xc + (16 * w + fr) * 528 + ch * 2);
            const float xcv[4] = {__uint_as_float(xw[0] << 16), __uint_as_float(xw[0] & 0xffff0000u), __uint_as_float(xw[1] << 16), __uint_as_float(xw[1] & 0xffff0000u)};
            f32x4 oa, ob;
#pragma unroll
            for (int r = 0; r < 4; ++r) { const float gr = __builtin_amdgcn_rcpf(1.f + __expf(-(ra[r] + b_a[r]))), gi = __builtin_amdgcn_rcpf(1.f + __expf(-(ri[r] + b_x[r]))); const float la = -8.f * gr * sp[r]; const float a = __expf(la);
                oa[r] = a; ob[r] = __builtin_amdgcn_sqrtf(fmaxf(1.f - a * a, 0.f)) * (gi * xcv[r]); }
#pragma unroll
            for (int dlt = 1; dlt < 16; dlt <<= 1) {
#pragma unroll
                for (int r = 0; r < 4; ++r) { const float pa = __shfl_up(oa[r], dlt, 16), pb = __shfl_up(ob[r], dlt, 16); if (fr >= dlt) { ob[r] = oa[r] * pb + ob[r]; oa[r] = oa[r] * pa; } } }
            sA[nc] = oa; sB[nc] = ob;
            if (fr == 15) { *(LAS f32x4*)(Tot + ((w * 64 + 16 * nc + 4 * fq) * 2) * 4) = oa; *(LAS f32x4*)(Tot + ((w * 64 + 16 * nc + 4 * fq) * 2 + 4) * 4) = ob; }
        }
        __syncthreads();
#pragma unroll
        for (int nc = 0; nc < 4; ++nc) { const int ch = sl * 64 + 16 * nc + 4 * fq;
            f32x4 cp = (f32x4){1.f, 1.f, 1.f, 1.f}, chh = (f32x4){0.f, 0.f, 0.f, 0.f};
            for (int w2 = 0; w2 < w; ++w2) { const f32x4 ta = *(const LAS f32x4*)(Tot + ((w2 * 64 + 16 * nc + 4 * fq) * 2) * 4), tb = *(const LAS f32x4*)(Tot + ((w2 * 64 + 16 * nc + 4 * fq) * 2 + 4) * 4);
                chh = ta * chh + tb; cp = cp * ta; }
            const f32x4 hl = sB[nc] + sA[nc] * chh, pc = sA[nc] * cp;
            u32x2 o1, o2; o1[0] = pk2(hl[0], hl[1]); o1[1] = pk2(hl[2], hl[3]); o2[0] = pk2(pc[0], pc[1]); o2[1] = pk2(pc[2], pc[3]);
            *(u32x2*)(HL + (size_t)t * 1280 + hh * 256 + ch) = o1; *(u32x2*)(PC + (size_t)t * 1280 + hh * 256 + ch) = o2;
            if (w == 7 && fr == 15) { float* sm = sum + ((size_t)bn * 1280 + hh * 256 + ch) * 2;
#pragma unroll
                for (int r = 0; r < 4; ++r) { sm[2 * r] = pc[r]; sm[2 * r + 1] = hl[r]; } } }
    }
}

__device__ __forceinline__ void sgu_unit(const Ctx& c, int unit, int j) {
    const int g = unit & 3, bn = unit >> 2, b = bn >> 6, n = bn & 63, lane = c.lane, fr = lane & 15, fq = lane >> 4, w = c.wid;
    const int t0 = bn * 128;
    const bf16_t* gu = (const bf16_t*)(c.ws + CD_GU); const bf16_t* gvT = (const bf16_t*)(c.ws + CD_GVT); const float* stats = (const float*)(c.ws + CD_STATS); bf16_t* ycat = (bf16_t*)(c.ws + WS_YCAT);
    const float* sw = c.inp(8) + (size_t)(j * 4 + g) * 16384; const float* sb = c.inp(9) + (size_t)(j * 4 + g) * 128;
    LAS unsigned char* Vt = c.lds; LAS float* mr = (LAS float*)(c.lds + 256 * 272);
    __syncthreads();
    tile_g2l<256, 256>(Vt, (const unsigned char*)(gvT + ((size_t)b * 1024 + g * 256) * SEQ + n * 128), (size_t)SEQ * 2, c.tid);
    if (c.tid < 128) { const f32x4* st = (const f32x4*)(stats + (size_t)(t0 + c.tid) * 32); float s1 = 0.f, s2 = 0.f; f32x4 sv[8];
#pragma unroll
        for (int q = 0; q < 8; ++q) sv[q] = st[q];
#pragma unroll
        for (int q = 0; q < 8; ++q) { s1 += sv[q][0] + sv[q][2]; s2 += sv[q][1] + sv[q][3]; }
        const float mean = s1 * (1.f / 1024.f), var = fmaxf(s2 * (1.f / 1024.f) - mean * mean, 0.f); mr[2 * c.tid] = mean; mr[2 * c.tid + 1] = rsqrtf(var + LN_EPS); }
    __syncthreads();
    const int i = 16 * w + fr, t = t0 + i, nks = (w >> 1) + 1;
    bf16x8 wf[4]; float ci = 0.f;
#pragma unroll
    for (int ks = 0; ks < 4; ++ks) { f32x4 lo = (f32x4){0.f, 0.f, 0.f, 0.f}, hi = lo;
        if (ks < nks) { const int j0 = ks * 32 + fq * 8; const f32x4 w0 = *(const f32x4*)(sw + (size_t)i * 128 + j0), w1 = *(const f32x4*)(sw + (size_t)i * 128 + j0 + 4);
#pragma unroll
            for (int e = 0; e < 4; ++e) { const float m0 = mr[2 * (j0 + e)], r0 = mr[2 * (j0 + e) + 1], m1 = mr[2 * (j0 + 4 + e)], r1 = mr[2 * (j0 + 4 + e) + 1];
                lo[e] = (j0 + e <= i) ? w0[e] * r0 : 0.f; hi[e] = (j0 + 4 + e <= i) ? w1[e] * r1 : 0.f; ci += lo[e] * m0 + hi[e] * m1; } }
        wf[ks] = pack8(lo, hi); }
    ci += __shfl_xor(ci, 16); ci += __shfl_xor(ci, 32);
    const float add = sb[i] - ci;
    f32x4 acc[16];
#pragma unroll
    for (int nd = 0; nd < 16; ++nd) { acc[nd] = (f32x4){0.f, 0.f, 0.f, 0.f};
#pragma unroll
        for (int ks = 0; ks < 4; ++ks) if (ks < nks) { const bf16x8 vf = *(const LAS bf16x8*)(Vt + (16 * nd + fr) * 272 + ks * 64 + fq * 16); acc[nd] = MFMA16(vf, wf[ks], acc[nd]); } }
#pragma unroll
    for (int nd = 0; nd < 16; ++nd) { const u32x2 uw = *(const u32x2*)(gu + (size_t)t * 1024 + g * 256 + 16 * nd + 4 * fq);
        const float u0 = __uint_as_float(uw[0] << 16), u1 = __uint_as_float(uw[0] & 0xffff0000u), u2 = __uint_as_float(uw[1] << 16), u3 = __uint_as_float(uw[1] & 0xffff0000u);
        u32x2 o; o[0] = pk2(u0 * (acc[nd][0] + add), u1 * (acc[nd][1] + add)); o[1] = pk2(u2 * (acc[nd][2] + add), u3 * (acc[nd][3] + add));
        *(u32x2*)(ycat + (size_t)t * CD_OUT + g * 256 + 16 * nd + 4 * fq) = o; }
}
__device__ __forceinline__ void phase_cd_p1(const Ctx& c, int j) {
    for (int u = c.bid; u < 640; u += c.G) lru_unit(c, u, j);
    if (c.G == 256) {
        if (c.bid < 128) sgu_unit(c, c.bid, j);
        else { for (int q = 0; q < 3; ++q) sgu_unit(c, 128 + (c.bid - 128) * 3 + q, j); }
    } else { for (int u = c.bid; u < 512; u += c.G) sgu_unit(c, u, j); }
}

__device__ __forceinline__ void phase_cd_scan2(const Ctx& c) {
    const bf16_t* gg = (const bf16_t*)(c.ws + CD_GG); bf16_t* ycat = (bf16_t*)(c.ws + WS_YCAT);
    const bf16_t* HL = (const bf16_t*)(c.ws + WS_U2); const bf16_t* PC = HL + (size_t)T * 1280; const float* sum = (const float*)(c.ws + WS_H);
    LAS float* carry = (LAS float*)c.lds;
    for (int u = c.bid; u < 256; u += c.G) {
        const int bn = u >> 1, half = u & 1, b = bn >> 6, n = bn & 63;
        __syncthreads();
        {
            LAS float* part = carry + 1280;
            for (int it = c.tid; it < 4 * 1280; it += NTHREADS) { const int seg = it / 1280, ch = it % 1280; const float* sp = sum + ((size_t)(b * 64 + seg * 16) * 1280 + ch) * 2;
                f32x2 v[16];
#pragma unroll
                for (int q = 0; q < 16; ++q) { v[q] = (f32x2){1.f, 0.f}; if (seg * 16 + q < n) v[q] = *(const f32x2*)(sp + (size_t)q * 2560); }
                float A = 1.f, Bv = 0.f;
#pragma unroll
                for (int q = 0; q < 16; ++q) { Bv = v[q][0] * Bv + v[q][1]; A *= v[q][0]; }
                part[(seg * 1280 + ch) * 2] = A; part[(seg * 1280 + ch) * 2 + 1] = Bv; }
            __syncthreads();
            for (int ch = c.tid; ch < 1280; ch += NTHREADS) { float cr = 0.f;
#pragma unroll
                for (int seg = 0; seg < 4; ++seg) cr = part[(seg * 1280 + ch) * 2] * cr + part[(seg * 1280 + ch) * 2 + 1];
                carry[ch] = cr; }
        }
        __syncthreads();
        const size_t t0 = (size_t)bn * 128 + half * 64;
#pragma unroll 8
        for (int it = c.tid; it < 64 * 320; it += NTHREADS) { const int r = it / 320, c4 = (it % 320) * 4; const size_t o = (t0 + r) * 1280 + c4;
            const u32x2 hw = *(const u32x2*)(HL + o), pw = *(const u32x2*)(PC + o), gw = *(const u32x2*)(gg + o); const f32x4 cr = *(const LAS f32x4*)(carry + c4);
            const float h0 = __uint_as_float(hw[0] << 16) + __uint_as_float(pw[0] << 16) * cr[0], h1 = __uint_as_float(hw[0] & 0xffff0000u) + __uint_as_float(pw[0] & 0xffff0000u) * cr[1];
            const float h2 = __uint_as_float(hw[1] << 16) + __uint_as_float(pw[1] << 16) * cr[2], h3 = __uint_as_float(hw[1] & 0xffff0000u) + __uint_as_float(pw[1] & 0xffff0000u) * cr[3];
            u32x2 ow; ow[0] = pk2(__uint_as_float(gw[0] << 16) * h0, __uint_as_float(gw[0] & 0xffff0000u) * h1); ow[1] = pk2(__uint_as_float(gw[1] << 16) * h2, __uint_as_float(gw[1] & 0xffff0000u) * h3);
            *(u32x2*)(ycat + (t0 + r) * CD_OUT + 1024 + c4) = ow; }
    }
}

__device__ __forceinline__ void phase_ln_moe(const Ctx& c, const float* g, const float* bta, float* xout) {
    typedef float f32x2v __attribute__((ext_vector_type(2)));
    bf16_t* xb = (bf16_t*)(c.ws + WS_XB); const unsigned char* Y = (const unsigned char*)(c.ws + WS_U1);
    for (long tt = (long)c.gw * 2; tt < T; tt += (long)c.nwaves * 2) {
        float v[2][2][8];
#pragma unroll
        for (int u = 0; u < 2; ++u) { const long t = tt + u;
#pragma unroll
            for (int q = 0; q < 2; ++q) { const int col = q * 512 + c.lane * 8;
                float f[8];
#pragma unroll
                for (int e = 0; e < 8; ++e) f[e] = 0.f;
#pragma unroll
                for (int k = 0; k < 8; ++k) { const size_t srow = (size_t)t * 8 + k; const u32x2 w = *(const u32x2*)(Y + srow * D + col);
#pragma unroll
                    for (int h2 = 0; h2 < 2; ++h2) { const f32x2v a = __builtin_amdgcn_cvt_pk_f32_fp8(w[h2], false), b = __builtin_amdgcn_cvt_pk_f32_fp8(w[h2], true);
                        f[4 * h2] += a[0]; f[4 * h2 + 1] += a[1]; f[4 * h2 + 2] += b[0]; f[4 * h2 + 3] += b[1]; } }
                const u32x4 xw = *(const u32x4*)(xb + (size_t)t * D + col), sw = *(const u32x4*)((const bf16_t*)(Y + (size_t)TK * D) + (size_t)t * D + col);
#pragma unroll
                for (int e2 = 0; e2 < 4; ++e2) { v[u][q][2 * e2] = __uint_as_float(xw[e2] << 16) * ALPHA + f[2 * e2] * (1.f / 64.f) + __uint_as_float(sw[e2] << 16);
                    v[u][q][2 * e2 + 1] = __uint_as_float(xw[e2] & 0xffff0000u) * ALPHA + f[2 * e2 + 1] * (1.f / 64.f) + __uint_as_float(sw[e2] & 0xffff0000u); } } }
#pragma unroll
        for (int u = 0; u < 2; ++u) { const long t = tt + u;
            float sm = 0.f;
#pragma unroll
            for (int q = 0; q < 2; ++q)
#pragma unroll
                for (int e = 0; e < 8; ++e) sm += v[u][q][e];
            const float mean = wave_sum(sm) * (1.f / 1024.f); float sq = 0.f;
#pragma unroll
            for (int q = 0; q < 2; ++q)
#pragma unroll
                for (int e = 0; e < 8; ++e) { v[u][q][e] -= mean; sq += v[u][q][e] * v[u][q][e]; }
            const float rstd = rsqrtf(wave_sum(sq) * (1.f / 1024.f) + LN_EPS);
#pragma unroll
            for (int q = 0; q < 2; ++q) { const int col = q * 512 + c.lane * 8; float o[8];
#pragma unroll
                for (int h2 = 0; h2 < 2; ++h2) { const f32x4 gg = *(const f32x4*)(g + col + 4 * h2), bb = *(const f32x4*)(bta + col + 4 * h2);
#pragma unroll
                    for (int e = 0; e < 4; ++e) o[4 * h2 + e] = v[u][q][4 * h2 + e] * rstd * gg[e] + bb[e];
                    if (xout) *(f32x4*)(xout + (size_t)t * D + col + 4 * h2) = (f32x4){o[4 * h2], o[4 * h2 + 1], o[4 * h2 + 2], o[4 * h2 + 3]}; }
                u32x4 w; w[0] = pk2(o[0], o[1]); w[1] = pk2(o[2], o[3]); w[2] = pk2(o[4], o[5]); w[3] = pk2(o[6], o[7]); *(u32x4*)(xb + (size_t)t * D + col) = w; } }
    }
}

__device__ __forceinline__ unsigned sortable_u32(float f) { const unsigned b = __float_as_uint(f); return b ^ ((b >> 31) ? 0xffffffffu : 0x80000000u); }
__device__ __forceinline__ int popc64(unsigned long long m) { return __builtin_popcountll(m); }
__device__ __forceinline__ int rank_lt(unsigned long long m) { return (int)__builtin_amdgcn_mbcnt_hi((unsigned)(m >> 32), __builtin_amdgcn_mbcnt_lo((unsigned)m, 0u)); }
__device__ __forceinline__ void phase_ln_route(const Ctx& c, int L) {
    bf16_t* xb = (bf16_t*)(c.ws + WS_XB); const bf16_t* hbuf = (const bf16_t*)(c.ws + WS_HB);
    const float* g = c.inp(19) + (size_t)L * D; const float* bta = c.inp(20) + (size_t)L * D; const float* rb = c.inp(22) + L * NE;
    const bf16_t* Wr = (const bf16_t*)(c.ws + WS_WRT) + (size_t)L * 256 * D;
    int* cnt = (int*)(c.ws + CTL_CNT) + L * NE * 1024; int* list = (int*)(c.ws + WS_LIST); float* gate = (float*)(c.ws + WS_GATE);
    LAS unsigned char* Xl = c.lds; LAS unsigned char* Wq = c.lds + 32 * 2064;
    LAS float* Sc = (LAS float*)Wq;
    LAS int* hist = (LAS int*)(Wq + 32768); LAS int* gbase = hist + 128; LAS int* sel = gbase + 128; LAS float* selg = (LAS float*)(sel + 512);
    const int lane = c.lane, fr = lane & 15, fq = lane >> 4, w = c.wid;
    for (int grp = c.bid; grp < T / 64; grp += c.G) {
        __syncthreads();
        u32x2 nb[8][4];
#pragma unroll
        for (int hb = 0; hb < 2; ++hb) {
            u32x2 xw[4][4], hw[4][4];
#pragma unroll
            for (int i = 0; i < 4; ++i) { const size_t t = (size_t)grp * 64 + hb * 32 + w * 4 + i;
#pragma unroll
                for (int q = 0; q < 4; ++q) { const int col = q * 256 + lane * 4; xw[i][q] = *(const u32x2*)(xb + t * D + col); hw[i][q] = *(const u32x2*)(hbuf + t * D + col); } }
#pragma unroll
            for (int i = 0; i < 4; ++i) { const size_t t = (size_t)grp * 64 + hb * 32 + w * 4 + i;
                f32x4 v[4]; float sm = 0.f;
#pragma unroll
                for (int q = 0; q < 4; ++q) { v[q] = (f32x4){__uint_as_float(xw[i][q][0] << 16), __uint_as_float(xw[i][q][0] & 0xffff0000u), __uint_as_float(xw[i][q][1] << 16), __uint_as_float(xw[i][q][1] & 0xffff0000u)} * ALPHA
                         + (f32x4){__uint_as_float(hw[i][q][0] << 16), __uint_as_float(hw[i][q][0] & 0xffff0000u), __uint_as_float(hw[i][q][1] << 16), __uint_as_float(hw[i][q][1] & 0xffff0000u)};
                    sm += v[q][0] + v[q][1] + v[q][2] + v[q][3]; }
                const float mean = wave_sum(sm) * (1.f / 1024.f); float sq = 0.f;
#pragma unroll
                for (int q = 0; q < 4; ++q) { v[q] = v[q] - mean; sq += v[q][0] * v[q][0] + v[q][1] * v[q][1] + v[q][2] * v[q][2] + v[q][3] * v[q][3]; }
                const float rstd = rsqrtf(wave_sum(sq) * (1.f / 1024.f) + LN_EPS);
#pragma unroll
                for (int q = 0; q < 4; ++q) { const f32x4 o = v[q] * rstd * *(const f32x4*)(g + q * 256 + lane * 4) + *(const f32x4*)(bta + q * 256 + lane * 4); nb[hb * 4 + i][q][0] = pk2(o[0], o[1]); nb[hb * 4 + i][q][1] = pk2(o[2], o[3]);
                    *(u32x2*)(xb + t * D + q * 256 + lane * 4) = nb[hb * 4 + i][q]; } }
        }
        f32x4 lg[2][2];
        const int st = w & 1, eg = w >> 1;
#pragma unroll
        for (int p2 = 0; p2 < 2; ++p2) {
            if (p2) __syncthreads();
#pragma unroll
            for (int u = 0; u < 4; ++u)
#pragma unroll
                for (int q = 0; q < 4; ++q) *(LAS u32x2*)(Xl + (w * 4 + u) * 2064 + (q * 256 + lane * 4) * 2) = nb[p2 * 4 + u][q];
            lg[p2][0] = (f32x4){0.f, 0.f, 0.f, 0.f}; lg[p2][1] = lg[p2][0];
            u32x4 wreg[8];
#pragma unroll
            for (int q = 0; q < 8; ++q) { const int i = c.tid + q * NTHREADS, r = i >> 5, cc = i & 31; wreg[q] = *(const u32x4*)((const unsigned char*)Wr + (size_t)r * 2048 + cc * 16); }
#pragma unroll
            for (int kq = 0; kq < 4; ++kq) {
                if (kq) __syncthreads();
#pragma unroll
                for (int q = 0; q < 8; ++q) { const int i = c.tid + q * NTHREADS, r = i >> 5, cc = i & 31; *(LAS u32x4*)(Wq + r * 528 + cc * 16) = wreg[q]; }
                if (kq < 3) {
#pragma unroll
                    for (int q = 0; q < 8; ++q) { const int i = c.tid + q * NTHREADS, r = i >> 5, cc = i & 31; wreg[q] = *(const u32x4*)((const unsigned char*)Wr + (size_t)r * 2048 + (kq + 1) * 512 + cc * 16); } }
                __syncthreads();
#pragma unroll
                for (int ks = 0; ks < 8; ++ks) { const bf16x8 bop = *(const LAS bf16x8*)(Xl + (16 * st + fr) * 2064 + kq * 512 + ks * 64 + fq * 16);
#pragma unroll
                    for (int ne2 = 0; ne2 < 2; ++ne2) { const bf16x8 aop = *(const LAS bf16x8*)(Wq + (32 * eg + 16 * ne2 + fr) * 528 + ks * 64 + fq * 16); lg[p2][ne2] = MFMA16(aop, bop, lg[p2][ne2]); } }
            }
        }
        __syncthreads();
#pragma unroll
        for (int p2 = 0; p2 < 2; ++p2)
#pragma unroll
            for (int ne2 = 0; ne2 < 2; ++ne2) { f32x4 sg;
#pragma unroll
                for (int r = 0; r < 4; ++r) sg[r] = sigmoidf_(lg[p2][ne2][r]);
                *(LAS f32x4*)(Sc + (p2 * 32 + 16 * st + fr) * 128 + 32 * eg + 16 * ne2 + 4 * fq) = sg; }
        if (c.tid < 128) hist[c.tid] = 0;
        __syncthreads();
        {
            const float rb0 = rb[lane], rb1 = rb[64 + lane];
#pragma unroll 2
            for (int q = 0; q < 8; ++q) { const int rr = w * 8 + q;
                const float s0 = Sc[rr * 128 + lane], s1 = Sc[rr * 128 + 64 + lane];
                const unsigned u0 = sortable_u32(s0 + rb0), u1 = sortable_u32(s1 + rb1);
                unsigned thr = 0u;
                for (int bit = 31; bit >= 0; --bit) { const unsigned cand = thr | (1u << bit); const int n = popc64(__ballot(u0 >= cand)) + popc64(__ballot(u1 >= cand)); if (n >= 8) thr = cand; }
                const bool gt0 = u0 > thr, gt1 = u1 > thr, eq0 = u0 == thr, eq1 = u1 == thr;
                const unsigned long long me0 = __ballot(eq0), me1 = __ballot(eq1);
                const int need = 8 - popc64(__ballot(gt0)) - popc64(__ballot(gt1));
                const bool sel0 = gt0 || (eq0 && rank_lt(me0) < need), sel1 = gt1 || (eq1 && popc64(me0) + rank_lt(me1) < need);
                const unsigned long long m0 = __ballot(sel0), m1 = __ballot(sel1);
                const float tot = wave_sum((sel0 ? s0 : 0.f) + (sel1 ? s1 : 0.f));
                if (sel0) { const int k = rank_lt(m0); const int lr = __hip_atomic_fetch_add(&hist[lane], 1, __ATOMIC_RELAXED, __HIP_MEMORY_SCOPE_WORKGROUP); sel[rr * 8 + k] = (lane << 16) | lr; selg[rr * 8 + k] = s0 / tot * 2.5f; }
                if (sel1) { const int k = popc64(m0) + rank_lt(m1); const int lr = __hip_atomic_fetch_add(&hist[64 + lane], 1, __ATOMIC_RELAXED, __HIP_MEMORY_SCOPE_WORKGROUP); sel[rr * 8 + k] = ((64 + lane) << 16) | lr; selg[rr * 8 + k] = s1 / tot * 2.5f; } }
        }
        __syncthreads();
        if (c.tid < 128) gbase[c.tid] = atomicAdd(&cnt[c.tid * 1024], hist[c.tid]);
        __syncthreads();
        { const int sv = sel[c.tid], e = sv >> 16, lr = sv & 0xffff; const int slot = (grp * 64 + (c.tid >> 3)) * 8 + (c.tid & 7);
          list[(size_t)e * LISTCAP + gbase[e] + lr] = slot; gate[slot] = selg[c.tid]; }
    }
}

struct MoeOrder {
    const char* Abase; const char* Bbase; size_t Bstride; int K, NT, NTG, total, G, c, mode, tid0;
    LAS int* tab; LAS int* desc;
    __device__ __forceinline__ bool next(int i, g8::Unit& u) const {
        const int ip = i / NTG, q = i - ip * NTG;
        const long L = (long)ip * G + c; if (L >= total || ip >= TAB_SLOTS) return false;
        const int d = desc[ip]; const int e = d >> 12, pn = (d & 15) * NTG + q;
        u.pm = (d >> 4) & 255; u.pn = pn; u.aux = ip; u.A = Abase; u.B = Bbase + (size_t)e * Bstride + (size_t)pn * 256 * K * 2; return true;
    }
    __device__ __forceinline__ void aoff(const g8::Unit& u, int tid, unsigned (&o)[2][2]) const {
#pragma unroll
        for (int i = 0; i < 2; ++i) { int R, C; g8::stage_rc(tid * 16 + i * 8192, R, C);
#pragma unroll
            for (int h = 0; h < 2; ++h) { int s = tab[u.aux * 256 + h * 128 + R]; s = s < 0 ? 0 : s; const int row = mode ? s : (s < TK ? (s >> 3) : s - TK);
                o[h][i] = (unsigned)(row * K + C) * 2u; } }
    }
};
__device__ __forceinline__ void moe_setup(const Ctx& c, MoeOrder& S, const int* cnt, int NT, int NTG) {
    LAS int* pref = (LAS int*)(c.lds + LDS_PREF); LAS int* desc = (LAS int*)(c.lds + LDS_DESC); LAS int* tab = (LAS int*)(c.lds + LDS_TAB);
    const int* list = (const int*)(c.ws + WS_LIST);
    if (c.tid < 64) { int nb[3]; int loc = 0;
#pragma unroll
        for (int q = 0; q < 3; ++q) { const int e = c.tid * 3 + q; int n = 0; if (e < NE) n = cnt[e * 1024]; else if (e == NE) n = T; nb[q] = (n + 255) >> 8; loc += nb[q]; }
        int inc = loc;
#pragma unroll
        for (int o = 1; o < 64; o <<= 1) { const int v = __shfl_up(inc, o); if (c.tid >= o) inc += v; }
        int acc = inc - loc;
#pragma unroll
        for (int q = 0; q < 3; ++q) { const int e = c.tid * 3 + q; if (e <= NE1) pref[e] = acc; acc += nb[q]; } }
    __syncthreads();
    const int NG = NT / NTG; const int total = pref[NE1] * NG;
    LAS float* gtab = (LAS float*)(c.lds + LDS_GTAB); const float* gate = (const float*)(c.ws + WS_GATE);
    S.NT = NT; S.NTG = NTG; S.total = total; S.G = c.G; S.c = c.bid; S.tab = tab; S.desc = desc;
    {
        int sv[TAB_SLOTS / 2];
#pragma unroll
        for (int k = 0; k < TAB_SLOTS / 2; ++k) { const int i = (c.tid >> 8) + 2 * k; sv[k] = -2;
            const long L = (long)i * c.G + c.bid;
            if (L < total) {
                int wgid = (int)L; { const int q = total / 8, r = total % 8, xcd = wgid % 8, off = wgid / 8; wgid = (xcd < r ? xcd * (q + 1) : r * (q + 1) + (xcd - r) * q) + off; }
                const int rbg = wgid / NG, pn = wgid % NG;
                int lo = 0, hi = NE1;
                while (hi - lo > 1) { const int mid = (lo + hi) >> 1; if (pref[mid] <= rbg) lo = mid; else hi = mid; }
                const int e = lo, rb = rbg - pref[e], n = e < NE ? cnt[e * 1024] : T;
                if ((c.tid & 255) == 0) desc[i] = (e << 12) | (rb << 4) | pn;
                const int r = rb * 256 + (c.tid & 255); sv[k] = -1; if (r < n) sv[k] = (e < NE) ? list[(size_t)e * LISTCAP + r] : TK + r; } }
#pragma unroll
        for (int k = 0; k < TAB_SLOTS / 2; ++k) { const int i = (c.tid >> 8) + 2 * k; if (sv[k] != -2) { tab[i * 256 + (c.tid & 255)] = sv[k]; if (S.mode) gtab[i * 256 + (c.tid & 255)] = sv[k] >= 0 ? gate[sv[k]] : 0.f; } }
    }
    __syncthreads();
}
struct EpiMoeGU {
    static constexpr bool PERM = true;
    bf16_t* H; LAS int* tab;
    __device__ __forceinline__ void operator()(const f32x4 (&acc)[2][2][4][2], const g8::Unit& u, int wr, int wc, int fr, int fq) const {
#pragma unroll
        for (int ai = 0; ai < 2; ++ai)
#pragma unroll
            for (int m = 0; m < 4; ++m) { const int r = ai * 128 + wr * 64 + m * 16 + fr; const int s = tab[u.aux * 256 + r];
                if (s >= 0) { u32x4 w;
#pragma unroll
                    for (int n = 0; n < 2; ++n) { const f32x4 g = acc[ai][0][m][n], up = acc[ai][1][m][n];
                        w[2 * n] = pk2(siluf_(g[0]) * up[0], siluf_(g[1]) * up[1]); w[2 * n + 1] = pk2(siluf_(g[2]) * up[2], siluf_(g[3]) * up[3]); }
                    *(u32x4*)(H + (size_t)s * ED + u.pn * 128 + wc * 32 + fq * 8) = w; } }
    }
};
struct EpiMoeDN {
    static constexpr bool PERM = true;
    unsigned char* Y; LAS float* gtab; LAS int* tab;
    __device__ __forceinline__ void operator()(const f32x4 (&acc)[2][2][4][2], const g8::Unit& u, int wr, int wc, int fr, int fq) const {
#pragma unroll
        for (int ai = 0; ai < 2; ++ai)
#pragma unroll
            for (int m = 0; m < 4; ++m) { const int r = ai * 128 + wr * 64 + m * 16 + fr; const int s = tab[u.aux * 256 + r];
                if (s >= TK) {
#pragma unroll
                    for (int bj = 0; bj < 2; ++bj) { u32x4 w;
#pragma unroll
                        for (int n = 0; n < 2; ++n) { const f32x4 a = acc[ai][bj][m][n]; w[2 * n] = pk2(a[0], a[1]); w[2 * n + 1] = pk2(a[2], a[3]); }
                        *(u32x4*)((bf16_t*)(Y + (size_t)TK * D) + (size_t)(s - TK) * D + u.pn * 256 + bj * 128 + wc * 32 + fq * 8) = w; }
                } else if (s >= 0) { const float gt = gtab[u.aux * 256 + r] * 64.f;
#pragma unroll
                    for (int bj = 0; bj < 2; ++bj) { u32x2 w;
#pragma unroll
                        for (int n = 0; n < 2; ++n) { f32x4 a = acc[ai][bj][m][n] * gt;
#pragma unroll
                            for (int e = 0; e < 4; ++e) a[e] = fminf(fmaxf(a[e], -448.f), 448.f);
                            unsigned pw = 0u; pw = __builtin_amdgcn_cvt_pk_fp8_f32(a[0], a[1], pw, false); pw = __builtin_amdgcn_cvt_pk_fp8_f32(a[2], a[3], pw, true); w[n] = pw; }
                        *(u32x2*)(Y + (size_t)s * D + u.pn * 256 + bj * 128 + wc * 32 + fq * 8) = w; } } }
    }
};
__device__ __forceinline__ void phase_moe_gu(const Ctx& c, int L) {
    MoeOrder S; S.Abase = (const char*)(c.ws + WS_XB); S.Bbase = (const char*)(c.ws + WS_WGU) + (size_t)L * NE1 * 512 * D * 2; S.Bstride = (size_t)512 * D * 2; S.K = D; S.mode = 0; S.tid0 = c.tid;
    moe_setup(c, S, (const int*)(c.ws + CTL_CNT) + L * NE * 1024, 2, 1);
    EpiMoeGU E{(bf16_t*)(c.ws + WS_HID), S.tab};
    g8::gemm_phase<EpiMoeGU, MoeOrder>(c.lds + LDS_STAGE, D, S, E);
}
__device__ __forceinline__ void phase_moe_dn(const Ctx& c, int L) {
    MoeOrder S; S.Abase = (const char*)(c.ws + WS_HID); S.Bbase = (const char*)(c.ws + WS_WDN) + (size_t)L * NE1 * D * ED * 2; S.Bstride = (size_t)D * ED * 2; S.K = ED; S.mode = 1; S.tid0 = c.tid;
    moe_setup(c, S, (const int*)(c.ws + CTL_CNT) + L * NE * 1024, 4, 2);
    EpiMoeDN E{(unsigned char*)(c.ws + WS_U1), (LAS float*)(c.lds + LDS_GTAB), S.tab};
    g8::gemm_phase<EpiMoeDN, MoeOrder>(c.lds + LDS_STAGE, ED, S, E);
}

constexpr int PH_PER_LAYER = 9;
constexpr int N_PHASES = 1 + 4 * PH_PER_LAYER;

__global__ void __launch_bounds__(NTHREADS, 2) fwd_kernel(Params p) {
    extern __shared__ __attribute__((aligned(16))) unsigned char lds_raw[];
    LAS unsigned char* const lds0 = (LAS unsigned char*)lds_raw;
    const int wave_id = __builtin_amdgcn_readfirstlane((int)threadIdx.x >> 6);
    volatile LAS unsigned* misc = (volatile LAS unsigned*)(lds0 + LDS_MISC);
    if (threadIdx.x < 4) misc[threadIdx.x] = 0u;
    __syncthreads();
    const int lo = p.ph_lo, hi = p.ph_hi;
    XcdBarrier bar; bar.bar = (unsigned*)(p.ws + WS_CTL); bar.x = 0; bar.st = misc;
    if (hi - lo > 1) bar = xcd_barrier_post((unsigned*)(p.ws + WS_CTL), misc);
#define MKCTX() Ctx c; { int wv_ = wave_id; asm volatile("" : "+s"(wv_)); int tid_ = wv_ * 64 + (int)__builtin_amdgcn_mbcnt_hi(~0u, __builtin_amdgcn_mbcnt_lo(~0u, 0u)); asm volatile("" : "+v"(tid_)); int bid_ = blockIdx.x; asm volatile("" : "+s"(bid_)); unsigned long long ws_ = (unsigned long long)p.ws; asm volatile("" : "+s"(ws_)); \
        c.in = p.in; c.out = (float*)p.out; c.ws = (unsigned char*)(GAS unsigned char*)ws_; c.lds = lds0; c.tid = tid_; c.lane = tid_ & 63; c.wid = __builtin_amdgcn_readfirstlane(tid_ >> 6); c.bid = bid_; c.G = gridDim.x; \
        c.gtid = c.bid * NTHREADS + c.tid; c.gthreads = c.G * NTHREADS; c.gw = c.bid * 8 + c.wid; c.nwaves = c.G * 8; } unsigned char* const ws = c.ws; (void)ws
    int id = 0;
#ifndef PMASK
#define PMASK 0xffffffffu
#endif
#ifndef DUPMASK
#define DUPMASK 0u
#endif
#define PHASE(k, body) do { if (((PMASK >> (k)) & 1u) && lo <= id && id < hi) { MKCTX(); body; if ((DUPMASK >> (k)) & 1u) { body; } if (id + 1 < hi) xcd_barrier(bar, c.tid == 0); } ++id; } while (0)
    PHASE(0, phase_convert(c));
#pragma unroll 1
    for (int L = 0; L < 4; ++L) {
        const int j = L >> 1; const bool cd = (L & 1);
        if (cd) {
            PHASE(1, phase_cd_inproj(c, j));
        } else {
            PHASE(2, phase_ab_inproj(c, j));
        }
        if (!cd) { PHASE(3, phase_ab_p1(c)); PHASE(4, phase_ab_p2(c, j)); PHASE(16, phase_ab_p3(c)); }
        else     { PHASE(5, phase_cd_p1(c, j)); PHASE(15, phase_cd_scan2(c)); id += 1; }
        {
            const size_t Woff = cd ? WS_WCDOUT + (size_t)j * D * CD_OUT * 2 : WS_WABOUT + (size_t)j * D * AB_OUT * 2;
            const int K = cd ? CD_OUT : AB_OUT; const float* bias = cd ? (const float*)p.in[18] + (size_t)j * D : (const float*)p.in[5] + (size_t)j * D;
            PHASE(8, phase_dense(c, (const bf16_t*)(ws + WS_YCAT), (const bf16_t*)(ws + Woff), T, D, K, (bf16_t*)(ws + WS_HB), D, bias));
        }
        PHASE(9, phase_ln_route(c, L));
        PHASE(12, phase_moe_gu(c, L));
        PHASE(13, phase_moe_dn(c, L));
        PHASE(14, phase_ln_moe(c, (const float*)p.in[29] + (size_t)L * D, (const float*)p.in[30] + (size_t)L * D, L == 3 ? (float*)p.out : (float*)nullptr));
    }
#undef PHASE
}

extern "C" void kernel_launch(void* const* d_in, const int* in_sizes, int n_in, void* d_out, int out_size, void* d_ws, size_t ws_size, hipStream_t stream) {
    static int grid = 0;
    if (grid == 0) {
        if (n_in != 31 || out_size != T * D || ws_size < WS_END) { fprintf(stderr, "kernel_launch: unexpected shapes (n_in %d out %d ws %zu need %zu)\n", n_in, out_size, ws_size, (size_t)WS_END); grid = -1; return; }
        int dev = 0, cus = 0, per_cu = 0;
        if (hipGetDevice(&dev) != hipSuccess || hipDeviceGetAttribute(&cus, hipDeviceAttributeMultiprocessorCount, dev) != hipSuccess) { grid = -1; return; }
        if (hipFuncSetAttribute((const void*)fwd_kernel, hipFuncAttributeMaxDynamicSharedMemorySize, LDS_BYTES) != hipSuccess) { fprintf(stderr, "kernel_launch: hipFuncSetAttribute failed\n"); grid = -1; return; }
        if (hipOccupancyMaxActiveBlocksPerMultiprocessor(&per_cu, (const void*)fwd_kernel, NTHREADS, LDS_BYTES) != hipSuccess || per_cu < 1) fprintf(stderr, "kernel_launch: occupancy query says %d\n", per_cu);
        (void)hipGetLastError();
        grid = cus;
    }
    if (grid < 0) return;
    (void)hipMemsetAsync((char*)d_ws + WS_CTL, 0, CTL_BYTES, stream);
    Params p{};
    for (int i = 0; i < 31; ++i) p.in[i] = (const GAS float*)d_in[i];
    p.out = (GAS float*)d_out; p.ws = (GAS unsigned char*)d_ws;
#if N_LAUNCH_MODE == 1
    p.ph_lo = 0; p.ph_hi = N_PHASES;
    hipLaunchKernelGGL(fwd_kernel, dim3(grid), dim3(NTHREADS), LDS_BYTES, stream, p);
#else
    for (int i = 0; i < N_PHASES; ++i) { p.ph_lo = i; p.ph_hi = i + 1; hipLaunchKernelGGL(fwd_kernel, dim3(grid), dim3(NTHREADS), LDS_BYTES, stream, p); }
#endif
}
```

```cpp
#include <hip/hip_runtime.h>
#include <cstdio>
#include <cstdint>

#define LAS __attribute__((address_space(3)))
typedef unsigned short bf16_t;
typedef short bf16x8 __attribute__((ext_vector_type(8)));
typedef float f32x4 __attribute__((ext_vector_type(4)));
typedef float f32x2 __attribute__((ext_vector_type(2)));
typedef unsigned u32x4 __attribute__((ext_vector_type(4)));
typedef unsigned u32x2 __attribute__((ext_vector_type(2)));

constexpr int T = 16384, D = 1024, SEQ = 8192;
constexpr int AB_IN = 4352, AB_OUT = 2048, CD_IN = 4608, CD_OUT = 2304;
constexpr int NE = 128, NE1 = 129, TOPK = 8, ED = 256;
constexpr int TK = T * TOPK;
constexpr int NSLOT = TK + T;
constexpr int LISTCAP = 16384;
constexpr float ALPHA = 1.681792830507429f;
constexpr float LN_EPS = 1e-5f;

#ifndef N_LAUNCH_MODE
#define N_LAUNCH_MODE 1
#endif

constexpr size_t al256(size_t x) { return (x + 255) & ~(size_t)255; }
constexpr size_t WS_CTL    = 0;
constexpr size_t CTL_BYTES = 65536 + (size_t)4 * 128 * 4096;
constexpr size_t CTL_CNT   = 65536;
constexpr size_t WS_WABIN  = CTL_BYTES;
constexpr size_t WS_WABOUT = WS_WABIN  + al256((size_t)2 * AB_IN * D * 2);
constexpr size_t WS_WCDIN  = WS_WABOUT + al256((size_t)2 * D * AB_OUT * 2);
constexpr size_t WS_WCDOUT = WS_WCDIN  + al256((size_t)2 * CD_IN * D * 2);
constexpr size_t WS_WRT    = WS_WCDOUT + al256((size_t)2 * D * CD_OUT * 2);
constexpr size_t WS_WGU    = WS_WRT    + al256((size_t)4 * 256 * D * 2);
constexpr size_t WS_WDN    = WS_WGU    + al256((size_t)4 * NE1 * 512 * D * 2);
constexpr size_t WS_X      = WS_WDN    + al256((size_t)4 * NE1 * D * ED * 2);
constexpr size_t WS_HB     = WS_X;
constexpr size_t WS_XB     = WS_X      + al256((size_t)T * D * 4);
constexpr size_t WS_U1     = WS_XB     + al256((size_t)T * D * 2);
constexpr size_t U1_BYTES  = al256((size_t)NSLOT * D * 2) > al256((size_t)T * CD_IN * 4) ? al256((size_t)NSLOT * D * 2) : al256((size_t)T * CD_IN * 4);
constexpr size_t WS_U2     = WS_U1     + U1_BYTES;
constexpr size_t U2_BYTES  = al256((size_t)T * 1280 * 4 * 3);
constexpr size_t WS_YCAT   = WS_U2     + U2_BYTES;
constexpr size_t WS_H      = WS_YCAT   + al256((size_t)T * CD_OUT * 2);
constexpr size_t WS_ZR     = WS_H      + al256((size_t)T * D * 4);
constexpr size_t WS_HID    = WS_ZR     + al256((size_t)T * 256 * 4);
constexpr size_t WS_LIST   = WS_HID    + al256((size_t)NSLOT * ED * 2);
constexpr size_t WS_GATE   = WS_LIST   + al256((size_t)NE * LISTCAP * 4);
constexpr size_t WS_ROPEA  = WS_GATE   + al256((size_t)NSLOT * 4);
constexpr size_t WS_ROPER  = WS_ROPEA  + al256((size_t)SEQ * 32 * 8);
constexpr size_t WS_BIASP  = WS_ROPER  + al256((size_t)SEQ * 64 * 8);
constexpr size_t WS_WLRU   = WS_BIASP  + al256((size_t)2 * AB_IN * 4);
constexpr size_t WS_SPL    = WS_WLRU   + al256((size_t)2 * 5 * 2 * 65536 * 2);
constexpr size_t WS_END    = WS_SPL    + al256((size_t)2 * 1280 * 4);
constexpr size_t CD_GU = WS_U1, CD_GVT = WS_U1 + 32 * (1024 * 1024), CD_GG = WS_U1 + 64 * (1024 * 1024), CD_XR = WS_U1 + 104 * (1024 * 1024), CD_STATS = WS_U1 + 144 * (1024 * 1024);
constexpr size_t MB = 1024 * 1024;
constexpr size_t AB_QB = WS_U1, AB_KB = WS_U1 + 32 * MB, AB_VT = WS_U1 + 36 * MB, AB_RQB = WS_U1 + 40 * MB, AB_RKB = WS_U1 + 56 * MB, AB_RKDT = WS_U1 + 72 * MB,
                 AB_RVT = WS_U1 + 88 * MB, AB_RGB = WS_U1 + 120 * MB, AB_KV = WS_U1 + 152 * MB  , AB_SPREV = WS_U1 + 216 * MB  ;
static_assert(AB_SPREV + 32 * MB <= WS_U1 + U1_BYTES, "U1 map");

__device__ __forceinline__ float bf2f(bf16_t b) { return __uint_as_float(((unsigned)b) << 16); }
__device__ __forceinline__ unsigned pk2(float lo, float hi) { unsigned r; asm("v_cvt_pk_bf16_f32 %0, %1, %2" : "=v"(r) : "v"(lo), "v"(hi)); return r; }
__device__ __forceinline__ bf16_t f2bf(float f) { return (bf16_t)(pk2(f, f) & 0xffffu); }
__device__ __forceinline__ float wave_sum(float v) {
#pragma unroll
    for (int o = 32; o; o >>= 1) v += __shfl_xor(v, o);
    return v; }
__device__ __forceinline__ float wave_max(float v) {
#pragma unroll
    for (int o = 32; o; o >>= 1) v = fmaxf(v, __shfl_xor(v, o));
    return v; }
__device__ __forceinline__ float gelu_tanh(float x) { const float u = 0.7978845608028654f * (x + 0.044715f * x * x * x); return 0.5f * x * (1.f + tanhf(u)); }
__device__ __forceinline__ float sigmoidf_(float x) { return __builtin_amdgcn_rcpf(1.f + __expf(-x)); }
__device__ __forceinline__ float siluf_(float x) { return x * __builtin_amdgcn_rcpf(1.f + __expf(-x)); }

#define XB_TMO      128
#define XB_XCNT(j)  (256  + 64 * (j))
#define XB_XSUB(j)  (1280 + 64 * (j))
#define XB_XGEN(j)  (2304 + 64 * (j))
#define XB_TOP      3328
#define XB_TOPGEN   3392
#define XCD_BAR_WORDS 3456
#define XB_SPIN_CAP (1u << 22)

__device__ __forceinline__ unsigned xb_ld(unsigned* p)              { return __hip_atomic_load(p, __ATOMIC_RELAXED, __HIP_MEMORY_SCOPE_AGENT); }
__device__ __forceinline__ unsigned xb_add(unsigned* p, unsigned v) { return __hip_atomic_fetch_add(p, v, __ATOMIC_RELAXED, __HIP_MEMORY_SCOPE_AGENT); }
__device__ __forceinline__ unsigned xb_xcc_id() { return (unsigned)__builtin_amdgcn_s_getreg((3 << 11) | 20) & 0xFu; }
#define XB_SPIN(cond, bar) do { unsigned _sp = 0; while (cond) { __builtin_amdgcn_s_sleep(1); \
    if ((++_sp & 255u) == 0u) { if (xb_ld(&(bar)[XB_TMO])) break; if (_sp > XB_SPIN_CAP) { atomicAdd(&(bar)[XB_TMO], 1u); break; } } } } while (0)

struct XcdBarrier { unsigned* bar; unsigned x; volatile LAS unsigned* st; };

__device__ __forceinline__ XcdBarrier xcd_barrier_post(unsigned* bar, volatile LAS unsigned* st) {
    XcdBarrier b; b.bar = bar; b.x = xb_xcc_id(); b.st = st;
    if (threadIdx.x == 0) (void)xb_add(&bar[XB_XCNT(b.x)], 1u);
    return b;
}
__device__ __forceinline__ void xcd_barrier_complete(unsigned* bar, unsigned x, unsigned& nloc, unsigned& nx) {
    const unsigned G = gridDim.x * gridDim.y * gridDim.z;
    unsigned sum, cnt, mine, sp = 0u;
    for (;;) {
        sum = 0u; cnt = 0u; mine = 0u;
#pragma unroll
        for (unsigned j = 0; j < 16; ++j) { const unsigned c = xb_ld(&bar[XB_XCNT(j)]); sum += c; cnt += (c > 0u) ? 1u : 0u; mine = (j == x) ? c : mine; }
        if (sum == G) break;
        __builtin_amdgcn_s_sleep(1);
        if ((++sp & 255u) == 0u) { if (xb_ld(&bar[XB_TMO])) break; if (sp > XB_SPIN_CAP) { atomicAdd(&bar[XB_TMO], 1u); break; } }
    }
    nloc = mine > 0u ? mine : 1u; nx = cnt > 0u ? cnt : 1u;
}
__device__ __forceinline__ void xcd_barrier(const XcdBarrier& b, const bool leader  ) {
    asm volatile("s_waitcnt vmcnt(0)" ::: "memory");
    __syncthreads();
    if (leader) {
        unsigned* bar = b.bar;
        __builtin_amdgcn_s_waitcnt(0);
        unsigned nloc = b.st[0], nx = b.st[1];
        if (nloc == 0u) { xcd_barrier_complete(bar, b.x, nloc, nx); b.st[0] = nloc; b.st[1] = nx; }
        const unsigned old = xb_add(&bar[XB_XSUB(b.x)], 1u);
        const unsigned gen = old / nloc;
        if (old + 1u == (gen + 1u) * nloc) {
            __builtin_amdgcn_fence(__ATOMIC_RELEASE, "agent");
            asm volatile("s_waitcnt vmcnt(0)" ::: "memory");
            const unsigned og = xb_add(&bar[XB_TOP], 1u);
            const unsigned tg = og / nx;
            if (og + 1u == (tg + 1u) * nx) xb_add(&bar[XB_TOPGEN], 1u);
            else XB_SPIN(xb_ld(&bar[XB_TOPGEN]) == tg, bar);
            __builtin_amdgcn_fence(__ATOMIC_ACQUIRE, "agent");
            xb_add(&bar[XB_XGEN(b.x)], 1u);
            asm volatile("s_waitcnt vmcnt(0)" ::: "memory");
        } else {
            XB_SPIN(xb_ld(&bar[XB_XGEN(b.x)]) == gen, bar);
            __builtin_amdgcn_fence(__ATOMIC_ACQUIRE, "agent");
            asm volatile("s_waitcnt vmcnt(0)" ::: "memory");
        }
    }
    __syncthreads();
}

namespace g8 {
constexpr int BM = 256, BK = 64, HALF = 128, HTB = HALF * BK * 2, STAGE_BYTES = 8 * HTB, NXCD = 8, WGM = 8;
__device__ __forceinline__ int lds_byte(int r, int c) { const int st = (r >> 4) * 2 + (c >> 5), rr = r & 15, cc = c & 31, ob = rr * 64 + cc * 2; return st * 1024 + (ob ^ (((ob >> 9) & 1) << 5)); }
__device__ __forceinline__ void stage_rc(int b, int& R, int& C) { const int st = b / 1024, sb = b % 1024, swz = sb ^ (((sb >> 9) & 1) << 5); R = (st >> 1) * 16 + swz / 64; C = (st & 1) * 32 + (swz % 64) / 2; }
__device__ __forceinline__ int perm32(int rho) { const int n = rho >> 4, i = rho & 15; return 8 * (i >> 2) + 4 * n + (i & 3); }

struct Unit { const char* A; const char* B; int pm, pn, aux; };

struct DenseOrder {
    const char* A; const char* Bt; int nM, nN, nwg, G, c, K, tid0;
    __device__ void init(const void* A_, const void* Bt_, int M, int N, int K_, int G_, int c_) { A = (const char*)A_; Bt = (const char*)Bt_; nM = M / BM; nN = N / BM; nwg = nM * nN; G = G_; c = c_; K = K_; }
    __device__ __forceinline__ bool next(int i, Unit& u) const {
        const long L = (long)i * G + c; if (L >= nwg) return false;
        int wgid = (int)L; { const int q = nwg / NXCD, r = nwg % NXCD, xcd = wgid % NXCD, off = wgid / NXCD; wgid = (xcd < r ? xcd * (q + 1) : r * (q + 1) + (xcd - r) * q) + off; }
        const int nig = WGM * nN, gid = wgid / nig, fm = gid * WGM, gsz = (nM - fm) < WGM ? (nM - fm) : WGM;
        u.pm = fm + ((wgid % nig) % gsz); u.pn = (wgid % nig) / gsz; u.aux = 0;
        u.A = A + (size_t)u.pm * BM * K * 2; u.B = Bt + (size_t)u.pn * BM * K * 2; return true;
    }
    __device__ __forceinline__ void aoff(const Unit&, int tid, unsigned (&o)[2][2]) const {
#pragma unroll
        for (int i = 0; i < 2; ++i) { int R, C; stage_rc(tid * 16 + i * 8192, R, C);
            o[0][i] = (unsigned)(R * K + C) * 2u; o[1][i] = (unsigned)((R + HALF) * K + C) * 2u; }
    }
};

__device__ __forceinline__ unsigned cvt_pk_bf16(float lo, float hi) { unsigned r; asm volatile("v_cvt_pk_bf16_f32 %0, %1, %2" : "=v"(r) : "v"(lo), "v"(hi)); return r; }

struct EpiF32 {
    static constexpr bool PERM = false;
    float* C; int ldc; const float* bias;
    __device__ __forceinline__ void operator()(const f32x4 (&acc)[2][2][4][2], const Unit& u, int wr, int wc, int fr, int fq) const {
        const int row0 = u.pm * BM + wr * 64 + fr, col0 = u.pn * BM + wc * 32 + 4 * fq;
        f32x4 bv[2][2];
#pragma unroll
        for (int bj = 0; bj < 2; ++bj)
#pragma unroll
            for (int n = 0; n < 2; ++n) bv[bj][n] = bias ? *(const f32x4*)(bias + col0 + bj * HALF + n * 16) : (f32x4){0.f, 0.f, 0.f, 0.f};
#pragma unroll
        for (int ai = 0; ai < 2; ++ai)
#pragma unroll
            for (int m = 0; m < 4; ++m) { float* rowp = C + (size_t)(row0 + ai * HALF + m * 16) * ldc + col0;
#pragma unroll
                for (int bj = 0; bj < 2; ++bj)
#pragma unroll
                    for (int n = 0; n < 2; ++n) *(f32x4*)(rowp + bj * HALF + n * 16) = acc[ai][bj][m][n] + bv[bj][n]; }
    }
};

struct EpiBf16 {
    static constexpr bool PERM = true;
    bf16_t* O; int ldc; const float* bias;
    __device__ __forceinline__ void operator()(const f32x4 (&acc)[2][2][4][2], const Unit& u, int wr, int wc, int fr, int fq) const {
        const int row0 = u.pm * BM + wr * 64 + fr, col0 = u.pn * BM + wc * 32 + 8 * fq;
        f32x4 bv[2][2];
#pragma unroll
        for (int bj = 0; bj < 2; ++bj)
#pragma unroll
            for (int n = 0; n < 2; ++n) bv[bj][n] = *(const f32x4*)(bias + col0 + bj * HALF + 4 * n);
#pragma unroll
        for (int ai = 0; ai < 2; ++ai)
#pragma unroll
            for (int m = 0; m < 4; ++m) { bf16_t* rowp = O + (size_t)(row0 + ai * HALF + m * 16) * ldc + col0;
#pragma unroll
                for (int bj = 0; bj < 2; ++bj) { const f32x4 v0 = acc[ai][bj][m][0] + bv[bj][0], v1 = acc[ai][bj][m][1] + bv[bj][1];
                    u32x4 w; w[0] = cvt_pk_bf16(v0[0], v0[1]); w[1] = cvt_pk_bf16(v0[2], v0[3]); w[2] = cvt_pk_bf16(v1[0], v1[1]); w[3] = cvt_pk_bf16(v1[2], v1[3]);
                    *(u32x4*)(rowp + bj * HALF) = w; } }
    }
};

template <class Epi, class Sched>
__device__ __forceinline__ void gemm_phase(LAS unsigned char* lds, const int K, const Sched& S, const Epi& E) {
    int tid_ = S.tid0; asm volatile("" : "+v"(tid_));
    const int tid = tid_, wid = __builtin_amdgcn_readfirstlane(tid >> 6), lane = tid & 63, wr = wid >> 2, wc = wid & 3, fr = lane & 15, fq = lane >> 4;
    const int nt = K / BK;
    unsigned voffB[2];
#pragma unroll
    for (int i = 0; i < 2; ++i) { int R, C; stage_rc(tid * 16 + i * 8192, R, C); const int Rb = Epi::PERM ? ((R & ~31) + perm32(R & 31)) : R;
        voffB[i] = (unsigned)(Rb * K + C) * 2u; }
    const size_t kstep = (size_t)(BK * 2);
    const size_t hstep = (size_t)HALF * K * 2;
    const unsigned ldsw = (unsigned)wid * 1024u;
    const int aoff = lds_byte(wr * 64 + fr, fq * 8), boff = lds_byte(wc * 32 + fr, fq * 8);
#define G8_SA(b, h) (((b) * 2 + (h)) * HTB)
#define G8_SB(b, h) ((4 + (b) * 2 + (h)) * HTB)
#define G8_STAGE(bufoff, gbase, voff) do { _Pragma("unroll") for (int _i = 0; _i < 2; ++_i) \
        __builtin_amdgcn_global_load_lds((const unsigned*)((const char*)(gbase) + (voff)[_i]), (LAS unsigned*)(lds + (bufoff) + ldsw + _i * 8192), 16, 0, 0); } while (0)
#define G8_LDA(dst, b, h) do { _Pragma("unroll") for (int m = 0; m < 4; ++m) _Pragma("unroll") for (int k = 0; k < 2; ++k) dst[m][k] = *(const LAS bf16x8*)(lds + G8_SA(b, h) + aoff + m * 2048 + k * 1024); } while (0)
#define G8_LDB(dst, b, h) do { _Pragma("unroll") for (int n = 0; n < 2; ++n) _Pragma("unroll") for (int k = 0; k < 2; ++k) dst[n][k] = *(const LAS bf16x8*)(lds + G8_SB(b, h) + boff + n * 2048 + k * 1024); } while (0)
#define G8_MMA(ai, bj, At, Bt) do { __builtin_amdgcn_s_setprio(1); _Pragma("unroll") for (int m = 0; m < 4; ++m) _Pragma("unroll") for (int n = 0; n < 2; ++n) _Pragma("unroll") for (int k = 0; k < 2; ++k) \
        acc[ai][bj][m][n] = __builtin_amdgcn_mfma_f32_16x16x32_bf16(Bt[n][k], At[m][k], acc[ai][bj][m][n], 0, 0, 0); __builtin_amdgcn_s_setprio(0); } while (0)
#define G8_WAIT_V(n) asm volatile("s_waitcnt vmcnt(" #n ")" ::: "memory")
#define G8_WAIT_L(n) asm volatile("s_waitcnt lgkmcnt(" #n ")" ::: "memory")
#define G8_BAR __builtin_amdgcn_s_barrier()
#define G8_SCHED __builtin_amdgcn_sched_barrier(0)
    Unit cur, nxt; int ui = 0;
    if (!S.next(0, cur)) return;
    f32x4 acc[2][2][4][2];
#pragma unroll
    for (int a = 0; a < 2; ++a)
#pragma unroll
        for (int b = 0; b < 2; ++b)
#pragma unroll
            for (int m = 0; m < 4; ++m)
#pragma unroll
                for (int n = 0; n < 2; ++n) acc[a][b][m][n] = (f32x4){0.f, 0.f, 0.f, 0.f};
    bf16x8 At[4][2], B0[2][2], B1[2][2];
    unsigned oc[2][2];
    S.aoff(cur, tid, oc);
    const char* cA = cur.A; const char* cB = cur.B;
    G8_STAGE(G8_SB(0, 0), cB, voffB); G8_STAGE(G8_SA(0, 0), cA, oc[0]); G8_STAGE(G8_SB(0, 1), cB + hstep, voffB); G8_STAGE(G8_SA(0, 1), cA, oc[1]);
    if (wr == 1) G8_BAR;
    G8_WAIT_V(4); G8_BAR;
    G8_STAGE(G8_SB(1, 0), cB + kstep, voffB); G8_STAGE(G8_SA(1, 0), cA + kstep, oc[0]); G8_STAGE(G8_SB(1, 1), cB + hstep + kstep, voffB);
    G8_WAIT_V(6); G8_BAR;
    for (;;) {
        const bool has_next = S.next(ui + 1, nxt);
        const char* nA = has_next ? nxt.A : cA; const char* nB = has_next ? nxt.B : cB;
#pragma unroll 1
        for (int t = 0; t < nt; t += 2) {
            const bool last = (t == nt - 2);
            const char* a1 = cA + (size_t)(t + 1) * kstep;
            const char* a2 = last ? nA : cA + (size_t)(t + 2) * kstep; const char* b2 = last ? nB : cB + (size_t)(t + 2) * kstep;
            const char* a3 = a2 + kstep; const char* b3 = b2 + kstep;
            G8_LDB(B0, 0, 0); G8_SCHED; G8_LDA(At, 0, 0); G8_STAGE(G8_SA(1, 1), a1, oc[1]);
            if (last && has_next) S.aoff(nxt, tid, oc);
            G8_WAIT_L(8); G8_BAR; G8_WAIT_L(0); G8_MMA(0, 0, At, B0); G8_BAR; G8_SCHED;
            G8_LDB(B1, 0, 1); G8_STAGE(G8_SB(0, 0), b2, voffB);
            G8_BAR; G8_WAIT_L(0); G8_MMA(0, 1, At, B1); G8_BAR;
            G8_LDA(At, 0, 1); G8_STAGE(G8_SA(0, 0), a2, oc[0]);
            G8_BAR; G8_WAIT_L(0); G8_MMA(1, 0, At, B0); G8_BAR; G8_SCHED;
            G8_STAGE(G8_SB(0, 1), b2 + hstep, voffB);
            G8_WAIT_V(6); G8_BAR; G8_MMA(1, 1, At, B1); G8_BAR;
            G8_LDB(B0, 1, 0); G8_SCHED; G8_LDA(At, 1, 0); G8_STAGE(G8_SA(0, 1), a2, oc[1]);
            G8_WAIT_L(8); G8_BAR; G8_WAIT_L(0); G8_MMA(0, 0, At, B0); G8_BAR; G8_SCHED;
            G8_LDB(B1, 1, 1); G8_STAGE(G8_SB(1, 0), b3, voffB);
            G8_BAR; G8_WAIT_L(0); G8_MMA(0, 1, At, B1); G8_BAR;
            G8_LDA(At, 1, 1); G8_STAGE(G8_SA(1, 0), a3, oc[0]);
            G8_BAR; G8_WAIT_L(0); G8_MMA(1, 0, At, B0); G8_BAR; G8_SCHED;
            G8_STAGE(G8_SB(1, 1), b3 + hstep, voffB);
            G8_WAIT_V(6); G8_BAR; G8_MMA(1, 1, At, B1); G8_BAR;
        }
        E(acc, cur, wr, wc, fr, fq);
        if (!has_next) break;
#pragma unroll
        for (int a = 0; a < 2; ++a)
#pragma unroll
            for (int b = 0; b < 2; ++b)
#pragma unroll
                for (int m = 0; m < 4; ++m)
#pragma unroll
                    for (int n = 0; n < 2; ++n) acc[a][b][m][n] = (f32x4){0.f, 0.f, 0.f, 0.f};
        cur = nxt; cA = nA; cB = nB; ++ui;
    }
    G8_WAIT_V(0);
    if (wr == 0) G8_BAR;
    G8_BAR;
#undef G8_SA
#undef G8_SB
#undef G8_STAGE
#undef G8_LDA
#undef G8_LDB
#undef G8_MMA
#undef G8_WAIT_V
#undef G8_WAIT_L
#undef G8_BAR
#undef G8_SCHED
}
}

constexpr int NTHREADS = 512;
constexpr int LDS_STAGE = 0;
constexpr int LDS_TAB   = g8::STAGE_BYTES;
constexpr int TAB_SLOTS = 6;
constexpr int LDS_GTAB  = LDS_TAB + TAB_SLOTS * 256 * 4;
constexpr int LDS_DESC  = LDS_GTAB + TAB_SLOTS * 256 * 4;
constexpr int LDS_PREF  = LDS_DESC + 64;
constexpr int LDS_MISC  = LDS_PREF + 132 * 4 + 48;
constexpr int LDS_BYTES = 147456;
static_assert(LDS_MISC % 16 == 0 && LDS_MISC + 64 <= LDS_BYTES, "LDS map");

#define GAS __attribute__((address_space(1)))
struct Params { const GAS float* in[31]; GAS float* out; GAS unsigned char* ws; int ph_lo, ph_hi; };

struct Ctx {
    const GAS float* const* in; float* out; unsigned char* ws; LAS unsigned char* lds;
    __device__ __forceinline__ const float* inp(int k) const { return (const float*)in[k]; }
    int tid, lane, wid, bid, G, gtid, gthreads, gw, nwaves;
};

__device__ __forceinline__ int ab_phys(int n) {
    if (n < 1024) { const int hd = n >> 6, jj = n & 63; return (hd >> 2) * 256 + (jj >> 5) * 128 + (hd & 3) * 32 + (jj & 31); }
    if (n < 1152) { const int nn = n - 1024, hh = nn >> 6, jj = nn & 63; return 1024 + (jj >> 5) * 128 + hh * 32 + (jj & 31); }
    if (n < 1280) { const int vv = n - 1152; return 1024 + (vv >> 6) * 128 + 64 + (vv & 63); }
    if (n < 2304) { const int base = n < 1792 ? 1280 : 1792, nn = n - base, h = nn >> 7, jj = nn & 127; return base + (h >> 1) * 256 + (jj >> 6) * 128 + (h & 1) * 64 + (jj & 63); }
    return n;
}
template <int TN, class DstFn>
__device__ __forceinline__ void convert_T(const Ctx& c, const float* src, int nmat, int K, int N, DstFn dstfn) {
    LAS float* tile = (LAS float*)(c.lds);
    constexpr int LDT = TN + 1, TPR = TN / 4  , KPI = NTHREADS / TPR  , NI = 64 / KPI, KPT = 64 * TN / NTHREADS  ;
    const int tk = K / 64, tn = N / TN; const long ntiles = (long)nmat * tk * tn;
    f32x4 v[NI];
    auto issue = [&](long tix) { const int m = (int)(tix / (tk * tn)); const int rem = (int)(tix % (tk * tn)); const int kt = rem / tn, nt = rem % tn;
        const float* s = src + (size_t)m * K * N + (size_t)(kt * 64) * N + nt * TN;
#pragma unroll
        for (int i = 0; i < NI; ++i) { const int k = c.tid / TPR + KPI * i, n4 = (c.tid % TPR) * 4; v[i] = __builtin_nontemporal_load((const f32x4*)(s + (size_t)k * N + n4)); } };
    if (c.bid < ntiles) issue(c.bid);
    for (long tix = c.bid; tix < ntiles; tix += c.G) {
        const int m = (int)(tix / (tk * tn)); const int rem = (int)(tix % (tk * tn)); const int kt = rem / tn, nt = rem % tn;
#pragma unroll
        for (int i = 0; i < NI; ++i) { const int k = c.tid / TPR + KPI * i, n4 = (c.tid % TPR) * 4;
            tile[k * LDT + n4 + 0] = v[i][0]; tile[k * LDT + n4 + 1] = v[i][1]; tile[k * LDT + n4 + 2] = v[i][2]; tile[k * LDT + n4 + 3] = v[i][3]; }
        if (tix + c.G < ntiles) issue(tix + c.G);
        __syncthreads();
        { constexpr int TPN = 64 / KPT; const int n = c.tid / TPN, k0 = (c.tid % TPN) * KPT;
          bf16_t* d = dstfn(m, nt * TN + n) + kt * 64 + k0;
#pragma unroll
          for (int q = 0; q < KPT / 8; ++q) { u32x4 w;
#pragma unroll
              for (int e = 0; e < 4; ++e) w[e] = pk2(tile[(k0 + q * 8 + 2 * e) * LDT + n], tile[(k0 + q * 8 + 2 * e + 1) * LDT + n]);
              *(u32x4*)(d + q * 8) = w; } }
        __syncthreads();
    }
}

__device__ __forceinline__ void phase_convert(const Ctx& c) {
    unsigned char* ws = c.ws;
    { const float* x = c.inp(0); bf16_t* xb = (bf16_t*)(ws + WS_XB);
      for (long i = c.gtid; i < (long)T * D / 4; i += c.gthreads) { const f32x4 v = *(const f32x4*)(x + i * 4); u32x2 w; w[0] = pk2(v[0], v[1]); w[1] = pk2(v[2], v[3]); *(u32x2*)(xb + i * 4) = w; } }
    { bf16_t* wrt = (bf16_t*)(ws + WS_WRT); for (long i = c.gtid; i < (long)4 * 128 * D / 8; i += c.gthreads) { const long l = i / (128 * D / 8), r = i % (128 * D / 8); *(u32x4*)(wrt + (size_t)l * 256 * D + (size_t)128 * D + r * 8) = (u32x4){0u, 0u, 0u, 0u}; }
      float* gate = (float*)(ws + WS_GATE); for (int i = c.gtid; i < T; i += c.gthreads) gate[TK + i] = 1.f;
      f32x2* ra = (f32x2*)(ws + WS_ROPEA); f32x2* rr = (f32x2*)(ws + WS_ROPER);
      for (int i = c.gtid; i < SEQ * 96; i += c.gthreads) { const int sidx = i / 96, q = i % 96; const bool isA = q < 32; const int jx = isA ? q : q - 32;
          const float e = isA ? (float)jx * (1.f / 32.f) : (float)jx * (1.f / 63.f); const float ang = (float)sidx * exp2f(-e * 13.287712379549449f); float sn, cs; sincosf(ang, &sn, &cs);
          if (isA) ra[sidx * 32 + jx] = (f32x2){cs, sn}; else rr[sidx * 64 + jx] = (f32x2){cs, sn}; }
      float* bp = (float*)(ws + WS_BIASP); for (int i = c.gtid; i < 2 * AB_IN; i += c.gthreads) { const int m = i / AB_IN, n = i % AB_IN; bp[m * AB_IN + ab_phys(n)] = c.inp(2)[i]; } }
    { bf16_t* d = (bf16_t*)(ws + WS_WABIN);  convert_T<256>(c, c.inp(1), 2, D, AB_IN, [=](int m, int n) { return d + (size_t)m * AB_IN * D + (size_t)ab_phys(n) * D; }); }
    { bf16_t* d = (bf16_t*)(ws + WS_WABOUT); convert_T<256>(c, c.inp(4), 2, AB_OUT, D, [=](int m, int n) { return d + (size_t)m * D * AB_OUT + (size_t)n * AB_OUT; }); }
    { bf16_t* d = (bf16_t*)(ws + WS_WCDIN);  convert_T<256>(c, c.inp(6), 2, D, CD_IN, [=](int m, int n) { return d + (size_t)m * CD_IN * D + (size_t)n * D; }); }
    { bf16_t* d = (bf16_t*)(ws + WS_WCDOUT); convert_T<256>(c, c.inp(17), 2, CD_OUT, D, [=](int m, int n) { return d + (size_t)m * D * CD_OUT + (size_t)n * CD_OUT; }); }
    { bf16_t* d = (bf16_t*)(ws + WS_WRT);    convert_T<128>(c, c.inp(21), 4, D, NE, [=](int m, int n) { return d + (size_t)m * 256 * D + (size_t)n * D; }); }
    { bf16_t* d = (bf16_t*)(ws + WS_WGU);
      convert_T<256>(c, c.inp(23), 4 * NE, D, ED, [=](int m, int n) { return d + (size_t)((m >> 7) * NE1 + (m & 127)) * 512 * D + (size_t)((n >> 7) * 256 + (n & 127)) * D; });
      convert_T<256>(c, c.inp(24), 4 * NE, D, ED, [=](int m, int n) { return d + (size_t)((m >> 7) * NE1 + (m & 127)) * 512 * D + (size_t)((n >> 7) * 256 + 128 + (n & 127)) * D; });
      convert_T<256>(c, c.inp(26), 4, D, ED, [=](int m, int n) { return d + (size_t)(m * NE1 + NE) * 512 * D + (size_t)((n >> 7) * 256 + (n & 127)) * D; });
      convert_T<256>(c, c.inp(27), 4, D, ED, [=](int m, int n) { return d + (size_t)(m * NE1 + NE) * 512 * D + (size_t)((n >> 7) * 256 + 128 + (n & 127)) * D; }); }
    { bf16_t* d = (bf16_t*)(ws + WS_WLRU);
      convert_T<256>(c, c.inp(12), 10, 256, 256, [=](int m, int n) { return d + (size_t)(m * 2 + 0) * 65536 + (size_t)n * 256; });
      convert_T<256>(c, c.inp(14), 10, 256, 256, [=](int m, int n) { return d + (size_t)(m * 2 + 1) * 65536 + (size_t)n * 256; });
      float* spl = (float*)(ws + WS_SPL); for (int i = c.gtid; i < 2 * 1280; i += c.gthreads) spl[i] = log1pf(expf(-c.inp(16)[i])); }
    { bf16_t* d = (bf16_t*)(ws + WS_WDN);
      convert_T<256>(c, c.inp(25), 4 * NE, ED, D, [=](int m, int n) { return d + (size_t)((m >> 7) * NE1 + (m & 127)) * D * ED + (size_t)n * ED; });
      convert_T<256>(c, c.inp(28), 4, ED, D, [=](int m, int n) { return d + (size_t)(m * NE1 + NE) * D * ED + (size_t)n * ED; }); }
}

__device__ __forceinline__ void phase_dense(const Ctx& c, const bf16_t* A, const bf16_t* Bt, int M, int N, int K, bf16_t* C, int ldc, const float* bias) {
    g8::DenseOrder S; S.init(A, Bt, M, N, K, c.G, c.bid); S.tid0 = c.tid;
    g8::EpiBf16 E{C, ldc, bias};
    g8::gemm_phase<g8::EpiBf16, g8::DenseOrder>(c.lds + LDS_STAGE, K, S, E);
}

struct EpiABIn {
    static constexpr bool PERM = true;
    LAS bf16_t* biasL; unsigned char* ws;
    __device__ __forceinline__ void operator()(const f32x4 (&acc)[2][2][4][2], const g8::Unit& u, int wr, int wc, int fr_, int fq_) const {
        int fr = fr_, fq = fq_; asm volatile("" : "+v"(fr), "+v"(fq));
        const int pn = u.pn; const int colp = pn * 256 + wc * 32 + fq * 8;
        bf16_t* qb = (bf16_t*)(ws + AB_QB); bf16_t* kb = (bf16_t*)(ws + AB_KB); bf16_t* vT = (bf16_t*)(ws + AB_VT); bf16_t* rqb = (bf16_t*)(ws + AB_RQB); bf16_t* rkb = (bf16_t*)(ws + AB_RKB);
        bf16_t* rkdT = (bf16_t*)(ws + AB_RKDT); bf16_t* rvT = (bf16_t*)(ws + AB_RVT); bf16_t* rgb = (bf16_t*)(ws + AB_RGB);
        const float frqA0 = exp2f(-(float)(fq * 8) * (13.287712379549449f / 32.f)) * 0.15915494309189535f;
        const float frqR0 = exp2f(-(float)((wc & 1) * 32 + fq * 8) * (13.287712379549449f / 63.f)) * 0.15915494309189535f;
        constexpr float RA[8] = {1.f, 0.7498942093324559f, 0.5623413251903491f, 0.4216965034285822f, 0.31622776601683794f, 0.23713737056616552f, 0.1778279410038923f, 0.1333521432163324f};
        constexpr float RR[8] = {1.f, 0.8639884494839686f, 0.746476040841712f, 0.6449466771037624f, 0.5572264795507174f, 0.4814372420784346f, 0.4159562163071847f, 0.35938136638046275f};
#pragma unroll
        for (int ai = 0; ai < 2; ++ai)
#pragma unroll
            for (int m = 0; m < 4; ++m) {
                const int t = u.pm * 256 + ai * 128 + wr * 64 + m * 16 + fr, sq = t & (SEQ - 1), b = t >> 13;
                f32x4 x[2][2];
#pragma unroll
                for (int bj = 0; bj < 2; ++bj)
#pragma unroll
                    for (int n = 0; n < 2; ++n) { const u32x2 bw = *(const LAS u32x2*)(biasL + colp + bj * 128 + 4 * n);
                        x[bj][n] = acc[ai][bj][m][n] + (f32x4){__uint_as_float(bw[0] << 16), __uint_as_float(bw[0] & 0xffff0000u), __uint_as_float(bw[1] << 16), __uint_as_float(bw[1] & 0xffff0000u)}; }
                if (pn < 4 || (pn == 4 && wc < 2)) {
                    const int j0 = fq * 8; const float sc = pn < 4 ? 0.125f : 1.f;
                    u32x4 w1, w2;
#pragma unroll
                    for (int n = 0; n < 2; ++n) { f32x4 o1, o2;
#pragma unroll
                        for (int e = 0; e < 4; ++e) { const float rev = __builtin_amdgcn_fractf((float)sq * (frqA0 * RA[4 * n + e])); const float cc = __builtin_amdgcn_cosf(rev) * sc, ss = __builtin_amdgcn_sinf(rev) * sc;
                            o1[e] = x[0][n][e] * cc - x[1][n][e] * ss; o2[e] = x[1][n][e] * cc + x[0][n][e] * ss; }
                        w1[2 * n] = pk2(o1[0], o1[1]); w1[2 * n + 1] = pk2(o1[2], o1[3]); w2[2 * n] = pk2(o2[0], o2[1]); w2[2 * n + 1] = pk2(o2[2], o2[3]); }
                    bf16_t* dst = pn < 4 ? qb + (size_t)t * 1024 + (pn * 4 + wc) * 64 + j0 : kb + (size_t)t * 128 + wc * 64 + j0;
                    *(u32x4*)dst = w1; *(u32x4*)(dst + 32) = w2;
                } else if (pn == 4) {
                    const int d0 = (wc - 2) * 32 + fq * 8;
#pragma unroll
                    for (int bj = 0; bj < 2; ++bj)
#pragma unroll
                        for (int n = 0; n < 2; ++n)
#pragma unroll
                            for (int e = 0; e < 4; ++e) vT[((size_t)(b * 2 + bj) * 64 + d0 + 4 * n + e) * SEQ + sq] = f2bf(x[bj][n][e]);
                } else if (pn < 9) {
                    const bool isk = pn >= 7; const int h = ((pn - 5) & 1) * 2 + (wc >> 1), j0 = (wc & 1) * 32 + fq * 8;
                    const float sc = isk ? 0.08838834764831845f : 1.f;
                    bf16_t* dT = rkdT + ((size_t)(b * 4 + h) * 128 + j0) * SEQ + sq;
                    u32x4 w1, w2;
#pragma unroll
                    for (int n = 0; n < 2; ++n) { f32x4 o1, o2;
#pragma unroll
                        for (int e = 0; e < 4; ++e) { const float rev = __builtin_amdgcn_fractf((float)sq * (frqR0 * RR[4 * n + e])); const float cc = __builtin_amdgcn_cosf(rev) * sc, ss = __builtin_amdgcn_sinf(rev) * sc;
                            o1[e] = x[0][n][e] * cc - x[1][n][e] * ss; o2[e] = x[1][n][e] * cc + x[0][n][e] * ss; }
                        w1[2 * n] = pk2(o1[0], o1[1]); w1[2 * n + 1] = pk2(o1[2], o1[3]); w2[2 * n] = pk2(o2[0], o2[1]); w2[2 * n + 1] = pk2(o2[2], o2[3]);
                        if (isk) {
#pragma unroll
                            for (int e = 0; e < 4; ++e) { dT[(size_t)(4 * n + e) * SEQ] = f2bf(o1[e]); dT[(size_t)(64 + 4 * n + e) * SEQ] = f2bf(o2[e]); } } }
                    bf16_t* dst = (isk ? rkb : rqb) + (size_t)t * 512 + h * 128 + j0;
                    *(u32x4*)dst = w1; *(u32x4*)(dst + 64) = w2;
                } else if (pn < 13) {
                    const int h = pn - 9;
#pragma unroll
                    for (int bj = 0; bj < 2; ++bj)
#pragma unroll
                        for (int n = 0; n < 2; ++n)
#pragma unroll
                            for (int e = 0; e < 4; ++e) rvT[((size_t)(b * 4 + h) * 256 + bj * 128 + wc * 32 + fq * 8 + 4 * n + e) * SEQ + sq] = f2bf(x[bj][n][e]);
                } else {
#pragma unroll
                    for (int bj = 0; bj < 2; ++bj) { u32x4 w;
#pragma unroll
                        for (int n = 0; n < 2; ++n) { w[2 * n] = pk2(siluf_(x[bj][n][0]), siluf_(x[bj][n][1])); w[2 * n + 1] = pk2(siluf_(x[bj][n][2]), siluf_(x[bj][n][3])); }
                        *(u32x4*)(rgb + (size_t)t * 1024 + (pn - 13) * 256 + bj * 128 + wc * 32 + fq * 8) = w; }
                }
            }
    }
};
__device__ __forceinline__ void phase_ab_inproj(const Ctx& c, int j) {
    g8::DenseOrder S; S.init(c.ws + WS_XB, c.ws + WS_WABIN + (size_t)j * AB_IN * D * 2, T, AB_IN, D, c.G, c.bid); S.tid0 = c.tid;
    LAS bf16_t* biasL = (LAS bf16_t*)(c.lds + LDS_TAB);
    { const float* bp = (const float*)(c.ws + WS_BIASP) + (size_t)j * AB_IN; for (int i = c.tid; i < AB_IN; i += NTHREADS) biasL[i] = f2bf(bp[i]); }
    __syncthreads();
    EpiABIn E{biasL, c.ws};
    g8::gemm_phase<EpiABIn, g8::DenseOrder>(c.lds + LDS_STAGE, D, S, E);
}

#define MFMA16(a, b, c) __builtin_amdgcn_mfma_f32_16x16x32_bf16((a), (b), (c), 0, 0, 0)
__device__ __forceinline__ bf16x8 pack8(const f32x4& lo, const f32x4& hi) { u32x4 w; w[0] = g8::cvt_pk_bf16(lo[0], lo[1]); w[1] = g8::cvt_pk_bf16(lo[2], lo[3]); w[2] = g8::cvt_pk_bf16(hi[0], hi[1]); w[3] = g8::cvt_pk_bf16(hi[2], hi[3]); return __builtin_bit_cast(bf16x8, w); }
__device__ __forceinline__ bf16x8 cat8(const u32x2& lo, const u32x2& hi) { u32x4 w; w[0] = lo[0]; w[1] = lo[1]; w[2] = hi[0]; w[3] = hi[1]; return __builtin_bit_cast(bf16x8, w); }
template <int ROWS, int RB>
__device__ __forceinline__ void tile_g2l(LAS unsigned char* dst, const unsigned char* src, size_t gs, int tid, int zrows = 0) {
    constexpr int CPR = RB / 16, TOTAL = ROWS * CPR;
#pragma unroll 8
    for (int i = tid; i < TOTAL; i += NTHREADS) { const int r = i / CPR, cc = i % CPR; u32x4 v = (u32x4){0u, 0u, 0u, 0u}; if (r >= zrows) v = *(const u32x4*)(src + (size_t)r * gs + cc * 16);
        *(LAS u32x4*)(dst + r * (RB + 16) + cc * 16) = v; }
}

__device__ __forceinline__ void attn_unit(const Ctx& c, int unit, const float* sinks) {
    const int b = unit >> 7, n = (unit >> 1) & 63, kvh = unit & 1, hd = kvh * 8 + c.wid, lane = c.lane, fr = lane & 15, fq = lane >> 4;
    const bf16_t* qb = (const bf16_t*)(c.ws + AB_QB); const bf16_t* kb = (const bf16_t*)(c.ws + AB_KB); const bf16_t* vT = (const bf16_t*)(c.ws + AB_VT); bf16_t* ycat = (bf16_t*)(c.ws + WS_YCAT);
    LAS unsigned char* Ks = c.lds; LAS unsigned char* Vs = c.lds + 256 * 144;
    const int t0 = b * SEQ + n * 128;
    __syncthreads();
    {
        const unsigned char* src = (const unsigned char*)(kb + (size_t)(t0 - 128) * 128 + kvh * 64);
        constexpr int TOTAL = 256 * 8;
#pragma unroll 4
        for (int i = c.tid; i < TOTAL; i += NTHREADS) { const int r = i >> 3, cc = i & 7; u32x4 v = (u32x4){0u, 0u, 0u, 0u}; if (n > 0 || r >= 128) v = *(const u32x4*)(src + (ptrdiff_t)r * 256 + cc * 16);
            *(LAS u32x4*)(Ks + r * 144 + cc * 16) = v; }
        const unsigned char* vsrc = (const unsigned char*)(vT + (size_t)(b * 2 + kvh) * 64 * SEQ + (n * 128 - 128));
        constexpr int TV = 64 * 32;
#pragma unroll 4
        for (int i = c.tid; i < TV; i += NTHREADS) { const int r = i >> 5, cc = i & 31; u32x4 v = (u32x4){0u, 0u, 0u, 0u}; if (n > 0 || cc >= 16) v = *(const u32x4*)(vsrc + (ptrdiff_t)r * SEQ * 2 + cc * 16);
            *(LAS u32x4*)(Vs + r * 528 + cc * 16) = v; }
    }
    __syncthreads();
    const float sink = sinks[hd];
    bf16x8 qn[2];
#pragma unroll
    for (int ks = 0; ks < 2; ++ks) qn[ks] = *(const bf16x8*)(qb + (size_t)(t0 + fr) * 1024 + hd * 64 + ks * 32 + fq * 8);
    for (int si = 0; si < 8; ++si) {
        const int t = t0 + si * 16 + fr;
        bf16x8 qf[2]; qf[0] = qn[0]; qf[1] = qn[1];
        if (si < 7) {
#pragma unroll
            for (int ks = 0; ks < 2; ++ks) qn[ks] = *(const bf16x8*)(qb + (size_t)(t + 16) * 1024 + hd * 64 + ks * 32 + fq * 8); }
        f32x4 S[10];
#pragma unroll
        for (int nk = 0; nk < 9; ++nk) { S[nk] = (f32x4){0.f, 0.f, 0.f, 0.f};
#pragma unroll
            for (int ks = 0; ks < 2; ++ks) { const bf16x8 a = *(const LAS bf16x8*)(Ks + (16 * (si + nk) + fr) * 144 + ks * 64 + fq * 16); S[nk] = MFMA16(a, qf[ks], S[nk]); } }
        S[9] = (f32x4){0.f, 0.f, 0.f, 0.f};
        const int i = si * 16 + fr;
        float mx = sink;
#pragma unroll
        for (int nk = 0; nk < 9; ++nk)
#pragma unroll
            for (int r = 0; r < 4; ++r) { const int p = 16 * (si + nk) + 4 * fq + r; const bool ok = (p >= i + 1) && (p <= i + 128) && (n > 0 || p >= 128);
                S[nk][r] = ok ? S[nk][r] : -1e30f; mx = fmaxf(mx, S[nk][r]); }
        mx = fmaxf(mx, __shfl_xor(mx, 16)); mx = fmaxf(mx, __shfl_xor(mx, 32));
        float sum = 0.f;
#pragma unroll
        for (int nk = 0; nk < 9; ++nk)
#pragma unroll
            for (int r = 0; r < 4; ++r) { const float pv = S[nk][r] > -1e29f ? exp2f((S[nk][r] - mx) * 1.4426950408889634f) : 0.f; S[nk][r] = pv; sum += pv; }
        sum += __shfl_xor(sum, 16); sum += __shfl_xor(sum, 32);
        const float inv = 1.f / (sum + exp2f((sink - mx) * 1.4426950408889634f));
        f32x4 O[4];
#pragma unroll
        for (int nd = 0; nd < 4; ++nd) O[nd] = (f32x4){0.f, 0.f, 0.f, 0.f};
#pragma unroll
        for (int kk = 0; kk < 5; ++kk) { const bf16x8 pf = pack8(S[2 * kk], S[2 * kk + 1]);
            const int p0 = 16 * (si + 2 * kk) + 4 * fq, p1 = (kk == 4 && si == 7) ? p0 : p0 + 16;
#pragma unroll
            for (int nd = 0; nd < 4; ++nd) { const u32x2 lo = *(const LAS u32x2*)(Vs + (16 * nd + fr) * 528 + p0 * 2), hi = *(const LAS u32x2*)(Vs + (16 * nd + fr) * 528 + p1 * 2);
                O[nd] = MFMA16(cat8(lo, hi), pf, O[nd]); } }
#pragma unroll
        for (int nd = 0; nd < 4; ++nd) { u32x2 w; w[0] = pk2(O[nd][0] * inv, O[nd][1] * inv); w[1] = pk2(O[nd][2] * inv, O[nd][3] * inv);
            *(u32x2*)(ycat + (size_t)t * AB_OUT + hd * 64 + 16 * nd + 4 * fq) = w; }
    }
}

__device__ __forceinline__ void ret_kv_unit(const Ctx& c, int unit) {
    const int b = unit >> 8, n = (unit >> 2) & 63, h = unit & 3, lane = c.lane, fr = lane & 15, fq = lane >> 4, w = c.wid;
    const bf16_t* rkdT = (const bf16_t*)(c.ws + AB_RKDT); const bf16_t* rvT = (const bf16_t*)(c.ws + AB_RVT); float* kv = (float*)(c.ws + AB_KV);
    LAS unsigned char* Kd = c.lds;
    __syncthreads();
    {
        const float lg = log2f(1.f - exp2f(-5.f - (float)h)); const int cc = c.tid & 15;
        float dec[8];
#pragma unroll
        for (int e = 0; e < 8; ++e) dec[e] = exp2f((float)(127 - (cc * 8 + e)) * lg);
        const unsigned char* src = (const unsigned char*)(rkdT + (size_t)(b * 4 + h) * 128 * SEQ + n * 128);
#pragma unroll
        for (int q = 0; q < 4; ++q) { const int r = (c.tid >> 4) + 32 * q; const u32x4 v = *(const u32x4*)(src + (size_t)r * SEQ * 2 + cc * 16); u32x4 o;
#pragma unroll
            for (int e2 = 0; e2 < 4; ++e2) o[e2] = pk2(__uint_as_float(v[e2] << 16) * dec[2 * e2], __uint_as_float(v[e2] & 0xffff0000u) * dec[2 * e2 + 1]);
            *(LAS u32x4*)(Kd + r * 272 + cc * 16) = o; }
    }
    bf16x8 vf[2][4];
#pragma unroll
    for (int ne = 0; ne < 2; ++ne)
#pragma unroll
        for (int ks = 0; ks < 4; ++ks) vf[ne][ks] = *(const bf16x8*)(rvT + ((size_t)(b * 4 + h) * 256 + 32 * w + 16 * ne + fr) * SEQ + n * 128 + ks * 32 + fq * 8);
    __syncthreads();
    float* out = kv + ((size_t)((b * 64 + n) * 4 + h)) * 256 * 128;
#pragma unroll
    for (int nd = 0; nd < 8; ++nd) { f32x4 a0 = (f32x4){0.f, 0.f, 0.f, 0.f}, a1 = a0;
#pragma unroll
        for (int ks = 0; ks < 4; ++ks) { const bf16x8 kf = *(const LAS bf16x8*)(Kd + (16 * nd + fr) * 272 + ks * 64 + fq * 16); a0 = MFMA16(kf, vf[0][ks], a0); a1 = MFMA16(kf, vf[1][ks], a1); }
        *(f32x4*)(out + (size_t)(32 * w + fr) * 128 + 16 * nd + 4 * fq) = a0; *(f32x4*)(out + (size_t)(32 * w + 16 + fr) * 128 + 16 * nd + 4 * fq) = a1; }
}
__device__ __forceinline__ void ret_scan(const Ctx& c, int first_block, int nblocks) {
    const float* kv = (const float*)(c.ws + AB_KV); bf16_t* sp = (bf16_t*)(c.ws + AB_SPREV);
    const int nthr = nblocks * NTHREADS;
    for (int idx = (c.bid - first_block) * NTHREADS + c.tid; idx < 2 * 4 * 256 * 128 / 4; idx += nthr) {
        const int b = idx >> 15, rem = idx & 32767, h = rem >> 13;
        const float g = exp2f(128.f * log2f(1.f - exp2f(-5.f - (float)h)));
        const size_t base = (size_t)b * 64 * 131072 + (size_t)rem * 4;
        f32x4 st = (f32x4){0.f, 0.f, 0.f, 0.f};
        for (int n0 = 0; n0 < 64; n0 += 16) { f32x4 v[16];
#pragma unroll
            for (int q = 0; q < 16; ++q) v[q] = *(const f32x4*)(kv + base + (size_t)(n0 + q) * 131072);
#pragma unroll
            for (int q = 0; q < 16; ++q) { u32x2 wv; wv[0] = pk2(st[0], st[1]); wv[1] = pk2(st[2], st[3]); *(u32x2*)(sp + base + (size_t)(n0 + q) * 131072) = wv; st = st * g + v[q]; } }
    }
}
__device__ __forceinline__ void ret_out_unit(const Ctx& c, int unit) {
    const int b = unit >> 8, n = (unit >> 2) & 63, h = unit & 3, lane = c.lane, fr = lane & 15, fq = lane >> 4, w = c.wid;
    const bf16_t* rqb = (const bf16_t*)(c.ws + AB_RQB); const bf16_t* rkb = (const bf16_t*)(c.ws + AB_RKB); const bf16_t* rvT = (const bf16_t*)(c.ws + AB_RVT);
    const bf16_t* sp = (const bf16_t*)(c.ws + AB_SPREV); const bf16_t* rgb = (const bf16_t*)(c.ws + AB_RGB); bf16_t* ycat = (bf16_t*)(c.ws + WS_YCAT);
    LAS unsigned char* Kl = c.lds; LAS unsigned char* Bl = c.lds + 128 * 272;
    const int t0 = b * SEQ + n * 128; const float lg = log2f(1.f - exp2f(-5.f - (float)h));
    __syncthreads();
    tile_g2l<128, 256>(Kl, (const unsigned char*)(rkb + (size_t)t0 * 512 + h * 128), (size_t)512 * 2, c.tid);
    tile_g2l<256, 256>(Bl, (const unsigned char*)(sp + ((size_t)((b * 64 + n) * 4 + h)) * 256 * 128), (size_t)128 * 2, c.tid);
    const int t = t0 + 16 * w + fr, i = 16 * w + fr;
    bf16x8 qf[4];
#pragma unroll
    for (int ks = 0; ks < 4; ++ks) qf[ks] = *(const bf16x8*)(rqb + (size_t)t * 512 + h * 128 + ks * 32 + fq * 8);
    __syncthreads();
    bf16x8 pf[4];
#pragma unroll
    for (int kk = 0; kk < 4; ++kk) { f32x4 s2[2];
#pragma unroll
        for (int q = 0; q < 2; ++q) { const int nj = 2 * kk + q; s2[q] = (f32x4){0.f, 0.f, 0.f, 0.f};
            if (nj <= w) {
#pragma unroll
                for (int ks = 0; ks < 4; ++ks) { const bf16x8 kf = *(const LAS bf16x8*)(Kl + (16 * nj + fr) * 272 + ks * 64 + fq * 16); s2[q] = MFMA16(kf, qf[ks], s2[q]); }
#pragma unroll
                for (int r = 0; r < 4; ++r) { const int jj = 16 * nj + 4 * fq + r; s2[q][r] = (i >= jj) ? s2[q][r] * exp2f((float)(i - jj) * lg) : 0.f; } } }
        pf[kk] = pack8(s2[0], s2[1]); }
    f32x4 acc[16];
#pragma unroll
    for (int ne = 0; ne < 16; ++ne) { acc[ne] = (f32x4){0.f, 0.f, 0.f, 0.f};
#pragma unroll
        for (int ks = 0; ks < 4; ++ks) { const bf16x8 sf = *(const LAS bf16x8*)(Bl + (16 * ne + fr) * 272 + ks * 64 + fq * 16); acc[ne] = MFMA16(sf, qf[ks], acc[ne]); } }
    const float rs = exp2f((float)(i + 1) * lg);
#pragma unroll
    for (int ne = 0; ne < 16; ++ne) acc[ne] = acc[ne] * rs;
    __syncthreads();
    tile_g2l<256, 256>(Bl, (const unsigned char*)(rvT + (size_t)(b * 4 + h) * 256 * SEQ + n * 128), (size_t)SEQ * 2, c.tid);
    __syncthreads();
    const int nkk = (w >> 1) + 1;
#pragma unroll
    for (int kk = 0; kk < 4; ++kk) if (kk < nkk) {
#pragma unroll
        for (int ne = 0; ne < 16; ++ne) { const u32x2 lo = *(const LAS u32x2*)(Bl + (16 * ne + fr) * 272 + (32 * kk + 4 * fq) * 2), hi = *(const LAS u32x2*)(Bl + (16 * ne + fr) * 272 + (32 * kk + 16 + 4 * fq) * 2);
            acc[ne] = MFMA16(cat8(lo, hi), pf[kk], acc[ne]); } }
    u32x2 gpre[16];
#pragma unroll
    for (int ne = 0; ne < 16; ++ne) gpre[ne] = *(const u32x2*)(rgb + (size_t)t * 1024 + h * 256 + 16 * ne + 4 * fq);
    float sm = 0.f;
#pragma unroll
    for (int ne = 0; ne < 16; ++ne) sm += acc[ne][0] + acc[ne][1] + acc[ne][2] + acc[ne][3];
    sm += __shfl_xor(sm, 16); sm += __shfl_xor(sm, 32);
    const float mean = sm * (1.f / 256.f); float sq = 0.f;
#pragma unroll
    for (int ne = 0; ne < 16; ++ne) { acc[ne] = acc[ne] - mean; sq += acc[ne][0] * acc[ne][0] + acc[ne][1] * acc[ne][1] + acc[ne][2] * acc[ne][2] + acc[ne][3] * acc[ne][3]; }
    sq += __shfl_xor(sq, 16); sq += __shfl_xor(sq, 32);
    const float rstd = rsqrtf(sq * (1.f / 256.f) + LN_EPS);
#pragma unroll
    for (int ne = 0; ne < 16; ++ne) { const u32x2 gw = gpre[ne];
        const float g0 = __uint_as_float(gw[0] << 16), g1 = __uint_as_float(gw[0] & 0xffff0000u), g2 = __uint_as_float(gw[1] << 16), g3 = __uint_as_float(gw[1] & 0xffff0000u);
        u32x2 o; o[0] = pk2(acc[ne][0] * rstd * g0, acc[ne][1] * rstd * g1); o[1] = pk2(acc[ne][2] * rstd * g2, acc[ne][3] * rstd * g3);
        *(u32x2*)(ycat + (size_t)t * AB_OUT + 1024 + h * 256 + 16 * ne + 4 * fq) = o; }
}

__device__ __forceinline__ void phase_ab_p1(const Ctx& c) {
    for (int u = c.bid; u < 512; u += c.G) ret_kv_unit(c, u);
}
__device__ __forceinline__ void phase_ab_p2(const Ctx& c, int j) {
    ret_scan(c, 0, c.G);
    { const float* sinks = c.inp(3) + j * 16; for (int u = c.bid; u < 256; u += c.G) attn_unit(c, u, sinks); }
}
__device__ __forceinline__ void phase_ab_p3(const Ctx& c) {
    for (int u = c.bid; u < 512; u += c.G) ret_out_unit(c, u);
}

__device__ __forceinline__ float gelu_fast(float x) { const float u = 1.5957691216057308f * (x + 0.044715f * x * x * x); return x * __builtin_amdgcn_rcpf(1.f + __expf(-u)); }
struct EpiCDIn {
    static constexpr bool PERM = true;
    LAS bf16_t* biasL; unsigned char* ws;
    __device__ __forceinline__ void operator()(const f32x4 (&acc)[2][2][4][2], const g8::Unit& u, int wr, int wc, int fr, int fq) const {
        const int pn = u.pn; const int col0 = pn * 256 + wc * 32 + fq * 8;
        f32x4 bv[2][2];
#pragma unroll
        for (int bj = 0; bj < 2; ++bj)
#pragma unroll
            for (int n = 0; n < 2; ++n) { const u32x2 bw = *(const LAS u32x2*)(biasL + col0 + bj * 128 + 4 * n); bv[bj][n] = (f32x4){__uint_as_float(bw[0] << 16), __uint_as_float(bw[0] & 0xffff0000u), __uint_as_float(bw[1] << 16), __uint_as_float(bw[1] & 0xffff0000u)}; }
        bf16_t* gu = (bf16_t*)(ws + CD_GU); bf16_t* gvT = (bf16_t*)(ws + CD_GVT); bf16_t* gg = (bf16_t*)(ws + CD_GG); bf16_t* xr = (bf16_t*)(ws + CD_XR); float* stats = (float*)(ws + CD_STATS);
#pragma unroll
        for (int ai = 0; ai < 2; ++ai)
#pragma unroll
            for (int m = 0; m < 4; ++m) {
                const int t = u.pm * 256 + ai * 128 + wr * 64 + m * 16 + fr, sq = t & (SEQ - 1), b = t >> 13;
                f32x4 x[2][2];
#pragma unroll
                for (int bj = 0; bj < 2; ++bj)
#pragma unroll
                    for (int n = 0; n < 2; ++n) { x[bj][n] = acc[ai][bj][m][n] + bv[bj][n];
                        if (pn < 13) {
#pragma unroll
                            for (int e = 0; e < 4; ++e) x[bj][n][e] = gelu_fast(x[bj][n][e]); } }
                if (pn >= 4 && pn < 8) {
                    float s1 = 0.f, s2 = 0.f;
#pragma unroll
                    for (int bj = 0; bj < 2; ++bj)
#pragma unroll
                        for (int n = 0; n < 2; ++n)
#pragma unroll
                            for (int e = 0; e < 4; ++e) { const float v = x[bj][n][e]; s1 += v; s2 += v * v;
                                gvT[((size_t)b * 1024 + (pn - 4) * 256 + bj * 128 + wc * 32 + fq * 8 + 4 * n + e) * SEQ + sq] = f2bf(v); }
                    s1 += __shfl_xor(s1, 16); s1 += __shfl_xor(s1, 32); s2 += __shfl_xor(s2, 16); s2 += __shfl_xor(s2, 32);
                    if (fq == 0) *(f32x2*)(stats + (size_t)t * 32 + ((pn - 4) * 4 + wc) * 2) = (f32x2){s1, s2};
                } else {
                    bf16_t* dst; int ld, cb;
                    if (pn < 4) { dst = gu; ld = 1024; cb = pn * 256; } else if (pn < 13) { dst = gg; ld = 1280; cb = (pn - 8) * 256; } else { dst = xr; ld = 1280; cb = (pn - 13) * 256; }
#pragma unroll
                    for (int bj = 0; bj < 2; ++bj) { u32x4 w;
#pragma unroll
                        for (int n = 0; n < 2; ++n) { w[2 * n] = pk2(x[bj][n][0], x[bj][n][1]); w[2 * n + 1] = pk2(x[bj][n][2], x[bj][n][3]); }
                        *(u32x4*)(dst + (size_t)t * ld + cb + bj * 128 + wc * 32 + fq * 8) = w; }
                }
            }
    }
};
__device__ __forceinline__ void phase_cd_inproj(const Ctx& c, int j) {
    g8::DenseOrder S; S.init(c.ws + WS_XB, c.ws + WS_WCDIN + (size_t)j * CD_IN * D * 2, T, CD_IN, D, c.G, c.bid); S.tid0 = c.tid;
    LAS bf16_t* biasL = (LAS bf16_t*)(c.lds + LDS_TAB);
    { const float* bp = c.inp(7) + (size_t)j * CD_IN; for (int i = c.tid; i < CD_IN; i += NTHREADS) biasL[i] = f2bf(bp[i]); }
    __syncthreads();
    EpiCDIn E{biasL, c.ws};
    g8::gemm_phase<EpiCDIn, g8::DenseOrder>(c.lds + LDS_STAGE, D, S, E);
}

__device__ __forceinline__ void lru_unit(const Ctx& c, int unit, int j) {
    const int hh = unit % 5, bn = unit / 5, lane = c.lane, fr = lane & 15, fq = lane >> 4, w = c.wid;
    const int t0 = bn * 128, s0 = t0 & (SEQ - 1);
    const bf16_t* xr = (const bf16_t*)(c.ws + CD_XR); bf16_t* HL = (bf16_t*)(c.ws + WS_U2); bf16_t* PC = HL + (size_t)T * 1280; float* sum = (float*)(c.ws + WS_H);
    const float* conv_w = c.inp(10) + (size_t)j * 4 * 1280 + hh * 256; const float* conv_b = c.inp(11) + (size_t)j * 1280 + hh * 256;
    const float* ba = c.inp(13) + (size_t)j * 1280 + hh * 256; const float* bx = c.inp(15) + (size_t)j * 1280 + hh * 256; const float* spl = (const float*)(c.ws + WS_SPL) + (size_t)j * 1280 + hh * 256;
    const bf16_t* Wl = (const bf16_t*)(c.ws + WS_WLRU) + (size_t)((j * 5 + hh) * 2) * 65536;
    LAS unsigned char* Xc = c.lds; LAS unsigned char* Wa = c.lds + 128 * 528; LAS unsigned char* Wx = Wa + 64 * 528; LAS unsigned char* Tot = Wx + 64 * 528; LAS float* Bl = (LAS float*)(Tot + 4096);
    __syncthreads();
    if (c.tid < 192) { const int which = c.tid >> 6, i4 = (c.tid & 63) * 4; const float* srcp = which == 0 ? ba : (which == 1 ? bx : spl); *(LAS f32x4*)(Bl + which * 256 + i4) = *(const f32x4*)(srcp + i4); }
    {
        const int cg = c.tid & 31, r0 = (c.tid >> 5) * 8;
        float wv[4][8], bv8[8];
        { const f32x4 b0 = *(const f32x4*)(conv_b + cg * 8), b1 = *(const f32x4*)(conv_b + cg * 8 + 4); bv8[0] = b0[0]; bv8[1] = b0[1]; bv8[2] = b0[2]; bv8[3] = b0[3]; bv8[4] = b1[0]; bv8[5] = b1[1]; bv8[6] = b1[2]; bv8[7] = b1[3]; }
#pragma unroll
        for (int k = 0; k < 4; ++k) { const f32x4 w0 = *(const f32x4*)(conv_w + k * 1280 + cg * 8), w1 = *(const f32x4*)(conv_w + k * 1280 + cg * 8 + 4);
            wv[k][0] = w0[0]; wv[k][1] = w0[1]; wv[k][2] = w0[2]; wv[k][3] = w0[3]; wv[k][4] = w1[0]; wv[k][5] = w1[1]; wv[k][6] = w1[2]; wv[k][7] = w1[3]; }
        u32x4 xin[11];
#pragma unroll
        for (int q = 0; q < 11; ++q) { xin[q] = (u32x4){0u, 0u, 0u, 0u}; if (s0 + r0 - 3 + q >= 0) xin[q] = *(const u32x4*)(xr + (size_t)(t0 + r0 - 3 + q) * 1280 + hh * 256 + cg * 8); }
#pragma unroll
        for (int rr = 0; rr < 8; ++rr) { float a[8];
#pragma unroll
            for (int e = 0; e < 8; ++e) a[e] = bv8[e];
#pragma unroll
            for (int k = 0; k < 4; ++k) { const u32x4 xv = xin[rr + k];
#pragma unroll
                for (int e2 = 0; e2 < 4; ++e2) { a[2 * e2] += wv[k][2 * e2] * __uint_as_float(xv[e2] << 16); a[2 * e2 + 1] += wv[k][2 * e2 + 1] * __uint_as_float(xv[e2] & 0xffff0000u); } }
            u32x4 o; o[0] = pk2(a[0], a[1]); o[1] = pk2(a[2], a[3]); o[2] = pk2(a[4], a[5]); o[3] = pk2(a[6], a[7]);
            *(LAS u32x4*)(Xc + (r0 + rr) * 528 + cg * 16) = o; }
    }
    u32x4 wreg[8];
#pragma unroll
    for (int q = 0; q < 4; ++q) { const int i = c.tid + q * NTHREADS, r = i >> 5, cc = i & 31; wreg[q] = *(const u32x4*)((const unsigned char*)Wl + (size_t)r * 512 + cc * 16); wreg[4 + q] = *(const u32x4*)((const unsigned char*)(Wl + 65536) + (size_t)r * 512 + cc * 16); }
    __syncthreads();
    bf16x8 xf[8];
#pragma unroll
    for (int ks = 0; ks < 8; ++ks) xf[ks] = *(const LAS bf16x8*)(Xc + (16 * w + fr) * 528 + ks * 64 + fq * 16);
    const int t = t0 + 16 * w + fr;
    for (int sl = 0; sl < 4; ++sl) {
        if (sl) __syncthreads();
#pragma unroll
        for (int q = 0; q < 4; ++q) { const int i = c.tid + q * NTHREADS, r = i >> 5, cc = i & 31; *(LAS u32x4*)(Wa + r * 528 + cc * 16) = wreg[q]; *(LAS u32x4*)(Wx + r * 528 + cc * 16) = wreg[4 + q]; }
        if (sl < 3) {
#pragma unroll
            for (int q = 0; q < 4; ++q) { const int i = c.tid + q * NTHREADS, r = i >> 5, cc = i & 31;
                wreg[q] = *(const u32x4*)((const unsigned char*)(Wl + (size_t)((sl + 1) * 64) * 256) + (size_t)r * 512 + cc * 16); wreg[4 + q] = *(const u32x4*)((const unsigned char*)(Wl + 65536 + (size_t)((sl + 1) * 64) * 256) + (size_t)r * 512 + cc * 16); } }
        __syncthreads();
        f32x4 sA[4], sB[4];
#pragma unroll
        for (int nc = 0; nc < 4; ++nc) { f32x4 ra = (f32x4){0.f, 0.f, 0.f, 0.f}, ri = ra;
#pragma unroll
            for (int ks = 0; ks < 8; ++ks) { const bf16x8 wa = *(const LAS bf16x8*)(Wa + (16 * nc + fr) * 528 + ks * 64 + fq * 16), wx = *(const LAS bf16x8*)(Wx + (16 * nc + fr) * 528 + ks * 64 + fq * 16);
                ra = MFMA16(wa, xf[ks], ra); ri = MFMA16(wx, xf[ks], ri); }
            const int ch = sl * 64 + 16 * nc + 4 * fq;
            const f32x4 b_a = *(const LAS f32x4*)(Bl + ch), b_x = *(const LAS f32x4*)(Bl + 256 + ch), sp = *(const LAS f32x4*)(Bl + 512 + ch);
            const u32x2 xw = *(const LAS u32x2*)(Xc + (16 * w + fr) * 528 + ch * 2);
            const float xcv[4] = {__uint_as_float(xw[0] << 16), __uint_as_float(xw[0] & 0xffff0000u), __uint_as_float(xw[1] << 16), __uint_as_float(xw[1] & 0xffff0000u)};
            f32x4 oa, ob;
#pragma unroll
            for (int r = 0; r < 4; ++r) { const float gr = __builtin_amdgcn_rcpf(1.f + __expf(-(ra[r] + b_a[r]))), gi = __builtin_amdgcn_rcpf(1.f + __expf(-(ri[r] + b_x[r]))); const float la = -8.f * gr * sp[r]; const float a = __expf(la);
                oa[r] = a; ob[r] = __builtin_amdgcn_sqrtf(fmaxf(1.f - a * a, 0.f)) * (gi * xcv[r]); }
#pragma unroll
            for (int dlt = 1; dlt < 16; dlt <<= 1) {
#pragma unroll
                for (int r = 0; r < 4; ++r) { const float pa = __shfl_up(oa[r], dlt, 16), pb = __shfl_up(ob[r], dlt, 16); if (fr >= dlt) { ob[r] = oa[r] * pb + ob[r]; oa[r] = oa[r] * pa; } } }
            sA[nc] = oa; sB[nc] = ob;
            if (fr == 15) { *(LAS f32x4*)(Tot + ((w * 64 + 16 * nc + 4 * fq) * 2) * 4) = oa; *(LAS f32x4*)(Tot + ((w * 64 + 16 * nc + 4 * fq) * 2 + 4) * 4) = ob; }
        }
        __syncthreads();
#pragma unroll
        for (int nc = 0; nc < 4; ++nc) { const int ch = sl * 64 + 16 * nc + 4 * fq;
            f32x4 cp = (f32x4){1.f, 1.f, 1.f, 1.f}, chh = (f32x4){0.f, 0.f, 0.f, 0.f};
            for (int w2 = 0; w2 < w; ++w2) { const f32x4 ta = *(const LAS f32x4*)(Tot + ((w2 * 64 + 16 * nc + 4 * fq) * 2) * 4), tb = *(const LAS f32x4*)(Tot + ((w2 * 64 + 16 * nc + 4 * fq) * 2 + 4) * 4);
                chh = ta * chh + tb; cp = cp * ta; }
            const f32x4 hl = sB[nc] + sA[nc] * chh, pc = sA[nc] * cp;
            u32x2 o1, o2; o1[0] = pk2(hl[0], hl[1]); o1[1] = pk2(hl[2], hl[3]); o2[0] = pk2(pc[0], pc[1]); o2[1] = pk2(pc[2], pc[3]);
            *(u32x2*)(HL + (size_t)t * 1280 + hh * 256 + ch) = o1; *(u32x2*)(PC + (size_t)t * 1280 + hh * 256 + ch) = o2;
            if (w == 7 && fr == 15) { float* sm = sum + ((size_t)bn * 1280 + hh * 256 + ch) * 2;
#pragma unroll
                for (int r = 0; r < 4; ++r) { sm[2 * r] = pc[r]; sm[2 * r + 1] = hl[r]; } } }
    }
}

__device__ __forceinline__ void sgu_unit(const Ctx& c, int unit, int j) {
    const int g = unit & 3, bn = unit >> 2, b = bn >> 6, n = bn & 63, lane = c.lane, fr = lane & 15, fq = lane >> 4, w = c.wid;
    const int t0 = bn * 128;
    const bf16_t* gu = (const bf16_t*)(c.ws + CD_GU); const bf16_t* gvT = (const bf16_t*)(c.ws + CD_GVT); const float* stats = (const float*)(c.ws + CD_STATS); bf16_t* ycat = (bf16_t*)(c.ws + WS_YCAT);
    const float* sw = c.inp(8) + (size_t)(j * 4 + g) * 16384; const float* sb = c.inp(9) + (size_t)(j * 4 + g) * 128;
    LAS unsigned char* Vt = c.lds; LAS float* mr = (LAS float*)(c.lds + 256 * 272);
    __syncthreads();
    tile_g2l<256, 256>(Vt, (const unsigned char*)(gvT + ((size_t)b * 1024 + g * 256) * SEQ + n * 128), (size_t)SEQ * 2, c.tid);
    if (c.tid < 128) { const f32x4* st = (const f32x4*)(stats + (size_t)(t0 + c.tid) * 32); float s1 = 0.f, s2 = 0.f; f32x4 sv[8];
#pragma unroll
        for (int q = 0; q < 8; ++q) sv[q] = st[q];
#pragma unroll
        for (int q = 0; q < 8; ++q) { s1 += sv[q][0] + sv[q][2]; s2 += sv[q][1] + sv[q][3]; }
        const float mean = s1 * (1.f / 1024.f), var = fmaxf(s2 * (1.f / 1024.f) - mean * mean, 0.f); mr[2 * c.tid] = mean; mr[2 * c.tid + 1] = rsqrtf(var + LN_EPS); }
    __syncthreads();
    const int i = 16 * w + fr, t = t0 + i, nks = (w >> 1) + 1;
    bf16x8 wf[4]; float ci = 0.f;
#pragma unroll
    for (int ks = 0; ks < 4; ++ks) { f32x4 lo = (f32x4){0.f, 0.f, 0.f, 0.f}, hi = lo;
        if (ks < nks) { const int j0 = ks * 32 + fq * 8; const f32x4 w0 = *(const f32x4*)(sw + (size_t)i * 128 + j0), w1 = *(const f32x4*)(sw + (size_t)i * 128 + j0 + 4);
#pragma unroll
            for (int e = 0; e < 4; ++e) { const float m0 = mr[2 * (j0 + e)], r0 = mr[2 * (j0 + e) + 1], m1 = mr[2 * (j0 + 4 + e)], r1 = mr[2 * (j0 + 4 + e) + 1];
                lo[e] = (j0 + e <= i) ? w0[e] * r0 : 0.f; hi[e] = (j0 + 4 + e <= i) ? w1[e] * r1 : 0.f; ci += lo[e] * m0 + hi[e] * m1; } }
        wf[ks] = pack8(lo, hi); }
    ci += __shfl_xor(ci, 16); ci += __shfl_xor(ci, 32);
    const float add = sb[i] - ci;
    f32x4 acc[16];
#pragma unroll
    for (int nd = 0; nd < 16; ++nd) { acc[nd] = (f32x4){0.f, 0.f, 0.f, 0.f};
#pragma unroll
        for (int ks = 0; ks < 4; ++ks) if (ks < nks) { const bf16x8 vf = *(const LAS bf16x8*)(Vt + (16 * nd + fr) * 272 + ks * 64 + fq * 16); acc[nd] = MFMA16(vf, wf[ks], acc[nd]); } }
    u32x2 upre[16];
#pragma unroll
    for (int nd = 0; nd < 16; ++nd) upre[nd] = *(const u32x2*)(gu + (size_t)t * 1024 + g * 256 + 16 * nd + 4 * fq);
#pragma unroll
    for (int nd = 0; nd < 16; ++nd) { const u32x2 uw = upre[nd];
        const float u0 = __uint_as_float(uw[0] << 16), u1 = __uint_as_float(uw[0] & 0xffff0000u), u2 = __uint_as_float(uw[1] << 16), u3 = __uint_as_float(uw[1] & 0xffff0000u);
        u32x2 o; o[0] = pk2(u0 * (acc[nd][0] + add), u1 * (acc[nd][1] + add)); o[1] = pk2(u2 * (acc[nd][2] + add), u3 * (acc[nd][3] + add));
        *(u32x2*)(ycat + (size_t)t * CD_OUT + g * 256 + 16 * nd + 4 * fq) = o; }
}
__device__ __forceinline__ void phase_cd_p1(const Ctx& c, int j) {
    for (int u = c.bid; u < 640; u += c.G) lru_unit(c, u, j);
    if (c.G == 256) {
        if (c.bid < 128) sgu_unit(c, c.bid, j);
        else { for (int q = 0; q < 3; ++q) sgu_unit(c, 128 + (c.bid - 128) * 3 + q, j); }
    } else { for (int u = c.bid; u < 512; u += c.G) sgu_unit(c, u, j); }
}

__device__ __forceinline__ void phase_cd_scan2(const Ctx& c) {
    const bf16_t* gg = (const bf16_t*)(c.ws + CD_GG); bf16_t* ycat = (bf16_t*)(c.ws + WS_YCAT);
    const bf16_t* HL = (const bf16_t*)(c.ws + WS_U2); const bf16_t* PC = HL + (size_t)T * 1280; const float* sum = (const float*)(c.ws + WS_H);
    LAS float* carry = (LAS float*)c.lds;
    for (int u = c.bid; u < 256; u += c.G) {
        const int bn = u >> 1, half = u & 1, b = bn >> 6, n = bn & 63;
        __syncthreads();
        {
            LAS float* part = carry + 1280;
            for (int it = c.tid; it < 4 * 1280; it += NTHREADS) { const int seg = it / 1280, ch = it % 1280; const float* sp = sum + ((size_t)(b * 64 + seg * 16) * 1280 + ch) * 2;
                f32x2 v[16];
#pragma unroll
                for (int q = 0; q < 16; ++q) { v[q] = (f32x2){1.f, 0.f}; if (seg * 16 + q < n) v[q] = *(const f32x2*)(sp + (size_t)q * 2560); }
                float A = 1.f, Bv = 0.f;
#pragma unroll
                for (int q = 0; q < 16; ++q) { Bv = v[q][0] * Bv + v[q][1]; A *= v[q][0]; }
                part[(seg * 1280 + ch) * 2] = A; part[(seg * 1280 + ch) * 2 + 1] = Bv; }
            __syncthreads();
            for (int ch = c.tid; ch < 1280; ch += NTHREADS) { float cr = 0.f;
#pragma unroll
                for (int seg = 0; seg < 4; ++seg) cr = part[(seg * 1280 + ch) * 2] * cr + part[(seg * 1280 + ch) * 2 + 1];
                carry[ch] = cr; }
        }
        __syncthreads();
        const size_t t0 = (size_t)bn * 128 + half * 64;
        for (int it0 = c.tid; it0 < 64 * 320; it0 += 8 * NTHREADS) {
            u32x2 hw[8], pw[8], gw[8];
#pragma unroll
            for (int q = 0; q < 8; ++q) { const int it = it0 + q * NTHREADS; const int r = it / 320, c4 = (it % 320) * 4; const size_t o = (t0 + r) * 1280 + c4; hw[q] = *(const u32x2*)(HL + o); pw[q] = *(const u32x2*)(PC + o); gw[q] = *(const u32x2*)(gg + o); }
#pragma unroll
            for (int q = 0; q < 8; ++q) { const int it = it0 + q * NTHREADS; const int r = it / 320, c4 = (it % 320) * 4; const f32x4 cr = *(const LAS f32x4*)(carry + c4);
                const float h0 = __uint_as_float(hw[q][0] << 16) + __uint_as_float(pw[q][0] << 16) * cr[0], h1 = __uint_as_float(hw[q][0] & 0xffff0000u) + __uint_as_float(pw[q][0] & 0xffff0000u) * cr[1];
                const float h2 = __uint_as_float(hw[q][1] << 16) + __uint_as_float(pw[q][1] << 16) * cr[2], h3 = __uint_as_float(hw[q][1] & 0xffff0000u) + __uint_as_float(pw[q][1] & 0xffff0000u) * cr[3];
                u32x2 ow; ow[0] = pk2(__uint_as_float(gw[q][0] << 16) * h0, __uint_as_float(gw[q][0] & 0xffff0000u) * h1); ow[1] = pk2(__uint_as_float(gw[q][1] << 16) * h2, __uint_as_float(gw[q][1] & 0xffff0000u) * h3);
                *(u32x2*)(ycat + (t0 + r) * CD_OUT + 1024 + c4) = ow; } }
    }
}

__device__ __forceinline__ void phase_ln_moe(const Ctx& c, const float* g, const float* bta, float* xout) {
    typedef float f32x2v __attribute__((ext_vector_type(2)));
    bf16_t* xb = (bf16_t*)(c.ws + WS_XB); const unsigned char* Y = (const unsigned char*)(c.ws + WS_U1);
    f32x4 gpre[2][2], bpre[2][2];
#pragma unroll
    for (int q = 0; q < 2; ++q)
#pragma unroll
        for (int h2 = 0; h2 < 2; ++h2) { gpre[q][h2] = *(const f32x4*)(g + q * 512 + c.lane * 8 + 4 * h2); bpre[q][h2] = *(const f32x4*)(bta + q * 512 + c.lane * 8 + 4 * h2); }
    for (long tt = (long)c.gw * 2; tt < T; tt += (long)c.nwaves * 2) {
        float v[2][2][8];
#pragma unroll
        for (int u = 0; u < 2; ++u) { const long t = tt + u;
#pragma unroll
            for (int q = 0; q < 2; ++q) { const int col = q * 512 + c.lane * 8;
                float f[8];
#pragma unroll
                for (int e = 0; e < 8; ++e) f[e] = 0.f;
#pragma unroll
                for (int k = 0; k < 8; ++k) { const size_t srow = (size_t)t * 8 + k; const u32x2 w = *(const u32x2*)(Y + srow * D + col);
#pragma unroll
                    for (int h2 = 0; h2 < 2; ++h2) { const f32x2v a = __builtin_amdgcn_cvt_pk_f32_fp8(w[h2], false), b = __builtin_amdgcn_cvt_pk_f32_fp8(w[h2], true);
                        f[4 * h2] += a[0]; f[4 * h2 + 1] += a[1]; f[4 * h2 + 2] += b[0]; f[4 * h2 + 3] += b[1]; } }
                const u32x4 xw = *(const u32x4*)(xb + (size_t)t * D + col), sw = *(const u32x4*)((const bf16_t*)(Y + (size_t)TK * D) + (size_t)t * D + col);
#pragma unroll
                for (int e2 = 0; e2 < 4; ++e2) { v[u][q][2 * e2] = __uint_as_float(xw[e2] << 16) * ALPHA + f[2 * e2] * (1.f / 64.f) + __uint_as_float(sw[e2] << 16);
                    v[u][q][2 * e2 + 1] = __uint_as_float(xw[e2] & 0xffff0000u) * ALPHA + f[2 * e2 + 1] * (1.f / 64.f) + __uint_as_float(sw[e2] & 0xffff0000u); } } }
#pragma unroll
        for (int u = 0; u < 2; ++u) { const long t = tt + u;
            float sm = 0.f;
#pragma unroll
            for (int q = 0; q < 2; ++q)
#pragma unroll
                for (int e = 0; e < 8; ++e) sm += v[u][q][e];
            const float mean = wave_sum(sm) * (1.f / 1024.f); float sq = 0.f;
#pragma unroll
            for (int q = 0; q < 2; ++q)
#pragma unroll
                for (int e = 0; e < 8; ++e) { v[u][q][e] -= mean; sq += v[u][q][e] * v[u][q][e]; }
            const float rstd = rsqrtf(wave_sum(sq) * (1.f / 1024.f) + LN_EPS);
#pragma unroll
            for (int q = 0; q < 2; ++q) { const int col = q * 512 + c.lane * 8; float o[8];
#pragma unroll
                for (int h2 = 0; h2 < 2; ++h2) { const f32x4 gg = gpre[q][h2], bb = bpre[q][h2];
#pragma unroll
                    for (int e = 0; e < 4; ++e) o[4 * h2 + e] = v[u][q][4 * h2 + e] * rstd * gg[e] + bb[e];
                    if (xout) *(f32x4*)(xout + (size_t)t * D + col + 4 * h2) = (f32x4){o[4 * h2], o[4 * h2 + 1], o[4 * h2 + 2], o[4 * h2 + 3]}; }
                u32x4 w; w[0] = pk2(o[0], o[1]); w[1] = pk2(o[2], o[3]); w[2] = pk2(o[4], o[5]); w[3] = pk2(o[6], o[7]); *(u32x4*)(xb + (size_t)t * D + col) = w; } }
    }
}

__device__ __forceinline__ unsigned sortable_u32(float f) { const unsigned b = __float_as_uint(f); return b ^ ((b >> 31) ? 0xffffffffu : 0x80000000u); }
__device__ __forceinline__ int popc64(unsigned long long m) { return __builtin_popcountll(m); }
__device__ __forceinline__ int rank_lt(unsigned long long m) { return (int)__builtin_amdgcn_mbcnt_hi((unsigned)(m >> 32), __builtin_amdgcn_mbcnt_lo((unsigned)m, 0u)); }
__device__ __forceinline__ void phase_ln_route(const Ctx& c, int L) {
    bf16_t* xb = (bf16_t*)(c.ws + WS_XB); const bf16_t* hbuf = (const bf16_t*)(c.ws + WS_HB);
    const float* g = c.inp(19) + (size_t)L * D; const float* bta = c.inp(20) + (size_t)L * D; const float* rb = c.inp(22) + L * NE;
    const bf16_t* Wr = (const bf16_t*)(c.ws + WS_WRT) + (size_t)L * 256 * D;
    int* cnt = (int*)(c.ws + CTL_CNT) + L * NE * 1024; int* list = (int*)(c.ws + WS_LIST); float* gate = (float*)(c.ws + WS_GATE);
    LAS unsigned char* Xl = c.lds; LAS unsigned char* Wq = c.lds + 32 * 2064;
    LAS float* Sc = (LAS float*)Wq;
    LAS int* hist = (LAS int*)(Wq + 32768); LAS int* gbase = hist + 128; LAS int* sel = gbase + 128; LAS float* selg = (LAS float*)(sel + 512);
    const int lane = c.lane, fr = lane & 15, fq = lane >> 4, w = c.wid;
    f32x4 gpre[4], bpre[4];
#pragma unroll
    for (int q = 0; q < 4; ++q) { gpre[q] = *(const f32x4*)(g + q * 256 + lane * 4); bpre[q] = *(const f32x4*)(bta + q * 256 + lane * 4); }
    for (int grp = c.bid; grp < T / 64; grp += c.G) {
        __syncthreads();
        u32x2 nb[8][4];
#pragma unroll
        for (int hb = 0; hb < 2; ++hb) {
            u32x2 xw[4][4], hw[4][4];
#pragma unroll
            for (int i = 0; i < 4; ++i) { const size_t t = (size_t)grp * 64 + hb * 32 + w * 4 + i;
#pragma unroll
                for (int q = 0; q < 4; ++q) { const int col = q * 256 + lane * 4; xw[i][q] = *(const u32x2*)(xb + t * D + col); hw[i][q] = *(const u32x2*)(hbuf + t * D + col); } }
#pragma unroll
            for (int i = 0; i < 4; ++i) { const size_t t = (size_t)grp * 64 + hb * 32 + w * 4 + i;
                f32x4 v[4]; float sm = 0.f;
#pragma unroll
                for (int q = 0; q < 4; ++q) { v[q] = (f32x4){__uint_as_float(xw[i][q][0] << 16), __uint_as_float(xw[i][q][0] & 0xffff0000u), __uint_as_float(xw[i][q][1] << 16), __uint_as_float(xw[i][q][1] & 0xffff0000u)} * ALPHA
                         + (f32x4){__uint_as_float(hw[i][q][0] << 16), __uint_as_float(hw[i][q][0] & 0xffff0000u), __uint_as_float(hw[i][q][1] << 16), __uint_as_float(hw[i][q][1] & 0xffff0000u)};
                    sm += v[q][0] + v[q][1] + v[q][2] + v[q][3]; }
                const float mean = wave_sum(sm) * (1.f / 1024.f); float sq = 0.f;
#pragma unroll
                for (int q = 0; q < 4; ++q) { v[q] = v[q] - mean; sq += v[q][0] * v[q][0] + v[q][1] * v[q][1] + v[q][2] * v[q][2] + v[q][3] * v[q][3]; }
                const float rstd = rsqrtf(wave_sum(sq) * (1.f / 1024.f) + LN_EPS);
#pragma unroll
                for (int q = 0; q < 4; ++q) { const f32x4 o = v[q] * rstd * gpre[q] + bpre[q]; nb[hb * 4 + i][q][0] = pk2(o[0], o[1]); nb[hb * 4 + i][q][1] = pk2(o[2], o[3]);
                    *(u32x2*)(xb + t * D + q * 256 + lane * 4) = nb[hb * 4 + i][q]; } }
        }
        f32x4 lg[2][2];
        const int st = w & 1, eg = w >> 1;
#pragma unroll
        for (int p2 = 0; p2 < 2; ++p2) {
            if (p2) __syncthreads();
#pragma unroll
            for (int u = 0; u < 4; ++u)
#pragma unroll
                for (int q = 0; q < 4; ++q) *(LAS u32x2*)(Xl + (w * 4 + u) * 2064 + (q * 256 + lane * 4) * 2) = nb[p2 * 4 + u][q];
            lg[p2][0] = (f32x4){0.f, 0.f, 0.f, 0.f}; lg[p2][1] = lg[p2][0];
            u32x4 wreg[8];
#pragma unroll
            for (int q = 0; q < 8; ++q) { const int i = c.tid + q * NTHREADS, r = i >> 5, cc = i & 31; wreg[q] = *(const u32x4*)((const unsigned char*)Wr + (size_t)r * 2048 + cc * 16); }
#pragma unroll
            for (int kq = 0; kq < 4; ++kq) {
                if (kq) __syncthreads();
#pragma unroll
                for (int q = 0; q < 8; ++q) { const int i = c.tid + q * NTHREADS, r = i >> 5, cc = i & 31; *(LAS u32x4*)(Wq + r * 528 + cc * 16) = wreg[q]; }
                if (kq < 3) {
#pragma unroll
                    for (int q = 0; q < 8; ++q) { const int i = c.tid + q * NTHREADS, r = i >> 5, cc = i & 31; wreg[q] = *(const u32x4*)((const unsigned char*)Wr + (size_t)r * 2048 + (kq + 1) * 512 + cc * 16); } }
                __syncthreads();
#pragma unroll
                for (int ks = 0; ks < 8; ++ks) { const bf16x8 bop = *(const LAS bf16x8*)(Xl + (16 * st + fr) * 2064 + kq * 512 + ks * 64 + fq * 16);
#pragma unroll
                    for (int ne2 = 0; ne2 < 2; ++ne2) { const bf16x8 aop = *(const LAS bf16x8*)(Wq + (32 * eg + 16 * ne2 + fr) * 528 + ks * 64 + fq * 16); lg[p2][ne2] = MFMA16(aop, bop, lg[p2][ne2]); } }
            }
        }
        __syncthreads();
#pragma unroll
        for (int p2 = 0; p2 < 2; ++p2)
#pragma unroll
            for (int ne2 = 0; ne2 < 2; ++ne2) { f32x4 sg;
#pragma unroll
                for (int r = 0; r < 4; ++r) sg[r] = sigmoidf_(lg[p2][ne2][r]);
                *(LAS f32x4*)(Sc + (p2 * 32 + 16 * st + fr) * 128 + 32 * eg + 16 * ne2 + 4 * fq) = sg; }
        if (c.tid < 128) hist[c.tid] = 0;
        __syncthreads();
        {
            const float rb0 = rb[lane], rb1 = rb[64 + lane];
#pragma unroll 2
            for (int q = 0; q < 8; ++q) { const int rr = w * 8 + q;
                const float s0 = Sc[rr * 128 + lane], s1 = Sc[rr * 128 + 64 + lane];
                const unsigned u0 = sortable_u32(s0 + rb0), u1 = sortable_u32(s1 + rb1);
                unsigned thr = 0u;
                for (int bit = 31; bit >= 0; --bit) { const unsigned cand = thr | (1u << bit); const int n = popc64(__ballot(u0 >= cand)) + popc64(__ballot(u1 >= cand)); if (n >= 8) thr = cand; }
                const bool gt0 = u0 > thr, gt1 = u1 > thr, eq0 = u0 == thr, eq1 = u1 == thr;
                const unsigned long long me0 = __ballot(eq0), me1 = __ballot(eq1);
                const int need = 8 - popc64(__ballot(gt0)) - popc64(__ballot(gt1));
                const bool sel0 = gt0 || (eq0 && rank_lt(me0) < need), sel1 = gt1 || (eq1 && popc64(me0) + rank_lt(me1) < need);
                const unsigned long long m0 = __ballot(sel0), m1 = __ballot(sel1);
                const float tot = wave_sum((sel0 ? s0 : 0.f) + (sel1 ? s1 : 0.f));
                if (sel0) { const int k = rank_lt(m0); const int lr = __hip_atomic_fetch_add(&hist[lane], 1, __ATOMIC_RELAXED, __HIP_MEMORY_SCOPE_WORKGROUP); sel[rr * 8 + k] = (lane << 16) | lr; selg[rr * 8 + k] = s0 / tot * 2.5f; }
                if (sel1) { const int k = popc64(m0) + rank_lt(m1); const int lr = __hip_atomic_fetch_add(&hist[64 + lane], 1, __ATOMIC_RELAXED, __HIP_MEMORY_SCOPE_WORKGROUP); sel[rr * 8 + k] = ((64 + lane) << 16) | lr; selg[rr * 8 + k] = s1 / tot * 2.5f; } }
        }
        __syncthreads();
        if (c.tid < 128) gbase[c.tid] = atomicAdd(&cnt[c.tid * 1024], hist[c.tid]);
        __syncthreads();
        { const int sv = sel[c.tid], e = sv >> 16, lr = sv & 0xffff; const int slot = (grp * 64 + (c.tid >> 3)) * 8 + (c.tid & 7);
          list[(size_t)e * LISTCAP + gbase[e] + lr] = slot; gate[slot] = selg[c.tid]; }
    }
}

struct MoeOrder {
    const char* Abase; const char* Bbase; size_t Bstride; int K, NT, NTG, total, G, c, mode, tid0;
    LAS int* tab; LAS int* desc;
    __device__ __forceinline__ bool next(int i, g8::Unit& u) const {
        const int ip = i / NTG, q = i - ip * NTG;
        const long L = (long)ip * G + c; if (L >= total || ip >= TAB_SLOTS) return false;
        const int d = desc[ip]; const int e = d >> 12, pn = (d & 15) * NTG + q;
        u.pm = (d >> 4) & 255; u.pn = pn; u.aux = ip; u.A = Abase; u.B = Bbase + (size_t)e * Bstride + (size_t)pn * 256 * K * 2; return true;
    }
    __device__ __forceinline__ void aoff(const g8::Unit& u, int tid, unsigned (&o)[2][2]) const {
#pragma unroll
        for (int i = 0; i < 2; ++i) { int R, C; g8::stage_rc(tid * 16 + i * 8192, R, C);
#pragma unroll
            for (int h = 0; h < 2; ++h) { int s = tab[u.aux * 256 + h * 128 + R]; s = s < 0 ? 0 : s; const int row = mode ? s : (s < TK ? (s >> 3) : s - TK);
                o[h][i] = (unsigned)(row * K + C) * 2u; } }
    }
};
__device__ __forceinline__ void moe_setup(const Ctx& c, MoeOrder& S, const int* cnt, int NT, int NTG) {
    LAS int* pref = (LAS int*)(c.lds + LDS_PREF); LAS int* desc = (LAS int*)(c.lds + LDS_DESC); LAS int* tab = (LAS int*)(c.lds + LDS_TAB);
    const int* list = (const int*)(c.ws + WS_LIST);
    if (c.tid < 64) { int nb[3]; int loc = 0;
#pragma unroll
        for (int q = 0; q < 3; ++q) { const int e = c.tid * 3 + q; int n = 0; if (e < NE) n = cnt[e * 1024]; else if (e == NE) n = T; nb[q] = (n + 255) >> 8; loc += nb[q]; }
        int inc = loc;
#pragma unroll
        for (int o = 1; o < 64; o <<= 1) { const int v = __shfl_up(inc, o); if (c.tid >= o) inc += v; }
        int acc = inc - loc;
#pragma unroll
        for (int q = 0; q < 3; ++q) { const int e = c.tid * 3 + q; if (e <= NE1) pref[e] = acc; acc += nb[q]; } }
    __syncthreads();
    const int NG = NT / NTG; const int total = pref[NE1] * NG;
    LAS float* gtab = (LAS float*)(c.lds + LDS_GTAB); const float* gate = (const float*)(c.ws + WS_GATE);
    S.NT = NT; S.NTG = NTG; S.total = total; S.G = c.G; S.c = c.bid; S.tab = tab; S.desc = desc;
    {
        int sv[TAB_SLOTS / 2];
#pragma unroll
        for (int k = 0; k < TAB_SLOTS / 2; ++k) { const int i = (c.tid >> 8) + 2 * k; sv[k] = -2;
            const long L = (long)i * c.G + c.bid;
            if (L < total) {
                int wgid = (int)L; { const int q = total / 8, r = total % 8, xcd = wgid % 8, off = wgid / 8; wgid = (xcd < r ? xcd * (q + 1) : r * (q + 1) + (xcd - r) * q) + off; }
                const int rbg = wgid / NG, pn = wgid % NG;
                int lo = 0, hi = NE1;
                while (hi - lo > 1) { const int mid = (lo + hi) >> 1; if (pref[mid] <= rbg) lo = mid; else hi = mid; }
                const int e = lo, rb = rbg - pref[e], n = e < NE ? cnt[e * 1024] : T;
                if ((c.tid & 255) == 0) desc[i] = (e << 12) | (rb << 4) | pn;
                const int r = rb * 256 + (c.tid & 255); sv[k] = -1; if (r < n) sv[k] = (e < NE) ? list[(size_t)e * LISTCAP + r] : TK + r; } }
#pragma unroll
        for (int k = 0; k < TAB_SLOTS / 2; ++k) { const int i = (c.tid >> 8) + 2 * k; if (sv[k] != -2) { tab[i * 256 + (c.tid & 255)] = sv[k]; if (S.mode) gtab[i * 256 + (c.tid & 255)] = sv[k] >= 0 ? gate[sv[k]] : 0.f; } }
    }
    __syncthreads();
}
struct EpiMoeGU {
    static constexpr bool PERM = true;
    bf16_t* H; LAS int* tab;
    __device__ __forceinline__ void operator()(const f32x4 (&acc)[2][2][4][2], const g8::Unit& u, int wr, int wc, int fr, int fq) const {
#pragma unroll
        for (int ai = 0; ai < 2; ++ai)
#pragma unroll
            for (int m = 0; m < 4; ++m) { const int r = ai * 128 + wr * 64 + m * 16 + fr; const int s = tab[u.aux * 256 + r];
                if (s >= 0) { u32x4 w;
#pragma unroll
                    for (int n = 0; n < 2; ++n) { const f32x4 g = acc[ai][0][m][n], up = acc[ai][1][m][n];
                        w[2 * n] = pk2(siluf_(g[0]) * up[0], siluf_(g[1]) * up[1]); w[2 * n + 1] = pk2(siluf_(g[2]) * up[2], siluf_(g[3]) * up[3]); }
                    *(u32x4*)(H + (size_t)s * ED + u.pn * 128 + wc * 32 + fq * 8) = w; } }
    }
};
struct EpiMoeDN {
    static constexpr bool PERM = true;
    unsigned char* Y; LAS float* gtab; LAS int* tab;
    __device__ __forceinline__ void operator()(const f32x4 (&acc)[2][2][4][2], const g8::Unit& u, int wr, int wc, int fr, int fq) const {
#pragma unroll
        for (int ai = 0; ai < 2; ++ai)
#pragma unroll
            for (int m = 0; m < 4; ++m) { const int r = ai * 128 + wr * 64 + m * 16 + fr; const int s = tab[u.aux * 256 + r];
                if (s >= TK) {
#pragma unroll
                    for (int bj = 0; bj < 2; ++bj) { u32x4 w;
#pragma unroll
                        for (int n = 0; n < 2; ++n) { const f32x4 a = acc[ai][bj][m][n]; w[2 * n] = pk2(a[0], a[1]); w[2 * n + 1] = pk2(a[2], a[3]); }
                        *(u32x4*)((bf16_t*)(Y + (size_t)TK * D) + (size_t)(s - TK) * D + u.pn * 256 + bj * 128 + wc * 32 + fq * 8) = w; }
                } else if (s >= 0) { const float gt = gtab[u.aux * 256 + r] * 64.f;
#pragma unroll
                    for (int bj = 0; bj < 2; ++bj) { u32x2 w;
#pragma unroll
                        for (int n = 0; n < 2; ++n) { f32x4 a = acc[ai][bj][m][n] * gt;
#pragma unroll
                            for (int e = 0; e < 4; ++e) a[e] = fminf(fmaxf(a[e], -448.f), 448.f);
                            unsigned pw = 0u; pw = __builtin_amdgcn_cvt_pk_fp8_f32(a[0], a[1], pw, false); pw = __builtin_amdgcn_cvt_pk_fp8_f32(a[2], a[3], pw, true); w[n] = pw; }
                        *(u32x2*)(Y + (size_t)s * D + u.pn * 256 + bj * 128 + wc * 32 + fq * 8) = w; } } }
    }
};
__device__ __forceinline__ void phase_moe_gu(const Ctx& c, int L) {
    MoeOrder S; S.Abase = (const char*)(c.ws + WS_XB); S.Bbase = (const char*)(c.ws + WS_WGU) + (size_t)L * NE1 * 512 * D * 2; S.Bstride = (size_t)512 * D * 2; S.K = D; S.mode = 0; S.tid0 = c.tid;
    moe_setup(c, S, (const int*)(c.ws + CTL_CNT) + L * NE * 1024, 2, 1);
    EpiMoeGU E{(bf16_t*)(c.ws + WS_HID), S.tab};
    g8::gemm_phase<EpiMoeGU, MoeOrder>(c.lds + LDS_STAGE, D, S, E);
}
__device__ __forceinline__ void phase_moe_dn(const Ctx& c, int L) {
    MoeOrder S; S.Abase = (const char*)(c.ws + WS_HID); S.Bbase = (const char*)(c.ws + WS_WDN) + (size_t)L * NE1 * D * ED * 2; S.Bstride = (size_t)D * ED * 2; S.K = ED; S.mode = 1; S.tid0 = c.tid;
    moe_setup(c, S, (const int*)(c.ws + CTL_CNT) + L * NE * 1024, 4, 2);
    EpiMoeDN E{(unsigned char*)(c.ws + WS_U1), (LAS float*)(c.lds + LDS_GTAB), S.tab};
    g8::gemm_phase<EpiMoeDN, MoeOrder>(c.lds + LDS_STAGE, ED, S, E);
}

constexpr int PH_PER_LAYER = 9;
constexpr int N_PHASES = 1 + 4 * PH_PER_LAYER;

__global__ void __launch_bounds__(NTHREADS, 2) fwd_kernel(Params p) {
    extern __shared__ __attribute__((aligned(16))) unsigned char lds_raw[];
    LAS unsigned char* const lds0 = (LAS unsigned char*)lds_raw;
    const int wave_id = __builtin_amdgcn_readfirstlane((int)threadIdx.x >> 6);
    volatile LAS unsigned* misc = (volatile LAS unsigned*)(lds0 + LDS_MISC);
    if (threadIdx.x < 4) misc[threadIdx.x] = 0u;
    __syncthreads();
    const int lo = p.ph_lo, hi = p.ph_hi;
    XcdBarrier bar; bar.bar = (unsigned*)(p.ws + WS_CTL); bar.x = 0; bar.st = misc;
    if (hi - lo > 1) bar = xcd_barrier_post((unsigned*)(p.ws + WS_CTL), misc);
#define MKCTX() Ctx c; { int wv_ = wave_id; asm volatile("" : "+s"(wv_)); int tid_ = wv_ * 64 + (int)__builtin_amdgcn_mbcnt_hi(~0u, __builtin_amdgcn_mbcnt_lo(~0u, 0u)); asm volatile("" : "+v"(tid_)); int bid_ = blockIdx.x; asm volatile("" : "+s"(bid_)); unsigned long long ws_ = (unsigned long long)p.ws; asm volatile("" : "+s"(ws_)); \
        c.in = p.in; c.out = (float*)p.out; c.ws = (unsigned char*)(GAS unsigned char*)ws_; c.lds = lds0; c.tid = tid_; c.lane = tid_ & 63; c.wid = __builtin_amdgcn_readfirstlane(tid_ >> 6); c.bid = bid_; c.G = gridDim.x; \
        c.gtid = c.bid * NTHREADS + c.tid; c.gthreads = c.G * NTHREADS; c.gw = c.bid * 8 + c.wid; c.nwaves = c.G * 8; } unsigned char* const ws = c.ws; (void)ws
    int id = 0;
#ifndef PMASK
#define PMASK 0xffffffffu
#endif
#ifndef DUPMASK
#define DUPMASK 0u
#endif
#define PHASE(k, body) do { if (((PMASK >> (k)) & 1u) && lo <= id && id < hi) { MKCTX(); body; if ((DUPMASK >> (k)) & 1u) { body; } if (id + 1 < hi) xcd_barrier(bar, c.tid == 0); } ++id; } while (0)
    PHASE(0, phase_convert(c));
#pragma unroll 1
    for (int L = 0; L < 4; ++L) {
        const int j = L >> 1; const bool cd = (L & 1);
        if (cd) {
            PHASE(1, phase_cd_inproj(c, j));
        } else {
            PHASE(2, phase_ab_inproj(c, j));
        }
        if (!cd) { PHASE(3, phase_ab_p1(c)); PHASE(4, phase_ab_p2(c, j)); PHASE(16, phase_ab_p3(c)); }
        else     { PHASE(5, phase_cd_p1(c, j)); PHASE(15, phase_cd_scan2(c)); id += 1; }
        {
            const size_t Woff = cd ? WS_WCDOUT + (size_t)j * D * CD_OUT * 2 : WS_WABOUT + (size_t)j * D * AB_OUT * 2;
            const int K = cd ? CD_OUT : AB_OUT; const float* bias = cd ? (const float*)p.in[18] + (size_t)j * D : (const float*)p.in[5] + (size_t)j * D;
            PHASE(8, phase_dense(c, (const bf16_t*)(ws + WS_YCAT), (const bf16_t*)(ws + Woff), T, D, K, (bf16_t*)(ws + WS_HB), D, bias));
        }
        PHASE(9, phase_ln_route(c, L));
        PHASE(12, phase_moe_gu(c, L));
        PHASE(13, phase_moe_dn(c, L));
        PHASE(14, phase_ln_moe(c, (const float*)p.in[29] + (size_t)L * D, (const float*)p.in[30] + (size_t)L * D, L == 3 ? (float*)p.out : (float*)nullptr));
    }
#undef PHASE
}

extern "C" void kernel_launch(void* const* d_in, const int* in_sizes, int n_in, void* d_out, int out_size, void* d_ws, size_t ws_size, hipStream_t stream) {
    static int grid = 0;
    if (grid == 0) {
        if (n_in != 31 || out_size != T * D || ws_size < WS_END) { fprintf(stderr, "kernel_launch: unexpected shapes (n_in %d out %d ws %zu need %zu)\n", n_in, out_size, ws_size, (size_t)WS_END); grid = -1; return; }
        int dev = 0, cus = 0, per_cu = 0;
        if (hipGetDevice(&dev) != hipSuccess || hipDeviceGetAttribute(&cus, hipDeviceAttributeMultiprocessorCount, dev) != hipSuccess) { grid = -1; return; }
        if (hipFuncSetAttribute((const void*)fwd_kernel, hipFuncAttributeMaxDynamicSharedMemorySize, LDS_BYTES) != hipSuccess) { fprintf(stderr, "kernel_launch: hipFuncSetAttribute failed\n"); grid = -1; return; }
        if (hipOccupancyMaxActiveBlocksPerMultiprocessor(&per_cu, (const void*)fwd_kernel, NTHREADS, LDS_BYTES) != hipSuccess || per_cu < 1) fprintf(stderr, "kernel_launch: occupancy query says %d\n", per_cu);
        (void)hipGetLastError();
        grid = cus;
    }
    if (grid < 0) return;
    (void)hipMemsetAsync((char*)d_ws + WS_CTL, 0, CTL_BYTES, stream);
    Params p{};
    for (int i = 0; i < 31; ++i) p.in[i] = (const GAS float*)d_in[i];
    p.out = (GAS float*)d_out; p.ws = (GAS unsigned char*)d_ws;
#if N_LAUNCH_MODE == 1
    p.ph_lo = 0; p.ph_hi = N_PHASES;
    hipLaunchKernelGGL(fwd_kernel, dim3(grid), dim3(NTHREADS), LDS_BYTES, stream, p);
#else
    for (int i = 0; i < N_PHASES; ++i) { p.ph_lo = i; p.ph_hi = i + 1; hipLaunchKernelGGL(fwd_kernel, dim3(grid), dim3(NTHREADS), LDS_BYTES, stream, p); }
#endif
}
```

```cpp
#include <hip/hip_runtime.h>
#include <cstdio>
#include <cstdint>

#define LAS __attribute__((address_space(3)))
typedef unsigned short bf16_t;
typedef short bf16x8 __attribute__((ext_vector_type(8)));
typedef float f32x4 __attribute__((ext_vector_type(4)));
typedef float f32x2 __attribute__((ext_vector_type(2)));
typedef unsigned u32x4 __attribute__((ext_vector_type(4)));
typedef unsigned u32x2 __attribute__((ext_vector_type(2)));

constexpr int T = 16384, D = 1024, SEQ = 8192;
constexpr int AB_IN = 4352, AB_OUT = 2048, CD_IN = 4608, CD_OUT = 2304;
constexpr int NE = 128, NE1 = 129, TOPK = 8, ED = 256;
constexpr int TK = T * TOPK;
constexpr int NSLOT = TK + T;
constexpr int LISTCAP = 16384;
constexpr float ALPHA = 1.681792830507429f;
constexpr float LN_EPS = 1e-5f;

#ifndef N_LAUNCH_MODE
#define N_LAUNCH_MODE 1
#endif

constexpr size_t al256(size_t x) { return (x + 255) & ~(size_t)255; }
constexpr size_t WS_CTL    = 0;
constexpr size_t CTL_BYTES = 131072;
constexpr size_t CTL_CNT   = 65536;
constexpr size_t WS_WABIN  = CTL_BYTES;
constexpr size_t WS_WABOUT = WS_WABIN  + al256((size_t)2 * AB_IN * D * 2);
constexpr size_t WS_WCDIN  = WS_WABOUT + al256((size_t)2 * D * AB_OUT * 2);
constexpr size_t WS_WCDOUT = WS_WCDIN  + al256((size_t)2 * CD_IN * D * 2);
constexpr size_t WS_WRT    = WS_WCDOUT + al256((size_t)2 * D * CD_OUT * 2);
constexpr size_t WS_WGU    = WS_WRT    + al256((size_t)4 * 256 * D * 2);
constexpr size_t WS_WDN    = WS_WGU    + al256((size_t)4 * NE1 * 512 * D * 2);
constexpr size_t WS_X      = WS_WDN    + al256((size_t)4 * NE1 * D * ED * 2);
constexpr size_t WS_HB     = WS_X;
constexpr size_t WS_XB     = WS_X      + al256((size_t)T * D * 4);
constexpr size_t WS_U1     = WS_XB     + al256((size_t)T * D * 2);
constexpr size_t U1_BYTES  = al256((size_t)NSLOT * D * 2) > al256((size_t)T * CD_IN * 4) ? al256((size_t)NSLOT * D * 2) : al256((size_t)T * CD_IN * 4);
constexpr size_t WS_U2     = WS_U1     + U1_BYTES;
constexpr size_t U2_BYTES  = al256((size_t)T * 1280 * 4 * 3);
constexpr size_t WS_YCAT   = WS_U2     + U2_BYTES;
constexpr size_t WS_H      = WS_YCAT   + al256((size_t)T * CD_OUT * 2);
constexpr size_t WS_ZR     = WS_H      + al256((size_t)T * D * 4);
constexpr size_t WS_HID    = WS_ZR     + al256((size_t)T * 256 * 4);
constexpr size_t WS_LIST   = WS_HID    + al256((size_t)NSLOT * ED * 2);
constexpr size_t WS_GATE   = WS_LIST   + al256((size_t)NE * LISTCAP * 4);
constexpr size_t WS_ROPEA  = WS_GATE   + al256((size_t)NSLOT * 4);
constexpr size_t WS_ROPER  = WS_ROPEA  + al256((size_t)SEQ * 32 * 8);
constexpr size_t WS_BIASP  = WS_ROPER  + al256((size_t)SEQ * 64 * 8);
constexpr size_t WS_WLRU   = WS_BIASP  + al256((size_t)2 * AB_IN * 4);
constexpr size_t WS_SPL    = WS_WLRU   + al256((size_t)2 * 5 * 2 * 65536 * 2);
constexpr size_t WS_END    = WS_SPL    + al256((size_t)2 * 1280 * 4);
constexpr size_t CD_GU = WS_U1, CD_GVT = WS_U1 + 32 * (1024 * 1024), CD_GG = WS_U1 + 64 * (1024 * 1024), CD_XR = WS_U1 + 104 * (1024 * 1024), CD_STATS = WS_U1 + 144 * (1024 * 1024);
constexpr size_t MB = 1024 * 1024;
constexpr size_t AB_QB = WS_U1, AB_KB = WS_U1 + 32 * MB, AB_VT = WS_U1 + 36 * MB, AB_RQB = WS_U1 + 40 * MB, AB_RKB = WS_U1 + 56 * MB, AB_RKDT = WS_U1 + 72 * MB,
                 AB_RVT = WS_U1 + 88 * MB, AB_RGB = WS_U1 + 120 * MB, AB_KV = WS_U1 + 152 * MB  , AB_SPREV = WS_U1 + 216 * MB  ;
static_assert(AB_SPREV + 32 * MB <= WS_U1 + U1_BYTES, "U1 map");

__device__ __forceinline__ float bf2f(bf16_t b) { return __uint_as_float(((unsigned)b) << 16); }
__device__ __forceinline__ unsigned pk2(float lo, float hi) { unsigned r; asm("v_cvt_pk_bf16_f32 %0, %1, %2" : "=v"(r) : "v"(lo), "v"(hi)); return r; }
__device__ __forceinline__ bf16_t f2bf(float f) { return (bf16_t)(pk2(f, f) & 0xffffu); }
__device__ __forceinline__ float wave_sum(float v) {
#pragma unroll
    for (int o = 32; o; o >>= 1) v += __shfl_xor(v, o);
    return v; }
__device__ __forceinline__ float wave_max(float v) {
#pragma unroll
    for (int o = 32; o; o >>= 1) v = fmaxf(v, __shfl_xor(v, o));
    return v; }
__device__ __forceinline__ float gelu_tanh(float x) { const float u = 0.7978845608028654f * (x + 0.044715f * x * x * x); return 0.5f * x * (1.f + tanhf(u)); }
__device__ __forceinline__ float sigmoidf_(float x) { return __builtin_amdgcn_rcpf(1.f + __expf(-x)); }
__device__ __forceinline__ float siluf_(float x) { return x * __builtin_amdgcn_rcpf(1.f + __expf(-x)); }
__device__ __forceinline__ f32x4 silu4(const f32x4 x) { const f32x4 t = x * (-1.4426950408889634f); f32x4 d;
#pragma unroll
    for (int e = 0; e < 4; ++e) d[e] = __builtin_amdgcn_exp2f(t[e]);
    d = d + 1.f;
#pragma unroll
    for (int e = 0; e < 4; ++e) d[e] = __builtin_amdgcn_rcpf(d[e]);
    return x * d; }
__device__ __forceinline__ f32x4 gelu4(const f32x4 x) {
    const f32x4 t = x * ((x * x) * (-0.10294323886f) + (-2.30220819813f)); f32x4 d;
#pragma unroll
    for (int e = 0; e < 4; ++e) d[e] = __builtin_amdgcn_exp2f(t[e]);
    d = d + 1.f;
#pragma unroll
    for (int e = 0; e < 4; ++e) d[e] = __builtin_amdgcn_rcpf(d[e]);
    return x * d; }

#define XB_TMO      128
#define XB_XCNT(j)  (256  + 64 * (j))
#define XB_XSUB(j)  (1280 + 64 * (j))
#define XB_XGEN(j)  (2304 + 64 * (j))
#define XB_TOP      3328
#define XB_TOPGEN   3392
#define XCD_BAR_WORDS 3456
#define XB_SPIN_CAP (1u << 22)

__device__ __forceinline__ unsigned xb_ld(unsigned* p)              { return __hip_atomic_load(p, __ATOMIC_RELAXED, __HIP_MEMORY_SCOPE_AGENT); }
__device__ __forceinline__ unsigned xb_add(unsigned* p, unsigned v) { return __hip_atomic_fetch_add(p, v, __ATOMIC_RELAXED, __HIP_MEMORY_SCOPE_AGENT); }
__device__ __forceinline__ unsigned xb_xcc_id() { return (unsigned)__builtin_amdgcn_s_getreg((3 << 11) | 20) & 0xFu; }
#define XB_SPIN(cond, bar) do { unsigned _sp = 0; while (cond) { __builtin_amdgcn_s_sleep(1); \
    if ((++_sp & 255u) == 0u) { if (xb_ld(&(bar)[XB_TMO])) break; if (_sp > XB_SPIN_CAP) { atomicAdd(&(bar)[XB_TMO], 1u); break; } } } } while (0)

struct XcdBarrier { unsigned* bar; unsigned x; volatile LAS unsigned* st; };

__device__ __forceinline__ XcdBarrier xcd_barrier_post(unsigned* bar, volatile LAS unsigned* st) {
    XcdBarrier b; b.bar = bar; b.x = xb_xcc_id(); b.st = st;
    if (threadIdx.x == 0) (void)xb_add(&bar[XB_XCNT(b.x)], 1u);
    return b;
}
__device__ __forceinline__ void xcd_barrier_complete(unsigned* bar, unsigned x, unsigned& nloc, unsigned& nx) {
    const unsigned G = gridDim.x * gridDim.y * gridDim.z;
    unsigned sum, cnt, mine, sp = 0u;
    for (;;) {
        sum = 0u; cnt = 0u; mine = 0u;
#pragma unroll
        for (unsigned j = 0; j < 16; ++j) { const unsigned c = xb_ld(&bar[XB_XCNT(j)]); sum += c; cnt += (c > 0u) ? 1u : 0u; mine = (j == x) ? c : mine; }
        if (sum == G) break;
        __builtin_amdgcn_s_sleep(1);
        if ((++sp & 255u) == 0u) { if (xb_ld(&bar[XB_TMO])) break; if (sp > XB_SPIN_CAP) { atomicAdd(&bar[XB_TMO], 1u); break; } }
    }
    nloc = mine > 0u ? mine : 1u; nx = cnt > 0u ? cnt : 1u;
}
__device__ __forceinline__ void xcd_barrier(const XcdBarrier& b, const bool leader  ) {
    asm volatile("s_waitcnt vmcnt(0)" ::: "memory");
    __syncthreads();
    if (leader) {
        unsigned* bar = b.bar;
        __builtin_amdgcn_s_waitcnt(0);
        unsigned nloc = b.st[0], nx = b.st[1];
        if (nloc == 0u) { xcd_barrier_complete(bar, b.x, nloc, nx); b.st[0] = nloc; b.st[1] = nx; }
        const unsigned old = xb_add(&bar[XB_XSUB(b.x)], 1u);
        const unsigned gen = old / nloc;
        if (old + 1u == (gen + 1u) * nloc) {
            __builtin_amdgcn_fence(__ATOMIC_RELEASE, "agent");
            asm volatile("s_waitcnt vmcnt(0)" ::: "memory");
            const unsigned og = xb_add(&bar[XB_TOP], 1u);
            const unsigned tg = og / nx;
            if (og + 1u == (tg + 1u) * nx) xb_add(&bar[XB_TOPGEN], 1u);
            else XB_SPIN(xb_ld(&bar[XB_TOPGEN]) == tg, bar);
            __builtin_amdgcn_fence(__ATOMIC_ACQUIRE, "agent");
            xb_add(&bar[XB_XGEN(b.x)], 1u);
            asm volatile("s_waitcnt vmcnt(0)" ::: "memory");
        } else {
            XB_SPIN(xb_ld(&bar[XB_XGEN(b.x)]) == gen, bar);
            __builtin_amdgcn_fence(__ATOMIC_ACQUIRE, "agent");
            asm volatile("s_waitcnt vmcnt(0)" ::: "memory");
        }
    }
    __syncthreads();
}

namespace g8 {
constexpr int BM = 256, BK = 64, HALF = 128, HTB = HALF * BK * 2, STAGE_BYTES = 8 * HTB, NXCD = 8, WGM = 8;
__device__ __forceinline__ int lds_byte(int r, int c) { const int st = (r >> 4) * 2 + (c >> 5), rr = r & 15, cc = c & 31, ob = rr * 64 + cc * 2; return st * 1024 + (ob ^ (((ob >> 9) & 1) << 5)); }
__device__ __forceinline__ void stage_rc(int b, int& R, int& C) { const int st = b / 1024, sb = b % 1024, swz = sb ^ (((sb >> 9) & 1) << 5); R = (st >> 1) * 16 + swz / 64; C = (st & 1) * 32 + (swz % 64) / 2; }
__device__ __forceinline__ int perm32(int rho) { const int n = rho >> 4, i = rho & 15; return 8 * (i >> 2) + 4 * n + (i & 3); }

struct Unit { const char* A; const char* B; int pm, pn, aux; };

struct DenseOrder {
    const char* A; const char* Bt; int nM, nN, nwg, G, c, K, tid0;
    __device__ void init(const void* A_, const void* Bt_, int M, int N, int K_, int G_, int c_) { A = (const char*)A_; Bt = (const char*)Bt_; nM = M / BM; nN = N / BM; nwg = nM * nN; G = G_; c = c_; K = K_; }
    __device__ __forceinline__ bool next(int i, Unit& u) const {
        const long L = (long)i * G + c; if (L >= nwg) return false;
        int wgid = (int)L; { const int q = nwg / NXCD, r = nwg % NXCD, xcd = wgid % NXCD, off = wgid / NXCD; wgid = (xcd < r ? xcd * (q + 1) : r * (q + 1) + (xcd - r) * q) + off; }
        const int nig = WGM * nN, gid = wgid / nig, fm = gid * WGM, gsz = (nM - fm) < WGM ? (nM - fm) : WGM;
        u.pm = fm + ((wgid % nig) % gsz); u.pn = (wgid % nig) / gsz; u.aux = 0;
        u.A = A + (size_t)u.pm * BM * K * 2; u.B = Bt + (size_t)u.pn * BM * K * 2; return true;
    }
    __device__ __forceinline__ void aoff(const Unit&, int tid, unsigned (&o)[2][2]) const {
#pragma unroll
        for (int i = 0; i < 2; ++i) { int R, C; stage_rc(tid * 16 + i * 8192, R, C);
            o[0][i] = (unsigned)(R * K + C) * 2u; o[1][i] = (unsigned)((R + HALF) * K + C) * 2u; }
    }
};

__device__ __forceinline__ unsigned cvt_pk_bf16(float lo, float hi) { unsigned r; asm volatile("v_cvt_pk_bf16_f32 %0, %1, %2" : "=v"(r) : "v"(lo), "v"(hi)); return r; }

struct EpiF32 {
    static constexpr bool PERM = false;
    float* C; int ldc; const float* bias;
    __device__ __forceinline__ void init(f32x4 (&acc)[2][2][4][2], const Unit&, int, int) const {
#pragma unroll
        for (int a = 0; a < 2; ++a)
#pragma unroll
            for (int b = 0; b < 2; ++b)
#pragma unroll
                for (int m = 0; m < 4; ++m)
#pragma unroll
                    for (int n = 0; n < 2; ++n) acc[a][b][m][n] = (f32x4){0.f, 0.f, 0.f, 0.f}; }
    __device__ __forceinline__ void operator()(const f32x4 (&acc)[2][2][4][2], const Unit& u, int wr, int wc, int fr, int fq) const {
        const int row0 = u.pm * BM + wr * 64 + fr, col0 = u.pn * BM + wc * 32 + 4 * fq;
        f32x4 bv[2][2];
#pragma unroll
        for (int bj = 0; bj < 2; ++bj)
#pragma unroll
            for (int n = 0; n < 2; ++n) bv[bj][n] = bias ? *(const f32x4*)(bias + col0 + bj * HALF + n * 16) : (f32x4){0.f, 0.f, 0.f, 0.f};
#pragma unroll
        for (int ai = 0; ai < 2; ++ai)
#pragma unroll
            for (int m = 0; m < 4; ++m) { float* rowp = C + (size_t)(row0 + ai * HALF + m * 16) * ldc + col0;
#pragma unroll
                for (int bj = 0; bj < 2; ++bj)
#pragma unroll
                    for (int n = 0; n < 2; ++n) *(f32x4*)(rowp + bj * HALF + n * 16) = acc[ai][bj][m][n] + bv[bj][n]; }
    }
};

struct EpiBf16 {
    static constexpr bool PERM = true;
    bf16_t* O; int ldc; const float* bias;
    __device__ __forceinline__ void init(f32x4 (&acc)[2][2][4][2], const Unit&, int, int) const {
#pragma unroll
        for (int a = 0; a < 2; ++a)
#pragma unroll
            for (int b = 0; b < 2; ++b)
#pragma unroll
                for (int m = 0; m < 4; ++m)
#pragma unroll
                    for (int n = 0; n < 2; ++n) acc[a][b][m][n] = (f32x4){0.f, 0.f, 0.f, 0.f}; }
    __device__ __forceinline__ void operator()(const f32x4 (&acc)[2][2][4][2], const Unit& u, int wr, int wc, int fr, int fq) const {
        const int row0 = u.pm * BM + wr * 64 + fr, col0 = u.pn * BM + wc * 32 + 8 * fq;
        f32x4 bv[2][2];
#pragma unroll
        for (int bj = 0; bj < 2; ++bj)
#pragma unroll
            for (int n = 0; n < 2; ++n) bv[bj][n] = *(const f32x4*)(bias + col0 + bj * HALF + 4 * n);
#pragma unroll
        for (int ai = 0; ai < 2; ++ai)
#pragma unroll
            for (int m = 0; m < 4; ++m) { bf16_t* rowp = O + (size_t)(row0 + ai * HALF + m * 16) * ldc + col0;
#pragma unroll
                for (int bj = 0; bj < 2; ++bj) { const f32x4 v0 = acc[ai][bj][m][0] + bv[bj][0], v1 = acc[ai][bj][m][1] + bv[bj][1];
                    u32x4 w; w[0] = cvt_pk_bf16(v0[0], v0[1]); w[1] = cvt_pk_bf16(v0[2], v0[3]); w[2] = cvt_pk_bf16(v1[0], v1[1]); w[3] = cvt_pk_bf16(v1[2], v1[3]);
                    *(u32x4*)(rowp + bj * HALF) = w; } }
    }
};

template <class Epi, class Sched>
__device__ __forceinline__ void gemm_phase(LAS unsigned char* lds, const int K, const Sched& S, const Epi& E) {
    int tid_ = S.tid0; asm volatile("" : "+v"(tid_));
    const int tid = tid_, wid = __builtin_amdgcn_readfirstlane(tid >> 6), lane = tid & 63, wr = wid >> 2, wc = wid & 3, fr = lane & 15, fq = lane >> 4;
    const int nt = K / BK;
    unsigned voffB[2];
#pragma unroll
    for (int i = 0; i < 2; ++i) { int R, C; stage_rc(tid * 16 + i * 8192, R, C); const int Rb = Epi::PERM ? ((R & ~31) + perm32(R & 31)) : R;
        voffB[i] = (unsigned)(Rb * K + C) * 2u; }
    const size_t kstep = (size_t)(BK * 2);
    const size_t hstep = (size_t)HALF * K * 2;
    const unsigned ldsw = (unsigned)wid * 1024u;
    const int aoff = lds_byte(wr * 64 + fr, fq * 8), boff = lds_byte(wc * 32 + fr, fq * 8);
#define G8_SA(b, h) (((b) * 2 + (h)) * HTB)
#define G8_SB(b, h) ((4 + (b) * 2 + (h)) * HTB)
#define G8_STAGE(bufoff, gbase, voff) do { _Pragma("unroll") for (int _i = 0; _i < 2; ++_i) \
        __builtin_amdgcn_global_load_lds((const unsigned*)((const char*)(gbase) + (voff)[_i]), (LAS unsigned*)(lds + (bufoff) + ldsw + _i * 8192), 16, 0, 0); } while (0)
#define G8_LDA(dst, b, h) do { _Pragma("unroll") for (int m = 0; m < 4; ++m) _Pragma("unroll") for (int k = 0; k < 2; ++k) dst[m][k] = *(const LAS bf16x8*)(lds + G8_SA(b, h) + aoff + m * 2048 + k * 1024); } while (0)
#define G8_LDB(dst, b, h) do { _Pragma("unroll") for (int n = 0; n < 2; ++n) _Pragma("unroll") for (int k = 0; k < 2; ++k) dst[n][k] = *(const LAS bf16x8*)(lds + G8_SB(b, h) + boff + n * 2048 + k * 1024); } while (0)
#define G8_MMA(ai, bj, At, Bt) do { __builtin_amdgcn_s_setprio(1); _Pragma("unroll") for (int m = 0; m < 4; ++m) _Pragma("unroll") for (int n = 0; n < 2; ++n) _Pragma("unroll") for (int k = 0; k < 2; ++k) \
        acc[ai][bj][m][n] = __builtin_amdgcn_mfma_f32_16x16x32_bf16(Bt[n][k], At[m][k], acc[ai][bj][m][n], 0, 0, 0); __builtin_amdgcn_s_setprio(0); } while (0)
#define G8_WAIT_V(n) asm volatile("s_waitcnt vmcnt(" #n ")" ::: "memory")
#define G8_WAIT_L(n) asm volatile("s_waitcnt lgkmcnt(" #n ")" ::: "memory")
#define G8_BAR __builtin_amdgcn_s_barrier()
#define G8_SCHED __builtin_amdgcn_sched_barrier(0)
    Unit cur, nxt; int ui = 0;
    if (!S.next(0, cur)) return;
    f32x4 acc[2][2][4][2];
    E.init(acc, cur, wc, fq);
    bf16x8 At[4][2], B0[2][2], B1[2][2];
    unsigned oc[2][2];
    S.aoff(cur, tid, oc);
    const char* cA = cur.A; const char* cB = cur.B;
    G8_STAGE(G8_SB(0, 0), cB, voffB); G8_STAGE(G8_SA(0, 0), cA, oc[0]); G8_STAGE(G8_SB(0, 1), cB + hstep, voffB); G8_STAGE(G8_SA(0, 1), cA, oc[1]);
    if (wr == 1) G8_BAR;
    G8_WAIT_V(4); G8_BAR;
    G8_STAGE(G8_SB(1, 0), cB + kstep, voffB); G8_STAGE(G8_SA(1, 0), cA + kstep, oc[0]); G8_STAGE(G8_SB(1, 1), cB + hstep + kstep, voffB);
    G8_WAIT_V(6); G8_BAR;
    for (;;) {
        const bool has_next = S.next(ui + 1, nxt);
        const char* nA = has_next ? nxt.A : cA; const char* nB = has_next ? nxt.B : cB;
#pragma unroll 1
        for (int t = 0; t < nt; t += 2) {
            const bool last = (t == nt - 2);
            const char* a1 = cA + (size_t)(t + 1) * kstep;
            const char* a2 = last ? nA : cA + (size_t)(t + 2) * kstep; const char* b2 = last ? nB : cB + (size_t)(t + 2) * kstep;
            const char* a3 = a2 + kstep; const char* b3 = b2 + kstep;
            G8_LDB(B0, 0, 0); G8_SCHED; G8_LDA(At, 0, 0); G8_STAGE(G8_SA(1, 1), a1, oc[1]);
            if (last && has_next) S.aoff(nxt, tid, oc);
            G8_WAIT_L(8); G8_BAR; G8_WAIT_L(0); G8_MMA(0, 0, At, B0); G8_BAR; G8_SCHED;
            G8_LDB(B1, 0, 1); G8_STAGE(G8_SB(0, 0), b2, voffB);
            G8_BAR; G8_WAIT_L(0); G8_MMA(0, 1, At, B1); G8_BAR;
            G8_LDA(At, 0, 1); G8_STAGE(G8_SA(0, 0), a2, oc[0]);
            G8_BAR; G8_WAIT_L(0); G8_MMA(1, 0, At, B0); G8_BAR; G8_SCHED;
            G8_STAGE(G8_SB(0, 1), b2 + hstep, voffB);
            G8_WAIT_V(6); G8_BAR; G8_MMA(1, 1, At, B1); G8_BAR;
            G8_LDB(B0, 1, 0); G8_SCHED; G8_LDA(At, 1, 0); G8_STAGE(G8_SA(0, 1), a2, oc[1]);
            G8_WAIT_L(8); G8_BAR; G8_WAIT_L(0); G8_MMA(0, 0, At, B0); G8_BAR; G8_SCHED;
            G8_LDB(B1, 1, 1); G8_STAGE(G8_SB(1, 0), b3, voffB);
            G8_BAR; G8_WAIT_L(0); G8_MMA(0, 1, At, B1); G8_BAR;
            G8_LDA(At, 1, 1); G8_STAGE(G8_SA(1, 0), a3, oc[0]);
            G8_BAR; G8_WAIT_L(0); G8_MMA(1, 0, At, B0); G8_BAR; G8_SCHED;
            G8_STAGE(G8_SB(1, 1), b3 + hstep, voffB);
            G8_WAIT_V(6); G8_BAR; G8_MMA(1, 1, At, B1); G8_BAR;
        }
        E(acc, cur, wr, wc, fr, fq);
        if (!has_next) break;
        cur = nxt; cA = nA; cB = nB; ++ui;
        E.init(acc, cur, wc, fq);
    }
    G8_WAIT_V(0);
    if (wr == 0) G8_BAR;
    G8_BAR;
#undef G8_SA
#undef G8_SB
#undef G8_STAGE
#undef G8_LDA
#undef G8_LDB
#undef G8_MMA
#undef G8_WAIT_V
#undef G8_WAIT_L
#undef G8_BAR
#undef G8_SCHED
}
}

constexpr int NTHREADS = 512;
constexpr int LDS_STAGE = 0;
constexpr int LDS_TAB   = g8::STAGE_BYTES;
constexpr int TAB_SLOTS = 6;
constexpr int LDS_GTAB  = LDS_TAB + TAB_SLOTS * 256 * 4;
constexpr int LDS_DESC  = LDS_GTAB + TAB_SLOTS * 256 * 4;
constexpr int LDS_PREF  = LDS_DESC + 64;
constexpr int LDS_MISC  = 147456 - 64;
constexpr int LDS_BYTES = 147456;
static_assert(LDS_MISC % 16 == 0 && LDS_MISC + 64 <= LDS_BYTES && LDS_PREF + 132 * 4 <= LDS_MISC, "LDS map");

#define GAS __attribute__((address_space(1)))
struct Params { const GAS float* in[31]; GAS float* out; GAS unsigned char* ws; int ph_lo, ph_hi; };

struct Ctx {
    const GAS float* const* in; float* out; unsigned char* ws; LAS unsigned char* lds;
    __device__ __forceinline__ const float* inp(int k) const { return (const float*)in[k]; }
    int tid, lane, wid, bid, G, gtid, gthreads, gw, nwaves;
};

__device__ __forceinline__ int ab_phys(int n) {
    if (n < 1024) { const int hd = n >> 6, jj = n & 63; return (hd >> 2) * 256 + (jj >> 5) * 128 + (hd & 3) * 32 + (jj & 31); }
    if (n < 1152) { const int nn = n - 1024, hh = nn >> 6, jj = nn & 63; return 1024 + (jj >> 5) * 128 + hh * 32 + (jj & 31); }
    if (n < 1280) { const int vv = n - 1152; return 1024 + (vv >> 6) * 128 + 64 + (vv & 63); }
    if (n < 2304) { const int base = n < 1792 ? 1280 : 1792, nn = n - base, h = nn >> 7, jj = nn & 127; return base + (h >> 1) * 256 + (jj >> 6) * 128 + (h & 1) * 64 + (jj & 63); }
    return n;
}
template <int TN, class DstFn>
__device__ __forceinline__ void convert_T(const Ctx& c, const float* src, int nmat, int K, int N, DstFn dstfn) {
    LAS float* tile = (LAS float*)(c.lds);
    constexpr int LDT = TN + 1, TPR = TN / 4  , KPI = NTHREADS / TPR  , NI = 64 / KPI, KPT = 64 * TN / NTHREADS  ;
    const int tk = K / 64, tn = N / TN; const long ntiles = (long)nmat * tk * tn;
    f32x4 v[NI];
    auto issue = [&](long tix) { const int m = (int)(tix / (tk * tn)); const int rem = (int)(tix % (tk * tn)); const int kt = rem / tn, nt = rem % tn;
        const float* s = src + (size_t)m * K * N + (size_t)(kt * 64) * N + nt * TN;
#pragma unroll
        for (int i = 0; i < NI; ++i) { const int k = c.tid / TPR + KPI * i, n4 = (c.tid % TPR) * 4; v[i] = __builtin_nontemporal_load((const f32x4*)(s + (size_t)k * N + n4)); } };
    if (c.bid < ntiles) issue(c.bid);
    for (long tix = c.bid; tix < ntiles; tix += c.G) {
        const int m = (int)(tix / (tk * tn)); const int rem = (int)(tix % (tk * tn)); const int kt = rem / tn, nt = rem % tn;
#pragma unroll
        for (int i = 0; i < NI; ++i) { const int k = c.tid / TPR + KPI * i, n4 = (c.tid % TPR) * 4;
            tile[k * LDT + n4 + 0] = v[i][0]; tile[k * LDT + n4 + 1] = v[i][1]; tile[k * LDT + n4 + 2] = v[i][2]; tile[k * LDT + n4 + 3] = v[i][3]; }
        if (tix + c.G < ntiles) issue(tix + c.G);
        __syncthreads();
        { constexpr int TPN = 64 / KPT; const int n = c.tid / TPN, k0 = (c.tid % TPN) * KPT;
          bf16_t* d = dstfn(m, nt * TN + n) + kt * 64 + k0;
#pragma unroll
          for (int q = 0; q < KPT / 8; ++q) { u32x4 w;
#pragma unroll
              for (int e = 0; e < 4; ++e) w[e] = pk2(tile[(k0 + q * 8 + 2 * e) * LDT + n], tile[(k0 + q * 8 + 2 * e + 1) * LDT + n]);
              *(u32x4*)(d + q * 8) = w; } }
        __syncthreads();
    }
}

__device__ __forceinline__ void phase_convert(const Ctx& c) {
    unsigned char* ws = c.ws;
    { const float* x = c.inp(0); bf16_t* xb = (bf16_t*)(ws + WS_XB);
      for (long i = c.gtid; i < (long)T * D / 4; i += c.gthreads) { const f32x4 v = *(const f32x4*)(x + i * 4); u32x2 w; w[0] = pk2(v[0], v[1]); w[1] = pk2(v[2], v[3]); *(u32x2*)(xb + i * 4) = w; } }
    { bf16_t* wrt = (bf16_t*)(ws + WS_WRT); for (long i = c.gtid; i < (long)4 * 128 * D / 8; i += c.gthreads) { const long l = i / (128 * D / 8), r = i % (128 * D / 8); *(u32x4*)(wrt + (size_t)l * 256 * D + (size_t)128 * D + r * 8) = (u32x4){0u, 0u, 0u, 0u}; }
      float* gate = (float*)(ws + WS_GATE); for (int i = c.gtid; i < T; i += c.gthreads) gate[TK + i] = 1.f;
      f32x2* ra = (f32x2*)(ws + WS_ROPEA); f32x2* rr = (f32x2*)(ws + WS_ROPER);
      for (int i = c.gtid; i < SEQ * 96; i += c.gthreads) { const int sidx = i / 96, q = i % 96; const bool isA = q < 32; const int jx = isA ? q : q - 32;
          const float e = isA ? (float)jx * (1.f / 32.f) : (float)jx * (1.f / 63.f); const float ang = (float)sidx * exp2f(-e * 13.287712379549449f); float sn, cs; sincosf(ang, &sn, &cs);
          if (isA) ra[sidx * 32 + jx] = (f32x2){cs, sn}; else rr[sidx * 64 + jx] = (f32x2){cs, sn}; }
      float* bp = (float*)(ws + WS_BIASP); for (int i = c.gtid; i < 2 * AB_IN; i += c.gthreads) { const int m = i / AB_IN, n = i % AB_IN; bp[m * AB_IN + ab_phys(n)] = c.inp(2)[i]; } }
    { bf16_t* d = (bf16_t*)(ws + WS_WABIN);  convert_T<256>(c, c.inp(1), 2, D, AB_IN, [=](int m, int n) { return d + (size_t)m * AB_IN * D + (size_t)ab_phys(n) * D; }); }
    { bf16_t* d = (bf16_t*)(ws + WS_WABOUT); convert_T<256>(c, c.inp(4), 2, AB_OUT, D, [=](int m, int n) { return d + (size_t)m * D * AB_OUT + (size_t)n * AB_OUT; }); }
    { bf16_t* d = (bf16_t*)(ws + WS_WCDIN);  convert_T<256>(c, c.inp(6), 2, D, CD_IN, [=](int m, int n) { return d + (size_t)m * CD_IN * D + (size_t)n * D; }); }
    { bf16_t* d = (bf16_t*)(ws + WS_WCDOUT); convert_T<256>(c, c.inp(17), 2, CD_OUT, D, [=](int m, int n) { return d + (size_t)m * D * CD_OUT + (size_t)n * CD_OUT; }); }
    { bf16_t* d = (bf16_t*)(ws + WS_WRT);    convert_T<128>(c, c.inp(21), 4, D, NE, [=](int m, int n) { return d + (size_t)m * 256 * D + (size_t)n * D; }); }
    { bf16_t* d = (bf16_t*)(ws + WS_WGU);
      convert_T<256>(c, c.inp(23), 4 * NE, D, ED, [=](int m, int n) { return d + (size_t)((m >> 7) * NE1 + (m & 127)) * 512 * D + (size_t)((n >> 7) * 256 + (n & 127)) * D; });
      convert_T<256>(c, c.inp(24), 4 * NE, D, ED, [=](int m, int n) { return d + (size_t)((m >> 7) * NE1 + (m & 127)) * 512 * D + (size_t)((n >> 7) * 256 + 128 + (n & 127)) * D; });
      convert_T<256>(c, c.inp(26), 4, D, ED, [=](int m, int n) { return d + (size_t)(m * NE1 + NE) * 512 * D + (size_t)((n >> 7) * 256 + (n & 127)) * D; });
      convert_T<256>(c, c.inp(27), 4, D, ED, [=](int m, int n) { return d + (size_t)(m * NE1 + NE) * 512 * D + (size_t)((n >> 7) * 256 + 128 + (n & 127)) * D; }); }
    { bf16_t* d = (bf16_t*)(ws + WS_WLRU);
      convert_T<256>(c, c.inp(12), 10, 256, 256, [=](int m, int n) { return d + (size_t)(m * 2 + 0) * 65536 + (size_t)n * 256; });
      convert_T<256>(c, c.inp(14), 10, 256, 256, [=](int m, int n) { return d + (size_t)(m * 2 + 1) * 65536 + (size_t)n * 256; });
      float* spl = (float*)(ws + WS_SPL); for (int i = c.gtid; i < 2 * 1280; i += c.gthreads) spl[i] = log1pf(expf(-c.inp(16)[i])); }
    { bf16_t* d = (bf16_t*)(ws + WS_WDN);
      convert_T<256>(c, c.inp(25), 4 * NE, ED, D, [=](int m, int n) { return d + (size_t)((m >> 7) * NE1 + (m & 127)) * D * ED + (size_t)n * ED; });
      convert_T<256>(c, c.inp(28), 4, ED, D, [=](int m, int n) { return d + (size_t)(m * NE1 + NE) * D * ED + (size_t)n * ED; }); }
}

__device__ __forceinline__ void phase_dense(const Ctx& c, const bf16_t* A, const bf16_t* Bt, int M, int N, int K, bf16_t* C, int ldc, const float* bias) {
    g8::DenseOrder S; S.init(A, Bt, M, N, K, c.G, c.bid); S.tid0 = c.tid;
    g8::EpiBf16 E{C, ldc, bias};
    g8::gemm_phase<g8::EpiBf16, g8::DenseOrder>(c.lds + LDS_STAGE, K, S, E);
}

__device__ __forceinline__ void st_bf16_off(unsigned char* base, unsigned byte_off, float v) { *(bf16_t*)(base + byte_off) = f2bf(v); }
struct EpiABIn {
    static constexpr bool PERM = true;
    LAS bf16_t* biasL; unsigned char* ws;
    __device__ __forceinline__ void init(f32x4 (&acc)[2][2][4][2], const g8::Unit& u, int wc, int fq) const {
        const int colp = u.pn * 256 + wc * 32 + fq * 8;
#pragma unroll
        for (int b = 0; b < 2; ++b)
#pragma unroll
            for (int n = 0; n < 2; ++n) { const u32x2 bw = *(const LAS u32x2*)(biasL + colp + b * 128 + 4 * n);
                const f32x4 bv = (f32x4){__uint_as_float(bw[0] << 16), __uint_as_float(bw[0] & 0xffff0000u), __uint_as_float(bw[1] << 16), __uint_as_float(bw[1] & 0xffff0000u)};
#pragma unroll
                for (int a = 0; a < 2; ++a)
#pragma unroll
                    for (int m = 0; m < 4; ++m) acc[a][b][m][n] = bv; } }
    __device__ __forceinline__ void operator()(const f32x4 (&acc)[2][2][4][2], const g8::Unit& u, int wr, int wc, int fr_, int fq_) const {
        int fr = fr_, fq = fq_; asm volatile("" : "+v"(fr), "+v"(fq));
        const int pn = u.pn; const int colp = pn * 256 + wc * 32 + fq * 8;
        bf16_t* qb = (bf16_t*)(ws + AB_QB); bf16_t* kb = (bf16_t*)(ws + AB_KB); bf16_t* vT = (bf16_t*)(ws + AB_VT); bf16_t* rqb = (bf16_t*)(ws + AB_RQB); bf16_t* rkb = (bf16_t*)(ws + AB_RKB);
        bf16_t* rkdT = (bf16_t*)(ws + AB_RKDT); bf16_t* rvT = (bf16_t*)(ws + AB_RVT); bf16_t* rgb = (bf16_t*)(ws + AB_RGB);
        const float frqA0 = exp2f(-(float)(fq * 8) * (13.287712379549449f / 32.f)) * 0.15915494309189535f;
        const float frqR0 = exp2f(-(float)((wc & 1) * 32 + fq * 8) * (13.287712379549449f / 63.f)) * 0.15915494309189535f;
        constexpr float RA[8] = {1.f, 0.7498942093324559f, 0.5623413251903491f, 0.4216965034285822f, 0.31622776601683794f, 0.23713737056616552f, 0.1778279410038923f, 0.1333521432163324f};
        constexpr float RR[8] = {1.f, 0.8639884494839686f, 0.746476040841712f, 0.6449466771037624f, 0.5572264795507174f, 0.4814372420784346f, 0.4159562163071847f, 0.35938136638046275f};
#pragma unroll
        for (int ai = 0; ai < 2; ++ai)
#pragma unroll
            for (int m = 0; m < 4; ++m) {
                const int t = u.pm * 256 + ai * 128 + wr * 64 + m * 16 + fr, sq = t & (SEQ - 1), b = t >> 13;
                f32x4 x[2][2];
#pragma unroll
                for (int bj = 0; bj < 2; ++bj)
#pragma unroll
                    for (int n = 0; n < 2; ++n) x[bj][n] = acc[ai][bj][m][n];
                if (pn < 4 || (pn == 4 && wc < 2)) {
                    const int j0 = fq * 8; const float sc = pn < 4 ? 0.125f : 1.f;
                    u32x4 w1, w2;
#pragma unroll
                    for (int n = 0; n < 2; ++n) { f32x4 o1, o2;
#pragma unroll
                        for (int e = 0; e < 4; ++e) { const float rev = __builtin_amdgcn_fractf((float)sq * (frqA0 * RA[4 * n + e])); const float cc = __builtin_amdgcn_cosf(rev) * sc, ss = __builtin_amdgcn_sinf(rev) * sc;
                            o1[e] = x[0][n][e] * cc - x[1][n][e] * ss; o2[e] = x[1][n][e] * cc + x[0][n][e] * ss; }
                        w1[2 * n] = pk2(o1[0], o1[1]); w1[2 * n + 1] = pk2(o1[2], o1[3]); w2[2 * n] = pk2(o2[0], o2[1]); w2[2 * n + 1] = pk2(o2[2], o2[3]); }
                    bf16_t* dst = pn < 4 ? qb + (size_t)t * 1024 + (pn * 4 + wc) * 64 + j0 : kb + (size_t)t * 128 + wc * 64 + j0;
                    *(u32x4*)dst = w1; *(u32x4*)(dst + 32) = w2;
                } else if (pn == 4) {
                    const int d0 = (wc - 2) * 32 + fq * 8;
#pragma unroll
                    for (int bj = 0; bj < 2; ++bj)
#pragma unroll
                        for (int n = 0; n < 2; ++n)
#pragma unroll
                            for (int e = 0; e < 4; ++e) st_bf16_off((unsigned char*)vT, (unsigned)((((b * 2 + bj) * 64 + d0 + 4 * n + e) * SEQ + sq) * 2), x[bj][n][e]);
                } else if (pn < 9) {
                    const bool isk = pn >= 7; const int h = ((pn - 5) & 1) * 2 + (wc >> 1), j0 = (wc & 1) * 32 + fq * 8;
                    const float sc = isk ? 0.08838834764831845f : 1.f;
                    const unsigned dToff = (unsigned)((((b * 4 + h) * 128 + j0) * SEQ + sq) * 2);
                    u32x4 w1, w2;
#pragma unroll
                    for (int n = 0; n < 2; ++n) { f32x4 o1, o2;
#pragma unroll
                        for (int e = 0; e < 4; ++e) { const float rev = __builtin_amdgcn_fractf((float)sq * (frqR0 * RR[4 * n + e])); const float cc = __builtin_amdgcn_cosf(rev) * sc, ss = __builtin_amdgcn_sinf(rev) * sc;
                            o1[e] = x[0][n][e] * cc - x[1][n][e] * ss; o2[e] = x[1][n][e] * cc + x[0][n][e] * ss; }
                        w1[2 * n] = pk2(o1[0], o1[1]); w1[2 * n + 1] = pk2(o1[2], o1[3]); w2[2 * n] = pk2(o2[0], o2[1]); w2[2 * n + 1] = pk2(o2[2], o2[3]);
                        if (isk) {
#pragma unroll
                            for (int e = 0; e < 4; ++e) { st_bf16_off((unsigned char*)rkdT, dToff + (unsigned)((4 * n + e) * SEQ * 2), o1[e]); st_bf16_off((unsigned char*)rkdT, dToff + (unsigned)((64 + 4 * n + e) * SEQ * 2), o2[e]); } } }
                    bf16_t* dst = (isk ? rkb : rqb) + (size_t)t * 512 + h * 128 + j0;
                    *(u32x4*)dst = w1; *(u32x4*)(dst + 64) = w2;
                } else if (pn < 13) {
                    const int h = pn - 9;
#pragma unroll
                    for (int bj = 0; bj < 2; ++bj)
#pragma unroll
                        for (int n = 0; n < 2; ++n)
#pragma unroll
                            for (int e = 0; e < 4; ++e) st_bf16_off((unsigned char*)rvT, (unsigned)((((b * 4 + h) * 256 + bj * 128 + wc * 32 + fq * 8 + 4 * n + e) * SEQ + sq) * 2), x[bj][n][e]);
                } else {
#pragma unroll
                    for (int bj = 0; bj < 2; ++bj) { u32x4 w;
#pragma unroll
                        for (int n = 0; n < 2; ++n) { const f32x4 sv = silu4(x[bj][n]); w[2 * n] = pk2(sv[0], sv[1]); w[2 * n + 1] = pk2(sv[2], sv[3]); }
                        *(u32x4*)(rgb + (size_t)t * 1024 + (pn - 13) * 256 + bj * 128 + wc * 32 + fq * 8) = w; }
                }
            }
    }
};
__device__ __forceinline__ void phase_ab_inproj(const Ctx& c, int j) {
    g8::DenseOrder S; S.init(c.ws + WS_XB, c.ws + WS_WABIN + (size_t)j * AB_IN * D * 2, T, AB_IN, D, c.G, c.bid); S.tid0 = c.tid;
    LAS bf16_t* biasL = (LAS bf16_t*)(c.lds + LDS_TAB);
    { const float* bp = (const float*)(c.ws + WS_BIASP) + (size_t)j * AB_IN; for (int i = c.tid; i < AB_IN; i += NTHREADS) biasL[i] = f2bf(bp[i]); }
    __syncthreads();
    EpiABIn E{biasL, c.ws};
    g8::gemm_phase<EpiABIn, g8::DenseOrder>(c.lds + LDS_STAGE, D, S, E);
}

#define MFMA16(a, b, c) __builtin_amdgcn_mfma_f32_16x16x32_bf16((a), (b), (c), 0, 0, 0)
__device__ __forceinline__ bf16x8 pack8(const f32x4& lo, const f32x4& hi) { u32x4 w; w[0] = g8::cvt_pk_bf16(lo[0], lo[1]); w[1] = g8::cvt_pk_bf16(lo[2], lo[3]); w[2] = g8::cvt_pk_bf16(hi[0], hi[1]); w[3] = g8::cvt_pk_bf16(hi[2], hi[3]); return __builtin_bit_cast(bf16x8, w); }
__device__ __forceinline__ bf16x8 cat8(const u32x2& lo, const u32x2& hi) { u32x4 w; w[0] = lo[0]; w[1] = lo[1]; w[2] = hi[0]; w[3] = hi[1]; return __builtin_bit_cast(bf16x8, w); }
template <int ROWS, int RB, int PAD = 32>
__device__ __forceinline__ void tile_g2l(LAS unsigned char* dst, const unsigned char* src, size_t gs, int tid, int zrows = 0) {
    constexpr int CPR = RB / 16, TOTAL = ROWS * CPR;
#pragma unroll 8
    for (int i = tid; i < TOTAL; i += NTHREADS) { const int r = i / CPR, cc = i % CPR; u32x4 v = (u32x4){0u, 0u, 0u, 0u}; if (r >= zrows) v = *(const u32x4*)(src + (size_t)r * gs + cc * 16);
        *(LAS u32x4*)(dst + r * (RB + PAD) + cc * 16) = v; }
}

__device__ __forceinline__ void attn_unit(const Ctx& c, int unit, const float* sinks) {
    const int b = unit >> 7, n = (unit >> 1) & 63, kvh = unit & 1, hd = kvh * 8 + c.wid, lane = c.lane, fr = lane & 15, fq = lane >> 4;
    const bf16_t* qb = (const bf16_t*)(c.ws + AB_QB); const bf16_t* kb = (const bf16_t*)(c.ws + AB_KB); const bf16_t* vT = (const bf16_t*)(c.ws + AB_VT); bf16_t* ycat = (bf16_t*)(c.ws + WS_YCAT);
    LAS unsigned char* Ks = c.lds; LAS unsigned char* Vs = c.lds + 256 * 160;
    const int t0 = b * SEQ + n * 128;
    __syncthreads();
    {
        const unsigned char* src = (const unsigned char*)(kb + (size_t)(t0 - 128) * 128 + kvh * 64);
        constexpr int TOTAL = 256 * 8;
#pragma unroll 4
        for (int i = c.tid; i < TOTAL; i += NTHREADS) { const int r = i >> 3, cc = i & 7; u32x4 v = (u32x4){0u, 0u, 0u, 0u}; if (n > 0 || r >= 128) v = *(const u32x4*)(src + (ptrdiff_t)r * 256 + cc * 16);
            *(LAS u32x4*)(Ks + r * 160 + cc * 16) = v; }
        const unsigned char* vsrc = (const unsigned char*)(vT + (size_t)(b * 2 + kvh) * 64 * SEQ + (n * 128 - 128));
        constexpr int TV = 64 * 32;
#pragma unroll 4
        for (int i = c.tid; i < TV; i += NTHREADS) { const int r = i >> 5, cc = i & 31; u32x4 v = (u32x4){0u, 0u, 0u, 0u}; if (n > 0 || cc >= 16) v = *(const u32x4*)(vsrc + (ptrdiff_t)r * SEQ * 2 + cc * 16);
            *(LAS u32x4*)(Vs + r * 528 + cc * 16) = v; }
    }
    __syncthreads();
    const float sink = sinks[hd];
    bf16x8 qn[2];
#pragma unroll
    for (int ks = 0; ks < 2; ++ks) qn[ks] = *(const bf16x8*)(qb + (size_t)(t0 + fr) * 1024 + hd * 64 + ks * 32 + fq * 8);
    for (int si = 0; si < 8; ++si) {
        const int t = t0 + si * 16 + fr;
        bf16x8 qf[2]; qf[0] = qn[0]; qf[1] = qn[1];
        if (si < 7) {
#pragma unroll
            for (int ks = 0; ks < 2; ++ks) qn[ks] = *(const bf16x8*)(qb + (size_t)(t + 16) * 1024 + hd * 64 + ks * 32 + fq * 8); }
        f32x4 S[10];
#pragma unroll
        for (int nk = 0; nk < 9; nk += 3) { bf16x8 kfr[3][2];
#pragma unroll
            for (int u = 0; u < 3; ++u)
#pragma unroll
                for (int ks = 0; ks < 2; ++ks) kfr[u][ks] = *(const LAS bf16x8*)(Ks + (16 * (si + nk + u) + fr) * 160 + ks * 64 + fq * 16);
            __builtin_amdgcn_sched_barrier(0);
#pragma unroll
            for (int u = 0; u < 3; ++u) { S[nk + u] = (f32x4){0.f, 0.f, 0.f, 0.f};
#pragma unroll
                for (int ks = 0; ks < 2; ++ks) S[nk + u] = MFMA16(kfr[u][ks], qf[ks], S[nk + u]); } }
        S[9] = (f32x4){0.f, 0.f, 0.f, 0.f};
        const int i = si * 16 + fr;
        float mx = sink;
#pragma unroll
        for (int nk = 0; nk < 9; ++nk)
#pragma unroll
            for (int r = 0; r < 4; ++r) { const int p = 16 * (si + nk) + 4 * fq + r; const bool ok = (p >= i + 1) && (p <= i + 128) && (n > 0 || p >= 128);
                S[nk][r] = ok ? S[nk][r] : -1e30f; mx = fmaxf(mx, S[nk][r]); }
        mx = fmaxf(mx, __shfl_xor(mx, 16)); mx = fmaxf(mx, __shfl_xor(mx, 32));
        float sum = 0.f;
#pragma unroll
        for (int nk = 0; nk < 9; ++nk)
#pragma unroll
            for (int r = 0; r < 4; ++r) { const float pv = S[nk][r] > -1e29f ? __builtin_amdgcn_exp2f((S[nk][r] - mx) * 1.4426950408889634f) : 0.f; S[nk][r] = pv; sum += pv; }
        sum += __shfl_xor(sum, 16); sum += __shfl_xor(sum, 32);
        const float inv = 1.f / (sum + exp2f((sink - mx) * 1.4426950408889634f));
        f32x4 O[4];
#pragma unroll
        for (int nd = 0; nd < 4; ++nd) O[nd] = (f32x4){0.f, 0.f, 0.f, 0.f};
#pragma unroll
        for (int kk = 0; kk < 5; ++kk) { const bf16x8 pf = pack8(S[2 * kk], S[2 * kk + 1]);
            const int p0 = 16 * (si + 2 * kk) + 4 * fq, p1 = (kk == 4 && si == 7) ? p0 : p0 + 16;
            u32x2 lo[4], hi[4];
#pragma unroll
            for (int nd = 0; nd < 4; ++nd) { lo[nd] = *(const LAS u32x2*)(Vs + (16 * nd + fr) * 528 + p0 * 2); hi[nd] = *(const LAS u32x2*)(Vs + (16 * nd + fr) * 528 + p1 * 2); }
            __builtin_amdgcn_sched_barrier(0);
#pragma unroll
            for (int nd = 0; nd < 4; ++nd) O[nd] = MFMA16(cat8(lo[nd], hi[nd]), pf, O[nd]); }
#pragma unroll
        for (int nd = 0; nd < 4; ++nd) { u32x2 w; w[0] = pk2(O[nd][0] * inv, O[nd][1] * inv); w[1] = pk2(O[nd][2] * inv, O[nd][3] * inv);
            *(u32x2*)(ycat + (size_t)t * AB_OUT + hd * 64 + 16 * nd + 4 * fq) = w; }
    }
}

__device__ __forceinline__ void ret_kv_unit(const Ctx& c, int unit) {
    const int b = unit >> 8, n = (unit >> 2) & 63, h = unit & 3, lane = c.lane, fr = lane & 15, fq = lane >> 4, w = c.wid;
    const bf16_t* rkdT = (const bf16_t*)(c.ws + AB_RKDT); const bf16_t* rvT = (const bf16_t*)(c.ws + AB_RVT); float* kv = (float*)(c.ws + AB_KV);
    LAS unsigned char* Kd = c.lds;
    __syncthreads();
    {
        const float lg = log2f(1.f - exp2f(-5.f - (float)h)); const int cc = c.tid & 15;
        float dec[8];
#pragma unroll
        for (int e = 0; e < 8; ++e) dec[e] = __builtin_amdgcn_exp2f((float)(127 - (cc * 8 + e)) * lg);
        const unsigned char* src = (const unsigned char*)(rkdT + (size_t)(b * 4 + h) * 128 * SEQ + n * 128);
#pragma unroll
        for (int q = 0; q < 4; ++q) { const int r = (c.tid >> 4) + 32 * q; const u32x4 v = *(const u32x4*)(src + (size_t)r * SEQ * 2 + cc * 16); u32x4 o;
#pragma unroll
            for (int e2 = 0; e2 < 4; ++e2) o[e2] = pk2(__uint_as_float(v[e2] << 16) * dec[2 * e2], __uint_as_float(v[e2] & 0xffff0000u) * dec[2 * e2 + 1]);
            *(LAS u32x4*)(Kd + r * 288 + cc * 16) = o; }
    }
    bf16x8 vf[2][4];
#pragma unroll
    for (int ne = 0; ne < 2; ++ne)
#pragma unroll
        for (int ks = 0; ks < 4; ++ks) vf[ne][ks] = *(const bf16x8*)(rvT + ((size_t)(b * 4 + h) * 256 + 32 * w + 16 * ne + fr) * SEQ + n * 128 + ks * 32 + fq * 8);
    __syncthreads();
    float* out = kv + ((size_t)((b * 64 + n) * 4 + h)) * 256 * 128;
#pragma unroll
    for (int nd = 0; nd < 8; ++nd) { f32x4 a0 = (f32x4){0.f, 0.f, 0.f, 0.f}, a1 = a0;
        bf16x8 kf[4];
#pragma unroll
        for (int ks = 0; ks < 4; ++ks) kf[ks] = *(const LAS bf16x8*)(Kd + (16 * nd + fr) * 288 + ks * 64 + fq * 16);
        __builtin_amdgcn_sched_barrier(0);
#pragma unroll
        for (int ks = 0; ks < 4; ++ks) { a0 = MFMA16(kf[ks], vf[0][ks], a0); a1 = MFMA16(kf[ks], vf[1][ks], a1); }
        *(f32x4*)(out + (size_t)(32 * w + fr) * 128 + 16 * nd + 4 * fq) = a0; *(f32x4*)(out + (size_t)(32 * w + 16 + fr) * 128 + 16 * nd + 4 * fq) = a1; }
}
__device__ __forceinline__ void ret_scan(const Ctx& c, int first_block, int nblocks) {
    const float* kv = (const float*)(c.ws + AB_KV); bf16_t* sp = (bf16_t*)(c.ws + AB_SPREV);
    const int nthr = nblocks * NTHREADS;
    for (int idx = (c.bid - first_block) * NTHREADS + c.tid; idx < 2 * 4 * 256 * 128 / 4; idx += nthr) {
        const int b = idx >> 15, rem = idx & 32767, h = rem >> 13;
        const float g = exp2f(128.f * log2f(1.f - exp2f(-5.f - (float)h)));
        const size_t base = (size_t)b * 64 * 131072 + (size_t)rem * 4;
        f32x4 st = (f32x4){0.f, 0.f, 0.f, 0.f};
        for (int n0 = 0; n0 < 64; n0 += 16) { f32x4 v[16];
#pragma unroll
            for (int q = 0; q < 16; ++q) v[q] = *(const f32x4*)(kv + base + (size_t)(n0 + q) * 131072);
#pragma unroll
            for (int q = 0; q < 16; ++q) { u32x2 wv; wv[0] = pk2(st[0], st[1]); wv[1] = pk2(st[2], st[3]); *(u32x2*)(sp + base + (size_t)(n0 + q) * 131072) = wv; st = st * g + v[q]; } }
    }
}
__device__ __forceinline__ void ret_out_unit(const Ctx& c, int unit) {
    const int b = unit >> 8, n = (unit >> 2) & 63, h = unit & 3, lane = c.lane, fr = lane & 15, fq = lane >> 4, w = c.wid;
    const bf16_t* rqb = (const bf16_t*)(c.ws + AB_RQB); const bf16_t* rkb = (const bf16_t*)(c.ws + AB_RKB); const bf16_t* rvT = (const bf16_t*)(c.ws + AB_RVT);
    const bf16_t* sp = (const bf16_t*)(c.ws + AB_SPREV); const bf16_t* rgb = (const bf16_t*)(c.ws + AB_RGB); bf16_t* ycat = (bf16_t*)(c.ws + WS_YCAT);
    LAS unsigned char* Kl = c.lds; LAS unsigned char* Bl = c.lds + 128 * 288;
    const int t0 = b * SEQ + n * 128; const float lg = log2f(1.f - exp2f(-5.f - (float)h));
    __syncthreads();
    tile_g2l<128, 256>(Kl, (const unsigned char*)(rkb + (size_t)t0 * 512 + h * 128), (size_t)512 * 2, c.tid);
    tile_g2l<256, 256>(Bl, (const unsigned char*)(sp + ((size_t)((b * 64 + n) * 4 + h)) * 256 * 128), (size_t)128 * 2, c.tid);
    const int t = t0 + 16 * w + fr, i = 16 * w + fr;
    bf16x8 qf[4];
#pragma unroll
    for (int ks = 0; ks < 4; ++ks) qf[ks] = *(const bf16x8*)(rqb + (size_t)t * 512 + h * 128 + ks * 32 + fq * 8);
    __syncthreads();
    bf16x8 pf[4];
#pragma unroll
    for (int kk = 0; kk < 4; ++kk) { f32x4 s2[2];
#pragma unroll
        for (int q = 0; q < 2; ++q) { const int nj = 2 * kk + q; s2[q] = (f32x4){0.f, 0.f, 0.f, 0.f};
            if (nj <= w) {
                bf16x8 kf[4];
#pragma unroll
                for (int ks = 0; ks < 4; ++ks) kf[ks] = *(const LAS bf16x8*)(Kl + (16 * nj + fr) * 288 + ks * 64 + fq * 16);
                __builtin_amdgcn_sched_barrier(0);
#pragma unroll
                for (int ks = 0; ks < 4; ++ks) s2[q] = MFMA16(kf[ks], qf[ks], s2[q]);
#pragma unroll
                for (int r = 0; r < 4; ++r) { const int jj = 16 * nj + 4 * fq + r; s2[q][r] = (i >= jj) ? s2[q][r] * __builtin_amdgcn_exp2f((float)(i - jj) * lg) : 0.f; } } }
        pf[kk] = pack8(s2[0], s2[1]); }
    f32x4 acc[16];
#pragma unroll
    for (int ne = 0; ne < 16; ne += 2) { bf16x8 sf[2][4];
#pragma unroll
        for (int u = 0; u < 2; ++u)
#pragma unroll
            for (int ks = 0; ks < 4; ++ks) sf[u][ks] = *(const LAS bf16x8*)(Bl + (16 * (ne + u) + fr) * 288 + ks * 64 + fq * 16);
        __builtin_amdgcn_sched_barrier(0);
#pragma unroll
        for (int u = 0; u < 2; ++u) { acc[ne + u] = (f32x4){0.f, 0.f, 0.f, 0.f};
#pragma unroll
            for (int ks = 0; ks < 4; ++ks) acc[ne + u] = MFMA16(sf[u][ks], qf[ks], acc[ne + u]); } }
    const float rs = exp2f((float)(i + 1) * lg);
#pragma unroll
    for (int ne = 0; ne < 16; ++ne) acc[ne] = acc[ne] * rs;
    __syncthreads();
    tile_g2l<256, 256, 16>(Bl, (const unsigned char*)(rvT + (size_t)(b * 4 + h) * 256 * SEQ + n * 128), (size_t)SEQ * 2, c.tid);
    __syncthreads();
    const int nkk = (w >> 1) + 1;
#pragma unroll
    for (int kk = 0; kk < 4; ++kk) if (kk < nkk) {
#pragma unroll
        for (int ne = 0; ne < 16; ne += 8) { u32x2 lo[8], hi[8];
#pragma unroll
            for (int u = 0; u < 8; ++u) { lo[u] = *(const LAS u32x2*)(Bl + (16 * (ne + u) + fr) * 272 + (32 * kk + 4 * fq) * 2); hi[u] = *(const LAS u32x2*)(Bl + (16 * (ne + u) + fr) * 272 + (32 * kk + 16 + 4 * fq) * 2); }
            __builtin_amdgcn_sched_barrier(0);
#pragma unroll
            for (int u = 0; u < 8; ++u) acc[ne + u] = MFMA16(cat8(lo[u], hi[u]), pf[kk], acc[ne + u]); } }
    u32x2 gpre[16];
#pragma unroll
    for (int ne = 0; ne < 16; ++ne) gpre[ne] = *(const u32x2*)(rgb + (size_t)t * 1024 + h * 256 + 16 * ne + 4 * fq);
    float sm = 0.f;
#pragma unroll
    for (int ne = 0; ne < 16; ++ne) sm += acc[ne][0] + acc[ne][1] + acc[ne][2] + acc[ne][3];
    sm += __shfl_xor(sm, 16); sm += __shfl_xor(sm, 32);
    const float mean = sm * (1.f / 256.f); float sq = 0.f;
#pragma unroll
    for (int ne = 0; ne < 16; ++ne) { acc[ne] = acc[ne] - mean; sq += acc[ne][0] * acc[ne][0] + acc[ne][1] * acc[ne][1] + acc[ne][2] * acc[ne][2] + acc[ne][3] * acc[ne][3]; }
    sq += __shfl_xor(sq, 16); sq += __shfl_xor(sq, 32);
    const float rstd = rsqrtf(sq * (1.f / 256.f) + LN_EPS);
#pragma unroll
    for (int ne = 0; ne < 16; ++ne) { const u32x2 gw = gpre[ne];
        const float g0 = __uint_as_float(gw[0] << 16), g1 = __uint_as_float(gw[0] & 0xffff0000u), g2 = __uint_as_float(gw[1] << 16), g3 = __uint_as_float(gw[1] & 0xffff0000u);
        u32x2 o; o[0] = pk2(acc[ne][0] * rstd * g0, acc[ne][1] * rstd * g1); o[1] = pk2(acc[ne][2] * rstd * g2, acc[ne][3] * rstd * g3);
        *(u32x2*)(ycat + (size_t)t * AB_OUT + 1024 + h * 256 + 16 * ne + 4 * fq) = o; }
}

__device__ __forceinline__ void phase_ab_p1(const Ctx& c) {
    for (int u = c.bid; u < 512; u += c.G) ret_kv_unit(c, u);
}
__device__ __forceinline__ void phase_ab_p2(const Ctx& c, int j) {
    ret_scan(c, 0, c.G);
    { const float* sinks = c.inp(3) + j * 16; for (int u = c.bid; u < 256; u += c.G) attn_unit(c, u, sinks); }
}
__device__ __forceinline__ void phase_ab_p3(const Ctx& c) {
    for (int u = c.bid; u < 512; u += c.G) ret_out_unit(c, u);
}

__device__ __forceinline__ float gelu_fast(float x) { const float u = 1.5957691216057308f * (x + 0.044715f * x * x * x); return x * __builtin_amdgcn_rcpf(1.f + __expf(-u)); }
struct EpiCDIn {
    static constexpr bool PERM = true;
    LAS bf16_t* biasL; unsigned char* ws;
    __device__ __forceinline__ void init(f32x4 (&acc)[2][2][4][2], const g8::Unit& u, int wc, int fq) const {
        const int colp = u.pn * 256 + wc * 32 + fq * 8;
#pragma unroll
        for (int b = 0; b < 2; ++b)
#pragma unroll
            for (int n = 0; n < 2; ++n) { const u32x2 bw = *(const LAS u32x2*)(biasL + colp + b * 128 + 4 * n);
                const f32x4 bv = (f32x4){__uint_as_float(bw[0] << 16), __uint_as_float(bw[0] & 0xffff0000u), __uint_as_float(bw[1] << 16), __uint_as_float(bw[1] & 0xffff0000u)};
#pragma unroll
                for (int a = 0; a < 2; ++a)
#pragma unroll
                    for (int m = 0; m < 4; ++m) acc[a][b][m][n] = bv; } }
    __device__ __forceinline__ void operator()(const f32x4 (&acc)[2][2][4][2], const g8::Unit& u, int wr, int wc, int fr, int fq) const {
        const int pn = u.pn; const int col0 = pn * 256 + wc * 32 + fq * 8;
        bf16_t* gu = (bf16_t*)(ws + CD_GU); bf16_t* gvT = (bf16_t*)(ws + CD_GVT); bf16_t* gg = (bf16_t*)(ws + CD_GG); bf16_t* xr = (bf16_t*)(ws + CD_XR); float* stats = (float*)(ws + CD_STATS);
#pragma unroll
        for (int ai = 0; ai < 2; ++ai)
#pragma unroll
            for (int m = 0; m < 4; ++m) {
                const int t = u.pm * 256 + ai * 128 + wr * 64 + m * 16 + fr, sq = t & (SEQ - 1), b = t >> 13;
                f32x4 x[2][2];
#pragma unroll
                for (int bj = 0; bj < 2; ++bj)
#pragma unroll
                    for (int n = 0; n < 2; ++n) { x[bj][n] = acc[ai][bj][m][n];
                        if (pn < 13) {
                            x[bj][n] = gelu4(x[bj][n]); } }
                if (pn >= 4 && pn < 8) {
                    float s1 = 0.f, s2 = 0.f;
#pragma unroll
                    for (int bj = 0; bj < 2; ++bj)
#pragma unroll
                        for (int n = 0; n < 2; ++n)
#pragma unroll
                            for (int e = 0; e < 4; ++e) { const float v = x[bj][n][e]; s1 += v; s2 += v * v;
                                st_bf16_off((unsigned char*)gvT, (unsigned)(((b * 1024 + (pn - 4) * 256 + bj * 128 + wc * 32 + fq * 8 + 4 * n + e) * SEQ + sq) * 2), v); }
                    s1 += __shfl_xor(s1, 16); s1 += __shfl_xor(s1, 32); s2 += __shfl_xor(s2, 16); s2 += __shfl_xor(s2, 32);
                    if (fq == 0) *(f32x2*)(stats + (size_t)t * 32 + ((pn - 4) * 4 + wc) * 2) = (f32x2){s1, s2};
                } else {
                    bf16_t* dst; int ld, cb;
                    if (pn < 4) { dst = gu; ld = 1024; cb = pn * 256; } else if (pn < 13) { dst = gg; ld = 1280; cb = (pn - 8) * 256; } else { dst = xr; ld = 1280; cb = (pn - 13) * 256; }
#pragma unroll
                    for (int bj = 0; bj < 2; ++bj) { u32x4 w;
#pragma unroll
                        for (int n = 0; n < 2; ++n) { w[2 * n] = pk2(x[bj][n][0], x[bj][n][1]); w[2 * n + 1] = pk2(x[bj][n][2], x[bj][n][3]); }
                        *(u32x4*)(dst + (size_t)t * ld + cb + bj * 128 + wc * 32 + fq * 8) = w; }
                }
            }
    }
};
__device__ __forceinline__ void phase_cd_inproj(const Ctx& c, int j) {
    g8::DenseOrder S; S.init(c.ws + WS_XB, c.ws + WS_WCDIN + (size_t)j * CD_IN * D * 2, T, CD_IN, D, c.G, c.bid); S.tid0 = c.tid;
    LAS bf16_t* biasL = (LAS bf16_t*)(c.lds + LDS_TAB);
    { const float* bp = c.inp(7) + (size_t)j * CD_IN; for (int i = c.tid; i < CD_IN; i += NTHREADS) biasL[i] = f2bf(bp[i]); }
    __syncthreads();
    EpiCDIn E{biasL, c.ws};
    g8::gemm_phase<EpiCDIn, g8::DenseOrder>(c.lds + LDS_STAGE, D, S, E);
}

__device__ __forceinline__ void lru_unit(const Ctx& c, int unit, int j) {
    const int hh = unit % 5, bn = unit / 5, lane = c.lane, fr = lane & 15, fq = lane >> 4, w = c.wid;
    const int t0 = bn * 128, s0 = t0 & (SEQ - 1);
    const bf16_t* xr = (const bf16_t*)(c.ws + CD_XR); bf16_t* HL = (bf16_t*)(c.ws + WS_U2); bf16_t* PC = HL + (size_t)T * 1280; float* sum = (float*)(c.ws + WS_H);
    const float* conv_w = c.inp(10) + (size_t)j * 4 * 1280 + hh * 256; const float* conv_b = c.inp(11) + (size_t)j * 1280 + hh * 256;
    const float* ba = c.inp(13) + (size_t)j * 1280 + hh * 256; const float* bx = c.inp(15) + (size_t)j * 1280 + hh * 256; const float* spl = (const float*)(c.ws + WS_SPL) + (size_t)j * 1280 + hh * 256;
    const bf16_t* Wl = (const bf16_t*)(c.ws + WS_WLRU) + (size_t)((j * 5 + hh) * 2) * 65536;
    LAS unsigned char* Xc = c.lds; LAS unsigned char* Wa = c.lds + 128 * 544; LAS unsigned char* Wx = Wa + 64 * 544; LAS unsigned char* Tot = Wx + 64 * 544; LAS float* Bl = (LAS float*)(Tot + 4096);
    __syncthreads();
    if (c.tid < 192) { const int which = c.tid >> 6, i4 = (c.tid & 63) * 4; const float* srcp = which == 0 ? ba : (which == 1 ? bx : spl); *(LAS f32x4*)(Bl + which * 256 + i4) = *(const f32x4*)(srcp + i4); }
    {
        const int cg = c.tid & 31, r0 = (c.tid >> 5) * 8;
        float wv[4][8], bv8[8];
        { const f32x4 b0 = *(const f32x4*)(conv_b + cg * 8), b1 = *(const f32x4*)(conv_b + cg * 8 + 4); bv8[0] = b0[0]; bv8[1] = b0[1]; bv8[2] = b0[2]; bv8[3] = b0[3]; bv8[4] = b1[0]; bv8[5] = b1[1]; bv8[6] = b1[2]; bv8[7] = b1[3]; }
#pragma unroll
        for (int k = 0; k < 4; ++k) { const f32x4 w0 = *(const f32x4*)(conv_w + k * 1280 + cg * 8), w1 = *(const f32x4*)(conv_w + k * 1280 + cg * 8 + 4);
            wv[k][0] = w0[0]; wv[k][1] = w0[1]; wv[k][2] = w0[2]; wv[k][3] = w0[3]; wv[k][4] = w1[0]; wv[k][5] = w1[1]; wv[k][6] = w1[2]; wv[k][7] = w1[3]; }
        u32x4 xin[11];
#pragma unroll
        for (int q = 0; q < 11; ++q) { xin[q] = (u32x4){0u, 0u, 0u, 0u}; if (s0 + r0 - 3 + q >= 0) xin[q] = *(const u32x4*)(xr + (size_t)(t0 + r0 - 3 + q) * 1280 + hh * 256 + cg * 8); }
#pragma unroll
        for (int rr = 0; rr < 8; ++rr) { float a[8];
#pragma unroll
            for (int e = 0; e < 8; ++e) a[e] = bv8[e];
#pragma unroll
            for (int k = 0; k < 4; ++k) { const u32x4 xv = xin[rr + k];
#pragma unroll
                for (int e2 = 0; e2 < 4; ++e2) { a[2 * e2] += wv[k][2 * e2] * __uint_as_float(xv[e2] << 16); a[2 * e2 + 1] += wv[k][2 * e2 + 1] * __uint_as_float(xv[e2] & 0xffff0000u); } }
            u32x4 o; o[0] = pk2(a[0], a[1]); o[1] = pk2(a[2], a[3]); o[2] = pk2(a[4], a[5]); o[3] = pk2(a[6], a[7]);
            *(LAS u32x4*)(Xc + (r0 + rr) * 544 + cg * 16) = o; }
    }
    u32x4 wreg[8];
#pragma unroll
    for (int q = 0; q < 4; ++q) { const int i = c.tid + q * NTHREADS, r = i >> 5, cc = i & 31; wreg[q] = *(const u32x4*)((const unsigned char*)Wl + (size_t)r * 512 + cc * 16); wreg[4 + q] = *(const u32x4*)((const unsigned char*)(Wl + 65536) + (size_t)r * 512 + cc * 16); }
    __syncthreads();
    bf16x8 xf[8];
#pragma unroll
    for (int ks = 0; ks < 8; ++ks) xf[ks] = *(const LAS bf16x8*)(Xc + (16 * w + fr) * 544 + ks * 64 + fq * 16);
    const int t = t0 + 16 * w + fr;
    for (int sl = 0; sl < 4; ++sl) {
        if (sl) __syncthreads();
#pragma unroll
        for (int q = 0; q < 4; ++q) { const int i = c.tid + q * NTHREADS, r = i >> 5, cc = i & 31; *(LAS u32x4*)(Wa + r * 544 + cc * 16) = wreg[q]; *(LAS u32x4*)(Wx + r * 544 + cc * 16) = wreg[4 + q]; }
        if (sl < 3) {
#pragma unroll
            for (int q = 0; q < 4; ++q) { const int i = c.tid + q * NTHREADS, r = i >> 5, cc = i & 31;
                wreg[q] = *(const u32x4*)((const unsigned char*)(Wl + (size_t)((sl + 1) * 64) * 256) + (size_t)r * 512 + cc * 16); wreg[4 + q] = *(const u32x4*)((const unsigned char*)(Wl + 65536 + (size_t)((sl + 1) * 64) * 256) + (size_t)r * 512 + cc * 16); } }
        __syncthreads();
        f32x4 sA[4], sB[4];
#pragma unroll
        for (int nc = 0; nc < 4; ++nc) { f32x4 ra = (f32x4){0.f, 0.f, 0.f, 0.f}, ri = ra;
            bf16x8 waf[8], wxf[8];
#pragma unroll
            for (int ks = 0; ks < 8; ++ks) { waf[ks] = *(const LAS bf16x8*)(Wa + (16 * nc + fr) * 544 + ks * 64 + fq * 16); wxf[ks] = *(const LAS bf16x8*)(Wx + (16 * nc + fr) * 544 + ks * 64 + fq * 16); }
            __builtin_amdgcn_sched_barrier(0);
#pragma unroll
            for (int ks = 0; ks < 8; ++ks) { ra = MFMA16(waf[ks], xf[ks], ra); ri = MFMA16(wxf[ks], xf[ks], ri); }
            const int ch = sl * 64 + 16 * nc + 4 * fq;
            const f32x4 b_a = *(const LAS f32x4*)(Bl + ch), b_x = *(const LAS f32x4*)(Bl + 256 + ch), sp = *(const LAS f32x4*)(Bl + 512 + ch);
            const u32x2 xw = *(const LAS u32x2*)(Xc + (16 * w + fr) * 544 + ch * 2);
            const float xcv[4] = {__uint_as_float(xw[0] << 16), __uint_as_float(xw[0] & 0xffff0000u), __uint_as_float(xw[1] << 16), __uint_as_float(xw[1] & 0xffff0000u)};
            f32x4 oa, ob;
#pragma unroll
            for (int r = 0; r < 4; ++r) { const float gr = __builtin_amdgcn_rcpf(1.f + __expf(-(ra[r] + b_a[r]))), gi = __builtin_amdgcn_rcpf(1.f + __expf(-(ri[r] + b_x[r]))); const float la = -8.f * gr * sp[r]; const float a = __expf(la);
                oa[r] = a; ob[r] = __builtin_amdgcn_sqrtf(fmaxf(1.f - a * a, 0.f)) * (gi * xcv[r]); }
            sA[nc] = oa; sB[nc] = ob;
        }
#pragma unroll
        for (int dlt = 1; dlt < 16; dlt <<= 1) { f32x4 pa[4], pb[4];
#pragma unroll
            for (int nc = 0; nc < 4; ++nc)
#pragma unroll
                for (int r = 0; r < 4; ++r) { pa[nc][r] = __shfl_up(sA[nc][r], dlt, 16); pb[nc][r] = __shfl_up(sB[nc][r], dlt, 16); }
            if (fr >= dlt) {
#pragma unroll
                for (int nc = 0; nc < 4; ++nc) { sB[nc] = sA[nc] * pb[nc] + sB[nc]; sA[nc] = sA[nc] * pa[nc]; } } }
        if (fr == 15) {
#pragma unroll
            for (int nc = 0; nc < 4; ++nc) { *(LAS f32x4*)(Tot + ((w * 64 + 16 * nc + 4 * fq) * 2) * 4) = sA[nc]; *(LAS f32x4*)(Tot + ((w * 64 + 16 * nc + 4 * fq) * 2 + 4) * 4) = sB[nc]; } }
        __syncthreads();
#pragma unroll
        for (int nc = 0; nc < 4; ++nc) { const int ch = sl * 64 + 16 * nc + 4 * fq;
            f32x4 cp = (f32x4){1.f, 1.f, 1.f, 1.f}, chh = (f32x4){0.f, 0.f, 0.f, 0.f};
            f32x4 ta[7], tb[7];
#pragma unroll
            for (int w2 = 0; w2 < 7; ++w2) { ta[w2] = *(const LAS f32x4*)(Tot + ((w2 * 64 + 16 * nc + 4 * fq) * 2) * 4); tb[w2] = *(const LAS f32x4*)(Tot + ((w2 * 64 + 16 * nc + 4 * fq) * 2 + 4) * 4); }
#pragma unroll
            for (int w2 = 0; w2 < 7; ++w2) if (w2 < w) { chh = ta[w2] * chh + tb[w2]; cp = cp * ta[w2]; }
            const f32x4 hl = sB[nc] + sA[nc] * chh, pc = sA[nc] * cp;
            u32x2 o1, o2; o1[0] = pk2(hl[0], hl[1]); o1[1] = pk2(hl[2], hl[3]); o2[0] = pk2(pc[0], pc[1]); o2[1] = pk2(pc[2], pc[3]);
            *(u32x2*)(HL + (size_t)t * 1280 + hh * 256 + ch) = o1; *(u32x2*)(PC + (size_t)t * 1280 + hh * 256 + ch) = o2;
            if (w == 7 && fr == 15) { float* sm = sum + ((size_t)bn * 1280 + hh * 256 + ch) * 2;
#pragma unroll
                for (int r = 0; r < 4; ++r) { sm[2 * r] = pc[r]; sm[2 * r + 1] = hl[r]; } } }
    }
}

__device__ __forceinline__ void sgu_unit(const Ctx& c, int unit, int j) {
    const int g = unit & 3, bn = unit >> 2, b = bn >> 6, n = bn & 63, lane = c.lane, fr = lane & 15, fq = lane >> 4, w = c.wid;
    const int t0 = bn * 128;
    const bf16_t* gu = (const bf16_t*)(c.ws + CD_GU); const bf16_t* gvT = (const bf16_t*)(c.ws + CD_GVT); const float* stats = (const float*)(c.ws + CD_STATS); bf16_t* ycat = (bf16_t*)(c.ws + WS_YCAT);
    const float* sw = c.inp(8) + (size_t)(j * 4 + g) * 16384; const float* sb = c.inp(9) + (size_t)(j * 4 + g) * 128;
    LAS unsigned char* Vt = c.lds; LAS float* mr = (LAS float*)(c.lds + 256 * 288);
    __syncthreads();
    tile_g2l<256, 256>(Vt, (const unsigned char*)(gvT + ((size_t)b * 1024 + g * 256) * SEQ + n * 128), (size_t)SEQ * 2, c.tid);
    if (c.tid < 128) { const f32x4* st = (const f32x4*)(stats + (size_t)(t0 + c.tid) * 32); float s1 = 0.f, s2 = 0.f; f32x4 sv[8];
#pragma unroll
        for (int q = 0; q < 8; ++q) sv[q] = st[q];
#pragma unroll
        for (int q = 0; q < 8; ++q) { s1 += sv[q][0] + sv[q][2]; s2 += sv[q][1] + sv[q][3]; }
        const float mean = s1 * (1.f / 1024.f), var = fmaxf(s2 * (1.f / 1024.f) - mean * mean, 0.f); mr[2 * c.tid] = mean; mr[2 * c.tid + 1] = rsqrtf(var + LN_EPS); }
    __syncthreads();
    const int i = 16 * w + fr, t = t0 + i, nks = (w >> 1) + 1;
    bf16x8 wf[4]; float ci = 0.f;
#pragma unroll
    for (int ks = 0; ks < 4; ++ks) { f32x4 lo = (f32x4){0.f, 0.f, 0.f, 0.f}, hi = lo;
        if (ks < nks) { const int j0 = ks * 32 + fq * 8; const f32x4 w0 = *(const f32x4*)(sw + (size_t)i * 128 + j0), w1 = *(const f32x4*)(sw + (size_t)i * 128 + j0 + 4);
#pragma unroll
            for (int e = 0; e < 4; ++e) { const float m0 = mr[2 * (j0 + e)], r0 = mr[2 * (j0 + e) + 1], m1 = mr[2 * (j0 + 4 + e)], r1 = mr[2 * (j0 + 4 + e) + 1];
                lo[e] = (j0 + e <= i) ? w0[e] * r0 : 0.f; hi[e] = (j0 + 4 + e <= i) ? w1[e] * r1 : 0.f; ci += lo[e] * m0 + hi[e] * m1; } }
        wf[ks] = pack8(lo, hi); }
    ci += __shfl_xor(ci, 16); ci += __shfl_xor(ci, 32);
    const float add = sb[i] - ci;
    f32x4 acc[16];
#pragma unroll
    for (int nd = 0; nd < 16; nd += 2) { bf16x8 vf[2][4];
#pragma unroll
        for (int u = 0; u < 2; ++u)
#pragma unroll
            for (int ks = 0; ks < 4; ++ks) if (ks < nks) vf[u][ks] = *(const LAS bf16x8*)(Vt + (16 * (nd + u) + fr) * 288 + ks * 64 + fq * 16);
        __builtin_amdgcn_sched_barrier(0);
#pragma unroll
        for (int u = 0; u < 2; ++u) { acc[nd + u] = (f32x4){0.f, 0.f, 0.f, 0.f};
#pragma unroll
            for (int ks = 0; ks < 4; ++ks) if (ks < nks) acc[nd + u] = MFMA16(vf[u][ks], wf[ks], acc[nd + u]); } }
    u32x2 upre[16];
#pragma unroll
    for (int nd = 0; nd < 16; ++nd) upre[nd] = *(const u32x2*)(gu + (size_t)t * 1024 + g * 256 + 16 * nd + 4 * fq);
#pragma unroll
    for (int nd = 0; nd < 16; ++nd) { const u32x2 uw = upre[nd];
        const float u0 = __uint_as_float(uw[0] << 16), u1 = __uint_as_float(uw[0] & 0xffff0000u), u2 = __uint_as_float(uw[1] << 16), u3 = __uint_as_float(uw[1] & 0xffff0000u);
        u32x2 o; o[0] = pk2(u0 * (acc[nd][0] + add), u1 * (acc[nd][1] + add)); o[1] = pk2(u2 * (acc[nd][2] + add), u3 * (acc[nd][3] + add));
        *(u32x2*)(ycat + (size_t)t * CD_OUT + g * 256 + 16 * nd + 4 * fq) = o; }
}
__device__ __forceinline__ void phase_cd_p1(const Ctx& c, int j) {
    for (int u = c.bid; u < 640; u += c.G) lru_unit(c, u, j);
    if (c.G == 256) {
        if (c.bid < 128) sgu_unit(c, c.bid, j);
        else { for (int q = 0; q < 3; ++q) sgu_unit(c, 128 + (c.bid - 128) * 3 + q, j); }
    } else { for (int u = c.bid; u < 512; u += c.G) sgu_unit(c, u, j); }
}

__device__ __forceinline__ void phase_cd_scan2(const Ctx& c) {
    const bf16_t* gg = (const bf16_t*)(c.ws + CD_GG); bf16_t* ycat = (bf16_t*)(c.ws + WS_YCAT);
    const bf16_t* HL = (const bf16_t*)(c.ws + WS_U2); const bf16_t* PC = HL + (size_t)T * 1280; const float* sum = (const float*)(c.ws + WS_H);
    LAS float* carry = (LAS float*)c.lds;
    for (int u = c.bid; u < 256; u += c.G) {
        const int bn = u >> 1, half = u & 1, b = bn >> 6, n = bn & 63;
        __syncthreads();
        {
            LAS float* part = carry + 1280;
            for (int it = c.tid; it < 4 * 1280; it += NTHREADS) { const int seg = it / 1280, ch = it % 1280; const float* sp = sum + ((size_t)(b * 64 + seg * 16) * 1280 + ch) * 2;
                f32x2 v[16];
#pragma unroll
                for (int q = 0; q < 16; ++q) { v[q] = (f32x2){1.f, 0.f}; if (seg * 16 + q < n) v[q] = *(const f32x2*)(sp + (size_t)q * 2560); }
                float A = 1.f, Bv = 0.f;
#pragma unroll
                for (int q = 0; q < 16; ++q) { Bv = v[q][0] * Bv + v[q][1]; A *= v[q][0]; }
                part[(seg * 1280 + ch) * 2] = A; part[(seg * 1280 + ch) * 2 + 1] = Bv; }
            __syncthreads();
            for (int ch = c.tid; ch < 1280; ch += NTHREADS) { float cr = 0.f;
#pragma unroll
                for (int seg = 0; seg < 4; ++seg) cr = part[(seg * 1280 + ch) * 2] * cr + part[(seg * 1280 + ch) * 2 + 1];
                carry[ch] = cr; }
        }
        __syncthreads();
        const size_t t0 = (size_t)bn * 128 + half * 64;
        for (int it0 = c.tid; it0 < 64 * 320; it0 += 8 * NTHREADS) {
            u32x2 hw[8], pw[8], gw[8];
#pragma unroll
            for (int q = 0; q < 8; ++q) { const int it = it0 + q * NTHREADS; const int r = it / 320, c4 = (it % 320) * 4; const size_t o = (t0 + r) * 1280 + c4; hw[q] = *(const u32x2*)(HL + o); pw[q] = *(const u32x2*)(PC + o); gw[q] = *(const u32x2*)(gg + o); }
#pragma unroll
            for (int q = 0; q < 8; ++q) { const int it = it0 + q * NTHREADS; const int r = it / 320, c4 = (it % 320) * 4; const f32x4 cr = *(const LAS f32x4*)(carry + c4);
                const float h0 = __uint_as_float(hw[q][0] << 16) + __uint_as_float(pw[q][0] << 16) * cr[0], h1 = __uint_as_float(hw[q][0] & 0xffff0000u) + __uint_as_float(pw[q][0] & 0xffff0000u) * cr[1];
                const float h2 = __uint_as_float(hw[q][1] << 16) + __uint_as_float(pw[q][1] << 16) * cr[2], h3 = __uint_as_float(hw[q][1] & 0xffff0000u) + __uint_as_float(pw[q][1] & 0xffff0000u) * cr[3];
                u32x2 ow; ow[0] = pk2(__uint_as_float(gw[q][0] << 16) * h0, __uint_as_float(gw[q][0] & 0xffff0000u) * h1); ow[1] = pk2(__uint_as_float(gw[q][1] << 16) * h2, __uint_as_float(gw[q][1] & 0xffff0000u) * h3);
                *(u32x2*)(ycat + (t0 + r) * CD_OUT + 1024 + c4) = ow; } }
    }
}

__device__ __forceinline__ void phase_ln_moe(const Ctx& c, const float* g, const float* bta, float* xout) {
    typedef float f32x2v __attribute__((ext_vector_type(2)));
    bf16_t* xb = (bf16_t*)(c.ws + WS_XB); const unsigned char* Y = (const unsigned char*)(c.ws + WS_U1);
    f32x4 gpre[2][2], bpre[2][2];
#pragma unroll
    for (int q = 0; q < 2; ++q)
#pragma unroll
        for (int h2 = 0; h2 < 2; ++h2) { gpre[q][h2] = *(const f32x4*)(g + q * 512 + c.lane * 8 + 4 * h2); bpre[q][h2] = *(const f32x4*)(bta + q * 512 + c.lane * 8 + 4 * h2); }
    for (long tt = (long)c.gw * 2; tt < T; tt += (long)c.nwaves * 2) {
        float v[2][2][8];
#pragma unroll
        for (int u = 0; u < 2; ++u) { const long t = tt + u;
#pragma unroll
            for (int q = 0; q < 2; ++q) { const int col = q * 512 + c.lane * 8;
                float f[8];
#pragma unroll
                for (int e = 0; e < 8; ++e) f[e] = 0.f;
#pragma unroll
                for (int k = 0; k < 8; ++k) { const size_t srow = (size_t)t * 8 + k; const u32x2 w = *(const u32x2*)(Y + srow * D + col);
#pragma unroll
                    for (int h2 = 0; h2 < 2; ++h2) { const f32x2v a = __builtin_amdgcn_cvt_pk_f32_fp8(w[h2], false), b = __builtin_amdgcn_cvt_pk_f32_fp8(w[h2], true);
                        f[4 * h2] += a[0]; f[4 * h2 + 1] += a[1]; f[4 * h2 + 2] += b[0]; f[4 * h2 + 3] += b[1]; } }
                const u32x4 xw = *(const u32x4*)(xb + (size_t)t * D + col), sw = *(const u32x4*)((const bf16_t*)(Y + (size_t)TK * D) + (size_t)t * D + col);
#pragma unroll
                for (int e2 = 0; e2 < 4; ++e2) { v[u][q][2 * e2] = __uint_as_float(xw[e2] << 16) * ALPHA + f[2 * e2] * (1.f / 64.f) + __uint_as_float(sw[e2] << 16);
                    v[u][q][2 * e2 + 1] = __uint_as_float(xw[e2] & 0xffff0000u) * ALPHA + f[2 * e2 + 1] * (1.f / 64.f) + __uint_as_float(sw[e2] & 0xffff0000u); } } }
#pragma unroll
        for (int u = 0; u < 2; ++u) { const long t = tt + u;
            float sm = 0.f;
#pragma unroll
            for (int q = 0; q < 2; ++q)
#pragma unroll
                for (int e = 0; e < 8; ++e) sm += v[u][q][e];
            const float mean = wave_sum(sm) * (1.f / 1024.f); float sq = 0.f;
#pragma unroll
            for (int q = 0; q < 2; ++q)
#pragma unroll
                for (int e = 0; e < 8; ++e) { v[u][q][e] -= mean; sq += v[u][q][e] * v[u][q][e]; }
            const float rstd = rsqrtf(wave_sum(sq) * (1.f / 1024.f) + LN_EPS);
#pragma unroll
            for (int q = 0; q < 2; ++q) { const int col = q * 512 + c.lane * 8; float o[8];
#pragma unroll
                for (int h2 = 0; h2 < 2; ++h2) { const f32x4 gg = gpre[q][h2], bb = bpre[q][h2];
#pragma unroll
                    for (int e = 0; e < 4; ++e) o[4 * h2 + e] = v[u][q][4 * h2 + e] * rstd * gg[e] + bb[e];
                    if (xout) *(f32x4*)(xout + (size_t)t * D + col + 4 * h2) = (f32x4){o[4 * h2], o[4 * h2 + 1], o[4 * h2 + 2], o[4 * h2 + 3]}; }
                u32x4 w; w[0] = pk2(o[0], o[1]); w[1] = pk2(o[2], o[3]); w[2] = pk2(o[4], o[5]); w[3] = pk2(o[6], o[7]); *(u32x4*)(xb + (size_t)t * D + col) = w; } }
    }
}

__device__ __forceinline__ unsigned sortable_u32(float f) { const unsigned b = __float_as_uint(f); return b ^ ((b >> 31) ? 0xffffffffu : 0x80000000u); }
__device__ __forceinline__ int popc64(unsigned long long m) { return __builtin_popcountll(m); }
__device__ __forceinline__ int rank_lt(unsigned long long m) { return (int)__builtin_amdgcn_mbcnt_hi((unsigned)(m >> 32), __builtin_amdgcn_mbcnt_lo((unsigned)m, 0u)); }
__device__ __forceinline__ void phase_ln_route(const Ctx& c, int L) {
    bf16_t* xb = (bf16_t*)(c.ws + WS_XB); const bf16_t* hbuf = (const bf16_t*)(c.ws + WS_HB);
    const float* g = c.inp(19) + (size_t)L * D; const float* bta = c.inp(20) + (size_t)L * D; const float* rb = c.inp(22) + L * NE;
    const bf16_t* Wr = (const bf16_t*)(c.ws + WS_WRT) + (size_t)L * 256 * D;
    int* cnt = (int*)(c.ws + CTL_CNT) + L * NE * 32; int* list = (int*)(c.ws + WS_LIST); float* gate = (float*)(c.ws + WS_GATE);
    LAS unsigned char* Xl = c.lds; LAS unsigned char* Wq = c.lds + 64 * 544;
    LAS float* Sc = (LAS float*)Wq;
    LAS int* hist = (LAS int*)(Wq + 32768); LAS int* gbase = hist + 128; LAS int* sel = gbase + 128; LAS float* selg = (LAS float*)(sel + 512);
    const int lane = c.lane, fr = lane & 15, fq = lane >> 4, w = c.wid;
    f32x4 gpre[4], bpre[4];
#pragma unroll
    for (int q = 0; q < 4; ++q) { gpre[q] = *(const f32x4*)(g + q * 256 + lane * 4); bpre[q] = *(const f32x4*)(bta + q * 256 + lane * 4); }
    for (int grp = c.bid; grp < T / 64; grp += c.G) {
        __syncthreads();
        u32x2 nb[8][4];
#pragma unroll
        for (int hb = 0; hb < 2; ++hb) {
            u32x2 xw[4][4], hw[4][4];
#pragma unroll
            for (int i = 0; i < 4; ++i) { const size_t t = (size_t)grp * 64 + hb * 32 + w * 4 + i;
#pragma unroll
                for (int q = 0; q < 4; ++q) { const int col = q * 256 + lane * 4; xw[i][q] = *(const u32x2*)(xb + t * D + col); hw[i][q] = *(const u32x2*)(hbuf + t * D + col); } }
#pragma unroll
            for (int i = 0; i < 4; ++i) { const size_t t = (size_t)grp * 64 + hb * 32 + w * 4 + i;
                f32x4 v[4]; float sm = 0.f;
#pragma unroll
                for (int q = 0; q < 4; ++q) { v[q] = (f32x4){__uint_as_float(xw[i][q][0] << 16), __uint_as_float(xw[i][q][0] & 0xffff0000u), __uint_as_float(xw[i][q][1] << 16), __uint_as_float(xw[i][q][1] & 0xffff0000u)} * ALPHA
                         + (f32x4){__uint_as_float(hw[i][q][0] << 16), __uint_as_float(hw[i][q][0] & 0xffff0000u), __uint_as_float(hw[i][q][1] << 16), __uint_as_float(hw[i][q][1] & 0xffff0000u)};
                    sm += v[q][0] + v[q][1] + v[q][2] + v[q][3]; }
                const float mean = wave_sum(sm) * (1.f / 1024.f); float sq = 0.f;
#pragma unroll
                for (int q = 0; q < 4; ++q) { v[q] = v[q] - mean; sq += v[q][0] * v[q][0] + v[q][1] * v[q][1] + v[q][2] * v[q][2] + v[q][3] * v[q][3]; }
                const float rstd = rsqrtf(wave_sum(sq) * (1.f / 1024.f) + LN_EPS);
#pragma unroll
                for (int q = 0; q < 4; ++q) { const f32x4 o = v[q] * rstd * gpre[q] + bpre[q]; nb[hb * 4 + i][q][0] = pk2(o[0], o[1]); nb[hb * 4 + i][q][1] = pk2(o[2], o[3]);
                    *(u32x2*)(xb + t * D + q * 256 + lane * 4) = nb[hb * 4 + i][q]; } }
        }
        f32x4 lg[2][2];
        const int st = w & 1, eg = w >> 1;
        lg[0][0] = (f32x4){0.f, 0.f, 0.f, 0.f}; lg[0][1] = lg[0][0]; lg[1][0] = lg[0][0]; lg[1][1] = lg[0][0];
        u32x4 wreg[8];
#pragma unroll
        for (int q = 0; q < 8; ++q) { const int i = c.tid + q * NTHREADS, r = i >> 5, cc = i & 31; wreg[q] = *(const u32x4*)((const unsigned char*)Wr + (size_t)r * 2048 + cc * 16); }
#pragma unroll
        for (int kq = 0; kq < 4; ++kq) {
            if (kq) __syncthreads();
#pragma unroll
            for (int q = 0; q < 8; ++q) { const int i = c.tid + q * NTHREADS, r = i >> 5, cc = i & 31; *(LAS u32x4*)(Wq + r * 544 + cc * 16) = wreg[q]; }
#pragma unroll
            for (int u = 0; u < 8; ++u) *(LAS u32x2*)(Xl + ((u >> 2) * 32 + w * 4 + (u & 3)) * 544 + lane * 8) = nb[u][kq];
            if (kq < 3) {
#pragma unroll
                for (int q = 0; q < 8; ++q) { const int i = c.tid + q * NTHREADS, r = i >> 5, cc = i & 31; wreg[q] = *(const u32x4*)((const unsigned char*)Wr + (size_t)r * 2048 + (kq + 1) * 512 + cc * 16); } }
            __syncthreads();
#pragma unroll
            for (int k4 = 0; k4 < 8; k4 += 2) { bf16x8 bop[2][2], aop[2][2];
#pragma unroll
                for (int u = 0; u < 2; ++u) { const int ks = k4 + u;
#pragma unroll
                    for (int p2 = 0; p2 < 2; ++p2) bop[p2][u] = *(const LAS bf16x8*)(Xl + (p2 * 32 + 16 * st + fr) * 544 + ks * 64 + fq * 16);
#pragma unroll
                    for (int ne2 = 0; ne2 < 2; ++ne2) aop[u][ne2] = *(const LAS bf16x8*)(Wq + (32 * eg + 16 * ne2 + fr) * 544 + ks * 64 + fq * 16); }
                __builtin_amdgcn_sched_barrier(0);
#pragma unroll
                for (int u = 0; u < 2; ++u)
#pragma unroll
                    for (int p2 = 0; p2 < 2; ++p2)
#pragma unroll
                        for (int ne2 = 0; ne2 < 2; ++ne2) lg[p2][ne2] = MFMA16(aop[u][ne2], bop[p2][u], lg[p2][ne2]); }
        }
        __syncthreads();
#pragma unroll
        for (int p2 = 0; p2 < 2; ++p2)
#pragma unroll
            for (int ne2 = 0; ne2 < 2; ++ne2) { f32x4 sg;
#pragma unroll
                for (int r = 0; r < 4; ++r) sg[r] = sigmoidf_(lg[p2][ne2][r]);
                *(LAS f32x4*)(Sc + (p2 * 32 + 16 * st + fr) * 128 + 32 * eg + 16 * ne2 + 4 * fq) = sg; }
        if (c.tid < 128) hist[c.tid] = 0;
        __syncthreads();
        {
            const float rb0 = rb[lane], rb1 = rb[64 + lane];
#pragma unroll 2
            for (int q = 0; q < 8; ++q) { const int rr = w * 8 + q;
                const float s0 = Sc[rr * 128 + lane], s1 = Sc[rr * 128 + 64 + lane];
                const unsigned u0 = sortable_u32(s0 + rb0), u1 = sortable_u32(s1 + rb1);
                unsigned thr = 0u;
                for (int bit = 31; bit >= 0; --bit) { const unsigned cand = thr | (1u << bit); const int n = popc64(__ballot(u0 >= cand)) + popc64(__ballot(u1 >= cand)); if (n >= 8) { thr = cand; if (n == 8) break; } }
                const bool gt0 = u0 > thr, gt1 = u1 > thr, eq0 = u0 == thr, eq1 = u1 == thr;
                const unsigned long long me0 = __ballot(eq0), me1 = __ballot(eq1);
                const int need = 8 - popc64(__ballot(gt0)) - popc64(__ballot(gt1));
                const bool sel0 = gt0 || (eq0 && rank_lt(me0) < need), sel1 = gt1 || (eq1 && popc64(me0) + rank_lt(me1) < need);
                const unsigned long long m0 = __ballot(sel0), m1 = __ballot(sel1);
                const float tot = wave_sum((sel0 ? s0 : 0.f) + (sel1 ? s1 : 0.f));
                if (sel0) { const int k = rank_lt(m0); const int lr = __hip_atomic_fetch_add(&hist[lane], 1, __ATOMIC_RELAXED, __HIP_MEMORY_SCOPE_WORKGROUP); sel[rr * 8 + k] = (lane << 16) | lr; selg[rr * 8 + k] = s0 / tot * 2.5f; }
                if (sel1) { const int k = popc64(m0) + rank_lt(m1); const int lr = __hip_atomic_fetch_add(&hist[64 + lane], 1, __ATOMIC_RELAXED, __HIP_MEMORY_SCOPE_WORKGROUP); sel[rr * 8 + k] = ((64 + lane) << 16) | lr; selg[rr * 8 + k] = s1 / tot * 2.5f; } }
        }
        __syncthreads();
        if (c.tid < 128) gbase[c.tid] = atomicAdd(&cnt[c.tid * 32], hist[c.tid]);
        __syncthreads();
        { const int sv = sel[c.tid], e = sv >> 16, lr = sv & 0xffff; const int slot = (grp * 64 + (c.tid >> 3)) * 8 + (c.tid & 7);
          list[(size_t)e * LISTCAP + gbase[e] + lr] = slot; gate[slot] = selg[c.tid]; }
    }
}

struct MoeOrder {
    const char* Abase; const char* Bbase; size_t Bstride; int K, NT, NTG, total, G, c, mode, tid0;
    LAS int* tab; LAS int* desc;
    __device__ __forceinline__ bool next(int i, g8::Unit& u) const {
        const int ip = i / NTG, q = i - ip * NTG;
        const long L = (long)ip * G + c; if (L >= total || ip >= TAB_SLOTS) return false;
        const int d = desc[ip]; const int e = d >> 12, pn = (d & 15) * NTG + q;
        u.pm = (d >> 4) & 255; u.pn = pn; u.aux = ip; u.A = Abase; u.B = Bbase + (size_t)e * Bstride + (size_t)pn * 256 * K * 2; return true;
    }
    __device__ __forceinline__ void aoff(const g8::Unit& u, int tid, unsigned (&o)[2][2]) const {
#pragma unroll
        for (int i = 0; i < 2; ++i) { int R, C; g8::stage_rc(tid * 16 + i * 8192, R, C);
#pragma unroll
            for (int h = 0; h < 2; ++h) { int s = tab[u.aux * 256 + h * 128 + R]; s = s < 0 ? 0 : s; const int row = mode ? s : (s < TK ? (s >> 3) : s - TK);
                o[h][i] = (unsigned)(row * K + C) * 2u; } }
    }
};
__device__ __forceinline__ void moe_setup(const Ctx& c, MoeOrder& S, const int* cnt, int NT, int NTG) {
    LAS int* pref = (LAS int*)(c.lds + LDS_PREF); LAS int* desc = (LAS int*)(c.lds + LDS_DESC); LAS int* tab = (LAS int*)(c.lds + LDS_TAB);
    const int* list = (const int*)(c.ws + WS_LIST);
    if (c.tid < 64) { int nb[3]; int loc = 0;
#pragma unroll
        for (int q = 0; q < 3; ++q) { const int e = c.tid * 3 + q; int n = 0; if (e < NE) n = cnt[e * 32]; else if (e == NE) n = T; nb[q] = (n + 255) >> 8; loc += nb[q]; }
        int inc = loc;
#pragma unroll
        for (int o = 1; o < 64; o <<= 1) { const int v = __shfl_up(inc, o); if (c.tid >= o) inc += v; }
        int acc = inc - loc;
#pragma unroll
        for (int q = 0; q < 3; ++q) { const int e = c.tid * 3 + q; if (e <= NE1) pref[e] = acc; acc += nb[q]; } }
    __syncthreads();
    const int NG = NT / NTG; const int total = pref[NE1] * NG;
    LAS float* gtab = (LAS float*)(c.lds + LDS_GTAB); const float* gate = (const float*)(c.ws + WS_GATE);
    S.NT = NT; S.NTG = NTG; S.total = total; S.G = c.G; S.c = c.bid; S.tab = tab; S.desc = desc;
    {
        int sv[TAB_SLOTS / 2];
#pragma unroll
        for (int k = 0; k < TAB_SLOTS / 2; ++k) { const int i = (c.tid >> 8) + 2 * k; sv[k] = -2;
            const long L = (long)i * c.G + c.bid;
            if (L < total) {
                int wgid = (int)L; { const int q = total / 8, r = total % 8, xcd = wgid % 8, off = wgid / 8; wgid = (xcd < r ? xcd * (q + 1) : r * (q + 1) + (xcd - r) * q) + off; }
                const int rbg = wgid / NG, pn = wgid % NG;
                int lo = 0, hi = NE1;
                while (hi - lo > 1) { const int mid = (lo + hi) >> 1; if (pref[mid] <= rbg) lo = mid; else hi = mid; }
                const int e = lo, rb = rbg - pref[e], n = e < NE ? cnt[e * 32] : T;
                if ((c.tid & 255) == 0) desc[i] = (e << 12) | (rb << 4) | pn;
                const int r = rb * 256 + (c.tid & 255); sv[k] = -1; if (r < n) sv[k] = (e < NE) ? list[(size_t)e * LISTCAP + r] : TK + r; } }
#pragma unroll
        for (int k = 0; k < TAB_SLOTS / 2; ++k) { const int i = (c.tid >> 8) + 2 * k; if (sv[k] != -2) { tab[i * 256 + (c.tid & 255)] = sv[k]; if (S.mode) gtab[i * 256 + (c.tid & 255)] = sv[k] >= 0 ? gate[sv[k]] : 0.f; } }
    }
    __syncthreads();
}
struct EpiMoeGU {
    static constexpr bool PERM = true;
    bf16_t* H; LAS int* tab;
    __device__ __forceinline__ void init(f32x4 (&acc)[2][2][4][2], const g8::Unit&, int, int) const {
#pragma unroll
        for (int a = 0; a < 2; ++a)
#pragma unroll
            for (int b = 0; b < 2; ++b)
#pragma unroll
                for (int m = 0; m < 4; ++m)
#pragma unroll
                    for (int n = 0; n < 2; ++n) acc[a][b][m][n] = (f32x4){0.f, 0.f, 0.f, 0.f}; }
    __device__ __forceinline__ void operator()(const f32x4 (&acc)[2][2][4][2], const g8::Unit& u, int wr, int wc, int fr, int fq) const {
#pragma unroll
        for (int ai = 0; ai < 2; ++ai)
#pragma unroll
            for (int m = 0; m < 4; ++m) { const int r = ai * 128 + wr * 64 + m * 16 + fr; const int s = tab[u.aux * 256 + r];
                if (s >= 0) { u32x4 w;
#pragma unroll
                    for (int n = 0; n < 2; ++n) { const f32x4 g = acc[ai][0][m][n], up = acc[ai][1][m][n];
                        const f32x4 hv = silu4(g) * up; w[2 * n] = pk2(hv[0], hv[1]); w[2 * n + 1] = pk2(hv[2], hv[3]); }
                    *(u32x4*)(H + (size_t)s * ED + u.pn * 128 + wc * 32 + fq * 8) = w; } }
    }
};
struct EpiMoeDN {
    static constexpr bool PERM = true;
    unsigned char* Y; LAS float* gtab; LAS int* tab;
    __device__ __forceinline__ void init(f32x4 (&acc)[2][2][4][2], const g8::Unit&, int, int) const {
#pragma unroll
        for (int a = 0; a < 2; ++a)
#pragma unroll
            for (int b = 0; b < 2; ++b)
#pragma unroll
                for (int m = 0; m < 4; ++m)
#pragma unroll
                    for (int n = 0; n < 2; ++n) acc[a][b][m][n] = (f32x4){0.f, 0.f, 0.f, 0.f}; }
    __device__ __forceinline__ void operator()(const f32x4 (&acc)[2][2][4][2], const g8::Unit& u, int wr, int wc, int fr, int fq) const {
#pragma unroll
        for (int ai = 0; ai < 2; ++ai)
#pragma unroll
            for (int m = 0; m < 4; ++m) { const int r = ai * 128 + wr * 64 + m * 16 + fr; const int s = tab[u.aux * 256 + r];
                if (s >= TK) {
#pragma unroll
                    for (int bj = 0; bj < 2; ++bj) { u32x4 w;
#pragma unroll
                        for (int n = 0; n < 2; ++n) { const f32x4 a = acc[ai][bj][m][n]; w[2 * n] = pk2(a[0], a[1]); w[2 * n + 1] = pk2(a[2], a[3]); }
                        *(u32x4*)((bf16_t*)(Y + (size_t)TK * D) + (size_t)(s - TK) * D + u.pn * 256 + bj * 128 + wc * 32 + fq * 8) = w; }
                } else if (s >= 0) { const float gt = gtab[u.aux * 256 + r] * 64.f;
#pragma unroll
                    for (int bj = 0; bj < 2; ++bj) { u32x2 w;
#pragma unroll
                        for (int n = 0; n < 2; ++n) { f32x4 a = acc[ai][bj][m][n] * gt;
#pragma unroll
                            for (int e = 0; e < 4; ++e) a[e] = fminf(fmaxf(a[e], -448.f), 448.f);
                            unsigned pw = 0u; pw = __builtin_amdgcn_cvt_pk_fp8_f32(a[0], a[1], pw, false); pw = __builtin_amdgcn_cvt_pk_fp8_f32(a[2], a[3], pw, true); w[n] = pw; }
                        *(u32x2*)(Y + (size_t)s * D + u.pn * 256 + bj * 128 + wc * 32 + fq * 8) = w; } } }
    }
};
__device__ __forceinline__ void phase_moe_gu(const Ctx& c, int L) {
    MoeOrder S; S.Abase = (const char*)(c.ws + WS_XB); S.Bbase = (const char*)(c.ws + WS_WGU) + (size_t)L * NE1 * 512 * D * 2; S.Bstride = (size_t)512 * D * 2; S.K = D; S.mode = 0; S.tid0 = c.tid;
    moe_setup(c, S, (const int*)(c.ws + CTL_CNT) + L * NE * 32, 2, 1);
    EpiMoeGU E{(bf16_t*)(c.ws + WS_HID), S.tab};
    g8::gemm_phase<EpiMoeGU, MoeOrder>(c.lds + LDS_STAGE, D, S, E);
}
__device__ __forceinline__ void phase_moe_dn(const Ctx& c, int L) {
    MoeOrder S; S.Abase = (const char*)(c.ws + WS_HID); S.Bbase = (const char*)(c.ws + WS_WDN) + (size_t)L * NE1 * D * ED * 2; S.Bstride = (size_t)D * ED * 2; S.K = ED; S.mode = 1; S.tid0 = c.tid;
    moe_setup(c, S, (const int*)(c.ws + CTL_CNT) + L * NE * 32, 4, 2);
    EpiMoeDN E{(unsigned char*)(c.ws + WS_U1), (LAS float*)(c.lds + LDS_GTAB), S.tab};
    g8::gemm_phase<EpiMoeDN, MoeOrder>(c.lds + LDS_STAGE, ED, S, E);
}

constexpr int PH_PER_LAYER = 9;
constexpr int N_PHASES = 1 + 4 * PH_PER_LAYER;

__global__ void __launch_bounds__(NTHREADS, 2) fwd_kernel(Params p) {
    extern __shared__ __attribute__((aligned(16))) unsigned char lds_raw[];
    LAS unsigned char* const lds0 = (LAS unsigned char*)lds_raw;
    const int wave_id = __builtin_amdgcn_readfirstlane((int)threadIdx.x >> 6);
    volatile LAS unsigned* misc = (volatile LAS unsigned*)(lds0 + LDS_MISC);
    if (threadIdx.x < 4) misc[threadIdx.x] = 0u;
    __syncthreads();
    const int lo = p.ph_lo, hi = p.ph_hi;
    XcdBarrier bar; bar.bar = (unsigned*)(p.ws + WS_CTL); bar.x = 0; bar.st = misc;
    if (hi - lo > 1) bar = xcd_barrier_post((unsigned*)(p.ws + WS_CTL), misc);
#define MKCTX() Ctx c; { int wv_ = wave_id; asm volatile("" : "+s"(wv_)); int tid_ = wv_ * 64 + (int)__builtin_amdgcn_mbcnt_hi(~0u, __builtin_amdgcn_mbcnt_lo(~0u, 0u)); asm volatile("" : "+v"(tid_)); int bid_ = blockIdx.x; asm volatile("" : "+s"(bid_)); unsigned long long ws_ = (unsigned long long)p.ws; asm volatile("" : "+s"(ws_)); \
        c.in = p.in; c.out = (float*)p.out; c.ws = (unsigned char*)(GAS unsigned char*)ws_; c.lds = lds0; c.tid = tid_; c.lane = tid_ & 63; c.wid = __builtin_amdgcn_readfirstlane(tid_ >> 6); c.bid = bid_; c.G = gridDim.x; \
        c.gtid = c.bid * NTHREADS + c.tid; c.gthreads = c.G * NTHREADS; c.gw = c.bid * 8 + c.wid; c.nwaves = c.G * 8; } unsigned char* const ws = c.ws; (void)ws
    int id = 0;
#ifndef PMASK
#define PMASK 0xffffffffu
#endif
#ifndef DUPMASK
#define DUPMASK 0u
#endif
#define PHASE(k, body) do { if (((PMASK >> (k)) & 1u) && lo <= id && id < hi) { MKCTX(); body; if ((DUPMASK >> (k)) & 1u) { body; } if (id + 1 < hi) xcd_barrier(bar, c.tid == 0); } ++id; } while (0)
    PHASE(0, phase_convert(c));
#pragma unroll 1
    for (int L = 0; L < 4; ++L) {
        const int j = L >> 1; const bool cd = (L & 1);
        if (cd) {
            PHASE(1, phase_cd_inproj(c, j));
        } else {
            PHASE(2, phase_ab_inproj(c, j));
        }
        if (!cd) { PHASE(3, phase_ab_p1(c)); PHASE(4, phase_ab_p2(c, j)); PHASE(16, phase_ab_p3(c)); }
        else     { PHASE(5, phase_cd_p1(c, j)); PHASE(15, phase_cd_scan2(c)); id += 1; }
        {
            const size_t Woff = cd ? WS_WCDOUT + (size_t)j * D * CD_OUT * 2 : WS_WABOUT + (size_t)j * D * AB_OUT * 2;
            const int K = cd ? CD_OUT : AB_OUT; const float* bias = cd ? (const float*)p.in[18] + (size_t)j * D : (const float*)p.in[5] + (size_t)j * D;
            PHASE(8, phase_dense(c, (const bf16_t*)(ws + WS_YCAT), (const bf16_t*)(ws + Woff), T, D, K, (bf16_t*)(ws + WS_HB), D, bias));
        }
        PHASE(9, phase_ln_route(c, L));
        PHASE(12, phase_moe_gu(c, L));
        PHASE(13, phase_moe_dn(c, L));
        PHASE(14, phase_ln_moe(c, (const float*)p.in[29] + (size_t)L * D, (const float*)p.in[30] + (size_t)L * D, L == 3 ? (float*)p.out : (float*)nullptr));
    }
#undef PHASE
}

extern "C" void kernel_launch(void* const* d_in, const int* in_sizes, int n_in, void* d_out, int out_size, void* d_ws, size_t ws_size, hipStream_t stream) {
    static int grid = 0;
    if (grid == 0) {
        if (n_in != 31 || out_size != T * D || ws_size < WS_END) { fprintf(stderr, "kernel_launch: unexpected shapes (n_in %d out %d ws %zu need %zu)\n", n_in, out_size, ws_size, (size_t)WS_END); grid = -1; return; }
        int dev = 0, cus = 0, per_cu = 0;
        if (hipGetDevice(&dev) != hipSuccess || hipDeviceGetAttribute(&cus, hipDeviceAttributeMultiprocessorCount, dev) != hipSuccess) { grid = -1; return; }
        if (hipFuncSetAttribute((const void*)fwd_kernel, hipFuncAttributeMaxDynamicSharedMemorySize, LDS_BYTES) != hipSuccess) { fprintf(stderr, "kernel_launch: hipFuncSetAttribute failed\n"); grid = -1; return; }
        if (hipOccupancyMaxActiveBlocksPerMultiprocessor(&per_cu, (const void*)fwd_kernel, NTHREADS, LDS_BYTES) != hipSuccess || per_cu < 1) fprintf(stderr, "kernel_launch: occupancy query says %d\n", per_cu);
        (void)hipGetLastError();
        grid = cus;
    }
    if (grid < 0) return;
    (void)hipMemsetAsync((char*)d_ws + WS_CTL, 0, CTL_BYTES, stream);
    Params p{};
    for (int i = 0; i < 31; ++i) p.in[i] = (const GAS float*)d_in[i];
    p.out = (GAS float*)d_out; p.ws = (GAS unsigned char*)d_ws;
#if N_LAUNCH_MODE == 1
    p.ph_lo = 0; p.ph_hi = N_PHASES;
    hipLaunchKernelGGL(fwd_kernel, dim3(grid), dim3(NTHREADS), LDS_BYTES, stream, p);
#else
    for (int i = 0; i < N_PHASES; ++i) { p.ph_lo = i; p.ph_hi = i + 1; hipLaunchKernelGGL(fwd_kernel, dim3(grid), dim3(NTHREADS), LDS_BYTES, stream, p); }
#endif
}
```

```cpp
#include <hip/hip_runtime.h>
#include <cstdio>
#include <cstdint>

#define LAS __attribute__((address_space(3)))
typedef unsigned short bf16_t;
typedef short bf16x8 __attribute__((ext_vector_type(8)));
typedef float f32x4 __attribute__((ext_vector_type(4)));
typedef float f32x2 __attribute__((ext_vector_type(2)));
typedef unsigned u32x4 __attribute__((ext_vector_type(4)));
typedef unsigned u32x2 __attribute__((ext_vector_type(2)));

constexpr int T = 16384, D = 1024, SEQ = 8192;
constexpr int AB_IN = 4352, AB_OUT = 2048, CD_IN = 4608, CD_OUT = 2304;
constexpr int NE = 128, NE1 = 129, TOPK = 8, ED = 256;
constexpr int TK = T * TOPK;
constexpr int NSLOT = TK + T;
constexpr int LISTCAP = 16384;
constexpr float ALPHA = 1.681792830507429f;
constexpr float LN_EPS = 1e-5f;

#ifndef N_LAUNCH_MODE
#define N_LAUNCH_MODE 1
#endif

constexpr size_t al256(size_t x) { return (x + 255) & ~(size_t)255; }
constexpr size_t WS_CTL    = 0;
constexpr size_t CTL_BYTES = 131072;
constexpr size_t CTL_CNT   = 65536;
constexpr size_t WS_WABIN  = CTL_BYTES;
constexpr size_t WS_WABOUT = WS_WABIN  + al256((size_t)2 * AB_IN * D * 2);
constexpr size_t WS_WCDIN  = WS_WABOUT + al256((size_t)2 * D * AB_OUT * 2);
constexpr size_t WS_WCDOUT = WS_WCDIN  + al256((size_t)2 * CD_IN * D * 2);
constexpr size_t WS_WRT    = WS_WCDOUT + al256((size_t)2 * D * CD_OUT * 2);
constexpr size_t WS_WGU    = WS_WRT    + al256((size_t)4 * 256 * D * 2);
constexpr size_t WS_WDN    = WS_WGU    + al256((size_t)4 * NE1 * 512 * D * 2);
constexpr size_t WS_X      = WS_WDN    + al256((size_t)4 * NE1 * D * ED * 2);
constexpr size_t WS_HB     = WS_X;
constexpr size_t WS_XB     = WS_X      + al256((size_t)T * D * 4);
constexpr size_t WS_U1     = WS_XB     + al256((size_t)T * D * 2);
constexpr size_t U1_BYTES  = al256((size_t)NSLOT * D * 2) > al256((size_t)T * CD_IN * 4) ? al256((size_t)NSLOT * D * 2) : al256((size_t)T * CD_IN * 4);
constexpr size_t WS_U2     = WS_U1     + U1_BYTES;
constexpr size_t U2_BYTES  = al256((size_t)T * 1280 * 4 * 3);
constexpr size_t WS_YCAT   = WS_U2     + U2_BYTES;
constexpr size_t WS_H      = WS_YCAT   + al256((size_t)T * CD_OUT * 2);
constexpr size_t WS_ZR     = WS_H      + al256((size_t)T * D * 4);
constexpr size_t WS_HID    = WS_ZR     + al256((size_t)T * 256 * 4);
constexpr size_t WS_LIST   = WS_HID    + al256((size_t)NSLOT * ED * 2);
constexpr size_t WS_GATE   = WS_LIST   + al256((size_t)NE * LISTCAP * 4);
constexpr size_t WS_ROPEA  = WS_GATE   + al256((size_t)NSLOT * 4);
constexpr size_t WS_ROPER  = WS_ROPEA  + al256((size_t)SEQ * 32 * 8);
constexpr size_t WS_BIASP  = WS_ROPER  + al256((size_t)SEQ * 64 * 8);
constexpr size_t WS_WLRU   = WS_BIASP  + al256((size_t)2 * AB_IN * 4);
constexpr size_t WS_SPL    = WS_WLRU   + al256((size_t)2 * 5 * 2 * 65536 * 2);
constexpr size_t WS_END    = WS_SPL    + al256((size_t)2 * 1280 * 4);
constexpr size_t CD_GU = WS_U1, CD_GVT = WS_U1 + 32 * (1024 * 1024), CD_GG = WS_U1 + 64 * (1024 * 1024), CD_XR = WS_U1 + 104 * (1024 * 1024), CD_STATS = WS_U1 + 144 * (1024 * 1024);
constexpr size_t MB = 1024 * 1024;
constexpr size_t AB_QB = WS_U1, AB_KB = WS_U1 + 32 * MB, AB_VT = WS_U1 + 36 * MB, AB_RQB = WS_U1 + 40 * MB, AB_RKB = WS_U1 + 56 * MB, AB_RKDT = WS_U1 + 72 * MB,
                 AB_RVT = WS_U1 + 88 * MB, AB_RGB = WS_U1 + 120 * MB, AB_KV = WS_U1 + 152 * MB  , AB_SPREV = WS_U1 + 216 * MB  ;
static_assert(AB_SPREV + 32 * MB <= WS_U1 + U1_BYTES, "U1 map");

__device__ __forceinline__ float bf2f(bf16_t b) { return __uint_as_float(((unsigned)b) << 16); }
__device__ __forceinline__ unsigned pk2(float lo, float hi) { unsigned r; asm("v_cvt_pk_bf16_f32 %0, %1, %2" : "=v"(r) : "v"(lo), "v"(hi)); return r; }
__device__ __forceinline__ bf16_t f2bf(float f) { return (bf16_t)(pk2(f, f) & 0xffffu); }
__device__ __forceinline__ float wave_sum(float v) {
#pragma unroll
    for (int o = 32; o; o >>= 1) v += __shfl_xor(v, o);
    return v; }
__device__ __forceinline__ float wave_max(float v) {
#pragma unroll
    for (int o = 32; o; o >>= 1) v = fmaxf(v, __shfl_xor(v, o));
    return v; }
__device__ __forceinline__ float gelu_tanh(float x) { const float u = 0.7978845608028654f * (x + 0.044715f * x * x * x); return 0.5f * x * (1.f + tanhf(u)); }
__device__ __forceinline__ float sigmoidf_(float x) { return __builtin_amdgcn_rcpf(1.f + __expf(-x)); }
__device__ __forceinline__ float siluf_(float x) { return x * __builtin_amdgcn_rcpf(1.f + __expf(-x)); }
__device__ __forceinline__ f32x4 silu4(const f32x4 x) { const f32x4 t = x * (-1.4426950408889634f); f32x4 d;
#pragma unroll
    for (int e = 0; e < 4; ++e) d[e] = __builtin_amdgcn_exp2f(t[e]);
    d = d + 1.f;
#pragma unroll
    for (int e = 0; e < 4; ++e) d[e] = __builtin_amdgcn_rcpf(d[e]);
    return x * d; }
__device__ __forceinline__ f32x4 gelu4(const f32x4 x) {
    const f32x4 t = x * ((x * x) * (-0.10294323886f) + (-2.30220819813f)); f32x4 d;
#pragma unroll
    for (int e = 0; e < 4; ++e) d[e] = __builtin_amdgcn_exp2f(t[e]);
    d = d + 1.f;
#pragma unroll
    for (int e = 0; e < 4; ++e) d[e] = __builtin_amdgcn_rcpf(d[e]);
    return x * d; }

#define XB_TMO      128
#define XB_XCNT(j)  (256  + 64 * (j))
#define XB_XSUB(j)  (1280 + 64 * (j))
#define XB_XGEN(j)  (2304 + 64 * (j))
#define XB_TOP      3328
#define XB_TOPGEN   3392
#define XCD_BAR_WORDS 3456
#define XB_SPIN_CAP (1u << 22)

__device__ __forceinline__ unsigned xb_ld(unsigned* p)              { return __hip_atomic_load(p, __ATOMIC_RELAXED, __HIP_MEMORY_SCOPE_AGENT); }
__device__ __forceinline__ unsigned xb_add(unsigned* p, unsigned v) { return __hip_atomic_fetch_add(p, v, __ATOMIC_RELAXED, __HIP_MEMORY_SCOPE_AGENT); }
__device__ __forceinline__ unsigned xb_xcc_id() { return (unsigned)__builtin_amdgcn_s_getreg((3 << 11) | 20) & 0xFu; }
#define XB_SPIN(cond, bar) do { unsigned _sp = 0; while (cond) { __builtin_amdgcn_s_sleep(1); \
    if ((++_sp & 255u) == 0u) { if (xb_ld(&(bar)[XB_TMO])) break; if (_sp > XB_SPIN_CAP) { atomicAdd(&(bar)[XB_TMO], 1u); break; } } } } while (0)

struct XcdBarrier { unsigned* bar; unsigned x; volatile LAS unsigned* st; };

__device__ __forceinline__ XcdBarrier xcd_barrier_post(unsigned* bar, volatile LAS unsigned* st) {
    XcdBarrier b; b.bar = bar; b.x = xb_xcc_id(); b.st = st;
    if (threadIdx.x == 0) (void)xb_add(&bar[XB_XCNT(b.x)], 1u);
    return b;
}
__device__ __forceinline__ void xcd_barrier_complete(unsigned* bar, unsigned x, unsigned& nloc, unsigned& nx) {
    const unsigned G = gridDim.x * gridDim.y * gridDim.z;
    unsigned sum, cnt, mine, sp = 0u;
    for (;;) {
        sum = 0u; cnt = 0u; mine = 0u;
#pragma unroll
        for (unsigned j = 0; j < 16; ++j) { const unsigned c = xb_ld(&bar[XB_XCNT(j)]); sum += c; cnt += (c > 0u) ? 1u : 0u; mine = (j == x) ? c : mine; }
        if (sum == G) break;
        __builtin_amdgcn_s_sleep(1);
        if ((++sp & 255u) == 0u) { if (xb_ld(&bar[XB_TMO])) break; if (sp > XB_SPIN_CAP) { atomicAdd(&bar[XB_TMO], 1u); break; } }
    }
    nloc = mine > 0u ? mine : 1u; nx = cnt > 0u ? cnt : 1u;
}
__device__ __forceinline__ void xcd_barrier(const XcdBarrier& b, const bool leader  ) {
    asm volatile("s_waitcnt vmcnt(0)" ::: "memory");
    __syncthreads();
    if (leader) {
        unsigned* bar = b.bar;
        __builtin_amdgcn_s_waitcnt(0);
        unsigned nloc = b.st[0], nx = b.st[1];
        if (nloc == 0u) { xcd_barrier_complete(bar, b.x, nloc, nx); b.st[0] = nloc; b.st[1] = nx; }
        const unsigned old = xb_add(&bar[XB_XSUB(b.x)], 1u);
        const unsigned gen = old / nloc;
        if (old + 1u == (gen + 1u) * nloc) {
            __builtin_amdgcn_fence(__ATOMIC_RELEASE, "agent");
            asm volatile("s_waitcnt vmcnt(0)" ::: "memory");
            const unsigned og = xb_add(&bar[XB_TOP], 1u);
            const unsigned tg = og / nx;
            if (og + 1u == (tg + 1u) * nx) xb_add(&bar[XB_TOPGEN], 1u);
            else XB_SPIN(xb_ld(&bar[XB_TOPGEN]) == tg, bar);
            __builtin_amdgcn_fence(__ATOMIC_ACQUIRE, "agent");
            xb_add(&bar[XB_XGEN(b.x)], 1u);
            asm volatile("s_waitcnt vmcnt(0)" ::: "memory");
        } else {
            XB_SPIN(xb_ld(&bar[XB_XGEN(b.x)]) == gen, bar);
            __builtin_amdgcn_fence(__ATOMIC_ACQUIRE, "agent");
            asm volatile("s_waitcnt vmcnt(0)" ::: "memory");
        }
    }
    __syncthreads();
}

namespace g8 {
constexpr int BM = 256, BK = 64, HALF = 128, HTB = HALF * BK * 2, STAGE_BYTES = 8 * HTB, NXCD = 8, WGM = 8;
__device__ __forceinline__ int lds_byte(int r, int c) { const int st = (r >> 4) * 2 + (c >> 5), rr = r & 15, cc = c & 31, ob = rr * 64 + cc * 2; return st * 1024 + (ob ^ (((ob >> 9) & 1) << 5)); }
__device__ __forceinline__ void stage_rc(int b, int& R, int& C) { const int st = b / 1024, sb = b % 1024, swz = sb ^ (((sb >> 9) & 1) << 5); R = (st >> 1) * 16 + swz / 64; C = (st & 1) * 32 + (swz % 64) / 2; }
__device__ __forceinline__ int perm32(int rho) { const int n = rho >> 4, i = rho & 15; return 8 * (i >> 2) + 4 * n + (i & 3); }

struct Unit { const char* A; const char* B; int pm, pn, aux; };

struct DenseOrder {
    const char* A; const char* Bt; int nM, nN, nwg, G, c, K, tid0;
    __device__ void init(const void* A_, const void* Bt_, int M, int N, int K_, int G_, int c_) { A = (const char*)A_; Bt = (const char*)Bt_; nM = M / BM; nN = N / BM; nwg = nM * nN; G = G_; c = c_; K = K_; }
    __device__ __forceinline__ bool next(int i, Unit& u) const {
        const long L = (long)i * G + c; if (L >= nwg) return false;
        int wgid = (int)L; { const int q = nwg / NXCD, r = nwg % NXCD, xcd = wgid % NXCD, off = wgid / NXCD; wgid = (xcd < r ? xcd * (q + 1) : r * (q + 1) + (xcd - r) * q) + off; }
        const int nig = WGM * nN, gid = wgid / nig, fm = gid * WGM, gsz = (nM - fm) < WGM ? (nM - fm) : WGM;
        u.pm = fm + ((wgid % nig) % gsz); u.pn = (wgid % nig) / gsz; u.aux = 0;
        u.A = A + (size_t)u.pm * BM * K * 2; u.B = Bt + (size_t)u.pn * BM * K * 2; return true;
    }
    __device__ __forceinline__ void aoff(const Unit&, int tid, unsigned (&o)[2][2]) const {
#pragma unroll
        for (int i = 0; i < 2; ++i) { int R, C; stage_rc(tid * 16 + i * 8192, R, C);
            o[0][i] = (unsigned)(R * K + C) * 2u; o[1][i] = (unsigned)((R + HALF) * K + C) * 2u; }
    }
};

__device__ __forceinline__ unsigned cvt_pk_bf16(float lo, float hi) { unsigned r; asm volatile("v_cvt_pk_bf16_f32 %0, %1, %2" : "=v"(r) : "v"(lo), "v"(hi)); return r; }

struct EpiF32 {
    static constexpr bool PERM = false;
    float* C; int ldc; const float* bias;
    __device__ __forceinline__ void init(f32x4 (&acc)[2][2][4][2], const Unit&, int, int) const {
#pragma unroll
        for (int a = 0; a < 2; ++a)
#pragma unroll
            for (int b = 0; b < 2; ++b)
#pragma unroll
                for (int m = 0; m < 4; ++m)
#pragma unroll
                    for (int n = 0; n < 2; ++n) acc[a][b][m][n] = (f32x4){0.f, 0.f, 0.f, 0.f}; }
    __device__ __forceinline__ void operator()(const f32x4 (&acc)[2][2][4][2], const Unit& u, int wr, int wc, int fr, int fq) const {
        const int row0 = u.pm * BM + wr * 64 + fr, col0 = u.pn * BM + wc * 32 + 4 * fq;
        f32x4 bv[2][2];
#pragma unroll
        for (int bj = 0; bj < 2; ++bj)
#pragma unroll
            for (int n = 0; n < 2; ++n) bv[bj][n] = bias ? *(const f32x4*)(bias + col0 + bj * HALF + n * 16) : (f32x4){0.f, 0.f, 0.f, 0.f};
#pragma unroll
        for (int ai = 0; ai < 2; ++ai)
#pragma unroll
            for (int m = 0; m < 4; ++m) { float* rowp = C + (size_t)(row0 + ai * HALF + m * 16) * ldc + col0;
#pragma unroll
                for (int bj = 0; bj < 2; ++bj)
#pragma unroll
                    for (int n = 0; n < 2; ++n) *(f32x4*)(rowp + bj * HALF + n * 16) = acc[ai][bj][m][n] + bv[bj][n]; }
    }
};

struct EpiBf16 {
    static constexpr bool PERM = true;
    bf16_t* O; int ldc; const float* bias;
    __device__ __forceinline__ void init(f32x4 (&acc)[2][2][4][2], const Unit&, int, int) const {
#pragma unroll
        for (int a = 0; a < 2; ++a)
#pragma unroll
            for (int b = 0; b < 2; ++b)
#pragma unroll
                for (int m = 0; m < 4; ++m)
#pragma unroll
                    for (int n = 0; n < 2; ++n) acc[a][b][m][n] = (f32x4){0.f, 0.f, 0.f, 0.f}; }
    __device__ __forceinline__ void operator()(const f32x4 (&acc)[2][2][4][2], const Unit& u, int wr, int wc, int fr, int fq) const {
        const int row0 = u.pm * BM + wr * 64 + fr, col0 = u.pn * BM + wc * 32 + 8 * fq;
        f32x4 bv[2][2];
#pragma unroll
        for (int bj = 0; bj < 2; ++bj)
#pragma unroll
            for (int n = 0; n < 2; ++n) bv[bj][n] = *(const f32x4*)(bias + col0 + bj * HALF + 4 * n);
#pragma unroll
        for (int ai = 0; ai < 2; ++ai)
#pragma unroll
            for (int m = 0; m < 4; ++m) { bf16_t* rowp = O + (size_t)(row0 + ai * HALF + m * 16) * ldc + col0;
#pragma unroll
                for (int bj = 0; bj < 2; ++bj) { const f32x4 v0 = acc[ai][bj][m][0] + bv[bj][0], v1 = acc[ai][bj][m][1] + bv[bj][1];
                    u32x4 w; w[0] = cvt_pk_bf16(v0[0], v0[1]); w[1] = cvt_pk_bf16(v0[2], v0[3]); w[2] = cvt_pk_bf16(v1[0], v1[1]); w[3] = cvt_pk_bf16(v1[2], v1[3]);
                    *(u32x4*)(rowp + bj * HALF) = w; } }
    }
};

template <class Epi, class Sched>
__device__ __forceinline__ void gemm_phase(LAS unsigned char* lds, const int K, const Sched& S, const Epi& E) {
    int tid_ = S.tid0; asm volatile("" : "+v"(tid_));
    const int tid = tid_, wid = __builtin_amdgcn_readfirstlane(tid >> 6), lane = tid & 63, wr = wid >> 2, wc = wid & 3, fr = lane & 15, fq = lane >> 4;
    const int nt = K / BK;
    unsigned voffB[2];
#pragma unroll
    for (int i = 0; i < 2; ++i) { int R, C; stage_rc(tid * 16 + i * 8192, R, C); const int Rb = Epi::PERM ? ((R & ~31) + perm32(R & 31)) : R;
        voffB[i] = (unsigned)(Rb * K + C) * 2u; }
    const size_t kstep = (size_t)(BK * 2);
    const size_t hstep = (size_t)HALF * K * 2;
    const unsigned ldsw = (unsigned)wid * 1024u;
    const int aoff = lds_byte(wr * 64 + fr, fq * 8), boff = lds_byte(wc * 32 + fr, fq * 8);
#define G8_SA(b, h) (((b) * 2 + (h)) * HTB)
#define G8_SB(b, h) ((4 + (b) * 2 + (h)) * HTB)
#define G8_STAGE(bufoff, gbase, voff) do { _Pragma("unroll") for (int _i = 0; _i < 2; ++_i) \
        __builtin_amdgcn_global_load_lds((const unsigned*)((const char*)(gbase) + (voff)[_i]), (LAS unsigned*)(lds + (bufoff) + ldsw + _i * 8192), 16, 0, 0); } while (0)
#define G8_LDA(dst, b, h) do { _Pragma("unroll") for (int m = 0; m < 4; ++m) _Pragma("unroll") for (int k = 0; k < 2; ++k) dst[m][k] = *(const LAS bf16x8*)(lds + G8_SA(b, h) + aoff + m * 2048 + k * 1024); } while (0)
#define G8_LDB(dst, b, h) do { _Pragma("unroll") for (int n = 0; n < 2; ++n) _Pragma("unroll") for (int k = 0; k < 2; ++k) dst[n][k] = *(const LAS bf16x8*)(lds + G8_SB(b, h) + boff + n * 2048 + k * 1024); } while (0)
#define G8_MMA(ai, bj, At, Bt) do { __builtin_amdgcn_s_setprio(1); _Pragma("unroll") for (int m = 0; m < 4; ++m) _Pragma("unroll") for (int n = 0; n < 2; ++n) _Pragma("unroll") for (int k = 0; k < 2; ++k) \
        acc[ai][bj][m][n] = __builtin_amdgcn_mfma_f32_16x16x32_bf16(Bt[n][k], At[m][k], acc[ai][bj][m][n], 0, 0, 0); __builtin_amdgcn_s_setprio(0); } while (0)
#define G8_WAIT_V(n) asm volatile("s_waitcnt vmcnt(" #n ")" ::: "memory")
#define G8_WAIT_L(n) asm volatile("s_waitcnt lgkmcnt(" #n ")" ::: "memory")
#define G8_BAR __builtin_amdgcn_s_barrier()
#define G8_SCHED __builtin_amdgcn_sched_barrier(0)
    Unit cur, nxt; int ui = 0;
    if (!S.next(0, cur)) return;
    f32x4 acc[2][2][4][2];
    E.init(acc, cur, wc, fq);
    bf16x8 At[4][2], B0[2][2], B1[2][2];
    unsigned oc[2][2];
    S.aoff(cur, tid, oc);
    const char* cA = cur.A; const char* cB = cur.B;
    G8_STAGE(G8_SB(0, 0), cB, voffB); G8_STAGE(G8_SA(0, 0), cA, oc[0]); G8_STAGE(G8_SB(0, 1), cB + hstep, voffB); G8_STAGE(G8_SA(0, 1), cA, oc[1]);
    if (wr == 1) G8_BAR;
    G8_WAIT_V(4); G8_BAR;
    G8_STAGE(G8_SB(1, 0), cB + kstep, voffB); G8_STAGE(G8_SA(1, 0), cA + kstep, oc[0]); G8_STAGE(G8_SB(1, 1), cB + hstep + kstep, voffB);
    G8_WAIT_V(6); G8_BAR;
    for (;;) {
        const bool has_next = S.next(ui + 1, nxt);
        const char* nA = has_next ? nxt.A : cA; const char* nB = has_next ? nxt.B : cB;
#pragma unroll 1
        for (int t = 0; t < nt; t += 2) {
            const bool last = (t == nt - 2);
            const char* a1 = cA + (size_t)(t + 1) * kstep;
            const char* a2 = last ? nA : cA + (size_t)(t + 2) * kstep; const char* b2 = last ? nB : cB + (size_t)(t + 2) * kstep;
            const char* a3 = a2 + kstep; const char* b3 = b2 + kstep;
            G8_LDB(B0, 0, 0); G8_SCHED; G8_LDA(At, 0, 0); G8_STAGE(G8_SA(1, 1), a1, oc[1]);
            if (last && has_next) S.aoff(nxt, tid, oc);
            G8_WAIT_L(8); G8_BAR; G8_WAIT_L(0); G8_MMA(0, 0, At, B0); G8_BAR; G8_SCHED;
            G8_LDB(B1, 0, 1); G8_STAGE(G8_SB(0, 0), b2, voffB);
            G8_BAR; G8_WAIT_L(0); G8_MMA(0, 1, At, B1); G8_BAR;
            G8_LDA(At, 0, 1); G8_STAGE(G8_SA(0, 0), a2, oc[0]);
            G8_BAR; G8_WAIT_L(0); G8_MMA(1, 0, At, B0); G8_BAR; G8_SCHED;
            G8_STAGE(G8_SB(0, 1), b2 + hstep, voffB);
            G8_WAIT_V(6); G8_BAR; G8_MMA(1, 1, At, B1); G8_BAR;
            G8_LDB(B0, 1, 0); G8_SCHED; G8_LDA(At, 1, 0); G8_STAGE(G8_SA(0, 1), a2, oc[1]);
            G8_WAIT_L(8); G8_BAR; G8_WAIT_L(0); G8_MMA(0, 0, At, B0); G8_BAR; G8_SCHED;
            G8_LDB(B1, 1, 1); G8_STAGE(G8_SB(1, 0), b3, voffB);
            G8_BAR; G8_WAIT_L(0); G8_MMA(0, 1, At, B1); G8_BAR;
            G8_LDA(At, 1, 1); G8_STAGE(G8_SA(1, 0), a3, oc[0]);
            G8_BAR; G8_WAIT_L(0); G8_MMA(1, 0, At, B0); G8_BAR; G8_SCHED;
            G8_STAGE(G8_SB(1, 1), b3 + hstep, voffB);
            G8_WAIT_V(6); G8_BAR; G8_MMA(1, 1, At, B1); G8_BAR;
        }
        E(acc, cur, wr, wc, fr, fq);
        if (!has_next) break;
        cur = nxt; cA = nA; cB = nB; ++ui;
        E.init(acc, cur, wc, fq);
    }
    G8_WAIT_V(0);
    if (wr == 0) G8_BAR;
    G8_BAR;
#undef G8_SA
#undef G8_SB
#undef G8_STAGE
#undef G8_LDA
#undef G8_LDB
#undef G8_MMA
#undef G8_WAIT_V
#undef G8_WAIT_L
#undef G8_BAR
#undef G8_SCHED
}
}

constexpr int NTHREADS = 512;
constexpr int LDS_STAGE = 0;
constexpr int LDS_TAB   = g8::STAGE_BYTES;
constexpr int TAB_SLOTS = 6;
constexpr int LDS_GTAB  = LDS_TAB + TAB_SLOTS * 256 * 4;
constexpr int LDS_DESC  = LDS_GTAB + TAB_SLOTS * 256 * 4;
constexpr int LDS_PREF  = LDS_DESC + 64;
constexpr int LDS_MISC  = 147456 - 64;
constexpr int LDS_BYTES = 147456;
static_assert(LDS_MISC % 16 == 0 && LDS_MISC + 64 <= LDS_BYTES && LDS_PREF + 132 * 4 <= LDS_MISC, "LDS map");

#define GAS __attribute__((address_space(1)))
struct Params { const GAS float* in[31]; GAS float* out; GAS unsigned char* ws; int ph_lo, ph_hi; };

struct Ctx {
    const GAS float* const* in; float* out; unsigned char* ws; LAS unsigned char* lds;
    __device__ __forceinline__ const float* inp(int k) const { return (const float*)in[k]; }
    int tid, lane, wid, bid, G, gtid, gthreads, gw, nwaves;
};

__device__ __forceinline__ int ab_phys(int n) {
    if (n < 1024) { const int hd = n >> 6, jj = n & 63; return (hd >> 2) * 256 + (jj >> 5) * 128 + (hd & 3) * 32 + (jj & 31); }
    if (n < 1152) { const int nn = n - 1024, hh = nn >> 6, jj = nn & 63; return 1024 + (jj >> 5) * 128 + hh * 32 + (jj & 31); }
    if (n < 1280) { const int vv = n - 1152; return 1024 + (vv >> 6) * 128 + 64 + (vv & 63); }
    if (n < 2304) { const int base = n < 1792 ? 1280 : 1792, nn = n - base, h = nn >> 7, jj = nn & 127; return base + (h >> 1) * 256 + (jj >> 6) * 128 + (h & 1) * 64 + (jj & 63); }
    return n;
}
template <int TN, class DstFn>
__device__ __forceinline__ void convert_T(const Ctx& c, const float* src, int nmat, int K, int N, DstFn dstfn) {
    LAS float* tile = (LAS float*)(c.lds);
    constexpr int LDT = TN + 1, TPR = TN / 4  , KPI = NTHREADS / TPR  , NI = 64 / KPI, KPT = 64 * TN / NTHREADS  ;
    const int tk = K / 64, tn = N / TN; const long ntiles = (long)nmat * tk * tn;
    f32x4 v[NI];
    auto issue = [&](long tix) { const int m = (int)(tix / (tk * tn)); const int rem = (int)(tix % (tk * tn)); const int kt = rem / tn, nt = rem % tn;
        const float* s = src + (size_t)m * K * N + (size_t)(kt * 64) * N + nt * TN;
#pragma unroll
        for (int i = 0; i < NI; ++i) { const int k = c.tid / TPR + KPI * i, n4 = (c.tid % TPR) * 4; v[i] = __builtin_nontemporal_load((const f32x4*)(s + (size_t)k * N + n4)); } };
    if (c.bid < ntiles) issue(c.bid);
    for (long tix = c.bid; tix < ntiles; tix += c.G) {
        const int m = (int)(tix / (tk * tn)); const int rem = (int)(tix % (tk * tn)); const int kt = rem / tn, nt = rem % tn;
#pragma unroll
        for (int i = 0; i < NI; ++i) { const int k = c.tid / TPR + KPI * i, n4 = (c.tid % TPR) * 4;
            tile[k * LDT + n4 + 0] = v[i][0]; tile[k * LDT + n4 + 1] = v[i][1]; tile[k * LDT + n4 + 2] = v[i][2]; tile[k * LDT + n4 + 3] = v[i][3]; }
        if (tix + c.G < ntiles) issue(tix + c.G);
        __syncthreads();
        { constexpr int TPN = 64 / KPT; const int n = c.tid / TPN, k0 = (c.tid % TPN) * KPT;
          bf16_t* d = dstfn(m, nt * TN + n) + kt * 64 + k0;
#pragma unroll
          for (int q = 0; q < KPT / 8; ++q) { u32x4 w;
#pragma unroll
              for (int e = 0; e < 4; ++e) w[e] = pk2(tile[(k0 + q * 8 + 2 * e) * LDT + n], tile[(k0 + q * 8 + 2 * e + 1) * LDT + n]);
              *(u32x4*)(d + q * 8) = w; } }
        __syncthreads();
    }
}

__device__ __forceinline__ void phase_convert(const Ctx& c) {
    unsigned char* ws = c.ws;
    { const float* x = c.inp(0); bf16_t* xb = (bf16_t*)(ws + WS_XB);
      for (long i = c.gtid; i < (long)T * D / 4; i += c.gthreads) { const f32x4 v = *(const f32x4*)(x + i * 4); u32x2 w; w[0] = pk2(v[0], v[1]); w[1] = pk2(v[2], v[3]); *(u32x2*)(xb + i * 4) = w; } }
    { bf16_t* wrt = (bf16_t*)(ws + WS_WRT); for (long i = c.gtid; i < (long)4 * 128 * D / 8; i += c.gthreads) { const long l = i / (128 * D / 8), r = i % (128 * D / 8); *(u32x4*)(wrt + (size_t)l * 256 * D + (size_t)128 * D + r * 8) = (u32x4){0u, 0u, 0u, 0u}; }
      float* gate = (float*)(ws + WS_GATE); for (int i = c.gtid; i < T; i += c.gthreads) gate[TK + i] = 1.f;
      f32x2* ra = (f32x2*)(ws + WS_ROPEA); f32x2* rr = (f32x2*)(ws + WS_ROPER);
      for (int i = c.gtid; i < SEQ * 96; i += c.gthreads) { const int sidx = i / 96, q = i % 96; const bool isA = q < 32; const int jx = isA ? q : q - 32;
          const float e = isA ? (float)jx * (1.f / 32.f) : (float)jx * (1.f / 63.f); const float ang = (float)sidx * exp2f(-e * 13.287712379549449f); float sn, cs; sincosf(ang, &sn, &cs);
          if (isA) ra[sidx * 32 + jx] = (f32x2){cs, sn}; else rr[sidx * 64 + jx] = (f32x2){cs, sn}; }
      float* bp = (float*)(ws + WS_BIASP); for (int i = c.gtid; i < 2 * AB_IN; i += c.gthreads) { const int m = i / AB_IN, n = i % AB_IN; bp[m * AB_IN + ab_phys(n)] = c.inp(2)[i]; } }
    { bf16_t* d = (bf16_t*)(ws + WS_WABIN);  convert_T<256>(c, c.inp(1), 2, D, AB_IN, [=](int m, int n) { return d + (size_t)m * AB_IN * D + (size_t)ab_phys(n) * D; }); }
    { bf16_t* d = (bf16_t*)(ws + WS_WABOUT); convert_T<256>(c, c.inp(4), 2, AB_OUT, D, [=](int m, int n) { return d + (size_t)m * D * AB_OUT + (size_t)n * AB_OUT; }); }
    { bf16_t* d = (bf16_t*)(ws + WS_WCDIN);  convert_T<256>(c, c.inp(6), 2, D, CD_IN, [=](int m, int n) { return d + (size_t)m * CD_IN * D + (size_t)n * D; }); }
    { bf16_t* d = (bf16_t*)(ws + WS_WCDOUT); convert_T<256>(c, c.inp(17), 2, CD_OUT, D, [=](int m, int n) { return d + (size_t)m * D * CD_OUT + (size_t)n * CD_OUT; }); }
    { bf16_t* d = (bf16_t*)(ws + WS_WRT);    convert_T<128>(c, c.inp(21), 4, D, NE, [=](int m, int n) { return d + (size_t)m * 256 * D + (size_t)n * D; }); }
    { bf16_t* d = (bf16_t*)(ws + WS_WGU);
      convert_T<256>(c, c.inp(23), 4 * NE, D, ED, [=](int m, int n) { return d + (size_t)((m >> 7) * NE1 + (m & 127)) * 512 * D + (size_t)((n >> 7) * 256 + (n & 127)) * D; });
      convert_T<256>(c, c.inp(24), 4 * NE, D, ED, [=](int m, int n) { return d + (size_t)((m >> 7) * NE1 + (m & 127)) * 512 * D + (size_t)((n >> 7) * 256 + 128 + (n & 127)) * D; });
      convert_T<256>(c, c.inp(26), 4, D, ED, [=](int m, int n) { return d + (size_t)(m * NE1 + NE) * 512 * D + (size_t)((n >> 7) * 256 + (n & 127)) * D; });
      convert_T<256>(c, c.inp(27), 4, D, ED, [=](int m, int n) { return d + (size_t)(m * NE1 + NE) * 512 * D + (size_t)((n >> 7) * 256 + 128 + (n & 127)) * D; }); }
    { bf16_t* d = (bf16_t*)(ws + WS_WLRU);
      convert_T<256>(c, c.inp(12), 10, 256, 256, [=](int m, int n) { return d + (size_t)(m * 2 + 0) * 65536 + (size_t)n * 256; });
      convert_T<256>(c, c.inp(14), 10, 256, 256, [=](int m, int n) { return d + (size_t)(m * 2 + 1) * 65536 + (size_t)n * 256; });
      float* spl = (float*)(ws + WS_SPL); for (int i = c.gtid; i < 2 * 1280; i += c.gthreads) spl[i] = log1pf(expf(-c.inp(16)[i])); }
    { bf16_t* d = (bf16_t*)(ws + WS_WDN);
      convert_T<256>(c, c.inp(25), 4 * NE, ED, D, [=](int m, int n) { return d + (size_t)((m >> 7) * NE1 + (m & 127)) * D * ED + (size_t)n * ED; });
      convert_T<256>(c, c.inp(28), 4, ED, D, [=](int m, int n) { return d + (size_t)(m * NE1 + NE) * D * ED + (size_t)n * ED; }); }
}

__device__ __forceinline__ void phase_dense(const Ctx& c, const bf16_t* A, const bf16_t* Bt, int M, int N, int K, bf16_t* C, int ldc, const float* bias) {
    g8::DenseOrder S; S.init(A, Bt, M, N, K, c.G, c.bid); S.tid0 = c.tid;
    g8::EpiBf16 E{C, ldc, bias};
    g8::gemm_phase<g8::EpiBf16, g8::DenseOrder>(c.lds + LDS_STAGE, K, S, E);
}

__device__ __forceinline__ void st_bf16_off(unsigned char* base, unsigned byte_off, float v) { *(bf16_t*)(base + byte_off) = f2bf(v); }
struct EpiABIn {
    static constexpr bool PERM = true;
    LAS bf16_t* biasL; unsigned char* ws;
    __device__ __forceinline__ void init(f32x4 (&acc)[2][2][4][2], const g8::Unit& u, int wc, int fq) const {
        const int colp = u.pn * 256 + wc * 32 + fq * 8;
#pragma unroll
        for (int b = 0; b < 2; ++b)
#pragma unroll
            for (int n = 0; n < 2; ++n) { const u32x2 bw = *(const LAS u32x2*)(biasL + colp + b * 128 + 4 * n);
                const f32x4 bv = (f32x4){__uint_as_float(bw[0] << 16), __uint_as_float(bw[0] & 0xffff0000u), __uint_as_float(bw[1] << 16), __uint_as_float(bw[1] & 0xffff0000u)};
#pragma unroll
                for (int a = 0; a < 2; ++a)
#pragma unroll
                    for (int m = 0; m < 4; ++m) acc[a][b][m][n] = bv; } }
    __device__ __forceinline__ void operator()(const f32x4 (&acc)[2][2][4][2], const g8::Unit& u, int wr, int wc, int fr_, int fq_) const {
        int fr = fr_, fq = fq_; asm volatile("" : "+v"(fr), "+v"(fq));
        const int pn = u.pn; const int colp = pn * 256 + wc * 32 + fq * 8;
        bf16_t* qb = (bf16_t*)(ws + AB_QB); bf16_t* kb = (bf16_t*)(ws + AB_KB); bf16_t* vT = (bf16_t*)(ws + AB_VT); bf16_t* rqb = (bf16_t*)(ws + AB_RQB); bf16_t* rkb = (bf16_t*)(ws + AB_RKB);
        bf16_t* rkdT = (bf16_t*)(ws + AB_RKDT); bf16_t* rvT = (bf16_t*)(ws + AB_RVT); bf16_t* rgb = (bf16_t*)(ws + AB_RGB);
        const float frqA0 = exp2f(-(float)(fq * 8) * (13.287712379549449f / 32.f)) * 0.15915494309189535f;
        const float frqR0 = exp2f(-(float)((wc & 1) * 32 + fq * 8) * (13.287712379549449f / 63.f)) * 0.15915494309189535f;
        constexpr float RA[8] = {1.f, 0.7498942093324559f, 0.5623413251903491f, 0.4216965034285822f, 0.31622776601683794f, 0.23713737056616552f, 0.1778279410038923f, 0.1333521432163324f};
        constexpr float RR[8] = {1.f, 0.8639884494839686f, 0.746476040841712f, 0.6449466771037624f, 0.5572264795507174f, 0.4814372420784346f, 0.4159562163071847f, 0.35938136638046275f};
#pragma unroll
        for (int ai = 0; ai < 2; ++ai)
#pragma unroll
            for (int m = 0; m < 4; ++m) {
                const int t = u.pm * 256 + ai * 128 + wr * 64 + m * 16 + fr, sq = t & (SEQ - 1), b = t >> 13;
                f32x4 x[2][2];
#pragma unroll
                for (int bj = 0; bj < 2; ++bj)
#pragma unroll
                    for (int n = 0; n < 2; ++n) x[bj][n] = acc[ai][bj][m][n];
                if (pn < 4 || (pn == 4 && wc < 2)) {
                    const int j0 = fq * 8; const float sc = pn < 4 ? 0.125f : 1.f;
                    u32x4 w1, w2;
#pragma unroll
                    for (int n = 0; n < 2; ++n) { f32x4 o1, o2;
#pragma unroll
                        for (int e = 0; e < 4; ++e) { const float rev = __builtin_amdgcn_fractf((float)sq * (frqA0 * RA[4 * n + e])); const float cc = __builtin_amdgcn_cosf(rev) * sc, ss = __builtin_amdgcn_sinf(rev) * sc;
                            o1[e] = x[0][n][e] * cc - x[1][n][e] * ss; o2[e] = x[1][n][e] * cc + x[0][n][e] * ss; }
                        w1[2 * n] = pk2(o1[0], o1[1]); w1[2 * n + 1] = pk2(o1[2], o1[3]); w2[2 * n] = pk2(o2[0], o2[1]); w2[2 * n + 1] = pk2(o2[2], o2[3]); }
                    bf16_t* dst = pn < 4 ? qb + (size_t)t * 1024 + (pn * 4 + wc) * 64 + j0 : kb + (size_t)t * 128 + wc * 64 + j0;
                    *(u32x4*)dst = w1; *(u32x4*)(dst + 32) = w2;
                } else if (pn == 4) {
                    const int d0 = (wc - 2) * 32 + fq * 8;
#pragma unroll
                    for (int bj = 0; bj < 2; ++bj)
#pragma unroll
                        for (int n = 0; n < 2; ++n)
#pragma unroll
                            for (int e = 0; e < 4; ++e) st_bf16_off((unsigned char*)vT, (unsigned)((((b * 2 + bj) * 64 + d0 + 4 * n + e) * SEQ + sq) * 2), x[bj][n][e]);
                } else if (pn < 9) {
                    const bool isk = pn >= 7; const int h = ((pn - 5) & 1) * 2 + (wc >> 1), j0 = (wc & 1) * 32 + fq * 8;
                    const float sc = isk ? 0.08838834764831845f : 1.f;
                    const unsigned dToff = (unsigned)((((b * 4 + h) * 128 + j0) * SEQ + sq) * 2);
                    u32x4 w1, w2;
#pragma unroll
                    for (int n = 0; n < 2; ++n) { f32x4 o1, o2;
#pragma unroll
                        for (int e = 0; e < 4; ++e) { const float rev = __builtin_amdgcn_fractf((float)sq * (frqR0 * RR[4 * n + e])); const float cc = __builtin_amdgcn_cosf(rev) * sc, ss = __builtin_amdgcn_sinf(rev) * sc;
                            o1[e] = x[0][n][e] * cc - x[1][n][e] * ss; o2[e] = x[1][n][e] * cc + x[0][n][e] * ss; }
                        w1[2 * n] = pk2(o1[0], o1[1]); w1[2 * n + 1] = pk2(o1[2], o1[3]); w2[2 * n] = pk2(o2[0], o2[1]); w2[2 * n + 1] = pk2(o2[2], o2[3]);
                        if (isk) {
#pragma unroll
                            for (int e = 0; e < 4; ++e) { st_bf16_off((unsigned char*)rkdT, dToff + (unsigned)((4 * n + e) * SEQ * 2), o1[e]); st_bf16_off((unsigned char*)rkdT, dToff + (unsigned)((64 + 4 * n + e) * SEQ * 2), o2[e]); } } }
                    bf16_t* dst = (isk ? rkb : rqb) + (size_t)t * 512 + h * 128 + j0;
                    *(u32x4*)dst = w1; *(u32x4*)(dst + 64) = w2;
                } else if (pn < 13) {
                    const int h = pn - 9;
#pragma unroll
                    for (int bj = 0; bj < 2; ++bj)
#pragma unroll
                        for (int n = 0; n < 2; ++n)
#pragma unroll
                            for (int e = 0; e < 4; ++e) st_bf16_off((unsigned char*)rvT, (unsigned)((((b * 4 + h) * 256 + bj * 128 + wc * 32 + fq * 8 + 4 * n + e) * SEQ + sq) * 2), x[bj][n][e]);
                } else {
#pragma unroll
                    for (int bj = 0; bj < 2; ++bj) { u32x4 w;
#pragma unroll
                        for (int n = 0; n < 2; ++n) { const f32x4 sv = silu4(x[bj][n]); w[2 * n] = pk2(sv[0], sv[1]); w[2 * n + 1] = pk2(sv[2], sv[3]); }
                        *(u32x4*)(rgb + (size_t)t * 1024 + (pn - 13) * 256 + bj * 128 + wc * 32 + fq * 8) = w; }
                }
            }
    }
};
__device__ __forceinline__ void phase_ab_inproj(const Ctx& c, int j) {
    g8::DenseOrder S; S.init(c.ws + WS_XB, c.ws + WS_WABIN + (size_t)j * AB_IN * D * 2, T, AB_IN, D, c.G, c.bid); S.tid0 = c.tid;
    LAS bf16_t* biasL = (LAS bf16_t*)(c.lds + LDS_TAB);
    { const float* bp = (const float*)(c.ws + WS_BIASP) + (size_t)j * AB_IN; for (int i = c.tid; i < AB_IN; i += NTHREADS) biasL[i] = f2bf(bp[i]); }
    __syncthreads();
    EpiABIn E{biasL, c.ws};
    g8::gemm_phase<EpiABIn, g8::DenseOrder>(c.lds + LDS_STAGE, D, S, E);
}

#define MFMA16(a, b, c) __builtin_amdgcn_mfma_f32_16x16x32_bf16((a), (b), (c), 0, 0, 0)
__device__ __forceinline__ bf16x8 pack8(const f32x4& lo, const f32x4& hi) { u32x4 w; w[0] = g8::cvt_pk_bf16(lo[0], lo[1]); w[1] = g8::cvt_pk_bf16(lo[2], lo[3]); w[2] = g8::cvt_pk_bf16(hi[0], hi[1]); w[3] = g8::cvt_pk_bf16(hi[2], hi[3]); return __builtin_bit_cast(bf16x8, w); }
__device__ __forceinline__ bf16x8 cat8(const u32x2& lo, const u32x2& hi) { u32x4 w; w[0] = lo[0]; w[1] = lo[1]; w[2] = hi[0]; w[3] = hi[1]; return __builtin_bit_cast(bf16x8, w); }
template <int ROWS, int RB, int PAD = 32>
__device__ __forceinline__ void tile_g2l(LAS unsigned char* dst, const unsigned char* src, size_t gs, int tid, int zrows = 0) {
    constexpr int CPR = RB / 16, TOTAL = ROWS * CPR;
#pragma unroll 8
    for (int i = tid; i < TOTAL; i += NTHREADS) { const int r = i / CPR, cc = i % CPR; u32x4 v = (u32x4){0u, 0u, 0u, 0u}; if (r >= zrows) v = *(const u32x4*)(src + (size_t)r * gs + cc * 16);
        *(LAS u32x4*)(dst + r * (RB + PAD) + cc * 16) = v; }
}

__device__ __forceinline__ void attn_unit(const Ctx& c, int unit, const float* sinks) {
    const int b = unit >> 7, n = (unit >> 1) & 63, kvh = unit & 1, hd = kvh * 8 + c.wid, lane = c.lane, fr = lane & 15, fq = lane >> 4;
    const bf16_t* qb = (const bf16_t*)(c.ws + AB_QB); const bf16_t* kb = (const bf16_t*)(c.ws + AB_KB); const bf16_t* vT = (const bf16_t*)(c.ws + AB_VT); bf16_t* ycat = (bf16_t*)(c.ws + WS_YCAT);
    LAS unsigned char* Ks = c.lds; LAS unsigned char* Vs = c.lds + 256 * 160;
    const int t0 = b * SEQ + n * 128;
    __syncthreads();
    {
        const unsigned char* src = (const unsigned char*)(kb + (size_t)(t0 - 128) * 128 + kvh * 64);
        constexpr int TOTAL = 256 * 8;
#pragma unroll 4
        for (int i = c.tid; i < TOTAL; i += NTHREADS) { const int r = i >> 3, cc = i & 7; u32x4 v = (u32x4){0u, 0u, 0u, 0u}; if (n > 0 || r >= 128) v = *(const u32x4*)(src + (ptrdiff_t)r * 256 + cc * 16);
            *(LAS u32x4*)(Ks + r * 160 + cc * 16) = v; }
        const unsigned char* vsrc = (const unsigned char*)(vT + (size_t)(b * 2 + kvh) * 64 * SEQ + (n * 128 - 128));
        constexpr int TV = 64 * 32;
#pragma unroll 4
        for (int i = c.tid; i < TV; i += NTHREADS) { const int r = i >> 5, cc = i & 31; u32x4 v = (u32x4){0u, 0u, 0u, 0u}; if (n > 0 || cc >= 16) v = *(const u32x4*)(vsrc + (ptrdiff_t)r * SEQ * 2 + cc * 16);
            *(LAS u32x4*)(Vs + r * 528 + cc * 16) = v; }
    }
    __syncthreads();
    const float sink = sinks[hd];
    bf16x8 qn[2];
#pragma unroll
    for (int ks = 0; ks < 2; ++ks) qn[ks] = *(const bf16x8*)(qb + (size_t)(t0 + fr) * 1024 + hd * 64 + ks * 32 + fq * 8);
    for (int si = 0; si < 8; ++si) {
        const int t = t0 + si * 16 + fr;
        bf16x8 qf[2]; qf[0] = qn[0]; qf[1] = qn[1];
        if (si < 7) {
#pragma unroll
            for (int ks = 0; ks < 2; ++ks) qn[ks] = *(const bf16x8*)(qb + (size_t)(t + 16) * 1024 + hd * 64 + ks * 32 + fq * 8); }
        f32x4 S[10];
#pragma unroll
        for (int nk = 0; nk < 9; nk += 3) { bf16x8 kfr[3][2];
#pragma unroll
            for (int u = 0; u < 3; ++u)
#pragma unroll
                for (int ks = 0; ks < 2; ++ks) kfr[u][ks] = *(const LAS bf16x8*)(Ks + (16 * (si + nk + u) + fr) * 160 + ks * 64 + fq * 16);
            __builtin_amdgcn_sched_barrier(0);
#pragma unroll
            for (int u = 0; u < 3; ++u) { S[nk + u] = (f32x4){0.f, 0.f, 0.f, 0.f};
#pragma unroll
                for (int ks = 0; ks < 2; ++ks) S[nk + u] = MFMA16(kfr[u][ks], qf[ks], S[nk + u]); } }
        S[9] = (f32x4){0.f, 0.f, 0.f, 0.f};
        const int i = si * 16 + fr;
        float mx = sink;
#pragma unroll
        for (int nk = 0; nk < 9; ++nk)
#pragma unroll
            for (int r = 0; r < 4; ++r) { const int p = 16 * (si + nk) + 4 * fq + r; const bool ok = (p >= i + 1) && (p <= i + 128) && (n > 0 || p >= 128);
                S[nk][r] = ok ? S[nk][r] : -1e30f; mx = fmaxf(mx, S[nk][r]); }
        mx = fmaxf(mx, __shfl_xor(mx, 16)); mx = fmaxf(mx, __shfl_xor(mx, 32));
        float sum = 0.f;
#pragma unroll
        for (int nk = 0; nk < 9; ++nk)
#pragma unroll
            for (int r = 0; r < 4; ++r) { const float pv = S[nk][r] > -1e29f ? __builtin_amdgcn_exp2f((S[nk][r] - mx) * 1.4426950408889634f) : 0.f; S[nk][r] = pv; sum += pv; }
        sum += __shfl_xor(sum, 16); sum += __shfl_xor(sum, 32);
        const float inv = 1.f / (sum + exp2f((sink - mx) * 1.4426950408889634f));
        f32x4 O[4];
#pragma unroll
        for (int nd = 0; nd < 4; ++nd) O[nd] = (f32x4){0.f, 0.f, 0.f, 0.f};
#pragma unroll
        for (int kk = 0; kk < 5; ++kk) { const bf16x8 pf = pack8(S[2 * kk], S[2 * kk + 1]);
            const int p0 = 16 * (si + 2 * kk) + 4 * fq, p1 = (kk == 4 && si == 7) ? p0 : p0 + 16;
            u32x2 lo[4], hi[4];
#pragma unroll
            for (int nd = 0; nd < 4; ++nd) { lo[nd] = *(const LAS u32x2*)(Vs + (16 * nd + fr) * 528 + p0 * 2); hi[nd] = *(const LAS u32x2*)(Vs + (16 * nd + fr) * 528 + p1 * 2); }
            __builtin_amdgcn_sched_barrier(0);
#pragma unroll
            for (int nd = 0; nd < 4; ++nd) O[nd] = MFMA16(cat8(lo[nd], hi[nd]), pf, O[nd]); }
#pragma unroll
        for (int nd = 0; nd < 4; ++nd) { u32x2 w; w[0] = pk2(O[nd][0] * inv, O[nd][1] * inv); w[1] = pk2(O[nd][2] * inv, O[nd][3] * inv);
            *(u32x2*)(ycat + (size_t)t * AB_OUT + hd * 64 + 16 * nd + 4 * fq) = w; }
    }
}

__device__ __forceinline__ void ret_kv_unit(const Ctx& c, int unit) {
    const int b = unit >> 8, n = (unit >> 2) & 63, h = unit & 3, lane = c.lane, fr = lane & 15, fq = lane >> 4, w = c.wid;
    const bf16_t* rkdT = (const bf16_t*)(c.ws + AB_RKDT); const bf16_t* rvT = (const bf16_t*)(c.ws + AB_RVT); bf16_t* kv = (bf16_t*)(c.ws + AB_KV);
    LAS unsigned char* Kd = c.lds;
    __syncthreads();
    {
        const float lg = log2f(1.f - exp2f(-5.f - (float)h)); const int cc = c.tid & 15;
        float dec[8];
#pragma unroll
        for (int e = 0; e < 8; ++e) dec[e] = __builtin_amdgcn_exp2f((float)(127 - (cc * 8 + e)) * lg);
        const unsigned char* src = (const unsigned char*)(rkdT + (size_t)(b * 4 + h) * 128 * SEQ + n * 128);
#pragma unroll
        for (int q = 0; q < 4; ++q) { const int r = (c.tid >> 4) + 32 * q; const u32x4 v = *(const u32x4*)(src + (size_t)r * SEQ * 2 + cc * 16); u32x4 o;
#pragma unroll
            for (int e2 = 0; e2 < 4; ++e2) o[e2] = pk2(__uint_as_float(v[e2] << 16) * dec[2 * e2], __uint_as_float(v[e2] & 0xffff0000u) * dec[2 * e2 + 1]);
            *(LAS u32x4*)(Kd + r * 288 + cc * 16) = o; }
    }
    bf16x8 vf[2][4];
#pragma unroll
    for (int ne = 0; ne < 2; ++ne)
#pragma unroll
        for (int ks = 0; ks < 4; ++ks) vf[ne][ks] = *(const bf16x8*)(rvT + ((size_t)(b * 4 + h) * 256 + 32 * w + 16 * ne + fr) * SEQ + n * 128 + ks * 32 + fq * 8);
    __syncthreads();
    bf16_t* out = kv + ((size_t)((b * 64 + n) * 4 + h)) * 256 * 128;
#pragma unroll
    for (int nd = 0; nd < 8; ++nd) { f32x4 a0 = (f32x4){0.f, 0.f, 0.f, 0.f}, a1 = a0;
        bf16x8 kf[4];
#pragma unroll
        for (int ks = 0; ks < 4; ++ks) kf[ks] = *(const LAS bf16x8*)(Kd + (16 * nd + fr) * 288 + ks * 64 + fq * 16);
        __builtin_amdgcn_sched_barrier(0);
#pragma unroll
        for (int ks = 0; ks < 4; ++ks) { a0 = MFMA16(kf[ks], vf[0][ks], a0); a1 = MFMA16(kf[ks], vf[1][ks], a1); }
        asm volatile("s_nop 7\n\ts_nop 7" : "+v"(a0), "+v"(a1));
        u32x2 o0, o1; o0[0] = pk2(a0[0], a0[1]); o0[1] = pk2(a0[2], a0[3]); o1[0] = pk2(a1[0], a1[1]); o1[1] = pk2(a1[2], a1[3]);
        *(u32x2*)(out + (size_t)(32 * w + fr) * 128 + 16 * nd + 4 * fq) = o0; *(u32x2*)(out + (size_t)(32 * w + 16 + fr) * 128 + 16 * nd + 4 * fq) = o1; }
}
__device__ __forceinline__ void ret_scan(const Ctx& c, int first_block, int nblocks) {
    const bf16_t* kv = (const bf16_t*)(c.ws + AB_KV); bf16_t* sp = (bf16_t*)(c.ws + AB_SPREV);
    const int nthr = nblocks * NTHREADS;
    for (int idx = (c.bid - first_block) * NTHREADS + c.tid; idx < 2 * 4 * 256 * 128 / 4; idx += nthr) {
        const int b = idx >> 15, rem = idx & 32767, h = rem >> 13;
        const float g = exp2f(128.f * log2f(1.f - exp2f(-5.f - (float)h)));
        const size_t base = (size_t)b * 64 * 131072 + (size_t)rem * 4;
        f32x4 st = (f32x4){0.f, 0.f, 0.f, 0.f};
        for (int n0 = 0; n0 < 64; n0 += 16) { u32x2 v[16];
#pragma unroll
            for (int q = 0; q < 16; ++q) v[q] = *(const u32x2*)(kv + base + (size_t)(n0 + q) * 131072);
#pragma unroll
            for (int q = 0; q < 16; ++q) { u32x2 wv; wv[0] = pk2(st[0], st[1]); wv[1] = pk2(st[2], st[3]); *(u32x2*)(sp + base + (size_t)(n0 + q) * 131072) = wv;
                st = st * g + (f32x4){__uint_as_float(v[q][0] << 16), __uint_as_float(v[q][0] & 0xffff0000u), __uint_as_float(v[q][1] << 16), __uint_as_float(v[q][1] & 0xffff0000u)}; } }
    }
}
__device__ __forceinline__ void ret_out_unit(const Ctx& c, int unit) {
    const int b = unit >> 8, n = (unit >> 2) & 63, h = unit & 3, lane = c.lane, fr = lane & 15, fq = lane >> 4, w = c.wid;
    const bf16_t* rqb = (const bf16_t*)(c.ws + AB_RQB); const bf16_t* rkb = (const bf16_t*)(c.ws + AB_RKB); const bf16_t* rvT = (const bf16_t*)(c.ws + AB_RVT);
    const bf16_t* sp = (const bf16_t*)(c.ws + AB_SPREV); const bf16_t* rgb = (const bf16_t*)(c.ws + AB_RGB); bf16_t* ycat = (bf16_t*)(c.ws + WS_YCAT);
    LAS unsigned char* Kl = c.lds; LAS unsigned char* Bl = c.lds + 128 * 288;
    const int t0 = b * SEQ + n * 128; const float lg = log2f(1.f - exp2f(-5.f - (float)h));
    __syncthreads();
    tile_g2l<128, 256>(Kl, (const unsigned char*)(rkb + (size_t)t0 * 512 + h * 128), (size_t)512 * 2, c.tid);
    tile_g2l<256, 256>(Bl, (const unsigned char*)(sp + ((size_t)((b * 64 + n) * 4 + h)) * 256 * 128), (size_t)128 * 2, c.tid);
    const int t = t0 + 16 * w + fr, i = 16 * w + fr;
    bf16x8 qf[4];
#pragma unroll
    for (int ks = 0; ks < 4; ++ks) qf[ks] = *(const bf16x8*)(rqb + (size_t)t * 512 + h * 128 + ks * 32 + fq * 8);
    __syncthreads();
    bf16x8 pf[4];
#pragma unroll
    for (int kk = 0; kk < 4; ++kk) { f32x4 s2[2];
#pragma unroll
        for (int q = 0; q < 2; ++q) { const int nj = 2 * kk + q; s2[q] = (f32x4){0.f, 0.f, 0.f, 0.f};
            if (nj <= w) {
                bf16x8 kf[4];
#pragma unroll
                for (int ks = 0; ks < 4; ++ks) kf[ks] = *(const LAS bf16x8*)(Kl + (16 * nj + fr) * 288 + ks * 64 + fq * 16);
                __builtin_amdgcn_sched_barrier(0);
#pragma unroll
                for (int ks = 0; ks < 4; ++ks) s2[q] = MFMA16(kf[ks], qf[ks], s2[q]);
#pragma unroll
                for (int r = 0; r < 4; ++r) { const int jj = 16 * nj + 4 * fq + r; s2[q][r] = (i >= jj) ? s2[q][r] * __builtin_amdgcn_exp2f((float)(i - jj) * lg) : 0.f; } } }
        pf[kk] = pack8(s2[0], s2[1]); }
    f32x4 acc[16];
#pragma unroll
    for (int ne = 0; ne < 16; ne += 2) { bf16x8 sf[2][4];
#pragma unroll
        for (int u = 0; u < 2; ++u)
#pragma unroll
            for (int ks = 0; ks < 4; ++ks) sf[u][ks] = *(const LAS bf16x8*)(Bl + (16 * (ne + u) + fr) * 288 + ks * 64 + fq * 16);
        __builtin_amdgcn_sched_barrier(0);
#pragma unroll
        for (int u = 0; u < 2; ++u) { acc[ne + u] = (f32x4){0.f, 0.f, 0.f, 0.f};
#pragma unroll
            for (int ks = 0; ks < 4; ++ks) acc[ne + u] = MFMA16(sf[u][ks], qf[ks], acc[ne + u]); } }
    const float rs = exp2f((float)(i + 1) * lg);
#pragma unroll
    for (int ne = 0; ne < 16; ++ne) acc[ne] = acc[ne] * rs;
    __syncthreads();
    tile_g2l<256, 256, 16>(Bl, (const unsigned char*)(rvT + (size_t)(b * 4 + h) * 256 * SEQ + n * 128), (size_t)SEQ * 2, c.tid);
    __syncthreads();
    const int nkk = (w >> 1) + 1;
#pragma unroll
    for (int kk = 0; kk < 4; ++kk) if (kk < nkk) {
#pragma unroll
        for (int ne = 0; ne < 16; ne += 8) { u32x2 lo[8], hi[8];
#pragma unroll
            for (int u = 0; u < 8; ++u) { lo[u] = *(const LAS u32x2*)(Bl + (16 * (ne + u) + fr) * 272 + (32 * kk + 4 * fq) * 2); hi[u] = *(const LAS u32x2*)(Bl + (16 * (ne + u) + fr) * 272 + (32 * kk + 16 + 4 * fq) * 2); }
            __builtin_amdgcn_sched_barrier(0);
#pragma unroll
            for (int u = 0; u < 8; ++u) acc[ne + u] = MFMA16(cat8(lo[u], hi[u]), pf[kk], acc[ne + u]); } }
    u32x2 gpre[16];
#pragma unroll
    for (int ne = 0; ne < 16; ++ne) gpre[ne] = *(const u32x2*)(rgb + (size_t)t * 1024 + h * 256 + 16 * ne + 4 * fq);
    float sm = 0.f;
#pragma unroll
    for (int ne = 0; ne < 16; ++ne) sm += acc[ne][0] + acc[ne][1] + acc[ne][2] + acc[ne][3];
    sm += __shfl_xor(sm, 16); sm += __shfl_xor(sm, 32);
    const float mean = sm * (1.f / 256.f); float sq = 0.f;
#pragma unroll
    for (int ne = 0; ne < 16; ++ne) { acc[ne] = acc[ne] - mean; sq += acc[ne][0] * acc[ne][0] + acc[ne][1] * acc[ne][1] + acc[ne][2] * acc[ne][2] + acc[ne][3] * acc[ne][3]; }
    sq += __shfl_xor(sq, 16); sq += __shfl_xor(sq, 32);
    const float rstd = rsqrtf(sq * (1.f / 256.f) + LN_EPS);
#pragma unroll
    for (int ne = 0; ne < 16; ++ne) { const u32x2 gw = gpre[ne];
        const float g0 = __uint_as_float(gw[0] << 16), g1 = __uint_as_float(gw[0] & 0xffff0000u), g2 = __uint_as_float(gw[1] << 16), g3 = __uint_as_float(gw[1] & 0xffff0000u);
        u32x2 o; o[0] = pk2(acc[ne][0] * rstd * g0, acc[ne][1] * rstd * g1); o[1] = pk2(acc[ne][2] * rstd * g2, acc[ne][3] * rstd * g3);
        *(u32x2*)(ycat + (size_t)t * AB_OUT + 1024 + h * 256 + 16 * ne + 4 * fq) = o; }
}

__device__ __forceinline__ void phase_ab_p1(const Ctx& c) {
    for (int u = c.bid; u < 512; u += c.G) ret_kv_unit(c, u);
}
__device__ __forceinline__ void phase_ab_p2(const Ctx& c, int j) {
    ret_scan(c, 0, c.G);
    { const float* sinks = c.inp(3) + j * 16; for (int u = c.bid; u < 256; u += c.G) attn_unit(c, u, sinks); }
}
__device__ __forceinline__ void phase_ab_p3(const Ctx& c) {
    for (int u = c.bid; u < 512; u += c.G) ret_out_unit(c, u);
}

__device__ __forceinline__ float gelu_fast(float x) { const float u = 1.5957691216057308f * (x + 0.044715f * x * x * x); return x * __builtin_amdgcn_rcpf(1.f + __expf(-u)); }
struct EpiCDIn {
    static constexpr bool PERM = true;
    LAS bf16_t* biasL; unsigned char* ws;
    __device__ __forceinline__ void init(f32x4 (&acc)[2][2][4][2], const g8::Unit& u, int wc, int fq) const {
        const int colp = u.pn * 256 + wc * 32 + fq * 8;
#pragma unroll
        for (int b = 0; b < 2; ++b)
#pragma unroll
            for (int n = 0; n < 2; ++n) { const u32x2 bw = *(const LAS u32x2*)(biasL + colp + b * 128 + 4 * n);
                const f32x4 bv = (f32x4){__uint_as_float(bw[0] << 16), __uint_as_float(bw[0] & 0xffff0000u), __uint_as_float(bw[1] << 16), __uint_as_float(bw[1] & 0xffff0000u)};
#pragma unroll
                for (int a = 0; a < 2; ++a)
#pragma unroll
                    for (int m = 0; m < 4; ++m) acc[a][b][m][n] = bv; } }
    __device__ __forceinline__ void operator()(const f32x4 (&acc)[2][2][4][2], const g8::Unit& u, int wr, int wc, int fr, int fq) const {
        const int pn = u.pn; const int col0 = pn * 256 + wc * 32 + fq * 8;
        bf16_t* gu = (bf16_t*)(ws + CD_GU); bf16_t* gvT = (bf16_t*)(ws + CD_GVT); bf16_t* gg = (bf16_t*)(ws + CD_GG); bf16_t* xr = (bf16_t*)(ws + CD_XR); float* stats = (float*)(ws + CD_STATS);
#pragma unroll
        for (int ai = 0; ai < 2; ++ai)
#pragma unroll
            for (int m = 0; m < 4; ++m) {
                const int t = u.pm * 256 + ai * 128 + wr * 64 + m * 16 + fr, sq = t & (SEQ - 1), b = t >> 13;
                f32x4 x[2][2];
#pragma unroll
                for (int bj = 0; bj < 2; ++bj)
#pragma unroll
                    for (int n = 0; n < 2; ++n) { x[bj][n] = acc[ai][bj][m][n];
                        if (pn < 13) {
                            x[bj][n] = gelu4(x[bj][n]); } }
                if (pn >= 4 && pn < 8) {
                    float s1 = 0.f, s2 = 0.f;
#pragma unroll
                    for (int bj = 0; bj < 2; ++bj)
#pragma unroll
                        for (int n = 0; n < 2; ++n)
#pragma unroll
                            for (int e = 0; e < 4; ++e) { const float v = x[bj][n][e]; s1 += v; s2 += v * v;
                                st_bf16_off((unsigned char*)gvT, (unsigned)(((b * 1024 + (pn - 4) * 256 + bj * 128 + wc * 32 + fq * 8 + 4 * n + e) * SEQ + sq) * 2), v); }
                    s1 += __shfl_xor(s1, 16); s1 += __shfl_xor(s1, 32); s2 += __shfl_xor(s2, 16); s2 += __shfl_xor(s2, 32);
                    if (fq == 0) *(f32x2*)(stats + (size_t)t * 32 + ((pn - 4) * 4 + wc) * 2) = (f32x2){s1, s2};
                } else {
                    bf16_t* dst; int ld, cb;
                    if (pn < 4) { dst = gu; ld = 1024; cb = pn * 256; } else if (pn < 13) { dst = gg; ld = 1280; cb = (pn - 8) * 256; } else { dst = xr; ld = 1280; cb = (pn - 13) * 256; }
#pragma unroll
                    for (int bj = 0; bj < 2; ++bj) { u32x4 w;
#pragma unroll
                        for (int n = 0; n < 2; ++n) { w[2 * n] = pk2(x[bj][n][0], x[bj][n][1]); w[2 * n + 1] = pk2(x[bj][n][2], x[bj][n][3]); }
                        *(u32x4*)(dst + (size_t)t * ld + cb + bj * 128 + wc * 32 + fq * 8) = w; }
                }
            }
    }
};
__device__ __forceinline__ void phase_cd_inproj(const Ctx& c, int j) {
    g8::DenseOrder S; S.init(c.ws + WS_XB, c.ws + WS_WCDIN + (size_t)j * CD_IN * D * 2, T, CD_IN, D, c.G, c.bid); S.tid0 = c.tid;
    LAS bf16_t* biasL = (LAS bf16_t*)(c.lds + LDS_TAB);
    { const float* bp = c.inp(7) + (size_t)j * CD_IN; for (int i = c.tid; i < CD_IN; i += NTHREADS) biasL[i] = f2bf(bp[i]); }
    __syncthreads();
    EpiCDIn E{biasL, c.ws};
    g8::gemm_phase<EpiCDIn, g8::DenseOrder>(c.lds + LDS_STAGE, D, S, E);
}

__device__ __forceinline__ void lru_unit(const Ctx& c, int unit, int j) {
    const int hh = unit % 5, bn = unit / 5, lane = c.lane, fr = lane & 15, fq = lane >> 4, w = c.wid;
    const int t0 = bn * 128, s0 = t0 & (SEQ - 1);
    const bf16_t* xr = (const bf16_t*)(c.ws + CD_XR); bf16_t* HL = (bf16_t*)(c.ws + WS_U2); bf16_t* PC = HL + (size_t)T * 1280; float* sum = (float*)(c.ws + WS_H);
    const float* conv_w = c.inp(10) + (size_t)j * 4 * 1280 + hh * 256; const float* conv_b = c.inp(11) + (size_t)j * 1280 + hh * 256;
    const float* ba = c.inp(13) + (size_t)j * 1280 + hh * 256; const float* bx = c.inp(15) + (size_t)j * 1280 + hh * 256; const float* spl = (const float*)(c.ws + WS_SPL) + (size_t)j * 1280 + hh * 256;
    const bf16_t* Wl = (const bf16_t*)(c.ws + WS_WLRU) + (size_t)((j * 5 + hh) * 2) * 65536;
    LAS unsigned char* Xc = c.lds; LAS unsigned char* Wa = c.lds + 128 * 544; LAS unsigned char* Wx = Wa + 64 * 544; LAS unsigned char* Tot = Wx + 64 * 544; LAS float* Bl = (LAS float*)(Tot + 4096);
    __syncthreads();
    if (c.tid < 192) { const int which = c.tid >> 6, i4 = (c.tid & 63) * 4; const float* srcp = which == 0 ? ba : (which == 1 ? bx : spl); *(LAS f32x4*)(Bl + which * 256 + i4) = *(const f32x4*)(srcp + i4); }
    {
        const int cg = c.tid & 31, r0 = (c.tid >> 5) * 8;
        float wv[4][8], bv8[8];
        { const f32x4 b0 = *(const f32x4*)(conv_b + cg * 8), b1 = *(const f32x4*)(conv_b + cg * 8 + 4); bv8[0] = b0[0]; bv8[1] = b0[1]; bv8[2] = b0[2]; bv8[3] = b0[3]; bv8[4] = b1[0]; bv8[5] = b1[1]; bv8[6] = b1[2]; bv8[7] = b1[3]; }
#pragma unroll
        for (int k = 0; k < 4; ++k) { const f32x4 w0 = *(const f32x4*)(conv_w + k * 1280 + cg * 8), w1 = *(const f32x4*)(conv_w + k * 1280 + cg * 8 + 4);
            wv[k][0] = w0[0]; wv[k][1] = w0[1]; wv[k][2] = w0[2]; wv[k][3] = w0[3]; wv[k][4] = w1[0]; wv[k][5] = w1[1]; wv[k][6] = w1[2]; wv[k][7] = w1[3]; }
        u32x4 xin[11];
#pragma unroll
        for (int q = 0; q < 11; ++q) { xin[q] = (u32x4){0u, 0u, 0u, 0u}; if (s0 + r0 - 3 + q >= 0) xin[q] = *(const u32x4*)(xr + (size_t)(t0 + r0 - 3 + q) * 1280 + hh * 256 + cg * 8); }
#pragma unroll
        for (int rr = 0; rr < 8; ++rr) { float a[8];
#pragma unroll
            for (int e = 0; e < 8; ++e) a[e] = bv8[e];
#pragma unroll
            for (int k = 0; k < 4; ++k) { const u32x4 xv = xin[rr + k];
#pragma unroll
                for (int e2 = 0; e2 < 4; ++e2) { a[2 * e2] += wv[k][2 * e2] * __uint_as_float(xv[e2] << 16); a[2 * e2 + 1] += wv[k][2 * e2 + 1] * __uint_as_float(xv[e2] & 0xffff0000u); } }
            u32x4 o; o[0] = pk2(a[0], a[1]); o[1] = pk2(a[2], a[3]); o[2] = pk2(a[4], a[5]); o[3] = pk2(a[6], a[7]);
            *(LAS u32x4*)(Xc + (r0 + rr) * 544 + cg * 16) = o; }
    }
    u32x4 wreg[8];
#pragma unroll
    for (int q = 0; q < 4; ++q) { const int i = c.tid + q * NTHREADS, r = i >> 5, cc = i & 31; wreg[q] = *(const u32x4*)((const unsigned char*)Wl + (size_t)r * 512 + cc * 16); wreg[4 + q] = *(const u32x4*)((const unsigned char*)(Wl + 65536) + (size_t)r * 512 + cc * 16); }
    __syncthreads();
    bf16x8 xf[8];
#pragma unroll
    for (int ks = 0; ks < 8; ++ks) xf[ks] = *(const LAS bf16x8*)(Xc + (16 * w + fr) * 544 + ks * 64 + fq * 16);
    const int t = t0 + 16 * w + fr;
    for (int sl = 0; sl < 4; ++sl) {
        if (sl) __syncthreads();
#pragma unroll
        for (int q = 0; q < 4; ++q) { const int i = c.tid + q * NTHREADS, r = i >> 5, cc = i & 31; *(LAS u32x4*)(Wa + r * 544 + cc * 16) = wreg[q]; *(LAS u32x4*)(Wx + r * 544 + cc * 16) = wreg[4 + q]; }
        if (sl < 3) {
#pragma unroll
            for (int q = 0; q < 4; ++q) { const int i = c.tid + q * NTHREADS, r = i >> 5, cc = i & 31;
                wreg[q] = *(const u32x4*)((const unsigned char*)(Wl + (size_t)((sl + 1) * 64) * 256) + (size_t)r * 512 + cc * 16); wreg[4 + q] = *(const u32x4*)((const unsigned char*)(Wl + 65536 + (size_t)((sl + 1) * 64) * 256) + (size_t)r * 512 + cc * 16); } }
        __syncthreads();
        f32x4 sA[4], sB[4];
#pragma unroll
        for (int nc = 0; nc < 4; ++nc) { f32x4 ra = (f32x4){0.f, 0.f, 0.f, 0.f}, ri = ra;
            bf16x8 waf[8], wxf[8];
#pragma unroll
            for (int ks = 0; ks < 8; ++ks) { waf[ks] = *(const LAS bf16x8*)(Wa + (16 * nc + fr) * 544 + ks * 64 + fq * 16); wxf[ks] = *(const LAS bf16x8*)(Wx + (16 * nc + fr) * 544 + ks * 64 + fq * 16); }
            __builtin_amdgcn_sched_barrier(0);
#pragma unroll
            for (int ks = 0; ks < 8; ++ks) { ra = MFMA16(waf[ks], xf[ks], ra); ri = MFMA16(wxf[ks], xf[ks], ri); }
            const int ch = sl * 64 + 16 * nc + 4 * fq;
            const f32x4 b_a = *(const LAS f32x4*)(Bl + ch), b_x = *(const LAS f32x4*)(Bl + 256 + ch), sp = *(const LAS f32x4*)(Bl + 512 + ch);
            const u32x2 xw = *(const LAS u32x2*)(Xc + (16 * w + fr) * 544 + ch * 2);
            const float xcv[4] = {__uint_as_float(xw[0] << 16), __uint_as_float(xw[0] & 0xffff0000u), __uint_as_float(xw[1] << 16), __uint_as_float(xw[1] & 0xffff0000u)};
            f32x4 oa, ob;
#pragma unroll
            for (int r = 0; r < 4; ++r) { const float gr = __builtin_amdgcn_rcpf(1.f + __expf(-(ra[r] + b_a[r]))), gi = __builtin_amdgcn_rcpf(1.f + __expf(-(ri[r] + b_x[r]))); const float la = -8.f * gr * sp[r]; const float a = __expf(la);
                oa[r] = a; ob[r] = __builtin_amdgcn_sqrtf(fmaxf(1.f - a * a, 0.f)) * (gi * xcv[r]); }
            sA[nc] = oa; sB[nc] = ob;
        }
#pragma unroll
        for (int dlt = 1; dlt < 16; dlt <<= 1) { f32x4 pa[4], pb[4];
#pragma unroll
            for (int nc = 0; nc < 4; ++nc)
#pragma unroll
                for (int r = 0; r < 4; ++r) { pa[nc][r] = __shfl_up(sA[nc][r], dlt, 16); pb[nc][r] = __shfl_up(sB[nc][r], dlt, 16); }
            if (fr >= dlt) {
#pragma unroll
                for (int nc = 0; nc < 4; ++nc) { sB[nc] = sA[nc] * pb[nc] + sB[nc]; sA[nc] = sA[nc] * pa[nc]; } } }
        if (fr == 15) {
#pragma unroll
            for (int nc = 0; nc < 4; ++nc) { *(LAS f32x4*)(Tot + ((w * 64 + 16 * nc + 4 * fq) * 2) * 4) = sA[nc]; *(LAS f32x4*)(Tot + ((w * 64 + 16 * nc + 4 * fq) * 2 + 4) * 4) = sB[nc]; } }
        __syncthreads();
#pragma unroll
        for (int nc = 0; nc < 4; ++nc) { const int ch = sl * 64 + 16 * nc + 4 * fq;
            f32x4 cp = (f32x4){1.f, 1.f, 1.f, 1.f}, chh = (f32x4){0.f, 0.f, 0.f, 0.f};
            for (int w2 = 0; w2 < w; ++w2) { const f32x4 ta = *(const LAS f32x4*)(Tot + ((w2 * 64 + 16 * nc + 4 * fq) * 2) * 4), tb = *(const LAS f32x4*)(Tot + ((w2 * 64 + 16 * nc + 4 * fq) * 2 + 4) * 4);
                chh = ta * chh + tb; cp = cp * ta; }
            const f32x4 hl = sB[nc] + sA[nc] * chh, pc = sA[nc] * cp;
            u32x2 o1, o2; o1[0] = pk2(hl[0], hl[1]); o1[1] = pk2(hl[2], hl[3]); o2[0] = pk2(pc[0], pc[1]); o2[1] = pk2(pc[2], pc[3]);
            *(u32x2*)(HL + (size_t)t * 1280 + hh * 256 + ch) = o1; *(u32x2*)(PC + (size_t)t * 1280 + hh * 256 + ch) = o2;
            if (w == 7 && fr == 15) { float* sm = sum + ((size_t)bn * 1280 + hh * 256 + ch) * 2;
#pragma unroll
                for (int r = 0; r < 4; ++r) { sm[2 * r] = pc[r]; sm[2 * r + 1] = hl[r]; } } }
    }
}

__device__ __forceinline__ void sgu_unit(const Ctx& c, int unit, int j) {
    const int g = unit & 3, bn = unit >> 2, b = bn >> 6, n = bn & 63, lane = c.lane, fr = lane & 15, fq = lane >> 4, w = c.wid;
    const int t0 = bn * 128;
    const bf16_t* gu = (const bf16_t*)(c.ws + CD_GU); const bf16_t* gvT = (const bf16_t*)(c.ws + CD_GVT); const float* stats = (const float*)(c.ws + CD_STATS); bf16_t* ycat = (bf16_t*)(c.ws + WS_YCAT);
    const float* sw = c.inp(8) + (size_t)(j * 4 + g) * 16384; const float* sb = c.inp(9) + (size_t)(j * 4 + g) * 128;
    LAS unsigned char* Vt = c.lds; LAS float* mr = (LAS float*)(c.lds + 256 * 288);
    __syncthreads();
    tile_g2l<256, 256>(Vt, (const unsigned char*)(gvT + ((size_t)b * 1024 + g * 256) * SEQ + n * 128), (size_t)SEQ * 2, c.tid);
    if (c.tid < 128) { const f32x4* st = (const f32x4*)(stats + (size_t)(t0 + c.tid) * 32); float s1 = 0.f, s2 = 0.f; f32x4 sv[8];
#pragma unroll
        for (int q = 0; q < 8; ++q) sv[q] = st[q];
#pragma unroll
        for (int q = 0; q < 8; ++q) { s1 += sv[q][0] + sv[q][2]; s2 += sv[q][1] + sv[q][3]; }
        const float mean = s1 * (1.f / 1024.f), var = fmaxf(s2 * (1.f / 1024.f) - mean * mean, 0.f); mr[2 * c.tid] = mean; mr[2 * c.tid + 1] = rsqrtf(var + LN_EPS); }
    __syncthreads();
    const int i = 16 * w + fr, t = t0 + i, nks = (w >> 1) + 1;
    bf16x8 wf[4]; float ci = 0.f;
#pragma unroll
    for (int ks = 0; ks < 4; ++ks) { f32x4 lo = (f32x4){0.f, 0.f, 0.f, 0.f}, hi = lo;
        if (ks < nks) { const int j0 = ks * 32 + fq * 8; const f32x4 w0 = *(const f32x4*)(sw + (size_t)i * 128 + j0), w1 = *(const f32x4*)(sw + (size_t)i * 128 + j0 + 4);
#pragma unroll
            for (int e = 0; e < 4; ++e) { const float m0 = mr[2 * (j0 + e)], r0 = mr[2 * (j0 + e) + 1], m1 = mr[2 * (j0 + 4 + e)], r1 = mr[2 * (j0 + 4 + e) + 1];
                lo[e] = (j0 + e <= i) ? w0[e] * r0 : 0.f; hi[e] = (j0 + 4 + e <= i) ? w1[e] * r1 : 0.f; ci += lo[e] * m0 + hi[e] * m1; } }
        wf[ks] = pack8(lo, hi); }
    ci += __shfl_xor(ci, 16); ci += __shfl_xor(ci, 32);
    const float add = sb[i] - ci;
    f32x4 acc[16];
#pragma unroll
    for (int nd = 0; nd < 16; nd += 2) { bf16x8 vf[2][4];
#pragma unroll
        for (int u = 0; u < 2; ++u)
#pragma unroll
            for (int ks = 0; ks < 4; ++ks) if (ks < nks) vf[u][ks] = *(const LAS bf16x8*)(Vt + (16 * (nd + u) + fr) * 288 + ks * 64 + fq * 16);
        __builtin_amdgcn_sched_barrier(0);
#pragma unroll
        for (int u = 0; u < 2; ++u) { acc[nd + u] = (f32x4){0.f, 0.f, 0.f, 0.f};
#pragma unroll
            for (int ks = 0; ks < 4; ++ks) if (ks < nks) acc[nd + u] = MFMA16(vf[u][ks], wf[ks], acc[nd + u]); } }
    u32x2 upre[16];
#pragma unroll
    for (int nd = 0; nd < 16; ++nd) upre[nd] = *(const u32x2*)(gu + (size_t)t * 1024 + g * 256 + 16 * nd + 4 * fq);
#pragma unroll
    for (int nd = 0; nd < 16; ++nd) { const u32x2 uw = upre[nd];
        const float u0 = __uint_as_float(uw[0] << 16), u1 = __uint_as_float(uw[0] & 0xffff0000u), u2 = __uint_as_float(uw[1] << 16), u3 = __uint_as_float(uw[1] & 0xffff0000u);
        u32x2 o; o[0] = pk2(u0 * (acc[nd][0] + add), u1 * (acc[nd][1] + add)); o[1] = pk2(u2 * (acc[nd][2] + add), u3 * (acc[nd][3] + add));
        *(u32x2*)(ycat + (size_t)t * CD_OUT + g * 256 + 16 * nd + 4 * fq) = o; }
}
__device__ __forceinline__ void phase_cd_p1(const Ctx& c, int j) {
    for (int u = c.bid; u < 640; u += c.G) lru_unit(c, u, j);
    if (c.G == 256) {
        if (c.bid < 128) sgu_unit(c, c.bid, j);
        else { for (int q = 0; q < 3; ++q) sgu_unit(c, 128 + (c.bid - 128) * 3 + q, j); }
    } else { for (int u = c.bid; u < 512; u += c.G) sgu_unit(c, u, j); }
}

__device__ __forceinline__ void phase_cd_scan2(const Ctx& c) {
    const bf16_t* gg = (const bf16_t*)(c.ws + CD_GG); bf16_t* ycat = (bf16_t*)(c.ws + WS_YCAT);
    const bf16_t* HL = (const bf16_t*)(c.ws + WS_U2); const bf16_t* PC = HL + (size_t)T * 1280; const float* sum = (const float*)(c.ws + WS_H);
    LAS float* carry = (LAS float*)c.lds;
    for (int u = c.bid; u < 256; u += c.G) {
        const int bn = u >> 1, half = u & 1, b = bn >> 6, n = bn & 63;
        __syncthreads();
        {
            LAS float* part = carry + 1280;
            for (int it = c.tid; it < 4 * 1280; it += NTHREADS) { const int seg = it / 1280, ch = it % 1280; const float* sp = sum + ((size_t)(b * 64 + seg * 16) * 1280 + ch) * 2;
                f32x2 v[16];
#pragma unroll
                for (int q = 0; q < 16; ++q) { v[q] = (f32x2){1.f, 0.f}; if (seg * 16 + q < n) v[q] = *(const f32x2*)(sp + (size_t)q * 2560); }
                float A = 1.f, Bv = 0.f;
#pragma unroll
                for (int q = 0; q < 16; ++q) { Bv = v[q][0] * Bv + v[q][1]; A *= v[q][0]; }
                part[(seg * 1280 + ch) * 2] = A; part[(seg * 1280 + ch) * 2 + 1] = Bv; }
            __syncthreads();
            for (int ch = c.tid; ch < 1280; ch += NTHREADS) { float cr = 0.f;
#pragma unroll
                for (int seg = 0; seg < 4; ++seg) cr = part[(seg * 1280 + ch) * 2] * cr + part[(seg * 1280 + ch) * 2 + 1];
                carry[ch] = cr; }
        }
        __syncthreads();
        const size_t t0 = (size_t)bn * 128 + half * 64;
        for (int it0 = c.tid; it0 < 64 * 320; it0 += 8 * NTHREADS) {
            u32x2 hw[8], pw[8], gw[8];
#pragma unroll
            for (int q = 0; q < 8; ++q) { const int it = it0 + q * NTHREADS; const int r = it / 320, c4 = (it % 320) * 4; const size_t o = (t0 + r) * 1280 + c4; hw[q] = *(const u32x2*)(HL + o); pw[q] = *(const u32x2*)(PC + o); gw[q] = *(const u32x2*)(gg + o); }
#pragma unroll
            for (int q = 0; q < 8; ++q) { const int it = it0 + q * NTHREADS; const int r = it / 320, c4 = (it % 320) * 4; const f32x4 cr = *(const LAS f32x4*)(carry + c4);
                const float h0 = __uint_as_float(hw[q][0] << 16) + __uint_as_float(pw[q][0] << 16) * cr[0], h1 = __uint_as_float(hw[q][0] & 0xffff0000u) + __uint_as_float(pw[q][0] & 0xffff0000u) * cr[1];
                const float h2 = __uint_as_float(hw[q][1] << 16) + __uint_as_float(pw[q][1] << 16) * cr[2], h3 = __uint_as_float(hw[q][1] & 0xffff0000u) + __uint_as_float(pw[q][1] & 0xffff0000u) * cr[3];
                u32x2 ow; ow[0] = pk2(__uint_as_float(gw[q][0] << 16) * h0, __uint_as_float(gw[q][0] & 0xffff0000u) * h1); ow[1] = pk2(__uint_as_float(gw[q][1] << 16) * h2, __uint_as_float(gw[q][1] & 0xffff0000u) * h3);
                *(u32x2*)(ycat + (t0 + r) * CD_OUT + 1024 + c4) = ow; } }
    }
}

__device__ __forceinline__ void phase_ln_moe(const Ctx& c, const float* g, const float* bta, float* xout) {
    typedef float f32x2v __attribute__((ext_vector_type(2)));
    bf16_t* xb = (bf16_t*)(c.ws + WS_XB); const unsigned char* Y = (const unsigned char*)(c.ws + WS_U1);
    f32x4 gpre[2][2], bpre[2][2];
#pragma unroll
    for (int q = 0; q < 2; ++q)
#pragma unroll
        for (int h2 = 0; h2 < 2; ++h2) { gpre[q][h2] = *(const f32x4*)(g + q * 512 + c.lane * 8 + 4 * h2); bpre[q][h2] = *(const f32x4*)(bta + q * 512 + c.lane * 8 + 4 * h2); }
    for (long tt = (long)c.gw * 2; tt < T; tt += (long)c.nwaves * 2) {
        float v[2][2][8];
#pragma unroll
        for (int u = 0; u < 2; ++u) { const long t = tt + u;
#pragma unroll
            for (int q = 0; q < 2; ++q) { const int col = q * 512 + c.lane * 8;
                float f[8];
#pragma unroll
                for (int e = 0; e < 8; ++e) f[e] = 0.f;
#pragma unroll
                for (int k = 0; k < 8; ++k) { const size_t srow = (size_t)t * 8 + k; const u32x2 w = *(const u32x2*)(Y + srow * D + col);
#pragma unroll
                    for (int h2 = 0; h2 < 2; ++h2) { const f32x2v a = __builtin_amdgcn_cvt_pk_f32_fp8(w[h2], false), b = __builtin_amdgcn_cvt_pk_f32_fp8(w[h2], true);
                        f[4 * h2] += a[0]; f[4 * h2 + 1] += a[1]; f[4 * h2 + 2] += b[0]; f[4 * h2 + 3] += b[1]; } }
                const u32x4 xw = *(const u32x4*)(xb + (size_t)t * D + col), sw = *(const u32x4*)((const bf16_t*)(Y + (size_t)TK * D) + (size_t)t * D + col);
#pragma unroll
                for (int e2 = 0; e2 < 4; ++e2) { v[u][q][2 * e2] = __uint_as_float(xw[e2] << 16) * ALPHA + f[2 * e2] * (1.f / 64.f) + __uint_as_float(sw[e2] << 16);
                    v[u][q][2 * e2 + 1] = __uint_as_float(xw[e2] & 0xffff0000u) * ALPHA + f[2 * e2 + 1] * (1.f / 64.f) + __uint_as_float(sw[e2] & 0xffff0000u); } } }
#pragma unroll
        for (int u = 0; u < 2; ++u) { const long t = tt + u;
            float sm = 0.f;
#pragma unroll
            for (int q = 0; q < 2; ++q)
#pragma unroll
                for (int e = 0; e < 8; ++e) sm += v[u][q][e];
            const float mean = wave_sum(sm) * (1.f / 1024.f); float sq = 0.f;
#pragma unroll
            for (int q = 0; q < 2; ++q)
#pragma unroll
                for (int e = 0; e < 8; ++e) { v[u][q][e] -= mean; sq += v[u][q][e] * v[u][q][e]; }
            const float rstd = rsqrtf(wave_sum(sq) * (1.f / 1024.f) + LN_EPS);
#pragma unroll
            for (int q = 0; q < 2; ++q) { const int col = q * 512 + c.lane * 8; float o[8];
#pragma unroll
                for (int h2 = 0; h2 < 2; ++h2) { const f32x4 gg = gpre[q][h2], bb = bpre[q][h2];
#pragma unroll
                    for (int e = 0; e < 4; ++e) o[4 * h2 + e] = v[u][q][4 * h2 + e] * rstd * gg[e] + bb[e];
                    if (xout) *(f32x4*)(xout + (size_t)t * D + col + 4 * h2) = (f32x4){o[4 * h2], o[4 * h2 + 1], o[4 * h2 + 2], o[4 * h2 + 3]}; }
                u32x4 w; w[0] = pk2(o[0], o[1]); w[1] = pk2(o[2], o[3]); w[2] = pk2(o[4], o[5]); w[3] = pk2(o[6], o[7]); *(u32x4*)(xb + (size_t)t * D + col) = w; } }
    }
}

__device__ __forceinline__ unsigned sortable_u32(float f) { const unsigned b = __float_as_uint(f); return b ^ ((b >> 31) ? 0xffffffffu : 0x80000000u); }
__device__ __forceinline__ int popc64(unsigned long long m) { return __builtin_popcountll(m); }
__device__ __forceinline__ int rank_lt(unsigned long long m) { return (int)__builtin_amdgcn_mbcnt_hi((unsigned)(m >> 32), __builtin_amdgcn_mbcnt_lo((unsigned)m, 0u)); }
__device__ __forceinline__ void phase_ln_route(const Ctx& c, int L) {
    bf16_t* xb = (bf16_t*)(c.ws + WS_XB); const bf16_t* hbuf = (const bf16_t*)(c.ws + WS_HB);
    const float* g = c.inp(19) + (size_t)L * D; const float* bta = c.inp(20) + (size_t)L * D; const float* rb = c.inp(22) + L * NE;
    const bf16_t* Wr = (const bf16_t*)(c.ws + WS_WRT) + (size_t)L * 256 * D;
    int* cnt = (int*)(c.ws + CTL_CNT) + L * NE * 32; int* list = (int*)(c.ws + WS_LIST); float* gate = (float*)(c.ws + WS_GATE);
    LAS unsigned char* Xl = c.lds; LAS unsigned char* Wq = c.lds + 64 * 544;
    LAS float* Sc = (LAS float*)Wq;
    LAS int* hist = (LAS int*)(Wq + 32768); LAS int* gbase = hist + 128; LAS int* sel = gbase + 128; LAS float* selg = (LAS float*)(sel + 512);
    const int lane = c.lane, fr = lane & 15, fq = lane >> 4, w = c.wid;
    f32x4 gpre[4], bpre[4];
#pragma unroll
    for (int q = 0; q < 4; ++q) { gpre[q] = *(const f32x4*)(g + q * 256 + lane * 4); bpre[q] = *(const f32x4*)(bta + q * 256 + lane * 4); }
    for (int grp = c.bid; grp < T / 64; grp += c.G) {
        __syncthreads();
        u32x2 nb[8][4];
#pragma unroll
        for (int hb = 0; hb < 2; ++hb) {
            u32x2 xw[4][4], hw[4][4];
#pragma unroll
            for (int i = 0; i < 4; ++i) { const size_t t = (size_t)grp * 64 + hb * 32 + w * 4 + i;
#pragma unroll
                for (int q = 0; q < 4; ++q) { const int col = q * 256 + lane * 4; xw[i][q] = *(const u32x2*)(xb + t * D + col); hw[i][q] = *(const u32x2*)(hbuf + t * D + col); } }
#pragma unroll
            for (int i = 0; i < 4; ++i) { const size_t t = (size_t)grp * 64 + hb * 32 + w * 4 + i;
                f32x4 v[4]; float sm = 0.f;
#pragma unroll
                for (int q = 0; q < 4; ++q) { v[q] = (f32x4){__uint_as_float(xw[i][q][0] << 16), __uint_as_float(xw[i][q][0] & 0xffff0000u), __uint_as_float(xw[i][q][1] << 16), __uint_as_float(xw[i][q][1] & 0xffff0000u)} * ALPHA
                         + (f32x4){__uint_as_float(hw[i][q][0] << 16), __uint_as_float(hw[i][q][0] & 0xffff0000u), __uint_as_float(hw[i][q][1] << 16), __uint_as_float(hw[i][q][1] & 0xffff0000u)};
                    sm += v[q][0] + v[q][1] + v[q][2] + v[q][3]; }
                const float mean = wave_sum(sm) * (1.f / 1024.f); float sq = 0.f;
#pragma unroll
                for (int q = 0; q < 4; ++q) { v[q] = v[q] - mean; sq += v[q][0] * v[q][0] + v[q][1] * v[q][1] + v[q][2] * v[q][2] + v[q][3] * v[q][3]; }
                const float rstd = rsqrtf(wave_sum(sq) * (1.f / 1024.f) + LN_EPS);
#pragma unroll
                for (int q = 0; q < 4; ++q) { const f32x4 o = v[q] * rstd * gpre[q] + bpre[q]; nb[hb * 4 + i][q][0] = pk2(o[0], o[1]); nb[hb * 4 + i][q][1] = pk2(o[2], o[3]);
                    *(u32x2*)(xb + t * D + q * 256 + lane * 4) = nb[hb * 4 + i][q]; } }
        }
        f32x4 lg[2][2];
        const int st = w & 1, eg = w >> 1;
        lg[0][0] = (f32x4){0.f, 0.f, 0.f, 0.f}; lg[0][1] = lg[0][0]; lg[1][0] = lg[0][0]; lg[1][1] = lg[0][0];
        u32x4 wreg[8];
#pragma unroll
        for (int q = 0; q < 8; ++q) { const int i = c.tid + q * NTHREADS, r = i >> 5, cc = i & 31; wreg[q] = *(const u32x4*)((const unsigned char*)Wr + (size_t)r * 2048 + cc * 16); }
#pragma unroll
        for (int kq = 0; kq < 4; ++kq) {
            if (kq) __syncthreads();
#pragma unroll
            for (int q = 0; q < 8; ++q) { const int i = c.tid + q * NTHREADS, r = i >> 5, cc = i & 31; *(LAS u32x4*)(Wq + r * 544 + cc * 16) = wreg[q]; }
#pragma unroll
            for (int u = 0; u < 8; ++u) *(LAS u32x2*)(Xl + ((u >> 2) * 32 + w * 4 + (u & 3)) * 544 + lane * 8) = nb[u][kq];
            if (kq < 3) {
#pragma unroll
                for (int q = 0; q < 8; ++q) { const int i = c.tid + q * NTHREADS, r = i >> 5, cc = i & 31; wreg[q] = *(const u32x4*)((const unsigned char*)Wr + (size_t)r * 2048 + (kq + 1) * 512 + cc * 16); } }
            __syncthreads();
#pragma unroll
            for (int k4 = 0; k4 < 8; k4 += 2) { bf16x8 bop[2][2], aop[2][2];
#pragma unroll
                for (int u = 0; u < 2; ++u) { const int ks = k4 + u;
#pragma unroll
                    for (int p2 = 0; p2 < 2; ++p2) bop[p2][u] = *(const LAS bf16x8*)(Xl + (p2 * 32 + 16 * st + fr) * 544 + ks * 64 + fq * 16);
#pragma unroll
                    for (int ne2 = 0; ne2 < 2; ++ne2) aop[u][ne2] = *(const LAS bf16x8*)(Wq + (32 * eg + 16 * ne2 + fr) * 544 + ks * 64 + fq * 16); }
                __builtin_amdgcn_sched_barrier(0);
#pragma unroll
                for (int u = 0; u < 2; ++u)
#pragma unroll
                    for (int p2 = 0; p2 < 2; ++p2)
#pragma unroll
                        for (int ne2 = 0; ne2 < 2; ++ne2) lg[p2][ne2] = MFMA16(aop[u][ne2], bop[p2][u], lg[p2][ne2]); }
        }
        __syncthreads();
#pragma unroll
        for (int p2 = 0; p2 < 2; ++p2)
#pragma unroll
            for (int ne2 = 0; ne2 < 2; ++ne2) { f32x4 sg;
#pragma unroll
                for (int r = 0; r < 4; ++r) sg[r] = sigmoidf_(lg[p2][ne2][r]);
                *(LAS f32x4*)(Sc + (p2 * 32 + 16 * st + fr) * 128 + 32 * eg + 16 * ne2 + 4 * fq) = sg; }
        if (c.tid < 128) hist[c.tid] = 0;
        __syncthreads();
        {
            const float rb0 = rb[lane], rb1 = rb[64 + lane];
#pragma unroll 2
            for (int q = 0; q < 8; ++q) { const int rr = w * 8 + q;
                const float s0 = Sc[rr * 128 + lane], s1 = Sc[rr * 128 + 64 + lane];
                const unsigned u0 = sortable_u32(s0 + rb0), u1 = sortable_u32(s1 + rb1);
                unsigned thr = 0u;
                for (int bit = 31; bit >= 0; --bit) { const unsigned cand = thr | (1u << bit); const int n = popc64(__ballot(u0 >= cand)) + popc64(__ballot(u1 >= cand)); if (n >= 8) { thr = cand; if (n == 8) break; } }
                const bool gt0 = u0 > thr, gt1 = u1 > thr, eq0 = u0 == thr, eq1 = u1 == thr;
                const unsigned long long me0 = __ballot(eq0), me1 = __ballot(eq1);
                const int need = 8 - popc64(__ballot(gt0)) - popc64(__ballot(gt1));
                const bool sel0 = gt0 || (eq0 && rank_lt(me0) < need), sel1 = gt1 || (eq1 && popc64(me0) + rank_lt(me1) < need);
                const unsigned long long m0 = __ballot(sel0), m1 = __ballot(sel1);
                const float tot = wave_sum((sel0 ? s0 : 0.f) + (sel1 ? s1 : 0.f));
                if (sel0) { const int k = rank_lt(m0); const int lr = __hip_atomic_fetch_add(&hist[lane], 1, __ATOMIC_RELAXED, __HIP_MEMORY_SCOPE_WORKGROUP); sel[rr * 8 + k] = (lane << 16) | lr; selg[rr * 8 + k] = s0 / tot * 2.5f; }
                if (sel1) { const int k = popc64(m0) + rank_lt(m1); const int lr = __hip_atomic_fetch_add(&hist[64 + lane], 1, __ATOMIC_RELAXED, __HIP_MEMORY_SCOPE_WORKGROUP); sel[rr * 8 + k] = ((64 + lane) << 16) | lr; selg[rr * 8 + k] = s1 / tot * 2.5f; } }
        }
        __syncthreads();
        if (c.tid < 128) gbase[c.tid] = atomicAdd(&cnt[c.tid * 32], hist[c.tid]);
        __syncthreads();
        { const int sv = sel[c.tid], e = sv >> 16, lr = sv & 0xffff; const int slot = (grp * 64 + (c.tid >> 3)) * 8 + (c.tid & 7);
          list[(size_t)e * LISTCAP + gbase[e] + lr] = slot; gate[slot] = selg[c.tid]; }
    }
}

struct MoeOrder {
    const char* Abase; const char* Bbase; size_t Bstride; int K, NT, NTG, total, G, c, mode, tid0;
    LAS int* tab; LAS int* desc;
    __device__ __forceinline__ bool next(int i, g8::Unit& u) const {
        const int ip = i / NTG, q = i - ip * NTG;
        const long L = (long)ip * G + c; if (L >= total || ip >= TAB_SLOTS) return false;
        const int d = desc[ip]; const int e = d >> 12, pn = (d & 15) * NTG + q;
        u.pm = (d >> 4) & 255; u.pn = pn; u.aux = ip; u.A = Abase; u.B = Bbase + (size_t)e * Bstride + (size_t)pn * 256 * K * 2; return true;
    }
    __device__ __forceinline__ void aoff(const g8::Unit& u, int tid, unsigned (&o)[2][2]) const {
#pragma unroll
        for (int i = 0; i < 2; ++i) { int R, C; g8::stage_rc(tid * 16 + i * 8192, R, C);
#pragma unroll
            for (int h = 0; h < 2; ++h) { int s = tab[u.aux * 256 + h * 128 + R]; s = s < 0 ? 0 : s; const int row = mode ? s : (s < TK ? (s >> 3) : s - TK);
                o[h][i] = (unsigned)(row * K + C) * 2u; } }
    }
};
__device__ __forceinline__ void moe_setup(const Ctx& c, MoeOrder& S, const int* cnt, int NT, int NTG) {
    LAS int* pref = (LAS int*)(c.lds + LDS_PREF); LAS int* desc = (LAS int*)(c.lds + LDS_DESC); LAS int* tab = (LAS int*)(c.lds + LDS_TAB);
    const int* list = (const int*)(c.ws + WS_LIST);
    if (c.tid < 64) { int nb[3]; int loc = 0;
#pragma unroll
        for (int q = 0; q < 3; ++q) { const int e = c.tid * 3 + q; int n = 0; if (e < NE) n = cnt[e * 32]; else if (e == NE) n = T; nb[q] = (n + 255) >> 8; loc += nb[q]; }
        int inc = loc;
#pragma unroll
        for (int o = 1; o < 64; o <<= 1) { const int v = __shfl_up(inc, o); if (c.tid >= o) inc += v; }
        int acc = inc - loc;
#pragma unroll
        for (int q = 0; q < 3; ++q) { const int e = c.tid * 3 + q; if (e <= NE1) pref[e] = acc; acc += nb[q]; } }
    __syncthreads();
    const int NG = NT / NTG; const int total = pref[NE1] * NG;
    LAS float* gtab = (LAS float*)(c.lds + LDS_GTAB); const float* gate = (const float*)(c.ws + WS_GATE);
    S.NT = NT; S.NTG = NTG; S.total = total; S.G = c.G; S.c = c.bid; S.tab = tab; S.desc = desc;
    {
        int sv[TAB_SLOTS / 2];
#pragma unroll
        for (int k = 0; k < TAB_SLOTS / 2; ++k) { const int i = (c.tid >> 8) + 2 * k; sv[k] = -2;
            const long L = (long)i * c.G + c.bid;
            if (L < total) {
                int wgid = (int)L; { const int q = total / 8, r = total % 8, xcd = wgid % 8, off = wgid / 8; wgid = (xcd < r ? xcd * (q + 1) : r * (q + 1) + (xcd - r) * q) + off; }
                const int rbg = wgid / NG, pn = wgid % NG;
                int lo = 0, hi = NE1;
                while (hi - lo > 1) { const int mid = (lo + hi) >> 1; if (pref[mid] <= rbg) lo = mid; else hi = mid; }
                const int e = lo, rb = rbg - pref[e], n = e < NE ? cnt[e * 32] : T;
                if ((c.tid & 255) == 0) desc[i] = (e << 12) | (rb << 4) | pn;
                const int r = rb * 256 + (c.tid & 255); sv[k] = -1; if (r < n) sv[k] = (e < NE) ? list[(size_t)e * LISTCAP + r] : TK + r; } }
#pragma unroll
        for (int k = 0; k < TAB_SLOTS / 2; ++k) { const int i = (c.tid >> 8) + 2 * k; if (sv[k] != -2) { tab[i * 256 + (c.tid & 255)] = sv[k]; if (S.mode) gtab[i * 256 + (c.tid & 255)] = sv[k] >= 0 ? gate[sv[k]] : 0.f; } }
    }
    __syncthreads();
}
struct EpiMoeGU {
    static constexpr bool PERM = true;
    bf16_t* H; LAS int* tab;
    __device__ __forceinline__ void init(f32x4 (&acc)[2][2][4][2], const g8::Unit&, int, int) const {
#pragma unroll
        for (int a = 0; a < 2; ++a)
#pragma unroll
            for (int b = 0; b < 2; ++b)
#pragma unroll
                for (int m = 0; m < 4; ++m)
#pragma unroll
                    for (int n = 0; n < 2; ++n) acc[a][b][m][n] = (f32x4){0.f, 0.f, 0.f, 0.f}; }
    __device__ __forceinline__ void operator()(const f32x4 (&acc)[2][2][4][2], const g8::Unit& u, int wr, int wc, int fr, int fq) const {
#pragma unroll
        for (int ai = 0; ai < 2; ++ai)
#pragma unroll
            for (int m = 0; m < 4; ++m) { const int r = ai * 128 + wr * 64 + m * 16 + fr; const int s = tab[u.aux * 256 + r];
                if (s >= 0) { u32x4 w;
#pragma unroll
                    for (int n = 0; n < 2; ++n) { const f32x4 g = acc[ai][0][m][n], up = acc[ai][1][m][n];
                        const f32x4 hv = silu4(g) * up; w[2 * n] = pk2(hv[0], hv[1]); w[2 * n + 1] = pk2(hv[2], hv[3]); }
                    *(u32x4*)(H + (size_t)s * ED + u.pn * 128 + wc * 32 + fq * 8) = w; } }
    }
};
struct EpiMoeDN {
    static constexpr bool PERM = true;
    unsigned char* Y; LAS float* gtab; LAS int* tab;
    __device__ __forceinline__ void init(f32x4 (&acc)[2][2][4][2], const g8::Unit&, int, int) const {
#pragma unroll
        for (int a = 0; a < 2; ++a)
#pragma unroll
            for (int b = 0; b < 2; ++b)
#pragma unroll
                for (int m = 0; m < 4; ++m)
#pragma unroll
                    for (int n = 0; n < 2; ++n) acc[a][b][m][n] = (f32x4){0.f, 0.f, 0.f, 0.f}; }
    __device__ __forceinline__ void operator()(const f32x4 (&acc)[2][2][4][2], const g8::Unit& u, int wr, int wc, int fr, int fq) const {
#pragma unroll
        for (int ai = 0; ai < 2; ++ai)
#pragma unroll
            for (int m = 0; m < 4; ++m) { const int r = ai * 128 + wr * 64 + m * 16 + fr; const int s = tab[u.aux * 256 + r];
                if (s >= TK) {
#pragma unroll
                    for (int bj = 0; bj < 2; ++bj) { u32x4 w;
#pragma unroll
                        for (int n = 0; n < 2; ++n) { const f32x4 a = acc[ai][bj][m][n]; w[2 * n] = pk2(a[0], a[1]); w[2 * n + 1] = pk2(a[2], a[3]); }
                        *(u32x4*)((bf16_t*)(Y + (size_t)TK * D) + (size_t)(s - TK) * D + u.pn * 256 + bj * 128 + wc * 32 + fq * 8) = w; }
                } else if (s >= 0) { const float gt = gtab[u.aux * 256 + r] * 64.f;
#pragma unroll
                    for (int bj = 0; bj < 2; ++bj) { u32x2 w;
#pragma unroll
                        for (int n = 0; n < 2; ++n) { f32x4 a = acc[ai][bj][m][n] * gt;
#pragma unroll
                            for (int e = 0; e < 4; ++e) a[e] = fminf(fmaxf(a[e], -448.f), 448.f);
                            unsigned pw = 0u; pw = __builtin_amdgcn_cvt_pk_fp8_f32(a[0], a[1], pw, false); pw = __builtin_amdgcn_cvt_pk_fp8_f32(a[2], a[3], pw, true); w[n] = pw; }
                        *(u32x2*)(Y + (size_t)s * D + u.pn * 256 + bj * 128 + wc * 32 + fq * 8) = w; } } }
    }
};
__device__ __forceinline__ void phase_moe_gu(const Ctx& c, int L) {
    MoeOrder S; S.Abase = (const char*)(c.ws + WS_XB); S.Bbase = (const char*)(c.ws + WS_WGU) + (size_t)L * NE1 * 512 * D * 2; S.Bstride = (size_t)512 * D * 2; S.K = D; S.mode = 0; S.tid0 = c.tid;
    moe_setup(c, S, (const int*)(c.ws + CTL_CNT) + L * NE * 32, 2, 1);
    EpiMoeGU E{(bf16_t*)(c.ws + WS_HID), S.tab};
    g8::gemm_phase<EpiMoeGU, MoeOrder>(c.lds + LDS_STAGE, D, S, E);
}
__device__ __forceinline__ void phase_moe_dn(const Ctx& c, int L) {
    MoeOrder S; S.Abase = (const char*)(c.ws + WS_HID); S.Bbase = (const char*)(c.ws + WS_WDN) + (size_t)L * NE1 * D * ED * 2; S.Bstride = (size_t)D * ED * 2; S.K = ED; S.mode = 1; S.tid0 = c.tid;
    moe_setup(c, S, (const int*)(c.ws + CTL_CNT) + L * NE * 32, 4, 2);
    EpiMoeDN E{(unsigned char*)(c.ws + WS_U1), (LAS float*)(c.lds + LDS_GTAB), S.tab};
    g8::gemm_phase<EpiMoeDN, MoeOrder>(c.lds + LDS_STAGE, ED, S, E);
}

constexpr int PH_PER_LAYER = 9;
constexpr int N_PHASES = 1 + 4 * PH_PER_LAYER;

__global__ void __launch_bounds__(NTHREADS, 2) fwd_kernel(Params p) {
    extern __shared__ __attribute__((aligned(16))) unsigned char lds_raw[];
    LAS unsigned char* const lds0 = (LAS unsigned char*)lds_raw;
    const int wave_id = __builtin_amdgcn_readfirstlane((int)threadIdx.x >> 6);
    volatile LAS unsigned* misc = (volatile LAS unsigned*)(lds0 + LDS_MISC);
    if (threadIdx.x < 4) misc[threadIdx.x] = 0u;
    __syncthreads();
    const int lo = p.ph_lo, hi = p.ph_hi;
    XcdBarrier bar; bar.bar = (unsigned*)(p.ws + WS_CTL); bar.x = 0; bar.st = misc;
    if (hi - lo > 1) bar = xcd_barrier_post((unsigned*)(p.ws + WS_CTL), misc);
#define MKCTX() Ctx c; { int wv_ = wave_id; asm volatile("" : "+s"(wv_)); int tid_ = wv_ * 64 + (int)__builtin_amdgcn_mbcnt_hi(~0u, __builtin_amdgcn_mbcnt_lo(~0u, 0u)); asm volatile("" : "+v"(tid_)); int bid_ = blockIdx.x; asm volatile("" : "+s"(bid_)); unsigned long long ws_ = (unsigned long long)p.ws; asm volatile("" : "+s"(ws_)); \
        c.in = p.in; c.out = (float*)p.out; c.ws = (unsigned char*)(GAS unsigned char*)ws_; c.lds = lds0; c.tid = tid_; c.lane = tid_ & 63; c.wid = __builtin_amdgcn_readfirstlane(tid_ >> 6); c.bid = bid_; c.G = gridDim.x; \
        c.gtid = c.bid * NTHREADS + c.tid; c.gthreads = c.G * NTHREADS; c.gw = c.bid * 8 + c.wid; c.nwaves = c.G * 8; } unsigned char* const ws = c.ws; (void)ws
    int id = 0;
#ifndef PMASK
#define PMASK 0xffffffffu
#endif
#ifndef DUPMASK
#define DUPMASK 0u
#endif
#define PHASE(k, body) do { if (((PMASK >> (k)) & 1u) && lo <= id && id < hi) { MKCTX(); body; if ((DUPMASK >> (k)) & 1u) { body; } if (id + 1 < hi) xcd_barrier(bar, c.tid == 0); } ++id; } while (0)
    PHASE(0, phase_convert(c));
#pragma unroll 1
    for (int L = 0; L < 4; ++L) {
        const int j = L >> 1; const bool cd = (L & 1);
        if (cd) {
            PHASE(1, phase_cd_inproj(c, j));
        } else {
            PHASE(2, phase_ab_inproj(c, j));
        }
        if (!cd) { PHASE(3, phase_ab_p1(c)); PHASE(4, phase_ab_p2(c, j)); PHASE(16, phase_ab_p3(c)); }
        else     { PHASE(5, phase_cd_p1(c, j)); PHASE(15, phase_cd_scan2(c)); id += 1; }
        {
            const size_t Woff = cd ? WS_WCDOUT + (size_t)j * D * CD_OUT * 2 : WS_WABOUT + (size_t)j * D * AB_OUT * 2;
            const int K = cd ? CD_OUT : AB_OUT; const float* bias = cd ? (const float*)p.in[18] + (size_t)j * D : (const float*)p.in[5] + (size_t)j * D;
            PHASE(8, phase_dense(c, (const bf16_t*)(ws + WS_YCAT), (const bf16_t*)(ws + Woff), T, D, K, (bf16_t*)(ws + WS_HB), D, bias));
        }
        PHASE(9, phase_ln_route(c, L));
        PHASE(12, phase_moe_gu(c, L));
        PHASE(13, phase_moe_dn(c, L));
        PHASE(14, phase_ln_moe(c, (const float*)p.in[29] + (size_t)L * D, (const float*)p.in[30] + (size_t)L * D, L == 3 ? (float*)p.out : (float*)nullptr));
    }
#undef PHASE
}

extern "C" void kernel_launch(void* const* d_in, const int* in_sizes, int n_in, void* d_out, int out_size, void* d_ws, size_t ws_size, hipStream_t stream) {
    static int grid = 0;
    if (grid == 0) {
        if (n_in != 31 || out_size != T * D || ws_size < WS_END) { fprintf(stderr, "kernel_launch: unexpected shapes (n_in %d out %d ws %zu need %zu)\n", n_in, out_size, ws_size, (size_t)WS_END); grid = -1; return; }
        int dev = 0, cus = 0, per_cu = 0;
        if (hipGetDevice(&dev) != hipSuccess || hipDeviceGetAttribute(&cus, hipDeviceAttributeMultiprocessorCount, dev) != hipSuccess) { grid = -1; return; }
        if (hipFuncSetAttribute((const void*)fwd_kernel, hipFuncAttributeMaxDynamicSharedMemorySize, LDS_BYTES) != hipSuccess) { fprintf(stderr, "kernel_launch: hipFuncSetAttribute failed\n"); grid = -1; return; }
        if (hipOccupancyMaxActiveBlocksPerMultiprocessor(&per_cu, (const void*)fwd_kernel, NTHREADS, LDS_BYTES) != hipSuccess || per_cu < 1) fprintf(stderr, "kernel_launch: occupancy query says %d\n", per_cu);
        (void)hipGetLastError();
        grid = cus;
    }
    if (grid < 0) return;
    (void)hipMemsetAsync((char*)d_ws + WS_CTL, 0, CTL_BYTES, stream);
    Params p{};
    for (int i = 0; i < 31; ++i) p.in[i] = (const GAS float*)d_in[i];
    p.out = (GAS float*)d_out; p.ws = (GAS unsigned char*)d_ws;
#if N_LAUNCH_MODE == 1
    p.ph_lo = 0; p.ph_hi = N_PHASES;
    hipLaunchKernelGGL(fwd_kernel, dim3(grid), dim3(NTHREADS), LDS_BYTES, stream, p);
#else
    for (int i = 0; i < N_PHASES; ++i) { p.ph_lo = i; p.ph_hi = i + 1; hipLaunchKernelGGL(fwd_kernel, dim3(grid), dim3(NTHREADS), LDS_BYTES, stream, p); }
#endif
}
```

```cpp
#include <hip/hip_runtime.h>
#include <cstdio>
#include <cstdint>

#define LAS __attribute__((address_space(3)))
typedef unsigned short bf16_t;
typedef short bf16x8 __attribute__((ext_vector_type(8)));
typedef float f32x4 __attribute__((ext_vector_type(4)));
typedef float f32x2 __attribute__((ext_vector_type(2)));
typedef unsigned u32x4 __attribute__((ext_vector_type(4)));
typedef unsigned u32x2 __attribute__((ext_vector_type(2)));

constexpr int T = 16384, D = 1024, SEQ = 8192;
constexpr int AB_IN = 4352, AB_OUT = 2048, CD_IN = 4608, CD_OUT = 2304;
constexpr int NE = 128, NE1 = 129, TOPK = 8, ED = 256;
constexpr int TK = T * TOPK;
constexpr int NSLOT = TK + T;
constexpr int LISTCAP = 16384;
constexpr float ALPHA = 1.681792830507429f;
constexpr float LN_EPS = 1e-5f;

#ifndef N_LAUNCH_MODE
#define N_LAUNCH_MODE 1
#endif

constexpr size_t al256(size_t x) { return (x + 255) & ~(size_t)255; }
constexpr size_t WS_CTL    = 0;
constexpr size_t CTL_BYTES = 131072;
constexpr size_t CTL_CNT   = 65536;
constexpr size_t WS_WABIN  = CTL_BYTES;
constexpr size_t WS_WABOUT = WS_WABIN  + al256((size_t)2 * AB_IN * D * 2);
constexpr size_t WS_WCDIN  = WS_WABOUT + al256((size_t)2 * D * AB_OUT * 2);
constexpr size_t WS_WCDOUT = WS_WCDIN  + al256((size_t)2 * CD_IN * D * 2);
constexpr size_t WS_WRT    = WS_WCDOUT + al256((size_t)2 * D * CD_OUT * 2);
constexpr size_t WS_WGU    = WS_WRT    + al256((size_t)4 * 256 * D * 2);
constexpr size_t WS_WDN    = WS_WGU    + al256((size_t)4 * NE1 * 512 * D * 2);
constexpr size_t WS_X      = WS_WDN    + al256((size_t)4 * NE1 * D * ED * 2);
constexpr size_t WS_HB     = WS_X;
constexpr size_t WS_XB     = WS_X      + al256((size_t)T * D * 4);
constexpr size_t WS_U1     = WS_XB     + al256((size_t)T * D * 2);
constexpr size_t U1_BYTES  = al256((size_t)NSLOT * D * 2) > al256((size_t)T * CD_IN * 4) ? al256((size_t)NSLOT * D * 2) : al256((size_t)T * CD_IN * 4);
constexpr size_t WS_U2     = WS_U1     + U1_BYTES;
constexpr size_t U2_BYTES  = al256((size_t)T * 1280 * 4 * 3);
constexpr size_t WS_YCAT   = WS_U2     + U2_BYTES;
constexpr size_t WS_H      = WS_YCAT   + al256((size_t)T * CD_OUT * 2);
constexpr size_t WS_ZR     = WS_H      + al256((size_t)T * D * 4);
constexpr size_t WS_HID    = WS_ZR     + al256((size_t)T * 256 * 4);
constexpr size_t WS_LIST   = WS_HID    + al256((size_t)NSLOT * ED * 2);
constexpr size_t WS_GATE   = WS_LIST   + al256((size_t)NE * LISTCAP * 4);
constexpr size_t WS_ROPEA  = WS_GATE   + al256((size_t)NSLOT * 4);
constexpr size_t WS_ROPER  = WS_ROPEA  + al256((size_t)SEQ * 32 * 8);
constexpr size_t WS_BIASP  = WS_ROPER  + al256((size_t)SEQ * 64 * 8);
constexpr size_t WS_WLRU   = WS_BIASP  + al256((size_t)2 * AB_IN * 4);
constexpr size_t WS_SPL    = WS_WLRU   + al256((size_t)2 * 5 * 2 * 65536 * 2);
constexpr size_t WS_END    = WS_SPL    + al256((size_t)2 * 1280 * 4);
constexpr size_t CD_GU = WS_U1, CD_GVT = WS_U1 + 32 * (1024 * 1024), CD_GG = WS_U1 + 64 * (1024 * 1024), CD_XR = WS_U1 + 104 * (1024 * 1024), CD_STATS = WS_U1 + 144 * (1024 * 1024);
constexpr size_t MB = 1024 * 1024;
constexpr size_t AB_QB = WS_U1, AB_KB = WS_U1 + 32 * MB, AB_VT = WS_U1 + 36 * MB, AB_RQB = WS_U1 + 40 * MB, AB_RKB = WS_U1 + 56 * MB, AB_RKDT = WS_U1 + 72 * MB,
                 AB_RVT = WS_U1 + 88 * MB, AB_RGB = WS_U1 + 120 * MB, AB_KV = WS_U1 + 152 * MB  , AB_SPREV = WS_U1 + 216 * MB  ;
static_assert(AB_SPREV + 32 * MB <= WS_U1 + U1_BYTES, "U1 map");

__device__ __forceinline__ float bf2f(bf16_t b) { return __uint_as_float(((unsigned)b) << 16); }
__device__ __forceinline__ unsigned pk2(float lo, float hi) { unsigned r; asm("v_cvt_pk_bf16_f32 %0, %1, %2" : "=v"(r) : "v"(lo), "v"(hi)); return r; }
__device__ __forceinline__ bf16_t f2bf(float f) { return (bf16_t)(pk2(f, f) & 0xffffu); }
__device__ __forceinline__ float wave_sum(float v) {
#pragma unroll
    for (int o = 32; o; o >>= 1) v += __shfl_xor(v, o);
    return v; }
__device__ __forceinline__ float wave_max(float v) {
#pragma unroll
    for (int o = 32; o; o >>= 1) v = fmaxf(v, __shfl_xor(v, o));
    return v; }
__device__ __forceinline__ float gelu_tanh(float x) { const float u = 0.7978845608028654f * (x + 0.044715f * x * x * x); return 0.5f * x * (1.f + tanhf(u)); }
__device__ __forceinline__ float sigmoidf_(float x) { return __builtin_amdgcn_rcpf(1.f + __expf(-x)); }
__device__ __forceinline__ float siluf_(float x) { return x * __builtin_amdgcn_rcpf(1.f + __expf(-x)); }
__device__ __forceinline__ f32x4 silu4(const f32x4 x) { const f32x4 t = x * (-1.4426950408889634f); f32x4 d;
#pragma unroll
    for (int e = 0; e < 4; ++e) d[e] = __builtin_amdgcn_exp2f(t[e]);
    d = d + 1.f;
#pragma unroll
    for (int e = 0; e < 4; ++e) d[e] = __builtin_amdgcn_rcpf(d[e]);
    return x * d; }
__device__ __forceinline__ f32x4 gelu4(const f32x4 x) {
    const f32x4 t = x * ((x * x) * (-0.10294323886f) + (-2.30220819813f)); f32x4 d;
#pragma unroll
    for (int e = 0; e < 4; ++e) d[e] = __builtin_amdgcn_exp2f(t[e]);
    d = d + 1.f;
#pragma unroll
    for (int e = 0; e < 4; ++e) d[e] = __builtin_amdgcn_rcpf(d[e]);
    return x * d; }

#define XB_TMO      128
#define XB_XCNT(j)  (256  + 64 * (j))
#define XB_XSUB(j)  (1280 + 64 * (j))
#define XB_XGEN(j)  (2304 + 64 * (j))
#define XB_TOP      3328
#define XB_TOPGEN   3392
#define XCD_BAR_WORDS 3456
#define XB_SPIN_CAP (1u << 22)

__device__ __forceinline__ unsigned xb_ld(unsigned* p)              { return __hip_atomic_load(p, __ATOMIC_RELAXED, __HIP_MEMORY_SCOPE_AGENT); }
__device__ __forceinline__ unsigned xb_add(unsigned* p, unsigned v) { return __hip_atomic_fetch_add(p, v, __ATOMIC_RELAXED, __HIP_MEMORY_SCOPE_AGENT); }
__device__ __forceinline__ unsigned xb_xcc_id() { return (unsigned)__builtin_amdgcn_s_getreg((3 << 11) | 20) & 0xFu; }
#define XB_SPIN(cond, bar) do { unsigned _sp = 0; while (cond) { __builtin_amdgcn_s_sleep(1); \
    if ((++_sp & 255u) == 0u) { if (xb_ld(&(bar)[XB_TMO])) break; if (_sp > XB_SPIN_CAP) { atomicAdd(&(bar)[XB_TMO], 1u); break; } } } } while (0)

struct XcdBarrier { unsigned* bar; unsigned x; volatile LAS unsigned* st; };

__device__ __forceinline__ XcdBarrier xcd_barrier_post(unsigned* bar, volatile LAS unsigned* st) {
    XcdBarrier b; b.bar = bar; b.x = xb_xcc_id(); b.st = st;
    if (threadIdx.x == 0) (void)xb_add(&bar[XB_XCNT(b.x)], 1u);
    return b;
}
__device__ __forceinline__ void xcd_barrier_complete(unsigned* bar, unsigned x, unsigned& nloc, unsigned& nx) {
    const unsigned G = gridDim.x * gridDim.y * gridDim.z;
    unsigned sum, cnt, mine, sp = 0u;
    for (;;) {
        sum = 0u; cnt = 0u; mine = 0u;
#pragma unroll
        for (unsigned j = 0; j < 16; ++j) { const unsigned c = xb_ld(&bar[XB_XCNT(j)]); sum += c; cnt += (c > 0u) ? 1u : 0u; mine = (j == x) ? c : mine; }
        if (sum == G) break;
        __builtin_amdgcn_s_sleep(1);
        if ((++sp & 255u) == 0u) { if (xb_ld(&bar[XB_TMO])) break; if (sp > XB_SPIN_CAP) { atomicAdd(&bar[XB_TMO], 1u); break; } }
    }
    nloc = mine > 0u ? mine : 1u; nx = cnt > 0u ? cnt : 1u;
}
__device__ __forceinline__ void xcd_barrier(const XcdBarrier& b, const bool leader  ) {
    asm volatile("s_waitcnt vmcnt(0)" ::: "memory");
    __syncthreads();
    if (leader) {
        unsigned* bar = b.bar;
        __builtin_amdgcn_s_waitcnt(0);
        unsigned nloc = b.st[0], nx = b.st[1];
        if (nloc == 0u) { xcd_barrier_complete(bar, b.x, nloc, nx); b.st[0] = nloc; b.st[1] = nx; }
        const unsigned old = xb_add(&bar[XB_XSUB(b.x)], 1u);
        const unsigned gen = old / nloc;
        if (old + 1u == (gen + 1u) * nloc) {
            __builtin_amdgcn_fence(__ATOMIC_RELEASE, "agent");
            asm volatile("s_waitcnt vmcnt(0)" ::: "memory");
            const unsigned og = xb_add(&bar[XB_TOP], 1u);
            const unsigned tg = og / nx;
            if (og + 1u == (tg + 1u) * nx) xb_add(&bar[XB_TOPGEN], 1u);
            else XB_SPIN(xb_ld(&bar[XB_TOPGEN]) == tg, bar);
            __builtin_amdgcn_fence(__ATOMIC_ACQUIRE, "agent");
            xb_add(&bar[XB_XGEN(b.x)], 1u);
            asm volatile("s_waitcnt vmcnt(0)" ::: "memory");
        } else {
            XB_SPIN(xb_ld(&bar[XB_XGEN(b.x)]) == gen, bar);
            __builtin_amdgcn_fence(__ATOMIC_ACQUIRE, "agent");
            asm volatile("s_waitcnt vmcnt(0)" ::: "memory");
        }
    }
    __syncthreads();
}

namespace g8 {
constexpr int BM = 256, BK = 64, HALF = 128, HTB = HALF * BK * 2, STAGE_BYTES = 8 * HTB, NXCD = 8, WGM = 8;
__device__ __forceinline__ int lds_byte(int r, int c) { const int st = (r >> 4) * 2 + (c >> 5), rr = r & 15, cc = c & 31, ob = rr * 64 + cc * 2; return st * 1024 + (ob ^ (((ob >> 9) & 1) << 5)); }
__device__ __forceinline__ void stage_rc(int b, int& R, int& C) { const int st = b / 1024, sb = b % 1024, swz = sb ^ (((sb >> 9) & 1) << 5); R = (st >> 1) * 16 + swz / 64; C = (st & 1) * 32 + (swz % 64) / 2; }
__device__ __forceinline__ int perm32(int rho) { const int n = rho >> 4, i = rho & 15; return 8 * (i >> 2) + 4 * n + (i & 3); }

struct Unit { const char* A; const char* B; int pm, pn, aux; };

struct DenseOrder {
    const char* A; const char* Bt; int nM, nN, nwg, G, c, K, tid0;
    __device__ void init(const void* A_, const void* Bt_, int M, int N, int K_, int G_, int c_) { A = (const char*)A_; Bt = (const char*)Bt_; nM = M / BM; nN = N / BM; nwg = nM * nN; G = G_; c = c_; K = K_; }
    __device__ __forceinline__ bool next(int i, Unit& u) const {
        const long L = (long)i * G + c; if (L >= nwg) return false;
        int wgid = (int)L; { const int q = nwg / NXCD, r = nwg % NXCD, xcd = wgid % NXCD, off = wgid / NXCD; wgid = (xcd < r ? xcd * (q + 1) : r * (q + 1) + (xcd - r) * q) + off; }
        const int nig = WGM * nN, gid = wgid / nig, fm = gid * WGM, gsz = (nM - fm) < WGM ? (nM - fm) : WGM;
        u.pm = fm + ((wgid % nig) % gsz); u.pn = (wgid % nig) / gsz; u.aux = 0;
        u.A = A + (size_t)u.pm * BM * K * 2; u.B = Bt + (size_t)u.pn * BM * K * 2; return true;
    }
    __device__ __forceinline__ void aoff(const Unit&, int tid, unsigned (&o)[2][2]) const {
#pragma unroll
        for (int i = 0; i < 2; ++i) { int R, C; stage_rc(tid * 16 + i * 8192, R, C);
            o[0][i] = (unsigned)(R * K + C) * 2u; o[1][i] = (unsigned)((R + HALF) * K + C) * 2u; }
    }
};

__device__ __forceinline__ unsigned cvt_pk_bf16(float lo, float hi) { unsigned r; asm volatile("v_cvt_pk_bf16_f32 %0, %1, %2" : "=v"(r) : "v"(lo), "v"(hi)); return r; }

struct EpiF32 {
    static constexpr bool PERM = false;
    float* C; int ldc; const float* bias;
    __device__ __forceinline__ void init(f32x4 (&acc)[2][2][4][2], const Unit&, int, int) const {
#pragma unroll
        for (int a = 0; a < 2; ++a)
#pragma unroll
            for (int b = 0; b < 2; ++b)
#pragma unroll
                for (int m = 0; m < 4; ++m)
#pragma unroll
                    for (int n = 0; n < 2; ++n) acc[a][b][m][n] = (f32x4){0.f, 0.f, 0.f, 0.f}; }
    __device__ __forceinline__ void operator()(const f32x4 (&acc)[2][2][4][2], const Unit& u, int wr, int wc, int fr, int fq) const {
        const int row0 = u.pm * BM + wr * 64 + fr, col0 = u.pn * BM + wc * 32 + 4 * fq;
        f32x4 bv[2][2];
#pragma unroll
        for (int bj = 0; bj < 2; ++bj)
#pragma unroll
            for (int n = 0; n < 2; ++n) bv[bj][n] = bias ? *(const f32x4*)(bias + col0 + bj * HALF + n * 16) : (f32x4){0.f, 0.f, 0.f, 0.f};
#pragma unroll
        for (int ai = 0; ai < 2; ++ai)
#pragma unroll
            for (int m = 0; m < 4; ++m) { float* rowp = C + (size_t)(row0 + ai * HALF + m * 16) * ldc + col0;
#pragma unroll
                for (int bj = 0; bj < 2; ++bj)
#pragma unroll
                    for (int n = 0; n < 2; ++n) *(f32x4*)(rowp + bj * HALF + n * 16) = acc[ai][bj][m][n] + bv[bj][n]; }
    }
};

struct EpiBf16 {
    static constexpr bool PERM = true;
    bf16_t* O; int ldc; const float* bias;
    __device__ __forceinline__ void init(f32x4 (&acc)[2][2][4][2], const Unit&, int, int) const {
#pragma unroll
        for (int a = 0; a < 2; ++a)
#pragma unroll
            for (int b = 0; b < 2; ++b)
#pragma unroll
                for (int m = 0; m < 4; ++m)
#pragma unroll
                    for (int n = 0; n < 2; ++n) acc[a][b][m][n] = (f32x4){0.f, 0.f, 0.f, 0.f}; }
    __device__ __forceinline__ void operator()(const f32x4 (&acc)[2][2][4][2], const Unit& u, int wr, int wc, int fr, int fq) const {
        const int row0 = u.pm * BM + wr * 64 + fr, col0 = u.pn * BM + wc * 32 + 8 * fq;
        f32x4 bv[2][2];
#pragma unroll
        for (int bj = 0; bj < 2; ++bj)
#pragma unroll
            for (int n = 0; n < 2; ++n) bv[bj][n] = *(const f32x4*)(bias + col0 + bj * HALF + 4 * n);
#pragma unroll
        for (int ai = 0; ai < 2; ++ai)
#pragma unroll
            for (int m = 0; m < 4; ++m) { bf16_t* rowp = O + (size_t)(row0 + ai * HALF + m * 16) * ldc + col0;
#pragma unroll
                for (int bj = 0; bj < 2; ++bj) { const f32x4 v0 = acc[ai][bj][m][0] + bv[bj][0], v1 = acc[ai][bj][m][1] + bv[bj][1];
                    u32x4 w; w[0] = cvt_pk_bf16(v0[0], v0[1]); w[1] = cvt_pk_bf16(v0[2], v0[3]); w[2] = cvt_pk_bf16(v1[0], v1[1]); w[3] = cvt_pk_bf16(v1[2], v1[3]);
                    *(u32x4*)(rowp + bj * HALF) = w; } }
    }
};

template <class Epi, class Sched>
__device__ __forceinline__ void gemm_phase(LAS unsigned char* lds, const int K, const Sched& S, const Epi& E) {
    int tid_ = S.tid0; asm volatile("" : "+v"(tid_));
    const int tid = tid_, wid = __builtin_amdgcn_readfirstlane(tid >> 6), lane = tid & 63, wr = wid >> 2, wc = wid & 3, fr = lane & 15, fq = lane >> 4;
    const int nt = K / BK;
    unsigned voffB[2];
#pragma unroll
    for (int i = 0; i < 2; ++i) { int R, C; stage_rc(tid * 16 + i * 8192, R, C); const int Rb = Epi::PERM ? ((R & ~31) + perm32(R & 31)) : R;
        voffB[i] = (unsigned)(Rb * K + C) * 2u; }
    const size_t kstep = (size_t)(BK * 2);
    const size_t hstep = (size_t)HALF * K * 2;
    const unsigned ldsw = (unsigned)wid * 1024u;
    const int aoff = lds_byte(wr * 64 + fr, fq * 8), boff = lds_byte(wc * 32 + fr, fq * 8);
#define G8_SA(b, h) (((b) * 2 + (h)) * HTB)
#define G8_SB(b, h) ((4 + (b) * 2 + (h)) * HTB)
#define G8_STAGE(bufoff, gbase, voff) do { _Pragma("unroll") for (int _i = 0; _i < 2; ++_i) \
        __builtin_amdgcn_global_load_lds((const unsigned*)((const char*)(gbase) + (voff)[_i]), (LAS unsigned*)(lds + (bufoff) + ldsw + _i * 8192), 16, 0, 0); } while (0)
#define G8_LDA(dst, b, h) do { _Pragma("unroll") for (int m = 0; m < 4; ++m) _Pragma("unroll") for (int k = 0; k < 2; ++k) dst[m][k] = *(const LAS bf16x8*)(lds + G8_SA(b, h) + aoff + m * 2048 + k * 1024); } while (0)
#define G8_LDB(dst, b, h) do { _Pragma("unroll") for (int n = 0; n < 2; ++n) _Pragma("unroll") for (int k = 0; k < 2; ++k) dst[n][k] = *(const LAS bf16x8*)(lds + G8_SB(b, h) + boff + n * 2048 + k * 1024); } while (0)
#define G8_MMA(ai, bj, At, Bt) do { __builtin_amdgcn_s_setprio(1); _Pragma("unroll") for (int m = 0; m < 4; ++m) _Pragma("unroll") for (int n = 0; n < 2; ++n) _Pragma("unroll") for (int k = 0; k < 2; ++k) \
        acc[ai][bj][m][n] = __builtin_amdgcn_mfma_f32_16x16x32_bf16(Bt[n][k], At[m][k], acc[ai][bj][m][n], 0, 0, 0); __builtin_amdgcn_s_setprio(0); } while (0)
#define G8_WAIT_V(n) asm volatile("s_waitcnt vmcnt(" #n ")" ::: "memory")
#define G8_WAIT_L(n) asm volatile("s_waitcnt lgkmcnt(" #n ")" ::: "memory")
#define G8_BAR __builtin_amdgcn_s_barrier()
#define G8_SCHED __builtin_amdgcn_sched_barrier(0)
    Unit cur, nxt; int ui = 0;
    if (!S.next(0, cur)) return;
    f32x4 acc[2][2][4][2];
    E.init(acc, cur, wc, fq);
    bf16x8 At[4][2], B0[2][2], B1[2][2];
    unsigned oc[2][2];
    S.aoff(cur, tid, oc);
    const char* cA = cur.A; const char* cB = cur.B;
    G8_STAGE(G8_SB(0, 0), cB, voffB); G8_STAGE(G8_SA(0, 0), cA, oc[0]); G8_STAGE(G8_SB(0, 1), cB + hstep, voffB); G8_STAGE(G8_SA(0, 1), cA, oc[1]);
    if (wr == 1) G8_BAR;
    G8_WAIT_V(4); G8_BAR;
    G8_STAGE(G8_SB(1, 0), cB + kstep, voffB); G8_STAGE(G8_SA(1, 0), cA + kstep, oc[0]); G8_STAGE(G8_SB(1, 1), cB + hstep + kstep, voffB);
    G8_WAIT_V(6); G8_BAR;
    for (;;) {
        const bool has_next = S.next(ui + 1, nxt);
        const char* nA = has_next ? nxt.A : cA; const char* nB = has_next ? nxt.B : cB;
#pragma unroll 1
        for (int t = 0; t < nt; t += 2) {
            const bool last = (t == nt - 2);
            const char* a1 = cA + (size_t)(t + 1) * kstep;
            const char* a2 = last ? nA : cA + (size_t)(t + 2) * kstep; const char* b2 = last ? nB : cB + (size_t)(t + 2) * kstep;
            const char* a3 = a2 + kstep; const char* b3 = b2 + kstep;
            G8_LDB(B0, 0, 0); G8_SCHED; G8_LDA(At, 0, 0); G8_STAGE(G8_SA(1, 1), a1, oc[1]);
            if (last && has_next) S.aoff(nxt, tid, oc);
            G8_WAIT_L(8); G8_BAR; G8_WAIT_L(0); G8_MMA(0, 0, At, B0); G8_BAR; G8_SCHED;
            G8_LDB(B1, 0, 1); G8_STAGE(G8_SB(0, 0), b2, voffB);
            G8_BAR; G8_WAIT_L(0); G8_MMA(0, 1, At, B1); G8_BAR;
            G8_LDA(At, 0, 1); G8_STAGE(G8_SA(0, 0), a2, oc[0]);
            G8_BAR; G8_WAIT_L(0); G8_MMA(1, 0, At, B0); G8_BAR; G8_SCHED;
            G8_STAGE(G8_SB(0, 1), b2 + hstep, voffB);
            G8_WAIT_V(6); G8_BAR; G8_MMA(1, 1, At, B1); G8_BAR;
            G8_LDB(B0, 1, 0); G8_SCHED; G8_LDA(At, 1, 0); G8_STAGE(G8_SA(0, 1), a2, oc[1]);
            G8_WAIT_L(8); G8_BAR; G8_WAIT_L(0); G8_MMA(0, 0, At, B0); G8_BAR; G8_SCHED;
            G8_LDB(B1, 1, 1); G8_STAGE(G8_SB(1, 0), b3, voffB);
            G8_BAR; G8_WAIT_L(0); G8_MMA(0, 1, At, B1); G8_BAR;
            G8_LDA(At, 1, 1); G8_STAGE(G8_SA(1, 0), a3, oc[0]);
            G8_BAR; G8_WAIT_L(0); G8_MMA(1, 0, At, B0); G8_BAR; G8_SCHED;
            G8_STAGE(G8_SB(1, 1), b3 + hstep, voffB);
            G8_WAIT_V(6); G8_BAR; G8_MMA(1, 1, At, B1); G8_BAR;
        }
        E(acc, cur, wr, wc, fr, fq);
        if (!has_next) break;
        cur = nxt; cA = nA; cB = nB; ++ui;
        E.init(acc, cur, wc, fq);
    }
    G8_WAIT_V(0);
    if (wr == 0) G8_BAR;
    G8_BAR;
#undef G8_SA
#undef G8_SB
#undef G8_STAGE
#undef G8_LDA
#undef G8_LDB
#undef G8_MMA
#undef G8_WAIT_V
#undef G8_WAIT_L
#undef G8_BAR
#undef G8_SCHED
}
}

constexpr int NTHREADS = 512;
constexpr int LDS_STAGE = 0;
constexpr int LDS_TAB   = g8::STAGE_BYTES;
constexpr int TAB_SLOTS = 6;
constexpr int LDS_GTAB  = LDS_TAB + TAB_SLOTS * 256 * 4;
constexpr int LDS_DESC  = LDS_GTAB + TAB_SLOTS * 256 * 4;
constexpr int LDS_PREF  = LDS_DESC + 64;
constexpr int LDS_MISC  = 147456 - 64;
constexpr int LDS_BYTES = 147456;
static_assert(LDS_MISC % 16 == 0 && LDS_MISC + 64 <= LDS_BYTES && LDS_PREF + 132 * 4 <= LDS_MISC, "LDS map");

#define GAS __attribute__((address_space(1)))
struct Params { const GAS float* in[31]; GAS float* out; GAS unsigned char* ws; int ph_lo, ph_hi; };

struct Ctx {
    const GAS float* const* in; float* out; unsigned char* ws; LAS unsigned char* lds;
    __device__ __forceinline__ const float* inp(int k) const { return (const float*)in[k]; }
    int tid, lane, wid, bid, G, gtid, gthreads, gw, nwaves;
};

__device__ __forceinline__ int ab_phys(int n) {
    if (n < 1024) { const int hd = n >> 6, jj = n & 63; return (hd >> 2) * 256 + (jj >> 5) * 128 + (hd & 3) * 32 + (jj & 31); }
    if (n < 1152) { const int nn = n - 1024, hh = nn >> 6, jj = nn & 63; return 1024 + (jj >> 5) * 128 + hh * 32 + (jj & 31); }
    if (n < 1280) { const int vv = n - 1152; return 1024 + (vv >> 6) * 128 + 64 + (vv & 63); }
    if (n < 2304) { const int base = n < 1792 ? 1280 : 1792, nn = n - base, h = nn >> 7, jj = nn & 127; return base + (h >> 1) * 256 + (jj >> 6) * 128 + (h & 1) * 64 + (jj & 63); }
    return n;
}
template <int TN, class DstFn>
__device__ __forceinline__ void convert_T(const Ctx& c, const float* src, int nmat, int K, int N, DstFn dstfn) {
    LAS float* tile = (LAS float*)(c.lds);
    constexpr int LDT = TN + 1, TPR = TN / 4  , KPI = NTHREADS / TPR  , NI = 64 / KPI, KPT = 64 * TN / NTHREADS  ;
    const int tk = K / 64, tn = N / TN; const long ntiles = (long)nmat * tk * tn;
    f32x4 v[NI];
    auto issue = [&](long tix) { const int m = (int)(tix / (tk * tn)); const int rem = (int)(tix % (tk * tn)); const int kt = rem / tn, nt = rem % tn;
        const float* s = src + (size_t)m * K * N + (size_t)(kt * 64) * N + nt * TN;
#pragma unroll
        for (int i = 0; i < NI; ++i) { const int k = c.tid / TPR + KPI * i, n4 = (c.tid % TPR) * 4; v[i] = __builtin_nontemporal_load((const f32x4*)(s + (size_t)k * N + n4)); } };
    if (c.bid < ntiles) issue(c.bid);
    for (long tix = c.bid; tix < ntiles; tix += c.G) {
        const int m = (int)(tix / (tk * tn)); const int rem = (int)(tix % (tk * tn)); const int kt = rem / tn, nt = rem % tn;
#pragma unroll
        for (int i = 0; i < NI; ++i) { const int k = c.tid / TPR + KPI * i, n4 = (c.tid % TPR) * 4;
            tile[k * LDT + n4 + 0] = v[i][0]; tile[k * LDT + n4 + 1] = v[i][1]; tile[k * LDT + n4 + 2] = v[i][2]; tile[k * LDT + n4 + 3] = v[i][3]; }
        if (tix + c.G < ntiles) issue(tix + c.G);
        __syncthreads();
        { constexpr int TPN = 64 / KPT; const int n = c.tid / TPN, k0 = (c.tid % TPN) * KPT;
          bf16_t* d = dstfn(m, nt * TN + n) + kt * 64 + k0;
#pragma unroll
          for (int q = 0; q < KPT / 8; ++q) { u32x4 w;
#pragma unroll
              for (int e = 0; e < 4; ++e) w[e] = pk2(tile[(k0 + q * 8 + 2 * e) * LDT + n], tile[(k0 + q * 8 + 2 * e + 1) * LDT + n]);
              *(u32x4*)(d + q * 8) = w; } }
        __syncthreads();
    }
}

__device__ __forceinline__ void phase_convert(const Ctx& c) {
    unsigned char* ws = c.ws;
    { const float* x = c.inp(0); bf16_t* xb = (bf16_t*)(ws + WS_XB);
      for (long i = c.gtid; i < (long)T * D / 4; i += c.gthreads) { const f32x4 v = *(const f32x4*)(x + i * 4); u32x2 w; w[0] = pk2(v[0], v[1]); w[1] = pk2(v[2], v[3]); *(u32x2*)(xb + i * 4) = w; } }
    { bf16_t* wrt = (bf16_t*)(ws + WS_WRT); for (long i = c.gtid; i < (long)4 * 128 * D / 8; i += c.gthreads) { const long l = i / (128 * D / 8), r = i % (128 * D / 8); *(u32x4*)(wrt + (size_t)l * 256 * D + (size_t)128 * D + r * 8) = (u32x4){0u, 0u, 0u, 0u}; }
      float* gate = (float*)(ws + WS_GATE); for (int i = c.gtid; i < T; i += c.gthreads) gate[TK + i] = 1.f;
      f32x2* ra = (f32x2*)(ws + WS_ROPEA); f32x2* rr = (f32x2*)(ws + WS_ROPER);
      for (int i = c.gtid; i < SEQ * 96; i += c.gthreads) { const int sidx = i / 96, q = i % 96; const bool isA = q < 32; const int jx = isA ? q : q - 32;
          const float e = isA ? (float)jx * (1.f / 32.f) : (float)jx * (1.f / 63.f); const float ang = (float)sidx * exp2f(-e * 13.287712379549449f); float sn, cs; sincosf(ang, &sn, &cs);
          if (isA) ra[sidx * 32 + jx] = (f32x2){cs, sn}; else rr[sidx * 64 + jx] = (f32x2){cs, sn}; }
      float* bp = (float*)(ws + WS_BIASP); for (int i = c.gtid; i < 2 * AB_IN; i += c.gthreads) { const int m = i / AB_IN, n = i % AB_IN; bp[m * AB_IN + ab_phys(n)] = c.inp(2)[i]; } }
    { bf16_t* d = (bf16_t*)(ws + WS_WABIN);  convert_T<256>(c, c.inp(1), 2, D, AB_IN, [=](int m, int n) { return d + (size_t)m * AB_IN * D + (size_t)ab_phys(n) * D; }); }
    { bf16_t* d = (bf16_t*)(ws + WS_WABOUT); convert_T<256>(c, c.inp(4), 2, AB_OUT, D, [=](int m, int n) { return d + (size_t)m * D * AB_OUT + (size_t)n * AB_OUT; }); }
    { bf16_t* d = (bf16_t*)(ws + WS_WCDIN);  convert_T<256>(c, c.inp(6), 2, D, CD_IN, [=](int m, int n) { return d + (size_t)m * CD_IN * D + (size_t)n * D; }); }
    { bf16_t* d = (bf16_t*)(ws + WS_WCDOUT); convert_T<256>(c, c.inp(17), 2, CD_OUT, D, [=](int m, int n) { return d + (size_t)m * D * CD_OUT + (size_t)n * CD_OUT; }); }
    { bf16_t* d = (bf16_t*)(ws + WS_WRT);    convert_T<128>(c, c.inp(21), 4, D, NE, [=](int m, int n) { return d + (size_t)m * 256 * D + (size_t)n * D; }); }
    { bf16_t* d = (bf16_t*)(ws + WS_WGU);
      convert_T<256>(c, c.inp(23), 4 * NE, D, ED, [=](int m, int n) { return d + (size_t)((m >> 7) * NE1 + (m & 127)) * 512 * D + (size_t)((n >> 7) * 256 + (n & 127)) * D; });
      convert_T<256>(c, c.inp(24), 4 * NE, D, ED, [=](int m, int n) { return d + (size_t)((m >> 7) * NE1 + (m & 127)) * 512 * D + (size_t)((n >> 7) * 256 + 128 + (n & 127)) * D; });
      convert_T<256>(c, c.inp(26), 4, D, ED, [=](int m, int n) { return d + (size_t)(m * NE1 + NE) * 512 * D + (size_t)((n >> 7) * 256 + (n & 127)) * D; });
      convert_T<256>(c, c.inp(27), 4, D, ED, [=](int m, int n) { return d + (size_t)(m * NE1 + NE) * 512 * D + (size_t)((n >> 7) * 256 + 128 + (n & 127)) * D; }); }
    { bf16_t* d = (bf16_t*)(ws + WS_WLRU);
      convert_T<256>(c, c.inp(12), 10, 256, 256, [=](int m, int n) { return d + (size_t)(m * 2 + 0) * 65536 + (size_t)n * 256; });
      convert_T<256>(c, c.inp(14), 10, 256, 256, [=](int m, int n) { return d + (size_t)(m * 2 + 1) * 65536 + (size_t)n * 256; });
      float* spl = (float*)(ws + WS_SPL); for (int i = c.gtid; i < 2 * 1280; i += c.gthreads) spl[i] = log1pf(expf(-c.inp(16)[i])); }
    { bf16_t* d = (bf16_t*)(ws + WS_WDN);
      convert_T<256>(c, c.inp(25), 4 * NE, ED, D, [=](int m, int n) { return d + (size_t)((m >> 7) * NE1 + (m & 127)) * D * ED + (size_t)n * ED; });
      convert_T<256>(c, c.inp(28), 4, ED, D, [=](int m, int n) { return d + (size_t)(m * NE1 + NE) * D * ED + (size_t)n * ED; }); }
}

__device__ __forceinline__ void phase_dense(const Ctx& c, const bf16_t* A, const bf16_t* Bt, int M, int N, int K, bf16_t* C, int ldc, const float* bias) {
    g8::DenseOrder S; S.init(A, Bt, M, N, K, c.G, c.bid); S.tid0 = c.tid;
    g8::EpiBf16 E{C, ldc, bias};
    g8::gemm_phase<g8::EpiBf16, g8::DenseOrder>(c.lds + LDS_STAGE, K, S, E);
}

__device__ __forceinline__ void st_bf16_off(unsigned char* base, unsigned byte_off, float v) { *(bf16_t*)(base + byte_off) = f2bf(v); }
struct EpiABIn {
    static constexpr bool PERM = true;
    LAS bf16_t* biasL; unsigned char* ws;
    __device__ __forceinline__ void init(f32x4 (&acc)[2][2][4][2], const g8::Unit& u, int wc, int fq) const {
        const int colp = u.pn * 256 + wc * 32 + fq * 8;
#pragma unroll
        for (int b = 0; b < 2; ++b)
#pragma unroll
            for (int n = 0; n < 2; ++n) { const u32x2 bw = *(const LAS u32x2*)(biasL + colp + b * 128 + 4 * n);
                const f32x4 bv = (f32x4){__uint_as_float(bw[0] << 16), __uint_as_float(bw[0] & 0xffff0000u), __uint_as_float(bw[1] << 16), __uint_as_float(bw[1] & 0xffff0000u)};
#pragma unroll
                for (int a = 0; a < 2; ++a)
#pragma unroll
                    for (int m = 0; m < 4; ++m) acc[a][b][m][n] = bv; } }
    __device__ __forceinline__ void operator()(const f32x4 (&acc)[2][2][4][2], const g8::Unit& u, int wr, int wc, int fr_, int fq_) const {
        int fr = fr_, fq = fq_; asm volatile("" : "+v"(fr), "+v"(fq));
        const int pn = u.pn; const int colp = pn * 256 + wc * 32 + fq * 8;
        bf16_t* qb = (bf16_t*)(ws + AB_QB); bf16_t* kb = (bf16_t*)(ws + AB_KB); bf16_t* vT = (bf16_t*)(ws + AB_VT); bf16_t* rqb = (bf16_t*)(ws + AB_RQB); bf16_t* rkb = (bf16_t*)(ws + AB_RKB);
        bf16_t* rkdT = (bf16_t*)(ws + AB_RKDT); bf16_t* rvT = (bf16_t*)(ws + AB_RVT); bf16_t* rgb = (bf16_t*)(ws + AB_RGB);
        const float frqA0 = exp2f(-(float)(fq * 8) * (13.287712379549449f / 32.f)) * 0.15915494309189535f;
        const float frqR0 = exp2f(-(float)((wc & 1) * 32 + fq * 8) * (13.287712379549449f / 63.f)) * 0.15915494309189535f;
        constexpr float RA[8] = {1.f, 0.7498942093324559f, 0.5623413251903491f, 0.4216965034285822f, 0.31622776601683794f, 0.23713737056616552f, 0.1778279410038923f, 0.1333521432163324f};
        constexpr float RR[8] = {1.f, 0.8639884494839686f, 0.746476040841712f, 0.6449466771037624f, 0.5572264795507174f, 0.4814372420784346f, 0.4159562163071847f, 0.35938136638046275f};
#pragma unroll
        for (int ai = 0; ai < 2; ++ai)
#pragma unroll
            for (int m = 0; m < 4; ++m) {
                const int t = u.pm * 256 + ai * 128 + wr * 64 + m * 16 + fr, sq = t & (SEQ - 1), b = t >> 13;
                f32x4 x[2][2];
#pragma unroll
                for (int bj = 0; bj < 2; ++bj)
#pragma unroll
                    for (int n = 0; n < 2; ++n) x[bj][n] = acc[ai][bj][m][n];
                if (pn < 4 || (pn == 4 && wc < 2)) {
                    const int j0 = fq * 8; const float sc = pn < 4 ? 0.125f : 1.f;
                    u32x4 w1, w2;
#pragma unroll
                    for (int n = 0; n < 2; ++n) { f32x4 o1, o2;
#pragma unroll
                        for (int e = 0; e < 4; ++e) { const float rev = __builtin_amdgcn_fractf((float)sq * (frqA0 * RA[4 * n + e])); const float cc = __builtin_amdgcn_cosf(rev) * sc, ss = __builtin_amdgcn_sinf(rev) * sc;
                            o1[e] = x[0][n][e] * cc - x[1][n][e] * ss; o2[e] = x[1][n][e] * cc + x[0][n][e] * ss; }
                        w1[2 * n] = pk2(o1[0], o1[1]); w1[2 * n + 1] = pk2(o1[2], o1[3]); w2[2 * n] = pk2(o2[0], o2[1]); w2[2 * n + 1] = pk2(o2[2], o2[3]); }
                    bf16_t* dst = pn < 4 ? qb + (size_t)t * 1024 + (pn * 4 + wc) * 64 + j0 : kb + (size_t)t * 128 + wc * 64 + j0;
                    *(u32x4*)dst = w1; *(u32x4*)(dst + 32) = w2;
                } else if (pn == 4) {
                    const int d0 = (wc - 2) * 32 + fq * 8;
#pragma unroll
                    for (int bj = 0; bj < 2; ++bj)
#pragma unroll
                        for (int n = 0; n < 2; ++n)
#pragma unroll
                            for (int e = 0; e < 4; ++e) st_bf16_off((unsigned char*)vT, (unsigned)((((b * 2 + bj) * 64 + d0 + 4 * n + e) * SEQ + sq) * 2), x[bj][n][e]);
                } else if (pn < 9) {
                    const bool isk = pn >= 7; const int h = ((pn - 5) & 1) * 2 + (wc >> 1), j0 = (wc & 1) * 32 + fq * 8;
                    const float sc = isk ? 0.08838834764831845f : 1.f;
                    const unsigned dToff = (unsigned)((((b * 4 + h) * 128 + j0) * SEQ + sq) * 2);
                    u32x4 w1, w2;
#pragma unroll
                    for (int n = 0; n < 2; ++n) { f32x4 o1, o2;
#pragma unroll
                        for (int e = 0; e < 4; ++e) { const float rev = __builtin_amdgcn_fractf((float)sq * (frqR0 * RR[4 * n + e])); const float cc = __builtin_amdgcn_cosf(rev) * sc, ss = __builtin_amdgcn_sinf(rev) * sc;
                            o1[e] = x[0][n][e] * cc - x[1][n][e] * ss; o2[e] = x[1][n][e] * cc + x[0][n][e] * ss; }
                        w1[2 * n] = pk2(o1[0], o1[1]); w1[2 * n + 1] = pk2(o1[2], o1[3]); w2[2 * n] = pk2(o2[0], o2[1]); w2[2 * n + 1] = pk2(o2[2], o2[3]);
                        if (isk) {
#pragma unroll
                            for (int e = 0; e < 4; ++e) { st_bf16_off((unsigned char*)rkdT, dToff + (unsigned)((4 * n + e) * SEQ * 2), o1[e]); st_bf16_off((unsigned char*)rkdT, dToff + (unsigned)((64 + 4 * n + e) * SEQ * 2), o2[e]); } } }
                    bf16_t* dst = (isk ? rkb : rqb) + (size_t)t * 512 + h * 128 + j0;
                    *(u32x4*)dst = w1; *(u32x4*)(dst + 64) = w2;
                } else if (pn < 13) {
                    const int h = pn - 9;
#pragma unroll
                    for (int bj = 0; bj < 2; ++bj)
#pragma unroll
                        for (int n = 0; n < 2; ++n)
#pragma unroll
                            for (int e = 0; e < 4; ++e) st_bf16_off((unsigned char*)rvT, (unsigned)((((b * 4 + h) * 256 + bj * 128 + wc * 32 + fq * 8 + 4 * n + e) * SEQ + sq) * 2), x[bj][n][e]);
                } else {
#pragma unroll
                    for (int bj = 0; bj < 2; ++bj) { u32x4 w;
#pragma unroll
                        for (int n = 0; n < 2; ++n) { const f32x4 sv = silu4(x[bj][n]); w[2 * n] = pk2(sv[0], sv[1]); w[2 * n + 1] = pk2(sv[2], sv[3]); }
                        *(u32x4*)(rgb + (size_t)t * 1024 + (pn - 13) * 256 + bj * 128 + wc * 32 + fq * 8) = w; }
                }
            }
    }
};
__device__ __forceinline__ void phase_ab_inproj(const Ctx& c, int j) {
    g8::DenseOrder S; S.init(c.ws + WS_XB, c.ws + WS_WABIN + (size_t)j * AB_IN * D * 2, T, AB_IN, D, c.G, c.bid); S.tid0 = c.tid;
    LAS bf16_t* biasL = (LAS bf16_t*)(c.lds + LDS_TAB);
    { const float* bp = (const float*)(c.ws + WS_BIASP) + (size_t)j * AB_IN; for (int i = c.tid; i < AB_IN; i += NTHREADS) biasL[i] = f2bf(bp[i]); }
    __syncthreads();
    EpiABIn E{biasL, c.ws};
    g8::gemm_phase<EpiABIn, g8::DenseOrder>(c.lds + LDS_STAGE, D, S, E);
}

#define MFMA16(a, b, c) __builtin_amdgcn_mfma_f32_16x16x32_bf16((a), (b), (c), 0, 0, 0)
__device__ __forceinline__ bf16x8 pack8(const f32x4& lo, const f32x4& hi) { u32x4 w; w[0] = g8::cvt_pk_bf16(lo[0], lo[1]); w[1] = g8::cvt_pk_bf16(lo[2], lo[3]); w[2] = g8::cvt_pk_bf16(hi[0], hi[1]); w[3] = g8::cvt_pk_bf16(hi[2], hi[3]); return __builtin_bit_cast(bf16x8, w); }
__device__ __forceinline__ bf16x8 cat8(const u32x2& lo, const u32x2& hi) { u32x4 w; w[0] = lo[0]; w[1] = lo[1]; w[2] = hi[0]; w[3] = hi[1]; return __builtin_bit_cast(bf16x8, w); }
template <int ROWS, int RB, int PAD = 32>
__device__ __forceinline__ void tile_g2l(LAS unsigned char* dst, const unsigned char* src, size_t gs, int tid, int zrows = 0) {
    constexpr int CPR = RB / 16, TOTAL = ROWS * CPR;
#pragma unroll 8
    for (int i = tid; i < TOTAL; i += NTHREADS) { const int r = i / CPR, cc = i % CPR; u32x4 v = (u32x4){0u, 0u, 0u, 0u}; if (r >= zrows) v = *(const u32x4*)(src + (size_t)r * gs + cc * 16);
        *(LAS u32x4*)(dst + r * (RB + PAD) + cc * 16) = v; }
}

__device__ __forceinline__ void attn_unit(const Ctx& c, int unit, const float* sinks) {
    const int b = unit >> 7, n = (unit >> 1) & 63, kvh = unit & 1, hd = kvh * 8 + c.wid, lane = c.lane, fr = lane & 15, fq = lane >> 4;
    const bf16_t* qb = (const bf16_t*)(c.ws + AB_QB); const bf16_t* kb = (const bf16_t*)(c.ws + AB_KB); const bf16_t* vT = (const bf16_t*)(c.ws + AB_VT); bf16_t* ycat = (bf16_t*)(c.ws + WS_YCAT);
    LAS unsigned char* Ks = c.lds; LAS unsigned char* Vs = c.lds + 256 * 160;
    const int t0 = b * SEQ + n * 128;
    __syncthreads();
    {
        const unsigned char* src = (const unsigned char*)(kb + (size_t)(t0 - 128) * 128 + kvh * 64);
        constexpr int TOTAL = 256 * 8;
#pragma unroll 4
        for (int i = c.tid; i < TOTAL; i += NTHREADS) { const int r = i >> 3, cc = i & 7; u32x4 v = (u32x4){0u, 0u, 0u, 0u}; if (n > 0 || r >= 128) v = *(const u32x4*)(src + (ptrdiff_t)r * 256 + cc * 16);
            *(LAS u32x4*)(Ks + r * 160 + cc * 16) = v; }
        const unsigned char* vsrc = (const unsigned char*)(vT + (size_t)(b * 2 + kvh) * 64 * SEQ + (n * 128 - 128));
        constexpr int TV = 64 * 32;
#pragma unroll 4
        for (int i = c.tid; i < TV; i += NTHREADS) { const int r = i >> 5, cc = i & 31; u32x4 v = (u32x4){0u, 0u, 0u, 0u}; if (n > 0 || cc >= 16) v = *(const u32x4*)(vsrc + (ptrdiff_t)r * SEQ * 2 + cc * 16);
            *(LAS u32x4*)(Vs + r * 528 + cc * 16) = v; }
    }
    __syncthreads();
    const float sink = sinks[hd];
    bf16x8 qn[2];
#pragma unroll
    for (int ks = 0; ks < 2; ++ks) qn[ks] = *(const bf16x8*)(qb + (size_t)(t0 + fr) * 1024 + hd * 64 + ks * 32 + fq * 8);
    for (int si = 0; si < 8; ++si) {
        const int t = t0 + si * 16 + fr;
        bf16x8 qf[2]; qf[0] = qn[0]; qf[1] = qn[1];
        if (si < 7) {
#pragma unroll
            for (int ks = 0; ks < 2; ++ks) qn[ks] = *(const bf16x8*)(qb + (size_t)(t + 16) * 1024 + hd * 64 + ks * 32 + fq * 8); }
        f32x4 S[10];
#pragma unroll
        for (int nk = 0; nk < 9; nk += 3) { bf16x8 kfr[3][2];
#pragma unroll
            for (int u = 0; u < 3; ++u)
#pragma unroll
                for (int ks = 0; ks < 2; ++ks) kfr[u][ks] = *(const LAS bf16x8*)(Ks + (16 * (si + nk + u) + fr) * 160 + ks * 64 + fq * 16);
            __builtin_amdgcn_sched_barrier(0);
#pragma unroll
            for (int u = 0; u < 3; ++u) { S[nk + u] = (f32x4){0.f, 0.f, 0.f, 0.f};
#pragma unroll
                for (int ks = 0; ks < 2; ++ks) S[nk + u] = MFMA16(kfr[u][ks], qf[ks], S[nk + u]); } }
        S[9] = (f32x4){0.f, 0.f, 0.f, 0.f};
        const int i = si * 16 + fr;
        float mx = sink;
#pragma unroll
        for (int nk = 0; nk < 9; ++nk)
#pragma unroll
            for (int r = 0; r < 4; ++r) { const int p = 16 * (si + nk) + 4 * fq + r; const bool ok = (p >= i + 1) && (p <= i + 128) && (n > 0 || p >= 128);
                S[nk][r] = ok ? S[nk][r] : -1e30f; mx = fmaxf(mx, S[nk][r]); }
        mx = fmaxf(mx, __shfl_xor(mx, 16)); mx = fmaxf(mx, __shfl_xor(mx, 32));
        float sum = 0.f;
#pragma unroll
        for (int nk = 0; nk < 9; ++nk)
#pragma unroll
            for (int r = 0; r < 4; ++r) { const float pv = S[nk][r] > -1e29f ? __builtin_amdgcn_exp2f((S[nk][r] - mx) * 1.4426950408889634f) : 0.f; S[nk][r] = pv; sum += pv; }
        sum += __shfl_xor(sum, 16); sum += __shfl_xor(sum, 32);
        const float inv = 1.f / (sum + exp2f((sink - mx) * 1.4426950408889634f));
        f32x4 O[4];
#pragma unroll
        for (int nd = 0; nd < 4; ++nd) O[nd] = (f32x4){0.f, 0.f, 0.f, 0.f};
#pragma unroll
        for (int kk = 0; kk < 5; ++kk) { const bf16x8 pf = pack8(S[2 * kk], S[2 * kk + 1]);
            const int p0 = 16 * (si + 2 * kk) + 4 * fq, p1 = (kk == 4 && si == 7) ? p0 : p0 + 16;
            u32x2 lo[4], hi[4];
#pragma unroll
            for (int nd = 0; nd < 4; ++nd) { lo[nd] = *(const LAS u32x2*)(Vs + (16 * nd + fr) * 528 + p0 * 2); hi[nd] = *(const LAS u32x2*)(Vs + (16 * nd + fr) * 528 + p1 * 2); }
            __builtin_amdgcn_sched_barrier(0);
#pragma unroll
            for (int nd = 0; nd < 4; ++nd) O[nd] = MFMA16(cat8(lo[nd], hi[nd]), pf, O[nd]); }
#pragma unroll
        for (int nd = 0; nd < 4; ++nd) { u32x2 w; w[0] = pk2(O[nd][0] * inv, O[nd][1] * inv); w[1] = pk2(O[nd][2] * inv, O[nd][3] * inv);
            *(u32x2*)(ycat + (size_t)t * AB_OUT + hd * 64 + 16 * nd + 4 * fq) = w; }
    }
}

__device__ __forceinline__ void ret_kv_unit(const Ctx& c, int unit) {
    const int b = unit >> 8, n = (unit >> 2) & 63, h = unit & 3, lane = c.lane, fr = lane & 15, fq = lane >> 4, w = c.wid;
    const bf16_t* rkdT = (const bf16_t*)(c.ws + AB_RKDT); const bf16_t* rvT = (const bf16_t*)(c.ws + AB_RVT); float* kv = (float*)(c.ws + AB_KV);
    LAS unsigned char* Kd = c.lds;
    __syncthreads();
    {
        const float lg = log2f(1.f - exp2f(-5.f - (float)h)); const int cc = c.tid & 15;
        float dec[8];
#pragma unroll
        for (int e = 0; e < 8; ++e) dec[e] = __builtin_amdgcn_exp2f((float)(127 - (cc * 8 + e)) * lg);
        const unsigned char* src = (const unsigned char*)(rkdT + (size_t)(b * 4 + h) * 128 * SEQ + n * 128);
#pragma unroll
        for (int q = 0; q < 4; ++q) { const int r = (c.tid >> 4) + 32 * q; const u32x4 v = *(const u32x4*)(src + (size_t)r * SEQ * 2 + cc * 16); u32x4 o;
#pragma unroll
            for (int e2 = 0; e2 < 4; ++e2) o[e2] = pk2(__uint_as_float(v[e2] << 16) * dec[2 * e2], __uint_as_float(v[e2] & 0xffff0000u) * dec[2 * e2 + 1]);
            *(LAS u32x4*)(Kd + r * 288 + cc * 16) = o; }
    }
    bf16x8 vf[2][4];
#pragma unroll
    for (int ne = 0; ne < 2; ++ne)
#pragma unroll
        for (int ks = 0; ks < 4; ++ks) vf[ne][ks] = *(const bf16x8*)(rvT + ((size_t)(b * 4 + h) * 256 + 32 * w + 16 * ne + fr) * SEQ + n * 128 + ks * 32 + fq * 8);
    __syncthreads();
    float* out = kv + ((size_t)((b * 64 + n) * 4 + h)) * 256 * 128;
#pragma unroll
    for (int nd = 0; nd < 8; ++nd) { f32x4 a0 = (f32x4){0.f, 0.f, 0.f, 0.f}, a1 = a0;
        bf16x8 kf[4];
#pragma unroll
        for (int ks = 0; ks < 4; ++ks) kf[ks] = *(const LAS bf16x8*)(Kd + (16 * nd + fr) * 288 + ks * 64 + fq * 16);
        __builtin_amdgcn_sched_barrier(0);
#pragma unroll
        for (int ks = 0; ks < 4; ++ks) { a0 = MFMA16(kf[ks], vf[0][ks], a0); a1 = MFMA16(kf[ks], vf[1][ks], a1); }
        *(f32x4*)(out + (size_t)(32 * w + fr) * 128 + 16 * nd + 4 * fq) = a0; *(f32x4*)(out + (size_t)(32 * w + 16 + fr) * 128 + 16 * nd + 4 * fq) = a1; }
}
__device__ __forceinline__ void ret_scan(const Ctx& c, int first_block, int nblocks) {
    const float* kv = (const float*)(c.ws + AB_KV); bf16_t* sp = (bf16_t*)(c.ws + AB_SPREV);
    const int nthr = nblocks * NTHREADS;
    typedef float f32x2s __attribute__((ext_vector_type(2)));
    for (int idx = (c.bid - first_block) * NTHREADS + c.tid; idx < 2 * 4 * 256 * 128 / 2; idx += nthr) {
        const int b = idx >> 16, rem = idx & 65535, h = rem >> 14;
        const float g = exp2f(128.f * log2f(1.f - exp2f(-5.f - (float)h)));
        const size_t base = (size_t)b * 64 * 131072 + (size_t)rem * 2;
        f32x2s v[64];
#pragma unroll
        for (int q = 0; q < 64; ++q) v[q] = *(const f32x2s*)(kv + base + (size_t)q * 131072);
        f32x2s st = (f32x2s){0.f, 0.f};
#pragma unroll
        for (int q = 0; q < 64; ++q) { *(unsigned*)(sp + base + (size_t)q * 131072) = pk2(st[0], st[1]); st = st * g + v[q]; }
    }
}
__device__ __forceinline__ void ret_out_unit(const Ctx& c, int unit) {
    const int b = unit >> 8, n = (unit >> 2) & 63, h = unit & 3, lane = c.lane, fr = lane & 15, fq = lane >> 4, w = c.wid;
    const bf16_t* rqb = (const bf16_t*)(c.ws + AB_RQB); const bf16_t* rkb = (const bf16_t*)(c.ws + AB_RKB); const bf16_t* rvT = (const bf16_t*)(c.ws + AB_RVT);
    const bf16_t* sp = (const bf16_t*)(c.ws + AB_SPREV); const bf16_t* rgb = (const bf16_t*)(c.ws + AB_RGB); bf16_t* ycat = (bf16_t*)(c.ws + WS_YCAT);
    LAS unsigned char* Kl = c.lds; LAS unsigned char* Bl = c.lds + 128 * 288;
    const int t0 = b * SEQ + n * 128; const float lg = log2f(1.f - exp2f(-5.f - (float)h));
    __syncthreads();
    tile_g2l<128, 256>(Kl, (const unsigned char*)(rkb + (size_t)t0 * 512 + h * 128), (size_t)512 * 2, c.tid);
    tile_g2l<256, 256>(Bl, (const unsigned char*)(sp + ((size_t)((b * 64 + n) * 4 + h)) * 256 * 128), (size_t)128 * 2, c.tid);
    const int t = t0 + 16 * w + fr, i = 16 * w + fr;
    bf16x8 qf[4];
#pragma unroll
    for (int ks = 0; ks < 4; ++ks) qf[ks] = *(const bf16x8*)(rqb + (size_t)t * 512 + h * 128 + ks * 32 + fq * 8);
    __syncthreads();
    bf16x8 pf[4];
#pragma unroll
    for (int kk = 0; kk < 4; ++kk) { f32x4 s2[2];
#pragma unroll
        for (int q = 0; q < 2; ++q) { const int nj = 2 * kk + q; s2[q] = (f32x4){0.f, 0.f, 0.f, 0.f};
            if (nj <= w) {
                bf16x8 kf[4];
#pragma unroll
                for (int ks = 0; ks < 4; ++ks) kf[ks] = *(const LAS bf16x8*)(Kl + (16 * nj + fr) * 288 + ks * 64 + fq * 16);
                __builtin_amdgcn_sched_barrier(0);
#pragma unroll
                for (int ks = 0; ks < 4; ++ks) s2[q] = MFMA16(kf[ks], qf[ks], s2[q]);
#pragma unroll
                for (int r = 0; r < 4; ++r) { const int jj = 16 * nj + 4 * fq + r; s2[q][r] = (i >= jj) ? s2[q][r] * __builtin_amdgcn_exp2f((float)(i - jj) * lg) : 0.f; } } }
        pf[kk] = pack8(s2[0], s2[1]); }
    f32x4 acc[16];
#pragma unroll
    for (int ne = 0; ne < 16; ne += 2) { bf16x8 sf[2][4];
#pragma unroll
        for (int u = 0; u < 2; ++u)
#pragma unroll
            for (int ks = 0; ks < 4; ++ks) sf[u][ks] = *(const LAS bf16x8*)(Bl + (16 * (ne + u) + fr) * 288 + ks * 64 + fq * 16);
        __builtin_amdgcn_sched_barrier(0);
#pragma unroll
        for (int u = 0; u < 2; ++u) { acc[ne + u] = (f32x4){0.f, 0.f, 0.f, 0.f};
#pragma unroll
            for (int ks = 0; ks < 4; ++ks) acc[ne + u] = MFMA16(sf[u][ks], qf[ks], acc[ne + u]); } }
    const float rs = exp2f((float)(i + 1) * lg);
#pragma unroll
    for (int ne = 0; ne < 16; ++ne) acc[ne] = acc[ne] * rs;
    __syncthreads();
    tile_g2l<256, 256, 16>(Bl, (const unsigned char*)(rvT + (size_t)(b * 4 + h) * 256 * SEQ + n * 128), (size_t)SEQ * 2, c.tid);
    __syncthreads();
    const int nkk = (w >> 1) + 1;
#pragma unroll
    for (int kk = 0; kk < 4; ++kk) if (kk < nkk) {
#pragma unroll
        for (int ne = 0; ne < 16; ne += 8) { u32x2 lo[8], hi[8];
#pragma unroll
            for (int u = 0; u < 8; ++u) { lo[u] = *(const LAS u32x2*)(Bl + (16 * (ne + u) + fr) * 272 + (32 * kk + 4 * fq) * 2); hi[u] = *(const LAS u32x2*)(Bl + (16 * (ne + u) + fr) * 272 + (32 * kk + 16 + 4 * fq) * 2); }
            __builtin_amdgcn_sched_barrier(0);
#pragma unroll
            for (int u = 0; u < 8; ++u) acc[ne + u] = MFMA16(cat8(lo[u], hi[u]), pf[kk], acc[ne + u]); } }
    u32x2 gpre[16];
#pragma unroll
    for (int ne = 0; ne < 16; ++ne) gpre[ne] = *(const u32x2*)(rgb + (size_t)t * 1024 + h * 256 + 16 * ne + 4 * fq);
    float sm = 0.f;
#pragma unroll
    for (int ne = 0; ne < 16; ++ne) sm += acc[ne][0] + acc[ne][1] + acc[ne][2] + acc[ne][3];
    sm += __shfl_xor(sm, 16); sm += __shfl_xor(sm, 32);
    const float mean = sm * (1.f / 256.f); float sq = 0.f;
#pragma unroll
    for (int ne = 0; ne < 16; ++ne) { acc[ne] = acc[ne] - mean; sq += acc[ne][0] * acc[ne][0] + acc[ne][1] * acc[ne][1] + acc[ne][2] * acc[ne][2] + acc[ne][3] * acc[ne][3]; }
    sq += __shfl_xor(sq, 16); sq += __shfl_xor(sq, 32);
    const float rstd = rsqrtf(sq * (1.f / 256.f) + LN_EPS);
#pragma unroll
    for (int ne = 0; ne < 16; ++ne) { const u32x2 gw = gpre[ne];
        const float g0 = __uint_as_float(gw[0] << 16), g1 = __uint_as_float(gw[0] & 0xffff0000u), g2 = __uint_as_float(gw[1] << 16), g3 = __uint_as_float(gw[1] & 0xffff0000u);
        u32x2 o; o[0] = pk2(acc[ne][0] * rstd * g0, acc[ne][1] * rstd * g1); o[1] = pk2(acc[ne][2] * rstd * g2, acc[ne][3] * rstd * g3);
        *(u32x2*)(ycat + (size_t)t * AB_OUT + 1024 + h * 256 + 16 * ne + 4 * fq) = o; }
}

__device__ __forceinline__ void phase_ab_p1(const Ctx& c) {
    for (int u = c.bid; u < 512; u += c.G) ret_kv_unit(c, u);
}
__device__ __forceinline__ void phase_ab_p2(const Ctx& c, int j) {
    ret_scan(c, 0, c.G);
    { const float* sinks = c.inp(3) + j * 16; for (int u = c.bid; u < 256; u += c.G) attn_unit(c, u, sinks); }
}
__device__ __forceinline__ void phase_ab_p3(const Ctx& c) {
    for (int u = c.bid; u < 512; u += c.G) ret_out_unit(c, u);
}

__device__ __forceinline__ float gelu_fast(float x) { const float u = 1.5957691216057308f * (x + 0.044715f * x * x * x); return x * __builtin_amdgcn_rcpf(1.f + __expf(-u)); }
struct EpiCDIn {
    static constexpr bool PERM = true;
    LAS bf16_t* biasL; unsigned char* ws;
    __device__ __forceinline__ void init(f32x4 (&acc)[2][2][4][2], const g8::Unit& u, int wc, int fq) const {
        const int colp = u.pn * 256 + wc * 32 + fq * 8;
#pragma unroll
        for (int b = 0; b < 2; ++b)
#pragma unroll
            for (int n = 0; n < 2; ++n) { const u32x2 bw = *(const LAS u32x2*)(biasL + colp + b * 128 + 4 * n);
                const f32x4 bv = (f32x4){__uint_as_float(bw[0] << 16), __uint_as_float(bw[0] & 0xffff0000u), __uint_as_float(bw[1] << 16), __uint_as_float(bw[1] & 0xffff0000u)};
#pragma unroll
                for (int a = 0; a < 2; ++a)
#pragma unroll
                    for (int m = 0; m < 4; ++m) acc[a][b][m][n] = bv; } }
    __device__ __forceinline__ void operator()(const f32x4 (&acc)[2][2][4][2], const g8::Unit& u, int wr, int wc, int fr, int fq) const {
        const int pn = u.pn; const int col0 = pn * 256 + wc * 32 + fq * 8;
        bf16_t* gu = (bf16_t*)(ws + CD_GU); bf16_t* gvT = (bf16_t*)(ws + CD_GVT); bf16_t* gg = (bf16_t*)(ws + CD_GG); bf16_t* xr = (bf16_t*)(ws + CD_XR); float* stats = (float*)(ws + CD_STATS);
#pragma unroll
        for (int ai = 0; ai < 2; ++ai)
#pragma unroll
            for (int m = 0; m < 4; ++m) {
                const int t = u.pm * 256 + ai * 128 + wr * 64 + m * 16 + fr, sq = t & (SEQ - 1), b = t >> 13;
                f32x4 x[2][2];
#pragma unroll
                for (int bj = 0; bj < 2; ++bj)
#pragma unroll
                    for (int n = 0; n < 2; ++n) { x[bj][n] = acc[ai][bj][m][n];
                        if (pn < 13) {
                            x[bj][n] = gelu4(x[bj][n]); } }
                if (pn >= 4 && pn < 8) {
                    float s1 = 0.f, s2 = 0.f;
#pragma unroll
                    for (int bj = 0; bj < 2; ++bj)
#pragma unroll
                        for (int n = 0; n < 2; ++n)
#pragma unroll
                            for (int e = 0; e < 4; ++e) { const float v = x[bj][n][e]; s1 += v; s2 += v * v;
                                st_bf16_off((unsigned char*)gvT, (unsigned)(((b * 1024 + (pn - 4) * 256 + bj * 128 + wc * 32 + fq * 8 + 4 * n + e) * SEQ + sq) * 2), v); }
                    s1 += __shfl_xor(s1, 16); s1 += __shfl_xor(s1, 32); s2 += __shfl_xor(s2, 16); s2 += __shfl_xor(s2, 32);
                    if (fq == 0) *(f32x2*)(stats + (size_t)t * 32 + ((pn - 4) * 4 + wc) * 2) = (f32x2){s1, s2};
                } else {
                    bf16_t* dst; int ld, cb;
                    if (pn < 4) { dst = gu; ld = 1024; cb = pn * 256; } else if (pn < 13) { dst = gg; ld = 1280; cb = (pn - 8) * 256; } else { dst = xr; ld = 1280; cb = (pn - 13) * 256; }
#pragma unroll
                    for (int bj = 0; bj < 2; ++bj) { u32x4 w;
#pragma unroll
                        for (int n = 0; n < 2; ++n) { w[2 * n] = pk2(x[bj][n][0], x[bj][n][1]); w[2 * n + 1] = pk2(x[bj][n][2], x[bj][n][3]); }
                        *(u32x4*)(dst + (size_t)t * ld + cb + bj * 128 + wc * 32 + fq * 8) = w; }
                }
            }
    }
};
__device__ __forceinline__ void phase_cd_inproj(const Ctx& c, int j) {
    g8::DenseOrder S; S.init(c.ws + WS_XB, c.ws + WS_WCDIN + (size_t)j * CD_IN * D * 2, T, CD_IN, D, c.G, c.bid); S.tid0 = c.tid;
    LAS bf16_t* biasL = (LAS bf16_t*)(c.lds + LDS_TAB);
    { const float* bp = c.inp(7) + (size_t)j * CD_IN; for (int i = c.tid; i < CD_IN; i += NTHREADS) biasL[i] = f2bf(bp[i]); }
    __syncthreads();
    EpiCDIn E{biasL, c.ws};
    g8::gemm_phase<EpiCDIn, g8::DenseOrder>(c.lds + LDS_STAGE, D, S, E);
}

__device__ __forceinline__ void lru_unit(const Ctx& c, int unit, int j) {
    const int hh = unit % 5, bn = unit / 5, lane = c.lane, fr = lane & 15, fq = lane >> 4, w = c.wid;
    const int t0 = bn * 128, s0 = t0 & (SEQ - 1);
    const bf16_t* xr = (const bf16_t*)(c.ws + CD_XR); bf16_t* HL = (bf16_t*)(c.ws + WS_U2); bf16_t* PC = HL + (size_t)T * 1280; float* sum = (float*)(c.ws + WS_H);
    const float* conv_w = c.inp(10) + (size_t)j * 4 * 1280 + hh * 256; const float* conv_b = c.inp(11) + (size_t)j * 1280 + hh * 256;
    const float* ba = c.inp(13) + (size_t)j * 1280 + hh * 256; const float* bx = c.inp(15) + (size_t)j * 1280 + hh * 256; const float* spl = (const float*)(c.ws + WS_SPL) + (size_t)j * 1280 + hh * 256;
    const bf16_t* Wl = (const bf16_t*)(c.ws + WS_WLRU) + (size_t)((j * 5 + hh) * 2) * 65536;
    LAS unsigned char* Xc = c.lds; LAS unsigned char* Wa = c.lds + 128 * 544; LAS unsigned char* Wx = Wa + 64 * 544; LAS unsigned char* Tot = Wx + 64 * 544; LAS float* Bl = (LAS float*)(Tot + 4096);
    __syncthreads();
    if (c.tid < 192) { const int which = c.tid >> 6, i4 = (c.tid & 63) * 4; const float* srcp = which == 0 ? ba : (which == 1 ? bx : spl); *(LAS f32x4*)(Bl + which * 256 + i4) = *(const f32x4*)(srcp + i4); }
    {
        const int cg = c.tid & 31, r0 = (c.tid >> 5) * 8;
        float wv[4][8], bv8[8];
        { const f32x4 b0 = *(const f32x4*)(conv_b + cg * 8), b1 = *(const f32x4*)(conv_b + cg * 8 + 4); bv8[0] = b0[0]; bv8[1] = b0[1]; bv8[2] = b0[2]; bv8[3] = b0[3]; bv8[4] = b1[0]; bv8[5] = b1[1]; bv8[6] = b1[2]; bv8[7] = b1[3]; }
#pragma unroll
        for (int k = 0; k < 4; ++k) { const f32x4 w0 = *(const f32x4*)(conv_w + k * 1280 + cg * 8), w1 = *(const f32x4*)(conv_w + k * 1280 + cg * 8 + 4);
            wv[k][0] = w0[0]; wv[k][1] = w0[1]; wv[k][2] = w0[2]; wv[k][3] = w0[3]; wv[k][4] = w1[0]; wv[k][5] = w1[1]; wv[k][6] = w1[2]; wv[k][7] = w1[3]; }
        u32x4 xin[11];
#pragma unroll
        for (int q = 0; q < 11; ++q) { xin[q] = (u32x4){0u, 0u, 0u, 0u}; if (s0 + r0 - 3 + q >= 0) xin[q] = *(const u32x4*)(xr + (size_t)(t0 + r0 - 3 + q) * 1280 + hh * 256 + cg * 8); }
#pragma unroll
        for (int rr = 0; rr < 8; ++rr) { float a[8];
#pragma unroll
            for (int e = 0; e < 8; ++e) a[e] = bv8[e];
#pragma unroll
            for (int k = 0; k < 4; ++k) { const u32x4 xv = xin[rr + k];
#pragma unroll
                for (int e2 = 0; e2 < 4; ++e2) { a[2 * e2] += wv[k][2 * e2] * __uint_as_float(xv[e2] << 16); a[2 * e2 + 1] += wv[k][2 * e2 + 1] * __uint_as_float(xv[e2] & 0xffff0000u); } }
            u32x4 o; o[0] = pk2(a[0], a[1]); o[1] = pk2(a[2], a[3]); o[2] = pk2(a[4], a[5]); o[3] = pk2(a[6], a[7]);
            *(LAS u32x4*)(Xc + (r0 + rr) * 544 + cg * 16) = o; }
    }
    u32x4 wreg[8];
#pragma unroll
    for (int q = 0; q < 4; ++q) { const int i = c.tid + q * NTHREADS, r = i >> 5, cc = i & 31; wreg[q] = *(const u32x4*)((const unsigned char*)Wl + (size_t)r * 512 + cc * 16); wreg[4 + q] = *(const u32x4*)((const unsigned char*)(Wl + 65536) + (size_t)r * 512 + cc * 16); }
    __syncthreads();
    bf16x8 xf[8];
#pragma unroll
    for (int ks = 0; ks < 8; ++ks) xf[ks] = *(const LAS bf16x8*)(Xc + (16 * w + fr) * 544 + ks * 64 + fq * 16);
    const int t = t0 + 16 * w + fr;
    for (int sl = 0; sl < 4; ++sl) {
        if (sl) __syncthreads();
#pragma unroll
        for (int q = 0; q < 4; ++q) { const int i = c.tid + q * NTHREADS, r = i >> 5, cc = i & 31; *(LAS u32x4*)(Wa + r * 544 + cc * 16) = wreg[q]; *(LAS u32x4*)(Wx + r * 544 + cc * 16) = wreg[4 + q]; }
        if (sl < 3) {
#pragma unroll
            for (int q = 0; q < 4; ++q) { const int i = c.tid + q * NTHREADS, r = i >> 5, cc = i & 31;
                wreg[q] = *(const u32x4*)((const unsigned char*)(Wl + (size_t)((sl + 1) * 64) * 256) + (size_t)r * 512 + cc * 16); wreg[4 + q] = *(const u32x4*)((const unsigned char*)(Wl + 65536 + (size_t)((sl + 1) * 64) * 256) + (size_t)r * 512 + cc * 16); } }
        __syncthreads();
        f32x4 sA[4], sB[4];
#pragma unroll
        for (int nc = 0; nc < 4; ++nc) { f32x4 ra = (f32x4){0.f, 0.f, 0.f, 0.f}, ri = ra;
            bf16x8 waf[8], wxf[8];
#pragma unroll
            for (int ks = 0; ks < 8; ++ks) { waf[ks] = *(const LAS bf16x8*)(Wa + (16 * nc + fr) * 544 + ks * 64 + fq * 16); wxf[ks] = *(const LAS bf16x8*)(Wx + (16 * nc + fr) * 544 + ks * 64 + fq * 16); }
            __builtin_amdgcn_sched_barrier(0);
#pragma unroll
            for (int ks = 0; ks < 8; ++ks) { ra = MFMA16(waf[ks], xf[ks], ra); ri = MFMA16(wxf[ks], xf[ks], ri); }
            const int ch = sl * 64 + 16 * nc + 4 * fq;
            const f32x4 b_a = *(const LAS f32x4*)(Bl + ch), b_x = *(const LAS f32x4*)(Bl + 256 + ch), sp = *(const LAS f32x4*)(Bl + 512 + ch);
            const u32x2 xw = *(const LAS u32x2*)(Xc + (16 * w + fr) * 544 + ch * 2);
            const float xcv[4] = {__uint_as_float(xw[0] << 16), __uint_as_float(xw[0] & 0xffff0000u), __uint_as_float(xw[1] << 16), __uint_as_float(xw[1] & 0xffff0000u)};
            f32x4 oa, ob;
#pragma unroll
            for (int r = 0; r < 4; ++r) { const float gr = __builtin_amdgcn_rcpf(1.f + __expf(-(ra[r] + b_a[r]))), gi = __builtin_amdgcn_rcpf(1.f + __expf(-(ri[r] + b_x[r]))); const float la = -8.f * gr * sp[r]; const float a = __expf(la);
                oa[r] = a; ob[r] = __builtin_amdgcn_sqrtf(fmaxf(1.f - a * a, 0.f)) * (gi * xcv[r]); }
            sA[nc] = oa; sB[nc] = ob;
        }
#pragma unroll
        for (int dlt = 1; dlt < 16; dlt <<= 1) { f32x4 pa[4], pb[4];
#pragma unroll
            for (int nc = 0; nc < 4; ++nc)
#pragma unroll
                for (int r = 0; r < 4; ++r) { pa[nc][r] = __shfl_up(sA[nc][r], dlt, 16); pb[nc][r] = __shfl_up(sB[nc][r], dlt, 16); }
            if (fr >= dlt) {
#pragma unroll
                for (int nc = 0; nc < 4; ++nc) { sB[nc] = sA[nc] * pb[nc] + sB[nc]; sA[nc] = sA[nc] * pa[nc]; } } }
        if (fr == 15) {
#pragma unroll
            for (int nc = 0; nc < 4; ++nc) { *(LAS f32x4*)(Tot + ((w * 64 + 16 * nc + 4 * fq) * 2) * 4) = sA[nc]; *(LAS f32x4*)(Tot + ((w * 64 + 16 * nc + 4 * fq) * 2 + 4) * 4) = sB[nc]; } }
        __syncthreads();
#pragma unroll
        for (int nc = 0; nc < 4; ++nc) { const int ch = sl * 64 + 16 * nc + 4 * fq;
            f32x4 cp = (f32x4){1.f, 1.f, 1.f, 1.f}, chh = (f32x4){0.f, 0.f, 0.f, 0.f};
            for (int w2 = 0; w2 < w; ++w2) { const f32x4 ta = *(const LAS f32x4*)(Tot + ((w2 * 64 + 16 * nc + 4 * fq) * 2) * 4), tb = *(const LAS f32x4*)(Tot + ((w2 * 64 + 16 * nc + 4 * fq) * 2 + 4) * 4);
                chh = ta * chh + tb; cp = cp * ta; }
            const f32x4 hl = sB[nc] + sA[nc] * chh, pc = sA[nc] * cp;
            u32x2 o1, o2; o1[0] = pk2(hl[0], hl[1]); o1[1] = pk2(hl[2], hl[3]); o2[0] = pk2(pc[0], pc[1]); o2[1] = pk2(pc[2], pc[3]);
            *(u32x2*)(HL + (size_t)t * 1280 + hh * 256 + ch) = o1; *(u32x2*)(PC + (size_t)t * 1280 + hh * 256 + ch) = o2;
            if (w == 7 && fr == 15) { float* sm = sum + ((size_t)bn * 1280 + hh * 256 + ch) * 2;
#pragma unroll
                for (int r = 0; r < 4; ++r) { sm[2 * r] = pc[r]; sm[2 * r + 1] = hl[r]; } } }
    }
}

__device__ __forceinline__ void sgu_unit(const Ctx& c, int unit, int j) {
    const int g = unit & 3, bn = unit >> 2, b = bn >> 6, n = bn & 63, lane = c.lane, fr = lane & 15, fq = lane >> 4, w = c.wid;
    const int t0 = bn * 128;
    const bf16_t* gu = (const bf16_t*)(c.ws + CD_GU); const bf16_t* gvT = (const bf16_t*)(c.ws + CD_GVT); const float* stats = (const float*)(c.ws + CD_STATS); bf16_t* ycat = (bf16_t*)(c.ws + WS_YCAT);
    const float* sw = c.inp(8) + (size_t)(j * 4 + g) * 16384; const float* sb = c.inp(9) + (size_t)(j * 4 + g) * 128;
    LAS unsigned char* Vt = c.lds; LAS float* mr = (LAS float*)(c.lds + 256 * 288);
    __syncthreads();
    tile_g2l<256, 256>(Vt, (const unsigned char*)(gvT + ((size_t)b * 1024 + g * 256) * SEQ + n * 128), (size_t)SEQ * 2, c.tid);
    if (c.tid < 128) { const f32x4* st = (const f32x4*)(stats + (size_t)(t0 + c.tid) * 32); float s1 = 0.f, s2 = 0.f; f32x4 sv[8];
#pragma unroll
        for (int q = 0; q < 8; ++q) sv[q] = st[q];
#pragma unroll
        for (int q = 0; q < 8; ++q) { s1 += sv[q][0] + sv[q][2]; s2 += sv[q][1] + sv[q][3]; }
        const float mean = s1 * (1.f / 1024.f), var = fmaxf(s2 * (1.f / 1024.f) - mean * mean, 0.f); mr[2 * c.tid] = mean; mr[2 * c.tid + 1] = rsqrtf(var + LN_EPS); }
    __syncthreads();
    const int i = 16 * w + fr, t = t0 + i, nks = (w >> 1) + 1;
    bf16x8 wf[4]; float ci = 0.f;
#pragma unroll
    for (int ks = 0; ks < 4; ++ks) { f32x4 lo = (f32x4){0.f, 0.f, 0.f, 0.f}, hi = lo;
        if (ks < nks) { const int j0 = ks * 32 + fq * 8; const f32x4 w0 = *(const f32x4*)(sw + (size_t)i * 128 + j0), w1 = *(const f32x4*)(sw + (size_t)i * 128 + j0 + 4);
#pragma unroll
            for (int e = 0; e < 4; ++e) { const float m0 = mr[2 * (j0 + e)], r0 = mr[2 * (j0 + e) + 1], m1 = mr[2 * (j0 + 4 + e)], r1 = mr[2 * (j0 + 4 + e) + 1];
                lo[e] = (j0 + e <= i) ? w0[e] * r0 : 0.f; hi[e] = (j0 + 4 + e <= i) ? w1[e] * r1 : 0.f; ci += lo[e] * m0 + hi[e] * m1; } }
        wf[ks] = pack8(lo, hi); }
    ci += __shfl_xor(ci, 16); ci += __shfl_xor(ci, 32);
    const float add = sb[i] - ci;
    f32x4 acc[16];
#pragma unroll
    for (int nd = 0; nd < 16; nd += 2) { bf16x8 vf[2][4];
#pragma unroll
        for (int u = 0; u < 2; ++u)
#pragma unroll
            for (int ks = 0; ks < 4; ++ks) if (ks < nks) vf[u][ks] = *(const LAS bf16x8*)(Vt + (16 * (nd + u) + fr) * 288 + ks * 64 + fq * 16);
        __builtin_amdgcn_sched_barrier(0);
#pragma unroll
        for (int u = 0; u < 2; ++u) { acc[nd + u] = (f32x4){0.f, 0.f, 0.f, 0.f};
#pragma unroll
            for (int ks = 0; ks < 4; ++ks) if (ks < nks) acc[nd + u] = MFMA16(vf[u][ks], wf[ks], acc[nd + u]); } }
    u32x2 upre[16];
#pragma unroll
    for (int nd = 0; nd < 16; ++nd) upre[nd] = *(const u32x2*)(gu + (size_t)t * 1024 + g * 256 + 16 * nd + 4 * fq);
#pragma unroll
    for (int nd = 0; nd < 16; ++nd) { const u32x2 uw = upre[nd];
        const float u0 = __uint_as_float(uw[0] << 16), u1 = __uint_as_float(uw[0] & 0xffff0000u), u2 = __uint_as_float(uw[1] << 16), u3 = __uint_as_float(uw[1] & 0xffff0000u);
        u32x2 o; o[0] = pk2(u0 * (acc[nd][0] + add), u1 * (acc[nd][1] + add)); o[1] = pk2(u2 * (acc[nd][2] + add), u3 * (acc[nd][3] + add));
        *(u32x2*)(ycat + (size_t)t * CD_OUT + g * 256 + 16 * nd + 4 * fq) = o; }
}
__device__ __forceinline__ void phase_cd_p1(const Ctx& c, int j) {
    for (int u = c.bid; u < 640; u += c.G) lru_unit(c, u, j);
    if (c.G == 256) {
        if (c.bid < 128) sgu_unit(c, c.bid, j);
        else { for (int q = 0; q < 3; ++q) sgu_unit(c, 128 + (c.bid - 128) * 3 + q, j); }
    } else { for (int u = c.bid; u < 512; u += c.G) sgu_unit(c, u, j); }
}

__device__ __forceinline__ void phase_cd_scan2(const Ctx& c) {
    const bf16_t* gg = (const bf16_t*)(c.ws + CD_GG); bf16_t* ycat = (bf16_t*)(c.ws + WS_YCAT);
    const bf16_t* HL = (const bf16_t*)(c.ws + WS_U2); const bf16_t* PC = HL + (size_t)T * 1280; const float* sum = (const float*)(c.ws + WS_H);
    LAS float* carry = (LAS float*)c.lds;
    for (int u = c.bid; u < 256; u += c.G) {
        const int bn = u >> 1, half = u & 1, b = bn >> 6, n = bn & 63;
        __syncthreads();
        {
            LAS float* part = carry + 1280;
            for (int it = c.tid; it < 4 * 1280; it += NTHREADS) { const int seg = it / 1280, ch = it % 1280; const float* sp = sum + ((size_t)(b * 64 + seg * 16) * 1280 + ch) * 2;
                f32x2 v[16];
#pragma unroll
                for (int q = 0; q < 16; ++q) { v[q] = (f32x2){1.f, 0.f}; if (seg * 16 + q < n) v[q] = *(const f32x2*)(sp + (size_t)q * 2560); }
                float A = 1.f, Bv = 0.f;
#pragma unroll
                for (int q = 0; q < 16; ++q) { Bv = v[q][0] * Bv + v[q][1]; A *= v[q][0]; }
                part[(seg * 1280 + ch) * 2] = A; part[(seg * 1280 + ch) * 2 + 1] = Bv; }
            __syncthreads();
            for (int ch = c.tid; ch < 1280; ch += NTHREADS) { float cr = 0.f;
#pragma unroll
                for (int seg = 0; seg < 4; ++seg) cr = part[(seg * 1280 + ch) * 2] * cr + part[(seg * 1280 + ch) * 2 + 1];
                carry[ch] = cr; }
        }
        __syncthreads();
        const size_t t0 = (size_t)bn * 128 + half * 64;
        for (int it0 = c.tid; it0 < 64 * 320; it0 += 8 * NTHREADS) {
            u32x2 hw[8], pw[8], gw[8];
#pragma unroll
            for (int q = 0; q < 8; ++q) { const int it = it0 + q * NTHREADS; const int r = it / 320, c4 = (it % 320) * 4; const size_t o = (t0 + r) * 1280 + c4; hw[q] = *(const u32x2*)(HL + o); pw[q] = *(const u32x2*)(PC + o); gw[q] = *(const u32x2*)(gg + o); }
#pragma unroll
            for (int q = 0; q < 8; ++q) { const int it = it0 + q * NTHREADS; const int r = it / 320, c4 = (it % 320) * 4; const f32x4 cr = *(const LAS f32x4*)(carry + c4);
                const float h0 = __uint_as_float(hw[q][0] << 16) + __uint_as_float(pw[q][0] << 16) * cr[0], h1 = __uint_as_float(hw[q][0] & 0xffff0000u) + __uint_as_float(pw[q][0] & 0xffff0000u) * cr[1];
                const float h2 = __uint_as_float(hw[q][1] << 16) + __uint_as_float(pw[q][1] << 16) * cr[2], h3 = __uint_as_float(hw[q][1] & 0xffff0000u) + __uint_as_float(pw[q][1] & 0xffff0000u) * cr[3];
                u32x2 ow; ow[0] = pk2(__uint_as_float(gw[q][0] << 16) * h0, __uint_as_float(gw[q][0] & 0xffff0000u) * h1); ow[1] = pk2(__uint_as_float(gw[q][1] << 16) * h2, __uint_as_float(gw[q][1] & 0xffff0000u) * h3);
                *(u32x2*)(ycat + (t0 + r) * CD_OUT + 1024 + c4) = ow; } }
    }
}

__device__ __forceinline__ void phase_ln_moe(const Ctx& c, const float* g, const float* bta, float* xout) {
    typedef float f32x2v __attribute__((ext_vector_type(2)));
    bf16_t* xb = (bf16_t*)(c.ws + WS_XB); const unsigned char* Y = (const unsigned char*)(c.ws + WS_U1);
    f32x4 gpre[2][2], bpre[2][2];
#pragma unroll
    for (int q = 0; q < 2; ++q)
#pragma unroll
        for (int h2 = 0; h2 < 2; ++h2) { gpre[q][h2] = *(const f32x4*)(g + q * 512 + c.lane * 8 + 4 * h2); bpre[q][h2] = *(const f32x4*)(bta + q * 512 + c.lane * 8 + 4 * h2); }
    for (long tt = (long)c.gw * 2; tt < T; tt += (long)c.nwaves * 2) {
        float v[2][2][8];
#pragma unroll
        for (int u = 0; u < 2; ++u) { const long t = tt + u;
#pragma unroll
            for (int q = 0; q < 2; ++q) { const int col = q * 512 + c.lane * 8;
                float f[8];
#pragma unroll
                for (int e = 0; e < 8; ++e) f[e] = 0.f;
#pragma unroll
                for (int k = 0; k < 8; ++k) { const size_t srow = (size_t)t * 8 + k; const u32x2 w = *(const u32x2*)(Y + srow * D + col);
#pragma unroll
                    for (int h2 = 0; h2 < 2; ++h2) { const f32x2v a = __builtin_amdgcn_cvt_pk_f32_fp8(w[h2], false), b = __builtin_amdgcn_cvt_pk_f32_fp8(w[h2], true);
                        f[4 * h2] += a[0]; f[4 * h2 + 1] += a[1]; f[4 * h2 + 2] += b[0]; f[4 * h2 + 3] += b[1]; } }
                const u32x4 xw = *(const u32x4*)(xb + (size_t)t * D + col), sw = *(const u32x4*)((const bf16_t*)(Y + (size_t)TK * D) + (size_t)t * D + col);
#pragma unroll
                for (int e2 = 0; e2 < 4; ++e2) { v[u][q][2 * e2] = __uint_as_float(xw[e2] << 16) * ALPHA + f[2 * e2] * (1.f / 64.f) + __uint_as_float(sw[e2] << 16);
                    v[u][q][2 * e2 + 1] = __uint_as_float(xw[e2] & 0xffff0000u) * ALPHA + f[2 * e2 + 1] * (1.f / 64.f) + __uint_as_float(sw[e2] & 0xffff0000u); } } }
#pragma unroll
        for (int u = 0; u < 2; ++u) { const long t = tt + u;
            float sm = 0.f;
#pragma unroll
            for (int q = 0; q < 2; ++q)
#pragma unroll
                for (int e = 0; e < 8; ++e) sm += v[u][q][e];
            const float mean = wave_sum(sm) * (1.f / 1024.f); float sq = 0.f;
#pragma unroll
            for (int q = 0; q < 2; ++q)
#pragma unroll
                for (int e = 0; e < 8; ++e) { v[u][q][e] -= mean; sq += v[u][q][e] * v[u][q][e]; }
            const float rstd = rsqrtf(wave_sum(sq) * (1.f / 1024.f) + LN_EPS);
#pragma unroll
            for (int q = 0; q < 2; ++q) { const int col = q * 512 + c.lane * 8; float o[8];
#pragma unroll
                for (int h2 = 0; h2 < 2; ++h2) { const f32x4 gg = gpre[q][h2], bb = bpre[q][h2];
#pragma unroll
                    for (int e = 0; e < 4; ++e) o[4 * h2 + e] = v[u][q][4 * h2 + e] * rstd * gg[e] + bb[e];
                    if (xout) *(f32x4*)(xout + (size_t)t * D + col + 4 * h2) = (f32x4){o[4 * h2], o[4 * h2 + 1], o[4 * h2 + 2], o[4 * h2 + 3]}; }
                u32x4 w; w[0] = pk2(o[0], o[1]); w[1] = pk2(o[2], o[3]); w[2] = pk2(o[4], o[5]); w[3] = pk2(o[6], o[7]); *(u32x4*)(xb + (size_t)t * D + col) = w; } }
    }
}

__device__ __forceinline__ unsigned sortable_u32(float f) { const unsigned b = __float_as_uint(f); return b ^ ((b >> 31) ? 0xffffffffu : 0x80000000u); }
__device__ __forceinline__ int popc64(unsigned long long m) { return __builtin_popcountll(m); }
__device__ __forceinline__ int rank_lt(unsigned long long m) { return (int)__builtin_amdgcn_mbcnt_hi((unsigned)(m >> 32), __builtin_amdgcn_mbcnt_lo((unsigned)m, 0u)); }
__device__ __forceinline__ void phase_ln_route(const Ctx& c, int L) {
    bf16_t* xb = (bf16_t*)(c.ws + WS_XB); const bf16_t* hbuf = (const bf16_t*)(c.ws + WS_HB);
    const float* g = c.inp(19) + (size_t)L * D; const float* bta = c.inp(20) + (size_t)L * D; const float* rb = c.inp(22) + L * NE;
    const bf16_t* Wr = (const bf16_t*)(c.ws + WS_WRT) + (size_t)L * 256 * D;
    int* cnt = (int*)(c.ws + CTL_CNT) + L * NE * 32; int* list = (int*)(c.ws + WS_LIST); float* gate = (float*)(c.ws + WS_GATE);
    LAS unsigned char* Xl = c.lds; LAS unsigned char* Wq = c.lds + 64 * 544;
    LAS float* Sc = (LAS float*)Wq;
    LAS int* hist = (LAS int*)(Wq + 32768); LAS int* gbase = hist + 128; LAS int* sel = gbase + 128; LAS float* selg = (LAS float*)(sel + 512);
    const int lane = c.lane, fr = lane & 15, fq = lane >> 4, w = c.wid;
    f32x4 gpre[4], bpre[4];
#pragma unroll
    for (int q = 0; q < 4; ++q) { gpre[q] = *(const f32x4*)(g + q * 256 + lane * 4); bpre[q] = *(const f32x4*)(bta + q * 256 + lane * 4); }
    for (int grp = c.bid; grp < T / 64; grp += c.G) {
        __syncthreads();
        u32x2 nb[8][4];
#pragma unroll
        for (int hb = 0; hb < 2; ++hb) {
            u32x2 xw[4][4], hw[4][4];
#pragma unroll
            for (int i = 0; i < 4; ++i) { const size_t t = (size_t)grp * 64 + hb * 32 + w * 4 + i;
#pragma unroll
                for (int q = 0; q < 4; ++q) { const int col = q * 256 + lane * 4; xw[i][q] = *(const u32x2*)(xb + t * D + col); hw[i][q] = *(const u32x2*)(hbuf + t * D + col); } }
#pragma unroll
            for (int i = 0; i < 4; ++i) { const size_t t = (size_t)grp * 64 + hb * 32 + w * 4 + i;
                f32x4 v[4]; float sm = 0.f;
#pragma unroll
                for (int q = 0; q < 4; ++q) { v[q] = (f32x4){__uint_as_float(xw[i][q][0] << 16), __uint_as_float(xw[i][q][0] & 0xffff0000u), __uint_as_float(xw[i][q][1] << 16), __uint_as_float(xw[i][q][1] & 0xffff0000u)} * ALPHA
                         + (f32x4){__uint_as_float(hw[i][q][0] << 16), __uint_as_float(hw[i][q][0] & 0xffff0000u), __uint_as_float(hw[i][q][1] << 16), __uint_as_float(hw[i][q][1] & 0xffff0000u)};
                    sm += v[q][0] + v[q][1] + v[q][2] + v[q][3]; }
                const float mean = wave_sum(sm) * (1.f / 1024.f); float sq = 0.f;
#pragma unroll
                for (int q = 0; q < 4; ++q) { v[q] = v[q] - mean; sq += v[q][0] * v[q][0] + v[q][1] * v[q][1] + v[q][2] * v[q][2] + v[q][3] * v[q][3]; }
                const float rstd = rsqrtf(wave_sum(sq) * (1.f / 1024.f) + LN_EPS);
#pragma unroll
                for (int q = 0; q < 4; ++q) { const f32x4 o = v[q] * rstd * gpre[q] + bpre[q]; nb[hb * 4 + i][q][0] = pk2(o[0], o[1]); nb[hb * 4 + i][q][1] = pk2(o[2], o[3]);
                    *(u32x2*)(xb + t * D + q * 256 + lane * 4) = nb[hb * 4 + i][q]; } }
        }
        f32x4 lg[2][2];
        const int st = w & 1, eg = w >> 1;
        lg[0][0] = (f32x4){0.f, 0.f, 0.f, 0.f}; lg[0][1] = lg[0][0]; lg[1][0] = lg[0][0]; lg[1][1] = lg[0][0];
        u32x4 wreg[8];
#pragma unroll
        for (int q = 0; q < 8; ++q) { const int i = c.tid + q * NTHREADS, r = i >> 5, cc = i & 31; wreg[q] = *(const u32x4*)((const unsigned char*)Wr + (size_t)r * 2048 + cc * 16); }
#pragma unroll
        for (int kq = 0; kq < 4; ++kq) {
            if (kq) __syncthreads();
#pragma unroll
            for (int q = 0; q < 8; ++q) { const int i = c.tid + q * NTHREADS, r = i >> 5, cc = i & 31; *(LAS u32x4*)(Wq + r * 544 + cc * 16) = wreg[q]; }
#pragma unroll
            for (int u = 0; u < 8; ++u) *(LAS u32x2*)(Xl + ((u >> 2) * 32 + w * 4 + (u & 3)) * 544 + lane * 8) = nb[u][kq];
            if (kq < 3) {
#pragma unroll
                for (int q = 0; q < 8; ++q) { const int i = c.tid + q * NTHREADS, r = i >> 5, cc = i & 31; wreg[q] = *(const u32x4*)((const unsigned char*)Wr + (size_t)r * 2048 + (kq + 1) * 512 + cc * 16); } }
            __syncthreads();
#pragma unroll
            for (int k4 = 0; k4 < 8; k4 += 2) { bf16x8 bop[2][2], aop[2][2];
#pragma unroll
                for (int u = 0; u < 2; ++u) { const int ks = k4 + u;
#pragma unroll
                    for (int p2 = 0; p2 < 2; ++p2) bop[p2][u] = *(const LAS bf16x8*)(Xl + (p2 * 32 + 16 * st + fr) * 544 + ks * 64 + fq * 16);
#pragma unroll
                    for (int ne2 = 0; ne2 < 2; ++ne2) aop[u][ne2] = *(const LAS bf16x8*)(Wq + (32 * eg + 16 * ne2 + fr) * 544 + ks * 64 + fq * 16); }
                __builtin_amdgcn_sched_barrier(0);
#pragma unroll
                for (int u = 0; u < 2; ++u)
#pragma unroll
                    for (int p2 = 0; p2 < 2; ++p2)
#pragma unroll
                        for (int ne2 = 0; ne2 < 2; ++ne2) lg[p2][ne2] = MFMA16(aop[u][ne2], bop[p2][u], lg[p2][ne2]); }
        }
        __syncthreads();
#pragma unroll
        for (int p2 = 0; p2 < 2; ++p2)
#pragma unroll
            for (int ne2 = 0; ne2 < 2; ++ne2) { f32x4 sg;
#pragma unroll
                for (int r = 0; r < 4; ++r) sg[r] = sigmoidf_(lg[p2][ne2][r]);
                *(LAS f32x4*)(Sc + (p2 * 32 + 16 * st + fr) * 128 + 32 * eg + 16 * ne2 + 4 * fq) = sg; }
        if (c.tid < 128) hist[c.tid] = 0;
        __syncthreads();
        {
            const float rb0 = rb[lane], rb1 = rb[64 + lane];
#pragma unroll 2
            for (int q = 0; q < 8; ++q) { const int rr = w * 8 + q;
                const float s0 = Sc[rr * 128 + lane], s1 = Sc[rr * 128 + 64 + lane];
                const unsigned u0 = sortable_u32(s0 + rb0), u1 = sortable_u32(s1 + rb1);
                unsigned thr = 0u;
                for (int bit = 31; bit >= 0; --bit) { const unsigned cand = thr | (1u << bit); const int n = popc64(__ballot(u0 >= cand)) + popc64(__ballot(u1 >= cand)); if (n >= 8) { thr = cand; if (n == 8) break; } }
                const bool gt0 = u0 > thr, gt1 = u1 > thr, eq0 = u0 == thr, eq1 = u1 == thr;
                const unsigned long long me0 = __ballot(eq0), me1 = __ballot(eq1);
                const int need = 8 - popc64(__ballot(gt0)) - popc64(__ballot(gt1));
                const bool sel0 = gt0 || (eq0 && rank_lt(me0) < need), sel1 = gt1 || (eq1 && popc64(me0) + rank_lt(me1) < need);
                const unsigned long long m0 = __ballot(sel0), m1 = __ballot(sel1);
                const float tot = wave_sum((sel0 ? s0 : 0.f) + (sel1 ? s1 : 0.f));
                if (sel0) { const int k = rank_lt(m0); const int lr = __hip_atomic_fetch_add(&hist[lane], 1, __ATOMIC_RELAXED, __HIP_MEMORY_SCOPE_WORKGROUP); sel[rr * 8 + k] = (lane << 16) | lr; selg[rr * 8 + k] = s0 / tot * 2.5f; }
                if (sel1) { const int k = popc64(m0) + rank_lt(m1); const int lr = __hip_atomic_fetch_add(&hist[64 + lane], 1, __ATOMIC_RELAXED, __HIP_MEMORY_SCOPE_WORKGROUP); sel[rr * 8 + k] = ((64 + lane) << 16) | lr; selg[rr * 8 + k] = s1 / tot * 2.5f; } }
        }
        __syncthreads();
        if (c.tid < 128) gbase[c.tid] = atomicAdd(&cnt[c.tid * 32], hist[c.tid]);
        __syncthreads();
        { const int sv = sel[c.tid], e = sv >> 16, lr = sv & 0xffff; const int slot = (grp * 64 + (c.tid >> 3)) * 8 + (c.tid & 7);
          list[(size_t)e * LISTCAP + gbase[e] + lr] = slot; gate[slot] = selg[c.tid]; }
    }
}

struct MoeOrder {
    const char* Abase; const char* Bbase; size_t Bstride; int K, NT, NTG, total, G, c, mode, tid0;
    LAS int* tab; LAS int* desc;
    __device__ __forceinline__ bool next(int i, g8::Unit& u) const {
        const int ip = i / NTG, q = i - ip * NTG;
        const long L = (long)ip * G + c; if (L >= total || ip >= TAB_SLOTS) return false;
        const int d = desc[ip]; const int e = d >> 12, pn = (d & 15) * NTG + q;
        u.pm = (d >> 4) & 255; u.pn = pn; u.aux = ip; u.A = Abase; u.B = Bbase + (size_t)e * Bstride + (size_t)pn * 256 * K * 2; return true;
    }
    __device__ __forceinline__ void aoff(const g8::Unit& u, int tid, unsigned (&o)[2][2]) const {
#pragma unroll
        for (int i = 0; i < 2; ++i) { int R, C; g8::stage_rc(tid * 16 + i * 8192, R, C);
#pragma unroll
            for (int h = 0; h < 2; ++h) { int s = tab[u.aux * 256 + h * 128 + R]; s = s < 0 ? 0 : s; const int row = mode ? s : (s < TK ? (s >> 3) : s - TK);
                o[h][i] = (unsigned)(row * K + C) * 2u; } }
    }
};
__device__ __forceinline__ void moe_setup(const Ctx& c, MoeOrder& S, const int* cnt, int NT, int NTG) {
    LAS int* pref = (LAS int*)(c.lds + LDS_PREF); LAS int* desc = (LAS int*)(c.lds + LDS_DESC); LAS int* tab = (LAS int*)(c.lds + LDS_TAB);
    const int* list = (const int*)(c.ws + WS_LIST);
    if (c.tid < 64) { int nb[3]; int loc = 0;
#pragma unroll
        for (int q = 0; q < 3; ++q) { const int e = c.tid * 3 + q; int n = 0; if (e < NE) n = cnt[e * 32]; else if (e == NE) n = T; nb[q] = (n + 255) >> 8; loc += nb[q]; }
        int inc = loc;
#pragma unroll
        for (int o = 1; o < 64; o <<= 1) { const int v = __shfl_up(inc, o); if (c.tid >= o) inc += v; }
        int acc = inc - loc;
#pragma unroll
        for (int q = 0; q < 3; ++q) { const int e = c.tid * 3 + q; if (e <= NE1) pref[e] = acc; acc += nb[q]; } }
    __syncthreads();
    const int NG = NT / NTG; const int total = pref[NE1] * NG;
    LAS float* gtab = (LAS float*)(c.lds + LDS_GTAB); const float* gate = (const float*)(c.ws + WS_GATE);
    S.NT = NT; S.NTG = NTG; S.total = total; S.G = c.G; S.c = c.bid; S.tab = tab; S.desc = desc;
    {
        int sv[TAB_SLOTS / 2];
#pragma unroll
        for (int k = 0; k < TAB_SLOTS / 2; ++k) { const int i = (c.tid >> 8) + 2 * k; sv[k] = -2;
            const long L = (long)i * c.G + c.bid;
            if (L < total) {
                int wgid = (int)L; { const int q = total / 8, r = total % 8, xcd = wgid % 8, off = wgid / 8; wgid = (xcd < r ? xcd * (q + 1) : r * (q + 1) + (xcd - r) * q) + off; }
                const int rbg = wgid / NG, pn = wgid % NG;
                int lo = 0, hi = NE1;
                while (hi - lo > 1) { const int mid = (lo + hi) >> 1; if (pref[mid] <= rbg) lo = mid; else hi = mid; }
                const int e = lo, rb = rbg - pref[e], n = e < NE ? cnt[e * 32] : T;
                if ((c.tid & 255) == 0) desc[i] = (e << 12) | (rb << 4) | pn;
                const int r = rb * 256 + (c.tid & 255); sv[k] = -1; if (r < n) sv[k] = (e < NE) ? list[(size_t)e * LISTCAP + r] : TK + r; } }
#pragma unroll
        for (int k = 0; k < TAB_SLOTS / 2; ++k) { const int i = (c.tid >> 8) + 2 * k; if (sv[k] != -2) { tab[i * 256 + (c.tid & 255)] = sv[k]; if (S.mode) gtab[i * 256 + (c.tid & 255)] = sv[k] >= 0 ? gate[sv[k]] : 0.f; } }
    }
    __syncthreads();
}
struct EpiMoeGU {
    static constexpr bool PERM = true;
    bf16_t* H; LAS int* tab;
    __device__ __forceinline__ void init(f32x4 (&acc)[2][2][4][2], const g8::Unit&, int, int) const {
#pragma unroll
        for (int a = 0; a < 2; ++a)
#pragma unroll
            for (int b = 0; b < 2; ++b)
#pragma unroll
                for (int m = 0; m < 4; ++m)
#pragma unroll
                    for (int n = 0; n < 2; ++n) acc[a][b][m][n] = (f32x4){0.f, 0.f, 0.f, 0.f}; }
    __device__ __forceinline__ void operator()(const f32x4 (&acc)[2][2][4][2], const g8::Unit& u, int wr, int wc, int fr, int fq) const {
#pragma unroll
        for (int ai = 0; ai < 2; ++ai)
#pragma unroll
            for (int m = 0; m < 4; ++m) { const int r = ai * 128 + wr * 64 + m * 16 + fr; const int s = tab[u.aux * 256 + r];
                if (s >= 0) { u32x4 w;
#pragma unroll
                    for (int n = 0; n < 2; ++n) { const f32x4 g = acc[ai][0][m][n], up = acc[ai][1][m][n];
                        const f32x4 hv = silu4(g) * up; w[2 * n] = pk2(hv[0], hv[1]); w[2 * n + 1] = pk2(hv[2], hv[3]); }
                    *(u32x4*)(H + (size_t)s * ED + u.pn * 128 + wc * 32 + fq * 8) = w; } }
    }
};
struct EpiMoeDN {
    static constexpr bool PERM = true;
    unsigned char* Y; LAS float* gtab; LAS int* tab;
    __device__ __forceinline__ void init(f32x4 (&acc)[2][2][4][2], const g8::Unit&, int, int) const {
#pragma unroll
        for (int a = 0; a < 2; ++a)
#pragma unroll
            for (int b = 0; b < 2; ++b)
#pragma unroll
                for (int m = 0; m < 4; ++m)
#pragma unroll
                    for (int n = 0; n < 2; ++n) acc[a][b][m][n] = (f32x4){0.f, 0.f, 0.f, 0.f}; }
    __device__ __forceinline__ void operator()(const f32x4 (&acc)[2][2][4][2], const g8::Unit& u, int wr, int wc, int fr, int fq) const {
#pragma unroll
        for (int ai = 0; ai < 2; ++ai)
#pragma unroll
            for (int m = 0; m < 4; ++m) { const int r = ai * 128 + wr * 64 + m * 16 + fr; const int s = tab[u.aux * 256 + r];
                if (s >= TK) {
#pragma unroll
                    for (int bj = 0; bj < 2; ++bj) { u32x4 w;
#pragma unroll
                        for (int n = 0; n < 2; ++n) { const f32x4 a = acc[ai][bj][m][n]; w[2 * n] = pk2(a[0], a[1]); w[2 * n + 1] = pk2(a[2], a[3]); }
                        *(u32x4*)((bf16_t*)(Y + (size_t)TK * D) + (size_t)(s - TK) * D + u.pn * 256 + bj * 128 + wc * 32 + fq * 8) = w; }
                } else if (s >= 0) { const float gt = gtab[u.aux * 256 + r] * 64.f;
#pragma unroll
                    for (int bj = 0; bj < 2; ++bj) { u32x2 w;
#pragma unroll
                        for (int n = 0; n < 2; ++n) { f32x4 a = acc[ai][bj][m][n] * gt;
#pragma unroll
                            for (int e = 0; e < 4; ++e) a[e] = fminf(fmaxf(a[e], -448.f), 448.f);
                            unsigned pw = 0u; pw = __builtin_amdgcn_cvt_pk_fp8_f32(a[0], a[1], pw, false); pw = __builtin_amdgcn_cvt_pk_fp8_f32(a[2], a[3], pw, true); w[n] = pw; }
                        *(u32x2*)(Y + (size_t)s * D + u.pn * 256 + bj * 128 + wc * 32 + fq * 8) = w; } } }
    }
};
__device__ __forceinline__ void phase_moe_gu(const Ctx& c, int L) {
    MoeOrder S; S.Abase = (const char*)(c.ws + WS_XB); S.Bbase = (const char*)(c.ws + WS_WGU) + (size_t)L * NE1 * 512 * D * 2; S.Bstride = (size_t)512 * D * 2; S.K = D; S.mode = 0; S.tid0 = c.tid;
    moe_setup(c, S, (const int*)(c.ws + CTL_CNT) + L * NE * 32, 2, 1);
    EpiMoeGU E{(bf16_t*)(c.ws + WS_HID), S.tab};
    g8::gemm_phase<EpiMoeGU, MoeOrder>(c.lds + LDS_STAGE, D, S, E);
}
__device__ __forceinline__ void phase_moe_dn(const Ctx& c, int L) {
    MoeOrder S; S.Abase = (const char*)(c.ws + WS_HID); S.Bbase = (const char*)(c.ws + WS_WDN) + (size_t)L * NE1 * D * ED * 2; S.Bstride = (size_t)D * ED * 2; S.K = ED; S.mode = 1; S.tid0 = c.tid;
    moe_setup(c, S, (const int*)(c.ws + CTL_CNT) + L * NE * 32, 4, 2);
    EpiMoeDN E{(unsigned char*)(c.ws + WS_U1), (LAS float*)(c.lds + LDS_GTAB), S.tab};
    g8::gemm_phase<EpiMoeDN, MoeOrder>(c.lds + LDS_STAGE, ED, S, E);
}

constexpr int PH_PER_LAYER = 9;
constexpr int N_PHASES = 1 + 4 * PH_PER_LAYER;

__global__ void __launch_bounds__(NTHREADS, 2) fwd_kernel(Params p) {
    extern __shared__ __attribute__((aligned(16))) unsigned char lds_raw[];
    LAS unsigned char* const lds0 = (LAS unsigned char*)lds_raw;
    const int wave_id = __builtin_amdgcn_readfirstlane((int)threadIdx.x >> 6);
    volatile LAS unsigned* misc = (volatile LAS unsigned*)(lds0 + LDS_MISC);
    if (threadIdx.x < 4) misc[threadIdx.x] = 0u;
    __syncthreads();
    const int lo = p.ph_lo, hi = p.ph_hi;
    XcdBarrier bar; bar.bar = (unsigned*)(p.ws + WS_CTL); bar.x = 0; bar.st = misc;
    if (hi - lo > 1) bar = xcd_barrier_post((unsigned*)(p.ws + WS_CTL), misc);
#define MKCTX() Ctx c; { int wv_ = wave_id; asm volatile("" : "+s"(wv_)); int tid_ = wv_ * 64 + (int)__builtin_amdgcn_mbcnt_hi(~0u, __builtin_amdgcn_mbcnt_lo(~0u, 0u)); asm volatile("" : "+v"(tid_)); int bid_ = blockIdx.x; asm volatile("" : "+s"(bid_)); unsigned long long ws_ = (unsigned long long)p.ws; asm volatile("" : "+s"(ws_)); \
        c.in = p.in; c.out = (float*)p.out; c.ws = (unsigned char*)(GAS unsigned char*)ws_; c.lds = lds0; c.tid = tid_; c.lane = tid_ & 63; c.wid = __builtin_amdgcn_readfirstlane(tid_ >> 6); c.bid = bid_; c.G = gridDim.x; \
        c.gtid = c.bid * NTHREADS + c.tid; c.gthreads = c.G * NTHREADS; c.gw = c.bid * 8 + c.wid; c.nwaves = c.G * 8; } unsigned char* const ws = c.ws; (void)ws
    int id = 0;
#ifndef PMASK
#define PMASK 0xffffffffu
#endif
#ifndef DUPMASK
#define DUPMASK 0u
#endif
#define PHASE(k, body) do { if (((PMASK >> (k)) & 1u) && lo <= id && id < hi) { MKCTX(); body; if ((DUPMASK >> (k)) & 1u) { body; } if (id + 1 < hi) xcd_barrier(bar, c.tid == 0); } ++id; } while (0)
    PHASE(0, phase_convert(c));
#pragma unroll 1
    for (int L = 0; L < 4; ++L) {
        const int j = L >> 1; const bool cd = (L & 1);
        if (cd) {
            PHASE(1, phase_cd_inproj(c, j));
        } else {
            PHASE(2, phase_ab_inproj(c, j));
        }
        if (!cd) { PHASE(3, phase_ab_p1(c)); PHASE(4, phase_ab_p2(c, j)); PHASE(16, phase_ab_p3(c)); }
        else     { PHASE(5, phase_cd_p1(c, j)); PHASE(15, phase_cd_scan2(c)); id += 1; }
        {
            const size_t Woff = cd ? WS_WCDOUT + (size_t)j * D * CD_OUT * 2 : WS_WABOUT + (size_t)j * D * AB_OUT * 2;
            const int K = cd ? CD_OUT : AB_OUT; const float* bias = cd ? (const float*)p.in[18] + (size_t)j * D : (const float*)p.in[5] + (size_t)j * D;
            PHASE(8, phase_dense(c, (const bf16_t*)(ws + WS_YCAT), (const bf16_t*)(ws + Woff), T, D, K, (bf16_t*)(ws + WS_HB), D, bias));
        }
        PHASE(9, phase_ln_route(c, L));
        PHASE(12, phase_moe_gu(c, L));
        PHASE(13, phase_moe_dn(c, L));
        PHASE(14, phase_ln_moe(c, (const float*)p.in[29] + (size_t)L * D, (const float*)p.in[30] + (size_t)L * D, L == 3 ? (float*)p.out : (float*)nullptr));
    }
#undef PHASE
}

extern "C" void kernel_launch(void* const* d_in, const int* in_sizes, int n_in, void* d_out, int out_size, void* d_ws, size_t ws_size, hipStream_t stream) {
    static int grid = 0;
    if (grid == 0) {
        if (n_in != 31 || out_size != T * D || ws_size < WS_END) { fprintf(stderr, "kernel_launch: unexpected shapes (n_in %d out %d ws %zu need %zu)\n", n_in, out_size, ws_size, (size_t)WS_END); grid = -1; return; }
        int dev = 0, cus = 0, per_cu = 0;
        if (hipGetDevice(&dev) != hipSuccess || hipDeviceGetAttribute(&cus, hipDeviceAttributeMultiprocessorCount, dev) != hipSuccess) { grid = -1; return; }
        if (hipFuncSetAttribute((const void*)fwd_kernel, hipFuncAttributeMaxDynamicSharedMemorySize, LDS_BYTES) != hipSuccess) { fprintf(stderr, "kernel_launch: hipFuncSetAttribute failed\n"); grid = -1; return; }
        if (hipOccupancyMaxActiveBlocksPerMultiprocessor(&per_cu, (const void*)fwd_kernel, NTHREADS, LDS_BYTES) != hipSuccess || per_cu < 1) fprintf(stderr, "kernel_launch: occupancy query says %d\n", per_cu);
        (void)hipGetLastError();
        grid = cus;
    }
    if (grid < 0) return;
    (void)hipMemsetAsync((char*)d_ws + WS_CTL, 0, CTL_BYTES, stream);
    Params p{};
    for (int i = 0; i < 31; ++i) p.in[i] = (const GAS float*)d_in[i];
    p.out = (GAS float*)d_out; p.ws = (GAS unsigned char*)d_ws;
#if N_LAUNCH_MODE == 1
    p.ph_lo = 0; p.ph_hi = N_PHASES;
    hipLaunchKernelGGL(fwd_kernel, dim3(grid), dim3(NTHREADS), LDS_BYTES, stream, p);
#else
    for (int i = 0; i < N_PHASES; ++i) { p.ph_lo = i; p.ph_hi = i + 1; hipLaunchKernelGGL(fwd_kernel, dim3(grid), dim3(NTHREADS), LDS_BYTES, stream, p); }
#endif
}
```

```cpp
#include <hip/hip_runtime.h>
#include <cstdio>
#include <cstdint>

#define LAS __attribute__((address_space(3)))
typedef unsigned short bf16_t;
typedef short bf16x8 __attribute__((ext_vector_type(8)));
typedef float f32x4 __attribute__((ext_vector_type(4)));
typedef float f32x2 __attribute__((ext_vector_type(2)));
typedef unsigned u32x4 __attribute__((ext_vector_type(4)));
typedef unsigned u32x2 __attribute__((ext_vector_type(2)));

constexpr int T = 16384, D = 1024, SEQ = 8192;
constexpr int AB_IN = 4352, AB_OUT = 2048, CD_IN = 4608, CD_OUT = 2304;
constexpr int NE = 128, NE1 = 129, TOPK = 8, ED = 256;
constexpr int TK = T * TOPK;
constexpr int NSLOT = TK + T;
constexpr int LISTCAP = 16384;
constexpr float ALPHA = 1.681792830507429f;
constexpr float LN_EPS = 1e-5f;

#ifndef N_LAUNCH_MODE
#define N_LAUNCH_MODE 1
#endif

constexpr size_t al256(size_t x) { return (x + 255) & ~(size_t)255; }
constexpr size_t WS_CTL    = 0;
constexpr size_t CTL_BYTES = 131072;
constexpr size_t CTL_CNT   = 65536;
constexpr size_t WS_WABIN  = CTL_BYTES;
constexpr size_t WS_WABOUT = WS_WABIN  + al256((size_t)2 * AB_IN * D * 2);
constexpr size_t WS_WCDIN  = WS_WABOUT + al256((size_t)2 * D * AB_OUT * 2);
constexpr size_t WS_WCDOUT = WS_WCDIN  + al256((size_t)2 * CD_IN * D * 2);
constexpr size_t WS_WRT    = WS_WCDOUT + al256((size_t)2 * D * CD_OUT * 2);
constexpr size_t WS_WGU    = WS_WRT    + al256((size_t)4 * 256 * D * 2);
constexpr size_t WS_WDN    = WS_WGU    + al256((size_t)4 * NE1 * 512 * D * 2);
constexpr size_t WS_X      = WS_WDN    + al256((size_t)4 * NE1 * D * ED * 2);
constexpr size_t WS_HB     = WS_X;
constexpr size_t WS_XB     = WS_X      + al256((size_t)T * D * 4);
constexpr size_t WS_U1     = WS_XB     + al256((size_t)T * D * 2);
constexpr size_t U1_BYTES  = al256((size_t)NSLOT * D * 2) > al256((size_t)T * CD_IN * 4) ? al256((size_t)NSLOT * D * 2) : al256((size_t)T * CD_IN * 4);
constexpr size_t WS_U2     = WS_U1     + U1_BYTES;
constexpr size_t U2_BYTES  = al256((size_t)T * 1280 * 4 * 3);
constexpr size_t WS_YCAT   = WS_U2     + U2_BYTES;
constexpr size_t WS_H      = WS_YCAT   + al256((size_t)T * CD_OUT * 2);
constexpr size_t WS_ZR     = WS_H      + al256((size_t)T * D * 4);
constexpr size_t WS_HID    = WS_ZR     + al256((size_t)T * 256 * 4);
constexpr size_t WS_LIST   = WS_HID    + al256((size_t)NSLOT * ED * 2);
constexpr size_t WS_GATE   = WS_LIST   + al256((size_t)NE * LISTCAP * 4);
constexpr size_t WS_ROPEA  = WS_GATE   + al256((size_t)NSLOT * 4);
constexpr size_t WS_ROPER  = WS_ROPEA  + al256((size_t)SEQ * 32 * 8);
constexpr size_t WS_BIASP  = WS_ROPER  + al256((size_t)SEQ * 64 * 8);
constexpr size_t WS_WLRU   = WS_BIASP  + al256((size_t)2 * AB_IN * 4);
constexpr size_t WS_SPL    = WS_WLRU   + al256((size_t)2 * 5 * 2 * 65536 * 2);
constexpr size_t WS_END    = WS_SPL    + al256((size_t)2 * 1280 * 4);
constexpr size_t CD_GU = WS_U1, CD_GVT = WS_U1 + 32 * (1024 * 1024), CD_GG = WS_U1 + 64 * (1024 * 1024), CD_XR = WS_U1 + 104 * (1024 * 1024), CD_STATS = WS_U1 + 144 * (1024 * 1024);
constexpr size_t MB = 1024 * 1024;
constexpr size_t AB_QB = WS_U1, AB_KB = WS_U1 + 32 * MB, AB_VT = WS_U1 + 36 * MB, AB_RQB = WS_U1 + 40 * MB, AB_RKB = WS_U1 + 56 * MB, AB_RKDT = WS_U1 + 72 * MB,
                 AB_RVT = WS_U1 + 88 * MB, AB_RGB = WS_U1 + 120 * MB, AB_KV = WS_U1 + 152 * MB  , AB_SPREV = WS_U1 + 216 * MB  ;
static_assert(AB_SPREV + 32 * MB <= WS_U1 + U1_BYTES, "U1 map");

__device__ __forceinline__ float bf2f(bf16_t b) { return __uint_as_float(((unsigned)b) << 16); }
__device__ __forceinline__ unsigned pk2(float lo, float hi) { unsigned r; asm("v_cvt_pk_bf16_f32 %0, %1, %2" : "=v"(r) : "v"(lo), "v"(hi)); return r; }
__device__ __forceinline__ bf16_t f2bf(float f) { return (bf16_t)(pk2(f, f) & 0xffffu); }
__device__ __forceinline__ float wave_sum(float v) {
#pragma unroll
    for (int o = 32; o; o >>= 1) v += __shfl_xor(v, o);
    return v; }
__device__ __forceinline__ float wave_max(float v) {
#pragma unroll
    for (int o = 32; o; o >>= 1) v = fmaxf(v, __shfl_xor(v, o));
    return v; }
__device__ __forceinline__ float gelu_tanh(float x) { const float u = 0.7978845608028654f * (x + 0.044715f * x * x * x); return 0.5f * x * (1.f + tanhf(u)); }
__device__ __forceinline__ float sigmoidf_(float x) { return __builtin_amdgcn_rcpf(1.f + __expf(-x)); }
__device__ __forceinline__ float siluf_(float x) { return x * __builtin_amdgcn_rcpf(1.f + __expf(-x)); }
__device__ __forceinline__ f32x4 silu4(const f32x4 x) { const f32x4 t = x * (-1.4426950408889634f); f32x4 d;
#pragma unroll
    for (int e = 0; e < 4; ++e) d[e] = __builtin_amdgcn_exp2f(t[e]);
    d = d + 1.f;
#pragma unroll
    for (int e = 0; e < 4; ++e) d[e] = __builtin_amdgcn_rcpf(d[e]);
    return x * d; }
__device__ __forceinline__ f32x4 gelu4(const f32x4 x) {
    const f32x4 t = x * ((x * x) * (-0.10294323886f) + (-2.30220819813f)); f32x4 d;
#pragma unroll
    for (int e = 0; e < 4; ++e) d[e] = __builtin_amdgcn_exp2f(t[e]);
    d = d + 1.f;
#pragma unroll
    for (int e = 0; e < 4; ++e) d[e] = __builtin_amdgcn_rcpf(d[e]);
    return x * d; }

#define XB_TMO      128
#define XB_XCNT(j)  (256  + 64 * (j))
#define XB_XSUB(j)  (1280 + 64 * (j))
#define XB_XGEN(j)  (2304 + 64 * (j))
#define XB_TOP      3328
#define XB_TOPGEN   3392
#define XCD_BAR_WORDS 3456
#define XB_SPIN_CAP (1u << 22)

__device__ __forceinline__ unsigned xb_ld(unsigned* p)              { return __hip_atomic_load(p, __ATOMIC_RELAXED, __HIP_MEMORY_SCOPE_AGENT); }
__device__ __forceinline__ unsigned xb_add(unsigned* p, unsigned v) { return __hip_atomic_fetch_add(p, v, __ATOMIC_RELAXED, __HIP_MEMORY_SCOPE_AGENT); }
__device__ __forceinline__ unsigned xb_xcc_id() { return (unsigned)__builtin_amdgcn_s_getreg((3 << 11) | 20) & 0xFu; }
#define XB_SPIN(cond, bar) do { unsigned _sp = 0; while (cond) { __builtin_amdgcn_s_sleep(1); \
    if ((++_sp & 255u) == 0u) { if (xb_ld(&(bar)[XB_TMO])) break; if (_sp > XB_SPIN_CAP) { atomicAdd(&(bar)[XB_TMO], 1u); break; } } } } while (0)

struct XcdBarrier { unsigned* bar; unsigned x; volatile LAS unsigned* st; };

__device__ __forceinline__ XcdBarrier xcd_barrier_post(unsigned* bar, volatile LAS unsigned* st) {
    XcdBarrier b; b.bar = bar; b.x = xb_xcc_id(); b.st = st;
    if (threadIdx.x == 0) (void)xb_add(&bar[XB_XCNT(b.x)], 1u);
    return b;
}
__device__ __forceinline__ void xcd_barrier_complete(unsigned* bar, unsigned x, unsigned& nloc, unsigned& nx) {
    const unsigned G = gridDim.x * gridDim.y * gridDim.z;
    unsigned sum, cnt, mine, sp = 0u;
    for (;;) {
        sum = 0u; cnt = 0u; mine = 0u;
#pragma unroll
        for (unsigned j = 0; j < 16; ++j) { const unsigned c = xb_ld(&bar[XB_XCNT(j)]); sum += c; cnt += (c > 0u) ? 1u : 0u; mine = (j == x) ? c : mine; }
        if (sum == G) break;
        __builtin_amdgcn_s_sleep(1);
        if ((++sp & 255u) == 0u) { if (xb_ld(&bar[XB_TMO])) break; if (sp > XB_SPIN_CAP) { atomicAdd(&bar[XB_TMO], 1u); break; } }
    }
    nloc = mine > 0u ? mine : 1u; nx = cnt > 0u ? cnt : 1u;
}
__device__ __forceinline__ void xcd_barrier(const XcdBarrier& b, const bool leader  ) {
    asm volatile("s_waitcnt vmcnt(0)" ::: "memory");
    __syncthreads();
    if (leader) {
        unsigned* bar = b.bar;
        __builtin_amdgcn_s_waitcnt(0);
        unsigned nloc = b.st[0], nx = b.st[1];
        if (nloc == 0u) { xcd_barrier_complete(bar, b.x, nloc, nx); b.st[0] = nloc; b.st[1] = nx; }
        const unsigned old = xb_add(&bar[XB_XSUB(b.x)], 1u);
        const unsigned gen = old / nloc;
        if (old + 1u == (gen + 1u) * nloc) {
            __builtin_amdgcn_fence(__ATOMIC_RELEASE, "agent");
            asm volatile("s_waitcnt vmcnt(0)" ::: "memory");
            const unsigned og = xb_add(&bar[XB_TOP], 1u);
            const unsigned tg = og / nx;
            if (og + 1u == (tg + 1u) * nx) xb_add(&bar[XB_TOPGEN], 1u);
            else XB_SPIN(xb_ld(&bar[XB_TOPGEN]) == tg, bar);
            __builtin_amdgcn_fence(__ATOMIC_ACQUIRE, "agent");
            xb_add(&bar[XB_XGEN(b.x)], 1u);
            asm volatile("s_waitcnt vmcnt(0)" ::: "memory");
        } else {
            XB_SPIN(xb_ld(&bar[XB_XGEN(b.x)]) == gen, bar);
            __builtin_amdgcn_fence(__ATOMIC_ACQUIRE, "agent");
            asm volatile("s_waitcnt vmcnt(0)" ::: "memory");
        }
    }
    __syncthreads();
}

namespace g8 {
constexpr int BM = 256, BK = 64, HALF = 128, HTB = HALF * BK * 2, STAGE_BYTES = 8 * HTB, NXCD = 8, WGM = 8;
__device__ __forceinline__ int lds_byte(int r, int c) { const int st = (r >> 4) * 2 + (c >> 5), rr = r & 15, cc = c & 31, ob = rr * 64 + cc * 2; return st * 1024 + (ob ^ (((ob >> 9) & 1) << 5)); }
__device__ __forceinline__ void stage_rc(int b, int& R, int& C) { const int st = b / 1024, sb = b % 1024, swz = sb ^ (((sb >> 9) & 1) << 5); R = (st >> 1) * 16 + swz / 64; C = (st & 1) * 32 + (swz % 64) / 2; }
__device__ __forceinline__ int perm32(int rho) { const int n = rho >> 4, i = rho & 15; return 8 * (i >> 2) + 4 * n + (i & 3); }

struct Unit { const char* A; const char* B; int pm, pn, aux; };

struct DenseOrder {
    const char* A; const char* Bt; int nM, nN, nwg, G, c, K, tid0;
    __device__ void init(const void* A_, const void* Bt_, int M, int N, int K_, int G_, int c_) { A = (const char*)A_; Bt = (const char*)Bt_; nM = M / BM; nN = N / BM; nwg = nM * nN; G = G_; c = c_; K = K_; }
    __device__ __forceinline__ bool next(int i, Unit& u) const {
        const long L = (long)i * G + c; if (L >= nwg) return false;
        int wgid = (int)L; { const int q = nwg / NXCD, r = nwg % NXCD, xcd = wgid % NXCD, off = wgid / NXCD; wgid = (xcd < r ? xcd * (q + 1) : r * (q + 1) + (xcd - r) * q) + off; }
        const int nig = WGM * nN, gid = wgid / nig, fm = gid * WGM, gsz = (nM - fm) < WGM ? (nM - fm) : WGM;
        u.pm = fm + ((wgid % nig) % gsz); u.pn = (wgid % nig) / gsz; u.aux = 0;
        u.A = A + (size_t)u.pm * BM * K * 2; u.B = Bt + (size_t)u.pn * BM * K * 2; return true;
    }
    __device__ __forceinline__ void aoff(const Unit&, int tid, unsigned (&o)[2][2]) const {
#pragma unroll
        for (int i = 0; i < 2; ++i) { int R, C; stage_rc(tid * 16 + i * 8192, R, C);
            o[0][i] = (unsigned)(R * K + C) * 2u; o[1][i] = (unsigned)((R + HALF) * K + C) * 2u; }
    }
};

__device__ __forceinline__ unsigned cvt_pk_bf16(float lo, float hi) { unsigned r; asm volatile("v_cvt_pk_bf16_f32 %0, %1, %2" : "=v"(r) : "v"(lo), "v"(hi)); return r; }

struct EpiF32 {
    static constexpr bool PERM = false;
    float* C; int ldc; const float* bias;
    __device__ __forceinline__ void init(f32x4 (&acc)[2][2][4][2], const Unit&, int, int) const {
#pragma unroll
        for (int a = 0; a < 2; ++a)
#pragma unroll
            for (int b = 0; b < 2; ++b)
#pragma unroll
                for (int m = 0; m < 4; ++m)
#pragma unroll
                    for (int n = 0; n < 2; ++n) acc[a][b][m][n] = (f32x4){0.f, 0.f, 0.f, 0.f}; }
    __device__ __forceinline__ void operator()(const f32x4 (&acc)[2][2][4][2], const Unit& u, int wr, int wc, int fr, int fq) const {
        const int row0 = u.pm * BM + wr * 64 + fr, col0 = u.pn * BM + wc * 32 + 4 * fq;
        f32x4 bv[2][2];
#pragma unroll
        for (int bj = 0; bj < 2; ++bj)
#pragma unroll
            for (int n = 0; n < 2; ++n) bv[bj][n] = bias ? *(const f32x4*)(bias + col0 + bj * HALF + n * 16) : (f32x4){0.f, 0.f, 0.f, 0.f};
#pragma unroll
        for (int ai = 0; ai < 2; ++ai)
#pragma unroll
            for (int m = 0; m < 4; ++m) { float* rowp = C + (size_t)(row0 + ai * HALF + m * 16) * ldc + col0;
#pragma unroll
                for (int bj = 0; bj < 2; ++bj)
#pragma unroll
                    for (int n = 0; n < 2; ++n) *(f32x4*)(rowp + bj * HALF + n * 16) = acc[ai][bj][m][n] + bv[bj][n]; }
    }
};

struct EpiBf16 {
    static constexpr bool PERM = true;
    bf16_t* O; int ldc; const float* bias;
    __device__ __forceinline__ void init(f32x4 (&acc)[2][2][4][2], const Unit&, int, int) const {
#pragma unroll
        for (int a = 0; a < 2; ++a)
#pragma unroll
            for (int b = 0; b < 2; ++b)
#pragma unroll
                for (int m = 0; m < 4; ++m)
#pragma unroll
                    for (int n = 0; n < 2; ++n) acc[a][b][m][n] = (f32x4){0.f, 0.f, 0.f, 0.f}; }
    __device__ __forceinline__ void operator()(const f32x4 (&acc)[2][2][4][2], const Unit& u, int wr, int wc, int fr, int fq) const {
        const int row0 = u.pm * BM + wr * 64 + fr, col0 = u.pn * BM + wc * 32 + 8 * fq;
        f32x4 bv[2][2];
#pragma unroll
        for (int bj = 0; bj < 2; ++bj)
#pragma unroll
            for (int n = 0; n < 2; ++n) bv[bj][n] = *(const f32x4*)(bias + col0 + bj * HALF + 4 * n);
#pragma unroll
        for (int ai = 0; ai < 2; ++ai)
#pragma unroll
            for (int m = 0; m < 4; ++m) { bf16_t* rowp = O + (size_t)(row0 + ai * HALF + m * 16) * ldc + col0;
#pragma unroll
                for (int bj = 0; bj < 2; ++bj) { const f32x4 v0 = acc[ai][bj][m][0] + bv[bj][0], v1 = acc[ai][bj][m][1] + bv[bj][1];
                    u32x4 w; w[0] = cvt_pk_bf16(v0[0], v0[1]); w[1] = cvt_pk_bf16(v0[2], v0[3]); w[2] = cvt_pk_bf16(v1[0], v1[1]); w[3] = cvt_pk_bf16(v1[2], v1[3]);
                    *(u32x4*)(rowp + bj * HALF) = w; } }
    }
};

template <class Epi, class Sched>
__device__ __forceinline__ void gemm_phase(LAS unsigned char* lds, const int K, const Sched& S, const Epi& E) {
    int tid_ = S.tid0; asm volatile("" : "+v"(tid_));
    const int tid = tid_, wid = __builtin_amdgcn_readfirstlane(tid >> 6), lane = tid & 63, wr = wid >> 2, wc = wid & 3, fr = lane & 15, fq = lane >> 4;
    const int nt = K / BK;
    unsigned voffB[2];
#pragma unroll
    for (int i = 0; i < 2; ++i) { int R, C; stage_rc(tid * 16 + i * 8192, R, C); const int Rb = Epi::PERM ? ((R & ~31) + perm32(R & 31)) : R;
        voffB[i] = (unsigned)(Rb * K + C) * 2u; }
    const size_t kstep = (size_t)(BK * 2);
    const size_t hstep = (size_t)HALF * K * 2;
    const unsigned ldsw = (unsigned)wid * 1024u;
    const int aoff = lds_byte(wr * 64 + fr, fq * 8), boff = lds_byte(wc * 32 + fr, fq * 8);
#define G8_SA(b, h) (((b) * 2 + (h)) * HTB)
#define G8_SB(b, h) ((4 + (b) * 2 + (h)) * HTB)
#define G8_STAGE(bufoff, gbase, voff) do { _Pragma("unroll") for (int _i = 0; _i < 2; ++_i) \
        __builtin_amdgcn_global_load_lds((const unsigned*)((const char*)(gbase) + (voff)[_i]), (LAS unsigned*)(lds + (bufoff) + ldsw + _i * 8192), 16, 0, 0); } while (0)
#define G8_LDA(dst, b, h) do { _Pragma("unroll") for (int m = 0; m < 4; ++m) _Pragma("unroll") for (int k = 0; k < 2; ++k) dst[m][k] = *(const LAS bf16x8*)(lds + G8_SA(b, h) + aoff + m * 2048 + k * 1024); } while (0)
#define G8_LDB(dst, b, h) do { _Pragma("unroll") for (int n = 0; n < 2; ++n) _Pragma("unroll") for (int k = 0; k < 2; ++k) dst[n][k] = *(const LAS bf16x8*)(lds + G8_SB(b, h) + boff + n * 2048 + k * 1024); } while (0)
#define G8_MMA(ai, bj, At, Bt) do { __builtin_amdgcn_s_setprio(1); _Pragma("unroll") for (int m = 0; m < 4; ++m) _Pragma("unroll") for (int n = 0; n < 2; ++n) _Pragma("unroll") for (int k = 0; k < 2; ++k) \
        acc[ai][bj][m][n] = __builtin_amdgcn_mfma_f32_16x16x32_bf16(Bt[n][k], At[m][k], acc[ai][bj][m][n], 0, 0, 0); __builtin_amdgcn_s_setprio(0); } while (0)
#define G8_WAIT_V(n) asm volatile("s_waitcnt vmcnt(" #n ")" ::: "memory")
#define G8_WAIT_L(n) asm volatile("s_waitcnt lgkmcnt(" #n ")" ::: "memory")
#define G8_BAR __builtin_amdgcn_s_barrier()
#define G8_SCHED __builtin_amdgcn_sched_barrier(0)
    Unit cur, nxt; int ui = 0;
    if (!S.next(0, cur)) return;
    f32x4 acc[2][2][4][2];
    E.init(acc, cur, wc, fq);
    bf16x8 At[4][2], B0[2][2], B1[2][2];
    unsigned oc[2][2];
    S.aoff(cur, tid, oc);
    const char* cA = cur.A; const char* cB = cur.B;
    G8_STAGE(G8_SB(0, 0), cB, voffB); G8_STAGE(G8_SA(0, 0), cA, oc[0]); G8_STAGE(G8_SB(0, 1), cB + hstep, voffB); G8_STAGE(G8_SA(0, 1), cA, oc[1]);
    if (wr == 1) G8_BAR;
    G8_WAIT_V(4); G8_BAR;
    G8_STAGE(G8_SB(1, 0), cB + kstep, voffB); G8_STAGE(G8_SA(1, 0), cA + kstep, oc[0]); G8_STAGE(G8_SB(1, 1), cB + hstep + kstep, voffB);
    G8_WAIT_V(6); G8_BAR;
    for (;;) {
        const bool has_next = S.next(ui + 1, nxt);
        const char* nA = has_next ? nxt.A : cA; const char* nB = has_next ? nxt.B : cB;
#pragma unroll 1
        for (int t = 0; t < nt; t += 2) {
            const bool last = (t == nt - 2);
            const char* a1 = cA + (size_t)(t + 1) * kstep;
            const char* a2 = last ? nA : cA + (size_t)(t + 2) * kstep; const char* b2 = last ? nB : cB + (size_t)(t + 2) * kstep;
            const char* a3 = a2 + kstep; const char* b3 = b2 + kstep;
            G8_LDB(B0, 0, 0); G8_SCHED; G8_LDA(At, 0, 0); G8_STAGE(G8_SA(1, 1), a1, oc[1]);
            if (last && has_next) S.aoff(nxt, tid, oc);
            G8_WAIT_L(8); G8_BAR; G8_WAIT_L(0); G8_MMA(0, 0, At, B0); G8_BAR; G8_SCHED;
            G8_LDB(B1, 0, 1); G8_STAGE(G8_SB(0, 0), b2, voffB);
            G8_BAR; G8_WAIT_L(0); G8_MMA(0, 1, At, B1); G8_BAR;
            G8_LDA(At, 0, 1); G8_STAGE(G8_SA(0, 0), a2, oc[0]);
            G8_BAR; G8_WAIT_L(0); G8_MMA(1, 0, At, B0); G8_BAR; G8_SCHED;
            G8_STAGE(G8_SB(0, 1), b2 + hstep, voffB);
            G8_WAIT_V(6); G8_BAR; G8_MMA(1, 1, At, B1); G8_BAR;
            G8_LDB(B0, 1, 0); G8_SCHED; G8_LDA(At, 1, 0); G8_STAGE(G8_SA(0, 1), a2, oc[1]);
            G8_WAIT_L(8); G8_BAR; G8_WAIT_L(0); G8_MMA(0, 0, At, B0); G8_BAR; G8_SCHED;
            G8_LDB(B1, 1, 1); G8_STAGE(G8_SB(1, 0), b3, voffB);
            G8_BAR; G8_WAIT_L(0); G8_MMA(0, 1, At, B1); G8_BAR;
            G8_LDA(At, 1, 1); G8_STAGE(G8_SA(1, 0), a3, oc[0]);
            G8_BAR; G8_WAIT_L(0); G8_MMA(1, 0, At, B0); G8_BAR; G8_SCHED;
            G8_STAGE(G8_SB(1, 1), b3 + hstep, voffB);
            G8_WAIT_V(6); G8_BAR; G8_MMA(1, 1, At, B1); G8_BAR;
        }
        E(acc, cur, wr, wc, fr, fq);
        if (!has_next) break;
        cur = nxt; cA = nA; cB = nB; ++ui;
        E.init(acc, cur, wc, fq);
    }
    G8_WAIT_V(0);
    if (wr == 0) G8_BAR;
    G8_BAR;
#undef G8_SA
#undef G8_SB
#undef G8_STAGE
#undef G8_LDA
#undef G8_LDB
#undef G8_MMA
#undef G8_WAIT_V
#undef G8_WAIT_L
#undef G8_BAR
#undef G8_SCHED
}
}

constexpr int NTHREADS = 512;
constexpr int LDS_STAGE = 0;
constexpr int LDS_TAB   = g8::STAGE_BYTES;
constexpr int TAB_SLOTS = 6;
constexpr int LDS_GTAB  = LDS_TAB + TAB_SLOTS * 256 * 4;
constexpr int LDS_DESC  = LDS_GTAB + TAB_SLOTS * 256 * 4;
constexpr int LDS_PREF  = LDS_DESC + 64;
constexpr int LDS_MISC  = 147456 - 64;
constexpr int LDS_BYTES = 147456;
static_assert(LDS_MISC % 16 == 0 && LDS_MISC + 64 <= LDS_BYTES && LDS_PREF + 132 * 4 <= LDS_MISC, "LDS map");

#define GAS __attribute__((address_space(1)))
struct Params { const GAS float* in[31]; GAS float* out; GAS unsigned char* ws; int ph_lo, ph_hi; };

struct Ctx {
    const GAS float* const* in; float* out; unsigned char* ws; LAS unsigned char* lds;
    __device__ __forceinline__ const float* inp(int k) const { return (const float*)in[k]; }
    int tid, lane, wid, bid, G, gtid, gthreads, gw, nwaves;
};

__device__ __forceinline__ int ab_phys(int n) {
    if (n < 1024) { const int hd = n >> 6, jj = n & 63; return (hd >> 2) * 256 + (jj >> 5) * 128 + (hd & 3) * 32 + (jj & 31); }
    if (n < 1152) { const int nn = n - 1024, hh = nn >> 6, jj = nn & 63; return 1024 + (jj >> 5) * 128 + hh * 32 + (jj & 31); }
    if (n < 1280) { const int vv = n - 1152; return 1024 + (vv >> 6) * 128 + 64 + (vv & 63); }
    if (n < 2304) { const int base = n < 1792 ? 1280 : 1792, nn = n - base, h = nn >> 7, jj = nn & 127; return base + (h >> 1) * 256 + (jj >> 6) * 128 + (h & 1) * 64 + (jj & 63); }
    return n;
}
template <int TN, class DstFn>
__device__ __forceinline__ void convert_T(const Ctx& c, const float* src, int nmat, int K, int N, DstFn dstfn) {
    LAS float* tile = (LAS float*)(c.lds);
    constexpr int LDT = TN + 1, TPR = TN / 4  , KPI = NTHREADS / TPR  , NI = 64 / KPI, KPT = 64 * TN / NTHREADS  ;
    const int tk = K / 64, tn = N / TN; const long ntiles = (long)nmat * tk * tn;
    f32x4 v[NI];
    auto issue = [&](long tix) { const int m = (int)(tix / (tk * tn)); const int rem = (int)(tix % (tk * tn)); const int kt = rem / tn, nt = rem % tn;
        const float* s = src + (size_t)m * K * N + (size_t)(kt * 64) * N + nt * TN;
#pragma unroll
        for (int i = 0; i < NI; ++i) { const int k = c.tid / TPR + KPI * i, n4 = (c.tid % TPR) * 4; v[i] = __builtin_nontemporal_load((const f32x4*)(s + (size_t)k * N + n4)); } };
    if (c.bid < ntiles) issue(c.bid);
    for (long tix = c.bid; tix < ntiles; tix += c.G) {
        const int m = (int)(tix / (tk * tn)); const int rem = (int)(tix % (tk * tn)); const int kt = rem / tn, nt = rem % tn;
#pragma unroll
        for (int i = 0; i < NI; ++i) { const int k = c.tid / TPR + KPI * i, n4 = (c.tid % TPR) * 4;
            tile[k * LDT + n4 + 0] = v[i][0]; tile[k * LDT + n4 + 1] = v[i][1]; tile[k * LDT + n4 + 2] = v[i][2]; tile[k * LDT + n4 + 3] = v[i][3]; }
        if (tix + c.G < ntiles) issue(tix + c.G);
        __syncthreads();
        { constexpr int TPN = 64 / KPT; const int n = c.tid / TPN, k0 = (c.tid % TPN) * KPT;
          bf16_t* d = dstfn(m, nt * TN + n) + kt * 64 + k0;
#pragma unroll
          for (int q = 0; q < KPT / 8; ++q) { u32x4 w;
#pragma unroll
              for (int e = 0; e < 4; ++e) w[e] = pk2(tile[(k0 + q * 8 + 2 * e) * LDT + n], tile[(k0 + q * 8 + 2 * e + 1) * LDT + n]);
              *(u32x4*)(d + q * 8) = w; } }
        __syncthreads();
    }
}

__device__ __forceinline__ void phase_convert(const Ctx& c) {
    unsigned char* ws = c.ws;
    { const float* x = c.inp(0); bf16_t* xb = (bf16_t*)(ws + WS_XB);
      for (long i = c.gtid; i < (long)T * D / 4; i += c.gthreads) { const f32x4 v = *(const f32x4*)(x + i * 4); u32x2 w; w[0] = pk2(v[0], v[1]); w[1] = pk2(v[2], v[3]); *(u32x2*)(xb + i * 4) = w; } }
    { bf16_t* wrt = (bf16_t*)(ws + WS_WRT); for (long i = c.gtid; i < (long)4 * 128 * D / 8; i += c.gthreads) { const long l = i / (128 * D / 8), r = i % (128 * D / 8); *(u32x4*)(wrt + (size_t)l * 256 * D + (size_t)128 * D + r * 8) = (u32x4){0u, 0u, 0u, 0u}; }
      float* gate = (float*)(ws + WS_GATE); for (int i = c.gtid; i < T; i += c.gthreads) gate[TK + i] = 1.f;
      f32x2* ra = (f32x2*)(ws + WS_ROPEA); f32x2* rr = (f32x2*)(ws + WS_ROPER);
      for (int i = c.gtid; i < SEQ * 96; i += c.gthreads) { const int sidx = i / 96, q = i % 96; const bool isA = q < 32; const int jx = isA ? q : q - 32;
          const float e = isA ? (float)jx * (1.f / 32.f) : (float)jx * (1.f / 63.f); const float ang = (float)sidx * exp2f(-e * 13.287712379549449f); float sn, cs; sincosf(ang, &sn, &cs);
          if (isA) ra[sidx * 32 + jx] = (f32x2){cs, sn}; else rr[sidx * 64 + jx] = (f32x2){cs, sn}; }
      float* bp = (float*)(ws + WS_BIASP); for (int i = c.gtid; i < 2 * AB_IN; i += c.gthreads) { const int m = i / AB_IN, n = i % AB_IN; bp[m * AB_IN + ab_phys(n)] = c.inp(2)[i]; } }
    { bf16_t* d = (bf16_t*)(ws + WS_WABIN);  convert_T<256>(c, c.inp(1), 2, D, AB_IN, [=](int m, int n) { return d + (size_t)m * AB_IN * D + (size_t)ab_phys(n) * D; }); }
    { bf16_t* d = (bf16_t*)(ws + WS_WABOUT); convert_T<256>(c, c.inp(4), 2, AB_OUT, D, [=](int m, int n) { return d + (size_t)m * D * AB_OUT + (size_t)n * AB_OUT; }); }
    { bf16_t* d = (bf16_t*)(ws + WS_WCDIN);  convert_T<256>(c, c.inp(6), 2, D, CD_IN, [=](int m, int n) { return d + (size_t)m * CD_IN * D + (size_t)n * D; }); }
    { bf16_t* d = (bf16_t*)(ws + WS_WCDOUT); convert_T<256>(c, c.inp(17), 2, CD_OUT, D, [=](int m, int n) { return d + (size_t)m * D * CD_OUT + (size_t)n * CD_OUT; }); }
    { bf16_t* d = (bf16_t*)(ws + WS_WRT);    convert_T<128>(c, c.inp(21), 4, D, NE, [=](int m, int n) { return d + (size_t)m * 256 * D + (size_t)n * D; }); }
    { bf16_t* d = (bf16_t*)(ws + WS_WGU);
      convert_T<256>(c, c.inp(23), 4 * NE, D, ED, [=](int m, int n) { return d + (size_t)((m >> 7) * NE1 + (m & 127)) * 512 * D + (size_t)((n >> 7) * 256 + (n & 127)) * D; });
      convert_T<256>(c, c.inp(24), 4 * NE, D, ED, [=](int m, int n) { return d + (size_t)((m >> 7) * NE1 + (m & 127)) * 512 * D + (size_t)((n >> 7) * 256 + 128 + (n & 127)) * D; });
      convert_T<256>(c, c.inp(26), 4, D, ED, [=](int m, int n) { return d + (size_t)(m * NE1 + NE) * 512 * D + (size_t)((n >> 7) * 256 + (n & 127)) * D; });
      convert_T<256>(c, c.inp(27), 4, D, ED, [=](int m, int n) { return d + (size_t)(m * NE1 + NE) * 512 * D + (size_t)((n >> 7) * 256 + 128 + (n & 127)) * D; }); }
    { bf16_t* d = (bf16_t*)(ws + WS_WLRU);
      convert_T<256>(c, c.inp(12), 10, 256, 256, [=](int m, int n) { return d + (size_t)(m * 2 + 0) * 65536 + (size_t)n * 256; });
      convert_T<256>(c, c.inp(14), 10, 256, 256, [=](int m, int n) { return d + (size_t)(m * 2 + 1) * 65536 + (size_t)n * 256; });
      float* spl = (float*)(ws + WS_SPL); for (int i = c.gtid; i < 2 * 1280; i += c.gthreads) spl[i] = log1pf(expf(-c.inp(16)[i])); }
    { bf16_t* d = (bf16_t*)(ws + WS_WDN);
      convert_T<256>(c, c.inp(25), 4 * NE, ED, D, [=](int m, int n) { return d + (size_t)((m >> 7) * NE1 + (m & 127)) * D * ED + (size_t)n * ED; });
      convert_T<256>(c, c.inp(28), 4, ED, D, [=](int m, int n) { return d + (size_t)(m * NE1 + NE) * D * ED + (size_t)n * ED; }); }
}

__device__ __forceinline__ void phase_dense(const Ctx& c, const bf16_t* A, const bf16_t* Bt, int M, int N, int K, bf16_t* C, int ldc, const float* bias) {
    g8::DenseOrder S; S.init(A, Bt, M, N, K, c.G, c.bid); S.tid0 = c.tid;
    g8::EpiBf16 E{C, ldc, bias};
    g8::gemm_phase<g8::EpiBf16, g8::DenseOrder>(c.lds + LDS_STAGE, K, S, E);
}

__device__ __forceinline__ void st_bf16_off(unsigned char* base, unsigned byte_off, float v) { *(bf16_t*)(base + byte_off) = f2bf(v); }
struct EpiABIn {
    static constexpr bool PERM = true;
    LAS bf16_t* biasL; unsigned char* ws;
    __device__ __forceinline__ void init(f32x4 (&acc)[2][2][4][2], const g8::Unit& u, int wc, int fq) const {
        const int colp = u.pn * 256 + wc * 32 + fq * 8;
#pragma unroll
        for (int b = 0; b < 2; ++b)
#pragma unroll
            for (int n = 0; n < 2; ++n) { const u32x2 bw = *(const LAS u32x2*)(biasL + colp + b * 128 + 4 * n);
                const f32x4 bv = (f32x4){__uint_as_float(bw[0] << 16), __uint_as_float(bw[0] & 0xffff0000u), __uint_as_float(bw[1] << 16), __uint_as_float(bw[1] & 0xffff0000u)};
#pragma unroll
                for (int a = 0; a < 2; ++a)
#pragma unroll
                    for (int m = 0; m < 4; ++m) acc[a][b][m][n] = bv; } }
    __device__ __forceinline__ void operator()(const f32x4 (&acc)[2][2][4][2], const g8::Unit& u, int wr, int wc, int fr_, int fq_) const {
        int fr = fr_, fq = fq_; asm volatile("" : "+v"(fr), "+v"(fq));
        const int pn = u.pn; const int colp = pn * 256 + wc * 32 + fq * 8;
        bf16_t* qb = (bf16_t*)(ws + AB_QB); bf16_t* kb = (bf16_t*)(ws + AB_KB); bf16_t* vT = (bf16_t*)(ws + AB_VT); bf16_t* rqb = (bf16_t*)(ws + AB_RQB); bf16_t* rkb = (bf16_t*)(ws + AB_RKB);
        bf16_t* rkdT = (bf16_t*)(ws + AB_RKDT); bf16_t* rvT = (bf16_t*)(ws + AB_RVT); bf16_t* rgb = (bf16_t*)(ws + AB_RGB);
        const float frqA0 = exp2f(-(float)(fq * 8) * (13.287712379549449f / 32.f)) * 0.15915494309189535f;
        const float frqR0 = exp2f(-(float)((wc & 1) * 32 + fq * 8) * (13.287712379549449f / 63.f)) * 0.15915494309189535f;
        constexpr float RA[8] = {1.f, 0.7498942093324559f, 0.5623413251903491f, 0.4216965034285822f, 0.31622776601683794f, 0.23713737056616552f, 0.1778279410038923f, 0.1333521432163324f};
        constexpr float RR[8] = {1.f, 0.8639884494839686f, 0.746476040841712f, 0.6449466771037624f, 0.5572264795507174f, 0.4814372420784346f, 0.4159562163071847f, 0.35938136638046275f};
#pragma unroll
        for (int ai = 0; ai < 2; ++ai)
#pragma unroll
            for (int m = 0; m < 4; ++m) {
                const int t = u.pm * 256 + ai * 128 + wr * 64 + m * 16 + fr, sq = t & (SEQ - 1), b = t >> 13;
                f32x4 x[2][2];
#pragma unroll
                for (int bj = 0; bj < 2; ++bj)
#pragma unroll
                    for (int n = 0; n < 2; ++n) x[bj][n] = acc[ai][bj][m][n];
                if (pn < 4 || (pn == 4 && wc < 2)) {
                    const int j0 = fq * 8; const float sc = pn < 4 ? 0.125f : 1.f;
                    u32x4 w1, w2;
#pragma unroll
                    for (int n = 0; n < 2; ++n) { f32x4 o1, o2;
#pragma unroll
                        for (int e = 0; e < 4; ++e) { const float rev = __builtin_amdgcn_fractf((float)sq * (frqA0 * RA[4 * n + e])); const float cc = __builtin_amdgcn_cosf(rev) * sc, ss = __builtin_amdgcn_sinf(rev) * sc;
                            o1[e] = x[0][n][e] * cc - x[1][n][e] * ss; o2[e] = x[1][n][e] * cc + x[0][n][e] * ss; }
                        w1[2 * n] = pk2(o1[0], o1[1]); w1[2 * n + 1] = pk2(o1[2], o1[3]); w2[2 * n] = pk2(o2[0], o2[1]); w2[2 * n + 1] = pk2(o2[2], o2[3]); }
                    bf16_t* dst = pn < 4 ? qb + (size_t)t * 1024 + (pn * 4 + wc) * 64 + j0 : kb + (size_t)t * 128 + wc * 64 + j0;
                    *(u32x4*)dst = w1; *(u32x4*)(dst + 32) = w2;
                } else if (pn == 4) {
                    const int d0 = (wc - 2) * 32 + fq * 8;
#pragma unroll
                    for (int bj = 0; bj < 2; ++bj)
#pragma unroll
                        for (int n = 0; n < 2; ++n)
#pragma unroll
                            for (int e = 0; e < 4; ++e) st_bf16_off((unsigned char*)vT, (unsigned)((((b * 2 + bj) * 64 + d0 + 4 * n + e) * SEQ + sq) * 2), x[bj][n][e]);
                } else if (pn < 9) {
                    const bool isk = pn >= 7; const int h = ((pn - 5) & 1) * 2 + (wc >> 1), j0 = (wc & 1) * 32 + fq * 8;
                    const float sc = isk ? 0.08838834764831845f : 1.f;
                    const unsigned dToff = (unsigned)((((b * 4 + h) * 128 + j0) * SEQ + sq) * 2);
                    u32x4 w1, w2;
#pragma unroll
                    for (int n = 0; n < 2; ++n) { f32x4 o1, o2;
#pragma unroll
                        for (int e = 0; e < 4; ++e) { const float rev = __builtin_amdgcn_fractf((float)sq * (frqR0 * RR[4 * n + e])); const float cc = __builtin_amdgcn_cosf(rev) * sc, ss = __builtin_amdgcn_sinf(rev) * sc;
                            o1[e] = x[0][n][e] * cc - x[1][n][e] * ss; o2[e] = x[1][n][e] * cc + x[0][n][e] * ss; }
                        w1[2 * n] = pk2(o1[0], o1[1]); w1[2 * n + 1] = pk2(o1[2], o1[3]); w2[2 * n] = pk2(o2[0], o2[1]); w2[2 * n + 1] = pk2(o2[2], o2[3]);
                        if (isk) {
#pragma unroll
                            for (int e = 0; e < 4; ++e) { st_bf16_off((unsigned char*)rkdT, dToff + (unsigned)((4 * n + e) * SEQ * 2), o1[e]); st_bf16_off((unsigned char*)rkdT, dToff + (unsigned)((64 + 4 * n + e) * SEQ * 2), o2[e]); } } }
                    bf16_t* dst = (isk ? rkb : rqb) + (size_t)t * 512 + h * 128 + j0;
                    *(u32x4*)dst = w1; *(u32x4*)(dst + 64) = w2;
                } else if (pn < 13) {
                    const int h = pn - 9;
#pragma unroll
                    for (int bj = 0; bj < 2; ++bj)
#pragma unroll
                        for (int n = 0; n < 2; ++n)
#pragma unroll
                            for (int e = 0; e < 4; ++e) st_bf16_off((unsigned char*)rvT, (unsigned)((((b * 4 + h) * 256 + bj * 128 + wc * 32 + fq * 8 + 4 * n + e) * SEQ + sq) * 2), x[bj][n][e]);
                } else {
#pragma unroll
                    for (int bj = 0; bj < 2; ++bj) { u32x4 w;
#pragma unroll
                        for (int n = 0; n < 2; ++n) { const f32x4 sv = silu4(x[bj][n]); w[2 * n] = pk2(sv[0], sv[1]); w[2 * n + 1] = pk2(sv[2], sv[3]); }
                        *(u32x4*)(rgb + (size_t)t * 1024 + (pn - 13) * 256 + bj * 128 + wc * 32 + fq * 8) = w; }
                }
            }
    }
};
__device__ __forceinline__ void phase_ab_inproj(const Ctx& c, int j) {
    g8::DenseOrder S; S.init(c.ws + WS_XB, c.ws + WS_WABIN + (size_t)j * AB_IN * D * 2, T, AB_IN, D, c.G, c.bid); S.tid0 = c.tid;
    LAS bf16_t* biasL = (LAS bf16_t*)(c.lds + LDS_TAB);
    { const float* bp = (const float*)(c.ws + WS_BIASP) + (size_t)j * AB_IN; for (int i = c.tid; i < AB_IN; i += NTHREADS) biasL[i] = f2bf(bp[i]); }
    __syncthreads();
    EpiABIn E{biasL, c.ws};
    g8::gemm_phase<EpiABIn, g8::DenseOrder>(c.lds + LDS_STAGE, D, S, E);
}

#define MFMA16(a, b, c) __builtin_amdgcn_mfma_f32_16x16x32_bf16((a), (b), (c), 0, 0, 0)
__device__ __forceinline__ bf16x8 pack8(const f32x4& lo, const f32x4& hi) { u32x4 w; w[0] = g8::cvt_pk_bf16(lo[0], lo[1]); w[1] = g8::cvt_pk_bf16(lo[2], lo[3]); w[2] = g8::cvt_pk_bf16(hi[0], hi[1]); w[3] = g8::cvt_pk_bf16(hi[2], hi[3]); return __builtin_bit_cast(bf16x8, w); }
__device__ __forceinline__ bf16x8 cat8(const u32x2& lo, const u32x2& hi) { u32x4 w; w[0] = lo[0]; w[1] = lo[1]; w[2] = hi[0]; w[3] = hi[1]; return __builtin_bit_cast(bf16x8, w); }
template <int ROWS, int RB, int PAD = 32>
__device__ __forceinline__ void tile_g2l(LAS unsigned char* dst, const unsigned char* src, size_t gs, int tid, int zrows = 0) {
    constexpr int CPR = RB / 16, TOTAL = ROWS * CPR;
#pragma unroll 8
    for (int i = tid; i < TOTAL; i += NTHREADS) { const int r = i / CPR, cc = i % CPR; u32x4 v = (u32x4){0u, 0u, 0u, 0u}; if (r >= zrows) v = *(const u32x4*)(src + (size_t)r * gs + cc * 16);
        *(LAS u32x4*)(dst + r * (RB + PAD) + cc * 16) = v; }
}

__device__ __forceinline__ void attn_unit(const Ctx& c, int unit, const float* sinks) {
    const int b = unit >> 7, n = (unit >> 1) & 63, kvh = unit & 1, hd = kvh * 8 + c.wid, lane = c.lane, fr = lane & 15, fq = lane >> 4;
    const bf16_t* qb = (const bf16_t*)(c.ws + AB_QB); const bf16_t* kb = (const bf16_t*)(c.ws + AB_KB); const bf16_t* vT = (const bf16_t*)(c.ws + AB_VT); bf16_t* ycat = (bf16_t*)(c.ws + WS_YCAT);
    LAS unsigned char* Ks = c.lds; LAS unsigned char* Vs = c.lds + 256 * 160;
    const int t0 = b * SEQ + n * 128;
    __syncthreads();
    {
        const unsigned char* src = (const unsigned char*)(kb + (size_t)(t0 - 128) * 128 + kvh * 64);
        constexpr int TOTAL = 256 * 8;
#pragma unroll 4
        for (int i = c.tid; i < TOTAL; i += NTHREADS) { const int r = i >> 3, cc = i & 7; u32x4 v = (u32x4){0u, 0u, 0u, 0u}; if (n > 0 || r >= 128) v = *(const u32x4*)(src + (ptrdiff_t)r * 256 + cc * 16);
            *(LAS u32x4*)(Ks + r * 160 + cc * 16) = v; }
        const unsigned char* vsrc = (const unsigned char*)(vT + (size_t)(b * 2 + kvh) * 64 * SEQ + (n * 128 - 128));
        constexpr int TV = 64 * 32;
#pragma unroll 4
        for (int i = c.tid; i < TV; i += NTHREADS) { const int r = i >> 5, cc = i & 31; u32x4 v = (u32x4){0u, 0u, 0u, 0u}; if (n > 0 || cc >= 16) v = *(const u32x4*)(vsrc + (ptrdiff_t)r * SEQ * 2 + cc * 16);
            *(LAS u32x4*)(Vs + r * 528 + cc * 16) = v; }
    }
    __syncthreads();
    const float sink = sinks[hd];
    bf16x8 qn[2];
#pragma unroll
    for (int ks = 0; ks < 2; ++ks) qn[ks] = *(const bf16x8*)(qb + (size_t)(t0 + fr) * 1024 + hd * 64 + ks * 32 + fq * 8);
    for (int si = 0; si < 8; ++si) {
        const int t = t0 + si * 16 + fr;
        bf16x8 qf[2]; qf[0] = qn[0]; qf[1] = qn[1];
        if (si < 7) {
#pragma unroll
            for (int ks = 0; ks < 2; ++ks) qn[ks] = *(const bf16x8*)(qb + (size_t)(t + 16) * 1024 + hd * 64 + ks * 32 + fq * 8); }
        f32x4 S[10];
#pragma unroll
        for (int nk = 0; nk < 9; nk += 3) { bf16x8 kfr[3][2];
#pragma unroll
            for (int u = 0; u < 3; ++u)
#pragma unroll
                for (int ks = 0; ks < 2; ++ks) kfr[u][ks] = *(const LAS bf16x8*)(Ks + (16 * (si + nk + u) + fr) * 160 + ks * 64 + fq * 16);
            __builtin_amdgcn_sched_barrier(0);
#pragma unroll
            for (int u = 0; u < 3; ++u) { S[nk + u] = (f32x4){0.f, 0.f, 0.f, 0.f};
#pragma unroll
                for (int ks = 0; ks < 2; ++ks) S[nk + u] = MFMA16(kfr[u][ks], qf[ks], S[nk + u]); } }
        S[9] = (f32x4){0.f, 0.f, 0.f, 0.f};
        const int i = si * 16 + fr;
        float mx = sink;
#pragma unroll
        for (int nk = 0; nk < 9; ++nk)
#pragma unroll
            for (int r = 0; r < 4; ++r) { const int p = 16 * (si + nk) + 4 * fq + r; const bool ok = (p >= i + 1) && (p <= i + 128) && (n > 0 || p >= 128);
                S[nk][r] = ok ? S[nk][r] : -1e30f; mx = fmaxf(mx, S[nk][r]); }
        mx = fmaxf(mx, __shfl_xor(mx, 16)); mx = fmaxf(mx, __shfl_xor(mx, 32));
        float sum = 0.f;
#pragma unroll
        for (int nk = 0; nk < 9; ++nk)
#pragma unroll
            for (int r = 0; r < 4; ++r) { const float pv = S[nk][r] > -1e29f ? __builtin_amdgcn_exp2f((S[nk][r] - mx) * 1.4426950408889634f) : 0.f; S[nk][r] = pv; sum += pv; }
        sum += __shfl_xor(sum, 16); sum += __shfl_xor(sum, 32);
        const float inv = 1.f / (sum + exp2f((sink - mx) * 1.4426950408889634f));
        f32x4 O[4];
#pragma unroll
        for (int nd = 0; nd < 4; ++nd) O[nd] = (f32x4){0.f, 0.f, 0.f, 0.f};
#pragma unroll
        for (int kk = 0; kk < 5; ++kk) { const bf16x8 pf = pack8(S[2 * kk], S[2 * kk + 1]);
            const int p0 = 16 * (si + 2 * kk) + 4 * fq, p1 = (kk == 4 && si == 7) ? p0 : p0 + 16;
            u32x2 lo[4], hi[4];
#pragma unroll
            for (int nd = 0; nd < 4; ++nd) { lo[nd] = *(const LAS u32x2*)(Vs + (16 * nd + fr) * 528 + p0 * 2); hi[nd] = *(const LAS u32x2*)(Vs + (16 * nd + fr) * 528 + p1 * 2); }
            __builtin_amdgcn_sched_barrier(0);
#pragma unroll
            for (int nd = 0; nd < 4; ++nd) O[nd] = MFMA16(cat8(lo[nd], hi[nd]), pf, O[nd]); }
#pragma unroll
        for (int nd = 0; nd < 4; ++nd) { u32x2 w; w[0] = pk2(O[nd][0] * inv, O[nd][1] * inv); w[1] = pk2(O[nd][2] * inv, O[nd][3] * inv);
            *(u32x2*)(ycat + (size_t)t * AB_OUT + hd * 64 + 16 * nd + 4 * fq) = w; }
    }
}

__device__ __forceinline__ void ret_kv_unit(const Ctx& c, int unit) {
    const int b = unit >> 8, n = (unit >> 2) & 63, h = unit & 3, lane = c.lane, fr = lane & 15, fq = lane >> 4, w = c.wid;
    const bf16_t* rkdT = (const bf16_t*)(c.ws + AB_RKDT); const bf16_t* rvT = (const bf16_t*)(c.ws + AB_RVT); float* kv = (float*)(c.ws + AB_KV);
    LAS unsigned char* Kd = c.lds;
    __syncthreads();
    {
        const float lg = log2f(1.f - exp2f(-5.f - (float)h)); const int cc = c.tid & 15;
        float dec[8];
#pragma unroll
        for (int e = 0; e < 8; ++e) dec[e] = __builtin_amdgcn_exp2f((float)(127 - (cc * 8 + e)) * lg);
        const unsigned char* src = (const unsigned char*)(rkdT + (size_t)(b * 4 + h) * 128 * SEQ + n * 128);
#pragma unroll
        for (int q = 0; q < 4; ++q) { const int r = (c.tid >> 4) + 32 * q; const u32x4 v = *(const u32x4*)(src + (size_t)r * SEQ * 2 + cc * 16); u32x4 o;
#pragma unroll
            for (int e2 = 0; e2 < 4; ++e2) o[e2] = pk2(__uint_as_float(v[e2] << 16) * dec[2 * e2], __uint_as_float(v[e2] & 0xffff0000u) * dec[2 * e2 + 1]);
            *(LAS u32x4*)(Kd + r * 288 + cc * 16) = o; }
    }
    bf16x8 vf[2][4];
#pragma unroll
    for (int ne = 0; ne < 2; ++ne)
#pragma unroll
        for (int ks = 0; ks < 4; ++ks) vf[ne][ks] = *(const bf16x8*)(rvT + ((size_t)(b * 4 + h) * 256 + 32 * w + 16 * ne + fr) * SEQ + n * 128 + ks * 32 + fq * 8);
    __syncthreads();
    float* out = kv + ((size_t)((b * 64 + n) * 4 + h)) * 256 * 128;
#pragma unroll
    for (int nd = 0; nd < 8; ++nd) { f32x4 a0 = (f32x4){0.f, 0.f, 0.f, 0.f}, a1 = a0;
        bf16x8 kf[4];
#pragma unroll
        for (int ks = 0; ks < 4; ++ks) kf[ks] = *(const LAS bf16x8*)(Kd + (16 * nd + fr) * 288 + ks * 64 + fq * 16);
        __builtin_amdgcn_sched_barrier(0);
#pragma unroll
        for (int ks = 0; ks < 4; ++ks) { a0 = MFMA16(kf[ks], vf[0][ks], a0); a1 = MFMA16(kf[ks], vf[1][ks], a1); }
        *(f32x4*)(out + (size_t)(32 * w + fr) * 128 + 16 * nd + 4 * fq) = a0; *(f32x4*)(out + (size_t)(32 * w + 16 + fr) * 128 + 16 * nd + 4 * fq) = a1; }
}
__device__ __forceinline__ void ret_scan(const Ctx& c, int first_block, int nblocks) {
    const float* kv = (const float*)(c.ws + AB_KV); bf16_t* sp = (bf16_t*)(c.ws + AB_SPREV);
    const int nthr = nblocks * NTHREADS;
    typedef float f32x2s __attribute__((ext_vector_type(2)));
    for (int idx = (c.bid - first_block) * NTHREADS + c.tid; idx < 2 * 4 * 256 * 128 / 2; idx += nthr) {
        const int b = idx >> 16, rem = idx & 65535, h = rem >> 14;
        const float g = exp2f(128.f * log2f(1.f - exp2f(-5.f - (float)h)));
        const size_t base = (size_t)b * 64 * 131072 + (size_t)rem * 2;
        f32x2s v[64];
#pragma unroll
        for (int q = 0; q < 64; ++q) v[q] = *(const f32x2s*)(kv + base + (size_t)q * 131072);
        f32x2s st = (f32x2s){0.f, 0.f};
#pragma unroll
        for (int q = 0; q < 64; ++q) { *(unsigned*)(sp + base + (size_t)q * 131072) = pk2(st[0], st[1]); st = st * g + v[q]; }
    }
}
__device__ __forceinline__ void ret_out_unit(const Ctx& c, int unit) {
    const int b = unit >> 8, n = (unit >> 2) & 63, h = unit & 3, lane = c.lane, fr = lane & 15, fq = lane >> 4, w = c.wid;
    const bf16_t* rqb = (const bf16_t*)(c.ws + AB_RQB); const bf16_t* rkb = (const bf16_t*)(c.ws + AB_RKB); const bf16_t* rvT = (const bf16_t*)(c.ws + AB_RVT);
    const bf16_t* sp = (const bf16_t*)(c.ws + AB_SPREV); const bf16_t* rgb = (const bf16_t*)(c.ws + AB_RGB); bf16_t* ycat = (bf16_t*)(c.ws + WS_YCAT);
    LAS unsigned char* Kl = c.lds; LAS unsigned char* Bl = c.lds + 128 * 288;
    const int t0 = b * SEQ + n * 128; const float lg = log2f(1.f - exp2f(-5.f - (float)h));
    __syncthreads();
    tile_g2l<128, 256>(Kl, (const unsigned char*)(rkb + (size_t)t0 * 512 + h * 128), (size_t)512 * 2, c.tid);
    tile_g2l<256, 256>(Bl, (const unsigned char*)(sp + ((size_t)((b * 64 + n) * 4 + h)) * 256 * 128), (size_t)128 * 2, c.tid);
    const int t = t0 + 16 * w + fr, i = 16 * w + fr;
    bf16x8 qf[4];
#pragma unroll
    for (int ks = 0; ks < 4; ++ks) qf[ks] = *(const bf16x8*)(rqb + (size_t)t * 512 + h * 128 + ks * 32 + fq * 8);
    __syncthreads();
    bf16x8 pf[4];
#pragma unroll
    for (int kk = 0; kk < 4; ++kk) { f32x4 s2[2];
#pragma unroll
        for (int q = 0; q < 2; ++q) { const int nj = 2 * kk + q; s2[q] = (f32x4){0.f, 0.f, 0.f, 0.f};
            if (nj <= w) {
                bf16x8 kf[4];
#pragma unroll
                for (int ks = 0; ks < 4; ++ks) kf[ks] = *(const LAS bf16x8*)(Kl + (16 * nj + fr) * 288 + ks * 64 + fq * 16);
                __builtin_amdgcn_sched_barrier(0);
#pragma unroll
                for (int ks = 0; ks < 4; ++ks) s2[q] = MFMA16(kf[ks], qf[ks], s2[q]);
#pragma unroll
                for (int r = 0; r < 4; ++r) { const int jj = 16 * nj + 4 * fq + r; s2[q][r] = (i >= jj) ? s2[q][r] * __builtin_amdgcn_exp2f((float)(i - jj) * lg) : 0.f; } } }
        pf[kk] = pack8(s2[0], s2[1]); }
    f32x4 acc[16];
#pragma unroll
    for (int ne = 0; ne < 16; ne += 2) { bf16x8 sf[2][4];
#pragma unroll
        for (int u = 0; u < 2; ++u)
#pragma unroll
            for (int ks = 0; ks < 4; ++ks) sf[u][ks] = *(const LAS bf16x8*)(Bl + (16 * (ne + u) + fr) * 288 + ks * 64 + fq * 16);
        __builtin_amdgcn_sched_barrier(0);
#pragma unroll
        for (int u = 0; u < 2; ++u) { acc[ne + u] = (f32x4){0.f, 0.f, 0.f, 0.f};
#pragma unroll
            for (int ks = 0; ks < 4; ++ks) acc[ne + u] = MFMA16(sf[u][ks], qf[ks], acc[ne + u]); } }
    const float rs = exp2f((float)(i + 1) * lg);
#pragma unroll
    for (int ne = 0; ne < 16; ++ne) acc[ne] = acc[ne] * rs;
    __syncthreads();
    tile_g2l<256, 256, 16>(Bl, (const unsigned char*)(rvT + (size_t)(b * 4 + h) * 256 * SEQ + n * 128), (size_t)SEQ * 2, c.tid);
    __syncthreads();
    const int nkk = (w >> 1) + 1;
#pragma unroll
    for (int kk = 0; kk < 4; ++kk) if (kk < nkk) {
#pragma unroll
        for (int ne = 0; ne < 16; ne += 8) { u32x2 lo[8], hi[8];
#pragma unroll
            for (int u = 0; u < 8; ++u) { lo[u] = *(const LAS u32x2*)(Bl + (16 * (ne + u) + fr) * 272 + (32 * kk + 4 * fq) * 2); hi[u] = *(const LAS u32x2*)(Bl + (16 * (ne + u) + fr) * 272 + (32 * kk + 16 + 4 * fq) * 2); }
            __builtin_amdgcn_sched_barrier(0);
#pragma unroll
            for (int u = 0; u < 8; ++u) acc[ne + u] = MFMA16(cat8(lo[u], hi[u]), pf[kk], acc[ne + u]); } }
    u32x2 gpre[16];
#pragma unroll
    for (int ne = 0; ne < 16; ++ne) gpre[ne] = *(const u32x2*)(rgb + (size_t)t * 1024 + h * 256 + 16 * ne + 4 * fq);
    float sm = 0.f;
#pragma unroll
    for (int ne = 0; ne < 16; ++ne) sm += acc[ne][0] + acc[ne][1] + acc[ne][2] + acc[ne][3];
    sm += __shfl_xor(sm, 16); sm += __shfl_xor(sm, 32);
    const float mean = sm * (1.f / 256.f); float sq = 0.f;
#pragma unroll
    for (int ne = 0; ne < 16; ++ne) { acc[ne] = acc[ne] - mean; sq += acc[ne][0] * acc[ne][0] + acc[ne][1] * acc[ne][1] + acc[ne][2] * acc[ne][2] + acc[ne][3] * acc[ne][3]; }
    sq += __shfl_xor(sq, 16); sq += __shfl_xor(sq, 32);
    const float rstd = rsqrtf(sq * (1.f / 256.f) + LN_EPS);
#pragma unroll
    for (int ne = 0; ne < 16; ++ne) { const u32x2 gw = gpre[ne];
        const float g0 = __uint_as_float(gw[0] << 16), g1 = __uint_as_float(gw[0] & 0xffff0000u), g2 = __uint_as_float(gw[1] << 16), g3 = __uint_as_float(gw[1] & 0xffff0000u);
        u32x2 o; o[0] = pk2(acc[ne][0] * rstd * g0, acc[ne][1] * rstd * g1); o[1] = pk2(acc[ne][2] * rstd * g2, acc[ne][3] * rstd * g3);
        *(u32x2*)(ycat + (size_t)t * AB_OUT + 1024 + h * 256 + 16 * ne + 4 * fq) = o; }
}

__device__ __forceinline__ void phase_ab_p1(const Ctx& c) {
    for (int u = c.bid; u < 512; u += c.G) ret_kv_unit(c, u);
}
__device__ __forceinline__ void phase_ab_p2(const Ctx& c, int j) {
    ret_scan(c, 0, c.G);
    { const float* sinks = c.inp(3) + j * 16; for (int u = c.bid; u < 256; u += c.G) attn_unit(c, u, sinks); }
}
__device__ __forceinline__ void phase_ab_p3(const Ctx& c) {
    for (int u = c.bid; u < 512; u += c.G) ret_out_unit(c, u);
}

__device__ __forceinline__ float gelu_fast(float x) { const float u = 1.5957691216057308f * (x + 0.044715f * x * x * x); return x * __builtin_amdgcn_rcpf(1.f + __expf(-u)); }
struct EpiCDIn {
    static constexpr bool PERM = true;
    LAS bf16_t* biasL; unsigned char* ws;
    __device__ __forceinline__ void init(f32x4 (&acc)[2][2][4][2], const g8::Unit& u, int wc, int fq) const {
        const int colp = u.pn * 256 + wc * 32 + fq * 8;
#pragma unroll
        for (int b = 0; b < 2; ++b)
#pragma unroll
            for (int n = 0; n < 2; ++n) { const u32x2 bw = *(const LAS u32x2*)(biasL + colp + b * 128 + 4 * n);
                const f32x4 bv = (f32x4){__uint_as_float(bw[0] << 16), __uint_as_float(bw[0] & 0xffff0000u), __uint_as_float(bw[1] << 16), __uint_as_float(bw[1] & 0xffff0000u)};
#pragma unroll
                for (int a = 0; a < 2; ++a)
#pragma unroll
                    for (int m = 0; m < 4; ++m) acc[a][b][m][n] = bv; } }
    __device__ __forceinline__ void operator()(const f32x4 (&acc)[2][2][4][2], const g8::Unit& u, int wr, int wc, int fr, int fq) const {
        const int pn = u.pn; const int col0 = pn * 256 + wc * 32 + fq * 8;
        bf16_t* gu = (bf16_t*)(ws + CD_GU); bf16_t* gvT = (bf16_t*)(ws + CD_GVT); bf16_t* gg = (bf16_t*)(ws + CD_GG); bf16_t* xr = (bf16_t*)(ws + CD_XR); float* stats = (float*)(ws + CD_STATS);
#pragma unroll
        for (int ai = 0; ai < 2; ++ai)
#pragma unroll
            for (int m = 0; m < 4; ++m) {
                const int t = u.pm * 256 + ai * 128 + wr * 64 + m * 16 + fr, sq = t & (SEQ - 1), b = t >> 13;
                f32x4 x[2][2];
#pragma unroll
                for (int bj = 0; bj < 2; ++bj)
#pragma unroll
                    for (int n = 0; n < 2; ++n) { x[bj][n] = acc[ai][bj][m][n];
                        if (pn < 13) {
                            x[bj][n] = gelu4(x[bj][n]); } }
                if (pn >= 4 && pn < 8) {
                    float s1 = 0.f, s2 = 0.f;
#pragma unroll
                    for (int bj = 0; bj < 2; ++bj)
#pragma unroll
                        for (int n = 0; n < 2; ++n)
#pragma unroll
                            for (int e = 0; e < 4; ++e) { const float v = x[bj][n][e]; s1 += v; s2 += v * v;
                                st_bf16_off((unsigned char*)gvT, (unsigned)(((b * 1024 + (pn - 4) * 256 + bj * 128 + wc * 32 + fq * 8 + 4 * n + e) * SEQ + sq) * 2), v); }
                    s1 += __shfl_xor(s1, 16); s1 += __shfl_xor(s1, 32); s2 += __shfl_xor(s2, 16); s2 += __shfl_xor(s2, 32);
                    if (fq == 0) *(f32x2*)(stats + (size_t)t * 32 + ((pn - 4) * 4 + wc) * 2) = (f32x2){s1, s2};
                } else {
                    bf16_t* dst; int ld, cb;
                    if (pn < 4) { dst = gu; ld = 1024; cb = pn * 256; } else if (pn < 13) { dst = gg; ld = 1280; cb = (pn - 8) * 256; } else { dst = xr; ld = 1280; cb = (pn - 13) * 256; }
#pragma unroll
                    for (int bj = 0; bj < 2; ++bj) { u32x4 w;
#pragma unroll
                        for (int n = 0; n < 2; ++n) { w[2 * n] = pk2(x[bj][n][0], x[bj][n][1]); w[2 * n + 1] = pk2(x[bj][n][2], x[bj][n][3]); }
                        *(u32x4*)(dst + (size_t)t * ld + cb + bj * 128 + wc * 32 + fq * 8) = w; }
                }
            }
    }
};
__device__ __forceinline__ void phase_cd_inproj(const Ctx& c, int j) {
    g8::DenseOrder S; S.init(c.ws + WS_XB, c.ws + WS_WCDIN + (size_t)j * CD_IN * D * 2, T, CD_IN, D, c.G, c.bid); S.tid0 = c.tid;
    LAS bf16_t* biasL = (LAS bf16_t*)(c.lds + LDS_TAB);
    { const float* bp = c.inp(7) + (size_t)j * CD_IN; for (int i = c.tid; i < CD_IN; i += NTHREADS) biasL[i] = f2bf(bp[i]); }
    __syncthreads();
    EpiCDIn E{biasL, c.ws};
    g8::gemm_phase<EpiCDIn, g8::DenseOrder>(c.lds + LDS_STAGE, D, S, E);
}

__device__ __forceinline__ void lru_unit(const Ctx& c, int unit, int j) {
    const int hh = unit % 5, bn = unit / 5, lane = c.lane, fr = lane & 15, fq = lane >> 4, w = c.wid;
    const int t0 = bn * 128, s0 = t0 & (SEQ - 1);
    const bf16_t* xr = (const bf16_t*)(c.ws + CD_XR); bf16_t* HL = (bf16_t*)(c.ws + WS_U2); bf16_t* PC = HL + (size_t)T * 1280; float* sum = (float*)(c.ws + WS_H);
    const float* conv_w = c.inp(10) + (size_t)j * 4 * 1280 + hh * 256; const float* conv_b = c.inp(11) + (size_t)j * 1280 + hh * 256;
    const float* ba = c.inp(13) + (size_t)j * 1280 + hh * 256; const float* bx = c.inp(15) + (size_t)j * 1280 + hh * 256; const float* spl = (const float*)(c.ws + WS_SPL) + (size_t)j * 1280 + hh * 256;
    const bf16_t* Wl = (const bf16_t*)(c.ws + WS_WLRU) + (size_t)((j * 5 + hh) * 2) * 65536;
    LAS unsigned char* Xc = c.lds; LAS unsigned char* Wa = c.lds + 128 * 544; LAS unsigned char* Wx = Wa + 64 * 544; LAS unsigned char* Tot = Wx + 64 * 544; LAS float* Bl = (LAS float*)(Tot + 4096);
    __syncthreads();
    if (c.tid < 192) { const int which = c.tid >> 6, i4 = (c.tid & 63) * 4; const float* srcp = which == 0 ? ba : (which == 1 ? bx : spl); *(LAS f32x4*)(Bl + which * 256 + i4) = *(const f32x4*)(srcp + i4); }
    {
        const int cg = c.tid & 31, r0 = (c.tid >> 5) * 8;
        float wv[4][8], bv8[8];
        { const f32x4 b0 = *(const f32x4*)(conv_b + cg * 8), b1 = *(const f32x4*)(conv_b + cg * 8 + 4); bv8[0] = b0[0]; bv8[1] = b0[1]; bv8[2] = b0[2]; bv8[3] = b0[3]; bv8[4] = b1[0]; bv8[5] = b1[1]; bv8[6] = b1[2]; bv8[7] = b1[3]; }
#pragma unroll
        for (int k = 0; k < 4; ++k) { const f32x4 w0 = *(const f32x4*)(conv_w + k * 1280 + cg * 8), w1 = *(const f32x4*)(conv_w + k * 1280 + cg * 8 + 4);
            wv[k][0] = w0[0]; wv[k][1] = w0[1]; wv[k][2] = w0[2]; wv[k][3] = w0[3]; wv[k][4] = w1[0]; wv[k][5] = w1[1]; wv[k][6] = w1[2]; wv[k][7] = w1[3]; }
        u32x4 xin[11];
#pragma unroll
        for (int q = 0; q < 11; ++q) { xin[q] = (u32x4){0u, 0u, 0u, 0u}; if (s0 + r0 - 3 + q >= 0) xin[q] = *(const u32x4*)(xr + (size_t)(t0 + r0 - 3 + q) * 1280 + hh * 256 + cg * 8); }
#pragma unroll
        for (int rr = 0; rr < 8; ++rr) { float a[8];
#pragma unroll
            for (int e = 0; e < 8; ++e) a[e] = bv8[e];
#pragma unroll
            for (int k = 0; k < 4; ++k) { const u32x4 xv = xin[rr + k];
#pragma unroll
                for (int e2 = 0; e2 < 4; ++e2) { a[2 * e2] += wv[k][2 * e2] * __uint_as_float(xv[e2] << 16); a[2 * e2 + 1] += wv[k][2 * e2 + 1] * __uint_as_float(xv[e2] & 0xffff0000u); } }
            u32x4 o; o[0] = pk2(a[0], a[1]); o[1] = pk2(a[2], a[3]); o[2] = pk2(a[4], a[5]); o[3] = pk2(a[6], a[7]);
            *(LAS u32x4*)(Xc + (r0 + rr) * 544 + cg * 16) = o; }
    }
    u32x4 wreg[8];
#pragma unroll
    for (int q = 0; q < 4; ++q) { const int i = c.tid + q * NTHREADS, r = i >> 5, cc = i & 31; wreg[q] = *(const u32x4*)((const unsigned char*)Wl + (size_t)r * 512 + cc * 16); wreg[4 + q] = *(const u32x4*)((const unsigned char*)(Wl + 65536) + (size_t)r * 512 + cc * 16); }
    __syncthreads();
    bf16x8 xf[8];
#pragma unroll
    for (int ks = 0; ks < 8; ++ks) xf[ks] = *(const LAS bf16x8*)(Xc + (16 * w + fr) * 544 + ks * 64 + fq * 16);
    const int t = t0 + 16 * w + fr;
    for (int sl = 0; sl < 4; ++sl) {
        if (sl) __syncthreads();
#pragma unroll
        for (int q = 0; q < 4; ++q) { const int i = c.tid + q * NTHREADS, r = i >> 5, cc = i & 31; *(LAS u32x4*)(Wa + r * 544 + cc * 16) = wreg[q]; *(LAS u32x4*)(Wx + r * 544 + cc * 16) = wreg[4 + q]; }
        if (sl < 3) {
#pragma unroll
            for (int q = 0; q < 4; ++q) { const int i = c.tid + q * NTHREADS, r = i >> 5, cc = i & 31;
                wreg[q] = *(const u32x4*)((const unsigned char*)(Wl + (size_t)((sl + 1) * 64) * 256) + (size_t)r * 512 + cc * 16); wreg[4 + q] = *(const u32x4*)((const unsigned char*)(Wl + 65536 + (size_t)((sl + 1) * 64) * 256) + (size_t)r * 512 + cc * 16); } }
        __syncthreads();
        f32x4 sA[4], sB[4];
#pragma unroll
        for (int nc = 0; nc < 4; ++nc) { f32x4 ra = (f32x4){0.f, 0.f, 0.f, 0.f}, ri = ra;
            bf16x8 waf[8], wxf[8];
#pragma unroll
            for (int ks = 0; ks < 8; ++ks) { waf[ks] = *(const LAS bf16x8*)(Wa + (16 * nc + fr) * 544 + ks * 64 + fq * 16); wxf[ks] = *(const LAS bf16x8*)(Wx + (16 * nc + fr) * 544 + ks * 64 + fq * 16); }
            __builtin_amdgcn_sched_barrier(0);
#pragma unroll
            for (int ks = 0; ks < 8; ++ks) { ra = MFMA16(waf[ks], xf[ks], ra); ri = MFMA16(wxf[ks], xf[ks], ri); }
            const int ch = sl * 64 + 16 * nc + 4 * fq;
            const f32x4 b_a = *(const LAS f32x4*)(Bl + ch), b_x = *(const LAS f32x4*)(Bl + 256 + ch), sp = *(const LAS f32x4*)(Bl + 512 + ch);
            const u32x2 xw = *(const LAS u32x2*)(Xc + (16 * w + fr) * 544 + ch * 2);
            const float xcv[4] = {__uint_as_float(xw[0] << 16), __uint_as_float(xw[0] & 0xffff0000u), __uint_as_float(xw[1] << 16), __uint_as_float(xw[1] & 0xffff0000u)};
            f32x4 oa, ob;
#pragma unroll
            for (int r = 0; r < 4; ++r) { const float gr = __builtin_amdgcn_rcpf(1.f + __expf(-(ra[r] + b_a[r]))), gi = __builtin_amdgcn_rcpf(1.f + __expf(-(ri[r] + b_x[r]))); const float la = -8.f * gr * sp[r]; const float a = __expf(la);
                oa[r] = a; ob[r] = __builtin_amdgcn_sqrtf(fmaxf(1.f - a * a, 0.f)) * (gi * xcv[r]); }
            sA[nc] = oa; sB[nc] = ob;
        }
#pragma unroll
        for (int dlt = 1; dlt < 16; dlt <<= 1) { f32x4 pa[4], pb[4];
#pragma unroll
            for (int nc = 0; nc < 4; ++nc)
#pragma unroll
                for (int r = 0; r < 4; ++r) { pa[nc][r] = __shfl_up(sA[nc][r], dlt, 16); pb[nc][r] = __shfl_up(sB[nc][r], dlt, 16); }
            if (fr >= dlt) {
#pragma unroll
                for (int nc = 0; nc < 4; ++nc) { sB[nc] = sA[nc] * pb[nc] + sB[nc]; sA[nc] = sA[nc] * pa[nc]; } } }
        if (fr == 15) {
#pragma unroll
            for (int nc = 0; nc < 4; ++nc) { *(LAS f32x4*)(Tot + ((w * 64 + 16 * nc + 4 * fq) * 2) * 4) = sA[nc]; *(LAS f32x4*)(Tot + ((w * 64 + 16 * nc + 4 * fq) * 2 + 4) * 4) = sB[nc]; } }
        __syncthreads();
#pragma unroll
        for (int nc = 0; nc < 4; ++nc) { const int ch = sl * 64 + 16 * nc + 4 * fq;
            f32x4 cp = (f32x4){1.f, 1.f, 1.f, 1.f}, chh = (f32x4){0.f, 0.f, 0.f, 0.f};
            for (int w2 = 0; w2 < w; ++w2) { const f32x4 ta = *(const LAS f32x4*)(Tot + ((w2 * 64 + 16 * nc + 4 * fq) * 2) * 4), tb = *(const LAS f32x4*)(Tot + ((w2 * 64 + 16 * nc + 4 * fq) * 2 + 4) * 4);
                chh = ta * chh + tb; cp = cp * ta; }
            const f32x4 hl = sB[nc] + sA[nc] * chh, pc = sA[nc] * cp;
            u32x2 o1, o2; o1[0] = pk2(hl[0], hl[1]); o1[1] = pk2(hl[2], hl[3]); o2[0] = pk2(pc[0], pc[1]); o2[1] = pk2(pc[2], pc[3]);
            *(u32x2*)(HL + (size_t)t * 1280 + hh * 256 + ch) = o1; *(u32x2*)(PC + (size_t)t * 1280 + hh * 256 + ch) = o2;
            if (w == 7 && fr == 15) { float* sm = sum + ((size_t)bn * 1280 + hh * 256 + ch) * 2;
#pragma unroll
                for (int r = 0; r < 4; ++r) { sm[2 * r] = pc[r]; sm[2 * r + 1] = hl[r]; } } }
    }
}

__device__ __forceinline__ void sgu_unit(const Ctx& c, int unit, int j) {
    const int g = unit & 3, bn = unit >> 2, b = bn >> 6, n = bn & 63, lane = c.lane, fr = lane & 15, fq = lane >> 4, w = c.wid;
    const int t0 = bn * 128;
    const bf16_t* gu = (const bf16_t*)(c.ws + CD_GU); const bf16_t* gvT = (const bf16_t*)(c.ws + CD_GVT); const float* stats = (const float*)(c.ws + CD_STATS); bf16_t* ycat = (bf16_t*)(c.ws + WS_YCAT);
    const float* sw = c.inp(8) + (size_t)(j * 4 + g) * 16384; const float* sb = c.inp(9) + (size_t)(j * 4 + g) * 128;
    LAS unsigned char* Vt = c.lds; LAS float* mr = (LAS float*)(c.lds + 256 * 288);
    __syncthreads();
    tile_g2l<256, 256>(Vt, (const unsigned char*)(gvT + ((size_t)b * 1024 + g * 256) * SEQ + n * 128), (size_t)SEQ * 2, c.tid);
    if (c.tid < 128) { const f32x4* st = (const f32x4*)(stats + (size_t)(t0 + c.tid) * 32); float s1 = 0.f, s2 = 0.f; f32x4 sv[8];
#pragma unroll
        for (int q = 0; q < 8; ++q) sv[q] = st[q];
#pragma unroll
        for (int q = 0; q < 8; ++q) { s1 += sv[q][0] + sv[q][2]; s2 += sv[q][1] + sv[q][3]; }
        const float mean = s1 * (1.f / 1024.f), var = fmaxf(s2 * (1.f / 1024.f) - mean * mean, 0.f); mr[2 * c.tid] = mean; mr[2 * c.tid + 1] = rsqrtf(var + LN_EPS); }
    __syncthreads();
    const int i = 16 * w + fr, t = t0 + i, nks = (w >> 1) + 1;
    bf16x8 wf[4]; float ci = 0.f;
#pragma unroll
    for (int ks = 0; ks < 4; ++ks) { f32x4 lo = (f32x4){0.f, 0.f, 0.f, 0.f}, hi = lo;
        if (ks < nks) { const int j0 = ks * 32 + fq * 8; const f32x4 w0 = *(const f32x4*)(sw + (size_t)i * 128 + j0), w1 = *(const f32x4*)(sw + (size_t)i * 128 + j0 + 4);
#pragma unroll
            for (int e = 0; e < 4; ++e) { const float m0 = mr[2 * (j0 + e)], r0 = mr[2 * (j0 + e) + 1], m1 = mr[2 * (j0 + 4 + e)], r1 = mr[2 * (j0 + 4 + e) + 1];
                lo[e] = (j0 + e <= i) ? w0[e] * r0 : 0.f; hi[e] = (j0 + 4 + e <= i) ? w1[e] * r1 : 0.f; ci += lo[e] * m0 + hi[e] * m1; } }
        wf[ks] = pack8(lo, hi); }
    ci += __shfl_xor(ci, 16); ci += __shfl_xor(ci, 32);
    const float add = sb[i] - ci;
    f32x4 acc[16];
#pragma unroll
    for (int nd = 0; nd < 16; nd += 2) { bf16x8 vf[2][4];
#pragma unroll
        for (int u = 0; u < 2; ++u)
#pragma unroll
            for (int ks = 0; ks < 4; ++ks) if (ks < nks) vf[u][ks] = *(const LAS bf16x8*)(Vt + (16 * (nd + u) + fr) * 288 + ks * 64 + fq * 16);
        __builtin_amdgcn_sched_barrier(0);
#pragma unroll
        for (int u = 0; u < 2; ++u) { acc[nd + u] = (f32x4){0.f, 0.f, 0.f, 0.f};
#pragma unroll
            for (int ks = 0; ks < 4; ++ks) if (ks < nks) acc[nd + u] = MFMA16(vf[u][ks], wf[ks], acc[nd + u]); } }
    u32x2 upre[16];
#pragma unroll
    for (int nd = 0; nd < 16; ++nd) upre[nd] = *(const u32x2*)(gu + (size_t)t * 1024 + g * 256 + 16 * nd + 4 * fq);
#pragma unroll
    for (int nd = 0; nd < 16; ++nd) { const u32x2 uw = upre[nd];
        const float u0 = __uint_as_float(uw[0] << 16), u1 = __uint_as_float(uw[0] & 0xffff0000u), u2 = __uint_as_float(uw[1] << 16), u3 = __uint_as_float(uw[1] & 0xffff0000u);
        u32x2 o; o[0] = pk2(u0 * (acc[nd][0] + add), u1 * (acc[nd][1] + add)); o[1] = pk2(u2 * (acc[nd][2] + add), u3 * (acc[nd][3] + add));
        *(u32x2*)(ycat + (size_t)t * CD_OUT + g * 256 + 16 * nd + 4 * fq) = o; }
}
__device__ __forceinline__ void phase_cd_p1(const Ctx& c, int j) {
    for (int u = c.bid; u < 640; u += c.G) lru_unit(c, u, j);
    if (c.G == 256) {
        if (c.bid < 128) sgu_unit(c, c.bid, j);
        else { for (int q = 0; q < 3; ++q) sgu_unit(c, 128 + (c.bid - 128) * 3 + q, j); }
    } else { for (int u = c.bid; u < 512; u += c.G) sgu_unit(c, u, j); }
}

__device__ __forceinline__ void phase_cd_scan2(const Ctx& c) {
    const bf16_t* gg = (const bf16_t*)(c.ws + CD_GG); bf16_t* ycat = (bf16_t*)(c.ws + WS_YCAT);
    const bf16_t* HL = (const bf16_t*)(c.ws + WS_U2); const bf16_t* PC = HL + (size_t)T * 1280; const float* sum = (const float*)(c.ws + WS_H);
    LAS float* carry = (LAS float*)c.lds;
    for (int u = c.bid; u < 256; u += c.G) {
        const int bn = u >> 1, half = u & 1, b = bn >> 6, n = bn & 63;
        __syncthreads();
        {
            LAS float* part = carry + 1280;
            for (int it = c.tid; it < 4 * 1280; it += NTHREADS) { const int seg = it / 1280, ch = it % 1280; const float* sp = sum + ((size_t)(b * 64 + seg * 16) * 1280 + ch) * 2;
                f32x2 v[16];
#pragma unroll
                for (int q = 0; q < 16; ++q) { v[q] = (f32x2){1.f, 0.f}; if (seg * 16 + q < n) v[q] = *(const f32x2*)(sp + (size_t)q * 2560); }
                float A = 1.f, Bv = 0.f;
#pragma unroll
                for (int q = 0; q < 16; ++q) { Bv = v[q][0] * Bv + v[q][1]; A *= v[q][0]; }
                part[(seg * 1280 + ch) * 2] = A; part[(seg * 1280 + ch) * 2 + 1] = Bv; }
            __syncthreads();
            for (int ch = c.tid; ch < 1280; ch += NTHREADS) { float cr = 0.f;
#pragma unroll
                for (int seg = 0; seg < 4; ++seg) cr = part[(seg * 1280 + ch) * 2] * cr + part[(seg * 1280 + ch) * 2 + 1];
                carry[ch] = cr; }
        }
        __syncthreads();
        const size_t t0 = (size_t)bn * 128 + half * 64;
        for (int it0 = c.tid; it0 < 64 * 320; it0 += 8 * NTHREADS) {
            u32x2 hw[8], pw[8], gw[8];
#pragma unroll
            for (int q = 0; q < 8; ++q) { const int it = it0 + q * NTHREADS; const int r = it / 320, c4 = (it % 320) * 4; const size_t o = (t0 + r) * 1280 + c4; hw[q] = *(const u32x2*)(HL + o); pw[q] = *(const u32x2*)(PC + o); gw[q] = *(const u32x2*)(gg + o); }
#pragma unroll
            for (int q = 0; q < 8; ++q) { const int it = it0 + q * NTHREADS; const int r = it / 320, c4 = (it % 320) * 4; const f32x4 cr = *(const LAS f32x4*)(carry + c4);
                const float h0 = __uint_as_float(hw[q][0] << 16) + __uint_as_float(pw[q][0] << 16) * cr[0], h1 = __uint_as_float(hw[q][0] & 0xffff0000u) + __uint_as_float(pw[q][0] & 0xffff0000u) * cr[1];
                const float h2 = __uint_as_float(hw[q][1] << 16) + __uint_as_float(pw[q][1] << 16) * cr[2], h3 = __uint_as_float(hw[q][1] & 0xffff0000u) + __uint_as_float(pw[q][1] & 0xffff0000u) * cr[3];
                u32x2 ow; ow[0] = pk2(__uint_as_float(gw[q][0] << 16) * h0, __uint_as_float(gw[q][0] & 0xffff0000u) * h1); ow[1] = pk2(__uint_as_float(gw[q][1] << 16) * h2, __uint_as_float(gw[q][1] & 0xffff0000u) * h3);
                *(u32x2*)(ycat + (t0 + r) * CD_OUT + 1024 + c4) = ow; } }
    }
}

__device__ __forceinline__ void phase_ln_moe(const Ctx& c, const float* g, const float* bta, float* xout) {
    typedef float f32x2v __attribute__((ext_vector_type(2)));
    bf16_t* xb = (bf16_t*)(c.ws + WS_XB); const unsigned char* Y = (const unsigned char*)(c.ws + WS_U1);
    f32x4 gpre[2][2], bpre[2][2];
#pragma unroll
    for (int q = 0; q < 2; ++q)
#pragma unroll
        for (int h2 = 0; h2 < 2; ++h2) { gpre[q][h2] = *(const f32x4*)(g + q * 512 + c.lane * 8 + 4 * h2); bpre[q][h2] = *(const f32x4*)(bta + q * 512 + c.lane * 8 + 4 * h2); }
    for (long tt = (long)c.gw * 2; tt < T; tt += (long)c.nwaves * 2) {
        float v[2][2][8];
#pragma unroll
        for (int u = 0; u < 2; ++u) { const long t = tt + u;
#pragma unroll
            for (int q = 0; q < 2; ++q) { const int col = q * 512 + c.lane * 8;
                float f[8];
#pragma unroll
                for (int e = 0; e < 8; ++e) f[e] = 0.f;
#pragma unroll
                for (int k = 0; k < 8; ++k) { const size_t srow = (size_t)t * 8 + k; const u32x2 w = *(const u32x2*)(Y + srow * D + col);
#pragma unroll
                    for (int h2 = 0; h2 < 2; ++h2) { const f32x2v a = __builtin_amdgcn_cvt_pk_f32_fp8(w[h2], false), b = __builtin_amdgcn_cvt_pk_f32_fp8(w[h2], true);
                        f[4 * h2] += a[0]; f[4 * h2 + 1] += a[1]; f[4 * h2 + 2] += b[0]; f[4 * h2 + 3] += b[1]; } }
                const u32x4 xw = *(const u32x4*)(xb + (size_t)t * D + col), sw = *(const u32x4*)((const bf16_t*)(Y + (size_t)TK * D) + (size_t)t * D + col);
#pragma unroll
                for (int e2 = 0; e2 < 4; ++e2) { v[u][q][2 * e2] = __uint_as_float(xw[e2] << 16) * ALPHA + f[2 * e2] * (1.f / 64.f) + __uint_as_float(sw[e2] << 16);
                    v[u][q][2 * e2 + 1] = __uint_as_float(xw[e2] & 0xffff0000u) * ALPHA + f[2 * e2 + 1] * (1.f / 64.f) + __uint_as_float(sw[e2] & 0xffff0000u); } } }
#pragma unroll
        for (int u = 0; u < 2; ++u) { const long t = tt + u;
            float sm = 0.f;
#pragma unroll
            for (int q = 0; q < 2; ++q)
#pragma unroll
                for (int e = 0; e < 8; ++e) sm += v[u][q][e];
            const float mean = wave_sum(sm) * (1.f / 1024.f); float sq = 0.f;
#pragma unroll
            for (int q = 0; q < 2; ++q)
#pragma unroll
                for (int e = 0; e < 8; ++e) { v[u][q][e] -= mean; sq += v[u][q][e] * v[u][q][e]; }
            const float rstd = rsqrtf(wave_sum(sq) * (1.f / 1024.f) + LN_EPS);
#pragma unroll
            for (int q = 0; q < 2; ++q) { const int col = q * 512 + c.lane * 8; float o[8];
#pragma unroll
                for (int h2 = 0; h2 < 2; ++h2) { const f32x4 gg = gpre[q][h2], bb = bpre[q][h2];
#pragma unroll
                    for (int e = 0; e < 4; ++e) o[4 * h2 + e] = v[u][q][4 * h2 + e] * rstd * gg[e] + bb[e];
                    if (xout) *(f32x4*)(xout + (size_t)t * D + col + 4 * h2) = (f32x4){o[4 * h2], o[4 * h2 + 1], o[4 * h2 + 2], o[4 * h2 + 3]}; }
                u32x4 w; w[0] = pk2(o[0], o[1]); w[1] = pk2(o[2], o[3]); w[2] = pk2(o[4], o[5]); w[3] = pk2(o[6], o[7]); *(u32x4*)(xb + (size_t)t * D + col) = w; } }
    }
}

__device__ __forceinline__ unsigned sortable_u32(float f) { const unsigned b = __float_as_uint(f); return b ^ ((b >> 31) ? 0xffffffffu : 0x80000000u); }
__device__ __forceinline__ int popc64(unsigned long long m) { return __builtin_popcountll(m); }
__device__ __forceinline__ int rank_lt(unsigned long long m) { return (int)__builtin_amdgcn_mbcnt_hi((unsigned)(m >> 32), __builtin_amdgcn_mbcnt_lo((unsigned)m, 0u)); }
__device__ __forceinline__ void phase_ln_route(const Ctx& c, int L) {
    bf16_t* xb = (bf16_t*)(c.ws + WS_XB); const bf16_t* hbuf = (const bf16_t*)(c.ws + WS_HB);
    const float* g = c.inp(19) + (size_t)L * D; const float* bta = c.inp(20) + (size_t)L * D; const float* rb = c.inp(22) + L * NE;
    const bf16_t* Wr = (const bf16_t*)(c.ws + WS_WRT) + (size_t)L * 256 * D;
    int* cnt = (int*)(c.ws + CTL_CNT) + L * NE * 32; int* list = (int*)(c.ws + WS_LIST); float* gate = (float*)(c.ws + WS_GATE);
    LAS unsigned char* Xl = c.lds; LAS unsigned char* Wq = c.lds + 64 * 544;
    LAS float* Sc = (LAS float*)Wq;
    LAS int* hist = (LAS int*)(Wq + 32768); LAS int* gbase = hist + 128; LAS int* sel = gbase + 128; LAS float* selg = (LAS float*)(sel + 512);
    const int lane = c.lane, fr = lane & 15, fq = lane >> 4, w = c.wid;
    f32x4 gpre[4], bpre[4];
#pragma unroll
    for (int q = 0; q < 4; ++q) { gpre[q] = *(const f32x4*)(g + q * 256 + lane * 4); bpre[q] = *(const f32x4*)(bta + q * 256 + lane * 4); }
    for (int grp = c.bid; grp < T / 64; grp += c.G) {
        __syncthreads();
        u32x2 nb[8][4];
#pragma unroll
        for (int hb = 0; hb < 2; ++hb) {
            u32x2 xw[4][4], hw[4][4];
#pragma unroll
            for (int i = 0; i < 4; ++i) { const size_t t = (size_t)grp * 64 + hb * 32 + w * 4 + i;
#pragma unroll
                for (int q = 0; q < 4; ++q) { const int col = q * 256 + lane * 4; xw[i][q] = *(const u32x2*)(xb + t * D + col); hw[i][q] = *(const u32x2*)(hbuf + t * D + col); } }
#pragma unroll
            for (int i = 0; i < 4; ++i) { const size_t t = (size_t)grp * 64 + hb * 32 + w * 4 + i;
                f32x4 v[4]; float sm = 0.f;
#pragma unroll
                for (int q = 0; q < 4; ++q) { v[q] = (f32x4){__uint_as_float(xw[i][q][0] << 16), __uint_as_float(xw[i][q][0] & 0xffff0000u), __uint_as_float(xw[i][q][1] << 16), __uint_as_float(xw[i][q][1] & 0xffff0000u)} * ALPHA
                         + (f32x4){__uint_as_float(hw[i][q][0] << 16), __uint_as_float(hw[i][q][0] & 0xffff0000u), __uint_as_float(hw[i][q][1] << 16), __uint_as_float(hw[i][q][1] & 0xffff0000u)};
                    sm += v[q][0] + v[q][1] + v[q][2] + v[q][3]; }
                const float mean = wave_sum(sm) * (1.f / 1024.f); float sq = 0.f;
#pragma unroll
                for (int q = 0; q < 4; ++q) { v[q] = v[q] - mean; sq += v[q][0] * v[q][0] + v[q][1] * v[q][1] + v[q][2] * v[q][2] + v[q][3] * v[q][3]; }
                const float rstd = rsqrtf(wave_sum(sq) * (1.f / 1024.f) + LN_EPS);
#pragma unroll
                for (int q = 0; q < 4; ++q) { const f32x4 o = v[q] * rstd * gpre[q] + bpre[q]; nb[hb * 4 + i][q][0] = pk2(o[0], o[1]); nb[hb * 4 + i][q][1] = pk2(o[2], o[3]);
                    *(u32x2*)(xb + t * D + q * 256 + lane * 4) = nb[hb * 4 + i][q]; } }
        }
        f32x4 lg[2][2];
        const int st = w & 1, eg = w >> 1;
        lg[0][0] = (f32x4){0.f, 0.f, 0.f, 0.f}; lg[0][1] = lg[0][0]; lg[1][0] = lg[0][0]; lg[1][1] = lg[0][0];
        u32x4 wreg[8];
#pragma unroll
        for (int q = 0; q < 8; ++q) { const int i = c.tid + q * NTHREADS, r = i >> 5, cc = i & 31; wreg[q] = *(const u32x4*)((const unsigned char*)Wr + (size_t)r * 2048 + cc * 16); }
#pragma unroll
        for (int kq = 0; kq < 4; ++kq) {
            if (kq) __syncthreads();
#pragma unroll
            for (int q = 0; q < 8; ++q) { const int i = c.tid + q * NTHREADS, r = i >> 5, cc = i & 31; *(LAS u32x4*)(Wq + r * 544 + cc * 16) = wreg[q]; }
#pragma unroll
            for (int u = 0; u < 8; ++u) *(LAS u32x2*)(Xl + ((u >> 2) * 32 + w * 4 + (u & 3)) * 544 + lane * 8) = nb[u][kq];
            if (kq < 3) {
#pragma unroll
                for (int q = 0; q < 8; ++q) { const int i = c.tid + q * NTHREADS, r = i >> 5, cc = i & 31; wreg[q] = *(const u32x4*)((const unsigned char*)Wr + (size_t)r * 2048 + (kq + 1) * 512 + cc * 16); } }
            __syncthreads();
#pragma unroll
            for (int k4 = 0; k4 < 8; k4 += 2) { bf16x8 bop[2][2], aop[2][2];
#pragma unroll
                for (int u = 0; u < 2; ++u) { const int ks = k4 + u;
#pragma unroll
                    for (int p2 = 0; p2 < 2; ++p2) bop[p2][u] = *(const LAS bf16x8*)(Xl + (p2 * 32 + 16 * st + fr) * 544 + ks * 64 + fq * 16);
#pragma unroll
                    for (int ne2 = 0; ne2 < 2; ++ne2) aop[u][ne2] = *(const LAS bf16x8*)(Wq + (32 * eg + 16 * ne2 + fr) * 544 + ks * 64 + fq * 16); }
                __builtin_amdgcn_sched_barrier(0);
#pragma unroll
                for (int u = 0; u < 2; ++u)
#pragma unroll
                    for (int p2 = 0; p2 < 2; ++p2)
#pragma unroll
                        for (int ne2 = 0; ne2 < 2; ++ne2) lg[p2][ne2] = MFMA16(aop[u][ne2], bop[p2][u], lg[p2][ne2]); }
        }
        __syncthreads();
#pragma unroll
        for (int p2 = 0; p2 < 2; ++p2)
#pragma unroll
            for (int ne2 = 0; ne2 < 2; ++ne2) { f32x4 sg;
#pragma unroll
                for (int r = 0; r < 4; ++r) sg[r] = sigmoidf_(lg[p2][ne2][r]);
                *(LAS f32x4*)(Sc + (p2 * 32 + 16 * st + fr) * 128 + 32 * eg + 16 * ne2 + 4 * fq) = sg; }
        if (c.tid < 128) hist[c.tid] = 0;
        __syncthreads();
        {
            const float rb0 = rb[lane], rb1 = rb[64 + lane];
#pragma unroll 2
            for (int q = 0; q < 8; ++q) { const int rr = w * 8 + q;
                const float s0 = Sc[rr * 128 + lane], s1 = Sc[rr * 128 + 64 + lane];
                const unsigned u0 = sortable_u32(s0 + rb0), u1 = sortable_u32(s1 + rb1);
                unsigned thr = 0u;
                for (int bit = 31; bit >= 0; --bit) { const unsigned cand = thr | (1u << bit); const int n = popc64(__ballot(u0 >= cand)) + popc64(__ballot(u1 >= cand)); if (n >= 8) { thr = cand; if (n == 8) break; } }
                const bool gt0 = u0 > thr, gt1 = u1 > thr, eq0 = u0 == thr, eq1 = u1 == thr;
                const unsigned long long me0 = __ballot(eq0), me1 = __ballot(eq1);
                const int need = 8 - popc64(__ballot(gt0)) - popc64(__ballot(gt1));
                const bool sel0 = gt0 || (eq0 && rank_lt(me0) < need), sel1 = gt1 || (eq1 && popc64(me0) + rank_lt(me1) < need);
                const unsigned long long m0 = __ballot(sel0), m1 = __ballot(sel1);
                const float tot = wave_sum((sel0 ? s0 : 0.f) + (sel1 ? s1 : 0.f));
                if (sel0) { const int k = rank_lt(m0); const int lr = __hip_atomic_fetch_add(&hist[lane], 1, __ATOMIC_RELAXED, __HIP_MEMORY_SCOPE_WORKGROUP); sel[rr * 8 + k] = (lane << 16) | lr; selg[rr * 8 + k] = s0 / tot * 2.5f; }
                if (sel1) { const int k = popc64(m0) + rank_lt(m1); const int lr = __hip_atomic_fetch_add(&hist[64 + lane], 1, __ATOMIC_RELAXED, __HIP_MEMORY_SCOPE_WORKGROUP); sel[rr * 8 + k] = ((64 + lane) << 16) | lr; selg[rr * 8 + k] = s1 / tot * 2.5f; } }
        }
        __syncthreads();
        if (c.tid < 128) gbase[c.tid] = atomicAdd(&cnt[c.tid * 32], hist[c.tid]);
        __syncthreads();
        { const int sv = sel[c.tid], e = sv >> 16, lr = sv & 0xffff; const int slot = (grp * 64 + (c.tid >> 3)) * 8 + (c.tid & 7);
          list[(size_t)e * LISTCAP + gbase[e] + lr] = slot; gate[slot] = selg[c.tid]; }
    }
}

struct MoeOrder {
    const char* Abase; const char* Bbase; size_t Bstride; int K, NT, NTG, total, G, c, mode, tid0;
    LAS int* tab; LAS int* desc;
    __device__ __forceinline__ bool next(int i, g8::Unit& u) const {
        const int ip = i / NTG, q = i - ip * NTG;
        const long L = (long)ip * G + c; if (L >= total || ip >= TAB_SLOTS) return false;
        const int d = desc[ip]; const int e = d >> 12, pn = (d & 15) * NTG + q;
        u.pm = (d >> 4) & 255; u.pn = pn; u.aux = ip; u.A = Abase; u.B = Bbase + (size_t)e * Bstride + (size_t)pn * 256 * K * 2; return true;
    }
    __device__ __forceinline__ void aoff(const g8::Unit& u, int tid, unsigned (&o)[2][2]) const {
#pragma unroll
        for (int i = 0; i < 2; ++i) { int R, C; g8::stage_rc(tid * 16 + i * 8192, R, C);
#pragma unroll
            for (int h = 0; h < 2; ++h) { int s = tab[u.aux * 256 + h * 128 + R]; s = s < 0 ? 0 : s; const int row = mode ? s : (s < TK ? (s >> 3) : s - TK);
                o[h][i] = (unsigned)(row * K + C) * 2u; } }
    }
};
__device__ __forceinline__ void moe_setup(const Ctx& c, MoeOrder& S, const int* cnt, int NT, int NTG) {
    LAS int* pref = (LAS int*)(c.lds + LDS_PREF); LAS int* desc = (LAS int*)(c.lds + LDS_DESC); LAS int* tab = (LAS int*)(c.lds + LDS_TAB);
    const int* list = (const int*)(c.ws + WS_LIST);
    if (c.tid < 64) { int nb[3]; int loc = 0;
#pragma unroll
        for (int q = 0; q < 3; ++q) { const int e = c.tid * 3 + q; int n = 0; if (e < NE) n = cnt[e * 32]; else if (e == NE) n = T; nb[q] = (n + 255) >> 8; loc += nb[q]; }
        int inc = loc;
#pragma unroll
        for (int o = 1; o < 64; o <<= 1) { const int v = __shfl_up(inc, o); if (c.tid >= o) inc += v; }
        int acc = inc - loc;
#pragma unroll
        for (int q = 0; q < 3; ++q) { const int e = c.tid * 3 + q; if (e <= NE1) pref[e] = acc; acc += nb[q]; } }
    __syncthreads();
    const int NG = NT / NTG; const int total = pref[NE1] * NG;
    LAS float* gtab = (LAS float*)(c.lds + LDS_GTAB); const float* gate = (const float*)(c.ws + WS_GATE);
    S.NT = NT; S.NTG = NTG; S.total = total; S.G = c.G; S.c = c.bid; S.tab = tab; S.desc = desc;
    {
        int sv[TAB_SLOTS / 2];
#pragma unroll
        for (int k = 0; k < TAB_SLOTS / 2; ++k) { const int i = (c.tid >> 8) + 2 * k; sv[k] = -2;
            const long L = (long)i * c.G + c.bid;
            if (L < total) {
                int wgid = (int)L; { const int q = total / 8, r = total % 8, xcd = wgid % 8, off = wgid / 8; wgid = (xcd < r ? xcd * (q + 1) : r * (q + 1) + (xcd - r) * q) + off; }
                const int rbg = wgid / NG, pn = wgid % NG;
                int lo = 0, hi = NE1;
                while (hi - lo > 1) { const int mid = (lo + hi) >> 1; if (pref[mid] <= rbg) lo = mid; else hi = mid; }
                const int e = lo, rb = rbg - pref[e], n = e < NE ? cnt[e * 32] : T;
                if ((c.tid & 255) == 0) desc[i] = (e << 12) | (rb << 4) | pn;
                const int r = rb * 256 + (c.tid & 255); sv[k] = -1; if (r < n) sv[k] = (e < NE) ? list[(size_t)e * LISTCAP + r] : TK + r; } }
#pragma unroll
        for (int k = 0; k < TAB_SLOTS / 2; ++k) { const int i = (c.tid >> 8) + 2 * k; if (sv[k] != -2) { tab[i * 256 + (c.tid & 255)] = sv[k]; gtab[i * 256 + (c.tid & 255)] = sv[k] >= 0 ? gate[sv[k]] : 0.f; } }
    }
    __syncthreads();
}
struct EpiMoeGU {
    static constexpr bool PERM = true;
    bf16_t* H; LAS int* tab;
    __device__ __forceinline__ void init(f32x4 (&acc)[2][2][4][2], const g8::Unit&, int, int) const {
#pragma unroll
        for (int a = 0; a < 2; ++a)
#pragma unroll
            for (int b = 0; b < 2; ++b)
#pragma unroll
                for (int m = 0; m < 4; ++m)
#pragma unroll
                    for (int n = 0; n < 2; ++n) acc[a][b][m][n] = (f32x4){0.f, 0.f, 0.f, 0.f}; }
    __device__ __forceinline__ void operator()(const f32x4 (&acc)[2][2][4][2], const g8::Unit& u, int wr, int wc, int fr, int fq) const {
#pragma unroll
        for (int ai = 0; ai < 2; ++ai)
#pragma unroll
            for (int m = 0; m < 4; ++m) { const int r = ai * 128 + wr * 64 + m * 16 + fr; const int s = tab[u.aux * 256 + r];
                if (s >= 0) { u32x4 w;
#pragma unroll
                    for (int n = 0; n < 2; ++n) { const f32x4 g = acc[ai][0][m][n], up = acc[ai][1][m][n];
                        const f32x4 hv = silu4(g) * up; w[2 * n] = pk2(hv[0], hv[1]); w[2 * n + 1] = pk2(hv[2], hv[3]); }
                    *(u32x4*)(H + (size_t)s * ED + u.pn * 128 + wc * 32 + fq * 8) = w; } }
    }
};
struct EpiMoeDN {
    static constexpr bool PERM = true;
    unsigned char* Y; LAS float* gtab; LAS int* tab;
    __device__ __forceinline__ void init(f32x4 (&acc)[2][2][4][2], const g8::Unit&, int, int) const {
#pragma unroll
        for (int a = 0; a < 2; ++a)
#pragma unroll
            for (int b = 0; b < 2; ++b)
#pragma unroll
                for (int m = 0; m < 4; ++m)
#pragma unroll
                    for (int n = 0; n < 2; ++n) acc[a][b][m][n] = (f32x4){0.f, 0.f, 0.f, 0.f}; }
    __device__ __forceinline__ void operator()(const f32x4 (&acc)[2][2][4][2], const g8::Unit& u, int wr, int wc, int fr, int fq) const {
#pragma unroll
        for (int ai = 0; ai < 2; ++ai)
#pragma unroll
            for (int m = 0; m < 4; ++m) { const int r = ai * 128 + wr * 64 + m * 16 + fr; const int s = tab[u.aux * 256 + r];
                if (s >= TK) {
#pragma unroll
                    for (int bj = 0; bj < 2; ++bj) { u32x4 w;
#pragma unroll
                        for (int n = 0; n < 2; ++n) { const f32x4 a = acc[ai][bj][m][n]; w[2 * n] = pk2(a[0], a[1]); w[2 * n + 1] = pk2(a[2], a[3]); }
                        *(u32x4*)((bf16_t*)(Y + (size_t)TK * D) + (size_t)(s - TK) * D + u.pn * 256 + bj * 128 + wc * 32 + fq * 8) = w; }
                } else if (s >= 0) { const float gt = gtab[u.aux * 256 + r] * 64.f;
#pragma unroll
                    for (int bj = 0; bj < 2; ++bj) { u32x2 w;
#pragma unroll
                        for (int n = 0; n < 2; ++n) { f32x4 a = acc[ai][bj][m][n] * gt;
#pragma unroll
                            for (int e = 0; e < 4; ++e) a[e] = fminf(fmaxf(a[e], -448.f), 448.f);
                            unsigned pw = 0u; pw = __builtin_amdgcn_cvt_pk_fp8_f32(a[0], a[1], pw, false); pw = __builtin_amdgcn_cvt_pk_fp8_f32(a[2], a[3], pw, true); w[n] = pw; }
                        *(u32x2*)(Y + (size_t)s * D + u.pn * 256 + bj * 128 + wc * 32 + fq * 8) = w; } } }
    }
};
__device__ __forceinline__ void phase_moe_gu(const Ctx& c, int L) {
    MoeOrder S; S.Abase = (const char*)(c.ws + WS_XB); S.Bbase = (const char*)(c.ws + WS_WGU) + (size_t)L * NE1 * 512 * D * 2; S.Bstride = (size_t)512 * D * 2; S.K = D; S.mode = 0; S.tid0 = c.tid;
    moe_setup(c, S, (const int*)(c.ws + CTL_CNT) + L * NE * 32, 2, 1);
    EpiMoeGU E{(bf16_t*)(c.ws + WS_HID), S.tab};
    g8::gemm_phase<EpiMoeGU, MoeOrder>(c.lds + LDS_STAGE, D, S, E);
}
__device__ __forceinline__ void phase_moe_dn(const Ctx& c, int L) {
    MoeOrder S; S.Abase = (const char*)(c.ws + WS_HID); S.Bbase = (const char*)(c.ws + WS_WDN) + (size_t)L * NE1 * D * ED * 2; S.Bstride = (size_t)D * ED * 2; S.K = ED; S.mode = 1; S.tid0 = c.tid;
    { LAS int* pref = (LAS int*)(c.lds + LDS_PREF); S.NT = 4; S.NTG = 2; S.total = pref[NE1] * 2; S.G = c.G; S.c = c.bid; S.tab = (LAS int*)(c.lds + LDS_TAB); S.desc = (LAS int*)(c.lds + LDS_DESC); }
    EpiMoeDN E{(unsigned char*)(c.ws + WS_U1), (LAS float*)(c.lds + LDS_GTAB), S.tab};
    g8::gemm_phase<EpiMoeDN, MoeOrder>(c.lds + LDS_STAGE, ED, S, E);
}

constexpr int PH_PER_LAYER = 9;
constexpr int N_PHASES = 1 + 4 * PH_PER_LAYER;

__global__ void __launch_bounds__(NTHREADS, 2) fwd_kernel(Params p) {
    extern __shared__ __attribute__((aligned(16))) unsigned char lds_raw[];
    LAS unsigned char* const lds0 = (LAS unsigned char*)lds_raw;
    const int wave_id = __builtin_amdgcn_readfirstlane((int)threadIdx.x >> 6);
    volatile LAS unsigned* misc = (volatile LAS unsigned*)(lds0 + LDS_MISC);
    if (threadIdx.x < 4) misc[threadIdx.x] = 0u;
    __syncthreads();
    const int lo = p.ph_lo, hi = p.ph_hi;
    XcdBarrier bar; bar.bar = (unsigned*)(p.ws + WS_CTL); bar.x = 0; bar.st = misc;
    if (hi - lo > 1) bar = xcd_barrier_post((unsigned*)(p.ws + WS_CTL), misc);
#define MKCTX() Ctx c; { int wv_ = wave_id; asm volatile("" : "+s"(wv_)); int tid_ = wv_ * 64 + (int)__builtin_amdgcn_mbcnt_hi(~0u, __builtin_amdgcn_mbcnt_lo(~0u, 0u)); asm volatile("" : "+v"(tid_)); int bid_ = blockIdx.x; asm volatile("" : "+s"(bid_)); unsigned long long ws_ = (unsigned long long)p.ws; asm volatile("" : "+s"(ws_)); \
        c.in = p.in; c.out = (float*)p.out; c.ws = (unsigned char*)(GAS unsigned char*)ws_; c.lds = lds0; c.tid = tid_; c.lane = tid_ & 63; c.wid = __builtin_amdgcn_readfirstlane(tid_ >> 6); c.bid = bid_; c.G = gridDim.x; \
        c.gtid = c.bid * NTHREADS + c.tid; c.gthreads = c.G * NTHREADS; c.gw = c.bid * 8 + c.wid; c.nwaves = c.G * 8; } unsigned char* const ws = c.ws; (void)ws
    int id = 0;
#ifndef PMASK
#define PMASK 0xffffffffu
#endif
#ifndef DUPMASK
#define DUPMASK 0u
#endif
#define PHASE(k, body) do { if (((PMASK >> (k)) & 1u) && lo <= id && id < hi) { MKCTX(); body; if ((DUPMASK >> (k)) & 1u) { body; } if (id + 1 < hi) xcd_barrier(bar, c.tid == 0); } ++id; } while (0)
    PHASE(0, phase_convert(c));
#pragma unroll 1
    for (int L = 0; L < 4; ++L) {
        const int j = L >> 1; const bool cd = (L & 1);
        if (cd) {
            PHASE(1, phase_cd_inproj(c, j));
        } else {
            PHASE(2, phase_ab_inproj(c, j));
        }
        if (!cd) { PHASE(3, phase_ab_p1(c)); PHASE(4, phase_ab_p2(c, j)); PHASE(16, phase_ab_p3(c)); }
        else     { PHASE(5, phase_cd_p1(c, j)); PHASE(15, phase_cd_scan2(c)); id += 1; }
        {
            const size_t Woff = cd ? WS_WCDOUT + (size_t)j * D * CD_OUT * 2 : WS_WABOUT + (size_t)j * D * AB_OUT * 2;
            const int K = cd ? CD_OUT : AB_OUT; const float* bias = cd ? (const float*)p.in[18] + (size_t)j * D : (const float*)p.in[5] + (size_t)j * D;
            PHASE(8, phase_dense(c, (const bf16_t*)(ws + WS_YCAT), (const bf16_t*)(ws + Woff), T, D, K, (bf16_t*)(ws + WS_HB), D, bias));
        }
        PHASE(9, phase_ln_route(c, L));
        PHASE(12, phase_moe_gu(c, L));
        PHASE(13, phase_moe_dn(c, L));
        PHASE(14, phase_ln_moe(c, (const float*)p.in[29] + (size_t)L * D, (const float*)p.in[30] + (size_t)L * D, L == 3 ? (float*)p.out : (float*)nullptr));
    }
#undef PHASE
}

extern "C" void kernel_launch(void* const* d_in, const int* in_sizes, int n_in, void* d_out, int out_size, void* d_ws, size_t ws_size, hipStream_t stream) {
    static int grid = 0;
    if (grid == 0) {
        if (n_in != 31 || out_size != T * D || ws_size < WS_END) { fprintf(stderr, "kernel_launch: unexpected shapes (n_in %d out %d ws %zu need %zu)\n", n_in, out_size, ws_size, (size_t)WS_END); grid = -1; return; }
        int dev = 0, cus = 0, per_cu = 0;
        if (hipGetDevice(&dev) != hipSuccess || hipDeviceGetAttribute(&cus, hipDeviceAttributeMultiprocessorCount, dev) != hipSuccess) { grid = -1; return; }
        if (hipFuncSetAttribute((const void*)fwd_kernel, hipFuncAttributeMaxDynamicSharedMemorySize, LDS_BYTES) != hipSuccess) { fprintf(stderr, "kernel_launch: hipFuncSetAttribute failed\n"); grid = -1; return; }
        if (hipOccupancyMaxActiveBlocksPerMultiprocessor(&per_cu, (const void*)fwd_kernel, NTHREADS, LDS_BYTES) != hipSuccess || per_cu < 1) fprintf(stderr, "kernel_launch: occupancy query says %d\n", per_cu);
        (void)hipGetLastError();
        grid = cus;
    }
    if (grid < 0) return;
    (void)hipMemsetAsync((char*)d_ws + WS_CTL, 0, CTL_BYTES, stream);
    Params p{};
    for (int i = 0; i < 31; ++i) p.in[i] = (const GAS float*)d_in[i];
    p.out = (GAS float*)d_out; p.ws = (GAS unsigned char*)d_ws;
#if N_LAUNCH_MODE == 1
    p.ph_lo = 0; p.ph_hi = N_PHASES;
    hipLaunchKernelGGL(fwd_kernel, dim3(grid), dim3(NTHREADS), LDS_BYTES, stream, p);
#else
    for (int i = 0; i < N_PHASES; ++i) { p.ph_lo = i; p.ph_hi = i + 1; hipLaunchKernelGGL(fwd_kernel, dim3(grid), dim3(NTHREADS), LDS_BYTES, stream, p); }
#endif
}
```

```cpp
#include <hip/hip_runtime.h>
#include <cstdio>
#include <cstdint>

#define LAS __attribute__((address_space(3)))
typedef unsigned short bf16_t;
typedef short bf16x8 __attribute__((ext_vector_type(8)));
typedef float f32x4 __attribute__((ext_vector_type(4)));
typedef float f32x2 __attribute__((ext_vector_type(2)));
typedef unsigned u32x4 __attribute__((ext_vector_type(4)));
typedef unsigned u32x2 __attribute__((ext_vector_type(2)));

constexpr int T = 16384, D = 1024, SEQ = 8192;
constexpr int AB_IN = 4352, AB_OUT = 2048, CD_IN = 4608, CD_OUT = 2304;
constexpr int NE = 128, NE1 = 129, TOPK = 8, ED = 256;
constexpr int TK = T * TOPK;
constexpr int NSLOT = TK + T;
constexpr int LISTCAP = 16384;
constexpr float ALPHA = 1.681792830507429f;
constexpr float LN_EPS = 1e-5f;

#ifndef N_LAUNCH_MODE
#define N_LAUNCH_MODE 1
#endif

constexpr size_t al256(size_t x) { return (x + 255) & ~(size_t)255; }
constexpr size_t WS_CTL    = 0;
constexpr size_t CTL_BYTES = 131072;
constexpr size_t CTL_CNT   = 65536;
constexpr size_t WS_WABIN  = CTL_BYTES;
constexpr size_t WS_WABOUT = WS_WABIN  + al256((size_t)2 * AB_IN * D * 2);
constexpr size_t WS_WCDIN  = WS_WABOUT + al256((size_t)2 * D * AB_OUT * 2);
constexpr size_t WS_WCDOUT = WS_WCDIN  + al256((size_t)2 * CD_IN * D * 2);
constexpr size_t WS_WRT    = WS_WCDOUT + al256((size_t)2 * D * CD_OUT * 2);
constexpr size_t WS_WGU    = WS_WRT    + al256((size_t)4 * 256 * D * 2);
constexpr size_t WS_WDN    = WS_WGU    + al256((size_t)4 * NE1 * 512 * D * 2);
constexpr size_t WS_X      = WS_WDN    + al256((size_t)4 * NE1 * D * ED * 2);
constexpr size_t WS_HB     = WS_X;
constexpr size_t WS_XB     = WS_X      + al256((size_t)T * D * 4);
constexpr size_t WS_U1     = WS_XB     + al256((size_t)T * D * 2);
constexpr size_t U1_BYTES  = al256((size_t)NSLOT * D * 2) > al256((size_t)T * CD_IN * 4) ? al256((size_t)NSLOT * D * 2) : al256((size_t)T * CD_IN * 4);
constexpr size_t WS_U2     = WS_U1     + U1_BYTES;
constexpr size_t U2_BYTES  = al256((size_t)T * 1280 * 4 * 3);
constexpr size_t WS_YCAT   = WS_U2     + U2_BYTES;
constexpr size_t WS_H      = WS_YCAT   + al256((size_t)T * CD_OUT * 2);
constexpr size_t WS_ZR     = WS_H      + al256((size_t)T * D * 4);
constexpr size_t WS_HID    = WS_ZR     + al256((size_t)T * 256 * 4);
constexpr size_t WS_LIST   = WS_HID    + al256((size_t)NSLOT * ED * 2);
constexpr size_t WS_GATE   = WS_LIST   + al256((size_t)NE * LISTCAP * 4);
constexpr size_t WS_ROPEA  = WS_GATE   + al256((size_t)NSLOT * 4);
constexpr size_t WS_ROPER  = WS_ROPEA  + al256((size_t)SEQ * 32 * 8);
constexpr size_t WS_BIASP  = WS_ROPER  + al256((size_t)SEQ * 64 * 8);
constexpr size_t WS_WLRU   = WS_BIASP  + al256((size_t)2 * AB_IN * 4);
constexpr size_t WS_SPL    = WS_WLRU   + al256((size_t)2 * 5 * 2 * 65536 * 2);
constexpr size_t WS_END    = WS_SPL    + al256((size_t)2 * 1280 * 4);
constexpr size_t CD_GU = WS_U1, CD_GVT = WS_U1 + 32 * (1024 * 1024), CD_GG = WS_U1 + 64 * (1024 * 1024), CD_XR = WS_U1 + 104 * (1024 * 1024), CD_STATS = WS_U1 + 144 * (1024 * 1024);
constexpr size_t MB = 1024 * 1024;
constexpr size_t AB_QB = WS_U1, AB_KB = WS_U1 + 32 * MB, AB_VT = WS_U1 + 36 * MB, AB_RQB = WS_U1 + 40 * MB, AB_RKB = WS_U1 + 56 * MB, AB_RKDT = WS_U1 + 72 * MB,
                 AB_RVT = WS_U1 + 88 * MB, AB_RGB = WS_U1 + 120 * MB, AB_KV = WS_U1 + 152 * MB  , AB_SPREV = WS_U1 + 216 * MB  ;
static_assert(AB_SPREV + 32 * MB <= WS_U1 + U1_BYTES, "U1 map");

__device__ __forceinline__ float bf2f(bf16_t b) { return __uint_as_float(((unsigned)b) << 16); }
__device__ __forceinline__ unsigned pk2(float lo, float hi) { unsigned r; asm("v_cvt_pk_bf16_f32 %0, %1, %2" : "=v"(r) : "v"(lo), "v"(hi)); return r; }
__device__ __forceinline__ bf16_t f2bf(float f) { return (bf16_t)(pk2(f, f) & 0xffffu); }
__device__ __forceinline__ float wave_sum(float v) {
#pragma unroll
    for (int o = 32; o; o >>= 1) v += __shfl_xor(v, o);
    return v; }
__device__ __forceinline__ float wave_max(float v) {
#pragma unroll
    for (int o = 32; o; o >>= 1) v = fmaxf(v, __shfl_xor(v, o));
    return v; }
__device__ __forceinline__ float gelu_tanh(float x) { const float u = 0.7978845608028654f * (x + 0.044715f * x * x * x); return 0.5f * x * (1.f + tanhf(u)); }
__device__ __forceinline__ float sigmoidf_(float x) { return __builtin_amdgcn_rcpf(1.f + __expf(-x)); }
__device__ __forceinline__ float siluf_(float x) { return x * __builtin_amdgcn_rcpf(1.f + __expf(-x)); }
__device__ __forceinline__ f32x4 silu4(const f32x4 x) { const f32x4 t = x * (-1.4426950408889634f); f32x4 d;
#pragma unroll
    for (int e = 0; e < 4; ++e) d[e] = __builtin_amdgcn_exp2f(t[e]);
    d = d + 1.f;
#pragma unroll
    for (int e = 0; e < 4; ++e) d[e] = __builtin_amdgcn_rcpf(d[e]);
    return x * d; }
__device__ __forceinline__ f32x4 gelu4(const f32x4 x) {
    const f32x4 t = x * ((x * x) * (-0.10294323886f) + (-2.30220819813f)); f32x4 d;
#pragma unroll
    for (int e = 0; e < 4; ++e) d[e] = __builtin_amdgcn_exp2f(t[e]);
    d = d + 1.f;
#pragma unroll
    for (int e = 0; e < 4; ++e) d[e] = __builtin_amdgcn_rcpf(d[e]);
    return x * d; }

#define XB_TMO      128
#define XB_XCNT(j)  (256  + 64 * (j))
#define XB_XSUB(j)  (1280 + 64 * (j))
#define XB_XGEN(j)  (2304 + 64 * (j))
#define XB_TOP      3328
#define XB_TOPGEN   3392
#define XCD_BAR_WORDS 3456
#define XB_SPIN_CAP (1u << 22)

__device__ __forceinline__ unsigned xb_ld(unsigned* p)              { return __hip_atomic_load(p, __ATOMIC_RELAXED, __HIP_MEMORY_SCOPE_AGENT); }
__device__ __forceinline__ unsigned xb_add(unsigned* p, unsigned v) { return __hip_atomic_fetch_add(p, v, __ATOMIC_RELAXED, __HIP_MEMORY_SCOPE_AGENT); }
__device__ __forceinline__ unsigned xb_xcc_id() { return (unsigned)__builtin_amdgcn_s_getreg((3 << 11) | 20) & 0xFu; }
#define XB_SPIN(cond, bar) do { unsigned _sp = 0; while (cond) { __builtin_amdgcn_s_sleep(1); \
    if ((++_sp & 255u) == 0u) { if (xb_ld(&(bar)[XB_TMO])) break; if (_sp > XB_SPIN_CAP) { atomicAdd(&(bar)[XB_TMO], 1u); break; } } } } while (0)

struct XcdBarrier { unsigned* bar; unsigned x; volatile LAS unsigned* st; };

__device__ __forceinline__ XcdBarrier xcd_barrier_post(unsigned* bar, volatile LAS unsigned* st) {
    XcdBarrier b; b.bar = bar; b.x = xb_xcc_id(); b.st = st;
    if (threadIdx.x == 0) (void)xb_add(&bar[XB_XCNT(b.x)], 1u);
    return b;
}
__device__ __forceinline__ void xcd_barrier_complete(unsigned* bar, unsigned x, unsigned& nloc, unsigned& nx) {
    const unsigned G = gridDim.x * gridDim.y * gridDim.z;
    unsigned sum, cnt, mine, sp = 0u;
    for (;;) {
        sum = 0u; cnt = 0u; mine = 0u;
#pragma unroll
        for (unsigned j = 0; j < 16; ++j) { const unsigned c = xb_ld(&bar[XB_XCNT(j)]); sum += c; cnt += (c > 0u) ? 1u : 0u; mine = (j == x) ? c : mine; }
        if (sum == G) break;
        __builtin_amdgcn_s_sleep(1);
        if ((++sp & 255u) == 0u) { if (xb_ld(&bar[XB_TMO])) break; if (sp > XB_SPIN_CAP) { atomicAdd(&bar[XB_TMO], 1u); break; } }
    }
    nloc = mine > 0u ? mine : 1u; nx = cnt > 0u ? cnt : 1u;
}
__device__ __forceinline__ void xcd_barrier(const XcdBarrier& b, const bool leader  ) {
    asm volatile("s_waitcnt vmcnt(0)" ::: "memory");
    __syncthreads();
    if (leader) {
        unsigned* bar = b.bar;
        __builtin_amdgcn_s_waitcnt(0);
        unsigned nloc = b.st[0], nx = b.st[1];
        if (nloc == 0u) { xcd_barrier_complete(bar, b.x, nloc, nx); b.st[0] = nloc; b.st[1] = nx; }
        const unsigned old = xb_add(&bar[XB_XSUB(b.x)], 1u);
        const unsigned gen = old / nloc;
        if (old + 1u == (gen + 1u) * nloc) {
            __builtin_amdgcn_fence(__ATOMIC_RELEASE, "agent");
            asm volatile("s_waitcnt vmcnt(0)" ::: "memory");
            const unsigned og = xb_add(&bar[XB_TOP], 1u);
            const unsigned tg = og / nx;
            if (og + 1u == (tg + 1u) * nx) xb_add(&bar[XB_TOPGEN], 1u);
            else XB_SPIN(xb_ld(&bar[XB_TOPGEN]) == tg, bar);
            __builtin_amdgcn_fence(__ATOMIC_ACQUIRE, "agent");
            xb_add(&bar[XB_XGEN(b.x)], 1u);
            asm volatile("s_waitcnt vmcnt(0)" ::: "memory");
        } else {
            XB_SPIN(xb_ld(&bar[XB_XGEN(b.x)]) == gen, bar);
            __builtin_amdgcn_fence(__ATOMIC_ACQUIRE, "agent");
            asm volatile("s_waitcnt vmcnt(0)" ::: "memory");
        }
    }
    __syncthreads();
}

namespace g8 {
constexpr int BM = 256, BK = 64, HALF = 128, HTB = HALF * BK * 2, STAGE_BYTES = 8 * HTB, NXCD = 8, WGM = 8;
__device__ __forceinline__ int lds_byte(int r, int c) { const int st = (r >> 4) * 2 + (c >> 5), rr = r & 15, cc = c & 31, ob = rr * 64 + cc * 2; return st * 1024 + (ob ^ (((ob >> 9) & 1) << 5)); }
__device__ __forceinline__ void stage_rc(int b, int& R, int& C) { const int st = b / 1024, sb = b % 1024, swz = sb ^ (((sb >> 9) & 1) << 5); R = (st >> 1) * 16 + swz / 64; C = (st & 1) * 32 + (swz % 64) / 2; }
__device__ __forceinline__ int perm32(int rho) { const int n = rho >> 4, i = rho & 15; return 8 * (i >> 2) + 4 * n + (i & 3); }

struct Unit { const char* A; const char* B; int pm, pn, aux; };

struct DenseOrder {
    const char* A; const char* Bt; int nM, nN, nwg, G, c, K, tid0;
    __device__ void init(const void* A_, const void* Bt_, int M, int N, int K_, int G_, int c_) { A = (const char*)A_; Bt = (const char*)Bt_; nM = M / BM; nN = N / BM; nwg = nM * nN; G = G_; c = c_; K = K_; }
    __device__ __forceinline__ bool next(int i, Unit& u) const {
        const long L = (long)i * G + c; if (L >= nwg) return false;
        int wgid = (int)L; { const int q = nwg / NXCD, r = nwg % NXCD, xcd = wgid % NXCD, off = wgid / NXCD; wgid = (xcd < r ? xcd * (q + 1) : r * (q + 1) + (xcd - r) * q) + off; }
        const int nig = WGM * nN, gid = wgid / nig, fm = gid * WGM, gsz = (nM - fm) < WGM ? (nM - fm) : WGM;
        u.pm = fm + ((wgid % nig) % gsz); u.pn = (wgid % nig) / gsz; u.aux = 0;
        u.A = A + (size_t)u.pm * BM * K * 2; u.B = Bt + (size_t)u.pn * BM * K * 2; return true;
    }
    __device__ __forceinline__ void aoff(const Unit&, int tid, unsigned (&o)[2][2]) const {
#pragma unroll
        for (int i = 0; i < 2; ++i) { int R, C; stage_rc(tid * 16 + i * 8192, R, C);
            o[0][i] = (unsigned)(R * K + C) * 2u; o[1][i] = (unsigned)((R + HALF) * K + C) * 2u; }
    }
};

__device__ __forceinline__ unsigned cvt_pk_bf16(float lo, float hi) { unsigned r; asm volatile("v_cvt_pk_bf16_f32 %0, %1, %2" : "=v"(r) : "v"(lo), "v"(hi)); return r; }

struct EpiF32 {
    static constexpr bool PERM = false;
    float* C; int ldc; const float* bias;
    __device__ __forceinline__ void init(f32x4 (&acc)[2][2][4][2], const Unit&, int, int) const {
#pragma unroll
        for (int a = 0; a < 2; ++a)
#pragma unroll
            for (int b = 0; b < 2; ++b)
#pragma unroll
                for (int m = 0; m < 4; ++m)
#pragma unroll
                    for (int n = 0; n < 2; ++n) acc[a][b][m][n] = (f32x4){0.f, 0.f, 0.f, 0.f}; }
    __device__ __forceinline__ void operator()(const f32x4 (&acc)[2][2][4][2], const Unit& u, int wr, int wc, int fr, int fq) const {
        const int row0 = u.pm * BM + wr * 64 + fr, col0 = u.pn * BM + wc * 32 + 4 * fq;
        f32x4 bv[2][2];
#pragma unroll
        for (int bj = 0; bj < 2; ++bj)
#pragma unroll
            for (int n = 0; n < 2; ++n) bv[bj][n] = bias ? *(const f32x4*)(bias + col0 + bj * HALF + n * 16) : (f32x4){0.f, 0.f, 0.f, 0.f};
#pragma unroll
        for (int ai = 0; ai < 2; ++ai)
#pragma unroll
            for (int m = 0; m < 4; ++m) { float* rowp = C + (size_t)(row0 + ai * HALF + m * 16) * ldc + col0;
#pragma unroll
                for (int bj = 0; bj < 2; ++bj)
#pragma unroll
                    for (int n = 0; n < 2; ++n) *(f32x4*)(rowp + bj * HALF + n * 16) = acc[ai][bj][m][n] + bv[bj][n]; }
    }
};

struct EpiBf16 {
    static constexpr bool PERM = true;
    bf16_t* O; int ldc; const float* bias;
    __device__ __forceinline__ void init(f32x4 (&acc)[2][2][4][2], const Unit&, int, int) const {
#pragma unroll
        for (int a = 0; a < 2; ++a)
#pragma unroll
            for (int b = 0; b < 2; ++b)
#pragma unroll
                for (int m = 0; m < 4; ++m)
#pragma unroll
                    for (int n = 0; n < 2; ++n) acc[a][b][m][n] = (f32x4){0.f, 0.f, 0.f, 0.f}; }
    __device__ __forceinline__ void operator()(const f32x4 (&acc)[2][2][4][2], const Unit& u, int wr, int wc, int fr, int fq) const {
        const int row0 = u.pm * BM + wr * 64 + fr, col0 = u.pn * BM + wc * 32 + 8 * fq;
        f32x4 bv[2][2];
#pragma unroll
        for (int bj = 0; bj < 2; ++bj)
#pragma unroll
            for (int n = 0; n < 2; ++n) bv[bj][n] = *(const f32x4*)(bias + col0 + bj * HALF + 4 * n);
#pragma unroll
        for (int ai = 0; ai < 2; ++ai)
#pragma unroll
            for (int m = 0; m < 4; ++m) { bf16_t* rowp = O + (size_t)(row0 + ai * HALF + m * 16) * ldc + col0;
#pragma unroll
                for (int bj = 0; bj < 2; ++bj) { const f32x4 v0 = acc[ai][bj][m][0] + bv[bj][0], v1 = acc[ai][bj][m][1] + bv[bj][1];
                    u32x4 w; w[0] = cvt_pk_bf16(v0[0], v0[1]); w[1] = cvt_pk_bf16(v0[2], v0[3]); w[2] = cvt_pk_bf16(v1[0], v1[1]); w[3] = cvt_pk_bf16(v1[2], v1[3]);
                    *(u32x4*)(rowp + bj * HALF) = w; } }
    }
};

template <class Epi, class Sched>
__device__ __forceinline__ void gemm_phase(LAS unsigned char* lds, const int K, const Sched& S, const Epi& E) {
    int tid_ = S.tid0; asm volatile("" : "+v"(tid_));
    const int tid = tid_, wid = __builtin_amdgcn_readfirstlane(tid >> 6), lane = tid & 63, wr = wid >> 2, wc = wid & 3, fr = lane & 15, fq = lane >> 4;
    const int nt = K / BK;
    unsigned voffB[2];
#pragma unroll
    for (int i = 0; i < 2; ++i) { int R, C; stage_rc(tid * 16 + i * 8192, R, C); const int Rb = Epi::PERM ? ((R & ~31) + perm32(R & 31)) : R;
        voffB[i] = (unsigned)(Rb * K + C) * 2u; }
    const size_t kstep = (size_t)(BK * 2);
    const size_t hstep = (size_t)HALF * K * 2;
    const unsigned ldsw = (unsigned)wid * 1024u;
    const int aoff = lds_byte(wr * 64 + fr, fq * 8), boff = lds_byte(wc * 32 + fr, fq * 8);
#define G8_SA(b, h) (((b) * 2 + (h)) * HTB)
#define G8_SB(b, h) ((4 + (b) * 2 + (h)) * HTB)
#define G8_STAGE(bufoff, gbase, voff) do { _Pragma("unroll") for (int _i = 0; _i < 2; ++_i) \
        __builtin_amdgcn_global_load_lds((const unsigned*)((const char*)(gbase) + (voff)[_i]), (LAS unsigned*)(lds + (bufoff) + ldsw + _i * 8192), 16, 0, 0); } while (0)
#define G8_LDA(dst, b, h) do { _Pragma("unroll") for (int m = 0; m < 4; ++m) _Pragma("unroll") for (int k = 0; k < 2; ++k) dst[m][k] = *(const LAS bf16x8*)(lds + G8_SA(b, h) + aoff + m * 2048 + k * 1024); } while (0)
#define G8_LDB(dst, b, h) do { _Pragma("unroll") for (int n = 0; n < 2; ++n) _Pragma("unroll") for (int k = 0; k < 2; ++k) dst[n][k] = *(const LAS bf16x8*)(lds + G8_SB(b, h) + boff + n * 2048 + k * 1024); } while (0)
#define G8_MMA(ai, bj, At, Bt) do { __builtin_amdgcn_s_setprio(1); _Pragma("unroll") for (int m = 0; m < 4; ++m) _Pragma("unroll") for (int n = 0; n < 2; ++n) _Pragma("unroll") for (int k = 0; k < 2; ++k) \
        acc[ai][bj][m][n] = __builtin_amdgcn_mfma_f32_16x16x32_bf16(Bt[n][k], At[m][k], acc[ai][bj][m][n], 0, 0, 0); __builtin_amdgcn_s_setprio(0); } while (0)
#define G8_WAIT_V(n) asm volatile("s_waitcnt vmcnt(" #n ")" ::: "memory")
#define G8_WAIT_L(n) asm volatile("s_waitcnt lgkmcnt(" #n ")" ::: "memory")
#define G8_BAR __builtin_amdgcn_s_barrier()
#define G8_SCHED __builtin_amdgcn_sched_barrier(0)
    Unit cur, nxt; int ui = 0;
    if (!S.next(0, cur)) return;
    f32x4 acc[2][2][4][2];
    E.init(acc, cur, wc, fq);
    bf16x8 At[4][2], B0[2][2], B1[2][2];
    unsigned oc[2][2];
    S.aoff(cur, tid, oc);
    const char* cA = cur.A; const char* cB = cur.B;
    G8_STAGE(G8_SB(0, 0), cB, voffB); G8_STAGE(G8_SA(0, 0), cA, oc[0]); G8_STAGE(G8_SB(0, 1), cB + hstep, voffB); G8_STAGE(G8_SA(0, 1), cA, oc[1]);
    if (wr == 1) G8_BAR;
    G8_WAIT_V(4); G8_BAR;
    G8_STAGE(G8_SB(1, 0), cB + kstep, voffB); G8_STAGE(G8_SA(1, 0), cA + kstep, oc[0]); G8_STAGE(G8_SB(1, 1), cB + hstep + kstep, voffB);
    G8_WAIT_V(6); G8_BAR;
    for (;;) {
        const bool has_next = S.next(ui + 1, nxt);
        const char* nA = has_next ? nxt.A : cA; const char* nB = has_next ? nxt.B : cB;
#pragma unroll 1
        for (int t = 0; t < nt; t += 2) {
            const bool last = (t == nt - 2);
            const char* a1 = cA + (size_t)(t + 1) * kstep;
            const char* a2 = last ? nA : cA + (size_t)(t + 2) * kstep; const char* b2 = last ? nB : cB + (size_t)(t + 2) * kstep;
            const char* a3 = a2 + kstep; const char* b3 = b2 + kstep;
            G8_LDB(B0, 0, 0); G8_SCHED; G8_LDA(At, 0, 0); G8_STAGE(G8_SA(1, 1), a1, oc[1]);
            if (last && has_next) S.aoff(nxt, tid, oc);
            G8_WAIT_L(8); G8_BAR; G8_WAIT_L(0); G8_MMA(0, 0, At, B0); G8_BAR; G8_SCHED;
            G8_LDB(B1, 0, 1); G8_STAGE(G8_SB(0, 0), b2, voffB);
            G8_BAR; G8_WAIT_L(0); G8_MMA(0, 1, At, B1); G8_BAR;
            G8_LDA(At, 0, 1); G8_STAGE(G8_SA(0, 0), a2, oc[0]);
            G8_BAR; G8_WAIT_L(0); G8_MMA(1, 0, At, B0); G8_BAR; G8_SCHED;
            G8_STAGE(G8_SB(0, 1), b2 + hstep, voffB);
            G8_WAIT_V(6); G8_BAR; G8_MMA(1, 1, At, B1); G8_BAR;
            G8_LDB(B0, 1, 0); G8_SCHED; G8_LDA(At, 1, 0); G8_STAGE(G8_SA(0, 1), a2, oc[1]);
            G8_WAIT_L(8); G8_BAR; G8_WAIT_L(0); G8_MMA(0, 0, At, B0); G8_BAR; G8_SCHED;
            G8_LDB(B1, 1, 1); G8_STAGE(G8_SB(1, 0), b3, voffB);
            G8_BAR; G8_WAIT_L(0); G8_MMA(0, 1, At, B1); G8_BAR;
            G8_LDA(At, 1, 1); G8_STAGE(G8_SA(1, 0), a3, oc[0]);
            G8_BAR; G8_WAIT_L(0); G8_MMA(1, 0, At, B0); G8_BAR; G8_SCHED;
            G8_STAGE(G8_SB(1, 1), b3 + hstep, voffB);
            G8_WAIT_V(6); G8_BAR; G8_MMA(1, 1, At, B1); G8_BAR;
        }
        E(acc, cur, wr, wc, fr, fq);
        if (!has_next) break;
        cur = nxt; cA = nA; cB = nB; ++ui;
        E.init(acc, cur, wc, fq);
    }
    G8_WAIT_V(0);
    if (wr == 0) G8_BAR;
    G8_BAR;
#undef G8_SA
#undef G8_SB
#undef G8_STAGE
#undef G8_LDA
#undef G8_LDB
#undef G8_MMA
#undef G8_WAIT_V
#undef G8_WAIT_L
#undef G8_BAR
#undef G8_SCHED
}
}

constexpr int NTHREADS = 512;
constexpr int LDS_STAGE = 0;
constexpr int LDS_TAB   = g8::STAGE_BYTES;
constexpr int TAB_SLOTS = 6;
constexpr int LDS_GTAB  = LDS_TAB + TAB_SLOTS * 256 * 4;
constexpr int LDS_DESC  = LDS_GTAB + TAB_SLOTS * 256 * 4;
constexpr int LDS_PREF  = LDS_DESC + 64;
constexpr int LDS_MISC  = 147456 - 64;
constexpr int LDS_BYTES = 147456;
static_assert(LDS_MISC % 16 == 0 && LDS_MISC + 64 <= LDS_BYTES && LDS_PREF + 132 * 4 <= LDS_MISC, "LDS map");

#define GAS __attribute__((address_space(1)))
struct Params { const GAS float* in[31]; GAS float* out; GAS unsigned char* ws; int ph_lo, ph_hi; };

struct Ctx {
    const GAS float* const* in; float* out; unsigned char* ws; LAS unsigned char* lds;
    __device__ __forceinline__ const float* inp(int k) const { return (const float*)in[k]; }
    int tid, lane, wid, bid, G, gtid, gthreads, gw, nwaves;
};

__device__ __forceinline__ int ab_phys(int n) {
    if (n < 1024) { const int hd = n >> 6, jj = n & 63; return (hd >> 2) * 256 + (jj >> 5) * 128 + (hd & 3) * 32 + (jj & 31); }
    if (n < 1152) { const int nn = n - 1024, hh = nn >> 6, jj = nn & 63; return 1024 + (jj >> 5) * 128 + hh * 32 + (jj & 31); }
    if (n < 1280) { const int vv = n - 1152; return 1024 + (vv >> 6) * 128 + 64 + (vv & 63); }
    if (n < 2304) { const int base = n < 1792 ? 1280 : 1792, nn = n - base, h = nn >> 7, jj = nn & 127; return base + (h >> 1) * 256 + (jj >> 6) * 128 + (h & 1) * 64 + (jj & 63); }
    return n;
}
template <int TN, class DstFn>
__device__ __forceinline__ void convert_T(const Ctx& c, const float* src, int nmat, int K, int N, DstFn dstfn) {
    LAS float* tile = (LAS float*)(c.lds);
    constexpr int LDT = TN + 1, TPR = TN / 4  , KPI = NTHREADS / TPR  , NI = 64 / KPI, KPT = 64 * TN / NTHREADS  ;
    const int tk = K / 64, tn = N / TN; const long ntiles = (long)nmat * tk * tn;
    f32x4 v[NI];
    auto issue = [&](long tix) { const int m = (int)(tix / (tk * tn)); const int rem = (int)(tix % (tk * tn)); const int kt = rem / tn, nt = rem % tn;
        const float* s = src + (size_t)m * K * N + (size_t)(kt * 64) * N + nt * TN;
#pragma unroll
        for (int i = 0; i < NI; ++i) { const int k = c.tid / TPR + KPI * i, n4 = (c.tid % TPR) * 4; v[i] = __builtin_nontemporal_load((const f32x4*)(s + (size_t)k * N + n4)); } };
    if (c.bid < ntiles) issue(c.bid);
    for (long tix = c.bid; tix < ntiles; tix += c.G) {
        const int m = (int)(tix / (tk * tn)); const int rem = (int)(tix % (tk * tn)); const int kt = rem / tn, nt = rem % tn;
#pragma unroll
        for (int i = 0; i < NI; ++i) { const int k = c.tid / TPR + KPI * i, n4 = (c.tid % TPR) * 4;
            tile[k * LDT + n4 + 0] = v[i][0]; tile[k * LDT + n4 + 1] = v[i][1]; tile[k * LDT + n4 + 2] = v[i][2]; tile[k * LDT + n4 + 3] = v[i][3]; }
        if (tix + c.G < ntiles) issue(tix + c.G);
        __syncthreads();
        { constexpr int TPN = 64 / KPT; const int n = c.tid / TPN, k0 = (c.tid % TPN) * KPT;
          bf16_t* d = dstfn(m, nt * TN + n) + kt * 64 + k0;
#pragma unroll
          for (int q = 0; q < KPT / 8; ++q) { u32x4 w;
#pragma unroll
              for (int e = 0; e < 4; ++e) w[e] = pk2(tile[(k0 + q * 8 + 2 * e) * LDT + n], tile[(k0 + q * 8 + 2 * e + 1) * LDT + n]);
              *(u32x4*)(d + q * 8) = w; } }
        __syncthreads();
    }
}

__device__ __forceinline__ void phase_convert(const Ctx& c) {
    unsigned char* ws = c.ws;
    { const float* x = c.inp(0); bf16_t* xb = (bf16_t*)(ws + WS_XB);
      for (long i = c.gtid; i < (long)T * D / 4; i += c.gthreads) { const f32x4 v = *(const f32x4*)(x + i * 4); u32x2 w; w[0] = pk2(v[0], v[1]); w[1] = pk2(v[2], v[3]); *(u32x2*)(xb + i * 4) = w; } }
    { bf16_t* wrt = (bf16_t*)(ws + WS_WRT); for (long i = c.gtid; i < (long)4 * 128 * D / 8; i += c.gthreads) { const long l = i / (128 * D / 8), r = i % (128 * D / 8); *(u32x4*)(wrt + (size_t)l * 256 * D + (size_t)128 * D + r * 8) = (u32x4){0u, 0u, 0u, 0u}; }
      float* gate = (float*)(ws + WS_GATE); for (int i = c.gtid; i < T; i += c.gthreads) gate[TK + i] = 1.f;
      f32x2* ra = (f32x2*)(ws + WS_ROPEA); f32x2* rr = (f32x2*)(ws + WS_ROPER);
      for (int i = c.gtid; i < SEQ * 96; i += c.gthreads) { const int sidx = i / 96, q = i % 96; const bool isA = q < 32; const int jx = isA ? q : q - 32;
          const float e = isA ? (float)jx * (1.f / 32.f) : (float)jx * (1.f / 63.f); const float ang = (float)sidx * exp2f(-e * 13.287712379549449f); float sn, cs; sincosf(ang, &sn, &cs);
          if (isA) ra[sidx * 32 + jx] = (f32x2){cs, sn}; else rr[sidx * 64 + jx] = (f32x2){cs, sn}; }
      float* bp = (float*)(ws + WS_BIASP); for (int i = c.gtid; i < 2 * AB_IN; i += c.gthreads) { const int m = i / AB_IN, n = i % AB_IN; bp[m * AB_IN + ab_phys(n)] = c.inp(2)[i]; } }
    { bf16_t* d = (bf16_t*)(ws + WS_WABIN);  convert_T<256>(c, c.inp(1), 2, D, AB_IN, [=](int m, int n) { return d + (size_t)m * AB_IN * D + (size_t)ab_phys(n) * D; }); }
    { bf16_t* d = (bf16_t*)(ws + WS_WABOUT); convert_T<256>(c, c.inp(4), 2, AB_OUT, D, [=](int m, int n) { return d + (size_t)m * D * AB_OUT + (size_t)n * AB_OUT; }); }
    { bf16_t* d = (bf16_t*)(ws + WS_WCDIN);  convert_T<256>(c, c.inp(6), 2, D, CD_IN, [=](int m, int n) { return d + (size_t)m * CD_IN * D + (size_t)n * D; }); }
    { bf16_t* d = (bf16_t*)(ws + WS_WCDOUT); convert_T<256>(c, c.inp(17), 2, CD_OUT, D, [=](int m, int n) { return d + (size_t)m * D * CD_OUT + (size_t)n * CD_OUT; }); }
    { bf16_t* d = (bf16_t*)(ws + WS_WRT);    convert_T<128>(c, c.inp(21), 4, D, NE, [=](int m, int n) { return d + (size_t)m * 256 * D + (size_t)n * D; }); }
    { bf16_t* d = (bf16_t*)(ws + WS_WGU);
      convert_T<256>(c, c.inp(23), 4 * NE, D, ED, [=](int m, int n) { return d + (size_t)((m >> 7) * NE1 + (m & 127)) * 512 * D + (size_t)((n >> 7) * 256 + (n & 127)) * D; });
      convert_T<256>(c, c.inp(24), 4 * NE, D, ED, [=](int m, int n) { return d + (size_t)((m >> 7) * NE1 + (m & 127)) * 512 * D + (size_t)((n >> 7) * 256 + 128 + (n & 127)) * D; });
      convert_T<256>(c, c.inp(26), 4, D, ED, [=](int m, int n) { return d + (size_t)(m * NE1 + NE) * 512 * D + (size_t)((n >> 7) * 256 + (n & 127)) * D; });
      convert_T<256>(c, c.inp(27), 4, D, ED, [=](int m, int n) { return d + (size_t)(m * NE1 + NE) * 512 * D + (size_t)((n >> 7) * 256 + 128 + (n & 127)) * D; }); }
    { bf16_t* d = (bf16_t*)(ws + WS_WLRU);
      convert_T<256>(c, c.inp(12), 10, 256, 256, [=](int m, int n) { return d + (size_t)(m * 2 + 0) * 65536 + (size_t)n * 256; });
      convert_T<256>(c, c.inp(14), 10, 256, 256, [=](int m, int n) { return d + (size_t)(m * 2 + 1) * 65536 + (size_t)n * 256; });
      float* spl = (float*)(ws + WS_SPL); for (int i = c.gtid; i < 2 * 1280; i += c.gthreads) spl[i] = log1pf(expf(-c.inp(16)[i])); }
    { bf16_t* d = (bf16_t*)(ws + WS_WDN);
      convert_T<256>(c, c.inp(25), 4 * NE, ED, D, [=](int m, int n) { return d + (size_t)((m >> 7) * NE1 + (m & 127)) * D * ED + (size_t)n * ED; });
      convert_T<256>(c, c.inp(28), 4, ED, D, [=](int m, int n) { return d + (size_t)(m * NE1 + NE) * D * ED + (size_t)n * ED; }); }
}

__device__ __forceinline__ void phase_dense(const Ctx& c, const bf16_t* A, const bf16_t* Bt, int M, int N, int K, bf16_t* C, int ldc, const float* bias) {
    g8::DenseOrder S; S.init(A, Bt, M, N, K, c.G, c.bid); S.tid0 = c.tid;
    g8::EpiBf16 E{C, ldc, bias};
    g8::gemm_phase<g8::EpiBf16, g8::DenseOrder>(c.lds + LDS_STAGE, K, S, E);
}

__device__ __forceinline__ void st_bf16_off(unsigned char* base, unsigned byte_off, float v) { *(bf16_t*)(base + byte_off) = f2bf(v); }
struct EpiABIn {
    static constexpr bool PERM = true;
    LAS bf16_t* biasL; unsigned char* ws;
    __device__ __forceinline__ void init(f32x4 (&acc)[2][2][4][2], const g8::Unit& u, int wc, int fq) const {
        const int colp = u.pn * 256 + wc * 32 + fq * 8;
#pragma unroll
        for (int b = 0; b < 2; ++b)
#pragma unroll
            for (int n = 0; n < 2; ++n) { const u32x2 bw = *(const LAS u32x2*)(biasL + colp + b * 128 + 4 * n);
                const f32x4 bv = (f32x4){__uint_as_float(bw[0] << 16), __uint_as_float(bw[0] & 0xffff0000u), __uint_as_float(bw[1] << 16), __uint_as_float(bw[1] & 0xffff0000u)};
#pragma unroll
                for (int a = 0; a < 2; ++a)
#pragma unroll
                    for (int m = 0; m < 4; ++m) acc[a][b][m][n] = bv; } }
    __device__ __forceinline__ void operator()(const f32x4 (&acc)[2][2][4][2], const g8::Unit& u, int wr, int wc, int fr_, int fq_) const {
        int fr = fr_, fq = fq_; asm volatile("" : "+v"(fr), "+v"(fq));
        const int pn = u.pn; const int colp = pn * 256 + wc * 32 + fq * 8;
        bf16_t* qb = (bf16_t*)(ws + AB_QB); bf16_t* kb = (bf16_t*)(ws + AB_KB); bf16_t* vT = (bf16_t*)(ws + AB_VT); bf16_t* rqb = (bf16_t*)(ws + AB_RQB); bf16_t* rkb = (bf16_t*)(ws + AB_RKB);
        bf16_t* rkdT = (bf16_t*)(ws + AB_RKDT); bf16_t* rvT = (bf16_t*)(ws + AB_RVT); bf16_t* rgb = (bf16_t*)(ws + AB_RGB);
        const float frqA0 = exp2f(-(float)(fq * 8) * (13.287712379549449f / 32.f)) * 0.15915494309189535f;
        const float frqR0 = exp2f(-(float)((wc & 1) * 32 + fq * 8) * (13.287712379549449f / 63.f)) * 0.15915494309189535f;
        constexpr float RA[8] = {1.f, 0.7498942093324559f, 0.5623413251903491f, 0.4216965034285822f, 0.31622776601683794f, 0.23713737056616552f, 0.1778279410038923f, 0.1333521432163324f};
        constexpr float RR[8] = {1.f, 0.8639884494839686f, 0.746476040841712f, 0.6449466771037624f, 0.5572264795507174f, 0.4814372420784346f, 0.4159562163071847f, 0.35938136638046275f};
#pragma unroll
        for (int ai = 0; ai < 2; ++ai)
#pragma unroll
            for (int m = 0; m < 4; ++m) {
                const int t = u.pm * 256 + ai * 128 + wr * 64 + m * 16 + fr, sq = t & (SEQ - 1), b = t >> 13;
                f32x4 x[2][2];
#pragma unroll
                for (int bj = 0; bj < 2; ++bj)
#pragma unroll
                    for (int n = 0; n < 2; ++n) x[bj][n] = acc[ai][bj][m][n];
                if (pn < 4 || (pn == 4 && wc < 2)) {
                    const int j0 = fq * 8; const float sc = pn < 4 ? 0.125f : 1.f;
                    u32x4 w1, w2;
#pragma unroll
                    for (int n = 0; n < 2; ++n) { f32x4 o1, o2;
#pragma unroll
                        for (int e = 0; e < 4; ++e) { const float rev = __builtin_amdgcn_fractf((float)sq * (frqA0 * RA[4 * n + e])); const float cc = __builtin_amdgcn_cosf(rev) * sc, ss = __builtin_amdgcn_sinf(rev) * sc;
                            o1[e] = x[0][n][e] * cc - x[1][n][e] * ss; o2[e] = x[1][n][e] * cc + x[0][n][e] * ss; }
                        w1[2 * n] = pk2(o1[0], o1[1]); w1[2 * n + 1] = pk2(o1[2], o1[3]); w2[2 * n] = pk2(o2[0], o2[1]); w2[2 * n + 1] = pk2(o2[2], o2[3]); }
                    bf16_t* dst = pn < 4 ? qb + (size_t)t * 1024 + (pn * 4 + wc) * 64 + j0 : kb + (size_t)t * 128 + wc * 64 + j0;
                    *(u32x4*)dst = w1; *(u32x4*)(dst + 32) = w2;
                } else if (pn == 4) {
                    const int d0 = (wc - 2) * 32 + fq * 8;
#pragma unroll
                    for (int bj = 0; bj < 2; ++bj)
#pragma unroll
                        for (int n = 0; n < 2; ++n)
#pragma unroll
                            for (int e = 0; e < 4; ++e) st_bf16_off((unsigned char*)vT, (unsigned)((((b * 2 + bj) * 64 + d0 + 4 * n + e) * SEQ + sq) * 2), x[bj][n][e]);
                } else if (pn < 9) {
                    const bool isk = pn >= 7; const int h = ((pn - 5) & 1) * 2 + (wc >> 1), j0 = (wc & 1) * 32 + fq * 8;
                    const float sc = isk ? 0.08838834764831845f : 1.f;
                    const unsigned dToff = (unsigned)((((b * 4 + h) * 128 + j0) * SEQ + sq) * 2);
                    u32x4 w1, w2;
#pragma unroll
                    for (int n = 0; n < 2; ++n) { f32x4 o1, o2;
#pragma unroll
                        for (int e = 0; e < 4; ++e) { const float rev = __builtin_amdgcn_fractf((float)sq * (frqR0 * RR[4 * n + e])); const float cc = __builtin_amdgcn_cosf(rev) * sc, ss = __builtin_amdgcn_sinf(rev) * sc;
                            o1[e] = x[0][n][e] * cc - x[1][n][e] * ss; o2[e] = x[1][n][e] * cc + x[0][n][e] * ss; }
                        w1[2 * n] = pk2(o1[0], o1[1]); w1[2 * n + 1] = pk2(o1[2], o1[3]); w2[2 * n] = pk2(o2[0], o2[1]); w2[2 * n + 1] = pk2(o2[2], o2[3]);
                        if (isk) {
#pragma unroll
                            for (int e = 0; e < 4; ++e) { st_bf16_off((unsigned char*)rkdT, dToff + (unsigned)((4 * n + e) * SEQ * 2), o1[e]); st_bf16_off((unsigned char*)rkdT, dToff + (unsigned)((64 + 4 * n + e) * SEQ * 2), o2[e]); } } }
                    bf16_t* dst = (isk ? rkb : rqb) + (size_t)t * 512 + h * 128 + j0;
                    *(u32x4*)dst = w1; *(u32x4*)(dst + 64) = w2;
                } else if (pn < 13) {
                    const int h = pn - 9;
#pragma unroll
                    for (int bj = 0; bj < 2; ++bj)
#pragma unroll
                        for (int n = 0; n < 2; ++n)
#pragma unroll
                            for (int e = 0; e < 4; ++e) st_bf16_off((unsigned char*)rvT, (unsigned)((((b * 4 + h) * 256 + bj * 128 + wc * 32 + fq * 8 + 4 * n + e) * SEQ + sq) * 2), x[bj][n][e]);
                } else {
#pragma unroll
                    for (int bj = 0; bj < 2; ++bj) { u32x4 w;
#pragma unroll
                        for (int n = 0; n < 2; ++n) { const f32x4 sv = silu4(x[bj][n]); w[2 * n] = pk2(sv[0], sv[1]); w[2 * n + 1] = pk2(sv[2], sv[3]); }
                        *(u32x4*)(rgb + (size_t)t * 1024 + (pn - 13) * 256 + bj * 128 + wc * 32 + fq * 8) = w; }
                }
            }
    }
};
__device__ __forceinline__ void phase_ab_inproj(const Ctx& c, int j) {
    g8::DenseOrder S; S.init(c.ws + WS_XB, c.ws + WS_WABIN + (size_t)j * AB_IN * D * 2, T, AB_IN, D, c.G, c.bid); S.tid0 = c.tid;
    LAS bf16_t* biasL = (LAS bf16_t*)(c.lds + LDS_TAB);
    { const float* bp = (const float*)(c.ws + WS_BIASP) + (size_t)j * AB_IN; for (int i = c.tid; i < AB_IN; i += NTHREADS) biasL[i] = f2bf(bp[i]); }
    __syncthreads();
    EpiABIn E{biasL, c.ws};
    g8::gemm_phase<EpiABIn, g8::DenseOrder>(c.lds + LDS_STAGE, D, S, E);
}

#define MFMA16(a, b, c) __builtin_amdgcn_mfma_f32_16x16x32_bf16((a), (b), (c), 0, 0, 0)
__device__ __forceinline__ bf16x8 pack8(const f32x4& lo, const f32x4& hi) { u32x4 w; w[0] = g8::cvt_pk_bf16(lo[0], lo[1]); w[1] = g8::cvt_pk_bf16(lo[2], lo[3]); w[2] = g8::cvt_pk_bf16(hi[0], hi[1]); w[3] = g8::cvt_pk_bf16(hi[2], hi[3]); return __builtin_bit_cast(bf16x8, w); }
__device__ __forceinline__ bf16x8 cat8(const u32x2& lo, const u32x2& hi) { u32x4 w; w[0] = lo[0]; w[1] = lo[1]; w[2] = hi[0]; w[3] = hi[1]; return __builtin_bit_cast(bf16x8, w); }
template <int ROWS, int RB, int PAD = 32>
__device__ __forceinline__ void tile_g2l(LAS unsigned char* dst, const unsigned char* src, size_t gs, int tid, int zrows = 0) {
    constexpr int CPR = RB / 16, TOTAL = ROWS * CPR;
#pragma unroll 8
    for (int i = tid; i < TOTAL; i += NTHREADS) { const int r = i / CPR, cc = i % CPR; u32x4 v = (u32x4){0u, 0u, 0u, 0u}; if (r >= zrows) v = *(const u32x4*)(src + (size_t)r * gs + cc * 16);
        *(LAS u32x4*)(dst + r * (RB + PAD) + cc * 16) = v; }
}

__device__ __forceinline__ void attn_unit(const Ctx& c, int unit, const float* sinks) {
    const int b = unit >> 7, n = (unit >> 1) & 63, kvh = unit & 1, hd = kvh * 8 + c.wid, lane = c.lane, fr = lane & 15, fq = lane >> 4;
    const bf16_t* qb = (const bf16_t*)(c.ws + AB_QB); const bf16_t* kb = (const bf16_t*)(c.ws + AB_KB); const bf16_t* vT = (const bf16_t*)(c.ws + AB_VT); bf16_t* ycat = (bf16_t*)(c.ws + WS_YCAT);
    LAS unsigned char* Ks = c.lds; LAS unsigned char* Vs = c.lds + 256 * 160;
    const int t0 = b * SEQ + n * 128;
    __syncthreads();
    const float sink = sinks[hd];
    bf16x8 qn[2];
#pragma unroll
    for (int ks = 0; ks < 2; ++ks) qn[ks] = *(const bf16x8*)(qb + (size_t)(t0 + fr) * 1024 + hd * 64 + ks * 32 + fq * 8);
    {
        const unsigned char* src = (const unsigned char*)(kb + (size_t)(t0 - 128) * 128 + kvh * 64);
        const unsigned char* vsrc = (const unsigned char*)(vT + (size_t)(b * 2 + kvh) * 64 * SEQ + (n * 128 - 128));
        u32x4 kv4[4], vv4[4];
#pragma unroll
        for (int q = 0; q < 4; ++q) { const int i = c.tid + q * NTHREADS; { const int r = i >> 3, cc = i & 7; kv4[q] = (u32x4){0u, 0u, 0u, 0u}; if (n > 0 || r >= 128) kv4[q] = *(const u32x4*)(src + (ptrdiff_t)r * 256 + cc * 16); }
            { const int r = i >> 5, cc = i & 31; vv4[q] = (u32x4){0u, 0u, 0u, 0u}; if (n > 0 || cc >= 16) vv4[q] = *(const u32x4*)(vsrc + (ptrdiff_t)r * SEQ * 2 + cc * 16); } }
#pragma unroll
        for (int q = 0; q < 4; ++q) { const int i = c.tid + q * NTHREADS; *(LAS u32x4*)(Ks + (i >> 3) * 160 + (i & 7) * 16) = kv4[q]; *(LAS u32x4*)(Vs + (i >> 5) * 528 + (i & 31) * 16) = vv4[q]; }
    }
    __syncthreads();
    for (int si = 0; si < 8; ++si) {
        const int t = t0 + si * 16 + fr;
        bf16x8 qf[2]; qf[0] = qn[0]; qf[1] = qn[1];
        if (si < 7) {
#pragma unroll
            for (int ks = 0; ks < 2; ++ks) qn[ks] = *(const bf16x8*)(qb + (size_t)(t + 16) * 1024 + hd * 64 + ks * 32 + fq * 8); }
        f32x4 S[10];
#pragma unroll
        for (int nk = 0; nk < 9; nk += 3) { bf16x8 kfr[3][2];
#pragma unroll
            for (int u = 0; u < 3; ++u)
#pragma unroll
                for (int ks = 0; ks < 2; ++ks) kfr[u][ks] = *(const LAS bf16x8*)(Ks + (16 * (si + nk + u) + fr) * 160 + ks * 64 + fq * 16);
            __builtin_amdgcn_sched_barrier(0);
#pragma unroll
            for (int u = 0; u < 3; ++u) { S[nk + u] = (f32x4){0.f, 0.f, 0.f, 0.f};
#pragma unroll
                for (int ks = 0; ks < 2; ++ks) S[nk + u] = MFMA16(kfr[u][ks], qf[ks], S[nk + u]); } }
        S[9] = (f32x4){0.f, 0.f, 0.f, 0.f};
        const int i = si * 16 + fr;
        float mx = sink;
#pragma unroll
        for (int nk = 0; nk < 9; ++nk)
#pragma unroll
            for (int r = 0; r < 4; ++r) { const int p = 16 * (si + nk) + 4 * fq + r; const bool ok = (p >= i + 1) && (p <= i + 128) && (n > 0 || p >= 128);
                S[nk][r] = ok ? S[nk][r] : -1e30f; mx = fmaxf(mx, S[nk][r]); }
        mx = fmaxf(mx, __shfl_xor(mx, 16)); mx = fmaxf(mx, __shfl_xor(mx, 32));
        float sum = 0.f;
#pragma unroll
        for (int nk = 0; nk < 9; ++nk)
#pragma unroll
            for (int r = 0; r < 4; ++r) { const float pv = S[nk][r] > -1e29f ? __builtin_amdgcn_exp2f((S[nk][r] - mx) * 1.4426950408889634f) : 0.f; S[nk][r] = pv; sum += pv; }
        sum += __shfl_xor(sum, 16); sum += __shfl_xor(sum, 32);
        const float inv = 1.f / (sum + exp2f((sink - mx) * 1.4426950408889634f));
        f32x4 O[4];
#pragma unroll
        for (int nd = 0; nd < 4; ++nd) O[nd] = (f32x4){0.f, 0.f, 0.f, 0.f};
#pragma unroll
        for (int kk = 0; kk < 5; ++kk) { const bf16x8 pf = pack8(S[2 * kk], S[2 * kk + 1]);
            const int p0 = 16 * (si + 2 * kk) + 4 * fq, p1 = (kk == 4 && si == 7) ? p0 : p0 + 16;
            u32x2 lo[4], hi[4];
#pragma unroll
            for (int nd = 0; nd < 4; ++nd) { lo[nd] = *(const LAS u32x2*)(Vs + (16 * nd + fr) * 528 + p0 * 2); hi[nd] = *(const LAS u32x2*)(Vs + (16 * nd + fr) * 528 + p1 * 2); }
            __builtin_amdgcn_sched_barrier(0);
#pragma unroll
            for (int nd = 0; nd < 4; ++nd) O[nd] = MFMA16(cat8(lo[nd], hi[nd]), pf, O[nd]); }
#pragma unroll
        for (int nd = 0; nd < 4; ++nd) { u32x2 w; w[0] = pk2(O[nd][0] * inv, O[nd][1] * inv); w[1] = pk2(O[nd][2] * inv, O[nd][3] * inv);
            *(u32x2*)(ycat + (size_t)t * AB_OUT + hd * 64 + 16 * nd + 4 * fq) = w; }
    }
}

__device__ __forceinline__ void ret_kv_unit(const Ctx& c, int unit) {
    const int b = unit >> 8, n = (unit >> 2) & 63, h = unit & 3, lane = c.lane, fr = lane & 15, fq = lane >> 4, w = c.wid;
    const bf16_t* rkdT = (const bf16_t*)(c.ws + AB_RKDT); const bf16_t* rvT = (const bf16_t*)(c.ws + AB_RVT); float* kv = (float*)(c.ws + AB_KV);
    LAS unsigned char* Kd = c.lds;
    __syncthreads();
    {
        const float lg = log2f(1.f - exp2f(-5.f - (float)h)); const int cc = c.tid & 15;
        float dec[8];
#pragma unroll
        for (int e = 0; e < 8; ++e) dec[e] = __builtin_amdgcn_exp2f((float)(127 - (cc * 8 + e)) * lg);
        const unsigned char* src = (const unsigned char*)(rkdT + (size_t)(b * 4 + h) * 128 * SEQ + n * 128);
#pragma unroll
        for (int q = 0; q < 4; ++q) { const int r = (c.tid >> 4) + 32 * q; const u32x4 v = *(const u32x4*)(src + (size_t)r * SEQ * 2 + cc * 16); u32x4 o;
#pragma unroll
            for (int e2 = 0; e2 < 4; ++e2) o[e2] = pk2(__uint_as_float(v[e2] << 16) * dec[2 * e2], __uint_as_float(v[e2] & 0xffff0000u) * dec[2 * e2 + 1]);
            *(LAS u32x4*)(Kd + r * 288 + cc * 16) = o; }
    }
    bf16x8 vf[2][4];
#pragma unroll
    for (int ne = 0; ne < 2; ++ne)
#pragma unroll
        for (int ks = 0; ks < 4; ++ks) vf[ne][ks] = *(const bf16x8*)(rvT + ((size_t)(b * 4 + h) * 256 + 32 * w + 16 * ne + fr) * SEQ + n * 128 + ks * 32 + fq * 8);
    __syncthreads();
    float* out = kv + ((size_t)((b * 64 + n) * 4 + h)) * 256 * 128;
#pragma unroll
    for (int nd = 0; nd < 8; ++nd) { f32x4 a0 = (f32x4){0.f, 0.f, 0.f, 0.f}, a1 = a0;
        bf16x8 kf[4];
#pragma unroll
        for (int ks = 0; ks < 4; ++ks) kf[ks] = *(const LAS bf16x8*)(Kd + (16 * nd + fr) * 288 + ks * 64 + fq * 16);
        __builtin_amdgcn_sched_barrier(0);
#pragma unroll
        for (int ks = 0; ks < 4; ++ks) { a0 = MFMA16(kf[ks], vf[0][ks], a0); a1 = MFMA16(kf[ks], vf[1][ks], a1); }
        *(f32x4*)(out + (size_t)(32 * w + fr) * 128 + 16 * nd + 4 * fq) = a0; *(f32x4*)(out + (size_t)(32 * w + 16 + fr) * 128 + 16 * nd + 4 * fq) = a1; }
}
__device__ __forceinline__ void ret_scan(const Ctx& c, int first_block, int nblocks) {
    const float* kv = (const float*)(c.ws + AB_KV); bf16_t* sp = (bf16_t*)(c.ws + AB_SPREV);
    const int nthr = nblocks * NTHREADS;
    typedef float f32x2s __attribute__((ext_vector_type(2)));
    for (int idx = (c.bid - first_block) * NTHREADS + c.tid; idx < 2 * 4 * 256 * 128 / 2; idx += nthr) {
        const int b = idx >> 16, rem = idx & 65535, h = rem >> 14;
        const float g = exp2f(128.f * log2f(1.f - exp2f(-5.f - (float)h)));
        const size_t base = (size_t)b * 64 * 131072 + (size_t)rem * 2;
        f32x2s v[64];
#pragma unroll
        for (int q = 0; q < 64; ++q) v[q] = *(const f32x2s*)(kv + base + (size_t)q * 131072);
        f32x2s st = (f32x2s){0.f, 0.f};
#pragma unroll
        for (int q = 0; q < 64; ++q) { *(unsigned*)(sp + base + (size_t)q * 131072) = pk2(st[0], st[1]); st = st * g + v[q]; }
    }
}
__device__ __forceinline__ void ret_out_unit(const Ctx& c, int unit) {
    const int b = unit >> 8, n = (unit >> 2) & 63, h = unit & 3, lane = c.lane, fr = lane & 15, fq = lane >> 4, w = c.wid;
    const bf16_t* rqb = (const bf16_t*)(c.ws + AB_RQB); const bf16_t* rkb = (const bf16_t*)(c.ws + AB_RKB); const bf16_t* rvT = (const bf16_t*)(c.ws + AB_RVT);
    const bf16_t* sp = (const bf16_t*)(c.ws + AB_SPREV); const bf16_t* rgb = (const bf16_t*)(c.ws + AB_RGB); bf16_t* ycat = (bf16_t*)(c.ws + WS_YCAT);
    LAS unsigned char* Kl = c.lds; LAS unsigned char* Bl = c.lds + 128 * 288;
    const int t0 = b * SEQ + n * 128; const float lg = log2f(1.f - exp2f(-5.f - (float)h));
    __syncthreads();
    tile_g2l<128, 256>(Kl, (const unsigned char*)(rkb + (size_t)t0 * 512 + h * 128), (size_t)512 * 2, c.tid);
    tile_g2l<256, 256>(Bl, (const unsigned char*)(sp + ((size_t)((b * 64 + n) * 4 + h)) * 256 * 128), (size_t)128 * 2, c.tid);
    const int t = t0 + 16 * w + fr, i = 16 * w + fr;
    bf16x8 qf[4];
#pragma unroll
    for (int ks = 0; ks < 4; ++ks) qf[ks] = *(const bf16x8*)(rqb + (size_t)t * 512 + h * 128 + ks * 32 + fq * 8);
    __syncthreads();
    bf16x8 pf[4];
#pragma unroll
    for (int kk = 0; kk < 4; ++kk) { f32x4 s2[2];
#pragma unroll
        for (int q = 0; q < 2; ++q) { const int nj = 2 * kk + q; s2[q] = (f32x4){0.f, 0.f, 0.f, 0.f};
            if (nj <= w) {
                bf16x8 kf[4];
#pragma unroll
                for (int ks = 0; ks < 4; ++ks) kf[ks] = *(const LAS bf16x8*)(Kl + (16 * nj + fr) * 288 + ks * 64 + fq * 16);
                __builtin_amdgcn_sched_barrier(0);
#pragma unroll
                for (int ks = 0; ks < 4; ++ks) s2[q] = MFMA16(kf[ks], qf[ks], s2[q]);
#pragma unroll
                for (int r = 0; r < 4; ++r) { const int jj = 16 * nj + 4 * fq + r; s2[q][r] = (i >= jj) ? s2[q][r] * __builtin_amdgcn_exp2f((float)(i - jj) * lg) : 0.f; } } }
        pf[kk] = pack8(s2[0], s2[1]); }
    f32x4 acc[16];
#pragma unroll
    for (int ne = 0; ne < 16; ne += 2) { bf16x8 sf[2][4];
#pragma unroll
        for (int u = 0; u < 2; ++u)
#pragma unroll
            for (int ks = 0; ks < 4; ++ks) sf[u][ks] = *(const LAS bf16x8*)(Bl + (16 * (ne + u) + fr) * 288 + ks * 64 + fq * 16);
        __builtin_amdgcn_sched_barrier(0);
#pragma unroll
        for (int u = 0; u < 2; ++u) { acc[ne + u] = (f32x4){0.f, 0.f, 0.f, 0.f};
#pragma unroll
            for (int ks = 0; ks < 4; ++ks) acc[ne + u] = MFMA16(sf[u][ks], qf[ks], acc[ne + u]); } }
    const float rs = exp2f((float)(i + 1) * lg);
#pragma unroll
    for (int ne = 0; ne < 16; ++ne) acc[ne] = acc[ne] * rs;
    __syncthreads();
    tile_g2l<256, 256, 16>(Bl, (const unsigned char*)(rvT + (size_t)(b * 4 + h) * 256 * SEQ + n * 128), (size_t)SEQ * 2, c.tid);
    __syncthreads();
    const int nkk = (w >> 1) + 1;
#pragma unroll
    for (int kk = 0; kk < 4; ++kk) if (kk < nkk) {
#pragma unroll
        for (int ne = 0; ne < 16; ne += 8) { u32x2 lo[8], hi[8];
#pragma unroll
            for (int u = 0; u < 8; ++u) { lo[u] = *(const LAS u32x2*)(Bl + (16 * (ne + u) + fr) * 272 + (32 * kk + 4 * fq) * 2); hi[u] = *(const LAS u32x2*)(Bl + (16 * (ne + u) + fr) * 272 + (32 * kk + 16 + 4 * fq) * 2); }
            __builtin_amdgcn_sched_barrier(0);
#pragma unroll
            for (int u = 0; u < 8; ++u) acc[ne + u] = MFMA16(cat8(lo[u], hi[u]), pf[kk], acc[ne + u]); } }
    u32x2 gpre[16];
#pragma unroll
    for (int ne = 0; ne < 16; ++ne) gpre[ne] = *(const u32x2*)(rgb + (size_t)t * 1024 + h * 256 + 16 * ne + 4 * fq);
    float sm = 0.f;
#pragma unroll
    for (int ne = 0; ne < 16; ++ne) sm += acc[ne][0] + acc[ne][1] + acc[ne][2] + acc[ne][3];
    sm += __shfl_xor(sm, 16); sm += __shfl_xor(sm, 32);
    const float mean = sm * (1.f / 256.f); float sq = 0.f;
#pragma unroll
    for (int ne = 0; ne < 16; ++ne) { acc[ne] = acc[ne] - mean; sq += acc[ne][0] * acc[ne][0] + acc[ne][1] * acc[ne][1] + acc[ne][2] * acc[ne][2] + acc[ne][3] * acc[ne][3]; }
    sq += __shfl_xor(sq, 16); sq += __shfl_xor(sq, 32);
    const float rstd = rsqrtf(sq * (1.f / 256.f) + LN_EPS);
#pragma unroll
    for (int ne = 0; ne < 16; ++ne) { const u32x2 gw = gpre[ne];
        const float g0 = __uint_as_float(gw[0] << 16), g1 = __uint_as_float(gw[0] & 0xffff0000u), g2 = __uint_as_float(gw[1] << 16), g3 = __uint_as_float(gw[1] & 0xffff0000u);
        u32x2 o; o[0] = pk2(acc[ne][0] * rstd * g0, acc[ne][1] * rstd * g1); o[1] = pk2(acc[ne][2] * rstd * g2, acc[ne][3] * rstd * g3);
        *(u32x2*)(ycat + (size_t)t * AB_OUT + 1024 + h * 256 + 16 * ne + 4 * fq) = o; }
}

__device__ __forceinline__ void phase_ab_p1(const Ctx& c) {
    for (int u = c.bid; u < 512; u += c.G) ret_kv_unit(c, u);
}
__device__ __forceinline__ void phase_ab_p2(const Ctx& c, int j) {
    ret_scan(c, 0, c.G);
    { const float* sinks = c.inp(3) + j * 16; for (int u = c.bid; u < 256; u += c.G) attn_unit(c, u, sinks); }
}
__device__ __forceinline__ void phase_ab_p3(const Ctx& c) {
    for (int u = c.bid; u < 512; u += c.G) ret_out_unit(c, u);
}

__device__ __forceinline__ float gelu_fast(float x) { const float u = 1.5957691216057308f * (x + 0.044715f * x * x * x); return x * __builtin_amdgcn_rcpf(1.f + __expf(-u)); }
struct EpiCDIn {
    static constexpr bool PERM = true;
    LAS bf16_t* biasL; unsigned char* ws;
    __device__ __forceinline__ void init(f32x4 (&acc)[2][2][4][2], const g8::Unit& u, int wc, int fq) const {
        const int colp = u.pn * 256 + wc * 32 + fq * 8;
#pragma unroll
        for (int b = 0; b < 2; ++b)
#pragma unroll
            for (int n = 0; n < 2; ++n) { const u32x2 bw = *(const LAS u32x2*)(biasL + colp + b * 128 + 4 * n);
                const f32x4 bv = (f32x4){__uint_as_float(bw[0] << 16), __uint_as_float(bw[0] & 0xffff0000u), __uint_as_float(bw[1] << 16), __uint_as_float(bw[1] & 0xffff0000u)};
#pragma unroll
                for (int a = 0; a < 2; ++a)
#pragma unroll
                    for (int m = 0; m < 4; ++m) acc[a][b][m][n] = bv; } }
    __device__ __forceinline__ void operator()(const f32x4 (&acc)[2][2][4][2], const g8::Unit& u, int wr, int wc, int fr, int fq) const {
        const int pn = u.pn; const int col0 = pn * 256 + wc * 32 + fq * 8;
        bf16_t* gu = (bf16_t*)(ws + CD_GU); bf16_t* gvT = (bf16_t*)(ws + CD_GVT); bf16_t* gg = (bf16_t*)(ws + CD_GG); bf16_t* xr = (bf16_t*)(ws + CD_XR); float* stats = (float*)(ws + CD_STATS);
#pragma unroll
        for (int ai = 0; ai < 2; ++ai)
#pragma unroll
            for (int m = 0; m < 4; ++m) {
                const int t = u.pm * 256 + ai * 128 + wr * 64 + m * 16 + fr, sq = t & (SEQ - 1), b = t >> 13;
                f32x4 x[2][2];
#pragma unroll
                for (int bj = 0; bj < 2; ++bj)
#pragma unroll
                    for (int n = 0; n < 2; ++n) { x[bj][n] = acc[ai][bj][m][n];
                        if (pn < 13) {
                            x[bj][n] = gelu4(x[bj][n]); } }
                if (pn >= 4 && pn < 8) {
                    float s1 = 0.f, s2 = 0.f;
#pragma unroll
                    for (int bj = 0; bj < 2; ++bj)
#pragma unroll
                        for (int n = 0; n < 2; ++n)
#pragma unroll
                            for (int e = 0; e < 4; ++e) { const float v = x[bj][n][e]; s1 += v; s2 += v * v;
                                st_bf16_off((unsigned char*)gvT, (unsigned)(((b * 1024 + (pn - 4) * 256 + bj * 128 + wc * 32 + fq * 8 + 4 * n + e) * SEQ + sq) * 2), v); }
                    s1 += __shfl_xor(s1, 16); s1 += __shfl_xor(s1, 32); s2 += __shfl_xor(s2, 16); s2 += __shfl_xor(s2, 32);
                    if (fq == 0) *(f32x2*)(stats + (size_t)t * 32 + ((pn - 4) * 4 + wc) * 2) = (f32x2){s1, s2};
                } else {
                    bf16_t* dst; int ld, cb;
                    if (pn < 4) { dst = gu; ld = 1024; cb = pn * 256; } else if (pn < 13) { dst = gg; ld = 1280; cb = (pn - 8) * 256; } else { dst = xr; ld = 1280; cb = (pn - 13) * 256; }
#pragma unroll
                    for (int bj = 0; bj < 2; ++bj) { u32x4 w;
#pragma unroll
                        for (int n = 0; n < 2; ++n) { w[2 * n] = pk2(x[bj][n][0], x[bj][n][1]); w[2 * n + 1] = pk2(x[bj][n][2], x[bj][n][3]); }
                        *(u32x4*)(dst + (size_t)t * ld + cb + bj * 128 + wc * 32 + fq * 8) = w; }
                }
            }
    }
};
__device__ __forceinline__ void phase_cd_inproj(const Ctx& c, int j) {
    g8::DenseOrder S; S.init(c.ws + WS_XB, c.ws + WS_WCDIN + (size_t)j * CD_IN * D * 2, T, CD_IN, D, c.G, c.bid); S.tid0 = c.tid;
    LAS bf16_t* biasL = (LAS bf16_t*)(c.lds + LDS_TAB);
    { const float* bp = c.inp(7) + (size_t)j * CD_IN; for (int i = c.tid; i < CD_IN; i += NTHREADS) biasL[i] = f2bf(bp[i]); }
    __syncthreads();
    EpiCDIn E{biasL, c.ws};
    g8::gemm_phase<EpiCDIn, g8::DenseOrder>(c.lds + LDS_STAGE, D, S, E);
}

__device__ __forceinline__ void lru_unit(const Ctx& c, int unit, int j) {
    const int hh = unit % 5, bn = unit / 5, lane = c.lane, fr = lane & 15, fq = lane >> 4, w = c.wid;
    const int t0 = bn * 128, s0 = t0 & (SEQ - 1);
    const bf16_t* xr = (const bf16_t*)(c.ws + CD_XR); bf16_t* HL = (bf16_t*)(c.ws + WS_U2); bf16_t* PC = HL + (size_t)T * 1280; float* sum = (float*)(c.ws + WS_H);
    const float* conv_w = c.inp(10) + (size_t)j * 4 * 1280 + hh * 256; const float* conv_b = c.inp(11) + (size_t)j * 1280 + hh * 256;
    const float* ba = c.inp(13) + (size_t)j * 1280 + hh * 256; const float* bx = c.inp(15) + (size_t)j * 1280 + hh * 256; const float* spl = (const float*)(c.ws + WS_SPL) + (size_t)j * 1280 + hh * 256;
    const bf16_t* Wl = (const bf16_t*)(c.ws + WS_WLRU) + (size_t)((j * 5 + hh) * 2) * 65536;
    LAS unsigned char* Xc = c.lds; LAS unsigned char* Wa = c.lds + 128 * 544; LAS unsigned char* Wx = Wa + 64 * 544; LAS unsigned char* Tot = Wx + 64 * 544; LAS float* Bl = (LAS float*)(Tot + 4096);
    __syncthreads();
    if (c.tid < 192) { const int which = c.tid >> 6, i4 = (c.tid & 63) * 4; const float* srcp = which == 0 ? ba : (which == 1 ? bx : spl); *(LAS f32x4*)(Bl + which * 256 + i4) = *(const f32x4*)(srcp + i4); }
    {
        const int cg = c.tid & 31, r0 = (c.tid >> 5) * 8;
        float wv[4][8], bv8[8];
        { const f32x4 b0 = *(const f32x4*)(conv_b + cg * 8), b1 = *(const f32x4*)(conv_b + cg * 8 + 4); bv8[0] = b0[0]; bv8[1] = b0[1]; bv8[2] = b0[2]; bv8[3] = b0[3]; bv8[4] = b1[0]; bv8[5] = b1[1]; bv8[6] = b1[2]; bv8[7] = b1[3]; }
#pragma unroll
        for (int k = 0; k < 4; ++k) { const f32x4 w0 = *(const f32x4*)(conv_w + k * 1280 + cg * 8), w1 = *(const f32x4*)(conv_w + k * 1280 + cg * 8 + 4);
            wv[k][0] = w0[0]; wv[k][1] = w0[1]; wv[k][2] = w0[2]; wv[k][3] = w0[3]; wv[k][4] = w1[0]; wv[k][5] = w1[1]; wv[k][6] = w1[2]; wv[k][7] = w1[3]; }
        u32x4 xin[11];
#pragma unroll
        for (int q = 0; q < 11; ++q) { xin[q] = (u32x4){0u, 0u, 0u, 0u}; if (s0 + r0 - 3 + q >= 0) xin[q] = *(const u32x4*)(xr + (size_t)(t0 + r0 - 3 + q) * 1280 + hh * 256 + cg * 8); }
#pragma unroll
        for (int rr = 0; rr < 8; ++rr) { float a[8];
#pragma unroll
            for (int e = 0; e < 8; ++e) a[e] = bv8[e];
#pragma unroll
            for (int k = 0; k < 4; ++k) { const u32x4 xv = xin[rr + k];
#pragma unroll
                for (int e2 = 0; e2 < 4; ++e2) { a[2 * e2] += wv[k][2 * e2] * __uint_as_float(xv[e2] << 16); a[2 * e2 + 1] += wv[k][2 * e2 + 1] * __uint_as_float(xv[e2] & 0xffff0000u); } }
            u32x4 o; o[0] = pk2(a[0], a[1]); o[1] = pk2(a[2], a[3]); o[2] = pk2(a[4], a[5]); o[3] = pk2(a[6], a[7]);
            *(LAS u32x4*)(Xc + (r0 + rr) * 544 + cg * 16) = o; }
    }
    u32x4 wreg[8];
#pragma unroll
    for (int q = 0; q < 4; ++q) { const int i = c.tid + q * NTHREADS, r = i >> 5, cc = i & 31; wreg[q] = *(const u32x4*)((const unsigned char*)Wl + (size_t)r * 512 + cc * 16); wreg[4 + q] = *(const u32x4*)((const unsigned char*)(Wl + 65536) + (size_t)r * 512 + cc * 16); }
    __syncthreads();
    bf16x8 xf[8];
#pragma unroll
    for (int ks = 0; ks < 8; ++ks) xf[ks] = *(const LAS bf16x8*)(Xc + (16 * w + fr) * 544 + ks * 64 + fq * 16);
    const int t = t0 + 16 * w + fr;
    for (int sl = 0; sl < 4; ++sl) {
        if (sl) __syncthreads();
#pragma unroll
        for (int q = 0; q < 4; ++q) { const int i = c.tid + q * NTHREADS, r = i >> 5, cc = i & 31; *(LAS u32x4*)(Wa + r * 544 + cc * 16) = wreg[q]; *(LAS u32x4*)(Wx + r * 544 + cc * 16) = wreg[4 + q]; }
        if (sl < 3) {
#pragma unroll
            for (int q = 0; q < 4; ++q) { const int i = c.tid + q * NTHREADS, r = i >> 5, cc = i & 31;
                wreg[q] = *(const u32x4*)((const unsigned char*)(Wl + (size_t)((sl + 1) * 64) * 256) + (size_t)r * 512 + cc * 16); wreg[4 + q] = *(const u32x4*)((const unsigned char*)(Wl + 65536 + (size_t)((sl + 1) * 64) * 256) + (size_t)r * 512 + cc * 16); } }
        __syncthreads();
        f32x4 sA[4], sB[4];
#pragma unroll
        for (int nc = 0; nc < 4; ++nc) { f32x4 ra = (f32x4){0.f, 0.f, 0.f, 0.f}, ri = ra;
            bf16x8 waf[8], wxf[8];
#pragma unroll
            for (int ks = 0; ks < 8; ++ks) { waf[ks] = *(const LAS bf16x8*)(Wa + (16 * nc + fr) * 544 + ks * 64 + fq * 16); wxf[ks] = *(const LAS bf16x8*)(Wx + (16 * nc + fr) * 544 + ks * 64 + fq * 16); }
            __builtin_amdgcn_sched_barrier(0);
#pragma unroll
            for (int ks = 0; ks < 8; ++ks) { ra = MFMA16(waf[ks], xf[ks], ra); ri = MFMA16(wxf[ks], xf[ks], ri); }
            const int ch = sl * 64 + 16 * nc + 4 * fq;
            const f32x4 b_a = *(const LAS f32x4*)(Bl + ch), b_x = *(const LAS f32x4*)(Bl + 256 + ch), sp = *(const LAS f32x4*)(Bl + 512 + ch);
            const u32x2 xw = *(const LAS u32x2*)(Xc + (16 * w + fr) * 544 + ch * 2);
            const float xcv[4] = {__uint_as_float(xw[0] << 16), __uint_as_float(xw[0] & 0xffff0000u), __uint_as_float(xw[1] << 16), __uint_as_float(xw[1] & 0xffff0000u)};
            f32x4 oa, ob;
#pragma unroll
            for (int r = 0; r < 4; ++r) { const float gr = __builtin_amdgcn_rcpf(1.f + __expf(-(ra[r] + b_a[r]))), gi = __builtin_amdgcn_rcpf(1.f + __expf(-(ri[r] + b_x[r]))); const float la = -8.f * gr * sp[r]; const float a = __expf(la);
                oa[r] = a; ob[r] = __builtin_amdgcn_sqrtf(fmaxf(1.f - a * a, 0.f)) * (gi * xcv[r]); }
            sA[nc] = oa; sB[nc] = ob;
        }
#pragma unroll
        for (int dlt = 1; dlt < 16; dlt <<= 1) { f32x4 pa[4], pb[4];
#pragma unroll
            for (int nc = 0; nc < 4; ++nc)
#pragma unroll
                for (int r = 0; r < 4; ++r) { pa[nc][r] = __shfl_up(sA[nc][r], dlt, 16); pb[nc][r] = __shfl_up(sB[nc][r], dlt, 16); }
            if (fr >= dlt) {
#pragma unroll
                for (int nc = 0; nc < 4; ++nc) { sB[nc] = sA[nc] * pb[nc] + sB[nc]; sA[nc] = sA[nc] * pa[nc]; } } }
        if (fr == 15) {
#pragma unroll
            for (int nc = 0; nc < 4; ++nc) { *(LAS f32x4*)(Tot + ((w * 64 + 16 * nc + 4 * fq) * 2) * 4) = sA[nc]; *(LAS f32x4*)(Tot + ((w * 64 + 16 * nc + 4 * fq) * 2 + 4) * 4) = sB[nc]; } }
        __syncthreads();
#pragma unroll
        for (int nc = 0; nc < 4; ++nc) { const int ch = sl * 64 + 16 * nc + 4 * fq;
            f32x4 cp = (f32x4){1.f, 1.f, 1.f, 1.f}, chh = (f32x4){0.f, 0.f, 0.f, 0.f};
            for (int w2 = 0; w2 < w; ++w2) { const f32x4 ta = *(const LAS f32x4*)(Tot + ((w2 * 64 + 16 * nc + 4 * fq) * 2) * 4), tb = *(const LAS f32x4*)(Tot + ((w2 * 64 + 16 * nc + 4 * fq) * 2 + 4) * 4);
                chh = ta * chh + tb; cp = cp * ta; }
            const f32x4 hl = sB[nc] + sA[nc] * chh, pc = sA[nc] * cp;
            u32x2 o1, o2; o1[0] = pk2(hl[0], hl[1]); o1[1] = pk2(hl[2], hl[3]); o2[0] = pk2(pc[0], pc[1]); o2[1] = pk2(pc[2], pc[3]);
            *(u32x2*)(HL + (size_t)t * 1280 + hh * 256 + ch) = o1; *(u32x2*)(PC + (size_t)t * 1280 + hh * 256 + ch) = o2;
            if (w == 7 && fr == 15) { float* sm = sum + ((size_t)bn * 1280 + hh * 256 + ch) * 2;
#pragma unroll
                for (int r = 0; r < 4; ++r) { sm[2 * r] = pc[r]; sm[2 * r + 1] = hl[r]; } } }
    }
}

__device__ __forceinline__ void sgu_unit(const Ctx& c, int unit, int j) {
    const int g = unit & 3, bn = unit >> 2, b = bn >> 6, n = bn & 63, lane = c.lane, fr = lane & 15, fq = lane >> 4, w = c.wid;
    const int t0 = bn * 128;
    const bf16_t* gu = (const bf16_t*)(c.ws + CD_GU); const bf16_t* gvT = (const bf16_t*)(c.ws + CD_GVT); const float* stats = (const float*)(c.ws + CD_STATS); bf16_t* ycat = (bf16_t*)(c.ws + WS_YCAT);
    const float* sw = c.inp(8) + (size_t)(j * 4 + g) * 16384; const float* sb = c.inp(9) + (size_t)(j * 4 + g) * 128;
    LAS unsigned char* Vt = c.lds; LAS float* mr = (LAS float*)(c.lds + 256 * 288);
    __syncthreads();
    tile_g2l<256, 256>(Vt, (const unsigned char*)(gvT + ((size_t)b * 1024 + g * 256) * SEQ + n * 128), (size_t)SEQ * 2, c.tid);
    if (c.tid < 128) { const f32x4* st = (const f32x4*)(stats + (size_t)(t0 + c.tid) * 32); float s1 = 0.f, s2 = 0.f; f32x4 sv[8];
#pragma unroll
        for (int q = 0; q < 8; ++q) sv[q] = st[q];
#pragma unroll
        for (int q = 0; q < 8; ++q) { s1 += sv[q][0] + sv[q][2]; s2 += sv[q][1] + sv[q][3]; }
        const float mean = s1 * (1.f / 1024.f), var = fmaxf(s2 * (1.f / 1024.f) - mean * mean, 0.f); mr[2 * c.tid] = mean; mr[2 * c.tid + 1] = rsqrtf(var + LN_EPS); }
    __syncthreads();
    const int i = 16 * w + fr, t = t0 + i, nks = (w >> 1) + 1;
    bf16x8 wf[4]; float ci = 0.f;
#pragma unroll
    for (int ks = 0; ks < 4; ++ks) { f32x4 lo = (f32x4){0.f, 0.f, 0.f, 0.f}, hi = lo;
        if (ks < nks) { const int j0 = ks * 32 + fq * 8; const f32x4 w0 = *(const f32x4*)(sw + (size_t)i * 128 + j0), w1 = *(const f32x4*)(sw + (size_t)i * 128 + j0 + 4);
#pragma unroll
            for (int e = 0; e < 4; ++e) { const float m0 = mr[2 * (j0 + e)], r0 = mr[2 * (j0 + e) + 1], m1 = mr[2 * (j0 + 4 + e)], r1 = mr[2 * (j0 + 4 + e) + 1];
                lo[e] = (j0 + e <= i) ? w0[e] * r0 : 0.f; hi[e] = (j0 + 4 + e <= i) ? w1[e] * r1 : 0.f; ci += lo[e] * m0 + hi[e] * m1; } }
        wf[ks] = pack8(lo, hi); }
    ci += __shfl_xor(ci, 16); ci += __shfl_xor(ci, 32);
    const float add = sb[i] - ci;
    f32x4 acc[16];
#pragma unroll
    for (int nd = 0; nd < 16; nd += 2) { bf16x8 vf[2][4];
#pragma unroll
        for (int u = 0; u < 2; ++u)
#pragma unroll
            for (int ks = 0; ks < 4; ++ks) if (ks < nks) vf[u][ks] = *(const LAS bf16x8*)(Vt + (16 * (nd + u) + fr) * 288 + ks * 64 + fq * 16);
        __builtin_amdgcn_sched_barrier(0);
#pragma unroll
        for (int u = 0; u < 2; ++u) { acc[nd + u] = (f32x4){0.f, 0.f, 0.f, 0.f};
#pragma unroll
            for (int ks = 0; ks < 4; ++ks) if (ks < nks) acc[nd + u] = MFMA16(vf[u][ks], wf[ks], acc[nd + u]); } }
    u32x2 upre[16];
#pragma unroll
    for (int nd = 0; nd < 16; ++nd) upre[nd] = *(const u32x2*)(gu + (size_t)t * 1024 + g * 256 + 16 * nd + 4 * fq);
#pragma unroll
    for (int nd = 0; nd < 16; ++nd) { const u32x2 uw = upre[nd];
        const float u0 = __uint_as_float(uw[0] << 16), u1 = __uint_as_float(uw[0] & 0xffff0000u), u2 = __uint_as_float(uw[1] << 16), u3 = __uint_as_float(uw[1] & 0xffff0000u);
        u32x2 o; o[0] = pk2(u0 * (acc[nd][0] + add), u1 * (acc[nd][1] + add)); o[1] = pk2(u2 * (acc[nd][2] + add), u3 * (acc[nd][3] + add));
        *(u32x2*)(ycat + (size_t)t * CD_OUT + g * 256 + 16 * nd + 4 * fq) = o; }
}
__device__ __forceinline__ void phase_cd_p1(const Ctx& c, int j) {
    for (int u = c.bid; u < 640; u += c.G) lru_unit(c, u, j);
    if (c.G == 256) {
        if (c.bid < 128) sgu_unit(c, c.bid, j);
        else { for (int q = 0; q < 3; ++q) sgu_unit(c, 128 + (c.bid - 128) * 3 + q, j); }
    } else { for (int u = c.bid; u < 512; u += c.G) sgu_unit(c, u, j); }
}

__device__ __forceinline__ void phase_cd_scan2(const Ctx& c) {
    const bf16_t* gg = (const bf16_t*)(c.ws + CD_GG); bf16_t* ycat = (bf16_t*)(c.ws + WS_YCAT);
    const bf16_t* HL = (const bf16_t*)(c.ws + WS_U2); const bf16_t* PC = HL + (size_t)T * 1280; const float* sum = (const float*)(c.ws + WS_H);
    LAS float* carry = (LAS float*)c.lds;
    for (int u = c.bid; u < 256; u += c.G) {
        const int bn = u >> 1, half = u & 1, b = bn >> 6, n = bn & 63;
        __syncthreads();
        {
            LAS float* part = carry + 1280;
            for (int it = c.tid; it < 4 * 1280; it += NTHREADS) { const int seg = it / 1280, ch = it % 1280; const float* sp = sum + ((size_t)(b * 64 + seg * 16) * 1280 + ch) * 2;
                f32x2 v[16];
#pragma unroll
                for (int q = 0; q < 16; ++q) { v[q] = (f32x2){1.f, 0.f}; if (seg * 16 + q < n) v[q] = *(const f32x2*)(sp + (size_t)q * 2560); }
                float A = 1.f, Bv = 0.f;
#pragma unroll
                for (int q = 0; q < 16; ++q) { Bv = v[q][0] * Bv + v[q][1]; A *= v[q][0]; }
                part[(seg * 1280 + ch) * 2] = A; part[(seg * 1280 + ch) * 2 + 1] = Bv; }
            __syncthreads();
            for (int ch = c.tid; ch < 1280; ch += NTHREADS) { float cr = 0.f;
#pragma unroll
                for (int seg = 0; seg < 4; ++seg) cr = part[(seg * 1280 + ch) * 2] * cr + part[(seg * 1280 + ch) * 2 + 1];
                carry[ch] = cr; }
        }
        __syncthreads();
        const size_t t0 = (size_t)bn * 128 + half * 64;
        for (int it0 = c.tid; it0 < 64 * 320; it0 += 20 * NTHREADS) {
            u32x2 hw[20], pw[20], gw[20];
#pragma unroll
            for (int q = 0; q < 20; ++q) { const int it = it0 + q * NTHREADS; const int r = it / 320, c4 = (it % 320) * 4; const size_t o = (t0 + r) * 1280 + c4; hw[q] = *(const u32x2*)(HL + o); pw[q] = *(const u32x2*)(PC + o); gw[q] = *(const u32x2*)(gg + o); }
#pragma unroll
            for (int q = 0; q < 20; ++q) { const int it = it0 + q * NTHREADS; const int r = it / 320, c4 = (it % 320) * 4; const f32x4 cr = *(const LAS f32x4*)(carry + c4);
                const float h0 = __uint_as_float(hw[q][0] << 16) + __uint_as_float(pw[q][0] << 16) * cr[0], h1 = __uint_as_float(hw[q][0] & 0xffff0000u) + __uint_as_float(pw[q][0] & 0xffff0000u) * cr[1];
                const float h2 = __uint_as_float(hw[q][1] << 16) + __uint_as_float(pw[q][1] << 16) * cr[2], h3 = __uint_as_float(hw[q][1] & 0xffff0000u) + __uint_as_float(pw[q][1] & 0xffff0000u) * cr[3];
                u32x2 ow; ow[0] = pk2(__uint_as_float(gw[q][0] << 16) * h0, __uint_as_float(gw[q][0] & 0xffff0000u) * h1); ow[1] = pk2(__uint_as_float(gw[q][1] << 16) * h2, __uint_as_float(gw[q][1] & 0xffff0000u) * h3);
                *(u32x2*)(ycat + (t0 + r) * CD_OUT + 1024 + c4) = ow; } }
    }
}

__device__ __forceinline__ void phase_ln_moe(const Ctx& c, const float* g, const float* bta, float* xout) {
    typedef float f32x2v __attribute__((ext_vector_type(2)));
    bf16_t* xb = (bf16_t*)(c.ws + WS_XB); const unsigned char* Y = (const unsigned char*)(c.ws + WS_U1);
    f32x4 gpre[2][2], bpre[2][2];
#pragma unroll
    for (int q = 0; q < 2; ++q)
#pragma unroll
        for (int h2 = 0; h2 < 2; ++h2) { gpre[q][h2] = *(const f32x4*)(g + q * 512 + c.lane * 8 + 4 * h2); bpre[q][h2] = *(const f32x4*)(bta + q * 512 + c.lane * 8 + 4 * h2); }
    for (long tt = (long)c.gw * 2; tt < T; tt += (long)c.nwaves * 2) {
        float v[2][2][8];
#pragma unroll
        for (int u = 0; u < 2; ++u) { const long t = tt + u;
#pragma unroll
            for (int q = 0; q < 2; ++q) { const int col = q * 512 + c.lane * 8;
                float f[8];
#pragma unroll
                for (int e = 0; e < 8; ++e) f[e] = 0.f;
#pragma unroll
                for (int k = 0; k < 8; ++k) { const size_t srow = (size_t)t * 8 + k; const u32x2 w = *(const u32x2*)(Y + srow * D + col);
#pragma unroll
                    for (int h2 = 0; h2 < 2; ++h2) { const f32x2v a = __builtin_amdgcn_cvt_pk_f32_fp8(w[h2], false), b = __builtin_amdgcn_cvt_pk_f32_fp8(w[h2], true);
                        f[4 * h2] += a[0]; f[4 * h2 + 1] += a[1]; f[4 * h2 + 2] += b[0]; f[4 * h2 + 3] += b[1]; } }
                const u32x4 xw = *(const u32x4*)(xb + (size_t)t * D + col), sw = *(const u32x4*)((const bf16_t*)(Y + (size_t)TK * D) + (size_t)t * D + col);
#pragma unroll
                for (int e2 = 0; e2 < 4; ++e2) { v[u][q][2 * e2] = __uint_as_float(xw[e2] << 16) * ALPHA + f[2 * e2] * (1.f / 64.f) + __uint_as_float(sw[e2] << 16);
                    v[u][q][2 * e2 + 1] = __uint_as_float(xw[e2] & 0xffff0000u) * ALPHA + f[2 * e2 + 1] * (1.f / 64.f) + __uint_as_float(sw[e2] & 0xffff0000u); } } }
#pragma unroll
        for (int u = 0; u < 2; ++u) { const long t = tt + u;
            float sm = 0.f;
#pragma unroll
            for (int q = 0; q < 2; ++q)
#pragma unroll
                for (int e = 0; e < 8; ++e) sm += v[u][q][e];
            const float mean = wave_sum(sm) * (1.f / 1024.f); float sq = 0.f;
#pragma unroll
            for (int q = 0; q < 2; ++q)
#pragma unroll
                for (int e = 0; e < 8; ++e) { v[u][q][e] -= mean; sq += v[u][q][e] * v[u][q][e]; }
            const float rstd = rsqrtf(wave_sum(sq) * (1.f / 1024.f) + LN_EPS);
#pragma unroll
            for (int q = 0; q < 2; ++q) { const int col = q * 512 + c.lane * 8; float o[8];
#pragma unroll
                for (int h2 = 0; h2 < 2; ++h2) { const f32x4 gg = gpre[q][h2], bb = bpre[q][h2];
#pragma unroll
                    for (int e = 0; e < 4; ++e) o[4 * h2 + e] = v[u][q][4 * h2 + e] * rstd * gg[e] + bb[e];
                    if (xout) *(f32x4*)(xout + (size_t)t * D + col + 4 * h2) = (f32x4){o[4 * h2], o[4 * h2 + 1], o[4 * h2 + 2], o[4 * h2 + 3]}; }
                u32x4 w; w[0] = pk2(o[0], o[1]); w[1] = pk2(o[2], o[3]); w[2] = pk2(o[4], o[5]); w[3] = pk2(o[6], o[7]); *(u32x4*)(xb + (size_t)t * D + col) = w; } }
    }
}

__device__ __forceinline__ unsigned sortable_u32(float f) { const unsigned b = __float_as_uint(f); return b ^ ((b >> 31) ? 0xffffffffu : 0x80000000u); }
__device__ __forceinline__ int popc64(unsigned long long m) { return __builtin_popcountll(m); }
__device__ __forceinline__ int rank_lt(unsigned long long m) { return (int)__builtin_amdgcn_mbcnt_hi((unsigned)(m >> 32), __builtin_amdgcn_mbcnt_lo((unsigned)m, 0u)); }
__device__ __forceinline__ void phase_ln_route(const Ctx& c, int L) {
    bf16_t* xb = (bf16_t*)(c.ws + WS_XB); const bf16_t* hbuf = (const bf16_t*)(c.ws + WS_HB);
    const float* g = c.inp(19) + (size_t)L * D; const float* bta = c.inp(20) + (size_t)L * D; const float* rb = c.inp(22) + L * NE;
    const bf16_t* Wr = (const bf16_t*)(c.ws + WS_WRT) + (size_t)L * 256 * D;
    int* cnt = (int*)(c.ws + CTL_CNT) + L * NE * 32; int* list = (int*)(c.ws + WS_LIST); float* gate = (float*)(c.ws + WS_GATE);
    LAS unsigned char* Xl = c.lds; LAS unsigned char* Wq = c.lds + 64 * 544;
    LAS float* Sc = (LAS float*)Wq;
    LAS int* hist = (LAS int*)(Wq + 32768); LAS int* gbase = hist + 128; LAS int* sel = gbase + 128; LAS float* selg = (LAS float*)(sel + 512);
    const int lane = c.lane, fr = lane & 15, fq = lane >> 4, w = c.wid;
    f32x4 gpre[4], bpre[4];
#pragma unroll
    for (int q = 0; q < 4; ++q) { gpre[q] = *(const f32x4*)(g + q * 256 + lane * 4); bpre[q] = *(const f32x4*)(bta + q * 256 + lane * 4); }
    for (int grp = c.bid; grp < T / 64; grp += c.G) {
        __syncthreads();
        u32x2 nb[8][4];
#pragma unroll
        for (int hb = 0; hb < 2; ++hb) {
            u32x2 xw[4][4], hw[4][4];
#pragma unroll
            for (int i = 0; i < 4; ++i) { const size_t t = (size_t)grp * 64 + hb * 32 + w * 4 + i;
#pragma unroll
                for (int q = 0; q < 4; ++q) { const int col = q * 256 + lane * 4; xw[i][q] = *(const u32x2*)(xb + t * D + col); hw[i][q] = *(const u32x2*)(hbuf + t * D + col); } }
#pragma unroll
            for (int i = 0; i < 4; ++i) { const size_t t = (size_t)grp * 64 + hb * 32 + w * 4 + i;
                f32x4 v[4]; float sm = 0.f;
#pragma unroll
                for (int q = 0; q < 4; ++q) { v[q] = (f32x4){__uint_as_float(xw[i][q][0] << 16), __uint_as_float(xw[i][q][0] & 0xffff0000u), __uint_as_float(xw[i][q][1] << 16), __uint_as_float(xw[i][q][1] & 0xffff0000u)} * ALPHA
                         + (f32x4){__uint_as_float(hw[i][q][0] << 16), __uint_as_float(hw[i][q][0] & 0xffff0000u), __uint_as_float(hw[i][q][1] << 16), __uint_as_float(hw[i][q][1] & 0xffff0000u)};
                    sm += v[q][0] + v[q][1] + v[q][2] + v[q][3]; }
                const float mean = wave_sum(sm) * (1.f / 1024.f); float sq = 0.f;
#pragma unroll
                for (int q = 0; q < 4; ++q) { v[q] = v[q] - mean; sq += v[q][0] * v[q][0] + v[q][1] * v[q][1] + v[q][2] * v[q][2] + v[q][3] * v[q][3]; }
                const float rstd = rsqrtf(wave_sum(sq) * (1.f / 1024.f) + LN_EPS);
#pragma unroll
                for (int q = 0; q < 4; ++q) { const f32x4 o = v[q] * rstd * gpre[q] + bpre[q]; nb[hb * 4 + i][q][0] = pk2(o[0], o[1]); nb[hb * 4 + i][q][1] = pk2(o[2], o[3]);
                    *(u32x2*)(xb + t * D + q * 256 + lane * 4) = nb[hb * 4 + i][q]; } }
        }
        f32x4 lg[2][2];
        const int st = w & 1, eg = w >> 1;
        lg[0][0] = (f32x4){0.f, 0.f, 0.f, 0.f}; lg[0][1] = lg[0][0]; lg[1][0] = lg[0][0]; lg[1][1] = lg[0][0];
        u32x4 wreg[8];
#pragma unroll
        for (int q = 0; q < 8; ++q) { const int i = c.tid + q * NTHREADS, r = i >> 5, cc = i & 31; wreg[q] = *(const u32x4*)((const unsigned char*)Wr + (size_t)r * 2048 + cc * 16); }
#pragma unroll
        for (int kq = 0; kq < 4; ++kq) {
            if (kq) __syncthreads();
#pragma unroll
            for (int q = 0; q < 8; ++q) { const int i = c.tid + q * NTHREADS, r = i >> 5, cc = i & 31; *(LAS u32x4*)(Wq + r * 544 + cc * 16) = wreg[q]; }
#pragma unroll
            for (int u = 0; u < 8; ++u) *(LAS u32x2*)(Xl + ((u >> 2) * 32 + w * 4 + (u & 3)) * 544 + lane * 8) = nb[u][kq];
            if (kq < 3) {
#pragma unroll
                for (int q = 0; q < 8; ++q) { const int i = c.tid + q * NTHREADS, r = i >> 5, cc = i & 31; wreg[q] = *(const u32x4*)((const unsigned char*)Wr + (size_t)r * 2048 + (kq + 1) * 512 + cc * 16); } }
            __syncthreads();
#pragma unroll
            for (int k4 = 0; k4 < 8; k4 += 2) { bf16x8 bop[2][2], aop[2][2];
#pragma unroll
                for (int u = 0; u < 2; ++u) { const int ks = k4 + u;
#pragma unroll
                    for (int p2 = 0; p2 < 2; ++p2) bop[p2][u] = *(const LAS bf16x8*)(Xl + (p2 * 32 + 16 * st + fr) * 544 + ks * 64 + fq * 16);
#pragma unroll
                    for (int ne2 = 0; ne2 < 2; ++ne2) aop[u][ne2] = *(const LAS bf16x8*)(Wq + (32 * eg + 16 * ne2 + fr) * 544 + ks * 64 + fq * 16); }
                __builtin_amdgcn_sched_barrier(0);
#pragma unroll
                for (int u = 0; u < 2; ++u)
#pragma unroll
                    for (int p2 = 0; p2 < 2; ++p2)
#pragma unroll
                        for (int ne2 = 0; ne2 < 2; ++ne2) lg[p2][ne2] = MFMA16(aop[u][ne2], bop[p2][u], lg[p2][ne2]); }
        }
        __syncthreads();
#pragma unroll
        for (int p2 = 0; p2 < 2; ++p2)
#pragma unroll
            for (int ne2 = 0; ne2 < 2; ++ne2) { f32x4 sg;
#pragma unroll
                for (int r = 0; r < 4; ++r) sg[r] = sigmoidf_(lg[p2][ne2][r]);
                *(LAS f32x4*)(Sc + (p2 * 32 + 16 * st + fr) * 128 + 32 * eg + 16 * ne2 + 4 * fq) = sg; }
        if (c.tid < 128) hist[c.tid] = 0;
        __syncthreads();
        {
            const float rb0 = rb[lane], rb1 = rb[64 + lane];
#pragma unroll 2
            for (int q = 0; q < 8; ++q) { const int rr = w * 8 + q;
                const float s0 = Sc[rr * 128 + lane], s1 = Sc[rr * 128 + 64 + lane];
                const unsigned u0 = sortable_u32(s0 + rb0), u1 = sortable_u32(s1 + rb1);
                unsigned thr = 0u;
                for (int bit = 31; bit >= 0; --bit) { const unsigned cand = thr | (1u << bit); const int n = popc64(__ballot(u0 >= cand)) + popc64(__ballot(u1 >= cand)); if (n >= 8) { thr = cand; if (n == 8) break; } }
                const bool gt0 = u0 > thr, gt1 = u1 > thr, eq0 = u0 == thr, eq1 = u1 == thr;
                const unsigned long long me0 = __ballot(eq0), me1 = __ballot(eq1);
                const int need = 8 - popc64(__ballot(gt0)) - popc64(__ballot(gt1));
                const bool sel0 = gt0 || (eq0 && rank_lt(me0) < need), sel1 = gt1 || (eq1 && popc64(me0) + rank_lt(me1) < need);
                const unsigned long long m0 = __ballot(sel0), m1 = __ballot(sel1);
                const float tot = wave_sum((sel0 ? s0 : 0.f) + (sel1 ? s1 : 0.f));
                if (sel0) { const int k = rank_lt(m0); const int lr = __hip_atomic_fetch_add(&hist[lane], 1, __ATOMIC_RELAXED, __HIP_MEMORY_SCOPE_WORKGROUP); sel[rr * 8 + k] = (lane << 16) | lr; selg[rr * 8 + k] = s0 / tot * 2.5f; }
                if (sel1) { const int k = popc64(m0) + rank_lt(m1); const int lr = __hip_atomic_fetch_add(&hist[64 + lane], 1, __ATOMIC_RELAXED, __HIP_MEMORY_SCOPE_WORKGROUP); sel[rr * 8 + k] = ((64 + lane) << 16) | lr; selg[rr * 8 + k] = s1 / tot * 2.5f; } }
        }
        __syncthreads();
        if (c.tid < 128) gbase[c.tid] = atomicAdd(&cnt[c.tid * 32], hist[c.tid]);
        __syncthreads();
        { const int sv = sel[c.tid], e = sv >> 16, lr = sv & 0xffff; const int slot = (grp * 64 + (c.tid >> 3)) * 8 + (c.tid & 7);
          list[(size_t)e * LISTCAP + gbase[e] + lr] = slot; gate[slot] = selg[c.tid]; }
    }
}

struct MoeOrder {
    const char* Abase; const char* Bbase; size_t Bstride; int K, NT, NTG, total, G, c, mode, tid0;
    LAS int* tab; LAS int* desc;
    __device__ __forceinline__ bool next(int i, g8::Unit& u) const {
        const int ip = i / NTG, q = i - ip * NTG;
        const long L = (long)ip * G + c; if (L >= total || ip >= TAB_SLOTS) return false;
        const int d = desc[ip]; const int e = d >> 12, pn = (d & 15) * NTG + q;
        u.pm = (d >> 4) & 255; u.pn = pn; u.aux = ip; u.A = Abase; u.B = Bbase + (size_t)e * Bstride + (size_t)pn * 256 * K * 2; return true;
    }
    __device__ __forceinline__ void aoff(const g8::Unit& u, int tid, unsigned (&o)[2][2]) const {
#pragma unroll
        for (int i = 0; i < 2; ++i) { int R, C; g8::stage_rc(tid * 16 + i * 8192, R, C);
#pragma unroll
            for (int h = 0; h < 2; ++h) { int s = tab[u.aux * 256 + h * 128 + R]; s = s < 0 ? 0 : s; const int row = mode ? s : (s < TK ? (s >> 3) : s - TK);
                o[h][i] = (unsigned)(row * K + C) * 2u; } }
    }
};
__device__ __forceinline__ void moe_setup(const Ctx& c, MoeOrder& S, const int* cnt, int NT, int NTG) {
    LAS int* pref = (LAS int*)(c.lds + LDS_PREF); LAS int* desc = (LAS int*)(c.lds + LDS_DESC); LAS int* tab = (LAS int*)(c.lds + LDS_TAB);
    const int* list = (const int*)(c.ws + WS_LIST);
    if (c.tid < 64) { int nb[3]; int loc = 0;
#pragma unroll
        for (int q = 0; q < 3; ++q) { const int e = c.tid * 3 + q; int n = 0; if (e < NE) n = cnt[e * 32]; else if (e == NE) n = T; nb[q] = (n + 255) >> 8; loc += nb[q]; }
        int inc = loc;
#pragma unroll
        for (int o = 1; o < 64; o <<= 1) { const int v = __shfl_up(inc, o); if (c.tid >= o) inc += v; }
        int acc = inc - loc;
#pragma unroll
        for (int q = 0; q < 3; ++q) { const int e = c.tid * 3 + q; if (e <= NE1) pref[e] = acc; acc += nb[q]; } }
    __syncthreads();
    const int NG = NT / NTG; const int total = pref[NE1] * NG;
    LAS float* gtab = (LAS float*)(c.lds + LDS_GTAB); const float* gate = (const float*)(c.ws + WS_GATE);
    S.NT = NT; S.NTG = NTG; S.total = total; S.G = c.G; S.c = c.bid; S.tab = tab; S.desc = desc;
    {
        int sv[TAB_SLOTS / 2];
#pragma unroll
        for (int k = 0; k < TAB_SLOTS / 2; ++k) { const int i = (c.tid >> 8) + 2 * k; sv[k] = -2;
            const long L = (long)i * c.G + c.bid;
            if (L < total) {
                int wgid = (int)L; { const int q = total / 8, r = total % 8, xcd = wgid % 8, off = wgid / 8; wgid = (xcd < r ? xcd * (q + 1) : r * (q + 1) + (xcd - r) * q) + off; }
                const int rbg = wgid / NG, pn = wgid % NG;
                int lo = 0, hi = NE1;
                while (hi - lo > 1) { const int mid = (lo + hi) >> 1; if (pref[mid] <= rbg) lo = mid; else hi = mid; }
                const int e = lo, rb = rbg - pref[e], n = e < NE ? cnt[e * 32] : T;
                if ((c.tid & 255) == 0) desc[i] = (e << 12) | (rb << 4) | pn;
                const int r = rb * 256 + (c.tid & 255); sv[k] = -1; if (r < n) sv[k] = (e < NE) ? list[(size_t)e * LISTCAP + r] : TK + r; } }
#pragma unroll
        for (int k = 0; k < TAB_SLOTS / 2; ++k) { const int i = (c.tid >> 8) + 2 * k; if (sv[k] != -2) { tab[i * 256 + (c.tid & 255)] = sv[k]; gtab[i * 256 + (c.tid & 255)] = sv[k] >= 0 ? gate[sv[k]] : 0.f; } }
    }
    __syncthreads();
}
struct EpiMoeGU {
    static constexpr bool PERM = true;
    bf16_t* H; LAS int* tab;
    __device__ __forceinline__ void init(f32x4 (&acc)[2][2][4][2], const g8::Unit&, int, int) const {
#pragma unroll
        for (int a = 0; a < 2; ++a)
#pragma unroll
            for (int b = 0; b < 2; ++b)
#pragma unroll
                for (int m = 0; m < 4; ++m)
#pragma unroll
                    for (int n = 0; n < 2; ++n) acc[a][b][m][n] = (f32x4){0.f, 0.f, 0.f, 0.f}; }
    __device__ __forceinline__ void operator()(const f32x4 (&acc)[2][2][4][2], const g8::Unit& u, int wr, int wc, int fr, int fq) const {
#pragma unroll
        for (int ai = 0; ai < 2; ++ai)
#pragma unroll
            for (int m = 0; m < 4; ++m) { const int r = ai * 128 + wr * 64 + m * 16 + fr; const int s = tab[u.aux * 256 + r];
                if (s >= 0) { u32x4 w;
#pragma unroll
                    for (int n = 0; n < 2; ++n) { const f32x4 g = acc[ai][0][m][n], up = acc[ai][1][m][n];
                        const f32x4 hv = silu4(g) * up; w[2 * n] = pk2(hv[0], hv[1]); w[2 * n + 1] = pk2(hv[2], hv[3]); }
                    *(u32x4*)(H + (size_t)s * ED + u.pn * 128 + wc * 32 + fq * 8) = w; } }
    }
};
struct EpiMoeDN {
    static constexpr bool PERM = true;
    unsigned char* Y; LAS float* gtab; LAS int* tab;
    __device__ __forceinline__ void init(f32x4 (&acc)[2][2][4][2], const g8::Unit&, int, int) const {
#pragma unroll
        for (int a = 0; a < 2; ++a)
#pragma unroll
            for (int b = 0; b < 2; ++b)
#pragma unroll
                for (int m = 0; m < 4; ++m)
#pragma unroll
                    for (int n = 0; n < 2; ++n) acc[a][b][m][n] = (f32x4){0.f, 0.f, 0.f, 0.f}; }
    __device__ __forceinline__ void operator()(const f32x4 (&acc)[2][2][4][2], const g8::Unit& u, int wr, int wc, int fr, int fq) const {
#pragma unroll
        for (int ai = 0; ai < 2; ++ai)
#pragma unroll
            for (int m = 0; m < 4; ++m) { const int r = ai * 128 + wr * 64 + m * 16 + fr; const int s = tab[u.aux * 256 + r];
                if (s >= TK) {
#pragma unroll
                    for (int bj = 0; bj < 2; ++bj) { u32x4 w;
#pragma unroll
                        for (int n = 0; n < 2; ++n) { const f32x4 a = acc[ai][bj][m][n]; w[2 * n] = pk2(a[0], a[1]); w[2 * n + 1] = pk2(a[2], a[3]); }
                        *(u32x4*)((bf16_t*)(Y + (size_t)TK * D) + (size_t)(s - TK) * D + u.pn * 256 + bj * 128 + wc * 32 + fq * 8) = w; }
                } else if (s >= 0) { const float gt = gtab[u.aux * 256 + r] * 64.f;
#pragma unroll
                    for (int bj = 0; bj < 2; ++bj) { u32x2 w;
#pragma unroll
                        for (int n = 0; n < 2; ++n) { f32x4 a = acc[ai][bj][m][n] * gt;
#pragma unroll
                            for (int e = 0; e < 4; ++e) a[e] = fminf(fmaxf(a[e], -448.f), 448.f);
                            unsigned pw = 0u; pw = __builtin_amdgcn_cvt_pk_fp8_f32(a[0], a[1], pw, false); pw = __builtin_amdgcn_cvt_pk_fp8_f32(a[2], a[3], pw, true); w[n] = pw; }
                        *(u32x2*)(Y + (size_t)s * D + u.pn * 256 + bj * 128 + wc * 32 + fq * 8) = w; } } }
    }
};
__device__ __forceinline__ void phase_moe_gu(const Ctx& c, int L) {
    MoeOrder S; S.Abase = (const char*)(c.ws + WS_XB); S.Bbase = (const char*)(c.ws + WS_WGU) + (size_t)L * NE1 * 512 * D * 2; S.Bstride = (size_t)512 * D * 2; S.K = D; S.mode = 0; S.tid0 = c.tid;
    moe_setup(c, S, (const int*)(c.ws + CTL_CNT) + L * NE * 32, 2, 1);
    EpiMoeGU E{(bf16_t*)(c.ws + WS_HID), S.tab};
    g8::gemm_phase<EpiMoeGU, MoeOrder>(c.lds + LDS_STAGE, D, S, E);
}
__device__ __forceinline__ void phase_moe_dn(const Ctx& c, int L) {
    MoeOrder S; S.Abase = (const char*)(c.ws + WS_HID); S.Bbase = (const char*)(c.ws + WS_WDN) + (size_t)L * NE1 * D * ED * 2; S.Bstride = (size_t)D * ED * 2; S.K = ED; S.mode = 1; S.tid0 = c.tid;
    { LAS int* pref = (LAS int*)(c.lds + LDS_PREF); S.NT = 4; S.NTG = 2; S.total = pref[NE1] * 2; S.G = c.G; S.c = c.bid; S.tab = (LAS int*)(c.lds + LDS_TAB); S.desc = (LAS int*)(c.lds + LDS_DESC); }
    EpiMoeDN E{(unsigned char*)(c.ws + WS_U1), (LAS float*)(c.lds + LDS_GTAB), S.tab};
    g8::gemm_phase<EpiMoeDN, MoeOrder>(c.lds + LDS_STAGE, ED, S, E);
}

constexpr int PH_PER_LAYER = 9;
constexpr int N_PHASES = 1 + 4 * PH_PER_LAYER;

__global__ void __launch_bounds__(NTHREADS, 2) fwd_kernel(Params p) {
    extern __shared__ __attribute__((aligned(16))) unsigned char lds_raw[];
    LAS unsigned char* const lds0 = (LAS unsigned char*)lds_raw;
    const int wave_id = __builtin_amdgcn_readfirstlane((int)threadIdx.x >> 6);
    volatile LAS unsigned* misc = (volatile LAS unsigned*)(lds0 + LDS_MISC);
    if (threadIdx.x < 4) misc[threadIdx.x] = 0u;
    __syncthreads();
    const int lo = p.ph_lo, hi = p.ph_hi;
    XcdBarrier bar; bar.bar = (unsigned*)(p.ws + WS_CTL); bar.x = 0; bar.st = misc;
    if (hi - lo > 1) bar = xcd_barrier_post((unsigned*)(p.ws + WS_CTL), misc);
#define MKCTX() Ctx c; { int wv_ = wave_id; asm volatile("" : "+s"(wv_)); int tid_ = wv_ * 64 + (int)__builtin_amdgcn_mbcnt_hi(~0u, __builtin_amdgcn_mbcnt_lo(~0u, 0u)); asm volatile("" : "+v"(tid_)); int bid_ = blockIdx.x; asm volatile("" : "+s"(bid_)); unsigned long long ws_ = (unsigned long long)p.ws; asm volatile("" : "+s"(ws_)); \
        c.in = p.in; c.out = (float*)p.out; c.ws = (unsigned char*)(GAS unsigned char*)ws_; c.lds = lds0; c.tid = tid_; c.lane = tid_ & 63; c.wid = __builtin_amdgcn_readfirstlane(tid_ >> 6); c.bid = bid_; c.G = gridDim.x; \
        c.gtid = c.bid * NTHREADS + c.tid; c.gthreads = c.G * NTHREADS; c.gw = c.bid * 8 + c.wid; c.nwaves = c.G * 8; } unsigned char* const ws = c.ws; (void)ws
    int id = 0;
#ifndef PMASK
#define PMASK 0xffffffffu
#endif
#ifndef DUPMASK
#define DUPMASK 0u
#endif
#define PHASE(k, body) do { if (((PMASK >> (k)) & 1u) && lo <= id && id < hi) { MKCTX(); body; if ((DUPMASK >> (k)) & 1u) { body; } if (id + 1 < hi) xcd_barrier(bar, c.tid == 0); } ++id; } while (0)
    PHASE(0, phase_convert(c));
#pragma unroll 1
    for (int L = 0; L < 4; ++L) {
        const int j = L >> 1; const bool cd = (L & 1);
        if (cd) {
            PHASE(1, phase_cd_inproj(c, j));
        } else {
            PHASE(2, phase_ab_inproj(c, j));
        }
        if (!cd) { PHASE(3, phase_ab_p1(c)); PHASE(4, phase_ab_p2(c, j)); PHASE(16, phase_ab_p3(c)); }
        else     { PHASE(5, phase_cd_p1(c, j)); PHASE(15, phase_cd_scan2(c)); id += 1; }
        {
            const size_t Woff = cd ? WS_WCDOUT + (size_t)j * D * CD_OUT * 2 : WS_WABOUT + (size_t)j * D * AB_OUT * 2;
            const int K = cd ? CD_OUT : AB_OUT; const float* bias = cd ? (const float*)p.in[18] + (size_t)j * D : (const float*)p.in[5] + (size_t)j * D;
            PHASE(8, phase_dense(c, (const bf16_t*)(ws + WS_YCAT), (const bf16_t*)(ws + Woff), T, D, K, (bf16_t*)(ws + WS_HB), D, bias));
        }
        PHASE(9, phase_ln_route(c, L));
        PHASE(12, phase_moe_gu(c, L));
        PHASE(13, phase_moe_dn(c, L));
        PHASE(14, phase_ln_moe(c, (const float*)p.in[29] + (size_t)L * D, (const float*)p.in[30] + (size_t)L * D, L == 3 ? (float*)p.out : (float*)nullptr));
    }
#undef PHASE
}

extern "C" void kernel_launch(void* const* d_in, const int* in_sizes, int n_in, void* d_out, int out_size, void* d_ws, size_t ws_size, hipStream_t stream) {
    static int grid = 0;
    if (grid == 0) {
        if (n_in != 31 || out_size != T * D || ws_size < WS_END) { fprintf(stderr, "kernel_launch: unexpected shapes (n_in %d out %d ws %zu need %zu)\n", n_in, out_size, ws_size, (size_t)WS_END); grid = -1; return; }
        int dev = 0, cus = 0, per_cu = 0;
        if (hipGetDevice(&dev) != hipSuccess || hipDeviceGetAttribute(&cus, hipDeviceAttributeMultiprocessorCount, dev) != hipSuccess) { grid = -1; return; }
        if (hipFuncSetAttribute((const void*)fwd_kernel, hipFuncAttributeMaxDynamicSharedMemorySize, LDS_BYTES) != hipSuccess) { fprintf(stderr, "kernel_launch: hipFuncSetAttribute failed\n"); grid = -1; return; }
        if (hipOccupancyMaxActiveBlocksPerMultiprocessor(&per_cu, (const void*)fwd_kernel, NTHREADS, LDS_BYTES) != hipSuccess || per_cu < 1) fprintf(stderr, "kernel_launch: occupancy query says %d\n", per_cu);
        (void)hipGetLastError();
        grid = cus;
    }
    if (grid < 0) return;
    (void)hipMemsetAsync((char*)d_ws + WS_CTL, 0, CTL_BYTES, stream);
    Params p{};
    for (int i = 0; i < 31; ++i) p.in[i] = (const GAS float*)d_in[i];
    p.out = (GAS float*)d_out; p.ws = (GAS unsigned char*)d_ws;
#if N_LAUNCH_MODE == 1
    p.ph_lo = 0; p.ph_hi = N_PHASES;
    hipLaunchKernelGGL(fwd_kernel, dim3(grid), dim3(NTHREADS), LDS_BYTES, stream, p);
#else
    for (int i = 0; i < N_PHASES; ++i) { p.ph_lo = i; p.ph_hi = i + 1; hipLaunchKernelGGL(fwd_kernel, dim3(grid), dim3(NTHREADS), LDS_BYTES, stream, p); }
#endif
}
```

```cpp
#include <hip/hip_runtime.h>
#include <cstdio>
#include <cstdint>

#define LAS __attribute__((address_space(3)))
typedef unsigned short bf16_t;
typedef short bf16x8 __attribute__((ext_vector_type(8)));
typedef float f32x4 __attribute__((ext_vector_type(4)));
typedef float f32x2 __attribute__((ext_vector_type(2)));
typedef unsigned u32x4 __attribute__((ext_vector_type(4)));
typedef unsigned u32x2 __attribute__((ext_vector_type(2)));

constexpr int T = 16384, D = 1024, SEQ = 8192;
constexpr int AB_IN = 4352, AB_OUT = 2048, CD_IN = 4608, CD_OUT = 2304;
constexpr int NE = 128, NE1 = 129, TOPK = 8, ED = 256;
constexpr int TK = T * TOPK;
constexpr int NSLOT = TK + T;
constexpr int LISTCAP = 16384;
constexpr float ALPHA = 1.681792830507429f;
constexpr float LN_EPS = 1e-5f;

#ifndef N_LAUNCH_MODE
#define N_LAUNCH_MODE 1
#endif

constexpr size_t al256(size_t x) { return (x + 255) & ~(size_t)255; }
constexpr size_t WS_CTL    = 0;
constexpr size_t CTL_BYTES = 131072;
constexpr size_t CTL_CNT   = 65536;
constexpr size_t WS_WABIN  = CTL_BYTES;
constexpr size_t WS_WABOUT = WS_WABIN  + al256((size_t)2 * AB_IN * D * 2);
constexpr size_t WS_WCDIN  = WS_WABOUT + al256((size_t)2 * D * AB_OUT * 2);
constexpr size_t WS_WCDOUT = WS_WCDIN  + al256((size_t)2 * CD_IN * D * 2);
constexpr size_t WS_WRT    = WS_WCDOUT + al256((size_t)2 * D * CD_OUT * 2);
constexpr size_t WS_WGU    = WS_WRT    + al256((size_t)4 * 256 * D * 2);
constexpr size_t WS_WDN    = WS_WGU    + al256((size_t)4 * NE1 * 512 * D * 2);
constexpr size_t WS_X      = WS_WDN    + al256((size_t)4 * NE1 * D * ED * 2);
constexpr size_t WS_HB     = WS_X;
constexpr size_t WS_XB     = WS_X      + al256((size_t)T * D * 4);
constexpr size_t WS_U1     = WS_XB     + al256((size_t)T * D * 2);
constexpr size_t U1_BYTES  = al256((size_t)NSLOT * D * 2) > al256((size_t)T * CD_IN * 4) ? al256((size_t)NSLOT * D * 2) : al256((size_t)T * CD_IN * 4);
constexpr size_t WS_U2     = WS_U1     + U1_BYTES;
constexpr size_t U2_BYTES  = al256((size_t)T * 1280 * 4 * 3);
constexpr size_t WS_YCAT   = WS_U2     + U2_BYTES;
constexpr size_t WS_H      = WS_YCAT   + al256((size_t)T * CD_OUT * 2);
constexpr size_t WS_ZR     = WS_H      + al256((size_t)T * D * 4);
constexpr size_t WS_HID    = WS_ZR     + al256((size_t)T * 256 * 4);
constexpr size_t WS_LIST   = WS_HID    + al256((size_t)NSLOT * ED * 2);
constexpr size_t WS_GATE   = WS_LIST   + al256((size_t)NE * LISTCAP * 4);
constexpr size_t WS_ROPEA  = WS_GATE   + al256((size_t)NSLOT * 4);
constexpr size_t WS_ROPER  = WS_ROPEA  + al256((size_t)SEQ * 32 * 8);
constexpr size_t WS_BIASP  = WS_ROPER  + al256((size_t)SEQ * 64 * 8);
constexpr size_t WS_WLRU   = WS_BIASP  + al256((size_t)2 * AB_IN * 4);
constexpr size_t WS_SPL    = WS_WLRU   + al256((size_t)2 * 5 * 2 * 65536 * 2);
constexpr size_t WS_END    = WS_SPL    + al256((size_t)2 * 1280 * 4);
constexpr size_t CD_GU = WS_U1, CD_GVT = WS_U1 + 32 * (1024 * 1024), CD_GG = WS_U1 + 64 * (1024 * 1024), CD_XR = WS_U1 + 104 * (1024 * 1024), CD_STATS = WS_U1 + 144 * (1024 * 1024);
constexpr size_t MB = 1024 * 1024;
constexpr size_t AB_QB = WS_U1, AB_KB = WS_U1 + 32 * MB, AB_VT = WS_U1 + 36 * MB, AB_RQB = WS_U1 + 40 * MB, AB_RKB = WS_U1 + 56 * MB, AB_RKDT = WS_U1 + 72 * MB,
                 AB_RVT = WS_U1 + 88 * MB, AB_RGB = WS_U1 + 120 * MB, AB_KV = WS_U1 + 152 * MB  , AB_SPREV = WS_U1 + 216 * MB  ;
static_assert(AB_SPREV + 32 * MB <= WS_U1 + U1_BYTES, "U1 map");

__device__ __forceinline__ float bf2f(bf16_t b) { return __uint_as_float(((unsigned)b) << 16); }
__device__ __forceinline__ unsigned pk2(float lo, float hi) { unsigned r; asm("v_cvt_pk_bf16_f32 %0, %1, %2" : "=v"(r) : "v"(lo), "v"(hi)); return r; }
__device__ __forceinline__ bf16_t f2bf(float f) { return (bf16_t)(pk2(f, f) & 0xffffu); }
__device__ __forceinline__ float xrow_sum(float v) {
    { const auto r = __builtin_amdgcn_permlane16_swap(__float_as_uint(v), __float_as_uint(v), false, false); v = __uint_as_float(r[0]) + __uint_as_float(r[1]); }
    { const auto r = __builtin_amdgcn_permlane32_swap(__float_as_uint(v), __float_as_uint(v), false, false); v = __uint_as_float(r[0]) + __uint_as_float(r[1]); }
    return v; }
__device__ __forceinline__ float xrow_max(float v) {
    { const auto r = __builtin_amdgcn_permlane16_swap(__float_as_uint(v), __float_as_uint(v), false, false); v = fmaxf(__uint_as_float(r[0]), __uint_as_float(r[1])); }
    { const auto r = __builtin_amdgcn_permlane32_swap(__float_as_uint(v), __float_as_uint(v), false, false); v = fmaxf(__uint_as_float(r[0]), __uint_as_float(r[1])); }
    return v; }
__device__ __forceinline__ u32x4 widen2(const u32x2& a, const u32x2& b) {
    unsigned a0 = a[0], a1 = a[1], b0 = b[0], b1 = b[1];
    asm volatile("s_nop 1" : "+v"(a0), "+v"(a1), "+v"(b0), "+v"(b1));
    const auto r0 = __builtin_amdgcn_permlane16_swap(a0, b0, false, false), r1 = __builtin_amdgcn_permlane16_swap(a1, b1, false, false);
    u32x4 w; w[0] = r0[0]; w[1] = r1[0]; w[2] = r0[1]; w[3] = r1[1]; return w; }
#define WS_DPP(v, CTRL) __int_as_float(__builtin_amdgcn_update_dpp(0, __float_as_int(v), (CTRL), 0xf, 0xf, false))
__device__ __forceinline__ float wave_sum(float v) {
    v += WS_DPP(v, 0xB1);
    v += WS_DPP(v, 0x4E);
    v += WS_DPP(v, 0x141);
    v += WS_DPP(v, 0x140);
    return xrow_sum(v); }
__device__ __forceinline__ float wave_max(float v) {
#pragma unroll
    for (int o = 32; o; o >>= 1) v = fmaxf(v, __shfl_xor(v, o));
    return v; }
__device__ __forceinline__ float gelu_tanh(float x) { const float u = 0.7978845608028654f * (x + 0.044715f * x * x * x); return 0.5f * x * (1.f + tanhf(u)); }
__device__ __forceinline__ float sigmoidf_(float x) { return __builtin_amdgcn_rcpf(1.f + __expf(-x)); }
__device__ __forceinline__ float siluf_(float x) { return x * __builtin_amdgcn_rcpf(1.f + __expf(-x)); }
__device__ __forceinline__ f32x4 silu4(const f32x4 x) { const f32x4 t = x * (-1.4426950408889634f); f32x4 d;
#pragma unroll
    for (int e = 0; e < 4; ++e) d[e] = __builtin_amdgcn_exp2f(t[e]);
    d = d + 1.f;
#pragma unroll
    for (int e = 0; e < 4; ++e) d[e] = __builtin_amdgcn_rcpf(d[e]);
    return x * d; }
__device__ __forceinline__ f32x4 gelu4(const f32x4 x) {
    const f32x4 t = x * ((x * x) * (-0.10294323886f) + (-2.30220819813f)); f32x4 d;
#pragma unroll
    for (int e = 0; e < 4; ++e) d[e] = __builtin_amdgcn_exp2f(t[e]);
    d = d + 1.f;
#pragma unroll
    for (int e = 0; e < 4; ++e) d[e] = __builtin_amdgcn_rcpf(d[e]);
    return x * d; }

#define XB_TMO      128
#define XB_XCNT(j)  (256  + 64 * (j))
#define XB_XSUB(j)  (1280 + 64 * (j))
#define XB_XGEN(j)  (2304 + 64 * (j))
#define XB_TOP      3328
#define XB_TOPGEN   3392
#define XCD_BAR_WORDS 3456
#define XB_SPIN_CAP (1u << 22)

__device__ __forceinline__ unsigned xb_ld(unsigned* p)              { return __hip_atomic_load(p, __ATOMIC_RELAXED, __HIP_MEMORY_SCOPE_AGENT); }
__device__ __forceinline__ unsigned xb_add(unsigned* p, unsigned v) { return __hip_atomic_fetch_add(p, v, __ATOMIC_RELAXED, __HIP_MEMORY_SCOPE_AGENT); }
__device__ __forceinline__ unsigned xb_xcc_id() { return (unsigned)__builtin_amdgcn_s_getreg((3 << 11) | 20) & 0xFu; }
#define XB_SPIN(cond, bar) do { unsigned _sp = 0; while (cond) { __builtin_amdgcn_s_sleep(1); \
    if ((++_sp & 255u) == 0u) { if (xb_ld(&(bar)[XB_TMO])) break; if (_sp > XB_SPIN_CAP) { atomicAdd(&(bar)[XB_TMO], 1u); break; } } } } while (0)

struct XcdBarrier { unsigned* bar; unsigned x; volatile LAS unsigned* st; };

__device__ __forceinline__ XcdBarrier xcd_barrier_post(unsigned* bar, volatile LAS unsigned* st) {
    XcdBarrier b; b.bar = bar; b.x = xb_xcc_id(); b.st = st;
    if (threadIdx.x == 0) (void)xb_add(&bar[XB_XCNT(b.x)], 1u);
    return b;
}
__device__ __forceinline__ void xcd_barrier_complete(unsigned* bar, unsigned x, unsigned& nloc, unsigned& nx) {
    const unsigned G = gridDim.x * gridDim.y * gridDim.z;
    unsigned sum, cnt, mine, sp = 0u;
    for (;;) {
        sum = 0u; cnt = 0u; mine = 0u;
#pragma unroll
        for (unsigned j = 0; j < 16; ++j) { const unsigned c = xb_ld(&bar[XB_XCNT(j)]); sum += c; cnt += (c > 0u) ? 1u : 0u; mine = (j == x) ? c : mine; }
        if (sum == G) break;
        __builtin_amdgcn_s_sleep(1);
        if ((++sp & 255u) == 0u) { if (xb_ld(&bar[XB_TMO])) break; if (sp > XB_SPIN_CAP) { atomicAdd(&bar[XB_TMO], 1u); break; } }
    }
    nloc = mine > 0u ? mine : 1u; nx = cnt > 0u ? cnt : 1u;
}
__device__ __forceinline__ void xcd_barrier(const XcdBarrier& b, const bool leader  ) {
    asm volatile("s_waitcnt vmcnt(0)" ::: "memory");
    __syncthreads();
    if (leader) {
        unsigned* bar = b.bar;
        __builtin_amdgcn_s_waitcnt(0);
        unsigned nloc = b.st[0], nx = b.st[1];
        if (nloc == 0u) { xcd_barrier_complete(bar, b.x, nloc, nx); b.st[0] = nloc; b.st[1] = nx; }
        const unsigned old = xb_add(&bar[XB_XSUB(b.x)], 1u);
        const unsigned gen = old / nloc;
        if (old + 1u == (gen + 1u) * nloc) {
            __builtin_amdgcn_fence(__ATOMIC_RELEASE, "agent");
            asm volatile("s_waitcnt vmcnt(0)" ::: "memory");
            const unsigned og = xb_add(&bar[XB_TOP], 1u);
            const unsigned tg = og / nx;
            if (og + 1u == (tg + 1u) * nx) xb_add(&bar[XB_TOPGEN], 1u);
            else XB_SPIN(xb_ld(&bar[XB_TOPGEN]) == tg, bar);
            __builtin_amdgcn_fence(__ATOMIC_ACQUIRE, "agent");
            xb_add(&bar[XB_XGEN(b.x)], 1u);
            asm volatile("s_waitcnt vmcnt(0)" ::: "memory");
        } else {
            XB_SPIN(xb_ld(&bar[XB_XGEN(b.x)]) == gen, bar);
            __builtin_amdgcn_fence(__ATOMIC_ACQUIRE, "agent");
            asm volatile("s_waitcnt vmcnt(0)" ::: "memory");
        }
    }
    __syncthreads();
}

namespace g8 {
constexpr int BM = 256, BK = 64, HALF = 128, HTB = HALF * BK * 2, STAGE_BYTES = 8 * HTB, NXCD = 8, WGM = 8;
__device__ __forceinline__ int lds_byte(int r, int c) { const int st = (r >> 4) * 2 + (c >> 5), rr = r & 15, cc = c & 31, ob = rr * 64 + cc * 2; return st * 1024 + (ob ^ (((ob >> 9) & 1) << 5)); }
__device__ __forceinline__ void stage_rc(int b, int& R, int& C) { const int st = b / 1024, sb = b % 1024, swz = sb ^ (((sb >> 9) & 1) << 5); R = (st >> 1) * 16 + swz / 64; C = (st & 1) * 32 + (swz % 64) / 2; }
__device__ __forceinline__ int perm32(int rho) { const int n = rho >> 4, i = rho & 15; return 8 * (i >> 2) + 4 * n + (i & 3); }

struct Unit { const char* A; const char* B; int pm, pn, aux; };

struct DenseOrder {
    const char* A; const char* Bt; int nM, nN, nwg, G, c, K, tid0;
    __device__ void init(const void* A_, const void* Bt_, int M, int N, int K_, int G_, int c_) { A = (const char*)A_; Bt = (const char*)Bt_; nM = M / BM; nN = N / BM; nwg = nM * nN; G = G_; c = c_; K = K_; }
    __device__ __forceinline__ bool next(int i, Unit& u) const {
        const long L = (long)i * G + c; if (L >= nwg) return false;
        int wgid = (int)L; { const int q = nwg / NXCD, r = nwg % NXCD, xcd = wgid % NXCD, off = wgid / NXCD; wgid = (xcd < r ? xcd * (q + 1) : r * (q + 1) + (xcd - r) * q) + off; }
        const int nig = WGM * nN, gid = wgid / nig, fm = gid * WGM, gsz = (nM - fm) < WGM ? (nM - fm) : WGM;
        u.pm = fm + ((wgid % nig) % gsz); u.pn = (wgid % nig) / gsz; u.aux = 0;
        u.A = A + (size_t)u.pm * BM * K * 2; u.B = Bt + (size_t)u.pn * BM * K * 2; return true;
    }
    __device__ __forceinline__ void aoff(const Unit&, int tid, unsigned (&o)[2][2]) const {
#pragma unroll
        for (int i = 0; i < 2; ++i) { int R, C; stage_rc(tid * 16 + i * 8192, R, C);
            o[0][i] = (unsigned)(R * K + C) * 2u; o[1][i] = (unsigned)((R + HALF) * K + C) * 2u; }
    }
};

__device__ __forceinline__ unsigned cvt_pk_bf16(float lo, float hi) { unsigned r; asm volatile("v_cvt_pk_bf16_f32 %0, %1, %2" : "=v"(r) : "v"(lo), "v"(hi)); return r; }

struct EpiF32 {
    static constexpr bool PERM = false;
    float* C; int ldc; const float* bias;
    __device__ __forceinline__ void init(f32x4 (&acc)[2][2][4][2], const Unit&, int, int) const {
#pragma unroll
        for (int a = 0; a < 2; ++a)
#pragma unroll
            for (int b = 0; b < 2; ++b)
#pragma unroll
                for (int m = 0; m < 4; ++m)
#pragma unroll
                    for (int n = 0; n < 2; ++n) acc[a][b][m][n] = (f32x4){0.f, 0.f, 0.f, 0.f}; }
    __device__ __forceinline__ void operator()(const f32x4 (&acc)[2][2][4][2], const Unit& u, int wr, int wc, int fr, int fq) const {
        const int row0 = u.pm * BM + wr * 64 + fr, col0 = u.pn * BM + wc * 32 + 4 * fq;
        f32x4 bv[2][2];
#pragma unroll
        for (int bj = 0; bj < 2; ++bj)
#pragma unroll
            for (int n = 0; n < 2; ++n) bv[bj][n] = bias ? *(const f32x4*)(bias + col0 + bj * HALF + n * 16) : (f32x4){0.f, 0.f, 0.f, 0.f};
#pragma unroll
        for (int ai = 0; ai < 2; ++ai)
#pragma unroll
            for (int m = 0; m < 4; ++m) { float* rowp = C + (size_t)(row0 + ai * HALF + m * 16) * ldc + col0;
#pragma unroll
                for (int bj = 0; bj < 2; ++bj)
#pragma unroll
                    for (int n = 0; n < 2; ++n) *(f32x4*)(rowp + bj * HALF + n * 16) = acc[ai][bj][m][n] + bv[bj][n]; }
    }
};

struct EpiBf16 {
    static constexpr bool PERM = true;
    bf16_t* O; int ldc; const float* bias;
    __device__ __forceinline__ void init(f32x4 (&acc)[2][2][4][2], const Unit& u, int wc, int fq) const {
        const int col0 = u.pn * BM + wc * 32 + 8 * fq;
#pragma unroll
        for (int b = 0; b < 2; ++b)
#pragma unroll
            for (int n = 0; n < 2; ++n) { const f32x4 bv = *(const f32x4*)(bias + col0 + b * HALF + 4 * n);
#pragma unroll
                for (int a = 0; a < 2; ++a)
#pragma unroll
                    for (int m = 0; m < 4; ++m) acc[a][b][m][n] = bv; } }
    __device__ __forceinline__ void operator()(const f32x4 (&acc)[2][2][4][2], const Unit& u, int wr, int wc, int fr, int fq) const {
        const int row0 = u.pm * BM + wr * 64 + fr, col0 = u.pn * BM + wc * 32 + 8 * fq;
#pragma unroll
        for (int ai = 0; ai < 2; ++ai)
#pragma unroll
            for (int m = 0; m < 4; ++m) { bf16_t* rowp = O + (size_t)(row0 + ai * HALF + m * 16) * ldc + col0;
#pragma unroll
                for (int bj = 0; bj < 2; ++bj) { const f32x4 v0 = acc[ai][bj][m][0], v1 = acc[ai][bj][m][1];
                    u32x4 w; w[0] = cvt_pk_bf16(v0[0], v0[1]); w[1] = cvt_pk_bf16(v0[2], v0[3]); w[2] = cvt_pk_bf16(v1[0], v1[1]); w[3] = cvt_pk_bf16(v1[2], v1[3]);
                    *(u32x4*)(rowp + bj * HALF) = w; } }
    }
};

template <class Epi, class Sched>
__device__ __forceinline__ void gemm_phase(LAS unsigned char* lds, const int K, const Sched& S, const Epi& E) {
    int tid_ = S.tid0; asm volatile("" : "+v"(tid_));
    const int tid = tid_, wid = __builtin_amdgcn_readfirstlane(tid >> 6), lane = tid & 63, wr = wid >> 2, wc = wid & 3, fr = lane & 15, fq = lane >> 4;
    const int nt = K / BK;
    unsigned voffB[2];
#pragma unroll
    for (int i = 0; i < 2; ++i) { int R, C; stage_rc(tid * 16 + i * 8192, R, C); const int Rb = Epi::PERM ? ((R & ~31) + perm32(R & 31)) : R;
        voffB[i] = (unsigned)(Rb * K + C) * 2u; }
    const size_t kstep = (size_t)(BK * 2);
    const size_t hstep = (size_t)HALF * K * 2;
    const unsigned ldsw = (unsigned)wid * 1024u;
    const int aoff = lds_byte(wr * 64 + fr, fq * 8), boff = lds_byte(wc * 32 + fr, fq * 8);
#define G8_SA(b, h) (((b) * 2 + (h)) * HTB)
#define G8_SB(b, h) ((4 + (b) * 2 + (h)) * HTB)
#define G8_STAGE(bufoff, gbase, voff) do { _Pragma("unroll") for (int _i = 0; _i < 2; ++_i) \
        __builtin_amdgcn_global_load_lds((const unsigned*)((const char*)(gbase) + (voff)[_i]), (LAS unsigned*)(lds + (bufoff) + ldsw + _i * 8192), 16, 0, 0); } while (0)
#define G8_LDA(dst, b, h) do { _Pragma("unroll") for (int m = 0; m < 4; ++m) _Pragma("unroll") for (int k = 0; k < 2; ++k) dst[m][k] = *(const LAS bf16x8*)(lds + G8_SA(b, h) + aoff + m * 2048 + k * 1024); } while (0)
#define G8_LDB(dst, b, h) do { _Pragma("unroll") for (int n = 0; n < 2; ++n) _Pragma("unroll") for (int k = 0; k < 2; ++k) dst[n][k] = *(const LAS bf16x8*)(lds + G8_SB(b, h) + boff + n * 2048 + k * 1024); } while (0)
#define G8_MMA(ai, bj, At, Bt) do { __builtin_amdgcn_s_setprio(1); _Pragma("unroll") for (int m = 0; m < 4; ++m) _Pragma("unroll") for (int n = 0; n < 2; ++n) _Pragma("unroll") for (int k = 0; k < 2; ++k) \
        acc[ai][bj][m][n] = __builtin_amdgcn_mfma_f32_16x16x32_bf16(Bt[n][k], At[m][k], acc[ai][bj][m][n], 0, 0, 0); __builtin_amdgcn_s_setprio(0); } while (0)
#define G8_WAIT_V(n) asm volatile("s_waitcnt vmcnt(" #n ")" ::: "memory")
#define G8_WAIT_L(n) asm volatile("s_waitcnt lgkmcnt(" #n ")" ::: "memory")
#define G8_BAR __builtin_amdgcn_s_barrier()
#define G8_SCHED __builtin_amdgcn_sched_barrier(0)
    Unit cur, nxt; int ui = 0;
    if (!S.next(0, cur)) return;
    f32x4 acc[2][2][4][2];
    E.init(acc, cur, wc, fq);
    bf16x8 At[4][2], B0[2][2], B1[2][2];
    unsigned oc[2][2];
    S.aoff(cur, tid, oc);
    const char* cA = cur.A; const char* cB = cur.B;
    G8_STAGE(G8_SB(0, 0), cB, voffB); G8_STAGE(G8_SA(0, 0), cA, oc[0]); G8_STAGE(G8_SB(0, 1), cB + hstep, voffB); G8_STAGE(G8_SA(0, 1), cA, oc[1]);
    if (wr == 1) G8_BAR;
    G8_WAIT_V(4); G8_BAR;
    G8_STAGE(G8_SB(1, 0), cB + kstep, voffB); G8_STAGE(G8_SA(1, 0), cA + kstep, oc[0]); G8_STAGE(G8_SB(1, 1), cB + hstep + kstep, voffB);
    G8_WAIT_V(6); G8_BAR;
    for (;;) {
        const bool has_next = S.next(ui + 1, nxt);
        const char* nA = has_next ? nxt.A : cA; const char* nB = has_next ? nxt.B : cB;
#pragma unroll 1
        for (int t = 0; t < nt; t += 2) {
            const bool last = (t == nt - 2);
            const char* a1 = cA + (size_t)(t + 1) * kstep;
            const char* a2 = last ? nA : cA + (size_t)(t + 2) * kstep; const char* b2 = last ? nB : cB + (size_t)(t + 2) * kstep;
            const char* a3 = a2 + kstep; const char* b3 = b2 + kstep;
            G8_LDB(B0, 0, 0); G8_SCHED; G8_LDA(At, 0, 0); G8_STAGE(G8_SA(1, 1), a1, oc[1]);
            if (last && has_next) S.aoff(nxt, tid, oc);
            G8_WAIT_L(8); G8_BAR; G8_WAIT_L(0); G8_MMA(0, 0, At, B0); G8_BAR; G8_SCHED;
            G8_LDB(B1, 0, 1); G8_STAGE(G8_SB(0, 0), b2, voffB);
            G8_BAR; G8_WAIT_L(0); G8_MMA(0, 1, At, B1); G8_BAR;
            G8_LDA(At, 0, 1); G8_STAGE(G8_SA(0, 0), a2, oc[0]);
            G8_BAR; G8_WAIT_L(0); G8_MMA(1, 0, At, B0); G8_BAR; G8_SCHED;
            G8_STAGE(G8_SB(0, 1), b2 + hstep, voffB);
            G8_WAIT_V(6); G8_BAR; G8_MMA(1, 1, At, B1); G8_BAR;
            G8_LDB(B0, 1, 0); G8_SCHED; G8_LDA(At, 1, 0); G8_STAGE(G8_SA(0, 1), a2, oc[1]);
            G8_WAIT_L(8); G8_BAR; G8_WAIT_L(0); G8_MMA(0, 0, At, B0); G8_BAR; G8_SCHED;
            G8_LDB(B1, 1, 1); G8_STAGE(G8_SB(1, 0), b3, voffB);
            G8_BAR; G8_WAIT_L(0); G8_MMA(0, 1, At, B1); G8_BAR;
            G8_LDA(At, 1, 1); G8_STAGE(G8_SA(1, 0), a3, oc[0]);
            G8_BAR; G8_WAIT_L(0); G8_MMA(1, 0, At, B0); G8_BAR; G8_SCHED;
            G8_STAGE(G8_SB(1, 1), b3 + hstep, voffB);
            G8_WAIT_V(6); G8_BAR; G8_MMA(1, 1, At, B1); G8_BAR;
        }
        E(acc, cur, wr, wc, fr, fq);
        if (!has_next) break;
        cur = nxt; cA = nA; cB = nB; ++ui;
        E.init(acc, cur, wc, fq);
    }
    G8_WAIT_V(0);
    if (wr == 0) G8_BAR;
    G8_BAR;
#undef G8_SA
#undef G8_SB
#undef G8_STAGE
#undef G8_LDA
#undef G8_LDB
#undef G8_MMA
#undef G8_WAIT_V
#undef G8_WAIT_L
#undef G8_BAR
#undef G8_SCHED
}
}

constexpr int NTHREADS = 512;
constexpr int LDS_STAGE = 0;
constexpr int LDS_TAB   = g8::STAGE_BYTES;
constexpr int TAB_SLOTS = 6;
constexpr int LDS_GTAB  = LDS_TAB + TAB_SLOTS * 256 * 4;
constexpr int LDS_DESC  = LDS_GTAB + TAB_SLOTS * 256 * 4;
constexpr int LDS_PREF  = LDS_DESC + 64;
constexpr int LDS_MISC  = 147456 - 64;
constexpr int LDS_BYTES = 147456;
static_assert(LDS_MISC % 16 == 0 && LDS_MISC + 64 <= LDS_BYTES && LDS_PREF + 2 * 132 * 4 <= LDS_MISC, "LDS map");

#define GAS __attribute__((address_space(1)))
struct Params { const GAS float* in[31]; GAS float* out; GAS unsigned char* ws; int ph_lo, ph_hi; };

struct Ctx {
    const GAS float* const* in; float* out; unsigned char* ws; LAS unsigned char* lds;
    __device__ __forceinline__ const float* inp(int k) const { return (const float*)in[k]; }
    int tid, lane, wid, bid, G, gtid, gthreads, gw, nwaves;
};

__device__ __forceinline__ int ab_phys(int n) {
    if (n < 1024) { const int hd = n >> 6, jj = n & 63; return (hd >> 2) * 256 + (jj >> 5) * 128 + (hd & 3) * 32 + (jj & 31); }
    if (n < 1152) { const int nn = n - 1024, hh = nn >> 6, jj = nn & 63; return 1024 + (jj >> 5) * 128 + hh * 32 + (jj & 31); }
    if (n < 1280) { const int vv = n - 1152; return 1024 + (vv >> 6) * 128 + 64 + (vv & 63); }
    if (n < 2304) { const int base = n < 1792 ? 1280 : 1792, nn = n - base, h = nn >> 7, jj = nn & 127; return base + (h >> 1) * 256 + (jj >> 6) * 128 + (h & 1) * 64 + (jj & 63); }
    return n;
}
template <int TN, class DstFn>
__device__ __forceinline__ void convert_T(const Ctx& c, const float* src, int nmat, int K, int N, DstFn dstfn) {
    LAS float* tile = (LAS float*)(c.lds);
    constexpr int LDT = TN + 1, TPR = TN / 4  , KPI = NTHREADS / TPR  , NI = 64 / KPI, KPT = 64 * TN / NTHREADS  ;
    const int tk = K / 64, tn = N / TN; const long ntiles = (long)nmat * tk * tn;
    f32x4 v[NI];
    auto issue = [&](long tix) { const int m = (int)(tix / (tk * tn)); const int rem = (int)(tix % (tk * tn)); const int kt = rem / tn, nt = rem % tn;
        const float* s = src + (size_t)m * K * N + (size_t)(kt * 64) * N + nt * TN;
#pragma unroll
        for (int i = 0; i < NI; ++i) { const int k = c.tid / TPR + KPI * i, n4 = (c.tid % TPR) * 4; v[i] = __builtin_nontemporal_load((const f32x4*)(s + (size_t)k * N + n4)); } };
    if (c.bid < ntiles) issue(c.bid);
    for (long tix = c.bid; tix < ntiles; tix += c.G) {
        const int m = (int)(tix / (tk * tn)); const int rem = (int)(tix % (tk * tn)); const int kt = rem / tn, nt = rem % tn;
#pragma unroll
        for (int i = 0; i < NI; ++i) { const int k = c.tid / TPR + KPI * i, n4 = (c.tid % TPR) * 4;
            tile[k * LDT + n4 + 0] = v[i][0]; tile[k * LDT + n4 + 1] = v[i][1]; tile[k * LDT + n4 + 2] = v[i][2]; tile[k * LDT + n4 + 3] = v[i][3]; }
        if (tix + c.G < ntiles) issue(tix + c.G);
        __syncthreads();
        { const int ch = c.tid & 7, nb = c.tid >> 3;
#pragma unroll
          for (int j = 0; j < TN / 64; ++j) { const int n = nb + 64 * j;
              bf16_t* d = dstfn(m, nt * TN + n) + kt * 64 + ch * 8; u32x4 w;
#pragma unroll
              for (int e = 0; e < 4; ++e) w[e] = pk2(tile[(ch * 8 + 2 * e) * LDT + n], tile[(ch * 8 + 2 * e + 1) * LDT + n]);
              *(u32x4*)d = w; } }
        __syncthreads();
    }
}

__device__ __forceinline__ void phase_convert(const Ctx& c) {
    unsigned char* ws = c.ws;
    { const float* x = c.inp(0); bf16_t* xb = (bf16_t*)(ws + WS_XB);
      for (long i0 = c.gtid; i0 < (long)T * D / 4; i0 += (long)c.gthreads * 8) { f32x4 v[8];
#pragma unroll
          for (int q = 0; q < 8; ++q) { const long i = i0 + (long)q * c.gthreads; v[q] = (f32x4){0.f, 0.f, 0.f, 0.f}; if (i < (long)T * D / 4) v[q] = __builtin_nontemporal_load((const f32x4*)(x + i * 4)); }
#pragma unroll
          for (int q = 0; q < 8; ++q) { const long i = i0 + (long)q * c.gthreads; if (i < (long)T * D / 4) { u32x2 w; w[0] = pk2(v[q][0], v[q][1]); w[1] = pk2(v[q][2], v[q][3]); *(u32x2*)(xb + i * 4) = w; } } } }
    { bf16_t* wrt = (bf16_t*)(ws + WS_WRT); for (long i = c.gtid; i < (long)4 * 128 * D / 8; i += c.gthreads) { const long l = i / (128 * D / 8), r = i % (128 * D / 8); *(u32x4*)(wrt + (size_t)l * 256 * D + (size_t)128 * D + r * 8) = (u32x4){0u, 0u, 0u, 0u}; }
      float* gate = (float*)(ws + WS_GATE); for (int i = c.gtid; i < T; i += c.gthreads) gate[TK + i] = 1.f;
      float* bp = (float*)(ws + WS_BIASP); for (int i = c.gtid; i < 2 * AB_IN; i += c.gthreads) { const int m = i / AB_IN, n = i % AB_IN; bp[m * AB_IN + ab_phys(n)] = c.inp(2)[i]; } }
    { bf16_t* d = (bf16_t*)(ws + WS_WABIN);  convert_T<256>(c, c.inp(1), 2, D, AB_IN, [=](int m, int n) { return d + (size_t)m * AB_IN * D + (size_t)ab_phys(n) * D; }); }
    { bf16_t* d = (bf16_t*)(ws + WS_WABOUT); convert_T<256>(c, c.inp(4), 2, AB_OUT, D, [=](int m, int n) { return d + (size_t)m * D * AB_OUT + (size_t)n * AB_OUT; }); }
    { bf16_t* d = (bf16_t*)(ws + WS_WCDIN);  convert_T<256>(c, c.inp(6), 2, D, CD_IN, [=](int m, int n) { return d + (size_t)m * CD_IN * D + (size_t)n * D; }); }
    { bf16_t* d = (bf16_t*)(ws + WS_WCDOUT); convert_T<256>(c, c.inp(17), 2, CD_OUT, D, [=](int m, int n) { return d + (size_t)m * D * CD_OUT + (size_t)n * CD_OUT; }); }
    { bf16_t* d = (bf16_t*)(ws + WS_WRT);    convert_T<128>(c, c.inp(21), 4, D, NE, [=](int m, int n) { return d + (size_t)m * 256 * D + (size_t)n * D; }); }
    { bf16_t* d = (bf16_t*)(ws + WS_WGU);
      convert_T<256>(c, c.inp(23), 4 * NE, D, ED, [=](int m, int n) { return d + (size_t)((m >> 7) * NE1 + (m & 127)) * 512 * D + (size_t)((n >> 7) * 256 + (n & 127)) * D; });
      convert_T<256>(c, c.inp(24), 4 * NE, D, ED, [=](int m, int n) { return d + (size_t)((m >> 7) * NE1 + (m & 127)) * 512 * D + (size_t)((n >> 7) * 256 + 128 + (n & 127)) * D; });
      convert_T<256>(c, c.inp(26), 4, D, ED, [=](int m, int n) { return d + (size_t)(m * NE1 + NE) * 512 * D + (size_t)((n >> 7) * 256 + (n & 127)) * D; });
      convert_T<256>(c, c.inp(27), 4, D, ED, [=](int m, int n) { return d + (size_t)(m * NE1 + NE) * 512 * D + (size_t)((n >> 7) * 256 + 128 + (n & 127)) * D; }); }
    { bf16_t* d = (bf16_t*)(ws + WS_WLRU);
      convert_T<256>(c, c.inp(12), 10, 256, 256, [=](int m, int n) { return d + (size_t)(m * 2 + 0) * 65536 + (size_t)n * 256; });
      convert_T<256>(c, c.inp(14), 10, 256, 256, [=](int m, int n) { return d + (size_t)(m * 2 + 1) * 65536 + (size_t)n * 256; });
      float* spl = (float*)(ws + WS_SPL); for (int i = c.gtid; i < 2 * 1280; i += c.gthreads) spl[i] = log1pf(expf(-c.inp(16)[i])); }
    { bf16_t* d = (bf16_t*)(ws + WS_WDN);
      convert_T<256>(c, c.inp(25), 4 * NE, ED, D, [=](int m, int n) { return d + (size_t)((m >> 7) * NE1 + (m & 127)) * D * ED + (size_t)n * ED; });
      convert_T<256>(c, c.inp(28), 4, ED, D, [=](int m, int n) { return d + (size_t)(m * NE1 + NE) * D * ED + (size_t)n * ED; }); }
}

__device__ __forceinline__ void phase_dense(const Ctx& c, const bf16_t* A, const bf16_t* Bt, int M, int N, int K, bf16_t* C, int ldc, const float* bias) {
    g8::DenseOrder S; S.init(A, Bt, M, N, K, c.G, c.bid); S.tid0 = c.tid;
    g8::EpiBf16 E{C, ldc, bias};
    g8::gemm_phase<g8::EpiBf16, g8::DenseOrder>(c.lds + LDS_STAGE, K, S, E);
}

__device__ __forceinline__ void st_bf16_off(unsigned char* base, unsigned byte_off, float v) { *(bf16_t*)(base + byte_off) = f2bf(v); }
struct EpiABIn {
    static constexpr bool PERM = true;
    LAS bf16_t* biasL; unsigned char* ws;
    __device__ __forceinline__ void init(f32x4 (&acc)[2][2][4][2], const g8::Unit& u, int wc, int fq) const {
        const int colp = u.pn * 256 + wc * 32 + fq * 8;
#pragma unroll
        for (int b = 0; b < 2; ++b)
#pragma unroll
            for (int n = 0; n < 2; ++n) { const u32x2 bw = *(const LAS u32x2*)(biasL + colp + b * 128 + 4 * n);
                const f32x4 bv = (f32x4){__uint_as_float(bw[0] << 16), __uint_as_float(bw[0] & 0xffff0000u), __uint_as_float(bw[1] << 16), __uint_as_float(bw[1] & 0xffff0000u)};
#pragma unroll
                for (int a = 0; a < 2; ++a)
#pragma unroll
                    for (int m = 0; m < 4; ++m) acc[a][b][m][n] = bv; } }
    __device__ __forceinline__ void operator()(const f32x4 (&acc)[2][2][4][2], const g8::Unit& u, int wr, int wc, int fr_, int fq_) const {
        int fr = fr_, fq = fq_; asm volatile("" : "+v"(fr), "+v"(fq));
        const int pn = u.pn; const int colp = pn * 256 + wc * 32 + fq * 8;
        bf16_t* qb = (bf16_t*)(ws + AB_QB); bf16_t* kb = (bf16_t*)(ws + AB_KB); bf16_t* vT = (bf16_t*)(ws + AB_VT); bf16_t* rqb = (bf16_t*)(ws + AB_RQB); bf16_t* rkb = (bf16_t*)(ws + AB_RKB);
        bf16_t* rkdT = (bf16_t*)(ws + AB_RKDT); bf16_t* rvT = (bf16_t*)(ws + AB_RVT); bf16_t* rgb = (bf16_t*)(ws + AB_RGB);
        const float frqA0 = exp2f(-(float)(fq * 8) * (13.287712379549449f / 32.f)) * 0.15915494309189535f;
        const float frqR0 = exp2f(-(float)((wc & 1) * 32 + fq * 8) * (13.287712379549449f / 63.f)) * 0.15915494309189535f;
        constexpr float RA[8] = {1.f, 0.7498942093324559f, 0.5623413251903491f, 0.4216965034285822f, 0.31622776601683794f, 0.23713737056616552f, 0.1778279410038923f, 0.1333521432163324f};
        constexpr float RR[8] = {1.f, 0.8639884494839686f, 0.746476040841712f, 0.6449466771037624f, 0.5572264795507174f, 0.4814372420784346f, 0.4159562163071847f, 0.35938136638046275f};
#pragma unroll
        for (int ai = 0; ai < 2; ++ai)
#pragma unroll
            for (int m = 0; m < 4; ++m) {
                const int t = u.pm * 256 + ai * 128 + wr * 64 + m * 16 + fr, sq = t & (SEQ - 1), b = t >> 13;
                f32x4 x[2][2];
#pragma unroll
                for (int bj = 0; bj < 2; ++bj)
#pragma unroll
                    for (int n = 0; n < 2; ++n) x[bj][n] = acc[ai][bj][m][n];
                if (pn < 4 || (pn == 4 && wc < 2)) {
                    const int j0 = fq * 8; const float sc = pn < 4 ? 0.125f : 1.f;
                    u32x4 w1, w2;
#pragma unroll
                    for (int n = 0; n < 2; ++n) { f32x4 o1, o2;
#pragma unroll
                        for (int e = 0; e < 4; ++e) { const float rev = __builtin_amdgcn_fractf((float)sq * (frqA0 * RA[4 * n + e])); const float cc = __builtin_amdgcn_cosf(rev) * sc, ss = __builtin_amdgcn_sinf(rev) * sc;
                            o1[e] = x[0][n][e] * cc - x[1][n][e] * ss; o2[e] = x[1][n][e] * cc + x[0][n][e] * ss; }
                        w1[2 * n] = pk2(o1[0], o1[1]); w1[2 * n + 1] = pk2(o1[2], o1[3]); w2[2 * n] = pk2(o2[0], o2[1]); w2[2 * n + 1] = pk2(o2[2], o2[3]); }
                    bf16_t* dst = pn < 4 ? qb + (size_t)t * 1024 + (pn * 4 + wc) * 64 + j0 : kb + (size_t)t * 128 + wc * 64 + j0;
                    *(u32x4*)dst = w1; *(u32x4*)(dst + 32) = w2;
                } else if (pn == 4) {
                    const int d0 = (wc - 2) * 32 + fq * 8;
#pragma unroll
                    for (int bj = 0; bj < 2; ++bj)
#pragma unroll
                        for (int n = 0; n < 2; ++n)
#pragma unroll
                            for (int e = 0; e < 4; ++e) st_bf16_off((unsigned char*)vT, (unsigned)((((b * 2 + bj) * 64 + d0 + 4 * n + e) * SEQ + sq) * 2), x[bj][n][e]);
                } else if (pn < 9) {
                    const bool isk = pn >= 7; const int h = ((pn - 5) & 1) * 2 + (wc >> 1), j0 = (wc & 1) * 32 + fq * 8;
                    const float sc = isk ? 0.08838834764831845f : 1.f;
                    const unsigned dToff = (unsigned)((((b * 4 + h) * 128 + j0) * SEQ + sq) * 2);
                    u32x4 w1, w2;
#pragma unroll
                    for (int n = 0; n < 2; ++n) { f32x4 o1, o2;
#pragma unroll
                        for (int e = 0; e < 4; ++e) { const float rev = __builtin_amdgcn_fractf((float)sq * (frqR0 * RR[4 * n + e])); const float cc = __builtin_amdgcn_cosf(rev) * sc, ss = __builtin_amdgcn_sinf(rev) * sc;
                            o1[e] = x[0][n][e] * cc - x[1][n][e] * ss; o2[e] = x[1][n][e] * cc + x[0][n][e] * ss; }
                        w1[2 * n] = pk2(o1[0], o1[1]); w1[2 * n + 1] = pk2(o1[2], o1[3]); w2[2 * n] = pk2(o2[0], o2[1]); w2[2 * n + 1] = pk2(o2[2], o2[3]);
                        if (isk) {
#pragma unroll
                            for (int e = 0; e < 4; ++e) { st_bf16_off((unsigned char*)rkdT, dToff + (unsigned)((4 * n + e) * SEQ * 2), o1[e]); st_bf16_off((unsigned char*)rkdT, dToff + (unsigned)((64 + 4 * n + e) * SEQ * 2), o2[e]); } } }
                    bf16_t* dst = (isk ? rkb : rqb) + (size_t)t * 512 + h * 128 + j0;
                    *(u32x4*)dst = w1; *(u32x4*)(dst + 64) = w2;
                } else if (pn < 13) {
                    const int h = pn - 9;
#pragma unroll
                    for (int bj = 0; bj < 2; ++bj)
#pragma unroll
                        for (int n = 0; n < 2; ++n)
#pragma unroll
                            for (int e = 0; e < 4; ++e) st_bf16_off((unsigned char*)rvT, (unsigned)((((b * 4 + h) * 256 + bj * 128 + wc * 32 + fq * 8 + 4 * n + e) * SEQ + sq) * 2), x[bj][n][e]);
                } else {
#pragma unroll
                    for (int bj = 0; bj < 2; ++bj) { u32x4 w;
#pragma unroll
                        for (int n = 0; n < 2; ++n) { const f32x4 sv = silu4(x[bj][n]); w[2 * n] = pk2(sv[0], sv[1]); w[2 * n + 1] = pk2(sv[2], sv[3]); }
                        *(u32x4*)(rgb + (size_t)t * 1024 + (pn - 13) * 256 + bj * 128 + wc * 32 + fq * 8) = w; }
                }
            }
    }
};
__device__ __forceinline__ void phase_ab_inproj(const Ctx& c, int j) {
    g8::DenseOrder S; S.init(c.ws + WS_XB, c.ws + WS_WABIN + (size_t)j * AB_IN * D * 2, T, AB_IN, D, c.G, c.bid); S.tid0 = c.tid;
    LAS bf16_t* biasL = (LAS bf16_t*)(c.lds + LDS_TAB);
    { const float* bp = (const float*)(c.ws + WS_BIASP) + (size_t)j * AB_IN; float bvv[9];
#pragma unroll
      for (int q = 0; q < 9; ++q) { const int i = c.tid + q * NTHREADS; bvv[q] = 0.f; if (i < AB_IN) bvv[q] = bp[i]; }
#pragma unroll
      for (int q = 0; q < 9; ++q) { const int i = c.tid + q * NTHREADS; if (i < AB_IN) biasL[i] = f2bf(bvv[q]); } }
    __syncthreads();
    EpiABIn E{biasL, c.ws};
    g8::gemm_phase<EpiABIn, g8::DenseOrder>(c.lds + LDS_STAGE, D, S, E);
}

#define MFMA16(a, b, c) __builtin_amdgcn_mfma_f32_16x16x32_bf16((a), (b), (c), 0, 0, 0)
__device__ __forceinline__ bf16x8 pack8(const f32x4& lo, const f32x4& hi) { u32x4 w; w[0] = g8::cvt_pk_bf16(lo[0], lo[1]); w[1] = g8::cvt_pk_bf16(lo[2], lo[3]); w[2] = g8::cvt_pk_bf16(hi[0], hi[1]); w[3] = g8::cvt_pk_bf16(hi[2], hi[3]); return __builtin_bit_cast(bf16x8, w); }
__device__ __forceinline__ bf16x8 cat8(const u32x2& lo, const u32x2& hi) { u32x4 w; w[0] = lo[0]; w[1] = lo[1]; w[2] = hi[0]; w[3] = hi[1]; return __builtin_bit_cast(bf16x8, w); }
template <int ROWS, int RB, int PAD = 32>
__device__ __forceinline__ void tile_g2l(LAS unsigned char* dst, const unsigned char* src, size_t gs, int tid, int zrows = 0) {
    constexpr int CPR = RB / 16, TOTAL = ROWS * CPR;
#pragma unroll 8
    for (int i = tid; i < TOTAL; i += NTHREADS) { const int r = i / CPR, cc = i % CPR; u32x4 v = (u32x4){0u, 0u, 0u, 0u}; if (r >= zrows) v = *(const u32x4*)(src + (size_t)r * gs + cc * 16);
        *(LAS u32x4*)(dst + r * (RB + PAD) + cc * 16) = v; }
}

__device__ __forceinline__ void attn_unit(const Ctx& c, int unit, const float* sinks) {
    const int b = unit >> 7, n = (unit >> 1) & 63, kvh = unit & 1, hd = kvh * 8 + c.wid, lane = c.lane, fr = lane & 15, fq = lane >> 4;
    const bf16_t* qb = (const bf16_t*)(c.ws + AB_QB); const bf16_t* kb = (const bf16_t*)(c.ws + AB_KB); const bf16_t* vT = (const bf16_t*)(c.ws + AB_VT); bf16_t* ycat = (bf16_t*)(c.ws + WS_YCAT);
    LAS unsigned char* Ks = c.lds; LAS unsigned char* Vs = c.lds + 256 * 160;
    const int t0 = b * SEQ + n * 128;
    __syncthreads();
    const float sink = sinks[hd];
    bf16x8 qn[2];
    {
        const unsigned char* src = (const unsigned char*)(kb + (size_t)(t0 - 128) * 128 + kvh * 64);
        const unsigned char* vsrc = (const unsigned char*)(vT + (size_t)(b * 2 + kvh) * 64 * SEQ + (n * 128 - 128));
        u32x4 kv4[4], vv4[4];
#pragma unroll
        for (int q = 0; q < 4; ++q) { const int i = c.tid + q * NTHREADS; { const int r = i >> 3, cc = i & 7; kv4[q] = (u32x4){0u, 0u, 0u, 0u}; if (n > 0 || r >= 128) kv4[q] = *(const u32x4*)(src + (ptrdiff_t)r * 256 + cc * 16); }
            { const int r = i >> 5, cc = i & 31; vv4[q] = (u32x4){0u, 0u, 0u, 0u}; if (n > 0 || cc >= 16) vv4[q] = *(const u32x4*)(vsrc + (ptrdiff_t)r * SEQ * 2 + cc * 16); } }
#pragma unroll
        for (int ks = 0; ks < 2; ++ks) qn[ks] = *(const bf16x8*)(qb + (size_t)(t0 + fr) * 1024 + hd * 64 + ks * 32 + fq * 8);
#pragma unroll
        for (int q = 0; q < 4; ++q) { const int i = c.tid + q * NTHREADS; *(LAS u32x4*)(Ks + (i >> 3) * 160 + (i & 7) * 16) = kv4[q]; *(LAS u32x4*)(Vs + (i >> 5) * 528 + (i & 31) * 16) = vv4[q]; }
    }
    __syncthreads();
    for (int si = 0; si < 8; ++si) {
        const int t = t0 + si * 16 + fr;
        bf16x8 qf[2]; qf[0] = qn[0]; qf[1] = qn[1];
        if (si < 7) {
#pragma unroll
            for (int ks = 0; ks < 2; ++ks) qn[ks] = *(const bf16x8*)(qb + (size_t)(t + 16) * 1024 + hd * 64 + ks * 32 + fq * 8); }
        f32x4 S[10];
#pragma unroll
        for (int nk = 0; nk < 9; nk += 3) { bf16x8 kfr[3][2];
#pragma unroll
            for (int u = 0; u < 3; ++u)
#pragma unroll
                for (int ks = 0; ks < 2; ++ks) kfr[u][ks] = *(const LAS bf16x8*)(Ks + (16 * (si + nk + u) + fr) * 160 + ks * 64 + fq * 16);
            __builtin_amdgcn_sched_barrier(0);
#pragma unroll
            for (int u = 0; u < 3; ++u) { S[nk + u] = (f32x4){0.f, 0.f, 0.f, 0.f};
#pragma unroll
                for (int ks = 0; ks < 2; ++ks) S[nk + u] = MFMA16(kfr[u][ks], qf[ks], S[nk + u]); } }
        S[9] = (f32x4){0.f, 0.f, 0.f, 0.f};
        const int i = si * 16 + fr;
        float mx = sink;
#pragma unroll
        for (int nk = 0; nk < 9; ++nk)
#pragma unroll
            for (int r = 0; r < 4; ++r) { const int p = 16 * (si + nk) + 4 * fq + r; const bool ok = (p >= i + 1) && (p <= i + 128) && (n > 0 || p >= 128);
                S[nk][r] = ok ? S[nk][r] : -1e30f; mx = fmaxf(mx, S[nk][r]); }
        mx = xrow_max(mx);
        float sum = 0.f;
#pragma unroll
        for (int nk = 0; nk < 9; ++nk)
#pragma unroll
            for (int r = 0; r < 4; ++r) { const float pv = S[nk][r] > -1e29f ? __builtin_amdgcn_exp2f((S[nk][r] - mx) * 1.4426950408889634f) : 0.f; S[nk][r] = pv; sum += pv; }
        sum = xrow_sum(sum);
        const float inv = 1.f / (sum + exp2f((sink - mx) * 1.4426950408889634f));
        f32x4 O[4];
#pragma unroll
        for (int nd = 0; nd < 4; ++nd) O[nd] = (f32x4){0.f, 0.f, 0.f, 0.f};
#pragma unroll
        for (int kk = 0; kk < 5; ++kk) { const bf16x8 pf = pack8(S[2 * kk], S[2 * kk + 1]);
            const int p0 = 16 * (si + 2 * kk) + 4 * fq, p1 = (kk == 4 && si == 7) ? p0 : p0 + 16;
            u32x2 lo[4], hi[4];
#pragma unroll
            for (int nd = 0; nd < 4; ++nd) { lo[nd] = *(const LAS u32x2*)(Vs + (16 * nd + fr) * 528 + p0 * 2); hi[nd] = *(const LAS u32x2*)(Vs + (16 * nd + fr) * 528 + p1 * 2); }
            __builtin_amdgcn_sched_barrier(0);
#pragma unroll
            for (int nd = 0; nd < 4; ++nd) O[nd] = MFMA16(cat8(lo[nd], hi[nd]), pf, O[nd]); }
#pragma unroll
        for (int nd = 0; nd < 4; nd += 2) { u32x2 wa, wb; wa[0] = pk2(O[nd][0] * inv, O[nd][1] * inv); wa[1] = pk2(O[nd][2] * inv, O[nd][3] * inv); wb[0] = pk2(O[nd + 1][0] * inv, O[nd + 1][1] * inv); wb[1] = pk2(O[nd + 1][2] * inv, O[nd + 1][3] * inv);
            *(u32x4*)(ycat + (size_t)t * AB_OUT + hd * 64 + 16 * (nd + (fq & 1)) + 4 * (fq & 2)) = widen2(wa, wb); }
    }
}

__device__ __forceinline__ void ret_kv_unit(const Ctx& c, int unit) {
    const int b = unit >> 8, n = (unit >> 2) & 63, h = unit & 3, lane = c.lane, fr = lane & 15, fq = lane >> 4, w = c.wid;
    const bf16_t* rkdT = (const bf16_t*)(c.ws + AB_RKDT); const bf16_t* rvT = (const bf16_t*)(c.ws + AB_RVT); float* kv = (float*)(c.ws + AB_KV);
    LAS unsigned char* Kd = c.lds;
    __syncthreads();
    {
        const float lg = log2f(1.f - exp2f(-5.f - (float)h)); const int cc = c.tid & 15;
        float dec[8];
#pragma unroll
        for (int e = 0; e < 8; ++e) dec[e] = __builtin_amdgcn_exp2f((float)(127 - (cc * 8 + e)) * lg);
        const unsigned char* src = (const unsigned char*)(rkdT + (size_t)(b * 4 + h) * 128 * SEQ + n * 128);
#pragma unroll
        for (int q = 0; q < 4; ++q) { const int r = (c.tid >> 4) + 32 * q; const u32x4 v = *(const u32x4*)(src + (size_t)r * SEQ * 2 + cc * 16); u32x4 o;
#pragma unroll
            for (int e2 = 0; e2 < 4; ++e2) o[e2] = pk2(__uint_as_float(v[e2] << 16) * dec[2 * e2], __uint_as_float(v[e2] & 0xffff0000u) * dec[2 * e2 + 1]);
            *(LAS u32x4*)(Kd + r * 288 + cc * 16) = o; }
    }
    bf16x8 vf[2][4];
#pragma unroll
    for (int ne = 0; ne < 2; ++ne)
#pragma unroll
        for (int ks = 0; ks < 4; ++ks) vf[ne][ks] = *(const bf16x8*)(rvT + ((size_t)(b * 4 + h) * 256 + 32 * w + 16 * ne + fr) * SEQ + n * 128 + ks * 32 + fq * 8);
    __syncthreads();
    float* out = kv + ((size_t)((b * 64 + n) * 4 + h)) * 256 * 128;
#pragma unroll
    for (int nd = 0; nd < 8; ++nd) { f32x4 a0 = (f32x4){0.f, 0.f, 0.f, 0.f}, a1 = a0;
        bf16x8 kf[4];
#pragma unroll
        for (int ks = 0; ks < 4; ++ks) kf[ks] = *(const LAS bf16x8*)(Kd + (16 * nd + fr) * 288 + ks * 64 + fq * 16);
        __builtin_amdgcn_sched_barrier(0);
#pragma unroll
        for (int ks = 0; ks < 4; ++ks) { a0 = MFMA16(kf[ks], vf[0][ks], a0); a1 = MFMA16(kf[ks], vf[1][ks], a1); }
        *(f32x4*)(out + (size_t)(32 * w + fr) * 128 + 16 * nd + 4 * fq) = a0; *(f32x4*)(out + (size_t)(32 * w + 16 + fr) * 128 + 16 * nd + 4 * fq) = a1; }
}
__device__ __forceinline__ void ret_scan(const Ctx& c, int first_block, int nblocks) {
    const float* kv = (const float*)(c.ws + AB_KV); bf16_t* sp = (bf16_t*)(c.ws + AB_SPREV);
    const int nthr = nblocks * NTHREADS;
    typedef float f32x2s __attribute__((ext_vector_type(2)));
    for (int idx = (c.bid - first_block) * NTHREADS + c.tid; idx < 2 * 4 * 256 * 128 / 2; idx += nthr) {
        const int b = idx >> 16, rem = idx & 65535, h = rem >> 14;
        const float g = exp2f(128.f * log2f(1.f - exp2f(-5.f - (float)h)));
        const size_t base = (size_t)b * 64 * 131072 + (size_t)rem * 2;
        f32x2s v[64];
#pragma unroll
        for (int q = 0; q < 64; ++q) v[q] = *(const f32x2s*)(kv + base + (size_t)q * 131072);
        f32x2s st = (f32x2s){0.f, 0.f};
#pragma unroll
        for (int q = 0; q < 64; ++q) { *(unsigned*)(sp + base + (size_t)q * 131072) = pk2(st[0], st[1]); st = st * g + v[q]; }
    }
}
__device__ __forceinline__ void ret_out_unit(const Ctx& c, int unit) {
    const int b = unit >> 8, n = (unit >> 2) & 63, h = unit & 3, lane = c.lane, fr = lane & 15, fq = lane >> 4, w = c.wid;
    const bf16_t* rqb = (const bf16_t*)(c.ws + AB_RQB); const bf16_t* rkb = (const bf16_t*)(c.ws + AB_RKB); const bf16_t* rvT = (const bf16_t*)(c.ws + AB_RVT);
    const bf16_t* sp = (const bf16_t*)(c.ws + AB_SPREV); const bf16_t* rgb = (const bf16_t*)(c.ws + AB_RGB); bf16_t* ycat = (bf16_t*)(c.ws + WS_YCAT);
    LAS unsigned char* Kl = c.lds; LAS unsigned char* Bl = c.lds + 128 * 288;
    const int t0 = b * SEQ + n * 128; const float lg = log2f(1.f - exp2f(-5.f - (float)h));
    __syncthreads();
    const int t = t0 + 16 * w + fr, i = 16 * w + fr;
    bf16x8 qf[4];
    {
        const unsigned char* ksrc = (const unsigned char*)(rkb + (size_t)t0 * 512 + h * 128); const unsigned char* ssrc = (const unsigned char*)(sp + ((size_t)((b * 64 + n) * 4 + h)) * 256 * 128);
        u32x4 k4[4], s8[8];
#pragma unroll
        for (int q = 0; q < 4; ++q) { const int ii = c.tid + q * NTHREADS; k4[q] = *(const u32x4*)(ksrc + (size_t)(ii >> 4) * 1024 + (ii & 15) * 16); }
#pragma unroll
        for (int q = 0; q < 8; ++q) { const int ii = c.tid + q * NTHREADS; s8[q] = *(const u32x4*)(ssrc + (size_t)(ii >> 4) * 256 + (ii & 15) * 16); }
#pragma unroll
        for (int ks = 0; ks < 4; ++ks) qf[ks] = *(const bf16x8*)(rqb + (size_t)t * 512 + h * 128 + ks * 32 + fq * 8);
#pragma unroll
        for (int q = 0; q < 4; ++q) { const int ii = c.tid + q * NTHREADS; *(LAS u32x4*)(Kl + (ii >> 4) * 288 + (ii & 15) * 16) = k4[q]; }
#pragma unroll
        for (int q = 0; q < 8; ++q) { const int ii = c.tid + q * NTHREADS; *(LAS u32x4*)(Bl + (ii >> 4) * 288 + (ii & 15) * 16) = s8[q]; } }
    __syncthreads();
    bf16x8 pf[4];
#pragma unroll
    for (int kk = 0; kk < 4; ++kk) { f32x4 s2[2];
#pragma unroll
        for (int q = 0; q < 2; ++q) { const int nj = 2 * kk + q; s2[q] = (f32x4){0.f, 0.f, 0.f, 0.f};
            if (nj <= w) {
                bf16x8 kf[4];
#pragma unroll
                for (int ks = 0; ks < 4; ++ks) kf[ks] = *(const LAS bf16x8*)(Kl + (16 * nj + fr) * 288 + ks * 64 + fq * 16);
                __builtin_amdgcn_sched_barrier(0);
#pragma unroll
                for (int ks = 0; ks < 4; ++ks) s2[q] = MFMA16(kf[ks], qf[ks], s2[q]);
#pragma unroll
                for (int r = 0; r < 4; ++r) { const int jj = 16 * nj + 4 * fq + r; s2[q][r] = (i >= jj) ? s2[q][r] * __builtin_amdgcn_exp2f((float)(i - jj) * lg) : 0.f; } } }
        pf[kk] = pack8(s2[0], s2[1]); }
    f32x4 acc[16];
#pragma unroll
    for (int ne = 0; ne < 16; ne += 2) { bf16x8 sf[2][4];
#pragma unroll
        for (int u = 0; u < 2; ++u)
#pragma unroll
            for (int ks = 0; ks < 4; ++ks) sf[u][ks] = *(const LAS bf16x8*)(Bl + (16 * (ne + u) + fr) * 288 + ks * 64 + fq * 16);
        __builtin_amdgcn_sched_barrier(0);
#pragma unroll
        for (int u = 0; u < 2; ++u) { acc[ne + u] = (f32x4){0.f, 0.f, 0.f, 0.f};
#pragma unroll
            for (int ks = 0; ks < 4; ++ks) acc[ne + u] = MFMA16(sf[u][ks], qf[ks], acc[ne + u]); } }
    const float rs = exp2f((float)(i + 1) * lg);
#pragma unroll
    for (int ne = 0; ne < 16; ++ne) acc[ne] = acc[ne] * rs;
    __syncthreads();
    tile_g2l<256, 256, 16>(Bl, (const unsigned char*)(rvT + (size_t)(b * 4 + h) * 256 * SEQ + n * 128), (size_t)SEQ * 2, c.tid);
    __syncthreads();
    const int nkk = (w >> 1) + 1;
#pragma unroll
    for (int kk = 0; kk < 4; ++kk) if (kk < nkk) {
#pragma unroll
        for (int ne = 0; ne < 16; ne += 8) { u32x2 lo[8], hi[8];
#pragma unroll
            for (int u = 0; u < 8; ++u) { lo[u] = *(const LAS u32x2*)(Bl + (16 * (ne + u) + fr) * 272 + (32 * kk + 4 * fq) * 2); hi[u] = *(const LAS u32x2*)(Bl + (16 * (ne + u) + fr) * 272 + (32 * kk + 16 + 4 * fq) * 2); }
            __builtin_amdgcn_sched_barrier(0);
#pragma unroll
            for (int u = 0; u < 8; ++u) acc[ne + u] = MFMA16(cat8(lo[u], hi[u]), pf[kk], acc[ne + u]); } }
    u32x2 gpre[16];
#pragma unroll
    for (int ne = 0; ne < 16; ++ne) gpre[ne] = *(const u32x2*)(rgb + (size_t)t * 1024 + h * 256 + 16 * ne + 4 * fq);
    float sm = 0.f;
#pragma unroll
    for (int ne = 0; ne < 16; ++ne) sm += acc[ne][0] + acc[ne][1] + acc[ne][2] + acc[ne][3];
    sm = xrow_sum(sm);
    const float mean = sm * (1.f / 256.f); float sq = 0.f;
#pragma unroll
    for (int ne = 0; ne < 16; ++ne) { acc[ne] = acc[ne] - mean; sq += acc[ne][0] * acc[ne][0] + acc[ne][1] * acc[ne][1] + acc[ne][2] * acc[ne][2] + acc[ne][3] * acc[ne][3]; }
    sq = xrow_sum(sq);
    const float rstd = rsqrtf(sq * (1.f / 256.f) + LN_EPS);
#pragma unroll
    for (int ne = 0; ne < 16; ne += 2) { u32x2 o[2];
#pragma unroll
        for (int u = 0; u < 2; ++u) { const u32x2 gw = gpre[ne + u];
            const float g0 = __uint_as_float(gw[0] << 16), g1 = __uint_as_float(gw[0] & 0xffff0000u), g2 = __uint_as_float(gw[1] << 16), g3 = __uint_as_float(gw[1] & 0xffff0000u);
            o[u][0] = pk2(acc[ne + u][0] * rstd * g0, acc[ne + u][1] * rstd * g1); o[u][1] = pk2(acc[ne + u][2] * rstd * g2, acc[ne + u][3] * rstd * g3); }
        *(u32x4*)(ycat + (size_t)t * AB_OUT + 1024 + h * 256 + 16 * (ne + (fq & 1)) + 4 * (fq & 2)) = widen2(o[0], o[1]); }
}

__device__ __forceinline__ void phase_ab_p1(const Ctx& c) {
    for (int u = c.bid; u < 512; u += c.G) ret_kv_unit(c, u);
}
__device__ __forceinline__ void phase_ab_p2(const Ctx& c, int j) {
    ret_scan(c, 0, c.G);
    { const float* sinks = c.inp(3) + j * 16; for (int u = c.bid; u < 256; u += c.G) attn_unit(c, u, sinks); }
}
__device__ __forceinline__ void phase_ab_p3(const Ctx& c) {
    for (int u = c.bid; u < 512; u += c.G) ret_out_unit(c, u);
}

__device__ __forceinline__ float gelu_fast(float x) { const float u = 1.5957691216057308f * (x + 0.044715f * x * x * x); return x * __builtin_amdgcn_rcpf(1.f + __expf(-u)); }
struct EpiCDIn {
    static constexpr bool PERM = true;
    LAS bf16_t* biasL; unsigned char* ws;
    __device__ __forceinline__ void init(f32x4 (&acc)[2][2][4][2], const g8::Unit& u, int wc, int fq) const {
        const int colp = u.pn * 256 + wc * 32 + fq * 8;
#pragma unroll
        for (int b = 0; b < 2; ++b)
#pragma unroll
            for (int n = 0; n < 2; ++n) { const u32x2 bw = *(const LAS u32x2*)(biasL + colp + b * 128 + 4 * n);
                const f32x4 bv = (f32x4){__uint_as_float(bw[0] << 16), __uint_as_float(bw[0] & 0xffff0000u), __uint_as_float(bw[1] << 16), __uint_as_float(bw[1] & 0xffff0000u)};
#pragma unroll
                for (int a = 0; a < 2; ++a)
#pragma unroll
                    for (int m = 0; m < 4; ++m) acc[a][b][m][n] = bv; } }
    __device__ __forceinline__ void operator()(const f32x4 (&acc)[2][2][4][2], const g8::Unit& u, int wr, int wc, int fr, int fq) const {
        const int pn = u.pn; const int col0 = pn * 256 + wc * 32 + fq * 8;
        bf16_t* gu = (bf16_t*)(ws + CD_GU); bf16_t* gvT = (bf16_t*)(ws + CD_GVT); bf16_t* gg = (bf16_t*)(ws + CD_GG); bf16_t* xr = (bf16_t*)(ws + CD_XR); float* stats = (float*)(ws + CD_STATS);
#pragma unroll
        for (int ai = 0; ai < 2; ++ai)
#pragma unroll
            for (int m = 0; m < 4; ++m) {
                const int t = u.pm * 256 + ai * 128 + wr * 64 + m * 16 + fr, sq = t & (SEQ - 1), b = t >> 13;
                f32x4 x[2][2];
#pragma unroll
                for (int bj = 0; bj < 2; ++bj)
#pragma unroll
                    for (int n = 0; n < 2; ++n) { x[bj][n] = acc[ai][bj][m][n];
                        if (pn < 13) {
                            x[bj][n] = gelu4(x[bj][n]); } }
                if (pn >= 4 && pn < 8) {
                    float s1 = 0.f, s2 = 0.f;
#pragma unroll
                    for (int bj = 0; bj < 2; ++bj)
#pragma unroll
                        for (int n = 0; n < 2; ++n)
#pragma unroll
                            for (int e = 0; e < 4; ++e) { const float v = x[bj][n][e]; s1 += v; s2 += v * v;
                                st_bf16_off((unsigned char*)gvT, (unsigned)(((b * 1024 + (pn - 4) * 256 + bj * 128 + wc * 32 + fq * 8 + 4 * n + e) * SEQ + sq) * 2), v); }
                    s1 = xrow_sum(s1); s2 = xrow_sum(s2);
                    if (fq == 0) *(f32x2*)(stats + (size_t)t * 32 + ((pn - 4) * 4 + wc) * 2) = (f32x2){s1, s2};
                } else {
                    bf16_t* dst; int ld, cb;
                    if (pn < 4) { dst = gu; ld = 1024; cb = pn * 256; } else if (pn < 13) { dst = gg; ld = 1280; cb = (pn - 8) * 256; } else { dst = xr; ld = 1280; cb = (pn - 13) * 256; }
#pragma unroll
                    for (int bj = 0; bj < 2; ++bj) { u32x4 w;
#pragma unroll
                        for (int n = 0; n < 2; ++n) { w[2 * n] = pk2(x[bj][n][0], x[bj][n][1]); w[2 * n + 1] = pk2(x[bj][n][2], x[bj][n][3]); }
                        *(u32x4*)(dst + (size_t)t * ld + cb + bj * 128 + wc * 32 + fq * 8) = w; }
                }
            }
    }
};
__device__ __forceinline__ void phase_cd_inproj(const Ctx& c, int j) {
    g8::DenseOrder S; S.init(c.ws + WS_XB, c.ws + WS_WCDIN + (size_t)j * CD_IN * D * 2, T, CD_IN, D, c.G, c.bid); S.tid0 = c.tid;
    LAS bf16_t* biasL = (LAS bf16_t*)(c.lds + LDS_TAB);
    { const float* bp = c.inp(7) + (size_t)j * CD_IN; float bvv[9];
#pragma unroll
      for (int q = 0; q < 9; ++q) { const int i = c.tid + q * NTHREADS; bvv[q] = 0.f; if (i < CD_IN) bvv[q] = bp[i]; }
#pragma unroll
      for (int q = 0; q < 9; ++q) { const int i = c.tid + q * NTHREADS; if (i < CD_IN) biasL[i] = f2bf(bvv[q]); } }
    __syncthreads();
    EpiCDIn E{biasL, c.ws};
    g8::gemm_phase<EpiCDIn, g8::DenseOrder>(c.lds + LDS_STAGE, D, S, E);
}

__device__ __forceinline__ void lru_unit(const Ctx& c, int unit, int j) {
    const int hh = unit % 5, bn = unit / 5, lane = c.lane, fr = lane & 15, fq = lane >> 4, w = c.wid;
    const int t0 = bn * 128, s0 = t0 & (SEQ - 1);
    const bf16_t* xr = (const bf16_t*)(c.ws + CD_XR); bf16_t* HL = (bf16_t*)(c.ws + WS_U2); bf16_t* PC = HL + (size_t)T * 1280; float* sum = (float*)(c.ws + WS_H);
    const float* conv_w = c.inp(10) + (size_t)j * 4 * 1280 + hh * 256; const float* conv_b = c.inp(11) + (size_t)j * 1280 + hh * 256;
    const float* ba = c.inp(13) + (size_t)j * 1280 + hh * 256; const float* bx = c.inp(15) + (size_t)j * 1280 + hh * 256; const float* spl = (const float*)(c.ws + WS_SPL) + (size_t)j * 1280 + hh * 256;
    const bf16_t* Wl = (const bf16_t*)(c.ws + WS_WLRU) + (size_t)((j * 5 + hh) * 2) * 65536;
    LAS unsigned char* Xc = c.lds; LAS unsigned char* Wa = c.lds + 128 * 544; LAS unsigned char* Wx = Wa + 64 * 544; LAS unsigned char* Tot = Wx + 64 * 544; LAS float* Bl = (LAS float*)(Tot + 4096);
    __syncthreads();
    f32x4 blv = (f32x4){0.f, 0.f, 0.f, 0.f};
    if (c.tid < 192) { const int which = c.tid >> 6, i4 = (c.tid & 63) * 4; const float* srcp = which == 0 ? ba : (which == 1 ? bx : spl); blv = *(const f32x4*)(srcp + i4); }
    {
        const int cg = c.tid & 31, r0 = (c.tid >> 5) * 8;
        float wv[4][8], bv8[8];
        { const f32x4 b0 = *(const f32x4*)(conv_b + cg * 8), b1 = *(const f32x4*)(conv_b + cg * 8 + 4); bv8[0] = b0[0]; bv8[1] = b0[1]; bv8[2] = b0[2]; bv8[3] = b0[3]; bv8[4] = b1[0]; bv8[5] = b1[1]; bv8[6] = b1[2]; bv8[7] = b1[3]; }
#pragma unroll
        for (int k = 0; k < 4; ++k) { const f32x4 w0 = *(const f32x4*)(conv_w + k * 1280 + cg * 8), w1 = *(const f32x4*)(conv_w + k * 1280 + cg * 8 + 4);
            wv[k][0] = w0[0]; wv[k][1] = w0[1]; wv[k][2] = w0[2]; wv[k][3] = w0[3]; wv[k][4] = w1[0]; wv[k][5] = w1[1]; wv[k][6] = w1[2]; wv[k][7] = w1[3]; }
        u32x4 xin[11];
#pragma unroll
        for (int q = 0; q < 11; ++q) { xin[q] = (u32x4){0u, 0u, 0u, 0u}; if (s0 + r0 - 3 + q >= 0) xin[q] = *(const u32x4*)(xr + (size_t)(t0 + r0 - 3 + q) * 1280 + hh * 256 + cg * 8); }
#pragma unroll
        for (int rr = 0; rr < 8; ++rr) { float a[8];
#pragma unroll
            for (int e = 0; e < 8; ++e) a[e] = bv8[e];
#pragma unroll
            for (int k = 0; k < 4; ++k) { const u32x4 xv = xin[rr + k];
#pragma unroll
                for (int e2 = 0; e2 < 4; ++e2) { a[2 * e2] += wv[k][2 * e2] * __uint_as_float(xv[e2] << 16); a[2 * e2 + 1] += wv[k][2 * e2 + 1] * __uint_as_float(xv[e2] & 0xffff0000u); } }
            u32x4 o; o[0] = pk2(a[0], a[1]); o[1] = pk2(a[2], a[3]); o[2] = pk2(a[4], a[5]); o[3] = pk2(a[6], a[7]);
            *(LAS u32x4*)(Xc + (r0 + rr) * 544 + cg * 16) = o; }
    }
    u32x4 wreg[8];
#pragma unroll
    for (int q = 0; q < 4; ++q) { const int i = c.tid + q * NTHREADS, r = i >> 5, cc = i & 31; wreg[q] = *(const u32x4*)((const unsigned char*)Wl + (size_t)r * 512 + cc * 16); wreg[4 + q] = *(const u32x4*)((const unsigned char*)(Wl + 65536) + (size_t)r * 512 + cc * 16); }
    if (c.tid < 192) { const int which = c.tid >> 6, i4 = (c.tid & 63) * 4; *(LAS f32x4*)(Bl + which * 256 + i4) = blv; }
    __syncthreads();
    bf16x8 xf[8];
#pragma unroll
    for (int ks = 0; ks < 8; ++ks) xf[ks] = *(const LAS bf16x8*)(Xc + (16 * w + fr) * 544 + ks * 64 + fq * 16);
    const int t = t0 + 16 * w + fr;
    for (int sl = 0; sl < 4; ++sl) {
        if (sl) __syncthreads();
#pragma unroll
        for (int q = 0; q < 4; ++q) { const int i = c.tid + q * NTHREADS, r = i >> 5, cc = i & 31; *(LAS u32x4*)(Wa + r * 544 + cc * 16) = wreg[q]; *(LAS u32x4*)(Wx + r * 544 + cc * 16) = wreg[4 + q]; }
        if (sl < 3) {
#pragma unroll
            for (int q = 0; q < 4; ++q) { const int i = c.tid + q * NTHREADS, r = i >> 5, cc = i & 31;
                wreg[q] = *(const u32x4*)((const unsigned char*)(Wl + (size_t)((sl + 1) * 64) * 256) + (size_t)r * 512 + cc * 16); wreg[4 + q] = *(const u32x4*)((const unsigned char*)(Wl + 65536 + (size_t)((sl + 1) * 64) * 256) + (size_t)r * 512 + cc * 16); } }
        __syncthreads();
        f32x4 sA[4], sB[4];
#pragma unroll
        for (int nc = 0; nc < 4; ++nc) { f32x4 ra = (f32x4){0.f, 0.f, 0.f, 0.f}, ri = ra;
            bf16x8 waf[8], wxf[8];
#pragma unroll
            for (int ks = 0; ks < 8; ++ks) { waf[ks] = *(const LAS bf16x8*)(Wa + (16 * nc + fr) * 544 + ks * 64 + fq * 16); wxf[ks] = *(const LAS bf16x8*)(Wx + (16 * nc + fr) * 544 + ks * 64 + fq * 16); }
            const int ch = sl * 64 + 16 * nc + 4 * fq;
            const f32x4 b_a = *(const LAS f32x4*)(Bl + ch), b_x = *(const LAS f32x4*)(Bl + 256 + ch), sp = *(const LAS f32x4*)(Bl + 512 + ch);
            const u32x2 xw = *(const LAS u32x2*)(Xc + (16 * w + fr) * 544 + ch * 2);
            __builtin_amdgcn_sched_barrier(0);
#pragma unroll
            for (int ks = 0; ks < 8; ++ks) { ra = MFMA16(waf[ks], xf[ks], ra); ri = MFMA16(wxf[ks], xf[ks], ri); }
            const float xcv[4] = {__uint_as_float(xw[0] << 16), __uint_as_float(xw[0] & 0xffff0000u), __uint_as_float(xw[1] << 16), __uint_as_float(xw[1] & 0xffff0000u)};
            f32x4 oa, ob;
#pragma unroll
            for (int r = 0; r < 4; ++r) { const float gr = __builtin_amdgcn_rcpf(1.f + __expf(-(ra[r] + b_a[r]))), gi = __builtin_amdgcn_rcpf(1.f + __expf(-(ri[r] + b_x[r]))); const float la = -8.f * gr * sp[r]; const float a = __expf(la);
                oa[r] = a; ob[r] = __builtin_amdgcn_sqrtf(fmaxf(1.f - a * a, 0.f)) * (gi * xcv[r]); }
            sA[nc] = oa; sB[nc] = ob;
        }
#define LRU_SCAN_STEP(DD) do { _Pragma("unroll") for (int nc = 0; nc < 4; ++nc) _Pragma("unroll") for (int r = 0; r < 4; ++r) { float a_ = sA[nc][r], b_ = sB[nc][r]; \
            asm volatile("s_nop 1\n\tv_fmac_f32_dpp %0, %0, %1 row_shr:" #DD " row_mask:0xf bank_mask:0xf\n\tv_mul_f32_dpp %1, %1, %1 row_shr:" #DD " row_mask:0xf bank_mask:0xf" : "+v"(b_), "+v"(a_)); \
            sA[nc][r] = a_; sB[nc][r] = b_; } } while (0)
        LRU_SCAN_STEP(1); LRU_SCAN_STEP(2); LRU_SCAN_STEP(4); LRU_SCAN_STEP(8);
#undef LRU_SCAN_STEP
        if (fr == 15) {
#pragma unroll
            for (int nc = 0; nc < 4; ++nc) { *(LAS f32x4*)(Tot + ((w * 64 + 16 * nc + 4 * fq) * 2) * 4) = sA[nc]; *(LAS f32x4*)(Tot + ((w * 64 + 16 * nc + 4 * fq) * 2 + 4) * 4) = sB[nc]; } }
        __syncthreads();
#pragma unroll
        for (int nc = 0; nc < 4; ++nc) { const int ch = sl * 64 + 16 * nc + 4 * fq;
            f32x4 cp = (f32x4){1.f, 1.f, 1.f, 1.f}, chh = (f32x4){0.f, 0.f, 0.f, 0.f};
            f32x4 ta[7], tb[7];
#pragma unroll
            for (int w2 = 0; w2 < 7; ++w2) { ta[w2] = *(const LAS f32x4*)(Tot + ((w2 * 64 + 16 * nc + 4 * fq) * 2) * 4); tb[w2] = *(const LAS f32x4*)(Tot + ((w2 * 64 + 16 * nc + 4 * fq) * 2 + 4) * 4); }
#pragma unroll
            for (int w2 = 0; w2 < 7; ++w2) if (w2 < w) { chh = ta[w2] * chh + tb[w2]; cp = cp * ta[w2]; }
            const f32x4 hl = sB[nc] + sA[nc] * chh, pc = sA[nc] * cp;
            u32x2 o1, o2; o1[0] = pk2(hl[0], hl[1]); o1[1] = pk2(hl[2], hl[3]); o2[0] = pk2(pc[0], pc[1]); o2[1] = pk2(pc[2], pc[3]);
            *(u32x2*)(HL + (size_t)t * 1280 + hh * 256 + ch) = o1; *(u32x2*)(PC + (size_t)t * 1280 + hh * 256 + ch) = o2;
            if (w == 7 && fr == 15) { float* sm = sum + ((size_t)bn * 1280 + hh * 256 + ch) * 2;
#pragma unroll
                for (int r = 0; r < 4; ++r) { sm[2 * r] = pc[r]; sm[2 * r + 1] = hl[r]; } } }
    }
}

__device__ __forceinline__ void sgu_unit(const Ctx& c, int unit, int j) {
    const int g = unit & 3, bn = unit >> 2, b = bn >> 6, n = bn & 63, lane = c.lane, fr = lane & 15, fq = lane >> 4, w = c.wid;
    const int t0 = bn * 128;
    const bf16_t* gu = (const bf16_t*)(c.ws + CD_GU); const bf16_t* gvT = (const bf16_t*)(c.ws + CD_GVT); const float* stats = (const float*)(c.ws + CD_STATS); bf16_t* ycat = (bf16_t*)(c.ws + WS_YCAT);
    const float* sw = c.inp(8) + (size_t)(j * 4 + g) * 16384; const float* sb = c.inp(9) + (size_t)(j * 4 + g) * 128;
    LAS unsigned char* Vt = c.lds; LAS float* mr = (LAS float*)(c.lds + 256 * 288);
    __syncthreads();
    const int i = 16 * w + fr, t = t0 + i, nks = (w >> 1) + 1;
    u32x4 tv[8];
    { const unsigned char* vsrc = (const unsigned char*)(gvT + ((size_t)b * 1024 + g * 256) * SEQ + n * 128);
#pragma unroll
      for (int q = 0; q < 8; ++q) { const int ii = c.tid + q * NTHREADS; tv[q] = *(const u32x4*)(vsrc + (size_t)(ii >> 4) * SEQ * 2 + (ii & 15) * 16); } }
    f32x4 sv[8];
#pragma unroll
    for (int q = 0; q < 8; ++q) sv[q] = (f32x4){0.f, 0.f, 0.f, 0.f};
    if (c.tid < 128) { const f32x4* st = (const f32x4*)(stats + (size_t)(t0 + c.tid) * 32);
#pragma unroll
        for (int q = 0; q < 8; ++q) sv[q] = st[q]; }
    f32x4 swp[4][2];
#pragma unroll
    for (int ks = 0; ks < 4; ++ks) { swp[ks][0] = (f32x4){0.f, 0.f, 0.f, 0.f}; swp[ks][1] = swp[ks][0];
        if (ks < nks) { const int j0 = ks * 32 + fq * 8; swp[ks][0] = *(const f32x4*)(sw + (size_t)i * 128 + j0); swp[ks][1] = *(const f32x4*)(sw + (size_t)i * 128 + j0 + 4); } }
    const float sbi = sb[i];
#pragma unroll
    for (int q = 0; q < 8; ++q) { const int ii = c.tid + q * NTHREADS; *(LAS u32x4*)(Vt + (ii >> 4) * 288 + (ii & 15) * 16) = tv[q]; }
    if (c.tid < 128) { float s1 = 0.f, s2 = 0.f;
#pragma unroll
        for (int q = 0; q < 8; ++q) { s1 += sv[q][0] + sv[q][2]; s2 += sv[q][1] + sv[q][3]; }
        const float mean = s1 * (1.f / 1024.f), var = fmaxf(s2 * (1.f / 1024.f) - mean * mean, 0.f); mr[2 * c.tid] = mean; mr[2 * c.tid + 1] = rsqrtf(var + LN_EPS); }
    __syncthreads();
    bf16x8 wf[4]; float ci = 0.f;
#pragma unroll
    for (int ks = 0; ks < 4; ++ks) { f32x4 lo = (f32x4){0.f, 0.f, 0.f, 0.f}, hi = lo;
        if (ks < nks) { const int j0 = ks * 32 + fq * 8; const f32x4 w0 = swp[ks][0], w1 = swp[ks][1];
#pragma unroll
            for (int e = 0; e < 4; ++e) { const float m0 = mr[2 * (j0 + e)], r0 = mr[2 * (j0 + e) + 1], m1 = mr[2 * (j0 + 4 + e)], r1 = mr[2 * (j0 + 4 + e) + 1];
                lo[e] = (j0 + e <= i) ? w0[e] * r0 : 0.f; hi[e] = (j0 + 4 + e <= i) ? w1[e] * r1 : 0.f; ci += lo[e] * m0 + hi[e] * m1; } }
        wf[ks] = pack8(lo, hi); }
    ci = xrow_sum(ci);
    const float add = sbi - ci;
    u32x2 upre[16];
#pragma unroll
    for (int nd = 0; nd < 16; ++nd) upre[nd] = *(const u32x2*)(gu + (size_t)t * 1024 + g * 256 + 16 * nd + 4 * fq);
    f32x4 acc[16];
#pragma unroll
    for (int nd = 0; nd < 16; nd += 2) { bf16x8 vf[2][4];
#pragma unroll
        for (int u = 0; u < 2; ++u)
#pragma unroll
            for (int ks = 0; ks < 4; ++ks) if (ks < nks) vf[u][ks] = *(const LAS bf16x8*)(Vt + (16 * (nd + u) + fr) * 288 + ks * 64 + fq * 16);
        __builtin_amdgcn_sched_barrier(0);
#pragma unroll
        for (int u = 0; u < 2; ++u) { acc[nd + u] = (f32x4){0.f, 0.f, 0.f, 0.f};
#pragma unroll
            for (int ks = 0; ks < 4; ++ks) if (ks < nks) acc[nd + u] = MFMA16(vf[u][ks], wf[ks], acc[nd + u]); } }
#pragma unroll
    for (int nd = 0; nd < 16; nd += 2) { u32x2 o[2];
#pragma unroll
        for (int q = 0; q < 2; ++q) { const u32x2 uw = upre[nd + q];
            const float u0 = __uint_as_float(uw[0] << 16), u1 = __uint_as_float(uw[0] & 0xffff0000u), u2 = __uint_as_float(uw[1] << 16), u3 = __uint_as_float(uw[1] & 0xffff0000u);
            o[q][0] = pk2(u0 * (acc[nd + q][0] + add), u1 * (acc[nd + q][1] + add)); o[q][1] = pk2(u2 * (acc[nd + q][2] + add), u3 * (acc[nd + q][3] + add)); }
        *(u32x4*)(ycat + (size_t)t * CD_OUT + g * 256 + 16 * (nd + (fq & 1)) + 4 * (fq & 2)) = widen2(o[0], o[1]); }
}
__device__ __forceinline__ void phase_cd_p1(const Ctx& c, int j) {
    for (int u = c.bid; u < 640; u += c.G) lru_unit(c, u, j);
    if (c.G == 256) {
        if (c.bid < 128) sgu_unit(c, c.bid, j);
        else { for (int q = 0; q < 3; ++q) sgu_unit(c, 128 + (c.bid - 128) * 3 + q, j); }
    } else { for (int u = c.bid; u < 512; u += c.G) sgu_unit(c, u, j); }
}

__device__ __forceinline__ void phase_cd_scan2(const Ctx& c) {
    const bf16_t* gg = (const bf16_t*)(c.ws + CD_GG); bf16_t* ycat = (bf16_t*)(c.ws + WS_YCAT);
    const bf16_t* HL = (const bf16_t*)(c.ws + WS_U2); const bf16_t* PC = HL + (size_t)T * 1280; const float* sum = (const float*)(c.ws + WS_H);
    LAS float* carry = (LAS float*)c.lds;
    for (int u = c.bid; u < 256; u += c.G) {
        const int bn = u >> 1, half = u & 1, b = bn >> 6, n = bn & 63;
        __syncthreads();
        {
            LAS float* part = carry + 1280;
#pragma unroll 1
            for (int k0 = 0; k0 < 10; k0 += 5) {
                f32x2 v[5][16];
#pragma unroll
                for (int k = 0; k < 5; ++k) { const int it = c.tid + (k0 + k) * NTHREADS; const int seg = it / 1280, ch = it % 1280; const float* sp = sum + ((size_t)(b * 64 + seg * 16) * 1280 + ch) * 2;
#pragma unroll
                    for (int q = 0; q < 16; ++q) { v[k][q] = (f32x2){1.f, 0.f}; if (seg * 16 + q < n) v[k][q] = *(const f32x2*)(sp + (size_t)q * 2560); } }
#pragma unroll
                for (int k = 0; k < 5; ++k) { const int it = c.tid + (k0 + k) * NTHREADS; const int seg = it / 1280, ch = it % 1280;
                    float A = 1.f, Bv = 0.f;
#pragma unroll
                    for (int q = 0; q < 16; ++q) { Bv = v[k][q][0] * Bv + v[k][q][1]; A *= v[k][q][0]; }
                    part[(seg * 1280 + ch) * 2] = A; part[(seg * 1280 + ch) * 2 + 1] = Bv; } }
            __syncthreads();
            for (int ch = c.tid; ch < 1280; ch += NTHREADS) { float cr = 0.f;
#pragma unroll
                for (int seg = 0; seg < 4; ++seg) cr = part[(seg * 1280 + ch) * 2] * cr + part[(seg * 1280 + ch) * 2 + 1];
                carry[ch] = cr; }
        }
        __syncthreads();
        const size_t t0 = (size_t)bn * 128 + half * 64;
        for (int it0 = c.tid; it0 < 64 * 320; it0 += 20 * NTHREADS) {
            u32x2 hw[20], pw[20], gw[20];
#pragma unroll
            for (int q = 0; q < 20; ++q) { const int it = it0 + q * NTHREADS; const int r = it / 320, c4 = (it % 320) * 4; const size_t o = (t0 + r) * 1280 + c4; hw[q] = *(const u32x2*)(HL + o); pw[q] = *(const u32x2*)(PC + o); gw[q] = *(const u32x2*)(gg + o); }
#pragma unroll
            for (int q = 0; q < 20; ++q) { const int it = it0 + q * NTHREADS; const int r = it / 320, c4 = (it % 320) * 4; const f32x4 cr = *(const LAS f32x4*)(carry + c4);
                const float h0 = __uint_as_float(hw[q][0] << 16) + __uint_as_float(pw[q][0] << 16) * cr[0], h1 = __uint_as_float(hw[q][0] & 0xffff0000u) + __uint_as_float(pw[q][0] & 0xffff0000u) * cr[1];
                const float h2 = __uint_as_float(hw[q][1] << 16) + __uint_as_float(pw[q][1] << 16) * cr[2], h3 = __uint_as_float(hw[q][1] & 0xffff0000u) + __uint_as_float(pw[q][1] & 0xffff0000u) * cr[3];
                u32x2 ow; ow[0] = pk2(__uint_as_float(gw[q][0] << 16) * h0, __uint_as_float(gw[q][0] & 0xffff0000u) * h1); ow[1] = pk2(__uint_as_float(gw[q][1] << 16) * h2, __uint_as_float(gw[q][1] & 0xffff0000u) * h3);
                *(u32x2*)(ycat + (t0 + r) * CD_OUT + 1024 + c4) = ow; } }
    }
}

__device__ __forceinline__ void phase_ln_moe(const Ctx& c, const float* g, const float* bta, float* xout) {
    typedef float f32x2v __attribute__((ext_vector_type(2)));
    bf16_t* xb = (bf16_t*)(c.ws + WS_XB); const unsigned char* Y = (const unsigned char*)(c.ws + WS_U1);
    f32x4 gpre[2][2], bpre[2][2];
#pragma unroll
    for (int q = 0; q < 2; ++q)
#pragma unroll
        for (int h2 = 0; h2 < 2; ++h2) { gpre[q][h2] = *(const f32x4*)(g + q * 512 + c.lane * 8 + 4 * h2); bpre[q][h2] = *(const f32x4*)(bta + q * 512 + c.lane * 8 + 4 * h2); }
    for (long tt = (long)c.gw * 2; tt < T; tt += (long)c.nwaves * 2) {
        float v[2][2][8];
#pragma unroll
        for (int u = 0; u < 2; ++u) { const long t = tt + u;
#pragma unroll
            for (int q = 0; q < 2; ++q) { const int col = q * 512 + c.lane * 8;
                float f[8];
#pragma unroll
                for (int e = 0; e < 8; ++e) f[e] = 0.f;
#pragma unroll
                for (int k = 0; k < 8; ++k) { const size_t srow = (size_t)t * 8 + k; const u32x2 w = *(const u32x2*)(Y + srow * D + col);
#pragma unroll
                    for (int h2 = 0; h2 < 2; ++h2) { const f32x2v a = __builtin_amdgcn_cvt_pk_f32_fp8(w[h2], false), b = __builtin_amdgcn_cvt_pk_f32_fp8(w[h2], true);
                        f[4 * h2] += a[0]; f[4 * h2 + 1] += a[1]; f[4 * h2 + 2] += b[0]; f[4 * h2 + 3] += b[1]; } }
                const u32x4 xw = *(const u32x4*)(xb + (size_t)t * D + col), sw = *(const u32x4*)((const bf16_t*)(Y + (size_t)TK * D) + (size_t)t * D + col);
#pragma unroll
                for (int e2 = 0; e2 < 4; ++e2) { v[u][q][2 * e2] = __uint_as_float(xw[e2] << 16) * ALPHA + f[2 * e2] * (1.f / 64.f) + __uint_as_float(sw[e2] << 16);
                    v[u][q][2 * e2 + 1] = __uint_as_float(xw[e2] & 0xffff0000u) * ALPHA + f[2 * e2 + 1] * (1.f / 64.f) + __uint_as_float(sw[e2] & 0xffff0000u); } } }
#pragma unroll
        for (int u = 0; u < 2; ++u) { const long t = tt + u;
            float sm = 0.f;
#pragma unroll
            for (int q = 0; q < 2; ++q)
#pragma unroll
                for (int e = 0; e < 8; ++e) sm += v[u][q][e];
            const float mean = wave_sum(sm) * (1.f / 1024.f); float sq = 0.f;
#pragma unroll
            for (int q = 0; q < 2; ++q)
#pragma unroll
                for (int e = 0; e < 8; ++e) { v[u][q][e] -= mean; sq += v[u][q][e] * v[u][q][e]; }
            const float rstd = rsqrtf(wave_sum(sq) * (1.f / 1024.f) + LN_EPS);
#pragma unroll
            for (int q = 0; q < 2; ++q) { const int col = q * 512 + c.lane * 8; float o[8];
#pragma unroll
                for (int h2 = 0; h2 < 2; ++h2) { const f32x4 gg = gpre[q][h2], bb = bpre[q][h2];
#pragma unroll
                    for (int e = 0; e < 4; ++e) o[4 * h2 + e] = v[u][q][4 * h2 + e] * rstd * gg[e] + bb[e];
                    if (xout) *(f32x4*)(xout + (size_t)t * D + col + 4 * h2) = (f32x4){o[4 * h2], o[4 * h2 + 1], o[4 * h2 + 2], o[4 * h2 + 3]}; }
                u32x4 w; w[0] = pk2(o[0], o[1]); w[1] = pk2(o[2], o[3]); w[2] = pk2(o[4], o[5]); w[3] = pk2(o[6], o[7]); *(u32x4*)(xb + (size_t)t * D + col) = w; } }
    }
}

__device__ __forceinline__ unsigned sortable_u32(float f) { const unsigned b = __float_as_uint(f); return b ^ ((b >> 31) ? 0xffffffffu : 0x80000000u); }
__device__ __forceinline__ int popc64(unsigned long long m) { return __builtin_popcountll(m); }
__device__ __forceinline__ int rank_lt(unsigned long long m) { return (int)__builtin_amdgcn_mbcnt_hi((unsigned)(m >> 32), __builtin_amdgcn_mbcnt_lo((unsigned)m, 0u)); }
__device__ __forceinline__ void phase_ln_route(const Ctx& c, int L) {
    bf16_t* xb = (bf16_t*)(c.ws + WS_XB); const bf16_t* hbuf = (const bf16_t*)(c.ws + WS_HB);
    const float* g = c.inp(19) + (size_t)L * D; const float* bta = c.inp(20) + (size_t)L * D; const float* rb = c.inp(22) + L * NE;
    const bf16_t* Wr = (const bf16_t*)(c.ws + WS_WRT) + (size_t)L * 256 * D;
    int* cnt = (int*)(c.ws + CTL_CNT) + L * NE * 32; int* list = (int*)(c.ws + WS_LIST); float* gate = (float*)(c.ws + WS_GATE);
    LAS unsigned char* Xl = c.lds; LAS unsigned char* Wq = c.lds + 64 * 544;
    LAS float* Sc = (LAS float*)Wq;
    LAS int* hist = (LAS int*)(Wq + 32768); LAS int* gbase = hist + 128; LAS int* sel = gbase + 128; LAS float* selg = (LAS float*)(sel + 512);
    const int lane = c.lane, fr = lane & 15, fq = lane >> 4, w = c.wid;
    f32x4 gpre[4], bpre[4];
#pragma unroll
    for (int q = 0; q < 4; ++q) { gpre[q] = *(const f32x4*)(g + q * 256 + lane * 4); bpre[q] = *(const f32x4*)(bta + q * 256 + lane * 4); }
    const float rb0 = rb[lane], rb1 = rb[64 + lane];
    for (int grp = c.bid; grp < T / 64; grp += c.G) {
        __syncthreads();
        u32x2 nb[8][4];
#pragma unroll
        for (int hb = 0; hb < 2; ++hb) {
            u32x2 xw[4][4], hw[4][4];
#pragma unroll
            for (int i = 0; i < 4; ++i) { const size_t t = (size_t)grp * 64 + hb * 32 + w * 4 + i;
#pragma unroll
                for (int q = 0; q < 4; ++q) { const int col = q * 256 + lane * 4; xw[i][q] = *(const u32x2*)(xb + t * D + col); hw[i][q] = *(const u32x2*)(hbuf + t * D + col); } }
#pragma unroll
            for (int i = 0; i < 4; ++i) { const size_t t = (size_t)grp * 64 + hb * 32 + w * 4 + i;
                f32x4 v[4]; float sm = 0.f;
#pragma unroll
                for (int q = 0; q < 4; ++q) { v[q] = (f32x4){__uint_as_float(xw[i][q][0] << 16), __uint_as_float(xw[i][q][0] & 0xffff0000u), __uint_as_float(xw[i][q][1] << 16), __uint_as_float(xw[i][q][1] & 0xffff0000u)} * ALPHA
                         + (f32x4){__uint_as_float(hw[i][q][0] << 16), __uint_as_float(hw[i][q][0] & 0xffff0000u), __uint_as_float(hw[i][q][1] << 16), __uint_as_float(hw[i][q][1] & 0xffff0000u)};
                    sm += v[q][0] + v[q][1] + v[q][2] + v[q][3]; }
                const float mean = wave_sum(sm) * (1.f / 1024.f); float sq = 0.f;
#pragma unroll
                for (int q = 0; q < 4; ++q) { v[q] = v[q] - mean; sq += v[q][0] * v[q][0] + v[q][1] * v[q][1] + v[q][2] * v[q][2] + v[q][3] * v[q][3]; }
                const float rstd = rsqrtf(wave_sum(sq) * (1.f / 1024.f) + LN_EPS);
#pragma unroll
                for (int q = 0; q < 4; ++q) { const f32x4 o = v[q] * rstd * gpre[q] + bpre[q]; nb[hb * 4 + i][q][0] = pk2(o[0], o[1]); nb[hb * 4 + i][q][1] = pk2(o[2], o[3]);
                    *(u32x2*)(xb + t * D + q * 256 + lane * 4) = nb[hb * 4 + i][q]; } }
        }
        f32x4 lg[2][2];
        const int st = w & 1, eg = w >> 1;
        lg[0][0] = (f32x4){0.f, 0.f, 0.f, 0.f}; lg[0][1] = lg[0][0]; lg[1][0] = lg[0][0]; lg[1][1] = lg[0][0];
        u32x4 wreg[8];
#pragma unroll
        for (int q = 0; q < 8; ++q) { const int i = c.tid + q * NTHREADS, r = i >> 5, cc = i & 31; wreg[q] = *(const u32x4*)((const unsigned char*)Wr + (size_t)r * 2048 + cc * 16); }
#pragma unroll
        for (int kq = 0; kq < 4; ++kq) {
            if (kq) __syncthreads();
#pragma unroll
            for (int q = 0; q < 8; ++q) { const int i = c.tid + q * NTHREADS, r = i >> 5, cc = i & 31; *(LAS u32x4*)(Wq + r * 544 + cc * 16) = wreg[q]; }
#pragma unroll
            for (int u = 0; u < 8; ++u) *(LAS u32x2*)(Xl + ((u >> 2) * 32 + w * 4 + (u & 3)) * 544 + lane * 8) = nb[u][kq];
            if (kq < 3) {
#pragma unroll
                for (int q = 0; q < 8; ++q) { const int i = c.tid + q * NTHREADS, r = i >> 5, cc = i & 31; wreg[q] = *(const u32x4*)((const unsigned char*)Wr + (size_t)r * 2048 + (kq + 1) * 512 + cc * 16); } }
            __syncthreads();
#pragma unroll
            for (int k4 = 0; k4 < 8; k4 += 2) { bf16x8 bop[2][2], aop[2][2];
#pragma unroll
                for (int u = 0; u < 2; ++u) { const int ks = k4 + u;
#pragma unroll
                    for (int p2 = 0; p2 < 2; ++p2) bop[p2][u] = *(const LAS bf16x8*)(Xl + (p2 * 32 + 16 * st + fr) * 544 + ks * 64 + fq * 16);
#pragma unroll
                    for (int ne2 = 0; ne2 < 2; ++ne2) aop[u][ne2] = *(const LAS bf16x8*)(Wq + (32 * eg + 16 * ne2 + fr) * 544 + ks * 64 + fq * 16); }
                __builtin_amdgcn_sched_barrier(0);
#pragma unroll
                for (int u = 0; u < 2; ++u)
#pragma unroll
                    for (int p2 = 0; p2 < 2; ++p2)
#pragma unroll
                        for (int ne2 = 0; ne2 < 2; ++ne2) lg[p2][ne2] = MFMA16(aop[u][ne2], bop[p2][u], lg[p2][ne2]); }
        }
        __syncthreads();
#pragma unroll
        for (int p2 = 0; p2 < 2; ++p2)
#pragma unroll
            for (int ne2 = 0; ne2 < 2; ++ne2) { f32x4 sg;
#pragma unroll
                for (int r = 0; r < 4; ++r) sg[r] = sigmoidf_(lg[p2][ne2][r]);
                *(LAS f32x4*)(Sc + (p2 * 32 + 16 * st + fr) * 128 + 32 * eg + 16 * ne2 + 4 * fq) = sg; }
        if (c.tid < 128) hist[c.tid] = 0;
        __syncthreads();
        {
#pragma unroll 2
            for (int q = 0; q < 8; ++q) { const int rr = w * 8 + q;
                const float s0 = Sc[rr * 128 + lane], s1 = Sc[rr * 128 + 64 + lane];
                const unsigned u0 = sortable_u32(s0 + rb0), u1 = sortable_u32(s1 + rb1);
                unsigned thr = 0u;
                for (int bit = 31; bit >= 0; --bit) { const unsigned cand = thr | (1u << bit); const int n = popc64(__ballot(u0 >= cand)) + popc64(__ballot(u1 >= cand)); if (n >= 8) { thr = cand; if (n == 8) break; } }
                const bool gt0 = u0 > thr, gt1 = u1 > thr, eq0 = u0 == thr, eq1 = u1 == thr;
                const unsigned long long me0 = __ballot(eq0), me1 = __ballot(eq1);
                const int need = 8 - popc64(__ballot(gt0)) - popc64(__ballot(gt1));
                const bool sel0 = gt0 || (eq0 && rank_lt(me0) < need), sel1 = gt1 || (eq1 && popc64(me0) + rank_lt(me1) < need);
                const unsigned long long m0 = __ballot(sel0), m1 = __ballot(sel1);
                const float tot = wave_sum((sel0 ? s0 : 0.f) + (sel1 ? s1 : 0.f));
                if (sel0) { const int k = rank_lt(m0); const int lr = __hip_atomic_fetch_add(&hist[lane], 1, __ATOMIC_RELAXED, __HIP_MEMORY_SCOPE_WORKGROUP); sel[rr * 8 + k] = (lane << 16) | lr; selg[rr * 8 + k] = s0 / tot * 2.5f; }
                if (sel1) { const int k = popc64(m0) + rank_lt(m1); const int lr = __hip_atomic_fetch_add(&hist[64 + lane], 1, __ATOMIC_RELAXED, __HIP_MEMORY_SCOPE_WORKGROUP); sel[rr * 8 + k] = ((64 + lane) << 16) | lr; selg[rr * 8 + k] = s1 / tot * 2.5f; } }
        }
        __syncthreads();
        if (c.tid < 128) gbase[c.tid] = atomicAdd(&cnt[c.tid * 32], hist[c.tid]);
        __syncthreads();
        { const int sv = sel[c.tid], e = sv >> 16, lr = sv & 0xffff; const int slot = (grp * 64 + (c.tid >> 3)) * 8 + (c.tid & 7);
          list[(size_t)e * LISTCAP + gbase[e] + lr] = slot; gate[slot] = selg[c.tid]; }
    }
}

struct MoeOrder {
    const char* Abase; const char* Bbase; size_t Bstride; int K, NT, NTG, total, G, c, mode, tid0;
    LAS int* tab; LAS int* desc;
    __device__ __forceinline__ bool next(int i, g8::Unit& u) const {
        const int ip = i / NTG, q = i - ip * NTG;
        const long L = (long)ip * G + c; if (L >= total || ip >= TAB_SLOTS) return false;
        const int d = desc[ip]; const int e = d >> 12, pn = (d & 15) * NTG + q;
        u.pm = (d >> 4) & 255; u.pn = pn; u.aux = ip; u.A = Abase; u.B = Bbase + (size_t)e * Bstride + (size_t)pn * 256 * K * 2; return true;
    }
    __device__ __forceinline__ void aoff(const g8::Unit& u, int tid, unsigned (&o)[2][2]) const {
#pragma unroll
        for (int i = 0; i < 2; ++i) { int R, C; g8::stage_rc(tid * 16 + i * 8192, R, C);
#pragma unroll
            for (int h = 0; h < 2; ++h) { int s = tab[u.aux * 256 + h * 128 + R]; s = s < 0 ? 0 : s; const int row = mode ? s : (s < TK ? (s >> 3) : s - TK);
                o[h][i] = (unsigned)(row * K + C) * 2u; } }
    }
};
__device__ __forceinline__ void moe_setup(const Ctx& c, MoeOrder& S, const int* cnt, int NT, int NTG) {
    LAS int* pref = (LAS int*)(c.lds + LDS_PREF); LAS int* desc = (LAS int*)(c.lds + LDS_DESC); LAS int* tab = (LAS int*)(c.lds + LDS_TAB);
    LAS int* cntl = pref + 132;
    const int* list = (const int*)(c.ws + WS_LIST);
    if (c.tid < 64) { int nb[3]; int loc = 0;
#pragma unroll
        for (int q = 0; q < 3; ++q) { const int e = c.tid * 3 + q; int n = 0; if (e < NE) n = cnt[e * 32]; else if (e == NE) n = T; nb[q] = (n + 255) >> 8; loc += nb[q]; if (e <= NE) cntl[e] = n; }
        int inc = loc;
#pragma unroll
        for (int o = 1; o < 64; o <<= 1) { const int v = __shfl_up(inc, o); if (c.tid >= o) inc += v; }
        int acc = inc - loc;
#pragma unroll
        for (int q = 0; q < 3; ++q) { const int e = c.tid * 3 + q; if (e <= NE1) pref[e] = acc; acc += nb[q]; } }
    __syncthreads();
    const int NG = NT / NTG; const int total = pref[NE1] * NG;
    LAS float* gtab = (LAS float*)(c.lds + LDS_GTAB); const float* gate = (const float*)(c.ws + WS_GATE);
    S.NT = NT; S.NTG = NTG; S.total = total; S.G = c.G; S.c = c.bid; S.tab = tab; S.desc = desc;
    {
        int sv[TAB_SLOTS / 2];
#pragma unroll
        for (int k = 0; k < TAB_SLOTS / 2; ++k) { const int i = (c.tid >> 8) + 2 * k; sv[k] = -2;
            const long L = (long)i * c.G + c.bid;
            if (L < total) {
                int wgid = (int)L; { const int q = total / 8, r = total % 8, xcd = wgid % 8, off = wgid / 8; wgid = (xcd < r ? xcd * (q + 1) : r * (q + 1) + (xcd - r) * q) + off; }
                const int rbg = wgid / NG, pn = wgid % NG;
                int lo = 0, hi = NE1;
                while (hi - lo > 1) { const int mid = (lo + hi) >> 1; if (pref[mid] <= rbg) lo = mid; else hi = mid; }
                const int e = lo, rb = rbg - pref[e], n = cntl[e];
                if ((c.tid & 255) == 0) desc[i] = (e << 12) | (rb << 4) | pn;
                const int r = rb * 256 + (c.tid & 255); sv[k] = -1; if (r < n) sv[k] = (e < NE) ? list[(size_t)e * LISTCAP + r] : TK + r; } }
#pragma unroll
        for (int k = 0; k < TAB_SLOTS / 2; ++k) { const int i = (c.tid >> 8) + 2 * k; if (sv[k] != -2) { tab[i * 256 + (c.tid & 255)] = sv[k]; gtab[i * 256 + (c.tid & 255)] = sv[k] >= 0 ? gate[sv[k]] : 0.f; } }
    }
    __syncthreads();
}
struct EpiMoeGU {
    static constexpr bool PERM = true;
    bf16_t* H; LAS int* tab;
    __device__ __forceinline__ void init(f32x4 (&acc)[2][2][4][2], const g8::Unit&, int, int) const {
#pragma unroll
        for (int a = 0; a < 2; ++a)
#pragma unroll
            for (int b = 0; b < 2; ++b)
#pragma unroll
                for (int m = 0; m < 4; ++m)
#pragma unroll
                    for (int n = 0; n < 2; ++n) acc[a][b][m][n] = (f32x4){0.f, 0.f, 0.f, 0.f}; }
    __device__ __forceinline__ void operator()(const f32x4 (&acc)[2][2][4][2], const g8::Unit& u, int wr, int wc, int fr, int fq) const {
        int sv[2][4];
#pragma unroll
        for (int ai = 0; ai < 2; ++ai)
#pragma unroll
            for (int m = 0; m < 4; ++m) sv[ai][m] = tab[u.aux * 256 + ai * 128 + wr * 64 + m * 16 + fr];
#pragma unroll
        for (int ai = 0; ai < 2; ++ai)
#pragma unroll
            for (int m = 0; m < 4; ++m) { const int s = sv[ai][m];
                if (s >= 0) { u32x4 w;
#pragma unroll
                    for (int n = 0; n < 2; ++n) { const f32x4 g = acc[ai][0][m][n], up = acc[ai][1][m][n];
                        const f32x4 hv = silu4(g) * up; w[2 * n] = pk2(hv[0], hv[1]); w[2 * n + 1] = pk2(hv[2], hv[3]); }
                    *(u32x4*)(H + (size_t)s * ED + u.pn * 128 + wc * 32 + fq * 8) = w; } }
    }
};
struct EpiMoeDN {
    static constexpr bool PERM = true;
    unsigned char* Y; LAS float* gtab; LAS int* tab;
    __device__ __forceinline__ void init(f32x4 (&acc)[2][2][4][2], const g8::Unit&, int, int) const {
#pragma unroll
        for (int a = 0; a < 2; ++a)
#pragma unroll
            for (int b = 0; b < 2; ++b)
#pragma unroll
                for (int m = 0; m < 4; ++m)
#pragma unroll
                    for (int n = 0; n < 2; ++n) acc[a][b][m][n] = (f32x4){0.f, 0.f, 0.f, 0.f}; }
    __device__ __forceinline__ void operator()(const f32x4 (&acc)[2][2][4][2], const g8::Unit& u, int wr, int wc, int fr, int fq) const {
        int sv[2][4]; float gv[2][4];
#pragma unroll
        for (int ai = 0; ai < 2; ++ai)
#pragma unroll
            for (int m = 0; m < 4; ++m) { const int r = ai * 128 + wr * 64 + m * 16 + fr; sv[ai][m] = tab[u.aux * 256 + r]; gv[ai][m] = gtab[u.aux * 256 + r]; }
#pragma unroll
        for (int ai = 0; ai < 2; ++ai)
#pragma unroll
            for (int m = 0; m < 4; ++m) { const int s = sv[ai][m];
                if (s >= TK) {
#pragma unroll
                    for (int bj = 0; bj < 2; ++bj) { u32x4 w;
#pragma unroll
                        for (int n = 0; n < 2; ++n) { const f32x4 a = acc[ai][bj][m][n]; w[2 * n] = pk2(a[0], a[1]); w[2 * n + 1] = pk2(a[2], a[3]); }
                        *(u32x4*)((bf16_t*)(Y + (size_t)TK * D) + (size_t)(s - TK) * D + u.pn * 256 + bj * 128 + wc * 32 + fq * 8) = w; }
                } else if (s >= 0) { const float gt = gv[ai][m] * 64.f;
                    u32x2 w2[2];
#pragma unroll
                    for (int bj = 0; bj < 2; ++bj)
#pragma unroll
                        for (int n = 0; n < 2; ++n) { f32x4 a = acc[ai][bj][m][n] * gt;
#pragma unroll
                            for (int e = 0; e < 4; ++e) a[e] = fminf(fmaxf(a[e], -448.f), 448.f);
                            unsigned pw = 0u; pw = __builtin_amdgcn_cvt_pk_fp8_f32(a[0], a[1], pw, false); pw = __builtin_amdgcn_cvt_pk_fp8_f32(a[2], a[3], pw, true); w2[bj][n] = pw; }
                    const auto r0 = __builtin_amdgcn_permlane16_swap(w2[0][0], w2[1][0], false, false), r1 = __builtin_amdgcn_permlane16_swap(w2[0][1], w2[1][1], false, false);
                    u32x4 w; w[0] = r0[0]; w[1] = r1[0]; w[2] = r0[1]; w[3] = r1[1];
                    *(u32x4*)(Y + (size_t)s * D + u.pn * 256 + (fq & 1) * 128 + wc * 32 + (fq & 2) * 8) = w; } }
    }
};
__device__ __forceinline__ void phase_moe_gu(const Ctx& c, int L) {
    MoeOrder S; S.Abase = (const char*)(c.ws + WS_XB); S.Bbase = (const char*)(c.ws + WS_WGU) + (size_t)L * NE1 * 512 * D * 2; S.Bstride = (size_t)512 * D * 2; S.K = D; S.mode = 0; S.tid0 = c.tid;
    moe_setup(c, S, (const int*)(c.ws + CTL_CNT) + L * NE * 32, 2, 1);
    EpiMoeGU E{(bf16_t*)(c.ws + WS_HID), S.tab};
    g8::gemm_phase<EpiMoeGU, MoeOrder>(c.lds + LDS_STAGE, D, S, E);
}
__device__ __forceinline__ void phase_moe_dn(const Ctx& c, int L) {
    MoeOrder S; S.Abase = (const char*)(c.ws + WS_HID); S.Bbase = (const char*)(c.ws + WS_WDN) + (size_t)L * NE1 * D * ED * 2; S.Bstride = (size_t)D * ED * 2; S.K = ED; S.mode = 1; S.tid0 = c.tid;
#if N_LAUNCH_MODE == 1
    { LAS int* pref = (LAS int*)(c.lds + LDS_PREF); S.NT = 4; S.NTG = 2; S.total = pref[NE1] * 2; S.G = c.G; S.c = c.bid; S.tab = (LAS int*)(c.lds + LDS_TAB); S.desc = (LAS int*)(c.lds + LDS_DESC); }
#else
    moe_setup(c, S, (const int*)(c.ws + CTL_CNT) + L * NE * 32, 4, 2);
#endif
    EpiMoeDN E{(unsigned char*)(c.ws + WS_U1), (LAS float*)(c.lds + LDS_GTAB), S.tab};
    g8::gemm_phase<EpiMoeDN, MoeOrder>(c.lds + LDS_STAGE, ED, S, E);
}

constexpr int PH_PER_LAYER = 9;
constexpr int N_PHASES = 1 + 4 * PH_PER_LAYER;

__global__ void __launch_bounds__(NTHREADS, 2) fwd_kernel(Params p) {
    extern __shared__ __attribute__((aligned(16))) unsigned char lds_raw[];
    LAS unsigned char* const lds0 = (LAS unsigned char*)lds_raw;
    const int wave_id = __builtin_amdgcn_readfirstlane((int)threadIdx.x >> 6);
    volatile LAS unsigned* misc = (volatile LAS unsigned*)(lds0 + LDS_MISC);
    if (threadIdx.x < 4) misc[threadIdx.x] = 0u;
    __syncthreads();
    const int lo = p.ph_lo, hi = p.ph_hi;
    XcdBarrier bar; bar.bar = (unsigned*)(p.ws + WS_CTL); bar.x = 0; bar.st = misc;
    if (hi - lo > 1) bar = xcd_barrier_post((unsigned*)(p.ws + WS_CTL), misc);
#define MKCTX() Ctx c; { int wv_ = wave_id; asm volatile("" : "+s"(wv_)); int tid_ = wv_ * 64 + (int)__builtin_amdgcn_mbcnt_hi(~0u, __builtin_amdgcn_mbcnt_lo(~0u, 0u)); asm volatile("" : "+v"(tid_)); int bid_ = blockIdx.x; asm volatile("" : "+s"(bid_)); unsigned long long ws_ = (unsigned long long)p.ws; asm volatile("" : "+s"(ws_)); \
        c.in = p.in; c.out = (float*)p.out; c.ws = (unsigned char*)(GAS unsigned char*)ws_; c.lds = lds0; c.tid = tid_; c.lane = tid_ & 63; c.wid = __builtin_amdgcn_readfirstlane(tid_ >> 6); c.bid = bid_; c.G = gridDim.x; \
        c.gtid = c.bid * NTHREADS + c.tid; c.gthreads = c.G * NTHREADS; c.gw = c.bid * 8 + c.wid; c.nwaves = c.G * 8; } unsigned char* const ws = c.ws; (void)ws
    int id = 0;
#ifndef PMASK
#define PMASK 0xffffffffu
#endif
#ifndef DUPMASK
#define DUPMASK 0u
#endif
#define PHASE(k, body) do { if (((PMASK >> (k)) & 1u) && lo <= id && id < hi) { MKCTX(); body; if ((DUPMASK >> (k)) & 1u) { body; } if (id + 1 < hi) xcd_barrier(bar, c.tid == 0); } ++id; } while (0)
    PHASE(0, phase_convert(c));
#pragma unroll 1
    for (int L = 0; L < 4; ++L) {
        const int j = L >> 1; const bool cd = (L & 1);
        if (cd) {
            PHASE(1, phase_cd_inproj(c, j));
        } else {
            PHASE(2, phase_ab_inproj(c, j));
        }
        if (!cd) { PHASE(3, phase_ab_p1(c)); PHASE(4, phase_ab_p2(c, j)); PHASE(16, phase_ab_p3(c)); }
        else     { PHASE(5, phase_cd_p1(c, j)); PHASE(15, phase_cd_scan2(c)); id += 1; }
        {
            const size_t Woff = cd ? WS_WCDOUT + (size_t)j * D * CD_OUT * 2 : WS_WABOUT + (size_t)j * D * AB_OUT * 2;
            const int K = cd ? CD_OUT : AB_OUT; const float* bias = cd ? (const float*)p.in[18] + (size_t)j * D : (const float*)p.in[5] + (size_t)j * D;
            PHASE(8, phase_dense(c, (const bf16_t*)(ws + WS_YCAT), (const bf16_t*)(ws + Woff), T, D, K, (bf16_t*)(ws + WS_HB), D, bias));
        }
        PHASE(9, phase_ln_route(c, L));
        PHASE(12, phase_moe_gu(c, L));
        PHASE(13, phase_moe_dn(c, L));
        PHASE(14, phase_ln_moe(c, (const float*)p.in[29] + (size_t)L * D, (const float*)p.in[30] + (size_t)L * D, L == 3 ? (float*)p.out : (float*)nullptr));
    }
#undef PHASE
}

extern "C" void kernel_launch(void* const* d_in, const int* in_sizes, int n_in, void* d_out, int out_size, void* d_ws, size_t ws_size, hipStream_t stream) {
    static int grid = 0;
    if (grid == 0) {
        if (n_in != 31 || out_size != T * D || ws_size < WS_END) { fprintf(stderr, "kernel_launch: unexpected shapes (n_in %d out %d ws %zu need %zu)\n", n_in, out_size, ws_size, (size_t)WS_END); grid = -1; return; }
        int dev = 0, cus = 0, per_cu = 0;
        if (hipGetDevice(&dev) != hipSuccess || hipDeviceGetAttribute(&cus, hipDeviceAttributeMultiprocessorCount, dev) != hipSuccess) { grid = -1; return; }
        if (hipFuncSetAttribute((const void*)fwd_kernel, hipFuncAttributeMaxDynamicSharedMemorySize, LDS_BYTES) != hipSuccess) { fprintf(stderr, "kernel_launch: hipFuncSetAttribute failed\n"); grid = -1; return; }
        if (hipOccupancyMaxActiveBlocksPerMultiprocessor(&per_cu, (const void*)fwd_kernel, NTHREADS, LDS_BYTES) != hipSuccess || per_cu < 1) fprintf(stderr, "kernel_launch: occupancy query says %d\n", per_cu);
        (void)hipGetLastError();
        grid = cus;
    }
    if (grid < 0) return;
    (void)hipMemsetAsync((char*)d_ws + WS_CTL, 0, CTL_BYTES, stream);
    Params p{};
    for (int i = 0; i < 31; ++i) p.in[i] = (const GAS float*)d_in[i];
    p.out = (GAS float*)d_out; p.ws = (GAS unsigned char*)d_ws;
#if N_LAUNCH_MODE == 1
    p.ph_lo = 0; p.ph_hi = N_PHASES;
    hipLaunchKernelGGL(fwd_kernel, dim3(grid), dim3(NTHREADS), LDS_BYTES, stream, p);
#else
    for (int i = 0; i < N_PHASES; ++i) { p.ph_lo = i; p.ph_hi = i + 1; hipLaunchKernelGGL(fwd_kernel, dim3(grid), dim3(NTHREADS), LDS_BYTES, stream, p); }
#endif
}
```
